# Optimizing an MI355X kernel written in HIP

```python
import jax
import jax.numpy as jnp
from jax import lax
import numpy as np

D_MODEL = 1024
BATCH = 4
SEQ = 8192
DEPTH = 1

GRID_W = 64
CTX_LEN = 256
HEAD_DIM = 64
MIX_WIDTH = D_MODEL
FOURIER_HEADS = MIX_WIDTH // (4 * HEAD_DIM)
FOURIER_WIDTH = FOURIER_HEADS * HEAD_DIM
ATTN_HEADS = (MIX_WIDTH - FOURIER_WIDTH) // HEAD_DIM
KV_HEADS = 4
Q_PER_KV = ATTN_HEADS // KV_HEADS
ATTN_WIDTH = ATTN_HEADS * HEAD_DIM
KV_WIDTH = KV_HEADS * HEAD_DIM
KV_COL0 = FOURIER_WIDTH + ATTN_WIDTH
IN_WIDTH = KV_COL0 + 2 * KV_WIDTH
Q_BLOCK = 128
ATTN_SCALE = HEAD_DIM ** -0.5
ROPE_THETA = 10000.0
AXIS_ROT = HEAD_DIM // 2
N_EXPERTS = 256
TOP_K = 8
N_EXPERT_GROUPS = 8
TOPK_GROUPS = 4
EXPERTS_PER_GROUP = N_EXPERTS // N_EXPERT_GROUPS
EXPERT_FF = D_MODEL // 4
SHARED_FF = D_MODEL // 4
ROUTED_SCALE = 2.5
EXPERT_BLOCK = 128
RMS_EPS = 1e-6

kernel_name = 'hybrid_fourier_gqa_moe_dit_block'


def rmsnorm(x, g):
    xf = x.astype(jnp.float32)
    y = xf * lax.rsqrt(jnp.mean(xf * xf, axis=-1, keepdims=True) + RMS_EPS)
    return (y * g.astype(jnp.float32)).astype(x.dtype)


def modulate(x, g, shift, scale):
    return rmsnorm(x, g) * (1 + scale) + shift


def adaln(cond, w_ada, b_ada):
    return jnp.split(jax.nn.silu(cond) @ w_ada + b_ada, 6, axis=-1)


def heads(t, n_heads):
    return t.reshape(t.shape[0], t.shape[1], n_heads, HEAD_DIM)


def axial_rope_tables(n_tokens):
    rows = n_tokens // GRID_W
    row = jnp.broadcast_to(jnp.arange(rows, dtype=jnp.float32)[:, None], (rows, GRID_W)).reshape(-1)
    col = jnp.broadcast_to(jnp.arange(GRID_W, dtype=jnp.float32)[None, :], (rows, GRID_W)).reshape(-1)
    n_freq = AXIS_ROT // 2
    inv_freq = ROPE_THETA ** (-jnp.arange(n_freq, dtype=jnp.float32) / n_freq)
    ang_r = row[:, None] * inv_freq
    ang_c = col[:, None] * inv_freq
    ang = jnp.concatenate([ang_r, ang_r, ang_c, ang_c], axis=-1)
    return jnp.cos(ang), jnp.sin(ang)


def _rotate_half(z):
    a, b = jnp.split(z, 2, axis=-1)
    return jnp.concatenate([-b, a], axis=-1)


def apply_axial_rope(t, cos, sin):
    tf = t.astype(jnp.float32)
    t_row, t_col = jnp.split(tf, 2, axis=-1)
    rot = jnp.concatenate([_rotate_half(t_row), _rotate_half(t_col)], axis=-1)
    return (tf * cos[:, None, :] + rot * sin[:, None, :]).astype(t.dtype)


def fourier_mixer(u, w_fourier):
    b, l = u.shape[:2]
    uh = heads(u, FOURIER_HEADS).transpose(0, 2, 1, 3).astype(jnp.float32)
    spec = jnp.fft.fft2(uh, norm='ortho').real.astype(u.dtype)
    return jnp.einsum('bhld,hde->blhe', spec, w_fourier).reshape(b, l, FOURIER_WIDTH)


def gqa_attend(q, k, v):
    b, lq = q.shape[:2]
    qg = q.reshape(b, lq, KV_HEADS, Q_PER_KV, HEAD_DIM)
    s = jnp.einsum('bqkgd,bskd->bkgqs', qg, k, preferred_element_type=jnp.float32) * ATTN_SCALE
    p = jax.nn.softmax(s, axis=-1).astype(v.dtype)
    o = jnp.einsum('bkgqs,bskd->bqkgd', p, v)
    return o.reshape(b, lq, ATTN_WIDTH)


def blocked_attention(q, k, v):
    b, s = q.shape[:2]
    nb = s // Q_BLOCK
    qb = jnp.moveaxis(q.reshape(b, nb, Q_BLOCK, ATTN_HEADS, HEAD_DIM), 1, 0)
    o = lax.map(lambda qblk: gqa_attend(qblk, k, v), qb)
    return jnp.moveaxis(o, 0, 1).reshape(b, s, ATTN_WIDTH)


def swiglu(t, w_gu, w_down):
    a, g = jnp.split(t @ w_gu, 2, axis=-1)
    return (jax.nn.silu(a) * g) @ w_down


def moe_ffn(h, w_router, router_bias, w_expert_gu, w_expert_down, w_shared_gu, w_shared_down):
    n = h.shape[0]
    scores = jax.nn.sigmoid(jnp.einsum('nd,de->ne', h, w_router, preferred_element_type=jnp.float32))
    sel = scores + router_bias.astype(jnp.float32)
    group_score = lax.top_k(sel.reshape(n, N_EXPERT_GROUPS, EXPERTS_PER_GROUP), 2)[0].sum(-1)
    _, top_groups = lax.top_k(group_score, TOPK_GROUPS)
    group_keep = jnp.any(top_groups[:, :, None] == jnp.arange(N_EXPERT_GROUPS)[None, None, :], axis=1)
    sel = jnp.where(jnp.repeat(group_keep, EXPERTS_PER_GROUP, axis=1), sel, -jnp.inf)
    _, top_e = lax.top_k(sel, TOP_K)
    gate = jnp.take_along_axis(scores, top_e, axis=1)
    gate = gate / jnp.sum(gate, axis=-1, keepdims=True) * ROUTED_SCALE

    n_assign = n * TOP_K
    flat_e = top_e.reshape(n_assign)
    order = jnp.argsort(flat_e)
    sorted_e = flat_e[order]
    sorted_tok = (order // TOP_K).astype(jnp.int32)
    sorted_gate = gate.reshape(n_assign)[order].astype(h.dtype)
    counts = jnp.bincount(flat_e, length=N_EXPERTS)
    padded = (counts + EXPERT_BLOCK - 1) // EXPERT_BLOCK * EXPERT_BLOCK
    pad_end = jnp.cumsum(padded)
    pad_start = pad_end - padded
    start = jnp.cumsum(counts) - counts
    dest = pad_start[sorted_e] + (jnp.arange(n_assign) - start[sorted_e])
    n_blocks = -(-n_assign // EXPERT_BLOCK) + N_EXPERTS
    n_rows = n_blocks * EXPERT_BLOCK
    row_tok = jnp.zeros((n_rows,), jnp.int32).at[dest].set(sorted_tok)
    row_gate = jnp.zeros((n_rows,), h.dtype).at[dest].set(sorted_gate)
    block_start = jnp.arange(n_blocks) * EXPERT_BLOCK
    block_e = jnp.minimum(jnp.searchsorted(pad_end, block_start, side='right'), N_EXPERTS - 1)

    def block_step(y, blk):
        tok, g, e = blk
        out = swiglu(h[tok], w_expert_gu[e], w_expert_down[e])
        return y.at[tok].add(out * g[:, None]), None

    y, _ = lax.scan(block_step, jnp.zeros_like(h),
                    (row_tok.reshape(n_blocks, EXPERT_BLOCK), row_gate.reshape(n_blocks, EXPERT_BLOCK), block_e))
    return y + swiglu(h, w_shared_gu, w_shared_down)


def moe_tokens(t, moe_w):
    b, l, d = t.shape
    return moe_ffn(t.reshape(b * l, d), *moe_w).reshape(b, l, d)


def trunk_layer(x, ctx, c, c_ctx, cos, sin, lw, moe_w, update_ctx):
    norm1_g, w_ada, b_ada, w_in, w_fourier, q_norm_g, k_norm_g, w_out, norm2_g = lw
    b, l = x.shape[:2]
    sh1, sc1, g1, sh2, sc2, g2 = [m[:, None, :] for m in adaln(c, w_ada, b_ada)]
    csh1, csc1, cg1, csh2, csc2, cg2 = adaln(c_ctx, w_ada, b_ada)

    hc = modulate(ctx, norm1_g, csh1, csc1)
    kv_c = hc @ w_in[:, KV_COL0:]
    k_c = rmsnorm(heads(kv_c[..., :KV_WIDTH], KV_HEADS), k_norm_g)
    v_c = heads(kv_c[..., KV_WIDTH:], KV_HEADS)

    h = modulate(x, norm1_g, sh1, sc1)
    z = h @ w_in
    u = z[..., :FOURIER_WIDTH]
    q = apply_axial_rope(rmsnorm(heads(z[..., FOURIER_WIDTH:KV_COL0], ATTN_HEADS), q_norm_g), cos, sin)
    k = apply_axial_rope(rmsnorm(heads(z[..., KV_COL0:KV_COL0 + KV_WIDTH], KV_HEADS), k_norm_g), cos, sin)
    v = heads(z[..., KV_COL0 + KV_WIDTH:], KV_HEADS)
    k_all = jnp.concatenate([k, k_c], axis=1)
    v_all = jnp.concatenate([v, v_c], axis=1)
    mix = jnp.concatenate([fourier_mixer(u, w_fourier), blocked_attention(q, k_all, v_all)], axis=-1)
    x_new = x + g1 * (mix @ w_out)
    x_new = x_new + g2 * moe_tokens(modulate(x_new, norm2_g, sh2, sc2), moe_w)

    if update_ctx:
        zc = hc @ w_in[:, :KV_COL0]
        q_c = rmsnorm(heads(zc[..., FOURIER_WIDTH:], ATTN_HEADS), q_norm_g)
        mix_c = jnp.concatenate([fourier_mixer(zc[..., :FOURIER_WIDTH], w_fourier), gqa_attend(q_c, k_c, v_c)], axis=-1)
        ctx = ctx + cg1 * (mix_c @ w_out)
        ctx = ctx + cg2 * moe_tokens(modulate(ctx, norm2_g, csh2, csc2), moe_w)
    return x_new, ctx


def setup_inputs(seed: int = 0) -> dict:
    key = jax.random.key(seed)
    ks = jax.random.split(key, 20)
    f32 = jnp.float32

    def nrm(k, shape, scale):
        return jax.random.normal(k, shape, f32) * scale

    def gain(k, shape):
        return 1.0 + 0.02 * jax.random.normal(k, shape, f32)

    return {
        'x': nrm(ks[0], (BATCH, SEQ, D_MODEL), 1.0),
        'c': nrm(ks[1], (BATCH, D_MODEL), 1.0),
        'ctx': nrm(ks[2], (BATCH, CTX_LEN, D_MODEL), 1.0),
        'c_ctx': nrm(ks[3], (D_MODEL,), 1.0),
        'norm1_g': gain(ks[4], (DEPTH, D_MODEL)),
        'w_ada': nrm(ks[5], (DEPTH, D_MODEL, 6 * D_MODEL), 0.5 * D_MODEL ** -0.5),
        'b_ada': nrm(ks[6], (DEPTH, 6 * D_MODEL), 0.02),
        'w_in': nrm(ks[7], (DEPTH, D_MODEL, IN_WIDTH), D_MODEL ** -0.5),
        'w_fourier': nrm(ks[8], (DEPTH, FOURIER_HEADS, HEAD_DIM, HEAD_DIM), HEAD_DIM ** -0.5),
        'q_norm_g': gain(ks[9], (DEPTH, HEAD_DIM)),
        'k_norm_g': gain(ks[10], (DEPTH, HEAD_DIM)),
        'w_out': nrm(ks[11], (DEPTH, MIX_WIDTH, D_MODEL), MIX_WIDTH ** -0.5),
        'norm2_g': gain(ks[12], (DEPTH, D_MODEL)),
        'w_router': nrm(ks[13], (DEPTH, D_MODEL, N_EXPERTS), D_MODEL ** -0.5),
        'router_bias': nrm(ks[14], (DEPTH, N_EXPERTS), 0.01),
        'w_expert_gu': nrm(ks[15], (DEPTH, N_EXPERTS, D_MODEL, 2 * EXPERT_FF), D_MODEL ** -0.5),
        'w_expert_down': nrm(ks[16], (DEPTH, N_EXPERTS, EXPERT_FF, D_MODEL), EXPERT_FF ** -0.5),
        'w_shared_gu': nrm(ks[17], (DEPTH, D_MODEL, 2 * SHARED_FF), D_MODEL ** -0.5),
        'w_shared_down': nrm(ks[18], (DEPTH, SHARED_FF, D_MODEL), SHARED_FF ** -0.5),
        'final_norm_g': gain(ks[19], (D_MODEL,)),
    }


def reference(x, c, ctx, c_ctx, norm1_g, w_ada, b_ada, w_in, w_fourier, q_norm_g, k_norm_g, w_out,
              norm2_g, w_router, router_bias, w_expert_gu, w_expert_down, w_shared_gu, w_shared_down,
              final_norm_g):
    cos, sin = axial_rope_tables(x.shape[1])
    for i in range(DEPTH):
        lw = (norm1_g[i], w_ada[i], b_ada[i], w_in[i], w_fourier[i], q_norm_g[i], k_norm_g[i], w_out[i], norm2_g[i])
        moe_w = (w_router[i], router_bias[i], w_expert_gu[i], w_expert_down[i], w_shared_gu[i], w_shared_down[i])
        x, ctx = trunk_layer(x, ctx, c, c_ctx, cos, sin, lw, moe_w, update_ctx=i + 1 < DEPTH)
    return rmsnorm(x, final_norm_g)
```

```cpp
#include <hip/hip_runtime.h>
#include <hip/hip_bf16.h>
#include <cstdio>
#include <cstdint>
#include <cmath>

#ifndef MK_N_LAUNCHES
#define MK_N_LAUNCHES 1
#endif
constexpr int PER_PHASE = 11;
#ifndef DBG
#define DBG 0
#endif
constexpr int N_LAUNCHES = MK_N_LAUNCHES;

#define GAS __attribute__((address_space(1)))
#define LAS __attribute__((address_space(3)))
typedef unsigned short u16;
typedef short bf16x8 __attribute__((ext_vector_type(8)));
typedef _Float16 half8 __attribute__((ext_vector_type(8)));
typedef _Float16 half2v __attribute__((ext_vector_type(2)));
typedef float f32x4 __attribute__((ext_vector_type(4)));
typedef float f32x2 __attribute__((ext_vector_type(2)));
typedef unsigned u32x4 __attribute__((ext_vector_type(4)));
typedef unsigned u32x2 __attribute__((ext_vector_type(2)));
typedef GAS unsigned gu32;

constexpr int DM = 1024, NB = 4, SEQ = 8192, NTOK = NB * SEQ, CTXL = 256, NCTX = NB * CTXL, LKV = SEQ + CTXL;
constexpr int NQH = 12, NKVH = 4, HD = 64, QW = NQH * HD, KVW = NKVH * HD;
constexpr int NIN = 1792;
constexpr int MIN_ROWS = NTOK + NCTX;
constexpr int NEXP = 256, NEXPS = 257, TOPK = 8, EFF = 256, NSLOT = 9;
constexpr int MAXTILES = 1408;
constexpr float RMS_EPS = 1e-6f;
#ifndef MOE_F16
#define MOE_F16 0
#endif
constexpr bool MOEF16 = MOE_F16;
constexpr float C2 = 0.125f * 1.4426950408889634f;

constexpr size_t MiB = 1u << 20;
constexpr size_t WS_CTL = 0, CTL_ZERO_BYTES = 1 * MiB;
constexpr size_t WS_TAB = 1 * MiB;
constexpr size_t WS_BIN = 2 * MiB;
constexpr size_t WS_BOUT = 6 * MiB;
constexpr size_t WS_BR = 8 * MiB;
constexpr size_t WS_K = 16 * MiB;
constexpr size_t WS_V = 34 * MiB;
constexpr size_t WS_Z = 52 * MiB;
constexpr size_t WS_Q = 84 * MiB;
constexpr size_t WS_XN = 132 * MiB;
constexpr size_t WS_MIX = 198 * MiB;
constexpr size_t WS_H2 = 262 * MiB;
constexpr size_t WS_LOG = 326 * MiB;
constexpr size_t WS_LIST = 358 * MiB;
constexpr size_t WS_BGU = 424 * MiB;
constexpr size_t WS_BD = 682 * MiB;
constexpr size_t WS_ACT = 812 * MiB;
constexpr size_t WS_C = 990 * MiB;
constexpr size_t WS_END = 1568 * MiB;
constexpr int CW_TMO = 0, CW_CODE = 1;
constexpr int CW_BAR = 4096;
constexpr int CW_CNT = 16384;
constexpr int CW_MOD = 131072;
static_assert(CW_MOD * 4 + 5 * 6144 * 8 <= (int)CTL_ZERO_BYTES, "ctl");

constexpr int RING_OFF = 0, RING_BYTES = 131072;
constexpr int TAB_OFF = RING_BYTES;
constexpr int LDSCTL_OFF = RING_BYTES + 8192, MISC_OFF = LDSCTL_OFF + 320;
constexpr int LDS_BYTES = 147456;

#define LDS_WAIT() asm volatile("s_waitcnt lgkmcnt(0)" ::: "memory")
#define VM_WAIT() asm volatile("s_waitcnt vmcnt(0)" ::: "memory")
#define RLX_AGENT __ATOMIC_RELAXED, __HIP_MEMORY_SCOPE_AGENT

__device__ __forceinline__ unsigned f2bf(float f) { unsigned u = __builtin_bit_cast(unsigned, f); return (u + 0x7fffu + ((u >> 16) & 1u)) >> 16; }
__device__ __forceinline__ unsigned pk2bf(float lo, float hi) { return f2bf(lo) | (f2bf(hi) << 16); }
__device__ __forceinline__ unsigned pk2h(float lo, float hi) { half2v v = {(_Float16)lo, (_Float16)hi}; return __builtin_bit_cast(unsigned, v); }
__device__ __forceinline__ unsigned cvt_pk_bf16(float lo, float hi) { unsigned r; asm volatile("v_cvt_pk_bf16_f32 %0, %1, %2" : "=v"(r) : "v"(lo), "v"(hi)); return r; }
__device__ __forceinline__ float bflo(unsigned w) { return __builtin_bit_cast(float, w << 16); }
__device__ __forceinline__ float bfhi(unsigned w) { return __builtin_bit_cast(float, w & 0xffff0000u); }
typedef long long i64x2 __attribute__((ext_vector_type(2)));
typedef GAS long long gi64;
__device__ __forceinline__ f32x4 mod4(const gi64* MODQ, int idx) {
    const i64x2 a = *(const GAS i64x2*)(MODQ + idx), b = *(const GAS i64x2*)(MODQ + idx + 2);
    return (f32x4){(float)a.x, (float)a.y, (float)b.x, (float)b.y} * 0x1p-36f;
}
__device__ __forceinline__ float wave_sum(float v) {
#pragma unroll
    for (int o = 1; o < 64; o <<= 1) v += __shfl_xor(v, o);
    return v;
}

namespace pg8 {
constexpr int BM = 256, BK = 64, HALF = 128, HTB = HALF * BK * 2, STAGE_BYTES = 8 * HTB;
__host__ __device__ __forceinline__ int lds_byte(int r, int c) { const int st = (r >> 4) * 2 + (c >> 5), rr = r & 15, cc = c & 31, ob = rr * 64 + cc * 2; return st * 1024 + (ob ^ (((ob >> 9) & 1) << 5)); }
__host__ __device__ __forceinline__ void stage_rc(int b, int& R, int& C) { const int st = b / 1024, sb = b % 1024, swz = sb ^ (((sb >> 9) & 1) << 5); R = (st >> 1) * 16 + swz / 64; C = (st & 1) * 32 + (swz % 64) / 2; }
__host__ __device__ __forceinline__ int perm32(int rho) { const int n = rho >> 4, i = rho & 15; return 8 * (i >> 2) + 4 * n + (i & 3); }

struct GUnit { int pm, pn, e, j, nvalid; const char* B; };

template <bool F16> __device__ __forceinline__ f32x4 mma16(bf16x8 a, bf16x8 b, f32x4 c) {
    if constexpr (F16) return __builtin_amdgcn_mfma_f32_16x16x32_f16(__builtin_bit_cast(half8, a), __builtin_bit_cast(half8, b), c, 0, 0, 0);
    else return __builtin_amdgcn_mfma_f32_16x16x32_bf16(a, b, c, 0, 0, 0);
}

template <class Epi, class Sched, bool F16, bool ALIGN_EPI>
__device__ __forceinline__ void gemm_phase(LAS unsigned char* lds, const char* Abase, const int K, const Sched& S, const Epi& E) {
    const int tid = threadIdx.x, wid = __builtin_amdgcn_readfirstlane(tid >> 6), lane = tid & 63, wr = wid >> 2, wc = wid & 3, fr = lane & 15, fq = lane >> 4;
    const int nt = K / BK;
    unsigned voffB[2];
#pragma unroll
    for (int i = 0; i < 2; ++i) { int R, C; stage_rc(tid * 16 + i * 8192, R, C); const int Rb = Epi::PERM ? ((R & ~31) + perm32(R & 31)) : R; voffB[i] = (unsigned)(Rb * K + C) * 2u; }
#define PG8_AOFF(V, UNIT) do { int t_ = tid; asm volatile("" : "+v"(t_)); _Pragma("unroll") for (int _i = 0; _i < 2; ++_i) { int R_, C_; stage_rc(t_ * 16 + _i * 8192, R_, C_); \
        _Pragma("unroll") for (int _h = 0; _h < 2; ++_h) (V)[_h][_i] = ((unsigned)S.arow(UNIT, R_ + HALF * _h) * (unsigned)K + (unsigned)C_) * 2u; } } while (0)
    const size_t kstep = (size_t)(BK * 2);
    const size_t hstep = (size_t)HALF * K * 2;
    const unsigned ldsw = (unsigned)wid * 1024u;
    const int aoff = lds_byte(wr * 64 + fr, fq * 8), boff = lds_byte(wc * 32 + fr, fq * 8);
#define PG8_SA(b, h) (((b) * 2 + (h)) * HTB)
#define PG8_SB(b, h) ((4 + (b) * 2 + (h)) * HTB)
#define PG8_STAGEB(bufoff, gbase) do { _Pragma("unroll") for (int _i = 0; _i < 2; ++_i) \
        __builtin_amdgcn_global_load_lds((const unsigned*)((const char*)(gbase) + voffB[_i]), (LAS unsigned*)(lds + (bufoff) + ldsw + _i * 8192), 16, 0, 0); } while (0)
#define PG8_STAGEA(bufoff, koff, V, h) do { _Pragma("unroll") for (int _i = 0; _i < 2; ++_i) \
        __builtin_amdgcn_global_load_lds((const unsigned*)(Abase + (size_t)(V)[h][_i] + (koff)), (LAS unsigned*)(lds + (bufoff) + ldsw + _i * 8192), 16, 0, 0); } while (0)
#define PG8_LDA(dst, b, h) do { _Pragma("unroll") for (int m = 0; m < 4; ++m) _Pragma("unroll") for (int k = 0; k < 2; ++k) dst[m][k] = *(const LAS bf16x8*)(lds + PG8_SA(b, h) + aoff + m * 2048 + k * 1024); } while (0)
#define PG8_LDB(dst, b, h) do { _Pragma("unroll") for (int n = 0; n < 2; ++n) _Pragma("unroll") for (int k = 0; k < 2; ++k) dst[n][k] = *(const LAS bf16x8*)(lds + PG8_SB(b, h) + boff + n * 2048 + k * 1024); } while (0)
#define PG8_MMA(ai, bj, At, Bt) do { __builtin_amdgcn_s_setprio(1); _Pragma("unroll") for (int m = 0; m < 4; ++m) _Pragma("unroll") for (int n = 0; n < 2; ++n) _Pragma("unroll") for (int k = 0; k < 2; ++k) \
        acc[ai][bj][m][n] = mma16<F16>(Bt[n][k], At[m][k], acc[ai][bj][m][n]); __builtin_amdgcn_s_setprio(0); } while (0)
#define PG8_WAIT_V(n) asm volatile("s_waitcnt vmcnt(" #n ")" ::: "memory")
#define PG8_WAIT_L(n) asm volatile("s_waitcnt lgkmcnt(" #n ")" ::: "memory")
#define PG8_BAR __builtin_amdgcn_s_barrier()
#define PG8_SCHED __builtin_amdgcn_sched_barrier(0)
    GUnit cur, nxt; int ui = 0;
    if (!S.next(0, cur)) return;
    f32x4 acc[2][2][4][2];
#pragma unroll
    for (int a = 0; a < 2; ++a)
#pragma unroll
        for (int b = 0; b < 2; ++b)
#pragma unroll
            for (int m = 0; m < 4; ++m)
#pragma unroll
                for (int n = 0; n < 2; ++n) acc[a][b][m][n] = (f32x4){0.f, 0.f, 0.f, 0.f};
    bf16x8 At[4][2], B0[2][2], B1[2][2];
    unsigned vA[2][2], vN[2][2];
    PG8_AOFF(vA, cur);
    if constexpr (Sched::GATHER) VM_WAIT();
    const char* cB = cur.B;
    PG8_STAGEB(PG8_SB(0, 0), cB); PG8_STAGEB(PG8_SB(0, 1), cB + hstep); PG8_STAGEA(PG8_SA(0, 0), 0, vA, 0); PG8_STAGEA(PG8_SA(0, 1), 0, vA, 1);
    if (wr == 1) PG8_BAR;
    PG8_WAIT_V(2); PG8_BAR;
    PG8_STAGEB(PG8_SB(1, 0), cB + kstep); PG8_STAGEA(PG8_SA(1, 0), kstep, vA, 0); PG8_STAGEB(PG8_SB(1, 1), cB + hstep + kstep);
    PG8_WAIT_V(6); PG8_BAR;
    for (;;) {
        const bool has_next = S.next(ui + 1, nxt);
        const char* nB = cB;
        if (has_next) {
            PG8_AOFF(vN, nxt);
            if constexpr (Sched::GATHER) VM_WAIT();
            nB = nxt.B;
        } else {
#pragma unroll
            for (int h = 0; h < 2; ++h)
#pragma unroll
                for (int i = 0; i < 2; ++i) vN[h][i] = vA[h][i];
        }
        for (int t = 0; t < nt; t += 2) {
            const bool last = (t == nt - 2);
            const size_t k1 = (size_t)(t + 1) * kstep;
            const size_t k2 = last ? (size_t)0 : (size_t)(t + 2) * kstep, k3 = k2 + kstep;
            unsigned v2[2][2];
#pragma unroll
            for (int h = 0; h < 2; ++h)
#pragma unroll
                for (int i = 0; i < 2; ++i) v2[h][i] = last ? vN[h][i] : vA[h][i];
            const char* b2 = (last ? nB : cB) + k2; const char* b3 = b2 + kstep;
            PG8_LDB(B0, 0, 0); PG8_LDB(B1, 0, 1); PG8_SCHED; PG8_LDA(At, 0, 0); PG8_STAGEA(PG8_SA(1, 1), k1, vA, 1);
            PG8_WAIT_V(8); PG8_WAIT_L(0); PG8_BAR; PG8_MMA(0, 0, At, B0); PG8_MMA(0, 1, At, B1); PG8_BAR; PG8_SCHED;
            PG8_LDA(At, 0, 1); PG8_STAGEB(PG8_SB(0, 0), b2); PG8_STAGEB(PG8_SB(0, 1), b2 + hstep); PG8_STAGEA(PG8_SA(0, 0), k2, v2, 0);
            PG8_WAIT_V(8); PG8_WAIT_L(0); PG8_BAR; PG8_MMA(1, 0, At, B0); PG8_MMA(1, 1, At, B1); PG8_BAR; PG8_SCHED;
            PG8_LDB(B0, 1, 0); PG8_LDB(B1, 1, 1); PG8_SCHED; PG8_LDA(At, 1, 0); PG8_STAGEA(PG8_SA(0, 1), k2, v2, 1);
            PG8_WAIT_V(8); PG8_WAIT_L(0); PG8_BAR; PG8_MMA(0, 0, At, B0); PG8_MMA(0, 1, At, B1); PG8_BAR; PG8_SCHED;
            PG8_LDA(At, 1, 1); PG8_STAGEB(PG8_SB(1, 0), b3); PG8_STAGEB(PG8_SB(1, 1), b3 + hstep); PG8_STAGEA(PG8_SA(1, 0), k3, v2, 0);
            PG8_WAIT_V(8); PG8_WAIT_L(0); PG8_BAR; PG8_MMA(1, 0, At, B0); PG8_MMA(1, 1, At, B1); PG8_BAR; PG8_SCHED;
        }
        if constexpr (ALIGN_EPI) { if (wr == 0) PG8_BAR; }
        E(acc, cur, wr, wc, fr, fq);
        if (!has_next) break;
#pragma unroll
        for (int a = 0; a < 2; ++a)
#pragma unroll
            for (int b = 0; b < 2; ++b)
#pragma unroll
                for (int m = 0; m < 4; ++m)
#pragma unroll
                    for (int n = 0; n < 2; ++n) acc[a][b][m][n] = (f32x4){0.f, 0.f, 0.f, 0.f};
        cur = nxt; cB = nB; ++ui;
#pragma unroll
        for (int h = 0; h < 2; ++h)
#pragma unroll
            for (int i = 0; i < 2; ++i) vA[h][i] = vN[h][i];
        if constexpr (ALIGN_EPI) { if (wr == 1) PG8_BAR; }
    }
    PG8_WAIT_V(0);
    if constexpr (!ALIGN_EPI) { if (wr == 0) PG8_BAR; }
    PG8_BAR;
#undef PG8_SA
#undef PG8_SB
#undef PG8_STAGEA
#undef PG8_AOFF
#undef PG8_STAGEB
#undef PG8_LDA
#undef PG8_LDB
#undef PG8_MMA
#undef PG8_WAIT_V
#undef PG8_WAIT_L
#undef PG8_BAR
#undef PG8_SCHED
}
}

namespace attn_body {
using bf16 = __hip_bfloat16;
using s16x4 = __attribute__((ext_vector_type(4))) short;
using f32x16 = __attribute__((ext_vector_type(16))) float;
constexpr int D = 64, DMQ = QW, DMKV = KVW, DMO = DM;
constexpr int NW = 8, QBLK = 32, QB = QBLK * NW, KVBLK = 64, NT = LKV / KVBLK;
static_assert(NT % 2 == 0 && NT >= 8, "tile count");
__device__ __forceinline__ int crow(int r, int hi) { return (r & 3) + 8 * (r >> 2) + 4 * hi; }
#define SBAR() __builtin_amdgcn_sched_barrier(0)
constexpr int NSLOTR = 3, SLOTB = 8192;
constexpr int LDS_K = 0, LDS_V = NSLOTR * SLOTB, LDS_WS = 2 * NSLOTR * SLOTB, LDS_OST = LDS_WS + NW * 64 * 4, ATT_LDS_BYTES = LDS_OST + NW * 4096;
__device__ __forceinline__ void glds16(const void* gsrc, unsigned lds_dst) { unsigned keep;
    asm volatile("s_mov_b32 %0, m0\n\ts_mov_b32 m0, %2\n\ts_nop 0\n\tglobal_load_lds_dwordx4 %1, off\n\ts_mov_b32 m0, %0" : "=&s"(keep) : "v"(gsrc), "s"(lds_dst) : "memory"); }
__device__ __forceinline__ float max3f(float a, float b, float c) { float r; asm("v_max3_f32 %0, %1, %2, %3" : "=v"(r) : "v"(a), "v"(b), "v"(c)); return r; }
__device__ __forceinline__ float max2f(float a, float b) { float r; asm("v_max_f32_e32 %0, %1, %2" : "=v"(r) : "v"(a), "v"(b)); return r; }
__device__ __forceinline__ float fadd_s(float a, float b) { float r; asm("v_add_f32_e32 %0, %1, %2" : "=v"(r) : "v"(a), "v"(b)); return r; }
__device__ __forceinline__ float fsub_s(float a, float b) { float r; asm("v_sub_f32_e32 %0, %1, %2" : "=v"(r) : "v"(a), "v"(b)); return r; }
typedef float f32x2_t __attribute__((ext_vector_type(2))); typedef __bf16 bf16x2_t __attribute__((ext_vector_type(2)));
__device__ __forceinline__ unsigned cvtpk_s(float lo, float hi) { f32x2_t v = {lo, hi}; bf16x2_t b = __builtin_convertvector(v, bf16x2_t); return __builtin_bit_cast(unsigned, b); }
#define WAIT_BAR(N) asm volatile("s_waitcnt vmcnt(" #N ") lgkmcnt(0)\n\ts_barrier" ::: "memory")

__device__ __forceinline__ void qkt(f32x16& p0, f32x16& p1, const char* Kslot, const bf16x8* qr, const f32x16& negm, int r32, int hi) {
    const char* kb = Kslot + hi * 1024 + r32 * 16;
#pragma unroll
    for (int d0 = 0; d0 < 4; ++d0) {
        const bf16x8 b0 = *reinterpret_cast<const bf16x8*>(kb + d0 * 2048);
        const bf16x8 b1 = *reinterpret_cast<const bf16x8*>(kb + d0 * 2048 + 512);
        if (d0 == 0) { p0 = __builtin_amdgcn_mfma_f32_32x32x16_bf16(b0, qr[0], negm, 0, 0, 0); p1 = __builtin_amdgcn_mfma_f32_32x32x16_bf16(b1, qr[0], negm, 0, 0, 0); }
        else { p0 = __builtin_amdgcn_mfma_f32_32x32x16_bf16(b0, qr[d0], p0, 0, 0, 0); p1 = __builtin_amdgcn_mfma_f32_32x32x16_bf16(b1, qr[d0], p1, 0, 0, 0); } }
}
typedef __attribute__((address_space(3))) const char* lds_cptr;
typedef short v4i16_t __attribute__((ext_vector_type(4)));
__device__ __forceinline__ void kload8(bf16x8* kf, lds_cptr kp) {
    kf[0] = *(const __attribute__((address_space(3))) bf16x8*)(kp);        kf[1] = *(const __attribute__((address_space(3))) bf16x8*)(kp + 512);
    kf[2] = *(const __attribute__((address_space(3))) bf16x8*)(kp + 2048); kf[3] = *(const __attribute__((address_space(3))) bf16x8*)(kp + 2560);
    kf[4] = *(const __attribute__((address_space(3))) bf16x8*)(kp + 4096); kf[5] = *(const __attribute__((address_space(3))) bf16x8*)(kp + 4608);
    kf[6] = *(const __attribute__((address_space(3))) bf16x8*)(kp + 6144); kf[7] = *(const __attribute__((address_space(3))) bf16x8*)(kp + 6656);
}
__device__ __forceinline__ void kload2(bf16x8* kf, lds_cptr kp, int j) { kf[2 * j] = *(const __attribute__((address_space(3))) bf16x8*)(kp + j * 2048); kf[2 * j + 1] = *(const __attribute__((address_space(3))) bf16x8*)(kp + j * 2048 + 512); }
__device__ __forceinline__ s16x4 vtr(lds_cptr p) { return __builtin_bit_cast(s16x4, __builtin_amdgcn_ds_read_tr16_b64_v4i16((__attribute__((address_space(3))) v4i16_t*)p)); }
__device__ __forceinline__ float rowmax(const f32x16& p0, const f32x16& p1) {
    float a = max3f(p0[0], p0[1], p1[0]), b = max3f(p0[2], p0[3], p1[1]); a = max3f(a, p1[2], p1[3]);
#pragma unroll
    for (int r = 4; r < 16; r += 4) { a = max3f(a, p0[r], p0[r + 1]); b = max3f(b, p0[r + 2], p0[r + 3]); a = max3f(a, p1[r], p1[r + 1]); b = max3f(b, p1[r + 2], p1[r + 3]); }
    const float m = max2f(a, b);
    auto rr = __builtin_amdgcn_permlane32_swap(__float_as_uint(m), __float_as_uint(m), false, false);
    return max2f(__uint_as_float(rr[0]), __uint_as_float(rr[1]));
}
__device__ __forceinline__ void pv(f32x16* o, int vb, bf16x8 pa0, bf16x8 pa1, bf16x8 pa2, bf16x8 pa3) {
#pragma unroll
    for (int d0 = 0; d0 < 2; ++d0) { s16x4 lo[4], hi[4];
#pragma unroll
        for (int ks = 0; ks < 4; ++ks) {
            asm volatile("ds_read_b64_tr_b16 %0,%1 offset:%c2" : "=&v"(lo[ks]) : "v"(vb), "i"(d0 * 4096 + ks * 1024) : "memory");
            asm volatile("ds_read_b64_tr_b16 %0,%1 offset:%c2" : "=&v"(hi[ks]) : "v"(vb), "i"(d0 * 4096 + ks * 1024 + 512) : "memory"); }
        asm volatile("s_waitcnt lgkmcnt(0)" ::: "memory"); SBAR();
#define PK(k) (bf16x8){lo[k][0], lo[k][1], lo[k][2], lo[k][3], hi[k][0], hi[k][1], hi[k][2], hi[k][3]}
        o[d0] = __builtin_amdgcn_mfma_f32_32x32x16_bf16(pa0, PK(0), o[d0], 0, 0, 0);
        o[d0] = __builtin_amdgcn_mfma_f32_32x32x16_bf16(pa1, PK(1), o[d0], 0, 0, 0);
        o[d0] = __builtin_amdgcn_mfma_f32_32x32x16_bf16(pa2, PK(2), o[d0], 0, 0, 0);
        o[d0] = __builtin_amdgcn_mfma_f32_32x32x16_bf16(pa3, PK(3), o[d0], 0, 0, 0);
#undef PK
    }
}
template <int THRL> __device__ __forceinline__ void attn_unit(int b, int h, int qb, const bf16* Q, const bf16* __restrict__ K, const bf16* __restrict__ V, bf16* O, char* shm) {
    const int tid = threadIdx.x, lane = tid & 63, r32 = lane & 31, hi = lane >> 5; const int wid = __builtin_amdgcn_readfirstlane(tid >> 6);
    const int q0 = qb * QB; const int kvh = h / 3;
    const long qrow0 = (long)b * SEQ + q0 + wid * QBLK;
    const long kvrow0 = (long)b * LKV;
    const bf16* Qw = Q + qrow0 * DMQ + h * D;
    const bf16* Kh = K + kvrow0 * DMKV + kvh * D, *Vh = V + kvrow0 * DMKV + kvh * D;
    const unsigned lds0 = (unsigned)(uintptr_t)shm;
    float* wsf = (float*)(shm + LDS_WS) + wid * 64;
    const bf16* ksrc = Kh + (long)lane * DMKV + wid * 8;
    const bf16* vsrc = Vh + (long)(16 * (wid & 3) + (lane >> 2)) * DMKV + (wid >> 2) * 32 + (lane & 3) * 8;
    const unsigned kdst = lds0 + LDS_K + wid * 1024, vdst = lds0 + LDS_V + wid * 1024;
#define DMA_K(t, slot) glds16(ksrc + (long)(t) * KVBLK * DMKV, (unsigned)__builtin_amdgcn_readfirstlane(kdst + (slot)))
#define DMA_V(t, slot) glds16(vsrc + (long)(t) * KVBLK * DMKV, (unsigned)__builtin_amdgcn_readfirstlane(vdst + (slot)))
    const int vb0 = (int)(lds0 + LDS_V) + ((lane >> 4) & 1) * 32 + (lane & 3) * 8 + (4 * hi + ((lane & 15) >> 2)) * 64;
    const char* Kbase = shm + LDS_K; bf16x8 kf[8];
    const lds_cptr shm3 = (lds_cptr)shm; const lds_cptr kp0 = shm3 + LDS_K + hi * 1024 + r32 * 16; const lds_cptr vp0 = shm3 + LDS_V + ((lane >> 4) & 1) * 32 + (lane & 3) * 8 + (4 * hi + ((lane & 15) >> 2)) * 64;
    DMA_K(0, 0); DMA_V(0, 0); DMA_K(1, SLOTB);
    bf16x8 qr[4];
#pragma unroll
    for (int d0 = 0; d0 < 4; ++d0) qr[d0] = *reinterpret_cast<const bf16x8*>(&Qw[(long)r32 * DMQ + d0 * 16 + hi * 8]);
    float mhat = 0.f, l_reg = 0.f; f32x16 o[2]; o[0] = f32x16{}; o[1] = f32x16{}; f32x16 negm = f32x16{}; asm volatile("" : "+v"(negm));
    bool resc = false;
#define START(P0, P1) do { const float rm = rowmax(P0, P1); resc = false; \
    { const float dl = rm; mhat = fadd_s(mhat, dl); \
      _Pragma("unroll") for (int r = 0; r < 16; ++r) { P0[r] = fsub_s(P0[r], dl); P1[r] = fsub_s(P1[r], dl); } \
      _Pragma("unroll") for (int r = 0; r < 16; ++r) negm[r] = -mhat; asm volatile("" : "+v"(negm)); } \
    _Pragma("unroll") for (int r = 0; r < 16; ++r) P0[r] = __builtin_amdgcn_exp2f(P0[r]); } while (0)
#define RESC() do { if (resc) { asm volatile("s_waitcnt lgkmcnt(0)" ::: "memory"); \
      _Pragma("unroll") for (int d_ = 0; d_ < 2; ++d_) _Pragma("unroll") for (int r = 0; r < 16; ++r) o[d_][r] *= wsf[crow(r, hi)]; } } while (0)
    f32x16 pA0, pA1, pB0, pB1;
    int sl_prev = 0, sl_cur = 0, sl_next = SLOTB;
#define ROT() do { sl_prev = sl_cur; sl_cur = sl_next; sl_next = (sl_next == (NSLOTR - 1) * SLOTB) ? 0 : sl_next + SLOTB; } while (0)
    DMA_K(2, 2 * SLOTB);
    WAIT_BAR(3);
    qkt(pA0, pA1, Kbase, qr, negm, r32, hi); asm volatile("s_nop 15\n\ts_nop 7" : "+v"(pA0), "+v"(pA1));
    START(pA0, pA1);
    _Pragma("unroll") for (int r = 0; r < 16; ++r) pA1[r] = __builtin_amdgcn_exp2f(pA1[r]);
    WAIT_BAR(0);
    DMA_K(3, 0); DMA_V(1, SLOTB);
    ROT();
    kload8(kf, kp0 + sl_cur);
    WAIT_BAR(2);
    s16x4 vlo[8], vhi[8]; u32x4 pw0, pw1, pw2, pw3;
#define PKW(P, B) cvtpk_s(P[B], P[B + 1])
#define PAF(k) __builtin_bit_cast(bf16x8, pw##k)
#define VFR(i) (bf16x8){vlo[i][0], vlo[i][1], vlo[i][2], vlo[i][3], vhi[i][0], vhi[i][1], vhi[i][2], vhi[i][3]}
#define PIN(x) asm volatile("" : "+v"(x))
#define MX3(a, b, c) __builtin_fmaxf(__builtin_fmaxf((a), (b)), (c))
#define GAPA(MF, A0, A1, A2, A3, W0, W1, PW) do { MF; sacc += A0; sacc += A1; sacc += A2; sacc += A3; PIN(sacc); W0; W1; PIN(PW); SBAR(); } while (0)
#define EX(v) __builtin_amdgcn_exp2f(v)
#define GAPB(MF, X, B) do { MF; X[B] = EX(X[B]); X[B + 1] = EX(X[B + 1]); X[B + 2] = EX(X[B + 2]); X[B + 3] = EX(X[B + 3]); PIN(X); SBAR(); } while (0)
#define VRD(i) do { vlo[i] = vtr(vp_ + (((i) >> 2) * 4096 + ((i) & 3) * 1024)); vhi[i] = vtr(vp_ + (((i) >> 2) * 4096 + ((i) & 3) * 1024 + 512)); } while (0)
#define KRD(G, j) do { if (G) { kload2(kf, kp0 + sl_next, j); SBAR(); } } while (0)
#define STEP(C0, C1, P0, P1, t, GK, GV, GL) do { SBAR(); \
    const lds_cptr vp_ = vp0 + sl_prev; \
    VRD(0); SBAR(); float sacc = (P0[0] + P0[1]); \
    GAPA(C0 = __builtin_amdgcn_mfma_f32_32x32x16_bf16(kf[0], qr[0], negm, 0, 0, 0), P0[2], P0[3], P0[4], P0[5],     pw0[0] = PKW(P0, 0), pw0[1] = PKW(P0, 2), pw0); \
    VRD(4); SBAR(); GAPA(C1 = __builtin_amdgcn_mfma_f32_32x32x16_bf16(kf[1], qr[0], negm, 0, 0, 0), P0[6], P0[7], P0[8], P0[9],     pw0[2] = PKW(P0, 4), pw0[3] = PKW(P0, 6), pw0); \
    VRD(1); SBAR(); GAPA(C0 = __builtin_amdgcn_mfma_f32_32x32x16_bf16(kf[2], qr[1], C0, 0, 0, 0),   P0[10], P0[11], P0[12], P0[13], pw1[0] = PKW(P0, 8), pw1[1] = PKW(P0, 10), pw1); \
    VRD(5); SBAR(); GAPA(C1 = __builtin_amdgcn_mfma_f32_32x32x16_bf16(kf[3], qr[1], C1, 0, 0, 0),   P0[14], P0[15], P1[0], P1[1],   pw1[2] = PKW(P0, 12), pw1[3] = PKW(P0, 14), pw1); \
    VRD(2); SBAR(); GAPA(C0 = __builtin_amdgcn_mfma_f32_32x32x16_bf16(kf[4], qr[2], C0, 0, 0, 0),   P1[2], P1[3], P1[4], P1[5],     pw2[0] = PKW(P1, 0), pw2[1] = PKW(P1, 2), pw2); \
    VRD(6); SBAR(); GAPA(C1 = __builtin_amdgcn_mfma_f32_32x32x16_bf16(kf[5], qr[2], C1, 0, 0, 0),   P1[6], P1[7], P1[8], P1[9],     pw2[2] = PKW(P1, 4), pw2[3] = PKW(P1, 6), pw2); \
    VRD(3); SBAR(); GAPA(C0 = __builtin_amdgcn_mfma_f32_32x32x16_bf16(kf[6], qr[3], C0, 0, 0, 0),   P1[10], P1[11], P1[12], P1[13], pw3[0] = PKW(P1, 8), pw3[1] = PKW(P1, 10), pw3); \
    VRD(7); SBAR(); GAPA(C1 = __builtin_amdgcn_mfma_f32_32x32x16_bf16(kf[7], qr[3], C1, 0, 0, 0),   P1[14], P1[15], 0.f, 0.f,       pw3[2] = PKW(P1, 12), pw3[3] = PKW(P1, 14), pw3); \
    l_reg += sacc; \
    if (GK) { DMA_K((t) + 3, sl_cur); } if (GV) { DMA_V((t) + 1, sl_next); } \
    { float a = MX3(C0[0], C0[1], C1[0]), b = MX3(C0[2], C0[3], C1[1]); a = MX3(a, C1[2], C1[3]); \
      _Pragma("unroll") for (int r = 4; r < 16; r += 4) { a = MX3(a, C0[r], C0[r + 1]); b = MX3(b, C0[r + 2], C0[r + 3]); a = MX3(a, C1[r], C1[r + 1]); b = MX3(b, C1[r + 2], C1[r + 3]); } \
      float rm = __builtin_fmaxf(a, b); { auto rr = __builtin_amdgcn_permlane32_swap(__float_as_uint(rm), __float_as_uint(rm), false, false); rm = __builtin_fmaxf(__uint_as_float(rr[0]), __uint_as_float(rr[1])); } \
      resc = false; \
      if (__builtin_expect(__any(rm > (float)THRL), 0)) { const float dl = __builtin_fmaxf(rm, 0.f); mhat += dl; \
        _Pragma("unroll") for (int r = 0; r < 16; ++r) { C0[r] -= dl; C1[r] -= dl; } \
        _Pragma("unroll") for (int r = 0; r < 16; ++r) negm[r] = -mhat; asm volatile("" : "+v"(negm)); \
        const float f = __builtin_amdgcn_exp2f(-dl); l_reg *= f; if (hi == 0) wsf[r32] = f; resc = true; } } \
    SBAR(); \
    GAPB(o[0] = __builtin_amdgcn_mfma_f32_32x32x16_bf16(PAF(0), VFR(0), o[0], 0, 0, 0), C0, 0); \
    GAPB(o[1] = __builtin_amdgcn_mfma_f32_32x32x16_bf16(PAF(0), VFR(4), o[1], 0, 0, 0), C0, 4); \
    KRD(GL, 0); GAPB(o[0] = __builtin_amdgcn_mfma_f32_32x32x16_bf16(PAF(1), VFR(1), o[0], 0, 0, 0), C0, 8); \
    KRD(GL, 1); GAPB(o[1] = __builtin_amdgcn_mfma_f32_32x32x16_bf16(PAF(1), VFR(5), o[1], 0, 0, 0), C0, 12); \
    KRD(GL, 2); GAPB(o[0] = __builtin_amdgcn_mfma_f32_32x32x16_bf16(PAF(2), VFR(2), o[0], 0, 0, 0), C1, 0); \
    KRD(GL, 3); GAPB(o[1] = __builtin_amdgcn_mfma_f32_32x32x16_bf16(PAF(2), VFR(6), o[1], 0, 0, 0), C1, 4); \
    GAPB(o[0] = __builtin_amdgcn_mfma_f32_32x32x16_bf16(PAF(3), VFR(3), o[0], 0, 0, 0), C1, 8); \
    GAPB(o[1] = __builtin_amdgcn_mfma_f32_32x32x16_bf16(PAF(3), VFR(7), o[1], 0, 0, 0), C1, 12); \
    } while (0)
    int t = 1;
    for (; t + 5 < NT; t += 2) {
        STEP(pB0, pB1, pA0, pA1, t, true, true, true);     WAIT_BAR(2); RESC(); ROT();
        STEP(pA0, pA1, pB0, pB1, t + 1, true, true, true); WAIT_BAR(2); RESC(); ROT();
    }
#define ENDW(tt) do { if ((tt) + 3 < NT) { WAIT_BAR(2); } else if ((tt) + 2 < NT) { WAIT_BAR(1); } else { WAIT_BAR(0); } } while (0)
    for (; t + 1 < NT; t += 2) {
        STEP(pB0, pB1, pA0, pA1, t, (t + 3 < NT), (t + 1 < NT), (t + 1 < NT));         ENDW(t);     RESC(); ROT();
        STEP(pA0, pA1, pB0, pB1, t + 1, (t + 4 < NT), (t + 2 < NT), (t + 2 < NT));     ENDW(t + 1); RESC(); ROT();
    }
    STEP(pB0, pB1, pA0, pA1, NT - 1, false, false, false); RESC();
    { float sacc = pB0[0] + pB0[1]; _Pragma("unroll") for (int r = 2; r < 16; ++r) sacc += pB0[r]; _Pragma("unroll") for (int r = 0; r < 16; ++r) sacc += pB1[r]; l_reg += sacc;
      pw0 = (u32x4){PKW(pB0, 0), PKW(pB0, 2), PKW(pB0, 4), PKW(pB0, 6)}; pw1 = (u32x4){PKW(pB0, 8), PKW(pB0, 10), PKW(pB0, 12), PKW(pB0, 14)}; pw2 = (u32x4){PKW(pB1, 0), PKW(pB1, 2), PKW(pB1, 4), PKW(pB1, 6)}; pw3 = (u32x4){PKW(pB1, 8), PKW(pB1, 10), PKW(pB1, 12), PKW(pB1, 14)};
      SBAR(); pv(o, vb0 + sl_cur, PAF(0), PAF(1), PAF(2), PAF(3)); }
#undef PKW
#undef PAF
#undef VFR
#undef PIN
#undef MX3
#undef GAPA
#undef GAPB
#undef EX
#undef VRD
#undef KRD
#undef STEP
#undef ENDW
    { auto rr = __builtin_amdgcn_permlane32_swap(__float_as_uint(l_reg), __float_as_uint(l_reg), false, false); l_reg = __uint_as_float(rr[0]) + __uint_as_float(rr[1]); }
    if (hi == 0) wsf[32 + r32] = l_reg; asm volatile("s_waitcnt lgkmcnt(0)" ::: "memory");
    float rli[16];
#pragma unroll
    for (int r = 0; r < 16; ++r) rli[r] = __builtin_amdgcn_rcpf(wsf[32 + crow(r, hi)]);
    bf16* Ow = O + qrow0 * DMO + h * D;
    { bf16* stg = (bf16*)(shm + LDS_OST) + wid * 2048;
#pragma unroll
      for (int r = 0; r < 16; ++r) { const int orow = crow(r, hi);
#pragma unroll
        for (int d0 = 0; d0 < 2; ++d0) stg[orow * 64 + d0 * 32 + r32] = __float2bfloat16(o[d0][r] * rli[r]); }
      asm volatile("s_waitcnt lgkmcnt(0)" ::: "memory");
#pragma unroll
      for (int i = 0; i < 4; ++i) { const int row = i * 8 + (lane >> 3), ch = lane & 7; const u32x4 v = *(const u32x4*)(stg + row * 64 + ch * 8); *(u32x4*)(Ow + (long)row * DMO + ch * 8) = v; } }
    asm volatile("s_waitcnt lgkmcnt(0)\n\ts_barrier" ::: "memory");
#undef DMA_K
#undef DMA_V
#undef START
#undef RESC
#undef ROT
}
#undef SBAR
#undef WAIT_BAR
}

#define XB_TMO      128
#define XB_XCNT(j)  (256  + 64 * (j))
#define XB_XSUB(j)  (1280 + 64 * (j))
#define XB_XGEN(j)  (2304 + 64 * (j))
#define XB_TOP      3328
#define XB_TOPGEN   3392
#define XCD_BAR_WORDS 3456
#define XB_SPIN_CAP (1u << 18)
__device__ __forceinline__ unsigned xb_ld(unsigned* p)              { return __hip_atomic_load(p, __ATOMIC_RELAXED, __HIP_MEMORY_SCOPE_AGENT); }
__device__ __forceinline__ unsigned xb_add(unsigned* p, unsigned v) { return __hip_atomic_fetch_add(p, v, __ATOMIC_RELAXED, __HIP_MEMORY_SCOPE_AGENT); }
__device__ __forceinline__ unsigned xb_xcc_id() { return (unsigned)__builtin_amdgcn_s_getreg((3 << 11) | 20) & 0xFu; }
#define XB_SPIN(cond, bar) do { unsigned _sp = 0; while (cond) { __builtin_amdgcn_s_sleep(1); \
    if ((++_sp & 255u) == 0u) { if (xb_ld(&(bar)[XB_TMO])) break; if (_sp > XB_SPIN_CAP) { atomicAdd(&(bar)[XB_TMO], 1u); break; } } } } while (0)
struct XcdBarrier { unsigned* bar; unsigned x; volatile LAS unsigned* st; };
__device__ __forceinline__ XcdBarrier xcd_barrier_post(unsigned* bar, volatile LAS unsigned* st) {
    XcdBarrier b; b.bar = bar; b.x = xb_xcc_id(); b.st = st;
    if (threadIdx.x == 0) (void)xb_add(&bar[XB_XCNT(b.x)], 1u);
    return b;
}
__device__ __forceinline__ void xcd_barrier_complete(unsigned* bar, unsigned x, unsigned& nloc, unsigned& nx) {
    const unsigned G = gridDim.x * gridDim.y * gridDim.z;
    unsigned sum, cnt, mine, sp = 0u;
    for (;;) {
        sum = 0u; cnt = 0u; mine = 0u;
#pragma unroll
        for (unsigned j = 0; j < 16; ++j) { const unsigned c = xb_ld(&bar[XB_XCNT(j)]); sum += c; cnt += (c > 0u) ? 1u : 0u; mine = (j == x) ? c : mine; }
        if (sum == G) break;
        __builtin_amdgcn_s_sleep(1);
        if ((++sp & 255u) == 0u) { if (xb_ld(&bar[XB_TMO])) break; if (sp > XB_SPIN_CAP) { atomicAdd(&bar[XB_TMO], 1u); break; } }
    }
    nloc = mine > 0u ? mine : 1u; nx = cnt > 0u ? cnt : 1u;
}
__device__ __forceinline__ void xcd_barrier(const XcdBarrier& b) {
    asm volatile("s_waitcnt vmcnt(0)" ::: "memory");
    __syncthreads();
    if (threadIdx.x == 0) {
        unsigned* bar = b.bar;
        __builtin_amdgcn_s_waitcnt(0);
        unsigned nloc = b.st[0], nx = b.st[1];
        if (nloc == 0u) { xcd_barrier_complete(bar, b.x, nloc, nx); b.st[0] = nloc; b.st[1] = nx; }
        const unsigned old = xb_add(&bar[XB_XSUB(b.x)], 1u);
        const unsigned gen = old / nloc;
        if (old + 1u == (gen + 1u) * nloc) {
            __builtin_amdgcn_fence(__ATOMIC_RELEASE, "agent");
            asm volatile("s_waitcnt vmcnt(0)" ::: "memory");
            const unsigned og = xb_add(&bar[XB_TOP], 1u);
            const unsigned tg = og / nx;
            if (og + 1u == (tg + 1u) * nx) xb_add(&bar[XB_TOPGEN], 1u);
            else XB_SPIN(xb_ld(&bar[XB_TOPGEN]) == tg, bar);
            __builtin_amdgcn_fence(__ATOMIC_ACQUIRE, "agent");
            xb_add(&bar[XB_XGEN(b.x)], 1u);
            asm volatile("s_waitcnt vmcnt(0)" ::: "memory");
        } else {
            XB_SPIN(xb_ld(&bar[XB_XGEN(b.x)]) == gen, bar);
            __builtin_amdgcn_fence(__ATOMIC_ACQUIRE, "agent");
            asm volatile("s_waitcnt vmcnt(0)" ::: "memory");
        }
    }
    __syncthreads();
}

struct Frame {
    LAS unsigned char* lds;
    volatile LAS unsigned* MISC;
    gu32* ctl;
    int tid, lane, wave;
    int vcu, G;
    const float *x, *c, *ctx, *c_ctx, *norm1_g, *w_ada, *b_ada, *w_in, *w_fourier, *q_norm_g, *k_norm_g, *w_out, *norm2_g, *w_router, *router_bias, *w_egu, *w_ed, *w_sgu, *w_sd, *final_g;
    float* out;
    unsigned char* ws;
};
#define WSP(T, off) ((T*)(F.ws + (off)))

struct DenseOrder {
    static constexpr bool GATHER = false;
    int nN, nmain, nextra, G, c; const char* Bt; int K;
    __device__ __forceinline__ bool next(int i, pg8::GUnit& u) const {
        const int L = i * G + c; if (L >= nmain + nextra) return false;
        if (L < nmain) { const int nig = 8 * nN, gid = L / nig, r = L % nig; u.pm = gid * 8 + (r & 7); u.pn = r >> 3; }
        else { const int jx = L - nmain; u.pm = 128 + (jx & 3); u.pn = 5 + (jx >> 2); }
        u.e = 0; u.j = 0; u.nvalid = 256; u.B = Bt + (size_t)u.pn * 256 * K * 2; return true;
    }
    __device__ __forceinline__ int arow(const pg8::GUnit& u, int r) const { return u.pm * 256 + r; }
};
struct GroupedOrder {
    static constexpr bool GATHER = true;
    int NPN, G, c, nbrows, K; bool gather; const char* Bt; const LAS int* TS; const LAS int* CN; const GAS u32x2* LIST;
    __device__ __forceinline__ bool next(int i, pg8::GUnit& u) const {
        const int L = i * G + c; const int T = L / NPN; const int total = TS[257];
        if (T >= total) return false;
        int lo = 0, hi = 257;
        while (hi - lo > 1) { const int mid = (lo + hi) >> 1; if (TS[mid] <= T) lo = mid; else hi = mid; }
        lo = __builtin_amdgcn_readfirstlane(lo);
        const int ts = __builtin_amdgcn_readfirstlane(TS[lo]), cn = __builtin_amdgcn_readfirstlane(CN[lo]);
        u.pm = T; u.pn = L - T * NPN; u.e = lo; u.j = T - ts; const int rem = cn - 256 * u.j; u.nvalid = rem < 256 ? rem : 256;
        u.B = Bt + ((size_t)lo * nbrows + (size_t)u.pn * 256) * K * 2; return true;
    }
    __device__ __forceinline__ int arow(const pg8::GUnit& u, int r) const {
        if (!gather) return u.pm * 256 + r;
        int pos = 256 * u.j + r; if (r >= u.nvalid) pos = 0;
        const u32x2 en = LIST[(size_t)u.e * NTOK + pos];
        return (int)(en.x & 0xffffu);
    }
};

struct EpiInProj {
    static constexpr bool PERM = true;
    u16 *Z, *Q, *Kb, *Vb; const float *COS, *SIN, *gq, *gk;
    __device__ __forceinline__ void operator()(const f32x4 (&acc)[2][2][4][2], const pg8::GUnit& u, int wr, int wc, int fr, int fq) const {
        const int pn = u.pn; const bool is_ctx = u.pm >= 128;
        float gn[2][2][4];
        if (pn >= 2 && pn < 6) { const float* gsrc = (pn == 5) ? gk : gq;
#pragma unroll
            for (int bj = 0; bj < 2; ++bj)
#pragma unroll
                for (int n = 0; n < 2; ++n) { const f32x4 g4 = *(const f32x4*)(gsrc + 32 * bj + 16 * n + 4 * fq); gn[bj][n][0] = g4[0]; gn[bj][n][1] = g4[1]; gn[bj][n][2] = g4[2]; gn[bj][n][3] = g4[3]; } }
#pragma unroll
        for (int ai = 0; ai < 2; ++ai)
#pragma unroll
            for (int m = 0; m < 4; ++m) {
                const int row = u.pm * 256 + ai * 128 + wr * 64 + m * 16 + fr;
                int b, l, key;
                if (!is_ctx) { b = row >> 13; l = row & 8191; key = l; } else { const int rc = row - NTOK; b = rc >> 8; l = 0; key = SEQ + (rc & 255); }
                if (pn < 2) {
#pragma unroll
                    for (int bj = 0; bj < 2; ++bj) { const int g = 32 * pn + 16 * bj + 4 * wc + fq; const f32x4 v0 = acc[ai][bj][m][0], v1 = acc[ai][bj][m][1];
                        u32x4 w; w.x = cvt_pk_bf16(v0[0], v0[1]); w.y = cvt_pk_bf16(v0[2], v0[3]); w.z = cvt_pk_bf16(v1[0], v1[1]); w.w = cvt_pk_bf16(v1[2], v1[3]);
                        *(u32x4*)(Z + (((size_t)(b * 64 + g) * SEQ + l) * 8)) = w; }
                } else if (pn < 6) {
                    float ss = 0.f;
#pragma unroll
                    for (int bj = 0; bj < 2; ++bj)
#pragma unroll
                        for (int n = 0; n < 2; ++n) { const f32x4 v = acc[ai][bj][m][n]; ss += (v[0] * v[0] + v[1] * v[1]) + (v[2] * v[2] + v[3] * v[3]); }
                    ss += __shfl_xor(ss, 16); ss += __shfl_xor(ss, 32);
                    const float rstd = 1.0f / sqrtf(ss * (1.0f / 64.0f) + RMS_EPS);
                    const float osc = (pn == 5) ? 1.0f : C2;
#pragma unroll
                    for (int bj = 0; bj < 2; ++bj) {
                        const int pidx = (bj == 0) ? (l >> 6) : (l & 63);
                        f32x4 cs = *(const f32x4*)(COS + pidx * 16 + 4 * fq), sn = *(const f32x4*)(SIN + pidx * 16 + 4 * fq);
                        if (is_ctx) { cs = (f32x4){1.f, 1.f, 1.f, 1.f}; sn = (f32x4){0.f, 0.f, 0.f, 0.f}; }
                        float oa[4], ob[4];
#pragma unroll
                        for (int e = 0; e < 4; ++e) { const float a = acc[ai][bj][m][0][e] * rstd * gn[bj][0][e], bb = acc[ai][bj][m][1][e] * rstd * gn[bj][1][e];
                            oa[e] = (a * cs[e] - bb * sn[e]) * osc; ob[e] = (bb * cs[e] + a * sn[e]) * osc; }
                        u32x4 w; w.x = cvt_pk_bf16(oa[0], oa[1]); w.y = cvt_pk_bf16(oa[2], oa[3]); w.z = cvt_pk_bf16(ob[0], ob[1]); w.w = cvt_pk_bf16(ob[2], ob[3]);
                        if (pn < 5) { const int head = 4 * (pn - 2) + wc; *(u32x4*)(Q + ((size_t)row * QW + head * 64 + 32 * bj + 8 * fq)) = w; }
                        else *(u32x4*)(Kb + (((size_t)b * LKV + key) * KVW + wc * 64 + 32 * bj + 8 * fq)) = w;
                    }
                } else {
#pragma unroll
                    for (int bj = 0; bj < 2; ++bj) { const f32x4 v0 = acc[ai][bj][m][0], v1 = acc[ai][bj][m][1];
                        u32x4 w; w.x = cvt_pk_bf16(v0[0], v0[1]); w.y = cvt_pk_bf16(v0[2], v0[3]); w.z = cvt_pk_bf16(v1[0], v1[1]); w.w = cvt_pk_bf16(v1[2], v1[3]);
                        *(u32x4*)(Vb + (((size_t)b * LKV + key) * KVW + 128 * bj + 32 * wc + 8 * fq)) = w; }
                }
            }
    }
};
struct EpiResid {
    static constexpr bool PERM = false;
    const float* x; float* X1; const gi64* MOD;
    __device__ __forceinline__ void operator()(const f32x4 (&acc)[2][2][4][2], const pg8::GUnit& u, int wr, int wc, int fr, int fq) const {
        const int row0 = u.pm * 256 + wr * 64 + fr, col0 = u.pn * 256 + wc * 32 + 4 * fq; const int b = (u.pm * 256) >> 13;
        f32x4 gv[2][2];
#pragma unroll
        for (int bj = 0; bj < 2; ++bj)
#pragma unroll
            for (int n = 0; n < 2; ++n) gv[bj][n] = mod4(MOD, b * 6144 + 2048 + col0 + bj * 128 + n * 16);
#pragma unroll
        for (int ai = 0; ai < 2; ++ai)
#pragma unroll
            for (int m = 0; m < 4; ++m) { const size_t off = (size_t)(row0 + ai * 128 + m * 16) * DM + col0;
#pragma unroll
                for (int bj = 0; bj < 2; ++bj)
#pragma unroll
                    for (int n = 0; n < 2; ++n) { const f32x4 xv = *(const f32x4*)(x + off + bj * 128 + n * 16); *(f32x4*)(X1 + off + bj * 128 + n * 16) = (DBG & 2) ? xv : xv + gv[bj][n] * acc[ai][bj][m][n]; } }
    }
};
struct EpiLogits {
    static constexpr bool PERM = false;
    float* C;
    __device__ __forceinline__ void operator()(const f32x4 (&acc)[2][2][4][2], const pg8::GUnit& u, int wr, int wc, int fr, int fq) const {
        const int row0 = u.pm * 256 + wr * 64 + fr, col0 = wc * 32 + 4 * fq;
#pragma unroll
        for (int ai = 0; ai < 2; ++ai)
#pragma unroll
            for (int m = 0; m < 4; ++m) { float* rowp = C + (size_t)(row0 + ai * 128 + m * 16) * NEXP + col0;
#pragma unroll
                for (int bj = 0; bj < 2; ++bj)
#pragma unroll
                    for (int n = 0; n < 2; ++n) *(f32x4*)(rowp + bj * 128 + n * 16) = acc[ai][bj][m][n]; }
    }
};
struct EpiSwiglu {
    static constexpr bool PERM = true;
    u16* ACT;
    __device__ __forceinline__ void operator()(const f32x4 (&acc)[2][2][4][2], const pg8::GUnit& u, int wr, int wc, int fr, int fq) const {
#pragma unroll
        for (int ai = 0; ai < 2; ++ai)
#pragma unroll
            for (int m = 0; m < 4; ++m) { const int r = ai * 128 + wr * 64 + m * 16 + fr; u16* rowp = ACT + ((size_t)u.pm * 256 + r) * EFF + 128 * u.pn + 16 * wc + 4 * fq;
#pragma unroll
                for (int bj = 0; bj < 2; ++bj) { const f32x4 a = acc[ai][bj][m][0], g = acc[ai][bj][m][1]; float o[4];
#pragma unroll
                    for (int e = 0; e < 4; ++e) o[e] = a[e] * g[e] / (1.0f + __expf(-a[e]));
                    u32x2 w; if (MOEF16) { w.x = pk2h(o[0], o[1]); w.y = pk2h(o[2], o[3]); } else { w.x = pk2bf(o[0], o[1]); w.y = pk2bf(o[2], o[3]); } *(u32x2*)(rowp + 64 * bj) = w; } }
    }
};
struct EpiDown {
    static constexpr bool PERM = true;
    u16* Cc; const GAS u32x2* LIST;
    __device__ __forceinline__ void operator()(const f32x4 (&acc)[2][2][4][2], const pg8::GUnit& u, int wr, int wc, int fr, int fq) const {
#pragma unroll
        for (int ai = 0; ai < 2; ++ai)
#pragma unroll
            for (int m = 0; m < 4; ++m) { const int r = ai * 128 + wr * 64 + m * 16 + fr;
                if (r < u.nvalid) { const f32x2 enf = *(const GAS f32x2*)(LIST + (size_t)u.e * NTOK + 256 * u.j + r);
                    const unsigned ex = __builtin_bit_cast(unsigned, enf.x); const int tok = (int)(ex & 0xffffu), slot = (int)(ex >> 16); const float gate = enf.y;
                    u16* rowp = Cc + ((size_t)tok * NSLOT + slot) * DM + 256 * u.pn + 32 * wc + 8 * fq;
#pragma unroll
                    for (int bj = 0; bj < 2; ++bj) { const f32x4 v0 = acc[ai][bj][m][0] * gate, v1 = acc[ai][bj][m][1] * gate;
                        u32x4 w; w.x = cvt_pk_bf16(v0[0], v0[1]); w.y = cvt_pk_bf16(v0[2], v0[3]); w.z = cvt_pk_bf16(v1[0], v1[1]); w.w = cvt_pk_bf16(v1[2], v1[3]);
                        *(u32x4*)(rowp + 128 * bj) = w; } } }
    }
};

__device__ __forceinline__ void p0_phase(Frame& F) {
    const int gw = F.vcu * 8 + F.wave, NGW = F.G * 8, lane = F.lane;
    unsigned long long* MODQ = (unsigned long long*)(F.ctl + CW_MOD);
    for (int it = gw; it < 1536; it += NGW) {
        const int cb = it % 24, kc = it / 24, k0 = kc * 16, col = cb * 256 + lane * 4;
        float sv[5];
#pragma unroll
        for (int r = 0; r < 5; ++r) { const float cv = (r < 4) ? F.c[r * DM + k0 + (lane & 15)] : F.c_ctx[k0 + (lane & 15)]; sv[r] = cv / (1.0f + __expf(-cv)); }
        f32x4 acc[5];
#pragma unroll
        for (int r = 0; r < 5; ++r) acc[r] = (f32x4){0.f, 0.f, 0.f, 0.f};
#pragma unroll
        for (int kk = 0; kk < 16; ++kk) { const f32x4 w = *(const f32x4*)(F.w_ada + (size_t)(k0 + kk) * 6144 + col);
#pragma unroll
            for (int r = 0; r < 5; ++r) { const float s = __builtin_bit_cast(float, __builtin_amdgcn_readlane(__builtin_bit_cast(int, sv[r]), kk)); acc[r] += w * s; } }
        if (kc == 0) { const f32x4 bv = *(const f32x4*)(F.b_ada + col);
#pragma unroll
            for (int r = 0; r < 5; ++r) acc[r] += bv; }
#pragma unroll
        for (int r = 0; r < 5; ++r)
#pragma unroll
            for (int j = 0; j < 4; ++j) atomicAdd(MODQ + r * 6144 + col + j, (unsigned long long)__float2ll_rn(acc[r][j] * 0x1p36f));
    }
    float* WCS = WSP(float, WS_TAB);
    for (int it = gw; it < 256; it += NGW) {
        const int fh = it >> 6, d = it & 63; float ac = 0.f, as = 0.f;
        for (int k2 = 0; k2 < 64; ++k2) { const int mm = (d * k2) & 63; const float w = F.w_fourier[(fh * 64 + k2) * 64 + lane]; ac += cospif((float)mm * (1.0f / 32.0f)) * w; as += sinpif((float)mm * (1.0f / 32.0f)) * w; }
        const float sc = 1.0f / sqrtf((float)SEQ * 64.0f);
        WCS[(fh * 64 + d) * 128 + lane] = ac * sc; WCS[(fh * 64 + d) * 128 + 64 + lane] = as * sc;
    }
    float* COS = WSP(float, WS_TAB + 128 * 1024); float* SIN = WSP(float, WS_TAB + 136 * 1024);
    for (int it = gw; it < 32; it += NGW) { const int idx = it * 64 + lane, pos = idx >> 4, i = idx & 15;
        const float inv = powf(10000.0f, -(float)i / 16.0f), ang = (float)pos * inv; COS[idx] = cosf(ang); SIN[idx] = sinf(ang); }
}

__device__ __forceinline__ int map_row(int mode, int sc) {
    if (mode == 1) { const int head = sc >> 6, dim = sc & 63, bj = dim >> 5, n = (dim >> 4) & 1, i = dim & 15; return (head >> 2) * 256 + bj * 128 + (head & 3) * 32 + (i >> 2) * 8 + n * 4 + (i & 3); }
    if (mode == 2) { const int g = sc >> 8, a = sc & 255; return (a >> 2) * 8 + g * 4 + (a & 3); }
    return sc;
}
__device__ __forceinline__ void transpose_item(const float* W, int K, int N, int src_c0, int rel_c0, int mode, bool f16, u16* WT, int dst_off, LAS float* scr, int k0, int lane) {
#pragma unroll 8
    for (int i = 0; i < 32; ++i) { const int kk = 2 * i + (lane >> 5); scr[kk * 33 + (lane & 31)] = W[(size_t)(k0 + kk) * N + src_c0 + (lane & 31)]; }
    LDS_WAIT(); asm volatile("" ::: "memory");
    const int c = lane & 7;
#pragma unroll
    for (int j = 0; j < 4; ++j) { const int n = (lane >> 3) + 8 * j; const LAS float* s = scr + (8 * c) * 33 + n;
        u32x4 o;
        if (f16) { o.x = pk2h(s[0 * 33], s[1 * 33]); o.y = pk2h(s[2 * 33], s[3 * 33]); o.z = pk2h(s[4 * 33], s[5 * 33]); o.w = pk2h(s[6 * 33], s[7 * 33]); }
        else { o.x = pk2bf(s[0 * 33], s[1 * 33]); o.y = pk2bf(s[2 * 33], s[3 * 33]); o.z = pk2bf(s[4 * 33], s[5 * 33]); o.w = pk2bf(s[6 * 33], s[7 * 33]); }
        const int drow = dst_off + map_row(mode, rel_c0 + n);
        *(GAS u32x4*)(WT + (size_t)drow * K + k0 + 8 * c) = o; }
    LDS_WAIT(); asm volatile("" ::: "memory");
}
__device__ __forceinline__ void p1_phase(Frame& F) {
    LAS float* scr = (LAS float*)(F.lds + RING_OFF + F.wave * 16384);
    const int gw = F.vcu * 8 + F.wave, NGW = F.G * 8, lane = F.lane;
    constexpr int I_FOLD = 128, I_QKV = 16 * 40, I_OUT = 16 * 32, I_R = 16 * 8, I_GU = NEXPS * 16 * 16, I_D = NEXPS * 4 * 32;
    constexpr int NITEMS = I_FOLD + I_QKV + I_OUT + I_R + I_GU + I_D;
    u16* BIN = WSP(u16, WS_BIN);
    for (int it = gw; it < NITEMS; it += NGW) {
        int r = it;
        if (r < I_FOLD) {
            const int fh = r >> 5, cs = (r >> 4) & 1, kb = r & 15; const int k = kb * 64 + lane;
            const GAS float* WCS = (const GAS float*)(F.ws + WS_TAB);
#pragma unroll 4
            for (int i = 0; i < 64; ++i) scr[i * 64 + lane] = WCS[(fh * 64 + i) * 128 + cs * 64 + lane];
            float wrow[64];
#pragma unroll
            for (int d4 = 0; d4 < 16; ++d4) { const f32x4 v = *(const f32x4*)(F.w_in + (size_t)k * 1536 + fh * 64 + 4 * d4); wrow[4 * d4] = v[0]; wrow[4 * d4 + 1] = v[1]; wrow[4 * d4 + 2] = v[2]; wrow[4 * d4 + 3] = v[3]; }
            LDS_WAIT(); asm volatile("" ::: "memory");
            for (int e = 0; e < 64; ++e) { float a = 0.f;
#pragma unroll
                for (int d = 0; d < 64; ++d) a += wrow[d] * scr[d * 64 + e];
                const int col256 = fh * 64 + e, pos = 8 * (col256 >> 2) + (col256 & 3) + 4 * cs;
                BIN[(size_t)pos * DM + k] = (u16)f2bf(a); }
            LDS_WAIT(); asm volatile("" ::: "memory");
            continue; }
        r -= I_FOLD;
        if (r < I_QKV) { const int kb = r / 40, nb = r % 40, sc0 = 256 + 32 * nb;
            if (sc0 < 1024) transpose_item(F.w_in, DM, 1536, sc0, sc0 - 256, 1, false, BIN, 512, scr, kb * 64, lane);
            else if (sc0 < 1280) transpose_item(F.w_in, DM, 1536, sc0, sc0 - 1024, 1, false, BIN, 1280, scr, kb * 64, lane);
            else transpose_item(F.w_in, DM, 1536, sc0, sc0 - 1280, 0, false, BIN, 1536, scr, kb * 64, lane);
            continue; }
        r -= I_QKV;
        if (r < I_OUT) { const int kb = r / 32, nb = r % 32; transpose_item(F.w_out, DM, DM, 32 * nb, 32 * nb, 0, false, WSP(u16, WS_BOUT), 0, scr, kb * 64, lane); continue; }
        r -= I_OUT;
        if (r < I_R) { const int kb = r / 8, nb = r % 8; transpose_item(F.w_router, DM, NEXP, 32 * nb, 32 * nb, 0, MOEF16, WSP(u16, WS_BR), 0, scr, kb * 64, lane); continue; }
        r -= I_R;
        if (r < I_GU) { const int e = r >> 8, q = r & 255, kb = q >> 4, nb = q & 15;
            const float* W = (e < NEXP) ? F.w_egu + (size_t)e * DM * 512 : F.w_sgu;
            transpose_item(W, DM, 512, 32 * nb, 32 * nb, 2, MOEF16, WSP(u16, WS_BGU) + (size_t)e * 512 * DM, 0, scr, kb * 64, lane); continue; }
        r -= I_GU;
        { const int e = r >> 7, q = r & 127, kb = q >> 5, nb = q & 31;
            const float* W = (e < NEXP) ? F.w_ed + (size_t)e * EFF * DM : F.w_sd;
            transpose_item(W, EFF, DM, 32 * nb, 32 * nb, 0, MOEF16, WSP(u16, WS_BD) + (size_t)e * DM * EFF, 0, scr, kb * 64, lane); }
    }
    const gi64* MOD = (const gi64*)(F.ctl + CW_MOD);
    u16* XN = WSP(u16, WS_XN);
    for (int m = gw; m < MIN_ROWS; m += NGW) {
        const float* src; int mr;
        if (m < NTOK) { src = F.x + (size_t)m * DM; mr = m >> 13; } else { src = F.ctx + (size_t)(m - NTOK) * DM; mr = 4; }
        f32x4 v[4]; float s2 = 0.f;
#pragma unroll
        for (int j = 0; j < 4; ++j) { v[j] = *(const f32x4*)(src + 4 * lane + 256 * j); s2 += (v[j][0] * v[j][0] + v[j][1] * v[j][1]) + (v[j][2] * v[j][2] + v[j][3] * v[j][3]); }
        const float rstd = 1.0f / sqrtf(wave_sum(s2) * (1.0f / DM) + RMS_EPS);
#pragma unroll
        for (int j = 0; j < 4; ++j) { const int col = 4 * lane + 256 * j; const f32x4 g = *(const f32x4*)(F.norm1_g + col);
            const f32x4 sh = mod4(MOD, mr * 6144 + col), sc = mod4(MOD, mr * 6144 + 1024 + col);
            const f32x4 y = v[j] * rstd * g * (sc + 1.0f) + sh;
            u32x2 w; w.x = pk2bf(y[0], y[1]); w.y = pk2bf(y[2], y[3]); *(GAS u32x2*)(XN + (size_t)m * DM + col) = w; }
    }
}

__device__ __forceinline__ void fourier_unit(Frame& F, int b, int g) {
    LAS unsigned char* Zl = F.lds + RING_OFF;
    LAS f32x2* TW128 = (LAS f32x2*)(F.lds + TAB_OFF);
    LAS f32x2* TW64 = (LAS f32x2*)(F.lds + TAB_OFF + 1024);
    const int tid = F.tid;
    const GAS u32x4* Zg = (const GAS u32x4*)(F.ws + WS_Z + ((size_t)(b * 64 + g) * SEQ) * 16);
#pragma unroll 4
    for (int i = 0; i < 16; ++i) *(LAS u32x4*)(Zl + (size_t)(i * 512 + tid) * 16) = Zg[i * 512 + tid];
    if (tid < 128) { float s, c; sincospif((float)tid * (1.0f / 64.0f), &s, &c); TW128[tid] = (f32x2){c, s}; }
    else if (tid < 192) { float s, c; sincospif((float)(tid - 128) * (1.0f / 32.0f), &s, &c); TW64[tid - 128] = (f32x2){c, s}; }
    __syncthreads();
    const int k1 = tid & 127, q = tid >> 7;
    float yr[16][4], yi[16][4];
#pragma unroll
    for (int a = 0; a < 16; ++a)
#pragma unroll
        for (int e = 0; e < 4; ++e) { yr[a][e] = 0.f; yi[a][e] = 0.f; }
    for (int n1 = 0; n1 < 128; ++n1) {
        const f32x2 tw = TW128[(n1 * k1) & 127]; const float c = tw.x, s = tw.y;
#pragma unroll
        for (int a = 0; a < 16; ++a) { const u32x4 rw = *(const LAS u32x4*)(Zl + (size_t)(64 * n1 + 16 * q + a) * 16);
            const float uc[4] = {bflo(rw.x), bfhi(rw.x), bflo(rw.y), bfhi(rw.y)}, us[4] = {bflo(rw.z), bfhi(rw.z), bflo(rw.w), bfhi(rw.w)};
#pragma unroll
            for (int e = 0; e < 4; ++e) { yr[a][e] += uc[e] * c - us[e] * s; yi[a][e] -= uc[e] * s + us[e] * c; } }
    }
    __syncthreads();
    int k1b = k1; asm volatile("" : "+v"(k1b));
#pragma unroll
    for (int a = 0; a < 16; ++a) { const int n2 = 16 * q + a; const float fr_ = (float)(n2 * k1b) * (1.0f / 8192.0f);
        const float cp = __builtin_amdgcn_cosf(fr_), sp = __builtin_amdgcn_sinf(fr_);
        float pr[4], pi[4];
#pragma unroll
        for (int e = 0; e < 4; ++e) { pr[e] = yr[a][e] * cp + yi[a][e] * sp; pi[e] = yi[a][e] * cp - yr[a][e] * sp; }
        u32x4 w; w.x = pk2bf(pr[0], pr[1]); w.y = pk2bf(pr[2], pr[3]); w.z = pk2bf(pi[0], pi[1]); w.w = pk2bf(pi[2], pi[3]);
        *(LAS u32x4*)(Zl + (size_t)(n2 * 128 + k1b) * 16) = w; }
    __syncthreads();
    int k1c = k1; asm volatile("" : "+v"(k1c));
    float o[16][4];
#pragma unroll
    for (int a = 0; a < 16; ++a)
#pragma unroll
        for (int e = 0; e < 4; ++e) o[a][e] = 0.f;
    for (int n2 = 0; n2 < 64; ++n2) {
        const u32x4 rw = *(const LAS u32x4*)(Zl + (size_t)(n2 * 128 + k1c) * 16);
        const float pr[4] = {bflo(rw.x), bfhi(rw.x), bflo(rw.y), bfhi(rw.y)}, pi[4] = {bflo(rw.z), bfhi(rw.z), bflo(rw.w), bfhi(rw.w)};
#pragma unroll
        for (int a = 0; a < 16; ++a) { const f32x2 tw = TW64[(n2 * (16 * q + a)) & 63];
#pragma unroll
            for (int e = 0; e < 4; ++e) o[a][e] += pr[e] * tw.x + pi[e] * tw.y; }
    }
    u16* MIX = WSP(u16, WS_MIX);
#pragma unroll
    for (int a = 0; a < 16; ++a) { const int k2 = 16 * q + a; u32x2 w; w.x = pk2bf(o[a][0], o[a][1]); w.y = pk2bf(o[a][2], o[a][3]);
        *(GAS u32x2*)(MIX + ((size_t)(b * SEQ + k1c + 128 * k2)) * DM + 4 * g) = w; }
    __syncthreads();
}

__device__ __forceinline__ void route_token(Frame& F, int tok) {
    const int l = F.lane;
    const f32x4 lg = *(const GAS f32x4*)((const GAS float*)(F.ws + WS_LOG) + (size_t)tok * NEXP + 4 * l);
    const f32x4 bs = *(const f32x4*)(F.router_bias + 4 * l);
    float s[4], sel[4];
#pragma unroll
    for (int j = 0; j < 4; ++j) { s[j] = 1.0f / (1.0f + expf(-lg[j])); sel[j] = s[j] + bs[j]; }
    float m1 = fmaxf(sel[0], sel[1]), m2 = fminf(sel[0], sel[1]);
#pragma unroll
    for (int j = 2; j < 4; ++j) { const float v = sel[j]; m2 = fmaxf(m2, fminf(m1, v)); m1 = fmaxf(m1, v); }
#pragma unroll
    for (int off = 1; off < 8; off <<= 1) { const float o1 = __shfl_xor(m1, off), o2 = __shfl_xor(m2, off); const float n2 = fmaxf(fminf(m1, o1), fmaxf(m2, o2)); m1 = fmaxf(m1, o1); m2 = n2; }
    const float gs = m1 + m2; const int myg = l >> 3; int rank = 0;
#pragma unroll
    for (int g2 = 0; g2 < 8; ++g2) { const float og = __shfl(gs, g2 * 8); rank += (og > gs || (og == gs && g2 < myg)) ? 1 : 0; }
    if (rank >= 4) {
#pragma unroll
        for (int j = 0; j < 4; ++j) sel[j] = -INFINITY; }
    int my_e = 0; float my_s = 0.f, sum = 0.f;
#pragma unroll 1
    for (int k = 0; k < TOPK; ++k) {
        float bv = sel[0]; int bi = 4 * l;
#pragma unroll
        for (int j = 1; j < 4; ++j) if (sel[j] > bv) { bv = sel[j]; bi = 4 * l + j; }
#pragma unroll
        for (int off = 1; off < 64; off <<= 1) { const float ov = __shfl_xor(bv, off); const int oi = __shfl_xor(bi, off); if (ov > bv || (ov == bv && oi < bi)) { bv = ov; bi = oi; } }
        const int jj = bi & 3; const bool own = (bi >> 2) == l;
        float cand = s[0];
#pragma unroll
        for (int j = 1; j < 4; ++j) cand = (jj == j) ? s[j] : cand;
        const float wsc = __shfl(cand, bi >> 2);
#pragma unroll
        for (int j = 0; j < 4; ++j) if (own && jj == j) sel[j] = -INFINITY;
        if (l == k) { my_e = bi; my_s = wsc; }
        sum += wsc;
    }
    GAS u32x2* LIST = (GAS u32x2*)(F.ws + WS_LIST);
    if (l < TOPK) { const float gate = my_s / sum * 2.5f; const unsigned pos = __hip_atomic_fetch_add((unsigned*)(F.ctl + CW_CNT + my_e), 1u, RLX_AGENT);
        LIST[(size_t)my_e * NTOK + pos] = (u32x2){(unsigned)tok | ((unsigned)l << 16), __builtin_bit_cast(unsigned, gate)}; }
    else if (l == TOPK) LIST[(size_t)NEXP * NTOK + tok] = (u32x2){(unsigned)tok | (8u << 16), __builtin_bit_cast(unsigned, 1.0f)};
}

__device__ __forceinline__ void build_tiles(Frame& F) {
    LAS int* TS = (LAS int*)(F.lds + TAB_OFF + 2048); LAS int* CN = (LAS int*)(F.lds + TAB_OFF + 3200);
    if (F.tid < 64) { const int l = F.tid; int c[5], t[5], tot = 0;
#pragma unroll
        for (int j = 0; j < 5; ++j) { const int e = 5 * l + j; c[j] = (e < NEXPS) ? (int)__hip_atomic_load((unsigned*)(F.ctl + CW_CNT + e), RLX_AGENT) : 0; t[j] = (c[j] + 255) >> 8; tot += t[j]; }
        int x = tot;
#pragma unroll
        for (int off = 1; off < 64; off <<= 1) { const int v = __shfl_up(x, off); if (l >= off) x += v; }
        int run = x - tot;
#pragma unroll
        for (int j = 0; j < 5; ++j) { const int e = 5 * l + j; if (e <= NEXPS) { TS[e] = run; if (e < NEXPS) CN[e] = c[j]; } run += t[j]; }
    }
    __syncthreads();
}

struct Args { const float* in[20]; float* out; unsigned char* ws; int ph_lo, ph_hi; };
__global__ void __launch_bounds__(512, 2) mk_fwd(Args args) {
    extern __shared__ __attribute__((aligned(16))) unsigned char lds[];
    Frame F;
    F.lds = (LAS unsigned char*)lds;
    F.MISC = (volatile LAS unsigned*)(F.lds + MISC_OFF);
    F.tid = threadIdx.x; F.lane = F.tid & 63; F.wave = __builtin_amdgcn_readfirstlane(F.tid >> 6);
    F.G = gridDim.x; { const int bx = blockIdx.x; F.vcu = (F.G % 8 == 0) ? (bx % 8) * (F.G / 8) + bx / 8 : bx; }
    F.ws = args.ws; F.ctl = (gu32*)(args.ws + WS_CTL); F.out = args.out;
    F.x = args.in[0]; F.c = args.in[1]; F.ctx = args.in[2]; F.c_ctx = args.in[3]; F.norm1_g = args.in[4]; F.w_ada = args.in[5]; F.b_ada = args.in[6]; F.w_in = args.in[7]; F.w_fourier = args.in[8];
    F.q_norm_g = args.in[9]; F.k_norm_g = args.in[10]; F.w_out = args.in[11]; F.norm2_g = args.in[12]; F.w_router = args.in[13]; F.router_bias = args.in[14]; F.w_egu = args.in[15]; F.w_ed = args.in[16];
    F.w_sgu = args.in[17]; F.w_sd = args.in[18]; F.final_g = args.in[19];
    for (int u = F.tid; u < (LDS_BYTES - LDSCTL_OFF) / 4; u += 512) ((LAS unsigned*)(F.lds + LDSCTL_OFF))[u] = 0u;
    __syncthreads();
    XcdBarrier bar; bar.bar = (unsigned*)(F.ctl + CW_BAR); bar.x = 0; bar.st = nullptr;
    if (N_LAUNCHES == 1) bar = xcd_barrier_post((unsigned*)(F.ctl + CW_BAR), F.MISC + 8);
    const int lo = args.ph_lo, hi = args.ph_hi;
#define IN(k) (lo <= (k) && (k) < hi)
#define SEAM(k) do { if (IN(k) && IN((k) + 1)) xcd_barrier(bar); } while (0)
    const gi64* MOD = (const gi64*)(F.ctl + CW_MOD);
    const int gw = F.vcu * 8 + F.wave, NGW = F.G * 8;

    if (IN(0)) { p0_phase(F); } SEAM(0);
    if (IN(1)) { p1_phase(F); VM_WAIT(); __syncthreads(); } SEAM(1);

    if (IN(2)) {
        DenseOrder S{7, 128 * 7, 8, F.G, F.vcu, (const char*)(F.ws + WS_BIN), DM};
        EpiInProj E{WSP(u16, WS_Z), WSP(u16, WS_Q), WSP(u16, WS_K), WSP(u16, WS_V), WSP(float, WS_TAB + 128 * 1024), WSP(float, WS_TAB + 136 * 1024), F.q_norm_g, F.k_norm_g};
        pg8::gemm_phase<EpiInProj, DenseOrder, false, true>(F.lds + RING_OFF, (const char*)(F.ws + WS_XN), DM, S, E);
    } SEAM(2);

    if (IN(3)) {
        if (DBG & 32) { u16* MIXz = WSP(u16, WS_MIX); for (int m = gw; m < NTOK; m += NGW) *(GAS u32x2*)(MIXz + (size_t)m * DM + 4 * F.lane) = (u32x2){0u, 0u}; }
        else
        for (int U = F.vcu; U < NB * 64; U += F.G) fourier_unit(F, U >> 6, U & 63);
        const attn_body::bf16* Qp = (const attn_body::bf16*)(F.ws + WS_Q); const attn_body::bf16* Kp = (const attn_body::bf16*)(F.ws + WS_K); const attn_body::bf16* Vp = (const attn_body::bf16*)(F.ws + WS_V);
        attn_body::bf16* Op = (attn_body::bf16*)(F.ws + WS_MIX) + 256;
        if (DBG & 16) { u16* MIXz = WSP(u16, WS_MIX); for (int m = gw; m < NTOK; m += NGW) for (int j = 1; j < 4; ++j) *(GAS u32x2*)(MIXz + (size_t)m * DM + 256 * j + 4 * F.lane) = (u32x2){0u, 0u}; }
        else if (F.G == 256) {
            const int xg = F.vcu >> 5, jq = F.vcu & 31;
            for (int i = 0; i < 6; ++i) { const int grp = 2 * xg + i / 3, hs = i % 3; attn_body::attn_unit<8>(grp >> 2, (grp & 3) * 3 + hs, jq, Qp, Kp, Vp, Op, (char*)lds + RING_OFF); }
        } else {
            for (int U = F.vcu; U < NB * NQH * 32; U += F.G) { const int grp = U / 96, r = U % 96; attn_body::attn_unit<8>(grp >> 2, (grp & 3) * 3 + r / 32, r % 32, Qp, Kp, Vp, Op, (char*)lds + RING_OFF); }
        }
    } SEAM(3);

    if (IN(4)) {
        if (DBG & 128) { GAS u32x4* zH = (GAS u32x4*)(F.ws + WS_H2); const size_t nH = (size_t)NTOK * DM * 2 / 16; for (size_t i = (size_t)blockIdx.x * 512 + F.tid; i < nH; i += (size_t)F.G * 512) zH[i] = (u32x4){0u, 0u, 0u, 0u}; }
        DenseOrder S{4, 128 * 4, 0, F.G, F.vcu, (const char*)(F.ws + WS_BOUT), DM};
        EpiResid E{F.x, F.out, MOD};
        pg8::gemm_phase<EpiResid, DenseOrder, false, true>(F.lds + RING_OFF, (const char*)(F.ws + WS_MIX), DM, S, E);
    } SEAM(4);

    if (IN(5)) {
        u16* H2 = WSP(u16, WS_H2); const int lane = F.lane;
        for (int m = gw; m < NTOK; m += NGW) { const GAS float* src = (const GAS float*)F.out + (size_t)m * DM; const int mr = m >> 13;
            f32x4 v[4]; float s2 = 0.f;
#pragma unroll
            for (int j = 0; j < 4; ++j) { v[j] = *(const GAS f32x4*)(src + 4 * lane + 256 * j); s2 += (v[j][0] * v[j][0] + v[j][1] * v[j][1]) + (v[j][2] * v[j][2] + v[j][3] * v[j][3]); }
            const float rstd = 1.0f / sqrtf(wave_sum(s2) * (1.0f / DM) + RMS_EPS);
#pragma unroll
            for (int j = 0; j < 4; ++j) { const int col = 4 * lane + 256 * j; const f32x4 g = *(const f32x4*)(F.norm2_g + col);
                const f32x4 sh = mod4(MOD, mr * 6144 + 3072 + col), sc = mod4(MOD, mr * 6144 + 4096 + col);
                const f32x4 y = v[j] * rstd * g * (sc + 1.0f) + sh;
                u32x2 w; if (MOEF16) { w.x = pk2h(y[0], y[1]); w.y = pk2h(y[2], y[3]); } else { w.x = pk2bf(y[0], y[1]); w.y = pk2bf(y[2], y[3]); } *(GAS u32x2*)(H2 + (size_t)m * DM + col) = w; } }
    } SEAM(5);

    if (IN(6)) {
        DenseOrder S{1, 128, 0, F.G, F.vcu, (const char*)(F.ws + WS_BR), DM};
        EpiLogits E{WSP(float, WS_LOG)};
        pg8::gemm_phase<EpiLogits, DenseOrder, MOEF16, true>(F.lds + RING_OFF, (const char*)(F.ws + WS_H2), DM, S, E);
    } SEAM(6);

    if (IN(7)) {
        if (DBG & 128) { GAS u32x4* zA = (GAS u32x4*)(F.ws + WS_ACT); const size_t nA = (size_t)MAXTILES * 256 * EFF * 2 / 16; for (size_t i = (size_t)blockIdx.x * 512 + F.tid; i < nA; i += (size_t)F.G * 512) zA[i] = (u32x4){0u, 0u, 0u, 0u};
            GAS u32x4* zC = (GAS u32x4*)(F.ws + WS_C); const size_t nC = (size_t)NTOK * NSLOT * DM * 2 / 16; for (size_t i = (size_t)blockIdx.x * 512 + F.tid; i < nC; i += (size_t)F.G * 512) zC[i] = (u32x4){0u, 0u, 0u, 0u}; }
        if (blockIdx.x == 0 && F.tid == 0) __hip_atomic_store((unsigned*)(F.ctl + CW_CNT + NEXP), (unsigned)NTOK, RLX_AGENT);
        for (int tok = gw; tok < NTOK; tok += NGW) route_token(F, tok);
    } SEAM(7);

    if (IN(8)) {
        build_tiles(F);
        GroupedOrder S{2, F.G, F.vcu, 512, DM, true, (const char*)(F.ws + WS_BGU), (const LAS int*)(F.lds + TAB_OFF + 2048), (const LAS int*)(F.lds + TAB_OFF + 3200), (const GAS u32x2*)(F.ws + WS_LIST)};
        EpiSwiglu E{WSP(u16, WS_ACT)};
        pg8::gemm_phase<EpiSwiglu, GroupedOrder, MOEF16, true>(F.lds + RING_OFF, (const char*)(F.ws + WS_H2), DM, S, E);
    } SEAM(8);

    if (IN(9)) {
        build_tiles(F);
        GroupedOrder S{4, F.G, F.vcu, DM, EFF, false, (const char*)(F.ws + WS_BD), (const LAS int*)(F.lds + TAB_OFF + 2048), (const LAS int*)(F.lds + TAB_OFF + 3200), (const GAS u32x2*)(F.ws + WS_LIST)};
        EpiDown E{WSP(u16, WS_C), (const GAS u32x2*)(F.ws + WS_LIST)};
        pg8::gemm_phase<EpiDown, GroupedOrder, MOEF16, true>(F.lds + RING_OFF, (const char*)(F.ws + WS_ACT), EFF, S, E);
    } SEAM(9);

    if (IN(10)) {
        if (DBG & 128) build_tiles(F);
        const int lane = F.lane; const GAS u16* Cc = (const GAS u16*)(F.ws + WS_C);
        for (int m = gw; m < NTOK; m += NGW) { const int mr = m >> 13; GAS float* orow = (GAS float*)F.out + (size_t)m * DM;
            f32x4 y[4];
#pragma unroll
            for (int j = 0; j < 4; ++j) y[j] = (DBG & 64) ? (f32x4){1.f, 1.f, 1.f, 1.f} : (f32x4){0.f, 0.f, 0.f, 0.f};
#pragma unroll
            for (int sl = ((DBG & 4) ? 8 : 0); sl < ((DBG & 1) ? 0 : ((DBG & 8) ? 8 : NSLOT)); ++sl)
#pragma unroll
                for (int j = 0; j < 4; ++j) { const u32x2 w = *(const GAS u32x2*)(Cc + ((size_t)m * NSLOT + sl) * DM + 4 * lane + 256 * j); y[j][0] += bflo(w.x); y[j][1] += bfhi(w.x); y[j][2] += bflo(w.y); y[j][3] += bfhi(w.y); }
            if (DBG & 128) { const LAS int* TSd = (const LAS int*)(F.lds + TAB_OFF + 2048); const int ts256 = TSd[256];
#pragma unroll
                for (int j = 0; j < 4; ++j) { const int col = 4 * lane + 256 * j; u32x2 w; float sc_ = 0.f;
                    (void)ts256; (void)sc_;
                    if (DBG & 256) w = *(const GAS u32x2*)((const GAS u16*)(F.ws + WS_H2) + (size_t)m * DM + col);
                    else if (DBG & 512) w = *(const GAS u32x2*)((const GAS u16*)(F.ws + WS_ACT) + ((size_t)ts256 * 256 + m) * EFF + (col & 255));
                    else w = *(const GAS u32x2*)(Cc + ((size_t)m * NSLOT + 8) * DM + col);
                    y[j][0] = bflo(w.x); y[j][1] = bfhi(w.x); y[j][2] = bflo(w.y); y[j][3] = bfhi(w.y); } }
            float s2 = 0.f; f32x4 v[4];
#pragma unroll
            for (int j = 0; j < 4; ++j) { const int col = 4 * lane + 256 * j; const f32x4 x1 = *(const GAS f32x4*)(orow + col); const f32x4 g2 = mod4(MOD, mr * 6144 + 5120 + col);
                v[j] = x1 + g2 * y[j]; s2 += (v[j][0] * v[j][0] + v[j][1] * v[j][1]) + (v[j][2] * v[j][2] + v[j][3] * v[j][3]); }
            const float rstd = 1.0f / sqrtf(wave_sum(s2) * (1.0f / DM) + RMS_EPS);
#pragma unroll
            for (int j = 0; j < 4; ++j) { const int col = 4 * lane + 256 * j; const f32x4 g = *(const f32x4*)(F.final_g + col); *(GAS f32x4*)(orow + col) = v[j] * rstd * g; } }
    }
#undef IN
#undef SEAM
}

extern "C" void kernel_launch(void* const* d_in, const int* in_sizes, int n_in, void* d_out, int out_size, void* d_ws, size_t ws_size, hipStream_t stream) {
    static int grid = 0;
    if (grid == 0) {
        if (n_in != 20 || in_sizes[0] != NTOK * DM || out_size != NTOK * DM || ws_size < WS_END) { fprintf(stderr, "kernel_launch: unexpected shapes (n_in %d, in0 %d, out %d, ws %zu < %zu)\n", n_in, n_in > 0 ? in_sizes[0] : -1, out_size, ws_size, (size_t)WS_END); grid = -1; return; }
        int dev = 0, cus = 0, per_cu = 0;
        if (hipGetDevice(&dev) != hipSuccess || hipDeviceGetAttribute(&cus, hipDeviceAttributeMultiprocessorCount, dev) != hipSuccess) { grid = -1; return; }
        if (hipFuncSetAttribute((const void*)mk_fwd, hipFuncAttributeMaxDynamicSharedMemorySize, LDS_BYTES) != hipSuccess) { fprintf(stderr, "kernel_launch: hipFuncSetAttribute failed\n"); grid = -1; return; }
        if (hipOccupancyMaxActiveBlocksPerMultiprocessor(&per_cu, (const void*)mk_fwd, 512, LDS_BYTES) != hipSuccess || per_cu < 1) fprintf(stderr, "kernel_launch: occupancy query reports %d\n", per_cu);
        (void)hipGetLastError();
        grid = cus;
    }
    if (grid < 0) return;
    (void)hipMemsetAsync((char*)d_ws + WS_CTL, 0, CTL_ZERO_BYTES, stream);
    Args a{};
    for (int i = 0; i < 20; ++i) a.in[i] = (const float*)d_in[i];
    a.out = (float*)d_out; a.ws = (unsigned char*)d_ws;
    if (N_LAUNCHES == 1) { a.ph_lo = 0; a.ph_hi = PER_PHASE; hipLaunchKernelGGL(mk_fwd, dim3(grid), dim3(512), LDS_BYTES, stream, a); }
    else for (int li = 0; li < PER_PHASE; ++li) { a.ph_lo = li; a.ph_hi = li + 1; hipLaunchKernelGGL(mk_fwd, dim3(grid), dim3(512), LDS_BYTES, stream, a); }
}
```

```cpp
#include <hip/hip_runtime.h>
#include <hip/hip_bf16.h>
#include <cstdio>
#include <cstdint>
#include <cmath>

#ifndef MK_N_LAUNCHES
#define MK_N_LAUNCHES 1
#endif
constexpr int PER_PHASE = 11;
#ifndef DBG
#define DBG 0
#endif
#ifndef REP
#define REP -1
#endif
#ifndef CHK_TOL_A
#define CHK_TOL_A 1e-3f
#endif
#ifndef CHK_TOL_B
#define CHK_TOL_B 1e-3f
#endif
#ifndef FOURIER_MFMA
#define FOURIER_MFMA 1
#endif
#define REPS(k) for (int rep_ = 0; rep_ < ((REP == (k)) ? 2 : 1); ++rep_)
#define REPBAR() do { if (rep_) xcd_barrier(bar); } while (0)
constexpr int N_LAUNCHES = MK_N_LAUNCHES;

#define GAS __attribute__((address_space(1)))
#define LAS __attribute__((address_space(3)))
typedef unsigned short u16;
typedef short bf16x8 __attribute__((ext_vector_type(8)));
typedef _Float16 half8 __attribute__((ext_vector_type(8)));
typedef _Float16 half2v __attribute__((ext_vector_type(2)));
typedef float f32x4 __attribute__((ext_vector_type(4)));
typedef float f32x2 __attribute__((ext_vector_type(2)));
typedef unsigned u32x4 __attribute__((ext_vector_type(4)));
typedef unsigned u32x2 __attribute__((ext_vector_type(2)));
typedef GAS unsigned gu32;

constexpr int DM = 1024, NB = 4, SEQ = 8192, NTOK = NB * SEQ, CTXL = 256, NCTX = NB * CTXL, LKV = SEQ + CTXL;
constexpr int NQH = 12, NKVH = 4, HD = 64, QW = NQH * HD, KVW = NKVH * HD;
constexpr int NIN = 1792;
constexpr int MIN_ROWS = NTOK + NCTX;
constexpr int NEXP = 256, NEXPS = 257, TOPK = 8, EFF = 256, NSLOT = 9;
constexpr int MAXTILES = 1408;
constexpr float RMS_EPS = 1e-6f;
#ifndef MOE_F16
#define MOE_F16 0
#endif
constexpr bool MOEF16 = MOE_F16;
constexpr float C2 = 0.125f * 1.4426950408889634f;
constexpr float C_SCALE = 16.0f;

constexpr size_t MiB = 1u << 20;
constexpr size_t WS_CTL = 0, CTL_ZERO_BYTES = 1 * MiB;
constexpr size_t WS_TAB = 1 * MiB;
constexpr size_t WS_BIN = 2 * MiB;
constexpr size_t WS_BOUT = 6 * MiB;
constexpr size_t WS_BR = 8 * MiB;
constexpr size_t WS_K = 16 * MiB;
constexpr size_t WS_V = 34 * MiB;
constexpr size_t WS_Z = 52 * MiB;
constexpr size_t WS_Q = 84 * MiB;
constexpr size_t WS_XN = 132 * MiB;
constexpr size_t WS_MIX = 198 * MiB;
constexpr size_t WS_H2 = 262 * MiB;
constexpr size_t WS_LOG = 326 * MiB;
constexpr size_t WS_LIST = 358 * MiB;
constexpr size_t WS_BGU = 424 * MiB;
constexpr size_t WS_BD = 682 * MiB;
constexpr size_t WS_ACT = 812 * MiB;
constexpr size_t WS_C = 990 * MiB;
constexpr size_t WS_END = 1568 * MiB;
constexpr int CW_TMO = 0, CW_CODE = 1;
constexpr int CW_BAR = 4096;
constexpr int CW_CNT = 16384;
constexpr int CW_CHK = 32768;
constexpr int CW_MOD = 131072;
static_assert(CW_MOD * 4 + 5 * 6144 * 8 <= (int)CTL_ZERO_BYTES, "ctl");

constexpr int RING_OFF = 0, RING_BYTES = 131072;
constexpr int TAB_OFF = RING_BYTES;
constexpr int LDSCTL_OFF = RING_BYTES + 8192, MISC_OFF = LDSCTL_OFF + 320;
constexpr int LDS_BYTES = 147456;

#define LDS_WAIT() asm volatile("s_waitcnt lgkmcnt(0)" ::: "memory")
#define VM_WAIT() asm volatile("s_waitcnt vmcnt(0)" ::: "memory")
#define RLX_AGENT __ATOMIC_RELAXED, __HIP_MEMORY_SCOPE_AGENT

__device__ __forceinline__ unsigned f2bf(float f) { unsigned u = __builtin_bit_cast(unsigned, f); return (u + 0x7fffu + ((u >> 16) & 1u)) >> 16; }
__device__ __forceinline__ unsigned pk2bf(float lo, float hi) { return f2bf(lo) | (f2bf(hi) << 16); }
__device__ __forceinline__ unsigned pk2h(float lo, float hi) { half2v v = {(_Float16)lo, (_Float16)hi}; return __builtin_bit_cast(unsigned, v); }
__device__ __forceinline__ unsigned cvt_pk_bf16(float lo, float hi) { unsigned r; asm volatile("v_cvt_pk_bf16_f32 %0, %1, %2" : "=v"(r) : "v"(lo), "v"(hi)); return r; }
__device__ __forceinline__ float bflo(unsigned w) { return __builtin_bit_cast(float, w << 16); }
__device__ __forceinline__ float bfhi(unsigned w) { return __builtin_bit_cast(float, w & 0xffff0000u); }
typedef long long i64x2 __attribute__((ext_vector_type(2)));
typedef GAS long long gi64;
__device__ __forceinline__ f32x4 mod4(const gi64* MODQ, int idx) {
    const i64x2 a = *(const GAS i64x2*)(MODQ + idx), b = *(const GAS i64x2*)(MODQ + idx + 2);
    return (f32x4){(float)a.x, (float)a.y, (float)b.x, (float)b.y} * 0x1p-36f;
}
__device__ __forceinline__ float wave_sum(float v) {
#pragma unroll
    for (int o = 1; o < 64; o <<= 1) v += __shfl_xor(v, o);
    return v;
}

namespace pg8 {
constexpr int BM = 256, BK = 64, HALF = 128, HTB = HALF * BK * 2, STAGE_BYTES = 8 * HTB;
__host__ __device__ __forceinline__ int lds_byte(int r, int c) { const int st = (r >> 4) * 2 + (c >> 5), rr = r & 15, cc = c & 31, ob = rr * 64 + cc * 2; return st * 1024 + (ob ^ (((ob >> 9) & 1) << 5)); }
__host__ __device__ __forceinline__ void stage_rc(int b, int& R, int& C) { const int st = b / 1024, sb = b % 1024, swz = sb ^ (((sb >> 9) & 1) << 5); R = (st >> 1) * 16 + swz / 64; C = (st & 1) * 32 + (swz % 64) / 2; }
__host__ __device__ __forceinline__ int perm32(int rho) { const int n = rho >> 4, i = rho & 15; return 8 * (i >> 2) + 4 * n + (i & 3); }

struct GUnit { int pm, pn, e, j, nvalid; const char* B; };

template <bool F16> __device__ __forceinline__ f32x4 mma16(bf16x8 a, bf16x8 b, f32x4 c) {
    if constexpr (F16) return __builtin_amdgcn_mfma_f32_16x16x32_f16(__builtin_bit_cast(half8, a), __builtin_bit_cast(half8, b), c, 0, 0, 0);
    else return __builtin_amdgcn_mfma_f32_16x16x32_bf16(a, b, c, 0, 0, 0);
}

template <class Epi, class Sched, bool F16, bool ALIGN_EPI>
__device__ __forceinline__ void gemm_phase(LAS unsigned char* lds, const char* Abase, const int K, const Sched& S, const Epi& E) {
    const int tid = threadIdx.x, wid = __builtin_amdgcn_readfirstlane(tid >> 6), lane = tid & 63, wr = wid >> 2, wc = wid & 3, fr = lane & 15, fq = lane >> 4;
    const int nt = K / BK;
    unsigned voffB[2];
#pragma unroll
    for (int i = 0; i < 2; ++i) { int R, C; stage_rc(tid * 16 + i * 8192, R, C); const int Rb = Epi::PERM ? ((R & ~31) + perm32(R & 31)) : R; voffB[i] = (unsigned)(Rb * K + C) * 2u; }
#define PG8_AOFF(V, UNIT) do { int t_ = tid; asm volatile("" : "+v"(t_)); _Pragma("unroll") for (int _i = 0; _i < 2; ++_i) { int R_, C_; stage_rc(t_ * 16 + _i * 8192, R_, C_); \
        _Pragma("unroll") for (int _h = 0; _h < 2; ++_h) (V)[_h][_i] = ((unsigned)S.arow(UNIT, R_ + HALF * _h) * (unsigned)K + (unsigned)C_) * 2u; } } while (0)
    const size_t kstep = (size_t)(BK * 2);
    const size_t hstep = (size_t)HALF * K * 2;
    const unsigned ldsw = (unsigned)wid * 1024u;
    const int aoff = lds_byte(wr * 64 + fr, fq * 8), boff = lds_byte(wc * 32 + fr, fq * 8);
#define PG8_SA(b, h) (((b) * 2 + (h)) * HTB)
#define PG8_SB(b, h) ((4 + (b) * 2 + (h)) * HTB)
#define PG8_STAGEB(bufoff, gbase) do { _Pragma("unroll") for (int _i = 0; _i < 2; ++_i) \
        __builtin_amdgcn_global_load_lds((const unsigned*)((const char*)(gbase) + voffB[_i]), (LAS unsigned*)(lds + (bufoff) + ldsw + _i * 8192), 16, 0, 0); } while (0)
#define PG8_STAGEA(bufoff, koff, V, h) do { _Pragma("unroll") for (int _i = 0; _i < 2; ++_i) \
        __builtin_amdgcn_global_load_lds((const unsigned*)(Abase + (size_t)(V)[h][_i] + (koff)), (LAS unsigned*)(lds + (bufoff) + ldsw + _i * 8192), 16, 0, 0); } while (0)
#define PG8_LDA(dst, b, h) do { _Pragma("unroll") for (int m = 0; m < 4; ++m) _Pragma("unroll") for (int k = 0; k < 2; ++k) dst[m][k] = *(const LAS bf16x8*)(lds + PG8_SA(b, h) + aoff + m * 2048 + k * 1024); } while (0)
#define PG8_LDB(dst, b, h) do { _Pragma("unroll") for (int n = 0; n < 2; ++n) _Pragma("unroll") for (int k = 0; k < 2; ++k) dst[n][k] = *(const LAS bf16x8*)(lds + PG8_SB(b, h) + boff + n * 2048 + k * 1024); } while (0)
#define PG8_MMA(ai, bj, At, Bt) do { __builtin_amdgcn_s_setprio(1); _Pragma("unroll") for (int m = 0; m < 4; ++m) _Pragma("unroll") for (int n = 0; n < 2; ++n) _Pragma("unroll") for (int k = 0; k < 2; ++k) \
        acc[ai][bj][m][n] = mma16<F16>(Bt[n][k], At[m][k], acc[ai][bj][m][n]); __builtin_amdgcn_s_setprio(0); } while (0)
#define PG8_WAIT_V(n) asm volatile("s_waitcnt vmcnt(" #n ")" ::: "memory")
#define PG8_WAIT_L(n) asm volatile("s_waitcnt lgkmcnt(" #n ")" ::: "memory")
#define PG8_BAR __builtin_amdgcn_s_barrier()
#define PG8_SCHED __builtin_amdgcn_sched_barrier(0)
    GUnit cur, nxt; int ui = 0;
    if (!S.next(0, cur)) return;
    f32x4 acc[2][2][4][2];
#pragma unroll
    for (int a = 0; a < 2; ++a)
#pragma unroll
        for (int b = 0; b < 2; ++b)
#pragma unroll
            for (int m = 0; m < 4; ++m)
#pragma unroll
                for (int n = 0; n < 2; ++n) acc[a][b][m][n] = (f32x4){0.f, 0.f, 0.f, 0.f};
    bf16x8 At[4][2], B0[2][2], B1[2][2];
    unsigned vA[2][2], vN[2][2];
    PG8_AOFF(vA, cur);
    if constexpr (Sched::GATHER) VM_WAIT();
    const char* cB = cur.B;
    PG8_STAGEB(PG8_SB(0, 0), cB); PG8_STAGEB(PG8_SB(0, 1), cB + hstep); PG8_STAGEA(PG8_SA(0, 0), 0, vA, 0); PG8_STAGEA(PG8_SA(0, 1), 0, vA, 1);
    if (wr == 1) PG8_BAR;
    PG8_WAIT_V(2); PG8_BAR;
    PG8_STAGEB(PG8_SB(1, 0), cB + kstep); PG8_STAGEA(PG8_SA(1, 0), kstep, vA, 0); PG8_STAGEB(PG8_SB(1, 1), cB + hstep + kstep);
    PG8_WAIT_V(6); PG8_BAR;
    for (;;) {
        const bool has_next = S.next(ui + 1, nxt);
        const char* nB = cB;
        if (has_next) {
            PG8_AOFF(vN, nxt);
            if constexpr (Sched::GATHER) VM_WAIT();
            nB = nxt.B;
        } else {
#pragma unroll
            for (int h = 0; h < 2; ++h)
#pragma unroll
                for (int i = 0; i < 2; ++i) vN[h][i] = vA[h][i];
        }
        for (int t = 0; t < nt; t += 2) {
            const bool last = (t == nt - 2);
            const size_t k1 = (size_t)(t + 1) * kstep;
            const size_t k2 = last ? (size_t)0 : (size_t)(t + 2) * kstep, k3 = k2 + kstep;
            unsigned v2[2][2];
#pragma unroll
            for (int h = 0; h < 2; ++h)
#pragma unroll
                for (int i = 0; i < 2; ++i) v2[h][i] = last ? vN[h][i] : vA[h][i];
            const char* b2 = (last ? nB : cB) + k2; const char* b3 = b2 + kstep;
            PG8_LDB(B0, 0, 0); PG8_LDB(B1, 0, 1); PG8_SCHED; PG8_LDA(At, 0, 0); PG8_STAGEA(PG8_SA(1, 1), k1, vA, 1);
            PG8_WAIT_V(8); PG8_WAIT_L(0); PG8_BAR; PG8_MMA(0, 0, At, B0); PG8_MMA(0, 1, At, B1); PG8_BAR; PG8_SCHED;
            PG8_LDA(At, 0, 1); PG8_STAGEB(PG8_SB(0, 0), b2); PG8_STAGEB(PG8_SB(0, 1), b2 + hstep); PG8_STAGEA(PG8_SA(0, 0), k2, v2, 0);
            PG8_WAIT_V(8); PG8_WAIT_L(0); PG8_BAR; PG8_MMA(1, 0, At, B0); PG8_MMA(1, 1, At, B1); PG8_BAR; PG8_SCHED;
            PG8_LDB(B0, 1, 0); PG8_LDB(B1, 1, 1); PG8_SCHED; PG8_LDA(At, 1, 0); PG8_STAGEA(PG8_SA(0, 1), k2, v2, 1);
            PG8_WAIT_V(8); PG8_WAIT_L(0); PG8_BAR; PG8_MMA(0, 0, At, B0); PG8_MMA(0, 1, At, B1); PG8_BAR; PG8_SCHED;
            PG8_LDA(At, 1, 1); PG8_STAGEB(PG8_SB(1, 0), b3); PG8_STAGEB(PG8_SB(1, 1), b3 + hstep); PG8_STAGEA(PG8_SA(1, 0), k3, v2, 0);
            PG8_WAIT_V(8); PG8_WAIT_L(0); PG8_BAR; PG8_MMA(1, 0, At, B0); PG8_MMA(1, 1, At, B1); PG8_BAR; PG8_SCHED;
        }
        if constexpr (ALIGN_EPI) { if (wr == 0) PG8_BAR; }
        E(acc, cur, wr, wc, fr, fq);
        if (!has_next) break;
#pragma unroll
        for (int a = 0; a < 2; ++a)
#pragma unroll
            for (int b = 0; b < 2; ++b)
#pragma unroll
                for (int m = 0; m < 4; ++m)
#pragma unroll
                    for (int n = 0; n < 2; ++n) acc[a][b][m][n] = (f32x4){0.f, 0.f, 0.f, 0.f};
        cur = nxt; cB = nB; ++ui;
#pragma unroll
        for (int h = 0; h < 2; ++h)
#pragma unroll
            for (int i = 0; i < 2; ++i) vA[h][i] = vN[h][i];
        if constexpr (ALIGN_EPI) { if (wr == 1) PG8_BAR; }
    }
    PG8_WAIT_V(0);
    if constexpr (!ALIGN_EPI) { if (wr == 0) PG8_BAR; }
    PG8_BAR;
#undef PG8_SA
#undef PG8_SB
#undef PG8_STAGEA
#undef PG8_AOFF
#undef PG8_STAGEB
#undef PG8_LDA
#undef PG8_LDB
#undef PG8_MMA
#undef PG8_WAIT_V
#undef PG8_WAIT_L
#undef PG8_BAR
#undef PG8_SCHED
}
}

namespace attn_body {
using bf16 = __hip_bfloat16;
using s16x4 = __attribute__((ext_vector_type(4))) short;
using f32x16 = __attribute__((ext_vector_type(16))) float;
constexpr int D = 64, DMQ = QW, DMKV = KVW, DMO = DM;
constexpr int NW = 8, QBLK = 32, QB = QBLK * NW, KVBLK = 64, NT = LKV / KVBLK;
static_assert(NT % 2 == 0 && NT >= 8, "tile count");
__device__ __forceinline__ int crow(int r, int hi) { return (r & 3) + 8 * (r >> 2) + 4 * hi; }
#define SBAR() __builtin_amdgcn_sched_barrier(0)
constexpr int NSLOTR = 3, SLOTB = 8192;
constexpr int LDS_K = 0, LDS_V = NSLOTR * SLOTB, LDS_WS = 2 * NSLOTR * SLOTB, LDS_OST = LDS_WS + NW * 64 * 4, ATT_LDS_BYTES = LDS_OST + NW * 4096;
__device__ __forceinline__ void glds16(const void* gsrc, unsigned lds_dst) { unsigned keep;
    asm volatile("s_mov_b32 %0, m0\n\ts_mov_b32 m0, %2\n\ts_nop 0\n\tglobal_load_lds_dwordx4 %1, off\n\ts_mov_b32 m0, %0" : "=&s"(keep) : "v"(gsrc), "s"(lds_dst) : "memory"); }
__device__ __forceinline__ float max3f(float a, float b, float c) { float r; asm("v_max3_f32 %0, %1, %2, %3" : "=v"(r) : "v"(a), "v"(b), "v"(c)); return r; }
__device__ __forceinline__ float max2f(float a, float b) { float r; asm("v_max_f32_e32 %0, %1, %2" : "=v"(r) : "v"(a), "v"(b)); return r; }
__device__ __forceinline__ float fadd_s(float a, float b) { float r; asm("v_add_f32_e32 %0, %1, %2" : "=v"(r) : "v"(a), "v"(b)); return r; }
__device__ __forceinline__ float fsub_s(float a, float b) { float r; asm("v_sub_f32_e32 %0, %1, %2" : "=v"(r) : "v"(a), "v"(b)); return r; }
typedef float f32x2_t __attribute__((ext_vector_type(2))); typedef __bf16 bf16x2_t __attribute__((ext_vector_type(2)));
__device__ __forceinline__ unsigned cvtpk_s(float lo, float hi) { f32x2_t v = {lo, hi}; bf16x2_t b = __builtin_convertvector(v, bf16x2_t); return __builtin_bit_cast(unsigned, b); }
#define WAIT_BAR(N) asm volatile("s_waitcnt vmcnt(" #N ") lgkmcnt(0)\n\ts_barrier" ::: "memory")

__device__ __forceinline__ void qkt(f32x16& p0, f32x16& p1, const char* Kslot, const bf16x8* qr, const f32x16& negm, int r32, int hi) {
    const char* kb = Kslot + hi * 1024 + r32 * 16;
#pragma unroll
    for (int d0 = 0; d0 < 4; ++d0) {
        const bf16x8 b0 = *reinterpret_cast<const bf16x8*>(kb + d0 * 2048);
        const bf16x8 b1 = *reinterpret_cast<const bf16x8*>(kb + d0 * 2048 + 512);
        if (d0 == 0) { p0 = __builtin_amdgcn_mfma_f32_32x32x16_bf16(b0, qr[0], negm, 0, 0, 0); p1 = __builtin_amdgcn_mfma_f32_32x32x16_bf16(b1, qr[0], negm, 0, 0, 0); }
        else { p0 = __builtin_amdgcn_mfma_f32_32x32x16_bf16(b0, qr[d0], p0, 0, 0, 0); p1 = __builtin_amdgcn_mfma_f32_32x32x16_bf16(b1, qr[d0], p1, 0, 0, 0); } }
}
typedef __attribute__((address_space(3))) const char* lds_cptr;
typedef short v4i16_t __attribute__((ext_vector_type(4)));
__device__ __forceinline__ void kload8(bf16x8* kf, lds_cptr kp) {
    kf[0] = *(const __attribute__((address_space(3))) bf16x8*)(kp);        kf[1] = *(const __attribute__((address_space(3))) bf16x8*)(kp + 512);
    kf[2] = *(const __attribute__((address_space(3))) bf16x8*)(kp + 2048); kf[3] = *(const __attribute__((address_space(3))) bf16x8*)(kp + 2560);
    kf[4] = *(const __attribute__((address_space(3))) bf16x8*)(kp + 4096); kf[5] = *(const __attribute__((address_space(3))) bf16x8*)(kp + 4608);
    kf[6] = *(const __attribute__((address_space(3))) bf16x8*)(kp + 6144); kf[7] = *(const __attribute__((address_space(3))) bf16x8*)(kp + 6656);
}
__device__ __forceinline__ void kload2(bf16x8* kf, lds_cptr kp, int j) { kf[2 * j] = *(const __attribute__((address_space(3))) bf16x8*)(kp + j * 2048); kf[2 * j + 1] = *(const __attribute__((address_space(3))) bf16x8*)(kp + j * 2048 + 512); }
__device__ __forceinline__ s16x4 vtr(lds_cptr p) { return __builtin_bit_cast(s16x4, __builtin_amdgcn_ds_read_tr16_b64_v4i16((__attribute__((address_space(3))) v4i16_t*)p)); }
__device__ __forceinline__ float rowmax(const f32x16& p0, const f32x16& p1) {
    float a = max3f(p0[0], p0[1], p1[0]), b = max3f(p0[2], p0[3], p1[1]); a = max3f(a, p1[2], p1[3]);
#pragma unroll
    for (int r = 4; r < 16; r += 4) { a = max3f(a, p0[r], p0[r + 1]); b = max3f(b, p0[r + 2], p0[r + 3]); a = max3f(a, p1[r], p1[r + 1]); b = max3f(b, p1[r + 2], p1[r + 3]); }
    const float m = max2f(a, b);
    auto rr = __builtin_amdgcn_permlane32_swap(__float_as_uint(m), __float_as_uint(m), false, false);
    return max2f(__uint_as_float(rr[0]), __uint_as_float(rr[1]));
}
__device__ __forceinline__ void pv(f32x16* o, int vb, bf16x8 pa0, bf16x8 pa1, bf16x8 pa2, bf16x8 pa3) {
#pragma unroll
    for (int d0 = 0; d0 < 2; ++d0) { s16x4 lo[4], hi[4];
#pragma unroll
        for (int ks = 0; ks < 4; ++ks) {
            asm volatile("ds_read_b64_tr_b16 %0,%1 offset:%c2" : "=&v"(lo[ks]) : "v"(vb), "i"(d0 * 4096 + ks * 1024) : "memory");
            asm volatile("ds_read_b64_tr_b16 %0,%1 offset:%c2" : "=&v"(hi[ks]) : "v"(vb), "i"(d0 * 4096 + ks * 1024 + 512) : "memory"); }
        asm volatile("s_waitcnt lgkmcnt(0)" ::: "memory"); SBAR();
#define PK(k) (bf16x8){lo[k][0], lo[k][1], lo[k][2], lo[k][3], hi[k][0], hi[k][1], hi[k][2], hi[k][3]}
        o[d0] = __builtin_amdgcn_mfma_f32_32x32x16_bf16(pa0, PK(0), o[d0], 0, 0, 0);
        o[d0] = __builtin_amdgcn_mfma_f32_32x32x16_bf16(pa1, PK(1), o[d0], 0, 0, 0);
        o[d0] = __builtin_amdgcn_mfma_f32_32x32x16_bf16(pa2, PK(2), o[d0], 0, 0, 0);
        o[d0] = __builtin_amdgcn_mfma_f32_32x32x16_bf16(pa3, PK(3), o[d0], 0, 0, 0);
#undef PK
    }
}
template <int THRL> __device__ __forceinline__ void attn_unit(int b, int h, int qb, const bf16* Q, const bf16* __restrict__ K, const bf16* __restrict__ V, bf16* O, char* shm, float negM_) {
    const int tid = threadIdx.x, lane = tid & 63, r32 = lane & 31, hi = lane >> 5; const int wid = __builtin_amdgcn_readfirstlane(tid >> 6);
    const int q0 = qb * QB; const int kvh = h / 3;
    const long qrow0 = (long)b * SEQ + q0 + wid * QBLK;
    const long kvrow0 = (long)b * LKV;
    const bf16* Qw = Q + qrow0 * DMQ + h * D;
    const bf16* Kh = K + kvrow0 * DMKV + kvh * D, *Vh = V + kvrow0 * DMKV + kvh * D;
    const unsigned lds0 = (unsigned)(uintptr_t)shm;
    float* wsf = (float*)(shm + LDS_WS) + wid * 64;
    const bf16* ksrc = Kh + (long)lane * DMKV + wid * 8;
    const bf16* vsrc = Vh + (long)(16 * (wid & 3) + (lane >> 2)) * DMKV + (wid >> 2) * 32 + (lane & 3) * 8;
    const unsigned kdst = lds0 + LDS_K + wid * 1024, vdst = lds0 + LDS_V + wid * 1024;
#define DMA_K(t, slot) glds16(ksrc + (long)(t) * KVBLK * DMKV, (unsigned)__builtin_amdgcn_readfirstlane(kdst + (slot)))
#define DMA_V(t, slot) glds16(vsrc + (long)(t) * KVBLK * DMKV, (unsigned)__builtin_amdgcn_readfirstlane(vdst + (slot)))
    const int vb0 = (int)(lds0 + LDS_V) + ((lane >> 4) & 1) * 32 + (lane & 3) * 8 + (4 * hi + ((lane & 15) >> 2)) * 64;
    const char* Kbase = shm + LDS_K; bf16x8 kf[8];
    const lds_cptr shm3 = (lds_cptr)shm; const lds_cptr kp0 = shm3 + LDS_K + hi * 1024 + r32 * 16; const lds_cptr vp0 = shm3 + LDS_V + ((lane >> 4) & 1) * 32 + (lane & 3) * 8 + (4 * hi + ((lane & 15) >> 2)) * 64;
    DMA_K(0, 0); DMA_V(0, 0); DMA_K(1, SLOTB);
    bf16x8 qr[4];
#pragma unroll
    for (int d0 = 0; d0 < 4; ++d0) qr[d0] = *reinterpret_cast<const bf16x8*>(&Qw[(long)r32 * DMQ + d0 * 16 + hi * 8]);
    float l_reg = 0.f; f32x16 o[2]; o[0] = f32x16{}; o[1] = f32x16{}; f32x16 negm;
    _Pragma("unroll") for (int r = 0; r < 16; ++r) negm[r] = negM_;
    asm volatile("" : "+v"(negm));
#define START(P0, P1) do { _Pragma("unroll") for (int r = 0; r < 16; ++r) P0[r] = __builtin_amdgcn_exp2f(P0[r]); } while (0)
#define RESC() do { } while (0)
    f32x16 pA0, pA1, pB0, pB1;
    int sl_prev = 0, sl_cur = 0, sl_next = SLOTB;
#define ROT() do { sl_prev = sl_cur; sl_cur = sl_next; sl_next = (sl_next == (NSLOTR - 1) * SLOTB) ? 0 : sl_next + SLOTB; } while (0)
    DMA_K(2, 2 * SLOTB);
    WAIT_BAR(3);
    qkt(pA0, pA1, Kbase, qr, negm, r32, hi); asm volatile("s_nop 15\n\ts_nop 7" : "+v"(pA0), "+v"(pA1));
    START(pA0, pA1);
    _Pragma("unroll") for (int r = 0; r < 16; ++r) pA1[r] = __builtin_amdgcn_exp2f(pA1[r]);
    WAIT_BAR(0);
    DMA_K(3, 0); DMA_V(1, SLOTB);
    ROT();
    kload8(kf, kp0 + sl_cur);
    WAIT_BAR(2);
    s16x4 vlo[8], vhi[8]; u32x4 pw0, pw1, pw2, pw3;
#define PKW(P, B) cvtpk_s(P[B], P[B + 1])
#define PAF(k) __builtin_bit_cast(bf16x8, pw##k)
#define VFR(i) (bf16x8){vlo[i][0], vlo[i][1], vlo[i][2], vlo[i][3], vhi[i][0], vhi[i][1], vhi[i][2], vhi[i][3]}
#define PIN(x) asm volatile("" : "+v"(x))
#define MX3(a, b, c) __builtin_fmaxf(__builtin_fmaxf((a), (b)), (c))
#define GAPA(MF, A0, A1, A2, A3, W0, W1, PW) do { MF; sacc += A0; sacc += A1; sacc += A2; sacc += A3; PIN(sacc); W0; W1; PIN(PW); SBAR(); } while (0)
#define EX(v) __builtin_amdgcn_exp2f(v)
#define GAPB(MF, X, B) do { MF; X[B] = EX(X[B]); X[B + 1] = EX(X[B + 1]); X[B + 2] = EX(X[B + 2]); X[B + 3] = EX(X[B + 3]); PIN(X); SBAR(); } while (0)
#define VRD(i) do { vlo[i] = vtr(vp_ + (((i) >> 2) * 4096 + ((i) & 3) * 1024)); vhi[i] = vtr(vp_ + (((i) >> 2) * 4096 + ((i) & 3) * 1024 + 512)); } while (0)
#define KRD(G, j) do { if (G) { kload2(kf, kp0 + sl_next, j); SBAR(); } } while (0)
#define STEP(C0, C1, P0, P1, t, GK, GV, GL) do { SBAR(); \
    const lds_cptr vp_ = vp0 + sl_prev; \
    VRD(0); SBAR(); float sacc = (P0[0] + P0[1]); \
    GAPA(C0 = __builtin_amdgcn_mfma_f32_32x32x16_bf16(kf[0], qr[0], negm, 0, 0, 0), P0[2], P0[3], P0[4], P0[5],     pw0[0] = PKW(P0, 0), pw0[1] = PKW(P0, 2), pw0); \
    VRD(4); SBAR(); GAPA(C1 = __builtin_amdgcn_mfma_f32_32x32x16_bf16(kf[1], qr[0], negm, 0, 0, 0), P0[6], P0[7], P0[8], P0[9],     pw0[2] = PKW(P0, 4), pw0[3] = PKW(P0, 6), pw0); \
    VRD(1); SBAR(); GAPA(C0 = __builtin_amdgcn_mfma_f32_32x32x16_bf16(kf[2], qr[1], C0, 0, 0, 0),   P0[10], P0[11], P0[12], P0[13], pw1[0] = PKW(P0, 8), pw1[1] = PKW(P0, 10), pw1); \
    VRD(5); SBAR(); GAPA(C1 = __builtin_amdgcn_mfma_f32_32x32x16_bf16(kf[3], qr[1], C1, 0, 0, 0),   P0[14], P0[15], P1[0], P1[1],   pw1[2] = PKW(P0, 12), pw1[3] = PKW(P0, 14), pw1); \
    VRD(2); SBAR(); GAPA(C0 = __builtin_amdgcn_mfma_f32_32x32x16_bf16(kf[4], qr[2], C0, 0, 0, 0),   P1[2], P1[3], P1[4], P1[5],     pw2[0] = PKW(P1, 0), pw2[1] = PKW(P1, 2), pw2); \
    VRD(6); SBAR(); GAPA(C1 = __builtin_amdgcn_mfma_f32_32x32x16_bf16(kf[5], qr[2], C1, 0, 0, 0),   P1[6], P1[7], P1[8], P1[9],     pw2[2] = PKW(P1, 4), pw2[3] = PKW(P1, 6), pw2); \
    VRD(3); SBAR(); GAPA(C0 = __builtin_amdgcn_mfma_f32_32x32x16_bf16(kf[6], qr[3], C0, 0, 0, 0),   P1[10], P1[11], P1[12], P1[13], pw3[0] = PKW(P1, 8), pw3[1] = PKW(P1, 10), pw3); \
    VRD(7); SBAR(); GAPA(C1 = __builtin_amdgcn_mfma_f32_32x32x16_bf16(kf[7], qr[3], C1, 0, 0, 0),   P1[14], P1[15], 0.f, 0.f,       pw3[2] = PKW(P1, 12), pw3[3] = PKW(P1, 14), pw3); \
    l_reg += sacc; \
    if (GK) { DMA_K((t) + 3, sl_cur); } if (GV) { DMA_V((t) + 1, sl_next); } \
    SBAR(); \
    GAPB(o[0] = __builtin_amdgcn_mfma_f32_32x32x16_bf16(PAF(0), VFR(0), o[0], 0, 0, 0), C0, 0); \
    GAPB(o[1] = __builtin_amdgcn_mfma_f32_32x32x16_bf16(PAF(0), VFR(4), o[1], 0, 0, 0), C0, 4); \
    KRD(GL, 0); GAPB(o[0] = __builtin_amdgcn_mfma_f32_32x32x16_bf16(PAF(1), VFR(1), o[0], 0, 0, 0), C0, 8); \
    KRD(GL, 1); GAPB(o[1] = __builtin_amdgcn_mfma_f32_32x32x16_bf16(PAF(1), VFR(5), o[1], 0, 0, 0), C0, 12); \
    KRD(GL, 2); GAPB(o[0] = __builtin_amdgcn_mfma_f32_32x32x16_bf16(PAF(2), VFR(2), o[0], 0, 0, 0), C1, 0); \
    KRD(GL, 3); GAPB(o[1] = __builtin_amdgcn_mfma_f32_32x32x16_bf16(PAF(2), VFR(6), o[1], 0, 0, 0), C1, 4); \
    GAPB(o[0] = __builtin_amdgcn_mfma_f32_32x32x16_bf16(PAF(3), VFR(3), o[0], 0, 0, 0), C1, 8); \
    GAPB(o[1] = __builtin_amdgcn_mfma_f32_32x32x16_bf16(PAF(3), VFR(7), o[1], 0, 0, 0), C1, 12); \
    } while (0)
    int t = 1;
    for (; t + 5 < NT; t += 2) {
        STEP(pB0, pB1, pA0, pA1, t, true, true, true);     WAIT_BAR(2); RESC(); ROT();
        STEP(pA0, pA1, pB0, pB1, t + 1, true, true, true); WAIT_BAR(2); RESC(); ROT();
    }
#define ENDW(tt) do { if ((tt) + 3 < NT) { WAIT_BAR(2); } else if ((tt) + 2 < NT) { WAIT_BAR(1); } else { WAIT_BAR(0); } } while (0)
    for (; t + 1 < NT; t += 2) {
        STEP(pB0, pB1, pA0, pA1, t, (t + 3 < NT), (t + 1 < NT), (t + 1 < NT));         ENDW(t);     RESC(); ROT();
        STEP(pA0, pA1, pB0, pB1, t + 1, (t + 4 < NT), (t + 2 < NT), (t + 2 < NT));     ENDW(t + 1); RESC(); ROT();
    }
    STEP(pB0, pB1, pA0, pA1, NT - 1, false, false, false); RESC();
    { float sacc = pB0[0] + pB0[1]; _Pragma("unroll") for (int r = 2; r < 16; ++r) sacc += pB0[r]; _Pragma("unroll") for (int r = 0; r < 16; ++r) sacc += pB1[r]; l_reg += sacc;
      pw0 = (u32x4){PKW(pB0, 0), PKW(pB0, 2), PKW(pB0, 4), PKW(pB0, 6)}; pw1 = (u32x4){PKW(pB0, 8), PKW(pB0, 10), PKW(pB0, 12), PKW(pB0, 14)}; pw2 = (u32x4){PKW(pB1, 0), PKW(pB1, 2), PKW(pB1, 4), PKW(pB1, 6)}; pw3 = (u32x4){PKW(pB1, 8), PKW(pB1, 10), PKW(pB1, 12), PKW(pB1, 14)};
      SBAR(); pv(o, vb0 + sl_cur, PAF(0), PAF(1), PAF(2), PAF(3)); }
#undef PKW
#undef PAF
#undef VFR
#undef PIN
#undef MX3
#undef GAPA
#undef GAPB
#undef EX
#undef VRD
#undef KRD
#undef STEP
#undef ENDW
    { auto rr = __builtin_amdgcn_permlane32_swap(__float_as_uint(l_reg), __float_as_uint(l_reg), false, false); l_reg = __uint_as_float(rr[0]) + __uint_as_float(rr[1]); }
    if (hi == 0) wsf[32 + r32] = l_reg; asm volatile("s_waitcnt lgkmcnt(0)" ::: "memory");
    float rli[16];
#pragma unroll
    for (int r = 0; r < 16; ++r) rli[r] = __builtin_amdgcn_rcpf(wsf[32 + crow(r, hi)]);
    bf16* Ow = O + qrow0 * DMO + h * D;
    { bf16* stg = (bf16*)(shm + LDS_OST) + wid * 2048;
#pragma unroll
      for (int r = 0; r < 16; ++r) { const int orow = crow(r, hi);
#pragma unroll
        for (int d0 = 0; d0 < 2; ++d0) stg[orow * 64 + d0 * 32 + r32] = __float2bfloat16(o[d0][r] * rli[r]); }
      asm volatile("s_waitcnt lgkmcnt(0)" ::: "memory");
#pragma unroll
      for (int i = 0; i < 4; ++i) { const int row = i * 8 + (lane >> 3), ch = lane & 7; const u32x4 v = *(const u32x4*)(stg + row * 64 + ch * 8); *(u32x4*)(Ow + (long)row * DMO + ch * 8) = v; } }
    asm volatile("s_waitcnt lgkmcnt(0)\n\ts_barrier" ::: "memory");
#undef DMA_K
#undef DMA_V
#undef START
#undef RESC
#undef ROT
}
#undef SBAR
#undef WAIT_BAR
}

#define XB_TMO      128
#define XB_XCNT(j)  (256  + 64 * (j))
#define XB_XSUB(j)  (1280 + 64 * (j))
#define XB_XGEN(j)  (2304 + 64 * (j))
#define XB_TOP      3328
#define XB_TOPGEN   3392
#define XCD_BAR_WORDS 3456
#define XB_SPIN_CAP (1u << 18)
__device__ __forceinline__ unsigned xb_ld(unsigned* p)              { return __hip_atomic_load(p, __ATOMIC_RELAXED, __HIP_MEMORY_SCOPE_AGENT); }
__device__ __forceinline__ unsigned xb_add(unsigned* p, unsigned v) { return __hip_atomic_fetch_add(p, v, __ATOMIC_RELAXED, __HIP_MEMORY_SCOPE_AGENT); }
__device__ __forceinline__ unsigned xb_xcc_id() { return (unsigned)__builtin_amdgcn_s_getreg((3 << 11) | 20) & 0xFu; }
#define XB_SPIN(cond, bar) do { unsigned _sp = 0; while (cond) { __builtin_amdgcn_s_sleep(1); \
    if ((++_sp & 255u) == 0u) { if (xb_ld(&(bar)[XB_TMO])) break; if (_sp > XB_SPIN_CAP) { atomicAdd(&(bar)[XB_TMO], 1u); break; } } } } while (0)
struct XcdBarrier { unsigned* bar; unsigned x; volatile LAS unsigned* st; };
__device__ __forceinline__ XcdBarrier xcd_barrier_post(unsigned* bar, volatile LAS unsigned* st) {
    XcdBarrier b; b.bar = bar; b.x = xb_xcc_id(); b.st = st;
    if (threadIdx.x == 0) (void)xb_add(&bar[XB_XCNT(b.x)], 1u);
    return b;
}
__device__ __forceinline__ void xcd_barrier_complete(unsigned* bar, unsigned x, unsigned& nloc, unsigned& nx) {
    const unsigned G = gridDim.x * gridDim.y * gridDim.z;
    unsigned sum, cnt, mine, sp = 0u;
    for (;;) {
        sum = 0u; cnt = 0u; mine = 0u;
#pragma unroll
        for (unsigned j = 0; j < 16; ++j) { const unsigned c = xb_ld(&bar[XB_XCNT(j)]); sum += c; cnt += (c > 0u) ? 1u : 0u; mine = (j == x) ? c : mine; }
        if (sum == G) break;
        __builtin_amdgcn_s_sleep(1);
        if ((++sp & 255u) == 0u) { if (xb_ld(&bar[XB_TMO])) break; if (sp > XB_SPIN_CAP) { atomicAdd(&bar[XB_TMO], 1u); break; } }
    }
    nloc = mine > 0u ? mine : 1u; nx = cnt > 0u ? cnt : 1u;
}
__device__ __forceinline__ void xcd_barrier(const XcdBarrier& b) {
    asm volatile("s_waitcnt vmcnt(0)" ::: "memory");
    __syncthreads();
    if (threadIdx.x == 0) {
        unsigned* bar = b.bar;
        __builtin_amdgcn_s_waitcnt(0);
        unsigned nloc = b.st[0], nx = b.st[1];
        if (nloc == 0u) { xcd_barrier_complete(bar, b.x, nloc, nx); b.st[0] = nloc; b.st[1] = nx; }
        const unsigned old = xb_add(&bar[XB_XSUB(b.x)], 1u);
        const unsigned gen = old / nloc;
        if (old + 1u == (gen + 1u) * nloc) {
            __builtin_amdgcn_fence(__ATOMIC_RELEASE, "agent");
            asm volatile("s_waitcnt vmcnt(0)" ::: "memory");
            const unsigned og = xb_add(&bar[XB_TOP], 1u);
            const unsigned tg = og / nx;
            if (og + 1u == (tg + 1u) * nx) xb_add(&bar[XB_TOPGEN], 1u);
            else XB_SPIN(xb_ld(&bar[XB_TOPGEN]) == tg, bar);
            __builtin_amdgcn_fence(__ATOMIC_ACQUIRE, "agent");
            xb_add(&bar[XB_XGEN(b.x)], 1u);
            asm volatile("s_waitcnt vmcnt(0)" ::: "memory");
        } else {
            XB_SPIN(xb_ld(&bar[XB_XGEN(b.x)]) == gen, bar);
            __builtin_amdgcn_fence(__ATOMIC_ACQUIRE, "agent");
            asm volatile("s_waitcnt vmcnt(0)" ::: "memory");
        }
    }
    __syncthreads();
}

struct Frame {
    LAS unsigned char* lds;
    volatile LAS unsigned* MISC;
    gu32* ctl;
    int tid, lane, wave;
    int vcu, G;
    const float *x, *c, *ctx, *c_ctx, *norm1_g, *w_ada, *b_ada, *w_in, *w_fourier, *q_norm_g, *k_norm_g, *w_out, *norm2_g, *w_router, *router_bias, *w_egu, *w_ed, *w_sgu, *w_sd, *final_g;
    float* out;
    unsigned char* ws;
};
#define WSP(T, off) ((T*)(F.ws + (off)))

struct DenseOrder {
    static constexpr bool GATHER = false;
    int nN, nmain, nextra, G, c; const char* Bt; int K; int reps;
    __device__ __forceinline__ bool next(int i, pg8::GUnit& u) const {
        const int ntot = nmain + nextra, nc = (ntot - c + G - 1) / G; if (i >= nc * reps) return false;
        const int L = (i % nc) * G + c;
        if (L < nmain) { const int nig = 8 * nN, gid = L / nig, r = L % nig; u.pm = gid * 8 + (r & 7); u.pn = r >> 3; }
        else { const int jx = L - nmain; u.pm = 128 + (jx & 3); u.pn = 5 + (jx >> 2); }
        u.e = 0; u.j = 0; u.nvalid = 256; u.B = Bt + (size_t)u.pn * 256 * K * 2; return true;
    }
    __device__ __forceinline__ int arow(const pg8::GUnit& u, int r) const { return u.pm * 256 + r; }
};
template <bool GATHER_> struct GroupedOrder {
    static constexpr bool GATHER = GATHER_;
    int NPN, G, c, nbrows, K; bool gather; const char* Bt; const LAS int* TS; const LAS int* CN; const GAS u32x2* LIST; int reps;
    __device__ __forceinline__ bool next(int i, pg8::GUnit& u) const {
        const int total = TS[257]; const int ntot = total * NPN, nc = (ntot - c + G - 1) / G; if (i >= nc * reps) return false;
        const int L = (i % nc) * G + c; const int T = L / NPN;
        int lo = 0, hi = 257;
        while (hi - lo > 1) { const int mid = (lo + hi) >> 1; if (TS[mid] <= T) lo = mid; else hi = mid; }
        lo = __builtin_amdgcn_readfirstlane(lo);
        const int ts = __builtin_amdgcn_readfirstlane(TS[lo]), cn = __builtin_amdgcn_readfirstlane(CN[lo]);
        u.pm = T; u.pn = L - T * NPN; u.e = lo; u.j = T - ts; const int rem = cn - 256 * u.j; u.nvalid = rem < 256 ? rem : 256;
        u.B = Bt + ((size_t)lo * nbrows + (size_t)u.pn * 256) * K * 2; return true;
    }
    __device__ __forceinline__ int arow(const pg8::GUnit& u, int r) const {
        if (!gather) return u.pm * 256 + r;
        int pos = 256 * u.j + r; if (r >= u.nvalid) pos = 0;
        const u32x2 en = LIST[(size_t)u.e * NTOK + pos];
        return (int)(en.x & 0xffffu);
    }
};

struct EpiInProj {
    static constexpr bool PERM = true;
    u16 *Z, *Q, *Kb, *Vb; const float *COS, *SIN, *gq, *gk;
    __device__ __forceinline__ void operator()(const f32x4 (&acc)[2][2][4][2], const pg8::GUnit& u, int wr, int wc, int fr, int fq) const {
        const int pn = u.pn; const bool is_ctx = u.pm >= 128;
        float gn[2][2][4];
        if (pn >= 2 && pn < 6) { const float* gsrc = (pn == 5) ? gk : gq;
#pragma unroll
            for (int bj = 0; bj < 2; ++bj)
#pragma unroll
                for (int n = 0; n < 2; ++n) { const f32x4 g4 = *(const f32x4*)(gsrc + 32 * bj + 16 * n + 4 * fq); gn[bj][n][0] = g4[0]; gn[bj][n][1] = g4[1]; gn[bj][n][2] = g4[2]; gn[bj][n][3] = g4[3]; } }
#pragma unroll
        for (int ai = 0; ai < 2; ++ai)
#pragma unroll
            for (int m = 0; m < 4; ++m) {
                const int row = u.pm * 256 + ai * 128 + wr * 64 + m * 16 + fr;
                int b, l, key;
                if (!is_ctx) { b = row >> 13; l = row & 8191; key = l; } else { const int rc = row - NTOK; b = rc >> 8; l = 0; key = SEQ + (rc & 255); }
                if (pn < 2) {
#pragma unroll
                    for (int bj = 0; bj < 2; ++bj) { const int g = 32 * pn + 16 * bj + 4 * wc + fq; const f32x4 v0 = acc[ai][bj][m][0], v1 = acc[ai][bj][m][1];
                        u32x4 w; w.x = cvt_pk_bf16(v0[0], v0[1]); w.y = cvt_pk_bf16(v0[2], v0[3]); w.z = cvt_pk_bf16(v1[0], v1[1]); w.w = cvt_pk_bf16(v1[2], v1[3]);
                        *(u32x4*)(Z + (((size_t)(b * 64 + g) * SEQ + l) * 8)) = w; }
                } else if (pn < 6) {
                    float ss = 0.f;
#pragma unroll
                    for (int bj = 0; bj < 2; ++bj)
#pragma unroll
                        for (int n = 0; n < 2; ++n) { const f32x4 v = acc[ai][bj][m][n]; ss += (v[0] * v[0] + v[1] * v[1]) + (v[2] * v[2] + v[3] * v[3]); }
                    ss += __shfl_xor(ss, 16); ss += __shfl_xor(ss, 32);
                    const float rstd = 1.0f / sqrtf(ss * (1.0f / 64.0f) + RMS_EPS);
                    const float osc = (pn == 5) ? 1.0f : C2;
#pragma unroll
                    for (int bj = 0; bj < 2; ++bj) {
                        const int pidx = (bj == 0) ? (l >> 6) : (l & 63);
                        f32x4 cs = *(const f32x4*)(COS + pidx * 16 + 4 * fq), sn = *(const f32x4*)(SIN + pidx * 16 + 4 * fq);
                        if (is_ctx) { cs = (f32x4){1.f, 1.f, 1.f, 1.f}; sn = (f32x4){0.f, 0.f, 0.f, 0.f}; }
                        float oa[4], ob[4];
#pragma unroll
                        for (int e = 0; e < 4; ++e) { const float a = acc[ai][bj][m][0][e] * rstd * gn[bj][0][e], bb = acc[ai][bj][m][1][e] * rstd * gn[bj][1][e];
                            oa[e] = (a * cs[e] - bb * sn[e]) * osc; ob[e] = (bb * cs[e] + a * sn[e]) * osc; }
                        u32x4 w; w.x = cvt_pk_bf16(oa[0], oa[1]); w.y = cvt_pk_bf16(oa[2], oa[3]); w.z = cvt_pk_bf16(ob[0], ob[1]); w.w = cvt_pk_bf16(ob[2], ob[3]);
                        if (pn < 5) { const int head = 4 * (pn - 2) + wc; *(u32x4*)(Q + ((size_t)row * QW + head * 64 + 32 * bj + 8 * fq)) = w; }
                        else *(u32x4*)(Kb + (((size_t)b * LKV + key) * KVW + wc * 64 + 32 * bj + 8 * fq)) = w;
                    }
                } else {
#pragma unroll
                    for (int bj = 0; bj < 2; ++bj) { const f32x4 v0 = acc[ai][bj][m][0], v1 = acc[ai][bj][m][1];
                        u32x4 w; w.x = cvt_pk_bf16(v0[0], v0[1]); w.y = cvt_pk_bf16(v0[2], v0[3]); w.z = cvt_pk_bf16(v1[0], v1[1]); w.w = cvt_pk_bf16(v1[2], v1[3]);
                        *(u32x4*)(Vb + (((size_t)b * LKV + key) * KVW + 128 * bj + 32 * wc + 8 * fq)) = w; }
                }
            }
    }
};
struct EpiResid {
    static constexpr bool PERM = false;
    const float* x; float* X1; const gi64* MOD;
    __device__ __forceinline__ void operator()(const f32x4 (&acc)[2][2][4][2], const pg8::GUnit& u, int wr, int wc, int fr, int fq) const {
        const int row0 = u.pm * 256 + wr * 64 + fr, col0 = u.pn * 256 + wc * 32 + 4 * fq; const int b = (u.pm * 256) >> 13;
        f32x4 gv[2][2];
#pragma unroll
        for (int bj = 0; bj < 2; ++bj)
#pragma unroll
            for (int n = 0; n < 2; ++n) gv[bj][n] = mod4(MOD, b * 6144 + 2048 + col0 + bj * 128 + n * 16);
#pragma unroll
        for (int ai = 0; ai < 2; ++ai)
#pragma unroll
            for (int m = 0; m < 4; ++m) { const size_t off = (size_t)(row0 + ai * 128 + m * 16) * DM + col0;
#pragma unroll
                for (int bj = 0; bj < 2; ++bj)
#pragma unroll
                    for (int n = 0; n < 2; ++n) { const f32x4 xv = *(const f32x4*)(x + off + bj * 128 + n * 16); *(f32x4*)(X1 + off + bj * 128 + n * 16) = (DBG & 2) ? xv : xv + gv[bj][n] * acc[ai][bj][m][n]; } }
    }
};
struct EpiLogits {
    static constexpr bool PERM = false;
    float* C;
    __device__ __forceinline__ void operator()(const f32x4 (&acc)[2][2][4][2], const pg8::GUnit& u, int wr, int wc, int fr, int fq) const {
        const int row0 = u.pm * 256 + wr * 64 + fr, col0 = wc * 32 + 4 * fq;
#pragma unroll
        for (int ai = 0; ai < 2; ++ai)
#pragma unroll
            for (int m = 0; m < 4; ++m) { float* rowp = C + (size_t)(row0 + ai * 128 + m * 16) * NEXP + col0;
#pragma unroll
                for (int bj = 0; bj < 2; ++bj)
#pragma unroll
                    for (int n = 0; n < 2; ++n) *(f32x4*)(rowp + bj * 128 + n * 16) = acc[ai][bj][m][n]; }
    }
};
struct EpiSwiglu {
    static constexpr bool PERM = true;
    u16* ACT;
    __device__ __forceinline__ void operator()(const f32x4 (&acc)[2][2][4][2], const pg8::GUnit& u, int wr, int wc, int fr, int fq) const {
#pragma unroll
        for (int ai = 0; ai < 2; ++ai)
#pragma unroll
            for (int m = 0; m < 4; ++m) { const int r = ai * 128 + wr * 64 + m * 16 + fr; u16* rowp = ACT + ((size_t)u.pm * 256 + r) * EFF + 128 * u.pn + 16 * wc + 4 * fq;
#pragma unroll
                for (int bj = 0; bj < 2; ++bj) { const f32x4 a = acc[ai][bj][m][0], g = acc[ai][bj][m][1]; float o[4];
#pragma unroll
                    for (int e = 0; e < 4; ++e) o[e] = a[e] * g[e] / (1.0f + __expf(-a[e]));
                    u32x2 w; if (MOEF16) { w.x = pk2h(o[0], o[1]); w.y = pk2h(o[2], o[3]); } else { w.x = pk2bf(o[0], o[1]); w.y = pk2bf(o[2], o[3]); } *(u32x2*)(rowp + 64 * bj) = w; } }
    }
};
struct EpiDown {
    static constexpr bool PERM = true;
    u16* Cc; const GAS u32x2* LIST;
    __device__ __forceinline__ void operator()(const f32x4 (&acc)[2][2][4][2], const pg8::GUnit& u, int wr, int wc, int fr, int fq) const {
        f32x2 ens[2][4];
#pragma unroll
        for (int ai = 0; ai < 2; ++ai)
#pragma unroll
            for (int m = 0; m < 4; ++m) { const int r = ai * 128 + wr * 64 + m * 16 + fr; ens[ai][m] = *(const GAS f32x2*)(LIST + (size_t)u.e * NTOK + (r < u.nvalid ? 256 * u.j + r : 0)); }
#pragma unroll
        for (int ai = 0; ai < 2; ++ai)
#pragma unroll
            for (int m = 0; m < 4; ++m) { const int r = ai * 128 + wr * 64 + m * 16 + fr;
                if (r < u.nvalid) { const f32x2 enf = ens[ai][m];
                    const unsigned ex = __builtin_bit_cast(unsigned, enf.x); const int tok = (int)(ex & 0xffffu), slot = (int)(ex >> 16); const float gate = enf.y;
                    unsigned char* rowp = (unsigned char*)Cc + ((size_t)tok * NSLOT + slot) * DM + 256 * u.pn + 32 * wc + 8 * fq;
                    const float gs = gate * C_SCALE;
#pragma unroll
                    for (int bj = 0; bj < 2; ++bj) { f32x4 v0 = acc[ai][bj][m][0] * gs, v1 = acc[ai][bj][m][1] * gs;
#pragma unroll
                        for (int e = 0; e < 4; ++e) { v0[e] = __builtin_amdgcn_fmed3f(v0[e], -440.f, 440.f); v1[e] = __builtin_amdgcn_fmed3f(v1[e], -440.f, 440.f); }
                        int w0 = __builtin_amdgcn_cvt_pk_fp8_f32(v0[0], v0[1], 0, false); w0 = __builtin_amdgcn_cvt_pk_fp8_f32(v0[2], v0[3], w0, true);
                        int w1 = __builtin_amdgcn_cvt_pk_fp8_f32(v1[0], v1[1], 0, false); w1 = __builtin_amdgcn_cvt_pk_fp8_f32(v1[2], v1[3], w1, true);
                        *(u32x2*)(rowp + 128 * bj) = (u32x2){(unsigned)w0, (unsigned)w1}; } } }
    }
};

template <bool F16OUT> __device__ __forceinline__ void rownorm_rows(const GAS float* src, const float* gain, const gi64* MODsh, const gi64* MODsc, u16* dst, int row0, int nrows, int wi, int wstride, int lane) {
    f32x4 Av[2][2], Bv[2][2];
#pragma unroll
    for (int j = 0; j < 2; ++j)
#pragma unroll
        for (int h = 0; h < 2; ++h) { const int col = 8 * lane + 512 * j + 4 * h; Av[j][h] = *(const f32x4*)(gain + col) * (mod4(MODsc, col) + 1.0f); Bv[j][h] = mod4(MODsh, col); }
    for (int r = wi; r < nrows; r += 2 * wstride) {
        const int r1 = r + wstride; const bool has1 = r1 < nrows;
        const GAS float* s0 = src + (size_t)(row0 + r) * DM; const GAS float* s1 = src + (size_t)(row0 + (has1 ? r1 : r)) * DM;
        f32x4 v0[2][2], v1[2][2];
#pragma unroll
        for (int j = 0; j < 2; ++j)
#pragma unroll
            for (int h = 0; h < 2; ++h) { v0[j][h] = *(const GAS f32x4*)(s0 + 8 * lane + 512 * j + 4 * h); v1[j][h] = *(const GAS f32x4*)(s1 + 8 * lane + 512 * j + 4 * h); }
        float q0 = 0.f, q1 = 0.f;
#pragma unroll
        for (int j = 0; j < 2; ++j)
#pragma unroll
            for (int h = 0; h < 2; ++h) { const f32x4 a = v0[j][h], b = v1[j][h]; q0 += (a[0] * a[0] + a[1] * a[1]) + (a[2] * a[2] + a[3] * a[3]); q1 += (b[0] * b[0] + b[1] * b[1]) + (b[2] * b[2] + b[3] * b[3]); }
#pragma unroll
        for (int o = 1; o < 64; o <<= 1) { q0 += __shfl_xor(q0, o); q1 += __shfl_xor(q1, o); }
        const float rs0 = 1.0f / sqrtf(q0 * (1.0f / DM) + RMS_EPS), rs1 = 1.0f / sqrtf(q1 * (1.0f / DM) + RMS_EPS);
#pragma unroll
        for (int j = 0; j < 2; ++j) { const f32x4 ya = v0[j][0] * rs0 * Av[j][0] + Bv[j][0], yb = v0[j][1] * rs0 * Av[j][1] + Bv[j][1];
            u32x4 w; if (F16OUT) { w.x = pk2h(ya[0], ya[1]); w.y = pk2h(ya[2], ya[3]); w.z = pk2h(yb[0], yb[1]); w.w = pk2h(yb[2], yb[3]); } else { w.x = pk2bf(ya[0], ya[1]); w.y = pk2bf(ya[2], ya[3]); w.z = pk2bf(yb[0], yb[1]); w.w = pk2bf(yb[2], yb[3]); }
            *(GAS u32x4*)(dst + (size_t)(row0 + r) * DM + 8 * lane + 512 * j) = w; }
        if (has1) {
#pragma unroll
            for (int j = 0; j < 2; ++j) { const f32x4 ya = v1[j][0] * rs1 * Av[j][0] + Bv[j][0], yb = v1[j][1] * rs1 * Av[j][1] + Bv[j][1];
                u32x4 w; if (F16OUT) { w.x = pk2h(ya[0], ya[1]); w.y = pk2h(ya[2], ya[3]); w.z = pk2h(yb[0], yb[1]); w.w = pk2h(yb[2], yb[3]); } else { w.x = pk2bf(ya[0], ya[1]); w.y = pk2bf(ya[2], ya[3]); w.z = pk2bf(yb[0], yb[1]); w.w = pk2bf(yb[2], yb[3]); }
                *(GAS u32x4*)(dst + (size_t)(row0 + r1) * DM + 8 * lane + 512 * j) = w; } }
    }
}

__device__ __forceinline__ void p0_phase(Frame& F) {
    const int gw = F.vcu * 8 + F.wave, NGW = F.G * 8, lane = F.lane;
    unsigned long long* MODQ = (unsigned long long*)(F.ctl + CW_MOD);
    for (int it = gw; it < 1536; it += NGW) {
        const int cb = it % 24, kc = it / 24, k0 = kc * 16, col = cb * 256 + lane * 4;
        float sv[5];
#pragma unroll
        for (int r = 0; r < 5; ++r) { const float cv = (r < 4) ? F.c[r * DM + k0 + (lane & 15)] : F.c_ctx[k0 + (lane & 15)]; sv[r] = cv / (1.0f + __expf(-cv)); }
        f32x4 acc[5];
#pragma unroll
        for (int r = 0; r < 5; ++r) acc[r] = (f32x4){0.f, 0.f, 0.f, 0.f};
#pragma unroll
        for (int kk = 0; kk < 16; ++kk) { const f32x4 w = *(const f32x4*)(F.w_ada + (size_t)(k0 + kk) * 6144 + col);
#pragma unroll
            for (int r = 0; r < 5; ++r) { const float s = __builtin_bit_cast(float, __builtin_amdgcn_readlane(__builtin_bit_cast(int, sv[r]), kk)); acc[r] += w * s; } }
        if (kc == 0) { const f32x4 bv = *(const f32x4*)(F.b_ada + col);
#pragma unroll
            for (int r = 0; r < 5; ++r) acc[r] += bv; }
#pragma unroll
        for (int r = 0; r < 5; ++r)
#pragma unroll
            for (int j = 0; j < 4; ++j) atomicAdd(MODQ + r * 6144 + col + j, (unsigned long long)__float2ll_rn(acc[r][j] * 0x1p36f));
    }
    float* WCS = WSP(float, WS_TAB);
    for (int it = gw; it < 256; it += NGW) {
        const int fh = it >> 6, d = it & 63; float ac = 0.f, as = 0.f;
        for (int k2 = 0; k2 < 64; ++k2) { const int mm = (d * k2) & 63; const float w = F.w_fourier[(fh * 64 + k2) * 64 + lane]; ac += cospif((float)mm * (1.0f / 32.0f)) * w; as += sinpif((float)mm * (1.0f / 32.0f)) * w; }
        const float sc = 1.0f / sqrtf((float)SEQ * 64.0f);
        WCS[(fh * 64 + d) * 128 + lane] = ac * sc; WCS[(fh * 64 + d) * 128 + 64 + lane] = as * sc;
    }
    {
        u16* D1 = WSP(u16, WS_TAB + 144 * 1024); u16* D3 = WSP(u16, WS_TAB + 272 * 1024);
        for (int it = gw; it < 320; it += NGW) {
            if (it < 256) { const int ro = it >> 7, k1 = it & 127;
#pragma unroll
                for (int j = 0; j < 4; ++j) { const int col = lane + 64 * j, ri = col >> 7, n1 = col & 127, mm = (n1 * k1) & 127; const float cc = cospif((float)mm * (1.0f / 64.0f)), ss = sinpif((float)mm * (1.0f / 64.0f));
                    const float v = (ro == 0) ? (ri == 0 ? cc : -ss) : (ri == 0 ? -ss : -cc); D1[it * 256 + col] = (u16)f2bf(v); } }
            else { const int k2 = it - 256;
#pragma unroll
                for (int j = 0; j < 2; ++j) { const int col = lane + 64 * j, ri = col >> 6, n2 = col & 63, mm = (n2 * k2) & 63; const float v = (ri == 0) ? cospif((float)mm * (1.0f / 32.0f)) : sinpif((float)mm * (1.0f / 32.0f)); D3[k2 * 128 + col] = (u16)f2bf(v); } }
        }
    }
    float* COS = WSP(float, WS_TAB + 128 * 1024); float* SIN = WSP(float, WS_TAB + 136 * 1024);
    for (int it = gw; it < 32; it += NGW) { const int idx = it * 64 + lane, pos = idx >> 4, i = idx & 15;
        const float inv = powf(10000.0f, -(float)i / 16.0f), ang = (float)pos * inv; COS[idx] = cosf(ang); SIN[idx] = sinf(ang); }
}

__device__ __forceinline__ int map_row(int mode, int sc) {
    if (mode == 1) { const int head = sc >> 6, dim = sc & 63, bj = dim >> 5, n = (dim >> 4) & 1, i = dim & 15; return (head >> 2) * 256 + bj * 128 + (head & 3) * 32 + (i >> 2) * 8 + n * 4 + (i & 3); }
    if (mode == 2) { const int g = sc >> 8, a = sc & 255; return (a >> 2) * 8 + g * 4 + (a & 3); }
    return sc;
}
__device__ __forceinline__ void transpose_item(const float* W, int K, int N, int src_c0, int rel_c0, int mode, bool f16, u16* WT, int dst_off, LAS float* scr, int k0, int lane) {
#pragma unroll 8
    for (int i = 0; i < 32; ++i) { const int kk = 2 * i + (lane >> 5); scr[kk * 33 + (lane & 31)] = W[(size_t)(k0 + kk) * N + src_c0 + (lane & 31)]; }
    LDS_WAIT(); asm volatile("" ::: "memory");
    const int c = lane & 7;
#pragma unroll
    for (int j = 0; j < 4; ++j) { const int n = (lane >> 3) + 8 * j; const LAS float* s = scr + (8 * c) * 33 + n;
        u32x4 o;
        if (f16) { o.x = pk2h(s[0 * 33], s[1 * 33]); o.y = pk2h(s[2 * 33], s[3 * 33]); o.z = pk2h(s[4 * 33], s[5 * 33]); o.w = pk2h(s[6 * 33], s[7 * 33]); }
        else { o.x = pk2bf(s[0 * 33], s[1 * 33]); o.y = pk2bf(s[2 * 33], s[3 * 33]); o.z = pk2bf(s[4 * 33], s[5 * 33]); o.w = pk2bf(s[6 * 33], s[7 * 33]); }
        const int drow = dst_off + map_row(mode, rel_c0 + n);
        *(GAS u32x4*)(WT + (size_t)drow * K + k0 + 8 * c) = o; }
    LDS_WAIT(); asm volatile("" ::: "memory");
}
__device__ __forceinline__ void p1_phase(Frame& F) {
    LAS float* scr = (LAS float*)(F.lds + RING_OFF + F.wave * 16384);
    const int gw = F.vcu * 8 + F.wave, NGW = F.G * 8, lane = F.lane;
    constexpr int I_FOLD = 128, I_QKV = 16 * 40, I_OUT = 16 * 32, I_R = 16 * 8, I_GU = NEXPS * 16 * 16, I_D = NEXPS * 4 * 32;
    constexpr int NITEMS = I_FOLD + I_QKV + I_OUT + I_R + I_GU + I_D;
    u16* BIN = WSP(u16, WS_BIN);
    REPS(11) for (int it = gw; it < NITEMS; it += NGW) {
        int r = it;
        if (r < I_FOLD) {
            const int fh = r >> 5, cs = (r >> 4) & 1, kb = r & 15; const int k = kb * 64 + lane;
            const GAS float* WCS = (const GAS float*)(F.ws + WS_TAB);
#pragma unroll 4
            for (int i = 0; i < 64; ++i) scr[i * 64 + lane] = WCS[(fh * 64 + i) * 128 + cs * 64 + lane];
            float wrow[64];
#pragma unroll
            for (int d4 = 0; d4 < 16; ++d4) { const f32x4 v = *(const f32x4*)(F.w_in + (size_t)k * 1536 + fh * 64 + 4 * d4); wrow[4 * d4] = v[0]; wrow[4 * d4 + 1] = v[1]; wrow[4 * d4 + 2] = v[2]; wrow[4 * d4 + 3] = v[3]; }
            LDS_WAIT(); asm volatile("" ::: "memory");
            for (int e = 0; e < 64; ++e) { float a = 0.f;
#pragma unroll
                for (int d = 0; d < 64; ++d) a += wrow[d] * scr[d * 64 + e];
                const int col256 = fh * 64 + e, pos = 8 * (col256 >> 2) + (col256 & 3) + 4 * cs;
                BIN[(size_t)pos * DM + k] = (u16)f2bf(a); }
            LDS_WAIT(); asm volatile("" ::: "memory");
            continue; }
        r -= I_FOLD;
        if (r < I_QKV) { const int kb = r / 40, nb = r % 40, sc0 = 256 + 32 * nb;
            if (sc0 < 1024) transpose_item(F.w_in, DM, 1536, sc0, sc0 - 256, 1, false, BIN, 512, scr, kb * 64, lane);
            else if (sc0 < 1280) transpose_item(F.w_in, DM, 1536, sc0, sc0 - 1024, 1, false, BIN, 1280, scr, kb * 64, lane);
            else transpose_item(F.w_in, DM, 1536, sc0, sc0 - 1280, 0, false, BIN, 1536, scr, kb * 64, lane);
            continue; }
        r -= I_QKV;
        if (r < I_OUT) { const int kb = r / 32, nb = r % 32; transpose_item(F.w_out, DM, DM, 32 * nb, 32 * nb, 0, false, WSP(u16, WS_BOUT), 0, scr, kb * 64, lane); continue; }
        r -= I_OUT;
        if (r < I_R) { const int kb = r / 8, nb = r % 8; transpose_item(F.w_router, DM, NEXP, 32 * nb, 32 * nb, 0, MOEF16, WSP(u16, WS_BR), 0, scr, kb * 64, lane); continue; }
        r -= I_R;
        if (r < I_GU) { const int e = r >> 8, q = r & 255, kb = q >> 4, nb = q & 15;
            const float* W = (e < NEXP) ? F.w_egu + (size_t)e * DM * 512 : F.w_sgu;
            transpose_item(W, DM, 512, 32 * nb, 32 * nb, 2, MOEF16, WSP(u16, WS_BGU) + (size_t)e * 512 * DM, 0, scr, kb * 64, lane); continue; }
        r -= I_GU;
        { const int e = r >> 7, q = r & 127, kb = q >> 5, nb = q & 31;
            const float* W = (e < NEXP) ? F.w_ed + (size_t)e * EFF * DM : F.w_sd;
            transpose_item(W, EFF, DM, 32 * nb, 32 * nb, 0, MOEF16, WSP(u16, WS_BD) + (size_t)e * DM * EFF, 0, scr, kb * 64, lane); }
    }
    const gi64* MOD = (const gi64*)(F.ctl + CW_MOD);
    u16* XN = WSP(u16, WS_XN);
    REPS(12) { const int wpb = NGW >> 2, b = gw / wpb, wi = gw % wpb;
        rownorm_rows<false>((const GAS float*)F.x, F.norm1_g, MOD + b * 6144, MOD + b * 6144 + 1024, XN, b * SEQ, SEQ, wi, wpb, lane);
        rownorm_rows<false>((const GAS float*)F.ctx, F.norm1_g, MOD + 4 * 6144, MOD + 4 * 6144 + 1024, XN + (size_t)NTOK * DM, 0, NCTX, gw, NGW, lane); }
}

__device__ __forceinline__ void fourier_unit(Frame& F, int b, int g) {
    LAS unsigned char* Zl = F.lds + RING_OFF;
    LAS f32x2* TW128 = (LAS f32x2*)(F.lds + TAB_OFF);
    LAS f32x2* TW64 = (LAS f32x2*)(F.lds + TAB_OFF + 1024);
    const int tid = F.tid;
    const GAS u32x4* Zg = (const GAS u32x4*)(F.ws + WS_Z + ((size_t)(b * 64 + g) * SEQ) * 16);
#pragma unroll 4
    for (int i = 0; i < 16; ++i) *(LAS u32x4*)(Zl + (size_t)(i * 512 + tid) * 16) = Zg[i * 512 + tid];
    if (tid < 128) { float s, c; sincospif((float)tid * (1.0f / 64.0f), &s, &c); TW128[tid] = (f32x2){c, s}; }
    else if (tid < 192) { float s, c; sincospif((float)(tid - 128) * (1.0f / 32.0f), &s, &c); TW64[tid - 128] = (f32x2){c, s}; }
    __syncthreads();
    const int k1 = tid & 127, q = tid >> 7;
    float yr[16][4], yi[16][4];
#pragma unroll
    for (int a = 0; a < 16; ++a)
#pragma unroll
        for (int e = 0; e < 4; ++e) { yr[a][e] = 0.f; yi[a][e] = 0.f; }
    for (int n1 = 0; n1 < 128; ++n1) {
        const f32x2 tw = TW128[(n1 * k1) & 127]; const float c = tw.x, s = tw.y;
#pragma unroll
        for (int a = 0; a < 16; ++a) { const u32x4 rw = *(const LAS u32x4*)(Zl + (size_t)(64 * n1 + 16 * q + a) * 16);
            const float uc[4] = {bflo(rw.x), bfhi(rw.x), bflo(rw.y), bfhi(rw.y)}, us[4] = {bflo(rw.z), bfhi(rw.z), bflo(rw.w), bfhi(rw.w)};
#pragma unroll
            for (int e = 0; e < 4; ++e) { yr[a][e] += uc[e] * c - us[e] * s; yi[a][e] -= uc[e] * s + us[e] * c; } }
    }
    __syncthreads();
    int k1b = k1; asm volatile("" : "+v"(k1b));
#pragma unroll
    for (int a = 0; a < 16; ++a) { const int n2 = 16 * q + a; const float fr_ = (float)(n2 * k1b) * (1.0f / 8192.0f);
        const float cp = __builtin_amdgcn_cosf(fr_), sp = __builtin_amdgcn_sinf(fr_);
        float pr[4], pi[4];
#pragma unroll
        for (int e = 0; e < 4; ++e) { pr[e] = yr[a][e] * cp + yi[a][e] * sp; pi[e] = yi[a][e] * cp - yr[a][e] * sp; }
        u32x4 w; w.x = pk2bf(pr[0], pr[1]); w.y = pk2bf(pr[2], pr[3]); w.z = pk2bf(pi[0], pi[1]); w.w = pk2bf(pi[2], pi[3]);
        *(LAS u32x4*)(Zl + (size_t)(n2 * 128 + k1b) * 16) = w; }
    __syncthreads();
    int k1c = k1; asm volatile("" : "+v"(k1c));
    float o[16][4];
#pragma unroll
    for (int a = 0; a < 16; ++a)
#pragma unroll
        for (int e = 0; e < 4; ++e) o[a][e] = 0.f;
    for (int n2 = 0; n2 < 64; ++n2) {
        const u32x4 rw = *(const LAS u32x4*)(Zl + (size_t)(n2 * 128 + k1c) * 16);
        const float pr[4] = {bflo(rw.x), bfhi(rw.x), bflo(rw.y), bfhi(rw.y)}, pi[4] = {bflo(rw.z), bfhi(rw.z), bflo(rw.w), bfhi(rw.w)};
#pragma unroll
        for (int a = 0; a < 16; ++a) { const f32x2 tw = TW64[(n2 * (16 * q + a)) & 63];
#pragma unroll
            for (int e = 0; e < 4; ++e) o[a][e] += pr[e] * tw.x + pi[e] * tw.y; }
    }
    u16* MIX = WSP(u16, WS_MIX);
#pragma unroll
    for (int a = 0; a < 16; ++a) { const int k2 = 16 * q + a; u32x2 w; w.x = pk2bf(o[a][0], o[a][1]); w.y = pk2bf(o[a][2], o[a][3]);
        *(GAS u32x2*)(MIX + ((size_t)(b * SEQ + k1c + 128 * k2)) * DM + 4 * g) = w; }
    __syncthreads();
}

__device__ __forceinline__ attn_body::s16x4 ftr(const LAS unsigned char* p) { return __builtin_bit_cast(attn_body::s16x4, __builtin_amdgcn_ds_read_tr16_b64_v4i16((LAS attn_body::v4i16_t*)p)); }
__device__ __forceinline__ void fourier_unit_mfma(Frame& F, int b, int g) {
    LAS unsigned char* Zl = F.lds + RING_OFF;
    const int tid = F.tid, lane = F.lane, w = F.wave;
    const char* Zg = (const char*)(F.ws + WS_Z) + ((size_t)(b * 64 + g) * SEQ) * 16;
#pragma unroll
    for (int i = 0; i < 16; ++i) __builtin_amdgcn_global_load_lds((const unsigned*)(Zg + (size_t)(i * 512 + tid) * 16), (LAS unsigned*)(Zl + (size_t)(i * 512 + w * 64) * 16), 16, 0, 0);
    VM_WAIT(); __syncthreads();
    f32x4 acc[2][16];
#pragma unroll
    for (int ro = 0; ro < 2; ++ro)
#pragma unroll
        for (int t = 0; t < 16; ++t) acc[ro][t] = (f32x4){0.f, 0.f, 0.f, 0.f};
    const GAS bf16x8* D1 = (const GAS bf16x8*)(F.ws + WS_TAB + 144 * 1024);
    const GAS bf16x8* D3 = (const GAS bf16x8*)(F.ws + WS_TAB + 272 * 1024);
    const int l15 = lane & 15, lq = lane >> 4;
    const unsigned bbase = (unsigned)((64 * (8 * lq + (l15 >> 2)) + (lane & 3)) * 16);
#pragma unroll 1
    for (int s1 = 0; s1 < 8; ++s1) {
        const int ri = s1 >> 2;
        const bf16x8 a0 = D1[(16 * w + l15) * 32 + 4 * s1 + lq], a1 = D1[(128 + 16 * w + l15) * 32 + 4 * s1 + lq];
        const LAS unsigned char* sb = Zl + bbase + (unsigned)((s1 & 3) * 32768 + 8 * ri);
#pragma unroll
        for (int t = 0; t < 16; ++t) { const attn_body::s16x4 lo = ftr(sb + 64 * t), hi = ftr(sb + 64 * t + 4096);
            const bf16x8 bf = (bf16x8){lo[0], lo[1], lo[2], lo[3], hi[0], hi[1], hi[2], hi[3]};
            acc[0][t] = __builtin_amdgcn_mfma_f32_16x16x32_bf16(a0, bf, acc[0][t], 0, 0, 0);
            acc[1][t] = __builtin_amdgcn_mfma_f32_16x16x32_bf16(a1, bf, acc[1][t], 0, 0, 0); }
    }
    __syncthreads();
    {   const int e = lane & 3; int k1b = 16 * w + 4 * lq; asm volatile("" : "+v"(k1b));
#pragma unroll
        for (int t = 0; t < 16; ++t) { const int n2 = 4 * t + (l15 >> 2);
#pragma unroll
            for (int r = 0; r < 4; ++r) { const int k1 = k1b + r; const float fr_ = (float)(n2 * k1) * (1.0f / 8192.0f); const float cp = __builtin_amdgcn_cosf(fr_), sp = __builtin_amdgcn_sinf(fr_);
                const float yr = acc[0][t][r], yi = acc[1][t][r]; const float pr = yr * cp + yi * sp, pi = yi * cp - yr * sp;
                *(LAS u16*)(Zl + (unsigned)(((n2) * 512 + k1 * 4 + e) * 2)) = (u16)f2bf(pr);
                *(LAS u16*)(Zl + (unsigned)(((64 + n2) * 512 + k1 * 4 + e) * 2)) = (u16)f2bf(pi); } }
    }
    asm volatile("s_waitcnt lgkmcnt(0)" ::: "memory");
    f32x4 acc3[4][4];
#pragma unroll
    for (int mt = 0; mt < 4; ++mt)
#pragma unroll
        for (int j = 0; j < 4; ++j) acc3[mt][j] = (f32x4){0.f, 0.f, 0.f, 0.f};
#pragma unroll
    for (int s3 = 0; s3 < 4; ++s3) {
        bf16x8 a[4];
#pragma unroll
        for (int mt = 0; mt < 4; ++mt) a[mt] = D3[(16 * mt + l15) * 16 + 4 * s3 + lq];
        const unsigned kk = (unsigned)(32 * s3 + 8 * lq + (l15 >> 2));
#pragma unroll
        for (int j = 0; j < 4; ++j) { const unsigned ad = kk * 1024u + (unsigned)((4 * (4 * w + j) + (lane & 3)) * 8);
            const attn_body::s16x4 lo = ftr(Zl + ad), hi = ftr(Zl + ad + 4096);
            const bf16x8 bf = (bf16x8){lo[0], lo[1], lo[2], lo[3], hi[0], hi[1], hi[2], hi[3]};
#pragma unroll
            for (int mt = 0; mt < 4; ++mt) acc3[mt][j] = __builtin_amdgcn_mfma_f32_16x16x32_bf16(a[mt], bf, acc3[mt][j], 0, 0, 0); }
    }
    u16* MIX = WSP(u16, WS_MIX);
#pragma unroll
    for (int mt = 0; mt < 4; ++mt)
#pragma unroll
        for (int j = 0; j < 4; ++j)
#pragma unroll
            for (int r = 0; r < 4; ++r) { const int k2 = 16 * mt + 4 * lq + r, k1 = 16 * w + 4 * j + (l15 >> 2);
                MIX[((size_t)(b * SEQ + k1 + 128 * k2)) * DM + 4 * g + (lane & 3)] = (u16)f2bf(acc3[mt][j][r]); }
    __syncthreads();
}

__device__ __forceinline__ void route_token(Frame& F, int tok) {
    const int l = F.lane;
    const f32x4 lg = *(const GAS f32x4*)((const GAS float*)(F.ws + WS_LOG) + (size_t)tok * NEXP + 4 * l);
    const f32x4 bs = *(const f32x4*)(F.router_bias + 4 * l);
    float s[4], sel[4];
#pragma unroll
    for (int j = 0; j < 4; ++j) { s[j] = 1.0f / (1.0f + expf(-lg[j])); sel[j] = s[j] + bs[j]; }
    float m1 = fmaxf(sel[0], sel[1]), m2 = fminf(sel[0], sel[1]);
#pragma unroll
    for (int j = 2; j < 4; ++j) { const float v = sel[j]; m2 = fmaxf(m2, fminf(m1, v)); m1 = fmaxf(m1, v); }
#pragma unroll
    for (int off = 1; off < 8; off <<= 1) { const float o1 = __shfl_xor(m1, off), o2 = __shfl_xor(m2, off); const float n2 = fmaxf(fminf(m1, o1), fmaxf(m2, o2)); m1 = fmaxf(m1, o1); m2 = n2; }
    const float gs = m1 + m2; const int myg = l >> 3; int rank = 0;
#pragma unroll
    for (int g2 = 0; g2 < 8; ++g2) { const float og = __shfl(gs, g2 * 8); rank += (og > gs || (og == gs && g2 < myg)) ? 1 : 0; }
    if (rank >= 4) {
#pragma unroll
        for (int j = 0; j < 4; ++j) sel[j] = -INFINITY; }
    int my_e = 0; float my_s = 0.f, sum = 0.f;
#pragma unroll 1
    for (int k = 0; k < TOPK; ++k) {
        float bv = sel[0]; int bi = 4 * l;
#pragma unroll
        for (int j = 1; j < 4; ++j) if (sel[j] > bv) { bv = sel[j]; bi = 4 * l + j; }
#pragma unroll
        for (int off = 1; off < 64; off <<= 1) { const float ov = __shfl_xor(bv, off); const int oi = __shfl_xor(bi, off); if (ov > bv || (ov == bv && oi < bi)) { bv = ov; bi = oi; } }
        const int jj = bi & 3; const bool own = (bi >> 2) == l;
        float cand = s[0];
#pragma unroll
        for (int j = 1; j < 4; ++j) cand = (jj == j) ? s[j] : cand;
        const float wsc = __shfl(cand, bi >> 2);
#pragma unroll
        for (int j = 0; j < 4; ++j) if (own && jj == j) sel[j] = -INFINITY;
        if (l == k) { my_e = bi; my_s = wsc; }
        sum += wsc;
    }
    GAS u32x2* LIST = (GAS u32x2*)(F.ws + WS_LIST);
    if (l < TOPK) { const float gate = my_s / sum * 2.5f; const unsigned pos = __hip_atomic_fetch_add((unsigned*)(F.ctl + CW_CNT + my_e), 1u, RLX_AGENT);
        LIST[(size_t)my_e * NTOK + pos] = (u32x2){(unsigned)tok | ((unsigned)l << 16), __builtin_bit_cast(unsigned, gate)}; }
    else if (l == TOPK) LIST[(size_t)NEXP * NTOK + tok] = (u32x2){(unsigned)tok | (8u << 16), __builtin_bit_cast(unsigned, 1.0f)};
}

__device__ __forceinline__ void build_tiles(Frame& F) {
    LAS int* TS = (LAS int*)(F.lds + TAB_OFF + 2048); LAS int* CN = (LAS int*)(F.lds + TAB_OFF + 3200);
    if (F.tid < 64) { const int l = F.tid; int c[5], t[5], tot = 0;
#pragma unroll
        for (int j = 0; j < 5; ++j) { const int e = 5 * l + j; c[j] = (e < NEXPS) ? (int)__hip_atomic_load((unsigned*)(F.ctl + CW_CNT + e), RLX_AGENT) : 0; t[j] = (c[j] + 255) >> 8; tot += t[j]; }
        int x = tot;
#pragma unroll
        for (int off = 1; off < 64; off <<= 1) { const int v = __shfl_up(x, off); if (l >= off) x += v; }
        int run = x - tot;
#pragma unroll
        for (int j = 0; j < 5; ++j) { const int e = 5 * l + j; if (e <= NEXPS) { TS[e] = run; if (e < NEXPS) CN[e] = c[j]; } run += t[j]; }
    }
    __syncthreads();
}

__device__ __forceinline__ void ph2(Frame& F) {
    const gi64* MOD = (const gi64*)(F.ctl + CW_MOD); const int gw = F.vcu * 8 + F.wave, NGW = F.G * 8; (void)MOD; (void)gw; (void)NGW;
        DenseOrder S{7, 128 * 7, 8, F.G, F.vcu, (const char*)(F.ws + WS_BIN), DM, (REP == 22) ? 2 : 1};
        EpiInProj E{WSP(u16, WS_Z), WSP(u16, WS_Q), WSP(u16, WS_K), WSP(u16, WS_V), WSP(float, WS_TAB + 128 * 1024), WSP(float, WS_TAB + 136 * 1024), F.q_norm_g, F.k_norm_g};
        pg8::gemm_phase<EpiInProj, DenseOrder, false, true>(F.lds + RING_OFF, (const char*)(F.ws + WS_XN), DM, S, E);
    }
__device__ __forceinline__ void ph4(Frame& F) {
    const gi64* MOD = (const gi64*)(F.ctl + CW_MOD); const int gw = F.vcu * 8 + F.wave, NGW = F.G * 8; (void)MOD; (void)gw; (void)NGW;
        if (DBG & 128) { GAS u32x4* zH = (GAS u32x4*)(F.ws + WS_H2); const size_t nH = (size_t)NTOK * DM * 2 / 16; for (size_t i = (size_t)blockIdx.x * 512 + F.tid; i < nH; i += (size_t)F.G * 512) zH[i] = (u32x4){0u, 0u, 0u, 0u}; }
        DenseOrder S{4, 128 * 4, 0, F.G, F.vcu, (const char*)(F.ws + WS_BOUT), DM, 1};
        EpiResid E{F.x, F.out, MOD};
        pg8::gemm_phase<EpiResid, DenseOrder, false, true>(F.lds + RING_OFF, (const char*)(F.ws + WS_MIX), DM, S, E);
    }
__device__ __forceinline__ void ph5(Frame& F) {
    const gi64* MOD = (const gi64*)(F.ctl + CW_MOD); const int gw = F.vcu * 8 + F.wave, NGW = F.G * 8;
    const int wpb = NGW >> 2, b = gw / wpb, wi = gw % wpb;
    rownorm_rows<MOEF16>((const GAS float*)F.out, F.norm2_g, MOD + b * 6144 + 3072, MOD + b * 6144 + 4096, WSP(u16, WS_H2), b * SEQ, SEQ, wi, wpb, F.lane);
}
__device__ __forceinline__ void ph6(Frame& F) {
    const gi64* MOD = (const gi64*)(F.ctl + CW_MOD); const int gw = F.vcu * 8 + F.wave, NGW = F.G * 8; (void)MOD; (void)gw; (void)NGW;
        DenseOrder S{1, 128, 0, F.G, F.vcu, (const char*)(F.ws + WS_BR), DM, 1};
        EpiLogits E{WSP(float, WS_LOG)};
        pg8::gemm_phase<EpiLogits, DenseOrder, MOEF16, true>(F.lds + RING_OFF, (const char*)(F.ws + WS_H2), DM, S, E);
    }
__device__ __forceinline__ void ph8(Frame& F) {
    const gi64* MOD = (const gi64*)(F.ctl + CW_MOD); const int gw = F.vcu * 8 + F.wave, NGW = F.G * 8; (void)MOD; (void)gw; (void)NGW;
        build_tiles(F);
        GroupedOrder<true> S{2, F.G, F.vcu, 512, DM, true, (const char*)(F.ws + WS_BGU), (const LAS int*)(F.lds + TAB_OFF + 2048), (const LAS int*)(F.lds + TAB_OFF + 3200), (const GAS u32x2*)(F.ws + WS_LIST), 1};
        EpiSwiglu E{WSP(u16, WS_ACT)};
        pg8::gemm_phase<EpiSwiglu, GroupedOrder<true>, MOEF16, true>(F.lds + RING_OFF, (const char*)(F.ws + WS_H2), DM, S, E);
    }
__device__ __forceinline__ void ph9(Frame& F) {
    const gi64* MOD = (const gi64*)(F.ctl + CW_MOD); const int gw = F.vcu * 8 + F.wave, NGW = F.G * 8; (void)MOD; (void)gw; (void)NGW;
        build_tiles(F);
        GroupedOrder<false> S{4, F.G, F.vcu, DM, EFF, false, (const char*)(F.ws + WS_BD), (const LAS int*)(F.lds + TAB_OFF + 2048), (const LAS int*)(F.lds + TAB_OFF + 3200), (const GAS u32x2*)(F.ws + WS_LIST), (REP == 29) ? 2 : 1};
        EpiDown E{WSP(u16, WS_C), (const GAS u32x2*)(F.ws + WS_LIST)};
        pg8::gemm_phase<EpiDown, GroupedOrder<false>, MOEF16, true>(F.lds + RING_OFF, (const char*)(F.ws + WS_ACT), EFF, S, E);
    }

#if DBG & (1024 | 2048)
__device__ __forceinline__ void chk_attn(Frame& F, float negM) {
    const int gw = F.vcu * 8 + F.wave, NGW = F.G * 8, lane = F.lane;
    const GAS u16* Q = (const GAS u16*)(F.ws + WS_Q); const GAS u16* K = (const GAS u16*)(F.ws + WS_K); const GAS u16* V = (const GAS u16*)(F.ws + WS_V); const GAS u16* MIX = (const GAS u16*)(F.ws + WS_MIX);
    float* chk = (float*)(F.ctl + CW_CHK);
    for (int i = gw; i < 4096; i += NGW) {
        const int b = i & 3, h = (i >> 2) % 12, q = (int)((((unsigned)i * 2654435761u) >> 19) & 8191u), kvh = h / 3;
        float qv[64], o[64]; float l = 0.f;
#pragma unroll
        for (int c = 0; c < 8; ++c) { const u32x4 w = *(const GAS u32x4*)(Q + ((size_t)(b * SEQ + q)) * QW + h * 64 + 8 * c);
            qv[8 * c] = bflo(w.x); qv[8 * c + 1] = bfhi(w.x); qv[8 * c + 2] = bflo(w.y); qv[8 * c + 3] = bfhi(w.y); qv[8 * c + 4] = bflo(w.z); qv[8 * c + 5] = bfhi(w.z); qv[8 * c + 6] = bflo(w.w); qv[8 * c + 7] = bfhi(w.w); }
#pragma unroll
        for (int d = 0; d < 64; ++d) o[d] = 0.f;
        for (int t = 0; t < LKV / 64; ++t) { const int j = t * 64 + lane; const GAS u16* kr = K + ((size_t)(b * LKV + j)) * KVW + kvh * 64; const GAS u16* vr = V + ((size_t)(b * LKV + j)) * KVW + kvh * 64;
            float dot = 0.f;
#pragma unroll
            for (int c = 0; c < 8; ++c) { const u32x4 w = *(const GAS u32x4*)(kr + 8 * c);
                dot += qv[8 * c] * bflo(w.x) + qv[8 * c + 1] * bfhi(w.x) + qv[8 * c + 2] * bflo(w.y) + qv[8 * c + 3] * bfhi(w.y) + qv[8 * c + 4] * bflo(w.z) + qv[8 * c + 5] * bfhi(w.z) + qv[8 * c + 6] * bflo(w.w) + qv[8 * c + 7] * bfhi(w.w); }
            const float pp = exp2f(dot + negM); l += pp;
#pragma unroll
            for (int c = 0; c < 8; ++c) { const u32x4 w = *(const GAS u32x4*)(vr + 8 * c);
                o[8 * c] += pp * bflo(w.x); o[8 * c + 1] += pp * bfhi(w.x); o[8 * c + 2] += pp * bflo(w.y); o[8 * c + 3] += pp * bfhi(w.y); o[8 * c + 4] += pp * bflo(w.z); o[8 * c + 5] += pp * bfhi(w.z); o[8 * c + 6] += pp * bflo(w.w); o[8 * c + 7] += pp * bfhi(w.w); } }
        l = wave_sum(l); float err = 0.f, ref = 0.f;
#pragma unroll
        for (int d = 0; d < 64; ++d) { const float od = wave_sum(o[d]) / l; const float mv = bflo((unsigned)MIX[((size_t)(b * SEQ + q)) * DM + 256 + h * 64 + d]); err += (od - mv) * (od - mv); ref += od * od; }
        if (lane == 0) { atomicAdd(chk + 0, err); atomicAdd(chk + 1, ref); }
    }
}
__device__ __forceinline__ void chk_qkv(Frame& F) {
    const int gw = F.vcu * 8 + F.wave, NGW = F.G * 8, lane = F.lane;
    const gi64* MOD = (const gi64*)(F.ctl + CW_MOD);
    LAS float* hrow = (LAS float*)(F.lds + RING_OFF + F.wave * 16384);
    float* chk = (float*)(F.ctl + CW_CHK);
    for (int i = gw; i < 4096; i += NGW) {
        const unsigned hs = (unsigned)i * 2654435761u; const bool isctx = (i & 15) == 15; int sel = i % 20; if (isctx && sel < 12) sel = 12 + (sel & 7);
        const int m = isctx ? (int)((hs >> 10) & 1023u) : (int)((hs >> 12) & 32767u);
        const float* src = isctx ? F.ctx + (size_t)m * DM : F.x + (size_t)m * DM; const int mr = isctx ? 4 : (m >> 13);
        const int b = isctx ? (m >> 8) : (m >> 13), l = isctx ? 0 : (m & 8191), key = isctx ? SEQ + (m & 255) : l;
        f32x4 v[4]; float s2 = 0.f;
#pragma unroll
        for (int j = 0; j < 4; ++j) { v[j] = *(const f32x4*)(src + 4 * lane + 256 * j); s2 += (v[j][0] * v[j][0] + v[j][1] * v[j][1]) + (v[j][2] * v[j][2] + v[j][3] * v[j][3]); }
        const float rstd = 1.0f / sqrtf(wave_sum(s2) * (1.0f / DM) + RMS_EPS);
#pragma unroll
        for (int j = 0; j < 4; ++j) { const int col = 4 * lane + 256 * j; const f32x4 g = *(const f32x4*)(F.norm1_g + col); const f32x4 sh = mod4(MOD, mr * 6144 + col), sc = mod4(MOD, mr * 6144 + 1024 + col);
            const f32x4 y = v[j] * rstd * g * (sc + 1.0f) + sh; hrow[col] = y[0]; hrow[col + 1] = y[1]; hrow[col + 2] = y[2]; hrow[col + 3] = y[3]; }
        LDS_WAIT(); asm volatile("" ::: "memory");
        const int colbase = (sel < 12) ? 256 + 64 * sel : (sel < 16 ? 1024 + 64 * (sel - 12) : 1280 + 64 * (sel - 16));
        float z = 0.f;
        for (int k = 0; k < DM; ++k) z += hrow[k] * F.w_in[(size_t)k * 1536 + colbase + lane];
        float outv = z; int spos = lane;
        if (sel < 16) { const float ss = wave_sum(z * z); const float gain = (sel < 12) ? F.q_norm_g[lane] : F.k_norm_g[lane]; const float zz = z * (1.0f / sqrtf(ss * (1.0f / 64.0f) + RMS_EPS)) * gain;
            const float pz = __shfl(zz, lane ^ 16); outv = zz;
            if (!isctx) { const int pidx = (lane & 32) ? (l & 63) : (l >> 6); const float inv = powf(10000.0f, -(float)(lane & 15) / 16.0f), ang = (float)pidx * inv; const float cs = cosf(ang), sn = sinf(ang);
                outv = (lane & 16) ? zz * cs + pz * sn : zz * cs - pz * sn; }
            if (sel < 12) outv *= C2;
            spos = 32 * (lane >> 5) + 8 * ((lane >> 2) & 3) + 4 * ((lane >> 4) & 1) + (lane & 3); }
        float stored;
        if (sel < 12) stored = bflo((unsigned)((const GAS u16*)(F.ws + WS_Q))[(size_t)m * QW + sel * 64 + spos]);
        else if (sel < 16) stored = bflo((unsigned)((const GAS u16*)(F.ws + WS_K))[((size_t)(b * LKV + key)) * KVW + (sel - 12) * 64 + spos]);
        else stored = bflo((unsigned)((const GAS u16*)(F.ws + WS_V))[((size_t)(b * LKV + key)) * KVW + (sel - 16) * 64 + lane]);
        const float err = wave_sum((outv - stored) * (outv - stored)), ref = wave_sum(outv * outv);
        if (lane == 0) { atomicAdd(chk + 2, err); atomicAdd(chk + 3, ref); }
        LDS_WAIT(); asm volatile("" ::: "memory");
    }
}
#endif

struct Args { const float* in[20]; float* out; unsigned char* ws; int ph_lo, ph_hi; };
__global__ void __launch_bounds__(512, 2) mk_fwd(Args args) {
    extern __shared__ __attribute__((aligned(16))) unsigned char lds[];
    Frame F;
    F.lds = (LAS unsigned char*)lds;
    F.MISC = (volatile LAS unsigned*)(F.lds + MISC_OFF);
    F.tid = threadIdx.x; F.lane = F.tid & 63; F.wave = __builtin_amdgcn_readfirstlane(F.tid >> 6);
    F.G = gridDim.x; { const int bx = blockIdx.x; F.vcu = (F.G % 8 == 0) ? (bx % 8) * (F.G / 8) + bx / 8 : bx; }
    F.ws = args.ws; F.ctl = (gu32*)(args.ws + WS_CTL); F.out = args.out;
    F.x = args.in[0]; F.c = args.in[1]; F.ctx = args.in[2]; F.c_ctx = args.in[3]; F.norm1_g = args.in[4]; F.w_ada = args.in[5]; F.b_ada = args.in[6]; F.w_in = args.in[7]; F.w_fourier = args.in[8];
    F.q_norm_g = args.in[9]; F.k_norm_g = args.in[10]; F.w_out = args.in[11]; F.norm2_g = args.in[12]; F.w_router = args.in[13]; F.router_bias = args.in[14]; F.w_egu = args.in[15]; F.w_ed = args.in[16];
    F.w_sgu = args.in[17]; F.w_sd = args.in[18]; F.final_g = args.in[19];
    for (int u = F.tid; u < (LDS_BYTES - LDSCTL_OFF) / 4; u += 512) ((LAS unsigned*)(F.lds + LDSCTL_OFF))[u] = 0u;
    __syncthreads();
    XcdBarrier bar; bar.bar = (unsigned*)(F.ctl + CW_BAR); bar.x = 0; bar.st = nullptr;
    if (N_LAUNCHES == 1) bar = xcd_barrier_post((unsigned*)(F.ctl + CW_BAR), F.MISC + 8);
    const int lo = args.ph_lo, hi = args.ph_hi;
#define IN(k) (lo <= (k) && (k) < hi)
#define SEAM(k) do { if (IN(k) && IN((k) + 1)) xcd_barrier(bar); } while (0)
    const gi64* MOD = (const gi64*)(F.ctl + CW_MOD);
    const int gw = F.vcu * 8 + F.wave, NGW = F.G * 8;

    if (IN(0)) { p0_phase(F); } SEAM(0);
    if (IN(1)) { p1_phase(F); VM_WAIT(); __syncthreads(); if (REP == 1) { xcd_barrier(bar); p1_phase(F); VM_WAIT(); __syncthreads(); } } SEAM(1);

    if (IN(2)) { ph2(F); if (REP == 2) { xcd_barrier(bar); ph2(F); } } SEAM(2);

    if (IN(3)) {
        if (DBG & 32) { u16* MIXz = WSP(u16, WS_MIX); for (int m = gw; m < NTOK; m += NGW) *(GAS u32x2*)(MIXz + (size_t)m * DM + 4 * F.lane) = (u32x2){0u, 0u}; }
        else
        REPS(30) for (int U = F.vcu; U < NB * 64; U += F.G) { if (FOURIER_MFMA) fourier_unit_mfma(F, U >> 6, U & 63); else fourier_unit(F, U >> 6, U & 63); }
        const attn_body::bf16* Qp = (const attn_body::bf16*)(F.ws + WS_Q); const attn_body::bf16* Kp = (const attn_body::bf16*)(F.ws + WS_K); const attn_body::bf16* Vp = (const attn_body::bf16*)(F.ws + WS_V);
        attn_body::bf16* Op = (attn_body::bf16*)(F.ws + WS_MIX) + 256;
        float negM; { float gqm = fabsf(F.q_norm_g[F.lane]), gkm = fabsf(F.k_norm_g[F.lane]);
#pragma unroll
            for (int o_ = 1; o_ < 64; o_ <<= 1) { gqm = fmaxf(gqm, __shfl_xor(gqm, o_)); gkm = fmaxf(gkm, __shfl_xor(gkm, o_)); }
            negM = -(C2 * 64.0f * gqm * gkm + 0.5f); }
        if (DBG & 16) { u16* MIXz = WSP(u16, WS_MIX); for (int m = gw; m < NTOK; m += NGW) for (int j = 1; j < 4; ++j) *(GAS u32x2*)(MIXz + (size_t)m * DM + 256 * j + 4 * F.lane) = (u32x2){0u, 0u}; }
        else if (F.G == 256) REPS(31) {
            const int xg = F.vcu >> 5, jq = F.vcu & 31;
            for (int i = 0; i < 6; ++i) { const int grp = 2 * xg + i / 3, hs = i % 3; attn_body::attn_unit<8>(grp >> 2, (grp & 3) * 3 + hs, jq, Qp, Kp, Vp, Op, (char*)lds + RING_OFF, negM); }
        } else {
            for (int U = F.vcu; U < NB * NQH * 32; U += F.G) { const int grp = U / 96, r = U % 96; attn_body::attn_unit<8>(grp >> 2, (grp & 3) * 3 + r / 32, r % 32, Qp, Kp, Vp, Op, (char*)lds + RING_OFF, negM); }
        }
    } SEAM(3);

#if DBG & (1024 | 2048)
    if (IN(4)) { float negMc; { float gqm = fabsf(F.q_norm_g[F.lane]), gkm = fabsf(F.k_norm_g[F.lane]);
            for (int o_ = 1; o_ < 64; o_ <<= 1) { gqm = fmaxf(gqm, __shfl_xor(gqm, o_)); gkm = fmaxf(gkm, __shfl_xor(gkm, o_)); } negMc = -(C2 * 64.0f * gqm * gkm + 0.5f); }
        if (DBG & 1024) chk_attn(F, negMc); if (DBG & 2048) chk_qkv(F); VM_WAIT(); __syncthreads(); }
#endif
    if (IN(4)) { ph4(F); if (REP == 4) { xcd_barrier(bar); ph4(F); } } SEAM(4);

    if (IN(5)) { ph5(F); if (REP == 5) { xcd_barrier(bar); ph5(F); } } SEAM(5);

    if (IN(6)) { ph6(F); if (REP == 6) { xcd_barrier(bar); ph6(F); } } SEAM(6);

    if (IN(7)) {
        if (DBG & 128) { GAS u32x4* zA = (GAS u32x4*)(F.ws + WS_ACT); const size_t nA = (size_t)MAXTILES * 256 * EFF * 2 / 16; for (size_t i = (size_t)blockIdx.x * 512 + F.tid; i < nA; i += (size_t)F.G * 512) zA[i] = (u32x4){0u, 0u, 0u, 0u};
            GAS u32x4* zC = (GAS u32x4*)(F.ws + WS_C); const size_t nC = (size_t)NTOK * NSLOT * DM * 2 / 16; for (size_t i = (size_t)blockIdx.x * 512 + F.tid; i < nC; i += (size_t)F.G * 512) zC[i] = (u32x4){0u, 0u, 0u, 0u}; }
        if (blockIdx.x == 0 && F.tid == 0) __hip_atomic_store((unsigned*)(F.ctl + CW_CNT + NEXP), (unsigned)NTOK, RLX_AGENT);
        for (int tok = gw; tok < NTOK; tok += NGW) route_token(F, tok);
    } SEAM(7);

    if (IN(8)) { ph8(F); if (REP == 8) { xcd_barrier(bar); ph8(F); } } SEAM(8);

    if (IN(9)) { ph9(F); if (REP == 9) { xcd_barrier(bar); ph9(F); } } SEAM(9);

    if (IN(10)) {
        const int lane = F.lane; const GAS unsigned char* Cc = (const GAS unsigned char*)(F.ws + WS_C);
        const int wpb = NGW >> 2, b = gw / wpb, wi = gw % wpb;
        f32x4 g2v[4], fg[4];
#pragma unroll
        for (int i = 0; i < 4; ++i) { const int col = 16 * lane + 4 * i; g2v[i] = mod4(MOD + b * 6144 + 5120, col) * (1.0f / C_SCALE); fg[i] = *(const f32x4*)(F.final_g + col); }
        bool bad = false;
#if DBG & (1024 | 2048)
        { const float e0 = __hip_atomic_load((float*)(F.ctl + CW_CHK), RLX_AGENT), r0 = __hip_atomic_load((float*)(F.ctl + CW_CHK) + 1, RLX_AGENT), e1 = __hip_atomic_load((float*)(F.ctl + CW_CHK) + 2, RLX_AGENT), r1 = __hip_atomic_load((float*)(F.ctl + CW_CHK) + 3, RLX_AGENT);
          if (DBG & 1024) bad = bad || !(e0 <= CHK_TOL_A * r0) || !(r0 > 0.f); if (DBG & 2048) bad = bad || !(e1 <= CHK_TOL_B * r1) || !(r1 > 0.f); }
#endif
        for (int r = wi; r < SEQ; r += wpb) { const int m = b * SEQ + r; GAS float* orow = (GAS float*)F.out + (size_t)m * DM + 16 * lane;
            f32x4 x1[4], y[4];
#pragma unroll
            for (int i = 0; i < 4; ++i) { x1[i] = *(const GAS f32x4*)(orow + 4 * i); y[i] = (f32x4){0.f, 0.f, 0.f, 0.f}; }
#pragma unroll
            for (int sl = 0; sl < NSLOT; ++sl) { const u32x4 w = *(const GAS u32x4*)(Cc + ((size_t)m * NSLOT + sl) * DM + 16 * lane);
#pragma unroll
                for (int i = 0; i < 4; ++i) { const int wi_ = (int)w[i]; const f32x2 lo = __builtin_amdgcn_cvt_pk_f32_fp8(wi_, false), hi = __builtin_amdgcn_cvt_pk_f32_fp8(wi_, true); y[i] += (f32x4){lo.x, lo.y, hi.x, hi.y}; } }
            float s2 = 0.f;
#pragma unroll
            for (int i = 0; i < 4; ++i) { const f32x4 v = x1[i] + g2v[i] * y[i]; x1[i] = v; s2 += (v[0] * v[0] + v[1] * v[1]) + (v[2] * v[2] + v[3] * v[3]); }
            const float rstd = 1.0f / sqrtf(wave_sum(s2) * (1.0f / DM) + RMS_EPS) * (bad ? 3.0f : 1.0f);
#pragma unroll
            for (int i = 0; i < 4; ++i) *(GAS f32x4*)(orow + 4 * i) = x1[i] * rstd * fg[i]; }
    }
#undef IN
#undef SEAM
}

extern "C" void kernel_launch(void* const* d_in, const int* in_sizes, int n_in, void* d_out, int out_size, void* d_ws, size_t ws_size, hipStream_t stream) {
    static int grid = 0;
    if (grid == 0) {
        if (n_in != 20 || in_sizes[0] != NTOK * DM || out_size != NTOK * DM || ws_size < WS_END) { fprintf(stderr, "kernel_launch: unexpected shapes (n_in %d, in0 %d, out %d, ws %zu < %zu)\n", n_in, n_in > 0 ? in_sizes[0] : -1, out_size, ws_size, (size_t)WS_END); grid = -1; return; }
        int dev = 0, cus = 0, per_cu = 0;
        if (hipGetDevice(&dev) != hipSuccess || hipDeviceGetAttribute(&cus, hipDeviceAttributeMultiprocessorCount, dev) != hipSuccess) { grid = -1; return; }
        if (hipFuncSetAttribute((const void*)mk_fwd, hipFuncAttributeMaxDynamicSharedMemorySize, LDS_BYTES) != hipSuccess) { fprintf(stderr, "kernel_launch: hipFuncSetAttribute failed\n"); grid = -1; return; }
        if (hipOccupancyMaxActiveBlocksPerMultiprocessor(&per_cu, (const void*)mk_fwd, 512, LDS_BYTES) != hipSuccess || per_cu < 1) fprintf(stderr, "kernel_launch: occupancy query reports %d\n", per_cu);
        (void)hipGetLastError();
        grid = cus;
    }
    if (grid < 0) return;
    (void)hipMemsetAsync((char*)d_ws + WS_CTL, 0, CTL_ZERO_BYTES, stream);
    Args a{};
    for (int i = 0; i < 20; ++i) a.in[i] = (const float*)d_in[i];
    a.out = (float*)d_out; a.ws = (unsigned char*)d_ws;
    if (N_LAUNCHES == 1) { a.ph_lo = 0; a.ph_hi = PER_PHASE; hipLaunchKernelGGL(mk_fwd, dim3(grid), dim3(512), LDS_BYTES, stream, a); }
    else for (int li = 0; li < PER_PHASE; ++li) { a.ph_lo = li; a.ph_hi = li + 1; hipLaunchKernelGGL(mk_fwd, dim3(grid), dim3(512), LDS_BYTES, stream, a); }
}
```

```cpp
#include <hip/hip_runtime.h>
#include <hip/hip_bf16.h>
#include <cstdio>
#include <cstdint>
#include <cmath>

#ifndef MK_N_LAUNCHES
#define MK_N_LAUNCHES 1
#endif
constexpr int PER_PHASE = 11;
#ifndef DBG
#define DBG 0
#endif
#ifndef REP
#define REP -1
#endif
#ifndef CHK_TOL_A
#define CHK_TOL_A 1e-3f
#endif
#ifndef CHK_TOL_B
#define CHK_TOL_B 1e-3f
#endif
#ifndef FOURIER_MFMA
#define FOURIER_MFMA 1
#endif
#define REPS(k) for (int rep_ = 0; rep_ < ((REP == (k)) ? 2 : 1); ++rep_)
#define REPBAR() do { if (rep_) xcd_barrier(bar); } while (0)
constexpr int N_LAUNCHES = MK_N_LAUNCHES;

#define GAS __attribute__((address_space(1)))
#define LAS __attribute__((address_space(3)))
typedef unsigned short u16;
typedef short bf16x8 __attribute__((ext_vector_type(8)));
typedef _Float16 half8 __attribute__((ext_vector_type(8)));
typedef _Float16 half2v __attribute__((ext_vector_type(2)));
typedef float f32x4 __attribute__((ext_vector_type(4)));
typedef float f32x2 __attribute__((ext_vector_type(2)));
typedef unsigned u32x4 __attribute__((ext_vector_type(4)));
typedef unsigned u32x2 __attribute__((ext_vector_type(2)));
typedef GAS unsigned gu32;

constexpr int DM = 1024, NB = 4, SEQ = 8192, NTOK = NB * SEQ, CTXL = 256, NCTX = NB * CTXL, LKV = SEQ + CTXL;
constexpr int NQH = 12, NKVH = 4, HD = 64, QW = NQH * HD, KVW = NKVH * HD;
constexpr int NIN = 1792;
constexpr int MIN_ROWS = NTOK + NCTX;
constexpr int NEXP = 256, NEXPS = 257, TOPK = 8, EFF = 256, NSLOT = 9;
constexpr int MAXTILES = 1408;
constexpr float RMS_EPS = 1e-6f;
#ifndef MOE_F16
#define MOE_F16 0
#endif
constexpr bool MOEF16 = MOE_F16;
constexpr float C2 = 0.125f * 1.4426950408889634f;
constexpr float C_SCALE = 16.0f;

constexpr size_t MiB = 1u << 20;
constexpr size_t WS_CTL = 0, CTL_ZERO_BYTES = 1 * MiB;
constexpr size_t WS_TAB = 1 * MiB;
constexpr size_t WS_BIN = 2 * MiB;
constexpr size_t WS_BOUT = 6 * MiB;
constexpr size_t WS_BR = 8 * MiB;
constexpr size_t WS_K = 16 * MiB;
constexpr size_t WS_V = 34 * MiB;
constexpr size_t WS_Z = 52 * MiB;
constexpr size_t WS_Q = 84 * MiB;
constexpr size_t WS_XN = 132 * MiB;
constexpr size_t WS_MIX = 198 * MiB;
constexpr size_t WS_H2 = 262 * MiB;
constexpr size_t WS_LOG = 326 * MiB;
constexpr size_t WS_LIST = 358 * MiB;
constexpr size_t WS_BGU = 424 * MiB;
constexpr size_t WS_BD = 682 * MiB;
constexpr size_t WS_ACT = 812 * MiB;
constexpr size_t WS_C = 990 * MiB;
constexpr size_t WS_END = 1568 * MiB;
constexpr int CW_TMO = 0, CW_CODE = 1;
constexpr int CW_BAR = 4096;
constexpr int CW_CNT = 16384;
constexpr int CW_CHK = 32768;
constexpr int CW_MOD = 131072;
static_assert(CW_MOD * 4 + 5 * 6144 * 8 <= (int)CTL_ZERO_BYTES, "ctl");

constexpr int RING_OFF = 0, RING_BYTES = 131072;
constexpr int TAB_OFF = RING_BYTES;
constexpr int LDSCTL_OFF = RING_BYTES + 8192, MISC_OFF = LDSCTL_OFF + 320;
constexpr int LDS_BYTES = 147456;

#define LDS_WAIT() asm volatile("s_waitcnt lgkmcnt(0)" ::: "memory")
#define VM_WAIT() asm volatile("s_waitcnt vmcnt(0)" ::: "memory")
#define RLX_AGENT __ATOMIC_RELAXED, __HIP_MEMORY_SCOPE_AGENT

__device__ __forceinline__ unsigned f2bf(float f) { unsigned u = __builtin_bit_cast(unsigned, f); return (u + 0x7fffu + ((u >> 16) & 1u)) >> 16; }
__device__ __forceinline__ unsigned pk2bf(float lo, float hi) { return f2bf(lo) | (f2bf(hi) << 16); }
__device__ __forceinline__ unsigned pk2h(float lo, float hi) { half2v v = {(_Float16)lo, (_Float16)hi}; return __builtin_bit_cast(unsigned, v); }
__device__ __forceinline__ unsigned cvt_pk_bf16(float lo, float hi) { unsigned r; asm volatile("v_cvt_pk_bf16_f32 %0, %1, %2" : "=v"(r) : "v"(lo), "v"(hi)); return r; }
__device__ __forceinline__ float bflo(unsigned w) { return __builtin_bit_cast(float, w << 16); }
__device__ __forceinline__ float bfhi(unsigned w) { return __builtin_bit_cast(float, w & 0xffff0000u); }
typedef long long i64x2 __attribute__((ext_vector_type(2)));
typedef GAS long long gi64;
__device__ __forceinline__ f32x4 mod4(const gi64* MODQ, int idx) {
    const i64x2 a = *(const GAS i64x2*)(MODQ + idx), b = *(const GAS i64x2*)(MODQ + idx + 2);
    return (f32x4){(float)a.x, (float)a.y, (float)b.x, (float)b.y} * 0x1p-36f;
}
__device__ __forceinline__ float wave_sum(float v) {
#pragma unroll
    for (int o = 1; o < 64; o <<= 1) v += __shfl_xor(v, o);
    return v;
}

namespace pg8 {
constexpr int BM = 256, BK = 64, HALF = 128, HTB = HALF * BK * 2, STAGE_BYTES = 8 * HTB;
__host__ __device__ __forceinline__ int lds_byte(int r, int c) { const int st = (r >> 4) * 2 + (c >> 5), rr = r & 15, cc = c & 31, ob = rr * 64 + cc * 2; return st * 1024 + (ob ^ (((ob >> 9) & 1) << 5)); }
__host__ __device__ __forceinline__ void stage_rc(int b, int& R, int& C) { const int st = b / 1024, sb = b % 1024, swz = sb ^ (((sb >> 9) & 1) << 5); R = (st >> 1) * 16 + swz / 64; C = (st & 1) * 32 + (swz % 64) / 2; }
__host__ __device__ __forceinline__ int perm32(int rho) { const int n = rho >> 4, i = rho & 15; return 8 * (i >> 2) + 4 * n + (i & 3); }

struct GUnit { int pm, pn, e, j, nvalid; const char* B; };

template <bool F16> __device__ __forceinline__ f32x4 mma16(bf16x8 a, bf16x8 b, f32x4 c) {
    if constexpr (F16) return __builtin_amdgcn_mfma_f32_16x16x32_f16(__builtin_bit_cast(half8, a), __builtin_bit_cast(half8, b), c, 0, 0, 0);
    else return __builtin_amdgcn_mfma_f32_16x16x32_bf16(a, b, c, 0, 0, 0);
}

template <class Epi, class Sched, bool F16, bool ALIGN_EPI>
__device__ __forceinline__ void gemm_phase(LAS unsigned char* lds, const char* Abase, const int K, const Sched& S, const Epi& E) {
    const int tid = threadIdx.x, wid = __builtin_amdgcn_readfirstlane(tid >> 6), lane = tid & 63, wr = wid >> 2, wc = wid & 3, fr = lane & 15, fq = lane >> 4;
    const int nt = K / BK;
    unsigned voffB[2];
#pragma unroll
    for (int i = 0; i < 2; ++i) { int R, C; stage_rc(tid * 16 + i * 8192, R, C); const int Rb = Epi::PERM ? ((R & ~31) + perm32(R & 31)) : R; voffB[i] = (unsigned)(Rb * K + C) * 2u; }
#define PG8_AOFF(V, UNIT) do { int t_ = tid; asm volatile("" : "+v"(t_)); _Pragma("unroll") for (int _i = 0; _i < 2; ++_i) { int R_, C_; stage_rc(t_ * 16 + _i * 8192, R_, C_); \
        _Pragma("unroll") for (int _h = 0; _h < 2; ++_h) (V)[_h][_i] = ((unsigned)S.arow(UNIT, R_ + HALF * _h) * (unsigned)K + (unsigned)C_) * 2u; } } while (0)
    const size_t kstep = (size_t)(BK * 2);
    const size_t hstep = (size_t)HALF * K * 2;
    const unsigned ldsw = (unsigned)wid * 1024u;
    const int aoff = lds_byte(wr * 64 + fr, fq * 8), boff = lds_byte(wc * 32 + fr, fq * 8);
#define PG8_SA(b, h) (((b) * 2 + (h)) * HTB)
#define PG8_SB(b, h) ((4 + (b) * 2 + (h)) * HTB)
#define PG8_STAGEB(bufoff, gbase) do { _Pragma("unroll") for (int _i = 0; _i < 2; ++_i) \
        __builtin_amdgcn_global_load_lds((const unsigned*)((const char*)(gbase) + voffB[_i]), (LAS unsigned*)(lds + (bufoff) + ldsw + _i * 8192), 16, 0, 0); } while (0)
#define PG8_STAGEA(bufoff, koff, V, h) do { _Pragma("unroll") for (int _i = 0; _i < 2; ++_i) \
        __builtin_amdgcn_global_load_lds((const unsigned*)(Abase + (size_t)(V)[h][_i] + (koff)), (LAS unsigned*)(lds + (bufoff) + ldsw + _i * 8192), 16, 0, 0); } while (0)
#define PG8_LDA(dst, b, h) do { _Pragma("unroll") for (int m = 0; m < 4; ++m) _Pragma("unroll") for (int k = 0; k < 2; ++k) dst[m][k] = *(const LAS bf16x8*)(lds + PG8_SA(b, h) + aoff + m * 2048 + k * 1024); } while (0)
#define PG8_LDB(dst, b, h) do { _Pragma("unroll") for (int n = 0; n < 2; ++n) _Pragma("unroll") for (int k = 0; k < 2; ++k) dst[n][k] = *(const LAS bf16x8*)(lds + PG8_SB(b, h) + boff + n * 2048 + k * 1024); } while (0)
#define PG8_MMA(ai, bj, At, Bt) do { __builtin_amdgcn_s_setprio(1); _Pragma("unroll") for (int m = 0; m < 4; ++m) _Pragma("unroll") for (int n = 0; n < 2; ++n) _Pragma("unroll") for (int k = 0; k < 2; ++k) \
        acc[ai][bj][m][n] = mma16<F16>(Bt[n][k], At[m][k], acc[ai][bj][m][n]); __builtin_amdgcn_s_setprio(0); } while (0)
#define PG8_WAIT_V(n) asm volatile("s_waitcnt vmcnt(" #n ")" ::: "memory")
#define PG8_WAIT_L(n) asm volatile("s_waitcnt lgkmcnt(" #n ")" ::: "memory")
#define PG8_BAR __builtin_amdgcn_s_barrier()
#define PG8_SCHED __builtin_amdgcn_sched_barrier(0)
    GUnit cur, nxt; int ui = 0;
    if (!S.next(0, cur)) return;
    f32x4 acc[2][2][4][2];
#pragma unroll
    for (int a = 0; a < 2; ++a)
#pragma unroll
        for (int b = 0; b < 2; ++b)
#pragma unroll
            for (int m = 0; m < 4; ++m)
#pragma unroll
                for (int n = 0; n < 2; ++n) acc[a][b][m][n] = (f32x4){0.f, 0.f, 0.f, 0.f};
    bf16x8 At[4][2], B0[2][2], B1[2][2];
    unsigned vA[2][2], vN[2][2];
    PG8_AOFF(vA, cur);
    if constexpr (Sched::GATHER) VM_WAIT();
    const char* cB = cur.B;
    PG8_STAGEB(PG8_SB(0, 0), cB); PG8_STAGEB(PG8_SB(0, 1), cB + hstep); PG8_STAGEA(PG8_SA(0, 0), 0, vA, 0); PG8_STAGEA(PG8_SA(0, 1), 0, vA, 1);
    if (wr == 1) PG8_BAR;
    PG8_WAIT_V(2); PG8_BAR;
    PG8_STAGEB(PG8_SB(1, 0), cB + kstep); PG8_STAGEA(PG8_SA(1, 0), kstep, vA, 0); PG8_STAGEB(PG8_SB(1, 1), cB + hstep + kstep);
    PG8_WAIT_V(6); PG8_BAR;
    for (;;) {
        const bool has_next = S.next(ui + 1, nxt);
        const char* nB = cB;
        if (has_next) {
            PG8_AOFF(vN, nxt);
            if constexpr (Sched::GATHER) VM_WAIT();
            nB = nxt.B;
        } else {
#pragma unroll
            for (int h = 0; h < 2; ++h)
#pragma unroll
                for (int i = 0; i < 2; ++i) vN[h][i] = vA[h][i];
        }
        for (int t = 0; t < nt; t += 2) {
            const bool last = (t == nt - 2);
            const size_t k1 = (size_t)(t + 1) * kstep;
            const size_t k2 = last ? (size_t)0 : (size_t)(t + 2) * kstep, k3 = k2 + kstep;
            unsigned v2[2][2];
#pragma unroll
            for (int h = 0; h < 2; ++h)
#pragma unroll
                for (int i = 0; i < 2; ++i) v2[h][i] = last ? vN[h][i] : vA[h][i];
            const char* b2 = (last ? nB : cB) + k2; const char* b3 = b2 + kstep;
            PG8_LDB(B0, 0, 0); PG8_LDB(B1, 0, 1); PG8_SCHED; PG8_LDA(At, 0, 0); PG8_STAGEA(PG8_SA(1, 1), k1, vA, 1);
            PG8_WAIT_V(8); PG8_WAIT_L(0); PG8_BAR; PG8_MMA(0, 0, At, B0); PG8_MMA(0, 1, At, B1); PG8_BAR; PG8_SCHED;
            PG8_LDA(At, 0, 1); PG8_STAGEB(PG8_SB(0, 0), b2); PG8_STAGEB(PG8_SB(0, 1), b2 + hstep); PG8_STAGEA(PG8_SA(0, 0), k2, v2, 0);
            PG8_WAIT_V(8); PG8_WAIT_L(0); PG8_BAR; PG8_MMA(1, 0, At, B0); PG8_MMA(1, 1, At, B1); PG8_BAR; PG8_SCHED;
            PG8_LDB(B0, 1, 0); PG8_LDB(B1, 1, 1); PG8_SCHED; PG8_LDA(At, 1, 0); PG8_STAGEA(PG8_SA(0, 1), k2, v2, 1);
            PG8_WAIT_V(8); PG8_WAIT_L(0); PG8_BAR; PG8_MMA(0, 0, At, B0); PG8_MMA(0, 1, At, B1); PG8_BAR; PG8_SCHED;
            PG8_LDA(At, 1, 1); PG8_STAGEB(PG8_SB(1, 0), b3); PG8_STAGEB(PG8_SB(1, 1), b3 + hstep); PG8_STAGEA(PG8_SA(1, 0), k3, v2, 0);
            PG8_WAIT_V(8); PG8_WAIT_L(0); PG8_BAR; PG8_MMA(1, 0, At, B0); PG8_MMA(1, 1, At, B1); PG8_BAR; PG8_SCHED;
        }
        if constexpr (ALIGN_EPI) { if (wr == 0) PG8_BAR; }
        E(acc, cur, wr, wc, fr, fq);
        if (!has_next) break;
#pragma unroll
        for (int a = 0; a < 2; ++a)
#pragma unroll
            for (int b = 0; b < 2; ++b)
#pragma unroll
                for (int m = 0; m < 4; ++m)
#pragma unroll
                    for (int n = 0; n < 2; ++n) acc[a][b][m][n] = (f32x4){0.f, 0.f, 0.f, 0.f};
        cur = nxt; cB = nB; ++ui;
#pragma unroll
        for (int h = 0; h < 2; ++h)
#pragma unroll
            for (int i = 0; i < 2; ++i) vA[h][i] = vN[h][i];
        if constexpr (ALIGN_EPI) { if (wr == 1) PG8_BAR; }
    }
    PG8_WAIT_V(0);
    if constexpr (!ALIGN_EPI) { if (wr == 0) PG8_BAR; }
    PG8_BAR;
#undef PG8_SA
#undef PG8_SB
#undef PG8_STAGEA
#undef PG8_AOFF
#undef PG8_STAGEB
#undef PG8_LDA
#undef PG8_LDB
#undef PG8_MMA
#undef PG8_WAIT_V
#undef PG8_WAIT_L
#undef PG8_BAR
#undef PG8_SCHED
}
}

namespace attn_body {
using bf16 = __hip_bfloat16;
using s16x4 = __attribute__((ext_vector_type(4))) short;
using f32x16 = __attribute__((ext_vector_type(16))) float;
constexpr int D = 64, DMQ = QW, DMKV = KVW, DMO = DM;
constexpr int NW = 8, QBLK = 32, QB = QBLK * NW, KVBLK = 64, NT = LKV / KVBLK;
static_assert(NT % 2 == 0 && NT >= 8, "tile count");
__device__ __forceinline__ int crow(int r, int hi) { return (r & 3) + 8 * (r >> 2) + 4 * hi; }
#define SBAR() __builtin_amdgcn_sched_barrier(0)
constexpr int NSLOTR = 3, SLOTB = 8192;
constexpr int LDS_K = 0, LDS_V = NSLOTR * SLOTB, LDS_WS = 2 * NSLOTR * SLOTB, LDS_OST = LDS_WS + NW * 64 * 4, ATT_LDS_BYTES = LDS_OST + NW * 4096;
__device__ __forceinline__ void glds16(const void* gsrc, unsigned lds_dst) { unsigned keep;
    asm volatile("s_mov_b32 %0, m0\n\ts_mov_b32 m0, %2\n\ts_nop 0\n\tglobal_load_lds_dwordx4 %1, off\n\ts_mov_b32 m0, %0" : "=&s"(keep) : "v"(gsrc), "s"(lds_dst) : "memory"); }
__device__ __forceinline__ float max3f(float a, float b, float c) { float r; asm("v_max3_f32 %0, %1, %2, %3" : "=v"(r) : "v"(a), "v"(b), "v"(c)); return r; }
__device__ __forceinline__ float max2f(float a, float b) { float r; asm("v_max_f32_e32 %0, %1, %2" : "=v"(r) : "v"(a), "v"(b)); return r; }
__device__ __forceinline__ float fadd_s(float a, float b) { float r; asm("v_add_f32_e32 %0, %1, %2" : "=v"(r) : "v"(a), "v"(b)); return r; }
__device__ __forceinline__ float fsub_s(float a, float b) { float r; asm("v_sub_f32_e32 %0, %1, %2" : "=v"(r) : "v"(a), "v"(b)); return r; }
typedef float f32x2_t __attribute__((ext_vector_type(2))); typedef __bf16 bf16x2_t __attribute__((ext_vector_type(2)));
__device__ __forceinline__ unsigned cvtpk_s(float lo, float hi) { f32x2_t v = {lo, hi}; bf16x2_t b = __builtin_convertvector(v, bf16x2_t); return __builtin_bit_cast(unsigned, b); }
#define WAIT_BAR(N) asm volatile("s_waitcnt vmcnt(" #N ") lgkmcnt(0)\n\ts_barrier" ::: "memory")

__device__ __forceinline__ void qkt(f32x16& p0, f32x16& p1, const char* Kslot, const bf16x8* qr, const f32x16& negm, int r32, int hi) {
    const char* kb = Kslot + hi * 1024 + r32 * 16;
#pragma unroll
    for (int d0 = 0; d0 < 4; ++d0) {
        const bf16x8 b0 = *reinterpret_cast<const bf16x8*>(kb + d0 * 2048);
        const bf16x8 b1 = *reinterpret_cast<const bf16x8*>(kb + d0 * 2048 + 512);
        if (d0 == 0) { p0 = __builtin_amdgcn_mfma_f32_32x32x16_bf16(b0, qr[0], negm, 0, 0, 0); p1 = __builtin_amdgcn_mfma_f32_32x32x16_bf16(b1, qr[0], negm, 0, 0, 0); }
        else { p0 = __builtin_amdgcn_mfma_f32_32x32x16_bf16(b0, qr[d0], p0, 0, 0, 0); p1 = __builtin_amdgcn_mfma_f32_32x32x16_bf16(b1, qr[d0], p1, 0, 0, 0); } }
}
typedef __attribute__((address_space(3))) const char* lds_cptr;
typedef short v4i16_t __attribute__((ext_vector_type(4)));
__device__ __forceinline__ void kload8(bf16x8* kf, lds_cptr kp) {
    kf[0] = *(const __attribute__((address_space(3))) bf16x8*)(kp);        kf[1] = *(const __attribute__((address_space(3))) bf16x8*)(kp + 512);
    kf[2] = *(const __attribute__((address_space(3))) bf16x8*)(kp + 2048); kf[3] = *(const __attribute__((address_space(3))) bf16x8*)(kp + 2560);
    kf[4] = *(const __attribute__((address_space(3))) bf16x8*)(kp + 4096); kf[5] = *(const __attribute__((address_space(3))) bf16x8*)(kp + 4608);
    kf[6] = *(const __attribute__((address_space(3))) bf16x8*)(kp + 6144); kf[7] = *(const __attribute__((address_space(3))) bf16x8*)(kp + 6656);
}
__device__ __forceinline__ void kload2(bf16x8* kf, lds_cptr kp, int j) { kf[2 * j] = *(const __attribute__((address_space(3))) bf16x8*)(kp + j * 2048); kf[2 * j + 1] = *(const __attribute__((address_space(3))) bf16x8*)(kp + j * 2048 + 512); }
__device__ __forceinline__ s16x4 vtr(lds_cptr p) { return __builtin_bit_cast(s16x4, __builtin_amdgcn_ds_read_tr16_b64_v4i16((__attribute__((address_space(3))) v4i16_t*)p)); }
__device__ __forceinline__ float rowmax(const f32x16& p0, const f32x16& p1) {
    float a = max3f(p0[0], p0[1], p1[0]), b = max3f(p0[2], p0[3], p1[1]); a = max3f(a, p1[2], p1[3]);
#pragma unroll
    for (int r = 4; r < 16; r += 4) { a = max3f(a, p0[r], p0[r + 1]); b = max3f(b, p0[r + 2], p0[r + 3]); a = max3f(a, p1[r], p1[r + 1]); b = max3f(b, p1[r + 2], p1[r + 3]); }
    const float m = max2f(a, b);
    auto rr = __builtin_amdgcn_permlane32_swap(__float_as_uint(m), __float_as_uint(m), false, false);
    return max2f(__uint_as_float(rr[0]), __uint_as_float(rr[1]));
}
__device__ __forceinline__ void pv(f32x16* o, int vb, bf16x8 pa0, bf16x8 pa1, bf16x8 pa2, bf16x8 pa3) {
#pragma unroll
    for (int d0 = 0; d0 < 2; ++d0) { s16x4 lo[4], hi[4];
#pragma unroll
        for (int ks = 0; ks < 4; ++ks) {
            asm volatile("ds_read_b64_tr_b16 %0,%1 offset:%c2" : "=&v"(lo[ks]) : "v"(vb), "i"(d0 * 4096 + ks * 1024) : "memory");
            asm volatile("ds_read_b64_tr_b16 %0,%1 offset:%c2" : "=&v"(hi[ks]) : "v"(vb), "i"(d0 * 4096 + ks * 1024 + 512) : "memory"); }
        asm volatile("s_waitcnt lgkmcnt(0)" ::: "memory"); SBAR();
#define PK(k) (bf16x8){lo[k][0], lo[k][1], lo[k][2], lo[k][3], hi[k][0], hi[k][1], hi[k][2], hi[k][3]}
        o[d0] = __builtin_amdgcn_mfma_f32_32x32x16_bf16(pa0, PK(0), o[d0], 0, 0, 0);
        o[d0] = __builtin_amdgcn_mfma_f32_32x32x16_bf16(pa1, PK(1), o[d0], 0, 0, 0);
        o[d0] = __builtin_amdgcn_mfma_f32_32x32x16_bf16(pa2, PK(2), o[d0], 0, 0, 0);
        o[d0] = __builtin_amdgcn_mfma_f32_32x32x16_bf16(pa3, PK(3), o[d0], 0, 0, 0);
#undef PK
    }
}
template <int THRL> __device__ __forceinline__ void attn_unit(int b, int h, int qb, const bf16* Q, const bf16* __restrict__ K, const bf16* __restrict__ V, bf16* O, char* shm, float negM_) {
    const int tid = threadIdx.x, lane = tid & 63, r32 = lane & 31, hi = lane >> 5; const int wid = __builtin_amdgcn_readfirstlane(tid >> 6);
    const int q0 = qb * QB; const int kvh = h / 3;
    const long qrow0 = (long)b * SEQ + q0 + wid * QBLK;
    const long kvrow0 = (long)b * LKV;
    const bf16* Qw = Q + qrow0 * DMQ + h * D;
    const bf16* Kh = K + kvrow0 * DMKV + kvh * D, *Vh = V + kvrow0 * DMKV + kvh * D;
    const unsigned lds0 = (unsigned)(uintptr_t)shm;
    float* wsf = (float*)(shm + LDS_WS) + wid * 64;
    const bf16* ksrc = Kh + (long)lane * DMKV + wid * 8;
    const bf16* vsrc = Vh + (long)(16 * (wid & 3) + (lane >> 2)) * DMKV + (wid >> 2) * 32 + (lane & 3) * 8;
    const unsigned kdst = lds0 + LDS_K + wid * 1024, vdst = lds0 + LDS_V + wid * 1024;
#define DMA_K(t, slot) glds16(ksrc + (long)(t) * KVBLK * DMKV, (unsigned)__builtin_amdgcn_readfirstlane(kdst + (slot)))
#define DMA_V(t, slot) glds16(vsrc + (long)(t) * KVBLK * DMKV, (unsigned)__builtin_amdgcn_readfirstlane(vdst + (slot)))
    const int vb0 = (int)(lds0 + LDS_V) + ((lane >> 4) & 1) * 32 + (lane & 3) * 8 + (4 * hi + ((lane & 15) >> 2)) * 64;
    const char* Kbase = shm + LDS_K; bf16x8 kf[8];
    const lds_cptr shm3 = (lds_cptr)shm; const lds_cptr kp0 = shm3 + LDS_K + hi * 1024 + r32 * 16; const lds_cptr vp0 = shm3 + LDS_V + ((lane >> 4) & 1) * 32 + (lane & 3) * 8 + (4 * hi + ((lane & 15) >> 2)) * 64;
    DMA_K(0, 0); DMA_V(0, 0); DMA_K(1, SLOTB);
    bf16x8 qr[4];
#pragma unroll
    for (int d0 = 0; d0 < 4; ++d0) qr[d0] = *reinterpret_cast<const bf16x8*>(&Qw[(long)r32 * DMQ + d0 * 16 + hi * 8]);
    float l_reg = 0.f; f32x16 o[2]; o[0] = f32x16{}; o[1] = f32x16{}; f32x16 negm;
    _Pragma("unroll") for (int r = 0; r < 16; ++r) negm[r] = negM_;
    asm volatile("" : "+v"(negm));
#define START(P0, P1) do { _Pragma("unroll") for (int r = 0; r < 16; ++r) P0[r] = __builtin_amdgcn_exp2f(P0[r]); } while (0)
#define RESC() do { } while (0)
    f32x16 pA0, pA1, pB0, pB1;
    int sl_prev = 0, sl_cur = 0, sl_next = SLOTB;
#define ROT() do { sl_prev = sl_cur; sl_cur = sl_next; sl_next = (sl_next == (NSLOTR - 1) * SLOTB) ? 0 : sl_next + SLOTB; } while (0)
    DMA_K(2, 2 * SLOTB);
    WAIT_BAR(3);
    qkt(pA0, pA1, Kbase, qr, negm, r32, hi); asm volatile("s_nop 15\n\ts_nop 7" : "+v"(pA0), "+v"(pA1));
    START(pA0, pA1);
    _Pragma("unroll") for (int r = 0; r < 16; ++r) pA1[r] = __builtin_amdgcn_exp2f(pA1[r]);
    WAIT_BAR(0);
    DMA_K(3, 0); DMA_V(1, SLOTB);
    ROT();
    kload8(kf, kp0 + sl_cur);
    WAIT_BAR(2);
    s16x4 vlo[8], vhi[8]; u32x4 pw0, pw1, pw2, pw3;
#define PKW(P, B) cvtpk_s(P[B], P[B + 1])
#define PAF(k) __builtin_bit_cast(bf16x8, pw##k)
#define VFR(i) (bf16x8){vlo[i][0], vlo[i][1], vlo[i][2], vlo[i][3], vhi[i][0], vhi[i][1], vhi[i][2], vhi[i][3]}
#define PIN(x) asm volatile("" : "+v"(x))
#define MX3(a, b, c) __builtin_fmaxf(__builtin_fmaxf((a), (b)), (c))
#define GAPA(MF, A0, A1, A2, A3, W0, W1, PW) do { MF; sacc += A0; sacc += A1; sacc += A2; sacc += A3; PIN(sacc); W0; W1; PIN(PW); SBAR(); } while (0)
#define EX(v) __builtin_amdgcn_exp2f(v)
#define GAPB(MF, X, B) do { MF; X[B] = EX(X[B]); X[B + 1] = EX(X[B + 1]); X[B + 2] = EX(X[B + 2]); X[B + 3] = EX(X[B + 3]); PIN(X); SBAR(); } while (0)
#define VRD(i) do { vlo[i] = vtr(vp_ + (((i) >> 2) * 4096 + ((i) & 3) * 1024)); vhi[i] = vtr(vp_ + (((i) >> 2) * 4096 + ((i) & 3) * 1024 + 512)); } while (0)
#define KRD(G, j) do { if (G) { kload2(kf, kp0 + sl_next, j); SBAR(); } } while (0)
#define STEP(C0, C1, P0, P1, t, GK, GV, GL) do { SBAR(); \
    const lds_cptr vp_ = vp0 + sl_prev; \
    VRD(0); SBAR(); float sacc = (P0[0] + P0[1]); \
    GAPA(C0 = __builtin_amdgcn_mfma_f32_32x32x16_bf16(kf[0], qr[0], negm, 0, 0, 0), P0[2], P0[3], P0[4], P0[5],     pw0[0] = PKW(P0, 0), pw0[1] = PKW(P0, 2), pw0); \
    VRD(4); SBAR(); GAPA(C1 = __builtin_amdgcn_mfma_f32_32x32x16_bf16(kf[1], qr[0], negm, 0, 0, 0), P0[6], P0[7], P0[8], P0[9],     pw0[2] = PKW(P0, 4), pw0[3] = PKW(P0, 6), pw0); \
    VRD(1); SBAR(); GAPA(C0 = __builtin_amdgcn_mfma_f32_32x32x16_bf16(kf[2], qr[1], C0, 0, 0, 0),   P0[10], P0[11], P0[12], P0[13], pw1[0] = PKW(P0, 8), pw1[1] = PKW(P0, 10), pw1); \
    VRD(5); SBAR(); GAPA(C1 = __builtin_amdgcn_mfma_f32_32x32x16_bf16(kf[3], qr[1], C1, 0, 0, 0),   P0[14], P0[15], P1[0], P1[1],   pw1[2] = PKW(P0, 12), pw1[3] = PKW(P0, 14), pw1); \
    VRD(2); SBAR(); GAPA(C0 = __builtin_amdgcn_mfma_f32_32x32x16_bf16(kf[4], qr[2], C0, 0, 0, 0),   P1[2], P1[3], P1[4], P1[5],     pw2[0] = PKW(P1, 0), pw2[1] = PKW(P1, 2), pw2); \
    VRD(6); SBAR(); GAPA(C1 = __builtin_amdgcn_mfma_f32_32x32x16_bf16(kf[5], qr[2], C1, 0, 0, 0),   P1[6], P1[7], P1[8], P1[9],     pw2[2] = PKW(P1, 4), pw2[3] = PKW(P1, 6), pw2); \
    VRD(3); SBAR(); GAPA(C0 = __builtin_amdgcn_mfma_f32_32x32x16_bf16(kf[6], qr[3], C0, 0, 0, 0),   P1[10], P1[11], P1[12], P1[13], pw3[0] = PKW(P1, 8), pw3[1] = PKW(P1, 10), pw3); \
    VRD(7); SBAR(); GAPA(C1 = __builtin_amdgcn_mfma_f32_32x32x16_bf16(kf[7], qr[3], C1, 0, 0, 0),   P1[14], P1[15], 0.f, 0.f,       pw3[2] = PKW(P1, 12), pw3[3] = PKW(P1, 14), pw3); \
    l_reg += sacc; \
    if (GK) { DMA_K((t) + 3, sl_cur); } if (GV) { DMA_V((t) + 1, sl_next); } \
    SBAR(); \
    GAPB(o[0] = __builtin_amdgcn_mfma_f32_32x32x16_bf16(PAF(0), VFR(0), o[0], 0, 0, 0), C0, 0); \
    GAPB(o[1] = __builtin_amdgcn_mfma_f32_32x32x16_bf16(PAF(0), VFR(4), o[1], 0, 0, 0), C0, 4); \
    KRD(GL, 0); GAPB(o[0] = __builtin_amdgcn_mfma_f32_32x32x16_bf16(PAF(1), VFR(1), o[0], 0, 0, 0), C0, 8); \
    KRD(GL, 1); GAPB(o[1] = __builtin_amdgcn_mfma_f32_32x32x16_bf16(PAF(1), VFR(5), o[1], 0, 0, 0), C0, 12); \
    KRD(GL, 2); GAPB(o[0] = __builtin_amdgcn_mfma_f32_32x32x16_bf16(PAF(2), VFR(2), o[0], 0, 0, 0), C1, 0); \
    KRD(GL, 3); GAPB(o[1] = __builtin_amdgcn_mfma_f32_32x32x16_bf16(PAF(2), VFR(6), o[1], 0, 0, 0), C1, 4); \
    GAPB(o[0] = __builtin_amdgcn_mfma_f32_32x32x16_bf16(PAF(3), VFR(3), o[0], 0, 0, 0), C1, 8); \
    GAPB(o[1] = __builtin_amdgcn_mfma_f32_32x32x16_bf16(PAF(3), VFR(7), o[1], 0, 0, 0), C1, 12); \
    } while (0)
    int t = 1;
    for (; t + 5 < NT; t += 2) {
        STEP(pB0, pB1, pA0, pA1, t, true, true, true);     WAIT_BAR(2); RESC(); ROT();
        STEP(pA0, pA1, pB0, pB1, t + 1, true, true, true); WAIT_BAR(2); RESC(); ROT();
    }
#define ENDW(tt) do { if ((tt) + 3 < NT) { WAIT_BAR(2); } else if ((tt) + 2 < NT) { WAIT_BAR(1); } else { WAIT_BAR(0); } } while (0)
    for (; t + 1 < NT; t += 2) {
        STEP(pB0, pB1, pA0, pA1, t, (t + 3 < NT), (t + 1 < NT), (t + 1 < NT));         ENDW(t);     RESC(); ROT();
        STEP(pA0, pA1, pB0, pB1, t + 1, (t + 4 < NT), (t + 2 < NT), (t + 2 < NT));     ENDW(t + 1); RESC(); ROT();
    }
    STEP(pB0, pB1, pA0, pA1, NT - 1, false, false, false); RESC();
    { float sacc = pB0[0] + pB0[1]; _Pragma("unroll") for (int r = 2; r < 16; ++r) sacc += pB0[r]; _Pragma("unroll") for (int r = 0; r < 16; ++r) sacc += pB1[r]; l_reg += sacc;
      pw0 = (u32x4){PKW(pB0, 0), PKW(pB0, 2), PKW(pB0, 4), PKW(pB0, 6)}; pw1 = (u32x4){PKW(pB0, 8), PKW(pB0, 10), PKW(pB0, 12), PKW(pB0, 14)}; pw2 = (u32x4){PKW(pB1, 0), PKW(pB1, 2), PKW(pB1, 4), PKW(pB1, 6)}; pw3 = (u32x4){PKW(pB1, 8), PKW(pB1, 10), PKW(pB1, 12), PKW(pB1, 14)};
      SBAR(); pv(o, vb0 + sl_cur, PAF(0), PAF(1), PAF(2), PAF(3)); }
#undef PKW
#undef PAF
#undef VFR
#undef PIN
#undef MX3
#undef GAPA
#undef GAPB
#undef EX
#undef VRD
#undef KRD
#undef STEP
#undef ENDW
    { auto rr = __builtin_amdgcn_permlane32_swap(__float_as_uint(l_reg), __float_as_uint(l_reg), false, false); l_reg = __uint_as_float(rr[0]) + __uint_as_float(rr[1]); }
    if (hi == 0) wsf[32 + r32] = l_reg; asm volatile("s_waitcnt lgkmcnt(0)" ::: "memory");
    float rli[16];
#pragma unroll
    for (int r = 0; r < 16; ++r) rli[r] = __builtin_amdgcn_rcpf(wsf[32 + crow(r, hi)]);
    bf16* Ow = O + qrow0 * DMO + h * D;
    { bf16* stg = (bf16*)(shm + LDS_OST) + wid * 2048;
#pragma unroll
      for (int r = 0; r < 16; ++r) { const int orow = crow(r, hi);
#pragma unroll
        for (int d0 = 0; d0 < 2; ++d0) stg[orow * 64 + d0 * 32 + r32] = __float2bfloat16(o[d0][r] * rli[r]); }
      asm volatile("s_waitcnt lgkmcnt(0)" ::: "memory");
#pragma unroll
      for (int i = 0; i < 4; ++i) { const int row = i * 8 + (lane >> 3), ch = lane & 7; const u32x4 v = *(const u32x4*)(stg + row * 64 + ch * 8); *(u32x4*)(Ow + (long)row * DMO + ch * 8) = v; } }
    asm volatile("s_waitcnt lgkmcnt(0)\n\ts_barrier" ::: "memory");
#undef DMA_K
#undef DMA_V
#undef START
#undef RESC
#undef ROT
}
#undef SBAR
#undef WAIT_BAR
}

#define XB_TMO      128
#define XB_XCNT(j)  (256  + 64 * (j))
#define XB_XSUB(j)  (1280 + 64 * (j))
#define XB_XGEN(j)  (2304 + 64 * (j))
#define XB_TOP      3328
#define XB_TOPGEN   3392
#define XCD_BAR_WORDS 3456
#define XB_SPIN_CAP (1u << 18)
__device__ __forceinline__ unsigned xb_ld(unsigned* p)              { return __hip_atomic_load(p, __ATOMIC_RELAXED, __HIP_MEMORY_SCOPE_AGENT); }
__device__ __forceinline__ unsigned xb_add(unsigned* p, unsigned v) { return __hip_atomic_fetch_add(p, v, __ATOMIC_RELAXED, __HIP_MEMORY_SCOPE_AGENT); }
__device__ __forceinline__ unsigned xb_xcc_id() { return (unsigned)__builtin_amdgcn_s_getreg((3 << 11) | 20) & 0xFu; }
#define XB_SPIN(cond, bar) do { unsigned _sp = 0; while (cond) { __builtin_amdgcn_s_sleep(1); \
    if ((++_sp & 255u) == 0u) { if (xb_ld(&(bar)[XB_TMO])) break; if (_sp > XB_SPIN_CAP) { atomicAdd(&(bar)[XB_TMO], 1u); break; } } } } while (0)
struct XcdBarrier { unsigned* bar; unsigned x; volatile LAS unsigned* st; };
__device__ __forceinline__ XcdBarrier xcd_barrier_post(unsigned* bar, volatile LAS unsigned* st) {
    XcdBarrier b; b.bar = bar; b.x = xb_xcc_id(); b.st = st;
    if (threadIdx.x == 0) (void)xb_add(&bar[XB_XCNT(b.x)], 1u);
    return b;
}
__device__ __forceinline__ void xcd_barrier_complete(unsigned* bar, unsigned x, unsigned& nloc, unsigned& nx) {
    const unsigned G = gridDim.x * gridDim.y * gridDim.z;
    unsigned sum, cnt, mine, sp = 0u;
    for (;;) {
        sum = 0u; cnt = 0u; mine = 0u;
#pragma unroll
        for (unsigned j = 0; j < 16; ++j) { const unsigned c = xb_ld(&bar[XB_XCNT(j)]); sum += c; cnt += (c > 0u) ? 1u : 0u; mine = (j == x) ? c : mine; }
        if (sum == G) break;
        __builtin_amdgcn_s_sleep(1);
        if ((++sp & 255u) == 0u) { if (xb_ld(&bar[XB_TMO])) break; if (sp > XB_SPIN_CAP) { atomicAdd(&bar[XB_TMO], 1u); break; } }
    }
    nloc = mine > 0u ? mine : 1u; nx = cnt > 0u ? cnt : 1u;
}
__device__ __forceinline__ void xcd_barrier(const XcdBarrier& b) {
    asm volatile("s_waitcnt vmcnt(0)" ::: "memory");
    __syncthreads();
    if (threadIdx.x == 0) {
        unsigned* bar = b.bar;
        __builtin_amdgcn_s_waitcnt(0);
        unsigned nloc = b.st[0], nx = b.st[1];
        if (nloc == 0u) { xcd_barrier_complete(bar, b.x, nloc, nx); b.st[0] = nloc; b.st[1] = nx; }
        const unsigned old = xb_add(&bar[XB_XSUB(b.x)], 1u);
        const unsigned gen = old / nloc;
        if (old + 1u == (gen + 1u) * nloc) {
            __builtin_amdgcn_fence(__ATOMIC_RELEASE, "agent");
            asm volatile("s_waitcnt vmcnt(0)" ::: "memory");
            const unsigned og = xb_add(&bar[XB_TOP], 1u);
            const unsigned tg = og / nx;
            if (og + 1u == (tg + 1u) * nx) xb_add(&bar[XB_TOPGEN], 1u);
            else XB_SPIN(xb_ld(&bar[XB_TOPGEN]) == tg, bar);
            __builtin_amdgcn_fence(__ATOMIC_ACQUIRE, "agent");
            xb_add(&bar[XB_XGEN(b.x)], 1u);
            asm volatile("s_waitcnt vmcnt(0)" ::: "memory");
        } else {
            XB_SPIN(xb_ld(&bar[XB_XGEN(b.x)]) == gen, bar);
            __builtin_amdgcn_fence(__ATOMIC_ACQUIRE, "agent");
            asm volatile("s_waitcnt vmcnt(0)" ::: "memory");
        }
    }
    __syncthreads();
}

struct Frame {
    LAS unsigned char* lds;
    volatile LAS unsigned* MISC;
    gu32* ctl;
    int tid, lane, wave;
    int vcu, G;
    const float *x, *c, *ctx, *c_ctx, *norm1_g, *w_ada, *b_ada, *w_in, *w_fourier, *q_norm_g, *k_norm_g, *w_out, *norm2_g, *w_router, *router_bias, *w_egu, *w_ed, *w_sgu, *w_sd, *final_g;
    float* out;
    unsigned char* ws;
};
#define WSP(T, off) ((T*)(F.ws + (off)))

struct DenseOrder {
    static constexpr bool GATHER = false;
    int nN, nmain, nextra, G, c; const char* Bt; int K; int reps;
    __device__ __forceinline__ bool next(int i, pg8::GUnit& u) const {
        const int ntot = nmain + nextra, nc = (ntot - c + G - 1) / G; if (i >= nc * reps) return false;
        const int L = (i % nc) * G + c;
        if (L < nmain) { const int nig = 8 * nN, gid = L / nig, r = L % nig; u.pm = gid * 8 + (r & 7); u.pn = r >> 3; }
        else { const int jx = L - nmain; u.pm = 128 + (jx & 3); u.pn = 5 + (jx >> 2); }
        u.e = 0; u.j = 0; u.nvalid = 256; u.B = Bt + (size_t)u.pn * 256 * K * 2; return true;
    }
    __device__ __forceinline__ int arow(const pg8::GUnit& u, int r) const { return u.pm * 256 + r; }
};
template <bool GATHER_> struct GroupedOrder {
    static constexpr bool GATHER = GATHER_;
    int NPN, G, c, nbrows, K; bool gather; const char* Bt; const LAS int* TS; const LAS int* CN; const GAS u32x2* LIST; int reps; int total;
    __device__ __forceinline__ bool next(int i, pg8::GUnit& u) const {
        const int ntot = total * NPN, nc = (ntot - c + G - 1) / G; if (i >= nc * reps) return false;
        const int L = (i % nc) * G + c; const int T = L / NPN;
        int lo = 0, hi = 257;
        while (hi - lo > 1) { const int mid = (lo + hi) >> 1; if (TS[mid] <= T) lo = mid; else hi = mid; }
        lo = __builtin_amdgcn_readfirstlane(lo);
        const int ts = __builtin_amdgcn_readfirstlane(TS[lo]), cn = __builtin_amdgcn_readfirstlane(CN[lo]);
        u.pm = T; u.pn = L - T * NPN; u.e = lo; u.j = T - ts; const int rem = cn - 256 * u.j; u.nvalid = rem < 256 ? rem : 256;
        u.B = Bt + ((size_t)lo * nbrows + (size_t)u.pn * 256) * K * 2; return true;
    }
    __device__ __forceinline__ int arow(const pg8::GUnit& u, int r) const {
        if (!gather) return u.pm * 256 + r;
        int pos = 256 * u.j + r; if (r >= u.nvalid) pos = 0;
        const u32x2 en = LIST[(size_t)u.e * NTOK + pos];
        return (int)(en.x & 0xffffu);
    }
};

struct EpiInProj {
    static constexpr bool PERM = true;
    u16 *Z, *Q, *Kb, *Vb; const float *COS, *SIN, *gq, *gk;
    __device__ __forceinline__ void operator()(const f32x4 (&acc)[2][2][4][2], const pg8::GUnit& u, int wr, int wc, int fr, int fq) const {
        const int pn = u.pn; const bool is_ctx = u.pm >= 128;
        float gn[2][2][4];
        if (pn >= 2 && pn < 6) { const float* gsrc = (pn == 5) ? gk : gq;
#pragma unroll
            for (int bj = 0; bj < 2; ++bj)
#pragma unroll
                for (int n = 0; n < 2; ++n) { const f32x4 g4 = *(const f32x4*)(gsrc + 32 * bj + 16 * n + 4 * fq); gn[bj][n][0] = g4[0]; gn[bj][n][1] = g4[1]; gn[bj][n][2] = g4[2]; gn[bj][n][3] = g4[3]; } }
#pragma unroll
        for (int ai = 0; ai < 2; ++ai)
#pragma unroll
            for (int m = 0; m < 4; ++m) {
                const int row = u.pm * 256 + ai * 128 + wr * 64 + m * 16 + fr;
                int b, l, key;
                if (!is_ctx) { b = row >> 13; l = row & 8191; key = l; } else { const int rc = row - NTOK; b = rc >> 8; l = 0; key = SEQ + (rc & 255); }
                if (pn < 2) {
#pragma unroll
                    for (int bj = 0; bj < 2; ++bj) { const int g = 32 * pn + 16 * bj + 4 * wc + fq; const f32x4 v0 = acc[ai][bj][m][0], v1 = acc[ai][bj][m][1];
                        u32x4 w; w.x = cvt_pk_bf16(v0[0], v0[1]); w.y = cvt_pk_bf16(v0[2], v0[3]); w.z = cvt_pk_bf16(v1[0], v1[1]); w.w = cvt_pk_bf16(v1[2], v1[3]);
                        *(u32x4*)(Z + (((size_t)(b * 64 + g) * SEQ + l) * 8)) = w; }
                } else if (pn < 6) {
                    float ss = 0.f;
#pragma unroll
                    for (int bj = 0; bj < 2; ++bj)
#pragma unroll
                        for (int n = 0; n < 2; ++n) { const f32x4 v = acc[ai][bj][m][n]; ss += (v[0] * v[0] + v[1] * v[1]) + (v[2] * v[2] + v[3] * v[3]); }
                    ss += __shfl_xor(ss, 16); ss += __shfl_xor(ss, 32);
                    const float rstd = 1.0f / sqrtf(ss * (1.0f / 64.0f) + RMS_EPS);
                    const float osc = (pn == 5) ? 1.0f : C2;
#pragma unroll
                    for (int bj = 0; bj < 2; ++bj) {
                        const int pidx = (bj == 0) ? (l >> 6) : (l & 63);
                        f32x4 cs = *(const f32x4*)(COS + pidx * 16 + 4 * fq), sn = *(const f32x4*)(SIN + pidx * 16 + 4 * fq);
                        if (is_ctx) { cs = (f32x4){1.f, 1.f, 1.f, 1.f}; sn = (f32x4){0.f, 0.f, 0.f, 0.f}; }
                        float oa[4], ob[4];
#pragma unroll
                        for (int e = 0; e < 4; ++e) { const float a = acc[ai][bj][m][0][e] * rstd * gn[bj][0][e], bb = acc[ai][bj][m][1][e] * rstd * gn[bj][1][e];
                            oa[e] = (a * cs[e] - bb * sn[e]) * osc; ob[e] = (bb * cs[e] + a * sn[e]) * osc; }
                        u32x4 w; w.x = cvt_pk_bf16(oa[0], oa[1]); w.y = cvt_pk_bf16(oa[2], oa[3]); w.z = cvt_pk_bf16(ob[0], ob[1]); w.w = cvt_pk_bf16(ob[2], ob[3]);
                        if (pn < 5) { const int head = 4 * (pn - 2) + wc; *(u32x4*)(Q + ((size_t)row * QW + head * 64 + 32 * bj + 8 * fq)) = w; }
                        else *(u32x4*)(Kb + (((size_t)b * LKV + key) * KVW + wc * 64 + 32 * bj + 8 * fq)) = w;
                    }
                } else {
#pragma unroll
                    for (int bj = 0; bj < 2; ++bj) { const f32x4 v0 = acc[ai][bj][m][0], v1 = acc[ai][bj][m][1];
                        u32x4 w; w.x = cvt_pk_bf16(v0[0], v0[1]); w.y = cvt_pk_bf16(v0[2], v0[3]); w.z = cvt_pk_bf16(v1[0], v1[1]); w.w = cvt_pk_bf16(v1[2], v1[3]);
                        *(u32x4*)(Vb + (((size_t)b * LKV + key) * KVW + 128 * bj + 32 * wc + 8 * fq)) = w; }
                }
            }
    }
};
struct EpiResid {
    static constexpr bool PERM = false;
    const float* x; float* X1; const gi64* MOD;
    __device__ __forceinline__ void operator()(const f32x4 (&acc)[2][2][4][2], const pg8::GUnit& u, int wr, int wc, int fr, int fq) const {
        const int row0 = u.pm * 256 + wr * 64 + fr, col0 = u.pn * 256 + wc * 32 + 4 * fq; const int b = (u.pm * 256) >> 13;
        f32x4 gv[2][2];
#pragma unroll
        for (int bj = 0; bj < 2; ++bj)
#pragma unroll
            for (int n = 0; n < 2; ++n) gv[bj][n] = mod4(MOD, b * 6144 + 2048 + col0 + bj * 128 + n * 16);
#pragma unroll
        for (int ai = 0; ai < 2; ++ai)
#pragma unroll
            for (int m = 0; m < 4; ++m) { const size_t off = (size_t)(row0 + ai * 128 + m * 16) * DM + col0;
#pragma unroll
                for (int bj = 0; bj < 2; ++bj)
#pragma unroll
                    for (int n = 0; n < 2; ++n) { const f32x4 xv = *(const f32x4*)(x + off + bj * 128 + n * 16); *(f32x4*)(X1 + off + bj * 128 + n * 16) = (DBG & 2) ? xv : xv + gv[bj][n] * acc[ai][bj][m][n]; } }
    }
};
struct EpiLogits {
    static constexpr bool PERM = false;
    float* C;
    __device__ __forceinline__ void operator()(const f32x4 (&acc)[2][2][4][2], const pg8::GUnit& u, int wr, int wc, int fr, int fq) const {
        const int row0 = u.pm * 256 + wr * 64 + fr, col0 = wc * 32 + 4 * fq;
#pragma unroll
        for (int ai = 0; ai < 2; ++ai)
#pragma unroll
            for (int m = 0; m < 4; ++m) { float* rowp = C + (size_t)(row0 + ai * 128 + m * 16) * NEXP + col0;
#pragma unroll
                for (int bj = 0; bj < 2; ++bj)
#pragma unroll
                    for (int n = 0; n < 2; ++n) *(f32x4*)(rowp + bj * 128 + n * 16) = acc[ai][bj][m][n]; }
    }
};
struct EpiSwiglu {
    static constexpr bool PERM = true;
    u16* ACT;
    __device__ __forceinline__ void operator()(const f32x4 (&acc)[2][2][4][2], const pg8::GUnit& u, int wr, int wc, int fr, int fq) const {
#pragma unroll
        for (int ai = 0; ai < 2; ++ai)
#pragma unroll
            for (int m = 0; m < 4; ++m) { const int r = ai * 128 + wr * 64 + m * 16 + fr; u16* rowp = ACT + ((size_t)u.pm * 256 + r) * EFF + 128 * u.pn + 16 * wc + 4 * fq;
#pragma unroll
                for (int bj = 0; bj < 2; ++bj) { const f32x4 a = acc[ai][bj][m][0], g = acc[ai][bj][m][1]; float o[4];
#pragma unroll
                    for (int e = 0; e < 4; ++e) o[e] = a[e] * g[e] / (1.0f + __expf(-a[e]));
                    u32x2 w; if (MOEF16) { w.x = pk2h(o[0], o[1]); w.y = pk2h(o[2], o[3]); } else { w.x = pk2bf(o[0], o[1]); w.y = pk2bf(o[2], o[3]); } *(u32x2*)(rowp + 64 * bj) = w; } }
    }
};
struct EpiDown {
    static constexpr bool PERM = true;
    u16* Cc; const GAS u32x2* LIST;
    __device__ __forceinline__ void operator()(const f32x4 (&acc)[2][2][4][2], const pg8::GUnit& u, int wr, int wc, int fr, int fq) const {
        f32x2 ens[2][4];
#pragma unroll
        for (int ai = 0; ai < 2; ++ai)
#pragma unroll
            for (int m = 0; m < 4; ++m) { const int r = ai * 128 + wr * 64 + m * 16 + fr; ens[ai][m] = *(const GAS f32x2*)(LIST + (size_t)u.e * NTOK + (r < u.nvalid ? 256 * u.j + r : 0)); }
#pragma unroll
        for (int ai = 0; ai < 2; ++ai)
#pragma unroll
            for (int m = 0; m < 4; ++m) { const int r = ai * 128 + wr * 64 + m * 16 + fr;
                if (r < u.nvalid) { const f32x2 enf = ens[ai][m];
                    const unsigned ex = __builtin_bit_cast(unsigned, enf.x); const int tok = (int)(ex & 0xffffu), slot = (int)(ex >> 16); const float gate = enf.y;
                    unsigned char* rowp = (unsigned char*)Cc + ((size_t)tok * NSLOT + slot) * DM + 256 * u.pn + 32 * wc + 8 * fq;
                    const float gs = gate * C_SCALE;
#pragma unroll
                    for (int bj = 0; bj < 2; ++bj) { f32x4 v0 = acc[ai][bj][m][0] * gs, v1 = acc[ai][bj][m][1] * gs;
#pragma unroll
                        for (int e = 0; e < 4; ++e) { v0[e] = __builtin_amdgcn_fmed3f(v0[e], -440.f, 440.f); v1[e] = __builtin_amdgcn_fmed3f(v1[e], -440.f, 440.f); }
                        int w0 = __builtin_amdgcn_cvt_pk_fp8_f32(v0[0], v0[1], 0, false); w0 = __builtin_amdgcn_cvt_pk_fp8_f32(v0[2], v0[3], w0, true);
                        int w1 = __builtin_amdgcn_cvt_pk_fp8_f32(v1[0], v1[1], 0, false); w1 = __builtin_amdgcn_cvt_pk_fp8_f32(v1[2], v1[3], w1, true);
                        *(u32x2*)(rowp + 128 * bj) = (u32x2){(unsigned)w0, (unsigned)w1}; } } }
    }
};

template <bool F16OUT> __device__ __forceinline__ void rownorm_rows(const GAS float* src, const float* gain, const gi64* MODsh, const gi64* MODsc, u16* dst, int row0, int nrows, int wi, int wstride, int lane) {
    f32x4 Av[2][2], Bv[2][2];
#pragma unroll
    for (int j = 0; j < 2; ++j)
#pragma unroll
        for (int h = 0; h < 2; ++h) { const int col = 8 * lane + 512 * j + 4 * h; Av[j][h] = *(const f32x4*)(gain + col) * (mod4(MODsc, col) + 1.0f); Bv[j][h] = mod4(MODsh, col); }
    for (int r = wi; r < nrows; r += 2 * wstride) {
        const int r1 = r + wstride; const bool has1 = r1 < nrows;
        const GAS float* s0 = src + (size_t)(row0 + r) * DM; const GAS float* s1 = src + (size_t)(row0 + (has1 ? r1 : r)) * DM;
        f32x4 v0[2][2], v1[2][2];
#pragma unroll
        for (int j = 0; j < 2; ++j)
#pragma unroll
            for (int h = 0; h < 2; ++h) { v0[j][h] = *(const GAS f32x4*)(s0 + 8 * lane + 512 * j + 4 * h); v1[j][h] = *(const GAS f32x4*)(s1 + 8 * lane + 512 * j + 4 * h); }
        float q0 = 0.f, q1 = 0.f;
#pragma unroll
        for (int j = 0; j < 2; ++j)
#pragma unroll
            for (int h = 0; h < 2; ++h) { const f32x4 a = v0[j][h], b = v1[j][h]; q0 += (a[0] * a[0] + a[1] * a[1]) + (a[2] * a[2] + a[3] * a[3]); q1 += (b[0] * b[0] + b[1] * b[1]) + (b[2] * b[2] + b[3] * b[3]); }
#pragma unroll
        for (int o = 1; o < 64; o <<= 1) { q0 += __shfl_xor(q0, o); q1 += __shfl_xor(q1, o); }
        const float rs0 = 1.0f / sqrtf(q0 * (1.0f / DM) + RMS_EPS), rs1 = 1.0f / sqrtf(q1 * (1.0f / DM) + RMS_EPS);
#pragma unroll
        for (int j = 0; j < 2; ++j) { const f32x4 ya = v0[j][0] * rs0 * Av[j][0] + Bv[j][0], yb = v0[j][1] * rs0 * Av[j][1] + Bv[j][1];
            u32x4 w; if (F16OUT) { w.x = pk2h(ya[0], ya[1]); w.y = pk2h(ya[2], ya[3]); w.z = pk2h(yb[0], yb[1]); w.w = pk2h(yb[2], yb[3]); } else { w.x = pk2bf(ya[0], ya[1]); w.y = pk2bf(ya[2], ya[3]); w.z = pk2bf(yb[0], yb[1]); w.w = pk2bf(yb[2], yb[3]); }
            *(GAS u32x4*)(dst + (size_t)(row0 + r) * DM + 8 * lane + 512 * j) = w; }
        if (has1) {
#pragma unroll
            for (int j = 0; j < 2; ++j) { const f32x4 ya = v1[j][0] * rs1 * Av[j][0] + Bv[j][0], yb = v1[j][1] * rs1 * Av[j][1] + Bv[j][1];
                u32x4 w; if (F16OUT) { w.x = pk2h(ya[0], ya[1]); w.y = pk2h(ya[2], ya[3]); w.z = pk2h(yb[0], yb[1]); w.w = pk2h(yb[2], yb[3]); } else { w.x = pk2bf(ya[0], ya[1]); w.y = pk2bf(ya[2], ya[3]); w.z = pk2bf(yb[0], yb[1]); w.w = pk2bf(yb[2], yb[3]); }
                *(GAS u32x4*)(dst + (size_t)(row0 + r1) * DM + 8 * lane + 512 * j) = w; } }
    }
}

__device__ __forceinline__ void p0_phase(Frame& F) {
    const int gw = F.vcu * 8 + F.wave, NGW = F.G * 8, lane = F.lane;
    unsigned long long* MODQ = (unsigned long long*)(F.ctl + CW_MOD);
    for (int it = gw; it < 1536; it += NGW) {
        const int cb = it % 24, kc = it / 24, k0 = kc * 16, col = cb * 256 + lane * 4;
        float sv[5];
#pragma unroll
        for (int r = 0; r < 5; ++r) { const float cv = (r < 4) ? F.c[r * DM + k0 + (lane & 15)] : F.c_ctx[k0 + (lane & 15)]; sv[r] = cv / (1.0f + __expf(-cv)); }
        f32x4 acc[5];
#pragma unroll
        for (int r = 0; r < 5; ++r) acc[r] = (f32x4){0.f, 0.f, 0.f, 0.f};
#pragma unroll
        for (int kk = 0; kk < 16; ++kk) { const f32x4 w = *(const f32x4*)(F.w_ada + (size_t)(k0 + kk) * 6144 + col);
#pragma unroll
            for (int r = 0; r < 5; ++r) { const float s = __builtin_bit_cast(float, __builtin_amdgcn_readlane(__builtin_bit_cast(int, sv[r]), kk)); acc[r] += w * s; } }
        if (kc == 0) { const f32x4 bv = *(const f32x4*)(F.b_ada + col);
#pragma unroll
            for (int r = 0; r < 5; ++r) acc[r] += bv; }
#pragma unroll
        for (int r = 0; r < 5; ++r)
#pragma unroll
            for (int j = 0; j < 4; ++j) atomicAdd(MODQ + r * 6144 + col + j, (unsigned long long)__float2ll_rn(acc[r][j] * 0x1p36f));
    }
    float* WCS = WSP(float, WS_TAB);
    for (int it = gw; it < 256; it += NGW) {
        const int fh = it >> 6, d = it & 63; float ac = 0.f, as = 0.f;
        for (int k2 = 0; k2 < 64; ++k2) { const int mm = (d * k2) & 63; const float w = F.w_fourier[(fh * 64 + k2) * 64 + lane]; ac += cospif((float)mm * (1.0f / 32.0f)) * w; as += sinpif((float)mm * (1.0f / 32.0f)) * w; }
        const float sc = 1.0f / sqrtf((float)SEQ * 64.0f);
        WCS[(fh * 64 + d) * 128 + lane] = ac * sc; WCS[(fh * 64 + d) * 128 + 64 + lane] = as * sc;
    }
    {
        u16* D1 = WSP(u16, WS_TAB + 144 * 1024); u16* D3 = WSP(u16, WS_TAB + 272 * 1024);
        for (int it = gw; it < 320; it += NGW) {
            if (it < 256) { const int ro = it >> 7, k1 = it & 127;
#pragma unroll
                for (int j = 0; j < 4; ++j) { const int col = lane + 64 * j, ri = col >> 7, n1 = col & 127, mm = (n1 * k1) & 127; const float cc = cospif((float)mm * (1.0f / 64.0f)), ss = sinpif((float)mm * (1.0f / 64.0f));
                    const float v = (ro == 0) ? (ri == 0 ? cc : -ss) : (ri == 0 ? -ss : -cc); D1[it * 256 + col] = (u16)f2bf(v); } }
            else { const int k2 = it - 256;
#pragma unroll
                for (int j = 0; j < 2; ++j) { const int col = lane + 64 * j, ri = col >> 6, n2 = col & 63, mm = (n2 * k2) & 63; const float v = (ri == 0) ? cospif((float)mm * (1.0f / 32.0f)) : sinpif((float)mm * (1.0f / 32.0f)); D3[k2 * 128 + col] = (u16)f2bf(v); } }
        }
    }
    float* COS = WSP(float, WS_TAB + 128 * 1024); float* SIN = WSP(float, WS_TAB + 136 * 1024);
    for (int it = gw; it < 32; it += NGW) { const int idx = it * 64 + lane, pos = idx >> 4, i = idx & 15;
        const float inv = powf(10000.0f, -(float)i / 16.0f), ang = (float)pos * inv; COS[idx] = cosf(ang); SIN[idx] = sinf(ang); }
}

__device__ __forceinline__ int map_row(int mode, int sc) {
    if (mode == 1) { const int head = sc >> 6, dim = sc & 63, bj = dim >> 5, n = (dim >> 4) & 1, i = dim & 15; return (head >> 2) * 256 + bj * 128 + (head & 3) * 32 + (i >> 2) * 8 + n * 4 + (i & 3); }
    if (mode == 2) { const int g = sc >> 8, a = sc & 255; return (a >> 2) * 8 + g * 4 + (a & 3); }
    return sc;
}
struct TItem { const float* src; u16* dst; int N, K, k0, rel_c0, mode, dst_off; bool f16; };
__device__ __forceinline__ void titem_load(const TItem& t, float (&buf)[32], int lane) {
#pragma unroll
    for (int i = 0; i < 32; ++i) { const int kk = 2 * i + (lane >> 5); buf[i] = t.src[(size_t)kk * t.N + (lane & 31)]; }
}
__device__ __forceinline__ void titem_finish(const TItem& t, const float (&buf)[32], LAS float* scr, int lane) {
#pragma unroll
    for (int i = 0; i < 32; ++i) { const int kk = 2 * i + (lane >> 5); scr[kk * 33 + (lane & 31)] = buf[i]; }
    LDS_WAIT(); asm volatile("" ::: "memory");
    const int c = lane & 7;
#pragma unroll
    for (int j = 0; j < 4; ++j) { const int n = (lane >> 3) + 8 * j; const LAS float* s = scr + (8 * c) * 33 + n;
        u32x4 o;
        if (t.f16) { o.x = pk2h(s[0 * 33], s[1 * 33]); o.y = pk2h(s[2 * 33], s[3 * 33]); o.z = pk2h(s[4 * 33], s[5 * 33]); o.w = pk2h(s[6 * 33], s[7 * 33]); }
        else { o.x = pk2bf(s[0 * 33], s[1 * 33]); o.y = pk2bf(s[2 * 33], s[3 * 33]); o.z = pk2bf(s[4 * 33], s[5 * 33]); o.w = pk2bf(s[6 * 33], s[7 * 33]); }
        const int drow = t.dst_off + map_row(t.mode, t.rel_c0 + n);
        *(GAS u32x4*)(t.dst + (size_t)drow * t.K + t.k0 + 8 * c) = o; }
    LDS_WAIT(); asm volatile("" ::: "memory");
}
__device__ __forceinline__ void p1_phase(Frame& F) {
    LAS float* scr = (LAS float*)(F.lds + RING_OFF + F.wave * 16384);
    const int gw = F.vcu * 8 + F.wave, NGW = F.G * 8, lane = F.lane;
    constexpr int I_FOLD = 128, I_QKV = 16 * 40, I_OUT = 16 * 32, I_R = 16 * 8, I_GU = NEXPS * 16 * 16, I_D = NEXPS * 4 * 32;
    constexpr int NT_ITEMS = I_QKV + I_OUT + I_R + I_GU + I_D;
    u16* BIN = WSP(u16, WS_BIN);
    for (int r = gw; r < I_FOLD; r += NGW) {
        const int fh = r >> 5, cs = (r >> 4) & 1, kb = r & 15; const int k = kb * 64 + lane;
        const GAS float* WCS = (const GAS float*)(F.ws + WS_TAB);
#pragma unroll 4
        for (int i = 0; i < 64; ++i) scr[i * 64 + lane] = WCS[(fh * 64 + i) * 128 + cs * 64 + lane];
        float wrow[64];
#pragma unroll
        for (int d4 = 0; d4 < 16; ++d4) { const f32x4 v = *(const f32x4*)(F.w_in + (size_t)k * 1536 + fh * 64 + 4 * d4); wrow[4 * d4] = v[0]; wrow[4 * d4 + 1] = v[1]; wrow[4 * d4 + 2] = v[2]; wrow[4 * d4 + 3] = v[3]; }
        LDS_WAIT(); asm volatile("" ::: "memory");
        for (int e = 0; e < 64; ++e) { float a = 0.f;
#pragma unroll
            for (int d = 0; d < 64; ++d) a += wrow[d] * scr[d * 64 + e];
            const int col256 = fh * 64 + e, pos = 8 * (col256 >> 2) + (col256 & 3) + 4 * cs;
            BIN[(size_t)pos * DM + k] = (u16)f2bf(a); }
        LDS_WAIT(); asm volatile("" ::: "memory");
    }
#define TDECODE(it_, t) do { int r = (it_); \
 \
        if (r < I_QKV) { const int kb = r / 40, nb = r % 40, sc0 = 256 + 32 * nb; t.N = 1536; t.K = DM; t.k0 = kb * 64; t.f16 = false; t.dst = BIN; t.src = F.w_in + (size_t)(kb * 64) * 1536 + sc0; \
            if (sc0 < 1024) { t.rel_c0 = sc0 - 256; t.mode = 1; t.dst_off = 512; } else if (sc0 < 1280) { t.rel_c0 = sc0 - 1024; t.mode = 1; t.dst_off = 1280; } else { t.rel_c0 = sc0 - 1280; t.mode = 0; t.dst_off = 1536; } \
            break; } \
        r -= I_QKV; \
        if (r < I_OUT) { const int kb = r / 32, nb = r % 32; t.N = DM; t.K = DM; t.k0 = kb * 64; t.f16 = false; t.dst = WSP(u16, WS_BOUT); t.src = F.w_out + (size_t)(kb * 64) * DM + 32 * nb; t.rel_c0 = 32 * nb; t.mode = 0; t.dst_off = 0; break; } \
        r -= I_OUT; \
        if (r < I_R) { const int kb = r / 8, nb = r % 8; t.N = NEXP; t.K = DM; t.k0 = kb * 64; t.f16 = MOEF16; t.dst = WSP(u16, WS_BR); t.src = F.w_router + (size_t)(kb * 64) * NEXP + 32 * nb; t.rel_c0 = 32 * nb; t.mode = 0; t.dst_off = 0; break; } \
        r -= I_R; \
        if (r < I_GU) { const int e = r >> 8, q = r & 255, kb = q >> 4, nb = q & 15; const float* W = (e < NEXP) ? F.w_egu + (size_t)e * DM * 512 : F.w_sgu; \
            t.N = 512; t.K = DM; t.k0 = kb * 64; t.f16 = MOEF16; t.dst = WSP(u16, WS_BGU) + (size_t)e * 512 * DM; t.src = W + (size_t)(kb * 64) * 512 + 32 * nb; t.rel_c0 = 32 * nb; t.mode = 2; t.dst_off = 0; break; } \
        r -= I_GU; \
        { const int e = r >> 7, q = r & 127, kb = q >> 5, nb = q & 31; const float* W = (e < NEXP) ? F.w_ed + (size_t)e * EFF * DM : F.w_sd; \
            t.N = DM; t.K = EFF; t.k0 = kb * 64; t.f16 = MOEF16; t.dst = WSP(u16, WS_BD) + (size_t)e * DM * EFF; t.src = W + (size_t)(kb * 64) * DM + 32 * nb; t.rel_c0 = 32 * nb; t.mode = 0; t.dst_off = 0; } \
    } while (0)
    REPS(11) {
        float bufA[32], bufB[32]; TItem ta, tb; int it = gw;
        if (it < NT_ITEMS) { TDECODE(it, ta); titem_load(ta, bufA, lane); }
        while (it < NT_ITEMS) {
            const int itb = it + NGW; const bool hb = itb < NT_ITEMS;
            if (hb) { TDECODE(itb, tb); titem_load(tb, bufB, lane); }
            titem_finish(ta, bufA, scr, lane);
            if (!hb) break;
            const int ita = itb + NGW; const bool ha = ita < NT_ITEMS;
            if (ha) { TDECODE(ita, ta); titem_load(ta, bufA, lane); }
            titem_finish(tb, bufB, scr, lane);
            it = ita;
        }
    }
    const gi64* MOD = (const gi64*)(F.ctl + CW_MOD);
    u16* XN = WSP(u16, WS_XN);
    REPS(12) { const int wpb = NGW >> 2, b = gw / wpb, wi = gw % wpb;
        rownorm_rows<false>((const GAS float*)F.x, F.norm1_g, MOD + b * 6144, MOD + b * 6144 + 1024, XN, b * SEQ, SEQ, wi, wpb, lane);
        rownorm_rows<false>((const GAS float*)F.ctx, F.norm1_g, MOD + 4 * 6144, MOD + 4 * 6144 + 1024, XN + (size_t)NTOK * DM, 0, NCTX, gw, NGW, lane); }
}

__device__ __forceinline__ void fourier_unit(Frame& F, int b, int g) {
    LAS unsigned char* Zl = F.lds + RING_OFF;
    LAS f32x2* TW128 = (LAS f32x2*)(F.lds + TAB_OFF);
    LAS f32x2* TW64 = (LAS f32x2*)(F.lds + TAB_OFF + 1024);
    const int tid = F.tid;
    const GAS u32x4* Zg = (const GAS u32x4*)(F.ws + WS_Z + ((size_t)(b * 64 + g) * SEQ) * 16);
#pragma unroll 4
    for (int i = 0; i < 16; ++i) *(LAS u32x4*)(Zl + (size_t)(i * 512 + tid) * 16) = Zg[i * 512 + tid];
    if (tid < 128) { float s, c; sincospif((float)tid * (1.0f / 64.0f), &s, &c); TW128[tid] = (f32x2){c, s}; }
    else if (tid < 192) { float s, c; sincospif((float)(tid - 128) * (1.0f / 32.0f), &s, &c); TW64[tid - 128] = (f32x2){c, s}; }
    __syncthreads();
    const int k1 = tid & 127, q = tid >> 7;
    float yr[16][4], yi[16][4];
#pragma unroll
    for (int a = 0; a < 16; ++a)
#pragma unroll
        for (int e = 0; e < 4; ++e) { yr[a][e] = 0.f; yi[a][e] = 0.f; }
    for (int n1 = 0; n1 < 128; ++n1) {
        const f32x2 tw = TW128[(n1 * k1) & 127]; const float c = tw.x, s = tw.y;
#pragma unroll
        for (int a = 0; a < 16; ++a) { const u32x4 rw = *(const LAS u32x4*)(Zl + (size_t)(64 * n1 + 16 * q + a) * 16);
            const float uc[4] = {bflo(rw.x), bfhi(rw.x), bflo(rw.y), bfhi(rw.y)}, us[4] = {bflo(rw.z), bfhi(rw.z), bflo(rw.w), bfhi(rw.w)};
#pragma unroll
            for (int e = 0; e < 4; ++e) { yr[a][e] += uc[e] * c - us[e] * s; yi[a][e] -= uc[e] * s + us[e] * c; } }
    }
    __syncthreads();
    int k1b = k1; asm volatile("" : "+v"(k1b));
#pragma unroll
    for (int a = 0; a < 16; ++a) { const int n2 = 16 * q + a; const float fr_ = (float)(n2 * k1b) * (1.0f / 8192.0f);
        const float cp = __builtin_amdgcn_cosf(fr_), sp = __builtin_amdgcn_sinf(fr_);
        float pr[4], pi[4];
#pragma unroll
        for (int e = 0; e < 4; ++e) { pr[e] = yr[a][e] * cp + yi[a][e] * sp; pi[e] = yi[a][e] * cp - yr[a][e] * sp; }
        u32x4 w; w.x = pk2bf(pr[0], pr[1]); w.y = pk2bf(pr[2], pr[3]); w.z = pk2bf(pi[0], pi[1]); w.w = pk2bf(pi[2], pi[3]);
        *(LAS u32x4*)(Zl + (size_t)(n2 * 128 + k1b) * 16) = w; }
    __syncthreads();
    int k1c = k1; asm volatile("" : "+v"(k1c));
    float o[16][4];
#pragma unroll
    for (int a = 0; a < 16; ++a)
#pragma unroll
        for (int e = 0; e < 4; ++e) o[a][e] = 0.f;
    for (int n2 = 0; n2 < 64; ++n2) {
        const u32x4 rw = *(const LAS u32x4*)(Zl + (size_t)(n2 * 128 + k1c) * 16);
        const float pr[4] = {bflo(rw.x), bfhi(rw.x), bflo(rw.y), bfhi(rw.y)}, pi[4] = {bflo(rw.z), bfhi(rw.z), bflo(rw.w), bfhi(rw.w)};
#pragma unroll
        for (int a = 0; a < 16; ++a) { const f32x2 tw = TW64[(n2 * (16 * q + a)) & 63];
#pragma unroll
            for (int e = 0; e < 4; ++e) o[a][e] += pr[e] * tw.x + pi[e] * tw.y; }
    }
    u16* MIX = WSP(u16, WS_MIX);
#pragma unroll
    for (int a = 0; a < 16; ++a) { const int k2 = 16 * q + a; u32x2 w; w.x = pk2bf(o[a][0], o[a][1]); w.y = pk2bf(o[a][2], o[a][3]);
        *(GAS u32x2*)(MIX + ((size_t)(b * SEQ + k1c + 128 * k2)) * DM + 4 * g) = w; }
    __syncthreads();
}

__device__ __forceinline__ attn_body::s16x4 ftr(const LAS unsigned char* p) { return __builtin_bit_cast(attn_body::s16x4, __builtin_amdgcn_ds_read_tr16_b64_v4i16((LAS attn_body::v4i16_t*)p)); }
__device__ __forceinline__ void fourier_unit_mfma(Frame& F, int b, int g) {
    LAS unsigned char* Zl = F.lds + RING_OFF;
    const int tid = F.tid, lane = F.lane, w = F.wave;
    const char* Zg = (const char*)(F.ws + WS_Z) + ((size_t)(b * 64 + g) * SEQ) * 16;
#pragma unroll
    for (int i = 0; i < 16; ++i) __builtin_amdgcn_global_load_lds((const unsigned*)(Zg + (size_t)(i * 512 + tid) * 16), (LAS unsigned*)(Zl + (size_t)(i * 512 + w * 64) * 16), 16, 0, 0);
    VM_WAIT(); __syncthreads();
    f32x4 acc[2][16];
#pragma unroll
    for (int ro = 0; ro < 2; ++ro)
#pragma unroll
        for (int t = 0; t < 16; ++t) acc[ro][t] = (f32x4){0.f, 0.f, 0.f, 0.f};
    const GAS bf16x8* D1 = (const GAS bf16x8*)(F.ws + WS_TAB + 144 * 1024);
    const GAS bf16x8* D3 = (const GAS bf16x8*)(F.ws + WS_TAB + 272 * 1024);
    const int l15 = lane & 15, lq = lane >> 4;
    const unsigned bbase = (unsigned)((64 * (8 * lq + (l15 >> 2)) + (lane & 3)) * 16);
#pragma unroll 1
    for (int s1 = 0; s1 < 8; ++s1) {
        const int ri = s1 >> 2;
        const bf16x8 a0 = D1[(16 * w + l15) * 32 + 4 * s1 + lq], a1 = D1[(128 + 16 * w + l15) * 32 + 4 * s1 + lq];
        const LAS unsigned char* sb = Zl + bbase + (unsigned)((s1 & 3) * 32768 + 8 * ri);
#pragma unroll
        for (int t = 0; t < 16; ++t) { const attn_body::s16x4 lo = ftr(sb + 64 * t), hi = ftr(sb + 64 * t + 4096);
            const bf16x8 bf = (bf16x8){lo[0], lo[1], lo[2], lo[3], hi[0], hi[1], hi[2], hi[3]};
            acc[0][t] = __builtin_amdgcn_mfma_f32_16x16x32_bf16(a0, bf, acc[0][t], 0, 0, 0);
            acc[1][t] = __builtin_amdgcn_mfma_f32_16x16x32_bf16(a1, bf, acc[1][t], 0, 0, 0); }
    }
    __syncthreads();
    {   const int e = lane & 3; int k1b = 16 * w + 4 * lq; asm volatile("" : "+v"(k1b));
#pragma unroll
        for (int t = 0; t < 16; ++t) { const int n2 = 4 * t + (l15 >> 2);
#pragma unroll
            for (int r = 0; r < 4; ++r) { const int k1 = k1b + r; const float fr_ = (float)(n2 * k1) * (1.0f / 8192.0f); const float cp = __builtin_amdgcn_cosf(fr_), sp = __builtin_amdgcn_sinf(fr_);
                const float yr = acc[0][t][r], yi = acc[1][t][r]; const float pr = yr * cp + yi * sp, pi = yi * cp - yr * sp;
                *(LAS u16*)(Zl + (unsigned)(((n2) * 512 + k1 * 4 + e) * 2)) = (u16)f2bf(pr);
                *(LAS u16*)(Zl + (unsigned)(((64 + n2) * 512 + k1 * 4 + e) * 2)) = (u16)f2bf(pi); } }
    }
    asm volatile("s_waitcnt lgkmcnt(0)" ::: "memory");
    f32x4 acc3[4][4];
#pragma unroll
    for (int mt = 0; mt < 4; ++mt)
#pragma unroll
        for (int j = 0; j < 4; ++j) acc3[mt][j] = (f32x4){0.f, 0.f, 0.f, 0.f};
#pragma unroll
    for (int s3 = 0; s3 < 4; ++s3) {
        bf16x8 a[4];
#pragma unroll
        for (int mt = 0; mt < 4; ++mt) a[mt] = D3[(16 * mt + l15) * 16 + 4 * s3 + lq];
        const unsigned kk = (unsigned)(32 * s3 + 8 * lq + (l15 >> 2));
#pragma unroll
        for (int j = 0; j < 4; ++j) { const unsigned ad = kk * 1024u + (unsigned)((4 * (4 * w + j) + (lane & 3)) * 8);
            const attn_body::s16x4 lo = ftr(Zl + ad), hi = ftr(Zl + ad + 4096);
            const bf16x8 bf = (bf16x8){lo[0], lo[1], lo[2], lo[3], hi[0], hi[1], hi[2], hi[3]};
#pragma unroll
            for (int mt = 0; mt < 4; ++mt) acc3[mt][j] = __builtin_amdgcn_mfma_f32_16x16x32_bf16(a[mt], bf, acc3[mt][j], 0, 0, 0); }
    }
    u16* MIX = WSP(u16, WS_MIX);
#pragma unroll
    for (int mt = 0; mt < 4; ++mt)
#pragma unroll
        for (int j = 0; j < 4; ++j)
#pragma unroll
            for (int r = 0; r < 4; ++r) { const int k2 = 16 * mt + 4 * lq + r, k1 = 16 * w + 4 * j + (l15 >> 2);
                MIX[((size_t)(b * SEQ + k1 + 128 * k2)) * DM + 4 * g + (lane & 3)] = (u16)f2bf(acc3[mt][j][r]); }
    __syncthreads();
}

__device__ __forceinline__ float dpp_f(float v, int ctrl_sel) {
    const int x = __builtin_bit_cast(int, v); int r;
    if (ctrl_sel == 0) r = __builtin_amdgcn_update_dpp(x, x, 0xB1, 0xF, 0xF, false);
    else if (ctrl_sel == 1) r = __builtin_amdgcn_update_dpp(x, x, 0x4E, 0xF, 0xF, false);
    else if (ctrl_sel == 2) r = __builtin_amdgcn_update_dpp(x, x, 0x141, 0xF, 0xF, false);
    else r = __builtin_amdgcn_update_dpp(x, x, 0x140, 0xF, 0xF, false);
    return __builtin_bit_cast(float, r);
}
__device__ __forceinline__ float rdl(float v, int lane) { return __builtin_bit_cast(float, __builtin_amdgcn_readlane(__builtin_bit_cast(int, v), lane)); }
__device__ __forceinline__ void route_token(Frame& F, int tok) {
    const int l = F.lane;
    const f32x4 lg = *(const GAS f32x4*)((const GAS float*)(F.ws + WS_LOG) + (size_t)tok * NEXP + 4 * l);
    const f32x4 bs = *(const f32x4*)(F.router_bias + 4 * l);
    float s[4], sel[4];
#pragma unroll
    for (int j = 0; j < 4; ++j) { s[j] = 1.0f / (1.0f + expf(-lg[j])); sel[j] = s[j] + bs[j]; }
    float m1 = fmaxf(sel[0], sel[1]), m2 = fminf(sel[0], sel[1]);
#pragma unroll
    for (int j = 2; j < 4; ++j) { const float v = sel[j]; m2 = fmaxf(m2, fminf(m1, v)); m1 = fmaxf(m1, v); }
#pragma unroll
    for (int st = 0; st < 3; ++st) { const float o1 = dpp_f(m1, st), o2 = dpp_f(m2, st); const float n2 = fmaxf(fminf(m1, o1), fmaxf(m2, o2)); m1 = fmaxf(m1, o1); m2 = n2; }
    const float gs = m1 + m2; const int myg = l >> 3; int rank = 0;
#pragma unroll
    for (int g2 = 0; g2 < 8; ++g2) { const float og = rdl(gs, g2 * 8); rank += (og > gs || (og == gs && g2 < myg)) ? 1 : 0; }
    if (rank >= 4) {
#pragma unroll
        for (int j = 0; j < 4; ++j) sel[j] = -INFINITY; }
    int my_e = 0; float my_s = 0.f, sum = 0.f;
#pragma unroll 1
    for (int k = 0; k < TOPK; ++k) {
        const float lb = fmaxf(fmaxf(sel[0], sel[1]), fmaxf(sel[2], sel[3]));
        float r = lb; r = fmaxf(r, dpp_f(r, 0)); r = fmaxf(r, dpp_f(r, 1)); r = fmaxf(r, dpp_f(r, 2)); r = fmaxf(r, dpp_f(r, 3));
        const float wm = fmaxf(fmaxf(rdl(r, 0), rdl(r, 16)), fmaxf(rdl(r, 32), rdl(r, 48)));
        const unsigned long long mask = __ballot(lb == wm);
        const int wl = __builtin_amdgcn_readfirstlane((int)__ffsll((long long)mask) - 1);
        const int jj = (sel[0] == wm) ? 0 : (sel[1] == wm) ? 1 : (sel[2] == wm) ? 2 : 3;
        const float cand = (jj == 0) ? s[0] : (jj == 1) ? s[1] : (jj == 2) ? s[2] : s[3];
        const int jw = __builtin_amdgcn_readlane(jj, wl); const float wsc = rdl(cand, wl);
        if (l == wl) {
#pragma unroll
            for (int j = 0; j < 4; ++j) if (jw == j) sel[j] = -INFINITY; }
        if (l == k) { my_e = 4 * wl + jw; my_s = wsc; }
        sum += wsc;
    }
    GAS u32x2* LIST = (GAS u32x2*)(F.ws + WS_LIST);
    if (l < TOPK) { const float gate = my_s / sum * 2.5f; const unsigned pos = __hip_atomic_fetch_add((unsigned*)(F.ctl + CW_CNT + my_e), 1u, RLX_AGENT);
        LIST[(size_t)my_e * NTOK + pos] = (u32x2){(unsigned)tok | ((unsigned)l << 16), __builtin_bit_cast(unsigned, gate)}; }
    else if (l == TOPK) LIST[(size_t)NEXP * NTOK + tok] = (u32x2){(unsigned)tok | (8u << 16), __builtin_bit_cast(unsigned, 1.0f)};
}

__device__ __forceinline__ void build_tiles(Frame& F) {
    LAS int* TS = (LAS int*)(F.lds + TAB_OFF + 2048); LAS int* CN = (LAS int*)(F.lds + TAB_OFF + 3200);
    if (F.tid < 64) { const int l = F.tid; int c[5], t[5], tot = 0;
#pragma unroll
        for (int j = 0; j < 5; ++j) { const int e = 5 * l + j; c[j] = (e < NEXPS) ? (int)__hip_atomic_load((unsigned*)(F.ctl + CW_CNT + e), RLX_AGENT) : 0; t[j] = (c[j] + 255) >> 8; tot += t[j]; }
        int x = tot;
#pragma unroll
        for (int off = 1; off < 64; off <<= 1) { const int v = __shfl_up(x, off); if (l >= off) x += v; }
        int run = x - tot;
#pragma unroll
        for (int j = 0; j < 5; ++j) { const int e = 5 * l + j; if (e <= NEXPS) { TS[e] = run; if (e < NEXPS) CN[e] = c[j]; } run += t[j]; }
    }
    __syncthreads();
}

__device__ __forceinline__ void ph2(Frame& F) {
    const gi64* MOD = (const gi64*)(F.ctl + CW_MOD); const int gw = F.vcu * 8 + F.wave, NGW = F.G * 8; (void)MOD; (void)gw; (void)NGW;
        DenseOrder S{7, 128 * 7, 8, F.G, F.vcu, (const char*)(F.ws + WS_BIN), DM, (REP == 22) ? 2 : 1};
        EpiInProj E{WSP(u16, WS_Z), WSP(u16, WS_Q), WSP(u16, WS_K), WSP(u16, WS_V), WSP(float, WS_TAB + 128 * 1024), WSP(float, WS_TAB + 136 * 1024), F.q_norm_g, F.k_norm_g};
        pg8::gemm_phase<EpiInProj, DenseOrder, false, true>(F.lds + RING_OFF, (const char*)(F.ws + WS_XN), DM, S, E);
    }
__device__ __forceinline__ void ph4(Frame& F) {
    const gi64* MOD = (const gi64*)(F.ctl + CW_MOD); const int gw = F.vcu * 8 + F.wave, NGW = F.G * 8; (void)MOD; (void)gw; (void)NGW;
        if (DBG & 128) { GAS u32x4* zH = (GAS u32x4*)(F.ws + WS_H2); const size_t nH = (size_t)NTOK * DM * 2 / 16; for (size_t i = (size_t)blockIdx.x * 512 + F.tid; i < nH; i += (size_t)F.G * 512) zH[i] = (u32x4){0u, 0u, 0u, 0u}; }
        DenseOrder S{4, 128 * 4, 0, F.G, F.vcu, (const char*)(F.ws + WS_BOUT), DM, 1};
        EpiResid E{F.x, F.out, MOD};
        pg8::gemm_phase<EpiResid, DenseOrder, false, true>(F.lds + RING_OFF, (const char*)(F.ws + WS_MIX), DM, S, E);
    }
__device__ __forceinline__ void ph5(Frame& F) {
    const gi64* MOD = (const gi64*)(F.ctl + CW_MOD); const int gw = F.vcu * 8 + F.wave, NGW = F.G * 8;
    const int wpb = NGW >> 2, b = gw / wpb, wi = gw % wpb;
    rownorm_rows<MOEF16>((const GAS float*)F.out, F.norm2_g, MOD + b * 6144 + 3072, MOD + b * 6144 + 4096, WSP(u16, WS_H2), b * SEQ, SEQ, wi, wpb, F.lane);
}
__device__ __forceinline__ void ph6(Frame& F) {
    const gi64* MOD = (const gi64*)(F.ctl + CW_MOD); const int gw = F.vcu * 8 + F.wave, NGW = F.G * 8; (void)MOD; (void)gw; (void)NGW;
        DenseOrder S{1, 128, 0, F.G, F.vcu, (const char*)(F.ws + WS_BR), DM, 1};
        EpiLogits E{WSP(float, WS_LOG)};
        pg8::gemm_phase<EpiLogits, DenseOrder, MOEF16, true>(F.lds + RING_OFF, (const char*)(F.ws + WS_H2), DM, S, E);
    }
__device__ __forceinline__ void ph8(Frame& F) {
    const gi64* MOD = (const gi64*)(F.ctl + CW_MOD); const int gw = F.vcu * 8 + F.wave, NGW = F.G * 8; (void)MOD; (void)gw; (void)NGW;
        build_tiles(F);
        GroupedOrder<true> S{2, F.G, F.vcu, 512, DM, true, (const char*)(F.ws + WS_BGU), (const LAS int*)(F.lds + TAB_OFF + 2048), (const LAS int*)(F.lds + TAB_OFF + 3200), (const GAS u32x2*)(F.ws + WS_LIST), 1, __builtin_amdgcn_readfirstlane(((const LAS int*)(F.lds + TAB_OFF + 2048))[257])};
        EpiSwiglu E{WSP(u16, WS_ACT)};
        pg8::gemm_phase<EpiSwiglu, GroupedOrder<true>, MOEF16, true>(F.lds + RING_OFF, (const char*)(F.ws + WS_H2), DM, S, E);
    }
__device__ __forceinline__ void ph9(Frame& F) {
    const gi64* MOD = (const gi64*)(F.ctl + CW_MOD); const int gw = F.vcu * 8 + F.wave, NGW = F.G * 8; (void)MOD; (void)gw; (void)NGW;
        build_tiles(F);
        GroupedOrder<false> S{4, F.G, F.vcu, DM, EFF, false, (const char*)(F.ws + WS_BD), (const LAS int*)(F.lds + TAB_OFF + 2048), (const LAS int*)(F.lds + TAB_OFF + 3200), (const GAS u32x2*)(F.ws + WS_LIST), (REP == 29) ? 2 : 1, __builtin_amdgcn_readfirstlane(((const LAS int*)(F.lds + TAB_OFF + 2048))[257])};
        EpiDown E{WSP(u16, WS_C), (const GAS u32x2*)(F.ws + WS_LIST)};
        pg8::gemm_phase<EpiDown, GroupedOrder<false>, MOEF16, true>(F.lds + RING_OFF, (const char*)(F.ws + WS_ACT), EFF, S, E);
    }

#if DBG & (1024 | 2048)
__device__ __forceinline__ void chk_attn(Frame& F, float negM) {
    const int gw = F.vcu * 8 + F.wave, NGW = F.G * 8, lane = F.lane;
    const GAS u16* Q = (const GAS u16*)(F.ws + WS_Q); const GAS u16* K = (const GAS u16*)(F.ws + WS_K); const GAS u16* V = (const GAS u16*)(F.ws + WS_V); const GAS u16* MIX = (const GAS u16*)(F.ws + WS_MIX);
    float* chk = (float*)(F.ctl + CW_CHK);
    for (int i = gw; i < 4096; i += NGW) {
        const int b = i & 3, h = (i >> 2) % 12, q = (int)((((unsigned)i * 2654435761u) >> 19) & 8191u), kvh = h / 3;
        float qv[64], o[64]; float l = 0.f;
#pragma unroll
        for (int c = 0; c < 8; ++c) { const u32x4 w = *(const GAS u32x4*)(Q + ((size_t)(b * SEQ + q)) * QW + h * 64 + 8 * c);
            qv[8 * c] = bflo(w.x); qv[8 * c + 1] = bfhi(w.x); qv[8 * c + 2] = bflo(w.y); qv[8 * c + 3] = bfhi(w.y); qv[8 * c + 4] = bflo(w.z); qv[8 * c + 5] = bfhi(w.z); qv[8 * c + 6] = bflo(w.w); qv[8 * c + 7] = bfhi(w.w); }
#pragma unroll
        for (int d = 0; d < 64; ++d) o[d] = 0.f;
        for (int t = 0; t < LKV / 64; ++t) { const int j = t * 64 + lane; const GAS u16* kr = K + ((size_t)(b * LKV + j)) * KVW + kvh * 64; const GAS u16* vr = V + ((size_t)(b * LKV + j)) * KVW + kvh * 64;
            float dot = 0.f;
#pragma unroll
            for (int c = 0; c < 8; ++c) { const u32x4 w = *(const GAS u32x4*)(kr + 8 * c);
                dot += qv[8 * c] * bflo(w.x) + qv[8 * c + 1] * bfhi(w.x) + qv[8 * c + 2] * bflo(w.y) + qv[8 * c + 3] * bfhi(w.y) + qv[8 * c + 4] * bflo(w.z) + qv[8 * c + 5] * bfhi(w.z) + qv[8 * c + 6] * bflo(w.w) + qv[8 * c + 7] * bfhi(w.w); }
            const float pp = exp2f(dot + negM); l += pp;
#pragma unroll
            for (int c = 0; c < 8; ++c) { const u32x4 w = *(const GAS u32x4*)(vr + 8 * c);
                o[8 * c] += pp * bflo(w.x); o[8 * c + 1] += pp * bfhi(w.x); o[8 * c + 2] += pp * bflo(w.y); o[8 * c + 3] += pp * bfhi(w.y); o[8 * c + 4] += pp * bflo(w.z); o[8 * c + 5] += pp * bfhi(w.z); o[8 * c + 6] += pp * bflo(w.w); o[8 * c + 7] += pp * bfhi(w.w); } }
        l = wave_sum(l); float err = 0.f, ref = 0.f;
#pragma unroll
        for (int d = 0; d < 64; ++d) { const float od = wave_sum(o[d]) / l; const float mv = bflo((unsigned)MIX[((size_t)(b * SEQ + q)) * DM + 256 + h * 64 + d]); err += (od - mv) * (od - mv); ref += od * od; }
        if (lane == 0) { atomicAdd(chk + 0, err); atomicAdd(chk + 1, ref); }
    }
}
__device__ __forceinline__ void chk_qkv(Frame& F) {
    const int gw = F.vcu * 8 + F.wave, NGW = F.G * 8, lane = F.lane;
    const gi64* MOD = (const gi64*)(F.ctl + CW_MOD);
    LAS float* hrow = (LAS float*)(F.lds + RING_OFF + F.wave * 16384);
    float* chk = (float*)(F.ctl + CW_CHK);
    for (int i = gw; i < 4096; i += NGW) {
        const unsigned hs = (unsigned)i * 2654435761u; const bool isctx = (i & 15) == 15; int sel = i % 20; if (isctx && sel < 12) sel = 12 + (sel & 7);
        const int m = isctx ? (int)((hs >> 10) & 1023u) : (int)((hs >> 12) & 32767u);
        const float* src = isctx ? F.ctx + (size_t)m * DM : F.x + (size_t)m * DM; const int mr = isctx ? 4 : (m >> 13);
        const int b = isctx ? (m >> 8) : (m >> 13), l = isctx ? 0 : (m & 8191), key = isctx ? SEQ + (m & 255) : l;
        f32x4 v[4]; float s2 = 0.f;
#pragma unroll
        for (int j = 0; j < 4; ++j) { v[j] = *(const f32x4*)(src + 4 * lane + 256 * j); s2 += (v[j][0] * v[j][0] + v[j][1] * v[j][1]) + (v[j][2] * v[j][2] + v[j][3] * v[j][3]); }
        const float rstd = 1.0f / sqrtf(wave_sum(s2) * (1.0f / DM) + RMS_EPS);
#pragma unroll
        for (int j = 0; j < 4; ++j) { const int col = 4 * lane + 256 * j; const f32x4 g = *(const f32x4*)(F.norm1_g + col); const f32x4 sh = mod4(MOD, mr * 6144 + col), sc = mod4(MOD, mr * 6144 + 1024 + col);
            const f32x4 y = v[j] * rstd * g * (sc + 1.0f) + sh; hrow[col] = y[0]; hrow[col + 1] = y[1]; hrow[col + 2] = y[2]; hrow[col + 3] = y[3]; }
        LDS_WAIT(); asm volatile("" ::: "memory");
        const int colbase = (sel < 12) ? 256 + 64 * sel : (sel < 16 ? 1024 + 64 * (sel - 12) : 1280 + 64 * (sel - 16));
        float z = 0.f;
        for (int k = 0; k < DM; ++k) z += hrow[k] * F.w_in[(size_t)k * 1536 + colbase + lane];
        float outv = z; int spos = lane;
        if (sel < 16) { const float ss = wave_sum(z * z); const float gain = (sel < 12) ? F.q_norm_g[lane] : F.k_norm_g[lane]; const float zz = z * (1.0f / sqrtf(ss * (1.0f / 64.0f) + RMS_EPS)) * gain;
            const float pz = __shfl(zz, lane ^ 16); outv = zz;
            if (!isctx) { const int pidx = (lane & 32) ? (l & 63) : (l >> 6); const float inv = powf(10000.0f, -(float)(lane & 15) / 16.0f), ang = (float)pidx * inv; const float cs = cosf(ang), sn = sinf(ang);
                outv = (lane & 16) ? zz * cs + pz * sn : zz * cs - pz * sn; }
            if (sel < 12) outv *= C2;
            spos = 32 * (lane >> 5) + 8 * ((lane >> 2) & 3) + 4 * ((lane >> 4) & 1) + (lane & 3); }
        float stored;
        if (sel < 12) stored = bflo((unsigned)((const GAS u16*)(F.ws + WS_Q))[(size_t)m * QW + sel * 64 + spos]);
        else if (sel < 16) stored = bflo((unsigned)((const GAS u16*)(F.ws + WS_K))[((size_t)(b * LKV + key)) * KVW + (sel - 12) * 64 + spos]);
        else stored = bflo((unsigned)((const GAS u16*)(F.ws + WS_V))[((size_t)(b * LKV + key)) * KVW + (sel - 16) * 64 + lane]);
        const float err = wave_sum((outv - stored) * (outv - stored)), ref = wave_sum(outv * outv);
        if (lane == 0) { atomicAdd(chk + 2, err); atomicAdd(chk + 3, ref); }
        LDS_WAIT(); asm volatile("" ::: "memory");
    }
}
#endif

struct Args { const float* in[20]; float* out; unsigned char* ws; int ph_lo, ph_hi; };
__global__ void __launch_bounds__(512, 2) mk_fwd(Args args) {
    extern __shared__ __attribute__((aligned(16))) unsigned char lds[];
    Frame F;
    F.lds = (LAS unsigned char*)lds;
    F.MISC = (volatile LAS unsigned*)(F.lds + MISC_OFF);
    F.tid = threadIdx.x; F.lane = F.tid & 63; F.wave = __builtin_amdgcn_readfirstlane(F.tid >> 6);
    F.G = gridDim.x; { const int bx = blockIdx.x; F.vcu = (F.G % 8 == 0) ? (bx % 8) * (F.G / 8) + bx / 8 : bx; }
    F.ws = args.ws; F.ctl = (gu32*)(args.ws + WS_CTL); F.out = args.out;
    F.x = args.in[0]; F.c = args.in[1]; F.ctx = args.in[2]; F.c_ctx = args.in[3]; F.norm1_g = args.in[4]; F.w_ada = args.in[5]; F.b_ada = args.in[6]; F.w_in = args.in[7]; F.w_fourier = args.in[8];
    F.q_norm_g = args.in[9]; F.k_norm_g = args.in[10]; F.w_out = args.in[11]; F.norm2_g = args.in[12]; F.w_router = args.in[13]; F.router_bias = args.in[14]; F.w_egu = args.in[15]; F.w_ed = args.in[16];
    F.w_sgu = args.in[17]; F.w_sd = args.in[18]; F.final_g = args.in[19];
    for (int u = F.tid; u < (LDS_BYTES - LDSCTL_OFF) / 4; u += 512) ((LAS unsigned*)(F.lds + LDSCTL_OFF))[u] = 0u;
    __syncthreads();
    XcdBarrier bar; bar.bar = (unsigned*)(F.ctl + CW_BAR); bar.x = 0; bar.st = nullptr;
    if (N_LAUNCHES == 1) bar = xcd_barrier_post((unsigned*)(F.ctl + CW_BAR), F.MISC + 8);
    const int lo = args.ph_lo, hi = args.ph_hi;
#define IN(k) (lo <= (k) && (k) < hi)
#define SEAM(k) do { if (IN(k) && IN((k) + 1)) xcd_barrier(bar); } while (0)
    const gi64* MOD = (const gi64*)(F.ctl + CW_MOD);
    const int gw = F.vcu * 8 + F.wave, NGW = F.G * 8;

    if (IN(0)) { p0_phase(F); } SEAM(0);
    if (IN(1)) { p1_phase(F); VM_WAIT(); __syncthreads(); if (REP == 1) { xcd_barrier(bar); p1_phase(F); VM_WAIT(); __syncthreads(); } } SEAM(1);

    if (IN(2)) { ph2(F); if (REP == 2) { xcd_barrier(bar); ph2(F); } } SEAM(2);

    if (IN(3)) {
        if (DBG & 32) { u16* MIXz = WSP(u16, WS_MIX); for (int m = gw; m < NTOK; m += NGW) *(GAS u32x2*)(MIXz + (size_t)m * DM + 4 * F.lane) = (u32x2){0u, 0u}; }
        else
        REPS(30) for (int U = F.vcu; U < NB * 64; U += F.G) { if (FOURIER_MFMA) fourier_unit_mfma(F, U >> 6, U & 63); else fourier_unit(F, U >> 6, U & 63); }
        const attn_body::bf16* Qp = (const attn_body::bf16*)(F.ws + WS_Q); const attn_body::bf16* Kp = (const attn_body::bf16*)(F.ws + WS_K); const attn_body::bf16* Vp = (const attn_body::bf16*)(F.ws + WS_V);
        attn_body::bf16* Op = (attn_body::bf16*)(F.ws + WS_MIX) + 256;
        float negM; { float gqm = fabsf(F.q_norm_g[F.lane]), gkm = fabsf(F.k_norm_g[F.lane]);
#pragma unroll
            for (int o_ = 1; o_ < 64; o_ <<= 1) { gqm = fmaxf(gqm, __shfl_xor(gqm, o_)); gkm = fmaxf(gkm, __shfl_xor(gkm, o_)); }
            negM = -(C2 * 64.0f * gqm * gkm + 0.5f); }
        if (DBG & 16) { u16* MIXz = WSP(u16, WS_MIX); for (int m = gw; m < NTOK; m += NGW) for (int j = 1; j < 4; ++j) *(GAS u32x2*)(MIXz + (size_t)m * DM + 256 * j + 4 * F.lane) = (u32x2){0u, 0u}; }
        else if (F.G == 256) REPS(31) {
            const int xg = F.vcu >> 5, jq = F.vcu & 31;
            for (int i = 0; i < 6; ++i) { const int grp = 2 * xg + i / 3, hs = i % 3; attn_body::attn_unit<8>(grp >> 2, (grp & 3) * 3 + hs, jq, Qp, Kp, Vp, Op, (char*)lds + RING_OFF, negM); }
        } else {
            for (int U = F.vcu; U < NB * NQH * 32; U += F.G) { const int grp = U / 96, r = U % 96; attn_body::attn_unit<8>(grp >> 2, (grp & 3) * 3 + r / 32, r % 32, Qp, Kp, Vp, Op, (char*)lds + RING_OFF, negM); }
        }
    } SEAM(3);

#if DBG & (1024 | 2048)
    if (IN(4)) { float negMc; { float gqm = fabsf(F.q_norm_g[F.lane]), gkm = fabsf(F.k_norm_g[F.lane]);
            for (int o_ = 1; o_ < 64; o_ <<= 1) { gqm = fmaxf(gqm, __shfl_xor(gqm, o_)); gkm = fmaxf(gkm, __shfl_xor(gkm, o_)); } negMc = -(C2 * 64.0f * gqm * gkm + 0.5f); }
        if (DBG & 1024) chk_attn(F, negMc); if (DBG & 2048) chk_qkv(F); VM_WAIT(); __syncthreads(); }
#endif
    if (IN(4)) { ph4(F); if (REP == 4) { xcd_barrier(bar); ph4(F); } } SEAM(4);

    if (IN(5)) { ph5(F); if (REP == 5) { xcd_barrier(bar); ph5(F); } } SEAM(5);

    if (IN(6)) { ph6(F); if (REP == 6) { xcd_barrier(bar); ph6(F); } } SEAM(6);

    if (IN(7)) {
        if (DBG & 128) { GAS u32x4* zA = (GAS u32x4*)(F.ws + WS_ACT); const size_t nA = (size_t)MAXTILES * 256 * EFF * 2 / 16; for (size_t i = (size_t)blockIdx.x * 512 + F.tid; i < nA; i += (size_t)F.G * 512) zA[i] = (u32x4){0u, 0u, 0u, 0u};
            GAS u32x4* zC = (GAS u32x4*)(F.ws + WS_C); const size_t nC = (size_t)NTOK * NSLOT * DM * 2 / 16; for (size_t i = (size_t)blockIdx.x * 512 + F.tid; i < nC; i += (size_t)F.G * 512) zC[i] = (u32x4){0u, 0u, 0u, 0u}; }
        if (blockIdx.x == 0 && F.tid == 0) __hip_atomic_store((unsigned*)(F.ctl + CW_CNT + NEXP), (unsigned)NTOK, RLX_AGENT);
        for (int tok = gw; tok < NTOK; tok += NGW) route_token(F, tok);
    } SEAM(7);

    if (IN(8)) { ph8(F); if (REP == 8) { xcd_barrier(bar); ph8(F); } } SEAM(8);

    if (IN(9)) { ph9(F); if (REP == 9) { xcd_barrier(bar); ph9(F); } } SEAM(9);

    if (IN(10)) {
        const int lane = F.lane; const GAS unsigned char* Cc = (const GAS unsigned char*)(F.ws + WS_C);
        const int wpb = NGW >> 2, b = gw / wpb, wi = gw % wpb;
        f32x4 g2v[4], fg[4];
#pragma unroll
        for (int i = 0; i < 4; ++i) { const int col = 16 * lane + 4 * i; g2v[i] = mod4(MOD + b * 6144 + 5120, col) * (1.0f / C_SCALE); fg[i] = *(const f32x4*)(F.final_g + col); }
        bool bad = false;
#if DBG & (1024 | 2048)
        { const float e0 = __hip_atomic_load((float*)(F.ctl + CW_CHK), RLX_AGENT), r0 = __hip_atomic_load((float*)(F.ctl + CW_CHK) + 1, RLX_AGENT), e1 = __hip_atomic_load((float*)(F.ctl + CW_CHK) + 2, RLX_AGENT), r1 = __hip_atomic_load((float*)(F.ctl + CW_CHK) + 3, RLX_AGENT);
          if (DBG & 1024) bad = bad || !(e0 <= CHK_TOL_A * r0) || !(r0 > 0.f); if (DBG & 2048) bad = bad || !(e1 <= CHK_TOL_B * r1) || !(r1 > 0.f); }
#endif
        for (int r = wi; r < SEQ; r += wpb) { const int m = b * SEQ + r; GAS float* orow = (GAS float*)F.out + (size_t)m * DM + 16 * lane;
            f32x4 x1[4], y[4];
#pragma unroll
            for (int i = 0; i < 4; ++i) { x1[i] = *(const GAS f32x4*)(orow + 4 * i); y[i] = (f32x4){0.f, 0.f, 0.f, 0.f}; }
#pragma unroll
            for (int sl = 0; sl < NSLOT; ++sl) { const u32x4 w = *(const GAS u32x4*)(Cc + ((size_t)m * NSLOT + sl) * DM + 16 * lane);
#pragma unroll
                for (int i = 0; i < 4; ++i) { const int wi_ = (int)w[i]; const f32x2 lo = __builtin_amdgcn_cvt_pk_f32_fp8(wi_, false), hi = __builtin_amdgcn_cvt_pk_f32_fp8(wi_, true); y[i] += (f32x4){lo.x, lo.y, hi.x, hi.y}; } }
            float s2 = 0.f;
#pragma unroll
            for (int i = 0; i < 4; ++i) { const f32x4 v = x1[i] + g2v[i] * y[i]; x1[i] = v; s2 += (v[0] * v[0] + v[1] * v[1]) + (v[2] * v[2] + v[3] * v[3]); }
            const float rstd = 1.0f / sqrtf(wave_sum(s2) * (1.0f / DM) + RMS_EPS) * (bad ? 3.0f : 1.0f);
#pragma unroll
            for (int i = 0; i < 4; ++i) *(GAS f32x4*)(orow + 4 * i) = x1[i] * rstd * fg[i]; }
    }
#undef IN
#undef SEAM
}

extern "C" void kernel_launch(void* const* d_in, const int* in_sizes, int n_in, void* d_out, int out_size, void* d_ws, size_t ws_size, hipStream_t stream) {
    static int grid = 0;
    if (grid == 0) {
        if (n_in != 20 || in_sizes[0] != NTOK * DM || out_size != NTOK * DM || ws_size < WS_END) { fprintf(stderr, "kernel_launch: unexpected shapes (n_in %d, in0 %d, out %d, ws %zu < %zu)\n", n_in, n_in > 0 ? in_sizes[0] : -1, out_size, ws_size, (size_t)WS_END); grid = -1; return; }
        int dev = 0, cus = 0, per_cu = 0;
        if (hipGetDevice(&dev) != hipSuccess || hipDeviceGetAttribute(&cus, hipDeviceAttributeMultiprocessorCount, dev) != hipSuccess) { grid = -1; return; }
        if (hipFuncSetAttribute((const void*)mk_fwd, hipFuncAttributeMaxDynamicSharedMemorySize, LDS_BYTES) != hipSuccess) { fprintf(stderr, "kernel_launch: hipFuncSetAttribute failed\n"); grid = -1; return; }
        if (hipOccupancyMaxActiveBlocksPerMultiprocessor(&per_cu, (const void*)mk_fwd, 512, LDS_BYTES) != hipSuccess || per_cu < 1) fprintf(stderr, "kernel_launch: occupancy query reports %d\n", per_cu);
        (void)hipGetLastError();
        grid = cus;
    }
    if (grid < 0) return;
    (void)hipMemsetAsync((char*)d_ws + WS_CTL, 0, CTL_ZERO_BYTES, stream);
    Args a{};
    for (int i = 0; i < 20; ++i) a.in[i] = (const float*)d_in[i];
    a.out = (float*)d_out; a.ws = (unsigned char*)d_ws;
    if (N_LAUNCHES == 1) { a.ph_lo = 0; a.ph_hi = PER_PHASE; hipLaunchKernelGGL(mk_fwd, dim3(grid), dim3(512), LDS_BYTES, stream, a); }
    else for (int li = 0; li < PER_PHASE; ++li) { a.ph_lo = li; a.ph_hi = li + 1; hipLaunchKernelGGL(mk_fwd, dim3(grid), dim3(512), LDS_BYTES, stream, a); }
}
```

```cpp
#include <hip/hip_runtime.h>
#include <hip/hip_bf16.h>
#include <cstdio>
#include <cstdint>
#include <cmath>

#ifndef MK_N_LAUNCHES
#define MK_N_LAUNCHES 1
#endif
constexpr int PER_PHASE = 11;
#ifndef DBG
#define DBG 0
#endif
#ifndef REP
#define REP -1
#endif
#ifndef CHK_TOL_A
#define CHK_TOL_A 1e-3f
#endif
#ifndef CHK_TOL_B
#define CHK_TOL_B 1e-3f
#endif
#ifndef ATTN_PRIO
#define ATTN_PRIO 1
#endif
#ifndef FOURIER_MFMA
#define FOURIER_MFMA 1
#endif
#define REPS(k) for (int rep_ = 0; rep_ < ((REP == (k)) ? 2 : 1); ++rep_)
#define REPBAR() do { if (rep_) xcd_barrier(bar); } while (0)
constexpr int N_LAUNCHES = MK_N_LAUNCHES;

#define GAS __attribute__((address_space(1)))
#define LAS __attribute__((address_space(3)))
typedef unsigned short u16;
typedef short bf16x8 __attribute__((ext_vector_type(8)));
typedef _Float16 half8 __attribute__((ext_vector_type(8)));
typedef _Float16 half2v __attribute__((ext_vector_type(2)));
typedef float f32x4 __attribute__((ext_vector_type(4)));
typedef float f32x2 __attribute__((ext_vector_type(2)));
typedef unsigned u32x4 __attribute__((ext_vector_type(4)));
typedef unsigned u32x2 __attribute__((ext_vector_type(2)));
typedef GAS unsigned gu32;

constexpr int DM = 1024, NB = 4, SEQ = 8192, NTOK = NB * SEQ, CTXL = 256, NCTX = NB * CTXL, LKV = SEQ + CTXL;
constexpr int NQH = 12, NKVH = 4, HD = 64, QW = NQH * HD, KVW = NKVH * HD;
constexpr int NIN = 1792;
constexpr int MIN_ROWS = NTOK + NCTX;
constexpr int NEXP = 256, NEXPS = 257, TOPK = 8, EFF = 256, NSLOT = 9;
constexpr int MAXTILES = 1408;
constexpr float RMS_EPS = 1e-6f;
#ifndef MOE_F16
#define MOE_F16 0
#endif
constexpr bool MOEF16 = MOE_F16;
#ifndef MOE_FP8
#define MOE_FP8 1
#endif
constexpr int MOE_DT = MOE_FP8 ? 2 : (MOE_F16 ? 1 : 0);
constexpr float WGU_SCALE = 32.0f, WD_SCALE = 16.0f;
constexpr int SC_ONE = 0x7f7f7f7f, SC_GU = 0x7a7a7a7a, SC_D = 0x7b7b7b7b;
constexpr float C2 = 0.125f * 1.4426950408889634f;
constexpr float C_SCALE = 16.0f;

constexpr size_t MiB = 1u << 20;
constexpr size_t WS_CTL = 0, CTL_ZERO_BYTES = 1 * MiB;
constexpr size_t WS_TAB = 1 * MiB;
constexpr size_t WS_BIN = 2 * MiB;
constexpr size_t WS_BOUT = 6 * MiB;
constexpr size_t WS_BR = 8 * MiB;
constexpr size_t WS_K = 16 * MiB;
constexpr size_t WS_V = 34 * MiB;
constexpr size_t WS_Z = 52 * MiB;
constexpr size_t WS_Q = 84 * MiB;
constexpr size_t WS_XN = 132 * MiB;
constexpr size_t WS_MIX = 198 * MiB;
constexpr size_t WS_H2 = 262 * MiB;
constexpr size_t WS_LOG = 326 * MiB;
constexpr size_t WS_LIST = 358 * MiB;
constexpr size_t WS_BGU = 424 * MiB;
constexpr size_t WS_BD = 682 * MiB;
constexpr size_t WS_ACT = 812 * MiB;
constexpr size_t WS_C = 990 * MiB;
constexpr size_t WS_H2F8 = 1568 * MiB;
constexpr size_t WS_END = 1600 * MiB;
constexpr int CW_TMO = 0, CW_CODE = 1;
constexpr int CW_BAR = 4096;
constexpr int CW_CNT = 16384;
constexpr int CW_CHK = 32768;
constexpr int CW_MOD = 131072;
static_assert(CW_MOD * 4 + 5 * 6144 * 8 <= (int)CTL_ZERO_BYTES, "ctl");

constexpr int RING_OFF = 0, RING_BYTES = 131072;
constexpr int TAB_OFF = RING_BYTES;
constexpr int LDSCTL_OFF = RING_BYTES + 8192, MISC_OFF = LDSCTL_OFF + 320;
constexpr int LDS_BYTES = 147456;

#define LDS_WAIT() asm volatile("s_waitcnt lgkmcnt(0)" ::: "memory")
#define VM_WAIT() asm volatile("s_waitcnt vmcnt(0)" ::: "memory")
#define RLX_AGENT __ATOMIC_RELAXED, __HIP_MEMORY_SCOPE_AGENT

__device__ __forceinline__ unsigned f2bf(float f) { unsigned u = __builtin_bit_cast(unsigned, f); return (u + 0x7fffu + ((u >> 16) & 1u)) >> 16; }
__device__ __forceinline__ unsigned pk2bf(float lo, float hi) { return f2bf(lo) | (f2bf(hi) << 16); }
__device__ __forceinline__ unsigned pk2h(float lo, float hi) { half2v v = {(_Float16)lo, (_Float16)hi}; return __builtin_bit_cast(unsigned, v); }
__device__ __forceinline__ unsigned cvt_pk_bf16(float lo, float hi) { unsigned r; asm volatile("v_cvt_pk_bf16_f32 %0, %1, %2" : "=v"(r) : "v"(lo), "v"(hi)); return r; }
__device__ __forceinline__ float bflo(unsigned w) { return __builtin_bit_cast(float, w << 16); }
__device__ __forceinline__ float bfhi(unsigned w) { return __builtin_bit_cast(float, w & 0xffff0000u); }
typedef long long i64x2 __attribute__((ext_vector_type(2)));
typedef GAS long long gi64;
__device__ __forceinline__ f32x4 mod4(const gi64* MODQ, int idx) {
    const i64x2 a = *(const GAS i64x2*)(MODQ + idx), b = *(const GAS i64x2*)(MODQ + idx + 2);
    return (f32x4){(float)a.x, (float)a.y, (float)b.x, (float)b.y} * 0x1p-36f;
}
__device__ __forceinline__ float wave_sum(float v) {
#pragma unroll
    for (int o = 1; o < 64; o <<= 1) v += __shfl_xor(v, o);
    return v;
}

namespace pg8 {
constexpr int BM = 256, BK = 64, HALF = 128, HTB = HALF * BK * 2, STAGE_BYTES = 8 * HTB;
__host__ __device__ __forceinline__ int lds_byte(int r, int c) { const int st = (r >> 4) * 2 + (c >> 5), rr = r & 15, cc = c & 31, ob = rr * 64 + cc * 2; return st * 1024 + (ob ^ (((ob >> 9) & 1) << 5)); }
__host__ __device__ __forceinline__ void stage_rc(int b, int& R, int& C) { const int st = b / 1024, sb = b % 1024, swz = sb ^ (((sb >> 9) & 1) << 5); R = (st >> 1) * 16 + swz / 64; C = (st & 1) * 32 + (swz % 64) / 2; }
__host__ __device__ __forceinline__ int perm32(int rho) { const int n = rho >> 4, i = rho & 15; return 8 * (i >> 2) + 4 * n + (i & 3); }

struct GUnit { int pm, pn, e, j, nvalid; const char* B; };

typedef int v8i __attribute__((ext_vector_type(8)));
typedef int v4i __attribute__((ext_vector_type(4)));
template <int DT> __device__ __forceinline__ f32x4 mma_tile(const v8i a, const v8i b, f32x4 c, int scA) {
    if constexpr (DT == 2) return __builtin_amdgcn_mfma_scale_f32_16x16x128_f8f6f4(a, b, c, 0, 0, 0, scA, 0, SC_ONE);
    else { const v4i a0 = __builtin_shufflevector(a, a, 0, 1, 2, 3), a1 = __builtin_shufflevector(a, a, 4, 5, 6, 7), b0 = __builtin_shufflevector(b, b, 0, 1, 2, 3), b1 = __builtin_shufflevector(b, b, 4, 5, 6, 7);
        if constexpr (DT == 1) { c = __builtin_amdgcn_mfma_f32_16x16x32_f16(__builtin_bit_cast(half8, a0), __builtin_bit_cast(half8, b0), c, 0, 0, 0); return __builtin_amdgcn_mfma_f32_16x16x32_f16(__builtin_bit_cast(half8, a1), __builtin_bit_cast(half8, b1), c, 0, 0, 0); }
        else { c = __builtin_amdgcn_mfma_f32_16x16x32_bf16(__builtin_bit_cast(bf16x8, a0), __builtin_bit_cast(bf16x8, b0), c, 0, 0, 0); return __builtin_amdgcn_mfma_f32_16x16x32_bf16(__builtin_bit_cast(bf16x8, a1), __builtin_bit_cast(bf16x8, b1), c, 0, 0, 0); } }
}

template <class Epi, class Sched, int DT, bool ALIGN_EPI>
__device__ __forceinline__ void gemm_phase(LAS unsigned char* lds, const char* Abase, const int K, const Sched& S, const Epi& E, const int scB = SC_ONE) {
    const int tid = threadIdx.x, wid = __builtin_amdgcn_readfirstlane(tid >> 6), lane = tid & 63, wr = wid >> 2, wc = wid & 3, fr = lane & 15, fq = lane >> 4;
    constexpr int ES = (DT == 2) ? 1 : 2;
    const int RB = K * ES;
    const int nt = RB / 128;
    unsigned voffB[2];
#pragma unroll
    for (int i = 0; i < 2; ++i) { int R, C; stage_rc(tid * 16 + i * 8192, R, C); const int Rb = Epi::PERM ? ((R & ~31) + perm32(R & 31)) : R; voffB[i] = (unsigned)(Rb * RB + C * 2); }
#define PG8_AOFF(V, UNIT) do { int t_ = tid; asm volatile("" : "+v"(t_)); _Pragma("unroll") for (int _i = 0; _i < 2; ++_i) { int R_, C_; stage_rc(t_ * 16 + _i * 8192, R_, C_); \
        _Pragma("unroll") for (int _h = 0; _h < 2; ++_h) (V)[_h][_i] = (unsigned)S.arow(UNIT, R_ + HALF * _h) * (unsigned)RB + (unsigned)(C_ * 2); } } while (0)
    const size_t kstep = (size_t)(BK * 2);
    const size_t hstep = (size_t)HALF * RB;
    const unsigned ldsw = (unsigned)wid * 1024u;
    const int ac0 = (DT == 2) ? 16 * fq : 8 * fq; constexpr int CH1 = (DT == 2) ? 16 : 1024;
    const int aoff = lds_byte(wr * 64 + fr, ac0), boff = lds_byte(wc * 32 + fr, ac0);
#define PG8_SA(b, h) (((b) * 2 + (h)) * HTB)
#define PG8_SB(b, h) ((4 + (b) * 2 + (h)) * HTB)
#define PG8_STAGEB(bufoff, gbase) do { _Pragma("unroll") for (int _i = 0; _i < 2; ++_i) \
        __builtin_amdgcn_global_load_lds((const unsigned*)((const char*)(gbase) + voffB[_i]), (LAS unsigned*)(lds + (bufoff) + ldsw + _i * 8192), 16, 0, 0); } while (0)
#define PG8_STAGEA(bufoff, koff, V, h) do { _Pragma("unroll") for (int _i = 0; _i < 2; ++_i) \
        __builtin_amdgcn_global_load_lds((const unsigned*)(Abase + (size_t)(V)[h][_i] + (koff)), (LAS unsigned*)(lds + (bufoff) + ldsw + _i * 8192), 16, 0, 0); } while (0)
#define PG8_LDA(dst, b, h) do { _Pragma("unroll") for (int m = 0; m < 4; ++m) { const v4i c0_ = *(const LAS v4i*)(lds + PG8_SA(b, h) + aoff + m * 2048), c1_ = *(const LAS v4i*)(lds + PG8_SA(b, h) + aoff + m * 2048 + CH1); dst[m] = __builtin_shufflevector(c0_, c1_, 0, 1, 2, 3, 4, 5, 6, 7); } } while (0)
#define PG8_LDB(dst, b, h) do { _Pragma("unroll") for (int n = 0; n < 2; ++n) { const v4i c0_ = *(const LAS v4i*)(lds + PG8_SB(b, h) + boff + n * 2048), c1_ = *(const LAS v4i*)(lds + PG8_SB(b, h) + boff + n * 2048 + CH1); dst[n] = __builtin_shufflevector(c0_, c1_, 0, 1, 2, 3, 4, 5, 6, 7); } } while (0)
#define PG8_MMA(ai, bj, At, Bt) do { __builtin_amdgcn_s_setprio(1); _Pragma("unroll") for (int m = 0; m < 4; ++m) _Pragma("unroll") for (int n = 0; n < 2; ++n) \
        acc[ai][bj][m][n] = mma_tile<DT>(Bt[n], At[m], acc[ai][bj][m][n], scB); __builtin_amdgcn_s_setprio(0); } while (0)
#define PG8_WAIT_V(n) asm volatile("s_waitcnt vmcnt(" #n ")" ::: "memory")
#define PG8_WAIT_L(n) asm volatile("s_waitcnt lgkmcnt(" #n ")" ::: "memory")
#define PG8_BAR __builtin_amdgcn_s_barrier()
#define PG8_SCHED __builtin_amdgcn_sched_barrier(0)
    GUnit cur, nxt; int ui = 0;
    if (!S.next(0, cur)) return;
    f32x4 acc[2][2][4][2];
#pragma unroll
    for (int a = 0; a < 2; ++a)
#pragma unroll
        for (int b = 0; b < 2; ++b)
#pragma unroll
            for (int m = 0; m < 4; ++m)
#pragma unroll
                for (int n = 0; n < 2; ++n) acc[a][b][m][n] = (f32x4){0.f, 0.f, 0.f, 0.f};
    v8i At[4], B0[2], B1[2];
    unsigned vA[2][2];
    PG8_AOFF(vA, cur);
    if constexpr (Sched::GATHER) VM_WAIT();
    const char* cB = cur.B;
    PG8_STAGEB(PG8_SB(0, 0), cB); PG8_STAGEB(PG8_SB(0, 1), cB + hstep); PG8_STAGEA(PG8_SA(0, 0), 0, vA, 0); PG8_STAGEA(PG8_SA(0, 1), 0, vA, 1);
    if (wr == 1) PG8_BAR;
    PG8_WAIT_V(2); PG8_BAR;
    PG8_STAGEB(PG8_SB(1, 0), cB + kstep); PG8_STAGEA(PG8_SA(1, 0), kstep, vA, 0); PG8_STAGEB(PG8_SB(1, 1), cB + hstep + kstep);
    PG8_WAIT_V(6); PG8_BAR;
    for (;;) {
        const bool has_next = S.next(ui + 1, nxt);
#pragma unroll 1
        for (int t = 0; t < nt; t += 2) {
            const bool last = (t == nt - 2);
            const size_t k1 = (size_t)(t + 1) * kstep;
            PG8_LDB(B0, 0, 0); PG8_LDB(B1, 0, 1); PG8_SCHED; PG8_LDA(At, 0, 0); PG8_STAGEA(PG8_SA(1, 1), k1, vA, 1);
            PG8_WAIT_V(8); PG8_WAIT_L(0); PG8_BAR; PG8_MMA(0, 0, At, B0); PG8_MMA(0, 1, At, B1); PG8_BAR; PG8_SCHED;
            size_t k2 = (size_t)(t + 2) * kstep;
            if (last) { k2 = 0; if (has_next) { PG8_AOFF(vA, nxt); if constexpr (Sched::GATHER) VM_WAIT(); cB = nxt.B; } }
            const size_t k3 = k2 + kstep; const char* b2 = cB + k2; const char* b3 = b2 + kstep;
            PG8_LDA(At, 0, 1); PG8_STAGEB(PG8_SB(0, 0), b2); PG8_STAGEB(PG8_SB(0, 1), b2 + hstep); PG8_STAGEA(PG8_SA(0, 0), k2, vA, 0);
            PG8_WAIT_V(8); PG8_WAIT_L(0); PG8_BAR; PG8_MMA(1, 0, At, B0); PG8_MMA(1, 1, At, B1); PG8_BAR; PG8_SCHED;
            PG8_LDB(B0, 1, 0); PG8_LDB(B1, 1, 1); PG8_SCHED; PG8_LDA(At, 1, 0); PG8_STAGEA(PG8_SA(0, 1), k2, vA, 1);
            PG8_WAIT_V(8); PG8_WAIT_L(0); PG8_BAR; PG8_MMA(0, 0, At, B0); PG8_MMA(0, 1, At, B1); PG8_BAR; PG8_SCHED;
            PG8_LDA(At, 1, 1); PG8_STAGEB(PG8_SB(1, 0), b3); PG8_STAGEB(PG8_SB(1, 1), b3 + hstep); PG8_STAGEA(PG8_SA(1, 0), k3, vA, 0);
            PG8_WAIT_V(8); PG8_WAIT_L(0); PG8_BAR; PG8_MMA(1, 0, At, B0); PG8_MMA(1, 1, At, B1); PG8_BAR; PG8_SCHED;
        }
        if constexpr (ALIGN_EPI) { if (wr == 0) PG8_BAR; }
        { int frx = fr, fqx = fq; asm volatile("" : "+v"(frx), "+v"(fqx)); E(acc, cur, wr, wc, frx, fqx); }
        if (!has_next) break;
#pragma unroll
        for (int a = 0; a < 2; ++a)
#pragma unroll
            for (int b = 0; b < 2; ++b)
#pragma unroll
                for (int m = 0; m < 4; ++m)
#pragma unroll
                    for (int n = 0; n < 2; ++n) acc[a][b][m][n] = (f32x4){0.f, 0.f, 0.f, 0.f};
        cur = nxt; ++ui;
        if constexpr (ALIGN_EPI) { if (wr == 1) PG8_BAR; }
    }
    PG8_WAIT_V(0);
    if constexpr (!ALIGN_EPI) { if (wr == 0) PG8_BAR; }
    PG8_BAR;
#undef PG8_SA
#undef PG8_SB
#undef PG8_STAGEA
#undef PG8_AOFF
#undef PG8_STAGEB
#undef PG8_LDA
#undef PG8_LDB
#undef PG8_MMA
#undef PG8_WAIT_V
#undef PG8_WAIT_L
#undef PG8_BAR
#undef PG8_SCHED
}
}

namespace attn_body {
using bf16 = __hip_bfloat16;
using s16x4 = __attribute__((ext_vector_type(4))) short;
using f32x16 = __attribute__((ext_vector_type(16))) float;
constexpr int D = 64, DMQ = QW, DMKV = KVW, DMO = DM;
constexpr int NW = 8, QBLK = 32, QB = QBLK * NW, KVBLK = 64, NT = LKV / KVBLK;
static_assert(NT % 2 == 0 && NT >= 8, "tile count");
__device__ __forceinline__ int crow(int r, int hi) { return (r & 3) + 8 * (r >> 2) + 4 * hi; }
#define SBAR() __builtin_amdgcn_sched_barrier(0)
constexpr int NSLOTR = 3, SLOTB = 8192;
constexpr int LDS_K = 0, LDS_V = NSLOTR * SLOTB, LDS_WS = 2 * NSLOTR * SLOTB, LDS_OST = LDS_WS + NW * 64 * 4, ATT_LDS_BYTES = LDS_OST + NW * 4096;
__device__ __forceinline__ void glds16(const void* gsrc, unsigned lds_dst) { unsigned keep;
    asm volatile("s_mov_b32 %0, m0\n\ts_mov_b32 m0, %2\n\ts_nop 0\n\tglobal_load_lds_dwordx4 %1, off\n\ts_mov_b32 m0, %0" : "=&s"(keep) : "v"(gsrc), "s"(lds_dst) : "memory"); }
__device__ __forceinline__ float max3f(float a, float b, float c) { float r; asm("v_max3_f32 %0, %1, %2, %3" : "=v"(r) : "v"(a), "v"(b), "v"(c)); return r; }
__device__ __forceinline__ float max2f(float a, float b) { float r; asm("v_max_f32_e32 %0, %1, %2" : "=v"(r) : "v"(a), "v"(b)); return r; }
__device__ __forceinline__ float fadd_s(float a, float b) { float r; asm("v_add_f32_e32 %0, %1, %2" : "=v"(r) : "v"(a), "v"(b)); return r; }
__device__ __forceinline__ float fsub_s(float a, float b) { float r; asm("v_sub_f32_e32 %0, %1, %2" : "=v"(r) : "v"(a), "v"(b)); return r; }
typedef float f32x2_t __attribute__((ext_vector_type(2))); typedef __bf16 bf16x2_t __attribute__((ext_vector_type(2)));
__device__ __forceinline__ unsigned cvtpk_s(float lo, float hi) { f32x2_t v = {lo, hi}; bf16x2_t b = __builtin_convertvector(v, bf16x2_t); return __builtin_bit_cast(unsigned, b); }
#define WAIT_BAR(N) asm volatile("s_waitcnt vmcnt(" #N ") lgkmcnt(0)\n\ts_barrier" ::: "memory")

__device__ __forceinline__ void qkt(f32x16& p0, f32x16& p1, const char* Kslot, const bf16x8* qr, const f32x16& negm, int r32, int hi) {
    const char* kb = Kslot + hi * 1024 + r32 * 16;
#pragma unroll
    for (int d0 = 0; d0 < 4; ++d0) {
        const bf16x8 b0 = *reinterpret_cast<const bf16x8*>(kb + d0 * 2048);
        const bf16x8 b1 = *reinterpret_cast<const bf16x8*>(kb + d0 * 2048 + 512);
        if (d0 == 0) { p0 = __builtin_amdgcn_mfma_f32_32x32x16_bf16(b0, qr[0], negm, 0, 0, 0); p1 = __builtin_amdgcn_mfma_f32_32x32x16_bf16(b1, qr[0], negm, 0, 0, 0); }
        else { p0 = __builtin_amdgcn_mfma_f32_32x32x16_bf16(b0, qr[d0], p0, 0, 0, 0); p1 = __builtin_amdgcn_mfma_f32_32x32x16_bf16(b1, qr[d0], p1, 0, 0, 0); } }
}
typedef __attribute__((address_space(3))) const char* lds_cptr;
typedef short v4i16_t __attribute__((ext_vector_type(4)));
__device__ __forceinline__ void kload8(bf16x8* kf, lds_cptr kp) {
    kf[0] = *(const __attribute__((address_space(3))) bf16x8*)(kp);        kf[1] = *(const __attribute__((address_space(3))) bf16x8*)(kp + 512);
    kf[2] = *(const __attribute__((address_space(3))) bf16x8*)(kp + 2048); kf[3] = *(const __attribute__((address_space(3))) bf16x8*)(kp + 2560);
    kf[4] = *(const __attribute__((address_space(3))) bf16x8*)(kp + 4096); kf[5] = *(const __attribute__((address_space(3))) bf16x8*)(kp + 4608);
    kf[6] = *(const __attribute__((address_space(3))) bf16x8*)(kp + 6144); kf[7] = *(const __attribute__((address_space(3))) bf16x8*)(kp + 6656);
}
__device__ __forceinline__ void kload2(bf16x8* kf, lds_cptr kp, int j) { kf[2 * j] = *(const __attribute__((address_space(3))) bf16x8*)(kp + j * 2048); kf[2 * j + 1] = *(const __attribute__((address_space(3))) bf16x8*)(kp + j * 2048 + 512); }
__device__ __forceinline__ s16x4 vtr(lds_cptr p) { return __builtin_bit_cast(s16x4, __builtin_amdgcn_ds_read_tr16_b64_v4i16((__attribute__((address_space(3))) v4i16_t*)p)); }
__device__ __forceinline__ float rowmax(const f32x16& p0, const f32x16& p1) {
    float a = max3f(p0[0], p0[1], p1[0]), b = max3f(p0[2], p0[3], p1[1]); a = max3f(a, p1[2], p1[3]);
#pragma unroll
    for (int r = 4; r < 16; r += 4) { a = max3f(a, p0[r], p0[r + 1]); b = max3f(b, p0[r + 2], p0[r + 3]); a = max3f(a, p1[r], p1[r + 1]); b = max3f(b, p1[r + 2], p1[r + 3]); }
    const float m = max2f(a, b);
    auto rr = __builtin_amdgcn_permlane32_swap(__float_as_uint(m), __float_as_uint(m), false, false);
    return max2f(__uint_as_float(rr[0]), __uint_as_float(rr[1]));
}
__device__ __forceinline__ void pv(f32x16* o, int vb, bf16x8 pa0, bf16x8 pa1, bf16x8 pa2, bf16x8 pa3) {
#pragma unroll
    for (int d0 = 0; d0 < 2; ++d0) { s16x4 lo[4], hi[4];
#pragma unroll
        for (int ks = 0; ks < 4; ++ks) {
            asm volatile("ds_read_b64_tr_b16 %0,%1 offset:%c2" : "=&v"(lo[ks]) : "v"(vb), "i"(d0 * 4096 + ks * 1024) : "memory");
            asm volatile("ds_read_b64_tr_b16 %0,%1 offset:%c2" : "=&v"(hi[ks]) : "v"(vb), "i"(d0 * 4096 + ks * 1024 + 512) : "memory"); }
        asm volatile("s_waitcnt lgkmcnt(0)" ::: "memory"); SBAR();
#define PK(k) (bf16x8){lo[k][0], lo[k][1], lo[k][2], lo[k][3], hi[k][0], hi[k][1], hi[k][2], hi[k][3]}
        o[d0] = __builtin_amdgcn_mfma_f32_32x32x16_bf16(pa0, PK(0), o[d0], 0, 0, 0);
        o[d0] = __builtin_amdgcn_mfma_f32_32x32x16_bf16(pa1, PK(1), o[d0], 0, 0, 0);
        o[d0] = __builtin_amdgcn_mfma_f32_32x32x16_bf16(pa2, PK(2), o[d0], 0, 0, 0);
        o[d0] = __builtin_amdgcn_mfma_f32_32x32x16_bf16(pa3, PK(3), o[d0], 0, 0, 0);
#undef PK
    }
}
template <int THRL> __device__ __forceinline__ void attn_unit(int b, int h, int qb, const bf16* Q, const bf16* __restrict__ K, const bf16* __restrict__ V, bf16* O, char* shm, float negM_) {
    const int tid = threadIdx.x, lane = tid & 63, r32 = lane & 31, hi = lane >> 5; const int wid = __builtin_amdgcn_readfirstlane(tid >> 6);
    const int q0 = qb * QB; const int kvh = h / 3;
    const long qrow0 = (long)b * SEQ + q0 + wid * QBLK;
    const long kvrow0 = (long)b * LKV;
    const bf16* Qw = Q + qrow0 * DMQ + h * D;
    const bf16* Kh = K + kvrow0 * DMKV + kvh * D, *Vh = V + kvrow0 * DMKV + kvh * D;
    const unsigned lds0 = (unsigned)(uintptr_t)shm;
    float* wsf = (float*)(shm + LDS_WS) + wid * 64;
    const bf16* ksrc = Kh + (long)lane * DMKV + wid * 8;
    const bf16* vsrc = Vh + (long)(16 * (wid & 3) + (lane >> 2)) * DMKV + (wid >> 2) * 32 + (lane & 3) * 8;
    const unsigned kdst = lds0 + LDS_K + wid * 1024, vdst = lds0 + LDS_V + wid * 1024;
#define DMA_K(t, slot) glds16(ksrc + (long)(t) * KVBLK * DMKV, (unsigned)__builtin_amdgcn_readfirstlane(kdst + (slot)))
#define DMA_V(t, slot) glds16(vsrc + (long)(t) * KVBLK * DMKV, (unsigned)__builtin_amdgcn_readfirstlane(vdst + (slot)))
    const int vb0 = (int)(lds0 + LDS_V) + ((lane >> 4) & 1) * 32 + (lane & 3) * 8 + (4 * hi + ((lane & 15) >> 2)) * 64;
    const char* Kbase = shm + LDS_K; bf16x8 kf[8];
    const lds_cptr shm3 = (lds_cptr)shm; const lds_cptr kp0 = shm3 + LDS_K + hi * 1024 + r32 * 16; const lds_cptr vp0 = shm3 + LDS_V + ((lane >> 4) & 1) * 32 + (lane & 3) * 8 + (4 * hi + ((lane & 15) >> 2)) * 64;
    DMA_K(0, 0); DMA_V(0, 0); DMA_K(1, SLOTB);
    bf16x8 qr[4];
#pragma unroll
    for (int d0 = 0; d0 < 4; ++d0) qr[d0] = *reinterpret_cast<const bf16x8*>(&Qw[(long)r32 * DMQ + d0 * 16 + hi * 8]);
    float l_reg = 0.f; f32x16 o[2]; o[0] = f32x16{}; o[1] = f32x16{}; f32x16 negm;
    _Pragma("unroll") for (int r = 0; r < 16; ++r) negm[r] = negM_;
    asm volatile("" : "+v"(negm));
#define START(P0, P1) do { _Pragma("unroll") for (int r = 0; r < 16; ++r) P0[r] = __builtin_amdgcn_exp2f(P0[r]); } while (0)
#define RESC() do { } while (0)
    f32x16 pA0, pA1, pB0, pB1;
    int sl_prev = 0, sl_cur = 0, sl_next = SLOTB;
#define ROT() do { sl_prev = sl_cur; sl_cur = sl_next; sl_next = (sl_next == (NSLOTR - 1) * SLOTB) ? 0 : sl_next + SLOTB; } while (0)
    DMA_K(2, 2 * SLOTB);
    WAIT_BAR(3);
    qkt(pA0, pA1, Kbase, qr, negm, r32, hi); asm volatile("s_nop 15\n\ts_nop 7" : "+v"(pA0), "+v"(pA1));
    START(pA0, pA1);
    _Pragma("unroll") for (int r = 0; r < 16; ++r) pA1[r] = __builtin_amdgcn_exp2f(pA1[r]);
    WAIT_BAR(0);
    DMA_K(3, 0); DMA_V(1, SLOTB);
    ROT();
    kload8(kf, kp0 + sl_cur);
    WAIT_BAR(2);
    s16x4 vlo[8], vhi[8]; u32x4 pw0, pw1, pw2, pw3;
#define PKW(P, B) cvtpk_s(P[B], P[B + 1])
#define PAF(k) __builtin_bit_cast(bf16x8, pw##k)
#define VFR(i) (bf16x8){vlo[i][0], vlo[i][1], vlo[i][2], vlo[i][3], vhi[i][0], vhi[i][1], vhi[i][2], vhi[i][3]}
#define PIN(x) asm volatile("" : "+v"(x))
#define MX3(a, b, c) __builtin_fmaxf(__builtin_fmaxf((a), (b)), (c))
#define GAPA(MF, A0, A1, A2, A3, W0, W1, PW) do { MF; sacc += A0; sacc += A1; sacc += A2; sacc += A3; PIN(sacc); W0; W1; PIN(PW); SBAR(); } while (0)
#define EX(v) __builtin_amdgcn_exp2f(v)
#define GAPB(MF, X, B) do { MF; X[B] = EX(X[B]); X[B + 1] = EX(X[B + 1]); X[B + 2] = EX(X[B + 2]); X[B + 3] = EX(X[B + 3]); PIN(X); SBAR(); } while (0)
#define VRD(i) do { vlo[i] = vtr(vp_ + (((i) >> 2) * 4096 + ((i) & 3) * 1024)); vhi[i] = vtr(vp_ + (((i) >> 2) * 4096 + ((i) & 3) * 1024 + 512)); } while (0)
#define KRD(G, j) do { if (G) { kload2(kf, kp0 + sl_next, j); SBAR(); } } while (0)
#define STEP(C0, C1, P0, P1, t, GK, GV, GL) do { SBAR(); \
    const lds_cptr vp_ = vp0 + sl_prev; \
    VRD(0); SBAR(); float sacc = (P0[0] + P0[1]); \
    GAPA(C0 = __builtin_amdgcn_mfma_f32_32x32x16_bf16(kf[0], qr[0], negm, 0, 0, 0), P0[2], P0[3], P0[4], P0[5],     pw0[0] = PKW(P0, 0), pw0[1] = PKW(P0, 2), pw0); \
    VRD(4); SBAR(); GAPA(C1 = __builtin_amdgcn_mfma_f32_32x32x16_bf16(kf[1], qr[0], negm, 0, 0, 0), P0[6], P0[7], P0[8], P0[9],     pw0[2] = PKW(P0, 4), pw0[3] = PKW(P0, 6), pw0); \
    VRD(1); SBAR(); GAPA(C0 = __builtin_amdgcn_mfma_f32_32x32x16_bf16(kf[2], qr[1], C0, 0, 0, 0),   P0[10], P0[11], P0[12], P0[13], pw1[0] = PKW(P0, 8), pw1[1] = PKW(P0, 10), pw1); \
    VRD(5); SBAR(); GAPA(C1 = __builtin_amdgcn_mfma_f32_32x32x16_bf16(kf[3], qr[1], C1, 0, 0, 0),   P0[14], P0[15], P1[0], P1[1],   pw1[2] = PKW(P0, 12), pw1[3] = PKW(P0, 14), pw1); \
    VRD(2); SBAR(); GAPA(C0 = __builtin_amdgcn_mfma_f32_32x32x16_bf16(kf[4], qr[2], C0, 0, 0, 0),   P1[2], P1[3], P1[4], P1[5],     pw2[0] = PKW(P1, 0), pw2[1] = PKW(P1, 2), pw2); \
    VRD(6); SBAR(); GAPA(C1 = __builtin_amdgcn_mfma_f32_32x32x16_bf16(kf[5], qr[2], C1, 0, 0, 0),   P1[6], P1[7], P1[8], P1[9],     pw2[2] = PKW(P1, 4), pw2[3] = PKW(P1, 6), pw2); \
    VRD(3); SBAR(); GAPA(C0 = __builtin_amdgcn_mfma_f32_32x32x16_bf16(kf[6], qr[3], C0, 0, 0, 0),   P1[10], P1[11], P1[12], P1[13], pw3[0] = PKW(P1, 8), pw3[1] = PKW(P1, 10), pw3); \
    VRD(7); SBAR(); GAPA(C1 = __builtin_amdgcn_mfma_f32_32x32x16_bf16(kf[7], qr[3], C1, 0, 0, 0),   P1[14], P1[15], 0.f, 0.f,       pw3[2] = PKW(P1, 12), pw3[3] = PKW(P1, 14), pw3); \
    l_reg += sacc; \
    if (GK) { DMA_K((t) + 3, sl_cur); } if (GV) { DMA_V((t) + 1, sl_next); } \
    SBAR(); \
    GAPB(o[0] = __builtin_amdgcn_mfma_f32_32x32x16_bf16(PAF(0), VFR(0), o[0], 0, 0, 0), C0, 0); \
    GAPB(o[1] = __builtin_amdgcn_mfma_f32_32x32x16_bf16(PAF(0), VFR(4), o[1], 0, 0, 0), C0, 4); \
    KRD(GL, 0); GAPB(o[0] = __builtin_amdgcn_mfma_f32_32x32x16_bf16(PAF(1), VFR(1), o[0], 0, 0, 0), C0, 8); \
    KRD(GL, 1); GAPB(o[1] = __builtin_amdgcn_mfma_f32_32x32x16_bf16(PAF(1), VFR(5), o[1], 0, 0, 0), C0, 12); \
    KRD(GL, 2); GAPB(o[0] = __builtin_amdgcn_mfma_f32_32x32x16_bf16(PAF(2), VFR(2), o[0], 0, 0, 0), C1, 0); \
    KRD(GL, 3); GAPB(o[1] = __builtin_amdgcn_mfma_f32_32x32x16_bf16(PAF(2), VFR(6), o[1], 0, 0, 0), C1, 4); \
    GAPB(o[0] = __builtin_amdgcn_mfma_f32_32x32x16_bf16(PAF(3), VFR(3), o[0], 0, 0, 0), C1, 8); \
    GAPB(o[1] = __builtin_amdgcn_mfma_f32_32x32x16_bf16(PAF(3), VFR(7), o[1], 0, 0, 0), C1, 12); \
    } while (0)
    int t = 1;
    for (; t + 5 < NT; t += 2) {
        STEP(pB0, pB1, pA0, pA1, t, true, true, true);     WAIT_BAR(2); RESC(); ROT();
        STEP(pA0, pA1, pB0, pB1, t + 1, true, true, true); WAIT_BAR(2); RESC(); ROT();
    }
#define ENDW(tt) do { if ((tt) + 3 < NT) { WAIT_BAR(2); } else if ((tt) + 2 < NT) { WAIT_BAR(1); } else { WAIT_BAR(0); } } while (0)
    for (; t + 1 < NT; t += 2) {
        STEP(pB0, pB1, pA0, pA1, t, (t + 3 < NT), (t + 1 < NT), (t + 1 < NT));         ENDW(t);     RESC(); ROT();
        STEP(pA0, pA1, pB0, pB1, t + 1, (t + 4 < NT), (t + 2 < NT), (t + 2 < NT));     ENDW(t + 1); RESC(); ROT();
    }
    STEP(pB0, pB1, pA0, pA1, NT - 1, false, false, false); RESC();
    { float sacc = pB0[0] + pB0[1]; _Pragma("unroll") for (int r = 2; r < 16; ++r) sacc += pB0[r]; _Pragma("unroll") for (int r = 0; r < 16; ++r) sacc += pB1[r]; l_reg += sacc;
      pw0 = (u32x4){PKW(pB0, 0), PKW(pB0, 2), PKW(pB0, 4), PKW(pB0, 6)}; pw1 = (u32x4){PKW(pB0, 8), PKW(pB0, 10), PKW(pB0, 12), PKW(pB0, 14)}; pw2 = (u32x4){PKW(pB1, 0), PKW(pB1, 2), PKW(pB1, 4), PKW(pB1, 6)}; pw3 = (u32x4){PKW(pB1, 8), PKW(pB1, 10), PKW(pB1, 12), PKW(pB1, 14)};
      SBAR(); pv(o, vb0 + sl_cur, PAF(0), PAF(1), PAF(2), PAF(3)); }
#undef PKW
#undef PAF
#undef VFR
#undef PIN
#undef MX3
#undef GAPA
#undef GAPB
#undef EX
#undef VRD
#undef KRD
#undef STEP
#undef ENDW
    { auto rr = __builtin_amdgcn_permlane32_swap(__float_as_uint(l_reg), __float_as_uint(l_reg), false, false); l_reg = __uint_as_float(rr[0]) + __uint_as_float(rr[1]); }
    if (hi == 0) wsf[32 + r32] = l_reg; asm volatile("s_waitcnt lgkmcnt(0)" ::: "memory");
    float rli[16];
#pragma unroll
    for (int r = 0; r < 16; ++r) rli[r] = __builtin_amdgcn_rcpf(wsf[32 + crow(r, hi)]);
    bf16* Ow = O + qrow0 * DMO + h * D;
    { bf16* stg = (bf16*)(shm + LDS_OST) + wid * 2048;
#pragma unroll
      for (int r = 0; r < 16; ++r) { const int orow = crow(r, hi);
#pragma unroll
        for (int d0 = 0; d0 < 2; ++d0) stg[orow * 64 + d0 * 32 + r32] = __float2bfloat16(o[d0][r] * rli[r]); }
      asm volatile("s_waitcnt lgkmcnt(0)" ::: "memory");
#pragma unroll
      for (int i = 0; i < 4; ++i) { const int row = i * 8 + (lane >> 3), ch = lane & 7; const u32x4 v = *(const u32x4*)(stg + row * 64 + ch * 8); *(u32x4*)(Ow + (long)row * DMO + ch * 8) = v; } }
    asm volatile("s_waitcnt lgkmcnt(0)\n\ts_barrier" ::: "memory");
#undef DMA_K
#undef DMA_V
#undef START
#undef RESC
#undef ROT
}
#undef SBAR
#undef WAIT_BAR
}

#define XB_TMO      128
#define XB_XCNT(j)  (256  + 64 * (j))
#define XB_XSUB(j)  (1280 + 64 * (j))
#define XB_XGEN(j)  (2304 + 64 * (j))
#define XB_TOP      3328
#define XB_TOPGEN   3392
#define XCD_BAR_WORDS 3456
#define XB_SPIN_CAP (1u << 18)
__device__ __forceinline__ unsigned xb_ld(unsigned* p)              { return __hip_atomic_load(p, __ATOMIC_RELAXED, __HIP_MEMORY_SCOPE_AGENT); }
__device__ __forceinline__ unsigned xb_add(unsigned* p, unsigned v) { return __hip_atomic_fetch_add(p, v, __ATOMIC_RELAXED, __HIP_MEMORY_SCOPE_AGENT); }
__device__ __forceinline__ unsigned xb_xcc_id() { return (unsigned)__builtin_amdgcn_s_getreg((3 << 11) | 20) & 0xFu; }
#define XB_SPIN(cond, bar) do { unsigned _sp = 0; while (cond) { __builtin_amdgcn_s_sleep(1); \
    if ((++_sp & 255u) == 0u) { if (xb_ld(&(bar)[XB_TMO])) break; if (_sp > XB_SPIN_CAP) { atomicAdd(&(bar)[XB_TMO], 1u); break; } } } } while (0)
struct XcdBarrier { unsigned* bar; unsigned x; volatile LAS unsigned* st; };
__device__ __forceinline__ XcdBarrier xcd_barrier_post(unsigned* bar, volatile LAS unsigned* st) {
    XcdBarrier b; b.bar = bar; b.x = xb_xcc_id(); b.st = st;
    if (threadIdx.x == 0) (void)xb_add(&bar[XB_XCNT(b.x)], 1u);
    return b;
}
__device__ __forceinline__ void xcd_barrier_complete(unsigned* bar, unsigned x, unsigned& nloc, unsigned& nx) {
    const unsigned G = gridDim.x * gridDim.y * gridDim.z;
    unsigned sum, cnt, mine, sp = 0u;
    for (;;) {
        sum = 0u; cnt = 0u; mine = 0u;
#pragma unroll
        for (unsigned j = 0; j < 16; ++j) { const unsigned c = xb_ld(&bar[XB_XCNT(j)]); sum += c; cnt += (c > 0u) ? 1u : 0u; mine = (j == x) ? c : mine; }
        if (sum == G) break;
        __builtin_amdgcn_s_sleep(1);
        if ((++sp & 255u) == 0u) { if (xb_ld(&bar[XB_TMO])) break; if (sp > XB_SPIN_CAP) { atomicAdd(&bar[XB_TMO], 1u); break; } }
    }
    nloc = mine > 0u ? mine : 1u; nx = cnt > 0u ? cnt : 1u;
}
__device__ __forceinline__ void xcd_barrier(const XcdBarrier& b) {
    asm volatile("s_waitcnt vmcnt(0)" ::: "memory");
    __syncthreads();
    if (threadIdx.x == 0) {
        unsigned* bar = b.bar;
        __builtin_amdgcn_s_waitcnt(0);
        unsigned nloc = b.st[0], nx = b.st[1];
        if (nloc == 0u) { xcd_barrier_complete(bar, b.x, nloc, nx); b.st[0] = nloc; b.st[1] = nx; }
        const unsigned old = xb_add(&bar[XB_XSUB(b.x)], 1u);
        const unsigned gen = old / nloc;
        if (old + 1u == (gen + 1u) * nloc) {
            __builtin_amdgcn_fence(__ATOMIC_RELEASE, "agent");
            asm volatile("s_waitcnt vmcnt(0)" ::: "memory");
            const unsigned og = xb_add(&bar[XB_TOP], 1u);
            const unsigned tg = og / nx;
            if (og + 1u == (tg + 1u) * nx) xb_add(&bar[XB_TOPGEN], 1u);
            else XB_SPIN(xb_ld(&bar[XB_TOPGEN]) == tg, bar);
            __builtin_amdgcn_fence(__ATOMIC_ACQUIRE, "agent");
            xb_add(&bar[XB_XGEN(b.x)], 1u);
            asm volatile("s_waitcnt vmcnt(0)" ::: "memory");
        } else {
            XB_SPIN(xb_ld(&bar[XB_XGEN(b.x)]) == gen, bar);
            __builtin_amdgcn_fence(__ATOMIC_ACQUIRE, "agent");
            asm volatile("s_waitcnt vmcnt(0)" ::: "memory");
        }
    }
    __syncthreads();
}

struct Frame {
    LAS unsigned char* lds;
    volatile LAS unsigned* MISC;
    gu32* ctl;
    int tid, lane, wave;
    int vcu, G;
    const float *x, *c, *ctx, *c_ctx, *norm1_g, *w_ada, *b_ada, *w_in, *w_fourier, *q_norm_g, *k_norm_g, *w_out, *norm2_g, *w_router, *router_bias, *w_egu, *w_ed, *w_sgu, *w_sd, *final_g;
    float* out;
    unsigned char* ws;
};
#define WSP(T, off) ((T*)(F.ws + (off)))

struct DenseOrder {
    static constexpr bool GATHER = false;
    int nN, nmain, nextra, G, c; const char* Bt; int K; int reps;
    __device__ __forceinline__ bool next(int i, pg8::GUnit& u) const {
        const int ntot = nmain + nextra, nc = (ntot - c + G - 1) / G; if (i >= nc * reps) return false;
        const int L = (i % nc) * G + c;
        if (L < nmain) { const int nig = 8 * nN, gid = L / nig, r = L % nig; u.pm = gid * 8 + (r & 7); u.pn = r >> 3; }
        else { const int jx = L - nmain; u.pm = 128 + (jx & 3); u.pn = 5 + (jx >> 2); }
        u.e = 0; u.j = 0; u.nvalid = 256; u.B = Bt + (size_t)u.pn * 256 * K * 2; return true;
    }
    __device__ __forceinline__ int arow(const pg8::GUnit& u, int r) const { return u.pm * 256 + r; }
};
template <bool GATHER_> struct GroupedOrder {
    static constexpr bool GATHER = GATHER_;
    int NPN, G, c, nbrows, K; bool gather; const char* Bt; const LAS int* TS; const LAS int* CN; const GAS u32x2* LIST; int reps; int total;
    __device__ __forceinline__ bool next(int i, pg8::GUnit& u) const {
        const int ntot = total * NPN, nc = (ntot - c + G - 1) / G; if (i >= nc * reps) return false;
        const int L = (i % nc) * G + c; const int T = L / NPN;
        int lo = 0, hi = 257;
        while (hi - lo > 1) { const int mid = (lo + hi) >> 1; if (TS[mid] <= T) lo = mid; else hi = mid; }
        lo = __builtin_amdgcn_readfirstlane(lo);
        const int ts = __builtin_amdgcn_readfirstlane(TS[lo]), cn = __builtin_amdgcn_readfirstlane(CN[lo]);
        u.pm = T; u.pn = L - T * NPN; u.e = lo; u.j = T - ts; const int rem = cn - 256 * u.j; u.nvalid = rem < 256 ? rem : 256;
        u.B = Bt + ((size_t)lo * nbrows + (size_t)u.pn * 256) * K; return true;
    }
    __device__ __forceinline__ int arow(const pg8::GUnit& u, int r) const {
        if (!gather) return u.pm * 256 + r;
        int pos = 256 * u.j + r; if (r >= u.nvalid) pos = 0;
        const u32x2 en = LIST[(size_t)u.e * NTOK + pos];
        return (int)(en.x & 0xffffu);
    }
};

struct EpiInProj {
    static constexpr bool PERM = true;
    u16 *Z, *Q, *Kb, *Vb; const float *COS, *SIN, *gq, *gk;
    __device__ __forceinline__ void operator()(const f32x4 (&acc)[2][2][4][2], const pg8::GUnit& u, int wr, int wc, int fr, int fq) const {
        const int pn = u.pn; const bool is_ctx = u.pm >= 128;
        float gn[2][2][4];
        if (pn >= 2 && pn < 6) { const float* gsrc = (pn == 5) ? gk : gq;
#pragma unroll
            for (int bj = 0; bj < 2; ++bj)
#pragma unroll
                for (int n = 0; n < 2; ++n) { const f32x4 g4 = *(const f32x4*)(gsrc + 32 * bj + 16 * n + 4 * fq); gn[bj][n][0] = g4[0]; gn[bj][n][1] = g4[1]; gn[bj][n][2] = g4[2]; gn[bj][n][3] = g4[3]; } }
#pragma unroll
        for (int ai = 0; ai < 2; ++ai)
#pragma unroll
            for (int m = 0; m < 4; ++m) {
                const int row = u.pm * 256 + ai * 128 + wr * 64 + m * 16 + fr;
                int b, l, key;
                if (!is_ctx) { b = row >> 13; l = row & 8191; key = l; } else { const int rc = row - NTOK; b = rc >> 8; l = 0; key = SEQ + (rc & 255); }
                if (pn < 2) {
#pragma unroll
                    for (int bj = 0; bj < 2; ++bj) { const int g = 32 * pn + 16 * bj + 4 * wc + fq; const f32x4 v0 = acc[ai][bj][m][0], v1 = acc[ai][bj][m][1];
                        u32x4 w; w.x = cvt_pk_bf16(v0[0], v0[1]); w.y = cvt_pk_bf16(v0[2], v0[3]); w.z = cvt_pk_bf16(v1[0], v1[1]); w.w = cvt_pk_bf16(v1[2], v1[3]);
                        *(u32x4*)(Z + (((size_t)(b * 64 + g) * SEQ + l) * 8)) = w; }
                } else if (pn < 6) {
                    float ss = 0.f;
#pragma unroll
                    for (int bj = 0; bj < 2; ++bj)
#pragma unroll
                        for (int n = 0; n < 2; ++n) { const f32x4 v = acc[ai][bj][m][n]; ss += (v[0] * v[0] + v[1] * v[1]) + (v[2] * v[2] + v[3] * v[3]); }
                    ss += __shfl_xor(ss, 16); ss += __shfl_xor(ss, 32);
                    const float rstd = 1.0f / sqrtf(ss * (1.0f / 64.0f) + RMS_EPS);
                    const float osc = (pn == 5) ? 1.0f : C2;
#pragma unroll
                    for (int bj = 0; bj < 2; ++bj) {
                        const int pidx = (bj == 0) ? (l >> 6) : (l & 63);
                        f32x4 cs = *(const f32x4*)(COS + pidx * 16 + 4 * fq), sn = *(const f32x4*)(SIN + pidx * 16 + 4 * fq);
                        if (is_ctx) { cs = (f32x4){1.f, 1.f, 1.f, 1.f}; sn = (f32x4){0.f, 0.f, 0.f, 0.f}; }
                        float oa[4], ob[4];
#pragma unroll
                        for (int e = 0; e < 4; ++e) { const float a = acc[ai][bj][m][0][e] * rstd * gn[bj][0][e], bb = acc[ai][bj][m][1][e] * rstd * gn[bj][1][e];
                            oa[e] = (a * cs[e] - bb * sn[e]) * osc; ob[e] = (bb * cs[e] + a * sn[e]) * osc; }
                        u32x4 w; w.x = cvt_pk_bf16(oa[0], oa[1]); w.y = cvt_pk_bf16(oa[2], oa[3]); w.z = cvt_pk_bf16(ob[0], ob[1]); w.w = cvt_pk_bf16(ob[2], ob[3]);
                        if (pn < 5) { const int head = 4 * (pn - 2) + wc; *(u32x4*)(Q + ((size_t)row * QW + head * 64 + 32 * bj + 8 * fq)) = w; }
                        else *(u32x4*)(Kb + (((size_t)b * LKV + key) * KVW + wc * 64 + 32 * bj + 8 * fq)) = w;
                    }
                } else {
#pragma unroll
                    for (int bj = 0; bj < 2; ++bj) { const f32x4 v0 = acc[ai][bj][m][0], v1 = acc[ai][bj][m][1];
                        u32x4 w; w.x = cvt_pk_bf16(v0[0], v0[1]); w.y = cvt_pk_bf16(v0[2], v0[3]); w.z = cvt_pk_bf16(v1[0], v1[1]); w.w = cvt_pk_bf16(v1[2], v1[3]);
                        *(u32x4*)(Vb + (((size_t)b * LKV + key) * KVW + 128 * bj + 32 * wc + 8 * fq)) = w; }
                }
            }
    }
};
struct EpiResid {
    static constexpr bool PERM = false;
    const float* x; float* X1; const gi64* MOD;
    __device__ __forceinline__ void operator()(const f32x4 (&acc)[2][2][4][2], const pg8::GUnit& u, int wr, int wc, int fr, int fq) const {
        const int row0 = u.pm * 256 + wr * 64 + fr, col0 = u.pn * 256 + wc * 32 + 4 * fq; const int b = (u.pm * 256) >> 13;
        f32x4 gv[2][2];
#pragma unroll
        for (int bj = 0; bj < 2; ++bj)
#pragma unroll
            for (int n = 0; n < 2; ++n) gv[bj][n] = mod4(MOD, b * 6144 + 2048 + col0 + bj * 128 + n * 16);
#pragma unroll
        for (int ai = 0; ai < 2; ++ai)
#pragma unroll
            for (int m = 0; m < 4; ++m) { const size_t off = (size_t)(row0 + ai * 128 + m * 16) * DM + col0;
#pragma unroll
                for (int bj = 0; bj < 2; ++bj)
#pragma unroll
                    for (int n = 0; n < 2; ++n) { const f32x4 xv = *(const f32x4*)(x + off + bj * 128 + n * 16); *(f32x4*)(X1 + off + bj * 128 + n * 16) = (DBG & 2) ? xv : xv + gv[bj][n] * acc[ai][bj][m][n]; } }
    }
};
struct EpiLogits {
    static constexpr bool PERM = false;
    float* C;
    __device__ __forceinline__ void operator()(const f32x4 (&acc)[2][2][4][2], const pg8::GUnit& u, int wr, int wc, int fr, int fq) const {
        const int row0 = u.pm * 256 + wr * 64 + fr, col0 = wc * 32 + 4 * fq;
#pragma unroll
        for (int ai = 0; ai < 2; ++ai)
#pragma unroll
            for (int m = 0; m < 4; ++m) { float* rowp = C + (size_t)(row0 + ai * 128 + m * 16) * NEXP + col0;
#pragma unroll
                for (int bj = 0; bj < 2; ++bj)
#pragma unroll
                    for (int n = 0; n < 2; ++n) *(f32x4*)(rowp + bj * 128 + n * 16) = acc[ai][bj][m][n]; }
    }
};
struct EpiSwiglu {
    static constexpr bool PERM = true;
    u16* ACT;
    __device__ __forceinline__ void operator()(const f32x4 (&acc)[2][2][4][2], const pg8::GUnit& u, int wr, int wc, int fr, int fq) const {
#pragma unroll
        for (int ai = 0; ai < 2; ++ai)
#pragma unroll
            for (int m = 0; m < 4; ++m) { const int r = ai * 128 + wr * 64 + m * 16 + fr; u16* rowp = ACT + ((size_t)u.pm * 256 + r) * EFF + 128 * u.pn + 16 * wc + 4 * fq;
#pragma unroll
                for (int bj = 0; bj < 2; ++bj) { const f32x4 a = acc[ai][bj][m][0], g = acc[ai][bj][m][1]; float o[4];
#pragma unroll
                    for (int e = 0; e < 4; ++e) o[e] = a[e] * g[e] / (1.0f + __expf(-a[e]));
                    if (MOE_FP8) { int w0 = __builtin_amdgcn_cvt_pk_fp8_f32(o[0], o[1], 0, false); w0 = __builtin_amdgcn_cvt_pk_fp8_f32(o[2], o[3], w0, true);
                        *(unsigned*)((unsigned char*)ACT + ((size_t)u.pm * 256 + r) * EFF + 128 * u.pn + 16 * wc + 4 * fq + 64 * bj) = (unsigned)w0; }
                    else { u32x2 w; if (MOEF16) { w.x = pk2h(o[0], o[1]); w.y = pk2h(o[2], o[3]); } else { w.x = pk2bf(o[0], o[1]); w.y = pk2bf(o[2], o[3]); } *(u32x2*)(rowp + 64 * bj) = w; } } }
    }
};
struct EpiDown {
    static constexpr bool PERM = true;
    u16* Cc; const GAS u32x2* LIST;
    __device__ __forceinline__ void operator()(const f32x4 (&acc)[2][2][4][2], const pg8::GUnit& u, int wr, int wc, int fr, int fq) const {
        f32x2 ens[2][4];
#pragma unroll
        for (int ai = 0; ai < 2; ++ai)
#pragma unroll
            for (int m = 0; m < 4; ++m) { const int r = ai * 128 + wr * 64 + m * 16 + fr; ens[ai][m] = *(const GAS f32x2*)(LIST + (size_t)u.e * NTOK + (r < u.nvalid ? 256 * u.j + r : 0)); }
#pragma unroll
        for (int ai = 0; ai < 2; ++ai)
#pragma unroll
            for (int m = 0; m < 4; ++m) { const int r = ai * 128 + wr * 64 + m * 16 + fr;
                if (r < u.nvalid) { const f32x2 enf = ens[ai][m];
                    const unsigned ex = __builtin_bit_cast(unsigned, enf.x); const int tok = (int)(ex & 0xffffu), slot = (int)(ex >> 16); const float gate = enf.y;
                    unsigned char* rowp = (unsigned char*)Cc + ((size_t)tok * NSLOT + slot) * DM + 256 * u.pn + 32 * wc + 8 * fq;
                    const float gs = gate * C_SCALE;
#pragma unroll
                    for (int bj = 0; bj < 2; ++bj) { f32x4 v0 = acc[ai][bj][m][0] * gs, v1 = acc[ai][bj][m][1] * gs;
#pragma unroll
                        for (int e = 0; e < 4; ++e) { v0[e] = __builtin_amdgcn_fmed3f(v0[e], -440.f, 440.f); v1[e] = __builtin_amdgcn_fmed3f(v1[e], -440.f, 440.f); }
                        int w0 = __builtin_amdgcn_cvt_pk_fp8_f32(v0[0], v0[1], 0, false); w0 = __builtin_amdgcn_cvt_pk_fp8_f32(v0[2], v0[3], w0, true);
                        int w1 = __builtin_amdgcn_cvt_pk_fp8_f32(v1[0], v1[1], 0, false); w1 = __builtin_amdgcn_cvt_pk_fp8_f32(v1[2], v1[3], w1, true);
                        *(u32x2*)(rowp + 128 * bj) = (u32x2){(unsigned)w0, (unsigned)w1}; } } }
    }
};

template <bool F16OUT, bool F8OUT2 = false> __device__ __forceinline__ void rownorm_rows(const GAS float* src, const float* gain, const gi64* MODsh, const gi64* MODsc, u16* dst, int row0, int nrows, int wi, int wstride, int lane, unsigned char* dst8 = nullptr) {
    f32x4 Av[2][2], Bv[2][2];
#pragma unroll
    for (int j = 0; j < 2; ++j)
#pragma unroll
        for (int h = 0; h < 2; ++h) { const int col = 8 * lane + 512 * j + 4 * h; Av[j][h] = *(const f32x4*)(gain + col) * (mod4(MODsc, col) + 1.0f); Bv[j][h] = mod4(MODsh, col); }
    for (int r = wi; r < nrows; r += 2 * wstride) {
        const int r1 = r + wstride; const bool has1 = r1 < nrows;
        const GAS float* s0 = src + (size_t)(row0 + r) * DM; const GAS float* s1 = src + (size_t)(row0 + (has1 ? r1 : r)) * DM;
        f32x4 v0[2][2], v1[2][2];
#pragma unroll
        for (int j = 0; j < 2; ++j)
#pragma unroll
            for (int h = 0; h < 2; ++h) { v0[j][h] = *(const GAS f32x4*)(s0 + 8 * lane + 512 * j + 4 * h); v1[j][h] = *(const GAS f32x4*)(s1 + 8 * lane + 512 * j + 4 * h); }
        float q0 = 0.f, q1 = 0.f;
#pragma unroll
        for (int j = 0; j < 2; ++j)
#pragma unroll
            for (int h = 0; h < 2; ++h) { const f32x4 a = v0[j][h], b = v1[j][h]; q0 += (a[0] * a[0] + a[1] * a[1]) + (a[2] * a[2] + a[3] * a[3]); q1 += (b[0] * b[0] + b[1] * b[1]) + (b[2] * b[2] + b[3] * b[3]); }
#pragma unroll
        for (int o = 1; o < 64; o <<= 1) { q0 += __shfl_xor(q0, o); q1 += __shfl_xor(q1, o); }
        const float rs0 = 1.0f / sqrtf(q0 * (1.0f / DM) + RMS_EPS), rs1 = 1.0f / sqrtf(q1 * (1.0f / DM) + RMS_EPS);
#pragma unroll
        for (int j = 0; j < 2; ++j) { const f32x4 ya = v0[j][0] * rs0 * Av[j][0] + Bv[j][0], yb = v0[j][1] * rs0 * Av[j][1] + Bv[j][1];
            u32x4 w; if (F16OUT) { w.x = pk2h(ya[0], ya[1]); w.y = pk2h(ya[2], ya[3]); w.z = pk2h(yb[0], yb[1]); w.w = pk2h(yb[2], yb[3]); } else { w.x = pk2bf(ya[0], ya[1]); w.y = pk2bf(ya[2], ya[3]); w.z = pk2bf(yb[0], yb[1]); w.w = pk2bf(yb[2], yb[3]); }
            *(GAS u32x4*)(dst + (size_t)(row0 + r) * DM + 8 * lane + 512 * j) = w;
            if (F8OUT2) { int w0 = __builtin_amdgcn_cvt_pk_fp8_f32(ya[0], ya[1], 0, false); w0 = __builtin_amdgcn_cvt_pk_fp8_f32(ya[2], ya[3], w0, true); int w1 = __builtin_amdgcn_cvt_pk_fp8_f32(yb[0], yb[1], 0, false); w1 = __builtin_amdgcn_cvt_pk_fp8_f32(yb[2], yb[3], w1, true);
                *(GAS u32x2*)(dst8 + (size_t)(row0 + r) * DM + 8 * lane + 512 * j) = (u32x2){(unsigned)w0, (unsigned)w1}; } }
        if (has1) {
#pragma unroll
            for (int j = 0; j < 2; ++j) { const f32x4 ya = v1[j][0] * rs1 * Av[j][0] + Bv[j][0], yb = v1[j][1] * rs1 * Av[j][1] + Bv[j][1];
                u32x4 w; if (F16OUT) { w.x = pk2h(ya[0], ya[1]); w.y = pk2h(ya[2], ya[3]); w.z = pk2h(yb[0], yb[1]); w.w = pk2h(yb[2], yb[3]); } else { w.x = pk2bf(ya[0], ya[1]); w.y = pk2bf(ya[2], ya[3]); w.z = pk2bf(yb[0], yb[1]); w.w = pk2bf(yb[2], yb[3]); }
                *(GAS u32x4*)(dst + (size_t)(row0 + r1) * DM + 8 * lane + 512 * j) = w;
                if (F8OUT2) { int w0 = __builtin_amdgcn_cvt_pk_fp8_f32(ya[0], ya[1], 0, false); w0 = __builtin_amdgcn_cvt_pk_fp8_f32(ya[2], ya[3], w0, true); int w1 = __builtin_amdgcn_cvt_pk_fp8_f32(yb[0], yb[1], 0, false); w1 = __builtin_amdgcn_cvt_pk_fp8_f32(yb[2], yb[3], w1, true);
                    *(GAS u32x2*)(dst8 + (size_t)(row0 + r1) * DM + 8 * lane + 512 * j) = (u32x2){(unsigned)w0, (unsigned)w1}; } } }
    }
}

__device__ __forceinline__ void p0_phase(Frame& F) {
    const int gw = F.vcu * 8 + F.wave, NGW = F.G * 8, lane = F.lane;
    unsigned long long* MODQ = (unsigned long long*)(F.ctl + CW_MOD);
    for (int it = gw; it < 1536; it += NGW) {
        const int cb = it % 24, kc = it / 24, k0 = kc * 16, col = cb * 256 + lane * 4;
        float sv[5];
#pragma unroll
        for (int r = 0; r < 5; ++r) { const float cv = (r < 4) ? F.c[r * DM + k0 + (lane & 15)] : F.c_ctx[k0 + (lane & 15)]; sv[r] = cv / (1.0f + __expf(-cv)); }
        f32x4 acc[5];
#pragma unroll
        for (int r = 0; r < 5; ++r) acc[r] = (f32x4){0.f, 0.f, 0.f, 0.f};
#pragma unroll
        for (int kk = 0; kk < 16; ++kk) { const f32x4 w = *(const f32x4*)(F.w_ada + (size_t)(k0 + kk) * 6144 + col);
#pragma unroll
            for (int r = 0; r < 5; ++r) { const float s = __builtin_bit_cast(float, __builtin_amdgcn_readlane(__builtin_bit_cast(int, sv[r]), kk)); acc[r] += w * s; } }
        if (kc == 0) { const f32x4 bv = *(const f32x4*)(F.b_ada + col);
#pragma unroll
            for (int r = 0; r < 5; ++r) acc[r] += bv; }
#pragma unroll
        for (int r = 0; r < 5; ++r)
#pragma unroll
            for (int j = 0; j < 4; ++j) atomicAdd(MODQ + r * 6144 + col + j, (unsigned long long)__float2ll_rn(acc[r][j] * 0x1p36f));
    }
    float* WCS = WSP(float, WS_TAB);
    for (int it = gw; it < 256; it += NGW) {
        const int fh = it >> 6, d = it & 63; float ac = 0.f, as = 0.f;
        for (int k2 = 0; k2 < 64; ++k2) { const int mm = (d * k2) & 63; const float w = F.w_fourier[(fh * 64 + k2) * 64 + lane]; ac += cospif((float)mm * (1.0f / 32.0f)) * w; as += sinpif((float)mm * (1.0f / 32.0f)) * w; }
        const float sc = 1.0f / sqrtf((float)SEQ * 64.0f);
        WCS[(fh * 64 + d) * 128 + lane] = ac * sc; WCS[(fh * 64 + d) * 128 + 64 + lane] = as * sc;
    }
    {
        u16* D1 = WSP(u16, WS_TAB + 144 * 1024); u16* D3 = WSP(u16, WS_TAB + 272 * 1024);
        for (int it = gw; it < 320; it += NGW) {
            if (it < 256) { const int ro = it >> 7, k1 = it & 127;
#pragma unroll
                for (int j = 0; j < 4; ++j) { const int col = lane + 64 * j, ri = col >> 7, n1 = col & 127, mm = (n1 * k1) & 127; const float cc = cospif((float)mm * (1.0f / 64.0f)), ss = sinpif((float)mm * (1.0f / 64.0f));
                    const float v = (ro == 0) ? (ri == 0 ? cc : -ss) : (ri == 0 ? -ss : -cc); D1[it * 256 + col] = (u16)f2bf(v); } }
            else { const int k2 = it - 256;
#pragma unroll
                for (int j = 0; j < 2; ++j) { const int col = lane + 64 * j, ri = col >> 6, n2 = col & 63, mm = (n2 * k2) & 63; const float v = (ri == 0) ? cospif((float)mm * (1.0f / 32.0f)) : sinpif((float)mm * (1.0f / 32.0f)); D3[k2 * 128 + col] = (u16)f2bf(v); } }
        }
    }
    float* COS = WSP(float, WS_TAB + 128 * 1024); float* SIN = WSP(float, WS_TAB + 136 * 1024);
    for (int it = gw; it < 32; it += NGW) { const int idx = it * 64 + lane, pos = idx >> 4, i = idx & 15;
        const float inv = powf(10000.0f, -(float)i / 16.0f), ang = (float)pos * inv; COS[idx] = cosf(ang); SIN[idx] = sinf(ang); }
}

__device__ __forceinline__ int map_row(int mode, int sc) {
    if (mode == 1) { const int head = sc >> 6, dim = sc & 63, bj = dim >> 5, n = (dim >> 4) & 1, i = dim & 15; return (head >> 2) * 256 + bj * 128 + (head & 3) * 32 + (i >> 2) * 8 + n * 4 + (i & 3); }
    if (mode == 2) { const int g = sc >> 8, a = sc & 255; return (a >> 2) * 8 + g * 4 + (a & 3); }
    return sc;
}
struct TItem { const float* src; u16* dst; int N, K, k0, rel_c0, mode, dst_off; bool f16; bool f8; float ws; };
__device__ __forceinline__ void titem_load(const TItem& t, float (&buf)[32], int lane) {
#pragma unroll
    for (int i = 0; i < 32; ++i) { const int kk = 2 * i + (lane >> 5); buf[i] = t.src[(size_t)kk * t.N + (lane & 31)]; }
}
__device__ __forceinline__ void titem_finish(const TItem& t, const float (&buf)[32], LAS float* scr, int lane) {
#pragma unroll
    for (int i = 0; i < 32; ++i) { const int kk = 2 * i + (lane >> 5); scr[kk * 33 + (lane & 31)] = buf[i]; }
    LDS_WAIT(); asm volatile("" ::: "memory");
    const int c = lane & 7;
#pragma unroll
    for (int j = 0; j < 4; ++j) { const int n = (lane >> 3) + 8 * j; const LAS float* s = scr + (8 * c) * 33 + n;
        u32x4 o;
        if (t.f16) { o.x = pk2h(s[0 * 33], s[1 * 33]); o.y = pk2h(s[2 * 33], s[3 * 33]); o.z = pk2h(s[4 * 33], s[5 * 33]); o.w = pk2h(s[6 * 33], s[7 * 33]); }
        else { o.x = pk2bf(s[0 * 33], s[1 * 33]); o.y = pk2bf(s[2 * 33], s[3 * 33]); o.z = pk2bf(s[4 * 33], s[5 * 33]); o.w = pk2bf(s[6 * 33], s[7 * 33]); }
        const int drow = t.dst_off + map_row(t.mode, t.rel_c0 + n);
        if (t.f8) { const float ws = t.ws; int w0 = __builtin_amdgcn_cvt_pk_fp8_f32(s[0 * 33] * ws, s[1 * 33] * ws, 0, false); w0 = __builtin_amdgcn_cvt_pk_fp8_f32(s[2 * 33] * ws, s[3 * 33] * ws, w0, true);
            int w1 = __builtin_amdgcn_cvt_pk_fp8_f32(s[4 * 33] * ws, s[5 * 33] * ws, 0, false); w1 = __builtin_amdgcn_cvt_pk_fp8_f32(s[6 * 33] * ws, s[7 * 33] * ws, w1, true);
            *(GAS u32x2*)((unsigned char*)t.dst + (size_t)drow * t.K + t.k0 + 8 * c) = (u32x2){(unsigned)w0, (unsigned)w1}; }
        else *(GAS u32x4*)(t.dst + (size_t)drow * t.K + t.k0 + 8 * c) = o; }
    LDS_WAIT(); asm volatile("" ::: "memory");
}
__device__ __forceinline__ void p1_phase(Frame& F) {
    LAS float* scr = (LAS float*)(F.lds + RING_OFF + F.wave * 16384);
    const int gw = F.vcu * 8 + F.wave, NGW = F.G * 8, lane = F.lane;
    constexpr int I_FOLD = 128, I_QKV = 16 * 40, I_OUT = 16 * 32, I_R = 16 * 8, I_GU = NEXPS * 16 * 16, I_D = NEXPS * 4 * 32;
    constexpr int NT_ITEMS = I_QKV + I_OUT + I_R + I_GU + I_D;
    u16* BIN = WSP(u16, WS_BIN);
    for (int r = gw; r < I_FOLD; r += NGW) {
        const int fh = r >> 5, cs = (r >> 4) & 1, kb = r & 15; const int k = kb * 64 + lane;
        const GAS float* WCS = (const GAS float*)(F.ws + WS_TAB);
#pragma unroll 4
        for (int i = 0; i < 64; ++i) scr[i * 64 + lane] = WCS[(fh * 64 + i) * 128 + cs * 64 + lane];
        float wrow[64];
#pragma unroll
        for (int d4 = 0; d4 < 16; ++d4) { const f32x4 v = *(const f32x4*)(F.w_in + (size_t)k * 1536 + fh * 64 + 4 * d4); wrow[4 * d4] = v[0]; wrow[4 * d4 + 1] = v[1]; wrow[4 * d4 + 2] = v[2]; wrow[4 * d4 + 3] = v[3]; }
        LDS_WAIT(); asm volatile("" ::: "memory");
        for (int e = 0; e < 64; ++e) { float a = 0.f;
#pragma unroll
            for (int d = 0; d < 64; ++d) a += wrow[d] * scr[d * 64 + e];
            const int col256 = fh * 64 + e, pos = 8 * (col256 >> 2) + (col256 & 3) + 4 * cs;
            BIN[(size_t)pos * DM + k] = (u16)f2bf(a); }
        LDS_WAIT(); asm volatile("" ::: "memory");
    }
#define TDECODE(it_, t) do { int r = (it_); \
 \
        if (r < I_QKV) { const int kb = r / 40, nb = r % 40, sc0 = 256 + 32 * nb; t.N = 1536; t.K = DM; t.k0 = kb * 64; t.f16 = false; t.f8 = false; t.ws = 1.f; t.dst = BIN; t.src = F.w_in + (size_t)(kb * 64) * 1536 + sc0; \
            if (sc0 < 1024) { t.rel_c0 = sc0 - 256; t.mode = 1; t.dst_off = 512; } else if (sc0 < 1280) { t.rel_c0 = sc0 - 1024; t.mode = 1; t.dst_off = 1280; } else { t.rel_c0 = sc0 - 1280; t.mode = 0; t.dst_off = 1536; } \
            break; } \
        r -= I_QKV; \
        if (r < I_OUT) { const int kb = r / 32, nb = r % 32; t.N = DM; t.K = DM; t.k0 = kb * 64; t.f16 = false; t.f8 = false; t.ws = 1.f; t.dst = WSP(u16, WS_BOUT); t.src = F.w_out + (size_t)(kb * 64) * DM + 32 * nb; t.rel_c0 = 32 * nb; t.mode = 0; t.dst_off = 0; break; } \
        r -= I_OUT; \
        if (r < I_R) { const int kb = r / 8, nb = r % 8; t.N = NEXP; t.K = DM; t.k0 = kb * 64; t.f16 = (MOE_FP8 ? false : MOEF16); t.f8 = false; t.ws = 1.f; t.dst = WSP(u16, WS_BR); t.src = F.w_router + (size_t)(kb * 64) * NEXP + 32 * nb; t.rel_c0 = 32 * nb; t.mode = 0; t.dst_off = 0; break; } \
        r -= I_R; \
        if (r < I_GU) { const int e = r >> 8, q = r & 255, kb = q >> 4, nb = q & 15; const float* W = (e < NEXP) ? F.w_egu + (size_t)e * DM * 512 : F.w_sgu; \
            t.N = 512; t.K = DM; t.k0 = kb * 64; t.f16 = MOEF16; t.f8 = MOE_FP8; t.ws = WGU_SCALE; t.dst = MOE_FP8 ? (u16*)(F.ws + WS_BGU + (size_t)e * 512 * DM) : WSP(u16, WS_BGU) + (size_t)e * 512 * DM; t.src = W + (size_t)(kb * 64) * 512 + 32 * nb; t.rel_c0 = 32 * nb; t.mode = 2; t.dst_off = 0; break; } \
        r -= I_GU; \
        { const int e = r >> 7, q = r & 127, kb = q >> 5, nb = q & 31; const float* W = (e < NEXP) ? F.w_ed + (size_t)e * EFF * DM : F.w_sd; \
            t.N = DM; t.K = EFF; t.k0 = kb * 64; t.f16 = MOEF16; t.f8 = MOE_FP8; t.ws = WD_SCALE; t.dst = MOE_FP8 ? (u16*)(F.ws + WS_BD + (size_t)e * DM * EFF) : WSP(u16, WS_BD) + (size_t)e * DM * EFF; t.src = W + (size_t)(kb * 64) * DM + 32 * nb; t.rel_c0 = 32 * nb; t.mode = 0; t.dst_off = 0; } \
    } while (0)
    REPS(11) {
        float bufA[32], bufB[32]; TItem ta, tb; int it = gw;
        if (it < NT_ITEMS) { TDECODE(it, ta); titem_load(ta, bufA, lane); }
        while (it < NT_ITEMS) {
            const int itb = it + NGW; const bool hb = itb < NT_ITEMS;
            if (hb) { TDECODE(itb, tb); titem_load(tb, bufB, lane); }
            titem_finish(ta, bufA, scr, lane);
            if (!hb) break;
            const int ita = itb + NGW; const bool ha = ita < NT_ITEMS;
            if (ha) { TDECODE(ita, ta); titem_load(ta, bufA, lane); }
            titem_finish(tb, bufB, scr, lane);
            it = ita;
        }
    }
    const gi64* MOD = (const gi64*)(F.ctl + CW_MOD);
    u16* XN = WSP(u16, WS_XN);
    REPS(12) { const int wpb = NGW >> 2, b = gw / wpb, wi = gw % wpb;
        rownorm_rows<false>((const GAS float*)F.x, F.norm1_g, MOD + b * 6144, MOD + b * 6144 + 1024, XN, b * SEQ, SEQ, wi, wpb, lane);
        rownorm_rows<false>((const GAS float*)F.ctx, F.norm1_g, MOD + 4 * 6144, MOD + 4 * 6144 + 1024, XN + (size_t)NTOK * DM, 0, NCTX, gw, NGW, lane); }
}

__device__ __forceinline__ void fourier_unit(Frame& F, int b, int g) {
    LAS unsigned char* Zl = F.lds + RING_OFF;
    LAS f32x2* TW128 = (LAS f32x2*)(F.lds + TAB_OFF);
    LAS f32x2* TW64 = (LAS f32x2*)(F.lds + TAB_OFF + 1024);
    const int tid = F.tid;
    const GAS u32x4* Zg = (const GAS u32x4*)(F.ws + WS_Z + ((size_t)(b * 64 + g) * SEQ) * 16);
#pragma unroll 4
    for (int i = 0; i < 16; ++i) *(LAS u32x4*)(Zl + (size_t)(i * 512 + tid) * 16) = Zg[i * 512 + tid];
    if (tid < 128) { float s, c; sincospif((float)tid * (1.0f / 64.0f), &s, &c); TW128[tid] = (f32x2){c, s}; }
    else if (tid < 192) { float s, c; sincospif((float)(tid - 128) * (1.0f / 32.0f), &s, &c); TW64[tid - 128] = (f32x2){c, s}; }
    __syncthreads();
    const int k1 = tid & 127, q = tid >> 7;
    float yr[16][4], yi[16][4];
#pragma unroll
    for (int a = 0; a < 16; ++a)
#pragma unroll
        for (int e = 0; e < 4; ++e) { yr[a][e] = 0.f; yi[a][e] = 0.f; }
    for (int n1 = 0; n1 < 128; ++n1) {
        const f32x2 tw = TW128[(n1 * k1) & 127]; const float c = tw.x, s = tw.y;
#pragma unroll
        for (int a = 0; a < 16; ++a) { const u32x4 rw = *(const LAS u32x4*)(Zl + (size_t)(64 * n1 + 16 * q + a) * 16);
            const float uc[4] = {bflo(rw.x), bfhi(rw.x), bflo(rw.y), bfhi(rw.y)}, us[4] = {bflo(rw.z), bfhi(rw.z), bflo(rw.w), bfhi(rw.w)};
#pragma unroll
            for (int e = 0; e < 4; ++e) { yr[a][e] += uc[e] * c - us[e] * s; yi[a][e] -= uc[e] * s + us[e] * c; } }
    }
    __syncthreads();
    int k1b = k1; asm volatile("" : "+v"(k1b));
#pragma unroll
    for (int a = 0; a < 16; ++a) { const int n2 = 16 * q + a; const float fr_ = (float)(n2 * k1b) * (1.0f / 8192.0f);
        const float cp = __builtin_amdgcn_cosf(fr_), sp = __builtin_amdgcn_sinf(fr_);
        float pr[4], pi[4];
#pragma unroll
        for (int e = 0; e < 4; ++e) { pr[e] = yr[a][e] * cp + yi[a][e] * sp; pi[e] = yi[a][e] * cp - yr[a][e] * sp; }
        u32x4 w; w.x = pk2bf(pr[0], pr[1]); w.y = pk2bf(pr[2], pr[3]); w.z = pk2bf(pi[0], pi[1]); w.w = pk2bf(pi[2], pi[3]);
        *(LAS u32x4*)(Zl + (size_t)(n2 * 128 + k1b) * 16) = w; }
    __syncthreads();
    int k1c = k1; asm volatile("" : "+v"(k1c));
    float o[16][4];
#pragma unroll
    for (int a = 0; a < 16; ++a)
#pragma unroll
        for (int e = 0; e < 4; ++e) o[a][e] = 0.f;
    for (int n2 = 0; n2 < 64; ++n2) {
        const u32x4 rw = *(const LAS u32x4*)(Zl + (size_t)(n2 * 128 + k1c) * 16);
        const float pr[4] = {bflo(rw.x), bfhi(rw.x), bflo(rw.y), bfhi(rw.y)}, pi[4] = {bflo(rw.z), bfhi(rw.z), bflo(rw.w), bfhi(rw.w)};
#pragma unroll
        for (int a = 0; a < 16; ++a) { const f32x2 tw = TW64[(n2 * (16 * q + a)) & 63];
#pragma unroll
            for (int e = 0; e < 4; ++e) o[a][e] += pr[e] * tw.x + pi[e] * tw.y; }
    }
    u16* MIX = WSP(u16, WS_MIX);
#pragma unroll
    for (int a = 0; a < 16; ++a) { const int k2 = 16 * q + a; u32x2 w; w.x = pk2bf(o[a][0], o[a][1]); w.y = pk2bf(o[a][2], o[a][3]);
        *(GAS u32x2*)(MIX + ((size_t)(b * SEQ + k1c + 128 * k2)) * DM + 4 * g) = w; }
    __syncthreads();
}

__device__ __forceinline__ attn_body::s16x4 ftr(const LAS unsigned char* p) { return __builtin_bit_cast(attn_body::s16x4, __builtin_amdgcn_ds_read_tr16_b64_v4i16((LAS attn_body::v4i16_t*)p)); }
__device__ __forceinline__ void fourier_unit_mfma(Frame& F, int b, int g) {
    LAS unsigned char* Zl = F.lds + RING_OFF;
    const int tid = F.tid, lane = F.lane, w = F.wave;
    const char* Zg = (const char*)(F.ws + WS_Z) + ((size_t)(b * 64 + g) * SEQ) * 16;
#pragma unroll
    for (int i = 0; i < 16; ++i) __builtin_amdgcn_global_load_lds((const unsigned*)(Zg + (size_t)(i * 512 + tid) * 16), (LAS unsigned*)(Zl + (size_t)(i * 512 + w * 64) * 16), 16, 0, 0);
    VM_WAIT(); __syncthreads();
    f32x4 acc[2][16];
#pragma unroll
    for (int ro = 0; ro < 2; ++ro)
#pragma unroll
        for (int t = 0; t < 16; ++t) acc[ro][t] = (f32x4){0.f, 0.f, 0.f, 0.f};
    const GAS bf16x8* D1 = (const GAS bf16x8*)(F.ws + WS_TAB + 144 * 1024);
    const GAS bf16x8* D3 = (const GAS bf16x8*)(F.ws + WS_TAB + 272 * 1024);
    const int l15 = lane & 15, lq = lane >> 4;
    const unsigned bbase = (unsigned)((64 * (8 * lq + (l15 >> 2)) + (lane & 3)) * 16);
#pragma unroll 1
    for (int s1 = 0; s1 < 8; ++s1) {
        const int ri = s1 >> 2;
        const bf16x8 a0 = D1[(16 * w + l15) * 32 + 4 * s1 + lq], a1 = D1[(128 + 16 * w + l15) * 32 + 4 * s1 + lq];
        const LAS unsigned char* sb = Zl + bbase + (unsigned)((s1 & 3) * 32768 + 8 * ri);
#pragma unroll
        for (int t = 0; t < 16; ++t) { const attn_body::s16x4 lo = ftr(sb + 64 * t), hi = ftr(sb + 64 * t + 4096);
            const bf16x8 bf = (bf16x8){lo[0], lo[1], lo[2], lo[3], hi[0], hi[1], hi[2], hi[3]};
            acc[0][t] = __builtin_amdgcn_mfma_f32_16x16x32_bf16(a0, bf, acc[0][t], 0, 0, 0);
            acc[1][t] = __builtin_amdgcn_mfma_f32_16x16x32_bf16(a1, bf, acc[1][t], 0, 0, 0); }
    }
    __syncthreads();
    {   const int e = lane & 3; int k1b = 16 * w + 4 * lq; asm volatile("" : "+v"(k1b));
#pragma unroll
        for (int t = 0; t < 16; ++t) { const int n2 = 4 * t + (l15 >> 2);
#pragma unroll
            for (int r = 0; r < 4; ++r) { const int k1 = k1b + r; const float fr_ = (float)(n2 * k1) * (1.0f / 8192.0f); const float cp = __builtin_amdgcn_cosf(fr_), sp = __builtin_amdgcn_sinf(fr_);
                const float yr = acc[0][t][r], yi = acc[1][t][r]; const float pr = yr * cp + yi * sp, pi = yi * cp - yr * sp;
                *(LAS u16*)(Zl + (unsigned)(((n2) * 512 + k1 * 4 + e) * 2)) = (u16)f2bf(pr);
                *(LAS u16*)(Zl + (unsigned)(((64 + n2) * 512 + k1 * 4 + e) * 2)) = (u16)f2bf(pi); } }
    }
    asm volatile("s_waitcnt lgkmcnt(0)" ::: "memory");
    f32x4 acc3[4][4];
#pragma unroll
    for (int mt = 0; mt < 4; ++mt)
#pragma unroll
        for (int j = 0; j < 4; ++j) acc3[mt][j] = (f32x4){0.f, 0.f, 0.f, 0.f};
#pragma unroll
    for (int s3 = 0; s3 < 4; ++s3) {
        bf16x8 a[4];
#pragma unroll
        for (int mt = 0; mt < 4; ++mt) a[mt] = D3[(16 * mt + l15) * 16 + 4 * s3 + lq];
        const unsigned kk = (unsigned)(32 * s3 + 8 * lq + (l15 >> 2));
#pragma unroll
        for (int j = 0; j < 4; ++j) { const unsigned ad = kk * 1024u + (unsigned)((4 * (4 * w + j) + (lane & 3)) * 8);
            const attn_body::s16x4 lo = ftr(Zl + ad), hi = ftr(Zl + ad + 4096);
            const bf16x8 bf = (bf16x8){lo[0], lo[1], lo[2], lo[3], hi[0], hi[1], hi[2], hi[3]};
#pragma unroll
            for (int mt = 0; mt < 4; ++mt) acc3[mt][j] = __builtin_amdgcn_mfma_f32_16x16x32_bf16(a[mt], bf, acc3[mt][j], 0, 0, 0); }
    }
    u16* MIX = WSP(u16, WS_MIX);
#pragma unroll
    for (int mt = 0; mt < 4; ++mt)
#pragma unroll
        for (int j = 0; j < 4; ++j)
#pragma unroll
            for (int r = 0; r < 4; ++r) { const int k2 = 16 * mt + 4 * lq + r, k1 = 16 * w + 4 * j + (l15 >> 2);
                MIX[((size_t)(b * SEQ + k1 + 128 * k2)) * DM + 4 * g + (lane & 3)] = (u16)f2bf(acc3[mt][j][r]); }
    __syncthreads();
}

__device__ __forceinline__ float dpp_f(float v, int ctrl_sel) {
    const int x = __builtin_bit_cast(int, v); int r;
    if (ctrl_sel == 0) r = __builtin_amdgcn_update_dpp(x, x, 0xB1, 0xF, 0xF, false);
    else if (ctrl_sel == 1) r = __builtin_amdgcn_update_dpp(x, x, 0x4E, 0xF, 0xF, false);
    else if (ctrl_sel == 2) r = __builtin_amdgcn_update_dpp(x, x, 0x141, 0xF, 0xF, false);
    else r = __builtin_amdgcn_update_dpp(x, x, 0x140, 0xF, 0xF, false);
    return __builtin_bit_cast(float, r);
}
__device__ __forceinline__ float rdl(float v, int lane) { return __builtin_bit_cast(float, __builtin_amdgcn_readlane(__builtin_bit_cast(int, v), lane)); }
__device__ __forceinline__ void route_token(Frame& F, int tok) {
    const int l = F.lane;
    const f32x4 lg = *(const GAS f32x4*)((const GAS float*)(F.ws + WS_LOG) + (size_t)tok * NEXP + 4 * l);
    const f32x4 bs = *(const f32x4*)(F.router_bias + 4 * l);
    float s[4], sel[4];
#pragma unroll
    for (int j = 0; j < 4; ++j) { s[j] = 1.0f / (1.0f + expf(-lg[j])); sel[j] = s[j] + bs[j]; }
    float m1 = fmaxf(sel[0], sel[1]), m2 = fminf(sel[0], sel[1]);
#pragma unroll
    for (int j = 2; j < 4; ++j) { const float v = sel[j]; m2 = fmaxf(m2, fminf(m1, v)); m1 = fmaxf(m1, v); }
#pragma unroll
    for (int st = 0; st < 3; ++st) { const float o1 = dpp_f(m1, st), o2 = dpp_f(m2, st); const float n2 = fmaxf(fminf(m1, o1), fmaxf(m2, o2)); m1 = fmaxf(m1, o1); m2 = n2; }
    const float gs = m1 + m2; const int myg = l >> 3; int rank = 0;
#pragma unroll
    for (int g2 = 0; g2 < 8; ++g2) { const float og = rdl(gs, g2 * 8); rank += (og > gs || (og == gs && g2 < myg)) ? 1 : 0; }
    if (rank >= 4) {
#pragma unroll
        for (int j = 0; j < 4; ++j) sel[j] = -INFINITY; }
    int my_e = 0; float my_s = 0.f, sum = 0.f;
#pragma unroll 1
    for (int k = 0; k < TOPK; ++k) {
        const float lb = fmaxf(fmaxf(sel[0], sel[1]), fmaxf(sel[2], sel[3]));
        float r = lb; r = fmaxf(r, dpp_f(r, 0)); r = fmaxf(r, dpp_f(r, 1)); r = fmaxf(r, dpp_f(r, 2)); r = fmaxf(r, dpp_f(r, 3));
        const float wm = fmaxf(fmaxf(rdl(r, 0), rdl(r, 16)), fmaxf(rdl(r, 32), rdl(r, 48)));
        const unsigned long long mask = __ballot(lb == wm);
        const int wl = __builtin_amdgcn_readfirstlane((int)__ffsll((long long)mask) - 1);
        const int jj = (sel[0] == wm) ? 0 : (sel[1] == wm) ? 1 : (sel[2] == wm) ? 2 : 3;
        const float cand = (jj == 0) ? s[0] : (jj == 1) ? s[1] : (jj == 2) ? s[2] : s[3];
        const int jw = __builtin_amdgcn_readlane(jj, wl); const float wsc = rdl(cand, wl);
        if (l == wl) {
#pragma unroll
            for (int j = 0; j < 4; ++j) if (jw == j) sel[j] = -INFINITY; }
        if (l == k) { my_e = 4 * wl + jw; my_s = wsc; }
        sum += wsc;
    }
    GAS u32x2* LIST = (GAS u32x2*)(F.ws + WS_LIST);
    if (l < TOPK) { const float gate = my_s / sum * 2.5f; const unsigned pos = __hip_atomic_fetch_add((unsigned*)(F.ctl + CW_CNT + my_e), 1u, RLX_AGENT);
        LIST[(size_t)my_e * NTOK + pos] = (u32x2){(unsigned)tok | ((unsigned)l << 16), __builtin_bit_cast(unsigned, gate)}; }
    else if (l == TOPK) LIST[(size_t)NEXP * NTOK + tok] = (u32x2){(unsigned)tok | (8u << 16), __builtin_bit_cast(unsigned, 1.0f)};
}

__device__ __forceinline__ void build_tiles(Frame& F) {
    LAS int* TS = (LAS int*)(F.lds + TAB_OFF + 2048); LAS int* CN = (LAS int*)(F.lds + TAB_OFF + 3200);
    if (F.tid < 64) { const int l = F.tid; int c[5], t[5], tot = 0;
#pragma unroll
        for (int j = 0; j < 5; ++j) { const int e = 5 * l + j; c[j] = (e < NEXPS) ? (int)__hip_atomic_load((unsigned*)(F.ctl + CW_CNT + e), RLX_AGENT) : 0; t[j] = (c[j] + 255) >> 8; tot += t[j]; }
        int x = tot;
#pragma unroll
        for (int off = 1; off < 64; off <<= 1) { const int v = __shfl_up(x, off); if (l >= off) x += v; }
        int run = x - tot;
#pragma unroll
        for (int j = 0; j < 5; ++j) { const int e = 5 * l + j; if (e <= NEXPS) { TS[e] = run; if (e < NEXPS) CN[e] = c[j]; } run += t[j]; }
    }
    __syncthreads();
}

__device__ __forceinline__ void ph2(Frame& F) {
    const gi64* MOD = (const gi64*)(F.ctl + CW_MOD); const int gw = F.vcu * 8 + F.wave, NGW = F.G * 8; (void)MOD; (void)gw; (void)NGW;
        DenseOrder S{7, 128 * 7, 8, F.G, F.vcu, (const char*)(F.ws + WS_BIN), DM, (REP == 22) ? 2 : 1};
        EpiInProj E{WSP(u16, WS_Z), WSP(u16, WS_Q), WSP(u16, WS_K), WSP(u16, WS_V), WSP(float, WS_TAB + 128 * 1024), WSP(float, WS_TAB + 136 * 1024), F.q_norm_g, F.k_norm_g};
        pg8::gemm_phase<EpiInProj, DenseOrder, 0, true>(F.lds + RING_OFF, (const char*)(F.ws + WS_XN), DM, S, E);
    }
__device__ __forceinline__ void ph4(Frame& F) {
    const gi64* MOD = (const gi64*)(F.ctl + CW_MOD); const int gw = F.vcu * 8 + F.wave, NGW = F.G * 8; (void)MOD; (void)gw; (void)NGW;
        if (DBG & 128) { GAS u32x4* zH = (GAS u32x4*)(F.ws + WS_H2); const size_t nH = (size_t)NTOK * DM * 2 / 16; for (size_t i = (size_t)blockIdx.x * 512 + F.tid; i < nH; i += (size_t)F.G * 512) zH[i] = (u32x4){0u, 0u, 0u, 0u}; }
        DenseOrder S{4, 128 * 4, 0, F.G, F.vcu, (const char*)(F.ws + WS_BOUT), DM, 1};
        EpiResid E{F.x, F.out, MOD};
        pg8::gemm_phase<EpiResid, DenseOrder, 0, true>(F.lds + RING_OFF, (const char*)(F.ws + WS_MIX), DM, S, E);
    }
__device__ __forceinline__ void ph5(Frame& F) {
    const gi64* MOD = (const gi64*)(F.ctl + CW_MOD); const int gw = F.vcu * 8 + F.wave, NGW = F.G * 8;
    const int wpb = NGW >> 2, b = gw / wpb, wi = gw % wpb;
    rownorm_rows<(MOE_FP8 ? false : MOEF16), MOE_FP8>((const GAS float*)F.out, F.norm2_g, MOD + b * 6144 + 3072, MOD + b * 6144 + 4096, WSP(u16, WS_H2), b * SEQ, SEQ, wi, wpb, F.lane, F.ws + WS_H2F8);
}
__device__ __forceinline__ void ph6(Frame& F) {
    const gi64* MOD = (const gi64*)(F.ctl + CW_MOD); const int gw = F.vcu * 8 + F.wave, NGW = F.G * 8; (void)MOD; (void)gw; (void)NGW;
        DenseOrder S{1, 128, 0, F.G, F.vcu, (const char*)(F.ws + WS_BR), DM, 1};
        EpiLogits E{WSP(float, WS_LOG)};
        pg8::gemm_phase<EpiLogits, DenseOrder, (MOE_FP8 ? 0 : (MOE_F16 ? 1 : 0)), true>(F.lds + RING_OFF, (const char*)(F.ws + WS_H2), DM, S, E);
    }
__device__ __forceinline__ void ph8(Frame& F) {
    const gi64* MOD = (const gi64*)(F.ctl + CW_MOD); const int gw = F.vcu * 8 + F.wave, NGW = F.G * 8; (void)MOD; (void)gw; (void)NGW;
        build_tiles(F);
        GroupedOrder<true> S{2, F.G, F.vcu, 512, DM * (MOE_FP8 ? 1 : 2), true, (const char*)(F.ws + WS_BGU), (const LAS int*)(F.lds + TAB_OFF + 2048), (const LAS int*)(F.lds + TAB_OFF + 3200), (const GAS u32x2*)(F.ws + WS_LIST), (REP == 28) ? 2 : 1, __builtin_amdgcn_readfirstlane(((const LAS int*)(F.lds + TAB_OFF + 2048))[257])};
        EpiSwiglu E{WSP(u16, WS_ACT)};
        pg8::gemm_phase<EpiSwiglu, GroupedOrder<true>, MOE_DT, true>(F.lds + RING_OFF, (const char*)(F.ws + (MOE_FP8 ? WS_H2F8 : WS_H2)), DM, S, E, SC_GU);
    }
__device__ __forceinline__ void ph9(Frame& F) {
    const gi64* MOD = (const gi64*)(F.ctl + CW_MOD); const int gw = F.vcu * 8 + F.wave, NGW = F.G * 8; (void)MOD; (void)gw; (void)NGW;
        build_tiles(F);
        GroupedOrder<false> S{4, F.G, F.vcu, DM, EFF * (MOE_FP8 ? 1 : 2), false, (const char*)(F.ws + WS_BD), (const LAS int*)(F.lds + TAB_OFF + 2048), (const LAS int*)(F.lds + TAB_OFF + 3200), (const GAS u32x2*)(F.ws + WS_LIST), (REP == 29) ? 2 : 1, __builtin_amdgcn_readfirstlane(((const LAS int*)(F.lds + TAB_OFF + 2048))[257])};
        EpiDown E{WSP(u16, WS_C), (const GAS u32x2*)(F.ws + WS_LIST)};
        pg8::gemm_phase<EpiDown, GroupedOrder<false>, MOE_DT, true>(F.lds + RING_OFF, (const char*)(F.ws + WS_ACT), EFF, S, E, SC_D);
    }

#if DBG & (1024 | 2048)
__device__ __forceinline__ void chk_attn(Frame& F, float negM) {
    const int gw = F.vcu * 8 + F.wave, NGW = F.G * 8, lane = F.lane;
    const GAS u16* Q = (const GAS u16*)(F.ws + WS_Q); const GAS u16* K = (const GAS u16*)(F.ws + WS_K); const GAS u16* V = (const GAS u16*)(F.ws + WS_V); const GAS u16* MIX = (const GAS u16*)(F.ws + WS_MIX);
    float* chk = (float*)(F.ctl + CW_CHK);
    for (int i = gw; i < 4096; i += NGW) {
        const int b = i & 3, h = (i >> 2) % 12, q = (int)((((unsigned)i * 2654435761u) >> 19) & 8191u), kvh = h / 3;
        float qv[64], o[64]; float l = 0.f;
#pragma unroll
        for (int c = 0; c < 8; ++c) { const u32x4 w = *(const GAS u32x4*)(Q + ((size_t)(b * SEQ + q)) * QW + h * 64 + 8 * c);
            qv[8 * c] = bflo(w.x); qv[8 * c + 1] = bfhi(w.x); qv[8 * c + 2] = bflo(w.y); qv[8 * c + 3] = bfhi(w.y); qv[8 * c + 4] = bflo(w.z); qv[8 * c + 5] = bfhi(w.z); qv[8 * c + 6] = bflo(w.w); qv[8 * c + 7] = bfhi(w.w); }
#pragma unroll
        for (int d = 0; d < 64; ++d) o[d] = 0.f;
        for (int t = 0; t < LKV / 64; ++t) { const int j = t * 64 + lane; const GAS u16* kr = K + ((size_t)(b * LKV + j)) * KVW + kvh * 64; const GAS u16* vr = V + ((size_t)(b * LKV + j)) * KVW + kvh * 64;
            float dot = 0.f;
#pragma unroll
            for (int c = 0; c < 8; ++c) { const u32x4 w = *(const GAS u32x4*)(kr + 8 * c);
                dot += qv[8 * c] * bflo(w.x) + qv[8 * c + 1] * bfhi(w.x) + qv[8 * c + 2] * bflo(w.y) + qv[8 * c + 3] * bfhi(w.y) + qv[8 * c + 4] * bflo(w.z) + qv[8 * c + 5] * bfhi(w.z) + qv[8 * c + 6] * bflo(w.w) + qv[8 * c + 7] * bfhi(w.w); }
            const float pp = exp2f(dot + negM); l += pp;
#pragma unroll
            for (int c = 0; c < 8; ++c) { const u32x4 w = *(const GAS u32x4*)(vr + 8 * c);
                o[8 * c] += pp * bflo(w.x); o[8 * c + 1] += pp * bfhi(w.x); o[8 * c + 2] += pp * bflo(w.y); o[8 * c + 3] += pp * bfhi(w.y); o[8 * c + 4] += pp * bflo(w.z); o[8 * c + 5] += pp * bfhi(w.z); o[8 * c + 6] += pp * bflo(w.w); o[8 * c + 7] += pp * bfhi(w.w); } }
        l = wave_sum(l); float err = 0.f, ref = 0.f;
#pragma unroll
        for (int d = 0; d < 64; ++d) { const float od = wave_sum(o[d]) / l; const float mv = bflo((unsigned)MIX[((size_t)(b * SEQ + q)) * DM + 256 + h * 64 + d]); err += (od - mv) * (od - mv); ref += od * od; }
        if (lane == 0) { atomicAdd(chk + 0, err); atomicAdd(chk + 1, ref); }
    }
}
__device__ __forceinline__ void chk_qkv(Frame& F) {
    const int gw = F.vcu * 8 + F.wave, NGW = F.G * 8, lane = F.lane;
    const gi64* MOD = (const gi64*)(F.ctl + CW_MOD);
    LAS float* hrow = (LAS float*)(F.lds + RING_OFF + F.wave * 16384);
    float* chk = (float*)(F.ctl + CW_CHK);
    for (int i = gw; i < 4096; i += NGW) {
        const unsigned hs = (unsigned)i * 2654435761u; const bool isctx = (i & 15) == 15; int sel = i % 20; if (isctx && sel < 12) sel = 12 + (sel & 7);
        const int m = isctx ? (int)((hs >> 10) & 1023u) : (int)((hs >> 12) & 32767u);
        const float* src = isctx ? F.ctx + (size_t)m * DM : F.x + (size_t)m * DM; const int mr = isctx ? 4 : (m >> 13);
        const int b = isctx ? (m >> 8) : (m >> 13), l = isctx ? 0 : (m & 8191), key = isctx ? SEQ + (m & 255) : l;
        f32x4 v[4]; float s2 = 0.f;
#pragma unroll
        for (int j = 0; j < 4; ++j) { v[j] = *(const f32x4*)(src + 4 * lane + 256 * j); s2 += (v[j][0] * v[j][0] + v[j][1] * v[j][1]) + (v[j][2] * v[j][2] + v[j][3] * v[j][3]); }
        const float rstd = 1.0f / sqrtf(wave_sum(s2) * (1.0f / DM) + RMS_EPS);
#pragma unroll
        for (int j = 0; j < 4; ++j) { const int col = 4 * lane + 256 * j; const f32x4 g = *(const f32x4*)(F.norm1_g + col); const f32x4 sh = mod4(MOD, mr * 6144 + col), sc = mod4(MOD, mr * 6144 + 1024 + col);
            const f32x4 y = v[j] * rstd * g * (sc + 1.0f) + sh; hrow[col] = y[0]; hrow[col + 1] = y[1]; hrow[col + 2] = y[2]; hrow[col + 3] = y[3]; }
        LDS_WAIT(); asm volatile("" ::: "memory");
        const int colbase = (sel < 12) ? 256 + 64 * sel : (sel < 16 ? 1024 + 64 * (sel - 12) : 1280 + 64 * (sel - 16));
        float z = 0.f;
        for (int k = 0; k < DM; ++k) z += hrow[k] * F.w_in[(size_t)k * 1536 + colbase + lane];
        float outv = z; int spos = lane;
        if (sel < 16) { const float ss = wave_sum(z * z); const float gain = (sel < 12) ? F.q_norm_g[lane] : F.k_norm_g[lane]; const float zz = z * (1.0f / sqrtf(ss * (1.0f / 64.0f) + RMS_EPS)) * gain;
            const float pz = __shfl(zz, lane ^ 16); outv = zz;
            if (!isctx) { const int pidx = (lane & 32) ? (l & 63) : (l >> 6); const float inv = powf(10000.0f, -(float)(lane & 15) / 16.0f), ang = (float)pidx * inv; const float cs = cosf(ang), sn = sinf(ang);
                outv = (lane & 16) ? zz * cs + pz * sn : zz * cs - pz * sn; }
            if (sel < 12) outv *= C2;
            spos = 32 * (lane >> 5) + 8 * ((lane >> 2) & 3) + 4 * ((lane >> 4) & 1) + (lane & 3); }
        float stored;
        if (sel < 12) stored = bflo((unsigned)((const GAS u16*)(F.ws + WS_Q))[(size_t)m * QW + sel * 64 + spos]);
        else if (sel < 16) stored = bflo((unsigned)((const GAS u16*)(F.ws + WS_K))[((size_t)(b * LKV + key)) * KVW + (sel - 12) * 64 + spos]);
        else stored = bflo((unsigned)((const GAS u16*)(F.ws + WS_V))[((size_t)(b * LKV + key)) * KVW + (sel - 16) * 64 + lane]);
        const float err = wave_sum((outv - stored) * (outv - stored)), ref = wave_sum(outv * outv);
        if (lane == 0) { atomicAdd(chk + 2, err); atomicAdd(chk + 3, ref); }
        LDS_WAIT(); asm volatile("" ::: "memory");
    }
}
#endif

struct Args { const float* in[20]; float* out; unsigned char* ws; int ph_lo, ph_hi; };
__global__ void __launch_bounds__(512, 2) mk_fwd(Args args) {
    extern __shared__ __attribute__((aligned(16))) unsigned char lds[];
    Frame F;
    F.lds = (LAS unsigned char*)lds;
    F.MISC = (volatile LAS unsigned*)(F.lds + MISC_OFF);
    F.tid = threadIdx.x; F.lane = F.tid & 63; F.wave = __builtin_amdgcn_readfirstlane(F.tid >> 6);
    F.G = gridDim.x; { const int bx = blockIdx.x; F.vcu = (F.G % 8 == 0) ? (bx % 8) * (F.G / 8) + bx / 8 : bx; }
    F.ws = args.ws; F.ctl = (gu32*)(args.ws + WS_CTL); F.out = args.out;
    F.x = args.in[0]; F.c = args.in[1]; F.ctx = args.in[2]; F.c_ctx = args.in[3]; F.norm1_g = args.in[4]; F.w_ada = args.in[5]; F.b_ada = args.in[6]; F.w_in = args.in[7]; F.w_fourier = args.in[8];
    F.q_norm_g = args.in[9]; F.k_norm_g = args.in[10]; F.w_out = args.in[11]; F.norm2_g = args.in[12]; F.w_router = args.in[13]; F.router_bias = args.in[14]; F.w_egu = args.in[15]; F.w_ed = args.in[16];
    F.w_sgu = args.in[17]; F.w_sd = args.in[18]; F.final_g = args.in[19];
    for (int u = F.tid; u < (LDS_BYTES - LDSCTL_OFF) / 4; u += 512) ((LAS unsigned*)(F.lds + LDSCTL_OFF))[u] = 0u;
    __syncthreads();
    XcdBarrier bar; bar.bar = (unsigned*)(F.ctl + CW_BAR); bar.x = 0; bar.st = nullptr;
    if (N_LAUNCHES == 1) bar = xcd_barrier_post((unsigned*)(F.ctl + CW_BAR), F.MISC + 8);
    const int lo = args.ph_lo, hi = args.ph_hi;
#define IN(k) (lo <= (k) && (k) < hi)
#define SEAM(k) do { if (IN(k) && IN((k) + 1)) xcd_barrier(bar); } while (0)
    const gi64* MOD = (const gi64*)(F.ctl + CW_MOD);
    const int gw = F.vcu * 8 + F.wave, NGW = F.G * 8;

    if (IN(0)) { p0_phase(F); } SEAM(0);
    if (IN(1)) { p1_phase(F); VM_WAIT(); __syncthreads(); if (REP == 1) { xcd_barrier(bar); p1_phase(F); VM_WAIT(); __syncthreads(); } } SEAM(1);

    if (IN(2)) { ph2(F); if (REP == 2) { xcd_barrier(bar); ph2(F); } } SEAM(2);

    if (IN(3)) {
        if (DBG & 32) { u16* MIXz = WSP(u16, WS_MIX); for (int m = gw; m < NTOK; m += NGW) *(GAS u32x2*)(MIXz + (size_t)m * DM + 4 * F.lane) = (u32x2){0u, 0u}; }
        else
        REPS(30) for (int U = F.vcu; U < NB * 64; U += F.G) { if (FOURIER_MFMA) fourier_unit_mfma(F, U >> 6, U & 63); else fourier_unit(F, U >> 6, U & 63); }
        const attn_body::bf16* Qp = (const attn_body::bf16*)(F.ws + WS_Q); const attn_body::bf16* Kp = (const attn_body::bf16*)(F.ws + WS_K); const attn_body::bf16* Vp = (const attn_body::bf16*)(F.ws + WS_V);
        attn_body::bf16* Op = (attn_body::bf16*)(F.ws + WS_MIX) + 256;
        float negM; { float gqm = fabsf(F.q_norm_g[F.lane]), gkm = fabsf(F.k_norm_g[F.lane]);
#pragma unroll
            for (int o_ = 1; o_ < 64; o_ <<= 1) { gqm = fmaxf(gqm, __shfl_xor(gqm, o_)); gkm = fmaxf(gkm, __shfl_xor(gkm, o_)); }
            negM = -(C2 * 64.0f * gqm * gkm + 0.5f); }
        if (ATTN_PRIO) { if (__builtin_amdgcn_readfirstlane(F.tid) >= 256) __builtin_amdgcn_s_setprio(1); }
        if (DBG & 16) { u16* MIXz = WSP(u16, WS_MIX); for (int m = gw; m < NTOK; m += NGW) for (int j = 1; j < 4; ++j) *(GAS u32x2*)(MIXz + (size_t)m * DM + 256 * j + 4 * F.lane) = (u32x2){0u, 0u}; }
        else if (F.G == 256) REPS(31) {
            const int xg = F.vcu >> 5, jq = F.vcu & 31;
            for (int i = 0; i < 6; ++i) { const int grp = 2 * xg + i / 3, hs = i % 3; attn_body::attn_unit<8>(grp >> 2, (grp & 3) * 3 + hs, jq, Qp, Kp, Vp, Op, (char*)lds + RING_OFF, negM); }
        } else {
            for (int U = F.vcu; U < NB * NQH * 32; U += F.G) { const int grp = U / 96, r = U % 96; attn_body::attn_unit<8>(grp >> 2, (grp & 3) * 3 + r / 32, r % 32, Qp, Kp, Vp, Op, (char*)lds + RING_OFF, negM); }
        }
        if (ATTN_PRIO) __builtin_amdgcn_s_setprio(0);
    } SEAM(3);

#if DBG & (1024 | 2048)
    if (IN(4)) { float negMc; { float gqm = fabsf(F.q_norm_g[F.lane]), gkm = fabsf(F.k_norm_g[F.lane]);
            for (int o_ = 1; o_ < 64; o_ <<= 1) { gqm = fmaxf(gqm, __shfl_xor(gqm, o_)); gkm = fmaxf(gkm, __shfl_xor(gkm, o_)); } negMc = -(C2 * 64.0f * gqm * gkm + 0.5f); }
        if (DBG & 1024) chk_attn(F, negMc); if (DBG & 2048) chk_qkv(F); VM_WAIT(); __syncthreads(); }
#endif
    if (IN(4)) { ph4(F); if (REP == 4) { xcd_barrier(bar); ph4(F); } } SEAM(4);

    if (IN(5)) { ph5(F); if (REP == 5) { xcd_barrier(bar); ph5(F); } if (REP == 55) { xcd_barrier(bar); xcd_barrier(bar); xcd_barrier(bar); xcd_barrier(bar); xcd_barrier(bar); } } SEAM(5);

    if (IN(6)) { ph6(F); if (REP == 6) { xcd_barrier(bar); ph6(F); } } SEAM(6);

    if (IN(7)) {
        if (DBG & 128) { GAS u32x4* zA = (GAS u32x4*)(F.ws + WS_ACT); const size_t nA = (size_t)MAXTILES * 256 * EFF * 2 / 16; for (size_t i = (size_t)blockIdx.x * 512 + F.tid; i < nA; i += (size_t)F.G * 512) zA[i] = (u32x4){0u, 0u, 0u, 0u};
            GAS u32x4* zC = (GAS u32x4*)(F.ws + WS_C); const size_t nC = (size_t)NTOK * NSLOT * DM * 2 / 16; for (size_t i = (size_t)blockIdx.x * 512 + F.tid; i < nC; i += (size_t)F.G * 512) zC[i] = (u32x4){0u, 0u, 0u, 0u}; }
        if (blockIdx.x == 0 && F.tid == 0) __hip_atomic_store((unsigned*)(F.ctl + CW_CNT + NEXP), (unsigned)NTOK, RLX_AGENT);
        for (int tok = gw; tok < NTOK; tok += NGW) route_token(F, tok);
    } SEAM(7);

    if (IN(8)) { ph8(F); if (REP == 8) { xcd_barrier(bar); ph8(F); } } SEAM(8);

    if (IN(9)) { ph9(F); if (REP == 9) { xcd_barrier(bar); ph9(F); } } SEAM(9);

    if (IN(10)) {
        const int lane = F.lane; const GAS unsigned char* Cc = (const GAS unsigned char*)(F.ws + WS_C);
        const int wpb = NGW >> 2, b = gw / wpb, wi = gw % wpb;
        f32x4 g2v[4], fg[4];
#pragma unroll
        for (int i = 0; i < 4; ++i) { const int col = 16 * lane + 4 * i; g2v[i] = mod4(MOD + b * 6144 + 5120, col) * (1.0f / C_SCALE); fg[i] = *(const f32x4*)(F.final_g + col); }
        bool bad = false;
#if DBG & (1024 | 2048)
        { const float e0 = __hip_atomic_load((float*)(F.ctl + CW_CHK), RLX_AGENT), r0 = __hip_atomic_load((float*)(F.ctl + CW_CHK) + 1, RLX_AGENT), e1 = __hip_atomic_load((float*)(F.ctl + CW_CHK) + 2, RLX_AGENT), r1 = __hip_atomic_load((float*)(F.ctl + CW_CHK) + 3, RLX_AGENT);
          if (DBG & 1024) bad = bad || !(e0 <= CHK_TOL_A * r0) || !(r0 > 0.f); if (DBG & 2048) bad = bad || !(e1 <= CHK_TOL_B * r1) || !(r1 > 0.f); }
#endif
        for (int r = wi; r < SEQ; r += wpb) { const int m = b * SEQ + r; GAS float* orow = (GAS float*)F.out + (size_t)m * DM + 16 * lane;
            f32x4 x1[4], y[4];
#pragma unroll
            for (int i = 0; i < 4; ++i) { x1[i] = *(const GAS f32x4*)(orow + 4 * i); y[i] = (f32x4){0.f, 0.f, 0.f, 0.f}; }
#pragma unroll
            for (int sl = 0; sl < NSLOT; ++sl) { const u32x4 w = *(const GAS u32x4*)(Cc + ((size_t)m * NSLOT + sl) * DM + 16 * lane);
#pragma unroll
                for (int i = 0; i < 4; ++i) { const int wi_ = (int)w[i]; const f32x2 lo = __builtin_amdgcn_cvt_pk_f32_fp8(wi_, false), hi = __builtin_amdgcn_cvt_pk_f32_fp8(wi_, true); y[i] += (f32x4){lo.x, lo.y, hi.x, hi.y}; } }
            float s2 = 0.f;
#pragma unroll
            for (int i = 0; i < 4; ++i) { const f32x4 v = x1[i] + g2v[i] * y[i]; x1[i] = v; s2 += (v[0] * v[0] + v[1] * v[1]) + (v[2] * v[2] + v[3] * v[3]); }
            const float rstd = 1.0f / sqrtf(wave_sum(s2) * (1.0f / DM) + RMS_EPS) * (bad ? 3.0f : 1.0f);
#pragma unroll
            for (int i = 0; i < 4; ++i) *(GAS f32x4*)(orow + 4 * i) = x1[i] * rstd * fg[i]; }
    }
#undef IN
#undef SEAM
}

extern "C" void kernel_launch(void* const* d_in, const int* in_sizes, int n_in, void* d_out, int out_size, void* d_ws, size_t ws_size, hipStream_t stream) {
    static int grid = 0;
    if (grid == 0) {
        if (n_in != 20 || in_sizes[0] != NTOK * DM || out_size != NTOK * DM || ws_size < WS_END) { fprintf(stderr, "kernel_launch: unexpected shapes (n_in %d, in0 %d, out %d, ws %zu < %zu)\n", n_in, n_in > 0 ? in_sizes[0] : -1, out_size, ws_size, (size_t)WS_END); grid = -1; return; }
        int dev = 0, cus = 0, per_cu = 0;
        if (hipGetDevice(&dev) != hipSuccess || hipDeviceGetAttribute(&cus, hipDeviceAttributeMultiprocessorCount, dev) != hipSuccess) { grid = -1; return; }
        if (hipFuncSetAttribute((const void*)mk_fwd, hipFuncAttributeMaxDynamicSharedMemorySize, LDS_BYTES) != hipSuccess) { fprintf(stderr, "kernel_launch: hipFuncSetAttribute failed\n"); grid = -1; return; }
        if (hipOccupancyMaxActiveBlocksPerMultiprocessor(&per_cu, (const void*)mk_fwd, 512, LDS_BYTES) != hipSuccess || per_cu < 1) fprintf(stderr, "kernel_launch: occupancy query reports %d\n", per_cu);
        (void)hipGetLastError();
        grid = cus;
    }
    if (grid < 0) return;
    (void)hipMemsetAsync((char*)d_ws + WS_CTL, 0, CTL_ZERO_BYTES, stream);
    Args a{};
    for (int i = 0; i < 20; ++i) a.in[i] = (const float*)d_in[i];
    a.out = (float*)d_out; a.ws = (unsigned char*)d_ws;
    if (N_LAUNCHES == 1) { a.ph_lo = 0; a.ph_hi = PER_PHASE; hipLaunchKernelGGL(mk_fwd, dim3(grid), dim3(512), LDS_BYTES, stream, a); }
    else for (int li = 0; li < PER_PHASE; ++li) { a.ph_lo = li; a.ph_hi = li + 1; hipLaunchKernelGGL(mk_fwd, dim3(grid), dim3(512), LDS_BYTES, stream, a); }
}
```

```cpp
#include <hip/hip_runtime.h>
#include <hip/hip_bf16.h>
#include <cstdio>
#include <cstdint>
#include <cmath>

#ifndef MK_N_LAUNCHES
#define MK_N_LAUNCHES 1
#endif
constexpr int PER_PHASE = 11;
#ifndef DBG
#define DBG 0
#endif
#ifndef REP
#define REP -1
#endif
#ifndef CHK_TOL_A
#define CHK_TOL_A 1e-3f
#endif
#ifndef CHK_TOL_B
#define CHK_TOL_B 1e-3f
#endif
#ifndef POSTEPI_WAITS
#define POSTEPI_WAITS 1
#endif
#ifndef ATTN_PRIO
#define ATTN_PRIO 1
#endif
#ifndef FOURIER_MFMA
#define FOURIER_MFMA 1
#endif
#define REPS(k) for (int rep_ = 0; rep_ < ((REP == (k)) ? 2 : 1); ++rep_)
#define REPBAR() do { if (rep_) xcd_barrier(bar); } while (0)
constexpr int N_LAUNCHES = MK_N_LAUNCHES;

#define GAS __attribute__((address_space(1)))
#define LAS __attribute__((address_space(3)))
typedef unsigned short u16;
typedef short bf16x8 __attribute__((ext_vector_type(8)));
typedef _Float16 half8 __attribute__((ext_vector_type(8)));
typedef _Float16 half2v __attribute__((ext_vector_type(2)));
typedef float f32x4 __attribute__((ext_vector_type(4)));
typedef float f32x2 __attribute__((ext_vector_type(2)));
typedef unsigned u32x4 __attribute__((ext_vector_type(4)));
typedef unsigned u32x2 __attribute__((ext_vector_type(2)));
typedef GAS unsigned gu32;

constexpr int DM = 1024, NB = 4, SEQ = 8192, NTOK = NB * SEQ, CTXL = 256, NCTX = NB * CTXL, LKV = SEQ + CTXL;
constexpr int NQH = 12, NKVH = 4, HD = 64, QW = NQH * HD, KVW = NKVH * HD;
constexpr int NIN = 1792;
constexpr int MIN_ROWS = NTOK + NCTX;
constexpr int NEXP = 256, NEXPS = 257, TOPK = 8, EFF = 256, NSLOT = 9;
constexpr int MAXTILES = 1408;
constexpr float RMS_EPS = 1e-6f;
#ifndef MOE_F16
#define MOE_F16 0
#endif
constexpr bool MOEF16 = MOE_F16;
#ifndef MOE_FP8
#define MOE_FP8 1
#endif
constexpr int MOE_DT = MOE_FP8 ? 2 : (MOE_F16 ? 1 : 0);
constexpr float WGU_SCALE = 32.0f, WD_SCALE = 16.0f;
constexpr int SC_ONE = 0x7f7f7f7f, SC_GU = 0x7f7f7f7a, SC_D = 0x7f7f7f7b;
constexpr float C2 = 0.125f * 1.4426950408889634f;
constexpr float C_SCALE = 16.0f;

constexpr size_t MiB = 1u << 20;
constexpr size_t WS_CTL = 0, CTL_ZERO_BYTES = 1 * MiB;
constexpr size_t WS_TAB = 1 * MiB;
constexpr size_t WS_BIN = 2 * MiB;
constexpr size_t WS_BOUT = 6 * MiB;
constexpr size_t WS_BR = 8 * MiB;
constexpr size_t WS_K = 16 * MiB;
constexpr size_t WS_V = 34 * MiB;
constexpr size_t WS_Z = 52 * MiB;
constexpr size_t WS_Q = 84 * MiB;
constexpr size_t WS_XN = 132 * MiB;
constexpr size_t WS_MIX = 198 * MiB;
constexpr size_t WS_H2 = 262 * MiB;
constexpr size_t WS_LOG = 326 * MiB;
constexpr size_t WS_LIST = 358 * MiB;
constexpr size_t WS_BGU = 424 * MiB;
constexpr size_t WS_BD = 682 * MiB;
constexpr size_t WS_ACT = 812 * MiB;
constexpr size_t WS_C = 990 * MiB;
constexpr size_t WS_H2F8 = 1568 * MiB;
constexpr size_t WS_DUMP = 1600 * MiB;
constexpr size_t WS_END = 1632 * MiB;
constexpr int CW_TMO = 0, CW_CODE = 1;
constexpr int CW_BAR = 4096;
constexpr int CW_CNT = 16384;
constexpr int CW_CHK = 32768;
constexpr int CW_MOD = 131072;
static_assert(CW_MOD * 4 + 5 * 6144 * 8 <= (int)CTL_ZERO_BYTES, "ctl");

constexpr int RING_OFF = 0, RING_BYTES = 131072;
constexpr int P1_SCR = 18432;
constexpr int TAB_OFF = 8 * P1_SCR;
constexpr int LDS_BYTES = 163840;
constexpr int LDSCTL_OFF = LDS_BYTES - 1024, MISC_OFF = LDSCTL_OFF + 320;
static_assert(TAB_OFF + 8192 <= LDSCTL_OFF, "LDS map");

#define LDS_WAIT() asm volatile("s_waitcnt lgkmcnt(0)" ::: "memory")
#define VM_WAIT() asm volatile("s_waitcnt vmcnt(0)" ::: "memory")
#define RLX_AGENT __ATOMIC_RELAXED, __HIP_MEMORY_SCOPE_AGENT

__device__ __forceinline__ unsigned f2bf(float f) { unsigned u = __builtin_bit_cast(unsigned, f); return (u + 0x7fffu + ((u >> 16) & 1u)) >> 16; }
__device__ __forceinline__ unsigned pk2bf(float lo, float hi) { return f2bf(lo) | (f2bf(hi) << 16); }
__device__ __forceinline__ unsigned pk2h(float lo, float hi) { half2v v = {(_Float16)lo, (_Float16)hi}; return __builtin_bit_cast(unsigned, v); }
__device__ __forceinline__ unsigned cvt_pk_bf16(float lo, float hi) { unsigned r; asm volatile("v_cvt_pk_bf16_f32 %0, %1, %2" : "=v"(r) : "v"(lo), "v"(hi)); return r; }
__device__ __forceinline__ float bflo(unsigned w) { return __builtin_bit_cast(float, w << 16); }
__device__ __forceinline__ float bfhi(unsigned w) { return __builtin_bit_cast(float, w & 0xffff0000u); }
typedef long long i64x2 __attribute__((ext_vector_type(2)));
typedef GAS long long gi64;
__device__ __forceinline__ f32x4 mod4(const gi64* MODQ, int idx) {
    const i64x2 a = *(const GAS i64x2*)(MODQ + idx), b = *(const GAS i64x2*)(MODQ + idx + 2);
    return (f32x4){(float)a.x, (float)a.y, (float)b.x, (float)b.y} * 0x1p-36f;
}
__device__ __forceinline__ float wave_sum(float v) {
#pragma unroll
    for (int o = 1; o < 64; o <<= 1) v += __shfl_xor(v, o);
    return v;
}

namespace pg8 {
constexpr int BM = 256, BK = 64, HALF = 128, HTB = HALF * BK * 2, STAGE_BYTES = 8 * HTB;
__host__ __device__ __forceinline__ int lds_byte(int r, int c) { const int st = (r >> 4) * 2 + (c >> 5), rr = r & 15, cc = c & 31, ob = rr * 64 + cc * 2; return st * 1024 + (ob ^ (((ob >> 9) & 1) << 5)); }
__host__ __device__ __forceinline__ void stage_rc(int b, int& R, int& C) { const int st = b / 1024, sb = b % 1024, swz = sb ^ (((sb >> 9) & 1) << 5); R = (st >> 1) * 16 + swz / 64; C = (st & 1) * 32 + (swz % 64) / 2; }
__host__ __device__ __forceinline__ int perm32(int rho) { const int n = rho >> 4, i = rho & 15; return 8 * (i >> 2) + 4 * n + (i & 3); }

struct GUnit { int pm, pn, e, j, nvalid; const char* B; };

typedef int v8i __attribute__((ext_vector_type(8)));
typedef int v4i __attribute__((ext_vector_type(4)));
template <int DT> __device__ __forceinline__ f32x4 mma_tile(const v8i a, const v8i b, f32x4 c, int scA) {
    if constexpr (DT == 2) return __builtin_amdgcn_mfma_scale_f32_16x16x128_f8f6f4(a, b, c, 0, 0, 0, scA, 1, scA);
    else { const v4i a0 = __builtin_shufflevector(a, a, 0, 1, 2, 3), a1 = __builtin_shufflevector(a, a, 4, 5, 6, 7), b0 = __builtin_shufflevector(b, b, 0, 1, 2, 3), b1 = __builtin_shufflevector(b, b, 4, 5, 6, 7);
        if constexpr (DT == 1) { c = __builtin_amdgcn_mfma_f32_16x16x32_f16(__builtin_bit_cast(half8, a0), __builtin_bit_cast(half8, b0), c, 0, 0, 0); return __builtin_amdgcn_mfma_f32_16x16x32_f16(__builtin_bit_cast(half8, a1), __builtin_bit_cast(half8, b1), c, 0, 0, 0); }
        else { c = __builtin_amdgcn_mfma_f32_16x16x32_bf16(__builtin_bit_cast(bf16x8, a0), __builtin_bit_cast(bf16x8, b0), c, 0, 0, 0); return __builtin_amdgcn_mfma_f32_16x16x32_bf16(__builtin_bit_cast(bf16x8, a1), __builtin_bit_cast(bf16x8, b1), c, 0, 0, 0); } }
}

template <class Epi, class Sched, int DT, bool ALIGN_EPI>
__device__ __forceinline__ void gemm_phase(LAS unsigned char* lds, const char* Abase, const int K, const Sched& S, const Epi& E, const int scB = SC_ONE) {
    const int tid = threadIdx.x, wid = __builtin_amdgcn_readfirstlane(tid >> 6), lane = tid & 63, wr = wid >> 2, wc = wid & 3, fr = lane & 15, fq = lane >> 4;
    constexpr int ES = (DT == 2) ? 1 : 2;
    const int RB = K * ES;
    const int nt = RB / 128;
    unsigned voffB0; { int R, C; stage_rc(tid * 16, R, C); const int Rb = Epi::PERM ? ((R & ~31) + perm32(R & 31)) : R; voffB0 = (unsigned)(Rb * RB + C * 2); }
    const unsigned voffBd = 64u * (unsigned)RB;
#define PG8_AOFF(V, UNIT) do { int t_ = threadIdx.x; asm volatile("" : "+v"(t_)); _Pragma("unroll") for (int _i = 0; _i < 2; ++_i) { int R_, C_; stage_rc(t_ * 16 + _i * 8192, R_, C_); \
        _Pragma("unroll") for (int _h = 0; _h < 2; ++_h) (V)[_h][_i] = (unsigned)S.arow(UNIT, R_ + HALF * _h) * (unsigned)RB + (unsigned)(C_ * 2); } } while (0)
    const size_t kstep = (size_t)(BK * 2);
    const size_t hstep = (size_t)HALF * RB;
    const unsigned ldsw = (unsigned)wid * 1024u;
    const int ac0 = (DT == 2) ? 16 * fq : 8 * fq; constexpr int CH1 = (DT == 2) ? 16 : 1024;
    const int aoff = lds_byte(wr * 64 + fr, ac0), boff = lds_byte(wc * 32 + fr, ac0);
#define PG8_SA(b, h) (((b) * 2 + (h)) * HTB)
#define PG8_SB(b, h) ((4 + (b) * 2 + (h)) * HTB)
#define PG8_STAGEB(bufoff, gbase) do { _Pragma("unroll") for (int _i = 0; _i < 2; ++_i) \
        __builtin_amdgcn_global_load_lds((const unsigned*)((const char*)(gbase) + voffB0 + _i * voffBd), (LAS unsigned*)(lds + (bufoff) + ldsw + _i * 8192), 16, 0, 0); } while (0)
#define PG8_STAGEA(bufoff, koff, V, h) do { _Pragma("unroll") for (int _i = 0; _i < 2; ++_i) \
        __builtin_amdgcn_global_load_lds((const unsigned*)(Abase + (size_t)(V)[h][_i] + (koff)), (LAS unsigned*)(lds + (bufoff) + ldsw + _i * 8192), 16, 0, 0); } while (0)
#define PG8_LDA(dst, b, h) do { _Pragma("unroll") for (int m = 0; m < 4; ++m) { const v4i c0_ = *(const LAS v4i*)(lds + PG8_SA(b, h) + aoff + m * 2048), c1_ = *(const LAS v4i*)(lds + PG8_SA(b, h) + aoff + m * 2048 + CH1); dst[m] = __builtin_shufflevector(c0_, c1_, 0, 1, 2, 3, 4, 5, 6, 7); } } while (0)
#define PG8_LDB(dst, b, h) do { _Pragma("unroll") for (int n = 0; n < 2; ++n) { const v4i c0_ = *(const LAS v4i*)(lds + PG8_SB(b, h) + boff + n * 2048), c1_ = *(const LAS v4i*)(lds + PG8_SB(b, h) + boff + n * 2048 + CH1); dst[n] = __builtin_shufflevector(c0_, c1_, 0, 1, 2, 3, 4, 5, 6, 7); } } while (0)
#define PG8_MMA(ai, bj, At, Bt) do { __builtin_amdgcn_s_setprio(1); _Pragma("unroll") for (int m = 0; m < 4; ++m) _Pragma("unroll") for (int n = 0; n < 2; ++n) \
        acc[ai][bj][m][n] = mma_tile<DT>(Bt[n], At[m], acc[ai][bj][m][n], scB); __builtin_amdgcn_s_setprio(0); } while (0)
#define PG8_WAIT_V(n) asm volatile("s_waitcnt vmcnt(" #n ")" ::: "memory")
#define PG8_WAIT_VE(pe) do { if (pe) asm volatile("s_waitcnt vmcnt(%0)" :: "n"(8 + Epi::NSTORE) : "memory"); else asm volatile("s_waitcnt vmcnt(8)" ::: "memory"); } while (0)
#define PG8_WAIT_L(n) asm volatile("s_waitcnt lgkmcnt(" #n ")" ::: "memory")
#define PG8_BAR __builtin_amdgcn_s_barrier()
#define PG8_SCHED __builtin_amdgcn_sched_barrier(0)
    GUnit cur, nxt; int ui = 0;
    if (!S.next(0, cur)) return;
    f32x4 acc[2][2][4][2];
#pragma unroll
    for (int a = 0; a < 2; ++a)
#pragma unroll
        for (int b = 0; b < 2; ++b)
#pragma unroll
            for (int m = 0; m < 4; ++m)
#pragma unroll
                for (int n = 0; n < 2; ++n) acc[a][b][m][n] = (f32x4){0.f, 0.f, 0.f, 0.f};
    v8i At[4], B0[2], B1[2];
    unsigned vA[2][2];
    PG8_AOFF(vA, cur);
    if constexpr (Sched::GATHER) VM_WAIT();
    const char* cB = cur.B;
    E.pre(lds, cur, 0, wid, lane);
    PG8_STAGEB(PG8_SB(0, 0), cB); PG8_STAGEB(PG8_SB(0, 1), cB + hstep); PG8_STAGEA(PG8_SA(0, 0), 0, vA, 0); PG8_STAGEA(PG8_SA(0, 1), 0, vA, 1);
    if (wr == 1) PG8_BAR;
    PG8_WAIT_V(2); PG8_BAR;
    PG8_STAGEB(PG8_SB(1, 0), cB + kstep); PG8_STAGEA(PG8_SA(1, 0), kstep, vA, 0); PG8_STAGEB(PG8_SB(1, 1), cB + hstep + kstep);
    PG8_WAIT_V(6); PG8_BAR;
    for (;;) {
        const bool has_next = S.next(ui + 1, nxt);
#pragma unroll 1
        for (int t = 0; t < nt; t += 2) {
            const bool last = (t == nt - 2);
            const bool pe = POSTEPI_WAITS && (t == 0) && (ui > 0);
            const size_t k1 = (size_t)(t + 1) * kstep;
            PG8_LDB(B0, 0, 0); PG8_LDB(B1, 0, 1); PG8_SCHED; PG8_LDA(At, 0, 0); PG8_STAGEA(PG8_SA(1, 1), k1, vA, 1);
            PG8_WAIT_VE(pe); PG8_WAIT_L(0); PG8_BAR; PG8_MMA(0, 0, At, B0); PG8_MMA(0, 1, At, B1); PG8_BAR; PG8_SCHED;
            size_t k2 = (size_t)(t + 2) * kstep;
            if (last) { k2 = 0; if (has_next) { PG8_AOFF(vA, nxt); if constexpr (Sched::GATHER) VM_WAIT(); cB = nxt.B; } }
            const size_t k3 = k2 + kstep; const char* b2 = cB + k2; const char* b3 = b2 + kstep;
            PG8_LDA(At, 0, 1); PG8_STAGEB(PG8_SB(0, 0), b2); PG8_STAGEB(PG8_SB(0, 1), b2 + hstep); PG8_STAGEA(PG8_SA(0, 0), k2, vA, 0);
            PG8_WAIT_VE(pe); PG8_WAIT_L(0); PG8_BAR; PG8_MMA(1, 0, At, B0); PG8_MMA(1, 1, At, B1); PG8_BAR; PG8_SCHED;
            PG8_LDB(B0, 1, 0); PG8_LDB(B1, 1, 1); PG8_SCHED; PG8_LDA(At, 1, 0); PG8_STAGEA(PG8_SA(0, 1), k2, vA, 1);
            PG8_WAIT_V(8); PG8_WAIT_L(0); PG8_BAR; PG8_MMA(0, 0, At, B0); PG8_MMA(0, 1, At, B1); PG8_BAR; PG8_SCHED;
            PG8_LDA(At, 1, 1); PG8_STAGEB(PG8_SB(1, 0), b3); PG8_STAGEB(PG8_SB(1, 1), b3 + hstep); PG8_STAGEA(PG8_SA(1, 0), k3, vA, 0);
            PG8_WAIT_V(8); PG8_WAIT_L(0); PG8_BAR; PG8_MMA(1, 0, At, B0); PG8_MMA(1, 1, At, B1); PG8_BAR; PG8_SCHED;
        }
        if constexpr (ALIGN_EPI) { if (wr == 0) PG8_BAR; }
        { int tx = threadIdx.x; asm volatile("" : "+v"(tx)); E(acc, cur, wr, wc, tx & 15, (tx >> 4) & 3, lds, ui); }
        if (!has_next) break;
#pragma unroll
        for (int a = 0; a < 2; ++a)
#pragma unroll
            for (int b = 0; b < 2; ++b)
#pragma unroll
                for (int m = 0; m < 4; ++m)
#pragma unroll
                    for (int n = 0; n < 2; ++n) acc[a][b][m][n] = (f32x4){0.f, 0.f, 0.f, 0.f};
        cur = nxt; ++ui;
        if constexpr (ALIGN_EPI) { if (wr == 1) PG8_BAR; }
        E.pre(lds, cur, ui, wid, lane);
    }
    PG8_WAIT_V(0);
    if constexpr (!ALIGN_EPI) { if (wr == 0) PG8_BAR; }
    PG8_BAR;
#undef PG8_SA
#undef PG8_SB
#undef PG8_STAGEA
#undef PG8_AOFF
#undef PG8_STAGEB
#undef PG8_LDA
#undef PG8_LDB
#undef PG8_MMA
#undef PG8_WAIT_V
#undef PG8_WAIT_VE
#undef PG8_WAIT_L
#undef PG8_BAR
#undef PG8_SCHED
}
}

namespace attn_body {
using bf16 = __hip_bfloat16;
using s16x4 = __attribute__((ext_vector_type(4))) short;
using f32x16 = __attribute__((ext_vector_type(16))) float;
constexpr int D = 64, DMQ = QW, DMKV = KVW, DMO = DM;
constexpr int NW = 8, QBLK = 32, QB = QBLK * NW, KVBLK = 64, NT = LKV / KVBLK;
static_assert(NT % 2 == 0 && NT >= 8, "tile count");
__device__ __forceinline__ int crow(int r, int hi) { return (r & 3) + 8 * (r >> 2) + 4 * hi; }
#define SBAR() __builtin_amdgcn_sched_barrier(0)
constexpr int NSLOTR = 3, SLOTB = 8192;
constexpr int LDS_K = 0, LDS_V = NSLOTR * SLOTB, LDS_WS = 2 * NSLOTR * SLOTB, LDS_OST = LDS_WS + NW * 64 * 4, ATT_LDS_BYTES = LDS_OST + NW * 4096;
__device__ __forceinline__ void glds16(const void* gsrc, unsigned lds_dst) { unsigned keep;
    asm volatile("s_mov_b32 %0, m0\n\ts_mov_b32 m0, %2\n\ts_nop 0\n\tglobal_load_lds_dwordx4 %1, off\n\ts_mov_b32 m0, %0" : "=&s"(keep) : "v"(gsrc), "s"(lds_dst) : "memory"); }
__device__ __forceinline__ float max3f(float a, float b, float c) { float r; asm("v_max3_f32 %0, %1, %2, %3" : "=v"(r) : "v"(a), "v"(b), "v"(c)); return r; }
__device__ __forceinline__ float max2f(float a, float b) { float r; asm("v_max_f32_e32 %0, %1, %2" : "=v"(r) : "v"(a), "v"(b)); return r; }
__device__ __forceinline__ float fadd_s(float a, float b) { float r; asm("v_add_f32_e32 %0, %1, %2" : "=v"(r) : "v"(a), "v"(b)); return r; }
__device__ __forceinline__ float fsub_s(float a, float b) { float r; asm("v_sub_f32_e32 %0, %1, %2" : "=v"(r) : "v"(a), "v"(b)); return r; }
typedef float f32x2_t __attribute__((ext_vector_type(2))); typedef __bf16 bf16x2_t __attribute__((ext_vector_type(2)));
__device__ __forceinline__ unsigned cvtpk_s(float lo, float hi) { f32x2_t v = {lo, hi}; bf16x2_t b = __builtin_convertvector(v, bf16x2_t); return __builtin_bit_cast(unsigned, b); }
#define WAIT_BAR(N) asm volatile("s_waitcnt vmcnt(" #N ") lgkmcnt(0)\n\ts_barrier" ::: "memory")

__device__ __forceinline__ void qkt(f32x16& p0, f32x16& p1, const char* Kslot, const bf16x8* qr, const f32x16& negm, int r32, int hi) {
    const char* kb = Kslot + hi * 1024 + r32 * 16;
#pragma unroll
    for (int d0 = 0; d0 < 4; ++d0) {
        const bf16x8 b0 = *reinterpret_cast<const bf16x8*>(kb + d0 * 2048);
        const bf16x8 b1 = *reinterpret_cast<const bf16x8*>(kb + d0 * 2048 + 512);
        if (d0 == 0) { p0 = __builtin_amdgcn_mfma_f32_32x32x16_bf16(b0, qr[0], negm, 0, 0, 0); p1 = __builtin_amdgcn_mfma_f32_32x32x16_bf16(b1, qr[0], negm, 0, 0, 0); }
        else { p0 = __builtin_amdgcn_mfma_f32_32x32x16_bf16(b0, qr[d0], p0, 0, 0, 0); p1 = __builtin_amdgcn_mfma_f32_32x32x16_bf16(b1, qr[d0], p1, 0, 0, 0); } }
}
typedef __attribute__((address_space(3))) const char* lds_cptr;
typedef short v4i16_t __attribute__((ext_vector_type(4)));
__device__ __forceinline__ void kload8(bf16x8* kf, lds_cptr kp) {
    kf[0] = *(const __attribute__((address_space(3))) bf16x8*)(kp);        kf[1] = *(const __attribute__((address_space(3))) bf16x8*)(kp + 512);
    kf[2] = *(const __attribute__((address_space(3))) bf16x8*)(kp + 2048); kf[3] = *(const __attribute__((address_space(3))) bf16x8*)(kp + 2560);
    kf[4] = *(const __attribute__((address_space(3))) bf16x8*)(kp + 4096); kf[5] = *(const __attribute__((address_space(3))) bf16x8*)(kp + 4608);
    kf[6] = *(const __attribute__((address_space(3))) bf16x8*)(kp + 6144); kf[7] = *(const __attribute__((address_space(3))) bf16x8*)(kp + 6656);
}
__device__ __forceinline__ void kload2(bf16x8* kf, lds_cptr kp, int j) { kf[2 * j] = *(const __attribute__((address_space(3))) bf16x8*)(kp + j * 2048); kf[2 * j + 1] = *(const __attribute__((address_space(3))) bf16x8*)(kp + j * 2048 + 512); }
__device__ __forceinline__ s16x4 vtr(lds_cptr p) { return __builtin_bit_cast(s16x4, __builtin_amdgcn_ds_read_tr16_b64_v4i16((__attribute__((address_space(3))) v4i16_t*)p)); }
__device__ __forceinline__ float rowmax(const f32x16& p0, const f32x16& p1) {
    float a = max3f(p0[0], p0[1], p1[0]), b = max3f(p0[2], p0[3], p1[1]); a = max3f(a, p1[2], p1[3]);
#pragma unroll
    for (int r = 4; r < 16; r += 4) { a = max3f(a, p0[r], p0[r + 1]); b = max3f(b, p0[r + 2], p0[r + 3]); a = max3f(a, p1[r], p1[r + 1]); b = max3f(b, p1[r + 2], p1[r + 3]); }
    const float m = max2f(a, b);
    auto rr = __builtin_amdgcn_permlane32_swap(__float_as_uint(m), __float_as_uint(m), false, false);
    return max2f(__uint_as_float(rr[0]), __uint_as_float(rr[1]));
}
__device__ __forceinline__ void pv(f32x16* o, int vb, bf16x8 pa0, bf16x8 pa1, bf16x8 pa2, bf16x8 pa3) {
#pragma unroll
    for (int d0 = 0; d0 < 2; ++d0) { s16x4 lo[4], hi[4];
#pragma unroll
        for (int ks = 0; ks < 4; ++ks) {
            asm volatile("ds_read_b64_tr_b16 %0,%1 offset:%c2" : "=&v"(lo[ks]) : "v"(vb), "i"(d0 * 4096 + ks * 1024) : "memory");
            asm volatile("ds_read_b64_tr_b16 %0,%1 offset:%c2" : "=&v"(hi[ks]) : "v"(vb), "i"(d0 * 4096 + ks * 1024 + 512) : "memory"); }
        asm volatile("s_waitcnt lgkmcnt(0)" ::: "memory"); SBAR();
#define PK(k) (bf16x8){lo[k][0], lo[k][1], lo[k][2], lo[k][3], hi[k][0], hi[k][1], hi[k][2], hi[k][3]}
        o[d0] = __builtin_amdgcn_mfma_f32_32x32x16_bf16(pa0, PK(0), o[d0], 0, 0, 0);
        o[d0] = __builtin_amdgcn_mfma_f32_32x32x16_bf16(pa1, PK(1), o[d0], 0, 0, 0);
        o[d0] = __builtin_amdgcn_mfma_f32_32x32x16_bf16(pa2, PK(2), o[d0], 0, 0, 0);
        o[d0] = __builtin_amdgcn_mfma_f32_32x32x16_bf16(pa3, PK(3), o[d0], 0, 0, 0);
#undef PK
    }
}
template <int THRL> __device__ __forceinline__ void attn_unit(int b, int h, int qb, const bf16* Q, const bf16* __restrict__ K, const bf16* __restrict__ V, bf16* O, char* shm, float negM_) {
    const int tid = threadIdx.x, lane = tid & 63, r32 = lane & 31, hi = lane >> 5; const int wid = __builtin_amdgcn_readfirstlane(tid >> 6);
    const int q0 = qb * QB; const int kvh = h / 3;
    const long qrow0 = (long)b * SEQ + q0 + wid * QBLK;
    const long kvrow0 = (long)b * LKV;
    const bf16* Qw = Q + qrow0 * DMQ + h * D;
    const bf16* Kh = K + kvrow0 * DMKV + kvh * D, *Vh = V + kvrow0 * DMKV + kvh * D;
    const unsigned lds0 = (unsigned)(uintptr_t)shm;
    float* wsf = (float*)(shm + LDS_WS) + wid * 64;
    const bf16* ksrc = Kh + (long)lane * DMKV + wid * 8;
    const bf16* vsrc = Vh + (long)(16 * (wid & 3) + (lane >> 2)) * DMKV + (wid >> 2) * 32 + (lane & 3) * 8;
    const unsigned kdst = lds0 + LDS_K + wid * 1024, vdst = lds0 + LDS_V + wid * 1024;
#define DMA_K(t, slot) glds16(ksrc + (long)(t) * KVBLK * DMKV, (unsigned)__builtin_amdgcn_readfirstlane(kdst + (slot)))
#define DMA_V(t, slot) glds16(vsrc + (long)(t) * KVBLK * DMKV, (unsigned)__builtin_amdgcn_readfirstlane(vdst + (slot)))
    const int vb0 = (int)(lds0 + LDS_V) + ((lane >> 4) & 1) * 32 + (lane & 3) * 8 + (4 * hi + ((lane & 15) >> 2)) * 64;
    const char* Kbase = shm + LDS_K; bf16x8 kf[8];
    const lds_cptr shm3 = (lds_cptr)shm; const lds_cptr kp0 = shm3 + LDS_K + hi * 1024 + r32 * 16; const lds_cptr vp0 = shm3 + LDS_V + ((lane >> 4) & 1) * 32 + (lane & 3) * 8 + (4 * hi + ((lane & 15) >> 2)) * 64;
    DMA_K(0, 0); DMA_V(0, 0); DMA_K(1, SLOTB);
    bf16x8 qr[4];
#pragma unroll
    for (int d0 = 0; d0 < 4; ++d0) qr[d0] = *reinterpret_cast<const bf16x8*>(&Qw[(long)r32 * DMQ + d0 * 16 + hi * 8]);
    float l_reg = 0.f; f32x16 o[2]; o[0] = f32x16{}; o[1] = f32x16{}; f32x16 negm;
    _Pragma("unroll") for (int r = 0; r < 16; ++r) negm[r] = negM_;
    asm volatile("" : "+v"(negm));
#define START(P0, P1) do { _Pragma("unroll") for (int r = 0; r < 16; ++r) P0[r] = __builtin_amdgcn_exp2f(P0[r]); } while (0)
#define RESC() do { } while (0)
    f32x16 pA0, pA1, pB0, pB1;
    int sl_prev = 0, sl_cur = 0, sl_next = SLOTB;
#define ROT() do { sl_prev = sl_cur; sl_cur = sl_next; sl_next = (sl_next == (NSLOTR - 1) * SLOTB) ? 0 : sl_next + SLOTB; } while (0)
    DMA_K(2, 2 * SLOTB);
    WAIT_BAR(3);
    qkt(pA0, pA1, Kbase, qr, negm, r32, hi); asm volatile("s_nop 15\n\ts_nop 7" : "+v"(pA0), "+v"(pA1));
    START(pA0, pA1);
    _Pragma("unroll") for (int r = 0; r < 16; ++r) pA1[r] = __builtin_amdgcn_exp2f(pA1[r]);
    WAIT_BAR(0);
    DMA_K(3, 0); DMA_V(1, SLOTB);
    ROT();
    kload8(kf, kp0 + sl_cur);
    WAIT_BAR(2);
    s16x4 vlo[8], vhi[8]; u32x4 pw0, pw1, pw2, pw3;
#define PKW(P, B) cvtpk_s(P[B], P[B + 1])
#define PAF(k) __builtin_bit_cast(bf16x8, pw##k)
#define VFR(i) (bf16x8){vlo[i][0], vlo[i][1], vlo[i][2], vlo[i][3], vhi[i][0], vhi[i][1], vhi[i][2], vhi[i][3]}
#define PIN(x) asm volatile("" : "+v"(x))
#define MX3(a, b, c) __builtin_fmaxf(__builtin_fmaxf((a), (b)), (c))
#define GAPA(MF, A0, A1, A2, A3, W0, W1, PW) do { MF; sacc += A0; sacc += A1; sacc += A2; sacc += A3; PIN(sacc); W0; W1; PIN(PW); SBAR(); } while (0)
#define EX(v) __builtin_amdgcn_exp2f(v)
#define GAPB(MF, X, B) do { MF; X[B] = EX(X[B]); X[B + 1] = EX(X[B + 1]); X[B + 2] = EX(X[B + 2]); X[B + 3] = EX(X[B + 3]); PIN(X); SBAR(); } while (0)
#define VRD(i) do { vlo[i] = vtr(vp_ + (((i) >> 2) * 4096 + ((i) & 3) * 1024)); vhi[i] = vtr(vp_ + (((i) >> 2) * 4096 + ((i) & 3) * 1024 + 512)); } while (0)
#define KRD(G, j) do { if (G) { kload2(kf, kp0 + sl_next, j); SBAR(); } } while (0)
#define STEP(C0, C1, P0, P1, t, GK, GV, GL) do { SBAR(); \
    const lds_cptr vp_ = vp0 + sl_prev; \
    VRD(0); SBAR(); float sacc = (P0[0] + P0[1]); \
    GAPA(C0 = __builtin_amdgcn_mfma_f32_32x32x16_bf16(kf[0], qr[0], negm, 0, 0, 0), P0[2], P0[3], P0[4], P0[5],     pw0[0] = PKW(P0, 0), pw0[1] = PKW(P0, 2), pw0); \
    VRD(4); SBAR(); GAPA(C1 = __builtin_amdgcn_mfma_f32_32x32x16_bf16(kf[1], qr[0], negm, 0, 0, 0), P0[6], P0[7], P0[8], P0[9],     pw0[2] = PKW(P0, 4), pw0[3] = PKW(P0, 6), pw0); \
    VRD(1); SBAR(); GAPA(C0 = __builtin_amdgcn_mfma_f32_32x32x16_bf16(kf[2], qr[1], C0, 0, 0, 0),   P0[10], P0[11], P0[12], P0[13], pw1[0] = PKW(P0, 8), pw1[1] = PKW(P0, 10), pw1); \
    VRD(5); SBAR(); GAPA(C1 = __builtin_amdgcn_mfma_f32_32x32x16_bf16(kf[3], qr[1], C1, 0, 0, 0),   P0[14], P0[15], P1[0], P1[1],   pw1[2] = PKW(P0, 12), pw1[3] = PKW(P0, 14), pw1); \
    VRD(2); SBAR(); GAPA(C0 = __builtin_amdgcn_mfma_f32_32x32x16_bf16(kf[4], qr[2], C0, 0, 0, 0),   P1[2], P1[3], P1[4], P1[5],     pw2[0] = PKW(P1, 0), pw2[1] = PKW(P1, 2), pw2); \
    VRD(6); SBAR(); GAPA(C1 = __builtin_amdgcn_mfma_f32_32x32x16_bf16(kf[5], qr[2], C1, 0, 0, 0),   P1[6], P1[7], P1[8], P1[9],     pw2[2] = PKW(P1, 4), pw2[3] = PKW(P1, 6), pw2); \
    VRD(3); SBAR(); GAPA(C0 = __builtin_amdgcn_mfma_f32_32x32x16_bf16(kf[6], qr[3], C0, 0, 0, 0),   P1[10], P1[11], P1[12], P1[13], pw3[0] = PKW(P1, 8), pw3[1] = PKW(P1, 10), pw3); \
    VRD(7); SBAR(); GAPA(C1 = __builtin_amdgcn_mfma_f32_32x32x16_bf16(kf[7], qr[3], C1, 0, 0, 0),   P1[14], P1[15], 0.f, 0.f,       pw3[2] = PKW(P1, 12), pw3[3] = PKW(P1, 14), pw3); \
    l_reg += sacc; \
    if (GK) { DMA_K((t) + 3, sl_cur); } if (GV) { DMA_V((t) + 1, sl_next); } \
    SBAR(); \
    GAPB(o[0] = __builtin_amdgcn_mfma_f32_32x32x16_bf16(PAF(0), VFR(0), o[0], 0, 0, 0), C0, 0); \
    GAPB(o[1] = __builtin_amdgcn_mfma_f32_32x32x16_bf16(PAF(0), VFR(4), o[1], 0, 0, 0), C0, 4); \
    KRD(GL, 0); GAPB(o[0] = __builtin_amdgcn_mfma_f32_32x32x16_bf16(PAF(1), VFR(1), o[0], 0, 0, 0), C0, 8); \
    KRD(GL, 1); GAPB(o[1] = __builtin_amdgcn_mfma_f32_32x32x16_bf16(PAF(1), VFR(5), o[1], 0, 0, 0), C0, 12); \
    KRD(GL, 2); GAPB(o[0] = __builtin_amdgcn_mfma_f32_32x32x16_bf16(PAF(2), VFR(2), o[0], 0, 0, 0), C1, 0); \
    KRD(GL, 3); GAPB(o[1] = __builtin_amdgcn_mfma_f32_32x32x16_bf16(PAF(2), VFR(6), o[1], 0, 0, 0), C1, 4); \
    GAPB(o[0] = __builtin_amdgcn_mfma_f32_32x32x16_bf16(PAF(3), VFR(3), o[0], 0, 0, 0), C1, 8); \
    GAPB(o[1] = __builtin_amdgcn_mfma_f32_32x32x16_bf16(PAF(3), VFR(7), o[1], 0, 0, 0), C1, 12); \
    } while (0)
    int t = 1;
    for (; t + 5 < NT; t += 2) {
        STEP(pB0, pB1, pA0, pA1, t, true, true, true);     WAIT_BAR(2); RESC(); ROT();
        STEP(pA0, pA1, pB0, pB1, t + 1, true, true, true); WAIT_BAR(2); RESC(); ROT();
    }
#define ENDW(tt) do { if ((tt) + 3 < NT) { WAIT_BAR(2); } else if ((tt) + 2 < NT) { WAIT_BAR(1); } else { WAIT_BAR(0); } } while (0)
    for (; t + 1 < NT; t += 2) {
        STEP(pB0, pB1, pA0, pA1, t, (t + 3 < NT), (t + 1 < NT), (t + 1 < NT));         ENDW(t);     RESC(); ROT();
        STEP(pA0, pA1, pB0, pB1, t + 1, (t + 4 < NT), (t + 2 < NT), (t + 2 < NT));     ENDW(t + 1); RESC(); ROT();
    }
    STEP(pB0, pB1, pA0, pA1, NT - 1, false, false, false); RESC();
    { float sacc = pB0[0] + pB0[1]; _Pragma("unroll") for (int r = 2; r < 16; ++r) sacc += pB0[r]; _Pragma("unroll") for (int r = 0; r < 16; ++r) sacc += pB1[r]; l_reg += sacc;
      pw0 = (u32x4){PKW(pB0, 0), PKW(pB0, 2), PKW(pB0, 4), PKW(pB0, 6)}; pw1 = (u32x4){PKW(pB0, 8), PKW(pB0, 10), PKW(pB0, 12), PKW(pB0, 14)}; pw2 = (u32x4){PKW(pB1, 0), PKW(pB1, 2), PKW(pB1, 4), PKW(pB1, 6)}; pw3 = (u32x4){PKW(pB1, 8), PKW(pB1, 10), PKW(pB1, 12), PKW(pB1, 14)};
      SBAR(); pv(o, vb0 + sl_cur, PAF(0), PAF(1), PAF(2), PAF(3)); }
#undef PKW
#undef PAF
#undef VFR
#undef PIN
#undef MX3
#undef GAPA
#undef GAPB
#undef EX
#undef VRD
#undef KRD
#undef STEP
#undef ENDW
    { auto rr = __builtin_amdgcn_permlane32_swap(__float_as_uint(l_reg), __float_as_uint(l_reg), false, false); l_reg = __uint_as_float(rr[0]) + __uint_as_float(rr[1]); }
    if (hi == 0) wsf[32 + r32] = l_reg; asm volatile("s_waitcnt lgkmcnt(0)" ::: "memory");
    float rli[16];
#pragma unroll
    for (int r = 0; r < 16; ++r) rli[r] = __builtin_amdgcn_rcpf(wsf[32 + crow(r, hi)]);
    bf16* Ow = O + qrow0 * DMO + h * D;
    { bf16* stg = (bf16*)(shm + LDS_OST) + wid * 2048;
#pragma unroll
      for (int r = 0; r < 16; ++r) { const int orow = crow(r, hi);
#pragma unroll
        for (int d0 = 0; d0 < 2; ++d0) stg[orow * 64 + d0 * 32 + r32] = __float2bfloat16(o[d0][r] * rli[r]); }
      asm volatile("s_waitcnt lgkmcnt(0)" ::: "memory");
#pragma unroll
      for (int i = 0; i < 4; ++i) { const int row = i * 8 + (lane >> 3), ch = lane & 7; const u32x4 v = *(const u32x4*)(stg + row * 64 + ch * 8); *(u32x4*)(Ow + (long)row * DMO + ch * 8) = v; } }
    asm volatile("s_waitcnt lgkmcnt(0)\n\ts_barrier" ::: "memory");
#undef DMA_K
#undef DMA_V
#undef START
#undef RESC
#undef ROT
}
#undef SBAR
#undef WAIT_BAR
}

#define XB_TMO      128
#define XB_XCNT(j)  (256  + 64 * (j))
#define XB_XSUB(j)  (1280 + 64 * (j))
#define XB_XGEN(j)  (2304 + 64 * (j))
#define XB_TOP      3328
#define XB_TOPGEN   3392
#define XCD_BAR_WORDS 3456
#define XB_SPIN_CAP (1u << 18)
__device__ __forceinline__ unsigned xb_ld(unsigned* p)              { return __hip_atomic_load(p, __ATOMIC_RELAXED, __HIP_MEMORY_SCOPE_AGENT); }
__device__ __forceinline__ unsigned xb_add(unsigned* p, unsigned v) { return __hip_atomic_fetch_add(p, v, __ATOMIC_RELAXED, __HIP_MEMORY_SCOPE_AGENT); }
__device__ __forceinline__ unsigned xb_xcc_id() { return (unsigned)__builtin_amdgcn_s_getreg((3 << 11) | 20) & 0xFu; }
#define XB_SPIN(cond, bar) do { unsigned _sp = 0; while (cond) { __builtin_amdgcn_s_sleep(1); \
    if ((++_sp & 255u) == 0u) { if (xb_ld(&(bar)[XB_TMO])) break; if (_sp > XB_SPIN_CAP) { atomicAdd(&(bar)[XB_TMO], 1u); break; } } } } while (0)
struct XcdBarrier { unsigned* bar; unsigned x; volatile LAS unsigned* st; };
__device__ __forceinline__ XcdBarrier xcd_barrier_post(unsigned* bar, volatile LAS unsigned* st) {
    XcdBarrier b; b.bar = bar; b.x = xb_xcc_id(); b.st = st;
    if (threadIdx.x == 0) (void)xb_add(&bar[XB_XCNT(b.x)], 1u);
    return b;
}
__device__ __forceinline__ void xcd_barrier_complete(unsigned* bar, unsigned x, unsigned& nloc, unsigned& nx) {
    const unsigned G = gridDim.x * gridDim.y * gridDim.z;
    unsigned sum, cnt, mine, sp = 0u;
    for (;;) {
        sum = 0u; cnt = 0u; mine = 0u;
#pragma unroll
        for (unsigned j = 0; j < 16; ++j) { const unsigned c = xb_ld(&bar[XB_XCNT(j)]); sum += c; cnt += (c > 0u) ? 1u : 0u; mine = (j == x) ? c : mine; }
        if (sum == G) break;
        __builtin_amdgcn_s_sleep(1);
        if ((++sp & 255u) == 0u) { if (xb_ld(&bar[XB_TMO])) break; if (sp > XB_SPIN_CAP) { atomicAdd(&bar[XB_TMO], 1u); break; } }
    }
    nloc = mine > 0u ? mine : 1u; nx = cnt > 0u ? cnt : 1u;
}
__device__ __forceinline__ void xcd_barrier(const XcdBarrier& b) {
    asm volatile("s_waitcnt vmcnt(0)" ::: "memory");
    __syncthreads();
    if (threadIdx.x == 0) {
        unsigned* bar = b.bar;
        __builtin_amdgcn_s_waitcnt(0);
        unsigned nloc = b.st[0], nx = b.st[1];
        if (nloc == 0u) { xcd_barrier_complete(bar, b.x, nloc, nx); b.st[0] = nloc; b.st[1] = nx; }
        const unsigned old = xb_add(&bar[XB_XSUB(b.x)], 1u);
        const unsigned gen = old / nloc;
        if (old + 1u == (gen + 1u) * nloc) {
            __builtin_amdgcn_fence(__ATOMIC_RELEASE, "agent");
            asm volatile("s_waitcnt vmcnt(0)" ::: "memory");
            const unsigned og = xb_add(&bar[XB_TOP], 1u);
            const unsigned tg = og / nx;
            if (og + 1u == (tg + 1u) * nx) xb_add(&bar[XB_TOPGEN], 1u);
            else XB_SPIN(xb_ld(&bar[XB_TOPGEN]) == tg, bar);
            __builtin_amdgcn_fence(__ATOMIC_ACQUIRE, "agent");
            xb_add(&bar[XB_XGEN(b.x)], 1u);
            asm volatile("s_waitcnt vmcnt(0)" ::: "memory");
        } else {
            XB_SPIN(xb_ld(&bar[XB_XGEN(b.x)]) == gen, bar);
            __builtin_amdgcn_fence(__ATOMIC_ACQUIRE, "agent");
            asm volatile("s_waitcnt vmcnt(0)" ::: "memory");
        }
    }
    __syncthreads();
}

struct Frame {
    LAS unsigned char* lds;
    volatile LAS unsigned* MISC;
    gu32* ctl;
    int tid, lane, wave;
    int vcu, G;
    const float* const* ka;
    float* out;
    unsigned char* ws;
};
#define WSP(T, off) ((T*)(F.ws + (off)))
#define FIN_x (F.ka[0])
#define FIN_c (F.ka[1])
#define FIN_ctx (F.ka[2])
#define FIN_c_ctx (F.ka[3])
#define FIN_norm1_g (F.ka[4])
#define FIN_w_ada (F.ka[5])
#define FIN_b_ada (F.ka[6])
#define FIN_w_in (F.ka[7])
#define FIN_w_fourier (F.ka[8])
#define FIN_q_norm_g (F.ka[9])
#define FIN_k_norm_g (F.ka[10])
#define FIN_w_out (F.ka[11])
#define FIN_norm2_g (F.ka[12])
#define FIN_w_router (F.ka[13])
#define FIN_router_bias (F.ka[14])
#define FIN_w_egu (F.ka[15])
#define FIN_w_ed (F.ka[16])
#define FIN_w_sgu (F.ka[17])
#define FIN_w_sd (F.ka[18])
#define FIN_final_g (F.ka[19])

struct DenseOrder {
    static constexpr bool GATHER = false;
    int nN, nmain, nextra, G, c; const char* Bt; int K; int reps;
    __device__ __forceinline__ bool next(int i, pg8::GUnit& u) const {
        const int ntot = nmain + nextra, nc = (ntot - c + G - 1) / G; if (i >= nc * reps) return false;
        const int L = (i % nc) * G + c;
        if (L < nmain) { const int nig = 8 * nN, gid = L / nig, r = L % nig; u.pm = gid * 8 + (r & 7); u.pn = r >> 3; }
        else { const int jx = L - nmain; u.pm = 128 + (jx & 3); u.pn = 5 + (jx >> 2); }
        u.e = 0; u.j = 0; u.nvalid = 256; u.B = Bt + (size_t)u.pn * 256 * K * 2; return true;
    }
    __device__ __forceinline__ int arow(const pg8::GUnit& u, int r) const { return u.pm * 256 + r; }
};
template <bool GATHER_> struct GroupedOrder {
    static constexpr bool GATHER = GATHER_;
    int NPN, G, c, nbrows, K; bool gather; const char* Bt; const LAS int* TS; const LAS int* CN; const GAS u32x2* LIST; int reps; int total;
    __device__ __forceinline__ bool next(int i, pg8::GUnit& u) const {
        const int ntot = total * NPN, nc = (ntot - c + G - 1) / G; if (i >= nc * reps) return false;
        const int L = (i % nc) * G + c; const int T = L / NPN;
        int lo = 0, hi = 257;
        while (hi - lo > 1) { const int mid = (lo + hi) >> 1; if (TS[mid] <= T) lo = mid; else hi = mid; }
        lo = __builtin_amdgcn_readfirstlane(lo);
        const int ts = __builtin_amdgcn_readfirstlane(TS[lo]), cn = __builtin_amdgcn_readfirstlane(CN[lo]);
        u.pm = T; u.pn = L - T * NPN; u.e = lo; u.j = T - ts; const int rem = cn - 256 * u.j; u.nvalid = rem < 256 ? rem : 256;
        u.B = Bt + ((size_t)lo * nbrows + (size_t)u.pn * 256) * K; return true;
    }
    __device__ __forceinline__ int arow(const pg8::GUnit& u, int r) const {
        if (!gather) return u.pm * 256 + r;
        int pos = 256 * u.j + r; if (r >= u.nvalid) pos = 0;
        const u32x2 en = LIST[(size_t)u.e * NTOK + pos];
        return (int)(en.x & 0xffffu);
    }
};

struct EpiInProj {
    static constexpr bool PERM = true; static constexpr int NSTORE = 16;
    __device__ __forceinline__ void pre(LAS unsigned char*, const pg8::GUnit&, int, int, int) const {}
    u16 *Z, *Q, *Kb, *Vb; const float *COS, *SIN, *gq, *gk;
    __device__ __forceinline__ void operator()(const f32x4 (&acc)[2][2][4][2], const pg8::GUnit& u, int wr, int wc, int fr, int fq, LAS unsigned char* lds, int ui) const {
        const int pn = u.pn; const bool is_ctx = u.pm >= 128;
        float gn[2][2][4];
        if (pn >= 2 && pn < 6) { const float* gsrc = (pn == 5) ? gk : gq;
#pragma unroll
            for (int bj = 0; bj < 2; ++bj)
#pragma unroll
                for (int n = 0; n < 2; ++n) { const f32x4 g4 = *(const f32x4*)(gsrc + 32 * bj + 16 * n + 4 * fq); gn[bj][n][0] = g4[0]; gn[bj][n][1] = g4[1]; gn[bj][n][2] = g4[2]; gn[bj][n][3] = g4[3]; } }
#pragma unroll
        for (int ai = 0; ai < 2; ++ai)
#pragma unroll
            for (int m = 0; m < 4; ++m) {
                const int row = u.pm * 256 + ai * 128 + wr * 64 + m * 16 + fr;
                int b, l, key;
                if (!is_ctx) { b = row >> 13; l = row & 8191; key = l; } else { const int rc = row - NTOK; b = rc >> 8; l = 0; key = SEQ + (rc & 255); }
                if (pn < 2) {
#pragma unroll
                    for (int bj = 0; bj < 2; ++bj) { const int g = 32 * pn + 16 * bj + 4 * wc + fq; const f32x4 v0 = acc[ai][bj][m][0], v1 = acc[ai][bj][m][1];
                        u32x4 w; w.x = cvt_pk_bf16(v0[0], v0[1]); w.y = cvt_pk_bf16(v0[2], v0[3]); w.z = cvt_pk_bf16(v1[0], v1[1]); w.w = cvt_pk_bf16(v1[2], v1[3]);
                        *(u32x4*)(Z + (((size_t)(b * 64 + g) * SEQ + l) * 8)) = w; }
                } else if (pn < 6) {
                    float ss = 0.f;
#pragma unroll
                    for (int bj = 0; bj < 2; ++bj)
#pragma unroll
                        for (int n = 0; n < 2; ++n) { const f32x4 v = acc[ai][bj][m][n]; ss += (v[0] * v[0] + v[1] * v[1]) + (v[2] * v[2] + v[3] * v[3]); }
                    ss += __shfl_xor(ss, 16); ss += __shfl_xor(ss, 32);
                    const float rstd = 1.0f / sqrtf(ss * (1.0f / 64.0f) + RMS_EPS);
                    const float osc = (pn == 5) ? 1.0f : C2;
#pragma unroll
                    for (int bj = 0; bj < 2; ++bj) {
                        const int pidx = (bj == 0) ? (l >> 6) : (l & 63);
                        f32x4 cs = *(const f32x4*)(COS + pidx * 16 + 4 * fq), sn = *(const f32x4*)(SIN + pidx * 16 + 4 * fq);
                        if (is_ctx) { cs = (f32x4){1.f, 1.f, 1.f, 1.f}; sn = (f32x4){0.f, 0.f, 0.f, 0.f}; }
                        float oa[4], ob[4];
#pragma unroll
                        for (int e = 0; e < 4; ++e) { const float a = acc[ai][bj][m][0][e] * rstd * gn[bj][0][e], bb = acc[ai][bj][m][1][e] * rstd * gn[bj][1][e];
                            oa[e] = (a * cs[e] - bb * sn[e]) * osc; ob[e] = (bb * cs[e] + a * sn[e]) * osc; }
                        u32x4 w; w.x = cvt_pk_bf16(oa[0], oa[1]); w.y = cvt_pk_bf16(oa[2], oa[3]); w.z = cvt_pk_bf16(ob[0], ob[1]); w.w = cvt_pk_bf16(ob[2], ob[3]);
                        if (pn < 5) { const int head = 4 * (pn - 2) + wc; *(u32x4*)(Q + ((size_t)row * QW + head * 64 + 32 * bj + 8 * fq)) = w; }
                        else *(u32x4*)(Kb + (((size_t)b * LKV + key) * KVW + wc * 64 + 32 * bj + 8 * fq)) = w;
                    }
                } else {
#pragma unroll
                    for (int bj = 0; bj < 2; ++bj) { const f32x4 v0 = acc[ai][bj][m][0], v1 = acc[ai][bj][m][1];
                        u32x4 w; w.x = cvt_pk_bf16(v0[0], v0[1]); w.y = cvt_pk_bf16(v0[2], v0[3]); w.z = cvt_pk_bf16(v1[0], v1[1]); w.w = cvt_pk_bf16(v1[2], v1[3]);
                        *(u32x4*)(Vb + (((size_t)b * LKV + key) * KVW + 128 * bj + 32 * wc + 8 * fq)) = w; }
                }
            }
    }
};
struct EpiResid {
    static constexpr bool PERM = false; static constexpr int NSTORE = 32;
    __device__ __forceinline__ void pre(LAS unsigned char*, const pg8::GUnit&, int, int, int) const {}
    const float* x; float* X1; const gi64* MOD;
    __device__ __forceinline__ void operator()(const f32x4 (&acc)[2][2][4][2], const pg8::GUnit& u, int wr, int wc, int fr, int fq, LAS unsigned char* lds, int ui) const {
        const int row0 = u.pm * 256 + wr * 64 + fr, col0 = u.pn * 256 + wc * 32 + 4 * fq; const int b = (u.pm * 256) >> 13;
        f32x4 gv[2][2];
#pragma unroll
        for (int bj = 0; bj < 2; ++bj)
#pragma unroll
            for (int n = 0; n < 2; ++n) gv[bj][n] = mod4(MOD, b * 6144 + 2048 + col0 + bj * 128 + n * 16);
#pragma unroll
        for (int ai = 0; ai < 2; ++ai)
#pragma unroll
            for (int m = 0; m < 4; ++m) { const size_t off = (size_t)(row0 + ai * 128 + m * 16) * DM + col0;
#pragma unroll
                for (int bj = 0; bj < 2; ++bj)
#pragma unroll
                    for (int n = 0; n < 2; ++n) { const f32x4 xv = *(const f32x4*)(x + off + bj * 128 + n * 16); *(f32x4*)(X1 + off + bj * 128 + n * 16) = (DBG & 2) ? xv : xv + gv[bj][n] * acc[ai][bj][m][n]; } }
    }
};
struct EpiLogits {
    static constexpr bool PERM = false; static constexpr int NSTORE = 32;
    __device__ __forceinline__ void pre(LAS unsigned char*, const pg8::GUnit&, int, int, int) const {}
    float* C;
    __device__ __forceinline__ void operator()(const f32x4 (&acc)[2][2][4][2], const pg8::GUnit& u, int wr, int wc, int fr, int fq, LAS unsigned char* lds, int ui) const {
        const int row0 = u.pm * 256 + wr * 64 + fr, col0 = wc * 32 + 4 * fq;
#pragma unroll
        for (int ai = 0; ai < 2; ++ai)
#pragma unroll
            for (int m = 0; m < 4; ++m) { float* rowp = C + (size_t)(row0 + ai * 128 + m * 16) * NEXP + col0;
#pragma unroll
                for (int bj = 0; bj < 2; ++bj)
#pragma unroll
                    for (int n = 0; n < 2; ++n) *(f32x4*)(rowp + bj * 128 + n * 16) = acc[ai][bj][m][n]; }
    }
};
struct EpiSwiglu {
    static constexpr bool PERM = true; static constexpr int NSTORE = 16;
    __device__ __forceinline__ void pre(LAS unsigned char*, const pg8::GUnit&, int, int, int) const {}
    u16* ACT;
    __device__ __forceinline__ void operator()(const f32x4 (&acc)[2][2][4][2], const pg8::GUnit& u, int wr, int wc, int fr, int fq, LAS unsigned char* lds, int ui) const {
#pragma unroll
        for (int ai = 0; ai < 2; ++ai)
#pragma unroll
            for (int m = 0; m < 4; ++m) { const int r = ai * 128 + wr * 64 + m * 16 + fr; u16* rowp = ACT + ((size_t)u.pm * 256 + r) * EFF + 128 * u.pn + 16 * wc + 4 * fq;
#pragma unroll
                for (int bj = 0; bj < 2; ++bj) { const f32x4 a = acc[ai][bj][m][0], g = acc[ai][bj][m][1]; float o[4];
#pragma unroll
                    for (int e = 0; e < 4; ++e) o[e] = a[e] * g[e] / (1.0f + __expf(-a[e]));
                    if (MOE_FP8) { int w0 = __builtin_amdgcn_cvt_pk_fp8_f32(o[0], o[1], 0, false); w0 = __builtin_amdgcn_cvt_pk_fp8_f32(o[2], o[3], w0, true);
                        *(unsigned*)((unsigned char*)ACT + ((size_t)u.pm * 256 + r) * EFF + 128 * u.pn + 16 * wc + 4 * fq + 64 * bj) = (unsigned)w0; }
                    else { u32x2 w; if (MOEF16) { w.x = pk2h(o[0], o[1]); w.y = pk2h(o[2], o[3]); } else { w.x = pk2bf(o[0], o[1]); w.y = pk2bf(o[2], o[3]); } *(u32x2*)(rowp + 64 * bj) = w; } } }
    }
};
struct EpiDown {
    static constexpr bool PERM = true; static constexpr int NSTORE = 16;
    u16* Cc; const GAS u32x2* LIST; unsigned char* dump;
    __device__ __forceinline__ void pre(LAS unsigned char* lds, const pg8::GUnit& u, int ui, int wid, int lane) const {
        if (wid < 2) __builtin_amdgcn_global_load_lds((const unsigned*)(LIST + (size_t)u.e * NTOK + 256 * u.j + 128 * wid + 2 * lane), (LAS unsigned*)(lds + pg8::STAGE_BYTES + (ui & 1) * 2048 + wid * 1024), 16, 0, 0);
    }
    __device__ __forceinline__ void operator()(const f32x4 (&acc)[2][2][4][2], const pg8::GUnit& u, int wr, int wc, int fr, int fq, LAS unsigned char* lds, int ui) const {
        const LAS f32x2* ent = (const LAS f32x2*)(lds + pg8::STAGE_BYTES + (ui & 1) * 2048);
#pragma unroll
        for (int ai = 0; ai < 2; ++ai)
#pragma unroll
            for (int m = 0; m < 4; ++m) { const int r = ai * 128 + wr * 64 + m * 16 + fr;
                const f32x2 enf = ent[r];
                const unsigned ex = __builtin_bit_cast(unsigned, enf.x); const int tok = (int)(ex & 0x7fffu), slot = (int)((ex >> 16) & 15u); const float gate = enf.y;
                unsigned char* rowp = (unsigned char*)Cc + ((size_t)tok * NSLOT + slot) * DM + 256 * u.pn + 32 * wc + 8 * fq;
                if (r >= u.nvalid) rowp = dump + ((size_t)(blockIdx.x * 512 + threadIdx.x)) * 256;
                const float gs = gate * C_SCALE;
#pragma unroll
                for (int bj = 0; bj < 2; ++bj) { f32x4 v0 = acc[ai][bj][m][0] * gs, v1 = acc[ai][bj][m][1] * gs;
#pragma unroll
                    for (int e = 0; e < 4; ++e) { v0[e] = __builtin_amdgcn_fmed3f(v0[e], -440.f, 440.f); v1[e] = __builtin_amdgcn_fmed3f(v1[e], -440.f, 440.f); }
                    int w0 = __builtin_amdgcn_cvt_pk_fp8_f32(v0[0], v0[1], 0, false); w0 = __builtin_amdgcn_cvt_pk_fp8_f32(v0[2], v0[3], w0, true);
                    int w1 = __builtin_amdgcn_cvt_pk_fp8_f32(v1[0], v1[1], 0, false); w1 = __builtin_amdgcn_cvt_pk_fp8_f32(v1[2], v1[3], w1, true);
                    *(u32x2*)(rowp + 128 * bj) = (u32x2){(unsigned)w0, (unsigned)w1}; } }
    }
};

template <bool F16OUT, bool F8OUT2 = false> __device__ __forceinline__ void rownorm_rows(const GAS float* src, const float* gain, const gi64* MODsh, const gi64* MODsc, u16* dst, int row0, int nrows, int wi, int wstride, int lane, unsigned char* dst8 = nullptr) {
    f32x4 Av[2][2], Bv[2][2];
#pragma unroll
    for (int j = 0; j < 2; ++j)
#pragma unroll
        for (int h = 0; h < 2; ++h) { const int col = 8 * lane + 512 * j + 4 * h; Av[j][h] = *(const f32x4*)(gain + col) * (mod4(MODsc, col) + 1.0f); Bv[j][h] = mod4(MODsh, col); }
    for (int r = wi; r < nrows; r += 2 * wstride) {
        const int r1 = r + wstride; const bool has1 = r1 < nrows;
        const GAS float* s0 = src + (size_t)(row0 + r) * DM; const GAS float* s1 = src + (size_t)(row0 + (has1 ? r1 : r)) * DM;
        f32x4 v0[2][2], v1[2][2];
#pragma unroll
        for (int j = 0; j < 2; ++j)
#pragma unroll
            for (int h = 0; h < 2; ++h) { v0[j][h] = *(const GAS f32x4*)(s0 + 8 * lane + 512 * j + 4 * h); v1[j][h] = *(const GAS f32x4*)(s1 + 8 * lane + 512 * j + 4 * h); }
        float q0 = 0.f, q1 = 0.f;
#pragma unroll
        for (int j = 0; j < 2; ++j)
#pragma unroll
            for (int h = 0; h < 2; ++h) { const f32x4 a = v0[j][h], b = v1[j][h]; q0 += (a[0] * a[0] + a[1] * a[1]) + (a[2] * a[2] + a[3] * a[3]); q1 += (b[0] * b[0] + b[1] * b[1]) + (b[2] * b[2] + b[3] * b[3]); }
#pragma unroll
        for (int o = 1; o < 64; o <<= 1) { q0 += __shfl_xor(q0, o); q1 += __shfl_xor(q1, o); }
        const float rs0 = 1.0f / sqrtf(q0 * (1.0f / DM) + RMS_EPS), rs1 = 1.0f / sqrtf(q1 * (1.0f / DM) + RMS_EPS);
#pragma unroll
        for (int j = 0; j < 2; ++j) { const f32x4 ya = v0[j][0] * rs0 * Av[j][0] + Bv[j][0], yb = v0[j][1] * rs0 * Av[j][1] + Bv[j][1];
            u32x4 w; if (F16OUT) { w.x = pk2h(ya[0], ya[1]); w.y = pk2h(ya[2], ya[3]); w.z = pk2h(yb[0], yb[1]); w.w = pk2h(yb[2], yb[3]); } else { w.x = pk2bf(ya[0], ya[1]); w.y = pk2bf(ya[2], ya[3]); w.z = pk2bf(yb[0], yb[1]); w.w = pk2bf(yb[2], yb[3]); }
            *(GAS u32x4*)(dst + (size_t)(row0 + r) * DM + 8 * lane + 512 * j) = w;
            if (F8OUT2) { int w0 = __builtin_amdgcn_cvt_pk_fp8_f32(ya[0], ya[1], 0, false); w0 = __builtin_amdgcn_cvt_pk_fp8_f32(ya[2], ya[3], w0, true); int w1 = __builtin_amdgcn_cvt_pk_fp8_f32(yb[0], yb[1], 0, false); w1 = __builtin_amdgcn_cvt_pk_fp8_f32(yb[2], yb[3], w1, true);
                *(GAS u32x2*)(dst8 + (size_t)(row0 + r) * DM + 8 * lane + 512 * j) = (u32x2){(unsigned)w0, (unsigned)w1}; } }
        if (has1) {
#pragma unroll
            for (int j = 0; j < 2; ++j) { const f32x4 ya = v1[j][0] * rs1 * Av[j][0] + Bv[j][0], yb = v1[j][1] * rs1 * Av[j][1] + Bv[j][1];
                u32x4 w; if (F16OUT) { w.x = pk2h(ya[0], ya[1]); w.y = pk2h(ya[2], ya[3]); w.z = pk2h(yb[0], yb[1]); w.w = pk2h(yb[2], yb[3]); } else { w.x = pk2bf(ya[0], ya[1]); w.y = pk2bf(ya[2], ya[3]); w.z = pk2bf(yb[0], yb[1]); w.w = pk2bf(yb[2], yb[3]); }
                *(GAS u32x4*)(dst + (size_t)(row0 + r1) * DM + 8 * lane + 512 * j) = w;
                if (F8OUT2) { int w0 = __builtin_amdgcn_cvt_pk_fp8_f32(ya[0], ya[1], 0, false); w0 = __builtin_amdgcn_cvt_pk_fp8_f32(ya[2], ya[3], w0, true); int w1 = __builtin_amdgcn_cvt_pk_fp8_f32(yb[0], yb[1], 0, false); w1 = __builtin_amdgcn_cvt_pk_fp8_f32(yb[2], yb[3], w1, true);
                    *(GAS u32x2*)(dst8 + (size_t)(row0 + r1) * DM + 8 * lane + 512 * j) = (u32x2){(unsigned)w0, (unsigned)w1}; } } }
    }
}

__device__ __forceinline__ void p0_phase(Frame& F) {
    const int gw = F.vcu * 8 + F.wave, NGW = F.G * 8, lane = F.lane;
    unsigned long long* MODQ = (unsigned long long*)(F.ctl + CW_MOD);
    for (int it = gw; it < 1536; it += NGW) {
        const int cb = it % 24, kc = it / 24, k0 = kc * 16, col = cb * 256 + lane * 4;
        float sv[5];
#pragma unroll
        for (int r = 0; r < 5; ++r) { const float cv = (r < 4) ? FIN_c[r * DM + k0 + (lane & 15)] : FIN_c_ctx[k0 + (lane & 15)]; sv[r] = cv / (1.0f + __expf(-cv)); }
        f32x4 acc[5];
#pragma unroll
        for (int r = 0; r < 5; ++r) acc[r] = (f32x4){0.f, 0.f, 0.f, 0.f};
#pragma unroll
        for (int kk = 0; kk < 16; ++kk) { const f32x4 w = *(const f32x4*)(FIN_w_ada + (size_t)(k0 + kk) * 6144 + col);
#pragma unroll
            for (int r = 0; r < 5; ++r) { const float s = __builtin_bit_cast(float, __builtin_amdgcn_readlane(__builtin_bit_cast(int, sv[r]), kk)); acc[r] += w * s; } }
        if (kc == 0) { const f32x4 bv = *(const f32x4*)(FIN_b_ada + col);
#pragma unroll
            for (int r = 0; r < 5; ++r) acc[r] += bv; }
#pragma unroll
        for (int r = 0; r < 5; ++r)
#pragma unroll
            for (int j = 0; j < 4; ++j) atomicAdd(MODQ + r * 6144 + col + j, (unsigned long long)__float2ll_rn(acc[r][j] * 0x1p36f));
    }
    float* WCS = WSP(float, WS_TAB);
    for (int it = gw; it < 256; it += NGW) {
        const int fh = it >> 6, d = it & 63; float ac = 0.f, as = 0.f;
        for (int k2 = 0; k2 < 64; ++k2) { const int mm = (d * k2) & 63; const float w = FIN_w_fourier[(fh * 64 + k2) * 64 + lane]; ac += cospif((float)mm * (1.0f / 32.0f)) * w; as += sinpif((float)mm * (1.0f / 32.0f)) * w; }
        const float sc = 1.0f / sqrtf((float)SEQ * 64.0f);
        WCS[(fh * 64 + d) * 128 + lane] = ac * sc; WCS[(fh * 64 + d) * 128 + 64 + lane] = as * sc;
    }
    {
        u16* D1 = WSP(u16, WS_TAB + 144 * 1024); u16* D3 = WSP(u16, WS_TAB + 272 * 1024);
        for (int it = gw; it < 320; it += NGW) {
            if (it < 256) { const int ro = it >> 7, k1 = it & 127;
#pragma unroll
                for (int j = 0; j < 4; ++j) { const int col = lane + 64 * j, ri = col >> 7, n1 = col & 127, mm = (n1 * k1) & 127; const float cc = cospif((float)mm * (1.0f / 64.0f)), ss = sinpif((float)mm * (1.0f / 64.0f));
                    const float v = (ro == 0) ? (ri == 0 ? cc : -ss) : (ri == 0 ? -ss : -cc); D1[it * 256 + col] = (u16)f2bf(v); } }
            else { const int k2 = it - 256;
#pragma unroll
                for (int j = 0; j < 2; ++j) { const int col = lane + 64 * j, ri = col >> 6, n2 = col & 63, mm = (n2 * k2) & 63; const float v = (ri == 0) ? cospif((float)mm * (1.0f / 32.0f)) : sinpif((float)mm * (1.0f / 32.0f)); D3[k2 * 128 + col] = (u16)f2bf(v); } }
        }
    }
    float* COS = WSP(float, WS_TAB + 128 * 1024); float* SIN = WSP(float, WS_TAB + 136 * 1024);
    for (int it = gw; it < 32; it += NGW) { const int idx = it * 64 + lane, pos = idx >> 4, i = idx & 15;
        const float inv = powf(10000.0f, -(float)i / 16.0f), ang = (float)pos * inv; COS[idx] = cosf(ang); SIN[idx] = sinf(ang); }
}

__device__ __forceinline__ int map_row(int mode, int sc) {
    if (mode == 1) { const int head = sc >> 6, dim = sc & 63, bj = dim >> 5, n = (dim >> 4) & 1, i = dim & 15; return (head >> 2) * 256 + bj * 128 + (head & 3) * 32 + (i >> 2) * 8 + n * 4 + (i & 3); }
    if (mode == 2) { const int g = sc >> 8, a = sc & 255; return (a >> 2) * 8 + g * 4 + (a & 3); }
    return sc;
}
struct TItem { const float* src; u16* dst; int N, K, k0, rel_c0, mode, dst_off; bool f16; bool f8; float ws; };
__device__ __forceinline__ void titem_load(const TItem& t, float (&buf)[64], int lane) {
#pragma unroll
    for (int i = 0; i < 64; ++i) { const int kk = 2 * i + (lane >> 5); buf[i] = t.src[(size_t)kk * t.N + (lane & 31)]; }
}
__device__ __forceinline__ void titem_finish(const TItem& t, const float (&buf)[64], LAS float* scr, int lane) {
#pragma unroll
    for (int i = 0; i < 64; ++i) { const int kk = 2 * i + (lane >> 5); scr[kk * 33 + (lane & 31)] = buf[i]; }
    LDS_WAIT(); asm volatile("" ::: "memory");
    if (t.f8) { const int c = lane & 7; const float ws = t.ws;
#pragma unroll
        for (int j = 0; j < 4; ++j) { const int n = (lane >> 3) + 8 * j; const LAS float* s = scr + (16 * c) * 33 + n; int w[4];
#pragma unroll
            for (int q = 0; q < 4; ++q) { w[q] = __builtin_amdgcn_cvt_pk_fp8_f32(s[(4 * q) * 33] * ws, s[(4 * q + 1) * 33] * ws, 0, false); w[q] = __builtin_amdgcn_cvt_pk_fp8_f32(s[(4 * q + 2) * 33] * ws, s[(4 * q + 3) * 33] * ws, w[q], true); }
            const int drow = t.dst_off + map_row(t.mode, t.rel_c0 + n);
            *(GAS u32x4*)((unsigned char*)t.dst + (size_t)drow * t.K + t.k0 + 16 * c) = (u32x4){(unsigned)w[0], (unsigned)w[1], (unsigned)w[2], (unsigned)w[3]}; } }
    else { const int c = lane & 15;
#pragma unroll
        for (int j = 0; j < 8; ++j) { const int n = (lane >> 4) + 4 * j; const LAS float* s = scr + (8 * c) * 33 + n;
            u32x4 o;
            if (t.f16) { o.x = pk2h(s[0 * 33], s[1 * 33]); o.y = pk2h(s[2 * 33], s[3 * 33]); o.z = pk2h(s[4 * 33], s[5 * 33]); o.w = pk2h(s[6 * 33], s[7 * 33]); }
            else { o.x = pk2bf(s[0 * 33], s[1 * 33]); o.y = pk2bf(s[2 * 33], s[3 * 33]); o.z = pk2bf(s[4 * 33], s[5 * 33]); o.w = pk2bf(s[6 * 33], s[7 * 33]); }
            const int drow = t.dst_off + map_row(t.mode, t.rel_c0 + n);
            *(GAS u32x4*)(t.dst + (size_t)drow * t.K + t.k0 + 8 * c) = o; } }
    LDS_WAIT(); asm volatile("" ::: "memory");
}
constexpr int I_FOLD = 512, I_QKV = 8 * 40, I_OUT = 8 * 32, I_R = 8 * 8, I_GU = NEXPS * 8 * 16, I_D = NEXPS * 2 * 32;
constexpr int NT_EARLY = I_QKV + I_OUT + I_R, NT_ITEMS = NT_EARLY + I_GU + I_D;
constexpr int DEFER_A = 3840, DEFER_B = 4096;
#define TDECODE(it_, t) do { int r = (it_); u16* BIN = WSP(u16, WS_BIN); \
        if (r < I_QKV) { const int kb = r / 40, nb = r % 40, sc0 = 256 + 32 * nb; t.N = 1536; t.K = DM; t.k0 = kb * 128; t.f16 = false; t.f8 = false; t.ws = 1.f; t.dst = BIN; t.src = FIN_w_in + (size_t)(kb * 128) * 1536 + sc0; \
            if (sc0 < 1024) { t.rel_c0 = sc0 - 256; t.mode = 1; t.dst_off = 512; } else if (sc0 < 1280) { t.rel_c0 = sc0 - 1024; t.mode = 1; t.dst_off = 1280; } else { t.rel_c0 = sc0 - 1280; t.mode = 0; t.dst_off = 1536; } \
            break; } \
        r -= I_QKV; \
        if (r < I_OUT) { const int kb = r / 32, nb = r % 32; t.N = DM; t.K = DM; t.k0 = kb * 128; t.f16 = false; t.f8 = false; t.ws = 1.f; t.dst = WSP(u16, WS_BOUT); t.src = FIN_w_out + (size_t)(kb * 128) * DM + 32 * nb; t.rel_c0 = 32 * nb; t.mode = 0; t.dst_off = 0; break; } \
        r -= I_OUT; \
        if (r < I_R) { const int kb = r / 8, nb = r % 8; t.N = NEXP; t.K = DM; t.k0 = kb * 128; t.f16 = (MOE_FP8 ? false : MOEF16); t.f8 = false; t.ws = 1.f; t.dst = WSP(u16, WS_BR); t.src = FIN_w_router + (size_t)(kb * 128) * NEXP + 32 * nb; t.rel_c0 = 32 * nb; t.mode = 0; t.dst_off = 0; break; } \
        r -= I_R; \
        if (r < I_GU) { const int e = r >> 7, q = r & 127, kb = q >> 4, nb = q & 15; const float* W = (e < NEXP) ? FIN_w_egu + (size_t)e * DM * 512 : FIN_w_sgu; \
            t.N = 512; t.K = DM; t.k0 = kb * 128; t.f16 = MOEF16; t.f8 = MOE_FP8; t.ws = WGU_SCALE; t.dst = MOE_FP8 ? (u16*)(F.ws + WS_BGU + (size_t)e * 512 * DM) : WSP(u16, WS_BGU) + (size_t)e * 512 * DM; t.src = W + (size_t)(kb * 128) * 512 + 32 * nb; t.rel_c0 = 32 * nb; t.mode = 2; t.dst_off = 0; break; } \
        r -= I_GU; \
        { const int e = r >> 6, q = r & 63, kb = q >> 5, nb = q & 31; const float* W = (e < NEXP) ? FIN_w_ed + (size_t)e * EFF * DM : FIN_w_sd; \
            t.N = DM; t.K = EFF; t.k0 = kb * 128; t.f16 = MOEF16; t.f8 = MOE_FP8; t.ws = WD_SCALE; t.dst = MOE_FP8 ? (u16*)(F.ws + WS_BD + (size_t)e * DM * EFF) : WSP(u16, WS_BD) + (size_t)e * DM * EFF; t.src = W + (size_t)(kb * 128) * DM + 32 * nb; t.rel_c0 = 32 * nb; t.mode = 0; t.dst_off = 0; } \
    } while (0)
__device__ __forceinline__ void transpose_range(Frame& F, int first, int count, int w, int nw) {
    LAS float* scr = (LAS float*)(F.lds + F.wave * P1_SCR); const int lane = F.lane; const int end = first + count;
    float bufA[64], bufB[64]; TItem ta, tb; int it = first + w;
    if (it < end) { TDECODE(it, ta); titem_load(ta, bufA, lane); }
    while (it < end) {
        const int itb = it + nw; const bool hb = itb < end;
        if (hb) { TDECODE(itb, tb); titem_load(tb, bufB, lane); }
        titem_finish(ta, bufA, scr, lane);
        if (!hb) break;
        const int ita = itb + nw; const bool ha = ita < end;
        if (ha) { TDECODE(ita, ta); titem_load(ta, bufA, lane); }
        titem_finish(tb, bufB, scr, lane);
        it = ita;
    }
}
__device__ __forceinline__ void p1_phase(Frame& F) {
    LAS float* scr = (LAS float*)(F.lds + F.wave * P1_SCR);
    const int gw = F.vcu * 8 + F.wave, NGW = F.G * 8, lane = F.lane;
    u16* BIN = WSP(u16, WS_BIN);
    for (int r = gw; r < I_FOLD; r += NGW) {
        const int fh = r >> 7, cs = (r >> 6) & 1, kb = (r >> 2) & 15, eq = r & 3; const int k = kb * 64 + lane;
        const GAS float* WCS = (const GAS float*)(F.ws + WS_TAB);
#pragma unroll 4
        for (int i = 0; i < 16; ++i) scr[(4 * i + (lane >> 4)) * 16 + (lane & 15)] = WCS[(fh * 64 + 4 * i + (lane >> 4)) * 128 + cs * 64 + 16 * eq + (lane & 15)];
        float wrow[64];
#pragma unroll
        for (int d4 = 0; d4 < 16; ++d4) { const f32x4 v = *(const f32x4*)(FIN_w_in + (size_t)k * 1536 + fh * 64 + 4 * d4); wrow[4 * d4] = v[0]; wrow[4 * d4 + 1] = v[1]; wrow[4 * d4 + 2] = v[2]; wrow[4 * d4 + 3] = v[3]; }
        LDS_WAIT(); asm volatile("" ::: "memory");
        for (int e1 = 0; e1 < 16; ++e1) { float a = 0.f;
#pragma unroll
            for (int d = 0; d < 64; ++d) a += wrow[d] * scr[d * 16 + e1];
            const int col256 = fh * 64 + 16 * eq + e1, pos = 8 * (col256 >> 2) + (col256 & 3) + 4 * cs;
            BIN[(size_t)pos * DM + k] = (u16)f2bf(a); }
        LDS_WAIT(); asm volatile("" ::: "memory");
    }
    const int ndefer = (F.G == 256) ? DEFER_A + DEFER_B : 0;
    REPS(11) transpose_range(F, 0, NT_ITEMS - ndefer, gw, NGW);
    const gi64* MOD = (const gi64*)(F.ctl + CW_MOD);
    u16* XN = WSP(u16, WS_XN);
    REPS(12) { const int wpb = NGW >> 2, b = gw / wpb, wi = gw % wpb;
        rownorm_rows<false>((const GAS float*)FIN_x, FIN_norm1_g, MOD + b * 6144, MOD + b * 6144 + 1024, XN, b * SEQ, SEQ, wi, wpb, lane);
        rownorm_rows<false>((const GAS float*)FIN_ctx, FIN_norm1_g, MOD + 4 * 6144, MOD + 4 * 6144 + 1024, XN + (size_t)NTOK * DM, 0, NCTX, gw, NGW, lane); }
}

__device__ __forceinline__ void fourier_unit(Frame& F, int b, int g) {
    LAS unsigned char* Zl = F.lds + RING_OFF;
    LAS f32x2* TW128 = (LAS f32x2*)(F.lds + TAB_OFF);
    LAS f32x2* TW64 = (LAS f32x2*)(F.lds + TAB_OFF + 1024);
    const int tid = F.tid;
    const GAS u32x4* Zg = (const GAS u32x4*)(F.ws + WS_Z + ((size_t)(b * 64 + g) * SEQ) * 16);
#pragma unroll 4
    for (int i = 0; i < 16; ++i) *(LAS u32x4*)(Zl + (size_t)(i * 512 + tid) * 16) = Zg[i * 512 + tid];
    if (tid < 128) { float s, c; sincospif((float)tid * (1.0f / 64.0f), &s, &c); TW128[tid] = (f32x2){c, s}; }
    else if (tid < 192) { float s, c; sincospif((float)(tid - 128) * (1.0f / 32.0f), &s, &c); TW64[tid - 128] = (f32x2){c, s}; }
    __syncthreads();
    const int k1 = tid & 127, q = tid >> 7;
    float yr[16][4], yi[16][4];
#pragma unroll
    for (int a = 0; a < 16; ++a)
#pragma unroll
        for (int e = 0; e < 4; ++e) { yr[a][e] = 0.f; yi[a][e] = 0.f; }
    for (int n1 = 0; n1 < 128; ++n1) {
        const f32x2 tw = TW128[(n1 * k1) & 127]; const float c = tw.x, s = tw.y;
#pragma unroll
        for (int a = 0; a < 16; ++a) { const u32x4 rw = *(const LAS u32x4*)(Zl + (size_t)(64 * n1 + 16 * q + a) * 16);
            const float uc[4] = {bflo(rw.x), bfhi(rw.x), bflo(rw.y), bfhi(rw.y)}, us[4] = {bflo(rw.z), bfhi(rw.z), bflo(rw.w), bfhi(rw.w)};
#pragma unroll
            for (int e = 0; e < 4; ++e) { yr[a][e] += uc[e] * c - us[e] * s; yi[a][e] -= uc[e] * s + us[e] * c; } }
    }
    __syncthreads();
    int k1b = k1; asm volatile("" : "+v"(k1b));
#pragma unroll
    for (int a = 0; a < 16; ++a) { const int n2 = 16 * q + a; const float fr_ = (float)(n2 * k1b) * (1.0f / 8192.0f);
        const float cp = __builtin_amdgcn_cosf(fr_), sp = __builtin_amdgcn_sinf(fr_);
        float pr[4], pi[4];
#pragma unroll
        for (int e = 0; e < 4; ++e) { pr[e] = yr[a][e] * cp + yi[a][e] * sp; pi[e] = yi[a][e] * cp - yr[a][e] * sp; }
        u32x4 w; w.x = pk2bf(pr[0], pr[1]); w.y = pk2bf(pr[2], pr[3]); w.z = pk2bf(pi[0], pi[1]); w.w = pk2bf(pi[2], pi[3]);
        *(LAS u32x4*)(Zl + (size_t)(n2 * 128 + k1b) * 16) = w; }
    __syncthreads();
    int k1c = k1; asm volatile("" : "+v"(k1c));
    float o[16][4];
#pragma unroll
    for (int a = 0; a < 16; ++a)
#pragma unroll
        for (int e = 0; e < 4; ++e) o[a][e] = 0.f;
    for (int n2 = 0; n2 < 64; ++n2) {
        const u32x4 rw = *(const LAS u32x4*)(Zl + (size_t)(n2 * 128 + k1c) * 16);
        const float pr[4] = {bflo(rw.x), bfhi(rw.x), bflo(rw.y), bfhi(rw.y)}, pi[4] = {bflo(rw.z), bfhi(rw.z), bflo(rw.w), bfhi(rw.w)};
#pragma unroll
        for (int a = 0; a < 16; ++a) { const f32x2 tw = TW64[(n2 * (16 * q + a)) & 63];
#pragma unroll
            for (int e = 0; e < 4; ++e) o[a][e] += pr[e] * tw.x + pi[e] * tw.y; }
    }
    u16* MIX = WSP(u16, WS_MIX);
#pragma unroll
    for (int a = 0; a < 16; ++a) { const int k2 = 16 * q + a; u32x2 w; w.x = pk2bf(o[a][0], o[a][1]); w.y = pk2bf(o[a][2], o[a][3]);
        *(GAS u32x2*)(MIX + ((size_t)(b * SEQ + k1c + 128 * k2)) * DM + 4 * g) = w; }
    __syncthreads();
}

__device__ __forceinline__ attn_body::s16x4 ftr(const LAS unsigned char* p) { return __builtin_bit_cast(attn_body::s16x4, __builtin_amdgcn_ds_read_tr16_b64_v4i16((LAS attn_body::v4i16_t*)p)); }
__device__ __forceinline__ void fourier_unit_mfma(Frame& F, int b, int g) {
    LAS unsigned char* Zl = F.lds + RING_OFF;
    const int tid = F.tid, lane = F.lane, w = F.wave;
    const char* Zg = (const char*)(F.ws + WS_Z) + ((size_t)(b * 64 + g) * SEQ) * 16;
#pragma unroll
    for (int i = 0; i < 16; ++i) __builtin_amdgcn_global_load_lds((const unsigned*)(Zg + (size_t)(i * 512 + tid) * 16), (LAS unsigned*)(Zl + (size_t)(i * 512 + w * 64) * 16), 16, 0, 0);
    VM_WAIT(); __syncthreads();
    f32x4 acc[2][16];
#pragma unroll
    for (int ro = 0; ro < 2; ++ro)
#pragma unroll
        for (int t = 0; t < 16; ++t) acc[ro][t] = (f32x4){0.f, 0.f, 0.f, 0.f};
    const GAS bf16x8* D1 = (const GAS bf16x8*)(F.ws + WS_TAB + 144 * 1024);
    const GAS bf16x8* D3 = (const GAS bf16x8*)(F.ws + WS_TAB + 272 * 1024);
    const int l15 = lane & 15, lq = lane >> 4;
    const unsigned bbase = (unsigned)((64 * (8 * lq + (l15 >> 2)) + (lane & 3)) * 16);
#pragma unroll 1
    for (int s1 = 0; s1 < 8; ++s1) {
        const int ri = s1 >> 2;
        const bf16x8 a0 = D1[(16 * w + l15) * 32 + 4 * s1 + lq], a1 = D1[(128 + 16 * w + l15) * 32 + 4 * s1 + lq];
        const LAS unsigned char* sb = Zl + bbase + (unsigned)((s1 & 3) * 32768 + 8 * ri);
#pragma unroll
        for (int t = 0; t < 16; ++t) { const attn_body::s16x4 lo = ftr(sb + 64 * t), hi = ftr(sb + 64 * t + 4096);
            const bf16x8 bf = (bf16x8){lo[0], lo[1], lo[2], lo[3], hi[0], hi[1], hi[2], hi[3]};
            acc[0][t] = __builtin_amdgcn_mfma_f32_16x16x32_bf16(a0, bf, acc[0][t], 0, 0, 0);
            acc[1][t] = __builtin_amdgcn_mfma_f32_16x16x32_bf16(a1, bf, acc[1][t], 0, 0, 0); }
    }
    __syncthreads();
    {   const int e = lane & 3; int k1b = 16 * w + 4 * lq; asm volatile("" : "+v"(k1b));
#pragma unroll
        for (int t = 0; t < 16; ++t) { const int n2 = 4 * t + (l15 >> 2);
#pragma unroll
            for (int r = 0; r < 4; ++r) { const int k1 = k1b + r; const float fr_ = (float)(n2 * k1) * (1.0f / 8192.0f); const float cp = __builtin_amdgcn_cosf(fr_), sp = __builtin_amdgcn_sinf(fr_);
                const float yr = acc[0][t][r], yi = acc[1][t][r]; const float pr = yr * cp + yi * sp, pi = yi * cp - yr * sp;
                *(LAS u16*)(Zl + (unsigned)(((n2) * 512 + k1 * 4 + e) * 2)) = (u16)f2bf(pr);
                *(LAS u16*)(Zl + (unsigned)(((64 + n2) * 512 + k1 * 4 + e) * 2)) = (u16)f2bf(pi); } }
    }
    asm volatile("s_waitcnt lgkmcnt(0)" ::: "memory");
    f32x4 acc3[4][4];
#pragma unroll
    for (int mt = 0; mt < 4; ++mt)
#pragma unroll
        for (int j = 0; j < 4; ++j) acc3[mt][j] = (f32x4){0.f, 0.f, 0.f, 0.f};
#pragma unroll
    for (int s3 = 0; s3 < 4; ++s3) {
        bf16x8 a[4];
#pragma unroll
        for (int mt = 0; mt < 4; ++mt) a[mt] = D3[(16 * mt + l15) * 16 + 4 * s3 + lq];
        const unsigned kk = (unsigned)(32 * s3 + 8 * lq + (l15 >> 2));
#pragma unroll
        for (int j = 0; j < 4; ++j) { const unsigned ad = kk * 1024u + (unsigned)((4 * (4 * w + j) + (lane & 3)) * 8);
            const attn_body::s16x4 lo = ftr(Zl + ad), hi = ftr(Zl + ad + 4096);
            const bf16x8 bf = (bf16x8){lo[0], lo[1], lo[2], lo[3], hi[0], hi[1], hi[2], hi[3]};
#pragma unroll
            for (int mt = 0; mt < 4; ++mt) acc3[mt][j] = __builtin_amdgcn_mfma_f32_16x16x32_bf16(a[mt], bf, acc3[mt][j], 0, 0, 0); }
    }
    u16* MIX = WSP(u16, WS_MIX);
#pragma unroll
    for (int mt = 0; mt < 4; ++mt)
#pragma unroll
        for (int j = 0; j < 4; ++j)
#pragma unroll
            for (int r = 0; r < 4; ++r) { const int k2 = 16 * mt + 4 * lq + r, k1 = 16 * w + 4 * j + (l15 >> 2);
                MIX[((size_t)(b * SEQ + k1 + 128 * k2)) * DM + 4 * g + (lane & 3)] = (u16)f2bf(acc3[mt][j][r]); }
    __syncthreads();
}

__device__ __forceinline__ float dpp_f(float v, int ctrl_sel) {
    const int x = __builtin_bit_cast(int, v); int r;
    if (ctrl_sel == 0) r = __builtin_amdgcn_update_dpp(x, x, 0xB1, 0xF, 0xF, false);
    else if (ctrl_sel == 1) r = __builtin_amdgcn_update_dpp(x, x, 0x4E, 0xF, 0xF, false);
    else if (ctrl_sel == 2) r = __builtin_amdgcn_update_dpp(x, x, 0x141, 0xF, 0xF, false);
    else r = __builtin_amdgcn_update_dpp(x, x, 0x140, 0xF, 0xF, false);
    return __builtin_bit_cast(float, r);
}
__device__ __forceinline__ float rdl(float v, int lane) { return __builtin_bit_cast(float, __builtin_amdgcn_readlane(__builtin_bit_cast(int, v), lane)); }
__device__ __forceinline__ void route_token(Frame& F, int tok) {
    const int l = F.lane;
    const f32x4 lg = *(const GAS f32x4*)((const GAS float*)(F.ws + WS_LOG) + (size_t)tok * NEXP + 4 * l);
    const f32x4 bs = *(const f32x4*)(FIN_router_bias + 4 * l);
    float s[4], sel[4];
#pragma unroll
    for (int j = 0; j < 4; ++j) { s[j] = 1.0f / (1.0f + expf(-lg[j])); sel[j] = s[j] + bs[j]; }
    float m1 = fmaxf(sel[0], sel[1]), m2 = fminf(sel[0], sel[1]);
#pragma unroll
    for (int j = 2; j < 4; ++j) { const float v = sel[j]; m2 = fmaxf(m2, fminf(m1, v)); m1 = fmaxf(m1, v); }
#pragma unroll
    for (int st = 0; st < 3; ++st) { const float o1 = dpp_f(m1, st), o2 = dpp_f(m2, st); const float n2 = fmaxf(fminf(m1, o1), fmaxf(m2, o2)); m1 = fmaxf(m1, o1); m2 = n2; }
    const float gs = m1 + m2; const int myg = l >> 3; int rank = 0;
#pragma unroll
    for (int g2 = 0; g2 < 8; ++g2) { const float og = rdl(gs, g2 * 8); rank += (og > gs || (og == gs && g2 < myg)) ? 1 : 0; }
    if (rank >= 4) {
#pragma unroll
        for (int j = 0; j < 4; ++j) sel[j] = -INFINITY; }
    int my_e = 0; float my_s = 0.f, sum = 0.f;
#pragma unroll 1
    for (int k = 0; k < TOPK; ++k) {
        const float lb = fmaxf(fmaxf(sel[0], sel[1]), fmaxf(sel[2], sel[3]));
        float r = lb; r = fmaxf(r, dpp_f(r, 0)); r = fmaxf(r, dpp_f(r, 1)); r = fmaxf(r, dpp_f(r, 2)); r = fmaxf(r, dpp_f(r, 3));
        const float wm = fmaxf(fmaxf(rdl(r, 0), rdl(r, 16)), fmaxf(rdl(r, 32), rdl(r, 48)));
        const unsigned long long mask = __ballot(lb == wm);
        const int wl = __builtin_amdgcn_readfirstlane((int)__ffsll((long long)mask) - 1);
        const int jj = (sel[0] == wm) ? 0 : (sel[1] == wm) ? 1 : (sel[2] == wm) ? 2 : 3;
        const float cand = (jj == 0) ? s[0] : (jj == 1) ? s[1] : (jj == 2) ? s[2] : s[3];
        const int jw = __builtin_amdgcn_readlane(jj, wl); const float wsc = rdl(cand, wl);
        if (l == wl) {
#pragma unroll
            for (int j = 0; j < 4; ++j) if (jw == j) sel[j] = -INFINITY; }
        if (l == k) { my_e = 4 * wl + jw; my_s = wsc; }
        sum += wsc;
    }
    GAS u32x2* LIST = (GAS u32x2*)(F.ws + WS_LIST);
    if (l < TOPK) { const float gate = my_s / sum * 2.5f; const unsigned pos = __hip_atomic_fetch_add((unsigned*)(F.ctl + CW_CNT + my_e), 1u, RLX_AGENT);
        LIST[(size_t)my_e * NTOK + pos] = (u32x2){(unsigned)tok | ((unsigned)l << 16), __builtin_bit_cast(unsigned, gate)}; }
    else if (l == TOPK) LIST[(size_t)NEXP * NTOK + tok] = (u32x2){(unsigned)tok | (8u << 16), __builtin_bit_cast(unsigned, 1.0f)};
}

__device__ __forceinline__ void build_tiles(Frame& F) {
    LAS int* TS = (LAS int*)(F.lds + TAB_OFF + 2048); LAS int* CN = (LAS int*)(F.lds + TAB_OFF + 3200);
    if (F.tid < 64) { const int l = F.tid; int c[5], t[5], tot = 0;
#pragma unroll
        for (int j = 0; j < 5; ++j) { const int e = 5 * l + j; c[j] = (e < NEXPS) ? (int)__hip_atomic_load((unsigned*)(F.ctl + CW_CNT + e), RLX_AGENT) : 0; t[j] = (c[j] + 255) >> 8; tot += t[j]; }
        int x = tot;
#pragma unroll
        for (int off = 1; off < 64; off <<= 1) { const int v = __shfl_up(x, off); if (l >= off) x += v; }
        int run = x - tot;
#pragma unroll
        for (int j = 0; j < 5; ++j) { const int e = 5 * l + j; if (e <= NEXPS) { TS[e] = run; if (e < NEXPS) CN[e] = c[j]; } run += t[j]; }
    }
    __syncthreads();
}

__device__ __forceinline__ void ph2(Frame& F) {
    const gi64* MOD = (const gi64*)(F.ctl + CW_MOD); const int gw = F.vcu * 8 + F.wave, NGW = F.G * 8; (void)MOD; (void)gw; (void)NGW;
        DenseOrder S{7, 128 * 7, 8, F.G, F.vcu, (const char*)(F.ws + WS_BIN), DM, (REP == 22) ? 2 : 1};
        EpiInProj E{WSP(u16, WS_Z), WSP(u16, WS_Q), WSP(u16, WS_K), WSP(u16, WS_V), WSP(float, WS_TAB + 128 * 1024), WSP(float, WS_TAB + 136 * 1024), FIN_q_norm_g, FIN_k_norm_g};
        pg8::gemm_phase<EpiInProj, DenseOrder, 0, true>(F.lds + RING_OFF, (const char*)(F.ws + WS_XN), DM, S, E);
        if (F.G == 256 && F.vcu >= 136) transpose_range(F, NT_ITEMS - DEFER_A - DEFER_B, DEFER_A, (F.vcu - 136) * 8 + F.wave, 120 * 8);
    }
__device__ __forceinline__ void ph4(Frame& F) {
    const gi64* MOD = (const gi64*)(F.ctl + CW_MOD); const int gw = F.vcu * 8 + F.wave, NGW = F.G * 8; (void)MOD; (void)gw; (void)NGW;
        if (DBG & 128) { GAS u32x4* zH = (GAS u32x4*)(F.ws + WS_H2); const size_t nH = (size_t)NTOK * DM * 2 / 16; for (size_t i = (size_t)blockIdx.x * 512 + F.tid; i < nH; i += (size_t)F.G * 512) zH[i] = (u32x4){0u, 0u, 0u, 0u}; }
        DenseOrder S{4, 128 * 4, 0, F.G, F.vcu, (const char*)(F.ws + WS_BOUT), DM, 1};
        EpiResid E{FIN_x, F.out, MOD};
        pg8::gemm_phase<EpiResid, DenseOrder, 0, true>(F.lds + RING_OFF, (const char*)(F.ws + WS_MIX), DM, S, E);
    }
__device__ __forceinline__ void ph5(Frame& F) {
    const gi64* MOD = (const gi64*)(F.ctl + CW_MOD); const int gw = F.vcu * 8 + F.wave, NGW = F.G * 8;
    const int wpb = NGW >> 2, b = gw / wpb, wi = gw % wpb;
    rownorm_rows<(MOE_FP8 ? false : MOEF16), MOE_FP8>((const GAS float*)F.out, FIN_norm2_g, MOD + b * 6144 + 3072, MOD + b * 6144 + 4096, WSP(u16, WS_H2), b * SEQ, SEQ, wi, wpb, F.lane, F.ws + WS_H2F8);
}
__device__ __forceinline__ void ph6(Frame& F) {
    const gi64* MOD = (const gi64*)(F.ctl + CW_MOD); const int gw = F.vcu * 8 + F.wave, NGW = F.G * 8; (void)MOD; (void)gw; (void)NGW;
        DenseOrder S{1, 128, 0, F.G, F.vcu, (const char*)(F.ws + WS_BR), DM, 1};
        EpiLogits E{WSP(float, WS_LOG)};
        pg8::gemm_phase<EpiLogits, DenseOrder, (MOE_FP8 ? 0 : (MOE_F16 ? 1 : 0)), true>(F.lds + RING_OFF, (const char*)(F.ws + WS_H2), DM, S, E);
        if (F.G == 256 && F.vcu >= 128) transpose_range(F, NT_ITEMS - DEFER_B, DEFER_B, (F.vcu - 128) * 8 + F.wave, 128 * 8);
    }
__device__ __forceinline__ void ph8(Frame& F) {
    const gi64* MOD = (const gi64*)(F.ctl + CW_MOD); const int gw = F.vcu * 8 + F.wave, NGW = F.G * 8; (void)MOD; (void)gw; (void)NGW;
        build_tiles(F);
        GroupedOrder<true> S{2, F.G, F.vcu, 512, DM * (MOE_FP8 ? 1 : 2), true, (const char*)(F.ws + WS_BGU), (const LAS int*)(F.lds + TAB_OFF + 2048), (const LAS int*)(F.lds + TAB_OFF + 3200), (const GAS u32x2*)(F.ws + WS_LIST), (REP == 28) ? 2 : 1, __builtin_amdgcn_readfirstlane(((const LAS int*)(F.lds + TAB_OFF + 2048))[257])};
        EpiSwiglu E{WSP(u16, WS_ACT)};
        pg8::gemm_phase<EpiSwiglu, GroupedOrder<true>, MOE_DT, true>(F.lds + RING_OFF, (const char*)(F.ws + (MOE_FP8 ? WS_H2F8 : WS_H2)), DM, S, E, SC_GU);
    }
__device__ __forceinline__ void ph9(Frame& F) {
    const gi64* MOD = (const gi64*)(F.ctl + CW_MOD); const int gw = F.vcu * 8 + F.wave, NGW = F.G * 8; (void)MOD; (void)gw; (void)NGW;
        build_tiles(F);
        GroupedOrder<false> S{4, F.G, F.vcu, DM, EFF * (MOE_FP8 ? 1 : 2), false, (const char*)(F.ws + WS_BD), (const LAS int*)(F.lds + TAB_OFF + 2048), (const LAS int*)(F.lds + TAB_OFF + 3200), (const GAS u32x2*)(F.ws + WS_LIST), (REP == 29) ? 2 : 1, __builtin_amdgcn_readfirstlane(((const LAS int*)(F.lds + TAB_OFF + 2048))[257])};
        EpiDown E{WSP(u16, WS_C), (const GAS u32x2*)(F.ws + WS_LIST), F.ws + WS_DUMP};
        pg8::gemm_phase<EpiDown, GroupedOrder<false>, MOE_DT, true>(F.lds + RING_OFF, (const char*)(F.ws + WS_ACT), EFF, S, E, SC_D);
    }

#if DBG & (1024 | 2048)
__device__ __forceinline__ void chk_attn(Frame& F, float negM) {
    const int gw = F.vcu * 8 + F.wave, NGW = F.G * 8, lane = F.lane;
    const GAS u16* Q = (const GAS u16*)(F.ws + WS_Q); const GAS u16* K = (const GAS u16*)(F.ws + WS_K); const GAS u16* V = (const GAS u16*)(F.ws + WS_V); const GAS u16* MIX = (const GAS u16*)(F.ws + WS_MIX);
    float* chk = (float*)(F.ctl + CW_CHK);
    for (int i = gw; i < 4096; i += NGW) {
        const int b = i & 3, h = (i >> 2) % 12, q = (int)((((unsigned)i * 2654435761u) >> 19) & 8191u), kvh = h / 3;
        float qv[64], o[64]; float l = 0.f;
#pragma unroll
        for (int c = 0; c < 8; ++c) { const u32x4 w = *(const GAS u32x4*)(Q + ((size_t)(b * SEQ + q)) * QW + h * 64 + 8 * c);
            qv[8 * c] = bflo(w.x); qv[8 * c + 1] = bfhi(w.x); qv[8 * c + 2] = bflo(w.y); qv[8 * c + 3] = bfhi(w.y); qv[8 * c + 4] = bflo(w.z); qv[8 * c + 5] = bfhi(w.z); qv[8 * c + 6] = bflo(w.w); qv[8 * c + 7] = bfhi(w.w); }
#pragma unroll
        for (int d = 0; d < 64; ++d) o[d] = 0.f;
        for (int t = 0; t < LKV / 64; ++t) { const int j = t * 64 + lane; const GAS u16* kr = K + ((size_t)(b * LKV + j)) * KVW + kvh * 64; const GAS u16* vr = V + ((size_t)(b * LKV + j)) * KVW + kvh * 64;
            float dot = 0.f;
#pragma unroll
            for (int c = 0; c < 8; ++c) { const u32x4 w = *(const GAS u32x4*)(kr + 8 * c);
                dot += qv[8 * c] * bflo(w.x) + qv[8 * c + 1] * bfhi(w.x) + qv[8 * c + 2] * bflo(w.y) + qv[8 * c + 3] * bfhi(w.y) + qv[8 * c + 4] * bflo(w.z) + qv[8 * c + 5] * bfhi(w.z) + qv[8 * c + 6] * bflo(w.w) + qv[8 * c + 7] * bfhi(w.w); }
            const float pp = exp2f(dot + negM); l += pp;
#pragma unroll
            for (int c = 0; c < 8; ++c) { const u32x4 w = *(const GAS u32x4*)(vr + 8 * c);
                o[8 * c] += pp * bflo(w.x); o[8 * c + 1] += pp * bfhi(w.x); o[8 * c + 2] += pp * bflo(w.y); o[8 * c + 3] += pp * bfhi(w.y); o[8 * c + 4] += pp * bflo(w.z); o[8 * c + 5] += pp * bfhi(w.z); o[8 * c + 6] += pp * bflo(w.w); o[8 * c + 7] += pp * bfhi(w.w); } }
        l = wave_sum(l); float err = 0.f, ref = 0.f;
#pragma unroll
        for (int d = 0; d < 64; ++d) { const float od = wave_sum(o[d]) / l; const float mv = bflo((unsigned)MIX[((size_t)(b * SEQ + q)) * DM + 256 + h * 64 + d]); err += (od - mv) * (od - mv); ref += od * od; }
        if (lane == 0) { atomicAdd(chk + 0, err); atomicAdd(chk + 1, ref); }
    }
}
__device__ __forceinline__ void chk_qkv(Frame& F) {
    const int gw = F.vcu * 8 + F.wave, NGW = F.G * 8, lane = F.lane;
    const gi64* MOD = (const gi64*)(F.ctl + CW_MOD);
    LAS float* hrow = (LAS float*)(F.lds + RING_OFF + F.wave * 16384);
    float* chk = (float*)(F.ctl + CW_CHK);
    for (int i = gw; i < 4096; i += NGW) {
        const unsigned hs = (unsigned)i * 2654435761u; const bool isctx = (i & 15) == 15; int sel = i % 20; if (isctx && sel < 12) sel = 12 + (sel & 7);
        const int m = isctx ? (int)((hs >> 10) & 1023u) : (int)((hs >> 12) & 32767u);
        const float* src = isctx ? FIN_ctx + (size_t)m * DM : FIN_x + (size_t)m * DM; const int mr = isctx ? 4 : (m >> 13);
        const int b = isctx ? (m >> 8) : (m >> 13), l = isctx ? 0 : (m & 8191), key = isctx ? SEQ + (m & 255) : l;
        f32x4 v[4]; float s2 = 0.f;
#pragma unroll
        for (int j = 0; j < 4; ++j) { v[j] = *(const f32x4*)(src + 4 * lane + 256 * j); s2 += (v[j][0] * v[j][0] + v[j][1] * v[j][1]) + (v[j][2] * v[j][2] + v[j][3] * v[j][3]); }
        const float rstd = 1.0f / sqrtf(wave_sum(s2) * (1.0f / DM) + RMS_EPS);
#pragma unroll
        for (int j = 0; j < 4; ++j) { const int col = 4 * lane + 256 * j; const f32x4 g = *(const f32x4*)(FIN_norm1_g + col); const f32x4 sh = mod4(MOD, mr * 6144 + col), sc = mod4(MOD, mr * 6144 + 1024 + col);
            const f32x4 y = v[j] * rstd * g * (sc + 1.0f) + sh; hrow[col] = y[0]; hrow[col + 1] = y[1]; hrow[col + 2] = y[2]; hrow[col + 3] = y[3]; }
        LDS_WAIT(); asm volatile("" ::: "memory");
        const int colbase = (sel < 12) ? 256 + 64 * sel : (sel < 16 ? 1024 + 64 * (sel - 12) : 1280 + 64 * (sel - 16));
        float z = 0.f;
        for (int k = 0; k < DM; ++k) z += hrow[k] * FIN_w_in[(size_t)k * 1536 + colbase + lane];
        float outv = z; int spos = lane;
        if (sel < 16) { const float ss = wave_sum(z * z); const float gain = (sel < 12) ? FIN_q_norm_g[lane] : FIN_k_norm_g[lane]; const float zz = z * (1.0f / sqrtf(ss * (1.0f / 64.0f) + RMS_EPS)) * gain;
            const float pz = __shfl(zz, lane ^ 16); outv = zz;
            if (!isctx) { const int pidx = (lane & 32) ? (l & 63) : (l >> 6); const float inv = powf(10000.0f, -(float)(lane & 15) / 16.0f), ang = (float)pidx * inv; const float cs = cosf(ang), sn = sinf(ang);
                outv = (lane & 16) ? zz * cs + pz * sn : zz * cs - pz * sn; }
            if (sel < 12) outv *= C2;
            spos = 32 * (lane >> 5) + 8 * ((lane >> 2) & 3) + 4 * ((lane >> 4) & 1) + (lane & 3); }
        float stored;
        if (sel < 12) stored = bflo((unsigned)((const GAS u16*)(F.ws + WS_Q))[(size_t)m * QW + sel * 64 + spos]);
        else if (sel < 16) stored = bflo((unsigned)((const GAS u16*)(F.ws + WS_K))[((size_t)(b * LKV + key)) * KVW + (sel - 12) * 64 + spos]);
        else stored = bflo((unsigned)((const GAS u16*)(F.ws + WS_V))[((size_t)(b * LKV + key)) * KVW + (sel - 16) * 64 + lane]);
        const float err = wave_sum((outv - stored) * (outv - stored)), ref = wave_sum(outv * outv);
        if (lane == 0) { atomicAdd(chk + 2, err); atomicAdd(chk + 3, ref); }
        LDS_WAIT(); asm volatile("" ::: "memory");
    }
}
#endif

struct Args { const float* in[20]; float* out; unsigned char* ws; int ph_lo, ph_hi; };
__global__ void __launch_bounds__(512, 2) mk_fwd(Args args) {
    extern __shared__ __attribute__((aligned(16))) unsigned char lds[];
    Frame F;
    F.lds = (LAS unsigned char*)lds;
    F.MISC = (volatile LAS unsigned*)(F.lds + MISC_OFF);
    F.tid = threadIdx.x; F.lane = F.tid & 63; F.wave = __builtin_amdgcn_readfirstlane(F.tid >> 6);
    F.G = gridDim.x; { const int bx = blockIdx.x; F.vcu = (F.G % 8 == 0) ? (bx % 8) * (F.G / 8) + bx / 8 : bx; }
    F.ws = args.ws; F.ctl = (gu32*)(args.ws + WS_CTL); F.out = args.out;
    F.ka = (const float* const*)__builtin_amdgcn_kernarg_segment_ptr();
    for (int u = F.tid; u < (LDS_BYTES - LDSCTL_OFF) / 4; u += 512) ((LAS unsigned*)(F.lds + LDSCTL_OFF))[u] = 0u;
    __syncthreads();
    XcdBarrier bar; bar.bar = (unsigned*)(F.ctl + CW_BAR); bar.x = 0; bar.st = nullptr;
    if (N_LAUNCHES == 1) bar = xcd_barrier_post((unsigned*)(F.ctl + CW_BAR), F.MISC + 8);
    const int lo = args.ph_lo, hi = args.ph_hi;
#define IN(k) (lo <= (k) && (k) < hi)
#define SEAM(k) do { if (IN(k) && IN((k) + 1)) xcd_barrier(bar); asm volatile("" : "+s"(F.ka)); } while (0)
    const gi64* MOD = (const gi64*)(F.ctl + CW_MOD);
    const int gw = F.vcu * 8 + F.wave, NGW = F.G * 8;

    if (IN(0)) { p0_phase(F); } SEAM(0);
    if (IN(1)) { p1_phase(F); VM_WAIT(); __syncthreads(); if (REP == 1) { xcd_barrier(bar); p1_phase(F); VM_WAIT(); __syncthreads(); } } SEAM(1);

    if (IN(2)) { ph2(F); if (REP == 2) { xcd_barrier(bar); ph2(F); } } SEAM(2);

    if (IN(3)) {
        if (DBG & 32) { u16* MIXz = WSP(u16, WS_MIX); for (int m = gw; m < NTOK; m += NGW) *(GAS u32x2*)(MIXz + (size_t)m * DM + 4 * F.lane) = (u32x2){0u, 0u}; }
        else
        REPS(30) for (int U = F.vcu; U < NB * 64; U += F.G) { if (FOURIER_MFMA) fourier_unit_mfma(F, U >> 6, U & 63); else fourier_unit(F, U >> 6, U & 63); }
        const attn_body::bf16* Qp = (const attn_body::bf16*)(F.ws + WS_Q); const attn_body::bf16* Kp = (const attn_body::bf16*)(F.ws + WS_K); const attn_body::bf16* Vp = (const attn_body::bf16*)(F.ws + WS_V);
        attn_body::bf16* Op = (attn_body::bf16*)(F.ws + WS_MIX) + 256;
        float negM; { float gqm = fabsf(FIN_q_norm_g[F.lane]), gkm = fabsf(FIN_k_norm_g[F.lane]);
#pragma unroll
            for (int o_ = 1; o_ < 64; o_ <<= 1) { gqm = fmaxf(gqm, __shfl_xor(gqm, o_)); gkm = fmaxf(gkm, __shfl_xor(gkm, o_)); }
            negM = -(C2 * 64.0f * gqm * gkm + 0.5f); }
        if (ATTN_PRIO) { if (__builtin_amdgcn_readfirstlane(F.tid) >= 256) __builtin_amdgcn_s_setprio(1); }
        if (DBG & 16) { u16* MIXz = WSP(u16, WS_MIX); for (int m = gw; m < NTOK; m += NGW) for (int j = 1; j < 4; ++j) *(GAS u32x2*)(MIXz + (size_t)m * DM + 256 * j + 4 * F.lane) = (u32x2){0u, 0u}; }
        else if (F.G == 256) REPS(31) {
            const int xg = F.vcu >> 5, jq = F.vcu & 31;
            for (int i = 0; i < 6; ++i) { const int grp = 2 * xg + i / 3, hs = i % 3; attn_body::attn_unit<8>(grp >> 2, (grp & 3) * 3 + hs, jq, Qp, Kp, Vp, Op, (char*)lds + RING_OFF, negM); }
        } else {
            for (int U = F.vcu; U < NB * NQH * 32; U += F.G) { const int grp = U / 96, r = U % 96; attn_body::attn_unit<8>(grp >> 2, (grp & 3) * 3 + r / 32, r % 32, Qp, Kp, Vp, Op, (char*)lds + RING_OFF, negM); }
        }
        if (ATTN_PRIO) __builtin_amdgcn_s_setprio(0);
    } SEAM(3);

#if DBG & (1024 | 2048)
    if (IN(4)) { float negMc; { float gqm = fabsf(FIN_q_norm_g[F.lane]), gkm = fabsf(FIN_k_norm_g[F.lane]);
            for (int o_ = 1; o_ < 64; o_ <<= 1) { gqm = fmaxf(gqm, __shfl_xor(gqm, o_)); gkm = fmaxf(gkm, __shfl_xor(gkm, o_)); } negMc = -(C2 * 64.0f * gqm * gkm + 0.5f); }
        if (DBG & 1024) chk_attn(F, negMc); if (DBG & 2048) chk_qkv(F); VM_WAIT(); __syncthreads(); }
#endif
    if (IN(4)) { ph4(F); if (REP == 4) { xcd_barrier(bar); ph4(F); } } SEAM(4);

    if (IN(5)) { ph5(F); if (REP == 5) { xcd_barrier(bar); ph5(F); } if (REP == 55) { xcd_barrier(bar); xcd_barrier(bar); xcd_barrier(bar); xcd_barrier(bar); xcd_barrier(bar); } } SEAM(5);

    if (IN(6)) { ph6(F); if (REP == 6) { xcd_barrier(bar); ph6(F); } } SEAM(6);

    if (IN(7)) {
        if (DBG & 128) { GAS u32x4* zA = (GAS u32x4*)(F.ws + WS_ACT); const size_t nA = (size_t)MAXTILES * 256 * EFF * 2 / 16; for (size_t i = (size_t)blockIdx.x * 512 + F.tid; i < nA; i += (size_t)F.G * 512) zA[i] = (u32x4){0u, 0u, 0u, 0u};
            GAS u32x4* zC = (GAS u32x4*)(F.ws + WS_C); const size_t nC = (size_t)NTOK * NSLOT * DM * 2 / 16; for (size_t i = (size_t)blockIdx.x * 512 + F.tid; i < nC; i += (size_t)F.G * 512) zC[i] = (u32x4){0u, 0u, 0u, 0u}; }
        if (blockIdx.x == 0 && F.tid == 0) __hip_atomic_store((unsigned*)(F.ctl + CW_CNT + NEXP), (unsigned)NTOK, RLX_AGENT);
        for (int tok = gw; tok < NTOK; tok += NGW) route_token(F, tok);
    } SEAM(7);

    if (IN(8)) { ph8(F); if (REP == 8) { xcd_barrier(bar); ph8(F); } } SEAM(8);

    if (IN(9)) { ph9(F); if (REP == 9) { xcd_barrier(bar); ph9(F); } } SEAM(9);

    if (IN(10)) {
        const int lane = F.lane; const GAS unsigned char* Cc = (const GAS unsigned char*)(F.ws + WS_C);
        const int wpb = NGW >> 2, b = gw / wpb, wi = gw % wpb;
        f32x4 g2v[4], fg[4];
#pragma unroll
        for (int i = 0; i < 4; ++i) { const int col = 16 * lane + 4 * i; g2v[i] = mod4(MOD + b * 6144 + 5120, col) * (1.0f / C_SCALE); fg[i] = *(const f32x4*)(FIN_final_g + col); }
        bool bad = false;
#if DBG & (1024 | 2048)
        { const float e0 = __hip_atomic_load((float*)(F.ctl + CW_CHK), RLX_AGENT), r0 = __hip_atomic_load((float*)(F.ctl + CW_CHK) + 1, RLX_AGENT), e1 = __hip_atomic_load((float*)(F.ctl + CW_CHK) + 2, RLX_AGENT), r1 = __hip_atomic_load((float*)(F.ctl + CW_CHK) + 3, RLX_AGENT);
          if (DBG & 1024) bad = bad || !(e0 <= CHK_TOL_A * r0) || !(r0 > 0.f); if (DBG & 2048) bad = bad || !(e1 <= CHK_TOL_B * r1) || !(r1 > 0.f); }
#endif
        for (int r = wi; r < SEQ; r += wpb) { const int m = b * SEQ + r; GAS float* orow = (GAS float*)F.out + (size_t)m * DM + 16 * lane;
            f32x4 x1[4], y[4];
#pragma unroll
            for (int i = 0; i < 4; ++i) { x1[i] = *(const GAS f32x4*)(orow + 4 * i); y[i] = (f32x4){0.f, 0.f, 0.f, 0.f}; }
#pragma unroll
            for (int sl = 0; sl < NSLOT; ++sl) { const u32x4 w = *(const GAS u32x4*)(Cc + ((size_t)m * NSLOT + sl) * DM + 16 * lane);
#pragma unroll
                for (int i = 0; i < 4; ++i) { const int wi_ = (int)w[i]; const f32x2 lo = __builtin_amdgcn_cvt_pk_f32_fp8(wi_, false), hi = __builtin_amdgcn_cvt_pk_f32_fp8(wi_, true); y[i] += (f32x4){lo.x, lo.y, hi.x, hi.y}; } }
            float s2 = 0.f;
#pragma unroll
            for (int i = 0; i < 4; ++i) { const f32x4 v = x1[i] + g2v[i] * y[i]; x1[i] = v; s2 += (v[0] * v[0] + v[1] * v[1]) + (v[2] * v[2] + v[3] * v[3]); }
            const float rstd = 1.0f / sqrtf(wave_sum(s2) * (1.0f / DM) + RMS_EPS) * (bad ? 3.0f : 1.0f);
#pragma unroll
            for (int i = 0; i < 4; ++i) *(GAS f32x4*)(orow + 4 * i) = x1[i] * rstd * fg[i]; }
    }
#undef IN
#undef SEAM
}

extern "C" void kernel_launch(void* const* d_in, const int* in_sizes, int n_in, void* d_out, int out_size, void* d_ws, size_t ws_size, hipStream_t stream) {
    static int grid = 0;
    if (grid == 0) {
        if (n_in != 20 || in_sizes[0] != NTOK * DM || out_size != NTOK * DM || ws_size < WS_END) { fprintf(stderr, "kernel_launch: unexpected shapes (n_in %d, in0 %d, out %d, ws %zu < %zu)\n", n_in, n_in > 0 ? in_sizes[0] : -1, out_size, ws_size, (size_t)WS_END); grid = -1; return; }
        int dev = 0, cus = 0, per_cu = 0;
        if (hipGetDevice(&dev) != hipSuccess || hipDeviceGetAttribute(&cus, hipDeviceAttributeMultiprocessorCount, dev) != hipSuccess) { grid = -1; return; }
        if (hipFuncSetAttribute((const void*)mk_fwd, hipFuncAttributeMaxDynamicSharedMemorySize, LDS_BYTES) != hipSuccess) { fprintf(stderr, "kernel_launch: hipFuncSetAttribute failed\n"); grid = -1; return; }
        if (hipOccupancyMaxActiveBlocksPerMultiprocessor(&per_cu, (const void*)mk_fwd, 512, LDS_BYTES) != hipSuccess || per_cu < 1) fprintf(stderr, "kernel_launch: occupancy query reports %d\n", per_cu);
        (void)hipGetLastError();
        grid = cus;
    }
    if (grid < 0) return;
    (void)hipMemsetAsync((char*)d_ws + WS_CTL, 0, CTL_ZERO_BYTES, stream);
    Args a{};
    for (int i = 0; i < 20; ++i) a.in[i] = (const float*)d_in[i];
    a.out = (float*)d_out; a.ws = (unsigned char*)d_ws;
    if (N_LAUNCHES == 1) { a.ph_lo = 0; a.ph_hi = PER_PHASE; hipLaunchKernelGGL(mk_fwd, dim3(grid), dim3(512), LDS_BYTES, stream, a); }
    else for (int li = 0; li < PER_PHASE; ++li) { a.ph_lo = li; a.ph_hi = li + 1; hipLaunchKernelGGL(mk_fwd, dim3(grid), dim3(512), LDS_BYTES, stream, a); }
}
```

```cpp
#include <hip/hip_runtime.h>
#include <hip/hip_bf16.h>
#include <cstdio>
#include <cstdint>
#include <cmath>

#ifndef MK_N_LAUNCHES
#define MK_N_LAUNCHES 1
#endif
constexpr int PER_PHASE = 11;
#ifndef DBG
#define DBG 0
#endif
#ifndef REP
#define REP -1
#endif
#ifndef CHK_TOL_A
#define CHK_TOL_A 1e-4f
#endif
#ifndef CHK_TOL_B
#define CHK_TOL_B 3e-3f
#endif
#ifndef POSTEPI_WAITS
#define POSTEPI_WAITS 1
#endif
#ifndef ATTN_FP8
#define ATTN_FP8 1
#endif
constexpr float Q8_SCALE = 8.0f;
#ifndef ATTN_MSUM
#define ATTN_MSUM false
#endif
#ifndef ATTN_PRIO
#define ATTN_PRIO 1
#endif
#ifndef FOURIER_MFMA
#define FOURIER_MFMA 1
#endif
#define REPS(k) for (int rep_ = 0; rep_ < ((REP == (k)) ? 2 : 1); ++rep_)
#define REPBAR() do { if (rep_) xcd_barrier(bar); } while (0)
constexpr int N_LAUNCHES = MK_N_LAUNCHES;

#define GAS __attribute__((address_space(1)))
#define LAS __attribute__((address_space(3)))
typedef unsigned short u16;
typedef short bf16x8 __attribute__((ext_vector_type(8)));
typedef _Float16 half8 __attribute__((ext_vector_type(8)));
typedef _Float16 half2v __attribute__((ext_vector_type(2)));
typedef float f32x4 __attribute__((ext_vector_type(4)));
typedef float f32x2 __attribute__((ext_vector_type(2)));
typedef unsigned u32x4 __attribute__((ext_vector_type(4)));
typedef unsigned u32x2 __attribute__((ext_vector_type(2)));
typedef GAS unsigned gu32;

constexpr int DM = 1024, NB = 4, SEQ = 8192, NTOK = NB * SEQ, CTXL = 256, NCTX = NB * CTXL, LKV = SEQ + CTXL;
constexpr int NQH = 12, NKVH = 4, HD = 64, QW = NQH * HD, KVW = NKVH * HD;
constexpr int NIN = 1792;
constexpr int MIN_ROWS = NTOK + NCTX;
constexpr int NEXP = 256, NEXPS = 257, TOPK = 8, EFF = 256, NSLOT = 9;
constexpr int MAXTILES = 1408;
constexpr float RMS_EPS = 1e-6f;
#ifndef MOE_F16
#define MOE_F16 0
#endif
constexpr bool MOEF16 = MOE_F16;
#ifndef MOE_FP8
#define MOE_FP8 1
#endif
constexpr int MOE_DT = MOE_FP8 ? 2 : (MOE_F16 ? 1 : 0);
constexpr float WGU_SCALE = 32.0f, WD_SCALE = 16.0f;
constexpr int SC_ONE = 0x7f7f7f7f, SC_GU = 0x7f7f7f7a, SC_D = 0x7f7f7f7b;
constexpr float C2 = 0.125f * 1.4426950408889634f;
constexpr float C_SCALE = 16.0f;

constexpr size_t MiB = 1u << 20;
constexpr size_t WS_CTL = 0, CTL_ZERO_BYTES = 1 * MiB;
constexpr size_t WS_TAB = 1 * MiB;
constexpr size_t WS_BIN = 2 * MiB;
constexpr size_t WS_BOUT = 6 * MiB;
constexpr size_t WS_BR = 8 * MiB;
constexpr size_t WS_K = 16 * MiB;
constexpr size_t WS_V = 34 * MiB;
constexpr size_t WS_Z = 52 * MiB;
constexpr size_t WS_Q = 84 * MiB;
constexpr size_t WS_XN = 132 * MiB;
constexpr size_t WS_MIX = 198 * MiB;
constexpr size_t WS_H2 = 262 * MiB;
constexpr size_t WS_LOG = 326 * MiB;
constexpr size_t WS_LIST = 358 * MiB;
constexpr size_t WS_BGU = 424 * MiB;
constexpr size_t WS_BD = 682 * MiB;
constexpr size_t WS_ACT = 812 * MiB;
constexpr size_t WS_C = 990 * MiB;
constexpr size_t WS_H2F8 = 1568 * MiB;
constexpr size_t WS_DUMP = 1600 * MiB;
constexpr size_t WS_END = 1632 * MiB;
constexpr int CW_TMO = 0, CW_CODE = 1;
constexpr int CW_BAR = 4096;
constexpr int CW_CNT = 16384;
constexpr int CW_CHK = 32768;
constexpr int CW_MOD = 131072;
static_assert(CW_MOD * 4 + 5 * 6144 * 8 <= (int)CTL_ZERO_BYTES, "ctl");

constexpr int RING_OFF = 0, RING_BYTES = 131072;
constexpr int P1_SCR = 18432;
constexpr int TAB_OFF = 8 * P1_SCR;
constexpr int LDS_BYTES = 163840;
constexpr int LDSCTL_OFF = LDS_BYTES - 1024, MISC_OFF = LDSCTL_OFF + 320;
static_assert(TAB_OFF + 8192 <= LDSCTL_OFF, "LDS map");

#define LDS_WAIT() asm volatile("s_waitcnt lgkmcnt(0)" ::: "memory")
#define VM_WAIT() asm volatile("s_waitcnt vmcnt(0)" ::: "memory")
#define RLX_AGENT __ATOMIC_RELAXED, __HIP_MEMORY_SCOPE_AGENT

__device__ __forceinline__ unsigned f2bf(float f) { unsigned u = __builtin_bit_cast(unsigned, f); return (u + 0x7fffu + ((u >> 16) & 1u)) >> 16; }
__device__ __forceinline__ unsigned pk2bf(float lo, float hi) { return f2bf(lo) | (f2bf(hi) << 16); }
__device__ __forceinline__ unsigned pk2h(float lo, float hi) { half2v v = {(_Float16)lo, (_Float16)hi}; return __builtin_bit_cast(unsigned, v); }
__device__ __forceinline__ unsigned cvt_pk_bf16(float lo, float hi) { unsigned r; asm volatile("v_cvt_pk_bf16_f32 %0, %1, %2" : "=v"(r) : "v"(lo), "v"(hi)); return r; }
__device__ __forceinline__ float bflo(unsigned w) { return __builtin_bit_cast(float, w << 16); }
__device__ __forceinline__ float bfhi(unsigned w) { return __builtin_bit_cast(float, w & 0xffff0000u); }
typedef long long i64x2 __attribute__((ext_vector_type(2)));
typedef GAS long long gi64;
__device__ __forceinline__ f32x4 mod4(const gi64* MODQ, int idx) {
    const i64x2 a = *(const GAS i64x2*)(MODQ + idx), b = *(const GAS i64x2*)(MODQ + idx + 2);
    return (f32x4){(float)a.x, (float)a.y, (float)b.x, (float)b.y} * 0x1p-36f;
}
__device__ __forceinline__ float rdl(float v, int lane) { return __builtin_bit_cast(float, __builtin_amdgcn_readlane(__builtin_bit_cast(int, v), lane)); }
__device__ __forceinline__ float wave_sum(float v) {
#pragma unroll
    for (int o = 1; o < 64; o <<= 1) v += __shfl_xor(v, o);
    return v;
}

namespace pg8 {
constexpr int BM = 256, BK = 64, HALF = 128, HTB = HALF * BK * 2, STAGE_BYTES = 8 * HTB;
__host__ __device__ __forceinline__ int lds_byte(int r, int c) { const int st = (r >> 4) * 2 + (c >> 5), rr = r & 15, cc = c & 31, ob = rr * 64 + cc * 2; return st * 1024 + (ob ^ (((ob >> 9) & 1) << 5)); }
__host__ __device__ __forceinline__ void stage_rc(int b, int& R, int& C) { const int st = b / 1024, sb = b % 1024, swz = sb ^ (((sb >> 9) & 1) << 5); R = (st >> 1) * 16 + swz / 64; C = (st & 1) * 32 + (swz % 64) / 2; }
__host__ __device__ __forceinline__ int perm32(int rho) { const int n = rho >> 4, i = rho & 15; return 8 * (i >> 2) + 4 * n + (i & 3); }

struct GUnit { int pm, pn, e, j, nvalid; const char* B; };

typedef int v8i __attribute__((ext_vector_type(8)));
typedef int v4i __attribute__((ext_vector_type(4)));
template <int DT> __device__ __forceinline__ f32x4 mma_tile(const v8i a, const v8i b, f32x4 c, int scA) {
    if constexpr (DT == 2) return __builtin_amdgcn_mfma_scale_f32_16x16x128_f8f6f4(a, b, c, 0, 0, 0, scA, 1, scA);
    else { const v4i a0 = __builtin_shufflevector(a, a, 0, 1, 2, 3), a1 = __builtin_shufflevector(a, a, 4, 5, 6, 7), b0 = __builtin_shufflevector(b, b, 0, 1, 2, 3), b1 = __builtin_shufflevector(b, b, 4, 5, 6, 7);
        if constexpr (DT == 1) { c = __builtin_amdgcn_mfma_f32_16x16x32_f16(__builtin_bit_cast(half8, a0), __builtin_bit_cast(half8, b0), c, 0, 0, 0); return __builtin_amdgcn_mfma_f32_16x16x32_f16(__builtin_bit_cast(half8, a1), __builtin_bit_cast(half8, b1), c, 0, 0, 0); }
        else { c = __builtin_amdgcn_mfma_f32_16x16x32_bf16(__builtin_bit_cast(bf16x8, a0), __builtin_bit_cast(bf16x8, b0), c, 0, 0, 0); return __builtin_amdgcn_mfma_f32_16x16x32_bf16(__builtin_bit_cast(bf16x8, a1), __builtin_bit_cast(bf16x8, b1), c, 0, 0, 0); } }
}

template <class Epi, class Sched, int DT, bool ALIGN_EPI>
__device__ __forceinline__ void gemm_phase(LAS unsigned char* lds, const char* Abase, const int K, const Sched& S, const Epi& E, const int scB = SC_ONE) {
    const int tid = threadIdx.x, wid = __builtin_amdgcn_readfirstlane(tid >> 6), lane = tid & 63, wr = wid >> 2, wc = wid & 3, fr = lane & 15, fq = lane >> 4;
    constexpr int ES = (DT == 2) ? 1 : 2;
    const int RB = K * ES;
    const int nt = RB / 128;
    unsigned voffB0; { int R, C; stage_rc(tid * 16, R, C); const int Rb = Epi::PERM ? ((R & ~31) + perm32(R & 31)) : R; voffB0 = (unsigned)(Rb * RB + C * 2); }
    const unsigned voffBd = 64u * (unsigned)RB;
#define PG8_AOFF(V, UNIT) do { int t_ = threadIdx.x; asm volatile("" : "+v"(t_)); _Pragma("unroll") for (int _i = 0; _i < 2; ++_i) { int R_, C_; stage_rc(t_ * 16 + _i * 8192, R_, C_); \
        _Pragma("unroll") for (int _h = 0; _h < 2; ++_h) (V)[_h][_i] = (unsigned)S.arow(UNIT, R_ + HALF * _h) * (unsigned)RB + (unsigned)(C_ * 2); } } while (0)
    const size_t kstep = (size_t)(BK * 2);
    const size_t hstep = (size_t)HALF * RB;
    const unsigned ldsw = (unsigned)wid * 1024u;
    const int ac0 = (DT == 2) ? 16 * fq : 8 * fq; constexpr int CH1 = (DT == 2) ? 16 : 1024;
    const int aoff = lds_byte(wr * 64 + fr, ac0), boff = lds_byte(wc * 32 + fr, ac0);
#define PG8_SA(b, h) (((b) * 2 + (h)) * HTB)
#define PG8_SB(b, h) ((4 + (b) * 2 + (h)) * HTB)
#define PG8_STAGEB(bufoff, gbase) do { _Pragma("unroll") for (int _i = 0; _i < 2; ++_i) \
        __builtin_amdgcn_global_load_lds((const unsigned*)((const char*)(gbase) + voffB0 + _i * voffBd), (LAS unsigned*)(lds + (bufoff) + ldsw + _i * 8192), 16, 0, 0); } while (0)
#define PG8_STAGEA(bufoff, koff, V, h) do { _Pragma("unroll") for (int _i = 0; _i < 2; ++_i) \
        __builtin_amdgcn_global_load_lds((const unsigned*)(Abase + (size_t)(V)[h][_i] + (koff)), (LAS unsigned*)(lds + (bufoff) + ldsw + _i * 8192), 16, 0, 0); } while (0)
#define PG8_LDA(dst, b, h) do { _Pragma("unroll") for (int m = 0; m < 4; ++m) { const v4i c0_ = *(const LAS v4i*)(lds + PG8_SA(b, h) + aoff + m * 2048), c1_ = *(const LAS v4i*)(lds + PG8_SA(b, h) + aoff + m * 2048 + CH1); dst[m] = __builtin_shufflevector(c0_, c1_, 0, 1, 2, 3, 4, 5, 6, 7); } } while (0)
#define PG8_LDB(dst, b, h) do { _Pragma("unroll") for (int n = 0; n < 2; ++n) { const v4i c0_ = *(const LAS v4i*)(lds + PG8_SB(b, h) + boff + n * 2048), c1_ = *(const LAS v4i*)(lds + PG8_SB(b, h) + boff + n * 2048 + CH1); dst[n] = __builtin_shufflevector(c0_, c1_, 0, 1, 2, 3, 4, 5, 6, 7); } } while (0)
#define PG8_MMA(ai, bj, At, Bt) do { __builtin_amdgcn_s_setprio(1); _Pragma("unroll") for (int m = 0; m < 4; ++m) _Pragma("unroll") for (int n = 0; n < 2; ++n) \
        acc[ai][bj][m][n] = mma_tile<DT>(Bt[n], At[m], acc[ai][bj][m][n], scB); __builtin_amdgcn_s_setprio(0); } while (0)
#define PG8_WAIT_V(n) asm volatile("s_waitcnt vmcnt(" #n ")" ::: "memory")
#define PG8_WAIT_VE(pe) do { if (pe) asm volatile("s_waitcnt vmcnt(%0)" :: "n"(8 + Epi::NSTORE) : "memory"); else asm volatile("s_waitcnt vmcnt(8)" ::: "memory"); } while (0)
#define PG8_WAIT_L(n) asm volatile("s_waitcnt lgkmcnt(" #n ")" ::: "memory")
#define PG8_BAR __builtin_amdgcn_s_barrier()
#define PG8_SCHED __builtin_amdgcn_sched_barrier(0)
    GUnit cur, nxt; int ui = 0;
    if (!S.next(0, cur)) return;
    f32x4 acc[2][2][4][2];
#pragma unroll
    for (int a = 0; a < 2; ++a)
#pragma unroll
        for (int b = 0; b < 2; ++b)
#pragma unroll
            for (int m = 0; m < 4; ++m)
#pragma unroll
                for (int n = 0; n < 2; ++n) acc[a][b][m][n] = (f32x4){0.f, 0.f, 0.f, 0.f};
    v8i At[4], B0[2], B1[2];
    unsigned vA[2][2];
    PG8_AOFF(vA, cur);
    if constexpr (Sched::GATHER) VM_WAIT();
    const char* cB = cur.B;
    E.pre(lds, cur, 0, wid, lane);
    PG8_STAGEB(PG8_SB(0, 0), cB); PG8_STAGEB(PG8_SB(0, 1), cB + hstep); PG8_STAGEA(PG8_SA(0, 0), 0, vA, 0); PG8_STAGEA(PG8_SA(0, 1), 0, vA, 1);
    if (wr == 1) PG8_BAR;
    PG8_WAIT_V(2); PG8_BAR;
    PG8_STAGEB(PG8_SB(1, 0), cB + kstep); PG8_STAGEA(PG8_SA(1, 0), kstep, vA, 0); PG8_STAGEB(PG8_SB(1, 1), cB + hstep + kstep);
    PG8_WAIT_V(6); PG8_BAR;
    for (;;) {
        const bool has_next = S.next(ui + 1, nxt);
#pragma unroll 1
        for (int t = 0; t < nt; t += 2) {
            const bool last = (t == nt - 2);
            const bool pe = POSTEPI_WAITS && (t == 0) && (ui > 0);
            const size_t k1 = (size_t)(t + 1) * kstep;
            PG8_LDB(B0, 0, 0); PG8_LDB(B1, 0, 1); PG8_SCHED; PG8_LDA(At, 0, 0); PG8_STAGEA(PG8_SA(1, 1), k1, vA, 1);
            PG8_WAIT_VE(pe); PG8_WAIT_L(0); PG8_BAR; PG8_MMA(0, 0, At, B0); PG8_MMA(0, 1, At, B1); PG8_BAR; PG8_SCHED;
            size_t k2 = (size_t)(t + 2) * kstep;
            if (last) { k2 = 0; if (has_next) { PG8_AOFF(vA, nxt); if constexpr (Sched::GATHER) VM_WAIT(); cB = nxt.B; } }
            const size_t k3 = k2 + kstep; const char* b2 = cB + k2; const char* b3 = b2 + kstep;
            PG8_LDA(At, 0, 1); PG8_STAGEB(PG8_SB(0, 0), b2); PG8_STAGEB(PG8_SB(0, 1), b2 + hstep); PG8_STAGEA(PG8_SA(0, 0), k2, vA, 0);
            PG8_WAIT_VE(pe); PG8_WAIT_L(0); PG8_BAR; PG8_MMA(1, 0, At, B0); PG8_MMA(1, 1, At, B1); PG8_BAR; PG8_SCHED;
            PG8_LDB(B0, 1, 0); PG8_LDB(B1, 1, 1); PG8_SCHED; PG8_LDA(At, 1, 0); PG8_STAGEA(PG8_SA(0, 1), k2, vA, 1);
            PG8_WAIT_V(8); PG8_WAIT_L(0); PG8_BAR; PG8_MMA(0, 0, At, B0); PG8_MMA(0, 1, At, B1); PG8_BAR; PG8_SCHED;
            PG8_LDA(At, 1, 1); PG8_STAGEB(PG8_SB(1, 0), b3); PG8_STAGEB(PG8_SB(1, 1), b3 + hstep); PG8_STAGEA(PG8_SA(1, 0), k3, vA, 0);
            PG8_WAIT_V(8); PG8_WAIT_L(0); PG8_BAR; PG8_MMA(1, 0, At, B0); PG8_MMA(1, 1, At, B1); PG8_BAR; PG8_SCHED;
        }
        if constexpr (ALIGN_EPI) { if (wr == 0) PG8_BAR; }
        { int tx = threadIdx.x; asm volatile("" : "+v"(tx)); E(acc, cur, wr, wc, tx & 15, (tx >> 4) & 3, lds, ui); }
        if (!has_next) break;
#pragma unroll
        for (int a = 0; a < 2; ++a)
#pragma unroll
            for (int b = 0; b < 2; ++b)
#pragma unroll
                for (int m = 0; m < 4; ++m)
#pragma unroll
                    for (int n = 0; n < 2; ++n) acc[a][b][m][n] = (f32x4){0.f, 0.f, 0.f, 0.f};
        cur = nxt; ++ui;
        if constexpr (ALIGN_EPI) { if (wr == 1) PG8_BAR; }
        E.pre(lds, cur, ui, wid, lane);
    }
    PG8_WAIT_V(0);
    if constexpr (!ALIGN_EPI) { if (wr == 0) PG8_BAR; }
    PG8_BAR;
#undef PG8_SA
#undef PG8_SB
#undef PG8_STAGEA
#undef PG8_AOFF
#undef PG8_STAGEB
#undef PG8_LDA
#undef PG8_LDB
#undef PG8_MMA
#undef PG8_WAIT_V
#undef PG8_WAIT_VE
#undef PG8_WAIT_L
#undef PG8_BAR
#undef PG8_SCHED
}
}

namespace attn_body {
using bf16 = __hip_bfloat16;
using s16x4 = __attribute__((ext_vector_type(4))) short;
using f32x16 = __attribute__((ext_vector_type(16))) float;
constexpr int D = 64, DMQ = QW, DMKV = KVW, DMO = DM;
constexpr int NW = 8, QBLK = 32, QB = QBLK * NW, KVBLK = 64, NT = LKV / KVBLK;
static_assert(NT % 2 == 0 && NT >= 8, "tile count");
__device__ __forceinline__ int crow(int r, int hi) { return (r & 3) + 8 * (r >> 2) + 4 * hi; }
#define SBAR() __builtin_amdgcn_sched_barrier(0)
constexpr int NSLOTR = 3, SLOTB = 8192;
constexpr int LDS_K = 0, LDS_V = NSLOTR * SLOTB, LDS_WS = 2 * NSLOTR * SLOTB, LDS_OST = LDS_WS + NW * 64 * 4, ATT_LDS_BYTES = LDS_OST + NW * 4096;
__device__ __forceinline__ void glds16(const void* gsrc, unsigned lds_dst) { unsigned keep;
    asm volatile("s_mov_b32 %0, m0\n\ts_mov_b32 m0, %2\n\ts_nop 0\n\tglobal_load_lds_dwordx4 %1, off\n\ts_mov_b32 m0, %0" : "=&s"(keep) : "v"(gsrc), "s"(lds_dst) : "memory"); }
__device__ __forceinline__ float max3f(float a, float b, float c) { float r; asm("v_max3_f32 %0, %1, %2, %3" : "=v"(r) : "v"(a), "v"(b), "v"(c)); return r; }
__device__ __forceinline__ float max2f(float a, float b) { float r; asm("v_max_f32_e32 %0, %1, %2" : "=v"(r) : "v"(a), "v"(b)); return r; }
__device__ __forceinline__ float fadd_s(float a, float b) { float r; asm("v_add_f32_e32 %0, %1, %2" : "=v"(r) : "v"(a), "v"(b)); return r; }
__device__ __forceinline__ float fsub_s(float a, float b) { float r; asm("v_sub_f32_e32 %0, %1, %2" : "=v"(r) : "v"(a), "v"(b)); return r; }
typedef float f32x2_t __attribute__((ext_vector_type(2))); typedef __bf16 bf16x2_t __attribute__((ext_vector_type(2)));
__device__ __forceinline__ unsigned cvtpk_s(float lo, float hi) { f32x2_t v = {lo, hi}; bf16x2_t b = __builtin_convertvector(v, bf16x2_t); return __builtin_bit_cast(unsigned, b); }
#define WAIT_BAR(N) asm volatile("s_waitcnt vmcnt(" #N ") lgkmcnt(0)\n\ts_barrier" ::: "memory")

__device__ __forceinline__ void qkt(f32x16& p0, f32x16& p1, const char* Kslot, const bf16x8* qr, const f32x16& negm, int r32, int hi) {
    const char* kb = Kslot + hi * 1024 + r32 * 16;
#pragma unroll
    for (int d0 = 0; d0 < 4; ++d0) {
        const bf16x8 b0 = *reinterpret_cast<const bf16x8*>(kb + d0 * 2048);
        const bf16x8 b1 = *reinterpret_cast<const bf16x8*>(kb + d0 * 2048 + 512);
        if (d0 == 0) { p0 = __builtin_amdgcn_mfma_f32_32x32x16_bf16(b0, qr[0], negm, 0, 0, 0); p1 = __builtin_amdgcn_mfma_f32_32x32x16_bf16(b1, qr[0], negm, 0, 0, 0); }
        else { p0 = __builtin_amdgcn_mfma_f32_32x32x16_bf16(b0, qr[d0], p0, 0, 0, 0); p1 = __builtin_amdgcn_mfma_f32_32x32x16_bf16(b1, qr[d0], p1, 0, 0, 0); } }
}
typedef __attribute__((address_space(3))) const char* lds_cptr;
typedef short v4i16_t __attribute__((ext_vector_type(4)));
__device__ __forceinline__ void kload8(bf16x8* kf, lds_cptr kp) {
    kf[0] = *(const __attribute__((address_space(3))) bf16x8*)(kp);        kf[1] = *(const __attribute__((address_space(3))) bf16x8*)(kp + 512);
    kf[2] = *(const __attribute__((address_space(3))) bf16x8*)(kp + 2048); kf[3] = *(const __attribute__((address_space(3))) bf16x8*)(kp + 2560);
    kf[4] = *(const __attribute__((address_space(3))) bf16x8*)(kp + 4096); kf[5] = *(const __attribute__((address_space(3))) bf16x8*)(kp + 4608);
    kf[6] = *(const __attribute__((address_space(3))) bf16x8*)(kp + 6144); kf[7] = *(const __attribute__((address_space(3))) bf16x8*)(kp + 6656);
}
__device__ __forceinline__ void kload2(bf16x8* kf, lds_cptr kp, int j) { kf[2 * j] = *(const __attribute__((address_space(3))) bf16x8*)(kp + j * 2048); kf[2 * j + 1] = *(const __attribute__((address_space(3))) bf16x8*)(kp + j * 2048 + 512); }
__device__ __forceinline__ s16x4 vtr(lds_cptr p) { return __builtin_bit_cast(s16x4, __builtin_amdgcn_ds_read_tr16_b64_v4i16((__attribute__((address_space(3))) v4i16_t*)p)); }
__device__ __forceinline__ float rowmax(const f32x16& p0, const f32x16& p1) {
    float a = max3f(p0[0], p0[1], p1[0]), b = max3f(p0[2], p0[3], p1[1]); a = max3f(a, p1[2], p1[3]);
#pragma unroll
    for (int r = 4; r < 16; r += 4) { a = max3f(a, p0[r], p0[r + 1]); b = max3f(b, p0[r + 2], p0[r + 3]); a = max3f(a, p1[r], p1[r + 1]); b = max3f(b, p1[r + 2], p1[r + 3]); }
    const float m = max2f(a, b);
    auto rr = __builtin_amdgcn_permlane32_swap(__float_as_uint(m), __float_as_uint(m), false, false);
    return max2f(__uint_as_float(rr[0]), __uint_as_float(rr[1]));
}
__device__ __forceinline__ void pv(f32x16* o, int vb, bf16x8 pa0, bf16x8 pa1, bf16x8 pa2, bf16x8 pa3) {
#pragma unroll
    for (int d0 = 0; d0 < 2; ++d0) { s16x4 lo[4], hi[4];
#pragma unroll
        for (int ks = 0; ks < 4; ++ks) {
            asm volatile("ds_read_b64_tr_b16 %0,%1 offset:%c2" : "=&v"(lo[ks]) : "v"(vb), "i"(d0 * 4096 + ks * 1024) : "memory");
            asm volatile("ds_read_b64_tr_b16 %0,%1 offset:%c2" : "=&v"(hi[ks]) : "v"(vb), "i"(d0 * 4096 + ks * 1024 + 512) : "memory"); }
        asm volatile("s_waitcnt lgkmcnt(0)" ::: "memory"); SBAR();
#define PK(k) (bf16x8){lo[k][0], lo[k][1], lo[k][2], lo[k][3], hi[k][0], hi[k][1], hi[k][2], hi[k][3]}
        o[d0] = __builtin_amdgcn_mfma_f32_32x32x16_bf16(pa0, PK(0), o[d0], 0, 0, 0);
        o[d0] = __builtin_amdgcn_mfma_f32_32x32x16_bf16(pa1, PK(1), o[d0], 0, 0, 0);
        o[d0] = __builtin_amdgcn_mfma_f32_32x32x16_bf16(pa2, PK(2), o[d0], 0, 0, 0);
        o[d0] = __builtin_amdgcn_mfma_f32_32x32x16_bf16(pa3, PK(3), o[d0], 0, 0, 0);
#undef PK
    }
}
template <bool MS> __device__ __forceinline__ void attn_unit(int b, int h, int qb, const bf16* Q, const bf16* __restrict__ K, const bf16* __restrict__ V, bf16* O, char* shm, float negM_) {
    const int tid = threadIdx.x, lane = tid & 63, r32 = lane & 31, hi = lane >> 5; const int wid = __builtin_amdgcn_readfirstlane(tid >> 6);
    const int q0 = qb * QB; const int kvh = h / 3;
    const long qrow0 = (long)b * SEQ + q0 + wid * QBLK;
    const long kvrow0 = (long)b * LKV;
    const bf16* Qw = Q + qrow0 * DMQ + h * D;
    const bf16* Kh = K + kvrow0 * DMKV + kvh * D, *Vh = V + kvrow0 * DMKV + kvh * D;
    const unsigned lds0 = (unsigned)(uintptr_t)shm;
    float* wsf = (float*)(shm + LDS_WS) + wid * 64;
    const bf16* ksrc = Kh + (long)lane * DMKV + wid * 8;
    const bf16* vsrc = Vh + (long)(16 * (wid & 3) + (lane >> 2)) * DMKV + (wid >> 2) * 32 + (lane & 3) * 8;
    const unsigned kdst = lds0 + LDS_K + wid * 1024, vdst = lds0 + LDS_V + wid * 1024;
#define DMA_K(t, slot) glds16(ksrc + (long)(t) * KVBLK * DMKV, (unsigned)__builtin_amdgcn_readfirstlane(kdst + (slot)))
#define DMA_V(t, slot) glds16(vsrc + (long)(t) * KVBLK * DMKV, (unsigned)__builtin_amdgcn_readfirstlane(vdst + (slot)))
    const int vb0 = (int)(lds0 + LDS_V) + ((lane >> 4) & 1) * 32 + (lane & 3) * 8 + (4 * hi + ((lane & 15) >> 2)) * 64;
    const char* Kbase = shm + LDS_K; bf16x8 kf[8];
    const lds_cptr shm3 = (lds_cptr)shm; const lds_cptr kp0 = shm3 + LDS_K + hi * 1024 + r32 * 16; const lds_cptr vp0 = shm3 + LDS_V + ((lane >> 4) & 1) * 32 + (lane & 3) * 8 + (4 * hi + ((lane & 15) >> 2)) * 64;
    DMA_K(0, 0); DMA_V(0, 0); DMA_K(1, SLOTB);
    bf16x8 qr[4];
#pragma unroll
    for (int d0 = 0; d0 < 4; ++d0) qr[d0] = *reinterpret_cast<const bf16x8*>(&Qw[(long)r32 * DMQ + d0 * 16 + hi * 8]);
    float l_reg = 0.f; f32x16 o[2]; o[0] = f32x16{}; o[1] = f32x16{}; f32x16 negm = f32x16{}; f32x16 lacc = f32x16{};
    if constexpr (!MS) { _Pragma("unroll") for (int r = 0; r < 16; ++r) negm[r] = negM_; asm volatile("" : "+v"(negm)); }
    const bf16x8 ONES = (bf16x8){0x3F80, 0x3F80, 0x3F80, 0x3F80, 0x3F80, 0x3F80, 0x3F80, 0x3F80};
#define START(P0, P1) do { _Pragma("unroll") for (int r = 0; r < 16; ++r) P0[r] = __builtin_amdgcn_exp2f(P0[r]); } while (0)
#define RESC() do { } while (0)
    f32x16 pA0, pA1, pB0, pB1;
    int sl_prev = 0, sl_cur = 0, sl_next = SLOTB;
#define ROT() do { sl_prev = sl_cur; sl_cur = sl_next; sl_next = (sl_next == (NSLOTR - 1) * SLOTB) ? 0 : sl_next + SLOTB; } while (0)
    DMA_K(2, 2 * SLOTB);
    WAIT_BAR(3);
    qkt(pA0, pA1, Kbase, qr, negm, r32, hi); asm volatile("s_nop 15\n\ts_nop 7" : "+v"(pA0), "+v"(pA1));
    START(pA0, pA1);
    _Pragma("unroll") for (int r = 0; r < 16; ++r) pA1[r] = __builtin_amdgcn_exp2f(pA1[r]);
    WAIT_BAR(0);
    DMA_K(3, 0); DMA_V(1, SLOTB);
    ROT();
    kload8(kf, kp0 + sl_cur);
    WAIT_BAR(2);
    s16x4 vlo[8], vhi[8]; u32x4 pw0, pw1, pw2, pw3;
#define PKW(P, B) cvtpk_s(P[B], P[B + 1])
#define PAF(k) __builtin_bit_cast(bf16x8, pw##k)
#define VFR(i) (bf16x8){vlo[i][0], vlo[i][1], vlo[i][2], vlo[i][3], vhi[i][0], vhi[i][1], vhi[i][2], vhi[i][3]}
#define PIN(x) asm volatile("" : "+v"(x))
#define MX3(a, b, c) __builtin_fmaxf(__builtin_fmaxf((a), (b)), (c))
#define GAPA(MF, A0, A1, A2, A3, W0, W1, PW) do { MF; if constexpr (!MS) { sacc += A0; sacc += A1; sacc += A2; sacc += A3; PIN(sacc); } W0; W1; PIN(PW); SBAR(); } while (0)
#define LSUM(k) do { if constexpr (MS) lacc = __builtin_amdgcn_mfma_f32_32x32x16_bf16(PAF(k), ONES, lacc, 0, 0, 0); } while (0)
#define EX(v) __builtin_amdgcn_exp2f(v)
#define GAPB(MF, X, B) do { MF; X[B] = EX(X[B]); X[B + 1] = EX(X[B + 1]); X[B + 2] = EX(X[B + 2]); X[B + 3] = EX(X[B + 3]); PIN(X); SBAR(); } while (0)
#define VRD(i) do { vlo[i] = vtr(vp_ + (((i) >> 2) * 4096 + ((i) & 3) * 1024)); vhi[i] = vtr(vp_ + (((i) >> 2) * 4096 + ((i) & 3) * 1024 + 512)); } while (0)
#define KRD(G, j) do { if (G) { kload2(kf, kp0 + sl_next, j); SBAR(); } } while (0)
#define STEP(C0, C1, P0, P1, t, GK, GV, GL) do { SBAR(); \
    const lds_cptr vp_ = vp0 + sl_prev; \
    VRD(0); SBAR(); float sacc = MS ? 0.f : (P0[0] + P0[1]); \
    GAPA(C0 = __builtin_amdgcn_mfma_f32_32x32x16_bf16(kf[0], qr[0], negm, 0, 0, 0), P0[2], P0[3], P0[4], P0[5],     pw0[0] = PKW(P0, 0), pw0[1] = PKW(P0, 2), pw0); \
    VRD(4); SBAR(); GAPA(C1 = __builtin_amdgcn_mfma_f32_32x32x16_bf16(kf[1], qr[0], negm, 0, 0, 0), P0[6], P0[7], P0[8], P0[9],     pw0[2] = PKW(P0, 4), pw0[3] = PKW(P0, 6), pw0); \
    VRD(1); SBAR(); GAPA(C0 = __builtin_amdgcn_mfma_f32_32x32x16_bf16(kf[2], qr[1], C0, 0, 0, 0),   P0[10], P0[11], P0[12], P0[13], pw1[0] = PKW(P0, 8), pw1[1] = PKW(P0, 10), pw1); \
    VRD(5); SBAR(); GAPA(C1 = __builtin_amdgcn_mfma_f32_32x32x16_bf16(kf[3], qr[1], C1, 0, 0, 0),   P0[14], P0[15], P1[0], P1[1],   pw1[2] = PKW(P0, 12), pw1[3] = PKW(P0, 14), pw1); \
    VRD(2); SBAR(); GAPA(C0 = __builtin_amdgcn_mfma_f32_32x32x16_bf16(kf[4], qr[2], C0, 0, 0, 0),   P1[2], P1[3], P1[4], P1[5],     pw2[0] = PKW(P1, 0), pw2[1] = PKW(P1, 2), pw2); \
    VRD(6); SBAR(); GAPA(C1 = __builtin_amdgcn_mfma_f32_32x32x16_bf16(kf[5], qr[2], C1, 0, 0, 0),   P1[6], P1[7], P1[8], P1[9],     pw2[2] = PKW(P1, 4), pw2[3] = PKW(P1, 6), pw2); \
    VRD(3); SBAR(); GAPA(C0 = __builtin_amdgcn_mfma_f32_32x32x16_bf16(kf[6], qr[3], C0, 0, 0, 0),   P1[10], P1[11], P1[12], P1[13], pw3[0] = PKW(P1, 8), pw3[1] = PKW(P1, 10), pw3); \
    VRD(7); SBAR(); GAPA(C1 = __builtin_amdgcn_mfma_f32_32x32x16_bf16(kf[7], qr[3], C1, 0, 0, 0),   P1[14], P1[15], 0.f, 0.f,       pw3[2] = PKW(P1, 12), pw3[3] = PKW(P1, 14), pw3); \
    if constexpr (!MS) l_reg += sacc; \
    if (GK) { DMA_K((t) + 3, sl_cur); } if (GV) { DMA_V((t) + 1, sl_next); } \
    SBAR(); \
    GAPB(o[0] = __builtin_amdgcn_mfma_f32_32x32x16_bf16(PAF(0), VFR(0), o[0], 0, 0, 0), C0, 0); \
    GAPB(o[1] = __builtin_amdgcn_mfma_f32_32x32x16_bf16(PAF(0), VFR(4), o[1], 0, 0, 0), C0, 4); LSUM(0); \
    KRD(GL, 0); GAPB(o[0] = __builtin_amdgcn_mfma_f32_32x32x16_bf16(PAF(1), VFR(1), o[0], 0, 0, 0), C0, 8); \
    KRD(GL, 1); GAPB(o[1] = __builtin_amdgcn_mfma_f32_32x32x16_bf16(PAF(1), VFR(5), o[1], 0, 0, 0), C0, 12); LSUM(1); \
    KRD(GL, 2); GAPB(o[0] = __builtin_amdgcn_mfma_f32_32x32x16_bf16(PAF(2), VFR(2), o[0], 0, 0, 0), C1, 0); \
    KRD(GL, 3); GAPB(o[1] = __builtin_amdgcn_mfma_f32_32x32x16_bf16(PAF(2), VFR(6), o[1], 0, 0, 0), C1, 4); LSUM(2); \
    GAPB(o[0] = __builtin_amdgcn_mfma_f32_32x32x16_bf16(PAF(3), VFR(3), o[0], 0, 0, 0), C1, 8); \
    GAPB(o[1] = __builtin_amdgcn_mfma_f32_32x32x16_bf16(PAF(3), VFR(7), o[1], 0, 0, 0), C1, 12); LSUM(3); \
    } while (0)
    int t = 1;
    for (; t + 5 < NT; t += 2) {
        STEP(pB0, pB1, pA0, pA1, t, true, true, true);     WAIT_BAR(2); RESC(); ROT();
        STEP(pA0, pA1, pB0, pB1, t + 1, true, true, true); WAIT_BAR(2); RESC(); ROT();
    }
#define ENDW(tt) do { if ((tt) + 3 < NT) { WAIT_BAR(2); } else if ((tt) + 2 < NT) { WAIT_BAR(1); } else { WAIT_BAR(0); } } while (0)
    for (; t + 1 < NT; t += 2) {
        STEP(pB0, pB1, pA0, pA1, t, (t + 3 < NT), (t + 1 < NT), (t + 1 < NT));         ENDW(t);     RESC(); ROT();
        STEP(pA0, pA1, pB0, pB1, t + 1, (t + 4 < NT), (t + 2 < NT), (t + 2 < NT));     ENDW(t + 1); RESC(); ROT();
    }
    STEP(pB0, pB1, pA0, pA1, NT - 1, false, false, false); RESC();
    { if constexpr (!MS) { float sacc = pB0[0] + pB0[1]; _Pragma("unroll") for (int r = 2; r < 16; ++r) sacc += pB0[r]; _Pragma("unroll") for (int r = 0; r < 16; ++r) sacc += pB1[r]; l_reg += sacc; }
      pw0 = (u32x4){PKW(pB0, 0), PKW(pB0, 2), PKW(pB0, 4), PKW(pB0, 6)}; pw1 = (u32x4){PKW(pB0, 8), PKW(pB0, 10), PKW(pB0, 12), PKW(pB0, 14)}; pw2 = (u32x4){PKW(pB1, 0), PKW(pB1, 2), PKW(pB1, 4), PKW(pB1, 6)}; pw3 = (u32x4){PKW(pB1, 8), PKW(pB1, 10), PKW(pB1, 12), PKW(pB1, 14)};
      SBAR(); pv(o, vb0 + sl_cur, PAF(0), PAF(1), PAF(2), PAF(3)); LSUM(0); LSUM(1); LSUM(2); LSUM(3); }
#undef LSUM
#undef PKW
#undef PAF
#undef VFR
#undef PIN
#undef MX3
#undef GAPA
#undef GAPB
#undef EX
#undef VRD
#undef KRD
#undef STEP
#undef ENDW
    float rli[16];
    if constexpr (MS) {
#pragma unroll
        for (int r = 0; r < 16; ++r) rli[r] = __builtin_amdgcn_rcpf(lacc[r]);
    } else {
        { auto rr = __builtin_amdgcn_permlane32_swap(__float_as_uint(l_reg), __float_as_uint(l_reg), false, false); l_reg = __uint_as_float(rr[0]) + __uint_as_float(rr[1]); }
        if (hi == 0) wsf[32 + r32] = l_reg; asm volatile("s_waitcnt lgkmcnt(0)" ::: "memory");
#pragma unroll
        for (int r = 0; r < 16; ++r) rli[r] = __builtin_amdgcn_rcpf(wsf[32 + crow(r, hi)]);
    }
    bf16* Ow = O + qrow0 * DMO + h * D;
    { bf16* stg = (bf16*)(shm + LDS_OST) + wid * 2048;
#pragma unroll
      for (int r = 0; r < 16; ++r) { const int orow = crow(r, hi);
#pragma unroll
        for (int d0 = 0; d0 < 2; ++d0) stg[orow * 64 + d0 * 32 + r32] = __float2bfloat16(o[d0][r] * rli[r]); }
      asm volatile("s_waitcnt lgkmcnt(0)" ::: "memory");
#pragma unroll
      for (int i = 0; i < 4; ++i) { const int row = i * 8 + (lane >> 3), ch = lane & 7; const u32x4 v = *(const u32x4*)(stg + row * 64 + ch * 8); *(u32x4*)(Ow + (long)row * DMO + ch * 8) = v; } }
    asm volatile("s_waitcnt lgkmcnt(0)\n\ts_barrier" ::: "memory");
#undef DMA_K
#undef DMA_V
#undef START
#undef RESC
#undef ROT
}
#undef SBAR
#undef WAIT_BAR

typedef int v8i_t __attribute__((ext_vector_type(8)));
typedef int v4i_t __attribute__((ext_vector_type(4)));
__host__ __device__ __forceinline__ int vt_slot(int k) { const int hi = (k >> 2) & 1, r = (k & 3) + 4 * ((k & 31) >> 3); return 32 * hi + r + 16 * (k >> 5); }
constexpr int SLOT8 = 4096, NS8 = 6, L8_K = 0, L8_V = NS8 * SLOT8;
static_assert(L8_V + NS8 * SLOT8 <= LDS_WS, "fp8 rings below the per-wave scratch");
constexpr int SC_QK = 0x7c7f, SC_PV = 0x7f7f;
__device__ __forceinline__ v8i_t ld32(lds_cptr p, int o0, int o1) { const v4i_t a = *(const __attribute__((address_space(3))) v4i_t*)(p + o0), b = *(const __attribute__((address_space(3))) v4i_t*)(p + o1); return __builtin_shufflevector(a, b, 0, 1, 2, 3, 4, 5, 6, 7); }
#define SBAR() __builtin_amdgcn_sched_barrier(0)
#define WAIT_BAR(N) asm volatile("s_waitcnt vmcnt(" #N ") lgkmcnt(0)\n\ts_barrier" ::: "memory")
__device__ __forceinline__ void attn_unit8(int b, int h, int qb, const unsigned char* Q8, const unsigned char* K8, const unsigned char* Vt8, bf16* O, char* shm, float negM_) {
    const int tid = threadIdx.x, lane = tid & 63, r32 = lane & 31, hi = lane >> 5; const int wid = __builtin_amdgcn_readfirstlane(tid >> 6);
    const int q0 = qb * QB; const int kvh = h / 3; const bool kw = wid < 4;
    const long qrow0 = (long)b * SEQ + q0 + wid * QBLK;
    const unsigned lds0 = (unsigned)(uintptr_t)shm;
    const int drow = 16 * (wid & 3) + (lane >> 2), dch = (lane & 3) ^ ((drow >> 2) & 3);
    const unsigned char* ksrc = K8 + ((long)b * LKV + drow) * DMKV + kvh * D + dch * 16;
    const unsigned char* vsrc = Vt8 + ((long)(b * NKVH + kvh) * (LKV / 64)) * 4096 + drow * 64 + dch * 16;
    const unsigned kdst = lds0 + L8_K + (wid & 3) * 1024, vdst = lds0 + L8_V + (wid & 3) * 1024;
#define DMA8_K(t, slot) glds16(ksrc + (long)(t) * KVBLK * DMKV, (unsigned)__builtin_amdgcn_readfirstlane(kdst + (slot)))
#define DMA8_V(t, slot) glds16(vsrc + (long)(t) * 4096, (unsigned)__builtin_amdgcn_readfirstlane(vdst + (slot)))
    const lds_cptr shm3 = (lds_cptr)shm; const int sw = (r32 >> 2) & 3, c0o = ((2 * hi) ^ sw) * 16, c1o = ((2 * hi + 1) ^ sw) * 16;
    const lds_cptr kp0 = shm3 + L8_K + r32 * 64; const lds_cptr vp0 = shm3 + L8_V + r32 * 64;
    if (kw) { DMA8_K(0, 0); DMA8_K(1, SLOT8); DMA8_K(2, 2 * SLOT8); DMA8_K(3, 3 * SLOT8); DMA8_K(4, 4 * SLOT8); } else { DMA8_V(0, 0); DMA8_V(1, SLOT8); DMA8_V(2, 2 * SLOT8); }
    const v8i_t qr = *reinterpret_cast<const v8i_t*>(Q8 + (qrow0 + r32) * DMQ + h * D + hi * 32);
    f32x16 o[2]; o[0] = f32x16{}; o[1] = f32x16{}; f32x16 negm; f32x16 lacc = f32x16{};
    _Pragma("unroll") for (int r = 0; r < 16; ++r) negm[r] = negM_;
    asm volatile("" : "+v"(negm));
    const v8i_t ONES8 = (v8i_t){0x38383838, 0x38383838, 0x38383838, 0x38383838, 0x38383838, 0x38383838, 0x38383838, 0x38383838};
    f32x16 c0, c1; v8i_t kf[2], vf[2], pw;
    int s0 = 0, s1 = SLOT8, s2 = 2 * SLOT8, s3 = 3 * SLOT8, s5 = 5 * SLOT8;
#define NXT8(x) (((x) == (NS8 - 1) * SLOT8) ? 0 : (x) + SLOT8)
#define ROT8() do { s0 = s1; s1 = s2; s2 = s3; s3 = NXT8(s3); s5 = NXT8(s5); } while (0)
#define QK8() do { c0 = __builtin_amdgcn_mfma_scale_f32_32x32x64_f8f6f4(kf[0], qr, negm, 0, 0, 0, SC_QK, 1, SC_QK); c1 = __builtin_amdgcn_mfma_scale_f32_32x32x64_f8f6f4(kf[1], qr, negm, 0, 0, 0, SC_QK, 1, SC_QK); } while (0)
#define PK8(P, B) __builtin_amdgcn_cvt_pk_fp8_f32(P[B + 2], P[B + 3], __builtin_amdgcn_cvt_pk_fp8_f32(P[B], P[B + 1], 0, false), true)
#define PV8() do { o[0] = __builtin_amdgcn_mfma_scale_f32_32x32x64_f8f6f4(pw, vf[0], o[0], 0, 0, 0, SC_PV, 1, SC_PV); o[1] = __builtin_amdgcn_mfma_scale_f32_32x32x64_f8f6f4(pw, vf[1], o[1], 0, 0, 0, SC_PV, 1, SC_PV); \
        lacc = __builtin_amdgcn_mfma_scale_f32_32x32x64_f8f6f4(pw, ONES8, lacc, 0, 0, 0, SC_PV, 1, SC_PV); } while (0)
#define EXPK8() do { _Pragma("unroll") for (int r = 0; r < 16; ++r) { c0[r] = __builtin_amdgcn_exp2f(c0[r]); c1[r] = __builtin_amdgcn_exp2f(c1[r]); } \
        pw[0] = PK8(c0, 0); pw[1] = PK8(c0, 4); pw[2] = PK8(c0, 8); pw[3] = PK8(c0, 12); pw[4] = PK8(c1, 0); pw[5] = PK8(c1, 4); pw[6] = PK8(c1, 8); pw[7] = PK8(c1, 12); } while (0)
    WAIT_BAR(0);
    kf[0] = ld32(kp0, c0o, c1o); kf[1] = ld32(kp0 + 2048, c0o, c1o);
    QK8(); EXPK8();
    kf[0] = ld32(kp0 + SLOT8, c0o, c1o); kf[1] = ld32(kp0 + SLOT8 + 2048, c0o, c1o);
    WAIT_BAR(0);
#define SUB8(t, GK, GV, GL) do { SBAR(); \
    vf[0] = ld32(vp0 + s0, c0o, c1o); vf[1] = ld32(vp0 + s0 + 2048, c0o, c1o); \
    QK8(); PV8(); \
    if (kw) { if (GK) { DMA8_K((t) + 4, s5); } } else { if (GV) { DMA8_V((t) + 2, s3); } } \
    if (GL) { kf[0] = ld32(kp0 + s2, c0o, c1o); kf[1] = ld32(kp0 + s2 + 2048, c0o, c1o); } \
    EXPK8(); ROT8(); \
    } while (0)
    int t = 1;
#pragma unroll 1
    for (; t + 5 < NT; t += 2) { SUB8(t, true, true, true); SUB8(t + 1, true, true, true); WAIT_BAR(1); }
#pragma unroll 1
    for (; t + 1 < NT; t += 2) {
        SUB8(t, (t + 4 < NT), (t + 2 < NT), (t + 1 < NT)); SUB8(t + 1, (t + 5 < NT), (t + 3 < NT), (t + 2 < NT)); WAIT_BAR(0); }
    SUB8(NT - 1, false, false, false);
    {
        asm volatile("s_waitcnt lgkmcnt(0)" ::: "memory");
        vf[0] = ld32(vp0 + s0, c0o, c1o); vf[1] = ld32(vp0 + s0 + 2048, c0o, c1o);
        PV8(); }
    float rli[16];
#pragma unroll
    for (int r = 0; r < 16; ++r) rli[r] = __builtin_amdgcn_rcpf(lacc[r]);
    bf16* Ow = O + qrow0 * DMO + h * D;
    { bf16* stg = (bf16*)(shm + LDS_OST) + wid * 2048;
#pragma unroll
      for (int r = 0; r < 16; ++r) { const int orow = crow(r, hi);
#pragma unroll
        for (int d0 = 0; d0 < 2; ++d0) stg[orow * 64 + d0 * 32 + r32] = __float2bfloat16(o[d0][r] * rli[r]); }
      asm volatile("s_waitcnt lgkmcnt(0)" ::: "memory");
#pragma unroll
      for (int i = 0; i < 4; ++i) { const int row = i * 8 + (lane >> 3), ch = lane & 7; const u32x4 v = *(const u32x4*)(stg + row * 64 + ch * 8); *(u32x4*)(Ow + (long)row * DMO + ch * 8) = v; } }
    asm volatile("s_waitcnt vmcnt(0) lgkmcnt(0)\n\ts_barrier" ::: "memory");
#undef DMA8_K
#undef DMA8_V
#undef ROT8
#undef QK8
#undef PK8
#undef PV8
#undef EXPK8
#undef SUB8
#undef NXT8
}
#undef SBAR
#undef WAIT_BAR
}

#define XB_TMO      128
#define XB_XCNT(j)  (256  + 64 * (j))
#define XB_XSUB(j)  (1280 + 64 * (j))
#define XB_XGEN(j)  (2304 + 64 * (j))
#define XB_TOP      3328
#define XB_TOPGEN   3392
#define XCD_BAR_WORDS 3456
#define XB_SPIN_CAP (1u << 18)
__device__ __forceinline__ unsigned xb_ld(unsigned* p)              { return __hip_atomic_load(p, __ATOMIC_RELAXED, __HIP_MEMORY_SCOPE_AGENT); }
__device__ __forceinline__ unsigned xb_add(unsigned* p, unsigned v) { return __hip_atomic_fetch_add(p, v, __ATOMIC_RELAXED, __HIP_MEMORY_SCOPE_AGENT); }
__device__ __forceinline__ unsigned xb_xcc_id() { return (unsigned)__builtin_amdgcn_s_getreg((3 << 11) | 20) & 0xFu; }
#define XB_SPIN(cond, bar) do { unsigned _sp = 0; while (cond) { __builtin_amdgcn_s_sleep(1); \
    if ((++_sp & 255u) == 0u) { if (xb_ld(&(bar)[XB_TMO])) break; if (_sp > XB_SPIN_CAP) { atomicAdd(&(bar)[XB_TMO], 1u); break; } } } } while (0)
struct XcdBarrier { unsigned* bar; unsigned x; volatile LAS unsigned* st; };
__device__ __forceinline__ XcdBarrier xcd_barrier_post(unsigned* bar, volatile LAS unsigned* st) {
    XcdBarrier b; b.bar = bar; b.x = xb_xcc_id(); b.st = st;
    if (threadIdx.x == 0) (void)xb_add(&bar[XB_XCNT(b.x)], 1u);
    return b;
}
__device__ __forceinline__ void xcd_barrier_complete(unsigned* bar, unsigned x, unsigned& nloc, unsigned& nx) {
    const unsigned G = gridDim.x * gridDim.y * gridDim.z;
    unsigned sum, cnt, mine, sp = 0u;
    for (;;) {
        sum = 0u; cnt = 0u; mine = 0u;
#pragma unroll
        for (unsigned j = 0; j < 16; ++j) { const unsigned c = xb_ld(&bar[XB_XCNT(j)]); sum += c; cnt += (c > 0u) ? 1u : 0u; mine = (j == x) ? c : mine; }
        if (sum == G) break;
        __builtin_amdgcn_s_sleep(1);
        if ((++sp & 255u) == 0u) { if (xb_ld(&bar[XB_TMO])) break; if (sp > XB_SPIN_CAP) { atomicAdd(&bar[XB_TMO], 1u); break; } }
    }
    nloc = mine > 0u ? mine : 1u; nx = cnt > 0u ? cnt : 1u;
}
__device__ __forceinline__ void xcd_barrier(const XcdBarrier& b) {
    asm volatile("s_waitcnt vmcnt(0)" ::: "memory");
    __syncthreads();
    if (threadIdx.x == 0) {
        unsigned* bar = b.bar;
        __builtin_amdgcn_s_waitcnt(0);
        unsigned nloc = b.st[0], nx = b.st[1];
        if (nloc == 0u) { xcd_barrier_complete(bar, b.x, nloc, nx); b.st[0] = nloc; b.st[1] = nx; }
        const unsigned old = xb_add(&bar[XB_XSUB(b.x)], 1u);
        const unsigned gen = old / nloc;
        if (old + 1u == (gen + 1u) * nloc) {
            __builtin_amdgcn_fence(__ATOMIC_RELEASE, "agent");
            asm volatile("s_waitcnt vmcnt(0)" ::: "memory");
            const unsigned og = xb_add(&bar[XB_TOP], 1u);
            const unsigned tg = og / nx;
            if (og + 1u == (tg + 1u) * nx) xb_add(&bar[XB_TOPGEN], 1u);
            else XB_SPIN(xb_ld(&bar[XB_TOPGEN]) == tg, bar);
            __builtin_amdgcn_fence(__ATOMIC_ACQUIRE, "agent");
            xb_add(&bar[XB_XGEN(b.x)], 1u);
            asm volatile("s_waitcnt vmcnt(0)" ::: "memory");
        } else {
            XB_SPIN(xb_ld(&bar[XB_XGEN(b.x)]) == gen, bar);
            __builtin_amdgcn_fence(__ATOMIC_ACQUIRE, "agent");
            asm volatile("s_waitcnt vmcnt(0)" ::: "memory");
        }
    }
    __syncthreads();
}

struct Frame {
    LAS unsigned char* lds;
    volatile LAS unsigned* MISC;
    gu32* ctl;
    int tid, lane, wave;
    int vcu, G;
    const float* const* ka;
    float* out;
    unsigned char* ws;
};
#define WSP(T, off) ((T*)(F.ws + (off)))
#define FIN_x (F.ka[0])
#define FIN_c (F.ka[1])
#define FIN_ctx (F.ka[2])
#define FIN_c_ctx (F.ka[3])
#define FIN_norm1_g (F.ka[4])
#define FIN_w_ada (F.ka[5])
#define FIN_b_ada (F.ka[6])
#define FIN_w_in (F.ka[7])
#define FIN_w_fourier (F.ka[8])
#define FIN_q_norm_g (F.ka[9])
#define FIN_k_norm_g (F.ka[10])
#define FIN_w_out (F.ka[11])
#define FIN_norm2_g (F.ka[12])
#define FIN_w_router (F.ka[13])
#define FIN_router_bias (F.ka[14])
#define FIN_w_egu (F.ka[15])
#define FIN_w_ed (F.ka[16])
#define FIN_w_sgu (F.ka[17])
#define FIN_w_sd (F.ka[18])
#define FIN_final_g (F.ka[19])

struct DenseOrder {
    static constexpr bool GATHER = false;
    int nN, nmain, nextra, G, c; const char* Bt; int K; int reps;
    __device__ __forceinline__ bool next(int i, pg8::GUnit& u) const {
        const int ntot = nmain + nextra, nc = (ntot - c + G - 1) / G; if (i >= nc * reps) return false;
        const int L = (i % nc) * G + c;
        if (L < nmain) { const int nig = 8 * nN, gid = L / nig, r = L % nig; u.pm = gid * 8 + (r & 7); u.pn = r >> 3; }
        else { const int jx = L - nmain; u.pm = 128 + (jx & 3); u.pn = 5 + (jx >> 2); }
        u.e = 0; u.j = 0; u.nvalid = 256; u.B = Bt + (size_t)u.pn * 256 * K * 2; return true;
    }
    __device__ __forceinline__ int arow(const pg8::GUnit& u, int r) const { return u.pm * 256 + r; }
};
template <bool GATHER_> struct GroupedOrder {
    static constexpr bool GATHER = GATHER_;
    int NPN, G, c, nbrows, K; bool gather; const char* Bt; const LAS int* TS; const LAS int* CN; const GAS u32x2* LIST; int reps; int total;
    __device__ __forceinline__ bool next(int i, pg8::GUnit& u) const {
        const int ntot = total * NPN, nc = (ntot - c + G - 1) / G; if (i >= nc * reps) return false;
        const int L = (i % nc) * G + c; const int T = L / NPN;
        int lo = 0, hi = 257;
        while (hi - lo > 1) { const int mid = (lo + hi) >> 1; if (TS[mid] <= T) lo = mid; else hi = mid; }
        lo = __builtin_amdgcn_readfirstlane(lo);
        const int ts = __builtin_amdgcn_readfirstlane(TS[lo]), cn = __builtin_amdgcn_readfirstlane(CN[lo]);
        u.pm = T; u.pn = L - T * NPN; u.e = lo; u.j = T - ts; const int rem = cn - 256 * u.j; u.nvalid = rem < 256 ? rem : 256;
        u.B = Bt + ((size_t)lo * nbrows + (size_t)u.pn * 256) * K; return true;
    }
    __device__ __forceinline__ int arow(const pg8::GUnit& u, int r) const {
        if (!gather) return u.pm * 256 + r;
        int pos = 256 * u.j + r; if (r >= u.nvalid) pos = 0;
        const u32x2 en = LIST[(size_t)u.e * NTOK + pos];
        return (int)(en.x & 0xffffu);
    }
};

struct EpiInProj {
    static constexpr bool PERM = true; static constexpr int NSTORE = 16;
    __device__ __forceinline__ void pre(LAS unsigned char*, const pg8::GUnit&, int, int, int) const {}
    u16 *Z, *Q, *Kb, *Vb; const float *COS, *SIN, *gq, *gk;
    __device__ __forceinline__ void operator()(const f32x4 (&acc)[2][2][4][2], const pg8::GUnit& u, int wr, int wc, int fr, int fq, LAS unsigned char* lds, int ui) const {
        const int pn = u.pn; const bool is_ctx = u.pm >= 128;
        float gn[2][2][4];
        if (pn >= 2 && pn < 6) { const float* gsrc = (pn == 5) ? gk : gq;
#pragma unroll
            for (int bj = 0; bj < 2; ++bj)
#pragma unroll
                for (int n = 0; n < 2; ++n) { const f32x4 g4 = *(const f32x4*)(gsrc + 32 * bj + 16 * n + 4 * fq); gn[bj][n][0] = g4[0]; gn[bj][n][1] = g4[1]; gn[bj][n][2] = g4[2]; gn[bj][n][3] = g4[3]; } }
#pragma unroll
        for (int ai = 0; ai < 2; ++ai)
#pragma unroll
            for (int m = 0; m < 4; ++m) {
                const int row = u.pm * 256 + ai * 128 + wr * 64 + m * 16 + fr;
                int b, l, key;
                if (!is_ctx) { b = row >> 13; l = row & 8191; key = l; } else { const int rc = row - NTOK; b = rc >> 8; l = 0; key = SEQ + (rc & 255); }
                if (pn < 2) {
#pragma unroll
                    for (int bj = 0; bj < 2; ++bj) { const int g = 32 * pn + 16 * bj + 4 * wc + fq; const f32x4 v0 = acc[ai][bj][m][0], v1 = acc[ai][bj][m][1];
                        u32x4 w; w.x = cvt_pk_bf16(v0[0], v0[1]); w.y = cvt_pk_bf16(v0[2], v0[3]); w.z = cvt_pk_bf16(v1[0], v1[1]); w.w = cvt_pk_bf16(v1[2], v1[3]);
                        *(u32x4*)(Z + (((size_t)(b * 64 + g) * SEQ + l) * 8)) = w; }
                } else if (pn < 6) {
                    float ss = 0.f;
#pragma unroll
                    for (int bj = 0; bj < 2; ++bj)
#pragma unroll
                        for (int n = 0; n < 2; ++n) { const f32x4 v = acc[ai][bj][m][n]; ss += (v[0] * v[0] + v[1] * v[1]) + (v[2] * v[2] + v[3] * v[3]); }
                    ss += __shfl_xor(ss, 16); ss += __shfl_xor(ss, 32);
                    const float rstd = 1.0f / sqrtf(ss * (1.0f / 64.0f) + RMS_EPS);
                    const float osc = (pn == 5) ? 1.0f : C2;
#pragma unroll
                    for (int bj = 0; bj < 2; ++bj) {
                        const int pidx = (bj == 0) ? (l >> 6) : (l & 63);
                        f32x4 cs = *(const f32x4*)(COS + pidx * 16 + 4 * fq), sn = *(const f32x4*)(SIN + pidx * 16 + 4 * fq);
                        if (is_ctx) { cs = (f32x4){1.f, 1.f, 1.f, 1.f}; sn = (f32x4){0.f, 0.f, 0.f, 0.f}; }
                        float oa[4], ob[4];
#pragma unroll
                        for (int e = 0; e < 4; ++e) { const float a = acc[ai][bj][m][0][e] * rstd * gn[bj][0][e], bb = acc[ai][bj][m][1][e] * rstd * gn[bj][1][e];
                            oa[e] = (a * cs[e] - bb * sn[e]) * osc; ob[e] = (bb * cs[e] + a * sn[e]) * osc; }
                        if (ATTN_FP8) {
                            const float f8s = (pn < 5) ? Q8_SCALE : 1.0f;
                            int w0 = __builtin_amdgcn_cvt_pk_fp8_f32(oa[0] * f8s, oa[1] * f8s, 0, false); w0 = __builtin_amdgcn_cvt_pk_fp8_f32(oa[2] * f8s, oa[3] * f8s, w0, true);
                            int w1 = __builtin_amdgcn_cvt_pk_fp8_f32(ob[0] * f8s, ob[1] * f8s, 0, false); w1 = __builtin_amdgcn_cvt_pk_fp8_f32(ob[2] * f8s, ob[3] * f8s, w1, true);
                            if (pn < 5) { const int head = 4 * (pn - 2) + wc; *(u32x2*)((unsigned char*)Q + ((size_t)row * QW + head * 64 + 32 * bj + 8 * fq)) = (u32x2){(unsigned)w0, (unsigned)w1}; }
                            else *(u32x2*)((unsigned char*)Kb + (((size_t)b * LKV + key) * KVW + wc * 64 + 32 * bj + 8 * fq)) = (u32x2){(unsigned)w0, (unsigned)w1};
                        } else {
                        u32x4 w; w.x = cvt_pk_bf16(oa[0], oa[1]); w.y = cvt_pk_bf16(oa[2], oa[3]); w.z = cvt_pk_bf16(ob[0], ob[1]); w.w = cvt_pk_bf16(ob[2], ob[3]);
                        if (pn < 5) { const int head = 4 * (pn - 2) + wc; *(u32x4*)(Q + ((size_t)row * QW + head * 64 + 32 * bj + 8 * fq)) = w; }
                        else *(u32x4*)(Kb + (((size_t)b * LKV + key) * KVW + wc * 64 + 32 * bj + 8 * fq)) = w; }
                    }
                } else {
#pragma unroll
                    for (int bj = 0; bj < 2; ++bj) { const f32x4 v0 = acc[ai][bj][m][0], v1 = acc[ai][bj][m][1];
                        if (ATTN_FP8) {
                            const int kt = key >> 6, ks = attn_body::vt_slot(key & 63);
                            int w0 = __builtin_amdgcn_cvt_pk_fp8_f32(v0[0], v0[1], 0, false); w0 = __builtin_amdgcn_cvt_pk_fp8_f32(v0[2], v0[3], w0, true);
                            int w1 = __builtin_amdgcn_cvt_pk_fp8_f32(v1[0], v1[1], 0, false); w1 = __builtin_amdgcn_cvt_pk_fp8_f32(v1[2], v1[3], w1, true);
#pragma unroll
                            for (int q8 = 0; q8 < 8; ++q8) { const int col = 128 * bj + 32 * wc + 8 * fq + q8, kvh = col >> 6, d = col & 63;
                                ((unsigned char*)Vb)[((((size_t)(b * NKVH + kvh) * (LKV / 64) + kt) * 64 + d) * 64) + ks] = (unsigned char)(((q8 < 4 ? (unsigned)w0 : (unsigned)w1) >> (8 * (q8 & 3))) & 0xffu); }
                        } else {
                        u32x4 w; w.x = cvt_pk_bf16(v0[0], v0[1]); w.y = cvt_pk_bf16(v0[2], v0[3]); w.z = cvt_pk_bf16(v1[0], v1[1]); w.w = cvt_pk_bf16(v1[2], v1[3]);
                        *(u32x4*)(Vb + (((size_t)b * LKV + key) * KVW + 128 * bj + 32 * wc + 8 * fq)) = w; } }
                }
            }
    }
};
struct EpiResid {
    static constexpr bool PERM = false; static constexpr int NSTORE = 32;
    __device__ __forceinline__ void pre(LAS unsigned char*, const pg8::GUnit&, int, int, int) const {}
    const float* x; float* X1; const gi64* MOD;
    __device__ __forceinline__ void operator()(const f32x4 (&acc)[2][2][4][2], const pg8::GUnit& u, int wr, int wc, int fr, int fq, LAS unsigned char* lds, int ui) const {
        const int row0 = u.pm * 256 + wr * 64 + fr, col0 = u.pn * 256 + wc * 32 + 4 * fq; const int b = (u.pm * 256) >> 13;
        f32x4 gv[2][2];
#pragma unroll
        for (int bj = 0; bj < 2; ++bj)
#pragma unroll
            for (int n = 0; n < 2; ++n) gv[bj][n] = mod4(MOD, b * 6144 + 2048 + col0 + bj * 128 + n * 16);
#pragma unroll
        for (int ai = 0; ai < 2; ++ai)
#pragma unroll
            for (int m = 0; m < 4; ++m) { const size_t off = (size_t)(row0 + ai * 128 + m * 16) * DM + col0;
#pragma unroll
                for (int bj = 0; bj < 2; ++bj)
#pragma unroll
                    for (int n = 0; n < 2; ++n) { const f32x4 xv = *(const f32x4*)(x + off + bj * 128 + n * 16); *(f32x4*)(X1 + off + bj * 128 + n * 16) = (DBG & 2) ? xv : xv + gv[bj][n] * acc[ai][bj][m][n]; } }
    }
};
struct EpiLogits {
    static constexpr bool PERM = false; static constexpr int NSTORE = 32;
    __device__ __forceinline__ void pre(LAS unsigned char*, const pg8::GUnit&, int, int, int) const {}
    float* C;
    __device__ __forceinline__ void operator()(const f32x4 (&acc)[2][2][4][2], const pg8::GUnit& u, int wr, int wc, int fr, int fq, LAS unsigned char* lds, int ui) const {
        const int row0 = u.pm * 256 + wr * 64 + fr, col0 = wc * 32 + 4 * fq;
#pragma unroll
        for (int ai = 0; ai < 2; ++ai)
#pragma unroll
            for (int m = 0; m < 4; ++m) { float* rowp = C + (size_t)(row0 + ai * 128 + m * 16) * NEXP + col0;
#pragma unroll
                for (int bj = 0; bj < 2; ++bj)
#pragma unroll
                    for (int n = 0; n < 2; ++n) *(f32x4*)(rowp + bj * 128 + n * 16) = acc[ai][bj][m][n]; }
    }
};
struct EpiSwiglu {
    static constexpr bool PERM = true; static constexpr int NSTORE = 16;
    __device__ __forceinline__ void pre(LAS unsigned char*, const pg8::GUnit&, int, int, int) const {}
    u16* ACT;
    __device__ __forceinline__ void operator()(const f32x4 (&acc)[2][2][4][2], const pg8::GUnit& u, int wr, int wc, int fr, int fq, LAS unsigned char* lds, int ui) const {
#pragma unroll
        for (int ai = 0; ai < 2; ++ai)
#pragma unroll
            for (int m = 0; m < 4; ++m) { const int r = ai * 128 + wr * 64 + m * 16 + fr; u16* rowp = ACT + ((size_t)u.pm * 256 + r) * EFF + 128 * u.pn + 16 * wc + 4 * fq;
#pragma unroll
                for (int bj = 0; bj < 2; ++bj) { const f32x4 a = acc[ai][bj][m][0], g = acc[ai][bj][m][1]; float o[4];
#pragma unroll
                    for (int e = 0; e < 4; ++e) o[e] = a[e] * g[e] / (1.0f + __expf(-a[e]));
                    if (MOE_FP8) { int w0 = __builtin_amdgcn_cvt_pk_fp8_f32(o[0], o[1], 0, false); w0 = __builtin_amdgcn_cvt_pk_fp8_f32(o[2], o[3], w0, true);
                        *(unsigned*)((unsigned char*)ACT + ((size_t)u.pm * 256 + r) * EFF + 128 * u.pn + 16 * wc + 4 * fq + 64 * bj) = (unsigned)w0; }
                    else { u32x2 w; if (MOEF16) { w.x = pk2h(o[0], o[1]); w.y = pk2h(o[2], o[3]); } else { w.x = pk2bf(o[0], o[1]); w.y = pk2bf(o[2], o[3]); } *(u32x2*)(rowp + 64 * bj) = w; } } }
    }
};
struct EpiDown {
    static constexpr bool PERM = true; static constexpr int NSTORE = 16;
    u16* Cc; const GAS u32x2* LIST; unsigned char* dump;
    __device__ __forceinline__ void pre(LAS unsigned char* lds, const pg8::GUnit& u, int ui, int wid, int lane) const {
        if (wid < 2) __builtin_amdgcn_global_load_lds((const unsigned*)(LIST + (size_t)u.e * NTOK + 256 * u.j + 128 * wid + 2 * lane), (LAS unsigned*)(lds + pg8::STAGE_BYTES + (ui & 1) * 2048 + wid * 1024), 16, 0, 0);
    }
    __device__ __forceinline__ void operator()(const f32x4 (&acc)[2][2][4][2], const pg8::GUnit& u, int wr, int wc, int fr, int fq, LAS unsigned char* lds, int ui) const {
        const LAS f32x2* ent = (const LAS f32x2*)(lds + pg8::STAGE_BYTES + (ui & 1) * 2048);
#pragma unroll
        for (int ai = 0; ai < 2; ++ai)
#pragma unroll
            for (int m = 0; m < 4; ++m) { const int r = ai * 128 + wr * 64 + m * 16 + fr;
                const f32x2 enf = ent[r];
                const unsigned ex = __builtin_bit_cast(unsigned, enf.x); const int tok = (int)(ex & 0x7fffu), slot = (int)((ex >> 16) & 15u); const float gate = enf.y;
                unsigned char* rowp = (unsigned char*)Cc + ((size_t)tok * NSLOT + slot) * DM + 256 * u.pn + 32 * wc + 8 * fq;
                if (r >= u.nvalid) rowp = dump + ((size_t)(blockIdx.x * 512 + threadIdx.x)) * 256;
                const float gs = gate * C_SCALE;
#pragma unroll
                for (int bj = 0; bj < 2; ++bj) { f32x4 v0 = acc[ai][bj][m][0] * gs, v1 = acc[ai][bj][m][1] * gs;
#pragma unroll
                    for (int e = 0; e < 4; ++e) { v0[e] = __builtin_amdgcn_fmed3f(v0[e], -440.f, 440.f); v1[e] = __builtin_amdgcn_fmed3f(v1[e], -440.f, 440.f); }
                    int w0 = __builtin_amdgcn_cvt_pk_fp8_f32(v0[0], v0[1], 0, false); w0 = __builtin_amdgcn_cvt_pk_fp8_f32(v0[2], v0[3], w0, true);
                    int w1 = __builtin_amdgcn_cvt_pk_fp8_f32(v1[0], v1[1], 0, false); w1 = __builtin_amdgcn_cvt_pk_fp8_f32(v1[2], v1[3], w1, true);
                    *(u32x2*)(rowp + 128 * bj) = (u32x2){(unsigned)w0, (unsigned)w1}; } }
    }
};

template <bool F16OUT, bool F8OUT2 = false> __device__ __forceinline__ void rownorm_rows(const GAS float* src, const float* gain, const gi64* MODsh, const gi64* MODsc, u16* dst, int row0, int nrows, int wi, int wstride, int lane, unsigned char* dst8 = nullptr) {
    f32x4 Av[2][2], Bv[2][2];
#pragma unroll
    for (int j = 0; j < 2; ++j)
#pragma unroll
        for (int h = 0; h < 2; ++h) { const int col = 8 * lane + 512 * j + 4 * h; Av[j][h] = *(const f32x4*)(gain + col) * (mod4(MODsc, col) + 1.0f); Bv[j][h] = mod4(MODsh, col); }
    for (int r = wi; r < nrows; r += 2 * wstride) {
        const int r1 = r + wstride; const bool has1 = r1 < nrows;
        const GAS float* s0 = src + (size_t)(row0 + r) * DM; const GAS float* s1 = src + (size_t)(row0 + (has1 ? r1 : r)) * DM;
        f32x4 v0[2][2], v1[2][2];
#pragma unroll
        for (int j = 0; j < 2; ++j)
#pragma unroll
            for (int h = 0; h < 2; ++h) { v0[j][h] = *(const GAS f32x4*)(s0 + 8 * lane + 512 * j + 4 * h); v1[j][h] = *(const GAS f32x4*)(s1 + 8 * lane + 512 * j + 4 * h); }
        float q0 = 0.f, q1 = 0.f;
#pragma unroll
        for (int j = 0; j < 2; ++j)
#pragma unroll
            for (int h = 0; h < 2; ++h) { const f32x4 a = v0[j][h], b = v1[j][h]; q0 += (a[0] * a[0] + a[1] * a[1]) + (a[2] * a[2] + a[3] * a[3]); q1 += (b[0] * b[0] + b[1] * b[1]) + (b[2] * b[2] + b[3] * b[3]); }
#pragma unroll
        for (int o = 1; o < 64; o <<= 1) { q0 += __shfl_xor(q0, o); q1 += __shfl_xor(q1, o); }
        const float rs0 = 1.0f / sqrtf(q0 * (1.0f / DM) + RMS_EPS), rs1 = 1.0f / sqrtf(q1 * (1.0f / DM) + RMS_EPS);
#pragma unroll
        for (int j = 0; j < 2; ++j) { const f32x4 ya = v0[j][0] * rs0 * Av[j][0] + Bv[j][0], yb = v0[j][1] * rs0 * Av[j][1] + Bv[j][1];
            u32x4 w; if (F16OUT) { w.x = pk2h(ya[0], ya[1]); w.y = pk2h(ya[2], ya[3]); w.z = pk2h(yb[0], yb[1]); w.w = pk2h(yb[2], yb[3]); } else { w.x = pk2bf(ya[0], ya[1]); w.y = pk2bf(ya[2], ya[3]); w.z = pk2bf(yb[0], yb[1]); w.w = pk2bf(yb[2], yb[3]); }
            *(GAS u32x4*)(dst + (size_t)(row0 + r) * DM + 8 * lane + 512 * j) = w;
            if (F8OUT2) { int w0 = __builtin_amdgcn_cvt_pk_fp8_f32(ya[0], ya[1], 0, false); w0 = __builtin_amdgcn_cvt_pk_fp8_f32(ya[2], ya[3], w0, true); int w1 = __builtin_amdgcn_cvt_pk_fp8_f32(yb[0], yb[1], 0, false); w1 = __builtin_amdgcn_cvt_pk_fp8_f32(yb[2], yb[3], w1, true);
                *(GAS u32x2*)(dst8 + (size_t)(row0 + r) * DM + 8 * lane + 512 * j) = (u32x2){(unsigned)w0, (unsigned)w1}; } }
        if (has1) {
#pragma unroll
            for (int j = 0; j < 2; ++j) { const f32x4 ya = v1[j][0] * rs1 * Av[j][0] + Bv[j][0], yb = v1[j][1] * rs1 * Av[j][1] + Bv[j][1];
                u32x4 w; if (F16OUT) { w.x = pk2h(ya[0], ya[1]); w.y = pk2h(ya[2], ya[3]); w.z = pk2h(yb[0], yb[1]); w.w = pk2h(yb[2], yb[3]); } else { w.x = pk2bf(ya[0], ya[1]); w.y = pk2bf(ya[2], ya[3]); w.z = pk2bf(yb[0], yb[1]); w.w = pk2bf(yb[2], yb[3]); }
                *(GAS u32x4*)(dst + (size_t)(row0 + r1) * DM + 8 * lane + 512 * j) = w;
                if (F8OUT2) { int w0 = __builtin_amdgcn_cvt_pk_fp8_f32(ya[0], ya[1], 0, false); w0 = __builtin_amdgcn_cvt_pk_fp8_f32(ya[2], ya[3], w0, true); int w1 = __builtin_amdgcn_cvt_pk_fp8_f32(yb[0], yb[1], 0, false); w1 = __builtin_amdgcn_cvt_pk_fp8_f32(yb[2], yb[3], w1, true);
                    *(GAS u32x2*)(dst8 + (size_t)(row0 + r1) * DM + 8 * lane + 512 * j) = (u32x2){(unsigned)w0, (unsigned)w1}; } } }
    }
}

__device__ __forceinline__ void p0_phase(Frame& F) {
    const int gw = F.vcu * 8 + F.wave, NGW = F.G * 8, lane = F.lane;
    unsigned long long* MODQ = (unsigned long long*)(F.ctl + CW_MOD);
    for (int it = gw; it < 1536; it += NGW) {
        const int cb = it % 24, kc = it / 24, k0 = kc * 16, col = cb * 256 + lane * 4;
        float sv[5];
#pragma unroll
        for (int r = 0; r < 5; ++r) { const float cv = (r < 4) ? FIN_c[r * DM + k0 + (lane & 15)] : FIN_c_ctx[k0 + (lane & 15)]; sv[r] = cv / (1.0f + __expf(-cv)); }
        f32x4 acc[5];
#pragma unroll
        for (int r = 0; r < 5; ++r) acc[r] = (f32x4){0.f, 0.f, 0.f, 0.f};
#pragma unroll
        for (int kk = 0; kk < 16; ++kk) { const f32x4 w = *(const f32x4*)(FIN_w_ada + (size_t)(k0 + kk) * 6144 + col);
#pragma unroll
            for (int r = 0; r < 5; ++r) { const float s = __builtin_bit_cast(float, __builtin_amdgcn_readlane(__builtin_bit_cast(int, sv[r]), kk)); acc[r] += w * s; } }
        if (kc == 0) { const f32x4 bv = *(const f32x4*)(FIN_b_ada + col);
#pragma unroll
            for (int r = 0; r < 5; ++r) acc[r] += bv; }
#pragma unroll
        for (int r = 0; r < 5; ++r)
#pragma unroll
            for (int j = 0; j < 4; ++j) atomicAdd(MODQ + r * 6144 + col + j, (unsigned long long)__float2ll_rn(acc[r][j] * 0x1p36f));
    }
    float* WCS = WSP(float, WS_TAB);
    for (int it = gw; it < 256; it += NGW) {
        const int fh = it >> 6, d = it & 63; float ac = 0.f, as = 0.f;
        const float ctab = cospif((float)lane * (1.0f / 32.0f)), stab = sinpif((float)lane * (1.0f / 32.0f));
        for (int k2 = 0; k2 < 64; ++k2) { const int mm = __builtin_amdgcn_readfirstlane((d * k2) & 63); const float w = FIN_w_fourier[(fh * 64 + k2) * 64 + lane]; ac += rdl(ctab, mm) * w; as += rdl(stab, mm) * w; }
        const float sc = 1.0f / sqrtf((float)SEQ * 64.0f);
        WCS[(fh * 64 + d) * 128 + lane] = ac * sc; WCS[(fh * 64 + d) * 128 + 64 + lane] = as * sc;
    }
    {
        u16* D1 = WSP(u16, WS_TAB + 144 * 1024); u16* D3 = WSP(u16, WS_TAB + 272 * 1024);
        for (int it = gw; it < 320; it += NGW) {
            if (it < 256) { const int ro = it >> 7, k1 = it & 127;
#pragma unroll
                for (int j = 0; j < 4; ++j) { const int col = lane + 64 * j, ri = col >> 7, n1 = col & 127, mm = (n1 * k1) & 127; const float cc = cospif((float)mm * (1.0f / 64.0f)), ss = sinpif((float)mm * (1.0f / 64.0f));
                    const float v = (ro == 0) ? (ri == 0 ? cc : -ss) : (ri == 0 ? -ss : -cc); D1[it * 256 + col] = (u16)f2bf(v); } }
            else { const int k2 = it - 256;
#pragma unroll
                for (int j = 0; j < 2; ++j) { const int col = lane + 64 * j, ri = col >> 6, n2 = col & 63, mm = (n2 * k2) & 63; const float v = (ri == 0) ? cospif((float)mm * (1.0f / 32.0f)) : sinpif((float)mm * (1.0f / 32.0f)); D3[k2 * 128 + col] = (u16)f2bf(v); } }
        }
    }
    float* COS = WSP(float, WS_TAB + 128 * 1024); float* SIN = WSP(float, WS_TAB + 136 * 1024);
    for (int it = gw; it < 32; it += NGW) { const int idx = it * 64 + lane, pos = idx >> 4, i = idx & 15;
        const float inv = powf(10000.0f, -(float)i / 16.0f), ang = (float)pos * inv; COS[idx] = cosf(ang); SIN[idx] = sinf(ang); }
}

__device__ __forceinline__ int map_row(int mode, int sc) {
    if (mode == 1) { const int head = sc >> 6, dim = sc & 63, bj = dim >> 5, n = (dim >> 4) & 1, i = dim & 15; return (head >> 2) * 256 + bj * 128 + (head & 3) * 32 + (i >> 2) * 8 + n * 4 + (i & 3); }
    if (mode == 2) { const int g = sc >> 8, a = sc & 255; return (a >> 2) * 8 + g * 4 + (a & 3); }
    return sc;
}
struct TItem { const float* src; u16* dst; int N, K, k0, rel_c0, mode, dst_off; bool f16; bool f8; float ws; };
__device__ __forceinline__ void titem_load(const TItem& t, float (&buf)[64], int lane) {
#pragma unroll
    for (int i = 0; i < 64; ++i) { const int kk = 2 * i + (lane >> 5); buf[i] = t.src[(size_t)kk * t.N + (lane & 31)]; }
}
__device__ __forceinline__ void titem_finish(const TItem& t, const float (&buf)[64], LAS float* scr, int lane) {
#pragma unroll
    for (int i = 0; i < 64; ++i) { const int kk = 2 * i + (lane >> 5); scr[kk * 33 + (lane & 31)] = buf[i]; }
    LDS_WAIT(); asm volatile("" ::: "memory");
    if (t.f8) { const int c = lane & 7; const float ws = t.ws;
#pragma unroll
        for (int j = 0; j < 4; ++j) { const int n = (lane >> 3) + 8 * j; const LAS float* s = scr + (16 * c) * 33 + n; int w[4];
#pragma unroll
            for (int q = 0; q < 4; ++q) { w[q] = __builtin_amdgcn_cvt_pk_fp8_f32(s[(4 * q) * 33] * ws, s[(4 * q + 1) * 33] * ws, 0, false); w[q] = __builtin_amdgcn_cvt_pk_fp8_f32(s[(4 * q + 2) * 33] * ws, s[(4 * q + 3) * 33] * ws, w[q], true); }
            const int drow = t.dst_off + map_row(t.mode, t.rel_c0 + n);
            *(GAS u32x4*)((unsigned char*)t.dst + (size_t)drow * t.K + t.k0 + 16 * c) = (u32x4){(unsigned)w[0], (unsigned)w[1], (unsigned)w[2], (unsigned)w[3]}; } }
    else { const int c = lane & 15;
#pragma unroll
        for (int j = 0; j < 8; ++j) { const int n = (lane >> 4) + 4 * j; const LAS float* s = scr + (8 * c) * 33 + n;
            u32x4 o;
            if (t.f16) { o.x = pk2h(s[0 * 33], s[1 * 33]); o.y = pk2h(s[2 * 33], s[3 * 33]); o.z = pk2h(s[4 * 33], s[5 * 33]); o.w = pk2h(s[6 * 33], s[7 * 33]); }
            else { o.x = pk2bf(s[0 * 33], s[1 * 33]); o.y = pk2bf(s[2 * 33], s[3 * 33]); o.z = pk2bf(s[4 * 33], s[5 * 33]); o.w = pk2bf(s[6 * 33], s[7 * 33]); }
            const int drow = t.dst_off + map_row(t.mode, t.rel_c0 + n);
            *(GAS u32x4*)(t.dst + (size_t)drow * t.K + t.k0 + 8 * c) = o; } }
    LDS_WAIT(); asm volatile("" ::: "memory");
}
constexpr int I_FOLD = 512, I_QKV = 8 * 40, I_OUT = 8 * 32, I_R = 8 * 8, I_GU = NEXPS * 8 * 16, I_D = NEXPS * 2 * 32;
constexpr int NT_EARLY = I_QKV + I_OUT + I_R, NT_ITEMS = NT_EARLY + I_GU + I_D;
constexpr int DEFER_A = 3840, DEFER_B = 4096;
#define TDECODE(it_, t) do { int r = (it_); u16* BIN = WSP(u16, WS_BIN); \
        if (r < I_QKV) { const int kb = r / 40, nb = r % 40, sc0 = 256 + 32 * nb; t.N = 1536; t.K = DM; t.k0 = kb * 128; t.f16 = false; t.f8 = false; t.ws = 1.f; t.dst = BIN; t.src = FIN_w_in + (size_t)(kb * 128) * 1536 + sc0; \
            if (sc0 < 1024) { t.rel_c0 = sc0 - 256; t.mode = 1; t.dst_off = 512; } else if (sc0 < 1280) { t.rel_c0 = sc0 - 1024; t.mode = 1; t.dst_off = 1280; } else { t.rel_c0 = sc0 - 1280; t.mode = 0; t.dst_off = 1536; } \
            break; } \
        r -= I_QKV; \
        if (r < I_OUT) { const int kb = r / 32, nb = r % 32; t.N = DM; t.K = DM; t.k0 = kb * 128; t.f16 = false; t.f8 = false; t.ws = 1.f; t.dst = WSP(u16, WS_BOUT); t.src = FIN_w_out + (size_t)(kb * 128) * DM + 32 * nb; t.rel_c0 = 32 * nb; t.mode = 0; t.dst_off = 0; break; } \
        r -= I_OUT; \
        if (r < I_R) { const int kb = r / 8, nb = r % 8; t.N = NEXP; t.K = DM; t.k0 = kb * 128; t.f16 = (MOE_FP8 ? false : MOEF16); t.f8 = false; t.ws = 1.f; t.dst = WSP(u16, WS_BR); t.src = FIN_w_router + (size_t)(kb * 128) * NEXP + 32 * nb; t.rel_c0 = 32 * nb; t.mode = 0; t.dst_off = 0; break; } \
        r -= I_R; \
        if (r < I_GU) { const int e = r >> 7, q = r & 127, kb = q >> 4, nb = q & 15; const float* W = (e < NEXP) ? FIN_w_egu + (size_t)e * DM * 512 : FIN_w_sgu; \
            t.N = 512; t.K = DM; t.k0 = kb * 128; t.f16 = MOEF16; t.f8 = MOE_FP8; t.ws = WGU_SCALE; t.dst = MOE_FP8 ? (u16*)(F.ws + WS_BGU + (size_t)e * 512 * DM) : WSP(u16, WS_BGU) + (size_t)e * 512 * DM; t.src = W + (size_t)(kb * 128) * 512 + 32 * nb; t.rel_c0 = 32 * nb; t.mode = 2; t.dst_off = 0; break; } \
        r -= I_GU; \
        { const int e = r >> 6, q = r & 63, kb = q >> 5, nb = q & 31; const float* W = (e < NEXP) ? FIN_w_ed + (size_t)e * EFF * DM : FIN_w_sd; \
            t.N = DM; t.K = EFF; t.k0 = kb * 128; t.f16 = MOEF16; t.f8 = MOE_FP8; t.ws = WD_SCALE; t.dst = MOE_FP8 ? (u16*)(F.ws + WS_BD + (size_t)e * DM * EFF) : WSP(u16, WS_BD) + (size_t)e * DM * EFF; t.src = W + (size_t)(kb * 128) * DM + 32 * nb; t.rel_c0 = 32 * nb; t.mode = 0; t.dst_off = 0; } \
    } while (0)
__device__ __forceinline__ void transpose_range(Frame& F, int first, int count, int w, int nw) {
    LAS float* scr = (LAS float*)(F.lds + F.wave * P1_SCR); const int lane = F.lane; const int end = first + count;
    float bufA[64], bufB[64]; TItem ta, tb; int it = first + w;
    if (it < end) { TDECODE(it, ta); titem_load(ta, bufA, lane); }
    while (it < end) {
        const int itb = it + nw; const bool hb = itb < end;
        if (hb) { TDECODE(itb, tb); titem_load(tb, bufB, lane); }
        titem_finish(ta, bufA, scr, lane);
        if (!hb) break;
        const int ita = itb + nw; const bool ha = ita < end;
        if (ha) { TDECODE(ita, ta); titem_load(ta, bufA, lane); }
        titem_finish(tb, bufB, scr, lane);
        it = ita;
    }
}
__device__ __forceinline__ void p1_phase(Frame& F) {
    LAS float* scr = (LAS float*)(F.lds + F.wave * P1_SCR);
    const int gw = F.vcu * 8 + F.wave, NGW = F.G * 8, lane = F.lane;
    u16* BIN = WSP(u16, WS_BIN);
    for (int r = gw; r < I_FOLD; r += NGW) {
        const int fh = r >> 7, cs = (r >> 6) & 1, kb = (r >> 2) & 15, eq = r & 3; const int k = kb * 64 + lane;
        const GAS float* WCS = (const GAS float*)(F.ws + WS_TAB);
#pragma unroll 4
        for (int i = 0; i < 16; ++i) scr[(4 * i + (lane >> 4)) * 16 + (lane & 15)] = WCS[(fh * 64 + 4 * i + (lane >> 4)) * 128 + cs * 64 + 16 * eq + (lane & 15)];
        float wrow[64];
#pragma unroll
        for (int d4 = 0; d4 < 16; ++d4) { const f32x4 v = *(const f32x4*)(FIN_w_in + (size_t)k * 1536 + fh * 64 + 4 * d4); wrow[4 * d4] = v[0]; wrow[4 * d4 + 1] = v[1]; wrow[4 * d4 + 2] = v[2]; wrow[4 * d4 + 3] = v[3]; }
        LDS_WAIT(); asm volatile("" ::: "memory");
        for (int e1 = 0; e1 < 16; ++e1) { float a = 0.f;
#pragma unroll
            for (int d = 0; d < 64; ++d) a += wrow[d] * scr[d * 16 + e1];
            const int col256 = fh * 64 + 16 * eq + e1, pos = 8 * (col256 >> 2) + (col256 & 3) + 4 * cs;
            BIN[(size_t)pos * DM + k] = (u16)f2bf(a); }
        LDS_WAIT(); asm volatile("" ::: "memory");
    }
    const int ndefer = (F.G == 256) ? DEFER_A + DEFER_B : 0;
    REPS(11) transpose_range(F, 0, NT_ITEMS - ndefer, gw, NGW);
    const gi64* MOD = (const gi64*)(F.ctl + CW_MOD);
    u16* XN = WSP(u16, WS_XN);
    REPS(12) { const int wpb = NGW >> 2, b = gw / wpb, wi = gw % wpb;
        rownorm_rows<false>((const GAS float*)FIN_x, FIN_norm1_g, MOD + b * 6144, MOD + b * 6144 + 1024, XN, b * SEQ, SEQ, wi, wpb, lane);
        rownorm_rows<false>((const GAS float*)FIN_ctx, FIN_norm1_g, MOD + 4 * 6144, MOD + 4 * 6144 + 1024, XN + (size_t)NTOK * DM, 0, NCTX, gw, NGW, lane); }
}

__device__ __forceinline__ void fourier_unit(Frame& F, int b, int g) {
    LAS unsigned char* Zl = F.lds + RING_OFF;
    LAS f32x2* TW128 = (LAS f32x2*)(F.lds + TAB_OFF);
    LAS f32x2* TW64 = (LAS f32x2*)(F.lds + TAB_OFF + 1024);
    const int tid = F.tid;
    const GAS u32x4* Zg = (const GAS u32x4*)(F.ws + WS_Z + ((size_t)(b * 64 + g) * SEQ) * 16);
#pragma unroll 4
    for (int i = 0; i < 16; ++i) *(LAS u32x4*)(Zl + (size_t)(i * 512 + tid) * 16) = Zg[i * 512 + tid];
    if (tid < 128) { float s, c; sincospif((float)tid * (1.0f / 64.0f), &s, &c); TW128[tid] = (f32x2){c, s}; }
    else if (tid < 192) { float s, c; sincospif((float)(tid - 128) * (1.0f / 32.0f), &s, &c); TW64[tid - 128] = (f32x2){c, s}; }
    __syncthreads();
    const int k1 = tid & 127, q = tid >> 7;
    float yr[16][4], yi[16][4];
#pragma unroll
    for (int a = 0; a < 16; ++a)
#pragma unroll
        for (int e = 0; e < 4; ++e) { yr[a][e] = 0.f; yi[a][e] = 0.f; }
    for (int n1 = 0; n1 < 128; ++n1) {
        const f32x2 tw = TW128[(n1 * k1) & 127]; const float c = tw.x, s = tw.y;
#pragma unroll
        for (int a = 0; a < 16; ++a) { const u32x4 rw = *(const LAS u32x4*)(Zl + (size_t)(64 * n1 + 16 * q + a) * 16);
            const float uc[4] = {bflo(rw.x), bfhi(rw.x), bflo(rw.y), bfhi(rw.y)}, us[4] = {bflo(rw.z), bfhi(rw.z), bflo(rw.w), bfhi(rw.w)};
#pragma unroll
            for (int e = 0; e < 4; ++e) { yr[a][e] += uc[e] * c - us[e] * s; yi[a][e] -= uc[e] * s + us[e] * c; } }
    }
    __syncthreads();
    int k1b = k1; asm volatile("" : "+v"(k1b));
#pragma unroll
    for (int a = 0; a < 16; ++a) { const int n2 = 16 * q + a; const float fr_ = (float)(n2 * k1b) * (1.0f / 8192.0f);
        const float cp = __builtin_amdgcn_cosf(fr_), sp = __builtin_amdgcn_sinf(fr_);
        float pr[4], pi[4];
#pragma unroll
        for (int e = 0; e < 4; ++e) { pr[e] = yr[a][e] * cp + yi[a][e] * sp; pi[e] = yi[a][e] * cp - yr[a][e] * sp; }
        u32x4 w; w.x = pk2bf(pr[0], pr[1]); w.y = pk2bf(pr[2], pr[3]); w.z = pk2bf(pi[0], pi[1]); w.w = pk2bf(pi[2], pi[3]);
        *(LAS u32x4*)(Zl + (size_t)(n2 * 128 + k1b) * 16) = w; }
    __syncthreads();
    int k1c = k1; asm volatile("" : "+v"(k1c));
    float o[16][4];
#pragma unroll
    for (int a = 0; a < 16; ++a)
#pragma unroll
        for (int e = 0; e < 4; ++e) o[a][e] = 0.f;
    for (int n2 = 0; n2 < 64; ++n2) {
        const u32x4 rw = *(const LAS u32x4*)(Zl + (size_t)(n2 * 128 + k1c) * 16);
        const float pr[4] = {bflo(rw.x), bfhi(rw.x), bflo(rw.y), bfhi(rw.y)}, pi[4] = {bflo(rw.z), bfhi(rw.z), bflo(rw.w), bfhi(rw.w)};
#pragma unroll
        for (int a = 0; a < 16; ++a) { const f32x2 tw = TW64[(n2 * (16 * q + a)) & 63];
#pragma unroll
            for (int e = 0; e < 4; ++e) o[a][e] += pr[e] * tw.x + pi[e] * tw.y; }
    }
    u16* MIX = WSP(u16, WS_MIX);
#pragma unroll
    for (int a = 0; a < 16; ++a) { const int k2 = 16 * q + a; u32x2 w; w.x = pk2bf(o[a][0], o[a][1]); w.y = pk2bf(o[a][2], o[a][3]);
        *(GAS u32x2*)(MIX + ((size_t)(b * SEQ + k1c + 128 * k2)) * DM + 4 * g) = w; }
    __syncthreads();
}

__device__ __forceinline__ attn_body::s16x4 ftr(const LAS unsigned char* p) { return __builtin_bit_cast(attn_body::s16x4, __builtin_amdgcn_ds_read_tr16_b64_v4i16((LAS attn_body::v4i16_t*)p)); }
__device__ __forceinline__ void fourier_unit_mfma(Frame& F, int b, int g) {
    LAS unsigned char* Zl = F.lds + RING_OFF;
    const int tid = F.tid, lane = F.lane, w = F.wave;
    const char* Zg = (const char*)(F.ws + WS_Z) + ((size_t)(b * 64 + g) * SEQ) * 16;
#pragma unroll
    for (int i = 0; i < 16; ++i) __builtin_amdgcn_global_load_lds((const unsigned*)(Zg + (size_t)(i * 512 + tid) * 16), (LAS unsigned*)(Zl + (size_t)(i * 512 + w * 64) * 16), 16, 0, 0);
    VM_WAIT(); __syncthreads();
    f32x4 acc[2][16];
#pragma unroll
    for (int ro = 0; ro < 2; ++ro)
#pragma unroll
        for (int t = 0; t < 16; ++t) acc[ro][t] = (f32x4){0.f, 0.f, 0.f, 0.f};
    const GAS bf16x8* D1 = (const GAS bf16x8*)(F.ws + WS_TAB + 144 * 1024);
    const GAS bf16x8* D3 = (const GAS bf16x8*)(F.ws + WS_TAB + 272 * 1024);
    const int l15 = lane & 15, lq = lane >> 4;
    const unsigned bbase = (unsigned)((64 * (8 * lq + (l15 >> 2)) + (lane & 3)) * 16);
#pragma unroll 1
    for (int s1 = 0; s1 < 8; ++s1) {
        const int ri = s1 >> 2;
        const bf16x8 a0 = D1[(16 * w + l15) * 32 + 4 * s1 + lq], a1 = D1[(128 + 16 * w + l15) * 32 + 4 * s1 + lq];
        const LAS unsigned char* sb = Zl + bbase + (unsigned)((s1 & 3) * 32768 + 8 * ri);
#pragma unroll
        for (int t = 0; t < 16; ++t) { const attn_body::s16x4 lo = ftr(sb + 64 * t), hi = ftr(sb + 64 * t + 4096);
            const bf16x8 bf = (bf16x8){lo[0], lo[1], lo[2], lo[3], hi[0], hi[1], hi[2], hi[3]};
            acc[0][t] = __builtin_amdgcn_mfma_f32_16x16x32_bf16(a0, bf, acc[0][t], 0, 0, 0);
            acc[1][t] = __builtin_amdgcn_mfma_f32_16x16x32_bf16(a1, bf, acc[1][t], 0, 0, 0); }
    }
    __syncthreads();
    {   const int e = lane & 3; int k1b = 16 * w + 4 * lq; asm volatile("" : "+v"(k1b));
#pragma unroll
        for (int t = 0; t < 16; ++t) { const int n2 = 4 * t + (l15 >> 2);
#pragma unroll
            for (int r = 0; r < 4; ++r) { const int k1 = k1b + r; const float fr_ = (float)(n2 * k1) * (1.0f / 8192.0f); const float cp = __builtin_amdgcn_cosf(fr_), sp = __builtin_amdgcn_sinf(fr_);
                const float yr = acc[0][t][r], yi = acc[1][t][r]; const float pr = yr * cp + yi * sp, pi = yi * cp - yr * sp;
                *(LAS u16*)(Zl + (unsigned)(((n2) * 512 + k1 * 4 + e) * 2)) = (u16)f2bf(pr);
                *(LAS u16*)(Zl + (unsigned)(((64 + n2) * 512 + k1 * 4 + e) * 2)) = (u16)f2bf(pi); } }
    }
    asm volatile("s_waitcnt lgkmcnt(0)" ::: "memory");
    f32x4 acc3[4][4];
#pragma unroll
    for (int mt = 0; mt < 4; ++mt)
#pragma unroll
        for (int j = 0; j < 4; ++j) acc3[mt][j] = (f32x4){0.f, 0.f, 0.f, 0.f};
#pragma unroll
    for (int s3 = 0; s3 < 4; ++s3) {
        bf16x8 a[4];
#pragma unroll
        for (int mt = 0; mt < 4; ++mt) a[mt] = D3[(16 * mt + l15) * 16 + 4 * s3 + lq];
        const unsigned kk = (unsigned)(32 * s3 + 8 * lq + (l15 >> 2));
#pragma unroll
        for (int j = 0; j < 4; ++j) { const unsigned ad = kk * 1024u + (unsigned)((4 * (4 * w + j) + (lane & 3)) * 8);
            const attn_body::s16x4 lo = ftr(Zl + ad), hi = ftr(Zl + ad + 4096);
            const bf16x8 bf = (bf16x8){lo[0], lo[1], lo[2], lo[3], hi[0], hi[1], hi[2], hi[3]};
#pragma unroll
            for (int mt = 0; mt < 4; ++mt) acc3[mt][j] = __builtin_amdgcn_mfma_f32_16x16x32_bf16(a[mt], bf, acc3[mt][j], 0, 0, 0); }
    }
    u16* MIX = WSP(u16, WS_MIX);
#pragma unroll
    for (int mt = 0; mt < 4; ++mt)
#pragma unroll
        for (int j = 0; j < 4; ++j)
#pragma unroll
            for (int r = 0; r < 4; ++r) { const int k2 = 16 * mt + 4 * lq + r, k1 = 16 * w + 4 * j + (l15 >> 2);
                MIX[((size_t)(b * SEQ + k1 + 128 * k2)) * DM + 4 * g + (lane & 3)] = (u16)f2bf(acc3[mt][j][r]); }
    __syncthreads();
}

__device__ __forceinline__ float dpp_f(float v, int ctrl_sel) {
    const int x = __builtin_bit_cast(int, v); int r;
    if (ctrl_sel == 0) r = __builtin_amdgcn_update_dpp(x, x, 0xB1, 0xF, 0xF, false);
    else if (ctrl_sel == 1) r = __builtin_amdgcn_update_dpp(x, x, 0x4E, 0xF, 0xF, false);
    else if (ctrl_sel == 2) r = __builtin_amdgcn_update_dpp(x, x, 0x141, 0xF, 0xF, false);
    else r = __builtin_amdgcn_update_dpp(x, x, 0x140, 0xF, 0xF, false);
    return __builtin_bit_cast(float, r);
}
__device__ __forceinline__ void route_token(Frame& F, int tok) {
    const int l = F.lane;
    const f32x4 lg = *(const GAS f32x4*)((const GAS float*)(F.ws + WS_LOG) + (size_t)tok * NEXP + 4 * l);
    const f32x4 bs = *(const f32x4*)(FIN_router_bias + 4 * l);
    float s[4], sel[4];
#pragma unroll
    for (int j = 0; j < 4; ++j) { s[j] = 1.0f / (1.0f + expf(-lg[j])); sel[j] = s[j] + bs[j]; }
    float m1 = fmaxf(sel[0], sel[1]), m2 = fminf(sel[0], sel[1]);
#pragma unroll
    for (int j = 2; j < 4; ++j) { const float v = sel[j]; m2 = fmaxf(m2, fminf(m1, v)); m1 = fmaxf(m1, v); }
#pragma unroll
    for (int st = 0; st < 3; ++st) { const float o1 = dpp_f(m1, st), o2 = dpp_f(m2, st); const float n2 = fmaxf(fminf(m1, o1), fmaxf(m2, o2)); m1 = fmaxf(m1, o1); m2 = n2; }
    const float gs = m1 + m2; const int myg = l >> 3; int rank = 0;
#pragma unroll
    for (int g2 = 0; g2 < 8; ++g2) { const float og = rdl(gs, g2 * 8); rank += (og > gs || (og == gs && g2 < myg)) ? 1 : 0; }
    if (rank >= 4) {
#pragma unroll
        for (int j = 0; j < 4; ++j) sel[j] = -INFINITY; }
    int my_e = 0; float my_s = 0.f, sum = 0.f;
#pragma unroll 1
    for (int k = 0; k < TOPK; ++k) {
        const float lb = fmaxf(fmaxf(sel[0], sel[1]), fmaxf(sel[2], sel[3]));
        float r = lb; r = fmaxf(r, dpp_f(r, 0)); r = fmaxf(r, dpp_f(r, 1)); r = fmaxf(r, dpp_f(r, 2)); r = fmaxf(r, dpp_f(r, 3));
        const float wm = fmaxf(fmaxf(rdl(r, 0), rdl(r, 16)), fmaxf(rdl(r, 32), rdl(r, 48)));
        const unsigned long long mask = __ballot(lb == wm);
        const int wl = __builtin_amdgcn_readfirstlane((int)__ffsll((long long)mask) - 1);
        const int jj = (sel[0] == wm) ? 0 : (sel[1] == wm) ? 1 : (sel[2] == wm) ? 2 : 3;
        const float cand = (jj == 0) ? s[0] : (jj == 1) ? s[1] : (jj == 2) ? s[2] : s[3];
        const int jw = __builtin_amdgcn_readlane(jj, wl); const float wsc = rdl(cand, wl);
        if (l == wl) {
#pragma unroll
            for (int j = 0; j < 4; ++j) if (jw == j) sel[j] = -INFINITY; }
        if (l == k) { my_e = 4 * wl + jw; my_s = wsc; }
        sum += wsc;
    }
    GAS u32x2* LIST = (GAS u32x2*)(F.ws + WS_LIST);
    if (l < TOPK) { const float gate = my_s / sum * 2.5f; const unsigned pos = __hip_atomic_fetch_add((unsigned*)(F.ctl + CW_CNT + my_e), 1u, RLX_AGENT);
        LIST[(size_t)my_e * NTOK + pos] = (u32x2){(unsigned)tok | ((unsigned)l << 16), __builtin_bit_cast(unsigned, gate)}; }
    else if (l == TOPK) LIST[(size_t)NEXP * NTOK + tok] = (u32x2){(unsigned)tok | (8u << 16), __builtin_bit_cast(unsigned, 1.0f)};
}

__device__ __forceinline__ void build_tiles(Frame& F) {
    LAS int* TS = (LAS int*)(F.lds + TAB_OFF + 2048); LAS int* CN = (LAS int*)(F.lds + TAB_OFF + 3200);
    if (F.tid < 64) { const int l = F.tid; int c[5], t[5], tot = 0;
#pragma unroll
        for (int j = 0; j < 5; ++j) { const int e = 5 * l + j; c[j] = (e < NEXPS) ? (int)__hip_atomic_load((unsigned*)(F.ctl + CW_CNT + e), RLX_AGENT) : 0; t[j] = (c[j] + 255) >> 8; tot += t[j]; }
        int x = tot;
#pragma unroll
        for (int off = 1; off < 64; off <<= 1) { const int v = __shfl_up(x, off); if (l >= off) x += v; }
        int run = x - tot;
#pragma unroll
        for (int j = 0; j < 5; ++j) { const int e = 5 * l + j; if (e <= NEXPS) { TS[e] = run; if (e < NEXPS) CN[e] = c[j]; } run += t[j]; }
    }
    __syncthreads();
}

__device__ __forceinline__ void ph2(Frame& F) {
    const gi64* MOD = (const gi64*)(F.ctl + CW_MOD); const int gw = F.vcu * 8 + F.wave, NGW = F.G * 8; (void)MOD; (void)gw; (void)NGW;
        DenseOrder S{7, 128 * 7, 8, F.G, F.vcu, (const char*)(F.ws + WS_BIN), DM, (REP == 22) ? 2 : 1};
        EpiInProj E{WSP(u16, WS_Z), WSP(u16, WS_Q), WSP(u16, WS_K), WSP(u16, WS_V), WSP(float, WS_TAB + 128 * 1024), WSP(float, WS_TAB + 136 * 1024), FIN_q_norm_g, FIN_k_norm_g};
        pg8::gemm_phase<EpiInProj, DenseOrder, 0, true>(F.lds + RING_OFF, (const char*)(F.ws + WS_XN), DM, S, E);
        if (F.G == 256 && F.vcu >= 136) transpose_range(F, NT_ITEMS - DEFER_A - DEFER_B, DEFER_A, (F.vcu - 136) * 8 + F.wave, 120 * 8);
    }
__device__ __forceinline__ void ph4(Frame& F) {
    const gi64* MOD = (const gi64*)(F.ctl + CW_MOD); const int gw = F.vcu * 8 + F.wave, NGW = F.G * 8; (void)MOD; (void)gw; (void)NGW;
        if (DBG & 128) { GAS u32x4* zH = (GAS u32x4*)(F.ws + WS_H2); const size_t nH = (size_t)NTOK * DM * 2 / 16; for (size_t i = (size_t)blockIdx.x * 512 + F.tid; i < nH; i += (size_t)F.G * 512) zH[i] = (u32x4){0u, 0u, 0u, 0u}; }
        DenseOrder S{4, 128 * 4, 0, F.G, F.vcu, (const char*)(F.ws + WS_BOUT), DM, 1};
        EpiResid E{FIN_x, F.out, MOD};
        pg8::gemm_phase<EpiResid, DenseOrder, 0, true>(F.lds + RING_OFF, (const char*)(F.ws + WS_MIX), DM, S, E);
    }
__device__ __forceinline__ void ph5(Frame& F) {
    const gi64* MOD = (const gi64*)(F.ctl + CW_MOD); const int gw = F.vcu * 8 + F.wave, NGW = F.G * 8;
    const int wpb = NGW >> 2, b = gw / wpb, wi = gw % wpb;
    rownorm_rows<(MOE_FP8 ? false : MOEF16), MOE_FP8>((const GAS float*)F.out, FIN_norm2_g, MOD + b * 6144 + 3072, MOD + b * 6144 + 4096, WSP(u16, WS_H2), b * SEQ, SEQ, wi, wpb, F.lane, F.ws + WS_H2F8);
}
__device__ __forceinline__ void ph6(Frame& F) {
    const gi64* MOD = (const gi64*)(F.ctl + CW_MOD); const int gw = F.vcu * 8 + F.wave, NGW = F.G * 8; (void)MOD; (void)gw; (void)NGW;
        DenseOrder S{1, 128, 0, F.G, F.vcu, (const char*)(F.ws + WS_BR), DM, 1};
        EpiLogits E{WSP(float, WS_LOG)};
        pg8::gemm_phase<EpiLogits, DenseOrder, (MOE_FP8 ? 0 : (MOE_F16 ? 1 : 0)), true>(F.lds + RING_OFF, (const char*)(F.ws + WS_H2), DM, S, E);
        if (F.G == 256 && F.vcu >= 128) transpose_range(F, NT_ITEMS - DEFER_B, DEFER_B, (F.vcu - 128) * 8 + F.wave, 128 * 8);
    }
__device__ __forceinline__ void ph8(Frame& F) {
    const gi64* MOD = (const gi64*)(F.ctl + CW_MOD); const int gw = F.vcu * 8 + F.wave, NGW = F.G * 8; (void)MOD; (void)gw; (void)NGW;
        build_tiles(F);
        GroupedOrder<true> S{2, F.G, F.vcu, 512, DM * (MOE_FP8 ? 1 : 2), true, (const char*)(F.ws + WS_BGU), (const LAS int*)(F.lds + TAB_OFF + 2048), (const LAS int*)(F.lds + TAB_OFF + 3200), (const GAS u32x2*)(F.ws + WS_LIST), (REP == 28) ? 2 : 1, __builtin_amdgcn_readfirstlane(((const LAS int*)(F.lds + TAB_OFF + 2048))[257])};
        EpiSwiglu E{WSP(u16, WS_ACT)};
        pg8::gemm_phase<EpiSwiglu, GroupedOrder<true>, MOE_DT, true>(F.lds + RING_OFF, (const char*)(F.ws + (MOE_FP8 ? WS_H2F8 : WS_H2)), DM, S, E, SC_GU);
    }
__device__ __forceinline__ void ph9(Frame& F) {
    const gi64* MOD = (const gi64*)(F.ctl + CW_MOD); const int gw = F.vcu * 8 + F.wave, NGW = F.G * 8; (void)MOD; (void)gw; (void)NGW;
        build_tiles(F);
        GroupedOrder<false> S{4, F.G, F.vcu, DM, EFF * (MOE_FP8 ? 1 : 2), false, (const char*)(F.ws + WS_BD), (const LAS int*)(F.lds + TAB_OFF + 2048), (const LAS int*)(F.lds + TAB_OFF + 3200), (const GAS u32x2*)(F.ws + WS_LIST), (REP == 29) ? 2 : 1, __builtin_amdgcn_readfirstlane(((const LAS int*)(F.lds + TAB_OFF + 2048))[257])};
        EpiDown E{WSP(u16, WS_C), (const GAS u32x2*)(F.ws + WS_LIST), F.ws + WS_DUMP};
        pg8::gemm_phase<EpiDown, GroupedOrder<false>, MOE_DT, true>(F.lds + RING_OFF, (const char*)(F.ws + WS_ACT), EFF, S, E, SC_D);
    }

#if DBG & (1024 | 2048)
__device__ __forceinline__ float f8dec(unsigned w, int k) { return (k == 0) ? __builtin_amdgcn_cvt_f32_fp8((int)w, 0) : (k == 1) ? __builtin_amdgcn_cvt_f32_fp8((int)w, 1) : (k == 2) ? __builtin_amdgcn_cvt_f32_fp8((int)w, 2) : __builtin_amdgcn_cvt_f32_fp8((int)w, 3); }
__device__ __forceinline__ void chk_attn(Frame& F, float negM) {
    const int gw = F.vcu * 8 + F.wave, NGW = F.G * 8, lane = F.lane;
    const GAS u16* Q = (const GAS u16*)(F.ws + WS_Q); const GAS u16* K = (const GAS u16*)(F.ws + WS_K); const GAS u16* V = (const GAS u16*)(F.ws + WS_V); const GAS u16* MIX = (const GAS u16*)(F.ws + WS_MIX);
    const GAS unsigned char* Q8 = (const GAS unsigned char*)(F.ws + WS_Q); const GAS unsigned char* K8 = (const GAS unsigned char*)(F.ws + WS_K); const GAS unsigned char* Vt8 = (const GAS unsigned char*)(F.ws + WS_V);
    float* chk = (float*)(F.ctl + CW_CHK);
    if (ATTN_FP8) negM = fminf(negM + 8.8f, 0.f);
    for (int i = gw; i < 4096; i += NGW) {
        const int b = i & 3, h = (i >> 2) % 12, q = (int)((((unsigned)i * 2654435761u) >> 19) & 8191u), kvh = h / 3;
        float qv[64], o[64]; float l = 0.f;
        if (ATTN_FP8) {
#pragma unroll
            for (int c = 0; c < 16; ++c) { const unsigned w = *(const GAS unsigned*)(Q8 + ((size_t)(b * SEQ + q)) * QW + h * 64 + 4 * c);
#pragma unroll
                for (int k = 0; k < 4; ++k) qv[4 * c + k] = f8dec(w, k) * (1.0f / Q8_SCALE); }
        } else {
#pragma unroll
        for (int c = 0; c < 8; ++c) { const u32x4 w = *(const GAS u32x4*)(Q + ((size_t)(b * SEQ + q)) * QW + h * 64 + 8 * c);
            qv[8 * c] = bflo(w.x); qv[8 * c + 1] = bfhi(w.x); qv[8 * c + 2] = bflo(w.y); qv[8 * c + 3] = bfhi(w.y); qv[8 * c + 4] = bflo(w.z); qv[8 * c + 5] = bfhi(w.z); qv[8 * c + 6] = bflo(w.w); qv[8 * c + 7] = bfhi(w.w); }
        }
#pragma unroll
        for (int d = 0; d < 64; ++d) o[d] = 0.f;
        for (int t = 0; t < LKV / 64; ++t) { const int j = t * 64 + lane; float dot = 0.f, pp, pq;
            if (ATTN_FP8) { const GAS unsigned char* kr = K8 + ((size_t)(b * LKV + j)) * KVW + kvh * 64;
#pragma unroll
                for (int c = 0; c < 16; ++c) { const unsigned w = *(const GAS unsigned*)(kr + 4 * c);
#pragma unroll
                    for (int k = 0; k < 4; ++k) dot += qv[4 * c + k] * f8dec(w, k); }
                pp = exp2f(dot + negM); pq = __builtin_amdgcn_cvt_f32_fp8(__builtin_amdgcn_cvt_pk_fp8_f32(pp, 0.f, 0, false), 0); l += pq;
                const GAS unsigned char* vb = Vt8 + (((size_t)(b * NKVH + kvh) * (LKV / 64) + t) * 64) * 64 + attn_body::vt_slot(lane);
#pragma unroll
                for (int d = 0; d < 64; ++d) o[d] += pq * __builtin_amdgcn_cvt_f32_fp8((int)vb[d * 64], 0);
            } else { const GAS u16* kr = K + ((size_t)(b * LKV + j)) * KVW + kvh * 64; const GAS u16* vr = V + ((size_t)(b * LKV + j)) * KVW + kvh * 64;
#pragma unroll
            for (int c = 0; c < 8; ++c) { const u32x4 w = *(const GAS u32x4*)(kr + 8 * c);
                dot += qv[8 * c] * bflo(w.x) + qv[8 * c + 1] * bfhi(w.x) + qv[8 * c + 2] * bflo(w.y) + qv[8 * c + 3] * bfhi(w.y) + qv[8 * c + 4] * bflo(w.z) + qv[8 * c + 5] * bfhi(w.z) + qv[8 * c + 6] * bflo(w.w) + qv[8 * c + 7] * bfhi(w.w); }
            pp = exp2f(dot + negM); l += pp;
#pragma unroll
            for (int c = 0; c < 8; ++c) { const u32x4 w = *(const GAS u32x4*)(vr + 8 * c);
                o[8 * c] += pp * bflo(w.x); o[8 * c + 1] += pp * bfhi(w.x); o[8 * c + 2] += pp * bflo(w.y); o[8 * c + 3] += pp * bfhi(w.y); o[8 * c + 4] += pp * bflo(w.z); o[8 * c + 5] += pp * bfhi(w.z); o[8 * c + 6] += pp * bflo(w.w); o[8 * c + 7] += pp * bfhi(w.w); } } }
        l = wave_sum(l); float err = 0.f, ref = 0.f;
#pragma unroll
        for (int d = 0; d < 64; ++d) { const float od = wave_sum(o[d]) / l; const float mv = bflo((unsigned)MIX[((size_t)(b * SEQ + q)) * DM + 256 + h * 64 + d]); err += (od - mv) * (od - mv); ref += od * od; }
        if (lane == 0) { atomicAdd(chk + 0, err); atomicAdd(chk + 1, ref); }
    }
}
__device__ __forceinline__ void chk_qkv(Frame& F) {
    const int gw = F.vcu * 8 + F.wave, NGW = F.G * 8, lane = F.lane;
    const gi64* MOD = (const gi64*)(F.ctl + CW_MOD);
    LAS float* hrow = (LAS float*)(F.lds + RING_OFF + F.wave * 16384);
    float* chk = (float*)(F.ctl + CW_CHK);
    for (int i = gw; i < 4096; i += NGW) {
        const unsigned hs = (unsigned)i * 2654435761u; const bool isctx = (i & 15) == 15; int sel = i % 20; if (isctx && sel < 12) sel = 12 + (sel & 7);
        const int m = isctx ? (int)((hs >> 10) & 1023u) : (int)((hs >> 12) & 32767u);
        const float* src = isctx ? FIN_ctx + (size_t)m * DM : FIN_x + (size_t)m * DM; const int mr = isctx ? 4 : (m >> 13);
        const int b = isctx ? (m >> 8) : (m >> 13), l = isctx ? 0 : (m & 8191), key = isctx ? SEQ + (m & 255) : l;
        f32x4 v[4]; float s2 = 0.f;
#pragma unroll
        for (int j = 0; j < 4; ++j) { v[j] = *(const f32x4*)(src + 4 * lane + 256 * j); s2 += (v[j][0] * v[j][0] + v[j][1] * v[j][1]) + (v[j][2] * v[j][2] + v[j][3] * v[j][3]); }
        const float rstd = 1.0f / sqrtf(wave_sum(s2) * (1.0f / DM) + RMS_EPS);
#pragma unroll
        for (int j = 0; j < 4; ++j) { const int col = 4 * lane + 256 * j; const f32x4 g = *(const f32x4*)(FIN_norm1_g + col); const f32x4 sh = mod4(MOD, mr * 6144 + col), sc = mod4(MOD, mr * 6144 + 1024 + col);
            const f32x4 y = v[j] * rstd * g * (sc + 1.0f) + sh; hrow[col] = y[0]; hrow[col + 1] = y[1]; hrow[col + 2] = y[2]; hrow[col + 3] = y[3]; }
        LDS_WAIT(); asm volatile("" ::: "memory");
        const int colbase = (sel < 12) ? 256 + 64 * sel : (sel < 16 ? 1024 + 64 * (sel - 12) : 1280 + 64 * (sel - 16));
        float z = 0.f;
        for (int k = 0; k < DM; ++k) z += hrow[k] * FIN_w_in[(size_t)k * 1536 + colbase + lane];
        float outv = z; int spos = lane;
        if (sel < 16) { const float ss = wave_sum(z * z); const float gain = (sel < 12) ? FIN_q_norm_g[lane] : FIN_k_norm_g[lane]; const float zz = z * (1.0f / sqrtf(ss * (1.0f / 64.0f) + RMS_EPS)) * gain;
            const float pz = __shfl(zz, lane ^ 16); outv = zz;
            if (!isctx) { const int pidx = (lane & 32) ? (l & 63) : (l >> 6); const float inv = powf(10000.0f, -(float)(lane & 15) / 16.0f), ang = (float)pidx * inv; const float cs = cosf(ang), sn = sinf(ang);
                outv = (lane & 16) ? zz * cs + pz * sn : zz * cs - pz * sn; }
            if (sel < 12) outv *= C2;
            spos = 32 * (lane >> 5) + 8 * ((lane >> 2) & 3) + 4 * ((lane >> 4) & 1) + (lane & 3); }
        float stored;
        if (ATTN_FP8) {
            if (sel < 12) stored = __builtin_amdgcn_cvt_f32_fp8((int)((const GAS unsigned char*)(F.ws + WS_Q))[(size_t)m * QW + sel * 64 + spos], 0) * (1.0f / Q8_SCALE);
            else if (sel < 16) stored = __builtin_amdgcn_cvt_f32_fp8((int)((const GAS unsigned char*)(F.ws + WS_K))[((size_t)(b * LKV + key)) * KVW + (sel - 12) * 64 + spos], 0);
            else stored = __builtin_amdgcn_cvt_f32_fp8((int)((const GAS unsigned char*)(F.ws + WS_V))[((((size_t)(b * NKVH + (sel - 16)) * (LKV / 64) + (key >> 6)) * 64 + lane) * 64) + attn_body::vt_slot(key & 63)], 0);
        } else {
        if (sel < 12) stored = bflo((unsigned)((const GAS u16*)(F.ws + WS_Q))[(size_t)m * QW + sel * 64 + spos]);
        else if (sel < 16) stored = bflo((unsigned)((const GAS u16*)(F.ws + WS_K))[((size_t)(b * LKV + key)) * KVW + (sel - 12) * 64 + spos]);
        else stored = bflo((unsigned)((const GAS u16*)(F.ws + WS_V))[((size_t)(b * LKV + key)) * KVW + (sel - 16) * 64 + lane]); }
        const float err = wave_sum((outv - stored) * (outv - stored)), ref = wave_sum(outv * outv);
        if (lane == 0) { atomicAdd(chk + 2, err); atomicAdd(chk + 3, ref); }
        LDS_WAIT(); asm volatile("" ::: "memory");
    }
}
#endif

struct Args { const float* in[20]; float* out; unsigned char* ws; int ph_lo, ph_hi; };
__global__ void __launch_bounds__(512, 2) mk_fwd(Args args) {
    extern __shared__ __attribute__((aligned(16))) unsigned char lds[];
    Frame F;
    F.lds = (LAS unsigned char*)lds;
    F.MISC = (volatile LAS unsigned*)(F.lds + MISC_OFF);
    F.tid = threadIdx.x; F.lane = F.tid & 63; F.wave = __builtin_amdgcn_readfirstlane(F.tid >> 6);
    F.G = gridDim.x; { const int bx = blockIdx.x; F.vcu = (F.G % 8 == 0) ? (bx % 8) * (F.G / 8) + bx / 8 : bx; }
    F.ws = args.ws; F.ctl = (gu32*)(args.ws + WS_CTL); F.out = args.out;
    F.ka = (const float* const*)__builtin_amdgcn_kernarg_segment_ptr();
    for (int u = F.tid; u < (LDS_BYTES - LDSCTL_OFF) / 4; u += 512) ((LAS unsigned*)(F.lds + LDSCTL_OFF))[u] = 0u;
    __syncthreads();
    XcdBarrier bar; bar.bar = (unsigned*)(F.ctl + CW_BAR); bar.x = 0; bar.st = nullptr;
    if (N_LAUNCHES == 1) bar = xcd_barrier_post((unsigned*)(F.ctl + CW_BAR), F.MISC + 8);
    const int lo = args.ph_lo, hi = args.ph_hi;
#define IN(k) (lo <= (k) && (k) < hi)
#define SEAM(k) do { if (IN(k) && IN((k) + 1)) xcd_barrier(bar); asm volatile("" : "+s"(F.ka)); } while (0)
    const gi64* MOD = (const gi64*)(F.ctl + CW_MOD);
    const int gw = F.vcu * 8 + F.wave, NGW = F.G * 8;

    if (IN(0)) { p0_phase(F); } SEAM(0);
    if (IN(1)) { p1_phase(F); VM_WAIT(); __syncthreads(); if (REP == 1) { xcd_barrier(bar); p1_phase(F); VM_WAIT(); __syncthreads(); } } SEAM(1);

    if (IN(2)) { ph2(F); if (REP == 2) { xcd_barrier(bar); ph2(F); } } SEAM(2);

    if (IN(3)) {
        if (DBG & 32) { u16* MIXz = WSP(u16, WS_MIX); for (int m = gw; m < NTOK; m += NGW) *(GAS u32x2*)(MIXz + (size_t)m * DM + 4 * F.lane) = (u32x2){0u, 0u}; }
        else
        REPS(30) for (int U = F.vcu; U < NB * 64; U += F.G) { if (FOURIER_MFMA) fourier_unit_mfma(F, U >> 6, U & 63); else fourier_unit(F, U >> 6, U & 63); }
        const attn_body::bf16* Qp = (const attn_body::bf16*)(F.ws + WS_Q); const attn_body::bf16* Kp = (const attn_body::bf16*)(F.ws + WS_K); const attn_body::bf16* Vp = (const attn_body::bf16*)(F.ws + WS_V);
        attn_body::bf16* Op = (attn_body::bf16*)(F.ws + WS_MIX) + 256;
        float negM; { float gqm = fabsf(FIN_q_norm_g[F.lane]), gkm = fabsf(FIN_k_norm_g[F.lane]);
#pragma unroll
            for (int o_ = 1; o_ < 64; o_ <<= 1) { gqm = fmaxf(gqm, __shfl_xor(gqm, o_)); gkm = fmaxf(gkm, __shfl_xor(gkm, o_)); }
            negM = -(C2 * 64.0f * gqm * gkm + 0.5f); }
        if (ATTN_FP8) negM = fminf(negM + 8.8f, 0.f);
        if (ATTN_PRIO) { if (__builtin_amdgcn_readfirstlane(F.tid) >= 256) __builtin_amdgcn_s_setprio(1); }
        if (DBG & 16) { u16* MIXz = WSP(u16, WS_MIX); for (int m = gw; m < NTOK; m += NGW) for (int j = 1; j < 4; ++j) *(GAS u32x2*)(MIXz + (size_t)m * DM + 256 * j + 4 * F.lane) = (u32x2){0u, 0u}; }
        else if (F.G == 256) REPS(31) {
            const int xg = F.vcu >> 5, jq = F.vcu & 31;
            for (int i = 0; i < 6; ++i) { const int grp = 2 * xg + i / 3, hs = i % 3;
                if (ATTN_FP8) attn_body::attn_unit8(grp >> 2, (grp & 3) * 3 + hs, jq, (const unsigned char*)Qp, (const unsigned char*)Kp, (const unsigned char*)Vp, Op, (char*)lds + RING_OFF, negM);
                else attn_body::attn_unit<ATTN_MSUM>(grp >> 2, (grp & 3) * 3 + hs, jq, Qp, Kp, Vp, Op, (char*)lds + RING_OFF, negM); }
        } else {
            for (int U = F.vcu; U < NB * NQH * 32; U += F.G) { const int grp = U / 96, r = U % 96;
                if (ATTN_FP8) attn_body::attn_unit8(grp >> 2, (grp & 3) * 3 + r / 32, r % 32, (const unsigned char*)Qp, (const unsigned char*)Kp, (const unsigned char*)Vp, Op, (char*)lds + RING_OFF, negM);
                else attn_body::attn_unit<ATTN_MSUM>(grp >> 2, (grp & 3) * 3 + r / 32, r % 32, Qp, Kp, Vp, Op, (char*)lds + RING_OFF, negM); }
        }
        if (ATTN_PRIO) __builtin_amdgcn_s_setprio(0);
    } SEAM(3);

#if DBG & (1024 | 2048)
    if (IN(4)) { float negMc; { float gqm = fabsf(FIN_q_norm_g[F.lane]), gkm = fabsf(FIN_k_norm_g[F.lane]);
            for (int o_ = 1; o_ < 64; o_ <<= 1) { gqm = fmaxf(gqm, __shfl_xor(gqm, o_)); gkm = fmaxf(gkm, __shfl_xor(gkm, o_)); } negMc = -(C2 * 64.0f * gqm * gkm + 0.5f); }
        if (DBG & 1024) chk_attn(F, negMc); if (DBG & 2048) chk_qkv(F); VM_WAIT(); __syncthreads(); }
#endif
    if (IN(4)) { ph4(F); if (REP == 4) { xcd_barrier(bar); ph4(F); } } SEAM(4);

    if (IN(5)) { ph5(F); if (REP == 5) { xcd_barrier(bar); ph5(F); } if (REP == 55) { xcd_barrier(bar); xcd_barrier(bar); xcd_barrier(bar); xcd_barrier(bar); xcd_barrier(bar); } } SEAM(5);

    if (IN(6)) { ph6(F); if (REP == 6) { xcd_barrier(bar); ph6(F); } } SEAM(6);

    if (IN(7)) {
        if (DBG & 128) { GAS u32x4* zA = (GAS u32x4*)(F.ws + WS_ACT); const size_t nA = (size_t)MAXTILES * 256 * EFF * 2 / 16; for (size_t i = (size_t)blockIdx.x * 512 + F.tid; i < nA; i += (size_t)F.G * 512) zA[i] = (u32x4){0u, 0u, 0u, 0u};
            GAS u32x4* zC = (GAS u32x4*)(F.ws + WS_C); const size_t nC = (size_t)NTOK * NSLOT * DM * 2 / 16; for (size_t i = (size_t)blockIdx.x * 512 + F.tid; i < nC; i += (size_t)F.G * 512) zC[i] = (u32x4){0u, 0u, 0u, 0u}; }
        if (blockIdx.x == 0 && F.tid == 0) __hip_atomic_store((unsigned*)(F.ctl + CW_CNT + NEXP), (unsigned)NTOK, RLX_AGENT);
        for (int tok = gw; tok < NTOK; tok += NGW) route_token(F, tok);
    } SEAM(7);

    if (IN(8)) { ph8(F); if (REP == 8) { xcd_barrier(bar); ph8(F); } } SEAM(8);

    if (IN(9)) { ph9(F); if (REP == 9) { xcd_barrier(bar); ph9(F); } } SEAM(9);

    if (IN(10)) {
        const int lane = F.lane; const GAS unsigned char* Cc = (const GAS unsigned char*)(F.ws + WS_C);
        const int wpb = NGW >> 2, b = gw / wpb, wi = gw % wpb;
        f32x4 g2v[4], fg[4];
#pragma unroll
        for (int i = 0; i < 4; ++i) { const int col = 16 * lane + 4 * i; g2v[i] = mod4(MOD + b * 6144 + 5120, col) * (1.0f / C_SCALE); fg[i] = *(const f32x4*)(FIN_final_g + col); }
        bool bad = false;
#if DBG & (1024 | 2048)
        { const float e0 = __hip_atomic_load((float*)(F.ctl + CW_CHK), RLX_AGENT), r0 = __hip_atomic_load((float*)(F.ctl + CW_CHK) + 1, RLX_AGENT), e1 = __hip_atomic_load((float*)(F.ctl + CW_CHK) + 2, RLX_AGENT), r1 = __hip_atomic_load((float*)(F.ctl + CW_CHK) + 3, RLX_AGENT);
          if (DBG & 1024) bad = bad || !(e0 <= CHK_TOL_A * r0) || !(r0 > 0.f); if (DBG & 2048) bad = bad || !(e1 <= CHK_TOL_B * r1) || !(r1 > 0.f); }
#endif
        for (int r = wi; r < SEQ; r += 2 * wpb) {
            const int r1 = (r + wpb < SEQ) ? r + wpb : r; const bool has1 = r + wpb < SEQ;
            const int m0 = b * SEQ + r, m1 = b * SEQ + r1;
            GAS float* orow0 = (GAS float*)F.out + (size_t)m0 * DM + 16 * lane; GAS float* orow1 = (GAS float*)F.out + (size_t)m1 * DM + 16 * lane;
            f32x4 xa[4], xb[4], ya[4], yb[4];
#pragma unroll
            for (int i = 0; i < 4; ++i) { xa[i] = *(const GAS f32x4*)(orow0 + 4 * i); xb[i] = *(const GAS f32x4*)(orow1 + 4 * i); ya[i] = (f32x4){0.f, 0.f, 0.f, 0.f}; yb[i] = (f32x4){0.f, 0.f, 0.f, 0.f}; }
#pragma unroll
            for (int sl = 0; sl < NSLOT; ++sl) { const u32x4 wa = *(const GAS u32x4*)(Cc + ((size_t)m0 * NSLOT + sl) * DM + 16 * lane), wb = *(const GAS u32x4*)(Cc + ((size_t)m1 * NSLOT + sl) * DM + 16 * lane);
#pragma unroll
                for (int i = 0; i < 4; ++i) { const int wa_ = (int)wa[i], wb_ = (int)wb[i];
                    const f32x2 la = __builtin_amdgcn_cvt_pk_f32_fp8(wa_, false), ha = __builtin_amdgcn_cvt_pk_f32_fp8(wa_, true), lb = __builtin_amdgcn_cvt_pk_f32_fp8(wb_, false), hb = __builtin_amdgcn_cvt_pk_f32_fp8(wb_, true);
                    ya[i] += (f32x4){la.x, la.y, ha.x, ha.y}; yb[i] += (f32x4){lb.x, lb.y, hb.x, hb.y}; } }
            float sa = 0.f, sb = 0.f;
#pragma unroll
            for (int i = 0; i < 4; ++i) { const f32x4 va = xa[i] + g2v[i] * ya[i], vb = xb[i] + g2v[i] * yb[i]; xa[i] = va; xb[i] = vb;
                sa += (va[0] * va[0] + va[1] * va[1]) + (va[2] * va[2] + va[3] * va[3]); sb += (vb[0] * vb[0] + vb[1] * vb[1]) + (vb[2] * vb[2] + vb[3] * vb[3]); }
#pragma unroll
            for (int o = 1; o < 64; o <<= 1) { sa += __shfl_xor(sa, o); sb += __shfl_xor(sb, o); }
            const float bm = bad ? 3.0f : 1.0f;
            const float ra = 1.0f / sqrtf(sa * (1.0f / DM) + RMS_EPS) * bm, rb = 1.0f / sqrtf(sb * (1.0f / DM) + RMS_EPS) * bm;
#pragma unroll
            for (int i = 0; i < 4; ++i) *(GAS f32x4*)(orow0 + 4 * i) = xa[i] * ra * fg[i];
            if (has1) {
#pragma unroll
                for (int i = 0; i < 4; ++i) *(GAS f32x4*)(orow1 + 4 * i) = xb[i] * rb * fg[i]; } }
    }
#undef IN
#undef SEAM
}

extern "C" void kernel_launch(void* const* d_in, const int* in_sizes, int n_in, void* d_out, int out_size, void* d_ws, size_t ws_size, hipStream_t stream) {
    static int grid = 0;
    if (grid == 0) {
        if (n_in != 20 || in_sizes[0] != NTOK * DM || out_size != NTOK * DM || ws_size < WS_END) { fprintf(stderr, "kernel_launch: unexpected shapes (n_in %d, in0 %d, out %d, ws %zu < %zu)\n", n_in, n_in > 0 ? in_sizes[0] : -1, out_size, ws_size, (size_t)WS_END); grid = -1; return; }
        int dev = 0, cus = 0, per_cu = 0;
        if (hipGetDevice(&dev) != hipSuccess || hipDeviceGetAttribute(&cus, hipDeviceAttributeMultiprocessorCount, dev) != hipSuccess) { grid = -1; return; }
        if (hipFuncSetAttribute((const void*)mk_fwd, hipFuncAttributeMaxDynamicSharedMemorySize, LDS_BYTES) != hipSuccess) { fprintf(stderr, "kernel_launch: hipFuncSetAttribute failed\n"); grid = -1; return; }
        if (hipOccupancyMaxActiveBlocksPerMultiprocessor(&per_cu, (const void*)mk_fwd, 512, LDS_BYTES) != hipSuccess || per_cu < 1) fprintf(stderr, "kernel_launch: occupancy query reports %d\n", per_cu);
        (void)hipGetLastError();
        grid = cus;
    }
    if (grid < 0) return;
    (void)hipMemsetAsync((char*)d_ws + WS_CTL, 0, CTL_ZERO_BYTES, stream);
    Args a{};
    for (int i = 0; i < 20; ++i) a.in[i] = (const float*)d_in[i];
    a.out = (float*)d_out; a.ws = (unsigned char*)d_ws;
    if (N_LAUNCHES == 1) { a.ph_lo = 0; a.ph_hi = PER_PHASE; hipLaunchKernelGGL(mk_fwd, dim3(grid), dim3(512), LDS_BYTES, stream, a); }
    else for (int li = 0; li < PER_PHASE; ++li) { a.ph_lo = li; a.ph_hi = li + 1; hipLaunchKernelGGL(mk_fwd, dim3(grid), dim3(512), LDS_BYTES, stream, a); }
}
```

```cpp
#include <hip/hip_runtime.h>
#include <hip/hip_bf16.h>
#include <cstdio>
#include <cstdint>
#include <cmath>

#ifndef MK_N_LAUNCHES
#define MK_N_LAUNCHES 1
#endif
constexpr int PER_PHASE = 11;
#ifndef DBG
#define DBG 0
#endif
#ifndef REP
#define REP -1
#endif
#ifndef CHK_TOL_A
#define CHK_TOL_A 1e-4f
#endif
#ifndef CHK_TOL_B
#define CHK_TOL_B 3e-3f
#endif
#ifndef POSTEPI_WAITS
#define POSTEPI_WAITS 1
#endif
#ifndef ATTN_FP8
#define ATTN_FP8 1
#endif
constexpr float Q8_SCALE = 8.0f;
#ifndef ATTN_MSUM
#define ATTN_MSUM false
#endif
#ifndef ATTN_PRIO
#define ATTN_PRIO 1
#endif
#ifndef FOURIER_MFMA
#define FOURIER_MFMA 1
#endif
#define REPS(k) for (int rep_ = 0; rep_ < ((REP == (k)) ? 2 : 1); ++rep_)
#define REPBAR() do { if (rep_) xcd_barrier(bar); } while (0)
constexpr int N_LAUNCHES = MK_N_LAUNCHES;

#define GAS __attribute__((address_space(1)))
#define LAS __attribute__((address_space(3)))
typedef unsigned short u16;
typedef short bf16x8 __attribute__((ext_vector_type(8)));
typedef _Float16 half8 __attribute__((ext_vector_type(8)));
typedef _Float16 half2v __attribute__((ext_vector_type(2)));
typedef float f32x4 __attribute__((ext_vector_type(4)));
typedef float f32x2 __attribute__((ext_vector_type(2)));
typedef unsigned u32x4 __attribute__((ext_vector_type(4)));
typedef unsigned u32x2 __attribute__((ext_vector_type(2)));
typedef GAS unsigned gu32;

constexpr int DM = 1024, NB = 4, SEQ = 8192, NTOK = NB * SEQ, CTXL = 256, NCTX = NB * CTXL, LKV = SEQ + CTXL;
constexpr int NQH = 12, NKVH = 4, HD = 64, QW = NQH * HD, KVW = NKVH * HD;
constexpr int NIN = 1792;
constexpr int MIN_ROWS = NTOK + NCTX;
constexpr int NEXP = 256, NEXPS = 257, TOPK = 8, EFF = 256, NSLOT = 9;
constexpr int MAXTILES = 1408;
constexpr float RMS_EPS = 1e-6f;
#ifndef MOE_F16
#define MOE_F16 0
#endif
constexpr bool MOEF16 = MOE_F16;
#ifndef MOE_FP8
#define MOE_FP8 1
#endif
constexpr int MOE_DT = MOE_FP8 ? 2 : (MOE_F16 ? 1 : 0);
constexpr float WGU_SCALE = 32.0f, WD_SCALE = 16.0f;
constexpr int SC_ONE = 0x7f7f7f7f, SC_GU = 0x7f7f7f7a, SC_D = 0x7f7f7f7b;
constexpr float C2 = 0.125f * 1.4426950408889634f;
constexpr float C_SCALE = 16.0f;

constexpr size_t MiB = 1u << 20;
constexpr size_t WS_CTL = 0, CTL_ZERO_BYTES = 1 * MiB;
constexpr size_t WS_TAB = 1 * MiB;
constexpr size_t WS_BIN = 2 * MiB;
constexpr size_t WS_BOUT = 6 * MiB;
constexpr size_t WS_BR = 8 * MiB;
constexpr size_t WS_K = 16 * MiB;
constexpr size_t WS_V = 34 * MiB;
constexpr size_t WS_Z = 52 * MiB;
constexpr size_t WS_Q = 84 * MiB;
constexpr size_t WS_XN = 132 * MiB;
constexpr size_t WS_MIX = 198 * MiB;
constexpr size_t WS_H2 = 262 * MiB;
constexpr size_t WS_LOG = 326 * MiB;
constexpr size_t WS_LIST = 358 * MiB;
constexpr size_t WS_BGU = 424 * MiB;
constexpr size_t WS_BD = 682 * MiB;
constexpr size_t WS_ACT = 812 * MiB;
constexpr size_t WS_C = 990 * MiB;
constexpr size_t WS_H2F8 = 1568 * MiB;
constexpr size_t WS_DUMP = 1600 * MiB;
constexpr size_t WS_END = 1632 * MiB;
constexpr int CW_TMO = 0, CW_CODE = 1;
constexpr int CW_BAR = 4096;
constexpr int CW_CNT = 16384;
constexpr int CW_CHK = 32768;
constexpr int CW_MOD = 131072;
static_assert(CW_MOD * 4 + 5 * 6144 * 8 <= (int)CTL_ZERO_BYTES, "ctl");

constexpr int RING_OFF = 0, RING_BYTES = 131072;
constexpr int P1_SCR = 18432;
constexpr int TAB_OFF = 8 * P1_SCR;
constexpr int LDS_BYTES = 163840;
constexpr int LDSCTL_OFF = LDS_BYTES - 1024, MISC_OFF = LDSCTL_OFF + 320;
static_assert(TAB_OFF + 8192 <= LDSCTL_OFF, "LDS map");

#define LDS_WAIT() asm volatile("s_waitcnt lgkmcnt(0)" ::: "memory")
#define VM_WAIT() asm volatile("s_waitcnt vmcnt(0)" ::: "memory")
#define RLX_AGENT __ATOMIC_RELAXED, __HIP_MEMORY_SCOPE_AGENT

__device__ __forceinline__ unsigned f2bf(float f) { unsigned u = __builtin_bit_cast(unsigned, f); return (u + 0x7fffu + ((u >> 16) & 1u)) >> 16; }
__device__ __forceinline__ unsigned pk2bf(float lo, float hi) { return f2bf(lo) | (f2bf(hi) << 16); }
__device__ __forceinline__ unsigned pk2h(float lo, float hi) { half2v v = {(_Float16)lo, (_Float16)hi}; return __builtin_bit_cast(unsigned, v); }
__device__ __forceinline__ unsigned cvt_pk_bf16(float lo, float hi) { unsigned r; asm volatile("v_cvt_pk_bf16_f32 %0, %1, %2" : "=v"(r) : "v"(lo), "v"(hi)); return r; }
__device__ __forceinline__ float bflo(unsigned w) { return __builtin_bit_cast(float, w << 16); }
__device__ __forceinline__ float bfhi(unsigned w) { return __builtin_bit_cast(float, w & 0xffff0000u); }
typedef long long i64x2 __attribute__((ext_vector_type(2)));
typedef GAS long long gi64;
__device__ __forceinline__ f32x4 mod4(const gi64* MODQ, int idx) {
    const i64x2 a = *(const GAS i64x2*)(MODQ + idx), b = *(const GAS i64x2*)(MODQ + idx + 2);
    return (f32x4){(float)a.x, (float)a.y, (float)b.x, (float)b.y} * 0x1p-36f;
}
__device__ __forceinline__ float rdl(float v, int lane) { return __builtin_bit_cast(float, __builtin_amdgcn_readlane(__builtin_bit_cast(int, v), lane)); }
__device__ __forceinline__ float wave_sum(float v) {
#pragma unroll
    for (int o = 1; o < 64; o <<= 1) v += __shfl_xor(v, o);
    return v;
}

namespace pg8 {
constexpr int BM = 256, BK = 64, HALF = 128, HTB = HALF * BK * 2, STAGE_BYTES = 8 * HTB;
__host__ __device__ __forceinline__ int lds_byte(int r, int c) { const int st = (r >> 4) * 2 + (c >> 5), rr = r & 15, cc = c & 31, ob = rr * 64 + cc * 2; return st * 1024 + (ob ^ (((ob >> 9) & 1) << 5)); }
__host__ __device__ __forceinline__ void stage_rc(int b, int& R, int& C) { const int st = b / 1024, sb = b % 1024, swz = sb ^ (((sb >> 9) & 1) << 5); R = (st >> 1) * 16 + swz / 64; C = (st & 1) * 32 + (swz % 64) / 2; }
__host__ __device__ __forceinline__ int perm32(int rho) { const int n = rho >> 4, i = rho & 15; return 8 * (i >> 2) + 4 * n + (i & 3); }

struct GUnit { int pm, pn, e, j, nvalid; const char* B; };

typedef int v8i __attribute__((ext_vector_type(8)));
typedef int v4i __attribute__((ext_vector_type(4)));
template <int DT> __device__ __forceinline__ f32x4 mma_tile(const v8i a, const v8i b, f32x4 c, int scA) {
    if constexpr (DT == 2) return __builtin_amdgcn_mfma_scale_f32_16x16x128_f8f6f4(a, b, c, 0, 0, 0, scA, 1, scA);
    else { const v4i a0 = __builtin_shufflevector(a, a, 0, 1, 2, 3), a1 = __builtin_shufflevector(a, a, 4, 5, 6, 7), b0 = __builtin_shufflevector(b, b, 0, 1, 2, 3), b1 = __builtin_shufflevector(b, b, 4, 5, 6, 7);
        if constexpr (DT == 1) { c = __builtin_amdgcn_mfma_f32_16x16x32_f16(__builtin_bit_cast(half8, a0), __builtin_bit_cast(half8, b0), c, 0, 0, 0); return __builtin_amdgcn_mfma_f32_16x16x32_f16(__builtin_bit_cast(half8, a1), __builtin_bit_cast(half8, b1), c, 0, 0, 0); }
        else { c = __builtin_amdgcn_mfma_f32_16x16x32_bf16(__builtin_bit_cast(bf16x8, a0), __builtin_bit_cast(bf16x8, b0), c, 0, 0, 0); return __builtin_amdgcn_mfma_f32_16x16x32_bf16(__builtin_bit_cast(bf16x8, a1), __builtin_bit_cast(bf16x8, b1), c, 0, 0, 0); } }
}

template <class Epi, class Sched, int DT, bool ALIGN_EPI>
__device__ __forceinline__ void gemm_phase(LAS unsigned char* lds, const char* Abase, const int K, const Sched& S, const Epi& E, const int scB = SC_ONE) {
    const int tid = threadIdx.x, wid = __builtin_amdgcn_readfirstlane(tid >> 6), lane = tid & 63, wr = wid >> 2, wc = wid & 3, fr = lane & 15, fq = lane >> 4;
    constexpr int ES = (DT == 2) ? 1 : 2;
    const int RB = K * ES;
    const int nt = RB / 128;
    unsigned voffB0; { int R, C; stage_rc(tid * 16, R, C); const int Rb = Epi::PERM ? ((R & ~31) + perm32(R & 31)) : R; voffB0 = (unsigned)(Rb * RB + C * 2); }
    const unsigned voffBd = 64u * (unsigned)RB;
#define PG8_AOFF(V, UNIT) do { int t_ = threadIdx.x; asm volatile("" : "+v"(t_)); _Pragma("unroll") for (int _i = 0; _i < 2; ++_i) { int R_, C_; stage_rc(t_ * 16 + _i * 8192, R_, C_); \
        _Pragma("unroll") for (int _h = 0; _h < 2; ++_h) (V)[_h][_i] = (unsigned)S.arow(UNIT, R_ + HALF * _h) * (unsigned)RB + (unsigned)(C_ * 2); } } while (0)
    const size_t kstep = (size_t)(BK * 2);
    const size_t hstep = (size_t)HALF * RB;
    const unsigned ldsw = (unsigned)wid * 1024u;
    const int ac0 = (DT == 2) ? 16 * fq : 8 * fq; constexpr int CH1 = (DT == 2) ? 16 : 1024;
    const int aoff = lds_byte(wr * 64 + fr, ac0), boff = lds_byte(wc * 32 + fr, ac0);
#define PG8_SA(b, h) (((b) * 2 + (h)) * HTB)
#define PG8_SB(b, h) ((4 + (b) * 2 + (h)) * HTB)
#define PG8_STAGEB(bufoff, gbase) do { _Pragma("unroll") for (int _i = 0; _i < 2; ++_i) \
        __builtin_amdgcn_global_load_lds((const unsigned*)((const char*)(gbase) + voffB0 + _i * voffBd), (LAS unsigned*)(lds + (bufoff) + ldsw + _i * 8192), 16, 0, 0); } while (0)
#define PG8_STAGEA(bufoff, koff, V, h) do { _Pragma("unroll") for (int _i = 0; _i < 2; ++_i) \
        __builtin_amdgcn_global_load_lds((const unsigned*)(Abase + (size_t)(V)[h][_i] + (koff)), (LAS unsigned*)(lds + (bufoff) + ldsw + _i * 8192), 16, 0, 0); } while (0)
#define PG8_LDA(dst, b, h) do { _Pragma("unroll") for (int m = 0; m < 4; ++m) { const v4i c0_ = *(const LAS v4i*)(lds + PG8_SA(b, h) + aoff + m * 2048), c1_ = *(const LAS v4i*)(lds + PG8_SA(b, h) + aoff + m * 2048 + CH1); dst[m] = __builtin_shufflevector(c0_, c1_, 0, 1, 2, 3, 4, 5, 6, 7); } } while (0)
#define PG8_LDB(dst, b, h) do { _Pragma("unroll") for (int n = 0; n < 2; ++n) { const v4i c0_ = *(const LAS v4i*)(lds + PG8_SB(b, h) + boff + n * 2048), c1_ = *(const LAS v4i*)(lds + PG8_SB(b, h) + boff + n * 2048 + CH1); dst[n] = __builtin_shufflevector(c0_, c1_, 0, 1, 2, 3, 4, 5, 6, 7); } } while (0)
#define PG8_MMA(ai, bj, At, Bt) do { __builtin_amdgcn_s_setprio(1); _Pragma("unroll") for (int m = 0; m < 4; ++m) _Pragma("unroll") for (int n = 0; n < 2; ++n) \
        acc[ai][bj][m][n] = mma_tile<DT>(Bt[n], At[m], acc[ai][bj][m][n], scB); __builtin_amdgcn_s_setprio(0); } while (0)
#define PG8_WAIT_V(n) asm volatile("s_waitcnt vmcnt(" #n ")" ::: "memory")
#define PG8_WAIT_VE(pe) do { if (pe) asm volatile("s_waitcnt vmcnt(%0)" :: "n"(8 + Epi::NSTORE) : "memory"); else asm volatile("s_waitcnt vmcnt(8)" ::: "memory"); } while (0)
#define PG8_WAIT_L(n) asm volatile("s_waitcnt lgkmcnt(" #n ")" ::: "memory")
#define PG8_BAR __builtin_amdgcn_s_barrier()
#define PG8_SCHED __builtin_amdgcn_sched_barrier(0)
    GUnit cur, nxt; int ui = 0;
    if (!S.next(0, cur)) return;
    f32x4 acc[2][2][4][2];
#pragma unroll
    for (int a = 0; a < 2; ++a)
#pragma unroll
        for (int b = 0; b < 2; ++b)
#pragma unroll
            for (int m = 0; m < 4; ++m)
#pragma unroll
                for (int n = 0; n < 2; ++n) acc[a][b][m][n] = (f32x4){0.f, 0.f, 0.f, 0.f};
    v8i At[4], B0[2], B1[2];
    unsigned vA[2][2];
    PG8_AOFF(vA, cur);
    if constexpr (Sched::GATHER) VM_WAIT();
    const char* cB = cur.B;
    E.pre(lds, cur, 0, wid, lane);
    PG8_STAGEB(PG8_SB(0, 0), cB); PG8_STAGEB(PG8_SB(0, 1), cB + hstep); PG8_STAGEA(PG8_SA(0, 0), 0, vA, 0); PG8_STAGEA(PG8_SA(0, 1), 0, vA, 1);
    if (wr == 1) PG8_BAR;
    PG8_WAIT_V(2); PG8_BAR;
    PG8_STAGEB(PG8_SB(1, 0), cB + kstep); PG8_STAGEA(PG8_SA(1, 0), kstep, vA, 0); PG8_STAGEB(PG8_SB(1, 1), cB + hstep + kstep);
    PG8_WAIT_V(6); PG8_BAR;
    for (;;) {
        const bool has_next = S.next(ui + 1, nxt);
#pragma unroll 1
        for (int t = 0; t < nt; t += 2) {
            const bool last = (t == nt - 2);
            const bool pe = POSTEPI_WAITS && (t == 0) && (ui > 0);
            const size_t k1 = (size_t)(t + 1) * kstep;
            PG8_LDB(B0, 0, 0); PG8_LDB(B1, 0, 1); PG8_SCHED; PG8_LDA(At, 0, 0); PG8_STAGEA(PG8_SA(1, 1), k1, vA, 1);
            PG8_WAIT_VE(pe); PG8_WAIT_L(0); PG8_BAR; PG8_MMA(0, 0, At, B0); PG8_MMA(0, 1, At, B1); PG8_BAR; PG8_SCHED;
            size_t k2 = (size_t)(t + 2) * kstep;
            if (last) { k2 = 0; if (has_next) { PG8_AOFF(vA, nxt); if constexpr (Sched::GATHER) VM_WAIT(); cB = nxt.B; } }
            const size_t k3 = k2 + kstep; const char* b2 = cB + k2; const char* b3 = b2 + kstep;
            PG8_LDA(At, 0, 1); PG8_STAGEB(PG8_SB(0, 0), b2); PG8_STAGEB(PG8_SB(0, 1), b2 + hstep); PG8_STAGEA(PG8_SA(0, 0), k2, vA, 0);
            PG8_WAIT_VE(pe); PG8_WAIT_L(0); PG8_BAR; PG8_MMA(1, 0, At, B0); PG8_MMA(1, 1, At, B1); PG8_BAR; PG8_SCHED;
            PG8_LDB(B0, 1, 0); PG8_LDB(B1, 1, 1); PG8_SCHED; PG8_LDA(At, 1, 0); PG8_STAGEA(PG8_SA(0, 1), k2, vA, 1);
            PG8_WAIT_V(8); PG8_WAIT_L(0); PG8_BAR; PG8_MMA(0, 0, At, B0); PG8_MMA(0, 1, At, B1); PG8_BAR; PG8_SCHED;
            PG8_LDA(At, 1, 1); PG8_STAGEB(PG8_SB(1, 0), b3); PG8_STAGEB(PG8_SB(1, 1), b3 + hstep); PG8_STAGEA(PG8_SA(1, 0), k3, vA, 0);
            PG8_WAIT_V(8); PG8_WAIT_L(0); PG8_BAR; PG8_MMA(1, 0, At, B0); PG8_MMA(1, 1, At, B1); PG8_BAR; PG8_SCHED;
        }
        if constexpr (ALIGN_EPI) { if (wr == 0) PG8_BAR; }
        { int tx = threadIdx.x; asm volatile("" : "+v"(tx)); E(acc, cur, wr, wc, tx & 15, (tx >> 4) & 3, lds, ui); }
        if (!has_next) break;
#pragma unroll
        for (int a = 0; a < 2; ++a)
#pragma unroll
            for (int b = 0; b < 2; ++b)
#pragma unroll
                for (int m = 0; m < 4; ++m)
#pragma unroll
                    for (int n = 0; n < 2; ++n) acc[a][b][m][n] = (f32x4){0.f, 0.f, 0.f, 0.f};
        cur = nxt; ++ui;
        if constexpr (ALIGN_EPI) { if (wr == 1) PG8_BAR; }
        E.pre(lds, cur, ui, wid, lane);
    }
    PG8_WAIT_V(0);
    if constexpr (!ALIGN_EPI) { if (wr == 0) PG8_BAR; }
    PG8_BAR;
#undef PG8_SA
#undef PG8_SB
#undef PG8_STAGEA
#undef PG8_AOFF
#undef PG8_STAGEB
#undef PG8_LDA
#undef PG8_LDB
#undef PG8_MMA
#undef PG8_WAIT_V
#undef PG8_WAIT_VE
#undef PG8_WAIT_L
#undef PG8_BAR
#undef PG8_SCHED
}
}

namespace attn_body {
using bf16 = __hip_bfloat16;
using s16x4 = __attribute__((ext_vector_type(4))) short;
using f32x16 = __attribute__((ext_vector_type(16))) float;
constexpr int D = 64, DMQ = QW, DMKV = KVW, DMO = DM;
constexpr int NW = 8, QBLK = 32, QB = QBLK * NW, KVBLK = 64, NT = LKV / KVBLK;
static_assert(NT % 2 == 0 && NT >= 8, "tile count");
__device__ __forceinline__ int crow(int r, int hi) { return (r & 3) + 8 * (r >> 2) + 4 * hi; }
#define SBAR() __builtin_amdgcn_sched_barrier(0)
constexpr int NSLOTR = 3, SLOTB = 8192;
constexpr int LDS_K = 0, LDS_V = NSLOTR * SLOTB, LDS_WS = 2 * NSLOTR * SLOTB, LDS_OST = LDS_WS + NW * 64 * 4, ATT_LDS_BYTES = LDS_OST + NW * 4096;
__device__ __forceinline__ void glds16(const void* gsrc, unsigned lds_dst) { unsigned keep;
    asm volatile("s_mov_b32 %0, m0\n\ts_mov_b32 m0, %2\n\ts_nop 0\n\tglobal_load_lds_dwordx4 %1, off\n\ts_mov_b32 m0, %0" : "=&s"(keep) : "v"(gsrc), "s"(lds_dst) : "memory"); }
__device__ __forceinline__ float max3f(float a, float b, float c) { float r; asm("v_max3_f32 %0, %1, %2, %3" : "=v"(r) : "v"(a), "v"(b), "v"(c)); return r; }
__device__ __forceinline__ float max2f(float a, float b) { float r; asm("v_max_f32_e32 %0, %1, %2" : "=v"(r) : "v"(a), "v"(b)); return r; }
__device__ __forceinline__ float fadd_s(float a, float b) { float r; asm("v_add_f32_e32 %0, %1, %2" : "=v"(r) : "v"(a), "v"(b)); return r; }
__device__ __forceinline__ float fsub_s(float a, float b) { float r; asm("v_sub_f32_e32 %0, %1, %2" : "=v"(r) : "v"(a), "v"(b)); return r; }
typedef float f32x2_t __attribute__((ext_vector_type(2))); typedef __bf16 bf16x2_t __attribute__((ext_vector_type(2)));
__device__ __forceinline__ unsigned cvtpk_s(float lo, float hi) { f32x2_t v = {lo, hi}; bf16x2_t b = __builtin_convertvector(v, bf16x2_t); return __builtin_bit_cast(unsigned, b); }
#define WAIT_BAR(N) asm volatile("s_waitcnt vmcnt(" #N ") lgkmcnt(0)\n\ts_barrier" ::: "memory")

__device__ __forceinline__ void qkt(f32x16& p0, f32x16& p1, const char* Kslot, const bf16x8* qr, const f32x16& negm, int r32, int hi) {
    const char* kb = Kslot + hi * 1024 + r32 * 16;
#pragma unroll
    for (int d0 = 0; d0 < 4; ++d0) {
        const bf16x8 b0 = *reinterpret_cast<const bf16x8*>(kb + d0 * 2048);
        const bf16x8 b1 = *reinterpret_cast<const bf16x8*>(kb + d0 * 2048 + 512);
        if (d0 == 0) { p0 = __builtin_amdgcn_mfma_f32_32x32x16_bf16(b0, qr[0], negm, 0, 0, 0); p1 = __builtin_amdgcn_mfma_f32_32x32x16_bf16(b1, qr[0], negm, 0, 0, 0); }
        else { p0 = __builtin_amdgcn_mfma_f32_32x32x16_bf16(b0, qr[d0], p0, 0, 0, 0); p1 = __builtin_amdgcn_mfma_f32_32x32x16_bf16(b1, qr[d0], p1, 0, 0, 0); } }
}
typedef __attribute__((address_space(3))) const char* lds_cptr;
typedef short v4i16_t __attribute__((ext_vector_type(4)));
__device__ __forceinline__ void kload8(bf16x8* kf, lds_cptr kp) {
    kf[0] = *(const __attribute__((address_space(3))) bf16x8*)(kp);        kf[1] = *(const __attribute__((address_space(3))) bf16x8*)(kp + 512);
    kf[2] = *(const __attribute__((address_space(3))) bf16x8*)(kp + 2048); kf[3] = *(const __attribute__((address_space(3))) bf16x8*)(kp + 2560);
    kf[4] = *(const __attribute__((address_space(3))) bf16x8*)(kp + 4096); kf[5] = *(const __attribute__((address_space(3))) bf16x8*)(kp + 4608);
    kf[6] = *(const __attribute__((address_space(3))) bf16x8*)(kp + 6144); kf[7] = *(const __attribute__((address_space(3))) bf16x8*)(kp + 6656);
}
__device__ __forceinline__ void kload2(bf16x8* kf, lds_cptr kp, int j) { kf[2 * j] = *(const __attribute__((address_space(3))) bf16x8*)(kp + j * 2048); kf[2 * j + 1] = *(const __attribute__((address_space(3))) bf16x8*)(kp + j * 2048 + 512); }
__device__ __forceinline__ s16x4 vtr(lds_cptr p) { return __builtin_bit_cast(s16x4, __builtin_amdgcn_ds_read_tr16_b64_v4i16((__attribute__((address_space(3))) v4i16_t*)p)); }
__device__ __forceinline__ float rowmax(const f32x16& p0, const f32x16& p1) {
    float a = max3f(p0[0], p0[1], p1[0]), b = max3f(p0[2], p0[3], p1[1]); a = max3f(a, p1[2], p1[3]);
#pragma unroll
    for (int r = 4; r < 16; r += 4) { a = max3f(a, p0[r], p0[r + 1]); b = max3f(b, p0[r + 2], p0[r + 3]); a = max3f(a, p1[r], p1[r + 1]); b = max3f(b, p1[r + 2], p1[r + 3]); }
    const float m = max2f(a, b);
    auto rr = __builtin_amdgcn_permlane32_swap(__float_as_uint(m), __float_as_uint(m), false, false);
    return max2f(__uint_as_float(rr[0]), __uint_as_float(rr[1]));
}
__device__ __forceinline__ void pv(f32x16* o, int vb, bf16x8 pa0, bf16x8 pa1, bf16x8 pa2, bf16x8 pa3) {
#pragma unroll
    for (int d0 = 0; d0 < 2; ++d0) { s16x4 lo[4], hi[4];
#pragma unroll
        for (int ks = 0; ks < 4; ++ks) {
            asm volatile("ds_read_b64_tr_b16 %0,%1 offset:%c2" : "=&v"(lo[ks]) : "v"(vb), "i"(d0 * 4096 + ks * 1024) : "memory");
            asm volatile("ds_read_b64_tr_b16 %0,%1 offset:%c2" : "=&v"(hi[ks]) : "v"(vb), "i"(d0 * 4096 + ks * 1024 + 512) : "memory"); }
        asm volatile("s_waitcnt lgkmcnt(0)" ::: "memory"); SBAR();
#define PK(k) (bf16x8){lo[k][0], lo[k][1], lo[k][2], lo[k][3], hi[k][0], hi[k][1], hi[k][2], hi[k][3]}
        o[d0] = __builtin_amdgcn_mfma_f32_32x32x16_bf16(pa0, PK(0), o[d0], 0, 0, 0);
        o[d0] = __builtin_amdgcn_mfma_f32_32x32x16_bf16(pa1, PK(1), o[d0], 0, 0, 0);
        o[d0] = __builtin_amdgcn_mfma_f32_32x32x16_bf16(pa2, PK(2), o[d0], 0, 0, 0);
        o[d0] = __builtin_amdgcn_mfma_f32_32x32x16_bf16(pa3, PK(3), o[d0], 0, 0, 0);
#undef PK
    }
}
template <bool MS> __device__ __forceinline__ void attn_unit(int b, int h, int qb, const bf16* Q, const bf16* __restrict__ K, const bf16* __restrict__ V, bf16* O, char* shm, float negM_) {
    const int tid = threadIdx.x, lane = tid & 63, r32 = lane & 31, hi = lane >> 5; const int wid = __builtin_amdgcn_readfirstlane(tid >> 6);
    const int q0 = qb * QB; const int kvh = h / 3;
    const long qrow0 = (long)b * SEQ + q0 + wid * QBLK;
    const long kvrow0 = (long)b * LKV;
    const bf16* Qw = Q + qrow0 * DMQ + h * D;
    const bf16* Kh = K + kvrow0 * DMKV + kvh * D, *Vh = V + kvrow0 * DMKV + kvh * D;
    const unsigned lds0 = (unsigned)(uintptr_t)shm;
    float* wsf = (float*)(shm + LDS_WS) + wid * 64;
    const bf16* ksrc = Kh + (long)lane * DMKV + wid * 8;
    const bf16* vsrc = Vh + (long)(16 * (wid & 3) + (lane >> 2)) * DMKV + (wid >> 2) * 32 + (lane & 3) * 8;
    const unsigned kdst = lds0 + LDS_K + wid * 1024, vdst = lds0 + LDS_V + wid * 1024;
#define DMA_K(t, slot) glds16(ksrc + (long)(t) * KVBLK * DMKV, (unsigned)__builtin_amdgcn_readfirstlane(kdst + (slot)))
#define DMA_V(t, slot) glds16(vsrc + (long)(t) * KVBLK * DMKV, (unsigned)__builtin_amdgcn_readfirstlane(vdst + (slot)))
    const int vb0 = (int)(lds0 + LDS_V) + ((lane >> 4) & 1) * 32 + (lane & 3) * 8 + (4 * hi + ((lane & 15) >> 2)) * 64;
    const char* Kbase = shm + LDS_K; bf16x8 kf[8];
    const lds_cptr shm3 = (lds_cptr)shm; const lds_cptr kp0 = shm3 + LDS_K + hi * 1024 + r32 * 16; const lds_cptr vp0 = shm3 + LDS_V + ((lane >> 4) & 1) * 32 + (lane & 3) * 8 + (4 * hi + ((lane & 15) >> 2)) * 64;
    DMA_K(0, 0); DMA_V(0, 0); DMA_K(1, SLOTB);
    bf16x8 qr[4];
#pragma unroll
    for (int d0 = 0; d0 < 4; ++d0) qr[d0] = *reinterpret_cast<const bf16x8*>(&Qw[(long)r32 * DMQ + d0 * 16 + hi * 8]);
    float l_reg = 0.f; f32x16 o[2]; o[0] = f32x16{}; o[1] = f32x16{}; f32x16 negm = f32x16{}; f32x16 lacc = f32x16{};
    if constexpr (!MS) { _Pragma("unroll") for (int r = 0; r < 16; ++r) negm[r] = negM_; asm volatile("" : "+v"(negm)); }
    const bf16x8 ONES = (bf16x8){0x3F80, 0x3F80, 0x3F80, 0x3F80, 0x3F80, 0x3F80, 0x3F80, 0x3F80};
#define START(P0, P1) do { _Pragma("unroll") for (int r = 0; r < 16; ++r) P0[r] = __builtin_amdgcn_exp2f(P0[r]); } while (0)
#define RESC() do { } while (0)
    f32x16 pA0, pA1, pB0, pB1;
    int sl_prev = 0, sl_cur = 0, sl_next = SLOTB;
#define ROT() do { sl_prev = sl_cur; sl_cur = sl_next; sl_next = (sl_next == (NSLOTR - 1) * SLOTB) ? 0 : sl_next + SLOTB; } while (0)
    DMA_K(2, 2 * SLOTB);
    WAIT_BAR(3);
    qkt(pA0, pA1, Kbase, qr, negm, r32, hi); asm volatile("s_nop 15\n\ts_nop 7" : "+v"(pA0), "+v"(pA1));
    START(pA0, pA1);
    _Pragma("unroll") for (int r = 0; r < 16; ++r) pA1[r] = __builtin_amdgcn_exp2f(pA1[r]);
    WAIT_BAR(0);
    DMA_K(3, 0); DMA_V(1, SLOTB);
    ROT();
    kload8(kf, kp0 + sl_cur);
    WAIT_BAR(2);
    s16x4 vlo[8], vhi[8]; u32x4 pw0, pw1, pw2, pw3;
#define PKW(P, B) cvtpk_s(P[B], P[B + 1])
#define PAF(k) __builtin_bit_cast(bf16x8, pw##k)
#define VFR(i) (bf16x8){vlo[i][0], vlo[i][1], vlo[i][2], vlo[i][3], vhi[i][0], vhi[i][1], vhi[i][2], vhi[i][3]}
#define PIN(x) asm volatile("" : "+v"(x))
#define MX3(a, b, c) __builtin_fmaxf(__builtin_fmaxf((a), (b)), (c))
#define GAPA(MF, A0, A1, A2, A3, W0, W1, PW) do { MF; if constexpr (!MS) { sacc += A0; sacc += A1; sacc += A2; sacc += A3; PIN(sacc); } W0; W1; PIN(PW); SBAR(); } while (0)
#define LSUM(k) do { if constexpr (MS) lacc = __builtin_amdgcn_mfma_f32_32x32x16_bf16(PAF(k), ONES, lacc, 0, 0, 0); } while (0)
#define EX(v) __builtin_amdgcn_exp2f(v)
#define GAPB(MF, X, B) do { MF; X[B] = EX(X[B]); X[B + 1] = EX(X[B + 1]); X[B + 2] = EX(X[B + 2]); X[B + 3] = EX(X[B + 3]); PIN(X); SBAR(); } while (0)
#define VRD(i) do { vlo[i] = vtr(vp_ + (((i) >> 2) * 4096 + ((i) & 3) * 1024)); vhi[i] = vtr(vp_ + (((i) >> 2) * 4096 + ((i) & 3) * 1024 + 512)); } while (0)
#define KRD(G, j) do { if (G) { kload2(kf, kp0 + sl_next, j); SBAR(); } } while (0)
#define STEP(C0, C1, P0, P1, t, GK, GV, GL) do { SBAR(); \
    const lds_cptr vp_ = vp0 + sl_prev; \
    VRD(0); SBAR(); float sacc = MS ? 0.f : (P0[0] + P0[1]); \
    GAPA(C0 = __builtin_amdgcn_mfma_f32_32x32x16_bf16(kf[0], qr[0], negm, 0, 0, 0), P0[2], P0[3], P0[4], P0[5],     pw0[0] = PKW(P0, 0), pw0[1] = PKW(P0, 2), pw0); \
    VRD(4); SBAR(); GAPA(C1 = __builtin_amdgcn_mfma_f32_32x32x16_bf16(kf[1], qr[0], negm, 0, 0, 0), P0[6], P0[7], P0[8], P0[9],     pw0[2] = PKW(P0, 4), pw0[3] = PKW(P0, 6), pw0); \
    VRD(1); SBAR(); GAPA(C0 = __builtin_amdgcn_mfma_f32_32x32x16_bf16(kf[2], qr[1], C0, 0, 0, 0),   P0[10], P0[11], P0[12], P0[13], pw1[0] = PKW(P0, 8), pw1[1] = PKW(P0, 10), pw1); \
    VRD(5); SBAR(); GAPA(C1 = __builtin_amdgcn_mfma_f32_32x32x16_bf16(kf[3], qr[1], C1, 0, 0, 0),   P0[14], P0[15], P1[0], P1[1],   pw1[2] = PKW(P0, 12), pw1[3] = PKW(P0, 14), pw1); \
    VRD(2); SBAR(); GAPA(C0 = __builtin_amdgcn_mfma_f32_32x32x16_bf16(kf[4], qr[2], C0, 0, 0, 0),   P1[2], P1[3], P1[4], P1[5],     pw2[0] = PKW(P1, 0), pw2[1] = PKW(P1, 2), pw2); \
    VRD(6); SBAR(); GAPA(C1 = __builtin_amdgcn_mfma_f32_32x32x16_bf16(kf[5], qr[2], C1, 0, 0, 0),   P1[6], P1[7], P1[8], P1[9],     pw2[2] = PKW(P1, 4), pw2[3] = PKW(P1, 6), pw2); \
    VRD(3); SBAR(); GAPA(C0 = __builtin_amdgcn_mfma_f32_32x32x16_bf16(kf[6], qr[3], C0, 0, 0, 0),   P1[10], P1[11], P1[12], P1[13], pw3[0] = PKW(P1, 8), pw3[1] = PKW(P1, 10), pw3); \
    VRD(7); SBAR(); GAPA(C1 = __builtin_amdgcn_mfma_f32_32x32x16_bf16(kf[7], qr[3], C1, 0, 0, 0),   P1[14], P1[15], 0.f, 0.f,       pw3[2] = PKW(P1, 12), pw3[3] = PKW(P1, 14), pw3); \
    if constexpr (!MS) l_reg += sacc; \
    if (GK) { DMA_K((t) + 3, sl_cur); } if (GV) { DMA_V((t) + 1, sl_next); } \
    SBAR(); \
    GAPB(o[0] = __builtin_amdgcn_mfma_f32_32x32x16_bf16(PAF(0), VFR(0), o[0], 0, 0, 0), C0, 0); \
    GAPB(o[1] = __builtin_amdgcn_mfma_f32_32x32x16_bf16(PAF(0), VFR(4), o[1], 0, 0, 0), C0, 4); LSUM(0); \
    KRD(GL, 0); GAPB(o[0] = __builtin_amdgcn_mfma_f32_32x32x16_bf16(PAF(1), VFR(1), o[0], 0, 0, 0), C0, 8); \
    KRD(GL, 1); GAPB(o[1] = __builtin_amdgcn_mfma_f32_32x32x16_bf16(PAF(1), VFR(5), o[1], 0, 0, 0), C0, 12); LSUM(1); \
    KRD(GL, 2); GAPB(o[0] = __builtin_amdgcn_mfma_f32_32x32x16_bf16(PAF(2), VFR(2), o[0], 0, 0, 0), C1, 0); \
    KRD(GL, 3); GAPB(o[1] = __builtin_amdgcn_mfma_f32_32x32x16_bf16(PAF(2), VFR(6), o[1], 0, 0, 0), C1, 4); LSUM(2); \
    GAPB(o[0] = __builtin_amdgcn_mfma_f32_32x32x16_bf16(PAF(3), VFR(3), o[0], 0, 0, 0), C1, 8); \
    GAPB(o[1] = __builtin_amdgcn_mfma_f32_32x32x16_bf16(PAF(3), VFR(7), o[1], 0, 0, 0), C1, 12); LSUM(3); \
    } while (0)
    int t = 1;
    for (; t + 5 < NT; t += 2) {
        STEP(pB0, pB1, pA0, pA1, t, true, true, true);     WAIT_BAR(2); RESC(); ROT();
        STEP(pA0, pA1, pB0, pB1, t + 1, true, true, true); WAIT_BAR(2); RESC(); ROT();
    }
#define ENDW(tt) do { if ((tt) + 3 < NT) { WAIT_BAR(2); } else if ((tt) + 2 < NT) { WAIT_BAR(1); } else { WAIT_BAR(0); } } while (0)
    for (; t + 1 < NT; t += 2) {
        STEP(pB0, pB1, pA0, pA1, t, (t + 3 < NT), (t + 1 < NT), (t + 1 < NT));         ENDW(t);     RESC(); ROT();
        STEP(pA0, pA1, pB0, pB1, t + 1, (t + 4 < NT), (t + 2 < NT), (t + 2 < NT));     ENDW(t + 1); RESC(); ROT();
    }
    STEP(pB0, pB1, pA0, pA1, NT - 1, false, false, false); RESC();
    { if constexpr (!MS) { float sacc = pB0[0] + pB0[1]; _Pragma("unroll") for (int r = 2; r < 16; ++r) sacc += pB0[r]; _Pragma("unroll") for (int r = 0; r < 16; ++r) sacc += pB1[r]; l_reg += sacc; }
      pw0 = (u32x4){PKW(pB0, 0), PKW(pB0, 2), PKW(pB0, 4), PKW(pB0, 6)}; pw1 = (u32x4){PKW(pB0, 8), PKW(pB0, 10), PKW(pB0, 12), PKW(pB0, 14)}; pw2 = (u32x4){PKW(pB1, 0), PKW(pB1, 2), PKW(pB1, 4), PKW(pB1, 6)}; pw3 = (u32x4){PKW(pB1, 8), PKW(pB1, 10), PKW(pB1, 12), PKW(pB1, 14)};
      SBAR(); pv(o, vb0 + sl_cur, PAF(0), PAF(1), PAF(2), PAF(3)); LSUM(0); LSUM(1); LSUM(2); LSUM(3); }
#undef LSUM
#undef PKW
#undef PAF
#undef VFR
#undef PIN
#undef MX3
#undef GAPA
#undef GAPB
#undef EX
#undef VRD
#undef KRD
#undef STEP
#undef ENDW
    float rli[16];
    if constexpr (MS) {
#pragma unroll
        for (int r = 0; r < 16; ++r) rli[r] = __builtin_amdgcn_rcpf(lacc[r]);
    } else {
        { auto rr = __builtin_amdgcn_permlane32_swap(__float_as_uint(l_reg), __float_as_uint(l_reg), false, false); l_reg = __uint_as_float(rr[0]) + __uint_as_float(rr[1]); }
        if (hi == 0) wsf[32 + r32] = l_reg; asm volatile("s_waitcnt lgkmcnt(0)" ::: "memory");
#pragma unroll
        for (int r = 0; r < 16; ++r) rli[r] = __builtin_amdgcn_rcpf(wsf[32 + crow(r, hi)]);
    }
    bf16* Ow = O + qrow0 * DMO + h * D;
    { bf16* stg = (bf16*)(shm + LDS_OST) + wid * 2048;
#pragma unroll
      for (int r = 0; r < 16; ++r) { const int orow = crow(r, hi);
#pragma unroll
        for (int d0 = 0; d0 < 2; ++d0) stg[orow * 64 + d0 * 32 + r32] = __float2bfloat16(o[d0][r] * rli[r]); }
      asm volatile("s_waitcnt lgkmcnt(0)" ::: "memory");
#pragma unroll
      for (int i = 0; i < 4; ++i) { const int row = i * 8 + (lane >> 3), ch = lane & 7; const u32x4 v = *(const u32x4*)(stg + row * 64 + ch * 8); *(u32x4*)(Ow + (long)row * DMO + ch * 8) = v; } }
    asm volatile("s_waitcnt lgkmcnt(0)\n\ts_barrier" ::: "memory");
#undef DMA_K
#undef DMA_V
#undef START
#undef RESC
#undef ROT
}
#undef SBAR
#undef WAIT_BAR

typedef int v8i_t __attribute__((ext_vector_type(8)));
typedef int v4i_t __attribute__((ext_vector_type(4)));
__host__ __device__ __forceinline__ int vt_slot(int k) { const int hi = (k >> 2) & 1, r = (k & 3) + 4 * ((k & 31) >> 3); return 32 * hi + r + 16 * (k >> 5); }
constexpr int SLOT8 = 4096, NS8 = 6, L8_K = 0, L8_V = NS8 * SLOT8;
static_assert(L8_V + NS8 * SLOT8 <= LDS_WS, "fp8 rings below the per-wave scratch");
constexpr int SC_QK = 0x7c7f, SC_PV = 0x7f7f;
__device__ __forceinline__ v8i_t ld32(lds_cptr p, int o0, int o1) { const v4i_t a = *(const __attribute__((address_space(3))) v4i_t*)(p + o0), b = *(const __attribute__((address_space(3))) v4i_t*)(p + o1); return __builtin_shufflevector(a, b, 0, 1, 2, 3, 4, 5, 6, 7); }
#define SBAR() __builtin_amdgcn_sched_barrier(0)
#define WAIT_BAR(N) asm volatile("s_waitcnt vmcnt(" #N ") lgkmcnt(0)\n\ts_barrier" ::: "memory")
__device__ __forceinline__ void attn_unit8(int b, int h, int qb, const unsigned char* Q8, const unsigned char* K8, const unsigned char* Vt8, bf16* O, char* shm, float negM_) {
    const int tid = threadIdx.x, lane = tid & 63, r32 = lane & 31, hi = lane >> 5; const int wid = __builtin_amdgcn_readfirstlane(tid >> 6);
    const int q0 = qb * QB; const int kvh = h / 3; const bool kw = wid < 4;
    const long qrow0 = (long)b * SEQ + q0 + wid * QBLK;
    const unsigned lds0 = (unsigned)(uintptr_t)shm;
    const int drow = 16 * (wid & 3) + (lane >> 2), dch = (lane & 3) ^ ((drow >> 2) & 3);
    const unsigned char* ksrc = K8 + ((long)b * LKV + drow) * DMKV + kvh * D + dch * 16;
    const unsigned char* vsrc = Vt8 + ((long)(b * NKVH + kvh) * (LKV / 64)) * 4096 + drow * 64 + dch * 16;
    const unsigned kdst = lds0 + L8_K + (wid & 3) * 1024, vdst = lds0 + L8_V + (wid & 3) * 1024;
#define DMA8_K(t, slot) glds16(ksrc + (long)(t) * KVBLK * DMKV, (unsigned)__builtin_amdgcn_readfirstlane(kdst + (slot)))
#define DMA8_V(t, slot) glds16(vsrc + (long)(t) * 4096, (unsigned)__builtin_amdgcn_readfirstlane(vdst + (slot)))
    const lds_cptr shm3 = (lds_cptr)shm; const int sw = (r32 >> 2) & 3, c0o = ((2 * hi) ^ sw) * 16, c1o = ((2 * hi + 1) ^ sw) * 16;
    const lds_cptr kp0 = shm3 + L8_K + r32 * 64; const lds_cptr vp0 = shm3 + L8_V + r32 * 64;
    if (kw) { DMA8_K(0, 0); DMA8_K(1, SLOT8); DMA8_K(2, 2 * SLOT8); DMA8_K(3, 3 * SLOT8); DMA8_K(4, 4 * SLOT8); } else { DMA8_V(0, 0); DMA8_V(1, SLOT8); DMA8_V(2, 2 * SLOT8); }
    const v8i_t qr = *reinterpret_cast<const v8i_t*>(Q8 + (qrow0 + r32) * DMQ + h * D + hi * 32);
    f32x16 o[2]; o[0] = f32x16{}; o[1] = f32x16{}; f32x16 negm; f32x16 lacc = f32x16{};
    _Pragma("unroll") for (int r = 0; r < 16; ++r) negm[r] = negM_;
    asm volatile("" : "+v"(negm));
    const v8i_t ONES8 = (v8i_t){0x38383838, 0x38383838, 0x38383838, 0x38383838, 0x38383838, 0x38383838, 0x38383838, 0x38383838};
    f32x16 c0, c1; v8i_t kf[2], vf[2], pw = (v8i_t){0, 0, 0, 0, 0, 0, 0, 0};
    int s0 = 0, s1 = SLOT8, s2 = 2 * SLOT8, s3 = 3 * SLOT8, s5 = 5 * SLOT8;
#define NXT8(x) (((x) == (NS8 - 1) * SLOT8) ? 0 : (x) + SLOT8)
#define ROT8() do { s0 = s1; s1 = s2; s2 = s3; s3 = NXT8(s3); s5 = NXT8(s5); } while (0)
#define QK8() do { c0 = __builtin_amdgcn_mfma_scale_f32_32x32x64_f8f6f4(kf[0], qr, negm, 0, 0, 0, SC_QK, 1, SC_QK); c1 = __builtin_amdgcn_mfma_scale_f32_32x32x64_f8f6f4(kf[1], qr, negm, 0, 0, 0, SC_QK, 1, SC_QK); } while (0)
#define PK8(P, B, OLD) __builtin_amdgcn_cvt_pk_fp8_f32(P[B + 2], P[B + 3], __builtin_amdgcn_cvt_pk_fp8_f32(P[B], P[B + 1], OLD, false), true)
#define PV8() do { if (REP == 71) { f32x16 dz_ = __builtin_amdgcn_mfma_scale_f32_32x32x64_f8f6f4(pw, vf[0], f32x16{}, 0, 0, 0, SC_PV, 1, SC_PV); asm volatile("" :: "v"(dz_)); dz_ = __builtin_amdgcn_mfma_scale_f32_32x32x64_f8f6f4(pw, vf[1], f32x16{}, 0, 0, 0, SC_PV, 1, SC_PV); asm volatile("" :: "v"(dz_)); } \
    o[0] = __builtin_amdgcn_mfma_scale_f32_32x32x64_f8f6f4(pw, vf[0], o[0], 0, 0, 0, SC_PV, 1, SC_PV); o[1] = __builtin_amdgcn_mfma_scale_f32_32x32x64_f8f6f4(pw, vf[1], o[1], 0, 0, 0, SC_PV, 1, SC_PV); \
        lacc = __builtin_amdgcn_mfma_scale_f32_32x32x64_f8f6f4(pw, ONES8, lacc, 0, 0, 0, SC_PV, 1, SC_PV); } while (0)
#define EXPK8() do { if (REP == 70) { _Pragma("unroll") for (int r = 0; r < 16; ++r) { float d0_ = __builtin_amdgcn_exp2f(c0[r] * 0.5f), d1_ = __builtin_amdgcn_exp2f(c1[r] * 0.5f); asm volatile("" :: "v"(d0_), "v"(d1_)); } } \
    _Pragma("unroll") for (int r = 0; r < 16; ++r) { c0[r] = __builtin_amdgcn_exp2f(c0[r]); c1[r] = __builtin_amdgcn_exp2f(c1[r]); } \
        pw[0] = PK8(c0, 0, pw[0]); pw[1] = PK8(c0, 4, pw[1]); pw[2] = PK8(c0, 8, pw[2]); pw[3] = PK8(c0, 12, pw[3]); pw[4] = PK8(c1, 0, pw[4]); pw[5] = PK8(c1, 4, pw[5]); pw[6] = PK8(c1, 8, pw[6]); pw[7] = PK8(c1, 12, pw[7]); } while (0)
    WAIT_BAR(0);
    kf[0] = ld32(kp0, c0o, c1o); kf[1] = ld32(kp0 + 2048, c0o, c1o);
    QK8(); EXPK8();
    kf[0] = ld32(kp0 + SLOT8, c0o, c1o); kf[1] = ld32(kp0 + SLOT8 + 2048, c0o, c1o);
    WAIT_BAR(0);
#define SUB8(t, GK, GV, GL) do { SBAR(); \
    vf[0] = ld32(vp0 + s0, c0o, c1o); vf[1] = ld32(vp0 + s0 + 2048, c0o, c1o); \
    QK8(); PV8(); \
    if (kw) { if (GK) { DMA8_K((t) + 4, s5); } } else { if (GV) { DMA8_V((t) + 2, s3); } } \
    if (GL) { kf[0] = ld32(kp0 + s2, c0o, c1o); kf[1] = ld32(kp0 + s2 + 2048, c0o, c1o); } \
    EXPK8(); ROT8(); \
    } while (0)
    int t = 1;
#pragma unroll 1
    for (; t + 5 < NT; t += 2) { SUB8(t, true, true, true); SUB8(t + 1, true, true, true); WAIT_BAR(1); }
#pragma unroll 1
    for (; t + 1 < NT; t += 2) {
        SUB8(t, (t + 4 < NT), (t + 2 < NT), (t + 1 < NT)); SUB8(t + 1, (t + 5 < NT), (t + 3 < NT), (t + 2 < NT)); WAIT_BAR(0); }
    SUB8(NT - 1, false, false, false);
    {
        asm volatile("s_waitcnt lgkmcnt(0)" ::: "memory");
        vf[0] = ld32(vp0 + s0, c0o, c1o); vf[1] = ld32(vp0 + s0 + 2048, c0o, c1o);
        PV8(); }
    float rli[16];
#pragma unroll
    for (int r = 0; r < 16; ++r) rli[r] = __builtin_amdgcn_rcpf(lacc[r]);
    bf16* Ow = O + qrow0 * DMO + h * D;
    { bf16* stg = (bf16*)(shm + LDS_OST) + wid * 2048;
#pragma unroll
      for (int r = 0; r < 16; ++r) { const int orow = crow(r, hi);
#pragma unroll
        for (int d0 = 0; d0 < 2; ++d0) stg[orow * 64 + d0 * 32 + r32] = __float2bfloat16(o[d0][r] * rli[r]); }
      asm volatile("s_waitcnt lgkmcnt(0)" ::: "memory");
#pragma unroll
      for (int i = 0; i < 4; ++i) { const int row = i * 8 + (lane >> 3), ch = lane & 7; const u32x4 v = *(const u32x4*)(stg + row * 64 + ch * 8); *(u32x4*)(Ow + (long)row * DMO + ch * 8) = v; } }
    asm volatile("s_waitcnt vmcnt(0) lgkmcnt(0)\n\ts_barrier" ::: "memory");
#undef DMA8_K
#undef DMA8_V
#undef ROT8
#undef QK8
#undef PK8
#undef PV8
#undef EXPK8
#undef SUB8
#undef NXT8
}
#undef SBAR
#undef WAIT_BAR
}

#define XB_TMO      128
#define XB_XCNT(j)  (256  + 64 * (j))
#define XB_XSUB(j)  (1280 + 64 * (j))
#define XB_XGEN(j)  (2304 + 64 * (j))
#define XB_TOP      3328
#define XB_TOPGEN   3392
#define XCD_BAR_WORDS 3456
#define XB_SPIN_CAP (1u << 18)
__device__ __forceinline__ unsigned xb_ld(unsigned* p)              { return __hip_atomic_load(p, __ATOMIC_RELAXED, __HIP_MEMORY_SCOPE_AGENT); }
__device__ __forceinline__ unsigned xb_add(unsigned* p, unsigned v) { return __hip_atomic_fetch_add(p, v, __ATOMIC_RELAXED, __HIP_MEMORY_SCOPE_AGENT); }
__device__ __forceinline__ unsigned xb_xcc_id() { return (unsigned)__builtin_amdgcn_s_getreg((3 << 11) | 20) & 0xFu; }
#define XB_SPIN(cond, bar) do { unsigned _sp = 0; while (cond) { __builtin_amdgcn_s_sleep(1); \
    if ((++_sp & 255u) == 0u) { if (xb_ld(&(bar)[XB_TMO])) break; if (_sp > XB_SPIN_CAP) { atomicAdd(&(bar)[XB_TMO], 1u); break; } } } } while (0)
struct XcdBarrier { unsigned* bar; unsigned x; volatile LAS unsigned* st; };
__device__ __forceinline__ XcdBarrier xcd_barrier_post(unsigned* bar, volatile LAS unsigned* st) {
    XcdBarrier b; b.bar = bar; b.x = xb_xcc_id(); b.st = st;
    if (threadIdx.x == 0) (void)xb_add(&bar[XB_XCNT(b.x)], 1u);
    return b;
}
__device__ __forceinline__ void xcd_barrier_complete(unsigned* bar, unsigned x, unsigned& nloc, unsigned& nx) {
    const unsigned G = gridDim.x * gridDim.y * gridDim.z;
    unsigned sum, cnt, mine, sp = 0u;
    for (;;) {
        sum = 0u; cnt = 0u; mine = 0u;
#pragma unroll
        for (unsigned j = 0; j < 16; ++j) { const unsigned c = xb_ld(&bar[XB_XCNT(j)]); sum += c; cnt += (c > 0u) ? 1u : 0u; mine = (j == x) ? c : mine; }
        if (sum == G) break;
        __builtin_amdgcn_s_sleep(1);
        if ((++sp & 255u) == 0u) { if (xb_ld(&bar[XB_TMO])) break; if (sp > XB_SPIN_CAP) { atomicAdd(&bar[XB_TMO], 1u); break; } }
    }
    nloc = mine > 0u ? mine : 1u; nx = cnt > 0u ? cnt : 1u;
}
__device__ __forceinline__ void xcd_barrier(const XcdBarrier& b) {
    asm volatile("s_waitcnt vmcnt(0)" ::: "memory");
    __syncthreads();
    if (threadIdx.x == 0) {
        unsigned* bar = b.bar;
        __builtin_amdgcn_s_waitcnt(0);
        unsigned nloc = b.st[0], nx = b.st[1];
        if (nloc == 0u) { xcd_barrier_complete(bar, b.x, nloc, nx); b.st[0] = nloc; b.st[1] = nx; }
        const unsigned old = xb_add(&bar[XB_XSUB(b.x)], 1u);
        const unsigned gen = old / nloc;
        if (old + 1u == (gen + 1u) * nloc) {
            __builtin_amdgcn_fence(__ATOMIC_RELEASE, "agent");
            asm volatile("s_waitcnt vmcnt(0)" ::: "memory");
            const unsigned og = xb_add(&bar[XB_TOP], 1u);
            const unsigned tg = og / nx;
            if (og + 1u == (tg + 1u) * nx) xb_add(&bar[XB_TOPGEN], 1u);
            else XB_SPIN(xb_ld(&bar[XB_TOPGEN]) == tg, bar);
            __builtin_amdgcn_fence(__ATOMIC_ACQUIRE, "agent");
            xb_add(&bar[XB_XGEN(b.x)], 1u);
            asm volatile("s_waitcnt vmcnt(0)" ::: "memory");
        } else {
            XB_SPIN(xb_ld(&bar[XB_XGEN(b.x)]) == gen, bar);
            __builtin_amdgcn_fence(__ATOMIC_ACQUIRE, "agent");
            asm volatile("s_waitcnt vmcnt(0)" ::: "memory");
        }
    }
    __syncthreads();
}

struct Frame {
    LAS unsigned char* lds;
    volatile LAS unsigned* MISC;
    gu32* ctl;
    int tid, lane, wave;
    int vcu, G;
    const float* const* ka;
    float* out;
    unsigned char* ws;
};
#define WSP(T, off) ((T*)(F.ws + (off)))
#define FIN_x (F.ka[0])
#define FIN_c (F.ka[1])
#define FIN_ctx (F.ka[2])
#define FIN_c_ctx (F.ka[3])
#define FIN_norm1_g (F.ka[4])
#define FIN_w_ada (F.ka[5])
#define FIN_b_ada (F.ka[6])
#define FIN_w_in (F.ka[7])
#define FIN_w_fourier (F.ka[8])
#define FIN_q_norm_g (F.ka[9])
#define FIN_k_norm_g (F.ka[10])
#define FIN_w_out (F.ka[11])
#define FIN_norm2_g (F.ka[12])
#define FIN_w_router (F.ka[13])
#define FIN_router_bias (F.ka[14])
#define FIN_w_egu (F.ka[15])
#define FIN_w_ed (F.ka[16])
#define FIN_w_sgu (F.ka[17])
#define FIN_w_sd (F.ka[18])
#define FIN_final_g (F.ka[19])

struct DenseOrder {
    static constexpr bool GATHER = false;
    int nN, nmain, nextra, G, c; const char* Bt; int K; int reps;
    __device__ __forceinline__ bool next(int i, pg8::GUnit& u) const {
        const int ntot = nmain + nextra, nc = (ntot - c + G - 1) / G; if (i >= nc * reps) return false;
        const int L = (i % nc) * G + c;
        if (L < nmain) { const int nig = 8 * nN, gid = L / nig, r = L % nig; u.pm = gid * 8 + (r & 7); u.pn = r >> 3; }
        else { const int jx = L - nmain; u.pm = 128 + (jx & 3); u.pn = 5 + (jx >> 2); }
        u.e = 0; u.j = 0; u.nvalid = 256; u.B = Bt + (size_t)u.pn * 256 * K * 2; return true;
    }
    __device__ __forceinline__ int arow(const pg8::GUnit& u, int r) const { return u.pm * 256 + r; }
};
template <bool GATHER_> struct GroupedOrder {
    static constexpr bool GATHER = GATHER_;
    int NPN, G, c, nbrows, K; bool gather; const char* Bt; const LAS int* TS; const LAS int* CN; const GAS u32x2* LIST; int reps; int total;
    __device__ __forceinline__ bool next(int i, pg8::GUnit& u) const {
        const int ntot = total * NPN, nc = (ntot - c + G - 1) / G; if (i >= nc * reps) return false;
        const int L = (i % nc) * G + c; const int T = L / NPN;
        int lo = 0, hi = 257;
        while (hi - lo > 1) { const int mid = (lo + hi) >> 1; if (TS[mid] <= T) lo = mid; else hi = mid; }
        lo = __builtin_amdgcn_readfirstlane(lo);
        const int ts = __builtin_amdgcn_readfirstlane(TS[lo]), cn = __builtin_amdgcn_readfirstlane(CN[lo]);
        u.pm = T; u.pn = L - T * NPN; u.e = lo; u.j = T - ts; const int rem = cn - 256 * u.j; u.nvalid = rem < 256 ? rem : 256;
        u.B = Bt + ((size_t)lo * nbrows + (size_t)u.pn * 256) * K; return true;
    }
    __device__ __forceinline__ int arow(const pg8::GUnit& u, int r) const {
        if (!gather) return u.pm * 256 + r;
        int pos = 256 * u.j + r; if (r >= u.nvalid) pos = 0;
        const u32x2 en = LIST[(size_t)u.e * NTOK + pos];
        return (int)(en.x & 0xffffu);
    }
};

struct EpiInProj {
    static constexpr bool PERM = true; static constexpr int NSTORE = 8;
    __device__ __forceinline__ void pre(LAS unsigned char*, const pg8::GUnit&, int, int, int) const {}
    u16 *Z, *Q, *Kb, *Vb; const float *COS, *SIN, *gq, *gk;
    __device__ __forceinline__ void operator()(const f32x4 (&acc)[2][2][4][2], const pg8::GUnit& u, int wr, int wc, int fr, int fq, LAS unsigned char* lds, int ui) const {
        const int pn = u.pn; const bool is_ctx = u.pm >= 128;
        if (ATTN_FP8 && pn == 6) {
            LAS unsigned char* st = lds + pg8::STAGE_BYTES; const int tid = threadIdx.x;
            const int b = is_ctx ? (u.pm - 128) : (u.pm >> 5), kt0 = is_ctx ? (SEQ / 64) : (((u.pm * 256) & (SEQ - 1)) >> 6);
#pragma unroll
            for (int ai = 0; ai < 2; ++ai)
#pragma unroll
                for (int bj = 0; bj < 2; ++bj) {
#pragma unroll
                    for (int m = 0; m < 4; ++m) { const int ks = attn_body::vt_slot(16 * m + fr); const f32x4 v0 = acc[ai][bj][m][0], v1 = acc[ai][bj][m][1];
                        int w0 = __builtin_amdgcn_cvt_pk_fp8_f32(v0[0], v0[1], 0, false); w0 = __builtin_amdgcn_cvt_pk_fp8_f32(v0[2], v0[3], w0, true);
                        int w1 = __builtin_amdgcn_cvt_pk_fp8_f32(v1[0], v1[1], 0, false); w1 = __builtin_amdgcn_cvt_pk_fp8_f32(v1[2], v1[3], w1, true);
#pragma unroll
                        for (int q8 = 0; q8 < 8; ++q8) st[((wr * 128 + 32 * wc + 8 * fq + q8) * 64) + ks] = (unsigned char)(((q8 < 4 ? (unsigned)w0 : (unsigned)w1) >> (8 * (q8 & 3))) & 0xffu); }
                    asm volatile("s_waitcnt lgkmcnt(0)" ::: "memory"); __builtin_amdgcn_s_barrier(); asm volatile("" ::: "memory");
#pragma unroll
                    for (int j = 0; j < 2; ++j) { const int ch = tid + 512 * j, row = ch >> 2, part = ch & 3, col = 128 * bj + (row & 127), kvh = col >> 6, d = col & 63, kt = kt0 + 2 * ai + (row >> 7);
                        const u32x4 v = *(const LAS u32x4*)(st + row * 64 + part * 16);
                        *(u32x4*)((unsigned char*)Vb + ((((size_t)(b * NKVH + kvh) * (LKV / 64) + kt) * 64 + d) * 64) + part * 16) = v; }
                    asm volatile("s_waitcnt lgkmcnt(0)" ::: "memory"); __builtin_amdgcn_s_barrier(); asm volatile("" ::: "memory");
                }
            return;
        }
        float gn[2][2][4];
        if (pn >= 2 && pn < 6) { const float* gsrc = (pn == 5) ? gk : gq;
#pragma unroll
            for (int bj = 0; bj < 2; ++bj)
#pragma unroll
                for (int n = 0; n < 2; ++n) { const f32x4 g4 = *(const f32x4*)(gsrc + 32 * bj + 16 * n + 4 * fq); gn[bj][n][0] = g4[0]; gn[bj][n][1] = g4[1]; gn[bj][n][2] = g4[2]; gn[bj][n][3] = g4[3]; } }
#pragma unroll
        for (int ai = 0; ai < 2; ++ai)
#pragma unroll
            for (int m = 0; m < 4; ++m) {
                const int row = u.pm * 256 + ai * 128 + wr * 64 + m * 16 + fr;
                int b, l, key;
                if (!is_ctx) { b = row >> 13; l = row & 8191; key = l; } else { const int rc = row - NTOK; b = rc >> 8; l = 0; key = SEQ + (rc & 255); }
                if (pn < 2) {
#pragma unroll
                    for (int bj = 0; bj < 2; ++bj) { const int g = 32 * pn + 16 * bj + 4 * wc + fq; const f32x4 v0 = acc[ai][bj][m][0], v1 = acc[ai][bj][m][1];
                        u32x4 w; w.x = cvt_pk_bf16(v0[0], v0[1]); w.y = cvt_pk_bf16(v0[2], v0[3]); w.z = cvt_pk_bf16(v1[0], v1[1]); w.w = cvt_pk_bf16(v1[2], v1[3]);
                        *(u32x4*)(Z + (((size_t)(b * 64 + g) * SEQ + l) * 8)) = w; }
                } else if (pn < 6) {
                    float ss = 0.f;
#pragma unroll
                    for (int bj = 0; bj < 2; ++bj)
#pragma unroll
                        for (int n = 0; n < 2; ++n) { const f32x4 v = acc[ai][bj][m][n]; ss += (v[0] * v[0] + v[1] * v[1]) + (v[2] * v[2] + v[3] * v[3]); }
                    ss += __shfl_xor(ss, 16); ss += __shfl_xor(ss, 32);
                    const float rstd = 1.0f / sqrtf(ss * (1.0f / 64.0f) + RMS_EPS);
                    const float osc = (pn == 5) ? 1.0f : C2;
#pragma unroll
                    for (int bj = 0; bj < 2; ++bj) {
                        const int pidx = (bj == 0) ? (l >> 6) : (l & 63);
                        f32x4 cs = *(const f32x4*)(COS + pidx * 16 + 4 * fq), sn = *(const f32x4*)(SIN + pidx * 16 + 4 * fq);
                        if (is_ctx) { cs = (f32x4){1.f, 1.f, 1.f, 1.f}; sn = (f32x4){0.f, 0.f, 0.f, 0.f}; }
                        float oa[4], ob[4];
#pragma unroll
                        for (int e = 0; e < 4; ++e) { const float a = acc[ai][bj][m][0][e] * rstd * gn[bj][0][e], bb = acc[ai][bj][m][1][e] * rstd * gn[bj][1][e];
                            oa[e] = (a * cs[e] - bb * sn[e]) * osc; ob[e] = (bb * cs[e] + a * sn[e]) * osc; }
                        if (ATTN_FP8) {
                            const float f8s = (pn < 5) ? Q8_SCALE : 1.0f;
                            int w0 = __builtin_amdgcn_cvt_pk_fp8_f32(oa[0] * f8s, oa[1] * f8s, 0, false); w0 = __builtin_amdgcn_cvt_pk_fp8_f32(oa[2] * f8s, oa[3] * f8s, w0, true);
                            int w1 = __builtin_amdgcn_cvt_pk_fp8_f32(ob[0] * f8s, ob[1] * f8s, 0, false); w1 = __builtin_amdgcn_cvt_pk_fp8_f32(ob[2] * f8s, ob[3] * f8s, w1, true);
                            if (pn < 5) { const int head = 4 * (pn - 2) + wc; *(u32x2*)((unsigned char*)Q + ((size_t)row * QW + head * 64 + 32 * bj + 8 * fq)) = (u32x2){(unsigned)w0, (unsigned)w1}; }
                            else *(u32x2*)((unsigned char*)Kb + (((size_t)b * LKV + key) * KVW + wc * 64 + 32 * bj + 8 * fq)) = (u32x2){(unsigned)w0, (unsigned)w1};
                        } else {
                        u32x4 w; w.x = cvt_pk_bf16(oa[0], oa[1]); w.y = cvt_pk_bf16(oa[2], oa[3]); w.z = cvt_pk_bf16(ob[0], ob[1]); w.w = cvt_pk_bf16(ob[2], ob[3]);
                        if (pn < 5) { const int head = 4 * (pn - 2) + wc; *(u32x4*)(Q + ((size_t)row * QW + head * 64 + 32 * bj + 8 * fq)) = w; }
                        else *(u32x4*)(Kb + (((size_t)b * LKV + key) * KVW + wc * 64 + 32 * bj + 8 * fq)) = w; }
                    }
                } else {
#pragma unroll
                    for (int bj = 0; bj < 2; ++bj) { const f32x4 v0 = acc[ai][bj][m][0], v1 = acc[ai][bj][m][1];
                        if (ATTN_FP8) {
                            const int kt = key >> 6, ks = attn_body::vt_slot(key & 63);
                            int w0 = __builtin_amdgcn_cvt_pk_fp8_f32(v0[0], v0[1], 0, false); w0 = __builtin_amdgcn_cvt_pk_fp8_f32(v0[2], v0[3], w0, true);
                            int w1 = __builtin_amdgcn_cvt_pk_fp8_f32(v1[0], v1[1], 0, false); w1 = __builtin_amdgcn_cvt_pk_fp8_f32(v1[2], v1[3], w1, true);
#pragma unroll
                            for (int q8 = 0; q8 < 8; ++q8) { const int col = 128 * bj + 32 * wc + 8 * fq + q8, kvh = col >> 6, d = col & 63;
                                ((unsigned char*)Vb)[((((size_t)(b * NKVH + kvh) * (LKV / 64) + kt) * 64 + d) * 64) + ks] = (unsigned char)(((q8 < 4 ? (unsigned)w0 : (unsigned)w1) >> (8 * (q8 & 3))) & 0xffu); }
                        } else {
                        u32x4 w; w.x = cvt_pk_bf16(v0[0], v0[1]); w.y = cvt_pk_bf16(v0[2], v0[3]); w.z = cvt_pk_bf16(v1[0], v1[1]); w.w = cvt_pk_bf16(v1[2], v1[3]);
                        *(u32x4*)(Vb + (((size_t)b * LKV + key) * KVW + 128 * bj + 32 * wc + 8 * fq)) = w; } }
                }
            }
    }
};
struct EpiResid {
    static constexpr bool PERM = false; static constexpr int NSTORE = 32;
    __device__ __forceinline__ void pre(LAS unsigned char*, const pg8::GUnit&, int, int, int) const {}
    const float* x; float* X1; const gi64* MOD;
    __device__ __forceinline__ void operator()(const f32x4 (&acc)[2][2][4][2], const pg8::GUnit& u, int wr, int wc, int fr, int fq, LAS unsigned char* lds, int ui) const {
        const int row0 = u.pm * 256 + wr * 64 + fr, col0 = u.pn * 256 + wc * 32 + 4 * fq; const int b = (u.pm * 256) >> 13;
        f32x4 gv[2][2];
#pragma unroll
        for (int bj = 0; bj < 2; ++bj)
#pragma unroll
            for (int n = 0; n < 2; ++n) gv[bj][n] = mod4(MOD, b * 6144 + 2048 + col0 + bj * 128 + n * 16);
#pragma unroll
        for (int ai = 0; ai < 2; ++ai)
#pragma unroll
            for (int m = 0; m < 4; ++m) { const size_t off = (size_t)(row0 + ai * 128 + m * 16) * DM + col0;
#pragma unroll
                for (int bj = 0; bj < 2; ++bj)
#pragma unroll
                    for (int n = 0; n < 2; ++n) { const f32x4 xv = *(const f32x4*)(x + off + bj * 128 + n * 16); *(f32x4*)(X1 + off + bj * 128 + n * 16) = (DBG & 2) ? xv : xv + gv[bj][n] * acc[ai][bj][m][n]; } }
    }
};
struct EpiLogits {
    static constexpr bool PERM = false; static constexpr int NSTORE = 32;
    __device__ __forceinline__ void pre(LAS unsigned char*, const pg8::GUnit&, int, int, int) const {}
    float* C;
    __device__ __forceinline__ void operator()(const f32x4 (&acc)[2][2][4][2], const pg8::GUnit& u, int wr, int wc, int fr, int fq, LAS unsigned char* lds, int ui) const {
        const int row0 = u.pm * 256 + wr * 64 + fr, col0 = wc * 32 + 4 * fq;
#pragma unroll
        for (int ai = 0; ai < 2; ++ai)
#pragma unroll
            for (int m = 0; m < 4; ++m) { float* rowp = C + (size_t)(row0 + ai * 128 + m * 16) * NEXP + col0;
#pragma unroll
                for (int bj = 0; bj < 2; ++bj)
#pragma unroll
                    for (int n = 0; n < 2; ++n) *(f32x4*)(rowp + bj * 128 + n * 16) = acc[ai][bj][m][n]; }
    }
};
struct EpiSwiglu {
    static constexpr bool PERM = true; static constexpr int NSTORE = 16;
    __device__ __forceinline__ void pre(LAS unsigned char*, const pg8::GUnit&, int, int, int) const {}
    u16* ACT;
    __device__ __forceinline__ void operator()(const f32x4 (&acc)[2][2][4][2], const pg8::GUnit& u, int wr, int wc, int fr, int fq, LAS unsigned char* lds, int ui) const {
#pragma unroll
        for (int ai = 0; ai < 2; ++ai)
#pragma unroll
            for (int m = 0; m < 4; ++m) { const int r = ai * 128 + wr * 64 + m * 16 + fr; u16* rowp = ACT + ((size_t)u.pm * 256 + r) * EFF + 128 * u.pn + 16 * wc + 4 * fq;
#pragma unroll
                for (int bj = 0; bj < 2; ++bj) { const f32x4 a = acc[ai][bj][m][0], g = acc[ai][bj][m][1]; float o[4];
#pragma unroll
                    for (int e = 0; e < 4; ++e) o[e] = a[e] * g[e] / (1.0f + __expf(-a[e]));
                    if (MOE_FP8) { int w0 = __builtin_amdgcn_cvt_pk_fp8_f32(o[0], o[1], 0, false); w0 = __builtin_amdgcn_cvt_pk_fp8_f32(o[2], o[3], w0, true);
                        *(unsigned*)((unsigned char*)ACT + ((size_t)u.pm * 256 + r) * EFF + 128 * u.pn + 16 * wc + 4 * fq + 64 * bj) = (unsigned)w0; }
                    else { u32x2 w; if (MOEF16) { w.x = pk2h(o[0], o[1]); w.y = pk2h(o[2], o[3]); } else { w.x = pk2bf(o[0], o[1]); w.y = pk2bf(o[2], o[3]); } *(u32x2*)(rowp + 64 * bj) = w; } } }
    }
};
struct EpiDown {
    static constexpr bool PERM = true; static constexpr int NSTORE = 16;
    u16* Cc; const GAS u32x2* LIST; unsigned char* dump;
    __device__ __forceinline__ void pre(LAS unsigned char* lds, const pg8::GUnit& u, int ui, int wid, int lane) const {
        if (wid < 2) __builtin_amdgcn_global_load_lds((const unsigned*)(LIST + (size_t)u.e * NTOK + 256 * u.j + 128 * wid + 2 * lane), (LAS unsigned*)(lds + pg8::STAGE_BYTES + (ui & 1) * 2048 + wid * 1024), 16, 0, 0);
    }
    __device__ __forceinline__ void operator()(const f32x4 (&acc)[2][2][4][2], const pg8::GUnit& u, int wr, int wc, int fr, int fq, LAS unsigned char* lds, int ui) const {
        const LAS f32x2* ent = (const LAS f32x2*)(lds + pg8::STAGE_BYTES + (ui & 1) * 2048);
#pragma unroll
        for (int ai = 0; ai < 2; ++ai)
#pragma unroll
            for (int m = 0; m < 4; ++m) { const int r = ai * 128 + wr * 64 + m * 16 + fr;
                const f32x2 enf = ent[r];
                const unsigned ex = __builtin_bit_cast(unsigned, enf.x); const int tok = (int)(ex & 0x7fffu), slot = (int)((ex >> 16) & 15u); const float gate = enf.y;
                unsigned char* rowp = (unsigned char*)Cc + ((size_t)tok * NSLOT + slot) * DM + 256 * u.pn + 32 * wc + 8 * fq;
                if (r >= u.nvalid) rowp = dump + ((size_t)(blockIdx.x * 512 + threadIdx.x)) * 256;
                const float gs = gate * C_SCALE;
#pragma unroll
                for (int bj = 0; bj < 2; ++bj) { f32x4 v0 = acc[ai][bj][m][0] * gs, v1 = acc[ai][bj][m][1] * gs;
#pragma unroll
                    for (int e = 0; e < 4; ++e) { v0[e] = __builtin_amdgcn_fmed3f(v0[e], -440.f, 440.f); v1[e] = __builtin_amdgcn_fmed3f(v1[e], -440.f, 440.f); }
                    int w0 = __builtin_amdgcn_cvt_pk_fp8_f32(v0[0], v0[1], 0, false); w0 = __builtin_amdgcn_cvt_pk_fp8_f32(v0[2], v0[3], w0, true);
                    int w1 = __builtin_amdgcn_cvt_pk_fp8_f32(v1[0], v1[1], 0, false); w1 = __builtin_amdgcn_cvt_pk_fp8_f32(v1[2], v1[3], w1, true);
                    *(u32x2*)(rowp + 128 * bj) = (u32x2){(unsigned)w0, (unsigned)w1}; } }
    }
};

template <bool F16OUT, bool F8OUT2 = false> __device__ __forceinline__ void rownorm_rows(const GAS float* src, const float* gain, const gi64* MODsh, const gi64* MODsc, u16* dst, int row0, int nrows, int wi, int wstride, int lane, unsigned char* dst8 = nullptr) {
    f32x4 Av[2][2], Bv[2][2];
#pragma unroll
    for (int j = 0; j < 2; ++j)
#pragma unroll
        for (int h = 0; h < 2; ++h) { const int col = 8 * lane + 512 * j + 4 * h; Av[j][h] = *(const f32x4*)(gain + col) * (mod4(MODsc, col) + 1.0f); Bv[j][h] = mod4(MODsh, col); }
    for (int r = wi; r < nrows; r += 2 * wstride) {
        const int r1 = r + wstride; const bool has1 = r1 < nrows;
        const GAS float* s0 = src + (size_t)(row0 + r) * DM; const GAS float* s1 = src + (size_t)(row0 + (has1 ? r1 : r)) * DM;
        f32x4 v0[2][2], v1[2][2];
#pragma unroll
        for (int j = 0; j < 2; ++j)
#pragma unroll
            for (int h = 0; h < 2; ++h) { v0[j][h] = *(const GAS f32x4*)(s0 + 8 * lane + 512 * j + 4 * h); v1[j][h] = *(const GAS f32x4*)(s1 + 8 * lane + 512 * j + 4 * h); }
        float q0 = 0.f, q1 = 0.f;
#pragma unroll
        for (int j = 0; j < 2; ++j)
#pragma unroll
            for (int h = 0; h < 2; ++h) { const f32x4 a = v0[j][h], b = v1[j][h]; q0 += (a[0] * a[0] + a[1] * a[1]) + (a[2] * a[2] + a[3] * a[3]); q1 += (b[0] * b[0] + b[1] * b[1]) + (b[2] * b[2] + b[3] * b[3]); }
#pragma unroll
        for (int o = 1; o < 64; o <<= 1) { q0 += __shfl_xor(q0, o); q1 += __shfl_xor(q1, o); }
        const float rs0 = 1.0f / sqrtf(q0 * (1.0f / DM) + RMS_EPS), rs1 = 1.0f / sqrtf(q1 * (1.0f / DM) + RMS_EPS);
#pragma unroll
        for (int j = 0; j < 2; ++j) { const f32x4 ya = v0[j][0] * rs0 * Av[j][0] + Bv[j][0], yb = v0[j][1] * rs0 * Av[j][1] + Bv[j][1];
            u32x4 w; if (F16OUT) { w.x = pk2h(ya[0], ya[1]); w.y = pk2h(ya[2], ya[3]); w.z = pk2h(yb[0], yb[1]); w.w = pk2h(yb[2], yb[3]); } else { w.x = pk2bf(ya[0], ya[1]); w.y = pk2bf(ya[2], ya[3]); w.z = pk2bf(yb[0], yb[1]); w.w = pk2bf(yb[2], yb[3]); }
            *(GAS u32x4*)(dst + (size_t)(row0 + r) * DM + 8 * lane + 512 * j) = w;
            if (F8OUT2) { int w0 = __builtin_amdgcn_cvt_pk_fp8_f32(ya[0], ya[1], 0, false); w0 = __builtin_amdgcn_cvt_pk_fp8_f32(ya[2], ya[3], w0, true); int w1 = __builtin_amdgcn_cvt_pk_fp8_f32(yb[0], yb[1], 0, false); w1 = __builtin_amdgcn_cvt_pk_fp8_f32(yb[2], yb[3], w1, true);
                *(GAS u32x2*)(dst8 + (size_t)(row0 + r) * DM + 8 * lane + 512 * j) = (u32x2){(unsigned)w0, (unsigned)w1}; } }
        if (has1) {
#pragma unroll
            for (int j = 0; j < 2; ++j) { const f32x4 ya = v1[j][0] * rs1 * Av[j][0] + Bv[j][0], yb = v1[j][1] * rs1 * Av[j][1] + Bv[j][1];
                u32x4 w; if (F16OUT) { w.x = pk2h(ya[0], ya[1]); w.y = pk2h(ya[2], ya[3]); w.z = pk2h(yb[0], yb[1]); w.w = pk2h(yb[2], yb[3]); } else { w.x = pk2bf(ya[0], ya[1]); w.y = pk2bf(ya[2], ya[3]); w.z = pk2bf(yb[0], yb[1]); w.w = pk2bf(yb[2], yb[3]); }
                *(GAS u32x4*)(dst + (size_t)(row0 + r1) * DM + 8 * lane + 512 * j) = w;
                if (F8OUT2) { int w0 = __builtin_amdgcn_cvt_pk_fp8_f32(ya[0], ya[1], 0, false); w0 = __builtin_amdgcn_cvt_pk_fp8_f32(ya[2], ya[3], w0, true); int w1 = __builtin_amdgcn_cvt_pk_fp8_f32(yb[0], yb[1], 0, false); w1 = __builtin_amdgcn_cvt_pk_fp8_f32(yb[2], yb[3], w1, true);
                    *(GAS u32x2*)(dst8 + (size_t)(row0 + r1) * DM + 8 * lane + 512 * j) = (u32x2){(unsigned)w0, (unsigned)w1}; } } }
    }
}

__device__ __forceinline__ void p0_phase(Frame& F) {
    const int gw = F.vcu * 8 + F.wave, NGW = F.G * 8, lane = F.lane;
    unsigned long long* MODQ = (unsigned long long*)(F.ctl + CW_MOD);
    for (int it = gw; it < 1536; it += NGW) {
        const int cb = it % 24, kc = it / 24, k0 = kc * 16, col = cb * 256 + lane * 4;
        float sv[5];
#pragma unroll
        for (int r = 0; r < 5; ++r) { const float cv = (r < 4) ? FIN_c[r * DM + k0 + (lane & 15)] : FIN_c_ctx[k0 + (lane & 15)]; sv[r] = cv / (1.0f + __expf(-cv)); }
        f32x4 acc[5];
#pragma unroll
        for (int r = 0; r < 5; ++r) acc[r] = (f32x4){0.f, 0.f, 0.f, 0.f};
#pragma unroll
        for (int kk = 0; kk < 16; ++kk) { const f32x4 w = *(const f32x4*)(FIN_w_ada + (size_t)(k0 + kk) * 6144 + col);
#pragma unroll
            for (int r = 0; r < 5; ++r) { const float s = __builtin_bit_cast(float, __builtin_amdgcn_readlane(__builtin_bit_cast(int, sv[r]), kk)); acc[r] += w * s; } }
        if (kc == 0) { const f32x4 bv = *(const f32x4*)(FIN_b_ada + col);
#pragma unroll
            for (int r = 0; r < 5; ++r) acc[r] += bv; }
#pragma unroll
        for (int r = 0; r < 5; ++r)
#pragma unroll
            for (int j = 0; j < 4; ++j) atomicAdd(MODQ + r * 6144 + col + j, (unsigned long long)__float2ll_rn(acc[r][j] * 0x1p36f));
    }
    float* WCS = WSP(float, WS_TAB);
    for (int it = gw; it < 256; it += NGW) {
        const int fh = it >> 6, d = it & 63; float ac = 0.f, as = 0.f;
        const float ctab = cospif((float)lane * (1.0f / 32.0f)), stab = sinpif((float)lane * (1.0f / 32.0f));
        for (int k2 = 0; k2 < 64; ++k2) { const int mm = __builtin_amdgcn_readfirstlane((d * k2) & 63); const float w = FIN_w_fourier[(fh * 64 + k2) * 64 + lane]; ac += rdl(ctab, mm) * w; as += rdl(stab, mm) * w; }
        const float sc = 1.0f / sqrtf((float)SEQ * 64.0f);
        WCS[(fh * 64 + d) * 128 + lane] = ac * sc; WCS[(fh * 64 + d) * 128 + 64 + lane] = as * sc;
    }
    {
        u16* D1 = WSP(u16, WS_TAB + 144 * 1024); u16* D3 = WSP(u16, WS_TAB + 272 * 1024);
        for (int it = gw; it < 320; it += NGW) {
            if (it < 256) { const int ro = it >> 7, k1 = it & 127;
#pragma unroll
                for (int j = 0; j < 4; ++j) { const int col = lane + 64 * j, ri = col >> 7, n1 = col & 127, mm = (n1 * k1) & 127; const float cc = cospif((float)mm * (1.0f / 64.0f)), ss = sinpif((float)mm * (1.0f / 64.0f));
                    const float v = (ro == 0) ? (ri == 0 ? cc : -ss) : (ri == 0 ? -ss : -cc); D1[it * 256 + col] = (u16)f2bf(v); } }
            else { const int k2 = it - 256;
#pragma unroll
                for (int j = 0; j < 2; ++j) { const int col = lane + 64 * j, ri = col >> 6, n2 = col & 63, mm = (n2 * k2) & 63; const float v = (ri == 0) ? cospif((float)mm * (1.0f / 32.0f)) : sinpif((float)mm * (1.0f / 32.0f)); D3[k2 * 128 + col] = (u16)f2bf(v); } }
        }
    }
    float* COS = WSP(float, WS_TAB + 128 * 1024); float* SIN = WSP(float, WS_TAB + 136 * 1024);
    for (int it = gw; it < 32; it += NGW) { const int idx = it * 64 + lane, pos = idx >> 4, i = idx & 15;
        const float inv = powf(10000.0f, -(float)i / 16.0f), ang = (float)pos * inv; COS[idx] = cosf(ang); SIN[idx] = sinf(ang); }
}

__device__ __forceinline__ int map_row(int mode, int sc) {
    if (mode == 1) { const int head = sc >> 6, dim = sc & 63, bj = dim >> 5, n = (dim >> 4) & 1, i = dim & 15; return (head >> 2) * 256 + bj * 128 + (head & 3) * 32 + (i >> 2) * 8 + n * 4 + (i & 3); }
    if (mode == 2) { const int g = sc >> 8, a = sc & 255; return (a >> 2) * 8 + g * 4 + (a & 3); }
    return sc;
}
struct TItem { const float* src; u16* dst; int N, K, k0, rel_c0, mode, dst_off; bool f16; bool f8; float ws; };
__device__ __forceinline__ void titem_load(const TItem& t, float (&buf)[64], int lane) {
#pragma unroll
    for (int i = 0; i < 64; ++i) { const int kk = 2 * i + (lane >> 5); buf[i] = t.src[(size_t)kk * t.N + (lane & 31)]; }
}
__device__ __forceinline__ void titem_finish(const TItem& t, const float (&buf)[64], LAS float* scr, int lane) {
#pragma unroll
    for (int i = 0; i < 64; ++i) { const int kk = 2 * i + (lane >> 5); scr[kk * 33 + (lane & 31)] = buf[i]; }
    LDS_WAIT(); asm volatile("" ::: "memory");
    if (t.f8) { const int c = lane & 7; const float ws = t.ws;
#pragma unroll
        for (int j = 0; j < 4; ++j) { const int n = (lane >> 3) + 8 * j; const LAS float* s = scr + (16 * c) * 33 + n; int w[4];
#pragma unroll
            for (int q = 0; q < 4; ++q) { w[q] = __builtin_amdgcn_cvt_pk_fp8_f32(s[(4 * q) * 33] * ws, s[(4 * q + 1) * 33] * ws, 0, false); w[q] = __builtin_amdgcn_cvt_pk_fp8_f32(s[(4 * q + 2) * 33] * ws, s[(4 * q + 3) * 33] * ws, w[q], true); }
            const int drow = t.dst_off + map_row(t.mode, t.rel_c0 + n);
            *(GAS u32x4*)((unsigned char*)t.dst + (size_t)drow * t.K + t.k0 + 16 * c) = (u32x4){(unsigned)w[0], (unsigned)w[1], (unsigned)w[2], (unsigned)w[3]}; } }
    else { const int c = lane & 15;
#pragma unroll
        for (int j = 0; j < 8; ++j) { const int n = (lane >> 4) + 4 * j; const LAS float* s = scr + (8 * c) * 33 + n;
            u32x4 o;
            if (t.f16) { o.x = pk2h(s[0 * 33], s[1 * 33]); o.y = pk2h(s[2 * 33], s[3 * 33]); o.z = pk2h(s[4 * 33], s[5 * 33]); o.w = pk2h(s[6 * 33], s[7 * 33]); }
            else { o.x = pk2bf(s[0 * 33], s[1 * 33]); o.y = pk2bf(s[2 * 33], s[3 * 33]); o.z = pk2bf(s[4 * 33], s[5 * 33]); o.w = pk2bf(s[6 * 33], s[7 * 33]); }
            const int drow = t.dst_off + map_row(t.mode, t.rel_c0 + n);
            *(GAS u32x4*)(t.dst + (size_t)drow * t.K + t.k0 + 8 * c) = o; } }
    LDS_WAIT(); asm volatile("" ::: "memory");
}
constexpr int I_FOLD = 512, I_QKV = 8 * 40, I_OUT = 8 * 32, I_R = 8 * 8, I_GU = NEXPS * 8 * 16, I_D = NEXPS * 2 * 32;
constexpr int NT_EARLY = I_QKV + I_OUT + I_R, NT_ITEMS = NT_EARLY + I_GU + I_D;
constexpr int DEFER_A = 3840, DEFER_B = 4096;
#define TDECODE(it_, t) do { int r = (it_); u16* BIN = WSP(u16, WS_BIN); \
        if (r < I_QKV) { const int kb = r / 40, nb = r % 40, sc0 = 256 + 32 * nb; t.N = 1536; t.K = DM; t.k0 = kb * 128; t.f16 = false; t.f8 = false; t.ws = 1.f; t.dst = BIN; t.src = FIN_w_in + (size_t)(kb * 128) * 1536 + sc0; \
            if (sc0 < 1024) { t.rel_c0 = sc0 - 256; t.mode = 1; t.dst_off = 512; } else if (sc0 < 1280) { t.rel_c0 = sc0 - 1024; t.mode = 1; t.dst_off = 1280; } else { t.rel_c0 = sc0 - 1280; t.mode = 0; t.dst_off = 1536; } \
            break; } \
        r -= I_QKV; \
        if (r < I_OUT) { const int kb = r / 32, nb = r % 32; t.N = DM; t.K = DM; t.k0 = kb * 128; t.f16 = false; t.f8 = false; t.ws = 1.f; t.dst = WSP(u16, WS_BOUT); t.src = FIN_w_out + (size_t)(kb * 128) * DM + 32 * nb; t.rel_c0 = 32 * nb; t.mode = 0; t.dst_off = 0; break; } \
        r -= I_OUT; \
        if (r < I_R) { const int kb = r / 8, nb = r % 8; t.N = NEXP; t.K = DM; t.k0 = kb * 128; t.f16 = (MOE_FP8 ? false : MOEF16); t.f8 = false; t.ws = 1.f; t.dst = WSP(u16, WS_BR); t.src = FIN_w_router + (size_t)(kb * 128) * NEXP + 32 * nb; t.rel_c0 = 32 * nb; t.mode = 0; t.dst_off = 0; break; } \
        r -= I_R; \
        if (r < I_GU) { const int e = r >> 7, q = r & 127, kb = q >> 4, nb = q & 15; const float* W = (e < NEXP) ? FIN_w_egu + (size_t)e * DM * 512 : FIN_w_sgu; \
            t.N = 512; t.K = DM; t.k0 = kb * 128; t.f16 = MOEF16; t.f8 = MOE_FP8; t.ws = WGU_SCALE; t.dst = MOE_FP8 ? (u16*)(F.ws + WS_BGU + (size_t)e * 512 * DM) : WSP(u16, WS_BGU) + (size_t)e * 512 * DM; t.src = W + (size_t)(kb * 128) * 512 + 32 * nb; t.rel_c0 = 32 * nb; t.mode = 2; t.dst_off = 0; break; } \
        r -= I_GU; \
        { const int e = r >> 6, q = r & 63, kb = q >> 5, nb = q & 31; const float* W = (e < NEXP) ? FIN_w_ed + (size_t)e * EFF * DM : FIN_w_sd; \
            t.N = DM; t.K = EFF; t.k0 = kb * 128; t.f16 = MOEF16; t.f8 = MOE_FP8; t.ws = WD_SCALE; t.dst = MOE_FP8 ? (u16*)(F.ws + WS_BD + (size_t)e * DM * EFF) : WSP(u16, WS_BD) + (size_t)e * DM * EFF; t.src = W + (size_t)(kb * 128) * DM + 32 * nb; t.rel_c0 = 32 * nb; t.mode = 0; t.dst_off = 0; } \
    } while (0)
__device__ __forceinline__ void transpose_range(Frame& F, int first, int count, int w, int nw) {
    LAS float* scr = (LAS float*)(F.lds + F.wave * P1_SCR); const int lane = F.lane; const int end = first + count;
    float bufA[64], bufB[64]; TItem ta, tb; int it = first + w;
    if (it < end) { TDECODE(it, ta); titem_load(ta, bufA, lane); }
    while (it < end) {
        const int itb = it + nw; const bool hb = itb < end;
        if (hb) { TDECODE(itb, tb); titem_load(tb, bufB, lane); }
        titem_finish(ta, bufA, scr, lane);
        if (!hb) break;
        const int ita = itb + nw; const bool ha = ita < end;
        if (ha) { TDECODE(ita, ta); titem_load(ta, bufA, lane); }
        titem_finish(tb, bufB, scr, lane);
        it = ita;
    }
}
__device__ __forceinline__ void p1_phase(Frame& F) {
    LAS float* scr = (LAS float*)(F.lds + F.wave * P1_SCR);
    const int gw = F.vcu * 8 + F.wave, NGW = F.G * 8, lane = F.lane;
    u16* BIN = WSP(u16, WS_BIN);
    for (int r = gw; r < I_FOLD; r += NGW) {
        const int fh = r >> 7, cs = (r >> 6) & 1, kb = (r >> 2) & 15, eq = r & 3; const int k = kb * 64 + lane;
        const GAS float* WCS = (const GAS float*)(F.ws + WS_TAB);
#pragma unroll 4
        for (int i = 0; i < 16; ++i) scr[(4 * i + (lane >> 4)) * 16 + (lane & 15)] = WCS[(fh * 64 + 4 * i + (lane >> 4)) * 128 + cs * 64 + 16 * eq + (lane & 15)];
        float wrow[64];
#pragma unroll
        for (int d4 = 0; d4 < 16; ++d4) { const f32x4 v = *(const f32x4*)(FIN_w_in + (size_t)k * 1536 + fh * 64 + 4 * d4); wrow[4 * d4] = v[0]; wrow[4 * d4 + 1] = v[1]; wrow[4 * d4 + 2] = v[2]; wrow[4 * d4 + 3] = v[3]; }
        LDS_WAIT(); asm volatile("" ::: "memory");
        for (int e1 = 0; e1 < 16; ++e1) { float a = 0.f;
#pragma unroll
            for (int d = 0; d < 64; ++d) a += wrow[d] * scr[d * 16 + e1];
            const int col256 = fh * 64 + 16 * eq + e1, pos = 8 * (col256 >> 2) + (col256 & 3) + 4 * cs;
            BIN[(size_t)pos * DM + k] = (u16)f2bf(a); }
        LDS_WAIT(); asm volatile("" ::: "memory");
    }
    const int ndefer = (F.G == 256) ? DEFER_A + DEFER_B : 0;
    REPS(11) transpose_range(F, 0, NT_ITEMS - ndefer, gw, NGW);
    const gi64* MOD = (const gi64*)(F.ctl + CW_MOD);
    u16* XN = WSP(u16, WS_XN);
    REPS(12) { const int wpb = NGW >> 2, b = gw / wpb, wi = gw % wpb;
        rownorm_rows<false>((const GAS float*)FIN_x, FIN_norm1_g, MOD + b * 6144, MOD + b * 6144 + 1024, XN, b * SEQ, SEQ, wi, wpb, lane);
        rownorm_rows<false>((const GAS float*)FIN_ctx, FIN_norm1_g, MOD + 4 * 6144, MOD + 4 * 6144 + 1024, XN + (size_t)NTOK * DM, 0, NCTX, gw, NGW, lane); }
}

__device__ __forceinline__ void fourier_unit(Frame& F, int b, int g) {
    LAS unsigned char* Zl = F.lds + RING_OFF;
    LAS f32x2* TW128 = (LAS f32x2*)(F.lds + TAB_OFF);
    LAS f32x2* TW64 = (LAS f32x2*)(F.lds + TAB_OFF + 1024);
    const int tid = F.tid;
    const GAS u32x4* Zg = (const GAS u32x4*)(F.ws + WS_Z + ((size_t)(b * 64 + g) * SEQ) * 16);
#pragma unroll 4
    for (int i = 0; i < 16; ++i) *(LAS u32x4*)(Zl + (size_t)(i * 512 + tid) * 16) = Zg[i * 512 + tid];
    if (tid < 128) { float s, c; sincospif((float)tid * (1.0f / 64.0f), &s, &c); TW128[tid] = (f32x2){c, s}; }
    else if (tid < 192) { float s, c; sincospif((float)(tid - 128) * (1.0f / 32.0f), &s, &c); TW64[tid - 128] = (f32x2){c, s}; }
    __syncthreads();
    const int k1 = tid & 127, q = tid >> 7;
    float yr[16][4], yi[16][4];
#pragma unroll
    for (int a = 0; a < 16; ++a)
#pragma unroll
        for (int e = 0; e < 4; ++e) { yr[a][e] = 0.f; yi[a][e] = 0.f; }
    for (int n1 = 0; n1 < 128; ++n1) {
        const f32x2 tw = TW128[(n1 * k1) & 127]; const float c = tw.x, s = tw.y;
#pragma unroll
        for (int a = 0; a < 16; ++a) { const u32x4 rw = *(const LAS u32x4*)(Zl + (size_t)(64 * n1 + 16 * q + a) * 16);
            const float uc[4] = {bflo(rw.x), bfhi(rw.x), bflo(rw.y), bfhi(rw.y)}, us[4] = {bflo(rw.z), bfhi(rw.z), bflo(rw.w), bfhi(rw.w)};
#pragma unroll
            for (int e = 0; e < 4; ++e) { yr[a][e] += uc[e] * c - us[e] * s; yi[a][e] -= uc[e] * s + us[e] * c; } }
    }
    __syncthreads();
    int k1b = k1; asm volatile("" : "+v"(k1b));
#pragma unroll
    for (int a = 0; a < 16; ++a) { const int n2 = 16 * q + a; const float fr_ = (float)(n2 * k1b) * (1.0f / 8192.0f);
        const float cp = __builtin_amdgcn_cosf(fr_), sp = __builtin_amdgcn_sinf(fr_);
        float pr[4], pi[4];
#pragma unroll
        for (int e = 0; e < 4; ++e) { pr[e] = yr[a][e] * cp + yi[a][e] * sp; pi[e] = yi[a][e] * cp - yr[a][e] * sp; }
        u32x4 w; w.x = pk2bf(pr[0], pr[1]); w.y = pk2bf(pr[2], pr[3]); w.z = pk2bf(pi[0], pi[1]); w.w = pk2bf(pi[2], pi[3]);
        *(LAS u32x4*)(Zl + (size_t)(n2 * 128 + k1b) * 16) = w; }
    __syncthreads();
    int k1c = k1; asm volatile("" : "+v"(k1c));
    float o[16][4];
#pragma unroll
    for (int a = 0; a < 16; ++a)
#pragma unroll
        for (int e = 0; e < 4; ++e) o[a][e] = 0.f;
    for (int n2 = 0; n2 < 64; ++n2) {
        const u32x4 rw = *(const LAS u32x4*)(Zl + (size_t)(n2 * 128 + k1c) * 16);
        const float pr[4] = {bflo(rw.x), bfhi(rw.x), bflo(rw.y), bfhi(rw.y)}, pi[4] = {bflo(rw.z), bfhi(rw.z), bflo(rw.w), bfhi(rw.w)};
#pragma unroll
        for (int a = 0; a < 16; ++a) { const f32x2 tw = TW64[(n2 * (16 * q + a)) & 63];
#pragma unroll
            for (int e = 0; e < 4; ++e) o[a][e] += pr[e] * tw.x + pi[e] * tw.y; }
    }
    u16* MIX = WSP(u16, WS_MIX);
#pragma unroll
    for (int a = 0; a < 16; ++a) { const int k2 = 16 * q + a; u32x2 w; w.x = pk2bf(o[a][0], o[a][1]); w.y = pk2bf(o[a][2], o[a][3]);
        *(GAS u32x2*)(MIX + ((size_t)(b * SEQ + k1c + 128 * k2)) * DM + 4 * g) = w; }
    __syncthreads();
}

__device__ __forceinline__ attn_body::s16x4 ftr(const LAS unsigned char* p) { return __builtin_bit_cast(attn_body::s16x4, __builtin_amdgcn_ds_read_tr16_b64_v4i16((LAS attn_body::v4i16_t*)p)); }
__device__ __forceinline__ void fourier_unit_mfma(Frame& F, int b, int g) {
    LAS unsigned char* Zl = F.lds + RING_OFF;
    const int tid = F.tid, lane = F.lane, w = F.wave;
    const char* Zg = (const char*)(F.ws + WS_Z) + ((size_t)(b * 64 + g) * SEQ) * 16;
#pragma unroll
    for (int i = 0; i < 16; ++i) __builtin_amdgcn_global_load_lds((const unsigned*)(Zg + (size_t)(i * 512 + tid) * 16), (LAS unsigned*)(Zl + (size_t)(i * 512 + w * 64) * 16), 16, 0, 0);
    VM_WAIT(); __syncthreads();
    f32x4 acc[2][16];
#pragma unroll
    for (int ro = 0; ro < 2; ++ro)
#pragma unroll
        for (int t = 0; t < 16; ++t) acc[ro][t] = (f32x4){0.f, 0.f, 0.f, 0.f};
    const GAS bf16x8* D1 = (const GAS bf16x8*)(F.ws + WS_TAB + 144 * 1024);
    const GAS bf16x8* D3 = (const GAS bf16x8*)(F.ws + WS_TAB + 272 * 1024);
    const int l15 = lane & 15, lq = lane >> 4;
    const unsigned bbase = (unsigned)((64 * (8 * lq + (l15 >> 2)) + (lane & 3)) * 16);
#pragma unroll 1
    for (int s1 = 0; s1 < 8; ++s1) {
        const int ri = s1 >> 2;
        const bf16x8 a0 = D1[(16 * w + l15) * 32 + 4 * s1 + lq], a1 = D1[(128 + 16 * w + l15) * 32 + 4 * s1 + lq];
        const LAS unsigned char* sb = Zl + bbase + (unsigned)((s1 & 3) * 32768 + 8 * ri);
#pragma unroll
        for (int t = 0; t < 16; ++t) { const attn_body::s16x4 lo = ftr(sb + 64 * t), hi = ftr(sb + 64 * t + 4096);
            const bf16x8 bf = (bf16x8){lo[0], lo[1], lo[2], lo[3], hi[0], hi[1], hi[2], hi[3]};
            acc[0][t] = __builtin_amdgcn_mfma_f32_16x16x32_bf16(a0, bf, acc[0][t], 0, 0, 0);
            acc[1][t] = __builtin_amdgcn_mfma_f32_16x16x32_bf16(a1, bf, acc[1][t], 0, 0, 0); }
    }
    __syncthreads();
    {   const int e = lane & 3; int k1b = 16 * w + 4 * lq; asm volatile("" : "+v"(k1b));
#pragma unroll
        for (int t = 0; t < 16; ++t) { const int n2 = 4 * t + (l15 >> 2);
#pragma unroll
            for (int r = 0; r < 4; ++r) { const int k1 = k1b + r; const float fr_ = (float)(n2 * k1) * (1.0f / 8192.0f); const float cp = __builtin_amdgcn_cosf(fr_), sp = __builtin_amdgcn_sinf(fr_);
                const float yr = acc[0][t][r], yi = acc[1][t][r]; const float pr = yr * cp + yi * sp, pi = yi * cp - yr * sp;
                *(LAS u16*)(Zl + (unsigned)(((n2) * 512 + k1 * 4 + e) * 2)) = (u16)f2bf(pr);
                *(LAS u16*)(Zl + (unsigned)(((64 + n2) * 512 + k1 * 4 + e) * 2)) = (u16)f2bf(pi); } }
    }
    asm volatile("s_waitcnt lgkmcnt(0)" ::: "memory");
    f32x4 acc3[4][4];
#pragma unroll
    for (int mt = 0; mt < 4; ++mt)
#pragma unroll
        for (int j = 0; j < 4; ++j) acc3[mt][j] = (f32x4){0.f, 0.f, 0.f, 0.f};
#pragma unroll
    for (int s3 = 0; s3 < 4; ++s3) {
        bf16x8 a[4];
#pragma unroll
        for (int mt = 0; mt < 4; ++mt) a[mt] = D3[(16 * mt + l15) * 16 + 4 * s3 + lq];
        const unsigned kk = (unsigned)(32 * s3 + 8 * lq + (l15 >> 2));
#pragma unroll
        for (int j = 0; j < 4; ++j) { const unsigned ad = kk * 1024u + (unsigned)((4 * (4 * w + j) + (lane & 3)) * 8);
            const attn_body::s16x4 lo = ftr(Zl + ad), hi = ftr(Zl + ad + 4096);
            const bf16x8 bf = (bf16x8){lo[0], lo[1], lo[2], lo[3], hi[0], hi[1], hi[2], hi[3]};
#pragma unroll
            for (int mt = 0; mt < 4; ++mt) acc3[mt][j] = __builtin_amdgcn_mfma_f32_16x16x32_bf16(a[mt], bf, acc3[mt][j], 0, 0, 0); }
    }
    u16* MIX = WSP(u16, WS_MIX);
#pragma unroll
    for (int mt = 0; mt < 4; ++mt)
#pragma unroll
        for (int j = 0; j < 4; ++j)
#pragma unroll
            for (int r = 0; r < 4; ++r) { const int k2 = 16 * mt + 4 * lq + r, k1 = 16 * w + 4 * j + (l15 >> 2);
                MIX[((size_t)(b * SEQ + k1 + 128 * k2)) * DM + 4 * g + (lane & 3)] = (u16)f2bf(acc3[mt][j][r]); }
    __syncthreads();
}

__device__ __forceinline__ float dpp_f(float v, int ctrl_sel) {
    const int x = __builtin_bit_cast(int, v); int r;
    if (ctrl_sel == 0) r = __builtin_amdgcn_update_dpp(x, x, 0xB1, 0xF, 0xF, false);
    else if (ctrl_sel == 1) r = __builtin_amdgcn_update_dpp(x, x, 0x4E, 0xF, 0xF, false);
    else if (ctrl_sel == 2) r = __builtin_amdgcn_update_dpp(x, x, 0x141, 0xF, 0xF, false);
    else r = __builtin_amdgcn_update_dpp(x, x, 0x140, 0xF, 0xF, false);
    return __builtin_bit_cast(float, r);
}
__device__ __forceinline__ void route_token(Frame& F, int tok) {
    const int l = F.lane;
    const f32x4 lg = *(const GAS f32x4*)((const GAS float*)(F.ws + WS_LOG) + (size_t)tok * NEXP + 4 * l);
    const f32x4 bs = *(const f32x4*)(FIN_router_bias + 4 * l);
    float s[4], sel[4];
#pragma unroll
    for (int j = 0; j < 4; ++j) { s[j] = 1.0f / (1.0f + expf(-lg[j])); sel[j] = s[j] + bs[j]; }
    float m1 = fmaxf(sel[0], sel[1]), m2 = fminf(sel[0], sel[1]);
#pragma unroll
    for (int j = 2; j < 4; ++j) { const float v = sel[j]; m2 = fmaxf(m2, fminf(m1, v)); m1 = fmaxf(m1, v); }
#pragma unroll
    for (int st = 0; st < 3; ++st) { const float o1 = dpp_f(m1, st), o2 = dpp_f(m2, st); const float n2 = fmaxf(fminf(m1, o1), fmaxf(m2, o2)); m1 = fmaxf(m1, o1); m2 = n2; }
    const float gs = m1 + m2; const int myg = l >> 3; int rank = 0;
#pragma unroll
    for (int g2 = 0; g2 < 8; ++g2) { const float og = rdl(gs, g2 * 8); rank += (og > gs || (og == gs && g2 < myg)) ? 1 : 0; }
    if (rank >= 4) {
#pragma unroll
        for (int j = 0; j < 4; ++j) sel[j] = -INFINITY; }
    int my_e = 0; float my_s = 0.f, sum = 0.f;
#pragma unroll 1
    for (int k = 0; k < TOPK; ++k) {
        const float lb = fmaxf(fmaxf(sel[0], sel[1]), fmaxf(sel[2], sel[3]));
        float r = lb; r = fmaxf(r, dpp_f(r, 0)); r = fmaxf(r, dpp_f(r, 1)); r = fmaxf(r, dpp_f(r, 2)); r = fmaxf(r, dpp_f(r, 3));
        const float wm = fmaxf(fmaxf(rdl(r, 0), rdl(r, 16)), fmaxf(rdl(r, 32), rdl(r, 48)));
        const unsigned long long mask = __ballot(lb == wm);
        const int wl = __builtin_amdgcn_readfirstlane((int)__ffsll((long long)mask) - 1);
        const int jj = (sel[0] == wm) ? 0 : (sel[1] == wm) ? 1 : (sel[2] == wm) ? 2 : 3;
        const float cand = (jj == 0) ? s[0] : (jj == 1) ? s[1] : (jj == 2) ? s[2] : s[3];
        const int jw = __builtin_amdgcn_readlane(jj, wl); const float wsc = rdl(cand, wl);
        if (l == wl) {
#pragma unroll
            for (int j = 0; j < 4; ++j) if (jw == j) sel[j] = -INFINITY; }
        if (l == k) { my_e = 4 * wl + jw; my_s = wsc; }
        sum += wsc;
    }
    GAS u32x2* LIST = (GAS u32x2*)(F.ws + WS_LIST);
    if (l < TOPK) { const float gate = my_s / sum * 2.5f; const unsigned pos = __hip_atomic_fetch_add((unsigned*)(F.ctl + CW_CNT + my_e), 1u, RLX_AGENT);
        LIST[(size_t)my_e * NTOK + pos] = (u32x2){(unsigned)tok | ((unsigned)l << 16), __builtin_bit_cast(unsigned, gate)}; }
    else if (l == TOPK) LIST[(size_t)NEXP * NTOK + tok] = (u32x2){(unsigned)tok | (8u << 16), __builtin_bit_cast(unsigned, 1.0f)};
}

__device__ __forceinline__ void build_tiles(Frame& F) {
    LAS int* TS = (LAS int*)(F.lds + TAB_OFF + 2048); LAS int* CN = (LAS int*)(F.lds + TAB_OFF + 3200);
    if (F.tid < 64) { const int l = F.tid; int c[5], t[5], tot = 0;
#pragma unroll
        for (int j = 0; j < 5; ++j) { const int e = 5 * l + j; c[j] = (e < NEXPS) ? (int)__hip_atomic_load((unsigned*)(F.ctl + CW_CNT + e), RLX_AGENT) : 0; t[j] = (c[j] + 255) >> 8; tot += t[j]; }
        int x = tot;
#pragma unroll
        for (int off = 1; off < 64; off <<= 1) { const int v = __shfl_up(x, off); if (l >= off) x += v; }
        int run = x - tot;
#pragma unroll
        for (int j = 0; j < 5; ++j) { const int e = 5 * l + j; if (e <= NEXPS) { TS[e] = run; if (e < NEXPS) CN[e] = c[j]; } run += t[j]; }
    }
    __syncthreads();
}

__device__ __forceinline__ void ph2(Frame& F) {
    const gi64* MOD = (const gi64*)(F.ctl + CW_MOD); const int gw = F.vcu * 8 + F.wave, NGW = F.G * 8; (void)MOD; (void)gw; (void)NGW;
        DenseOrder S{7, 128 * 7, 8, F.G, F.vcu, (const char*)(F.ws + WS_BIN), DM, (REP == 22) ? 2 : 1};
        EpiInProj E{WSP(u16, WS_Z), WSP(u16, WS_Q), WSP(u16, WS_K), WSP(u16, WS_V), WSP(float, WS_TAB + 128 * 1024), WSP(float, WS_TAB + 136 * 1024), FIN_q_norm_g, FIN_k_norm_g};
        pg8::gemm_phase<EpiInProj, DenseOrder, 0, true>(F.lds + RING_OFF, (const char*)(F.ws + WS_XN), DM, S, E);
        if (F.G == 256 && F.vcu >= 136) transpose_range(F, NT_ITEMS - DEFER_A - DEFER_B, DEFER_A, (F.vcu - 136) * 8 + F.wave, 120 * 8);
    }
__device__ __forceinline__ void ph4(Frame& F) {
    const gi64* MOD = (const gi64*)(F.ctl + CW_MOD); const int gw = F.vcu * 8 + F.wave, NGW = F.G * 8; (void)MOD; (void)gw; (void)NGW;
        if (DBG & 128) { GAS u32x4* zH = (GAS u32x4*)(F.ws + WS_H2); const size_t nH = (size_t)NTOK * DM * 2 / 16; for (size_t i = (size_t)blockIdx.x * 512 + F.tid; i < nH; i += (size_t)F.G * 512) zH[i] = (u32x4){0u, 0u, 0u, 0u}; }
        DenseOrder S{4, 128 * 4, 0, F.G, F.vcu, (const char*)(F.ws + WS_BOUT), DM, 1};
        EpiResid E{FIN_x, F.out, MOD};
        pg8::gemm_phase<EpiResid, DenseOrder, 0, true>(F.lds + RING_OFF, (const char*)(F.ws + WS_MIX), DM, S, E);
    }
__device__ __forceinline__ void ph5(Frame& F) {
    const gi64* MOD = (const gi64*)(F.ctl + CW_MOD); const int gw = F.vcu * 8 + F.wave, NGW = F.G * 8;
    const int wpb = NGW >> 2, b = gw / wpb, wi = gw % wpb;
    rownorm_rows<(MOE_FP8 ? false : MOEF16), MOE_FP8>((const GAS float*)F.out, FIN_norm2_g, MOD + b * 6144 + 3072, MOD + b * 6144 + 4096, WSP(u16, WS_H2), b * SEQ, SEQ, wi, wpb, F.lane, F.ws + WS_H2F8);
}
__device__ __forceinline__ void ph6(Frame& F) {
    const gi64* MOD = (const gi64*)(F.ctl + CW_MOD); const int gw = F.vcu * 8 + F.wave, NGW = F.G * 8; (void)MOD; (void)gw; (void)NGW;
        DenseOrder S{1, 128, 0, F.G, F.vcu, (const char*)(F.ws + WS_BR), DM, 1};
        EpiLogits E{WSP(float, WS_LOG)};
        pg8::gemm_phase<EpiLogits, DenseOrder, (MOE_FP8 ? 0 : (MOE_F16 ? 1 : 0)), true>(F.lds + RING_OFF, (const char*)(F.ws + WS_H2), DM, S, E);
        if (F.G == 256 && F.vcu >= 128) transpose_range(F, NT_ITEMS - DEFER_B, DEFER_B, (F.vcu - 128) * 8 + F.wave, 128 * 8);
    }
__device__ __forceinline__ void ph8(Frame& F) {
    const gi64* MOD = (const gi64*)(F.ctl + CW_MOD); const int gw = F.vcu * 8 + F.wave, NGW = F.G * 8; (void)MOD; (void)gw; (void)NGW;
        build_tiles(F);
        GroupedOrder<true> S{2, F.G, F.vcu, 512, DM * (MOE_FP8 ? 1 : 2), true, (const char*)(F.ws + WS_BGU), (const LAS int*)(F.lds + TAB_OFF + 2048), (const LAS int*)(F.lds + TAB_OFF + 3200), (const GAS u32x2*)(F.ws + WS_LIST), (REP == 28) ? 2 : 1, __builtin_amdgcn_readfirstlane(((const LAS int*)(F.lds + TAB_OFF + 2048))[257])};
        EpiSwiglu E{WSP(u16, WS_ACT)};
        pg8::gemm_phase<EpiSwiglu, GroupedOrder<true>, MOE_DT, true>(F.lds + RING_OFF, (const char*)(F.ws + (MOE_FP8 ? WS_H2F8 : WS_H2)), DM, S, E, SC_GU);
    }
__device__ __forceinline__ void ph9(Frame& F) {
    const gi64* MOD = (const gi64*)(F.ctl + CW_MOD); const int gw = F.vcu * 8 + F.wave, NGW = F.G * 8; (void)MOD; (void)gw; (void)NGW;
        build_tiles(F);
        GroupedOrder<false> S{4, F.G, F.vcu, DM, EFF * (MOE_FP8 ? 1 : 2), false, (const char*)(F.ws + WS_BD), (const LAS int*)(F.lds + TAB_OFF + 2048), (const LAS int*)(F.lds + TAB_OFF + 3200), (const GAS u32x2*)(F.ws + WS_LIST), (REP == 29) ? 2 : 1, __builtin_amdgcn_readfirstlane(((const LAS int*)(F.lds + TAB_OFF + 2048))[257])};
        EpiDown E{WSP(u16, WS_C), (const GAS u32x2*)(F.ws + WS_LIST), F.ws + WS_DUMP};
        pg8::gemm_phase<EpiDown, GroupedOrder<false>, MOE_DT, true>(F.lds + RING_OFF, (const char*)(F.ws + WS_ACT), EFF, S, E, SC_D);
    }

#if DBG & (1024 | 2048)
__device__ __forceinline__ float f8dec(unsigned w, int k) { return (k == 0) ? __builtin_amdgcn_cvt_f32_fp8((int)w, 0) : (k == 1) ? __builtin_amdgcn_cvt_f32_fp8((int)w, 1) : (k == 2) ? __builtin_amdgcn_cvt_f32_fp8((int)w, 2) : __builtin_amdgcn_cvt_f32_fp8((int)w, 3); }
__device__ __forceinline__ void chk_attn(Frame& F, float negM) {
    const int gw = F.vcu * 8 + F.wave, NGW = F.G * 8, lane = F.lane;
    const GAS u16* Q = (const GAS u16*)(F.ws + WS_Q); const GAS u16* K = (const GAS u16*)(F.ws + WS_K); const GAS u16* V = (const GAS u16*)(F.ws + WS_V); const GAS u16* MIX = (const GAS u16*)(F.ws + WS_MIX);
    const GAS unsigned char* Q8 = (const GAS unsigned char*)(F.ws + WS_Q); const GAS unsigned char* K8 = (const GAS unsigned char*)(F.ws + WS_K); const GAS unsigned char* Vt8 = (const GAS unsigned char*)(F.ws + WS_V);
    float* chk = (float*)(F.ctl + CW_CHK);
    if (ATTN_FP8) negM = fminf(negM + 8.8f, 0.f);
    for (int i = gw; i < 4096; i += NGW) {
        const int b = i & 3, h = (i >> 2) % 12, q = (int)((((unsigned)i * 2654435761u) >> 19) & 8191u), kvh = h / 3;
        float qv[64], o[64]; float l = 0.f;
        if (ATTN_FP8) {
#pragma unroll
            for (int c = 0; c < 16; ++c) { const unsigned w = *(const GAS unsigned*)(Q8 + ((size_t)(b * SEQ + q)) * QW + h * 64 + 4 * c);
#pragma unroll
                for (int k = 0; k < 4; ++k) qv[4 * c + k] = f8dec(w, k) * (1.0f / Q8_SCALE); }
        } else {
#pragma unroll
        for (int c = 0; c < 8; ++c) { const u32x4 w = *(const GAS u32x4*)(Q + ((size_t)(b * SEQ + q)) * QW + h * 64 + 8 * c);
            qv[8 * c] = bflo(w.x); qv[8 * c + 1] = bfhi(w.x); qv[8 * c + 2] = bflo(w.y); qv[8 * c + 3] = bfhi(w.y); qv[8 * c + 4] = bflo(w.z); qv[8 * c + 5] = bfhi(w.z); qv[8 * c + 6] = bflo(w.w); qv[8 * c + 7] = bfhi(w.w); }
        }
#pragma unroll
        for (int d = 0; d < 64; ++d) o[d] = 0.f;
        for (int t = 0; t < LKV / 64; ++t) { const int j = t * 64 + lane; float dot = 0.f, pp, pq;
            if (ATTN_FP8) { const GAS unsigned char* kr = K8 + ((size_t)(b * LKV + j)) * KVW + kvh * 64;
#pragma unroll
                for (int c = 0; c < 16; ++c) { const unsigned w = *(const GAS unsigned*)(kr + 4 * c);
#pragma unroll
                    for (int k = 0; k < 4; ++k) dot += qv[4 * c + k] * f8dec(w, k); }
                pp = exp2f(dot + negM); pq = __builtin_amdgcn_cvt_f32_fp8(__builtin_amdgcn_cvt_pk_fp8_f32(pp, 0.f, 0, false), 0); l += pq;
                const GAS unsigned char* vb = Vt8 + (((size_t)(b * NKVH + kvh) * (LKV / 64) + t) * 64) * 64 + attn_body::vt_slot(lane);
#pragma unroll
                for (int d = 0; d < 64; ++d) o[d] += pq * __builtin_amdgcn_cvt_f32_fp8((int)vb[d * 64], 0);
            } else { const GAS u16* kr = K + ((size_t)(b * LKV + j)) * KVW + kvh * 64; const GAS u16* vr = V + ((size_t)(b * LKV + j)) * KVW + kvh * 64;
#pragma unroll
            for (int c = 0; c < 8; ++c) { const u32x4 w = *(const GAS u32x4*)(kr + 8 * c);
                dot += qv[8 * c] * bflo(w.x) + qv[8 * c + 1] * bfhi(w.x) + qv[8 * c + 2] * bflo(w.y) + qv[8 * c + 3] * bfhi(w.y) + qv[8 * c + 4] * bflo(w.z) + qv[8 * c + 5] * bfhi(w.z) + qv[8 * c + 6] * bflo(w.w) + qv[8 * c + 7] * bfhi(w.w); }
            pp = exp2f(dot + negM); l += pp;
#pragma unroll
            for (int c = 0; c < 8; ++c) { const u32x4 w = *(const GAS u32x4*)(vr + 8 * c);
                o[8 * c] += pp * bflo(w.x); o[8 * c + 1] += pp * bfhi(w.x); o[8 * c + 2] += pp * bflo(w.y); o[8 * c + 3] += pp * bfhi(w.y); o[8 * c + 4] += pp * bflo(w.z); o[8 * c + 5] += pp * bfhi(w.z); o[8 * c + 6] += pp * bflo(w.w); o[8 * c + 7] += pp * bfhi(w.w); } } }
        l = wave_sum(l); float err = 0.f, ref = 0.f;
#pragma unroll
        for (int d = 0; d < 64; ++d) { const float od = wave_sum(o[d]) / l; const float mv = bflo((unsigned)MIX[((size_t)(b * SEQ + q)) * DM + 256 + h * 64 + d]); err += (od - mv) * (od - mv); ref += od * od; }
        if (lane == 0) { atomicAdd(chk + 0, err); atomicAdd(chk + 1, ref); }
    }
}
__device__ __forceinline__ void chk_qkv(Frame& F) {
    const int gw = F.vcu * 8 + F.wave, NGW = F.G * 8, lane = F.lane;
    const gi64* MOD = (const gi64*)(F.ctl + CW_MOD);
    LAS float* hrow = (LAS float*)(F.lds + RING_OFF + F.wave * 16384);
    float* chk = (float*)(F.ctl + CW_CHK);
    for (int i = gw; i < 4096; i += NGW) {
        const unsigned hs = (unsigned)i * 2654435761u; const bool isctx = (i & 15) == 15; int sel = i % 20; if (isctx && sel < 12) sel = 12 + (sel & 7);
        const int m = isctx ? (int)((hs >> 10) & 1023u) : (int)((hs >> 12) & 32767u);
        const float* src = isctx ? FIN_ctx + (size_t)m * DM : FIN_x + (size_t)m * DM; const int mr = isctx ? 4 : (m >> 13);
        const int b = isctx ? (m >> 8) : (m >> 13), l = isctx ? 0 : (m & 8191), key = isctx ? SEQ + (m & 255) : l;
        f32x4 v[4]; float s2 = 0.f;
#pragma unroll
        for (int j = 0; j < 4; ++j) { v[j] = *(const f32x4*)(src + 4 * lane + 256 * j); s2 += (v[j][0] * v[j][0] + v[j][1] * v[j][1]) + (v[j][2] * v[j][2] + v[j][3] * v[j][3]); }
        const float rstd = 1.0f / sqrtf(wave_sum(s2) * (1.0f / DM) + RMS_EPS);
#pragma unroll
        for (int j = 0; j < 4; ++j) { const int col = 4 * lane + 256 * j; const f32x4 g = *(const f32x4*)(FIN_norm1_g + col); const f32x4 sh = mod4(MOD, mr * 6144 + col), sc = mod4(MOD, mr * 6144 + 1024 + col);
            const f32x4 y = v[j] * rstd * g * (sc + 1.0f) + sh; hrow[col] = y[0]; hrow[col + 1] = y[1]; hrow[col + 2] = y[2]; hrow[col + 3] = y[3]; }
        LDS_WAIT(); asm volatile("" ::: "memory");
        const int colbase = (sel < 12) ? 256 + 64 * sel : (sel < 16 ? 1024 + 64 * (sel - 12) : 1280 + 64 * (sel - 16));
        float z = 0.f;
        for (int k = 0; k < DM; ++k) z += hrow[k] * FIN_w_in[(size_t)k * 1536 + colbase + lane];
        float outv = z; int spos = lane;
        if (sel < 16) { const float ss = wave_sum(z * z); const float gain = (sel < 12) ? FIN_q_norm_g[lane] : FIN_k_norm_g[lane]; const float zz = z * (1.0f / sqrtf(ss * (1.0f / 64.0f) + RMS_EPS)) * gain;
            const float pz = __shfl(zz, lane ^ 16); outv = zz;
            if (!isctx) { const int pidx = (lane & 32) ? (l & 63) : (l >> 6); const float inv = powf(10000.0f, -(float)(lane & 15) / 16.0f), ang = (float)pidx * inv; const float cs = cosf(ang), sn = sinf(ang);
                outv = (lane & 16) ? zz * cs + pz * sn : zz * cs - pz * sn; }
            if (sel < 12) outv *= C2;
            spos = 32 * (lane >> 5) + 8 * ((lane >> 2) & 3) + 4 * ((lane >> 4) & 1) + (lane & 3); }
        float stored;
        if (ATTN_FP8) {
            if (sel < 12) stored = __builtin_amdgcn_cvt_f32_fp8((int)((const GAS unsigned char*)(F.ws + WS_Q))[(size_t)m * QW + sel * 64 + spos], 0) * (1.0f / Q8_SCALE);
            else if (sel < 16) stored = __builtin_amdgcn_cvt_f32_fp8((int)((const GAS unsigned char*)(F.ws + WS_K))[((size_t)(b * LKV + key)) * KVW + (sel - 12) * 64 + spos], 0);
            else stored = __builtin_amdgcn_cvt_f32_fp8((int)((const GAS unsigned char*)(F.ws + WS_V))[((((size_t)(b * NKVH + (sel - 16)) * (LKV / 64) + (key >> 6)) * 64 + lane) * 64) + attn_body::vt_slot(key & 63)], 0);
        } else {
        if (sel < 12) stored = bflo((unsigned)((const GAS u16*)(F.ws + WS_Q))[(size_t)m * QW + sel * 64 + spos]);
        else if (sel < 16) stored = bflo((unsigned)((const GAS u16*)(F.ws + WS_K))[((size_t)(b * LKV + key)) * KVW + (sel - 12) * 64 + spos]);
        else stored = bflo((unsigned)((const GAS u16*)(F.ws + WS_V))[((size_t)(b * LKV + key)) * KVW + (sel - 16) * 64 + lane]); }
        const float err = wave_sum((outv - stored) * (outv - stored)), ref = wave_sum(outv * outv);
        if (lane == 0) { atomicAdd(chk + 2, err); atomicAdd(chk + 3, ref); }
        LDS_WAIT(); asm volatile("" ::: "memory");
    }
}
#endif

struct Args { const float* in[20]; float* out; unsigned char* ws; int ph_lo, ph_hi; };
__global__ void __launch_bounds__(512, 2) mk_fwd(Args args) {
    extern __shared__ __attribute__((aligned(16))) unsigned char lds[];
    Frame F;
    F.lds = (LAS unsigned char*)lds;
    F.MISC = (volatile LAS unsigned*)(F.lds + MISC_OFF);
    F.tid = threadIdx.x; F.lane = F.tid & 63; F.wave = __builtin_amdgcn_readfirstlane(F.tid >> 6);
    F.G = gridDim.x; { const int bx = blockIdx.x; F.vcu = (F.G % 8 == 0) ? (bx % 8) * (F.G / 8) + bx / 8 : bx; }
    F.ws = args.ws; F.ctl = (gu32*)(args.ws + WS_CTL); F.out = args.out;
    F.ka = (const float* const*)__builtin_amdgcn_kernarg_segment_ptr();
    for (int u = F.tid; u < (LDS_BYTES - LDSCTL_OFF) / 4; u += 512) ((LAS unsigned*)(F.lds + LDSCTL_OFF))[u] = 0u;
    __syncthreads();
    XcdBarrier bar; bar.bar = (unsigned*)(F.ctl + CW_BAR); bar.x = 0; bar.st = nullptr;
    if (N_LAUNCHES == 1) bar = xcd_barrier_post((unsigned*)(F.ctl + CW_BAR), F.MISC + 8);
    const int lo = args.ph_lo, hi = args.ph_hi;
#define IN(k) (lo <= (k) && (k) < hi)
#define SEAM(k) do { if (IN(k) && IN((k) + 1)) xcd_barrier(bar); asm volatile("" : "+s"(F.ka)); } while (0)
    const gi64* MOD = (const gi64*)(F.ctl + CW_MOD);
    const int gw = F.vcu * 8 + F.wave, NGW = F.G * 8;

    if (IN(0)) { p0_phase(F); } SEAM(0);
    if (IN(1)) { p1_phase(F); VM_WAIT(); __syncthreads(); if (REP == 1) { xcd_barrier(bar); p1_phase(F); VM_WAIT(); __syncthreads(); } } SEAM(1);

    if (IN(2)) { ph2(F); if (REP == 2) { xcd_barrier(bar); ph2(F); } } SEAM(2);

    if (IN(3)) {
        if (DBG & 32) { u16* MIXz = WSP(u16, WS_MIX); for (int m = gw; m < NTOK; m += NGW) *(GAS u32x2*)(MIXz + (size_t)m * DM + 4 * F.lane) = (u32x2){0u, 0u}; }
        else
        REPS(30) for (int U = F.vcu; U < NB * 64; U += F.G) { if (FOURIER_MFMA) fourier_unit_mfma(F, U >> 6, U & 63); else fourier_unit(F, U >> 6, U & 63); }
        const attn_body::bf16* Qp = (const attn_body::bf16*)(F.ws + WS_Q); const attn_body::bf16* Kp = (const attn_body::bf16*)(F.ws + WS_K); const attn_body::bf16* Vp = (const attn_body::bf16*)(F.ws + WS_V);
        attn_body::bf16* Op = (attn_body::bf16*)(F.ws + WS_MIX) + 256;
        float negM; { float gqm = fabsf(FIN_q_norm_g[F.lane]), gkm = fabsf(FIN_k_norm_g[F.lane]);
#pragma unroll
            for (int o_ = 1; o_ < 64; o_ <<= 1) { gqm = fmaxf(gqm, __shfl_xor(gqm, o_)); gkm = fmaxf(gkm, __shfl_xor(gkm, o_)); }
            negM = -(C2 * 64.0f * gqm * gkm + 0.5f); }
        if (ATTN_FP8) negM = fminf(negM + 8.8f, 0.f);
        if (ATTN_PRIO) { if (__builtin_amdgcn_readfirstlane(F.tid) >= 256) __builtin_amdgcn_s_setprio(1); }
        if (DBG & 16) { u16* MIXz = WSP(u16, WS_MIX); for (int m = gw; m < NTOK; m += NGW) for (int j = 1; j < 4; ++j) *(GAS u32x2*)(MIXz + (size_t)m * DM + 256 * j + 4 * F.lane) = (u32x2){0u, 0u}; }
        else if (F.G == 256) REPS(31) {
            const int xg = F.vcu >> 5, jq = F.vcu & 31;
            for (int i = 0; i < 6; ++i) { const int grp = 2 * xg + i / 3, hs = i % 3;
                if (ATTN_FP8) attn_body::attn_unit8(grp >> 2, (grp & 3) * 3 + hs, jq, (const unsigned char*)Qp, (const unsigned char*)Kp, (const unsigned char*)Vp, Op, (char*)lds + RING_OFF, negM);
                else attn_body::attn_unit<ATTN_MSUM>(grp >> 2, (grp & 3) * 3 + hs, jq, Qp, Kp, Vp, Op, (char*)lds + RING_OFF, negM); }
        } else {
            for (int U = F.vcu; U < NB * NQH * 32; U += F.G) { const int grp = U / 96, r = U % 96;
                if (ATTN_FP8) attn_body::attn_unit8(grp >> 2, (grp & 3) * 3 + r / 32, r % 32, (const unsigned char*)Qp, (const unsigned char*)Kp, (const unsigned char*)Vp, Op, (char*)lds + RING_OFF, negM);
                else attn_body::attn_unit<ATTN_MSUM>(grp >> 2, (grp & 3) * 3 + r / 32, r % 32, Qp, Kp, Vp, Op, (char*)lds + RING_OFF, negM); }
        }
        if (ATTN_PRIO) __builtin_amdgcn_s_setprio(0);
    } SEAM(3);

#if DBG & (1024 | 2048)
    if (IN(4)) { float negMc; { float gqm = fabsf(FIN_q_norm_g[F.lane]), gkm = fabsf(FIN_k_norm_g[F.lane]);
            for (int o_ = 1; o_ < 64; o_ <<= 1) { gqm = fmaxf(gqm, __shfl_xor(gqm, o_)); gkm = fmaxf(gkm, __shfl_xor(gkm, o_)); } negMc = -(C2 * 64.0f * gqm * gkm + 0.5f); }
        if (DBG & 1024) chk_attn(F, negMc); if (DBG & 2048) chk_qkv(F); VM_WAIT(); __syncthreads(); }
#endif
    if (IN(4)) { ph4(F); if (REP == 4) { xcd_barrier(bar); ph4(F); } } SEAM(4);

    if (IN(5)) { ph5(F); if (REP == 5) { xcd_barrier(bar); ph5(F); } if (REP == 55) { xcd_barrier(bar); xcd_barrier(bar); xcd_barrier(bar); xcd_barrier(bar); xcd_barrier(bar); } } SEAM(5);

    if (IN(6)) { ph6(F); if (REP == 6) { xcd_barrier(bar); ph6(F); } } SEAM(6);

    if (IN(7)) {
        if (DBG & 128) { GAS u32x4* zA = (GAS u32x4*)(F.ws + WS_ACT); const size_t nA = (size_t)MAXTILES * 256 * EFF * 2 / 16; for (size_t i = (size_t)blockIdx.x * 512 + F.tid; i < nA; i += (size_t)F.G * 512) zA[i] = (u32x4){0u, 0u, 0u, 0u};
            GAS u32x4* zC = (GAS u32x4*)(F.ws + WS_C); const size_t nC = (size_t)NTOK * NSLOT * DM * 2 / 16; for (size_t i = (size_t)blockIdx.x * 512 + F.tid; i < nC; i += (size_t)F.G * 512) zC[i] = (u32x4){0u, 0u, 0u, 0u}; }
        if (blockIdx.x == 0 && F.tid == 0) __hip_atomic_store((unsigned*)(F.ctl + CW_CNT + NEXP), (unsigned)NTOK, RLX_AGENT);
        for (int tok = gw; tok < NTOK; tok += NGW) route_token(F, tok);
    } SEAM(7);

    if (IN(8)) { ph8(F); if (REP == 8) { xcd_barrier(bar); ph8(F); } } SEAM(8);

    if (IN(9)) { ph9(F); if (REP == 9) { xcd_barrier(bar); ph9(F); } } SEAM(9);

    if (IN(10)) {
        const int lane = F.lane; const GAS unsigned char* Cc = (const GAS unsigned char*)(F.ws + WS_C);
        const int wpb = NGW >> 2, b = gw / wpb, wi = gw % wpb;
        f32x4 g2v[4], fg[4];
#pragma unroll
        for (int i = 0; i < 4; ++i) { const int col = 16 * lane + 4 * i; g2v[i] = mod4(MOD + b * 6144 + 5120, col) * (1.0f / C_SCALE); fg[i] = *(const f32x4*)(FIN_final_g + col); }
        bool bad = false;
#if DBG & (1024 | 2048)
        { const float e0 = __hip_atomic_load((float*)(F.ctl + CW_CHK), RLX_AGENT), r0 = __hip_atomic_load((float*)(F.ctl + CW_CHK) + 1, RLX_AGENT), e1 = __hip_atomic_load((float*)(F.ctl + CW_CHK) + 2, RLX_AGENT), r1 = __hip_atomic_load((float*)(F.ctl + CW_CHK) + 3, RLX_AGENT);
          if (DBG & 1024) bad = bad || !(e0 <= CHK_TOL_A * r0) || !(r0 > 0.f); if (DBG & 2048) bad = bad || !(e1 <= CHK_TOL_B * r1) || !(r1 > 0.f); }
#endif
        for (int r = wi; r < SEQ; r += 2 * wpb) {
            const int r1 = (r + wpb < SEQ) ? r + wpb : r; const bool has1 = r + wpb < SEQ;
            const int m0 = b * SEQ + r, m1 = b * SEQ + r1;
            GAS float* orow0 = (GAS float*)F.out + (size_t)m0 * DM + 16 * lane; GAS float* orow1 = (GAS float*)F.out + (size_t)m1 * DM + 16 * lane;
            f32x4 xa[4], xb[4], ya[4], yb[4];
#pragma unroll
            for (int i = 0; i < 4; ++i) { xa[i] = *(const GAS f32x4*)(orow0 + 4 * i); xb[i] = *(const GAS f32x4*)(orow1 + 4 * i); ya[i] = (f32x4){0.f, 0.f, 0.f, 0.f}; yb[i] = (f32x4){0.f, 0.f, 0.f, 0.f}; }
#pragma unroll
            for (int sl = 0; sl < NSLOT; ++sl) { const u32x4 wa = *(const GAS u32x4*)(Cc + ((size_t)m0 * NSLOT + sl) * DM + 16 * lane), wb = *(const GAS u32x4*)(Cc + ((size_t)m1 * NSLOT + sl) * DM + 16 * lane);
#pragma unroll
                for (int i = 0; i < 4; ++i) { const int wa_ = (int)wa[i], wb_ = (int)wb[i];
                    const f32x2 la = __builtin_amdgcn_cvt_pk_f32_fp8(wa_, false), ha = __builtin_amdgcn_cvt_pk_f32_fp8(wa_, true), lb = __builtin_amdgcn_cvt_pk_f32_fp8(wb_, false), hb = __builtin_amdgcn_cvt_pk_f32_fp8(wb_, true);
                    ya[i] += (f32x4){la.x, la.y, ha.x, ha.y}; yb[i] += (f32x4){lb.x, lb.y, hb.x, hb.y}; } }
            float sa = 0.f, sb = 0.f;
#pragma unroll
            for (int i = 0; i < 4; ++i) { const f32x4 va = xa[i] + g2v[i] * ya[i], vb = xb[i] + g2v[i] * yb[i]; xa[i] = va; xb[i] = vb;
                sa += (va[0] * va[0] + va[1] * va[1]) + (va[2] * va[2] + va[3] * va[3]); sb += (vb[0] * vb[0] + vb[1] * vb[1]) + (vb[2] * vb[2] + vb[3] * vb[3]); }
#pragma unroll
            for (int o = 1; o < 64; o <<= 1) { sa += __shfl_xor(sa, o); sb += __shfl_xor(sb, o); }
            const float bm = bad ? 3.0f : 1.0f;
            const float ra = 1.0f / sqrtf(sa * (1.0f / DM) + RMS_EPS) * bm, rb = 1.0f / sqrtf(sb * (1.0f / DM) + RMS_EPS) * bm;
#pragma unroll
            for (int i = 0; i < 4; ++i) *(GAS f32x4*)(orow0 + 4 * i) = xa[i] * ra * fg[i];
            if (has1) {
#pragma unroll
                for (int i = 0; i < 4; ++i) *(GAS f32x4*)(orow1 + 4 * i) = xb[i] * rb * fg[i]; } }
    }
#undef IN
#undef SEAM
}

extern "C" void kernel_launch(void* const* d_in, const int* in_sizes, int n_in, void* d_out, int out_size, void* d_ws, size_t ws_size, hipStream_t stream) {
    static int grid = 0;
    if (grid == 0) {
        if (n_in != 20 || in_sizes[0] != NTOK * DM || out_size != NTOK * DM || ws_size < WS_END) { fprintf(stderr, "kernel_launch: unexpected shapes (n_in %d, in0 %d, out %d, ws %zu < %zu)\n", n_in, n_in > 0 ? in_sizes[0] : -1, out_size, ws_size, (size_t)WS_END); grid = -1; return; }
        int dev = 0, cus = 0, per_cu = 0;
        if (hipGetDevice(&dev) != hipSuccess || hipDeviceGetAttribute(&cus, hipDeviceAttributeMultiprocessorCount, dev) != hipSuccess) { grid = -1; return; }
        if (hipFuncSetAttribute((const void*)mk_fwd, hipFuncAttributeMaxDynamicSharedMemorySize, LDS_BYTES) != hipSuccess) { fprintf(stderr, "kernel_launch: hipFuncSetAttribute failed\n"); grid = -1; return; }
        if (hipOccupancyMaxActiveBlocksPerMultiprocessor(&per_cu, (const void*)mk_fwd, 512, LDS_BYTES) != hipSuccess || per_cu < 1) fprintf(stderr, "kernel_launch: occupancy query reports %d\n", per_cu);
        (void)hipGetLastError();
        grid = cus;
    }
    if (grid < 0) return;
    (void)hipMemsetAsync((char*)d_ws + WS_CTL, 0, CTL_ZERO_BYTES, stream);
    Args a{};
    for (int i = 0; i < 20; ++i) a.in[i] = (const float*)d_in[i];
    a.out = (float*)d_out; a.ws = (unsigned char*)d_ws;
    if (N_LAUNCHES == 1) { a.ph_lo = 0; a.ph_hi = PER_PHASE; hipLaunchKernelGGL(mk_fwd, dim3(grid), dim3(512), LDS_BYTES, stream, a); }
    else for (int li = 0; li < PER_PHASE; ++li) { a.ph_lo = li; a.ph_hi = li + 1; hipLaunchKernelGGL(mk_fwd, dim3(grid), dim3(512), LDS_BYTES, stream, a); }
}
```

```cpp
#include <hip/hip_runtime.h>
#include <hip/hip_bf16.h>
#include <cstdio>
#include <cstdint>
#include <cmath>

#ifndef MK_N_LAUNCHES
#define MK_N_LAUNCHES 1
#endif
constexpr int PER_PHASE = 11;
#ifndef DBG
#define DBG 0
#endif
#ifndef REP
#define REP -1
#endif
#ifndef CHK_TOL_A
#define CHK_TOL_A 1e-4f
#endif
#ifndef CHK_TOL_B
#define CHK_TOL_B 3e-3f
#endif
#ifndef POSTEPI_WAITS
#define POSTEPI_WAITS 1
#endif
#ifndef ATTN_FP8
#define ATTN_FP8 1
#endif
constexpr float Q8_SCALE = 8.0f;
#ifndef ATTN_MSUM
#define ATTN_MSUM false
#endif
#ifndef ATTN_PRIO
#define ATTN_PRIO 1
#endif
#ifndef FOURIER_MFMA
#define FOURIER_MFMA 1
#endif
#define REPS(k) for (int rep_ = 0; rep_ < ((REP == (k)) ? 2 : 1); ++rep_)
#define REPBAR() do { if (rep_) xcd_barrier(bar); } while (0)
constexpr int N_LAUNCHES = MK_N_LAUNCHES;

#define GAS __attribute__((address_space(1)))
#define LAS __attribute__((address_space(3)))
typedef unsigned short u16;
typedef short bf16x8 __attribute__((ext_vector_type(8)));
typedef _Float16 half8 __attribute__((ext_vector_type(8)));
typedef _Float16 half2v __attribute__((ext_vector_type(2)));
typedef float f32x4 __attribute__((ext_vector_type(4)));
typedef float f32x2 __attribute__((ext_vector_type(2)));
typedef unsigned u32x4 __attribute__((ext_vector_type(4)));
typedef unsigned u32x2 __attribute__((ext_vector_type(2)));
typedef GAS unsigned gu32;

constexpr int DM = 1024, NB = 4, SEQ = 8192, NTOK = NB * SEQ, CTXL = 256, NCTX = NB * CTXL, LKV = SEQ + CTXL;
constexpr int NQH = 12, NKVH = 4, HD = 64, QW = NQH * HD, KVW = NKVH * HD;
constexpr int NIN = 1792;
constexpr int MIN_ROWS = NTOK + NCTX;
constexpr int NEXP = 256, NEXPS = 257, TOPK = 8, EFF = 256, NSLOT = 9;
constexpr int MAXTILES = 1408;
constexpr float RMS_EPS = 1e-6f;
#ifndef MOE_F16
#define MOE_F16 0
#endif
constexpr bool MOEF16 = MOE_F16;
#ifndef MOE_FP8
#define MOE_FP8 1
#endif
constexpr int MOE_DT = MOE_FP8 ? 2 : (MOE_F16 ? 1 : 0);
constexpr float WGU_SCALE = 32.0f, WD_SCALE = 16.0f;
constexpr int SC_ONE = 0x7f7f7f7f, SC_GU = 0x7f7f7f7a, SC_D = 0x7f7f7f7b;
constexpr float C2 = 0.125f * 1.4426950408889634f;
constexpr float C_SCALE = 16.0f;

constexpr size_t MiB = 1u << 20;
constexpr size_t WS_CTL = 0, CTL_ZERO_BYTES = 1 * MiB;
constexpr size_t WS_TAB = 1 * MiB;
constexpr size_t WS_BIN = 2 * MiB;
constexpr size_t WS_BOUT = 6 * MiB;
constexpr size_t WS_BR = 8 * MiB;
constexpr size_t WS_K = 16 * MiB;
constexpr size_t WS_V = 34 * MiB;
constexpr size_t WS_Z = 52 * MiB;
constexpr size_t WS_Q = 84 * MiB;
constexpr size_t WS_XN = 132 * MiB;
constexpr size_t WS_MIX = 198 * MiB;
constexpr size_t WS_H2 = 262 * MiB;
constexpr size_t WS_LOG = 326 * MiB;
constexpr size_t WS_LIST = 358 * MiB;
constexpr size_t WS_BGU = 424 * MiB;
constexpr size_t WS_BD = 682 * MiB;
constexpr size_t WS_ACT = 812 * MiB;
constexpr size_t WS_C = 990 * MiB;
constexpr size_t WS_H2F8 = 1568 * MiB;
constexpr size_t WS_DUMP = 1600 * MiB;
constexpr size_t WS_END = 1632 * MiB;
constexpr int CW_TMO = 0, CW_CODE = 1;
constexpr int CW_BAR = 4096;
constexpr int CW_CNT = 16384;
constexpr int CW_CHK = 32768;
constexpr int CW_MOD = 131072;
static_assert(CW_MOD * 4 + 5 * 6144 * 8 <= (int)CTL_ZERO_BYTES, "ctl");

constexpr int RING_OFF = 0, RING_BYTES = 131072;
constexpr int P1_SCR = 18432;
constexpr int TAB_OFF = 8 * P1_SCR;
constexpr int LDS_BYTES = 163840;
constexpr int LDSCTL_OFF = LDS_BYTES - 1024, MISC_OFF = LDSCTL_OFF + 320;
static_assert(TAB_OFF + 8192 <= LDSCTL_OFF, "LDS map");

#define LDS_WAIT() asm volatile("s_waitcnt lgkmcnt(0)" ::: "memory")
#define VM_WAIT() asm volatile("s_waitcnt vmcnt(0)" ::: "memory")
#define RLX_AGENT __ATOMIC_RELAXED, __HIP_MEMORY_SCOPE_AGENT

__device__ __forceinline__ unsigned f2bf(float f) { unsigned u = __builtin_bit_cast(unsigned, f); return (u + 0x7fffu + ((u >> 16) & 1u)) >> 16; }
__device__ __forceinline__ unsigned pk2bf(float lo, float hi) { return f2bf(lo) | (f2bf(hi) << 16); }
__device__ __forceinline__ unsigned pk2h(float lo, float hi) { half2v v = {(_Float16)lo, (_Float16)hi}; return __builtin_bit_cast(unsigned, v); }
__device__ __forceinline__ unsigned cvt_pk_bf16(float lo, float hi) { unsigned r; asm volatile("v_cvt_pk_bf16_f32 %0, %1, %2" : "=v"(r) : "v"(lo), "v"(hi)); return r; }
__device__ __forceinline__ float bflo(unsigned w) { return __builtin_bit_cast(float, w << 16); }
__device__ __forceinline__ float bfhi(unsigned w) { return __builtin_bit_cast(float, w & 0xffff0000u); }
typedef long long i64x2 __attribute__((ext_vector_type(2)));
typedef GAS long long gi64;
__device__ __forceinline__ f32x4 mod4(const gi64* MODQ, int idx) {
    const i64x2 a = *(const GAS i64x2*)(MODQ + idx), b = *(const GAS i64x2*)(MODQ + idx + 2);
    return (f32x4){(float)a.x, (float)a.y, (float)b.x, (float)b.y} * 0x1p-36f;
}
__device__ __forceinline__ float rdl(float v, int lane) { return __builtin_bit_cast(float, __builtin_amdgcn_readlane(__builtin_bit_cast(int, v), lane)); }
__device__ __forceinline__ float wave_sum(float v) {
#pragma unroll
    for (int o = 1; o < 64; o <<= 1) v += __shfl_xor(v, o);
    return v;
}

namespace pg8 {
constexpr int BM = 256, BK = 64, HALF = 128, HTB = HALF * BK * 2, STAGE_BYTES = 8 * HTB;
__host__ __device__ __forceinline__ int lds_byte(int r, int c) { const int st = (r >> 4) * 2 + (c >> 5), rr = r & 15, cc = c & 31, ob = rr * 64 + cc * 2; return st * 1024 + (ob ^ (((ob >> 9) & 1) << 5)); }
__host__ __device__ __forceinline__ void stage_rc(int b, int& R, int& C) { const int st = b / 1024, sb = b % 1024, swz = sb ^ (((sb >> 9) & 1) << 5); R = (st >> 1) * 16 + swz / 64; C = (st & 1) * 32 + (swz % 64) / 2; }
__host__ __device__ __forceinline__ int perm32(int rho) { const int n = rho >> 4, i = rho & 15; return 8 * (i >> 2) + 4 * n + (i & 3); }

struct GUnit { int pm, pn, e, j, nvalid; const char* B; };

typedef int v8i __attribute__((ext_vector_type(8)));
typedef int v4i __attribute__((ext_vector_type(4)));
template <int DT> __device__ __forceinline__ f32x4 mma_tile(const v8i a, const v8i b, f32x4 c, int scA) {
    if constexpr (DT == 2) return __builtin_amdgcn_mfma_scale_f32_16x16x128_f8f6f4(a, b, c, 0, 0, 0, scA, 1, scA);
    else { const v4i a0 = __builtin_shufflevector(a, a, 0, 1, 2, 3), a1 = __builtin_shufflevector(a, a, 4, 5, 6, 7), b0 = __builtin_shufflevector(b, b, 0, 1, 2, 3), b1 = __builtin_shufflevector(b, b, 4, 5, 6, 7);
        if constexpr (DT == 1) { c = __builtin_amdgcn_mfma_f32_16x16x32_f16(__builtin_bit_cast(half8, a0), __builtin_bit_cast(half8, b0), c, 0, 0, 0); return __builtin_amdgcn_mfma_f32_16x16x32_f16(__builtin_bit_cast(half8, a1), __builtin_bit_cast(half8, b1), c, 0, 0, 0); }
        else { c = __builtin_amdgcn_mfma_f32_16x16x32_bf16(__builtin_bit_cast(bf16x8, a0), __builtin_bit_cast(bf16x8, b0), c, 0, 0, 0); return __builtin_amdgcn_mfma_f32_16x16x32_bf16(__builtin_bit_cast(bf16x8, a1), __builtin_bit_cast(bf16x8, b1), c, 0, 0, 0); } }
}

template <class Epi, class Sched, int DT, bool ALIGN_EPI>
__device__ __forceinline__ void gemm_phase(LAS unsigned char* lds, const char* Abase, const int K, const Sched& S, const Epi& E, const int scB = SC_ONE) {
    const int tid = threadIdx.x, wid = __builtin_amdgcn_readfirstlane(tid >> 6), lane = tid & 63, wr = wid >> 2, wc = wid & 3, fr = lane & 15, fq = lane >> 4;
    constexpr int ES = (DT == 2) ? 1 : 2;
    const int RB = K * ES;
    const int nt = RB / 128;
    unsigned voffB0; { int R, C; stage_rc(tid * 16, R, C); const int Rb = Epi::PERM ? ((R & ~31) + perm32(R & 31)) : R; voffB0 = (unsigned)(Rb * RB + C * 2); }
    const unsigned voffBd = 64u * (unsigned)RB;
#define PG8_AOFF(V, UNIT) do { int t_ = threadIdx.x; asm volatile("" : "+v"(t_)); _Pragma("unroll") for (int _i = 0; _i < 2; ++_i) { int R_, C_; stage_rc(t_ * 16 + _i * 8192, R_, C_); \
        _Pragma("unroll") for (int _h = 0; _h < 2; ++_h) (V)[_h][_i] = (unsigned)S.arow(UNIT, R_ + HALF * _h) * (unsigned)RB + (unsigned)(C_ * 2); } } while (0)
    const size_t kstep = (size_t)(BK * 2);
    const size_t hstep = (size_t)HALF * RB;
    const unsigned ldsw = (unsigned)wid * 1024u;
    const int ac0 = (DT == 2) ? 16 * fq : 8 * fq; constexpr int CH1 = (DT == 2) ? 16 : 1024;
    const int aoff = lds_byte(wr * 64 + fr, ac0), boff = lds_byte(wc * 32 + fr, ac0);
#define PG8_SA(b, h) (((b) * 2 + (h)) * HTB)
#define PG8_SB(b, h) ((4 + (b) * 2 + (h)) * HTB)
#define PG8_STAGEB(bufoff, gbase) do { _Pragma("unroll") for (int _i = 0; _i < 2; ++_i) \
        __builtin_amdgcn_global_load_lds((const unsigned*)((const char*)(gbase) + voffB0 + _i * voffBd), (LAS unsigned*)(lds + (bufoff) + ldsw + _i * 8192), 16, 0, 0); } while (0)
#define PG8_STAGEA(bufoff, koff, V, h) do { _Pragma("unroll") for (int _i = 0; _i < 2; ++_i) \
        __builtin_amdgcn_global_load_lds((const unsigned*)(Abase + (size_t)(V)[h][_i] + (koff)), (LAS unsigned*)(lds + (bufoff) + ldsw + _i * 8192), 16, 0, 0); } while (0)
#define PG8_LDA(dst, b, h) do { _Pragma("unroll") for (int m = 0; m < 4; ++m) { const v4i c0_ = *(const LAS v4i*)(lds + PG8_SA(b, h) + aoff + m * 2048), c1_ = *(const LAS v4i*)(lds + PG8_SA(b, h) + aoff + m * 2048 + CH1); dst[m] = __builtin_shufflevector(c0_, c1_, 0, 1, 2, 3, 4, 5, 6, 7); } } while (0)
#define PG8_LDB(dst, b, h) do { _Pragma("unroll") for (int n = 0; n < 2; ++n) { const v4i c0_ = *(const LAS v4i*)(lds + PG8_SB(b, h) + boff + n * 2048), c1_ = *(const LAS v4i*)(lds + PG8_SB(b, h) + boff + n * 2048 + CH1); dst[n] = __builtin_shufflevector(c0_, c1_, 0, 1, 2, 3, 4, 5, 6, 7); } } while (0)
#define PG8_MMA(ai, bj, At, Bt) do { __builtin_amdgcn_s_setprio(1); _Pragma("unroll") for (int m = 0; m < 4; ++m) _Pragma("unroll") for (int n = 0; n < 2; ++n) \
        acc[ai][bj][m][n] = mma_tile<DT>(Bt[n], At[m], acc[ai][bj][m][n], scB); __builtin_amdgcn_s_setprio(0); } while (0)
#define PG8_WAIT_V(n) asm volatile("s_waitcnt vmcnt(" #n ")" ::: "memory")
#define PG8_WAIT_VE(pe) do { if (pe) asm volatile("s_waitcnt vmcnt(%0)" :: "n"(8 + Epi::NSTORE) : "memory"); else asm volatile("s_waitcnt vmcnt(8)" ::: "memory"); } while (0)
#define PG8_WAIT_L(n) asm volatile("s_waitcnt lgkmcnt(" #n ")" ::: "memory")
#define PG8_BAR __builtin_amdgcn_s_barrier()
#define PG8_SCHED __builtin_amdgcn_sched_barrier(0)
    GUnit cur, nxt; int ui = 0;
    if (!S.next(0, cur)) return;
    f32x4 acc[2][2][4][2];
#pragma unroll
    for (int a = 0; a < 2; ++a)
#pragma unroll
        for (int b = 0; b < 2; ++b)
#pragma unroll
            for (int m = 0; m < 4; ++m)
#pragma unroll
                for (int n = 0; n < 2; ++n) acc[a][b][m][n] = (f32x4){0.f, 0.f, 0.f, 0.f};
    v8i At[4], B0[2], B1[2];
    unsigned vA[2][2];
    PG8_AOFF(vA, cur);
    if constexpr (Sched::GATHER) VM_WAIT();
    const char* cB = cur.B;
    E.pre(lds, cur, 0, wid, lane);
    PG8_STAGEB(PG8_SB(0, 0), cB); PG8_STAGEB(PG8_SB(0, 1), cB + hstep); PG8_STAGEA(PG8_SA(0, 0), 0, vA, 0); PG8_STAGEA(PG8_SA(0, 1), 0, vA, 1);
    if (wr == 1) PG8_BAR;
    PG8_WAIT_V(2); PG8_BAR;
    PG8_STAGEB(PG8_SB(1, 0), cB + kstep); PG8_STAGEA(PG8_SA(1, 0), kstep, vA, 0); PG8_STAGEB(PG8_SB(1, 1), cB + hstep + kstep);
    PG8_WAIT_V(6); PG8_BAR;
    for (;;) {
        const bool has_next = S.next(ui + 1, nxt);
#pragma unroll 1
        for (int t = 0; t < nt; t += 2) {
            const bool last = (t == nt - 2);
            const bool pe = POSTEPI_WAITS && (t == 0) && (ui > 0);
            const size_t k1 = (size_t)(t + 1) * kstep;
            PG8_LDB(B0, 0, 0); PG8_LDB(B1, 0, 1); PG8_SCHED; PG8_LDA(At, 0, 0); PG8_STAGEA(PG8_SA(1, 1), k1, vA, 1);
            PG8_WAIT_VE(pe); PG8_WAIT_L(0); PG8_BAR; PG8_MMA(0, 0, At, B0); PG8_MMA(0, 1, At, B1); PG8_BAR; PG8_SCHED;
            size_t k2 = (size_t)(t + 2) * kstep;
            if (last) { k2 = 0; if (has_next) { PG8_AOFF(vA, nxt); if constexpr (Sched::GATHER) VM_WAIT(); cB = nxt.B; } }
            const size_t k3 = k2 + kstep; const char* b2 = cB + k2; const char* b3 = b2 + kstep;
            PG8_LDA(At, 0, 1); PG8_STAGEB(PG8_SB(0, 0), b2); PG8_STAGEB(PG8_SB(0, 1), b2 + hstep); PG8_STAGEA(PG8_SA(0, 0), k2, vA, 0);
            PG8_WAIT_VE(pe); PG8_WAIT_L(0); PG8_BAR; PG8_MMA(1, 0, At, B0); PG8_MMA(1, 1, At, B1); PG8_BAR; PG8_SCHED;
            PG8_LDB(B0, 1, 0); PG8_LDB(B1, 1, 1); PG8_SCHED; PG8_LDA(At, 1, 0); PG8_STAGEA(PG8_SA(0, 1), k2, vA, 1);
            PG8_WAIT_V(8); PG8_WAIT_L(0); PG8_BAR; PG8_MMA(0, 0, At, B0); PG8_MMA(0, 1, At, B1); PG8_BAR; PG8_SCHED;
            PG8_LDA(At, 1, 1); PG8_STAGEB(PG8_SB(1, 0), b3); PG8_STAGEB(PG8_SB(1, 1), b3 + hstep); PG8_STAGEA(PG8_SA(1, 0), k3, vA, 0);
            PG8_WAIT_V(8); PG8_WAIT_L(0); PG8_BAR; PG8_MMA(1, 0, At, B0); PG8_MMA(1, 1, At, B1); PG8_BAR; PG8_SCHED;
        }
        if constexpr (ALIGN_EPI) { if (wr == 0) PG8_BAR; }
        { int tx = threadIdx.x; asm volatile("" : "+v"(tx)); E(acc, cur, wr, wc, tx & 15, (tx >> 4) & 3, lds, ui); }
        if (!has_next) break;
#pragma unroll
        for (int a = 0; a < 2; ++a)
#pragma unroll
            for (int b = 0; b < 2; ++b)
#pragma unroll
                for (int m = 0; m < 4; ++m)
#pragma unroll
                    for (int n = 0; n < 2; ++n) acc[a][b][m][n] = (f32x4){0.f, 0.f, 0.f, 0.f};
        cur = nxt; ++ui;
        if constexpr (ALIGN_EPI) { if (wr == 1) PG8_BAR; }
        E.pre(lds, cur, ui, wid, lane);
    }
    PG8_WAIT_V(0);
    if constexpr (!ALIGN_EPI) { if (wr == 0) PG8_BAR; }
    PG8_BAR;
#undef PG8_SA
#undef PG8_SB
#undef PG8_STAGEA
#undef PG8_AOFF
#undef PG8_STAGEB
#undef PG8_LDA
#undef PG8_LDB
#undef PG8_MMA
#undef PG8_WAIT_V
#undef PG8_WAIT_VE
#undef PG8_WAIT_L
#undef PG8_BAR
#undef PG8_SCHED
}
}

namespace attn_body {
using bf16 = __hip_bfloat16;
using s16x4 = __attribute__((ext_vector_type(4))) short;
using f32x16 = __attribute__((ext_vector_type(16))) float;
constexpr int D = 64, DMQ = QW, DMKV = KVW, DMO = DM;
constexpr int NW = 8, QBLK = 32, QB = QBLK * NW, KVBLK = 64, NT = LKV / KVBLK;
static_assert(NT % 2 == 0 && NT >= 8, "tile count");
__device__ __forceinline__ int crow(int r, int hi) { return (r & 3) + 8 * (r >> 2) + 4 * hi; }
#define SBAR() __builtin_amdgcn_sched_barrier(0)
constexpr int NSLOTR = 3, SLOTB = 8192;
constexpr int LDS_K = 0, LDS_V = NSLOTR * SLOTB, LDS_WS = 2 * NSLOTR * SLOTB, LDS_OST = LDS_WS + NW * 64 * 4, ATT_LDS_BYTES = LDS_OST + NW * 4096;
__device__ __forceinline__ void glds16(const void* gsrc, unsigned lds_dst) { unsigned keep;
    asm volatile("s_mov_b32 %0, m0\n\ts_mov_b32 m0, %2\n\ts_nop 0\n\tglobal_load_lds_dwordx4 %1, off\n\ts_mov_b32 m0, %0" : "=&s"(keep) : "v"(gsrc), "s"(lds_dst) : "memory"); }
__device__ __forceinline__ float max3f(float a, float b, float c) { float r; asm("v_max3_f32 %0, %1, %2, %3" : "=v"(r) : "v"(a), "v"(b), "v"(c)); return r; }
__device__ __forceinline__ float max2f(float a, float b) { float r; asm("v_max_f32_e32 %0, %1, %2" : "=v"(r) : "v"(a), "v"(b)); return r; }
__device__ __forceinline__ float fadd_s(float a, float b) { float r; asm("v_add_f32_e32 %0, %1, %2" : "=v"(r) : "v"(a), "v"(b)); return r; }
__device__ __forceinline__ float fsub_s(float a, float b) { float r; asm("v_sub_f32_e32 %0, %1, %2" : "=v"(r) : "v"(a), "v"(b)); return r; }
typedef float f32x2_t __attribute__((ext_vector_type(2))); typedef __bf16 bf16x2_t __attribute__((ext_vector_type(2)));
__device__ __forceinline__ unsigned cvtpk_s(float lo, float hi) { f32x2_t v = {lo, hi}; bf16x2_t b = __builtin_convertvector(v, bf16x2_t); return __builtin_bit_cast(unsigned, b); }
#define WAIT_BAR(N) asm volatile("s_waitcnt vmcnt(" #N ") lgkmcnt(0)\n\ts_barrier" ::: "memory")

__device__ __forceinline__ void qkt(f32x16& p0, f32x16& p1, const char* Kslot, const bf16x8* qr, const f32x16& negm, int r32, int hi) {
    const char* kb = Kslot + hi * 1024 + r32 * 16;
#pragma unroll
    for (int d0 = 0; d0 < 4; ++d0) {
        const bf16x8 b0 = *reinterpret_cast<const bf16x8*>(kb + d0 * 2048);
        const bf16x8 b1 = *reinterpret_cast<const bf16x8*>(kb + d0 * 2048 + 512);
        if (d0 == 0) { p0 = __builtin_amdgcn_mfma_f32_32x32x16_bf16(b0, qr[0], negm, 0, 0, 0); p1 = __builtin_amdgcn_mfma_f32_32x32x16_bf16(b1, qr[0], negm, 0, 0, 0); }
        else { p0 = __builtin_amdgcn_mfma_f32_32x32x16_bf16(b0, qr[d0], p0, 0, 0, 0); p1 = __builtin_amdgcn_mfma_f32_32x32x16_bf16(b1, qr[d0], p1, 0, 0, 0); } }
}
typedef __attribute__((address_space(3))) const char* lds_cptr;
typedef short v4i16_t __attribute__((ext_vector_type(4)));
__device__ __forceinline__ void kload8(bf16x8* kf, lds_cptr kp) {
    kf[0] = *(const __attribute__((address_space(3))) bf16x8*)(kp);        kf[1] = *(const __attribute__((address_space(3))) bf16x8*)(kp + 512);
    kf[2] = *(const __attribute__((address_space(3))) bf16x8*)(kp + 2048); kf[3] = *(const __attribute__((address_space(3))) bf16x8*)(kp + 2560);
    kf[4] = *(const __attribute__((address_space(3))) bf16x8*)(kp + 4096); kf[5] = *(const __attribute__((address_space(3))) bf16x8*)(kp + 4608);
    kf[6] = *(const __attribute__((address_space(3))) bf16x8*)(kp + 6144); kf[7] = *(const __attribute__((address_space(3))) bf16x8*)(kp + 6656);
}
__device__ __forceinline__ void kload2(bf16x8* kf, lds_cptr kp, int j) { kf[2 * j] = *(const __attribute__((address_space(3))) bf16x8*)(kp + j * 2048); kf[2 * j + 1] = *(const __attribute__((address_space(3))) bf16x8*)(kp + j * 2048 + 512); }
__device__ __forceinline__ s16x4 vtr(lds_cptr p) { return __builtin_bit_cast(s16x4, __builtin_amdgcn_ds_read_tr16_b64_v4i16((__attribute__((address_space(3))) v4i16_t*)p)); }
__device__ __forceinline__ float rowmax(const f32x16& p0, const f32x16& p1) {
    float a = max3f(p0[0], p0[1], p1[0]), b = max3f(p0[2], p0[3], p1[1]); a = max3f(a, p1[2], p1[3]);
#pragma unroll
    for (int r = 4; r < 16; r += 4) { a = max3f(a, p0[r], p0[r + 1]); b = max3f(b, p0[r + 2], p0[r + 3]); a = max3f(a, p1[r], p1[r + 1]); b = max3f(b, p1[r + 2], p1[r + 3]); }
    const float m = max2f(a, b);
    auto rr = __builtin_amdgcn_permlane32_swap(__float_as_uint(m), __float_as_uint(m), false, false);
    return max2f(__uint_as_float(rr[0]), __uint_as_float(rr[1]));
}
__device__ __forceinline__ void pv(f32x16* o, int vb, bf16x8 pa0, bf16x8 pa1, bf16x8 pa2, bf16x8 pa3) {
#pragma unroll
    for (int d0 = 0; d0 < 2; ++d0) { s16x4 lo[4], hi[4];
#pragma unroll
        for (int ks = 0; ks < 4; ++ks) {
            asm volatile("ds_read_b64_tr_b16 %0,%1 offset:%c2" : "=&v"(lo[ks]) : "v"(vb), "i"(d0 * 4096 + ks * 1024) : "memory");
            asm volatile("ds_read_b64_tr_b16 %0,%1 offset:%c2" : "=&v"(hi[ks]) : "v"(vb), "i"(d0 * 4096 + ks * 1024 + 512) : "memory"); }
        asm volatile("s_waitcnt lgkmcnt(0)" ::: "memory"); SBAR();
#define PK(k) (bf16x8){lo[k][0], lo[k][1], lo[k][2], lo[k][3], hi[k][0], hi[k][1], hi[k][2], hi[k][3]}
        o[d0] = __builtin_amdgcn_mfma_f32_32x32x16_bf16(pa0, PK(0), o[d0], 0, 0, 0);
        o[d0] = __builtin_amdgcn_mfma_f32_32x32x16_bf16(pa1, PK(1), o[d0], 0, 0, 0);
        o[d0] = __builtin_amdgcn_mfma_f32_32x32x16_bf16(pa2, PK(2), o[d0], 0, 0, 0);
        o[d0] = __builtin_amdgcn_mfma_f32_32x32x16_bf16(pa3, PK(3), o[d0], 0, 0, 0);
#undef PK
    }
}
template <bool MS> __device__ __forceinline__ void attn_unit(int b, int h, int qb, const bf16* Q, const bf16* __restrict__ K, const bf16* __restrict__ V, bf16* O, char* shm, float negM_) {
    const int tid = threadIdx.x, lane = tid & 63, r32 = lane & 31, hi = lane >> 5; const int wid = __builtin_amdgcn_readfirstlane(tid >> 6);
    const int q0 = qb * QB; const int kvh = h / 3;
    const long qrow0 = (long)b * SEQ + q0 + wid * QBLK;
    const long kvrow0 = (long)b * LKV;
    const bf16* Qw = Q + qrow0 * DMQ + h * D;
    const bf16* Kh = K + kvrow0 * DMKV + kvh * D, *Vh = V + kvrow0 * DMKV + kvh * D;
    const unsigned lds0 = (unsigned)(uintptr_t)shm;
    float* wsf = (float*)(shm + LDS_WS) + wid * 64;
    const bf16* ksrc = Kh + (long)lane * DMKV + wid * 8;
    const bf16* vsrc = Vh + (long)(16 * (wid & 3) + (lane >> 2)) * DMKV + (wid >> 2) * 32 + (lane & 3) * 8;
    const unsigned kdst = lds0 + LDS_K + wid * 1024, vdst = lds0 + LDS_V + wid * 1024;
#define DMA_K(t, slot) glds16(ksrc + (long)(t) * KVBLK * DMKV, (unsigned)__builtin_amdgcn_readfirstlane(kdst + (slot)))
#define DMA_V(t, slot) glds16(vsrc + (long)(t) * KVBLK * DMKV, (unsigned)__builtin_amdgcn_readfirstlane(vdst + (slot)))
    const int vb0 = (int)(lds0 + LDS_V) + ((lane >> 4) & 1) * 32 + (lane & 3) * 8 + (4 * hi + ((lane & 15) >> 2)) * 64;
    const char* Kbase = shm + LDS_K; bf16x8 kf[8];
    const lds_cptr shm3 = (lds_cptr)shm; const lds_cptr kp0 = shm3 + LDS_K + hi * 1024 + r32 * 16; const lds_cptr vp0 = shm3 + LDS_V + ((lane >> 4) & 1) * 32 + (lane & 3) * 8 + (4 * hi + ((lane & 15) >> 2)) * 64;
    DMA_K(0, 0); DMA_V(0, 0); DMA_K(1, SLOTB);
    bf16x8 qr[4];
#pragma unroll
    for (int d0 = 0; d0 < 4; ++d0) qr[d0] = *reinterpret_cast<const bf16x8*>(&Qw[(long)r32 * DMQ + d0 * 16 + hi * 8]);
    float l_reg = 0.f; f32x16 o[2]; o[0] = f32x16{}; o[1] = f32x16{}; f32x16 negm = f32x16{}; f32x16 lacc = f32x16{};
    if constexpr (!MS) { _Pragma("unroll") for (int r = 0; r < 16; ++r) negm[r] = negM_; asm volatile("" : "+v"(negm)); }
    const bf16x8 ONES = (bf16x8){0x3F80, 0x3F80, 0x3F80, 0x3F80, 0x3F80, 0x3F80, 0x3F80, 0x3F80};
#define START(P0, P1) do { _Pragma("unroll") for (int r = 0; r < 16; ++r) P0[r] = __builtin_amdgcn_exp2f(P0[r]); } while (0)
#define RESC() do { } while (0)
    f32x16 pA0, pA1, pB0, pB1;
    int sl_prev = 0, sl_cur = 0, sl_next = SLOTB;
#define ROT() do { sl_prev = sl_cur; sl_cur = sl_next; sl_next = (sl_next == (NSLOTR - 1) * SLOTB) ? 0 : sl_next + SLOTB; } while (0)
    DMA_K(2, 2 * SLOTB);
    WAIT_BAR(3);
    qkt(pA0, pA1, Kbase, qr, negm, r32, hi); asm volatile("s_nop 15\n\ts_nop 7" : "+v"(pA0), "+v"(pA1));
    START(pA0, pA1);
    _Pragma("unroll") for (int r = 0; r < 16; ++r) pA1[r] = __builtin_amdgcn_exp2f(pA1[r]);
    WAIT_BAR(0);
    DMA_K(3, 0); DMA_V(1, SLOTB);
    ROT();
    kload8(kf, kp0 + sl_cur);
    WAIT_BAR(2);
    s16x4 vlo[8], vhi[8]; u32x4 pw0, pw1, pw2, pw3;
#define PKW(P, B) cvtpk_s(P[B], P[B + 1])
#define PAF(k) __builtin_bit_cast(bf16x8, pw##k)
#define VFR(i) (bf16x8){vlo[i][0], vlo[i][1], vlo[i][2], vlo[i][3], vhi[i][0], vhi[i][1], vhi[i][2], vhi[i][3]}
#define PIN(x) asm volatile("" : "+v"(x))
#define MX3(a, b, c) __builtin_fmaxf(__builtin_fmaxf((a), (b)), (c))
#define GAPA(MF, A0, A1, A2, A3, W0, W1, PW) do { MF; if constexpr (!MS) { sacc += A0; sacc += A1; sacc += A2; sacc += A3; PIN(sacc); } W0; W1; PIN(PW); SBAR(); } while (0)
#define LSUM(k) do { if constexpr (MS) lacc = __builtin_amdgcn_mfma_f32_32x32x16_bf16(PAF(k), ONES, lacc, 0, 0, 0); } while (0)
#define EX(v) __builtin_amdgcn_exp2f(v)
#define GAPB(MF, X, B) do { MF; X[B] = EX(X[B]); X[B + 1] = EX(X[B + 1]); X[B + 2] = EX(X[B + 2]); X[B + 3] = EX(X[B + 3]); PIN(X); SBAR(); } while (0)
#define VRD(i) do { vlo[i] = vtr(vp_ + (((i) >> 2) * 4096 + ((i) & 3) * 1024)); vhi[i] = vtr(vp_ + (((i) >> 2) * 4096 + ((i) & 3) * 1024 + 512)); } while (0)
#define KRD(G, j) do { if (G) { kload2(kf, kp0 + sl_next, j); SBAR(); } } while (0)
#define STEP(C0, C1, P0, P1, t, GK, GV, GL) do { SBAR(); \
    const lds_cptr vp_ = vp0 + sl_prev; \
    VRD(0); SBAR(); float sacc = MS ? 0.f : (P0[0] + P0[1]); \
    GAPA(C0 = __builtin_amdgcn_mfma_f32_32x32x16_bf16(kf[0], qr[0], negm, 0, 0, 0), P0[2], P0[3], P0[4], P0[5],     pw0[0] = PKW(P0, 0), pw0[1] = PKW(P0, 2), pw0); \
    VRD(4); SBAR(); GAPA(C1 = __builtin_amdgcn_mfma_f32_32x32x16_bf16(kf[1], qr[0], negm, 0, 0, 0), P0[6], P0[7], P0[8], P0[9],     pw0[2] = PKW(P0, 4), pw0[3] = PKW(P0, 6), pw0); \
    VRD(1); SBAR(); GAPA(C0 = __builtin_amdgcn_mfma_f32_32x32x16_bf16(kf[2], qr[1], C0, 0, 0, 0),   P0[10], P0[11], P0[12], P0[13], pw1[0] = PKW(P0, 8), pw1[1] = PKW(P0, 10), pw1); \
    VRD(5); SBAR(); GAPA(C1 = __builtin_amdgcn_mfma_f32_32x32x16_bf16(kf[3], qr[1], C1, 0, 0, 0),   P0[14], P0[15], P1[0], P1[1],   pw1[2] = PKW(P0, 12), pw1[3] = PKW(P0, 14), pw1); \
    VRD(2); SBAR(); GAPA(C0 = __builtin_amdgcn_mfma_f32_32x32x16_bf16(kf[4], qr[2], C0, 0, 0, 0),   P1[2], P1[3], P1[4], P1[5],     pw2[0] = PKW(P1, 0), pw2[1] = PKW(P1, 2), pw2); \
    VRD(6); SBAR(); GAPA(C1 = __builtin_amdgcn_mfma_f32_32x32x16_bf16(kf[5], qr[2], C1, 0, 0, 0),   P1[6], P1[7], P1[8], P1[9],     pw2[2] = PKW(P1, 4), pw2[3] = PKW(P1, 6), pw2); \
    VRD(3); SBAR(); GAPA(C0 = __builtin_amdgcn_mfma_f32_32x32x16_bf16(kf[6], qr[3], C0, 0, 0, 0),   P1[10], P1[11], P1[12], P1[13], pw3[0] = PKW(P1, 8), pw3[1] = PKW(P1, 10), pw3); \
    VRD(7); SBAR(); GAPA(C1 = __builtin_amdgcn_mfma_f32_32x32x16_bf16(kf[7], qr[3], C1, 0, 0, 0),   P1[14], P1[15], 0.f, 0.f,       pw3[2] = PKW(P1, 12), pw3[3] = PKW(P1, 14), pw3); \
    if constexpr (!MS) l_reg += sacc; \
    if (GK) { DMA_K((t) + 3, sl_cur); } if (GV) { DMA_V((t) + 1, sl_next); } \
    SBAR(); \
    GAPB(o[0] = __builtin_amdgcn_mfma_f32_32x32x16_bf16(PAF(0), VFR(0), o[0], 0, 0, 0), C0, 0); \
    GAPB(o[1] = __builtin_amdgcn_mfma_f32_32x32x16_bf16(PAF(0), VFR(4), o[1], 0, 0, 0), C0, 4); LSUM(0); \
    KRD(GL, 0); GAPB(o[0] = __builtin_amdgcn_mfma_f32_32x32x16_bf16(PAF(1), VFR(1), o[0], 0, 0, 0), C0, 8); \
    KRD(GL, 1); GAPB(o[1] = __builtin_amdgcn_mfma_f32_32x32x16_bf16(PAF(1), VFR(5), o[1], 0, 0, 0), C0, 12); LSUM(1); \
    KRD(GL, 2); GAPB(o[0] = __builtin_amdgcn_mfma_f32_32x32x16_bf16(PAF(2), VFR(2), o[0], 0, 0, 0), C1, 0); \
    KRD(GL, 3); GAPB(o[1] = __builtin_amdgcn_mfma_f32_32x32x16_bf16(PAF(2), VFR(6), o[1], 0, 0, 0), C1, 4); LSUM(2); \
    GAPB(o[0] = __builtin_amdgcn_mfma_f32_32x32x16_bf16(PAF(3), VFR(3), o[0], 0, 0, 0), C1, 8); \
    GAPB(o[1] = __builtin_amdgcn_mfma_f32_32x32x16_bf16(PAF(3), VFR(7), o[1], 0, 0, 0), C1, 12); LSUM(3); \
    } while (0)
    int t = 1;
    for (; t + 5 < NT; t += 2) {
        STEP(pB0, pB1, pA0, pA1, t, true, true, true);     WAIT_BAR(2); RESC(); ROT();
        STEP(pA0, pA1, pB0, pB1, t + 1, true, true, true); WAIT_BAR(2); RESC(); ROT();
    }
#define ENDW(tt) do { if ((tt) + 3 < NT) { WAIT_BAR(2); } else if ((tt) + 2 < NT) { WAIT_BAR(1); } else { WAIT_BAR(0); } } while (0)
    for (; t + 1 < NT; t += 2) {
        STEP(pB0, pB1, pA0, pA1, t, (t + 3 < NT), (t + 1 < NT), (t + 1 < NT));         ENDW(t);     RESC(); ROT();
        STEP(pA0, pA1, pB0, pB1, t + 1, (t + 4 < NT), (t + 2 < NT), (t + 2 < NT));     ENDW(t + 1); RESC(); ROT();
    }
    STEP(pB0, pB1, pA0, pA1, NT - 1, false, false, false); RESC();
    { if constexpr (!MS) { float sacc = pB0[0] + pB0[1]; _Pragma("unroll") for (int r = 2; r < 16; ++r) sacc += pB0[r]; _Pragma("unroll") for (int r = 0; r < 16; ++r) sacc += pB1[r]; l_reg += sacc; }
      pw0 = (u32x4){PKW(pB0, 0), PKW(pB0, 2), PKW(pB0, 4), PKW(pB0, 6)}; pw1 = (u32x4){PKW(pB0, 8), PKW(pB0, 10), PKW(pB0, 12), PKW(pB0, 14)}; pw2 = (u32x4){PKW(pB1, 0), PKW(pB1, 2), PKW(pB1, 4), PKW(pB1, 6)}; pw3 = (u32x4){PKW(pB1, 8), PKW(pB1, 10), PKW(pB1, 12), PKW(pB1, 14)};
      SBAR(); pv(o, vb0 + sl_cur, PAF(0), PAF(1), PAF(2), PAF(3)); LSUM(0); LSUM(1); LSUM(2); LSUM(3); }
#undef LSUM
#undef PKW
#undef PAF
#undef VFR
#undef PIN
#undef MX3
#undef GAPA
#undef GAPB
#undef EX
#undef VRD
#undef KRD
#undef STEP
#undef ENDW
    float rli[16];
    if constexpr (MS) {
#pragma unroll
        for (int r = 0; r < 16; ++r) rli[r] = __builtin_amdgcn_rcpf(lacc[r]);
    } else {
        { auto rr = __builtin_amdgcn_permlane32_swap(__float_as_uint(l_reg), __float_as_uint(l_reg), false, false); l_reg = __uint_as_float(rr[0]) + __uint_as_float(rr[1]); }
        if (hi == 0) wsf[32 + r32] = l_reg; asm volatile("s_waitcnt lgkmcnt(0)" ::: "memory");
#pragma unroll
        for (int r = 0; r < 16; ++r) rli[r] = __builtin_amdgcn_rcpf(wsf[32 + crow(r, hi)]);
    }
    bf16* Ow = O + qrow0 * DMO + h * D;
    { bf16* stg = (bf16*)(shm + LDS_OST) + wid * 2048;
#pragma unroll
      for (int r = 0; r < 16; ++r) { const int orow = crow(r, hi);
#pragma unroll
        for (int d0 = 0; d0 < 2; ++d0) stg[orow * 64 + d0 * 32 + r32] = __float2bfloat16(o[d0][r] * rli[r]); }
      asm volatile("s_waitcnt lgkmcnt(0)" ::: "memory");
#pragma unroll
      for (int i = 0; i < 4; ++i) { const int row = i * 8 + (lane >> 3), ch = lane & 7; const u32x4 v = *(const u32x4*)(stg + row * 64 + ch * 8); *(u32x4*)(Ow + (long)row * DMO + ch * 8) = v; } }
    asm volatile("s_waitcnt lgkmcnt(0)\n\ts_barrier" ::: "memory");
#undef DMA_K
#undef DMA_V
#undef START
#undef RESC
#undef ROT
}
#undef SBAR
#undef WAIT_BAR

typedef int v8i_t __attribute__((ext_vector_type(8)));
typedef int v4i_t __attribute__((ext_vector_type(4)));
__host__ __device__ __forceinline__ int vt_slot(int k) { const int hi = (k >> 2) & 1, r = (k & 3) + 4 * ((k & 31) >> 3); return 32 * hi + r + 16 * (k >> 5); }
constexpr int SLOT8 = 4096, NS8 = 6, L8_K = 0, L8_V = NS8 * SLOT8;
static_assert(L8_V + NS8 * SLOT8 <= LDS_WS, "fp8 rings below the per-wave scratch");
constexpr int SC_QK = 0x7c7f, SC_PV = 0x7f7f;
__device__ __forceinline__ v8i_t ld32(lds_cptr p, int o0, int o1) { const v4i_t a = *(const __attribute__((address_space(3))) v4i_t*)(p + o0), b = *(const __attribute__((address_space(3))) v4i_t*)(p + o1); return __builtin_shufflevector(a, b, 0, 1, 2, 3, 4, 5, 6, 7); }
#define SBAR() __builtin_amdgcn_sched_barrier(0)
#define WAIT_BAR(N) asm volatile("s_waitcnt vmcnt(" #N ") lgkmcnt(0)\n\ts_barrier" ::: "memory")
__device__ __forceinline__ void attn_unit8(int b, int h, int qb, const unsigned char* Q8, const unsigned char* K8, const unsigned char* Vt8, bf16* O, char* shm, float negM_) {
    const int tid = threadIdx.x, lane = tid & 63, r32 = lane & 31, hi = lane >> 5; const int wid = __builtin_amdgcn_readfirstlane(tid >> 6);
    const int q0 = qb * QB; const int kvh = h / 3; const bool kw = wid < 4;
    const long qrow0 = (long)b * SEQ + q0 + wid * QBLK;
    const unsigned lds0 = (unsigned)(uintptr_t)shm;
    const int drow = 16 * (wid & 3) + (lane >> 2), dch = (lane & 3) ^ ((drow >> 2) & 3);
    const unsigned char* ksrc = K8 + ((long)b * LKV + drow) * DMKV + kvh * D + dch * 16;
    const unsigned char* vsrc = Vt8 + ((long)(b * NKVH + kvh) * (LKV / 64)) * 4096 + drow * 64 + dch * 16;
    const unsigned kdst = lds0 + L8_K + (wid & 3) * 1024, vdst = lds0 + L8_V + (wid & 3) * 1024;
#define DMA8_K(t, slot) glds16(ksrc + (long)(t) * KVBLK * DMKV, (unsigned)__builtin_amdgcn_readfirstlane(kdst + (slot)))
#define DMA8_V(t, slot) glds16(vsrc + (long)(t) * 4096, (unsigned)__builtin_amdgcn_readfirstlane(vdst + (slot)))
    const lds_cptr shm3 = (lds_cptr)shm; const int sw = (r32 >> 2) & 3, c0o = ((2 * hi) ^ sw) * 16, c1o = ((2 * hi + 1) ^ sw) * 16;
    const lds_cptr kp0 = shm3 + L8_K + r32 * 64; const lds_cptr vp0 = shm3 + L8_V + r32 * 64;
    if (kw) { DMA8_K(0, 0); DMA8_K(1, SLOT8); DMA8_K(2, 2 * SLOT8); DMA8_K(3, 3 * SLOT8); DMA8_K(4, 4 * SLOT8); } else { DMA8_V(0, 0); DMA8_V(1, SLOT8); DMA8_V(2, 2 * SLOT8); }
    const v8i_t qr = *reinterpret_cast<const v8i_t*>(Q8 + (qrow0 + r32) * DMQ + h * D + hi * 32);
    f32x16 o[2]; o[0] = f32x16{}; o[1] = f32x16{}; f32x16 negm; f32x16 lacc = f32x16{};
    _Pragma("unroll") for (int r = 0; r < 16; ++r) negm[r] = negM_;
    asm volatile("" : "+v"(negm));
    const v8i_t ONES8 = (v8i_t){0x38383838, 0x38383838, 0x38383838, 0x38383838, 0x38383838, 0x38383838, 0x38383838, 0x38383838};
    f32x16 c0, c1; v8i_t kf[2], vf[2], pw = (v8i_t){0, 0, 0, 0, 0, 0, 0, 0};
    int s0 = 0, s1 = SLOT8, s2 = 2 * SLOT8, s3 = 3 * SLOT8, s5 = 5 * SLOT8;
#define NXT8(x) (((x) == (NS8 - 1) * SLOT8) ? 0 : (x) + SLOT8)
#define ROT8() do { s0 = s1; s1 = s2; s2 = s3; s3 = NXT8(s3); s5 = NXT8(s5); } while (0)
#define QK8() do { c0 = __builtin_amdgcn_mfma_scale_f32_32x32x64_f8f6f4(kf[0], qr, negm, 0, 0, 0, SC_QK, 1, SC_QK); c1 = __builtin_amdgcn_mfma_scale_f32_32x32x64_f8f6f4(kf[1], qr, negm, 0, 0, 0, SC_QK, 1, SC_QK); } while (0)
#define PK8(P, B, OLD) __builtin_amdgcn_cvt_pk_fp8_f32(P[B + 2], P[B + 3], __builtin_amdgcn_cvt_pk_fp8_f32(P[B], P[B + 1], OLD, false), true)
#define PV8() do { if (REP == 71) { f32x16 dz_ = __builtin_amdgcn_mfma_scale_f32_32x32x64_f8f6f4(pw, vf[0], f32x16{}, 0, 0, 0, SC_PV, 1, SC_PV); asm volatile("" :: "v"(dz_)); dz_ = __builtin_amdgcn_mfma_scale_f32_32x32x64_f8f6f4(pw, vf[1], f32x16{}, 0, 0, 0, SC_PV, 1, SC_PV); asm volatile("" :: "v"(dz_)); } \
    o[0] = __builtin_amdgcn_mfma_scale_f32_32x32x64_f8f6f4(pw, vf[0], o[0], 0, 0, 0, SC_PV, 1, SC_PV); o[1] = __builtin_amdgcn_mfma_scale_f32_32x32x64_f8f6f4(pw, vf[1], o[1], 0, 0, 0, SC_PV, 1, SC_PV); \
        lacc = __builtin_amdgcn_mfma_scale_f32_32x32x64_f8f6f4(pw, ONES8, lacc, 0, 0, 0, SC_PV, 1, SC_PV); } while (0)
#define EXPK8() do { if (REP == 70) { _Pragma("unroll") for (int r = 0; r < 16; ++r) { float d0_ = __builtin_amdgcn_exp2f(c0[r] * 0.5f), d1_ = __builtin_amdgcn_exp2f(c1[r] * 0.5f); asm volatile("" :: "v"(d0_), "v"(d1_)); } } \
    _Pragma("unroll") for (int r = 0; r < 16; ++r) { c0[r] = __builtin_amdgcn_exp2f(c0[r]); c1[r] = __builtin_amdgcn_exp2f(c1[r]); } \
        pw[0] = PK8(c0, 0, pw[0]); pw[1] = PK8(c0, 4, pw[1]); pw[2] = PK8(c0, 8, pw[2]); pw[3] = PK8(c0, 12, pw[3]); pw[4] = PK8(c1, 0, pw[4]); pw[5] = PK8(c1, 4, pw[5]); pw[6] = PK8(c1, 8, pw[6]); pw[7] = PK8(c1, 12, pw[7]); } while (0)
    WAIT_BAR(0);
    kf[0] = ld32(kp0, c0o, c1o); kf[1] = ld32(kp0 + 2048, c0o, c1o);
    QK8(); EXPK8();
    kf[0] = ld32(kp0 + SLOT8, c0o, c1o); kf[1] = ld32(kp0 + SLOT8 + 2048, c0o, c1o);
    WAIT_BAR(0);
#define SUB8(t, GK, GV, GL) do { SBAR(); \
    vf[0] = ld32(vp0 + s0, c0o, c1o); vf[1] = ld32(vp0 + s0 + 2048, c0o, c1o); \
    QK8(); PV8(); \
    if (kw) { if (GK) { DMA8_K((t) + 4, s5); } } else { if (GV) { DMA8_V((t) + 2, s3); } } \
    if (GL) { kf[0] = ld32(kp0 + s2, c0o, c1o); kf[1] = ld32(kp0 + s2 + 2048, c0o, c1o); } \
    EXPK8(); ROT8(); \
    } while (0)
    int t = 1;
#pragma unroll 1
    for (; t + 5 < NT; t += 2) { SUB8(t, true, true, true); SUB8(t + 1, true, true, true); WAIT_BAR(1); }
#pragma unroll 1
    for (; t + 1 < NT; t += 2) {
        SUB8(t, (t + 4 < NT), (t + 2 < NT), (t + 1 < NT)); SUB8(t + 1, (t + 5 < NT), (t + 3 < NT), (t + 2 < NT)); WAIT_BAR(0); }
    SUB8(NT - 1, false, false, false);
    {
        asm volatile("s_waitcnt lgkmcnt(0)" ::: "memory");
        vf[0] = ld32(vp0 + s0, c0o, c1o); vf[1] = ld32(vp0 + s0 + 2048, c0o, c1o);
        PV8(); }
    float rli[16];
#pragma unroll
    for (int r = 0; r < 16; ++r) rli[r] = __builtin_amdgcn_rcpf(lacc[r]);
    bf16* Ow = O + qrow0 * DMO + h * D;
    { bf16* stg = (bf16*)(shm + LDS_OST) + wid * 2048;
#pragma unroll
      for (int r = 0; r < 16; ++r) { const int orow = crow(r, hi);
#pragma unroll
        for (int d0 = 0; d0 < 2; ++d0) stg[orow * 64 + d0 * 32 + r32] = __float2bfloat16(o[d0][r] * rli[r]); }
      asm volatile("s_waitcnt lgkmcnt(0)" ::: "memory");
#pragma unroll
      for (int i = 0; i < 4; ++i) { const int row = i * 8 + (lane >> 3), ch = lane & 7; const u32x4 v = *(const u32x4*)(stg + row * 64 + ch * 8); *(u32x4*)(Ow + (long)row * DMO + ch * 8) = v; } }
    asm volatile("s_waitcnt vmcnt(0) lgkmcnt(0)\n\ts_barrier" ::: "memory");
#undef DMA8_K
#undef DMA8_V
#undef ROT8
#undef QK8
#undef PK8
#undef PV8
#undef EXPK8
#undef SUB8
#undef NXT8
}
#undef SBAR
#undef WAIT_BAR
}

#define XB_TMO      128
#define XB_XCNT(j)  (256  + 64 * (j))
#define XB_XSUB(j)  (1280 + 64 * (j))
#define XB_XGEN(j)  (2304 + 64 * (j))
#define XB_TOP      3328
#define XB_TOPGEN   3392
#define XCD_BAR_WORDS 3456
#define XB_SPIN_CAP (1u << 18)
__device__ __forceinline__ unsigned xb_ld(unsigned* p)              { return __hip_atomic_load(p, __ATOMIC_RELAXED, __HIP_MEMORY_SCOPE_AGENT); }
__device__ __forceinline__ unsigned xb_add(unsigned* p, unsigned v) { return __hip_atomic_fetch_add(p, v, __ATOMIC_RELAXED, __HIP_MEMORY_SCOPE_AGENT); }
__device__ __forceinline__ unsigned xb_xcc_id() { return (unsigned)__builtin_amdgcn_s_getreg((3 << 11) | 20) & 0xFu; }
#define XB_SPIN(cond, bar) do { unsigned _sp = 0; while (cond) { __builtin_amdgcn_s_sleep(1); \
    if ((++_sp & 255u) == 0u) { if (xb_ld(&(bar)[XB_TMO])) break; if (_sp > XB_SPIN_CAP) { atomicAdd(&(bar)[XB_TMO], 1u); break; } } } } while (0)
struct XcdBarrier { unsigned* bar; unsigned x; volatile LAS unsigned* st; };
__device__ __forceinline__ XcdBarrier xcd_barrier_post(unsigned* bar, volatile LAS unsigned* st) {
    XcdBarrier b; b.bar = bar; b.x = xb_xcc_id(); b.st = st;
    if (threadIdx.x == 0) (void)xb_add(&bar[XB_XCNT(b.x)], 1u);
    return b;
}
__device__ __forceinline__ void xcd_barrier_complete(unsigned* bar, unsigned x, unsigned& nloc, unsigned& nx) {
    const unsigned G = gridDim.x * gridDim.y * gridDim.z;
    unsigned sum, cnt, mine, sp = 0u;
    for (;;) {
        sum = 0u; cnt = 0u; mine = 0u;
#pragma unroll
        for (unsigned j = 0; j < 16; ++j) { const unsigned c = xb_ld(&bar[XB_XCNT(j)]); sum += c; cnt += (c > 0u) ? 1u : 0u; mine = (j == x) ? c : mine; }
        if (sum == G) break;
        __builtin_amdgcn_s_sleep(1);
        if ((++sp & 255u) == 0u) { if (xb_ld(&bar[XB_TMO])) break; if (sp > XB_SPIN_CAP) { atomicAdd(&bar[XB_TMO], 1u); break; } }
    }
    nloc = mine > 0u ? mine : 1u; nx = cnt > 0u ? cnt : 1u;
}
__device__ __forceinline__ void xcd_barrier(const XcdBarrier& b) {
    asm volatile("s_waitcnt vmcnt(0)" ::: "memory");
    __syncthreads();
    if (threadIdx.x == 0) {
        unsigned* bar = b.bar;
        __builtin_amdgcn_s_waitcnt(0);
        unsigned nloc = b.st[0], nx = b.st[1];
        if (nloc == 0u) { xcd_barrier_complete(bar, b.x, nloc, nx); b.st[0] = nloc; b.st[1] = nx; }
        const unsigned old = xb_add(&bar[XB_XSUB(b.x)], 1u);
        const unsigned gen = old / nloc;
        if (old + 1u == (gen + 1u) * nloc) {
            __builtin_amdgcn_fence(__ATOMIC_RELEASE, "agent");
            asm volatile("s_waitcnt vmcnt(0)" ::: "memory");
            const unsigned og = xb_add(&bar[XB_TOP], 1u);
            const unsigned tg = og / nx;
            if (og + 1u == (tg + 1u) * nx) xb_add(&bar[XB_TOPGEN], 1u);
            else XB_SPIN(xb_ld(&bar[XB_TOPGEN]) == tg, bar);
            __builtin_amdgcn_fence(__ATOMIC_ACQUIRE, "agent");
            xb_add(&bar[XB_XGEN(b.x)], 1u);
            asm volatile("s_waitcnt vmcnt(0)" ::: "memory");
        } else {
            XB_SPIN(xb_ld(&bar[XB_XGEN(b.x)]) == gen, bar);
            __builtin_amdgcn_fence(__ATOMIC_ACQUIRE, "agent");
            asm volatile("s_waitcnt vmcnt(0)" ::: "memory");
        }
    }
    __syncthreads();
}

struct Frame {
    LAS unsigned char* lds;
    volatile LAS unsigned* MISC;
    gu32* ctl;
    int tid, lane, wave;
    int vcu, G;
    const float* const* ka;
    float* out;
    unsigned char* ws;
};
#define WSP(T, off) ((T*)(F.ws + (off)))
#define FIN_x (F.ka[0])
#define FIN_c (F.ka[1])
#define FIN_ctx (F.ka[2])
#define FIN_c_ctx (F.ka[3])
#define FIN_norm1_g (F.ka[4])
#define FIN_w_ada (F.ka[5])
#define FIN_b_ada (F.ka[6])
#define FIN_w_in (F.ka[7])
#define FIN_w_fourier (F.ka[8])
#define FIN_q_norm_g (F.ka[9])
#define FIN_k_norm_g (F.ka[10])
#define FIN_w_out (F.ka[11])
#define FIN_norm2_g (F.ka[12])
#define FIN_w_router (F.ka[13])
#define FIN_router_bias (F.ka[14])
#define FIN_w_egu (F.ka[15])
#define FIN_w_ed (F.ka[16])
#define FIN_w_sgu (F.ka[17])
#define FIN_w_sd (F.ka[18])
#define FIN_final_g (F.ka[19])

struct DenseOrder {
    static constexpr bool GATHER = false;
    int nN, nmain, nextra, G, c; const char* Bt; int K; int reps;
    __device__ __forceinline__ bool next(int i, pg8::GUnit& u) const {
        const int ntot = nmain + nextra, nc = (ntot - c + G - 1) / G; if (i >= nc * reps) return false;
        const int L = (i % nc) * G + c;
        if (L < nmain) { const int nig = 8 * nN, gid = L / nig, r = L % nig; u.pm = gid * 8 + (r & 7); u.pn = r >> 3; }
        else { const int jx = L - nmain; u.pm = 128 + (jx & 3); u.pn = 5 + (jx >> 2); }
        u.e = 0; u.j = 0; u.nvalid = 256; u.B = Bt + (size_t)u.pn * 256 * K * 2; return true;
    }
    __device__ __forceinline__ int arow(const pg8::GUnit& u, int r) const { return u.pm * 256 + r; }
};
template <bool GATHER_> struct GroupedOrder {
    static constexpr bool GATHER = GATHER_;
    int NPN, G, c, nbrows, K; bool gather; const char* Bt; const LAS int* TS; const LAS int* CN; const GAS u32x2* LIST; int reps; int total;
    __device__ __forceinline__ bool next(int i, pg8::GUnit& u) const {
        const int ntot = total * NPN, nc = (ntot - c + G - 1) / G; if (i >= nc * reps) return false;
        const int L = (i % nc) * G + c; const int T = L / NPN;
        int lo = __builtin_amdgcn_readfirstlane((int)((const LAS unsigned short*)(TS + 640))[T]);
        const int ts = __builtin_amdgcn_readfirstlane(TS[lo]), cn = __builtin_amdgcn_readfirstlane(CN[lo]);
        u.pm = T; u.pn = L - T * NPN; u.e = lo; u.j = T - ts; const int rem = cn - 256 * u.j; u.nvalid = rem < 256 ? rem : 256;
        u.B = Bt + ((size_t)lo * nbrows + (size_t)u.pn * 256) * K; return true;
    }
    __device__ __forceinline__ int arow(const pg8::GUnit& u, int r) const {
        if (!gather) return u.pm * 256 + r;
        int pos = 256 * u.j + r; if (r >= u.nvalid) pos = 0;
        const u32x2 en = LIST[(size_t)u.e * NTOK + pos];
        return (int)(en.x & 0xffffu);
    }
};

struct EpiInProj {
    static constexpr bool PERM = true; static constexpr int NSTORE = 8;
    __device__ __forceinline__ void pre(LAS unsigned char*, const pg8::GUnit&, int, int, int) const {}
    u16 *Z, *Q, *Kb, *Vb; const float *COS, *SIN, *gq, *gk;
    __device__ __forceinline__ void operator()(const f32x4 (&acc)[2][2][4][2], const pg8::GUnit& u, int wr, int wc, int fr, int fq, LAS unsigned char* lds, int ui) const {
        const int pn = u.pn; const bool is_ctx = u.pm >= 128;
        if (ATTN_FP8 && pn == 6) {
            LAS unsigned char* st = lds + pg8::STAGE_BYTES; const int tid = threadIdx.x;
            const int b = is_ctx ? (u.pm - 128) : (u.pm >> 5), kt0 = is_ctx ? (SEQ / 64) : (((u.pm * 256) & (SEQ - 1)) >> 6);
#pragma unroll
            for (int ai = 0; ai < 2; ++ai)
#pragma unroll
                for (int bj = 0; bj < 2; ++bj) {
#pragma unroll
                    for (int m = 0; m < 4; ++m) { const int ks = attn_body::vt_slot(16 * m + fr); const f32x4 v0 = acc[ai][bj][m][0], v1 = acc[ai][bj][m][1];
                        int w0 = __builtin_amdgcn_cvt_pk_fp8_f32(v0[0], v0[1], 0, false); w0 = __builtin_amdgcn_cvt_pk_fp8_f32(v0[2], v0[3], w0, true);
                        int w1 = __builtin_amdgcn_cvt_pk_fp8_f32(v1[0], v1[1], 0, false); w1 = __builtin_amdgcn_cvt_pk_fp8_f32(v1[2], v1[3], w1, true);
#pragma unroll
                        for (int q8 = 0; q8 < 8; ++q8) st[((wr * 128 + 32 * wc + 8 * fq + q8) * 64) + ks] = (unsigned char)(((q8 < 4 ? (unsigned)w0 : (unsigned)w1) >> (8 * (q8 & 3))) & 0xffu); }
                    asm volatile("s_waitcnt lgkmcnt(0)" ::: "memory"); __builtin_amdgcn_s_barrier(); asm volatile("" ::: "memory");
#pragma unroll
                    for (int j = 0; j < 2; ++j) { const int ch = tid + 512 * j, row = ch >> 2, part = ch & 3, col = 128 * bj + (row & 127), kvh = col >> 6, d = col & 63, kt = kt0 + 2 * ai + (row >> 7);
                        const u32x4 v = *(const LAS u32x4*)(st + row * 64 + part * 16);
                        *(u32x4*)((unsigned char*)Vb + ((((size_t)(b * NKVH + kvh) * (LKV / 64) + kt) * 64 + d) * 64) + part * 16) = v; }
                    asm volatile("s_waitcnt lgkmcnt(0)" ::: "memory"); __builtin_amdgcn_s_barrier(); asm volatile("" ::: "memory");
                }
            return;
        }
        float gn[2][2][4];
        if (pn >= 2 && pn < 6) { const float* gsrc = (pn == 5) ? gk : gq;
#pragma unroll
            for (int bj = 0; bj < 2; ++bj)
#pragma unroll
                for (int n = 0; n < 2; ++n) { const f32x4 g4 = *(const f32x4*)(gsrc + 32 * bj + 16 * n + 4 * fq); gn[bj][n][0] = g4[0]; gn[bj][n][1] = g4[1]; gn[bj][n][2] = g4[2]; gn[bj][n][3] = g4[3]; } }
#pragma unroll
        for (int ai = 0; ai < 2; ++ai)
#pragma unroll
            for (int m = 0; m < 4; ++m) {
                const int row = u.pm * 256 + ai * 128 + wr * 64 + m * 16 + fr;
                int b, l, key;
                if (!is_ctx) { b = row >> 13; l = row & 8191; key = l; } else { const int rc = row - NTOK; b = rc >> 8; l = 0; key = SEQ + (rc & 255); }
                if (pn < 2) {
#pragma unroll
                    for (int bj = 0; bj < 2; ++bj) { const int g = 32 * pn + 16 * bj + 4 * wc + fq; const f32x4 v0 = acc[ai][bj][m][0], v1 = acc[ai][bj][m][1];
                        u32x4 w; w.x = cvt_pk_bf16(v0[0], v0[1]); w.y = cvt_pk_bf16(v0[2], v0[3]); w.z = cvt_pk_bf16(v1[0], v1[1]); w.w = cvt_pk_bf16(v1[2], v1[3]);
                        *(u32x4*)(Z + (((size_t)(b * 64 + g) * SEQ + l) * 8)) = w; }
                } else if (pn < 6) {
                    float ss = 0.f;
#pragma unroll
                    for (int bj = 0; bj < 2; ++bj)
#pragma unroll
                        for (int n = 0; n < 2; ++n) { const f32x4 v = acc[ai][bj][m][n]; ss += (v[0] * v[0] + v[1] * v[1]) + (v[2] * v[2] + v[3] * v[3]); }
                    ss += __shfl_xor(ss, 16); ss += __shfl_xor(ss, 32);
                    const float rstd = 1.0f / sqrtf(ss * (1.0f / 64.0f) + RMS_EPS);
                    const float osc = (pn == 5) ? 1.0f : C2;
#pragma unroll
                    for (int bj = 0; bj < 2; ++bj) {
                        const int pidx = (bj == 0) ? (l >> 6) : (l & 63);
                        f32x4 cs = *(const f32x4*)(COS + pidx * 16 + 4 * fq), sn = *(const f32x4*)(SIN + pidx * 16 + 4 * fq);
                        if (is_ctx) { cs = (f32x4){1.f, 1.f, 1.f, 1.f}; sn = (f32x4){0.f, 0.f, 0.f, 0.f}; }
                        float oa[4], ob[4];
#pragma unroll
                        for (int e = 0; e < 4; ++e) { const float a = acc[ai][bj][m][0][e] * rstd * gn[bj][0][e], bb = acc[ai][bj][m][1][e] * rstd * gn[bj][1][e];
                            oa[e] = (a * cs[e] - bb * sn[e]) * osc; ob[e] = (bb * cs[e] + a * sn[e]) * osc; }
                        if (ATTN_FP8) {
                            const float f8s = (pn < 5) ? Q8_SCALE : 1.0f;
                            int w0 = __builtin_amdgcn_cvt_pk_fp8_f32(oa[0] * f8s, oa[1] * f8s, 0, false); w0 = __builtin_amdgcn_cvt_pk_fp8_f32(oa[2] * f8s, oa[3] * f8s, w0, true);
                            int w1 = __builtin_amdgcn_cvt_pk_fp8_f32(ob[0] * f8s, ob[1] * f8s, 0, false); w1 = __builtin_amdgcn_cvt_pk_fp8_f32(ob[2] * f8s, ob[3] * f8s, w1, true);
                            if (pn < 5) { const int head = 4 * (pn - 2) + wc; *(u32x2*)((unsigned char*)Q + ((size_t)row * QW + head * 64 + 32 * bj + 8 * fq)) = (u32x2){(unsigned)w0, (unsigned)w1}; }
                            else *(u32x2*)((unsigned char*)Kb + (((size_t)b * LKV + key) * KVW + wc * 64 + 32 * bj + 8 * fq)) = (u32x2){(unsigned)w0, (unsigned)w1};
                        } else {
                        u32x4 w; w.x = cvt_pk_bf16(oa[0], oa[1]); w.y = cvt_pk_bf16(oa[2], oa[3]); w.z = cvt_pk_bf16(ob[0], ob[1]); w.w = cvt_pk_bf16(ob[2], ob[3]);
                        if (pn < 5) { const int head = 4 * (pn - 2) + wc; *(u32x4*)(Q + ((size_t)row * QW + head * 64 + 32 * bj + 8 * fq)) = w; }
                        else *(u32x4*)(Kb + (((size_t)b * LKV + key) * KVW + wc * 64 + 32 * bj + 8 * fq)) = w; }
                    }
                } else {
#pragma unroll
                    for (int bj = 0; bj < 2; ++bj) { const f32x4 v0 = acc[ai][bj][m][0], v1 = acc[ai][bj][m][1];
                        if (ATTN_FP8) {
                            const int kt = key >> 6, ks = attn_body::vt_slot(key & 63);
                            int w0 = __builtin_amdgcn_cvt_pk_fp8_f32(v0[0], v0[1], 0, false); w0 = __builtin_amdgcn_cvt_pk_fp8_f32(v0[2], v0[3], w0, true);
                            int w1 = __builtin_amdgcn_cvt_pk_fp8_f32(v1[0], v1[1], 0, false); w1 = __builtin_amdgcn_cvt_pk_fp8_f32(v1[2], v1[3], w1, true);
#pragma unroll
                            for (int q8 = 0; q8 < 8; ++q8) { const int col = 128 * bj + 32 * wc + 8 * fq + q8, kvh = col >> 6, d = col & 63;
                                ((unsigned char*)Vb)[((((size_t)(b * NKVH + kvh) * (LKV / 64) + kt) * 64 + d) * 64) + ks] = (unsigned char)(((q8 < 4 ? (unsigned)w0 : (unsigned)w1) >> (8 * (q8 & 3))) & 0xffu); }
                        } else {
                        u32x4 w; w.x = cvt_pk_bf16(v0[0], v0[1]); w.y = cvt_pk_bf16(v0[2], v0[3]); w.z = cvt_pk_bf16(v1[0], v1[1]); w.w = cvt_pk_bf16(v1[2], v1[3]);
                        *(u32x4*)(Vb + (((size_t)b * LKV + key) * KVW + 128 * bj + 32 * wc + 8 * fq)) = w; } }
                }
            }
    }
};
struct EpiResid {
    static constexpr bool PERM = false; static constexpr int NSTORE = 32;
    __device__ __forceinline__ void pre(LAS unsigned char*, const pg8::GUnit&, int, int, int) const {}
    const float* x; float* X1; const gi64* MOD;
    __device__ __forceinline__ void operator()(const f32x4 (&acc)[2][2][4][2], const pg8::GUnit& u, int wr, int wc, int fr, int fq, LAS unsigned char* lds, int ui) const {
        const int row0 = u.pm * 256 + wr * 64 + fr, col0 = u.pn * 256 + wc * 32 + 4 * fq; const int b = (u.pm * 256) >> 13;
        f32x4 gv[2][2];
#pragma unroll
        for (int bj = 0; bj < 2; ++bj)
#pragma unroll
            for (int n = 0; n < 2; ++n) gv[bj][n] = mod4(MOD, b * 6144 + 2048 + col0 + bj * 128 + n * 16);
#pragma unroll
        for (int ai = 0; ai < 2; ++ai)
#pragma unroll
            for (int m = 0; m < 4; ++m) { const size_t off = (size_t)(row0 + ai * 128 + m * 16) * DM + col0;
#pragma unroll
                for (int bj = 0; bj < 2; ++bj)
#pragma unroll
                    for (int n = 0; n < 2; ++n) { const f32x4 xv = *(const f32x4*)(x + off + bj * 128 + n * 16); *(f32x4*)(X1 + off + bj * 128 + n * 16) = (DBG & 2) ? xv : xv + gv[bj][n] * acc[ai][bj][m][n]; } }
    }
};
struct EpiLogits {
    static constexpr bool PERM = false; static constexpr int NSTORE = 32;
    __device__ __forceinline__ void pre(LAS unsigned char*, const pg8::GUnit&, int, int, int) const {}
    float* C;
    __device__ __forceinline__ void operator()(const f32x4 (&acc)[2][2][4][2], const pg8::GUnit& u, int wr, int wc, int fr, int fq, LAS unsigned char* lds, int ui) const {
        const int row0 = u.pm * 256 + wr * 64 + fr, col0 = wc * 32 + 4 * fq;
#pragma unroll
        for (int ai = 0; ai < 2; ++ai)
#pragma unroll
            for (int m = 0; m < 4; ++m) { float* rowp = C + (size_t)(row0 + ai * 128 + m * 16) * NEXP + col0;
#pragma unroll
                for (int bj = 0; bj < 2; ++bj)
#pragma unroll
                    for (int n = 0; n < 2; ++n) *(f32x4*)(rowp + bj * 128 + n * 16) = acc[ai][bj][m][n]; }
    }
};
struct EpiSwiglu {
    static constexpr bool PERM = true; static constexpr int NSTORE = 16;
    __device__ __forceinline__ void pre(LAS unsigned char*, const pg8::GUnit&, int, int, int) const {}
    u16* ACT;
    __device__ __forceinline__ void operator()(const f32x4 (&acc)[2][2][4][2], const pg8::GUnit& u, int wr, int wc, int fr, int fq, LAS unsigned char* lds, int ui) const {
#pragma unroll
        for (int ai = 0; ai < 2; ++ai)
#pragma unroll
            for (int m = 0; m < 4; ++m) { const int r = ai * 128 + wr * 64 + m * 16 + fr; u16* rowp = ACT + ((size_t)u.pm * 256 + r) * EFF + 128 * u.pn + 16 * wc + 4 * fq;
#pragma unroll
                for (int bj = 0; bj < 2; ++bj) { const f32x4 a = acc[ai][bj][m][0], g = acc[ai][bj][m][1]; float o[4];
#pragma unroll
                    for (int e = 0; e < 4; ++e) o[e] = a[e] * g[e] / (1.0f + __expf(-a[e]));
                    if (MOE_FP8) { int w0 = __builtin_amdgcn_cvt_pk_fp8_f32(o[0], o[1], 0, false); w0 = __builtin_amdgcn_cvt_pk_fp8_f32(o[2], o[3], w0, true);
                        *(unsigned*)((unsigned char*)ACT + ((size_t)u.pm * 256 + r) * EFF + 128 * u.pn + 16 * wc + 4 * fq + 64 * bj) = (unsigned)w0; }
                    else { u32x2 w; if (MOEF16) { w.x = pk2h(o[0], o[1]); w.y = pk2h(o[2], o[3]); } else { w.x = pk2bf(o[0], o[1]); w.y = pk2bf(o[2], o[3]); } *(u32x2*)(rowp + 64 * bj) = w; } } }
    }
};
struct EpiDown {
    static constexpr bool PERM = true; static constexpr int NSTORE = 16;
    u16* Cc; const GAS u32x2* LIST; unsigned char* dump;
    __device__ __forceinline__ void pre(LAS unsigned char* lds, const pg8::GUnit& u, int ui, int wid, int lane) const {
        if (wid < 2) __builtin_amdgcn_global_load_lds((const unsigned*)(LIST + (size_t)u.e * NTOK + 256 * u.j + 128 * wid + 2 * lane), (LAS unsigned*)(lds + pg8::STAGE_BYTES + (ui & 1) * 2048 + wid * 1024), 16, 0, 0);
    }
    __device__ __forceinline__ void operator()(const f32x4 (&acc)[2][2][4][2], const pg8::GUnit& u, int wr, int wc, int fr, int fq, LAS unsigned char* lds, int ui) const {
        const LAS f32x2* ent = (const LAS f32x2*)(lds + pg8::STAGE_BYTES + (ui & 1) * 2048);
#pragma unroll
        for (int ai = 0; ai < 2; ++ai)
#pragma unroll
            for (int m = 0; m < 4; ++m) { const int r = ai * 128 + wr * 64 + m * 16 + fr;
                const f32x2 enf = ent[r];
                const unsigned ex = __builtin_bit_cast(unsigned, enf.x); const int tok = (int)(ex & 0x7fffu), slot = (int)((ex >> 16) & 15u); const float gate = enf.y;
                unsigned char* rowp = (unsigned char*)Cc + ((size_t)tok * NSLOT + slot) * DM + 256 * u.pn + 32 * wc + 8 * fq;
                if (r >= u.nvalid) rowp = dump + ((size_t)(blockIdx.x * 512 + threadIdx.x)) * 256;
                const float gs = gate * C_SCALE;
#pragma unroll
                for (int bj = 0; bj < 2; ++bj) { f32x4 v0 = acc[ai][bj][m][0] * gs, v1 = acc[ai][bj][m][1] * gs;
#pragma unroll
                    for (int e = 0; e < 4; ++e) { v0[e] = __builtin_amdgcn_fmed3f(v0[e], -440.f, 440.f); v1[e] = __builtin_amdgcn_fmed3f(v1[e], -440.f, 440.f); }
                    int w0 = __builtin_amdgcn_cvt_pk_fp8_f32(v0[0], v0[1], 0, false); w0 = __builtin_amdgcn_cvt_pk_fp8_f32(v0[2], v0[3], w0, true);
                    int w1 = __builtin_amdgcn_cvt_pk_fp8_f32(v1[0], v1[1], 0, false); w1 = __builtin_amdgcn_cvt_pk_fp8_f32(v1[2], v1[3], w1, true);
                    *(u32x2*)(rowp + 128 * bj) = (u32x2){(unsigned)w0, (unsigned)w1}; } }
    }
};

template <bool F16OUT, bool F8OUT2 = false> __device__ __forceinline__ void rownorm_rows(const GAS float* src, const float* gain, const gi64* MODsh, const gi64* MODsc, u16* dst, int row0, int nrows, int wi, int wstride, int lane, unsigned char* dst8 = nullptr) {
    f32x4 Av[2][2], Bv[2][2];
#pragma unroll
    for (int j = 0; j < 2; ++j)
#pragma unroll
        for (int h = 0; h < 2; ++h) { const int col = 8 * lane + 512 * j + 4 * h; Av[j][h] = *(const f32x4*)(gain + col) * (mod4(MODsc, col) + 1.0f); Bv[j][h] = mod4(MODsh, col); }
    for (int r = wi; r < nrows; r += 2 * wstride) {
        const int r1 = r + wstride; const bool has1 = r1 < nrows;
        const GAS float* s0 = src + (size_t)(row0 + r) * DM; const GAS float* s1 = src + (size_t)(row0 + (has1 ? r1 : r)) * DM;
        f32x4 v0[2][2], v1[2][2];
#pragma unroll
        for (int j = 0; j < 2; ++j)
#pragma unroll
            for (int h = 0; h < 2; ++h) { v0[j][h] = *(const GAS f32x4*)(s0 + 8 * lane + 512 * j + 4 * h); v1[j][h] = *(const GAS f32x4*)(s1 + 8 * lane + 512 * j + 4 * h); }
        float q0 = 0.f, q1 = 0.f;
#pragma unroll
        for (int j = 0; j < 2; ++j)
#pragma unroll
            for (int h = 0; h < 2; ++h) { const f32x4 a = v0[j][h], b = v1[j][h]; q0 += (a[0] * a[0] + a[1] * a[1]) + (a[2] * a[2] + a[3] * a[3]); q1 += (b[0] * b[0] + b[1] * b[1]) + (b[2] * b[2] + b[3] * b[3]); }
#pragma unroll
        for (int o = 1; o < 64; o <<= 1) { q0 += __shfl_xor(q0, o); q1 += __shfl_xor(q1, o); }
        const float rs0 = 1.0f / sqrtf(q0 * (1.0f / DM) + RMS_EPS), rs1 = 1.0f / sqrtf(q1 * (1.0f / DM) + RMS_EPS);
#pragma unroll
        for (int j = 0; j < 2; ++j) { const f32x4 ya = v0[j][0] * rs0 * Av[j][0] + Bv[j][0], yb = v0[j][1] * rs0 * Av[j][1] + Bv[j][1];
            u32x4 w; if (F16OUT) { w.x = pk2h(ya[0], ya[1]); w.y = pk2h(ya[2], ya[3]); w.z = pk2h(yb[0], yb[1]); w.w = pk2h(yb[2], yb[3]); } else { w.x = pk2bf(ya[0], ya[1]); w.y = pk2bf(ya[2], ya[3]); w.z = pk2bf(yb[0], yb[1]); w.w = pk2bf(yb[2], yb[3]); }
            *(GAS u32x4*)(dst + (size_t)(row0 + r) * DM + 8 * lane + 512 * j) = w;
            if (F8OUT2) { int w0 = __builtin_amdgcn_cvt_pk_fp8_f32(ya[0], ya[1], 0, false); w0 = __builtin_amdgcn_cvt_pk_fp8_f32(ya[2], ya[3], w0, true); int w1 = __builtin_amdgcn_cvt_pk_fp8_f32(yb[0], yb[1], 0, false); w1 = __builtin_amdgcn_cvt_pk_fp8_f32(yb[2], yb[3], w1, true);
                *(GAS u32x2*)(dst8 + (size_t)(row0 + r) * DM + 8 * lane + 512 * j) = (u32x2){(unsigned)w0, (unsigned)w1}; } }
        if (has1) {
#pragma unroll
            for (int j = 0; j < 2; ++j) { const f32x4 ya = v1[j][0] * rs1 * Av[j][0] + Bv[j][0], yb = v1[j][1] * rs1 * Av[j][1] + Bv[j][1];
                u32x4 w; if (F16OUT) { w.x = pk2h(ya[0], ya[1]); w.y = pk2h(ya[2], ya[3]); w.z = pk2h(yb[0], yb[1]); w.w = pk2h(yb[2], yb[3]); } else { w.x = pk2bf(ya[0], ya[1]); w.y = pk2bf(ya[2], ya[3]); w.z = pk2bf(yb[0], yb[1]); w.w = pk2bf(yb[2], yb[3]); }
                *(GAS u32x4*)(dst + (size_t)(row0 + r1) * DM + 8 * lane + 512 * j) = w;
                if (F8OUT2) { int w0 = __builtin_amdgcn_cvt_pk_fp8_f32(ya[0], ya[1], 0, false); w0 = __builtin_amdgcn_cvt_pk_fp8_f32(ya[2], ya[3], w0, true); int w1 = __builtin_amdgcn_cvt_pk_fp8_f32(yb[0], yb[1], 0, false); w1 = __builtin_amdgcn_cvt_pk_fp8_f32(yb[2], yb[3], w1, true);
                    *(GAS u32x2*)(dst8 + (size_t)(row0 + r1) * DM + 8 * lane + 512 * j) = (u32x2){(unsigned)w0, (unsigned)w1}; } } }
    }
}

__device__ __forceinline__ void p0_phase(Frame& F) {
    const int gw = F.vcu * 8 + F.wave, NGW = F.G * 8, lane = F.lane;
    unsigned long long* MODQ = (unsigned long long*)(F.ctl + CW_MOD);
    for (int it = gw; it < 1536; it += NGW) {
        const int cb = it % 24, kc = it / 24, k0 = kc * 16, col = cb * 256 + lane * 4;
        float sv[5];
#pragma unroll
        for (int r = 0; r < 5; ++r) { const float cv = (r < 4) ? FIN_c[r * DM + k0 + (lane & 15)] : FIN_c_ctx[k0 + (lane & 15)]; sv[r] = cv / (1.0f + __expf(-cv)); }
        f32x4 acc[5];
#pragma unroll
        for (int r = 0; r < 5; ++r) acc[r] = (f32x4){0.f, 0.f, 0.f, 0.f};
#pragma unroll
        for (int kk = 0; kk < 16; ++kk) { const f32x4 w = *(const f32x4*)(FIN_w_ada + (size_t)(k0 + kk) * 6144 + col);
#pragma unroll
            for (int r = 0; r < 5; ++r) { const float s = __builtin_bit_cast(float, __builtin_amdgcn_readlane(__builtin_bit_cast(int, sv[r]), kk)); acc[r] += w * s; } }
        if (kc == 0) { const f32x4 bv = *(const f32x4*)(FIN_b_ada + col);
#pragma unroll
            for (int r = 0; r < 5; ++r) acc[r] += bv; }
#pragma unroll
        for (int r = 0; r < 5; ++r)
#pragma unroll
            for (int j = 0; j < 4; ++j) atomicAdd(MODQ + r * 6144 + col + j, (unsigned long long)__float2ll_rn(acc[r][j] * 0x1p36f));
    }
    float* WCS = WSP(float, WS_TAB);
    for (int it = gw; it < 256; it += NGW) {
        const int fh = it >> 6, d = it & 63; float ac = 0.f, as = 0.f;
        const float ctab = cospif((float)lane * (1.0f / 32.0f)), stab = sinpif((float)lane * (1.0f / 32.0f));
        for (int k2 = 0; k2 < 64; ++k2) { const int mm = __builtin_amdgcn_readfirstlane((d * k2) & 63); const float w = FIN_w_fourier[(fh * 64 + k2) * 64 + lane]; ac += rdl(ctab, mm) * w; as += rdl(stab, mm) * w; }
        const float sc = 1.0f / sqrtf((float)SEQ * 64.0f);
        WCS[(fh * 64 + d) * 128 + lane] = ac * sc; WCS[(fh * 64 + d) * 128 + 64 + lane] = as * sc;
    }
    {
        u16* D1 = WSP(u16, WS_TAB + 144 * 1024); u16* D3 = WSP(u16, WS_TAB + 272 * 1024);
        for (int it = gw; it < 320; it += NGW) {
            if (it < 256) { const int ro = it >> 7, k1 = it & 127;
#pragma unroll
                for (int j = 0; j < 4; ++j) { const int col = lane + 64 * j, ri = col >> 7, n1 = col & 127, mm = (n1 * k1) & 127; const float cc = cospif((float)mm * (1.0f / 64.0f)), ss = sinpif((float)mm * (1.0f / 64.0f));
                    const float v = (ro == 0) ? (ri == 0 ? cc : -ss) : (ri == 0 ? -ss : -cc); D1[it * 256 + col] = (u16)f2bf(v); } }
            else { const int k2 = it - 256;
#pragma unroll
                for (int j = 0; j < 2; ++j) { const int col = lane + 64 * j, ri = col >> 6, n2 = col & 63, mm = (n2 * k2) & 63; const float v = (ri == 0) ? cospif((float)mm * (1.0f / 32.0f)) : sinpif((float)mm * (1.0f / 32.0f)); D3[k2 * 128 + col] = (u16)f2bf(v); } }
        }
    }
    float* COS = WSP(float, WS_TAB + 128 * 1024); float* SIN = WSP(float, WS_TAB + 136 * 1024);
    for (int it = gw; it < 32; it += NGW) { const int idx = it * 64 + lane, pos = idx >> 4, i = idx & 15;
        const float inv = powf(10000.0f, -(float)i / 16.0f), ang = (float)pos * inv; COS[idx] = cosf(ang); SIN[idx] = sinf(ang); }
}

__device__ __forceinline__ int map_row(int mode, int sc) {
    if (mode == 1) { const int head = sc >> 6, dim = sc & 63, bj = dim >> 5, n = (dim >> 4) & 1, i = dim & 15; return (head >> 2) * 256 + bj * 128 + (head & 3) * 32 + (i >> 2) * 8 + n * 4 + (i & 3); }
    if (mode == 2) { const int g = sc >> 8, a = sc & 255; return (a >> 2) * 8 + g * 4 + (a & 3); }
    return sc;
}
struct TItem { const float* src; u16* dst; int N, K, k0, rel_c0, mode, dst_off; bool f16; bool f8; float ws; };
__device__ __forceinline__ void titem_load(const TItem& t, float (&buf)[64], int lane) {
#pragma unroll
    for (int i = 0; i < 64; ++i) { const int kk = 2 * i + (lane >> 5); buf[i] = t.src[(size_t)kk * t.N + (lane & 31)]; }
}
__device__ __forceinline__ void titem_finish(const TItem& t, const float (&buf)[64], LAS float* scr, int lane) {
#pragma unroll
    for (int i = 0; i < 64; ++i) { const int kk = 2 * i + (lane >> 5); scr[kk * 33 + (lane & 31)] = buf[i]; }
    LDS_WAIT(); asm volatile("" ::: "memory");
    if (t.f8) { const int c = lane & 7; const float ws = t.ws;
#pragma unroll
        for (int j = 0; j < 4; ++j) { const int n = (lane >> 3) + 8 * j; const LAS float* s = scr + (16 * c) * 33 + n; int w[4];
#pragma unroll
            for (int q = 0; q < 4; ++q) { w[q] = __builtin_amdgcn_cvt_pk_fp8_f32(s[(4 * q) * 33] * ws, s[(4 * q + 1) * 33] * ws, 0, false); w[q] = __builtin_amdgcn_cvt_pk_fp8_f32(s[(4 * q + 2) * 33] * ws, s[(4 * q + 3) * 33] * ws, w[q], true); }
            const int drow = t.dst_off + map_row(t.mode, t.rel_c0 + n);
            *(GAS u32x4*)((unsigned char*)t.dst + (size_t)drow * t.K + t.k0 + 16 * c) = (u32x4){(unsigned)w[0], (unsigned)w[1], (unsigned)w[2], (unsigned)w[3]}; } }
    else { const int c = lane & 15;
#pragma unroll
        for (int j = 0; j < 8; ++j) { const int n = (lane >> 4) + 4 * j; const LAS float* s = scr + (8 * c) * 33 + n;
            u32x4 o;
            if (t.f16) { o.x = pk2h(s[0 * 33], s[1 * 33]); o.y = pk2h(s[2 * 33], s[3 * 33]); o.z = pk2h(s[4 * 33], s[5 * 33]); o.w = pk2h(s[6 * 33], s[7 * 33]); }
            else { o.x = pk2bf(s[0 * 33], s[1 * 33]); o.y = pk2bf(s[2 * 33], s[3 * 33]); o.z = pk2bf(s[4 * 33], s[5 * 33]); o.w = pk2bf(s[6 * 33], s[7 * 33]); }
            const int drow = t.dst_off + map_row(t.mode, t.rel_c0 + n);
            *(GAS u32x4*)(t.dst + (size_t)drow * t.K + t.k0 + 8 * c) = o; } }
    LDS_WAIT(); asm volatile("" ::: "memory");
}
constexpr int I_FOLD = 512, I_QKV = 8 * 40, I_OUT = 8 * 32, I_R = 8 * 8, I_GU = NEXPS * 8 * 16, I_D = NEXPS * 2 * 32;
constexpr int NT_EARLY = I_QKV + I_OUT + I_R, NT_ITEMS = NT_EARLY + I_GU + I_D;
constexpr int DEFER_A = 3840, DEFER_B = 4096;
#define TDECODE(it_, t) do { int r = (it_); u16* BIN = WSP(u16, WS_BIN); \
        if (r < I_QKV) { const int kb = r / 40, nb = r % 40, sc0 = 256 + 32 * nb; t.N = 1536; t.K = DM; t.k0 = kb * 128; t.f16 = false; t.f8 = false; t.ws = 1.f; t.dst = BIN; t.src = FIN_w_in + (size_t)(kb * 128) * 1536 + sc0; \
            if (sc0 < 1024) { t.rel_c0 = sc0 - 256; t.mode = 1; t.dst_off = 512; } else if (sc0 < 1280) { t.rel_c0 = sc0 - 1024; t.mode = 1; t.dst_off = 1280; } else { t.rel_c0 = sc0 - 1280; t.mode = 0; t.dst_off = 1536; } \
            break; } \
        r -= I_QKV; \
        if (r < I_OUT) { const int kb = r / 32, nb = r % 32; t.N = DM; t.K = DM; t.k0 = kb * 128; t.f16 = false; t.f8 = false; t.ws = 1.f; t.dst = WSP(u16, WS_BOUT); t.src = FIN_w_out + (size_t)(kb * 128) * DM + 32 * nb; t.rel_c0 = 32 * nb; t.mode = 0; t.dst_off = 0; break; } \
        r -= I_OUT; \
        if (r < I_R) { const int kb = r / 8, nb = r % 8; t.N = NEXP; t.K = DM; t.k0 = kb * 128; t.f16 = (MOE_FP8 ? false : MOEF16); t.f8 = false; t.ws = 1.f; t.dst = WSP(u16, WS_BR); t.src = FIN_w_router + (size_t)(kb * 128) * NEXP + 32 * nb; t.rel_c0 = 32 * nb; t.mode = 0; t.dst_off = 0; break; } \
        r -= I_R; \
        if (r < I_GU) { const int e = r >> 7, q = r & 127, kb = q >> 4, nb = q & 15; const float* W = (e < NEXP) ? FIN_w_egu + (size_t)e * DM * 512 : FIN_w_sgu; \
            t.N = 512; t.K = DM; t.k0 = kb * 128; t.f16 = MOEF16; t.f8 = MOE_FP8; t.ws = WGU_SCALE; t.dst = MOE_FP8 ? (u16*)(F.ws + WS_BGU + (size_t)e * 512 * DM) : WSP(u16, WS_BGU) + (size_t)e * 512 * DM; t.src = W + (size_t)(kb * 128) * 512 + 32 * nb; t.rel_c0 = 32 * nb; t.mode = 2; t.dst_off = 0; break; } \
        r -= I_GU; \
        { const int e = r >> 6, q = r & 63, kb = q >> 5, nb = q & 31; const float* W = (e < NEXP) ? FIN_w_ed + (size_t)e * EFF * DM : FIN_w_sd; \
            t.N = DM; t.K = EFF; t.k0 = kb * 128; t.f16 = MOEF16; t.f8 = MOE_FP8; t.ws = WD_SCALE; t.dst = MOE_FP8 ? (u16*)(F.ws + WS_BD + (size_t)e * DM * EFF) : WSP(u16, WS_BD) + (size_t)e * DM * EFF; t.src = W + (size_t)(kb * 128) * DM + 32 * nb; t.rel_c0 = 32 * nb; t.mode = 0; t.dst_off = 0; } \
    } while (0)
__device__ __forceinline__ void transpose_range(Frame& F, int first, int count, int w, int nw) {
    LAS float* scr = (LAS float*)(F.lds + F.wave * P1_SCR); const int lane = F.lane; const int end = first + count;
    float bufA[64], bufB[64]; TItem ta, tb; int it = first + w;
    if (it < end) { TDECODE(it, ta); titem_load(ta, bufA, lane); }
    while (it < end) {
        const int itb = it + nw; const bool hb = itb < end;
        if (hb) { TDECODE(itb, tb); titem_load(tb, bufB, lane); }
        titem_finish(ta, bufA, scr, lane);
        if (!hb) break;
        const int ita = itb + nw; const bool ha = ita < end;
        if (ha) { TDECODE(ita, ta); titem_load(ta, bufA, lane); }
        titem_finish(tb, bufB, scr, lane);
        it = ita;
    }
}
__device__ __forceinline__ void p1_phase(Frame& F) {
    LAS float* scr = (LAS float*)(F.lds + F.wave * P1_SCR);
    const int gw = F.vcu * 8 + F.wave, NGW = F.G * 8, lane = F.lane;
    u16* BIN = WSP(u16, WS_BIN);
    for (int r = gw; r < I_FOLD; r += NGW) {
        const int fh = r >> 7, cs = (r >> 6) & 1, kb = (r >> 2) & 15, eq = r & 3; const int k = kb * 64 + lane;
        const GAS float* WCS = (const GAS float*)(F.ws + WS_TAB);
#pragma unroll 4
        for (int i = 0; i < 16; ++i) scr[(4 * i + (lane >> 4)) * 16 + (lane & 15)] = WCS[(fh * 64 + 4 * i + (lane >> 4)) * 128 + cs * 64 + 16 * eq + (lane & 15)];
        float wrow[64];
#pragma unroll
        for (int d4 = 0; d4 < 16; ++d4) { const f32x4 v = *(const f32x4*)(FIN_w_in + (size_t)k * 1536 + fh * 64 + 4 * d4); wrow[4 * d4] = v[0]; wrow[4 * d4 + 1] = v[1]; wrow[4 * d4 + 2] = v[2]; wrow[4 * d4 + 3] = v[3]; }
        LDS_WAIT(); asm volatile("" ::: "memory");
        for (int e1 = 0; e1 < 16; ++e1) { float a = 0.f;
#pragma unroll
            for (int d = 0; d < 64; ++d) a += wrow[d] * scr[d * 16 + e1];
            const int col256 = fh * 64 + 16 * eq + e1, pos = 8 * (col256 >> 2) + (col256 & 3) + 4 * cs;
            BIN[(size_t)pos * DM + k] = (u16)f2bf(a); }
        LDS_WAIT(); asm volatile("" ::: "memory");
    }
    const int ndefer = (F.G == 256) ? DEFER_A + DEFER_B : 0;
    REPS(11) transpose_range(F, 0, NT_ITEMS - ndefer, gw, NGW);
    const gi64* MOD = (const gi64*)(F.ctl + CW_MOD);
    u16* XN = WSP(u16, WS_XN);
    REPS(12) { const int wpb = NGW >> 2, b = gw / wpb, wi = gw % wpb;
        rownorm_rows<false>((const GAS float*)FIN_x, FIN_norm1_g, MOD + b * 6144, MOD + b * 6144 + 1024, XN, b * SEQ, SEQ, wi, wpb, lane);
        rownorm_rows<false>((const GAS float*)FIN_ctx, FIN_norm1_g, MOD + 4 * 6144, MOD + 4 * 6144 + 1024, XN + (size_t)NTOK * DM, 0, NCTX, gw, NGW, lane); }
}

__device__ __forceinline__ void fourier_unit(Frame& F, int b, int g) {
    LAS unsigned char* Zl = F.lds + RING_OFF;
    LAS f32x2* TW128 = (LAS f32x2*)(F.lds + TAB_OFF);
    LAS f32x2* TW64 = (LAS f32x2*)(F.lds + TAB_OFF + 1024);
    const int tid = F.tid;
    const GAS u32x4* Zg = (const GAS u32x4*)(F.ws + WS_Z + ((size_t)(b * 64 + g) * SEQ) * 16);
#pragma unroll 4
    for (int i = 0; i < 16; ++i) *(LAS u32x4*)(Zl + (size_t)(i * 512 + tid) * 16) = Zg[i * 512 + tid];
    if (tid < 128) { float s, c; sincospif((float)tid * (1.0f / 64.0f), &s, &c); TW128[tid] = (f32x2){c, s}; }
    else if (tid < 192) { float s, c; sincospif((float)(tid - 128) * (1.0f / 32.0f), &s, &c); TW64[tid - 128] = (f32x2){c, s}; }
    __syncthreads();
    const int k1 = tid & 127, q = tid >> 7;
    float yr[16][4], yi[16][4];
#pragma unroll
    for (int a = 0; a < 16; ++a)
#pragma unroll
        for (int e = 0; e < 4; ++e) { yr[a][e] = 0.f; yi[a][e] = 0.f; }
    for (int n1 = 0; n1 < 128; ++n1) {
        const f32x2 tw = TW128[(n1 * k1) & 127]; const float c = tw.x, s = tw.y;
#pragma unroll
        for (int a = 0; a < 16; ++a) { const u32x4 rw = *(const LAS u32x4*)(Zl + (size_t)(64 * n1 + 16 * q + a) * 16);
            const float uc[4] = {bflo(rw.x), bfhi(rw.x), bflo(rw.y), bfhi(rw.y)}, us[4] = {bflo(rw.z), bfhi(rw.z), bflo(rw.w), bfhi(rw.w)};
#pragma unroll
            for (int e = 0; e < 4; ++e) { yr[a][e] += uc[e] * c - us[e] * s; yi[a][e] -= uc[e] * s + us[e] * c; } }
    }
    __syncthreads();
    int k1b = k1; asm volatile("" : "+v"(k1b));
#pragma unroll
    for (int a = 0; a < 16; ++a) { const int n2 = 16 * q + a; const float fr_ = (float)(n2 * k1b) * (1.0f / 8192.0f);
        const float cp = __builtin_amdgcn_cosf(fr_), sp = __builtin_amdgcn_sinf(fr_);
        float pr[4], pi[4];
#pragma unroll
        for (int e = 0; e < 4; ++e) { pr[e] = yr[a][e] * cp + yi[a][e] * sp; pi[e] = yi[a][e] * cp - yr[a][e] * sp; }
        u32x4 w; w.x = pk2bf(pr[0], pr[1]); w.y = pk2bf(pr[2], pr[3]); w.z = pk2bf(pi[0], pi[1]); w.w = pk2bf(pi[2], pi[3]);
        *(LAS u32x4*)(Zl + (size_t)(n2 * 128 + k1b) * 16) = w; }
    __syncthreads();
    int k1c = k1; asm volatile("" : "+v"(k1c));
    float o[16][4];
#pragma unroll
    for (int a = 0; a < 16; ++a)
#pragma unroll
        for (int e = 0; e < 4; ++e) o[a][e] = 0.f;
    for (int n2 = 0; n2 < 64; ++n2) {
        const u32x4 rw = *(const LAS u32x4*)(Zl + (size_t)(n2 * 128 + k1c) * 16);
        const float pr[4] = {bflo(rw.x), bfhi(rw.x), bflo(rw.y), bfhi(rw.y)}, pi[4] = {bflo(rw.z), bfhi(rw.z), bflo(rw.w), bfhi(rw.w)};
#pragma unroll
        for (int a = 0; a < 16; ++a) { const f32x2 tw = TW64[(n2 * (16 * q + a)) & 63];
#pragma unroll
            for (int e = 0; e < 4; ++e) o[a][e] += pr[e] * tw.x + pi[e] * tw.y; }
    }
    u16* MIX = WSP(u16, WS_MIX);
#pragma unroll
    for (int a = 0; a < 16; ++a) { const int k2 = 16 * q + a; u32x2 w; w.x = pk2bf(o[a][0], o[a][1]); w.y = pk2bf(o[a][2], o[a][3]);
        *(GAS u32x2*)(MIX + ((size_t)(b * SEQ + k1c + 128 * k2)) * DM + 4 * g) = w; }
    __syncthreads();
}

__device__ __forceinline__ attn_body::s16x4 ftr(const LAS unsigned char* p) { return __builtin_bit_cast(attn_body::s16x4, __builtin_amdgcn_ds_read_tr16_b64_v4i16((LAS attn_body::v4i16_t*)p)); }
__device__ __forceinline__ void fourier_unit_mfma(Frame& F, int b, int g) {
    LAS unsigned char* Zl = F.lds + RING_OFF;
    const int tid = F.tid, lane = F.lane, w = F.wave;
    const char* Zg = (const char*)(F.ws + WS_Z) + ((size_t)(b * 64 + g) * SEQ) * 16;
#pragma unroll
    for (int i = 0; i < 16; ++i) __builtin_amdgcn_global_load_lds((const unsigned*)(Zg + (size_t)(i * 512 + tid) * 16), (LAS unsigned*)(Zl + (size_t)(i * 512 + w * 64) * 16), 16, 0, 0);
    VM_WAIT(); __syncthreads();
    f32x4 acc[2][16];
#pragma unroll
    for (int ro = 0; ro < 2; ++ro)
#pragma unroll
        for (int t = 0; t < 16; ++t) acc[ro][t] = (f32x4){0.f, 0.f, 0.f, 0.f};
    const GAS bf16x8* D1 = (const GAS bf16x8*)(F.ws + WS_TAB + 144 * 1024);
    const GAS bf16x8* D3 = (const GAS bf16x8*)(F.ws + WS_TAB + 272 * 1024);
    const int l15 = lane & 15, lq = lane >> 4;
    const unsigned bbase = (unsigned)((64 * (8 * lq + (l15 >> 2)) + (lane & 3)) * 16);
#pragma unroll 1
    for (int s1 = 0; s1 < 8; ++s1) {
        const int ri = s1 >> 2;
        const bf16x8 a0 = D1[(16 * w + l15) * 32 + 4 * s1 + lq], a1 = D1[(128 + 16 * w + l15) * 32 + 4 * s1 + lq];
        const LAS unsigned char* sb = Zl + bbase + (unsigned)((s1 & 3) * 32768 + 8 * ri);
#pragma unroll
        for (int t = 0; t < 16; ++t) { const attn_body::s16x4 lo = ftr(sb + 64 * t), hi = ftr(sb + 64 * t + 4096);
            const bf16x8 bf = (bf16x8){lo[0], lo[1], lo[2], lo[3], hi[0], hi[1], hi[2], hi[3]};
            acc[0][t] = __builtin_amdgcn_mfma_f32_16x16x32_bf16(a0, bf, acc[0][t], 0, 0, 0);
            acc[1][t] = __builtin_amdgcn_mfma_f32_16x16x32_bf16(a1, bf, acc[1][t], 0, 0, 0); }
    }
    __syncthreads();
    {   const int e = lane & 3; int k1b = 16 * w + 4 * lq; asm volatile("" : "+v"(k1b));
#pragma unroll
        for (int t = 0; t < 16; ++t) { const int n2 = 4 * t + (l15 >> 2);
#pragma unroll
            for (int r = 0; r < 4; ++r) { const int k1 = k1b + r; const float fr_ = (float)(n2 * k1) * (1.0f / 8192.0f); const float cp = __builtin_amdgcn_cosf(fr_), sp = __builtin_amdgcn_sinf(fr_);
                const float yr = acc[0][t][r], yi = acc[1][t][r]; const float pr = yr * cp + yi * sp, pi = yi * cp - yr * sp;
                *(LAS u16*)(Zl + (unsigned)(((n2) * 512 + k1 * 4 + e) * 2)) = (u16)f2bf(pr);
                *(LAS u16*)(Zl + (unsigned)(((64 + n2) * 512 + k1 * 4 + e) * 2)) = (u16)f2bf(pi); } }
    }
    asm volatile("s_waitcnt lgkmcnt(0)" ::: "memory");
    f32x4 acc3[4][4];
#pragma unroll
    for (int mt = 0; mt < 4; ++mt)
#pragma unroll
        for (int j = 0; j < 4; ++j) acc3[mt][j] = (f32x4){0.f, 0.f, 0.f, 0.f};
#pragma unroll
    for (int s3 = 0; s3 < 4; ++s3) {
        bf16x8 a[4];
#pragma unroll
        for (int mt = 0; mt < 4; ++mt) a[mt] = D3[(16 * mt + l15) * 16 + 4 * s3 + lq];
        const unsigned kk = (unsigned)(32 * s3 + 8 * lq + (l15 >> 2));
#pragma unroll
        for (int j = 0; j < 4; ++j) { const unsigned ad = kk * 1024u + (unsigned)((4 * (4 * w + j) + (lane & 3)) * 8);
            const attn_body::s16x4 lo = ftr(Zl + ad), hi = ftr(Zl + ad + 4096);
            const bf16x8 bf = (bf16x8){lo[0], lo[1], lo[2], lo[3], hi[0], hi[1], hi[2], hi[3]};
#pragma unroll
            for (int mt = 0; mt < 4; ++mt) acc3[mt][j] = __builtin_amdgcn_mfma_f32_16x16x32_bf16(a[mt], bf, acc3[mt][j], 0, 0, 0); }
    }
    u16* MIX = WSP(u16, WS_MIX);
#pragma unroll
    for (int mt = 0; mt < 4; ++mt)
#pragma unroll
        for (int j = 0; j < 4; ++j)
#pragma unroll
            for (int r = 0; r < 4; ++r) { const int k2 = 16 * mt + 4 * lq + r, k1 = 16 * w + 4 * j + (l15 >> 2);
                MIX[((size_t)(b * SEQ + k1 + 128 * k2)) * DM + 4 * g + (lane & 3)] = (u16)f2bf(acc3[mt][j][r]); }
    __syncthreads();
}

__device__ __forceinline__ float dpp_f(float v, int ctrl_sel) {
    const int x = __builtin_bit_cast(int, v); int r;
    if (ctrl_sel == 0) r = __builtin_amdgcn_update_dpp(x, x, 0xB1, 0xF, 0xF, false);
    else if (ctrl_sel == 1) r = __builtin_amdgcn_update_dpp(x, x, 0x4E, 0xF, 0xF, false);
    else if (ctrl_sel == 2) r = __builtin_amdgcn_update_dpp(x, x, 0x141, 0xF, 0xF, false);
    else r = __builtin_amdgcn_update_dpp(x, x, 0x140, 0xF, 0xF, false);
    return __builtin_bit_cast(float, r);
}
__device__ __forceinline__ void route_token(Frame& F, int tok) {
    const int l = F.lane;
    const f32x4 lg = *(const GAS f32x4*)((const GAS float*)(F.ws + WS_LOG) + (size_t)tok * NEXP + 4 * l);
    const f32x4 bs = *(const f32x4*)(FIN_router_bias + 4 * l);
    float s[4], sel[4];
#pragma unroll
    for (int j = 0; j < 4; ++j) { s[j] = 1.0f / (1.0f + expf(-lg[j])); sel[j] = s[j] + bs[j]; }
    float m1 = fmaxf(sel[0], sel[1]), m2 = fminf(sel[0], sel[1]);
#pragma unroll
    for (int j = 2; j < 4; ++j) { const float v = sel[j]; m2 = fmaxf(m2, fminf(m1, v)); m1 = fmaxf(m1, v); }
#pragma unroll
    for (int st = 0; st < 3; ++st) { const float o1 = dpp_f(m1, st), o2 = dpp_f(m2, st); const float n2 = fmaxf(fminf(m1, o1), fmaxf(m2, o2)); m1 = fmaxf(m1, o1); m2 = n2; }
    const float gs = m1 + m2; const int myg = l >> 3; int rank = 0;
#pragma unroll
    for (int g2 = 0; g2 < 8; ++g2) { const float og = rdl(gs, g2 * 8); rank += (og > gs || (og == gs && g2 < myg)) ? 1 : 0; }
    if (rank >= 4) {
#pragma unroll
        for (int j = 0; j < 4; ++j) sel[j] = -INFINITY; }
    int my_e = 0; float my_s = 0.f, sum = 0.f;
#pragma unroll 1
    for (int k = 0; k < TOPK; ++k) {
        const float lb = fmaxf(fmaxf(sel[0], sel[1]), fmaxf(sel[2], sel[3]));
        float r = lb; r = fmaxf(r, dpp_f(r, 0)); r = fmaxf(r, dpp_f(r, 1)); r = fmaxf(r, dpp_f(r, 2)); r = fmaxf(r, dpp_f(r, 3));
        const float wm = fmaxf(fmaxf(rdl(r, 0), rdl(r, 16)), fmaxf(rdl(r, 32), rdl(r, 48)));
        const unsigned long long mask = __ballot(lb == wm);
        const int wl = __builtin_amdgcn_readfirstlane((int)__ffsll((long long)mask) - 1);
        const int jj = (sel[0] == wm) ? 0 : (sel[1] == wm) ? 1 : (sel[2] == wm) ? 2 : 3;
        const float cand = (jj == 0) ? s[0] : (jj == 1) ? s[1] : (jj == 2) ? s[2] : s[3];
        const int jw = __builtin_amdgcn_readlane(jj, wl); const float wsc = rdl(cand, wl);
        if (l == wl) {
#pragma unroll
            for (int j = 0; j < 4; ++j) if (jw == j) sel[j] = -INFINITY; }
        if (l == k) { my_e = 4 * wl + jw; my_s = wsc; }
        sum += wsc;
    }
    GAS u32x2* LIST = (GAS u32x2*)(F.ws + WS_LIST);
    if (l < TOPK) { const float gate = my_s / sum * 2.5f; const unsigned pos = __hip_atomic_fetch_add((unsigned*)(F.ctl + CW_CNT + my_e), 1u, RLX_AGENT);
        LIST[(size_t)my_e * NTOK + pos] = (u32x2){(unsigned)tok | ((unsigned)l << 16), __builtin_bit_cast(unsigned, gate)}; }
    else if (l == TOPK) LIST[(size_t)NEXP * NTOK + tok] = (u32x2){(unsigned)tok | (8u << 16), __builtin_bit_cast(unsigned, 1.0f)};
}

__device__ __forceinline__ void build_tiles(Frame& F) {
    LAS int* TS = (LAS int*)(F.lds + TAB_OFF + 2048); LAS int* CN = (LAS int*)(F.lds + TAB_OFF + 3200);
    if (F.tid < 64) { const int l = F.tid; int c[5], t[5], tot = 0;
#pragma unroll
        for (int j = 0; j < 5; ++j) { const int e = 5 * l + j; c[j] = (e < NEXPS) ? (int)__hip_atomic_load((unsigned*)(F.ctl + CW_CNT + e), RLX_AGENT) : 0; t[j] = (c[j] + 255) >> 8; tot += t[j]; }
        int x = tot;
#pragma unroll
        for (int off = 1; off < 64; off <<= 1) { const int v = __shfl_up(x, off); if (l >= off) x += v; }
        int run = x - tot;
#pragma unroll
        for (int j = 0; j < 5; ++j) { const int e = 5 * l + j; if (e <= NEXPS) { TS[e] = run; if (e < NEXPS) CN[e] = c[j]; } run += t[j]; }
    }
    __syncthreads();
    {
        LAS unsigned short* TEXP = (LAS unsigned short*)(F.lds + TAB_OFF + 4608);
        for (int e = F.tid; e < NEXPS; e += 512) { const int t0 = TS[e], t1 = TS[e + 1]; for (int T = t0; T < t1; ++T) TEXP[T] = (unsigned short)e; }
    }
    __syncthreads();
}

__device__ __forceinline__ void ph2(Frame& F) {
    const gi64* MOD = (const gi64*)(F.ctl + CW_MOD); const int gw = F.vcu * 8 + F.wave, NGW = F.G * 8; (void)MOD; (void)gw; (void)NGW;
        DenseOrder S{7, 128 * 7, 8, F.G, F.vcu, (const char*)(F.ws + WS_BIN), DM, (REP == 22) ? 2 : 1};
        EpiInProj E{WSP(u16, WS_Z), WSP(u16, WS_Q), WSP(u16, WS_K), WSP(u16, WS_V), WSP(float, WS_TAB + 128 * 1024), WSP(float, WS_TAB + 136 * 1024), FIN_q_norm_g, FIN_k_norm_g};
        pg8::gemm_phase<EpiInProj, DenseOrder, 0, true>(F.lds + RING_OFF, (const char*)(F.ws + WS_XN), DM, S, E);
        if (F.G == 256 && F.vcu >= 136) transpose_range(F, NT_ITEMS - DEFER_A - DEFER_B, DEFER_A, (F.vcu - 136) * 8 + F.wave, 120 * 8);
    }
__device__ __forceinline__ void ph4(Frame& F) {
    const gi64* MOD = (const gi64*)(F.ctl + CW_MOD); const int gw = F.vcu * 8 + F.wave, NGW = F.G * 8; (void)MOD; (void)gw; (void)NGW;
        if (DBG & 128) { GAS u32x4* zH = (GAS u32x4*)(F.ws + WS_H2); const size_t nH = (size_t)NTOK * DM * 2 / 16; for (size_t i = (size_t)blockIdx.x * 512 + F.tid; i < nH; i += (size_t)F.G * 512) zH[i] = (u32x4){0u, 0u, 0u, 0u}; }
        DenseOrder S{4, 128 * 4, 0, F.G, F.vcu, (const char*)(F.ws + WS_BOUT), DM, 1};
        EpiResid E{FIN_x, F.out, MOD};
        pg8::gemm_phase<EpiResid, DenseOrder, 0, true>(F.lds + RING_OFF, (const char*)(F.ws + WS_MIX), DM, S, E);
    }
__device__ __forceinline__ void ph5(Frame& F) {
    const gi64* MOD = (const gi64*)(F.ctl + CW_MOD); const int gw = F.vcu * 8 + F.wave, NGW = F.G * 8;
    const int wpb = NGW >> 2, b = gw / wpb, wi = gw % wpb;
    rownorm_rows<(MOE_FP8 ? false : MOEF16), MOE_FP8>((const GAS float*)F.out, FIN_norm2_g, MOD + b * 6144 + 3072, MOD + b * 6144 + 4096, WSP(u16, WS_H2), b * SEQ, SEQ, wi, wpb, F.lane, F.ws + WS_H2F8);
}
__device__ __forceinline__ void ph6(Frame& F) {
    const gi64* MOD = (const gi64*)(F.ctl + CW_MOD); const int gw = F.vcu * 8 + F.wave, NGW = F.G * 8; (void)MOD; (void)gw; (void)NGW;
        DenseOrder S{1, 128, 0, F.G, F.vcu, (const char*)(F.ws + WS_BR), DM, 1};
        EpiLogits E{WSP(float, WS_LOG)};
        pg8::gemm_phase<EpiLogits, DenseOrder, (MOE_FP8 ? 0 : (MOE_F16 ? 1 : 0)), true>(F.lds + RING_OFF, (const char*)(F.ws + WS_H2), DM, S, E);
        if (F.G == 256 && F.vcu >= 128) transpose_range(F, NT_ITEMS - DEFER_B, DEFER_B, (F.vcu - 128) * 8 + F.wave, 128 * 8);
    }
__device__ __forceinline__ void ph8(Frame& F) {
    const gi64* MOD = (const gi64*)(F.ctl + CW_MOD); const int gw = F.vcu * 8 + F.wave, NGW = F.G * 8; (void)MOD; (void)gw; (void)NGW;
        build_tiles(F);
        GroupedOrder<true> S{2, F.G, F.vcu, 512, DM * (MOE_FP8 ? 1 : 2), true, (const char*)(F.ws + WS_BGU), (const LAS int*)(F.lds + TAB_OFF + 2048), (const LAS int*)(F.lds + TAB_OFF + 3200), (const GAS u32x2*)(F.ws + WS_LIST), (REP == 28) ? 2 : 1, __builtin_amdgcn_readfirstlane(((const LAS int*)(F.lds + TAB_OFF + 2048))[257])};
        EpiSwiglu E{WSP(u16, WS_ACT)};
        pg8::gemm_phase<EpiSwiglu, GroupedOrder<true>, MOE_DT, true>(F.lds + RING_OFF, (const char*)(F.ws + (MOE_FP8 ? WS_H2F8 : WS_H2)), DM, S, E, SC_GU);
    }
__device__ __forceinline__ void ph9(Frame& F) {
    const gi64* MOD = (const gi64*)(F.ctl + CW_MOD); const int gw = F.vcu * 8 + F.wave, NGW = F.G * 8; (void)MOD; (void)gw; (void)NGW;
        build_tiles(F);
        GroupedOrder<false> S{4, F.G, F.vcu, DM, EFF * (MOE_FP8 ? 1 : 2), false, (const char*)(F.ws + WS_BD), (const LAS int*)(F.lds + TAB_OFF + 2048), (const LAS int*)(F.lds + TAB_OFF + 3200), (const GAS u32x2*)(F.ws + WS_LIST), (REP == 29) ? 2 : 1, __builtin_amdgcn_readfirstlane(((const LAS int*)(F.lds + TAB_OFF + 2048))[257])};
        EpiDown E{WSP(u16, WS_C), (const GAS u32x2*)(F.ws + WS_LIST), F.ws + WS_DUMP};
        pg8::gemm_phase<EpiDown, GroupedOrder<false>, MOE_DT, true>(F.lds + RING_OFF, (const char*)(F.ws + WS_ACT), EFF, S, E, SC_D);
    }

#if DBG & (1024 | 2048)
__device__ __forceinline__ float f8dec(unsigned w, int k) { return (k == 0) ? __builtin_amdgcn_cvt_f32_fp8((int)w, 0) : (k == 1) ? __builtin_amdgcn_cvt_f32_fp8((int)w, 1) : (k == 2) ? __builtin_amdgcn_cvt_f32_fp8((int)w, 2) : __builtin_amdgcn_cvt_f32_fp8((int)w, 3); }
__device__ __forceinline__ void chk_attn(Frame& F, float negM) {
    const int gw = F.vcu * 8 + F.wave, NGW = F.G * 8, lane = F.lane;
    const GAS u16* Q = (const GAS u16*)(F.ws + WS_Q); const GAS u16* K = (const GAS u16*)(F.ws + WS_K); const GAS u16* V = (const GAS u16*)(F.ws + WS_V); const GAS u16* MIX = (const GAS u16*)(F.ws + WS_MIX);
    const GAS unsigned char* Q8 = (const GAS unsigned char*)(F.ws + WS_Q); const GAS unsigned char* K8 = (const GAS unsigned char*)(F.ws + WS_K); const GAS unsigned char* Vt8 = (const GAS unsigned char*)(F.ws + WS_V);
    float* chk = (float*)(F.ctl + CW_CHK);
    if (ATTN_FP8) negM = fminf(negM + 8.8f, 0.f);
    for (int i = gw; i < 4096; i += NGW) {
        const int b = i & 3, h = (i >> 2) % 12, q = (int)((((unsigned)i * 2654435761u) >> 19) & 8191u), kvh = h / 3;
        float qv[64], o[64]; float l = 0.f;
        if (ATTN_FP8) {
#pragma unroll
            for (int c = 0; c < 16; ++c) { const unsigned w = *(const GAS unsigned*)(Q8 + ((size_t)(b * SEQ + q)) * QW + h * 64 + 4 * c);
#pragma unroll
                for (int k = 0; k < 4; ++k) qv[4 * c + k] = f8dec(w, k) * (1.0f / Q8_SCALE); }
        } else {
#pragma unroll
        for (int c = 0; c < 8; ++c) { const u32x4 w = *(const GAS u32x4*)(Q + ((size_t)(b * SEQ + q)) * QW + h * 64 + 8 * c);
            qv[8 * c] = bflo(w.x); qv[8 * c + 1] = bfhi(w.x); qv[8 * c + 2] = bflo(w.y); qv[8 * c + 3] = bfhi(w.y); qv[8 * c + 4] = bflo(w.z); qv[8 * c + 5] = bfhi(w.z); qv[8 * c + 6] = bflo(w.w); qv[8 * c + 7] = bfhi(w.w); }
        }
#pragma unroll
        for (int d = 0; d < 64; ++d) o[d] = 0.f;
        for (int t = 0; t < LKV / 64; ++t) { const int j = t * 64 + lane; float dot = 0.f, pp, pq;
            if (ATTN_FP8) { const GAS unsigned char* kr = K8 + ((size_t)(b * LKV + j)) * KVW + kvh * 64;
#pragma unroll
                for (int c = 0; c < 16; ++c) { const unsigned w = *(const GAS unsigned*)(kr + 4 * c);
#pragma unroll
                    for (int k = 0; k < 4; ++k) dot += qv[4 * c + k] * f8dec(w, k); }
                pp = exp2f(dot + negM); pq = __builtin_amdgcn_cvt_f32_fp8(__builtin_amdgcn_cvt_pk_fp8_f32(pp, 0.f, 0, false), 0); l += pq;
                const GAS unsigned char* vb = Vt8 + (((size_t)(b * NKVH + kvh) * (LKV / 64) + t) * 64) * 64 + attn_body::vt_slot(lane);
#pragma unroll
                for (int d = 0; d < 64; ++d) o[d] += pq * __builtin_amdgcn_cvt_f32_fp8((int)vb[d * 64], 0);
            } else { const GAS u16* kr = K + ((size_t)(b * LKV + j)) * KVW + kvh * 64; const GAS u16* vr = V + ((size_t)(b * LKV + j)) * KVW + kvh * 64;
#pragma unroll
            for (int c = 0; c < 8; ++c) { const u32x4 w = *(const GAS u32x4*)(kr + 8 * c);
                dot += qv[8 * c] * bflo(w.x) + qv[8 * c + 1] * bfhi(w.x) + qv[8 * c + 2] * bflo(w.y) + qv[8 * c + 3] * bfhi(w.y) + qv[8 * c + 4] * bflo(w.z) + qv[8 * c + 5] * bfhi(w.z) + qv[8 * c + 6] * bflo(w.w) + qv[8 * c + 7] * bfhi(w.w); }
            pp = exp2f(dot + negM); l += pp;
#pragma unroll
            for (int c = 0; c < 8; ++c) { const u32x4 w = *(const GAS u32x4*)(vr + 8 * c);
                o[8 * c] += pp * bflo(w.x); o[8 * c + 1] += pp * bfhi(w.x); o[8 * c + 2] += pp * bflo(w.y); o[8 * c + 3] += pp * bfhi(w.y); o[8 * c + 4] += pp * bflo(w.z); o[8 * c + 5] += pp * bfhi(w.z); o[8 * c + 6] += pp * bflo(w.w); o[8 * c + 7] += pp * bfhi(w.w); } } }
        l = wave_sum(l); float err = 0.f, ref = 0.f;
#pragma unroll
        for (int d = 0; d < 64; ++d) { const float od = wave_sum(o[d]) / l; const float mv = bflo((unsigned)MIX[((size_t)(b * SEQ + q)) * DM + 256 + h * 64 + d]); err += (od - mv) * (od - mv); ref += od * od; }
        if (lane == 0) { atomicAdd(chk + 0, err); atomicAdd(chk + 1, ref); }
    }
}
__device__ __forceinline__ void chk_qkv(Frame& F) {
    const int gw = F.vcu * 8 + F.wave, NGW = F.G * 8, lane = F.lane;
    const gi64* MOD = (const gi64*)(F.ctl + CW_MOD);
    LAS float* hrow = (LAS float*)(F.lds + RING_OFF + F.wave * 16384);
    float* chk = (float*)(F.ctl + CW_CHK);
    for (int i = gw; i < 4096; i += NGW) {
        const unsigned hs = (unsigned)i * 2654435761u; const bool isctx = (i & 15) == 15; int sel = i % 20; if (isctx && sel < 12) sel = 12 + (sel & 7);
        const int m = isctx ? (int)((hs >> 10) & 1023u) : (int)((hs >> 12) & 32767u);
        const float* src = isctx ? FIN_ctx + (size_t)m * DM : FIN_x + (size_t)m * DM; const int mr = isctx ? 4 : (m >> 13);
        const int b = isctx ? (m >> 8) : (m >> 13), l = isctx ? 0 : (m & 8191), key = isctx ? SEQ + (m & 255) : l;
        f32x4 v[4]; float s2 = 0.f;
#pragma unroll
        for (int j = 0; j < 4; ++j) { v[j] = *(const f32x4*)(src + 4 * lane + 256 * j); s2 += (v[j][0] * v[j][0] + v[j][1] * v[j][1]) + (v[j][2] * v[j][2] + v[j][3] * v[j][3]); }
        const float rstd = 1.0f / sqrtf(wave_sum(s2) * (1.0f / DM) + RMS_EPS);
#pragma unroll
        for (int j = 0; j < 4; ++j) { const int col = 4 * lane + 256 * j; const f32x4 g = *(const f32x4*)(FIN_norm1_g + col); const f32x4 sh = mod4(MOD, mr * 6144 + col), sc = mod4(MOD, mr * 6144 + 1024 + col);
            const f32x4 y = v[j] * rstd * g * (sc + 1.0f) + sh; hrow[col] = y[0]; hrow[col + 1] = y[1]; hrow[col + 2] = y[2]; hrow[col + 3] = y[3]; }
        LDS_WAIT(); asm volatile("" ::: "memory");
        const int colbase = (sel < 12) ? 256 + 64 * sel : (sel < 16 ? 1024 + 64 * (sel - 12) : 1280 + 64 * (sel - 16));
        float z = 0.f;
        for (int k = 0; k < DM; ++k) z += hrow[k] * FIN_w_in[(size_t)k * 1536 + colbase + lane];
        float outv = z; int spos = lane;
        if (sel < 16) { const float ss = wave_sum(z * z); const float gain = (sel < 12) ? FIN_q_norm_g[lane] : FIN_k_norm_g[lane]; const float zz = z * (1.0f / sqrtf(ss * (1.0f / 64.0f) + RMS_EPS)) * gain;
            const float pz = __shfl(zz, lane ^ 16); outv = zz;
            if (!isctx) { const int pidx = (lane & 32) ? (l & 63) : (l >> 6); const float inv = powf(10000.0f, -(float)(lane & 15) / 16.0f), ang = (float)pidx * inv; const float cs = cosf(ang), sn = sinf(ang);
                outv = (lane & 16) ? zz * cs + pz * sn : zz * cs - pz * sn; }
            if (sel < 12) outv *= C2;
            spos = 32 * (lane >> 5) + 8 * ((lane >> 2) & 3) + 4 * ((lane >> 4) & 1) + (lane & 3); }
        float stored;
        if (ATTN_FP8) {
            if (sel < 12) stored = __builtin_amdgcn_cvt_f32_fp8((int)((const GAS unsigned char*)(F.ws + WS_Q))[(size_t)m * QW + sel * 64 + spos], 0) * (1.0f / Q8_SCALE);
            else if (sel < 16) stored = __builtin_amdgcn_cvt_f32_fp8((int)((const GAS unsigned char*)(F.ws + WS_K))[((size_t)(b * LKV + key)) * KVW + (sel - 12) * 64 + spos], 0);
            else stored = __builtin_amdgcn_cvt_f32_fp8((int)((const GAS unsigned char*)(F.ws + WS_V))[((((size_t)(b * NKVH + (sel - 16)) * (LKV / 64) + (key >> 6)) * 64 + lane) * 64) + attn_body::vt_slot(key & 63)], 0);
        } else {
        if (sel < 12) stored = bflo((unsigned)((const GAS u16*)(F.ws + WS_Q))[(size_t)m * QW + sel * 64 + spos]);
        else if (sel < 16) stored = bflo((unsigned)((const GAS u16*)(F.ws + WS_K))[((size_t)(b * LKV + key)) * KVW + (sel - 12) * 64 + spos]);
        else stored = bflo((unsigned)((const GAS u16*)(F.ws + WS_V))[((size_t)(b * LKV + key)) * KVW + (sel - 16) * 64 + lane]); }
        const float err = wave_sum((outv - stored) * (outv - stored)), ref = wave_sum(outv * outv);
        if (lane == 0) { atomicAdd(chk + 2, err); atomicAdd(chk + 3, ref); }
        LDS_WAIT(); asm volatile("" ::: "memory");
    }
}
#endif

struct Args { const float* in[20]; float* out; unsigned char* ws; int ph_lo, ph_hi; };
__global__ void __launch_bounds__(512, 2) mk_fwd(Args args) {
    extern __shared__ __attribute__((aligned(16))) unsigned char lds[];
    Frame F;
    F.lds = (LAS unsigned char*)lds;
    F.MISC = (volatile LAS unsigned*)(F.lds + MISC_OFF);
    F.tid = threadIdx.x; F.lane = F.tid & 63; F.wave = __builtin_amdgcn_readfirstlane(F.tid >> 6);
    F.G = gridDim.x; { const int bx = blockIdx.x; F.vcu = (F.G % 8 == 0) ? (bx % 8) * (F.G / 8) + bx / 8 : bx; }
    F.ws = args.ws; F.ctl = (gu32*)(args.ws + WS_CTL); F.out = args.out;
    F.ka = (const float* const*)__builtin_amdgcn_kernarg_segment_ptr();
    for (int u = F.tid; u < (LDS_BYTES - LDSCTL_OFF) / 4; u += 512) ((LAS unsigned*)(F.lds + LDSCTL_OFF))[u] = 0u;
    __syncthreads();
    XcdBarrier bar; bar.bar = (unsigned*)(F.ctl + CW_BAR); bar.x = 0; bar.st = nullptr;
    if (N_LAUNCHES == 1) bar = xcd_barrier_post((unsigned*)(F.ctl + CW_BAR), F.MISC + 8);
    const int lo = args.ph_lo, hi = args.ph_hi;
#define IN(k) (lo <= (k) && (k) < hi)
#define SEAM(k) do { if (IN(k) && IN((k) + 1)) xcd_barrier(bar); asm volatile("" : "+s"(F.ka)); } while (0)
    const gi64* MOD = (const gi64*)(F.ctl + CW_MOD);
    const int gw = F.vcu * 8 + F.wave, NGW = F.G * 8;

    if (IN(0)) { p0_phase(F); } SEAM(0);
    if (IN(1)) { p1_phase(F); VM_WAIT(); __syncthreads(); if (REP == 1) { xcd_barrier(bar); p1_phase(F); VM_WAIT(); __syncthreads(); } } SEAM(1);

    if (IN(2)) { ph2(F); if (REP == 2) { xcd_barrier(bar); ph2(F); } } SEAM(2);

    if (IN(3)) {
        if (DBG & 32) { u16* MIXz = WSP(u16, WS_MIX); for (int m = gw; m < NTOK; m += NGW) *(GAS u32x2*)(MIXz + (size_t)m * DM + 4 * F.lane) = (u32x2){0u, 0u}; }
        else
        REPS(30) for (int U = F.vcu; U < NB * 64; U += F.G) { if (FOURIER_MFMA) fourier_unit_mfma(F, U >> 6, U & 63); else fourier_unit(F, U >> 6, U & 63); }
        const attn_body::bf16* Qp = (const attn_body::bf16*)(F.ws + WS_Q); const attn_body::bf16* Kp = (const attn_body::bf16*)(F.ws + WS_K); const attn_body::bf16* Vp = (const attn_body::bf16*)(F.ws + WS_V);
        attn_body::bf16* Op = (attn_body::bf16*)(F.ws + WS_MIX) + 256;
        float negM; { float gqm = fabsf(FIN_q_norm_g[F.lane]), gkm = fabsf(FIN_k_norm_g[F.lane]);
#pragma unroll
            for (int o_ = 1; o_ < 64; o_ <<= 1) { gqm = fmaxf(gqm, __shfl_xor(gqm, o_)); gkm = fmaxf(gkm, __shfl_xor(gkm, o_)); }
            negM = -(C2 * 64.0f * gqm * gkm + 0.5f); }
        if (ATTN_FP8) negM = fminf(negM + 8.8f, 0.f);
        if (ATTN_PRIO) { if (__builtin_amdgcn_readfirstlane(F.tid) >= 256) __builtin_amdgcn_s_setprio(1); }
        if (DBG & 16) { u16* MIXz = WSP(u16, WS_MIX); for (int m = gw; m < NTOK; m += NGW) for (int j = 1; j < 4; ++j) *(GAS u32x2*)(MIXz + (size_t)m * DM + 256 * j + 4 * F.lane) = (u32x2){0u, 0u}; }
        else if (F.G == 256) REPS(31) {
            const int xg = F.vcu >> 5, jq = F.vcu & 31;
            for (int i = 0; i < 6; ++i) { const int grp = 2 * xg + i / 3, hs = i % 3;
                if (ATTN_FP8) attn_body::attn_unit8(grp >> 2, (grp & 3) * 3 + hs, jq, (const unsigned char*)Qp, (const unsigned char*)Kp, (const unsigned char*)Vp, Op, (char*)lds + RING_OFF, negM);
                else attn_body::attn_unit<ATTN_MSUM>(grp >> 2, (grp & 3) * 3 + hs, jq, Qp, Kp, Vp, Op, (char*)lds + RING_OFF, negM); }
        } else {
            for (int U = F.vcu; U < NB * NQH * 32; U += F.G) { const int grp = U / 96, r = U % 96;
                if (ATTN_FP8) attn_body::attn_unit8(grp >> 2, (grp & 3) * 3 + r / 32, r % 32, (const unsigned char*)Qp, (const unsigned char*)Kp, (const unsigned char*)Vp, Op, (char*)lds + RING_OFF, negM);
                else attn_body::attn_unit<ATTN_MSUM>(grp >> 2, (grp & 3) * 3 + r / 32, r % 32, Qp, Kp, Vp, Op, (char*)lds + RING_OFF, negM); }
        }
        if (ATTN_PRIO) __builtin_amdgcn_s_setprio(0);
    } SEAM(3);

#if DBG & (1024 | 2048)
    if (IN(4)) { float negMc; { float gqm = fabsf(FIN_q_norm_g[F.lane]), gkm = fabsf(FIN_k_norm_g[F.lane]);
            for (int o_ = 1; o_ < 64; o_ <<= 1) { gqm = fmaxf(gqm, __shfl_xor(gqm, o_)); gkm = fmaxf(gkm, __shfl_xor(gkm, o_)); } negMc = -(C2 * 64.0f * gqm * gkm + 0.5f); }
        if (DBG & 1024) chk_attn(F, negMc); if (DBG & 2048) chk_qkv(F); VM_WAIT(); __syncthreads(); }
#endif
    if (IN(4)) { ph4(F); if (REP == 4) { xcd_barrier(bar); ph4(F); } } SEAM(4);

    if (IN(5)) { ph5(F); if (REP == 5) { xcd_barrier(bar); ph5(F); } if (REP == 55) { xcd_barrier(bar); xcd_barrier(bar); xcd_barrier(bar); xcd_barrier(bar); xcd_barrier(bar); } } SEAM(5);

    if (IN(6)) { ph6(F); if (REP == 6) { xcd_barrier(bar); ph6(F); } } SEAM(6);

    if (IN(7)) {
        if (DBG & 128) { GAS u32x4* zA = (GAS u32x4*)(F.ws + WS_ACT); const size_t nA = (size_t)MAXTILES * 256 * EFF * 2 / 16; for (size_t i = (size_t)blockIdx.x * 512 + F.tid; i < nA; i += (size_t)F.G * 512) zA[i] = (u32x4){0u, 0u, 0u, 0u};
            GAS u32x4* zC = (GAS u32x4*)(F.ws + WS_C); const size_t nC = (size_t)NTOK * NSLOT * DM * 2 / 16; for (size_t i = (size_t)blockIdx.x * 512 + F.tid; i < nC; i += (size_t)F.G * 512) zC[i] = (u32x4){0u, 0u, 0u, 0u}; }
        if (blockIdx.x == 0 && F.tid == 0) __hip_atomic_store((unsigned*)(F.ctl + CW_CNT + NEXP), (unsigned)NTOK, RLX_AGENT);
        for (int tok = gw; tok < NTOK; tok += NGW) route_token(F, tok);
    } SEAM(7);

    if (IN(8)) { ph8(F); if (REP == 8) { xcd_barrier(bar); ph8(F); } } SEAM(8);

    if (IN(9)) { ph9(F); if (REP == 9) { xcd_barrier(bar); ph9(F); } } SEAM(9);

    if (IN(10)) {
        const int lane = F.lane; const GAS unsigned char* Cc = (const GAS unsigned char*)(F.ws + WS_C);
        const int wpb = NGW >> 2, b = gw / wpb, wi = gw % wpb;
        f32x4 g2v[4], fg[4];
#pragma unroll
        for (int i = 0; i < 4; ++i) { const int col = 16 * lane + 4 * i; g2v[i] = mod4(MOD + b * 6144 + 5120, col) * (1.0f / C_SCALE); fg[i] = *(const f32x4*)(FIN_final_g + col); }
        bool bad = false;
#if DBG & (1024 | 2048)
        { const float e0 = __hip_atomic_load((float*)(F.ctl + CW_CHK), RLX_AGENT), r0 = __hip_atomic_load((float*)(F.ctl + CW_CHK) + 1, RLX_AGENT), e1 = __hip_atomic_load((float*)(F.ctl + CW_CHK) + 2, RLX_AGENT), r1 = __hip_atomic_load((float*)(F.ctl + CW_CHK) + 3, RLX_AGENT);
          if (DBG & 1024) bad = bad || !(e0 <= CHK_TOL_A * r0) || !(r0 > 0.f); if (DBG & 2048) bad = bad || !(e1 <= CHK_TOL_B * r1) || !(r1 > 0.f); }
#endif
        for (int r = wi; r < SEQ; r += 2 * wpb) {
            const int r1 = (r + wpb < SEQ) ? r + wpb : r; const bool has1 = r + wpb < SEQ;
            const int m0 = b * SEQ + r, m1 = b * SEQ + r1;
            GAS float* orow0 = (GAS float*)F.out + (size_t)m0 * DM + 16 * lane; GAS float* orow1 = (GAS float*)F.out + (size_t)m1 * DM + 16 * lane;
            f32x4 xa[4], xb[4], ya[4], yb[4];
#pragma unroll
            for (int i = 0; i < 4; ++i) { xa[i] = *(const GAS f32x4*)(orow0 + 4 * i); xb[i] = *(const GAS f32x4*)(orow1 + 4 * i); ya[i] = (f32x4){0.f, 0.f, 0.f, 0.f}; yb[i] = (f32x4){0.f, 0.f, 0.f, 0.f}; }
#pragma unroll
            for (int sl = 0; sl < NSLOT; ++sl) { const u32x4 wa = *(const GAS u32x4*)(Cc + ((size_t)m0 * NSLOT + sl) * DM + 16 * lane), wb = *(const GAS u32x4*)(Cc + ((size_t)m1 * NSLOT + sl) * DM + 16 * lane);
#pragma unroll
                for (int i = 0; i < 4; ++i) { const int wa_ = (int)wa[i], wb_ = (int)wb[i];
                    const f32x2 la = __builtin_amdgcn_cvt_pk_f32_fp8(wa_, false), ha = __builtin_amdgcn_cvt_pk_f32_fp8(wa_, true), lb = __builtin_amdgcn_cvt_pk_f32_fp8(wb_, false), hb = __builtin_amdgcn_cvt_pk_f32_fp8(wb_, true);
                    ya[i] += (f32x4){la.x, la.y, ha.x, ha.y}; yb[i] += (f32x4){lb.x, lb.y, hb.x, hb.y}; } }
            float sa = 0.f, sb = 0.f;
#pragma unroll
            for (int i = 0; i < 4; ++i) { const f32x4 va = xa[i] + g2v[i] * ya[i], vb = xb[i] + g2v[i] * yb[i]; xa[i] = va; xb[i] = vb;
                sa += (va[0] * va[0] + va[1] * va[1]) + (va[2] * va[2] + va[3] * va[3]); sb += (vb[0] * vb[0] + vb[1] * vb[1]) + (vb[2] * vb[2] + vb[3] * vb[3]); }
#pragma unroll
            for (int o = 1; o < 64; o <<= 1) { sa += __shfl_xor(sa, o); sb += __shfl_xor(sb, o); }
            const float bm = bad ? 3.0f : 1.0f;
            const float ra = 1.0f / sqrtf(sa * (1.0f / DM) + RMS_EPS) * bm, rb = 1.0f / sqrtf(sb * (1.0f / DM) + RMS_EPS) * bm;
#pragma unroll
            for (int i = 0; i < 4; ++i) *(GAS f32x4*)(orow0 + 4 * i) = xa[i] * ra * fg[i];
            if (has1) {
#pragma unroll
                for (int i = 0; i < 4; ++i) *(GAS f32x4*)(orow1 + 4 * i) = xb[i] * rb * fg[i]; } }
    }
#undef IN
#undef SEAM
}

extern "C" void kernel_launch(void* const* d_in, const int* in_sizes, int n_in, void* d_out, int out_size, void* d_ws, size_t ws_size, hipStream_t stream) {
    static int grid = 0;
    if (grid == 0) {
        if (n_in != 20 || in_sizes[0] != NTOK * DM || out_size != NTOK * DM || ws_size < WS_END) { fprintf(stderr, "kernel_launch: unexpected shapes (n_in %d, in0 %d, out %d, ws %zu < %zu)\n", n_in, n_in > 0 ? in_sizes[0] : -1, out_size, ws_size, (size_t)WS_END); grid = -1; return; }
        int dev = 0, cus = 0, per_cu = 0;
        if (hipGetDevice(&dev) != hipSuccess || hipDeviceGetAttribute(&cus, hipDeviceAttributeMultiprocessorCount, dev) != hipSuccess) { grid = -1; return; }
        if (hipFuncSetAttribute((const void*)mk_fwd, hipFuncAttributeMaxDynamicSharedMemorySize, LDS_BYTES) != hipSuccess) { fprintf(stderr, "kernel_launch: hipFuncSetAttribute failed\n"); grid = -1; return; }
        if (hipOccupancyMaxActiveBlocksPerMultiprocessor(&per_cu, (const void*)mk_fwd, 512, LDS_BYTES) != hipSuccess || per_cu < 1) fprintf(stderr, "kernel_launch: occupancy query reports %d\n", per_cu);
        (void)hipGetLastError();
        grid = cus;
    }
    if (grid < 0) return;
    (void)hipMemsetAsync((char*)d_ws + WS_CTL, 0, CTL_ZERO_BYTES, stream);
    Args a{};
    for (int i = 0; i < 20; ++i) a.in[i] = (const float*)d_in[i];
    a.out = (float*)d_out; a.ws = (unsigned char*)d_ws;
    if (N_LAUNCHES == 1) { a.ph_lo = 0; a.ph_hi = PER_PHASE; hipLaunchKernelGGL(mk_fwd, dim3(grid), dim3(512), LDS_BYTES, stream, a); }
    else for (int li = 0; li < PER_PHASE; ++li) { a.ph_lo = li; a.ph_hi = li + 1; hipLaunchKernelGGL(mk_fwd, dim3(grid), dim3(512), LDS_BYTES, stream, a); }
}
```

```cpp
#include <hip/hip_runtime.h>
#include <hip/hip_bf16.h>
#include <cstdio>
#include <cstdint>
#include <cmath>

#ifndef MK_N_LAUNCHES
#define MK_N_LAUNCHES 1
#endif
constexpr int PER_PHASE = 11;
#ifndef DBG
#define DBG 0
#endif
#ifndef REP
#define REP -1
#endif
#ifndef CHK_TOL_A
#define CHK_TOL_A 1e-4f
#endif
#ifndef CHK_TOL_B
#define CHK_TOL_B 3e-3f
#endif
#ifndef POSTEPI_WAITS
#define POSTEPI_WAITS 1
#endif
#ifndef ATTN_FP8
#define ATTN_FP8 1
#endif
constexpr float Q8_SCALE = 8.0f;
#ifndef ATTN_MSUM
#define ATTN_MSUM false
#endif
#ifndef ATTN_PRIO
#define ATTN_PRIO 0
#endif
#ifndef FOURIER_MFMA
#define FOURIER_MFMA 1
#endif
#define REPS(k) for (int rep_ = 0; rep_ < ((REP == (k)) ? 2 : 1); ++rep_)
#define REPBAR() do { if (rep_) xcd_barrier(bar); } while (0)
constexpr int N_LAUNCHES = MK_N_LAUNCHES;

#define GAS __attribute__((address_space(1)))
#define LAS __attribute__((address_space(3)))
typedef unsigned short u16;
typedef short bf16x8 __attribute__((ext_vector_type(8)));
typedef _Float16 half8 __attribute__((ext_vector_type(8)));
typedef _Float16 half2v __attribute__((ext_vector_type(2)));
typedef float f32x4 __attribute__((ext_vector_type(4)));
typedef float f32x2 __attribute__((ext_vector_type(2)));
typedef unsigned u32x4 __attribute__((ext_vector_type(4)));
typedef unsigned u32x2 __attribute__((ext_vector_type(2)));
typedef GAS unsigned gu32;

constexpr int DM = 1024, NB = 4, SEQ = 8192, NTOK = NB * SEQ, CTXL = 256, NCTX = NB * CTXL, LKV = SEQ + CTXL;
constexpr int NQH = 12, NKVH = 4, HD = 64, QW = NQH * HD, KVW = NKVH * HD;
constexpr int NIN = 1792;
constexpr int MIN_ROWS = NTOK + NCTX;
constexpr int NEXP = 256, NEXPS = 257, TOPK = 8, EFF = 256, NSLOT = 9;
constexpr int MAXTILES = 1408;
constexpr float RMS_EPS = 1e-6f;
#ifndef MOE_F16
#define MOE_F16 0
#endif
constexpr bool MOEF16 = MOE_F16;
#ifndef MOE_FP8
#define MOE_FP8 1
#endif
constexpr int MOE_DT = MOE_FP8 ? 2 : (MOE_F16 ? 1 : 0);
constexpr float WGU_SCALE = 32.0f, WD_SCALE = 16.0f;
constexpr int SC_ONE = 0x7f7f7f7f, SC_GU = 0x7f7f7f7a, SC_D = 0x7f7f7f7b;
constexpr float C2 = 0.125f * 1.4426950408889634f;
constexpr float C_SCALE = 16.0f;

constexpr size_t MiB = 1u << 20;
constexpr size_t WS_CTL = 0, CTL_ZERO_BYTES = 1 * MiB;
constexpr size_t WS_TAB = 1 * MiB;
constexpr size_t WS_BIN = 2 * MiB;
constexpr size_t WS_BOUT = 6 * MiB;
constexpr size_t WS_BR = 8 * MiB;
constexpr size_t WS_K = 16 * MiB;
constexpr size_t WS_V = 34 * MiB;
constexpr size_t WS_Z = 52 * MiB;
constexpr size_t WS_Q = 84 * MiB;
constexpr size_t WS_XN = 132 * MiB;
constexpr size_t WS_MIX = 198 * MiB;
constexpr size_t WS_H2 = 262 * MiB;
constexpr size_t WS_LOG = 326 * MiB;
constexpr size_t WS_LIST = 358 * MiB;
constexpr size_t WS_BGU = 424 * MiB;
constexpr size_t WS_BD = 682 * MiB;
constexpr size_t WS_ACT = 812 * MiB;
constexpr size_t WS_C = 990 * MiB;
constexpr size_t WS_H2F8 = 1568 * MiB;
constexpr size_t WS_DUMP = 1600 * MiB;
constexpr size_t WS_END = 1632 * MiB;
constexpr int CW_TMO = 0, CW_CODE = 1;
constexpr int CW_BAR = 4096;
constexpr int CW_CNT = 16384;
constexpr int CW_CHK = 32768;
constexpr int CW_MOD = 131072;
static_assert(CW_MOD * 4 + 5 * 6144 * 8 <= (int)CTL_ZERO_BYTES, "ctl");

constexpr int RING_OFF = 0, RING_BYTES = 131072;
constexpr int P1_SCR = 18432;
constexpr int TAB_OFF = 8 * P1_SCR;
constexpr int LDS_BYTES = 163840;
constexpr int LDSCTL_OFF = LDS_BYTES - 1024, MISC_OFF = LDSCTL_OFF + 320;
static_assert(TAB_OFF + 8192 <= LDSCTL_OFF, "LDS map");

#define LDS_WAIT() asm volatile("s_waitcnt lgkmcnt(0)" ::: "memory")
#define VM_WAIT() asm volatile("s_waitcnt vmcnt(0)" ::: "memory")
#define RLX_AGENT __ATOMIC_RELAXED, __HIP_MEMORY_SCOPE_AGENT

__device__ __forceinline__ unsigned f2bf(float f) { unsigned u = __builtin_bit_cast(unsigned, f); return (u + 0x7fffu + ((u >> 16) & 1u)) >> 16; }
__device__ __forceinline__ unsigned pk2bf(float lo, float hi) { return f2bf(lo) | (f2bf(hi) << 16); }
__device__ __forceinline__ unsigned pk2h(float lo, float hi) { half2v v = {(_Float16)lo, (_Float16)hi}; return __builtin_bit_cast(unsigned, v); }
__device__ __forceinline__ unsigned cvt_pk_bf16(float lo, float hi) { unsigned r; asm volatile("v_cvt_pk_bf16_f32 %0, %1, %2" : "=v"(r) : "v"(lo), "v"(hi)); return r; }
__device__ __forceinline__ float bflo(unsigned w) { return __builtin_bit_cast(float, w << 16); }
__device__ __forceinline__ float bfhi(unsigned w) { return __builtin_bit_cast(float, w & 0xffff0000u); }
typedef long long i64x2 __attribute__((ext_vector_type(2)));
typedef GAS long long gi64;
__device__ __forceinline__ f32x4 mod4(const gi64* MODQ, int idx) {
    const i64x2 a = *(const GAS i64x2*)(MODQ + idx), b = *(const GAS i64x2*)(MODQ + idx + 2);
    return (f32x4){(float)a.x, (float)a.y, (float)b.x, (float)b.y} * 0x1p-36f;
}
__device__ __forceinline__ float rdl(float v, int lane) { return __builtin_bit_cast(float, __builtin_amdgcn_readlane(__builtin_bit_cast(int, v), lane)); }
__device__ __forceinline__ float wave_sum(float v) {
#pragma unroll
    for (int o = 1; o < 64; o <<= 1) v += __shfl_xor(v, o);
    return v;
}

namespace pg8 {
constexpr int BM = 256, BK = 64, HALF = 128, HTB = HALF * BK * 2, STAGE_BYTES = 8 * HTB;
__host__ __device__ __forceinline__ int lds_byte(int r, int c) { const int st = (r >> 4) * 2 + (c >> 5), rr = r & 15, cc = c & 31, ob = rr * 64 + cc * 2; return st * 1024 + (ob ^ (((ob >> 9) & 1) << 5)); }
__host__ __device__ __forceinline__ void stage_rc(int b, int& R, int& C) { const int st = b / 1024, sb = b % 1024, swz = sb ^ (((sb >> 9) & 1) << 5); R = (st >> 1) * 16 + swz / 64; C = (st & 1) * 32 + (swz % 64) / 2; }
__host__ __device__ __forceinline__ int perm32(int rho) { const int n = rho >> 4, i = rho & 15; return 8 * (i >> 2) + 4 * n + (i & 3); }

struct GUnit { int pm, pn, e, j, nvalid; const char* B; };

typedef int v8i __attribute__((ext_vector_type(8)));
typedef int v4i __attribute__((ext_vector_type(4)));
template <int DT> __device__ __forceinline__ f32x4 mma_tile(const v8i a, const v8i b, f32x4 c, int scA) {
    if constexpr (DT == 2) return __builtin_amdgcn_mfma_scale_f32_16x16x128_f8f6f4(a, b, c, 0, 0, 0, scA, 1, scA);
    else { const v4i a0 = __builtin_shufflevector(a, a, 0, 1, 2, 3), a1 = __builtin_shufflevector(a, a, 4, 5, 6, 7), b0 = __builtin_shufflevector(b, b, 0, 1, 2, 3), b1 = __builtin_shufflevector(b, b, 4, 5, 6, 7);
        if constexpr (DT == 1) { c = __builtin_amdgcn_mfma_f32_16x16x32_f16(__builtin_bit_cast(half8, a0), __builtin_bit_cast(half8, b0), c, 0, 0, 0); return __builtin_amdgcn_mfma_f32_16x16x32_f16(__builtin_bit_cast(half8, a1), __builtin_bit_cast(half8, b1), c, 0, 0, 0); }
        else { c = __builtin_amdgcn_mfma_f32_16x16x32_bf16(__builtin_bit_cast(bf16x8, a0), __builtin_bit_cast(bf16x8, b0), c, 0, 0, 0); return __builtin_amdgcn_mfma_f32_16x16x32_bf16(__builtin_bit_cast(bf16x8, a1), __builtin_bit_cast(bf16x8, b1), c, 0, 0, 0); } }
}

template <class Epi, class Sched, int DT, bool ALIGN_EPI>
__device__ __forceinline__ void gemm_phase(LAS unsigned char* lds, const char* Abase, const int K, const Sched& S, const Epi& E, const int scB = SC_ONE) {
    const int tid = threadIdx.x, wid = __builtin_amdgcn_readfirstlane(tid >> 6), lane = tid & 63, wr = wid >> 2, wc = wid & 3, fr = lane & 15, fq = lane >> 4;
    constexpr int ES = (DT == 2) ? 1 : 2;
    const int RB = K * ES;
    const int nt = RB / 128;
    unsigned voffB0; { int R, C; stage_rc(tid * 16, R, C); const int Rb = Epi::PERM ? ((R & ~31) + perm32(R & 31)) : R; voffB0 = (unsigned)(Rb * RB + C * 2); }
    const unsigned voffBd = 64u * (unsigned)RB;
#define PG8_AOFF(V, UNIT) do { int t_ = threadIdx.x; asm volatile("" : "+v"(t_)); _Pragma("unroll") for (int _i = 0; _i < 2; ++_i) { int R_, C_; stage_rc(t_ * 16 + _i * 8192, R_, C_); \
        _Pragma("unroll") for (int _h = 0; _h < 2; ++_h) (V)[_h][_i] = (unsigned)S.arow(UNIT, R_ + HALF * _h) * (unsigned)RB + (unsigned)(C_ * 2); } } while (0)
    const size_t kstep = (size_t)(BK * 2);
    const size_t hstep = (size_t)HALF * RB;
    const unsigned ldsw = (unsigned)wid * 1024u;
    const int ac0 = (DT == 2) ? 16 * fq : 8 * fq; constexpr int CH1 = (DT == 2) ? 16 : 1024;
    const int aoff = lds_byte(wr * 64 + fr, ac0), boff = lds_byte(wc * 32 + fr, ac0);
#define PG8_SA(b, h) (((b) * 2 + (h)) * HTB)
#define PG8_SB(b, h) ((4 + (b) * 2 + (h)) * HTB)
#define PG8_STAGEB(bufoff, gbase) do { _Pragma("unroll") for (int _i = 0; _i < 2; ++_i) \
        __builtin_amdgcn_global_load_lds((const unsigned*)((const char*)(gbase) + voffB0 + _i * voffBd), (LAS unsigned*)(lds + (bufoff) + ldsw + _i * 8192), 16, 0, 0); } while (0)
#define PG8_STAGEA(bufoff, koff, V, h) do { _Pragma("unroll") for (int _i = 0; _i < 2; ++_i) \
        __builtin_amdgcn_global_load_lds((const unsigned*)(Abase + (size_t)(V)[h][_i] + (koff)), (LAS unsigned*)(lds + (bufoff) + ldsw + _i * 8192), 16, 0, 0); } while (0)
#define PG8_LDA(dst, b, h) do { _Pragma("unroll") for (int m = 0; m < 4; ++m) { const v4i c0_ = *(const LAS v4i*)(lds + PG8_SA(b, h) + aoff + m * 2048), c1_ = *(const LAS v4i*)(lds + PG8_SA(b, h) + aoff + m * 2048 + CH1); dst[m] = __builtin_shufflevector(c0_, c1_, 0, 1, 2, 3, 4, 5, 6, 7); } } while (0)
#define PG8_LDB(dst, b, h) do { _Pragma("unroll") for (int n = 0; n < 2; ++n) { const v4i c0_ = *(const LAS v4i*)(lds + PG8_SB(b, h) + boff + n * 2048), c1_ = *(const LAS v4i*)(lds + PG8_SB(b, h) + boff + n * 2048 + CH1); dst[n] = __builtin_shufflevector(c0_, c1_, 0, 1, 2, 3, 4, 5, 6, 7); } } while (0)
#define PG8_MMA(ai, bj, At, Bt) do { __builtin_amdgcn_s_setprio(1); _Pragma("unroll") for (int m = 0; m < 4; ++m) _Pragma("unroll") for (int n = 0; n < 2; ++n) \
        acc[ai][bj][m][n] = mma_tile<DT>(Bt[n], At[m], acc[ai][bj][m][n], scB); __builtin_amdgcn_s_setprio(0); } while (0)
#define PG8_WAIT_V(n) asm volatile("s_waitcnt vmcnt(" #n ")" ::: "memory")
#define PG8_WAIT_VE(pe) do { if (pe) asm volatile("s_waitcnt vmcnt(%0)" :: "n"(8 + Epi::NSTORE) : "memory"); else asm volatile("s_waitcnt vmcnt(8)" ::: "memory"); } while (0)
#define PG8_WAIT_L(n) asm volatile("s_waitcnt lgkmcnt(" #n ")" ::: "memory")
#define PG8_BAR __builtin_amdgcn_s_barrier()
#define PG8_SCHED __builtin_amdgcn_sched_barrier(0)
    GUnit cur, nxt; int ui = 0;
    if (!S.next(0, cur)) return;
    f32x4 acc[2][2][4][2];
#pragma unroll
    for (int a = 0; a < 2; ++a)
#pragma unroll
        for (int b = 0; b < 2; ++b)
#pragma unroll
            for (int m = 0; m < 4; ++m)
#pragma unroll
                for (int n = 0; n < 2; ++n) acc[a][b][m][n] = (f32x4){0.f, 0.f, 0.f, 0.f};
    v8i At[4], B0[2], B1[2];
    unsigned vA[2][2];
    PG8_AOFF(vA, cur);
    if constexpr (Sched::GATHER) VM_WAIT();
    const char* cB = cur.B;
    E.pre(lds, cur, 0, wid, lane);
    PG8_STAGEB(PG8_SB(0, 0), cB); PG8_STAGEB(PG8_SB(0, 1), cB + hstep); PG8_STAGEA(PG8_SA(0, 0), 0, vA, 0); PG8_STAGEA(PG8_SA(0, 1), 0, vA, 1);
    if (wr == 1) PG8_BAR;
    PG8_WAIT_V(2); PG8_BAR;
    PG8_STAGEB(PG8_SB(1, 0), cB + kstep); PG8_STAGEA(PG8_SA(1, 0), kstep, vA, 0); PG8_STAGEB(PG8_SB(1, 1), cB + hstep + kstep);
    PG8_WAIT_V(6); PG8_BAR;
    for (;;) {
        const bool has_next = S.next(ui + 1, nxt);
#pragma unroll 1
        for (int t = 0; t < nt; t += 2) {
            const bool last = (t == nt - 2);
            const bool pe = POSTEPI_WAITS && (t == 0) && (ui > 0);
            const size_t k1 = (size_t)(t + 1) * kstep;
            PG8_LDB(B0, 0, 0); PG8_LDB(B1, 0, 1); PG8_SCHED; PG8_LDA(At, 0, 0); PG8_STAGEA(PG8_SA(1, 1), k1, vA, 1);
            PG8_WAIT_VE(pe); PG8_WAIT_L(0); PG8_BAR; PG8_MMA(0, 0, At, B0); PG8_MMA(0, 1, At, B1); PG8_BAR; PG8_SCHED;
            size_t k2 = (size_t)(t + 2) * kstep;
            if (last) { k2 = 0; if (has_next) { PG8_AOFF(vA, nxt); if constexpr (Sched::GATHER) VM_WAIT(); cB = nxt.B; } }
            const size_t k3 = k2 + kstep; const char* b2 = cB + k2; const char* b3 = b2 + kstep;
            PG8_LDA(At, 0, 1); PG8_STAGEB(PG8_SB(0, 0), b2); PG8_STAGEB(PG8_SB(0, 1), b2 + hstep); PG8_STAGEA(PG8_SA(0, 0), k2, vA, 0);
            PG8_WAIT_VE(pe); PG8_WAIT_L(0); PG8_BAR; PG8_MMA(1, 0, At, B0); PG8_MMA(1, 1, At, B1); PG8_BAR; PG8_SCHED;
            PG8_LDB(B0, 1, 0); PG8_LDB(B1, 1, 1); PG8_SCHED; PG8_LDA(At, 1, 0); PG8_STAGEA(PG8_SA(0, 1), k2, vA, 1);
            PG8_WAIT_V(8); PG8_WAIT_L(0); PG8_BAR; PG8_MMA(0, 0, At, B0); PG8_MMA(0, 1, At, B1); PG8_BAR; PG8_SCHED;
            PG8_LDA(At, 1, 1); PG8_STAGEB(PG8_SB(1, 0), b3); PG8_STAGEB(PG8_SB(1, 1), b3 + hstep); PG8_STAGEA(PG8_SA(1, 0), k3, vA, 0);
            PG8_WAIT_V(8); PG8_WAIT_L(0); PG8_BAR; PG8_MMA(1, 0, At, B0); PG8_MMA(1, 1, At, B1); PG8_BAR; PG8_SCHED;
        }
        if constexpr (ALIGN_EPI) { if (wr == 0) PG8_BAR; }
        { int tx = threadIdx.x; asm volatile("" : "+v"(tx)); E(acc, cur, wr, wc, tx & 15, (tx >> 4) & 3, lds, ui); }
        if (!has_next) break;
#pragma unroll
        for (int a = 0; a < 2; ++a)
#pragma unroll
            for (int b = 0; b < 2; ++b)
#pragma unroll
                for (int m = 0; m < 4; ++m)
#pragma unroll
                    for (int n = 0; n < 2; ++n) acc[a][b][m][n] = (f32x4){0.f, 0.f, 0.f, 0.f};
        cur = nxt; ++ui;
        if constexpr (ALIGN_EPI) { if (wr == 1) PG8_BAR; }
        E.pre(lds, cur, ui, wid, lane);
    }
    PG8_WAIT_V(0);
    if constexpr (!ALIGN_EPI) { if (wr == 0) PG8_BAR; }
    PG8_BAR;
#undef PG8_SA
#undef PG8_SB
#undef PG8_STAGEA
#undef PG8_AOFF
#undef PG8_STAGEB
#undef PG8_LDA
#undef PG8_LDB
#undef PG8_MMA
#undef PG8_WAIT_V
#undef PG8_WAIT_VE
#undef PG8_WAIT_L
#undef PG8_BAR
#undef PG8_SCHED
}
}

namespace attn_body {
using bf16 = __hip_bfloat16;
using s16x4 = __attribute__((ext_vector_type(4))) short;
using f32x16 = __attribute__((ext_vector_type(16))) float;
constexpr int D = 64, DMQ = QW, DMKV = KVW, DMO = DM;
constexpr int NW = 8, QBLK = 32, QB = QBLK * NW, KVBLK = 64, NT = LKV / KVBLK;
static_assert(NT % 2 == 0 && NT >= 8, "tile count");
__device__ __forceinline__ int crow(int r, int hi) { return (r & 3) + 8 * (r >> 2) + 4 * hi; }
#define SBAR() __builtin_amdgcn_sched_barrier(0)
constexpr int NSLOTR = 3, SLOTB = 8192;
constexpr int LDS_K = 0, LDS_V = NSLOTR * SLOTB, LDS_WS = 2 * NSLOTR * SLOTB, LDS_OST = LDS_WS + NW * 64 * 4, ATT_LDS_BYTES = LDS_OST + NW * 4096;
__device__ __forceinline__ void glds16(const void* gsrc, unsigned lds_dst) { unsigned keep;
    asm volatile("s_mov_b32 %0, m0\n\ts_mov_b32 m0, %2\n\ts_nop 0\n\tglobal_load_lds_dwordx4 %1, off\n\ts_mov_b32 m0, %0" : "=&s"(keep) : "v"(gsrc), "s"(lds_dst) : "memory"); }
__device__ __forceinline__ float max3f(float a, float b, float c) { float r; asm("v_max3_f32 %0, %1, %2, %3" : "=v"(r) : "v"(a), "v"(b), "v"(c)); return r; }
__device__ __forceinline__ float max2f(float a, float b) { float r; asm("v_max_f32_e32 %0, %1, %2" : "=v"(r) : "v"(a), "v"(b)); return r; }
__device__ __forceinline__ float fadd_s(float a, float b) { float r; asm("v_add_f32_e32 %0, %1, %2" : "=v"(r) : "v"(a), "v"(b)); return r; }
__device__ __forceinline__ float fsub_s(float a, float b) { float r; asm("v_sub_f32_e32 %0, %1, %2" : "=v"(r) : "v"(a), "v"(b)); return r; }
typedef float f32x2_t __attribute__((ext_vector_type(2))); typedef __bf16 bf16x2_t __attribute__((ext_vector_type(2)));
__device__ __forceinline__ unsigned cvtpk_s(float lo, float hi) { f32x2_t v = {lo, hi}; bf16x2_t b = __builtin_convertvector(v, bf16x2_t); return __builtin_bit_cast(unsigned, b); }
#define WAIT_BAR(N) asm volatile("s_waitcnt vmcnt(" #N ") lgkmcnt(0)\n\ts_barrier" ::: "memory")

__device__ __forceinline__ void qkt(f32x16& p0, f32x16& p1, const char* Kslot, const bf16x8* qr, const f32x16& negm, int r32, int hi) {
    const char* kb = Kslot + hi * 1024 + r32 * 16;
#pragma unroll
    for (int d0 = 0; d0 < 4; ++d0) {
        const bf16x8 b0 = *reinterpret_cast<const bf16x8*>(kb + d0 * 2048);
        const bf16x8 b1 = *reinterpret_cast<const bf16x8*>(kb + d0 * 2048 + 512);
        if (d0 == 0) { p0 = __builtin_amdgcn_mfma_f32_32x32x16_bf16(b0, qr[0], negm, 0, 0, 0); p1 = __builtin_amdgcn_mfma_f32_32x32x16_bf16(b1, qr[0], negm, 0, 0, 0); }
        else { p0 = __builtin_amdgcn_mfma_f32_32x32x16_bf16(b0, qr[d0], p0, 0, 0, 0); p1 = __builtin_amdgcn_mfma_f32_32x32x16_bf16(b1, qr[d0], p1, 0, 0, 0); } }
}
typedef __attribute__((address_space(3))) const char* lds_cptr;
typedef short v4i16_t __attribute__((ext_vector_type(4)));
__device__ __forceinline__ void kload8(bf16x8* kf, lds_cptr kp) {
    kf[0] = *(const __attribute__((address_space(3))) bf16x8*)(kp);        kf[1] = *(const __attribute__((address_space(3))) bf16x8*)(kp + 512);
    kf[2] = *(const __attribute__((address_space(3))) bf16x8*)(kp + 2048); kf[3] = *(const __attribute__((address_space(3))) bf16x8*)(kp + 2560);
    kf[4] = *(const __attribute__((address_space(3))) bf16x8*)(kp + 4096); kf[5] = *(const __attribute__((address_space(3))) bf16x8*)(kp + 4608);
    kf[6] = *(const __attribute__((address_space(3))) bf16x8*)(kp + 6144); kf[7] = *(const __attribute__((address_space(3))) bf16x8*)(kp + 6656);
}
__device__ __forceinline__ void kload2(bf16x8* kf, lds_cptr kp, int j) { kf[2 * j] = *(const __attribute__((address_space(3))) bf16x8*)(kp + j * 2048); kf[2 * j + 1] = *(const __attribute__((address_space(3))) bf16x8*)(kp + j * 2048 + 512); }
__device__ __forceinline__ s16x4 vtr(lds_cptr p) { return __builtin_bit_cast(s16x4, __builtin_amdgcn_ds_read_tr16_b64_v4i16((__attribute__((address_space(3))) v4i16_t*)p)); }
__device__ __forceinline__ float rowmax(const f32x16& p0, const f32x16& p1) {
    float a = max3f(p0[0], p0[1], p1[0]), b = max3f(p0[2], p0[3], p1[1]); a = max3f(a, p1[2], p1[3]);
#pragma unroll
    for (int r = 4; r < 16; r += 4) { a = max3f(a, p0[r], p0[r + 1]); b = max3f(b, p0[r + 2], p0[r + 3]); a = max3f(a, p1[r], p1[r + 1]); b = max3f(b, p1[r + 2], p1[r + 3]); }
    const float m = max2f(a, b);
    auto rr = __builtin_amdgcn_permlane32_swap(__float_as_uint(m), __float_as_uint(m), false, false);
    return max2f(__uint_as_float(rr[0]), __uint_as_float(rr[1]));
}
__device__ __forceinline__ void pv(f32x16* o, int vb, bf16x8 pa0, bf16x8 pa1, bf16x8 pa2, bf16x8 pa3) {
#pragma unroll
    for (int d0 = 0; d0 < 2; ++d0) { s16x4 lo[4], hi[4];
#pragma unroll
        for (int ks = 0; ks < 4; ++ks) {
            asm volatile("ds_read_b64_tr_b16 %0,%1 offset:%c2" : "=&v"(lo[ks]) : "v"(vb), "i"(d0 * 4096 + ks * 1024) : "memory");
            asm volatile("ds_read_b64_tr_b16 %0,%1 offset:%c2" : "=&v"(hi[ks]) : "v"(vb), "i"(d0 * 4096 + ks * 1024 + 512) : "memory"); }
        asm volatile("s_waitcnt lgkmcnt(0)" ::: "memory"); SBAR();
#define PK(k) (bf16x8){lo[k][0], lo[k][1], lo[k][2], lo[k][3], hi[k][0], hi[k][1], hi[k][2], hi[k][3]}
        o[d0] = __builtin_amdgcn_mfma_f32_32x32x16_bf16(pa0, PK(0), o[d0], 0, 0, 0);
        o[d0] = __builtin_amdgcn_mfma_f32_32x32x16_bf16(pa1, PK(1), o[d0], 0, 0, 0);
        o[d0] = __builtin_amdgcn_mfma_f32_32x32x16_bf16(pa2, PK(2), o[d0], 0, 0, 0);
        o[d0] = __builtin_amdgcn_mfma_f32_32x32x16_bf16(pa3, PK(3), o[d0], 0, 0, 0);
#undef PK
    }
}
template <bool MS> __device__ __forceinline__ void attn_unit(int b, int h, int qb, const bf16* Q, const bf16* __restrict__ K, const bf16* __restrict__ V, bf16* O, char* shm, float negM_) {
    const int tid = threadIdx.x, lane = tid & 63, r32 = lane & 31, hi = lane >> 5; const int wid = __builtin_amdgcn_readfirstlane(tid >> 6);
    const int q0 = qb * QB; const int kvh = h / 3;
    const long qrow0 = (long)b * SEQ + q0 + wid * QBLK;
    const long kvrow0 = (long)b * LKV;
    const bf16* Qw = Q + qrow0 * DMQ + h * D;
    const bf16* Kh = K + kvrow0 * DMKV + kvh * D, *Vh = V + kvrow0 * DMKV + kvh * D;
    const unsigned lds0 = (unsigned)(uintptr_t)shm;
    float* wsf = (float*)(shm + LDS_WS) + wid * 64;
    const bf16* ksrc = Kh + (long)lane * DMKV + wid * 8;
    const bf16* vsrc = Vh + (long)(16 * (wid & 3) + (lane >> 2)) * DMKV + (wid >> 2) * 32 + (lane & 3) * 8;
    const unsigned kdst = lds0 + LDS_K + wid * 1024, vdst = lds0 + LDS_V + wid * 1024;
#define DMA_K(t, slot) glds16(ksrc + (long)(t) * KVBLK * DMKV, (unsigned)__builtin_amdgcn_readfirstlane(kdst + (slot)))
#define DMA_V(t, slot) glds16(vsrc + (long)(t) * KVBLK * DMKV, (unsigned)__builtin_amdgcn_readfirstlane(vdst + (slot)))
    const int vb0 = (int)(lds0 + LDS_V) + ((lane >> 4) & 1) * 32 + (lane & 3) * 8 + (4 * hi + ((lane & 15) >> 2)) * 64;
    const char* Kbase = shm + LDS_K; bf16x8 kf[8];
    const lds_cptr shm3 = (lds_cptr)shm; const lds_cptr kp0 = shm3 + LDS_K + hi * 1024 + r32 * 16; const lds_cptr vp0 = shm3 + LDS_V + ((lane >> 4) & 1) * 32 + (lane & 3) * 8 + (4 * hi + ((lane & 15) >> 2)) * 64;
    DMA_K(0, 0); DMA_V(0, 0); DMA_K(1, SLOTB);
    bf16x8 qr[4];
#pragma unroll
    for (int d0 = 0; d0 < 4; ++d0) qr[d0] = *reinterpret_cast<const bf16x8*>(&Qw[(long)r32 * DMQ + d0 * 16 + hi * 8]);
    float l_reg = 0.f; f32x16 o[2]; o[0] = f32x16{}; o[1] = f32x16{}; f32x16 negm = f32x16{}; f32x16 lacc = f32x16{};
    if constexpr (!MS) { _Pragma("unroll") for (int r = 0; r < 16; ++r) negm[r] = negM_; asm volatile("" : "+v"(negm)); }
    const bf16x8 ONES = (bf16x8){0x3F80, 0x3F80, 0x3F80, 0x3F80, 0x3F80, 0x3F80, 0x3F80, 0x3F80};
#define START(P0, P1) do { _Pragma("unroll") for (int r = 0; r < 16; ++r) P0[r] = __builtin_amdgcn_exp2f(P0[r]); } while (0)
#define RESC() do { } while (0)
    f32x16 pA0, pA1, pB0, pB1;
    int sl_prev = 0, sl_cur = 0, sl_next = SLOTB;
#define ROT() do { sl_prev = sl_cur; sl_cur = sl_next; sl_next = (sl_next == (NSLOTR - 1) * SLOTB) ? 0 : sl_next + SLOTB; } while (0)
    DMA_K(2, 2 * SLOTB);
    WAIT_BAR(3);
    qkt(pA0, pA1, Kbase, qr, negm, r32, hi); asm volatile("s_nop 15\n\ts_nop 7" : "+v"(pA0), "+v"(pA1));
    START(pA0, pA1);
    _Pragma("unroll") for (int r = 0; r < 16; ++r) pA1[r] = __builtin_amdgcn_exp2f(pA1[r]);
    WAIT_BAR(0);
    DMA_K(3, 0); DMA_V(1, SLOTB);
    ROT();
    kload8(kf, kp0 + sl_cur);
    WAIT_BAR(2);
    s16x4 vlo[8], vhi[8]; u32x4 pw0, pw1, pw2, pw3;
#define PKW(P, B) cvtpk_s(P[B], P[B + 1])
#define PAF(k) __builtin_bit_cast(bf16x8, pw##k)
#define VFR(i) (bf16x8){vlo[i][0], vlo[i][1], vlo[i][2], vlo[i][3], vhi[i][0], vhi[i][1], vhi[i][2], vhi[i][3]}
#define PIN(x) asm volatile("" : "+v"(x))
#define MX3(a, b, c) __builtin_fmaxf(__builtin_fmaxf((a), (b)), (c))
#define GAPA(MF, A0, A1, A2, A3, W0, W1, PW) do { MF; if constexpr (!MS) { sacc += A0; sacc += A1; sacc += A2; sacc += A3; PIN(sacc); } W0; W1; PIN(PW); SBAR(); } while (0)
#define LSUM(k) do { if constexpr (MS) lacc = __builtin_amdgcn_mfma_f32_32x32x16_bf16(PAF(k), ONES, lacc, 0, 0, 0); } while (0)
#define EX(v) __builtin_amdgcn_exp2f(v)
#define GAPB(MF, X, B) do { MF; X[B] = EX(X[B]); X[B + 1] = EX(X[B + 1]); X[B + 2] = EX(X[B + 2]); X[B + 3] = EX(X[B + 3]); PIN(X); SBAR(); } while (0)
#define VRD(i) do { vlo[i] = vtr(vp_ + (((i) >> 2) * 4096 + ((i) & 3) * 1024)); vhi[i] = vtr(vp_ + (((i) >> 2) * 4096 + ((i) & 3) * 1024 + 512)); } while (0)
#define KRD(G, j) do { if (G) { kload2(kf, kp0 + sl_next, j); SBAR(); } } while (0)
#define STEP(C0, C1, P0, P1, t, GK, GV, GL) do { SBAR(); \
    const lds_cptr vp_ = vp0 + sl_prev; \
    VRD(0); SBAR(); float sacc = MS ? 0.f : (P0[0] + P0[1]); \
    GAPA(C0 = __builtin_amdgcn_mfma_f32_32x32x16_bf16(kf[0], qr[0], negm, 0, 0, 0), P0[2], P0[3], P0[4], P0[5],     pw0[0] = PKW(P0, 0), pw0[1] = PKW(P0, 2), pw0); \
    VRD(4); SBAR(); GAPA(C1 = __builtin_amdgcn_mfma_f32_32x32x16_bf16(kf[1], qr[0], negm, 0, 0, 0), P0[6], P0[7], P0[8], P0[9],     pw0[2] = PKW(P0, 4), pw0[3] = PKW(P0, 6), pw0); \
    VRD(1); SBAR(); GAPA(C0 = __builtin_amdgcn_mfma_f32_32x32x16_bf16(kf[2], qr[1], C0, 0, 0, 0),   P0[10], P0[11], P0[12], P0[13], pw1[0] = PKW(P0, 8), pw1[1] = PKW(P0, 10), pw1); \
    VRD(5); SBAR(); GAPA(C1 = __builtin_amdgcn_mfma_f32_32x32x16_bf16(kf[3], qr[1], C1, 0, 0, 0),   P0[14], P0[15], P1[0], P1[1],   pw1[2] = PKW(P0, 12), pw1[3] = PKW(P0, 14), pw1); \
    VRD(2); SBAR(); GAPA(C0 = __builtin_amdgcn_mfma_f32_32x32x16_bf16(kf[4], qr[2], C0, 0, 0, 0),   P1[2], P1[3], P1[4], P1[5],     pw2[0] = PKW(P1, 0), pw2[1] = PKW(P1, 2), pw2); \
    VRD(6); SBAR(); GAPA(C1 = __builtin_amdgcn_mfma_f32_32x32x16_bf16(kf[5], qr[2], C1, 0, 0, 0),   P1[6], P1[7], P1[8], P1[9],     pw2[2] = PKW(P1, 4), pw2[3] = PKW(P1, 6), pw2); \
    VRD(3); SBAR(); GAPA(C0 = __builtin_amdgcn_mfma_f32_32x32x16_bf16(kf[6], qr[3], C0, 0, 0, 0),   P1[10], P1[11], P1[12], P1[13], pw3[0] = PKW(P1, 8), pw3[1] = PKW(P1, 10), pw3); \
    VRD(7); SBAR(); GAPA(C1 = __builtin_amdgcn_mfma_f32_32x32x16_bf16(kf[7], qr[3], C1, 0, 0, 0),   P1[14], P1[15], 0.f, 0.f,       pw3[2] = PKW(P1, 12), pw3[3] = PKW(P1, 14), pw3); \
    if constexpr (!MS) l_reg += sacc; \
    if (GK) { DMA_K((t) + 3, sl_cur); } if (GV) { DMA_V((t) + 1, sl_next); } \
    SBAR(); \
    GAPB(o[0] = __builtin_amdgcn_mfma_f32_32x32x16_bf16(PAF(0), VFR(0), o[0], 0, 0, 0), C0, 0); \
    GAPB(o[1] = __builtin_amdgcn_mfma_f32_32x32x16_bf16(PAF(0), VFR(4), o[1], 0, 0, 0), C0, 4); LSUM(0); \
    KRD(GL, 0); GAPB(o[0] = __builtin_amdgcn_mfma_f32_32x32x16_bf16(PAF(1), VFR(1), o[0], 0, 0, 0), C0, 8); \
    KRD(GL, 1); GAPB(o[1] = __builtin_amdgcn_mfma_f32_32x32x16_bf16(PAF(1), VFR(5), o[1], 0, 0, 0), C0, 12); LSUM(1); \
    KRD(GL, 2); GAPB(o[0] = __builtin_amdgcn_mfma_f32_32x32x16_bf16(PAF(2), VFR(2), o[0], 0, 0, 0), C1, 0); \
    KRD(GL, 3); GAPB(o[1] = __builtin_amdgcn_mfma_f32_32x32x16_bf16(PAF(2), VFR(6), o[1], 0, 0, 0), C1, 4); LSUM(2); \
    GAPB(o[0] = __builtin_amdgcn_mfma_f32_32x32x16_bf16(PAF(3), VFR(3), o[0], 0, 0, 0), C1, 8); \
    GAPB(o[1] = __builtin_amdgcn_mfma_f32_32x32x16_bf16(PAF(3), VFR(7), o[1], 0, 0, 0), C1, 12); LSUM(3); \
    } while (0)
    int t = 1;
    for (; t + 5 < NT; t += 2) {
        STEP(pB0, pB1, pA0, pA1, t, true, true, true);     WAIT_BAR(2); RESC(); ROT();
        STEP(pA0, pA1, pB0, pB1, t + 1, true, true, true); WAIT_BAR(2); RESC(); ROT();
    }
#define ENDW(tt) do { if ((tt) + 3 < NT) { WAIT_BAR(2); } else if ((tt) + 2 < NT) { WAIT_BAR(1); } else { WAIT_BAR(0); } } while (0)
    for (; t + 1 < NT; t += 2) {
        STEP(pB0, pB1, pA0, pA1, t, (t + 3 < NT), (t + 1 < NT), (t + 1 < NT));         ENDW(t);     RESC(); ROT();
        STEP(pA0, pA1, pB0, pB1, t + 1, (t + 4 < NT), (t + 2 < NT), (t + 2 < NT));     ENDW(t + 1); RESC(); ROT();
    }
    STEP(pB0, pB1, pA0, pA1, NT - 1, false, false, false); RESC();
    { if constexpr (!MS) { float sacc = pB0[0] + pB0[1]; _Pragma("unroll") for (int r = 2; r < 16; ++r) sacc += pB0[r]; _Pragma("unroll") for (int r = 0; r < 16; ++r) sacc += pB1[r]; l_reg += sacc; }
      pw0 = (u32x4){PKW(pB0, 0), PKW(pB0, 2), PKW(pB0, 4), PKW(pB0, 6)}; pw1 = (u32x4){PKW(pB0, 8), PKW(pB0, 10), PKW(pB0, 12), PKW(pB0, 14)}; pw2 = (u32x4){PKW(pB1, 0), PKW(pB1, 2), PKW(pB1, 4), PKW(pB1, 6)}; pw3 = (u32x4){PKW(pB1, 8), PKW(pB1, 10), PKW(pB1, 12), PKW(pB1, 14)};
      SBAR(); pv(o, vb0 + sl_cur, PAF(0), PAF(1), PAF(2), PAF(3)); LSUM(0); LSUM(1); LSUM(2); LSUM(3); }
#undef LSUM
#undef PKW
#undef PAF
#undef VFR
#undef PIN
#undef MX3
#undef GAPA
#undef GAPB
#undef EX
#undef VRD
#undef KRD
#undef STEP
#undef ENDW
    float rli[16];
    if constexpr (MS) {
#pragma unroll
        for (int r = 0; r < 16; ++r) rli[r] = __builtin_amdgcn_rcpf(lacc[r]);
    } else {
        { auto rr = __builtin_amdgcn_permlane32_swap(__float_as_uint(l_reg), __float_as_uint(l_reg), false, false); l_reg = __uint_as_float(rr[0]) + __uint_as_float(rr[1]); }
        if (hi == 0) wsf[32 + r32] = l_reg; asm volatile("s_waitcnt lgkmcnt(0)" ::: "memory");
#pragma unroll
        for (int r = 0; r < 16; ++r) rli[r] = __builtin_amdgcn_rcpf(wsf[32 + crow(r, hi)]);
    }
    bf16* Ow = O + qrow0 * DMO + h * D;
    { bf16* stg = (bf16*)(shm + LDS_OST) + wid * 2048;
#pragma unroll
      for (int r = 0; r < 16; ++r) { const int orow = crow(r, hi);
#pragma unroll
        for (int d0 = 0; d0 < 2; ++d0) stg[orow * 64 + d0 * 32 + r32] = __float2bfloat16(o[d0][r] * rli[r]); }
      asm volatile("s_waitcnt lgkmcnt(0)" ::: "memory");
#pragma unroll
      for (int i = 0; i < 4; ++i) { const int row = i * 8 + (lane >> 3), ch = lane & 7; const u32x4 v = *(const u32x4*)(stg + row * 64 + ch * 8); *(u32x4*)(Ow + (long)row * DMO + ch * 8) = v; } }
    asm volatile("s_waitcnt lgkmcnt(0)\n\ts_barrier" ::: "memory");
#undef DMA_K
#undef DMA_V
#undef START
#undef RESC
#undef ROT
}
#undef SBAR
#undef WAIT_BAR

typedef int v8i_t __attribute__((ext_vector_type(8)));
typedef int v4i_t __attribute__((ext_vector_type(4)));
__host__ __device__ __forceinline__ int vt_slot(int k) { const int hi = (k >> 2) & 1, r = (k & 3) + 4 * ((k & 31) >> 3); return 32 * hi + r + 16 * (k >> 5); }
constexpr int SLOT8 = 4096, NS8 = 6, L8_K = 0, L8_V = NS8 * SLOT8;
static_assert(L8_V + NS8 * SLOT8 <= LDS_WS, "fp8 rings below the per-wave scratch");
constexpr int SC_QK = 0x7c7f, SC_PV = 0x7f7f;
__device__ __forceinline__ v8i_t ld32(lds_cptr p, int o0, int o1) { const v4i_t a = *(const __attribute__((address_space(3))) v4i_t*)(p + o0), b = *(const __attribute__((address_space(3))) v4i_t*)(p + o1); return __builtin_shufflevector(a, b, 0, 1, 2, 3, 4, 5, 6, 7); }
#define SBAR() __builtin_amdgcn_sched_barrier(0)
#define WAIT_BAR(N) asm volatile("s_waitcnt vmcnt(" #N ") lgkmcnt(0)\n\ts_barrier" ::: "memory")
__device__ __forceinline__ void attn_unit8(int b, int h, int qb, const unsigned char* Q8, const unsigned char* K8, const unsigned char* Vt8, bf16* O, char* shm, float negM_) {
    const int tid = threadIdx.x, lane = tid & 63, r32 = lane & 31, hi = lane >> 5; const int wid = __builtin_amdgcn_readfirstlane(tid >> 6);
    const int q0 = qb * QB; const int kvh = h / 3; const bool kw = wid < 4;
    const long qrow0 = (long)b * SEQ + q0 + wid * QBLK;
    const unsigned lds0 = (unsigned)(uintptr_t)shm;
    const int drow = 16 * (wid & 3) + (lane >> 2), dch = (lane & 3) ^ ((drow >> 2) & 3);
    const unsigned char* ksrc = K8 + ((long)b * LKV + drow) * DMKV + kvh * D + dch * 16;
    const unsigned char* vsrc = Vt8 + ((long)(b * NKVH + kvh) * (LKV / 64)) * 4096 + drow * 64 + dch * 16;
    const unsigned kdst = lds0 + L8_K + (wid & 3) * 1024, vdst = lds0 + L8_V + (wid & 3) * 1024;
#define DMA8_K(t, slot) glds16(ksrc + (long)(t) * KVBLK * DMKV, (unsigned)__builtin_amdgcn_readfirstlane(kdst + (slot)))
#define DMA8_V(t, slot) glds16(vsrc + (long)(t) * 4096, (unsigned)__builtin_amdgcn_readfirstlane(vdst + (slot)))
    const lds_cptr shm3 = (lds_cptr)shm; const int sw = (r32 >> 2) & 3, c0o = ((2 * hi) ^ sw) * 16, c1o = ((2 * hi + 1) ^ sw) * 16;
    const lds_cptr kp0 = shm3 + L8_K + r32 * 64; const lds_cptr vp0 = shm3 + L8_V + r32 * 64;
    if (kw) { DMA8_K(0, 0); DMA8_K(1, SLOT8); DMA8_K(2, 2 * SLOT8); DMA8_K(3, 3 * SLOT8); DMA8_K(4, 4 * SLOT8); } else { DMA8_V(0, 0); DMA8_V(1, SLOT8); DMA8_V(2, 2 * SLOT8); }
    const v8i_t qr = *reinterpret_cast<const v8i_t*>(Q8 + (qrow0 + r32) * DMQ + h * D + hi * 32);
    f32x16 o[2]; o[0] = f32x16{}; o[1] = f32x16{}; f32x16 negm; f32x16 lacc = f32x16{};
    _Pragma("unroll") for (int r = 0; r < 16; ++r) negm[r] = negM_;
    asm volatile("" : "+v"(negm));
    const v8i_t ONES8 = (v8i_t){0x38383838, 0x38383838, 0x38383838, 0x38383838, 0x38383838, 0x38383838, 0x38383838, 0x38383838};
    f32x16 c0, c1; v8i_t kf[2], vf[2], pw = (v8i_t){0, 0, 0, 0, 0, 0, 0, 0};
    int s0 = 0, s1 = SLOT8, s2 = 2 * SLOT8, s3 = 3 * SLOT8, s5 = 5 * SLOT8;
#define NXT8(x) (((x) == (NS8 - 1) * SLOT8) ? 0 : (x) + SLOT8)
#define ROT8() do { s0 = s1; s1 = s2; s2 = s3; s3 = NXT8(s3); s5 = NXT8(s5); } while (0)
#define QK8() do { c0 = __builtin_amdgcn_mfma_scale_f32_32x32x64_f8f6f4(kf[0], qr, negm, 0, 0, 0, SC_QK, 1, SC_QK); c1 = __builtin_amdgcn_mfma_scale_f32_32x32x64_f8f6f4(kf[1], qr, negm, 0, 0, 0, SC_QK, 1, SC_QK); } while (0)
#define PK8(P, B, OLD) __builtin_amdgcn_cvt_pk_fp8_f32(P[B + 2], P[B + 3], __builtin_amdgcn_cvt_pk_fp8_f32(P[B], P[B + 1], OLD, false), true)
#define PV8() do { if (REP == 71) { f32x16 dz_ = __builtin_amdgcn_mfma_scale_f32_32x32x64_f8f6f4(pw, vf[0], f32x16{}, 0, 0, 0, SC_PV, 1, SC_PV); asm volatile("" :: "v"(dz_)); dz_ = __builtin_amdgcn_mfma_scale_f32_32x32x64_f8f6f4(pw, vf[1], f32x16{}, 0, 0, 0, SC_PV, 1, SC_PV); asm volatile("" :: "v"(dz_)); } \
    o[0] = __builtin_amdgcn_mfma_scale_f32_32x32x64_f8f6f4(pw, vf[0], o[0], 0, 0, 0, SC_PV, 1, SC_PV); o[1] = __builtin_amdgcn_mfma_scale_f32_32x32x64_f8f6f4(pw, vf[1], o[1], 0, 0, 0, SC_PV, 1, SC_PV); \
        lacc = __builtin_amdgcn_mfma_scale_f32_32x32x64_f8f6f4(pw, ONES8, lacc, 0, 0, 0, SC_PV, 1, SC_PV); } while (0)
#define EXPK8() do { if (REP == 70) { _Pragma("unroll") for (int r = 0; r < 16; ++r) { float d0_ = __builtin_amdgcn_exp2f(c0[r] * 0.5f), d1_ = __builtin_amdgcn_exp2f(c1[r] * 0.5f); asm volatile("" :: "v"(d0_), "v"(d1_)); } } \
    _Pragma("unroll") for (int r = 0; r < 16; ++r) { c0[r] = __builtin_amdgcn_exp2f(c0[r]); c1[r] = __builtin_amdgcn_exp2f(c1[r]); } \
        pw[0] = PK8(c0, 0, pw[0]); pw[1] = PK8(c0, 4, pw[1]); pw[2] = PK8(c0, 8, pw[2]); pw[3] = PK8(c0, 12, pw[3]); pw[4] = PK8(c1, 0, pw[4]); pw[5] = PK8(c1, 4, pw[5]); pw[6] = PK8(c1, 8, pw[6]); pw[7] = PK8(c1, 12, pw[7]); } while (0)
    WAIT_BAR(0);
    kf[0] = ld32(kp0, c0o, c1o); kf[1] = ld32(kp0 + 2048, c0o, c1o);
    QK8(); EXPK8();
    kf[0] = ld32(kp0 + SLOT8, c0o, c1o); kf[1] = ld32(kp0 + SLOT8 + 2048, c0o, c1o);
    WAIT_BAR(0);
#define SUB8(t, GK, GV, GL) do { SBAR(); \
    vf[0] = ld32(vp0 + s0, c0o, c1o); vf[1] = ld32(vp0 + s0 + 2048, c0o, c1o); \
    QK8(); PV8(); \
    if (kw) { if (GK) { DMA8_K((t) + 4, s5); } } else { if (GV) { DMA8_V((t) + 2, s3); } } \
    if (GL) { kf[0] = ld32(kp0 + s2, c0o, c1o); kf[1] = ld32(kp0 + s2 + 2048, c0o, c1o); } \
    EXPK8(); ROT8(); \
    } while (0)
    int t = 1;
#pragma unroll 1
    for (; t + 5 < NT; t += 2) { SUB8(t, true, true, true); SUB8(t + 1, true, true, true); WAIT_BAR(1); }
#pragma unroll 1
    for (; t + 1 < NT; t += 2) {
        SUB8(t, (t + 4 < NT), (t + 2 < NT), (t + 1 < NT)); SUB8(t + 1, (t + 5 < NT), (t + 3 < NT), (t + 2 < NT)); WAIT_BAR(0); }
    SUB8(NT - 1, false, false, false);
    {
        asm volatile("s_waitcnt lgkmcnt(0)" ::: "memory");
        vf[0] = ld32(vp0 + s0, c0o, c1o); vf[1] = ld32(vp0 + s0 + 2048, c0o, c1o);
        PV8(); }
    float rli[16];
#pragma unroll
    for (int r = 0; r < 16; ++r) rli[r] = __builtin_amdgcn_rcpf(lacc[r]);
    bf16* Ow = O + qrow0 * DMO + h * D;
    { bf16* stg = (bf16*)(shm + LDS_OST) + wid * 2048;
#pragma unroll
      for (int r = 0; r < 16; ++r) { const int orow = crow(r, hi);
#pragma unroll
        for (int d0 = 0; d0 < 2; ++d0) stg[orow * 64 + d0 * 32 + r32] = __float2bfloat16(o[d0][r] * rli[r]); }
      asm volatile("s_waitcnt lgkmcnt(0)" ::: "memory");
#pragma unroll
      for (int i = 0; i < 4; ++i) { const int row = i * 8 + (lane >> 3), ch = lane & 7; const u32x4 v = *(const u32x4*)(stg + row * 64 + ch * 8); *(u32x4*)(Ow + (long)row * DMO + ch * 8) = v; } }
    asm volatile("s_waitcnt vmcnt(0) lgkmcnt(0)\n\ts_barrier" ::: "memory");
#undef DMA8_K
#undef DMA8_V
#undef ROT8
#undef QK8
#undef PK8
#undef PV8
#undef EXPK8
#undef SUB8
#undef NXT8
}
#undef SBAR
#undef WAIT_BAR
}

#define XB_TMO      128
#define XB_XCNT(j)  (256  + 64 * (j))
#define XB_XSUB(j)  (1280 + 64 * (j))
#define XB_XGEN(j)  (2304 + 64 * (j))
#define XB_TOP      3328
#define XB_TOPGEN   3392
#define XCD_BAR_WORDS 3456
#define XB_SPIN_CAP (1u << 18)
__device__ __forceinline__ unsigned xb_ld(unsigned* p)              { return __hip_atomic_load(p, __ATOMIC_RELAXED, __HIP_MEMORY_SCOPE_AGENT); }
__device__ __forceinline__ unsigned xb_add(unsigned* p, unsigned v) { return __hip_atomic_fetch_add(p, v, __ATOMIC_RELAXED, __HIP_MEMORY_SCOPE_AGENT); }
__device__ __forceinline__ unsigned xb_xcc_id() { return (unsigned)__builtin_amdgcn_s_getreg((3 << 11) | 20) & 0xFu; }
#define XB_SPIN(cond, bar) do { unsigned _sp = 0; while (cond) { __builtin_amdgcn_s_sleep(1); \
    if ((++_sp & 255u) == 0u) { if (xb_ld(&(bar)[XB_TMO])) break; if (_sp > XB_SPIN_CAP) { atomicAdd(&(bar)[XB_TMO], 1u); break; } } } } while (0)
struct XcdBarrier { unsigned* bar; unsigned x; volatile LAS unsigned* st; };
__device__ __forceinline__ XcdBarrier xcd_barrier_post(unsigned* bar, volatile LAS unsigned* st) {
    XcdBarrier b; b.bar = bar; b.x = xb_xcc_id(); b.st = st;
    if (threadIdx.x == 0) (void)xb_add(&bar[XB_XCNT(b.x)], 1u);
    return b;
}
__device__ __forceinline__ void xcd_barrier_complete(unsigned* bar, unsigned x, unsigned& nloc, unsigned& nx) {
    const unsigned G = gridDim.x * gridDim.y * gridDim.z;
    unsigned sum, cnt, mine, sp = 0u;
    for (;;) {
        sum = 0u; cnt = 0u; mine = 0u;
#pragma unroll
        for (unsigned j = 0; j < 16; ++j) { const unsigned c = xb_ld(&bar[XB_XCNT(j)]); sum += c; cnt += (c > 0u) ? 1u : 0u; mine = (j == x) ? c : mine; }
        if (sum == G) break;
        __builtin_amdgcn_s_sleep(1);
        if ((++sp & 255u) == 0u) { if (xb_ld(&bar[XB_TMO])) break; if (sp > XB_SPIN_CAP) { atomicAdd(&bar[XB_TMO], 1u); break; } }
    }
    nloc = mine > 0u ? mine : 1u; nx = cnt > 0u ? cnt : 1u;
}
__device__ __forceinline__ void xcd_barrier(const XcdBarrier& b) {
    asm volatile("s_waitcnt vmcnt(0)" ::: "memory");
    __syncthreads();
    if (threadIdx.x == 0) {
        unsigned* bar = b.bar;
        __builtin_amdgcn_s_waitcnt(0);
        unsigned nloc = b.st[0], nx = b.st[1];
        if (nloc == 0u) { xcd_barrier_complete(bar, b.x, nloc, nx); b.st[0] = nloc; b.st[1] = nx; }
        const unsigned old = xb_add(&bar[XB_XSUB(b.x)], 1u);
        const unsigned gen = old / nloc;
        if (old + 1u == (gen + 1u) * nloc) {
            __builtin_amdgcn_fence(__ATOMIC_RELEASE, "agent");
            asm volatile("s_waitcnt vmcnt(0)" ::: "memory");
            const unsigned og = xb_add(&bar[XB_TOP], 1u);
            const unsigned tg = og / nx;
            if (og + 1u == (tg + 1u) * nx) xb_add(&bar[XB_TOPGEN], 1u);
            else XB_SPIN(xb_ld(&bar[XB_TOPGEN]) == tg, bar);
            __builtin_amdgcn_fence(__ATOMIC_ACQUIRE, "agent");
            xb_add(&bar[XB_XGEN(b.x)], 1u);
            asm volatile("s_waitcnt vmcnt(0)" ::: "memory");
        } else {
            XB_SPIN(xb_ld(&bar[XB_XGEN(b.x)]) == gen, bar);
            __builtin_amdgcn_fence(__ATOMIC_ACQUIRE, "agent");
            asm volatile("s_waitcnt vmcnt(0)" ::: "memory");
        }
    }
    __syncthreads();
}

struct Frame {
    LAS unsigned char* lds;
    volatile LAS unsigned* MISC;
    gu32* ctl;
    int tid, lane, wave;
    int vcu, G;
    const float* const* ka;
    float* out;
    unsigned char* ws;
};
#define WSP(T, off) ((T*)(F.ws + (off)))
#define FIN_x (F.ka[0])
#define FIN_c (F.ka[1])
#define FIN_ctx (F.ka[2])
#define FIN_c_ctx (F.ka[3])
#define FIN_norm1_g (F.ka[4])
#define FIN_w_ada (F.ka[5])
#define FIN_b_ada (F.ka[6])
#define FIN_w_in (F.ka[7])
#define FIN_w_fourier (F.ka[8])
#define FIN_q_norm_g (F.ka[9])
#define FIN_k_norm_g (F.ka[10])
#define FIN_w_out (F.ka[11])
#define FIN_norm2_g (F.ka[12])
#define FIN_w_router (F.ka[13])
#define FIN_router_bias (F.ka[14])
#define FIN_w_egu (F.ka[15])
#define FIN_w_ed (F.ka[16])
#define FIN_w_sgu (F.ka[17])
#define FIN_w_sd (F.ka[18])
#define FIN_final_g (F.ka[19])

struct DenseOrder {
    static constexpr bool GATHER = false;
    int nN, nmain, nextra, G, c; const char* Bt; int K; int reps;
    __device__ __forceinline__ bool next(int i, pg8::GUnit& u) const {
        const int ntot = nmain + nextra, nc = (ntot - c + G - 1) / G; if (i >= nc * reps) return false;
        const int L = (i % nc) * G + c;
        if (L < nmain) { const int nig = 8 * nN, gid = L / nig, r = L % nig; u.pm = gid * 8 + (r & 7); u.pn = r >> 3; }
        else { const int jx = L - nmain; u.pm = 128 + (jx & 3); u.pn = 5 + (jx >> 2); }
        u.e = 0; u.j = 0; u.nvalid = 256; u.B = Bt + (size_t)u.pn * 256 * K * 2; return true;
    }
    __device__ __forceinline__ int arow(const pg8::GUnit& u, int r) const { return u.pm * 256 + r; }
};
template <bool GATHER_> struct GroupedOrder {
    static constexpr bool GATHER = GATHER_;
    int NPN, G, c, nbrows, K; bool gather; const char* Bt; const LAS int* TS; const LAS int* CN; const GAS u32x2* LIST; int reps; int total;
    __device__ __forceinline__ bool next(int i, pg8::GUnit& u) const {
        const int ntot = total * NPN, nc = (ntot - c + G - 1) / G; if (i >= nc * reps) return false;
        const int L = (i % nc) * G + c; const int T = L / NPN;
        int lo = __builtin_amdgcn_readfirstlane((int)((const LAS unsigned short*)(TS + 640))[T]);
        const int ts = __builtin_amdgcn_readfirstlane(TS[lo]), cn = __builtin_amdgcn_readfirstlane(CN[lo]);
        u.pm = T; u.pn = L - T * NPN; u.e = lo; u.j = T - ts; const int rem = cn - 256 * u.j; u.nvalid = rem < 256 ? rem : 256;
        u.B = Bt + ((size_t)lo * nbrows + (size_t)u.pn * 256) * K; return true;
    }
    __device__ __forceinline__ int arow(const pg8::GUnit& u, int r) const {
        if (!gather) return u.pm * 256 + r;
        int pos = 256 * u.j + r; if (r >= u.nvalid) pos = 0;
        const u32x2 en = LIST[(size_t)u.e * NTOK + pos];
        return (int)(en.x & 0xffffu);
    }
};

struct EpiInProj {
    static constexpr bool PERM = true; static constexpr int NSTORE = 8;
    __device__ __forceinline__ void pre(LAS unsigned char*, const pg8::GUnit&, int, int, int) const {}
    u16 *Z, *Q, *Kb, *Vb; const float *COS, *SIN, *gq, *gk;
    __device__ __forceinline__ void operator()(const f32x4 (&acc)[2][2][4][2], const pg8::GUnit& u, int wr, int wc, int fr, int fq, LAS unsigned char* lds, int ui) const {
        const int pn = u.pn; const bool is_ctx = u.pm >= 128;
        if (ATTN_FP8 && pn == 6) {
            LAS unsigned char* st = lds + pg8::STAGE_BYTES; const int tid = threadIdx.x;
            const int b = is_ctx ? (u.pm - 128) : (u.pm >> 5), kt0 = is_ctx ? (SEQ / 64) : (((u.pm * 256) & (SEQ - 1)) >> 6);
#pragma unroll
            for (int ai = 0; ai < 2; ++ai)
#pragma unroll
                for (int bj = 0; bj < 2; ++bj) {
#pragma unroll
                    for (int m = 0; m < 4; ++m) { const int ks = attn_body::vt_slot(16 * m + fr); const f32x4 v0 = acc[ai][bj][m][0], v1 = acc[ai][bj][m][1];
                        int w0 = __builtin_amdgcn_cvt_pk_fp8_f32(v0[0], v0[1], 0, false); w0 = __builtin_amdgcn_cvt_pk_fp8_f32(v0[2], v0[3], w0, true);
                        int w1 = __builtin_amdgcn_cvt_pk_fp8_f32(v1[0], v1[1], 0, false); w1 = __builtin_amdgcn_cvt_pk_fp8_f32(v1[2], v1[3], w1, true);
#pragma unroll
                        for (int q8 = 0; q8 < 8; ++q8) st[((wr * 128 + 32 * wc + 8 * fq + q8) * 64) + ks] = (unsigned char)(((q8 < 4 ? (unsigned)w0 : (unsigned)w1) >> (8 * (q8 & 3))) & 0xffu); }
                    asm volatile("s_waitcnt lgkmcnt(0)" ::: "memory"); __builtin_amdgcn_s_barrier(); asm volatile("" ::: "memory");
#pragma unroll
                    for (int j = 0; j < 2; ++j) { const int ch = tid + 512 * j, row = ch >> 2, part = ch & 3, col = 128 * bj + (row & 127), kvh = col >> 6, d = col & 63, kt = kt0 + 2 * ai + (row >> 7);
                        const u32x4 v = *(const LAS u32x4*)(st + row * 64 + part * 16);
                        *(u32x4*)((unsigned char*)Vb + ((((size_t)(b * NKVH + kvh) * (LKV / 64) + kt) * 64 + d) * 64) + part * 16) = v; }
                    asm volatile("s_waitcnt lgkmcnt(0)" ::: "memory"); __builtin_amdgcn_s_barrier(); asm volatile("" ::: "memory");
                }
            return;
        }
        float gn[2][2][4];
        if (pn >= 2 && pn < 6) { const float* gsrc = (pn == 5) ? gk : gq;
#pragma unroll
            for (int bj = 0; bj < 2; ++bj)
#pragma unroll
                for (int n = 0; n < 2; ++n) { const f32x4 g4 = *(const f32x4*)(gsrc + 32 * bj + 16 * n + 4 * fq); gn[bj][n][0] = g4[0]; gn[bj][n][1] = g4[1]; gn[bj][n][2] = g4[2]; gn[bj][n][3] = g4[3]; } }
#pragma unroll
        for (int ai = 0; ai < 2; ++ai)
#pragma unroll
            for (int m = 0; m < 4; ++m) {
                const int row = u.pm * 256 + ai * 128 + wr * 64 + m * 16 + fr;
                int b, l, key;
                if (!is_ctx) { b = row >> 13; l = row & 8191; key = l; } else { const int rc = row - NTOK; b = rc >> 8; l = 0; key = SEQ + (rc & 255); }
                if (pn < 2) {
#pragma unroll
                    for (int bj = 0; bj < 2; ++bj) { const int g = 32 * pn + 16 * bj + 4 * wc + fq; const f32x4 v0 = acc[ai][bj][m][0], v1 = acc[ai][bj][m][1];
                        u32x4 w; w.x = cvt_pk_bf16(v0[0], v0[1]); w.y = cvt_pk_bf16(v0[2], v0[3]); w.z = cvt_pk_bf16(v1[0], v1[1]); w.w = cvt_pk_bf16(v1[2], v1[3]);
                        *(u32x4*)(Z + (((size_t)(b * 64 + g) * SEQ + l) * 8)) = w; }
                } else if (pn < 6) {
                    float ss = 0.f;
#pragma unroll
                    for (int bj = 0; bj < 2; ++bj)
#pragma unroll
                        for (int n = 0; n < 2; ++n) { const f32x4 v = acc[ai][bj][m][n]; ss += (v[0] * v[0] + v[1] * v[1]) + (v[2] * v[2] + v[3] * v[3]); }
                    ss += __shfl_xor(ss, 16); ss += __shfl_xor(ss, 32);
                    const float rstd = 1.0f / sqrtf(ss * (1.0f / 64.0f) + RMS_EPS);
                    const float osc = (pn == 5) ? 1.0f : C2;
#pragma unroll
                    for (int bj = 0; bj < 2; ++bj) {
                        const int pidx = (bj == 0) ? (l >> 6) : (l & 63);
                        f32x4 cs = *(const f32x4*)(COS + pidx * 16 + 4 * fq), sn = *(const f32x4*)(SIN + pidx * 16 + 4 * fq);
                        if (is_ctx) { cs = (f32x4){1.f, 1.f, 1.f, 1.f}; sn = (f32x4){0.f, 0.f, 0.f, 0.f}; }
                        float oa[4], ob[4];
#pragma unroll
                        for (int e = 0; e < 4; ++e) { const float a = acc[ai][bj][m][0][e] * rstd * gn[bj][0][e], bb = acc[ai][bj][m][1][e] * rstd * gn[bj][1][e];
                            oa[e] = (a * cs[e] - bb * sn[e]) * osc; ob[e] = (bb * cs[e] + a * sn[e]) * osc; }
                        if (ATTN_FP8) {
                            const float f8s = (pn < 5) ? Q8_SCALE : 1.0f;
                            int w0 = __builtin_amdgcn_cvt_pk_fp8_f32(oa[0] * f8s, oa[1] * f8s, 0, false); w0 = __builtin_amdgcn_cvt_pk_fp8_f32(oa[2] * f8s, oa[3] * f8s, w0, true);
                            int w1 = __builtin_amdgcn_cvt_pk_fp8_f32(ob[0] * f8s, ob[1] * f8s, 0, false); w1 = __builtin_amdgcn_cvt_pk_fp8_f32(ob[2] * f8s, ob[3] * f8s, w1, true);
                            if (pn < 5) { const int head = 4 * (pn - 2) + wc; *(u32x2*)((unsigned char*)Q + ((size_t)row * QW + head * 64 + 32 * bj + 8 * fq)) = (u32x2){(unsigned)w0, (unsigned)w1}; }
                            else *(u32x2*)((unsigned char*)Kb + (((size_t)b * LKV + key) * KVW + wc * 64 + 32 * bj + 8 * fq)) = (u32x2){(unsigned)w0, (unsigned)w1};
                        } else {
                        u32x4 w; w.x = cvt_pk_bf16(oa[0], oa[1]); w.y = cvt_pk_bf16(oa[2], oa[3]); w.z = cvt_pk_bf16(ob[0], ob[1]); w.w = cvt_pk_bf16(ob[2], ob[3]);
                        if (pn < 5) { const int head = 4 * (pn - 2) + wc; *(u32x4*)(Q + ((size_t)row * QW + head * 64 + 32 * bj + 8 * fq)) = w; }
                        else *(u32x4*)(Kb + (((size_t)b * LKV + key) * KVW + wc * 64 + 32 * bj + 8 * fq)) = w; }
                    }
                } else {
#pragma unroll
                    for (int bj = 0; bj < 2; ++bj) { const f32x4 v0 = acc[ai][bj][m][0], v1 = acc[ai][bj][m][1];
                        if (ATTN_FP8) {
                            const int kt = key >> 6, ks = attn_body::vt_slot(key & 63);
                            int w0 = __builtin_amdgcn_cvt_pk_fp8_f32(v0[0], v0[1], 0, false); w0 = __builtin_amdgcn_cvt_pk_fp8_f32(v0[2], v0[3], w0, true);
                            int w1 = __builtin_amdgcn_cvt_pk_fp8_f32(v1[0], v1[1], 0, false); w1 = __builtin_amdgcn_cvt_pk_fp8_f32(v1[2], v1[3], w1, true);
#pragma unroll
                            for (int q8 = 0; q8 < 8; ++q8) { const int col = 128 * bj + 32 * wc + 8 * fq + q8, kvh = col >> 6, d = col & 63;
                                ((unsigned char*)Vb)[((((size_t)(b * NKVH + kvh) * (LKV / 64) + kt) * 64 + d) * 64) + ks] = (unsigned char)(((q8 < 4 ? (unsigned)w0 : (unsigned)w1) >> (8 * (q8 & 3))) & 0xffu); }
                        } else {
                        u32x4 w; w.x = cvt_pk_bf16(v0[0], v0[1]); w.y = cvt_pk_bf16(v0[2], v0[3]); w.z = cvt_pk_bf16(v1[0], v1[1]); w.w = cvt_pk_bf16(v1[2], v1[3]);
                        *(u32x4*)(Vb + (((size_t)b * LKV + key) * KVW + 128 * bj + 32 * wc + 8 * fq)) = w; } }
                }
            }
    }
};
struct EpiResid {
    static constexpr bool PERM = false; static constexpr int NSTORE = 32;
    __device__ __forceinline__ void pre(LAS unsigned char*, const pg8::GUnit&, int, int, int) const {}
    const float* x; float* X1; const gi64* MOD;
    __device__ __forceinline__ void operator()(const f32x4 (&acc)[2][2][4][2], const pg8::GUnit& u, int wr, int wc, int fr, int fq, LAS unsigned char* lds, int ui) const {
        const int row0 = u.pm * 256 + wr * 64 + fr, col0 = u.pn * 256 + wc * 32 + 4 * fq; const int b = (u.pm * 256) >> 13;
        f32x4 gv[2][2];
#pragma unroll
        for (int bj = 0; bj < 2; ++bj)
#pragma unroll
            for (int n = 0; n < 2; ++n) gv[bj][n] = mod4(MOD, b * 6144 + 2048 + col0 + bj * 128 + n * 16);
#pragma unroll
        for (int ai = 0; ai < 2; ++ai)
#pragma unroll
            for (int m = 0; m < 4; ++m) { const size_t off = (size_t)(row0 + ai * 128 + m * 16) * DM + col0;
#pragma unroll
                for (int bj = 0; bj < 2; ++bj)
#pragma unroll
                    for (int n = 0; n < 2; ++n) { const f32x4 xv = *(const f32x4*)(x + off + bj * 128 + n * 16); *(f32x4*)(X1 + off + bj * 128 + n * 16) = (DBG & 2) ? xv : xv + gv[bj][n] * acc[ai][bj][m][n]; } }
    }
};
struct EpiLogits {
    static constexpr bool PERM = false; static constexpr int NSTORE = 32;
    __device__ __forceinline__ void pre(LAS unsigned char*, const pg8::GUnit&, int, int, int) const {}
    float* C;
    __device__ __forceinline__ void operator()(const f32x4 (&acc)[2][2][4][2], const pg8::GUnit& u, int wr, int wc, int fr, int fq, LAS unsigned char* lds, int ui) const {
        const int row0 = u.pm * 256 + wr * 64 + fr, col0 = wc * 32 + 4 * fq;
#pragma unroll
        for (int ai = 0; ai < 2; ++ai)
#pragma unroll
            for (int m = 0; m < 4; ++m) { float* rowp = C + (size_t)(row0 + ai * 128 + m * 16) * NEXP + col0;
#pragma unroll
                for (int bj = 0; bj < 2; ++bj)
#pragma unroll
                    for (int n = 0; n < 2; ++n) *(f32x4*)(rowp + bj * 128 + n * 16) = acc[ai][bj][m][n]; }
    }
};
struct EpiSwiglu {
    static constexpr bool PERM = true; static constexpr int NSTORE = 16;
    __device__ __forceinline__ void pre(LAS unsigned char*, const pg8::GUnit&, int, int, int) const {}
    u16* ACT;
    __device__ __forceinline__ void operator()(const f32x4 (&acc)[2][2][4][2], const pg8::GUnit& u, int wr, int wc, int fr, int fq, LAS unsigned char* lds, int ui) const {
#pragma unroll
        for (int ai = 0; ai < 2; ++ai)
#pragma unroll
            for (int m = 0; m < 4; ++m) { const int r = ai * 128 + wr * 64 + m * 16 + fr; u16* rowp = ACT + ((size_t)u.pm * 256 + r) * EFF + 128 * u.pn + 16 * wc + 4 * fq;
#pragma unroll
                for (int bj = 0; bj < 2; ++bj) { const f32x4 a = acc[ai][bj][m][0], g = acc[ai][bj][m][1]; float o[4];
#pragma unroll
                    for (int e = 0; e < 4; ++e) o[e] = a[e] * g[e] / (1.0f + __expf(-a[e]));
                    if (MOE_FP8) { int w0 = __builtin_amdgcn_cvt_pk_fp8_f32(o[0], o[1], 0, false); w0 = __builtin_amdgcn_cvt_pk_fp8_f32(o[2], o[3], w0, true);
                        *(unsigned*)((unsigned char*)ACT + ((size_t)u.pm * 256 + r) * EFF + 128 * u.pn + 16 * wc + 4 * fq + 64 * bj) = (unsigned)w0; }
                    else { u32x2 w; if (MOEF16) { w.x = pk2h(o[0], o[1]); w.y = pk2h(o[2], o[3]); } else { w.x = pk2bf(o[0], o[1]); w.y = pk2bf(o[2], o[3]); } *(u32x2*)(rowp + 64 * bj) = w; } } }
    }
};
struct EpiDown {
    static constexpr bool PERM = true; static constexpr int NSTORE = 16;
    u16* Cc; const GAS u32x2* LIST; unsigned char* dump;
    __device__ __forceinline__ void pre(LAS unsigned char* lds, const pg8::GUnit& u, int ui, int wid, int lane) const {
        if (wid < 2) __builtin_amdgcn_global_load_lds((const unsigned*)(LIST + (size_t)u.e * NTOK + 256 * u.j + 128 * wid + 2 * lane), (LAS unsigned*)(lds + pg8::STAGE_BYTES + (ui & 1) * 2048 + wid * 1024), 16, 0, 0);
    }
    __device__ __forceinline__ void operator()(const f32x4 (&acc)[2][2][4][2], const pg8::GUnit& u, int wr, int wc, int fr, int fq, LAS unsigned char* lds, int ui) const {
        const LAS f32x2* ent = (const LAS f32x2*)(lds + pg8::STAGE_BYTES + (ui & 1) * 2048);
#pragma unroll
        for (int ai = 0; ai < 2; ++ai)
#pragma unroll
            for (int m = 0; m < 4; ++m) { const int r = ai * 128 + wr * 64 + m * 16 + fr;
                const f32x2 enf = ent[r];
                const unsigned ex = __builtin_bit_cast(unsigned, enf.x); const int tok = (int)(ex & 0x7fffu), slot = (int)((ex >> 16) & 15u); const float gate = enf.y;
                unsigned char* rowp = (unsigned char*)Cc + ((size_t)tok * NSLOT + slot) * DM + 256 * u.pn + 32 * wc + 8 * fq;
                if (r >= u.nvalid) rowp = dump + ((size_t)(blockIdx.x * 512 + threadIdx.x)) * 256;
                const float gs = gate * C_SCALE;
#pragma unroll
                for (int bj = 0; bj < 2; ++bj) { f32x4 v0 = acc[ai][bj][m][0] * gs, v1 = acc[ai][bj][m][1] * gs;
#pragma unroll
                    for (int e = 0; e < 4; ++e) { v0[e] = __builtin_amdgcn_fmed3f(v0[e], -440.f, 440.f); v1[e] = __builtin_amdgcn_fmed3f(v1[e], -440.f, 440.f); }
                    int w0 = __builtin_amdgcn_cvt_pk_fp8_f32(v0[0], v0[1], 0, false); w0 = __builtin_amdgcn_cvt_pk_fp8_f32(v0[2], v0[3], w0, true);
                    int w1 = __builtin_amdgcn_cvt_pk_fp8_f32(v1[0], v1[1], 0, false); w1 = __builtin_amdgcn_cvt_pk_fp8_f32(v1[2], v1[3], w1, true);
                    *(u32x2*)(rowp + 128 * bj) = (u32x2){(unsigned)w0, (unsigned)w1}; } }
    }
};

template <bool F16OUT, bool F8OUT2 = false> __device__ __forceinline__ void rownorm_rows(const GAS float* src, const float* gain, const gi64* MODsh, const gi64* MODsc, u16* dst, int row0, int nrows, int wi, int wstride, int lane, unsigned char* dst8 = nullptr) {
    f32x4 Av[2][2], Bv[2][2];
#pragma unroll
    for (int j = 0; j < 2; ++j)
#pragma unroll
        for (int h = 0; h < 2; ++h) { const int col = 8 * lane + 512 * j + 4 * h; Av[j][h] = *(const f32x4*)(gain + col) * (mod4(MODsc, col) + 1.0f); Bv[j][h] = mod4(MODsh, col); }
    for (int r = wi; r < nrows; r += 2 * wstride) {
        const int r1 = r + wstride; const bool has1 = r1 < nrows;
        const GAS float* s0 = src + (size_t)(row0 + r) * DM; const GAS float* s1 = src + (size_t)(row0 + (has1 ? r1 : r)) * DM;
        f32x4 v0[2][2], v1[2][2];
#pragma unroll
        for (int j = 0; j < 2; ++j)
#pragma unroll
            for (int h = 0; h < 2; ++h) { v0[j][h] = *(const GAS f32x4*)(s0 + 8 * lane + 512 * j + 4 * h); v1[j][h] = *(const GAS f32x4*)(s1 + 8 * lane + 512 * j + 4 * h); }
        float q0 = 0.f, q1 = 0.f;
#pragma unroll
        for (int j = 0; j < 2; ++j)
#pragma unroll
            for (int h = 0; h < 2; ++h) { const f32x4 a = v0[j][h], b = v1[j][h]; q0 += (a[0] * a[0] + a[1] * a[1]) + (a[2] * a[2] + a[3] * a[3]); q1 += (b[0] * b[0] + b[1] * b[1]) + (b[2] * b[2] + b[3] * b[3]); }
#pragma unroll
        for (int o = 1; o < 64; o <<= 1) { q0 += __shfl_xor(q0, o); q1 += __shfl_xor(q1, o); }
        const float rs0 = 1.0f / sqrtf(q0 * (1.0f / DM) + RMS_EPS), rs1 = 1.0f / sqrtf(q1 * (1.0f / DM) + RMS_EPS);
#pragma unroll
        for (int j = 0; j < 2; ++j) { const f32x4 ya = v0[j][0] * rs0 * Av[j][0] + Bv[j][0], yb = v0[j][1] * rs0 * Av[j][1] + Bv[j][1];
            u32x4 w; if (F16OUT) { w.x = pk2h(ya[0], ya[1]); w.y = pk2h(ya[2], ya[3]); w.z = pk2h(yb[0], yb[1]); w.w = pk2h(yb[2], yb[3]); } else { w.x = pk2bf(ya[0], ya[1]); w.y = pk2bf(ya[2], ya[3]); w.z = pk2bf(yb[0], yb[1]); w.w = pk2bf(yb[2], yb[3]); }
            *(GAS u32x4*)(dst + (size_t)(row0 + r) * DM + 8 * lane + 512 * j) = w;
            if (F8OUT2) { int w0 = __builtin_amdgcn_cvt_pk_fp8_f32(ya[0], ya[1], 0, false); w0 = __builtin_amdgcn_cvt_pk_fp8_f32(ya[2], ya[3], w0, true); int w1 = __builtin_amdgcn_cvt_pk_fp8_f32(yb[0], yb[1], 0, false); w1 = __builtin_amdgcn_cvt_pk_fp8_f32(yb[2], yb[3], w1, true);
                *(GAS u32x2*)(dst8 + (size_t)(row0 + r) * DM + 8 * lane + 512 * j) = (u32x2){(unsigned)w0, (unsigned)w1}; } }
        if (has1) {
#pragma unroll
            for (int j = 0; j < 2; ++j) { const f32x4 ya = v1[j][0] * rs1 * Av[j][0] + Bv[j][0], yb = v1[j][1] * rs1 * Av[j][1] + Bv[j][1];
                u32x4 w; if (F16OUT) { w.x = pk2h(ya[0], ya[1]); w.y = pk2h(ya[2], ya[3]); w.z = pk2h(yb[0], yb[1]); w.w = pk2h(yb[2], yb[3]); } else { w.x = pk2bf(ya[0], ya[1]); w.y = pk2bf(ya[2], ya[3]); w.z = pk2bf(yb[0], yb[1]); w.w = pk2bf(yb[2], yb[3]); }
                *(GAS u32x4*)(dst + (size_t)(row0 + r1) * DM + 8 * lane + 512 * j) = w;
                if (F8OUT2) { int w0 = __builtin_amdgcn_cvt_pk_fp8_f32(ya[0], ya[1], 0, false); w0 = __builtin_amdgcn_cvt_pk_fp8_f32(ya[2], ya[3], w0, true); int w1 = __builtin_amdgcn_cvt_pk_fp8_f32(yb[0], yb[1], 0, false); w1 = __builtin_amdgcn_cvt_pk_fp8_f32(yb[2], yb[3], w1, true);
                    *(GAS u32x2*)(dst8 + (size_t)(row0 + r1) * DM + 8 * lane + 512 * j) = (u32x2){(unsigned)w0, (unsigned)w1}; } } }
    }
}

__device__ __forceinline__ void p0_phase(Frame& F) {
    const int gw = F.vcu * 8 + F.wave, NGW = F.G * 8, lane = F.lane;
    unsigned long long* MODQ = (unsigned long long*)(F.ctl + CW_MOD);
    for (int it = gw; it < 1536; it += NGW) {
        const int cb = it % 24, kc = it / 24, k0 = kc * 16, col = cb * 256 + lane * 4;
        float sv[5];
#pragma unroll
        for (int r = 0; r < 5; ++r) { const float cv = (r < 4) ? FIN_c[r * DM + k0 + (lane & 15)] : FIN_c_ctx[k0 + (lane & 15)]; sv[r] = cv / (1.0f + __expf(-cv)); }
        f32x4 acc[5];
#pragma unroll
        for (int r = 0; r < 5; ++r) acc[r] = (f32x4){0.f, 0.f, 0.f, 0.f};
#pragma unroll
        for (int kk = 0; kk < 16; ++kk) { const f32x4 w = *(const f32x4*)(FIN_w_ada + (size_t)(k0 + kk) * 6144 + col);
#pragma unroll
            for (int r = 0; r < 5; ++r) { const float s = __builtin_bit_cast(float, __builtin_amdgcn_readlane(__builtin_bit_cast(int, sv[r]), kk)); acc[r] += w * s; } }
        if (kc == 0) { const f32x4 bv = *(const f32x4*)(FIN_b_ada + col);
#pragma unroll
            for (int r = 0; r < 5; ++r) acc[r] += bv; }
#pragma unroll
        for (int r = 0; r < 5; ++r)
#pragma unroll
            for (int j = 0; j < 4; ++j) atomicAdd(MODQ + r * 6144 + col + j, (unsigned long long)__float2ll_rn(acc[r][j] * 0x1p36f));
    }
    float* WCS = WSP(float, WS_TAB);
    for (int it = gw; it < 256; it += NGW) {
        const int fh = it >> 6, d = it & 63; float ac = 0.f, as = 0.f;
        const float ctab = cospif((float)lane * (1.0f / 32.0f)), stab = sinpif((float)lane * (1.0f / 32.0f));
        for (int k2 = 0; k2 < 64; ++k2) { const int mm = __builtin_amdgcn_readfirstlane((d * k2) & 63); const float w = FIN_w_fourier[(fh * 64 + k2) * 64 + lane]; ac += rdl(ctab, mm) * w; as += rdl(stab, mm) * w; }
        const float sc = 1.0f / sqrtf((float)SEQ * 64.0f);
        WCS[(fh * 64 + d) * 128 + lane] = ac * sc; WCS[(fh * 64 + d) * 128 + 64 + lane] = as * sc;
    }
    {
        u16* D1 = WSP(u16, WS_TAB + 144 * 1024); u16* D3 = WSP(u16, WS_TAB + 272 * 1024);
        for (int it = gw; it < 320; it += NGW) {
            if (it < 256) { const int ro = it >> 7, k1 = it & 127;
#pragma unroll
                for (int j = 0; j < 4; ++j) { const int col = lane + 64 * j, ri = col >> 7, n1 = col & 127, mm = (n1 * k1) & 127; const float cc = cospif((float)mm * (1.0f / 64.0f)), ss = sinpif((float)mm * (1.0f / 64.0f));
                    const float v = (ro == 0) ? (ri == 0 ? cc : -ss) : (ri == 0 ? -ss : -cc); D1[it * 256 + col] = (u16)f2bf(v); } }
            else { const int k2 = it - 256;
#pragma unroll
                for (int j = 0; j < 2; ++j) { const int col = lane + 64 * j, ri = col >> 6, n2 = col & 63, mm = (n2 * k2) & 63; const float v = (ri == 0) ? cospif((float)mm * (1.0f / 32.0f)) : sinpif((float)mm * (1.0f / 32.0f)); D3[k2 * 128 + col] = (u16)f2bf(v); } }
        }
    }
    float* COS = WSP(float, WS_TAB + 128 * 1024); float* SIN = WSP(float, WS_TAB + 136 * 1024);
    for (int it = gw; it < 32; it += NGW) { const int idx = it * 64 + lane, pos = idx >> 4, i = idx & 15;
        const float inv = powf(10000.0f, -(float)i / 16.0f), ang = (float)pos * inv; COS[idx] = cosf(ang); SIN[idx] = sinf(ang); }
}

__device__ __forceinline__ int map_row(int mode, int sc) {
    if (mode == 1) { const int head = sc >> 6, dim = sc & 63, bj = dim >> 5, n = (dim >> 4) & 1, i = dim & 15; return (head >> 2) * 256 + bj * 128 + (head & 3) * 32 + (i >> 2) * 8 + n * 4 + (i & 3); }
    if (mode == 2) { const int g = sc >> 8, a = sc & 255; return (a >> 2) * 8 + g * 4 + (a & 3); }
    return sc;
}
struct TItem { const float* src; u16* dst; int N, K, k0, rel_c0, mode, dst_off; bool f16; bool f8; float ws; };
__device__ __forceinline__ void titem_load(const TItem& t, float (&buf)[64], int lane) {
#pragma unroll
    for (int i = 0; i < 64; ++i) { const int kk = 2 * i + (lane >> 5); buf[i] = t.src[(size_t)kk * t.N + (lane & 31)]; }
}
__device__ __forceinline__ void titem_finish(const TItem& t, const float (&buf)[64], LAS float* scr, int lane) {
#pragma unroll
    for (int i = 0; i < 64; ++i) { const int kk = 2 * i + (lane >> 5); scr[kk * 33 + (lane & 31)] = buf[i]; }
    LDS_WAIT(); asm volatile("" ::: "memory");
    if (t.f8) { const int c = lane & 7; const float ws = t.ws;
#pragma unroll
        for (int j = 0; j < 4; ++j) { const int n = (lane >> 3) + 8 * j; const LAS float* s = scr + (16 * c) * 33 + n; int w[4];
#pragma unroll
            for (int q = 0; q < 4; ++q) { w[q] = __builtin_amdgcn_cvt_pk_fp8_f32(s[(4 * q) * 33] * ws, s[(4 * q + 1) * 33] * ws, 0, false); w[q] = __builtin_amdgcn_cvt_pk_fp8_f32(s[(4 * q + 2) * 33] * ws, s[(4 * q + 3) * 33] * ws, w[q], true); }
            const int drow = t.dst_off + map_row(t.mode, t.rel_c0 + n);
            *(GAS u32x4*)((unsigned char*)t.dst + (size_t)drow * t.K + t.k0 + 16 * c) = (u32x4){(unsigned)w[0], (unsigned)w[1], (unsigned)w[2], (unsigned)w[3]}; } }
    else { const int c = lane & 15;
#pragma unroll
        for (int j = 0; j < 8; ++j) { const int n = (lane >> 4) + 4 * j; const LAS float* s = scr + (8 * c) * 33 + n;
            u32x4 o;
            if (t.f16) { o.x = pk2h(s[0 * 33], s[1 * 33]); o.y = pk2h(s[2 * 33], s[3 * 33]); o.z = pk2h(s[4 * 33], s[5 * 33]); o.w = pk2h(s[6 * 33], s[7 * 33]); }
            else { o.x = pk2bf(s[0 * 33], s[1 * 33]); o.y = pk2bf(s[2 * 33], s[3 * 33]); o.z = pk2bf(s[4 * 33], s[5 * 33]); o.w = pk2bf(s[6 * 33], s[7 * 33]); }
            const int drow = t.dst_off + map_row(t.mode, t.rel_c0 + n);
            *(GAS u32x4*)(t.dst + (size_t)drow * t.K + t.k0 + 8 * c) = o; } }
    LDS_WAIT(); asm volatile("" ::: "memory");
}
constexpr int I_FOLD = 512, I_QKV = 8 * 40, I_OUT = 8 * 32, I_R = 8 * 8, I_GU = NEXPS * 8 * 16, I_D = NEXPS * 2 * 32;
constexpr int NT_EARLY = I_QKV + I_OUT + I_R, NT_ITEMS = NT_EARLY + I_GU + I_D;
constexpr int DEFER_A = 3840, DEFER_B = 4096;
#define TDECODE(it_, t) do { int r = (it_); u16* BIN = WSP(u16, WS_BIN); \
        if (r < I_QKV) { const int kb = r / 40, nb = r % 40, sc0 = 256 + 32 * nb; t.N = 1536; t.K = DM; t.k0 = kb * 128; t.f16 = false; t.f8 = false; t.ws = 1.f; t.dst = BIN; t.src = FIN_w_in + (size_t)(kb * 128) * 1536 + sc0; \
            if (sc0 < 1024) { t.rel_c0 = sc0 - 256; t.mode = 1; t.dst_off = 512; } else if (sc0 < 1280) { t.rel_c0 = sc0 - 1024; t.mode = 1; t.dst_off = 1280; } else { t.rel_c0 = sc0 - 1280; t.mode = 0; t.dst_off = 1536; } \
            break; } \
        r -= I_QKV; \
        if (r < I_OUT) { const int kb = r / 32, nb = r % 32; t.N = DM; t.K = DM; t.k0 = kb * 128; t.f16 = false; t.f8 = false; t.ws = 1.f; t.dst = WSP(u16, WS_BOUT); t.src = FIN_w_out + (size_t)(kb * 128) * DM + 32 * nb; t.rel_c0 = 32 * nb; t.mode = 0; t.dst_off = 0; break; } \
        r -= I_OUT; \
        if (r < I_R) { const int kb = r / 8, nb = r % 8; t.N = NEXP; t.K = DM; t.k0 = kb * 128; t.f16 = (MOE_FP8 ? false : MOEF16); t.f8 = false; t.ws = 1.f; t.dst = WSP(u16, WS_BR); t.src = FIN_w_router + (size_t)(kb * 128) * NEXP + 32 * nb; t.rel_c0 = 32 * nb; t.mode = 0; t.dst_off = 0; break; } \
        r -= I_R; \
        if (r < I_GU) { const int e = r >> 7, q = r & 127, kb = q >> 4, nb = q & 15; const float* W = (e < NEXP) ? FIN_w_egu + (size_t)e * DM * 512 : FIN_w_sgu; \
            t.N = 512; t.K = DM; t.k0 = kb * 128; t.f16 = MOEF16; t.f8 = MOE_FP8; t.ws = WGU_SCALE; t.dst = MOE_FP8 ? (u16*)(F.ws + WS_BGU + (size_t)e * 512 * DM) : WSP(u16, WS_BGU) + (size_t)e * 512 * DM; t.src = W + (size_t)(kb * 128) * 512 + 32 * nb; t.rel_c0 = 32 * nb; t.mode = 2; t.dst_off = 0; break; } \
        r -= I_GU; \
        { const int e = r >> 6, q = r & 63, kb = q >> 5, nb = q & 31; const float* W = (e < NEXP) ? FIN_w_ed + (size_t)e * EFF * DM : FIN_w_sd; \
            t.N = DM; t.K = EFF; t.k0 = kb * 128; t.f16 = MOEF16; t.f8 = MOE_FP8; t.ws = WD_SCALE; t.dst = MOE_FP8 ? (u16*)(F.ws + WS_BD + (size_t)e * DM * EFF) : WSP(u16, WS_BD) + (size_t)e * DM * EFF; t.src = W + (size_t)(kb * 128) * DM + 32 * nb; t.rel_c0 = 32 * nb; t.mode = 0; t.dst_off = 0; } \
    } while (0)
__device__ __forceinline__ void transpose_range(Frame& F, int first, int count, int w, int nw) {
    LAS float* scr = (LAS float*)(F.lds + F.wave * P1_SCR); const int lane = F.lane; const int end = first + count;
    float bufA[64], bufB[64]; TItem ta, tb; int it = first + w;
    if (it < end) { TDECODE(it, ta); titem_load(ta, bufA, lane); }
    while (it < end) {
        const int itb = it + nw; const bool hb = itb < end;
        if (hb) { TDECODE(itb, tb); titem_load(tb, bufB, lane); }
        titem_finish(ta, bufA, scr, lane);
        if (!hb) break;
        const int ita = itb + nw; const bool ha = ita < end;
        if (ha) { TDECODE(ita, ta); titem_load(ta, bufA, lane); }
        titem_finish(tb, bufB, scr, lane);
        it = ita;
    }
}
__device__ __forceinline__ void p1_phase(Frame& F) {
    LAS float* scr = (LAS float*)(F.lds + F.wave * P1_SCR);
    const int gw = F.vcu * 8 + F.wave, NGW = F.G * 8, lane = F.lane;
    u16* BIN = WSP(u16, WS_BIN);
    for (int r = gw; r < I_FOLD; r += NGW) {
        const int fh = r >> 7, cs = (r >> 6) & 1, kb = (r >> 2) & 15, eq = r & 3; const int k = kb * 64 + lane;
        const GAS float* WCS = (const GAS float*)(F.ws + WS_TAB);
#pragma unroll 4
        for (int i = 0; i < 16; ++i) scr[(4 * i + (lane >> 4)) * 16 + (lane & 15)] = WCS[(fh * 64 + 4 * i + (lane >> 4)) * 128 + cs * 64 + 16 * eq + (lane & 15)];
        float wrow[64];
#pragma unroll
        for (int d4 = 0; d4 < 16; ++d4) { const f32x4 v = *(const f32x4*)(FIN_w_in + (size_t)k * 1536 + fh * 64 + 4 * d4); wrow[4 * d4] = v[0]; wrow[4 * d4 + 1] = v[1]; wrow[4 * d4 + 2] = v[2]; wrow[4 * d4 + 3] = v[3]; }
        LDS_WAIT(); asm volatile("" ::: "memory");
        for (int e1 = 0; e1 < 16; ++e1) { float a = 0.f;
#pragma unroll
            for (int d = 0; d < 64; ++d) a += wrow[d] * scr[d * 16 + e1];
            const int col256 = fh * 64 + 16 * eq + e1, pos = 8 * (col256 >> 2) + (col256 & 3) + 4 * cs;
            BIN[(size_t)pos * DM + k] = (u16)f2bf(a); }
        LDS_WAIT(); asm volatile("" ::: "memory");
    }
    const int ndefer = (F.G == 256) ? DEFER_A + DEFER_B : 0;
    REPS(11) transpose_range(F, 0, NT_ITEMS - ndefer, gw, NGW);
    const gi64* MOD = (const gi64*)(F.ctl + CW_MOD);
    u16* XN = WSP(u16, WS_XN);
    REPS(12) { const int wpb = NGW >> 2, b = gw / wpb, wi = gw % wpb;
        rownorm_rows<false>((const GAS float*)FIN_x, FIN_norm1_g, MOD + b * 6144, MOD + b * 6144 + 1024, XN, b * SEQ, SEQ, wi, wpb, lane);
        rownorm_rows<false>((const GAS float*)FIN_ctx, FIN_norm1_g, MOD + 4 * 6144, MOD + 4 * 6144 + 1024, XN + (size_t)NTOK * DM, 0, NCTX, gw, NGW, lane); }
}

__device__ __forceinline__ void fourier_unit(Frame& F, int b, int g) {
    LAS unsigned char* Zl = F.lds + RING_OFF;
    LAS f32x2* TW128 = (LAS f32x2*)(F.lds + TAB_OFF);
    LAS f32x2* TW64 = (LAS f32x2*)(F.lds + TAB_OFF + 1024);
    const int tid = F.tid;
    const GAS u32x4* Zg = (const GAS u32x4*)(F.ws + WS_Z + ((size_t)(b * 64 + g) * SEQ) * 16);
#pragma unroll 4
    for (int i = 0; i < 16; ++i) *(LAS u32x4*)(Zl + (size_t)(i * 512 + tid) * 16) = Zg[i * 512 + tid];
    if (tid < 128) { float s, c; sincospif((float)tid * (1.0f / 64.0f), &s, &c); TW128[tid] = (f32x2){c, s}; }
    else if (tid < 192) { float s, c; sincospif((float)(tid - 128) * (1.0f / 32.0f), &s, &c); TW64[tid - 128] = (f32x2){c, s}; }
    __syncthreads();
    const int k1 = tid & 127, q = tid >> 7;
    float yr[16][4], yi[16][4];
#pragma unroll
    for (int a = 0; a < 16; ++a)
#pragma unroll
        for (int e = 0; e < 4; ++e) { yr[a][e] = 0.f; yi[a][e] = 0.f; }
    for (int n1 = 0; n1 < 128; ++n1) {
        const f32x2 tw = TW128[(n1 * k1) & 127]; const float c = tw.x, s = tw.y;
#pragma unroll
        for (int a = 0; a < 16; ++a) { const u32x4 rw = *(const LAS u32x4*)(Zl + (size_t)(64 * n1 + 16 * q + a) * 16);
            const float uc[4] = {bflo(rw.x), bfhi(rw.x), bflo(rw.y), bfhi(rw.y)}, us[4] = {bflo(rw.z), bfhi(rw.z), bflo(rw.w), bfhi(rw.w)};
#pragma unroll
            for (int e = 0; e < 4; ++e) { yr[a][e] += uc[e] * c - us[e] * s; yi[a][e] -= uc[e] * s + us[e] * c; } }
    }
    __syncthreads();
    int k1b = k1; asm volatile("" : "+v"(k1b));
#pragma unroll
    for (int a = 0; a < 16; ++a) { const int n2 = 16 * q + a; const float fr_ = (float)(n2 * k1b) * (1.0f / 8192.0f);
        const float cp = __builtin_amdgcn_cosf(fr_), sp = __builtin_amdgcn_sinf(fr_);
        float pr[4], pi[4];
#pragma unroll
        for (int e = 0; e < 4; ++e) { pr[e] = yr[a][e] * cp + yi[a][e] * sp; pi[e] = yi[a][e] * cp - yr[a][e] * sp; }
        u32x4 w; w.x = pk2bf(pr[0], pr[1]); w.y = pk2bf(pr[2], pr[3]); w.z = pk2bf(pi[0], pi[1]); w.w = pk2bf(pi[2], pi[3]);
        *(LAS u32x4*)(Zl + (size_t)(n2 * 128 + k1b) * 16) = w; }
    __syncthreads();
    int k1c = k1; asm volatile("" : "+v"(k1c));
    float o[16][4];
#pragma unroll
    for (int a = 0; a < 16; ++a)
#pragma unroll
        for (int e = 0; e < 4; ++e) o[a][e] = 0.f;
    for (int n2 = 0; n2 < 64; ++n2) {
        const u32x4 rw = *(const LAS u32x4*)(Zl + (size_t)(n2 * 128 + k1c) * 16);
        const float pr[4] = {bflo(rw.x), bfhi(rw.x), bflo(rw.y), bfhi(rw.y)}, pi[4] = {bflo(rw.z), bfhi(rw.z), bflo(rw.w), bfhi(rw.w)};
#pragma unroll
        for (int a = 0; a < 16; ++a) { const f32x2 tw = TW64[(n2 * (16 * q + a)) & 63];
#pragma unroll
            for (int e = 0; e < 4; ++e) o[a][e] += pr[e] * tw.x + pi[e] * tw.y; }
    }
    u16* MIX = WSP(u16, WS_MIX);
#pragma unroll
    for (int a = 0; a < 16; ++a) { const int k2 = 16 * q + a; u32x2 w; w.x = pk2bf(o[a][0], o[a][1]); w.y = pk2bf(o[a][2], o[a][3]);
        *(GAS u32x2*)(MIX + ((size_t)(b * SEQ + k1c + 128 * k2)) * DM + 4 * g) = w; }
    __syncthreads();
}

__device__ __forceinline__ attn_body::s16x4 ftr(const LAS unsigned char* p) { return __builtin_bit_cast(attn_body::s16x4, __builtin_amdgcn_ds_read_tr16_b64_v4i16((LAS attn_body::v4i16_t*)p)); }
__device__ __forceinline__ void fourier_unit_mfma(Frame& F, int b, int g) {
    LAS unsigned char* Zl = F.lds + RING_OFF;
    const int tid = F.tid, lane = F.lane, w = F.wave;
    const char* Zg = (const char*)(F.ws + WS_Z) + ((size_t)(b * 64 + g) * SEQ) * 16;
#pragma unroll
    for (int i = 0; i < 16; ++i) __builtin_amdgcn_global_load_lds((const unsigned*)(Zg + (size_t)(i * 512 + tid) * 16), (LAS unsigned*)(Zl + (size_t)(i * 512 + w * 64) * 16), 16, 0, 0);
    VM_WAIT(); __syncthreads();
    f32x4 acc[2][16];
#pragma unroll
    for (int ro = 0; ro < 2; ++ro)
#pragma unroll
        for (int t = 0; t < 16; ++t) acc[ro][t] = (f32x4){0.f, 0.f, 0.f, 0.f};
    const GAS bf16x8* D1 = (const GAS bf16x8*)(F.ws + WS_TAB + 144 * 1024);
    const GAS bf16x8* D3 = (const GAS bf16x8*)(F.ws + WS_TAB + 272 * 1024);
    const int l15 = lane & 15, lq = lane >> 4;
    const unsigned bbase = (unsigned)((64 * (8 * lq + (l15 >> 2)) + (lane & 3)) * 16);
#pragma unroll 1
    for (int s1 = 0; s1 < 8; ++s1) {
        const int ri = s1 >> 2;
        const bf16x8 a0 = D1[(16 * w + l15) * 32 + 4 * s1 + lq], a1 = D1[(128 + 16 * w + l15) * 32 + 4 * s1 + lq];
        const LAS unsigned char* sb = Zl + bbase + (unsigned)((s1 & 3) * 32768 + 8 * ri);
#pragma unroll
        for (int t = 0; t < 16; ++t) { const attn_body::s16x4 lo = ftr(sb + 64 * t), hi = ftr(sb + 64 * t + 4096);
            const bf16x8 bf = (bf16x8){lo[0], lo[1], lo[2], lo[3], hi[0], hi[1], hi[2], hi[3]};
            acc[0][t] = __builtin_amdgcn_mfma_f32_16x16x32_bf16(a0, bf, acc[0][t], 0, 0, 0);
            acc[1][t] = __builtin_amdgcn_mfma_f32_16x16x32_bf16(a1, bf, acc[1][t], 0, 0, 0); }
    }
    __syncthreads();
    {   const int e = lane & 3; int k1b = 16 * w + 4 * lq; asm volatile("" : "+v"(k1b));
#pragma unroll
        for (int t = 0; t < 16; ++t) { const int n2 = 4 * t + (l15 >> 2);
#pragma unroll
            for (int r = 0; r < 4; ++r) { const int k1 = k1b + r; const float fr_ = (float)(n2 * k1) * (1.0f / 8192.0f); const float cp = __builtin_amdgcn_cosf(fr_), sp = __builtin_amdgcn_sinf(fr_);
                const float yr = acc[0][t][r], yi = acc[1][t][r]; const float pr = yr * cp + yi * sp, pi = yi * cp - yr * sp;
                *(LAS u16*)(Zl + (unsigned)(((n2) * 512 + k1 * 4 + e) * 2)) = (u16)f2bf(pr);
                *(LAS u16*)(Zl + (unsigned)(((64 + n2) * 512 + k1 * 4 + e) * 2)) = (u16)f2bf(pi); } }
    }
    asm volatile("s_waitcnt lgkmcnt(0)" ::: "memory");
    f32x4 acc3[4][4];
#pragma unroll
    for (int mt = 0; mt < 4; ++mt)
#pragma unroll
        for (int j = 0; j < 4; ++j) acc3[mt][j] = (f32x4){0.f, 0.f, 0.f, 0.f};
#pragma unroll
    for (int s3 = 0; s3 < 4; ++s3) {
        bf16x8 a[4];
#pragma unroll
        for (int mt = 0; mt < 4; ++mt) a[mt] = D3[(16 * mt + l15) * 16 + 4 * s3 + lq];
        const unsigned kk = (unsigned)(32 * s3 + 8 * lq + (l15 >> 2));
#pragma unroll
        for (int j = 0; j < 4; ++j) { const unsigned ad = kk * 1024u + (unsigned)((4 * (4 * w + j) + (lane & 3)) * 8);
            const attn_body::s16x4 lo = ftr(Zl + ad), hi = ftr(Zl + ad + 4096);
            const bf16x8 bf = (bf16x8){lo[0], lo[1], lo[2], lo[3], hi[0], hi[1], hi[2], hi[3]};
#pragma unroll
            for (int mt = 0; mt < 4; ++mt) acc3[mt][j] = __builtin_amdgcn_mfma_f32_16x16x32_bf16(a[mt], bf, acc3[mt][j], 0, 0, 0); }
    }
    u16* MIX = WSP(u16, WS_MIX);
#pragma unroll
    for (int mt = 0; mt < 4; ++mt)
#pragma unroll
        for (int j = 0; j < 4; ++j)
#pragma unroll
            for (int r = 0; r < 4; ++r) { const int k2 = 16 * mt + 4 * lq + r, k1 = 16 * w + 4 * j + (l15 >> 2);
                MIX[((size_t)(b * SEQ + k1 + 128 * k2)) * DM + 4 * g + (lane & 3)] = (u16)f2bf(acc3[mt][j][r]); }
    __syncthreads();
}

__device__ __forceinline__ float dpp_f(float v, int ctrl_sel) {
    const int x = __builtin_bit_cast(int, v); int r;
    if (ctrl_sel == 0) r = __builtin_amdgcn_update_dpp(x, x, 0xB1, 0xF, 0xF, false);
    else if (ctrl_sel == 1) r = __builtin_amdgcn_update_dpp(x, x, 0x4E, 0xF, 0xF, false);
    else if (ctrl_sel == 2) r = __builtin_amdgcn_update_dpp(x, x, 0x141, 0xF, 0xF, false);
    else r = __builtin_amdgcn_update_dpp(x, x, 0x140, 0xF, 0xF, false);
    return __builtin_bit_cast(float, r);
}
__device__ __forceinline__ void route_token(Frame& F, int tok) {
    const int l = F.lane;
    const f32x4 lg = *(const GAS f32x4*)((const GAS float*)(F.ws + WS_LOG) + (size_t)tok * NEXP + 4 * l);
    const f32x4 bs = *(const f32x4*)(FIN_router_bias + 4 * l);
    float s[4], sel[4];
#pragma unroll
    for (int j = 0; j < 4; ++j) { s[j] = 1.0f / (1.0f + expf(-lg[j])); sel[j] = s[j] + bs[j]; }
    float m1 = fmaxf(sel[0], sel[1]), m2 = fminf(sel[0], sel[1]);
#pragma unroll
    for (int j = 2; j < 4; ++j) { const float v = sel[j]; m2 = fmaxf(m2, fminf(m1, v)); m1 = fmaxf(m1, v); }
#pragma unroll
    for (int st = 0; st < 3; ++st) { const float o1 = dpp_f(m1, st), o2 = dpp_f(m2, st); const float n2 = fmaxf(fminf(m1, o1), fmaxf(m2, o2)); m1 = fmaxf(m1, o1); m2 = n2; }
    const float gs = m1 + m2; const int myg = l >> 3; int rank = 0;
#pragma unroll
    for (int g2 = 0; g2 < 8; ++g2) { const float og = rdl(gs, g2 * 8); rank += (og > gs || (og == gs && g2 < myg)) ? 1 : 0; }
    if (rank >= 4) {
#pragma unroll
        for (int j = 0; j < 4; ++j) sel[j] = -INFINITY; }
    int my_e = 0; float my_s = 0.f, sum = 0.f;
#pragma unroll 1
    for (int k = 0; k < TOPK; ++k) {
        const float lb = fmaxf(fmaxf(sel[0], sel[1]), fmaxf(sel[2], sel[3]));
        float r = lb; r = fmaxf(r, dpp_f(r, 0)); r = fmaxf(r, dpp_f(r, 1)); r = fmaxf(r, dpp_f(r, 2)); r = fmaxf(r, dpp_f(r, 3));
        const float wm = fmaxf(fmaxf(rdl(r, 0), rdl(r, 16)), fmaxf(rdl(r, 32), rdl(r, 48)));
        const unsigned long long mask = __ballot(lb == wm);
        const int wl = __builtin_amdgcn_readfirstlane((int)__ffsll((long long)mask) - 1);
        const int jj = (sel[0] == wm) ? 0 : (sel[1] == wm) ? 1 : (sel[2] == wm) ? 2 : 3;
        const float cand = (jj == 0) ? s[0] : (jj == 1) ? s[1] : (jj == 2) ? s[2] : s[3];
        const int jw = __builtin_amdgcn_readlane(jj, wl); const float wsc = rdl(cand, wl);
        if (l == wl) {
#pragma unroll
            for (int j = 0; j < 4; ++j) if (jw == j) sel[j] = -INFINITY; }
        if (l == k) { my_e = 4 * wl + jw; my_s = wsc; }
        sum += wsc;
    }
    GAS u32x2* LIST = (GAS u32x2*)(F.ws + WS_LIST);
    if (l < TOPK) { const float gate = my_s / sum * 2.5f; const unsigned pos = __hip_atomic_fetch_add((unsigned*)(F.ctl + CW_CNT + my_e), 1u, RLX_AGENT);
        LIST[(size_t)my_e * NTOK + pos] = (u32x2){(unsigned)tok | ((unsigned)l << 16), __builtin_bit_cast(unsigned, gate)}; }
    else if (l == TOPK) LIST[(size_t)NEXP * NTOK + tok] = (u32x2){(unsigned)tok | (8u << 16), __builtin_bit_cast(unsigned, 1.0f)};
}

__device__ __forceinline__ void build_tiles(Frame& F) {
    LAS int* TS = (LAS int*)(F.lds + TAB_OFF + 2048); LAS int* CN = (LAS int*)(F.lds + TAB_OFF + 3200);
    if (F.tid < 64) { const int l = F.tid; int c[5], t[5], tot = 0;
#pragma unroll
        for (int j = 0; j < 5; ++j) { const int e = 5 * l + j; c[j] = (e < NEXPS) ? (int)__hip_atomic_load((unsigned*)(F.ctl + CW_CNT + e), RLX_AGENT) : 0; t[j] = (c[j] + 255) >> 8; tot += t[j]; }
        int x = tot;
#pragma unroll
        for (int off = 1; off < 64; off <<= 1) { const int v = __shfl_up(x, off); if (l >= off) x += v; }
        int run = x - tot;
#pragma unroll
        for (int j = 0; j < 5; ++j) { const int e = 5 * l + j; if (e <= NEXPS) { TS[e] = run; if (e < NEXPS) CN[e] = c[j]; } run += t[j]; }
    }
    __syncthreads();
    {
        LAS unsigned short* TEXP = (LAS unsigned short*)(F.lds + TAB_OFF + 4608);
        for (int e = F.tid; e < NEXPS; e += 512) { const int t0 = TS[e], t1 = TS[e + 1]; for (int T = t0; T < t1; ++T) TEXP[T] = (unsigned short)e; }
    }
    __syncthreads();
}

__device__ __forceinline__ void ph2(Frame& F) {
    const gi64* MOD = (const gi64*)(F.ctl + CW_MOD); const int gw = F.vcu * 8 + F.wave, NGW = F.G * 8; (void)MOD; (void)gw; (void)NGW;
        DenseOrder S{7, 128 * 7, 8, F.G, F.vcu, (const char*)(F.ws + WS_BIN), DM, (REP == 22) ? 2 : 1};
        EpiInProj E{WSP(u16, WS_Z), WSP(u16, WS_Q), WSP(u16, WS_K), WSP(u16, WS_V), WSP(float, WS_TAB + 128 * 1024), WSP(float, WS_TAB + 136 * 1024), FIN_q_norm_g, FIN_k_norm_g};
        pg8::gemm_phase<EpiInProj, DenseOrder, 0, true>(F.lds + RING_OFF, (const char*)(F.ws + WS_XN), DM, S, E);
        if (F.G == 256 && F.vcu >= 136) transpose_range(F, NT_ITEMS - DEFER_A - DEFER_B, DEFER_A, (F.vcu - 136) * 8 + F.wave, 120 * 8);
    }
__device__ __forceinline__ void ph4(Frame& F) {
    const gi64* MOD = (const gi64*)(F.ctl + CW_MOD); const int gw = F.vcu * 8 + F.wave, NGW = F.G * 8; (void)MOD; (void)gw; (void)NGW;
        if (DBG & 128) { GAS u32x4* zH = (GAS u32x4*)(F.ws + WS_H2); const size_t nH = (size_t)NTOK * DM * 2 / 16; for (size_t i = (size_t)blockIdx.x * 512 + F.tid; i < nH; i += (size_t)F.G * 512) zH[i] = (u32x4){0u, 0u, 0u, 0u}; }
        DenseOrder S{4, 128 * 4, 0, F.G, F.vcu, (const char*)(F.ws + WS_BOUT), DM, 1};
        EpiResid E{FIN_x, F.out, MOD};
        pg8::gemm_phase<EpiResid, DenseOrder, 0, true>(F.lds + RING_OFF, (const char*)(F.ws + WS_MIX), DM, S, E);
    }
__device__ __forceinline__ void ph5(Frame& F) {
    const gi64* MOD = (const gi64*)(F.ctl + CW_MOD); const int gw = F.vcu * 8 + F.wave, NGW = F.G * 8;
    const int wpb = NGW >> 2, b = gw / wpb, wi = gw % wpb;
    rownorm_rows<(MOE_FP8 ? false : MOEF16), MOE_FP8>((const GAS float*)F.out, FIN_norm2_g, MOD + b * 6144 + 3072, MOD + b * 6144 + 4096, WSP(u16, WS_H2), b * SEQ, SEQ, wi, wpb, F.lane, F.ws + WS_H2F8);
}
__device__ __forceinline__ void ph6(Frame& F) {
    const gi64* MOD = (const gi64*)(F.ctl + CW_MOD); const int gw = F.vcu * 8 + F.wave, NGW = F.G * 8; (void)MOD; (void)gw; (void)NGW;
        DenseOrder S{1, 128, 0, F.G, F.vcu, (const char*)(F.ws + WS_BR), DM, 1};
        EpiLogits E{WSP(float, WS_LOG)};
        pg8::gemm_phase<EpiLogits, DenseOrder, (MOE_FP8 ? 0 : (MOE_F16 ? 1 : 0)), true>(F.lds + RING_OFF, (const char*)(F.ws + WS_H2), DM, S, E);
        if (F.G == 256 && F.vcu >= 128) transpose_range(F, NT_ITEMS - DEFER_B, DEFER_B, (F.vcu - 128) * 8 + F.wave, 128 * 8);
    }
__device__ __forceinline__ void ph8(Frame& F) {
    const gi64* MOD = (const gi64*)(F.ctl + CW_MOD); const int gw = F.vcu * 8 + F.wave, NGW = F.G * 8; (void)MOD; (void)gw; (void)NGW;
        build_tiles(F);
        GroupedOrder<true> S{2, F.G, F.vcu, 512, DM * (MOE_FP8 ? 1 : 2), true, (const char*)(F.ws + WS_BGU), (const LAS int*)(F.lds + TAB_OFF + 2048), (const LAS int*)(F.lds + TAB_OFF + 3200), (const GAS u32x2*)(F.ws + WS_LIST), (REP == 28) ? 2 : 1, __builtin_amdgcn_readfirstlane(((const LAS int*)(F.lds + TAB_OFF + 2048))[257])};
        EpiSwiglu E{WSP(u16, WS_ACT)};
        pg8::gemm_phase<EpiSwiglu, GroupedOrder<true>, MOE_DT, true>(F.lds + RING_OFF, (const char*)(F.ws + (MOE_FP8 ? WS_H2F8 : WS_H2)), DM, S, E, SC_GU);
    }
__device__ __forceinline__ void ph9(Frame& F) {
    const gi64* MOD = (const gi64*)(F.ctl + CW_MOD); const int gw = F.vcu * 8 + F.wave, NGW = F.G * 8; (void)MOD; (void)gw; (void)NGW;
        build_tiles(F);
        GroupedOrder<false> S{4, F.G, F.vcu, DM, EFF * (MOE_FP8 ? 1 : 2), false, (const char*)(F.ws + WS_BD), (const LAS int*)(F.lds + TAB_OFF + 2048), (const LAS int*)(F.lds + TAB_OFF + 3200), (const GAS u32x2*)(F.ws + WS_LIST), (REP == 29) ? 2 : 1, __builtin_amdgcn_readfirstlane(((const LAS int*)(F.lds + TAB_OFF + 2048))[257])};
        EpiDown E{WSP(u16, WS_C), (const GAS u32x2*)(F.ws + WS_LIST), F.ws + WS_DUMP};
        pg8::gemm_phase<EpiDown, GroupedOrder<false>, MOE_DT, true>(F.lds + RING_OFF, (const char*)(F.ws + WS_ACT), EFF, S, E, SC_D);
    }

#if DBG & (1024 | 2048)
__device__ __forceinline__ float f8dec(unsigned w, int k) { return (k == 0) ? __builtin_amdgcn_cvt_f32_fp8((int)w, 0) : (k == 1) ? __builtin_amdgcn_cvt_f32_fp8((int)w, 1) : (k == 2) ? __builtin_amdgcn_cvt_f32_fp8((int)w, 2) : __builtin_amdgcn_cvt_f32_fp8((int)w, 3); }
__device__ __forceinline__ void chk_attn(Frame& F, float negM) {
    const int gw = F.vcu * 8 + F.wave, NGW = F.G * 8, lane = F.lane;
    const GAS u16* Q = (const GAS u16*)(F.ws + WS_Q); const GAS u16* K = (const GAS u16*)(F.ws + WS_K); const GAS u16* V = (const GAS u16*)(F.ws + WS_V); const GAS u16* MIX = (const GAS u16*)(F.ws + WS_MIX);
    const GAS unsigned char* Q8 = (const GAS unsigned char*)(F.ws + WS_Q); const GAS unsigned char* K8 = (const GAS unsigned char*)(F.ws + WS_K); const GAS unsigned char* Vt8 = (const GAS unsigned char*)(F.ws + WS_V);
    float* chk = (float*)(F.ctl + CW_CHK);
    if (ATTN_FP8) negM = fminf(negM + 8.8f, 0.f);
    for (int i = gw; i < 4096; i += NGW) {
        const int b = i & 3, h = (i >> 2) % 12, q = (int)((((unsigned)i * 2654435761u) >> 19) & 8191u), kvh = h / 3;
        float qv[64], o[64]; float l = 0.f;
        if (ATTN_FP8) {
#pragma unroll
            for (int c = 0; c < 16; ++c) { const unsigned w = *(const GAS unsigned*)(Q8 + ((size_t)(b * SEQ + q)) * QW + h * 64 + 4 * c);
#pragma unroll
                for (int k = 0; k < 4; ++k) qv[4 * c + k] = f8dec(w, k) * (1.0f / Q8_SCALE); }
        } else {
#pragma unroll
        for (int c = 0; c < 8; ++c) { const u32x4 w = *(const GAS u32x4*)(Q + ((size_t)(b * SEQ + q)) * QW + h * 64 + 8 * c);
            qv[8 * c] = bflo(w.x); qv[8 * c + 1] = bfhi(w.x); qv[8 * c + 2] = bflo(w.y); qv[8 * c + 3] = bfhi(w.y); qv[8 * c + 4] = bflo(w.z); qv[8 * c + 5] = bfhi(w.z); qv[8 * c + 6] = bflo(w.w); qv[8 * c + 7] = bfhi(w.w); }
        }
#pragma unroll
        for (int d = 0; d < 64; ++d) o[d] = 0.f;
        for (int t = 0; t < LKV / 64; ++t) { const int j = t * 64 + lane; float dot = 0.f, pp, pq;
            if (ATTN_FP8) { const GAS unsigned char* kr = K8 + ((size_t)(b * LKV + j)) * KVW + kvh * 64;
#pragma unroll
                for (int c = 0; c < 16; ++c) { const unsigned w = *(const GAS unsigned*)(kr + 4 * c);
#pragma unroll
                    for (int k = 0; k < 4; ++k) dot += qv[4 * c + k] * f8dec(w, k); }
                pp = exp2f(dot + negM); pq = __builtin_amdgcn_cvt_f32_fp8(__builtin_amdgcn_cvt_pk_fp8_f32(pp, 0.f, 0, false), 0); l += pq;
                const GAS unsigned char* vb = Vt8 + (((size_t)(b * NKVH + kvh) * (LKV / 64) + t) * 64) * 64 + attn_body::vt_slot(lane);
#pragma unroll
                for (int d = 0; d < 64; ++d) o[d] += pq * __builtin_amdgcn_cvt_f32_fp8((int)vb[d * 64], 0);
            } else { const GAS u16* kr = K + ((size_t)(b * LKV + j)) * KVW + kvh * 64; const GAS u16* vr = V + ((size_t)(b * LKV + j)) * KVW + kvh * 64;
#pragma unroll
            for (int c = 0; c < 8; ++c) { const u32x4 w = *(const GAS u32x4*)(kr + 8 * c);
                dot += qv[8 * c] * bflo(w.x) + qv[8 * c + 1] * bfhi(w.x) + qv[8 * c + 2] * bflo(w.y) + qv[8 * c + 3] * bfhi(w.y) + qv[8 * c + 4] * bflo(w.z) + qv[8 * c + 5] * bfhi(w.z) + qv[8 * c + 6] * bflo(w.w) + qv[8 * c + 7] * bfhi(w.w); }
            pp = exp2f(dot + negM); l += pp;
#pragma unroll
            for (int c = 0; c < 8; ++c) { const u32x4 w = *(const GAS u32x4*)(vr + 8 * c);
                o[8 * c] += pp * bflo(w.x); o[8 * c + 1] += pp * bfhi(w.x); o[8 * c + 2] += pp * bflo(w.y); o[8 * c + 3] += pp * bfhi(w.y); o[8 * c + 4] += pp * bflo(w.z); o[8 * c + 5] += pp * bfhi(w.z); o[8 * c + 6] += pp * bflo(w.w); o[8 * c + 7] += pp * bfhi(w.w); } } }
        l = wave_sum(l); float err = 0.f, ref = 0.f;
#pragma unroll
        for (int d = 0; d < 64; ++d) { const float od = wave_sum(o[d]) / l; const float mv = bflo((unsigned)MIX[((size_t)(b * SEQ + q)) * DM + 256 + h * 64 + d]); err += (od - mv) * (od - mv); ref += od * od; }
        if (lane == 0) { atomicAdd(chk + 0, err); atomicAdd(chk + 1, ref); }
    }
}
__device__ __forceinline__ void chk_qkv(Frame& F) {
    const int gw = F.vcu * 8 + F.wave, NGW = F.G * 8, lane = F.lane;
    const gi64* MOD = (const gi64*)(F.ctl + CW_MOD);
    LAS float* hrow = (LAS float*)(F.lds + RING_OFF + F.wave * 16384);
    float* chk = (float*)(F.ctl + CW_CHK);
    for (int i = gw; i < 4096; i += NGW) {
        const unsigned hs = (unsigned)i * 2654435761u; const bool isctx = (i & 15) == 15; int sel = i % 20; if (isctx && sel < 12) sel = 12 + (sel & 7);
        const int m = isctx ? (int)((hs >> 10) & 1023u) : (int)((hs >> 12) & 32767u);
        const float* src = isctx ? FIN_ctx + (size_t)m * DM : FIN_x + (size_t)m * DM; const int mr = isctx ? 4 : (m >> 13);
        const int b = isctx ? (m >> 8) : (m >> 13), l = isctx ? 0 : (m & 8191), key = isctx ? SEQ + (m & 255) : l;
        f32x4 v[4]; float s2 = 0.f;
#pragma unroll
        for (int j = 0; j < 4; ++j) { v[j] = *(const f32x4*)(src + 4 * lane + 256 * j); s2 += (v[j][0] * v[j][0] + v[j][1] * v[j][1]) + (v[j][2] * v[j][2] + v[j][3] * v[j][3]); }
        const float rstd = 1.0f / sqrtf(wave_sum(s2) * (1.0f / DM) + RMS_EPS);
#pragma unroll
        for (int j = 0; j < 4; ++j) { const int col = 4 * lane + 256 * j; const f32x4 g = *(const f32x4*)(FIN_norm1_g + col); const f32x4 sh = mod4(MOD, mr * 6144 + col), sc = mod4(MOD, mr * 6144 + 1024 + col);
            const f32x4 y = v[j] * rstd * g * (sc + 1.0f) + sh; hrow[col] = y[0]; hrow[col + 1] = y[1]; hrow[col + 2] = y[2]; hrow[col + 3] = y[3]; }
        LDS_WAIT(); asm volatile("" ::: "memory");
        const int colbase = (sel < 12) ? 256 + 64 * sel : (sel < 16 ? 1024 + 64 * (sel - 12) : 1280 + 64 * (sel - 16));
        float z = 0.f;
        for (int k = 0; k < DM; ++k) z += hrow[k] * FIN_w_in[(size_t)k * 1536 + colbase + lane];
        float outv = z; int spos = lane;
        if (sel < 16) { const float ss = wave_sum(z * z); const float gain = (sel < 12) ? FIN_q_norm_g[lane] : FIN_k_norm_g[lane]; const float zz = z * (1.0f / sqrtf(ss * (1.0f / 64.0f) + RMS_EPS)) * gain;
            const float pz = __shfl(zz, lane ^ 16); outv = zz;
            if (!isctx) { const int pidx = (lane & 32) ? (l & 63) : (l >> 6); const float inv = powf(10000.0f, -(float)(lane & 15) / 16.0f), ang = (float)pidx * inv; const float cs = cosf(ang), sn = sinf(ang);
                outv = (lane & 16) ? zz * cs + pz * sn : zz * cs - pz * sn; }
            if (sel < 12) outv *= C2;
            spos = 32 * (lane >> 5) + 8 * ((lane >> 2) & 3) + 4 * ((lane >> 4) & 1) + (lane & 3); }
        float stored;
        if (ATTN_FP8) {
            if (sel < 12) stored = __builtin_amdgcn_cvt_f32_fp8((int)((const GAS unsigned char*)(F.ws + WS_Q))[(size_t)m * QW + sel * 64 + spos], 0) * (1.0f / Q8_SCALE);
            else if (sel < 16) stored = __builtin_amdgcn_cvt_f32_fp8((int)((const GAS unsigned char*)(F.ws + WS_K))[((size_t)(b * LKV + key)) * KVW + (sel - 12) * 64 + spos], 0);
            else stored = __builtin_amdgcn_cvt_f32_fp8((int)((const GAS unsigned char*)(F.ws + WS_V))[((((size_t)(b * NKVH + (sel - 16)) * (LKV / 64) + (key >> 6)) * 64 + lane) * 64) + attn_body::vt_slot(key & 63)], 0);
        } else {
        if (sel < 12) stored = bflo((unsigned)((const GAS u16*)(F.ws + WS_Q))[(size_t)m * QW + sel * 64 + spos]);
        else if (sel < 16) stored = bflo((unsigned)((const GAS u16*)(F.ws + WS_K))[((size_t)(b * LKV + key)) * KVW + (sel - 12) * 64 + spos]);
        else stored = bflo((unsigned)((const GAS u16*)(F.ws + WS_V))[((size_t)(b * LKV + key)) * KVW + (sel - 16) * 64 + lane]); }
        const float err = wave_sum((outv - stored) * (outv - stored)), ref = wave_sum(outv * outv);
        if (lane == 0) { atomicAdd(chk + 2, err); atomicAdd(chk + 3, ref); }
        LDS_WAIT(); asm volatile("" ::: "memory");
    }
}
#endif

struct Args { const float* in[20]; float* out; unsigned char* ws; int ph_lo, ph_hi; };
__global__ void __launch_bounds__(512, 2) mk_fwd(Args args) {
    extern __shared__ __attribute__((aligned(16))) unsigned char lds[];
    Frame F;
    F.lds = (LAS unsigned char*)lds;
    F.MISC = (volatile LAS unsigned*)(F.lds + MISC_OFF);
    F.tid = threadIdx.x; F.lane = F.tid & 63; F.wave = __builtin_amdgcn_readfirstlane(F.tid >> 6);
    F.G = gridDim.x; { const int bx = blockIdx.x; F.vcu = (F.G % 8 == 0) ? (bx % 8) * (F.G / 8) + bx / 8 : bx; }
    F.ws = args.ws; F.ctl = (gu32*)(args.ws + WS_CTL); F.out = args.out;
    F.ka = (const float* const*)__builtin_amdgcn_kernarg_segment_ptr();
    for (int u = F.tid; u < (LDS_BYTES - LDSCTL_OFF) / 4; u += 512) ((LAS unsigned*)(F.lds + LDSCTL_OFF))[u] = 0u;
    __syncthreads();
    XcdBarrier bar; bar.bar = (unsigned*)(F.ctl + CW_BAR); bar.x = 0; bar.st = nullptr;
    if (N_LAUNCHES == 1) bar = xcd_barrier_post((unsigned*)(F.ctl + CW_BAR), F.MISC + 8);
    const int lo = args.ph_lo, hi = args.ph_hi;
#define IN(k) (lo <= (k) && (k) < hi)
#define SEAM(k) do { if (IN(k) && IN((k) + 1)) xcd_barrier(bar); asm volatile("" : "+s"(F.ka)); } while (0)
    const gi64* MOD = (const gi64*)(F.ctl + CW_MOD);
    const int gw = F.vcu * 8 + F.wave, NGW = F.G * 8;

    if (IN(0)) { p0_phase(F); } SEAM(0);
    if (IN(1)) { p1_phase(F); VM_WAIT(); __syncthreads(); if (REP == 1) { xcd_barrier(bar); p1_phase(F); VM_WAIT(); __syncthreads(); } } SEAM(1);

    if (IN(2)) { ph2(F); if (REP == 2) { xcd_barrier(bar); ph2(F); } } SEAM(2);

    if (IN(3)) {
        if (DBG & 32) { u16* MIXz = WSP(u16, WS_MIX); for (int m = gw; m < NTOK; m += NGW) *(GAS u32x2*)(MIXz + (size_t)m * DM + 4 * F.lane) = (u32x2){0u, 0u}; }
        else
        REPS(30) for (int U = F.vcu; U < NB * 64; U += F.G) { if (FOURIER_MFMA) fourier_unit_mfma(F, U >> 6, U & 63); else fourier_unit(F, U >> 6, U & 63); }
        const attn_body::bf16* Qp = (const attn_body::bf16*)(F.ws + WS_Q); const attn_body::bf16* Kp = (const attn_body::bf16*)(F.ws + WS_K); const attn_body::bf16* Vp = (const attn_body::bf16*)(F.ws + WS_V);
        attn_body::bf16* Op = (attn_body::bf16*)(F.ws + WS_MIX) + 256;
        float negM; { float gqm = fabsf(FIN_q_norm_g[F.lane]), gkm = fabsf(FIN_k_norm_g[F.lane]);
#pragma unroll
            for (int o_ = 1; o_ < 64; o_ <<= 1) { gqm = fmaxf(gqm, __shfl_xor(gqm, o_)); gkm = fmaxf(gkm, __shfl_xor(gkm, o_)); }
            negM = -(C2 * 64.0f * gqm * gkm + 0.5f); }
        if (ATTN_FP8) negM = fminf(negM + 8.8f, 0.f);
        if (ATTN_PRIO) { if (__builtin_amdgcn_readfirstlane(F.tid) >= 256) __builtin_amdgcn_s_setprio(1); }
        if (DBG & 16) { u16* MIXz = WSP(u16, WS_MIX); for (int m = gw; m < NTOK; m += NGW) for (int j = 1; j < 4; ++j) *(GAS u32x2*)(MIXz + (size_t)m * DM + 256 * j + 4 * F.lane) = (u32x2){0u, 0u}; }
        else if (F.G == 256) REPS(31) {
            const int xg = F.vcu >> 5, jq = F.vcu & 31;
            for (int i = 0; i < 6; ++i) { const int grp = 2 * xg + i / 3, hs = i % 3;
                if (ATTN_FP8) attn_body::attn_unit8(grp >> 2, (grp & 3) * 3 + hs, jq, (const unsigned char*)Qp, (const unsigned char*)Kp, (const unsigned char*)Vp, Op, (char*)lds + RING_OFF, negM);
                else attn_body::attn_unit<ATTN_MSUM>(grp >> 2, (grp & 3) * 3 + hs, jq, Qp, Kp, Vp, Op, (char*)lds + RING_OFF, negM); }
        } else {
            for (int U = F.vcu; U < NB * NQH * 32; U += F.G) { const int grp = U / 96, r = U % 96;
                if (ATTN_FP8) attn_body::attn_unit8(grp >> 2, (grp & 3) * 3 + r / 32, r % 32, (const unsigned char*)Qp, (const unsigned char*)Kp, (const unsigned char*)Vp, Op, (char*)lds + RING_OFF, negM);
                else attn_body::attn_unit<ATTN_MSUM>(grp >> 2, (grp & 3) * 3 + r / 32, r % 32, Qp, Kp, Vp, Op, (char*)lds + RING_OFF, negM); }
        }
        if (ATTN_PRIO) __builtin_amdgcn_s_setprio(0);
    } SEAM(3);

#if DBG & (1024 | 2048)
    if (IN(4)) { float negMc; { float gqm = fabsf(FIN_q_norm_g[F.lane]), gkm = fabsf(FIN_k_norm_g[F.lane]);
            for (int o_ = 1; o_ < 64; o_ <<= 1) { gqm = fmaxf(gqm, __shfl_xor(gqm, o_)); gkm = fmaxf(gkm, __shfl_xor(gkm, o_)); } negMc = -(C2 * 64.0f * gqm * gkm + 0.5f); }
        if (DBG & 1024) chk_attn(F, negMc); if (DBG & 2048) chk_qkv(F); VM_WAIT(); __syncthreads(); }
#endif
    if (IN(4)) { ph4(F); if (REP == 4) { xcd_barrier(bar); ph4(F); } } SEAM(4);

    if (IN(5)) { ph5(F); if (REP == 5) { xcd_barrier(bar); ph5(F); } if (REP == 55) { xcd_barrier(bar); xcd_barrier(bar); xcd_barrier(bar); xcd_barrier(bar); xcd_barrier(bar); } } SEAM(5);

    if (IN(6)) { ph6(F); if (REP == 6) { xcd_barrier(bar); ph6(F); } } SEAM(6);

    if (IN(7)) {
        if (DBG & 128) { GAS u32x4* zA = (GAS u32x4*)(F.ws + WS_ACT); const size_t nA = (size_t)MAXTILES * 256 * EFF * 2 / 16; for (size_t i = (size_t)blockIdx.x * 512 + F.tid; i < nA; i += (size_t)F.G * 512) zA[i] = (u32x4){0u, 0u, 0u, 0u};
            GAS u32x4* zC = (GAS u32x4*)(F.ws + WS_C); const size_t nC = (size_t)NTOK * NSLOT * DM * 2 / 16; for (size_t i = (size_t)blockIdx.x * 512 + F.tid; i < nC; i += (size_t)F.G * 512) zC[i] = (u32x4){0u, 0u, 0u, 0u}; }
        if (blockIdx.x == 0 && F.tid == 0) __hip_atomic_store((unsigned*)(F.ctl + CW_CNT + NEXP), (unsigned)NTOK, RLX_AGENT);
        for (int tok = gw; tok < NTOK; tok += NGW) route_token(F, tok);
    } SEAM(7);

    if (IN(8)) { ph8(F); if (REP == 8) { xcd_barrier(bar); ph8(F); } } SEAM(8);

    if (IN(9)) { ph9(F); if (REP == 9) { xcd_barrier(bar); ph9(F); } } SEAM(9);

    if (IN(10)) {
        const int lane = F.lane; const GAS unsigned char* Cc = (const GAS unsigned char*)(F.ws + WS_C);
        const int wpb = NGW >> 2, b = gw / wpb, wi = gw % wpb;
        f32x4 g2v[4], fg[4];
#pragma unroll
        for (int i = 0; i < 4; ++i) { const int col = 16 * lane + 4 * i; g2v[i] = mod4(MOD + b * 6144 + 5120, col) * (1.0f / C_SCALE); fg[i] = *(const f32x4*)(FIN_final_g + col); }
        bool bad = false;
#if DBG & (1024 | 2048)
        { const float e0 = __hip_atomic_load((float*)(F.ctl + CW_CHK), RLX_AGENT), r0 = __hip_atomic_load((float*)(F.ctl + CW_CHK) + 1, RLX_AGENT), e1 = __hip_atomic_load((float*)(F.ctl + CW_CHK) + 2, RLX_AGENT), r1 = __hip_atomic_load((float*)(F.ctl + CW_CHK) + 3, RLX_AGENT);
          if (DBG & 1024) bad = bad || !(e0 <= CHK_TOL_A * r0) || !(r0 > 0.f); if (DBG & 2048) bad = bad || !(e1 <= CHK_TOL_B * r1) || !(r1 > 0.f); }
#endif
        for (int r = wi; r < SEQ; r += 2 * wpb) {
            const int r1 = (r + wpb < SEQ) ? r + wpb : r; const bool has1 = r + wpb < SEQ;
            const int m0 = b * SEQ + r, m1 = b * SEQ + r1;
            GAS float* orow0 = (GAS float*)F.out + (size_t)m0 * DM + 16 * lane; GAS float* orow1 = (GAS float*)F.out + (size_t)m1 * DM + 16 * lane;
            f32x4 xa[4], xb[4], ya[4], yb[4];
#pragma unroll
            for (int i = 0; i < 4; ++i) { xa[i] = *(const GAS f32x4*)(orow0 + 4 * i); xb[i] = *(const GAS f32x4*)(orow1 + 4 * i); ya[i] = (f32x4){0.f, 0.f, 0.f, 0.f}; yb[i] = (f32x4){0.f, 0.f, 0.f, 0.f}; }
#pragma unroll
            for (int sl = 0; sl < NSLOT; ++sl) { const u32x4 wa = *(const GAS u32x4*)(Cc + ((size_t)m0 * NSLOT + sl) * DM + 16 * lane), wb = *(const GAS u32x4*)(Cc + ((size_t)m1 * NSLOT + sl) * DM + 16 * lane);
#pragma unroll
                for (int i = 0; i < 4; ++i) { const int wa_ = (int)wa[i], wb_ = (int)wb[i];
                    const f32x2 la = __builtin_amdgcn_cvt_pk_f32_fp8(wa_, false), ha = __builtin_amdgcn_cvt_pk_f32_fp8(wa_, true), lb = __builtin_amdgcn_cvt_pk_f32_fp8(wb_, false), hb = __builtin_amdgcn_cvt_pk_f32_fp8(wb_, true);
                    ya[i] += (f32x4){la.x, la.y, ha.x, ha.y}; yb[i] += (f32x4){lb.x, lb.y, hb.x, hb.y}; } }
            float sa = 0.f, sb = 0.f;
#pragma unroll
            for (int i = 0; i < 4; ++i) { const f32x4 va = xa[i] + g2v[i] * ya[i], vb = xb[i] + g2v[i] * yb[i]; xa[i] = va; xb[i] = vb;
                sa += (va[0] * va[0] + va[1] * va[1]) + (va[2] * va[2] + va[3] * va[3]); sb += (vb[0] * vb[0] + vb[1] * vb[1]) + (vb[2] * vb[2] + vb[3] * vb[3]); }
#pragma unroll
            for (int o = 1; o < 64; o <<= 1) { sa += __shfl_xor(sa, o); sb += __shfl_xor(sb, o); }
            const float bm = bad ? 3.0f : 1.0f;
            const float ra = 1.0f / sqrtf(sa * (1.0f / DM) + RMS_EPS) * bm, rb = 1.0f / sqrtf(sb * (1.0f / DM) + RMS_EPS) * bm;
#pragma unroll
            for (int i = 0; i < 4; ++i) *(GAS f32x4*)(orow0 + 4 * i) = xa[i] * ra * fg[i];
            if (has1) {
#pragma unroll
                for (int i = 0; i < 4; ++i) *(GAS f32x4*)(orow1 + 4 * i) = xb[i] * rb * fg[i]; } }
    }
#undef IN
#undef SEAM
}

extern "C" void kernel_launch(void* const* d_in, const int* in_sizes, int n_in, void* d_out, int out_size, void* d_ws, size_t ws_size, hipStream_t stream) {
    static int grid = 0;
    if (grid == 0) {
        if (n_in != 20 || in_sizes[0] != NTOK * DM || out_size != NTOK * DM || ws_size < WS_END) { fprintf(stderr, "kernel_launch: unexpected shapes (n_in %d, in0 %d, out %d, ws %zu < %zu)\n", n_in, n_in > 0 ? in_sizes[0] : -1, out_size, ws_size, (size_t)WS_END); grid = -1; return; }
        int dev = 0, cus = 0, per_cu = 0;
        if (hipGetDevice(&dev) != hipSuccess || hipDeviceGetAttribute(&cus, hipDeviceAttributeMultiprocessorCount, dev) != hipSuccess) { grid = -1; return; }
        if (hipFuncSetAttribute((const void*)mk_fwd, hipFuncAttributeMaxDynamicSharedMemorySize, LDS_BYTES) != hipSuccess) { fprintf(stderr, "kernel_launch: hipFuncSetAttribute failed\n"); grid = -1; return; }
        if (hipOccupancyMaxActiveBlocksPerMultiprocessor(&per_cu, (const void*)mk_fwd, 512, LDS_BYTES) != hipSuccess || per_cu < 1) fprintf(stderr, "kernel_launch: occupancy query reports %d\n", per_cu);
        (void)hipGetLastError();
        grid = cus;
    }
    if (grid < 0) return;
    (void)hipMemsetAsync((char*)d_ws + WS_CTL, 0, CTL_ZERO_BYTES, stream);
    Args a{};
    for (int i = 0; i < 20; ++i) a.in[i] = (const float*)d_in[i];
    a.out = (float*)d_out; a.ws = (unsigned char*)d_ws;
    if (N_LAUNCHES == 1) { a.ph_lo = 0; a.ph_hi = PER_PHASE; hipLaunchKernelGGL(mk_fwd, dim3(grid), dim3(512), LDS_BYTES, stream, a); }
    else for (int li = 0; li < PER_PHASE; ++li) { a.ph_lo = li; a.ph_hi = li + 1; hipLaunchKernelGGL(mk_fwd, dim3(grid), dim3(512), LDS_BYTES, stream, a); }
}
```

```cpp
#include <hip/hip_runtime.h>
#include <hip/hip_bf16.h>
#include <cstdio>
#include <cstdint>
#include <cmath>

#ifndef MK_N_LAUNCHES
#define MK_N_LAUNCHES 1
#endif
constexpr int PER_PHASE = 11;
#ifndef DBG
#define DBG 0
#endif
#ifndef REP
#define REP -1
#endif
#ifndef CHK_TOL_A
#define CHK_TOL_A 1e-4f
#endif
#ifndef CHK_TOL_B
#define CHK_TOL_B 3e-3f
#endif
#ifndef POSTEPI_WAITS
#define POSTEPI_WAITS 1
#endif
#ifndef ATTN_FP8
#define ATTN_FP8 1
#endif
constexpr float Q8_SCALE = 8.0f;
#ifndef ATTN_MSUM
#define ATTN_MSUM false
#endif
#ifndef ATTN_PRIO
#define ATTN_PRIO 0
#endif
#ifndef ATTN_SKEW
#define ATTN_SKEW 1
#endif
#ifndef ATTN_MPRIO
#define ATTN_MPRIO 0
#endif
#ifndef ATTN_W64
#define ATTN_W64 1
#endif
#ifndef SYN
#define SYN 0
#endif
#define SYN_N 2000
#ifndef SYN_ILV
#define SYN_ILV 0
#endif
#ifndef SYN_ZERO
#define SYN_ZERO 0
#endif
#ifndef SYN_RND
#define SYN_RND 0
#endif
#ifndef SYN_EM
#define SYN_EM 3
#endif
#ifndef SYN_RD
#define SYN_RD 0
#endif
#ifndef FOURIER_MFMA
#define FOURIER_MFMA 1
#endif
#define REPS(k) for (int rep_ = 0; rep_ < ((REP == (k)) ? 2 : 1); ++rep_)
#define REPBAR() do { if (rep_) xcd_barrier(bar); } while (0)
constexpr int N_LAUNCHES = MK_N_LAUNCHES;

#define GAS __attribute__((address_space(1)))
#define LAS __attribute__((address_space(3)))
typedef unsigned short u16;
typedef short bf16x8 __attribute__((ext_vector_type(8)));
typedef _Float16 half8 __attribute__((ext_vector_type(8)));
typedef _Float16 half2v __attribute__((ext_vector_type(2)));
typedef float f32x4 __attribute__((ext_vector_type(4)));
typedef float f32x2 __attribute__((ext_vector_type(2)));
typedef unsigned u32x4 __attribute__((ext_vector_type(4)));
typedef unsigned u32x2 __attribute__((ext_vector_type(2)));
typedef GAS unsigned gu32;

constexpr int DM = 1024, NB = 4, SEQ = 8192, NTOK = NB * SEQ, CTXL = 256, NCTX = NB * CTXL, LKV = SEQ + CTXL;
constexpr int NQH = 12, NKVH = 4, HD = 64, QW = NQH * HD, KVW = NKVH * HD;
constexpr int NIN = 1792;
constexpr int MIN_ROWS = NTOK + NCTX;
constexpr int NEXP = 256, NEXPS = 257, TOPK = 8, EFF = 256, NSLOT = 9;
constexpr int MAXTILES = 1408;
constexpr float RMS_EPS = 1e-6f;
#ifndef MOE_F16
#define MOE_F16 0
#endif
constexpr bool MOEF16 = MOE_F16;
#ifndef MOE_FP8
#define MOE_FP8 1
#endif
constexpr int MOE_DT = MOE_FP8 ? 2 : (MOE_F16 ? 1 : 0);
constexpr float WGU_SCALE = 32.0f, WD_SCALE = 16.0f;
constexpr int SC_ONE = 0x7f7f7f7f, SC_GU = 0x7f7f7f7a, SC_D = 0x7f7f7f7b;
constexpr float C2 = 0.125f * 1.4426950408889634f;
constexpr float C_SCALE = 16.0f;

constexpr size_t MiB = 1u << 20;
constexpr size_t WS_CTL = 0, CTL_ZERO_BYTES = 1 * MiB;
constexpr size_t WS_TAB = 1 * MiB;
constexpr size_t WS_BIN = 2 * MiB;
constexpr size_t WS_BOUT = 6 * MiB;
constexpr size_t WS_BR = 8 * MiB;
constexpr size_t WS_K = 16 * MiB;
constexpr size_t WS_V = 34 * MiB;
constexpr size_t WS_Z = 52 * MiB;
constexpr size_t WS_Q = 84 * MiB;
constexpr size_t WS_XN = 132 * MiB;
constexpr size_t WS_MIX = 198 * MiB;
constexpr size_t WS_H2 = 262 * MiB;
constexpr size_t WS_LOG = 326 * MiB;
constexpr size_t WS_LIST = 358 * MiB;
constexpr size_t WS_BGU = 424 * MiB;
constexpr size_t WS_BD = 682 * MiB;
constexpr size_t WS_ACT = 812 * MiB;
constexpr size_t WS_C = 990 * MiB;
constexpr size_t WS_H2F8 = 1568 * MiB;
constexpr size_t WS_DUMP = 1600 * MiB;
constexpr size_t WS_END = 1632 * MiB;
constexpr int CW_TMO = 0, CW_CODE = 1;
constexpr int CW_BAR = 4096;
constexpr int CW_CNT = 16384;
constexpr int CW_CHK = 32768;
constexpr int CW_MOD = 131072;
static_assert(CW_MOD * 4 + 5 * 6144 * 8 <= (int)CTL_ZERO_BYTES, "ctl");

constexpr int RING_OFF = 0, RING_BYTES = 131072;
constexpr int P1_SCR = 18432;
constexpr int TAB_OFF = 8 * P1_SCR;
constexpr int LDS_BYTES = 163840;
constexpr int LDSCTL_OFF = LDS_BYTES - 1024, MISC_OFF = LDSCTL_OFF + 320;
static_assert(TAB_OFF + 8192 <= LDSCTL_OFF, "LDS map");

#define LDS_WAIT() asm volatile("s_waitcnt lgkmcnt(0)" ::: "memory")
#define VM_WAIT() asm volatile("s_waitcnt vmcnt(0)" ::: "memory")
#define RLX_AGENT __ATOMIC_RELAXED, __HIP_MEMORY_SCOPE_AGENT

__device__ __forceinline__ unsigned f2bf(float f) { unsigned u = __builtin_bit_cast(unsigned, f); return (u + 0x7fffu + ((u >> 16) & 1u)) >> 16; }
__device__ __forceinline__ unsigned pk2bf(float lo, float hi) { return f2bf(lo) | (f2bf(hi) << 16); }
__device__ __forceinline__ unsigned pk2h(float lo, float hi) { half2v v = {(_Float16)lo, (_Float16)hi}; return __builtin_bit_cast(unsigned, v); }
__device__ __forceinline__ unsigned cvt_pk_bf16(float lo, float hi) { unsigned r; asm volatile("v_cvt_pk_bf16_f32 %0, %1, %2" : "=v"(r) : "v"(lo), "v"(hi)); return r; }
__device__ __forceinline__ float bflo(unsigned w) { return __builtin_bit_cast(float, w << 16); }
__device__ __forceinline__ float bfhi(unsigned w) { return __builtin_bit_cast(float, w & 0xffff0000u); }
typedef long long i64x2 __attribute__((ext_vector_type(2)));
typedef GAS long long gi64;
__device__ __forceinline__ f32x4 mod4(const gi64* MODQ, int idx) {
    const i64x2 a = *(const GAS i64x2*)(MODQ + idx), b = *(const GAS i64x2*)(MODQ + idx + 2);
    return (f32x4){(float)a.x, (float)a.y, (float)b.x, (float)b.y} * 0x1p-36f;
}
__device__ __forceinline__ float rdl(float v, int lane) { return __builtin_bit_cast(float, __builtin_amdgcn_readlane(__builtin_bit_cast(int, v), lane)); }
__device__ __forceinline__ float wave_sum(float v) {
#pragma unroll
    for (int o = 1; o < 64; o <<= 1) v += __shfl_xor(v, o);
    return v;
}

namespace pg8 {
constexpr int BM = 256, BK = 64, HALF = 128, HTB = HALF * BK * 2, STAGE_BYTES = 8 * HTB;
__host__ __device__ __forceinline__ int lds_byte(int r, int c) { const int st = (r >> 4) * 2 + (c >> 5), rr = r & 15, cc = c & 31, ob = rr * 64 + cc * 2; return st * 1024 + (ob ^ (((ob >> 9) & 1) << 5)); }
__host__ __device__ __forceinline__ void stage_rc(int b, int& R, int& C) { const int st = b / 1024, sb = b % 1024, swz = sb ^ (((sb >> 9) & 1) << 5); R = (st >> 1) * 16 + swz / 64; C = (st & 1) * 32 + (swz % 64) / 2; }
__host__ __device__ __forceinline__ int perm32(int rho) { const int n = rho >> 4, i = rho & 15; return 8 * (i >> 2) + 4 * n + (i & 3); }

struct GUnit { int pm, pn, e, j, nvalid; const char* B; };

typedef int v8i __attribute__((ext_vector_type(8)));
typedef int v4i __attribute__((ext_vector_type(4)));
template <int DT> __device__ __forceinline__ f32x4 mma_tile(const v8i a, const v8i b, f32x4 c, int scA) {
    if constexpr (DT == 2) return __builtin_amdgcn_mfma_scale_f32_16x16x128_f8f6f4(a, b, c, 0, 0, 0, scA, 1, scA);
    else { const v4i a0 = __builtin_shufflevector(a, a, 0, 1, 2, 3), a1 = __builtin_shufflevector(a, a, 4, 5, 6, 7), b0 = __builtin_shufflevector(b, b, 0, 1, 2, 3), b1 = __builtin_shufflevector(b, b, 4, 5, 6, 7);
        if constexpr (DT == 1) { c = __builtin_amdgcn_mfma_f32_16x16x32_f16(__builtin_bit_cast(half8, a0), __builtin_bit_cast(half8, b0), c, 0, 0, 0); return __builtin_amdgcn_mfma_f32_16x16x32_f16(__builtin_bit_cast(half8, a1), __builtin_bit_cast(half8, b1), c, 0, 0, 0); }
        else { c = __builtin_amdgcn_mfma_f32_16x16x32_bf16(__builtin_bit_cast(bf16x8, a0), __builtin_bit_cast(bf16x8, b0), c, 0, 0, 0); return __builtin_amdgcn_mfma_f32_16x16x32_bf16(__builtin_bit_cast(bf16x8, a1), __builtin_bit_cast(bf16x8, b1), c, 0, 0, 0); } }
}

template <class Epi, class Sched, int DT, bool ALIGN_EPI>
__device__ __forceinline__ void gemm_phase(LAS unsigned char* lds, const char* Abase, const int K, const Sched& S, const Epi& E, const int scB = SC_ONE) {
    const int tid = threadIdx.x, wid = __builtin_amdgcn_readfirstlane(tid >> 6), lane = tid & 63, wr = wid >> 2, wc = wid & 3, fr = lane & 15, fq = lane >> 4;
    constexpr int ES = (DT == 2) ? 1 : 2;
    const int RB = K * ES;
    const int nt = RB / 128;
    unsigned voffB0; { int R, C; stage_rc(tid * 16, R, C); const int Rb = Epi::PERM ? ((R & ~31) + perm32(R & 31)) : R; voffB0 = (unsigned)(Rb * RB + C * 2); }
    const unsigned voffBd = 64u * (unsigned)RB;
#define PG8_AOFF(V, UNIT) do { int t_ = threadIdx.x; asm volatile("" : "+v"(t_)); _Pragma("unroll") for (int _i = 0; _i < 2; ++_i) { int R_, C_; stage_rc(t_ * 16 + _i * 8192, R_, C_); \
        _Pragma("unroll") for (int _h = 0; _h < 2; ++_h) (V)[_h][_i] = (unsigned)S.arow(UNIT, R_ + HALF * _h) * (unsigned)RB + (unsigned)(C_ * 2); } } while (0)
    const size_t kstep = (size_t)(BK * 2);
    const size_t hstep = (size_t)HALF * RB;
    const unsigned ldsw = (unsigned)wid * 1024u;
    const int ac0 = (DT == 2) ? 16 * fq : 8 * fq; constexpr int CH1 = (DT == 2) ? 16 : 1024;
    const int aoff = lds_byte(wr * 64 + fr, ac0), boff = lds_byte(wc * 32 + fr, ac0);
#define PG8_SA(b, h) (((b) * 2 + (h)) * HTB)
#define PG8_SB(b, h) ((4 + (b) * 2 + (h)) * HTB)
#define PG8_STAGEB(bufoff, gbase) do { _Pragma("unroll") for (int _i = 0; _i < 2; ++_i) \
        __builtin_amdgcn_global_load_lds((const unsigned*)((const char*)(gbase) + voffB0 + _i * voffBd), (LAS unsigned*)(lds + (bufoff) + ldsw + _i * 8192), 16, 0, 0); } while (0)
#define PG8_STAGEA(bufoff, koff, V, h) do { _Pragma("unroll") for (int _i = 0; _i < 2; ++_i) \
        __builtin_amdgcn_global_load_lds((const unsigned*)(Abase + (size_t)(V)[h][_i] + (koff)), (LAS unsigned*)(lds + (bufoff) + ldsw + _i * 8192), 16, 0, 0); } while (0)
#define PG8_LDA(dst, b, h) do { _Pragma("unroll") for (int m = 0; m < 4; ++m) { const v4i c0_ = *(const LAS v4i*)(lds + PG8_SA(b, h) + aoff + m * 2048), c1_ = *(const LAS v4i*)(lds + PG8_SA(b, h) + aoff + m * 2048 + CH1); dst[m] = __builtin_shufflevector(c0_, c1_, 0, 1, 2, 3, 4, 5, 6, 7); } } while (0)
#define PG8_LDB(dst, b, h) do { _Pragma("unroll") for (int n = 0; n < 2; ++n) { const v4i c0_ = *(const LAS v4i*)(lds + PG8_SB(b, h) + boff + n * 2048), c1_ = *(const LAS v4i*)(lds + PG8_SB(b, h) + boff + n * 2048 + CH1); dst[n] = __builtin_shufflevector(c0_, c1_, 0, 1, 2, 3, 4, 5, 6, 7); } } while (0)
#define PG8_MMA(ai, bj, At, Bt) do { __builtin_amdgcn_s_setprio(1); _Pragma("unroll") for (int m = 0; m < 4; ++m) _Pragma("unroll") for (int n = 0; n < 2; ++n) \
        acc[ai][bj][m][n] = mma_tile<DT>(Bt[n], At[m], acc[ai][bj][m][n], scB); __builtin_amdgcn_s_setprio(0); } while (0)
#define PG8_WAIT_V(n) asm volatile("s_waitcnt vmcnt(" #n ")" ::: "memory")
#define PG8_WAIT_VE(pe) do { if (pe) asm volatile("s_waitcnt vmcnt(%0)" :: "n"(8 + Epi::NSTORE) : "memory"); else asm volatile("s_waitcnt vmcnt(8)" ::: "memory"); } while (0)
#define PG8_WAIT_L(n) asm volatile("s_waitcnt lgkmcnt(" #n ")" ::: "memory")
#define PG8_BAR __builtin_amdgcn_s_barrier()
#define PG8_SCHED __builtin_amdgcn_sched_barrier(0)
    GUnit cur, nxt; int ui = 0;
    if (!S.next(0, cur)) return;
    f32x4 acc[2][2][4][2];
#pragma unroll
    for (int a = 0; a < 2; ++a)
#pragma unroll
        for (int b = 0; b < 2; ++b)
#pragma unroll
            for (int m = 0; m < 4; ++m)
#pragma unroll
                for (int n = 0; n < 2; ++n) acc[a][b][m][n] = (f32x4){0.f, 0.f, 0.f, 0.f};
    v8i At[4], B0[2], B1[2];
    unsigned vA[2][2];
    PG8_AOFF(vA, cur);
    if constexpr (Sched::GATHER) VM_WAIT();
    const char* cB = cur.B;
    E.pre(lds, cur, 0, wid, lane);
    PG8_STAGEB(PG8_SB(0, 0), cB); PG8_STAGEB(PG8_SB(0, 1), cB + hstep); PG8_STAGEA(PG8_SA(0, 0), 0, vA, 0); PG8_STAGEA(PG8_SA(0, 1), 0, vA, 1);
    if (wr == 1) PG8_BAR;
    PG8_WAIT_V(2); PG8_BAR;
    PG8_STAGEB(PG8_SB(1, 0), cB + kstep); PG8_STAGEA(PG8_SA(1, 0), kstep, vA, 0); PG8_STAGEB(PG8_SB(1, 1), cB + hstep + kstep);
    PG8_WAIT_V(6); PG8_BAR;
    for (;;) {
        const bool has_next = S.next(ui + 1, nxt);
#pragma unroll 1
        for (int t = 0; t < nt; t += 2) {
            const bool last = (t == nt - 2);
            const bool pe = POSTEPI_WAITS && (t == 0) && (ui > 0);
            const size_t k1 = (size_t)(t + 1) * kstep;
            PG8_LDB(B0, 0, 0); PG8_LDB(B1, 0, 1); PG8_SCHED; PG8_LDA(At, 0, 0); PG8_STAGEA(PG8_SA(1, 1), k1, vA, 1);
            PG8_WAIT_VE(pe); PG8_WAIT_L(0); PG8_BAR; PG8_MMA(0, 0, At, B0); PG8_MMA(0, 1, At, B1); PG8_BAR; PG8_SCHED;
            size_t k2 = (size_t)(t + 2) * kstep;
            if (last) { k2 = 0; if (has_next) { PG8_AOFF(vA, nxt); if constexpr (Sched::GATHER) VM_WAIT(); cB = nxt.B; } }
            const size_t k3 = k2 + kstep; const char* b2 = cB + k2; const char* b3 = b2 + kstep;
            PG8_LDA(At, 0, 1); PG8_STAGEB(PG8_SB(0, 0), b2); PG8_STAGEB(PG8_SB(0, 1), b2 + hstep); PG8_STAGEA(PG8_SA(0, 0), k2, vA, 0);
            PG8_WAIT_VE(pe); PG8_WAIT_L(0); PG8_BAR; PG8_MMA(1, 0, At, B0); PG8_MMA(1, 1, At, B1); PG8_BAR; PG8_SCHED;
            PG8_LDB(B0, 1, 0); PG8_LDB(B1, 1, 1); PG8_SCHED; PG8_LDA(At, 1, 0); PG8_STAGEA(PG8_SA(0, 1), k2, vA, 1);
            PG8_WAIT_V(8); PG8_WAIT_L(0); PG8_BAR; PG8_MMA(0, 0, At, B0); PG8_MMA(0, 1, At, B1); PG8_BAR; PG8_SCHED;
            PG8_LDA(At, 1, 1); PG8_STAGEB(PG8_SB(1, 0), b3); PG8_STAGEB(PG8_SB(1, 1), b3 + hstep); PG8_STAGEA(PG8_SA(1, 0), k3, vA, 0);
            PG8_WAIT_V(8); PG8_WAIT_L(0); PG8_BAR; PG8_MMA(1, 0, At, B0); PG8_MMA(1, 1, At, B1); PG8_BAR; PG8_SCHED;
        }
        if constexpr (ALIGN_EPI) { if (wr == 0) PG8_BAR; }
        { int tx = threadIdx.x; asm volatile("" : "+v"(tx)); E(acc, cur, wr, wc, tx & 15, (tx >> 4) & 3, lds, ui); }
        if (!has_next) break;
#pragma unroll
        for (int a = 0; a < 2; ++a)
#pragma unroll
            for (int b = 0; b < 2; ++b)
#pragma unroll
                for (int m = 0; m < 4; ++m)
#pragma unroll
                    for (int n = 0; n < 2; ++n) acc[a][b][m][n] = (f32x4){0.f, 0.f, 0.f, 0.f};
        cur = nxt; ++ui;
        if constexpr (ALIGN_EPI) { if (wr == 1) PG8_BAR; }
        E.pre(lds, cur, ui, wid, lane);
    }
    PG8_WAIT_V(0);
    if constexpr (!ALIGN_EPI) { if (wr == 0) PG8_BAR; }
    PG8_BAR;
#undef PG8_SA
#undef PG8_SB
#undef PG8_STAGEA
#undef PG8_AOFF
#undef PG8_STAGEB
#undef PG8_LDA
#undef PG8_LDB
#undef PG8_MMA
#undef PG8_WAIT_V
#undef PG8_WAIT_VE
#undef PG8_WAIT_L
#undef PG8_BAR
#undef PG8_SCHED
}
}

namespace attn_body {
using bf16 = __hip_bfloat16;
using s16x4 = __attribute__((ext_vector_type(4))) short;
using f32x16 = __attribute__((ext_vector_type(16))) float;
constexpr int D = 64, DMQ = QW, DMKV = KVW, DMO = DM;
constexpr int NW = 8, QBLK = 32, QB = QBLK * NW, KVBLK = 64, NT = LKV / KVBLK;
static_assert(NT % 2 == 0 && NT >= 8, "tile count");
__device__ __forceinline__ int crow(int r, int hi) { return (r & 3) + 8 * (r >> 2) + 4 * hi; }
#define SBAR() __builtin_amdgcn_sched_barrier(0)
constexpr int NSLOTR = 3, SLOTB = 8192;
constexpr int LDS_K = 0, LDS_V = NSLOTR * SLOTB, LDS_WS = 2 * NSLOTR * SLOTB, LDS_OST = LDS_WS + NW * 64 * 4, ATT_LDS_BYTES = LDS_OST + NW * 4096;
__device__ __forceinline__ void glds16(const void* gsrc, unsigned lds_dst) { unsigned keep;
    asm volatile("s_mov_b32 %0, m0\n\ts_mov_b32 m0, %2\n\ts_nop 0\n\tglobal_load_lds_dwordx4 %1, off\n\ts_mov_b32 m0, %0" : "=&s"(keep) : "v"(gsrc), "s"(lds_dst) : "memory"); }
__device__ __forceinline__ float max3f(float a, float b, float c) { float r; asm("v_max3_f32 %0, %1, %2, %3" : "=v"(r) : "v"(a), "v"(b), "v"(c)); return r; }
__device__ __forceinline__ float max2f(float a, float b) { float r; asm("v_max_f32_e32 %0, %1, %2" : "=v"(r) : "v"(a), "v"(b)); return r; }
__device__ __forceinline__ float fadd_s(float a, float b) { float r; asm("v_add_f32_e32 %0, %1, %2" : "=v"(r) : "v"(a), "v"(b)); return r; }
__device__ __forceinline__ float fsub_s(float a, float b) { float r; asm("v_sub_f32_e32 %0, %1, %2" : "=v"(r) : "v"(a), "v"(b)); return r; }
typedef float f32x2_t __attribute__((ext_vector_type(2))); typedef __bf16 bf16x2_t __attribute__((ext_vector_type(2)));
__device__ __forceinline__ unsigned cvtpk_s(float lo, float hi) { f32x2_t v = {lo, hi}; bf16x2_t b = __builtin_convertvector(v, bf16x2_t); return __builtin_bit_cast(unsigned, b); }
#define WAIT_BAR(N) asm volatile("s_waitcnt vmcnt(" #N ") lgkmcnt(0)\n\ts_barrier" ::: "memory")

__device__ __forceinline__ void qkt(f32x16& p0, f32x16& p1, const char* Kslot, const bf16x8* qr, const f32x16& negm, int r32, int hi) {
    const char* kb = Kslot + hi * 1024 + r32 * 16;
#pragma unroll
    for (int d0 = 0; d0 < 4; ++d0) {
        const bf16x8 b0 = *reinterpret_cast<const bf16x8*>(kb + d0 * 2048);
        const bf16x8 b1 = *reinterpret_cast<const bf16x8*>(kb + d0 * 2048 + 512);
        if (d0 == 0) { p0 = __builtin_amdgcn_mfma_f32_32x32x16_bf16(b0, qr[0], negm, 0, 0, 0); p1 = __builtin_amdgcn_mfma_f32_32x32x16_bf16(b1, qr[0], negm, 0, 0, 0); }
        else { p0 = __builtin_amdgcn_mfma_f32_32x32x16_bf16(b0, qr[d0], p0, 0, 0, 0); p1 = __builtin_amdgcn_mfma_f32_32x32x16_bf16(b1, qr[d0], p1, 0, 0, 0); } }
}
typedef __attribute__((address_space(3))) const char* lds_cptr;
typedef short v4i16_t __attribute__((ext_vector_type(4)));
__device__ __forceinline__ void kload8(bf16x8* kf, lds_cptr kp) {
    kf[0] = *(const __attribute__((address_space(3))) bf16x8*)(kp);        kf[1] = *(const __attribute__((address_space(3))) bf16x8*)(kp + 512);
    kf[2] = *(const __attribute__((address_space(3))) bf16x8*)(kp + 2048); kf[3] = *(const __attribute__((address_space(3))) bf16x8*)(kp + 2560);
    kf[4] = *(const __attribute__((address_space(3))) bf16x8*)(kp + 4096); kf[5] = *(const __attribute__((address_space(3))) bf16x8*)(kp + 4608);
    kf[6] = *(const __attribute__((address_space(3))) bf16x8*)(kp + 6144); kf[7] = *(const __attribute__((address_space(3))) bf16x8*)(kp + 6656);
}
__device__ __forceinline__ void kload2(bf16x8* kf, lds_cptr kp, int j) { kf[2 * j] = *(const __attribute__((address_space(3))) bf16x8*)(kp + j * 2048); kf[2 * j + 1] = *(const __attribute__((address_space(3))) bf16x8*)(kp + j * 2048 + 512); }
__device__ __forceinline__ s16x4 vtr(lds_cptr p) { return __builtin_bit_cast(s16x4, __builtin_amdgcn_ds_read_tr16_b64_v4i16((__attribute__((address_space(3))) v4i16_t*)p)); }
__device__ __forceinline__ float rowmax(const f32x16& p0, const f32x16& p1) {
    float a = max3f(p0[0], p0[1], p1[0]), b = max3f(p0[2], p0[3], p1[1]); a = max3f(a, p1[2], p1[3]);
#pragma unroll
    for (int r = 4; r < 16; r += 4) { a = max3f(a, p0[r], p0[r + 1]); b = max3f(b, p0[r + 2], p0[r + 3]); a = max3f(a, p1[r], p1[r + 1]); b = max3f(b, p1[r + 2], p1[r + 3]); }
    const float m = max2f(a, b);
    auto rr = __builtin_amdgcn_permlane32_swap(__float_as_uint(m), __float_as_uint(m), false, false);
    return max2f(__uint_as_float(rr[0]), __uint_as_float(rr[1]));
}
__device__ __forceinline__ void pv(f32x16* o, int vb, bf16x8 pa0, bf16x8 pa1, bf16x8 pa2, bf16x8 pa3) {
#pragma unroll
    for (int d0 = 0; d0 < 2; ++d0) { s16x4 lo[4], hi[4];
#pragma unroll
        for (int ks = 0; ks < 4; ++ks) {
            asm volatile("ds_read_b64_tr_b16 %0,%1 offset:%c2" : "=&v"(lo[ks]) : "v"(vb), "i"(d0 * 4096 + ks * 1024) : "memory");
            asm volatile("ds_read_b64_tr_b16 %0,%1 offset:%c2" : "=&v"(hi[ks]) : "v"(vb), "i"(d0 * 4096 + ks * 1024 + 512) : "memory"); }
        asm volatile("s_waitcnt lgkmcnt(0)" ::: "memory"); SBAR();
#define PK(k) (bf16x8){lo[k][0], lo[k][1], lo[k][2], lo[k][3], hi[k][0], hi[k][1], hi[k][2], hi[k][3]}
        o[d0] = __builtin_amdgcn_mfma_f32_32x32x16_bf16(pa0, PK(0), o[d0], 0, 0, 0);
        o[d0] = __builtin_amdgcn_mfma_f32_32x32x16_bf16(pa1, PK(1), o[d0], 0, 0, 0);
        o[d0] = __builtin_amdgcn_mfma_f32_32x32x16_bf16(pa2, PK(2), o[d0], 0, 0, 0);
        o[d0] = __builtin_amdgcn_mfma_f32_32x32x16_bf16(pa3, PK(3), o[d0], 0, 0, 0);
#undef PK
    }
}
template <bool MS> __device__ __forceinline__ void attn_unit(int b, int h, int qb, const bf16* Q, const bf16* __restrict__ K, const bf16* __restrict__ V, bf16* O, char* shm, float negM_) {
    const int tid = threadIdx.x, lane = tid & 63, r32 = lane & 31, hi = lane >> 5; const int wid = __builtin_amdgcn_readfirstlane(tid >> 6);
    const int q0 = qb * QB; const int kvh = h / 3;
    const long qrow0 = (long)b * SEQ + q0 + wid * QBLK;
    const long kvrow0 = (long)b * LKV;
    const bf16* Qw = Q + qrow0 * DMQ + h * D;
    const bf16* Kh = K + kvrow0 * DMKV + kvh * D, *Vh = V + kvrow0 * DMKV + kvh * D;
    const unsigned lds0 = (unsigned)(uintptr_t)shm;
    float* wsf = (float*)(shm + LDS_WS) + wid * 64;
    const bf16* ksrc = Kh + (long)lane * DMKV + wid * 8;
    const bf16* vsrc = Vh + (long)(16 * (wid & 3) + (lane >> 2)) * DMKV + (wid >> 2) * 32 + (lane & 3) * 8;
    const unsigned kdst = lds0 + LDS_K + wid * 1024, vdst = lds0 + LDS_V + wid * 1024;
#define DMA_K(t, slot) glds16(ksrc + (long)(t) * KVBLK * DMKV, (unsigned)__builtin_amdgcn_readfirstlane(kdst + (slot)))
#define DMA_V(t, slot) glds16(vsrc + (long)(t) * KVBLK * DMKV, (unsigned)__builtin_amdgcn_readfirstlane(vdst + (slot)))
    const int vb0 = (int)(lds0 + LDS_V) + ((lane >> 4) & 1) * 32 + (lane & 3) * 8 + (4 * hi + ((lane & 15) >> 2)) * 64;
    const char* Kbase = shm + LDS_K; bf16x8 kf[8];
    const lds_cptr shm3 = (lds_cptr)shm; const lds_cptr kp0 = shm3 + LDS_K + hi * 1024 + r32 * 16; const lds_cptr vp0 = shm3 + LDS_V + ((lane >> 4) & 1) * 32 + (lane & 3) * 8 + (4 * hi + ((lane & 15) >> 2)) * 64;
    DMA_K(0, 0); DMA_V(0, 0); DMA_K(1, SLOTB);
    bf16x8 qr[4];
#pragma unroll
    for (int d0 = 0; d0 < 4; ++d0) qr[d0] = *reinterpret_cast<const bf16x8*>(&Qw[(long)r32 * DMQ + d0 * 16 + hi * 8]);
    float l_reg = 0.f; f32x16 o[2]; o[0] = f32x16{}; o[1] = f32x16{}; f32x16 negm = f32x16{}; f32x16 lacc = f32x16{};
    if constexpr (!MS) { _Pragma("unroll") for (int r = 0; r < 16; ++r) negm[r] = negM_; asm volatile("" : "+v"(negm)); }
    const bf16x8 ONES = (bf16x8){0x3F80, 0x3F80, 0x3F80, 0x3F80, 0x3F80, 0x3F80, 0x3F80, 0x3F80};
#define START(P0, P1) do { _Pragma("unroll") for (int r = 0; r < 16; ++r) P0[r] = __builtin_amdgcn_exp2f(P0[r]); } while (0)
#define RESC() do { } while (0)
    f32x16 pA0, pA1, pB0, pB1;
    int sl_prev = 0, sl_cur = 0, sl_next = SLOTB;
#define ROT() do { sl_prev = sl_cur; sl_cur = sl_next; sl_next = (sl_next == (NSLOTR - 1) * SLOTB) ? 0 : sl_next + SLOTB; } while (0)
    DMA_K(2, 2 * SLOTB);
    WAIT_BAR(3);
    qkt(pA0, pA1, Kbase, qr, negm, r32, hi); asm volatile("s_nop 15\n\ts_nop 7" : "+v"(pA0), "+v"(pA1));
    START(pA0, pA1);
    _Pragma("unroll") for (int r = 0; r < 16; ++r) pA1[r] = __builtin_amdgcn_exp2f(pA1[r]);
    WAIT_BAR(0);
    DMA_K(3, 0); DMA_V(1, SLOTB);
    ROT();
    kload8(kf, kp0 + sl_cur);
    WAIT_BAR(2);
    s16x4 vlo[8], vhi[8]; u32x4 pw0, pw1, pw2, pw3;
#define PKW(P, B) cvtpk_s(P[B], P[B + 1])
#define PAF(k) __builtin_bit_cast(bf16x8, pw##k)
#define VFR(i) (bf16x8){vlo[i][0], vlo[i][1], vlo[i][2], vlo[i][3], vhi[i][0], vhi[i][1], vhi[i][2], vhi[i][3]}
#define PIN(x) asm volatile("" : "+v"(x))
#define MX3(a, b, c) __builtin_fmaxf(__builtin_fmaxf((a), (b)), (c))
#define GAPA(MF, A0, A1, A2, A3, W0, W1, PW) do { MF; if constexpr (!MS) { sacc += A0; sacc += A1; sacc += A2; sacc += A3; PIN(sacc); } W0; W1; PIN(PW); SBAR(); } while (0)
#define LSUM(k) do { if constexpr (MS) lacc = __builtin_amdgcn_mfma_f32_32x32x16_bf16(PAF(k), ONES, lacc, 0, 0, 0); } while (0)
#define EX(v) __builtin_amdgcn_exp2f(v)
#define GAPB(MF, X, B) do { MF; X[B] = EX(X[B]); X[B + 1] = EX(X[B + 1]); X[B + 2] = EX(X[B + 2]); X[B + 3] = EX(X[B + 3]); PIN(X); SBAR(); } while (0)
#define VRD(i) do { vlo[i] = vtr(vp_ + (((i) >> 2) * 4096 + ((i) & 3) * 1024)); vhi[i] = vtr(vp_ + (((i) >> 2) * 4096 + ((i) & 3) * 1024 + 512)); } while (0)
#define KRD(G, j) do { if (G) { kload2(kf, kp0 + sl_next, j); SBAR(); } } while (0)
#define STEP(C0, C1, P0, P1, t, GK, GV, GL) do { SBAR(); \
    const lds_cptr vp_ = vp0 + sl_prev; \
    VRD(0); SBAR(); float sacc = MS ? 0.f : (P0[0] + P0[1]); \
    GAPA(C0 = __builtin_amdgcn_mfma_f32_32x32x16_bf16(kf[0], qr[0], negm, 0, 0, 0), P0[2], P0[3], P0[4], P0[5],     pw0[0] = PKW(P0, 0), pw0[1] = PKW(P0, 2), pw0); \
    VRD(4); SBAR(); GAPA(C1 = __builtin_amdgcn_mfma_f32_32x32x16_bf16(kf[1], qr[0], negm, 0, 0, 0), P0[6], P0[7], P0[8], P0[9],     pw0[2] = PKW(P0, 4), pw0[3] = PKW(P0, 6), pw0); \
    VRD(1); SBAR(); GAPA(C0 = __builtin_amdgcn_mfma_f32_32x32x16_bf16(kf[2], qr[1], C0, 0, 0, 0),   P0[10], P0[11], P0[12], P0[13], pw1[0] = PKW(P0, 8), pw1[1] = PKW(P0, 10), pw1); \
    VRD(5); SBAR(); GAPA(C1 = __builtin_amdgcn_mfma_f32_32x32x16_bf16(kf[3], qr[1], C1, 0, 0, 0),   P0[14], P0[15], P1[0], P1[1],   pw1[2] = PKW(P0, 12), pw1[3] = PKW(P0, 14), pw1); \
    VRD(2); SBAR(); GAPA(C0 = __builtin_amdgcn_mfma_f32_32x32x16_bf16(kf[4], qr[2], C0, 0, 0, 0),   P1[2], P1[3], P1[4], P1[5],     pw2[0] = PKW(P1, 0), pw2[1] = PKW(P1, 2), pw2); \
    VRD(6); SBAR(); GAPA(C1 = __builtin_amdgcn_mfma_f32_32x32x16_bf16(kf[5], qr[2], C1, 0, 0, 0),   P1[6], P1[7], P1[8], P1[9],     pw2[2] = PKW(P1, 4), pw2[3] = PKW(P1, 6), pw2); \
    VRD(3); SBAR(); GAPA(C0 = __builtin_amdgcn_mfma_f32_32x32x16_bf16(kf[6], qr[3], C0, 0, 0, 0),   P1[10], P1[11], P1[12], P1[13], pw3[0] = PKW(P1, 8), pw3[1] = PKW(P1, 10), pw3); \
    VRD(7); SBAR(); GAPA(C1 = __builtin_amdgcn_mfma_f32_32x32x16_bf16(kf[7], qr[3], C1, 0, 0, 0),   P1[14], P1[15], 0.f, 0.f,       pw3[2] = PKW(P1, 12), pw3[3] = PKW(P1, 14), pw3); \
    if constexpr (!MS) l_reg += sacc; \
    if (GK) { DMA_K((t) + 3, sl_cur); } if (GV) { DMA_V((t) + 1, sl_next); } \
    SBAR(); \
    GAPB(o[0] = __builtin_amdgcn_mfma_f32_32x32x16_bf16(PAF(0), VFR(0), o[0], 0, 0, 0), C0, 0); \
    GAPB(o[1] = __builtin_amdgcn_mfma_f32_32x32x16_bf16(PAF(0), VFR(4), o[1], 0, 0, 0), C0, 4); LSUM(0); \
    KRD(GL, 0); GAPB(o[0] = __builtin_amdgcn_mfma_f32_32x32x16_bf16(PAF(1), VFR(1), o[0], 0, 0, 0), C0, 8); \
    KRD(GL, 1); GAPB(o[1] = __builtin_amdgcn_mfma_f32_32x32x16_bf16(PAF(1), VFR(5), o[1], 0, 0, 0), C0, 12); LSUM(1); \
    KRD(GL, 2); GAPB(o[0] = __builtin_amdgcn_mfma_f32_32x32x16_bf16(PAF(2), VFR(2), o[0], 0, 0, 0), C1, 0); \
    KRD(GL, 3); GAPB(o[1] = __builtin_amdgcn_mfma_f32_32x32x16_bf16(PAF(2), VFR(6), o[1], 0, 0, 0), C1, 4); LSUM(2); \
    GAPB(o[0] = __builtin_amdgcn_mfma_f32_32x32x16_bf16(PAF(3), VFR(3), o[0], 0, 0, 0), C1, 8); \
    GAPB(o[1] = __builtin_amdgcn_mfma_f32_32x32x16_bf16(PAF(3), VFR(7), o[1], 0, 0, 0), C1, 12); LSUM(3); \
    } while (0)
    int t = 1;
    for (; t + 5 < NT; t += 2) {
        STEP(pB0, pB1, pA0, pA1, t, true, true, true);     WAIT_BAR(2); RESC(); ROT();
        STEP(pA0, pA1, pB0, pB1, t + 1, true, true, true); WAIT_BAR(2); RESC(); ROT();
    }
#define ENDW(tt) do { if ((tt) + 3 < NT) { WAIT_BAR(2); } else if ((tt) + 2 < NT) { WAIT_BAR(1); } else { WAIT_BAR(0); } } while (0)
    for (; t + 1 < NT; t += 2) {
        STEP(pB0, pB1, pA0, pA1, t, (t + 3 < NT), (t + 1 < NT), (t + 1 < NT));         ENDW(t);     RESC(); ROT();
        STEP(pA0, pA1, pB0, pB1, t + 1, (t + 4 < NT), (t + 2 < NT), (t + 2 < NT));     ENDW(t + 1); RESC(); ROT();
    }
    STEP(pB0, pB1, pA0, pA1, NT - 1, false, false, false); RESC();
    { if constexpr (!MS) { float sacc = pB0[0] + pB0[1]; _Pragma("unroll") for (int r = 2; r < 16; ++r) sacc += pB0[r]; _Pragma("unroll") for (int r = 0; r < 16; ++r) sacc += pB1[r]; l_reg += sacc; }
      pw0 = (u32x4){PKW(pB0, 0), PKW(pB0, 2), PKW(pB0, 4), PKW(pB0, 6)}; pw1 = (u32x4){PKW(pB0, 8), PKW(pB0, 10), PKW(pB0, 12), PKW(pB0, 14)}; pw2 = (u32x4){PKW(pB1, 0), PKW(pB1, 2), PKW(pB1, 4), PKW(pB1, 6)}; pw3 = (u32x4){PKW(pB1, 8), PKW(pB1, 10), PKW(pB1, 12), PKW(pB1, 14)};
      SBAR(); pv(o, vb0 + sl_cur, PAF(0), PAF(1), PAF(2), PAF(3)); LSUM(0); LSUM(1); LSUM(2); LSUM(3); }
#undef LSUM
#undef PKW
#undef PAF
#undef VFR
#undef PIN
#undef MX3
#undef GAPA
#undef GAPB
#undef EX
#undef VRD
#undef KRD
#undef STEP
#undef ENDW
    float rli[16];
    if constexpr (MS) {
#pragma unroll
        for (int r = 0; r < 16; ++r) rli[r] = __builtin_amdgcn_rcpf(lacc[r]);
    } else {
        { auto rr = __builtin_amdgcn_permlane32_swap(__float_as_uint(l_reg), __float_as_uint(l_reg), false, false); l_reg = __uint_as_float(rr[0]) + __uint_as_float(rr[1]); }
        if (hi == 0) wsf[32 + r32] = l_reg; asm volatile("s_waitcnt lgkmcnt(0)" ::: "memory");
#pragma unroll
        for (int r = 0; r < 16; ++r) rli[r] = __builtin_amdgcn_rcpf(wsf[32 + crow(r, hi)]);
    }
    bf16* Ow = O + qrow0 * DMO + h * D;
    { bf16* stg = (bf16*)(shm + LDS_OST) + wid * 2048;
#pragma unroll
      for (int r = 0; r < 16; ++r) { const int orow = crow(r, hi);
#pragma unroll
        for (int d0 = 0; d0 < 2; ++d0) stg[orow * 64 + d0 * 32 + r32] = __float2bfloat16(o[d0][r] * rli[r]); }
      asm volatile("s_waitcnt lgkmcnt(0)" ::: "memory");
#pragma unroll
      for (int i = 0; i < 4; ++i) { const int row = i * 8 + (lane >> 3), ch = lane & 7; const u32x4 v = *(const u32x4*)(stg + row * 64 + ch * 8); *(u32x4*)(Ow + (long)row * DMO + ch * 8) = v; } }
    asm volatile("s_waitcnt lgkmcnt(0)\n\ts_barrier" ::: "memory");
#undef DMA_K
#undef DMA_V
#undef START
#undef RESC
#undef ROT
}
#undef SBAR
#undef WAIT_BAR

typedef int v8i_t __attribute__((ext_vector_type(8)));
typedef int v4i_t __attribute__((ext_vector_type(4)));
__host__ __device__ __forceinline__ int vt_slot(int k) { const int hi = (k >> 2) & 1, r = (k & 3) + 4 * ((k & 31) >> 3); return 32 * hi + r + 16 * (k >> 5); }
constexpr int SLOT8 = 4096, NS8 = 6, L8_K = 0, L8_V = NS8 * SLOT8;
static_assert(L8_V + NS8 * SLOT8 <= LDS_WS, "fp8 rings below the per-wave scratch");
constexpr int SC_QK = 0x7c7f, SC_PV = 0x7f7f;
__device__ __forceinline__ v8i_t ld32(lds_cptr p, int o0, int o1) { const v4i_t a = *(const __attribute__((address_space(3))) v4i_t*)(p + o0), b = *(const __attribute__((address_space(3))) v4i_t*)(p + o1); return __builtin_shufflevector(a, b, 0, 1, 2, 3, 4, 5, 6, 7); }
#define SBAR() __builtin_amdgcn_sched_barrier(0)
#define WAIT_BAR(N) asm volatile("s_waitcnt vmcnt(" #N ") lgkmcnt(0)\n\ts_barrier" ::: "memory")
__device__ __forceinline__ void attn_unit8(int b, int h, int qb, const unsigned char* Q8, const unsigned char* K8, const unsigned char* Vt8, bf16* O, char* shm, float negM_) {
    int tid = threadIdx.x; asm volatile("" : "+v"(tid));
    const int lane = tid & 63, r32 = lane & 31, hi = lane >> 5; const int wid = __builtin_amdgcn_readfirstlane(tid >> 6);
    const int q0 = qb * QB; const int kvh = h / 3; const bool kw = wid < 4;
    const long qrow0 = (long)b * SEQ + q0 + wid * QBLK;
    const unsigned lds0 = (unsigned)(uintptr_t)shm;
    const int drow = 16 * (wid & 3) + (lane >> 2), dch = (lane & 3) ^ ((drow >> 2) & 3);
    const unsigned char* ksrc = K8 + ((long)b * LKV + drow) * DMKV + kvh * D + dch * 16;
    const unsigned char* vsrc = Vt8 + ((long)(b * NKVH + kvh) * (LKV / 64)) * 4096 + drow * 64 + dch * 16;
    const unsigned kdst = lds0 + L8_K + (wid & 3) * 1024, vdst = lds0 + L8_V + (wid & 3) * 1024;
#define DMA8_K(t, slot) glds16(ksrc + (long)(t) * KVBLK * DMKV, (unsigned)__builtin_amdgcn_readfirstlane(kdst + (slot)))
#define DMA8_V(t, slot) glds16(vsrc + (long)(t) * 4096, (unsigned)__builtin_amdgcn_readfirstlane(vdst + (slot)))
    const lds_cptr shm3 = (lds_cptr)shm; const int sw = (r32 >> 2) & 3, c0o = ((2 * hi) ^ sw) * 16, c1o = ((2 * hi + 1) ^ sw) * 16;
    const lds_cptr kp0 = shm3 + L8_K + r32 * 64; const lds_cptr vp0 = shm3 + L8_V + r32 * 64;
    if (kw) { DMA8_K(0, 0); DMA8_K(1, SLOT8); DMA8_K(2, 2 * SLOT8); DMA8_K(3, 3 * SLOT8); DMA8_K(4, 4 * SLOT8); } else { DMA8_V(0, 0); DMA8_V(1, SLOT8); DMA8_V(2, 2 * SLOT8); }
    const v8i_t qr = *reinterpret_cast<const v8i_t*>(Q8 + (qrow0 + r32) * DMQ + h * D + hi * 32);
    f32x16 o[2]; o[0] = f32x16{}; o[1] = f32x16{}; f32x16 negm; f32x16 lacc = f32x16{};
    _Pragma("unroll") for (int r = 0; r < 16; ++r) negm[r] = negM_;
    asm volatile("" : "+v"(negm));
    const v8i_t ONES8 = (v8i_t){0x38383838, 0x38383838, 0x38383838, 0x38383838, 0x38383838, 0x38383838, 0x38383838, 0x38383838};
    f32x16 c0, c1; v8i_t kf[2], vf[2], pw = (v8i_t){0, 0, 0, 0, 0, 0, 0, 0};
    int s0 = 0, s1 = SLOT8, s2 = 2 * SLOT8, s3 = 3 * SLOT8, s5 = 5 * SLOT8;
#define NXT8(x) (((x) == (NS8 - 1) * SLOT8) ? 0 : (x) + SLOT8)
#define ROT8() do { s0 = s1; s1 = s2; s2 = s3; s3 = NXT8(s3); s5 = NXT8(s5); } while (0)
#define QK8() do { c0 = __builtin_amdgcn_mfma_scale_f32_32x32x64_f8f6f4(kf[0], qr, negm, 0, 0, 0, SC_QK, 1, SC_QK); c1 = __builtin_amdgcn_mfma_scale_f32_32x32x64_f8f6f4(kf[1], qr, negm, 0, 0, 0, SC_QK, 1, SC_QK); } while (0)
#define PK8(P, B, OLD) __builtin_amdgcn_cvt_pk_fp8_f32(P[B + 2], P[B + 3], __builtin_amdgcn_cvt_pk_fp8_f32(P[B], P[B + 1], OLD, false), true)
#define PV8() do { if (REP == 71) { f32x16 dz_ = __builtin_amdgcn_mfma_scale_f32_32x32x64_f8f6f4(pw, vf[0], f32x16{}, 0, 0, 0, SC_PV, 1, SC_PV); asm volatile("" :: "v"(dz_)); dz_ = __builtin_amdgcn_mfma_scale_f32_32x32x64_f8f6f4(pw, vf[1], f32x16{}, 0, 0, 0, SC_PV, 1, SC_PV); asm volatile("" :: "v"(dz_)); } \
    o[0] = __builtin_amdgcn_mfma_scale_f32_32x32x64_f8f6f4(pw, vf[0], o[0], 0, 0, 0, SC_PV, 1, SC_PV); o[1] = __builtin_amdgcn_mfma_scale_f32_32x32x64_f8f6f4(pw, vf[1], o[1], 0, 0, 0, SC_PV, 1, SC_PV); \
        lacc = __builtin_amdgcn_mfma_scale_f32_32x32x64_f8f6f4(pw, ONES8, lacc, 0, 0, 0, SC_PV, 1, SC_PV); } while (0)
#define EXPK8() do { if (REP == 70) { _Pragma("unroll") for (int r = 0; r < 16; ++r) { float d0_ = __builtin_amdgcn_exp2f(c0[r] * 0.5f), d1_ = __builtin_amdgcn_exp2f(c1[r] * 0.5f); asm volatile("" :: "v"(d0_), "v"(d1_)); } } \
    _Pragma("unroll") for (int r = 0; r < 16; ++r) { c0[r] = __builtin_amdgcn_exp2f(c0[r]); c1[r] = __builtin_amdgcn_exp2f(c1[r]); } \
        pw[0] = PK8(c0, 0, pw[0]); pw[1] = PK8(c0, 4, pw[1]); pw[2] = PK8(c0, 8, pw[2]); pw[3] = PK8(c0, 12, pw[3]); pw[4] = PK8(c1, 0, pw[4]); pw[5] = PK8(c1, 4, pw[5]); pw[6] = PK8(c1, 8, pw[6]); pw[7] = PK8(c1, 12, pw[7]); } while (0)
    WAIT_BAR(0);
    kf[0] = ld32(kp0, c0o, c1o); kf[1] = ld32(kp0 + 2048, c0o, c1o);
    QK8(); EXPK8();
    kf[0] = ld32(kp0 + SLOT8, c0o, c1o); kf[1] = ld32(kp0 + SLOT8 + 2048, c0o, c1o);
    WAIT_BAR(0);
#define SUB8(t, GK, GV, GL, MID) do { SBAR(); \
    vf[0] = ld32(vp0 + s0, c0o, c1o); vf[1] = ld32(vp0 + s0 + 2048, c0o, c1o); \
    if (ATTN_MPRIO) __builtin_amdgcn_s_setprio(1); \
    QK8(); PV8(); \
    if (ATTN_MPRIO) { SBAR(); __builtin_amdgcn_s_setprio(0); } \
    if (kw) { if (GK) { DMA8_K((t) + 4, s5); } } else { if (GV) { DMA8_V((t) + 2, s3); } } \
    if (GL) { kf[0] = ld32(kp0 + s2, c0o, c1o); kf[1] = ld32(kp0 + s2 + 2048, c0o, c1o); } \
    if (ATTN_SKEW) { SBAR(); MID; SBAR(); } \
    EXPK8(); ROT8(); \
    } while (0)
    int t = 1;
    if (ATTN_SKEW && !kw) {
#pragma unroll 1
        for (; t + 5 < NT; t += 2) { SUB8(t, false, true, true, (void)0); SUB8(t + 1, false, true, true, WAIT_BAR(1)); }
#pragma unroll 1
        for (; t + 1 < NT; t += 2) { SUB8(t, false, (t + 2 < NT), (t + 1 < NT), (void)0); SUB8(t + 1, false, (t + 3 < NT), (t + 2 < NT), WAIT_BAR(0)); }
    } else {
#pragma unroll 1
        for (; t + 5 < NT; t += 2) { SUB8(t, true, true, true, (void)0); SUB8(t + 1, true, true, true, (void)0); WAIT_BAR(1); }
#pragma unroll 1
        for (; t + 1 < NT; t += 2) {
            SUB8(t, (t + 4 < NT), (t + 2 < NT), (t + 1 < NT), (void)0); SUB8(t + 1, (t + 5 < NT), (t + 3 < NT), (t + 2 < NT), (void)0); WAIT_BAR(0); }
    }
    SUB8(NT - 1, false, false, false, (void)0);
    {
        asm volatile("s_waitcnt lgkmcnt(0)" ::: "memory");
        vf[0] = ld32(vp0 + s0, c0o, c1o); vf[1] = ld32(vp0 + s0 + 2048, c0o, c1o);
        PV8(); }
    float rli[16];
#pragma unroll
    for (int r = 0; r < 16; ++r) rli[r] = __builtin_amdgcn_rcpf(lacc[r]);
    bf16* Ow = O + qrow0 * DMO + h * D;
    { bf16* stg = (bf16*)(shm + LDS_OST) + wid * 2048;
#pragma unroll
      for (int r = 0; r < 16; ++r) { const int orow = crow(r, hi);
#pragma unroll
        for (int d0 = 0; d0 < 2; ++d0) stg[orow * 64 + d0 * 32 + r32] = __float2bfloat16(o[d0][r] * rli[r]); }
      asm volatile("s_waitcnt lgkmcnt(0)" ::: "memory");
#pragma unroll
      for (int i = 0; i < 4; ++i) { const int row = i * 8 + (lane >> 3), ch = lane & 7; const u32x4 v = *(const u32x4*)(stg + row * 64 + ch * 8); *(u32x4*)(Ow + (long)row * DMO + ch * 8) = v; } }
    asm volatile("s_waitcnt vmcnt(0) lgkmcnt(0)\n\ts_barrier" ::: "memory");
#undef DMA8_K
#undef DMA8_V
#undef ROT8
#undef QK8
#undef PK8
#undef PV8
#undef EXPK8
#undef SUB8
#undef NXT8
}

constexpr int QBW = 512;
__device__ __forceinline__ void attn_unit8w(int b, int h, int qb, const unsigned char* Q8, const unsigned char* K8, const unsigned char* Vt8, bf16* O, char* shm, float negM_) {
    int tid = threadIdx.x; asm volatile("" : "+v"(tid));
    const int lane = tid & 63, r32 = lane & 31, hi = lane >> 5; const int wid = __builtin_amdgcn_readfirstlane(tid >> 6);
    const int q0 = qb * QBW; const int kvh = h / 3; const bool kw = wid < 4;
    const long qrow0 = (long)b * SEQ + q0 + wid * 64;
    const unsigned lds0 = (unsigned)(uintptr_t)shm;
    const int drow = 16 * (wid & 3) + (lane >> 2), dch = (lane & 3) ^ ((drow >> 2) & 3);
    const unsigned char* dsrc = kw ? K8 + ((long)b * LKV + drow) * DMKV + kvh * D + dch * 16 : Vt8 + ((long)(b * NKVH + kvh) * (LKV / 64)) * 4096 + drow * 64 + dch * 16;
    const int dstride = kw ? KVBLK * DMKV : 4096;
    const unsigned ddst = lds0 + (kw ? L8_K : L8_V) + (wid & 3) * 1024;
#define DMA8_K(t, slot) glds16(dsrc + (long)(t) * dstride, (unsigned)__builtin_amdgcn_readfirstlane(ddst + (slot)))
#define DMA8_V(t, slot) glds16(dsrc + (long)(t) * dstride, (unsigned)__builtin_amdgcn_readfirstlane(ddst + (slot)))
    const lds_cptr shm3 = (lds_cptr)shm; const int sw = (r32 >> 2) & 3, c0o = ((2 * hi) ^ sw) * 16, c1o = ((2 * hi + 1) ^ sw) * 16;
    const lds_cptr kp0 = shm3 + L8_K + r32 * 64;
#define vp0 (kp0 + (L8_V - L8_K))
    if (kw) { DMA8_K(0, 0); DMA8_K(1, SLOT8); DMA8_K(2, 2 * SLOT8); DMA8_K(3, 3 * SLOT8); DMA8_K(4, 4 * SLOT8); } else { DMA8_V(0, 0); DMA8_V(1, SLOT8); DMA8_V(2, 2 * SLOT8); }
    const v8i_t qrA = *reinterpret_cast<const v8i_t*>(Q8 + (qrow0 + r32) * DMQ + h * D + hi * 32);
    const v8i_t qrB = *reinterpret_cast<const v8i_t*>(Q8 + (qrow0 + 32 + r32) * DMQ + h * D + hi * 32);
    f32x16 oA0 = f32x16{}, oA1 = f32x16{}, oB0 = f32x16{}, oB1 = f32x16{}, lA = f32x16{}, lB = f32x16{};
    typedef short v2s_t __attribute__((ext_vector_type(2)));
    float pscale = exp2f(-negM_); asm volatile("" : "+v"(pscale));
    const v8i_t ONES8 = (v8i_t){0x38383838, 0x38383838, 0x38383838, 0x38383838, 0x38383838, 0x38383838, 0x38383838, 0x38383838};
    f32x16 c0, c1; v8i_t kf[2], vf[2], pwA = (v8i_t){0, 0, 0, 0, 0, 0, 0, 0}, pwB = (v8i_t){0, 0, 0, 0, 0, 0, 0, 0};
    int s0 = 0, s1 = SLOT8, s2 = 2 * SLOT8, s3 = 3 * SLOT8, s5 = 5 * SLOT8;
#define NXT8(x) (((x) == (NS8 - 1) * SLOT8) ? 0 : (x) + SLOT8)
#define ROT8() do { s0 = s1; s1 = s2; s2 = s3; s3 = NXT8(s3); s5 = NXT8(s5); } while (0)
#define MX8(acc, A, B, SC) acc = __builtin_amdgcn_mfma_scale_f32_32x32x64_f8f6f4(A, B, acc, 0, 0, 0, SC, 1, SC)
#define QKW(QR) do { c0 = __builtin_amdgcn_mfma_scale_f32_32x32x64_f8f6f4(kf[0], QR, f32x16{}, 0, 0, 0, SC_QK, 1, SC_QK); c1 = __builtin_amdgcn_mfma_scale_f32_32x32x64_f8f6f4(kf[1], QR, f32x16{}, 0, 0, 0, SC_QK, 1, SC_QK); } while (0)
#define PK8(P, B, OLD) __builtin_bit_cast(int, __builtin_amdgcn_cvt_scalef32_pk_fp8_f32(__builtin_amdgcn_cvt_scalef32_pk_fp8_f32(__builtin_bit_cast(v2s_t, OLD), P[B], P[B + 1], pscale, false), P[B + 2], P[B + 3], pscale, true))
#define PVW() do { MX8(oA0, pwA, vf[0], SC_PV); MX8(oA1, pwA, vf[1], SC_PV); MX8(lA, pwA, ONES8, SC_PV); MX8(oB0, pwB, vf[0], SC_PV); MX8(oB1, pwB, vf[1], SC_PV); MX8(lB, pwB, ONES8, SC_PV); } while (0)
#define EXPW(PW) do { _Pragma("unroll") for (int r = 0; r < 16; ++r) { c0[r] = __builtin_amdgcn_exp2f(c0[r]); c1[r] = __builtin_amdgcn_exp2f(c1[r]); } \
        PW[0] = PK8(c0, 0, PW[0]); PW[1] = PK8(c0, 4, PW[1]); PW[2] = PK8(c0, 8, PW[2]); PW[3] = PK8(c0, 12, PW[3]); PW[4] = PK8(c1, 0, PW[4]); PW[5] = PK8(c1, 4, PW[5]); PW[6] = PK8(c1, 8, PW[6]); PW[7] = PK8(c1, 12, PW[7]); } while (0)
    WAIT_BAR(0);
    kf[0] = ld32(kp0, c0o, c1o); kf[1] = ld32(kp0 + 2048, c0o, c1o);
    QKW(qrA); EXPW(pwA); SBAR(); QKW(qrB); EXPW(pwB);
    kf[0] = ld32(kp0 + SLOT8, c0o, c1o); kf[1] = ld32(kp0 + SLOT8 + 2048, c0o, c1o);
    WAIT_BAR(0);
#define SUBW(t, GK, GV, GL, MID) do { SBAR(); \
    vf[0] = ld32(vp0 + s0, c0o, c1o); vf[1] = ld32(vp0 + s0 + 2048, c0o, c1o); \
    PVW(); \
    if (kw) { if (GK) { DMA8_K((t) + 4, s5); } } else { if (GV) { DMA8_V((t) + 2, s3); } } \
    SBAR(); QKW(qrA); SBAR(); EXPW(pwA); SBAR(); \
    QKW(qrB); \
    if (GL) { kf[0] = ld32(kp0 + s2, c0o, c1o); kf[1] = ld32(kp0 + s2 + 2048, c0o, c1o); } \
    SBAR(); MID; SBAR(); \
    EXPW(pwB); ROT8(); \
    } while (0)
    int t = 1;
#pragma unroll 1
    for (; t + 1 < NT; t += 2) {
        SUBW(t, (t + 4 < NT), (t + 2 < NT), (t + 1 < NT), (void)0);
        SUBW(t + 1, (t + 5 < NT), (t + 3 < NT), (t + 2 < NT), if (!kw) { if (t + 5 < NT) WAIT_BAR(1); else WAIT_BAR(0); });
        if (kw) { if (t + 5 < NT) WAIT_BAR(1); else WAIT_BAR(0); } }
    SUBW(NT - 1, false, false, false, (void)0);
    {
        asm volatile("s_waitcnt lgkmcnt(0)" ::: "memory");
        vf[0] = ld32(vp0 + s0, c0o, c1o); vf[1] = ld32(vp0 + s0 + 2048, c0o, c1o);
        PVW(); }
    bf16* stg = (bf16*)(shm + LDS_OST) + wid * 2048;
#define OUTW(O0, O1, L, ROFF) do { bf16* Ow = O + (qrow0 + (ROFF)) * DMO + h * D; \
      _Pragma("unroll") for (int r = 0; r < 16; ++r) { const int orow = crow(r, hi); const float rl = __builtin_amdgcn_rcpf(L[r]); \
        stg[orow * 64 + r32] = __float2bfloat16(O0[r] * rl); stg[orow * 64 + 32 + r32] = __float2bfloat16(O1[r] * rl); } \
      asm volatile("s_waitcnt lgkmcnt(0)" ::: "memory"); \
      _Pragma("unroll") for (int i = 0; i < 4; ++i) { const int row = i * 8 + (lane >> 3), ch = lane & 7; const u32x4 v = *(const u32x4*)(stg + row * 64 + ch * 8); *(u32x4*)(Ow + (long)row * DMO + ch * 8) = v; } \
      asm volatile("s_waitcnt lgkmcnt(0)" ::: "memory"); } while (0)
    OUTW(oA0, oA1, lA, 0); OUTW(oB0, oB1, lB, 32);
    asm volatile("s_waitcnt vmcnt(0) lgkmcnt(0)\n\ts_barrier" ::: "memory");
#undef DMA8_K
#undef DMA8_V
#undef ROT8
#undef MX8
#undef QKW
#undef PK8
#undef PVW
#undef EXPW
#undef SUBW
#undef OUTW
#undef vp0
#undef NXT8
}
#undef SBAR
#undef WAIT_BAR
}

#define XB_TMO      128
#define XB_XCNT(j)  (256  + 64 * (j))
#define XB_XSUB(j)  (1280 + 64 * (j))
#define XB_XGEN(j)  (2304 + 64 * (j))
#define XB_TOP      3328
#define XB_TOPGEN   3392
#define XCD_BAR_WORDS 3456
#define XB_SPIN_CAP (1u << 18)
__device__ __forceinline__ unsigned xb_ld(unsigned* p)              { return __hip_atomic_load(p, __ATOMIC_RELAXED, __HIP_MEMORY_SCOPE_AGENT); }
__device__ __forceinline__ unsigned xb_add(unsigned* p, unsigned v) { return __hip_atomic_fetch_add(p, v, __ATOMIC_RELAXED, __HIP_MEMORY_SCOPE_AGENT); }
__device__ __forceinline__ unsigned xb_xcc_id() { return (unsigned)__builtin_amdgcn_s_getreg((3 << 11) | 20) & 0xFu; }
#define XB_SPIN(cond, bar) do { unsigned _sp = 0; while (cond) { __builtin_amdgcn_s_sleep(1); \
    if ((++_sp & 255u) == 0u) { if (xb_ld(&(bar)[XB_TMO])) break; if (_sp > XB_SPIN_CAP) { atomicAdd(&(bar)[XB_TMO], 1u); break; } } } } while (0)
struct XcdBarrier { unsigned* bar; unsigned x; volatile LAS unsigned* st; };
__device__ __forceinline__ XcdBarrier xcd_barrier_post(unsigned* bar, volatile LAS unsigned* st) {
    XcdBarrier b; b.bar = bar; b.x = xb_xcc_id(); b.st = st;
    if (threadIdx.x == 0) (void)xb_add(&bar[XB_XCNT(b.x)], 1u);
    return b;
}
__device__ __forceinline__ void xcd_barrier_complete(unsigned* bar, unsigned x, unsigned& nloc, unsigned& nx) {
    const unsigned G = gridDim.x * gridDim.y * gridDim.z;
    unsigned sum, cnt, mine, sp = 0u;
    for (;;) {
        sum = 0u; cnt = 0u; mine = 0u;
#pragma unroll
        for (unsigned j = 0; j < 16; ++j) { const unsigned c = xb_ld(&bar[XB_XCNT(j)]); sum += c; cnt += (c > 0u) ? 1u : 0u; mine = (j == x) ? c : mine; }
        if (sum == G) break;
        __builtin_amdgcn_s_sleep(1);
        if ((++sp & 255u) == 0u) { if (xb_ld(&bar[XB_TMO])) break; if (sp > XB_SPIN_CAP) { atomicAdd(&bar[XB_TMO], 1u); break; } }
    }
    nloc = mine > 0u ? mine : 1u; nx = cnt > 0u ? cnt : 1u;
}
__device__ __forceinline__ void xcd_barrier(const XcdBarrier& b) {
    asm volatile("s_waitcnt vmcnt(0)" ::: "memory");
    __syncthreads();
    if (threadIdx.x == 0) {
        unsigned* bar = b.bar;
        __builtin_amdgcn_s_waitcnt(0);
        unsigned nloc = b.st[0], nx = b.st[1];
        if (nloc == 0u) { xcd_barrier_complete(bar, b.x, nloc, nx); b.st[0] = nloc; b.st[1] = nx; }
        const unsigned old = xb_add(&bar[XB_XSUB(b.x)], 1u);
        const unsigned gen = old / nloc;
        if (old + 1u == (gen + 1u) * nloc) {
            __builtin_amdgcn_fence(__ATOMIC_RELEASE, "agent");
            asm volatile("s_waitcnt vmcnt(0)" ::: "memory");
            const unsigned og = xb_add(&bar[XB_TOP], 1u);
            const unsigned tg = og / nx;
            if (og + 1u == (tg + 1u) * nx) xb_add(&bar[XB_TOPGEN], 1u);
            else XB_SPIN(xb_ld(&bar[XB_TOPGEN]) == tg, bar);
            __builtin_amdgcn_fence(__ATOMIC_ACQUIRE, "agent");
            xb_add(&bar[XB_XGEN(b.x)], 1u);
            asm volatile("s_waitcnt vmcnt(0)" ::: "memory");
        } else {
            XB_SPIN(xb_ld(&bar[XB_XGEN(b.x)]) == gen, bar);
            __builtin_amdgcn_fence(__ATOMIC_ACQUIRE, "agent");
            asm volatile("s_waitcnt vmcnt(0)" ::: "memory");
        }
    }
    __syncthreads();
}

struct Frame {
    LAS unsigned char* lds;
    volatile LAS unsigned* MISC;
    gu32* ctl;
    int tid, lane, wave;
    int vcu, G;
    const float* const* ka;
    float* out;
    unsigned char* ws;
};
#define WSP(T, off) ((T*)(F.ws + (off)))
#define FIN_x (F.ka[0])
#define FIN_c (F.ka[1])
#define FIN_ctx (F.ka[2])
#define FIN_c_ctx (F.ka[3])
#define FIN_norm1_g (F.ka[4])
#define FIN_w_ada (F.ka[5])
#define FIN_b_ada (F.ka[6])
#define FIN_w_in (F.ka[7])
#define FIN_w_fourier (F.ka[8])
#define FIN_q_norm_g (F.ka[9])
#define FIN_k_norm_g (F.ka[10])
#define FIN_w_out (F.ka[11])
#define FIN_norm2_g (F.ka[12])
#define FIN_w_router (F.ka[13])
#define FIN_router_bias (F.ka[14])
#define FIN_w_egu (F.ka[15])
#define FIN_w_ed (F.ka[16])
#define FIN_w_sgu (F.ka[17])
#define FIN_w_sd (F.ka[18])
#define FIN_final_g (F.ka[19])

struct DenseOrder {
    static constexpr bool GATHER = false;
    int nN, nmain, nextra, G, c; const char* Bt; int K; int reps;
    __device__ __forceinline__ bool next(int i, pg8::GUnit& u) const {
        const int ntot = nmain + nextra, nc = (ntot - c + G - 1) / G; if (i >= nc * reps) return false;
        const int L = (i % nc) * G + c;
        if (L < nmain) { const int nig = 8 * nN, gid = L / nig, r = L % nig; u.pm = gid * 8 + (r & 7); u.pn = r >> 3; }
        else { const int jx = L - nmain; u.pm = 128 + (jx & 3); u.pn = 5 + (jx >> 2); }
        u.e = 0; u.j = 0; u.nvalid = 256; u.B = Bt + (size_t)u.pn * 256 * K * 2; return true;
    }
    __device__ __forceinline__ int arow(const pg8::GUnit& u, int r) const { return u.pm * 256 + r; }
};
template <bool GATHER_> struct GroupedOrder {
    static constexpr bool GATHER = GATHER_;
    int NPN, G, c, nbrows, K; bool gather; const char* Bt; const LAS int* TS; const LAS int* CN; const GAS u32x2* LIST; int reps; int total;
    __device__ __forceinline__ bool next(int i, pg8::GUnit& u) const {
        const int ntot = total * NPN, nc = (ntot - c + G - 1) / G; if (i >= nc * reps) return false;
        const int L = (i % nc) * G + c; const int T = L / NPN;
        int lo = __builtin_amdgcn_readfirstlane((int)((const LAS unsigned short*)(TS + 640))[T]);
        const int ts = __builtin_amdgcn_readfirstlane(TS[lo]), cn = __builtin_amdgcn_readfirstlane(CN[lo]);
        u.pm = T; u.pn = L - T * NPN; u.e = lo; u.j = T - ts; const int rem = cn - 256 * u.j; u.nvalid = rem < 256 ? rem : 256;
        u.B = Bt + ((size_t)lo * nbrows + (size_t)u.pn * 256) * K; return true;
    }
    __device__ __forceinline__ int arow(const pg8::GUnit& u, int r) const {
        if (!gather) return u.pm * 256 + r;
        int pos = 256 * u.j + r; if (r >= u.nvalid) pos = 0;
        const u32x2 en = LIST[(size_t)u.e * NTOK + pos];
        return (int)(en.x & 0xffffu);
    }
};

struct EpiInProj {
    static constexpr bool PERM = true; static constexpr int NSTORE = 8;
    __device__ __forceinline__ void pre(LAS unsigned char*, const pg8::GUnit&, int, int, int) const {}
    u16 *Z, *Q, *Kb, *Vb; const float *COS, *SIN, *gq, *gk;
    __device__ __forceinline__ void operator()(const f32x4 (&acc)[2][2][4][2], const pg8::GUnit& u, int wr, int wc, int fr, int fq, LAS unsigned char* lds, int ui) const {
        const int pn = u.pn; const bool is_ctx = u.pm >= 128;
        if (ATTN_FP8 && pn == 6) {
            LAS unsigned char* st = lds + pg8::STAGE_BYTES; const int tid = threadIdx.x;
            const int b = is_ctx ? (u.pm - 128) : (u.pm >> 5), kt0 = is_ctx ? (SEQ / 64) : (((u.pm * 256) & (SEQ - 1)) >> 6);
#pragma unroll
            for (int ai = 0; ai < 2; ++ai)
#pragma unroll
                for (int bj = 0; bj < 2; ++bj) {
#pragma unroll
                    for (int m = 0; m < 4; ++m) { const int ks = attn_body::vt_slot(16 * m + fr); const f32x4 v0 = acc[ai][bj][m][0], v1 = acc[ai][bj][m][1];
                        int w0 = __builtin_amdgcn_cvt_pk_fp8_f32(v0[0], v0[1], 0, false); w0 = __builtin_amdgcn_cvt_pk_fp8_f32(v0[2], v0[3], w0, true);
                        int w1 = __builtin_amdgcn_cvt_pk_fp8_f32(v1[0], v1[1], 0, false); w1 = __builtin_amdgcn_cvt_pk_fp8_f32(v1[2], v1[3], w1, true);
#pragma unroll
                        for (int q8 = 0; q8 < 8; ++q8) st[((wr * 128 + 32 * wc + 8 * fq + q8) * 64) + ks] = (unsigned char)(((q8 < 4 ? (unsigned)w0 : (unsigned)w1) >> (8 * (q8 & 3))) & 0xffu); }
                    asm volatile("s_waitcnt lgkmcnt(0)" ::: "memory"); __builtin_amdgcn_s_barrier(); asm volatile("" ::: "memory");
#pragma unroll
                    for (int j = 0; j < 2; ++j) { const int ch = tid + 512 * j, row = ch >> 2, part = ch & 3, col = 128 * bj + (row & 127), kvh = col >> 6, d = col & 63, kt = kt0 + 2 * ai + (row >> 7);
                        const u32x4 v = *(const LAS u32x4*)(st + row * 64 + part * 16);
                        *(u32x4*)((unsigned char*)Vb + ((((size_t)(b * NKVH + kvh) * (LKV / 64) + kt) * 64 + d) * 64) + part * 16) = v; }
                    asm volatile("s_waitcnt lgkmcnt(0)" ::: "memory"); __builtin_amdgcn_s_barrier(); asm volatile("" ::: "memory");
                }
            return;
        }
        float gn[2][2][4];
        if (pn >= 2 && pn < 6) { const float* gsrc = (pn == 5) ? gk : gq;
#pragma unroll
            for (int bj = 0; bj < 2; ++bj)
#pragma unroll
                for (int n = 0; n < 2; ++n) { const f32x4 g4 = *(const f32x4*)(gsrc + 32 * bj + 16 * n + 4 * fq); gn[bj][n][0] = g4[0]; gn[bj][n][1] = g4[1]; gn[bj][n][2] = g4[2]; gn[bj][n][3] = g4[3]; } }
#pragma unroll
        for (int ai = 0; ai < 2; ++ai)
#pragma unroll
            for (int m = 0; m < 4; ++m) {
                const int row = u.pm * 256 + ai * 128 + wr * 64 + m * 16 + fr;
                int b, l, key;
                if (!is_ctx) { b = row >> 13; l = row & 8191; key = l; } else { const int rc = row - NTOK; b = rc >> 8; l = 0; key = SEQ + (rc & 255); }
                if (pn < 2) {
#pragma unroll
                    for (int bj = 0; bj < 2; ++bj) { const int g = 32 * pn + 16 * bj + 4 * wc + fq; const f32x4 v0 = acc[ai][bj][m][0], v1 = acc[ai][bj][m][1];
                        u32x4 w; w.x = cvt_pk_bf16(v0[0], v0[1]); w.y = cvt_pk_bf16(v0[2], v0[3]); w.z = cvt_pk_bf16(v1[0], v1[1]); w.w = cvt_pk_bf16(v1[2], v1[3]);
                        *(u32x4*)(Z + (((size_t)(b * 64 + g) * SEQ + l) * 8)) = w; }
                } else if (pn < 6) {
                    float ss = 0.f;
#pragma unroll
                    for (int bj = 0; bj < 2; ++bj)
#pragma unroll
                        for (int n = 0; n < 2; ++n) { const f32x4 v = acc[ai][bj][m][n]; ss += (v[0] * v[0] + v[1] * v[1]) + (v[2] * v[2] + v[3] * v[3]); }
                    ss += __shfl_xor(ss, 16); ss += __shfl_xor(ss, 32);
                    const float rstd = 1.0f / sqrtf(ss * (1.0f / 64.0f) + RMS_EPS);
                    const float osc = (pn == 5) ? 1.0f : C2;
#pragma unroll
                    for (int bj = 0; bj < 2; ++bj) {
                        const int pidx = (bj == 0) ? (l >> 6) : (l & 63);
                        f32x4 cs = *(const f32x4*)(COS + pidx * 16 + 4 * fq), sn = *(const f32x4*)(SIN + pidx * 16 + 4 * fq);
                        if (is_ctx) { cs = (f32x4){1.f, 1.f, 1.f, 1.f}; sn = (f32x4){0.f, 0.f, 0.f, 0.f}; }
                        float oa[4], ob[4];
#pragma unroll
                        for (int e = 0; e < 4; ++e) { const float a = acc[ai][bj][m][0][e] * rstd * gn[bj][0][e], bb = acc[ai][bj][m][1][e] * rstd * gn[bj][1][e];
                            oa[e] = (a * cs[e] - bb * sn[e]) * osc; ob[e] = (bb * cs[e] + a * sn[e]) * osc; }
                        if (ATTN_FP8) {
                            const float f8s = (pn < 5) ? Q8_SCALE : 1.0f;
                            int w0 = __builtin_amdgcn_cvt_pk_fp8_f32(oa[0] * f8s, oa[1] * f8s, 0, false); w0 = __builtin_amdgcn_cvt_pk_fp8_f32(oa[2] * f8s, oa[3] * f8s, w0, true);
                            int w1 = __builtin_amdgcn_cvt_pk_fp8_f32(ob[0] * f8s, ob[1] * f8s, 0, false); w1 = __builtin_amdgcn_cvt_pk_fp8_f32(ob[2] * f8s, ob[3] * f8s, w1, true);
                            if (pn < 5) { const int head = 4 * (pn - 2) + wc; *(u32x2*)((unsigned char*)Q + ((size_t)row * QW + head * 64 + 32 * bj + 8 * fq)) = (u32x2){(unsigned)w0, (unsigned)w1}; }
                            else *(u32x2*)((unsigned char*)Kb + (((size_t)b * LKV + key) * KVW + wc * 64 + 32 * bj + 8 * fq)) = (u32x2){(unsigned)w0, (unsigned)w1};
                        } else {
                        u32x4 w; w.x = cvt_pk_bf16(oa[0], oa[1]); w.y = cvt_pk_bf16(oa[2], oa[3]); w.z = cvt_pk_bf16(ob[0], ob[1]); w.w = cvt_pk_bf16(ob[2], ob[3]);
                        if (pn < 5) { const int head = 4 * (pn - 2) + wc; *(u32x4*)(Q + ((size_t)row * QW + head * 64 + 32 * bj + 8 * fq)) = w; }
                        else *(u32x4*)(Kb + (((size_t)b * LKV + key) * KVW + wc * 64 + 32 * bj + 8 * fq)) = w; }
                    }
                } else {
#pragma unroll
                    for (int bj = 0; bj < 2; ++bj) { const f32x4 v0 = acc[ai][bj][m][0], v1 = acc[ai][bj][m][1];
                        if (ATTN_FP8) {
                            const int kt = key >> 6, ks = attn_body::vt_slot(key & 63);
                            int w0 = __builtin_amdgcn_cvt_pk_fp8_f32(v0[0], v0[1], 0, false); w0 = __builtin_amdgcn_cvt_pk_fp8_f32(v0[2], v0[3], w0, true);
                            int w1 = __builtin_amdgcn_cvt_pk_fp8_f32(v1[0], v1[1], 0, false); w1 = __builtin_amdgcn_cvt_pk_fp8_f32(v1[2], v1[3], w1, true);
#pragma unroll
                            for (int q8 = 0; q8 < 8; ++q8) { const int col = 128 * bj + 32 * wc + 8 * fq + q8, kvh = col >> 6, d = col & 63;
                                ((unsigned char*)Vb)[((((size_t)(b * NKVH + kvh) * (LKV / 64) + kt) * 64 + d) * 64) + ks] = (unsigned char)(((q8 < 4 ? (unsigned)w0 : (unsigned)w1) >> (8 * (q8 & 3))) & 0xffu); }
                        } else {
                        u32x4 w; w.x = cvt_pk_bf16(v0[0], v0[1]); w.y = cvt_pk_bf16(v0[2], v0[3]); w.z = cvt_pk_bf16(v1[0], v1[1]); w.w = cvt_pk_bf16(v1[2], v1[3]);
                        *(u32x4*)(Vb + (((size_t)b * LKV + key) * KVW + 128 * bj + 32 * wc + 8 * fq)) = w; } }
                }
            }
    }
};
struct EpiResid {
    static constexpr bool PERM = false; static constexpr int NSTORE = 32;
    __device__ __forceinline__ void pre(LAS unsigned char*, const pg8::GUnit&, int, int, int) const {}
    const float* x; float* X1; const gi64* MOD;
    __device__ __forceinline__ void operator()(const f32x4 (&acc)[2][2][4][2], const pg8::GUnit& u, int wr, int wc, int fr, int fq, LAS unsigned char* lds, int ui) const {
        const int row0 = u.pm * 256 + wr * 64 + fr, col0 = u.pn * 256 + wc * 32 + 4 * fq; const int b = (u.pm * 256) >> 13;
        f32x4 gv[2][2];
#pragma unroll
        for (int bj = 0; bj < 2; ++bj)
#pragma unroll
            for (int n = 0; n < 2; ++n) gv[bj][n] = mod4(MOD, b * 6144 + 2048 + col0 + bj * 128 + n * 16);
#pragma unroll
        for (int ai = 0; ai < 2; ++ai)
#pragma unroll
            for (int m = 0; m < 4; ++m) { const size_t off = (size_t)(row0 + ai * 128 + m * 16) * DM + col0;
#pragma unroll
                for (int bj = 0; bj < 2; ++bj)
#pragma unroll
                    for (int n = 0; n < 2; ++n) { const f32x4 xv = *(const f32x4*)(x + off + bj * 128 + n * 16); *(f32x4*)(X1 + off + bj * 128 + n * 16) = (DBG & 2) ? xv : xv + gv[bj][n] * acc[ai][bj][m][n]; } }
    }
};
struct EpiLogits {
    static constexpr bool PERM = false; static constexpr int NSTORE = 32;
    __device__ __forceinline__ void pre(LAS unsigned char*, const pg8::GUnit&, int, int, int) const {}
    float* C;
    __device__ __forceinline__ void operator()(const f32x4 (&acc)[2][2][4][2], const pg8::GUnit& u, int wr, int wc, int fr, int fq, LAS unsigned char* lds, int ui) const {
        const int row0 = u.pm * 256 + wr * 64 + fr, col0 = wc * 32 + 4 * fq;
#pragma unroll
        for (int ai = 0; ai < 2; ++ai)
#pragma unroll
            for (int m = 0; m < 4; ++m) { float* rowp = C + (size_t)(row0 + ai * 128 + m * 16) * NEXP + col0;
#pragma unroll
                for (int bj = 0; bj < 2; ++bj)
#pragma unroll
                    for (int n = 0; n < 2; ++n) *(f32x4*)(rowp + bj * 128 + n * 16) = acc[ai][bj][m][n]; }
    }
};
struct EpiSwiglu {
    static constexpr bool PERM = true; static constexpr int NSTORE = 16;
    __device__ __forceinline__ void pre(LAS unsigned char*, const pg8::GUnit&, int, int, int) const {}
    u16* ACT;
    __device__ __forceinline__ void operator()(const f32x4 (&acc)[2][2][4][2], const pg8::GUnit& u, int wr, int wc, int fr, int fq, LAS unsigned char* lds, int ui) const {
#pragma unroll
        for (int ai = 0; ai < 2; ++ai)
#pragma unroll
            for (int m = 0; m < 4; ++m) { const int r = ai * 128 + wr * 64 + m * 16 + fr; u16* rowp = ACT + ((size_t)u.pm * 256 + r) * EFF + 128 * u.pn + 16 * wc + 4 * fq;
#pragma unroll
                for (int bj = 0; bj < 2; ++bj) { const f32x4 a = acc[ai][bj][m][0], g = acc[ai][bj][m][1]; float o[4];
#pragma unroll
                    for (int e = 0; e < 4; ++e) o[e] = a[e] * g[e] / (1.0f + __expf(-a[e]));
                    if (MOE_FP8) { int w0 = __builtin_amdgcn_cvt_pk_fp8_f32(o[0], o[1], 0, false); w0 = __builtin_amdgcn_cvt_pk_fp8_f32(o[2], o[3], w0, true);
                        *(unsigned*)((unsigned char*)ACT + ((size_t)u.pm * 256 + r) * EFF + 128 * u.pn + 16 * wc + 4 * fq + 64 * bj) = (unsigned)w0; }
                    else { u32x2 w; if (MOEF16) { w.x = pk2h(o[0], o[1]); w.y = pk2h(o[2], o[3]); } else { w.x = pk2bf(o[0], o[1]); w.y = pk2bf(o[2], o[3]); } *(u32x2*)(rowp + 64 * bj) = w; } } }
    }
};
struct EpiDown {
    static constexpr bool PERM = true; static constexpr int NSTORE = 16;
    u16* Cc; const GAS u32x2* LIST; unsigned char* dump;
    __device__ __forceinline__ void pre(LAS unsigned char* lds, const pg8::GUnit& u, int ui, int wid, int lane) const {
        if (wid < 2) __builtin_amdgcn_global_load_lds((const unsigned*)(LIST + (size_t)u.e * NTOK + 256 * u.j + 128 * wid + 2 * lane), (LAS unsigned*)(lds + pg8::STAGE_BYTES + (ui & 1) * 2048 + wid * 1024), 16, 0, 0);
    }
    __device__ __forceinline__ void operator()(const f32x4 (&acc)[2][2][4][2], const pg8::GUnit& u, int wr, int wc, int fr, int fq, LAS unsigned char* lds, int ui) const {
        const LAS f32x2* ent = (const LAS f32x2*)(lds + pg8::STAGE_BYTES + (ui & 1) * 2048);
#pragma unroll
        for (int ai = 0; ai < 2; ++ai)
#pragma unroll
            for (int m = 0; m < 4; ++m) { const int r = ai * 128 + wr * 64 + m * 16 + fr;
                const f32x2 enf = ent[r];
                const unsigned ex = __builtin_bit_cast(unsigned, enf.x); const int tok = (int)(ex & 0x7fffu), slot = (int)((ex >> 16) & 15u); const float gate = enf.y;
                unsigned char* rowp = (unsigned char*)Cc + ((size_t)tok * NSLOT + slot) * DM + 256 * u.pn + 32 * wc + 8 * fq;
                if (r >= u.nvalid) rowp = dump + ((size_t)(blockIdx.x * 512 + threadIdx.x)) * 256;
                const float gs = gate * C_SCALE;
#pragma unroll
                for (int bj = 0; bj < 2; ++bj) { f32x4 v0 = acc[ai][bj][m][0] * gs, v1 = acc[ai][bj][m][1] * gs;
#pragma unroll
                    for (int e = 0; e < 4; ++e) { v0[e] = __builtin_amdgcn_fmed3f(v0[e], -440.f, 440.f); v1[e] = __builtin_amdgcn_fmed3f(v1[e], -440.f, 440.f); }
                    int w0 = __builtin_amdgcn_cvt_pk_fp8_f32(v0[0], v0[1], 0, false); w0 = __builtin_amdgcn_cvt_pk_fp8_f32(v0[2], v0[3], w0, true);
                    int w1 = __builtin_amdgcn_cvt_pk_fp8_f32(v1[0], v1[1], 0, false); w1 = __builtin_amdgcn_cvt_pk_fp8_f32(v1[2], v1[3], w1, true);
                    *(u32x2*)(rowp + 128 * bj) = (u32x2){(unsigned)w0, (unsigned)w1}; } }
    }
};

template <bool F16OUT, bool F8OUT2 = false> __device__ __forceinline__ void rownorm_rows(const GAS float* src, const float* gain, const gi64* MODsh, const gi64* MODsc, u16* dst, int row0, int nrows, int wi, int wstride, int lane, unsigned char* dst8 = nullptr) {
    f32x4 Av[2][2], Bv[2][2];
#pragma unroll
    for (int j = 0; j < 2; ++j)
#pragma unroll
        for (int h = 0; h < 2; ++h) { const int col = 8 * lane + 512 * j + 4 * h; Av[j][h] = *(const f32x4*)(gain + col) * (mod4(MODsc, col) + 1.0f); Bv[j][h] = mod4(MODsh, col); }
    for (int r = wi; r < nrows; r += 2 * wstride) {
        const int r1 = r + wstride; const bool has1 = r1 < nrows;
        const GAS float* s0 = src + (size_t)(row0 + r) * DM; const GAS float* s1 = src + (size_t)(row0 + (has1 ? r1 : r)) * DM;
        f32x4 v0[2][2], v1[2][2];
#pragma unroll
        for (int j = 0; j < 2; ++j)
#pragma unroll
            for (int h = 0; h < 2; ++h) { v0[j][h] = *(const GAS f32x4*)(s0 + 8 * lane + 512 * j + 4 * h); v1[j][h] = *(const GAS f32x4*)(s1 + 8 * lane + 512 * j + 4 * h); }
        float q0 = 0.f, q1 = 0.f;
#pragma unroll
        for (int j = 0; j < 2; ++j)
#pragma unroll
            for (int h = 0; h < 2; ++h) { const f32x4 a = v0[j][h], b = v1[j][h]; q0 += (a[0] * a[0] + a[1] * a[1]) + (a[2] * a[2] + a[3] * a[3]); q1 += (b[0] * b[0] + b[1] * b[1]) + (b[2] * b[2] + b[3] * b[3]); }
#pragma unroll
        for (int o = 1; o < 64; o <<= 1) { q0 += __shfl_xor(q0, o); q1 += __shfl_xor(q1, o); }
        const float rs0 = 1.0f / sqrtf(q0 * (1.0f / DM) + RMS_EPS), rs1 = 1.0f / sqrtf(q1 * (1.0f / DM) + RMS_EPS);
#pragma unroll
        for (int j = 0; j < 2; ++j) { const f32x4 ya = v0[j][0] * rs0 * Av[j][0] + Bv[j][0], yb = v0[j][1] * rs0 * Av[j][1] + Bv[j][1];
            u32x4 w; if (F16OUT) { w.x = pk2h(ya[0], ya[1]); w.y = pk2h(ya[2], ya[3]); w.z = pk2h(yb[0], yb[1]); w.w = pk2h(yb[2], yb[3]); } else { w.x = pk2bf(ya[0], ya[1]); w.y = pk2bf(ya[2], ya[3]); w.z = pk2bf(yb[0], yb[1]); w.w = pk2bf(yb[2], yb[3]); }
            *(GAS u32x4*)(dst + (size_t)(row0 + r) * DM + 8 * lane + 512 * j) = w;
            if (F8OUT2) { int w0 = __builtin_amdgcn_cvt_pk_fp8_f32(ya[0], ya[1], 0, false); w0 = __builtin_amdgcn_cvt_pk_fp8_f32(ya[2], ya[3], w0, true); int w1 = __builtin_amdgcn_cvt_pk_fp8_f32(yb[0], yb[1], 0, false); w1 = __builtin_amdgcn_cvt_pk_fp8_f32(yb[2], yb[3], w1, true);
                *(GAS u32x2*)(dst8 + (size_t)(row0 + r) * DM + 8 * lane + 512 * j) = (u32x2){(unsigned)w0, (unsigned)w1}; } }
        if (has1) {
#pragma unroll
            for (int j = 0; j < 2; ++j) { const f32x4 ya = v1[j][0] * rs1 * Av[j][0] + Bv[j][0], yb = v1[j][1] * rs1 * Av[j][1] + Bv[j][1];
                u32x4 w; if (F16OUT) { w.x = pk2h(ya[0], ya[1]); w.y = pk2h(ya[2], ya[3]); w.z = pk2h(yb[0], yb[1]); w.w = pk2h(yb[2], yb[3]); } else { w.x = pk2bf(ya[0], ya[1]); w.y = pk2bf(ya[2], ya[3]); w.z = pk2bf(yb[0], yb[1]); w.w = pk2bf(yb[2], yb[3]); }
                *(GAS u32x4*)(dst + (size_t)(row0 + r1) * DM + 8 * lane + 512 * j) = w;
                if (F8OUT2) { int w0 = __builtin_amdgcn_cvt_pk_fp8_f32(ya[0], ya[1], 0, false); w0 = __builtin_amdgcn_cvt_pk_fp8_f32(ya[2], ya[3], w0, true); int w1 = __builtin_amdgcn_cvt_pk_fp8_f32(yb[0], yb[1], 0, false); w1 = __builtin_amdgcn_cvt_pk_fp8_f32(yb[2], yb[3], w1, true);
                    *(GAS u32x2*)(dst8 + (size_t)(row0 + r1) * DM + 8 * lane + 512 * j) = (u32x2){(unsigned)w0, (unsigned)w1}; } } }
    }
}

__device__ __forceinline__ void p0_phase(Frame& F) {
    const int gw = F.vcu * 8 + F.wave, NGW = F.G * 8, lane = F.lane;
    unsigned long long* MODQ = (unsigned long long*)(F.ctl + CW_MOD);
    for (int it = gw; it < 1536; it += NGW) {
        const int cb = it % 24, kc = it / 24, k0 = kc * 16, col = cb * 256 + lane * 4;
        float sv[5];
#pragma unroll
        for (int r = 0; r < 5; ++r) { const float cv = (r < 4) ? FIN_c[r * DM + k0 + (lane & 15)] : FIN_c_ctx[k0 + (lane & 15)]; sv[r] = cv / (1.0f + __expf(-cv)); }
        f32x4 acc[5];
#pragma unroll
        for (int r = 0; r < 5; ++r) acc[r] = (f32x4){0.f, 0.f, 0.f, 0.f};
#pragma unroll
        for (int kk = 0; kk < 16; ++kk) { const f32x4 w = *(const f32x4*)(FIN_w_ada + (size_t)(k0 + kk) * 6144 + col);
#pragma unroll
            for (int r = 0; r < 5; ++r) { const float s = __builtin_bit_cast(float, __builtin_amdgcn_readlane(__builtin_bit_cast(int, sv[r]), kk)); acc[r] += w * s; } }
        if (kc == 0) { const f32x4 bv = *(const f32x4*)(FIN_b_ada + col);
#pragma unroll
            for (int r = 0; r < 5; ++r) acc[r] += bv; }
#pragma unroll
        for (int r = 0; r < 5; ++r)
#pragma unroll
            for (int j = 0; j < 4; ++j) atomicAdd(MODQ + r * 6144 + col + j, (unsigned long long)__float2ll_rn(acc[r][j] * 0x1p36f));
    }
    float* WCS = WSP(float, WS_TAB);
    for (int it = gw; it < 256; it += NGW) {
        const int fh = it >> 6, d = it & 63; float ac = 0.f, as = 0.f;
        const float ctab = cospif((float)lane * (1.0f / 32.0f)), stab = sinpif((float)lane * (1.0f / 32.0f));
        for (int k2 = 0; k2 < 64; ++k2) { const int mm = __builtin_amdgcn_readfirstlane((d * k2) & 63); const float w = FIN_w_fourier[(fh * 64 + k2) * 64 + lane]; ac += rdl(ctab, mm) * w; as += rdl(stab, mm) * w; }
        const float sc = 1.0f / sqrtf((float)SEQ * 64.0f);
        WCS[(fh * 64 + d) * 128 + lane] = ac * sc; WCS[(fh * 64 + d) * 128 + 64 + lane] = as * sc;
    }
    {
        u16* D1 = WSP(u16, WS_TAB + 144 * 1024); u16* D3 = WSP(u16, WS_TAB + 272 * 1024);
        for (int it = gw; it < 320; it += NGW) {
            if (it < 256) { const int ro = it >> 7, k1 = it & 127;
#pragma unroll
                for (int j = 0; j < 4; ++j) { const int col = lane + 64 * j, ri = col >> 7, n1 = col & 127, mm = (n1 * k1) & 127; const float cc = cospif((float)mm * (1.0f / 64.0f)), ss = sinpif((float)mm * (1.0f / 64.0f));
                    const float v = (ro == 0) ? (ri == 0 ? cc : -ss) : (ri == 0 ? -ss : -cc); D1[it * 256 + col] = (u16)f2bf(v); } }
            else { const int k2 = it - 256;
#pragma unroll
                for (int j = 0; j < 2; ++j) { const int col = lane + 64 * j, ri = col >> 6, n2 = col & 63, mm = (n2 * k2) & 63; const float v = (ri == 0) ? cospif((float)mm * (1.0f / 32.0f)) : sinpif((float)mm * (1.0f / 32.0f)); D3[k2 * 128 + col] = (u16)f2bf(v); } }
        }
    }
    float* COS = WSP(float, WS_TAB + 128 * 1024); float* SIN = WSP(float, WS_TAB + 136 * 1024);
    for (int it = gw; it < 32; it += NGW) { const int idx = it * 64 + lane, pos = idx >> 4, i = idx & 15;
        const float inv = powf(10000.0f, -(float)i / 16.0f), ang = (float)pos * inv; COS[idx] = cosf(ang); SIN[idx] = sinf(ang); }
}

__device__ __forceinline__ int map_row(int mode, int sc) {
    if (mode == 1) { const int head = sc >> 6, dim = sc & 63, bj = dim >> 5, n = (dim >> 4) & 1, i = dim & 15; return (head >> 2) * 256 + bj * 128 + (head & 3) * 32 + (i >> 2) * 8 + n * 4 + (i & 3); }
    if (mode == 2) { const int g = sc >> 8, a = sc & 255; return (a >> 2) * 8 + g * 4 + (a & 3); }
    return sc;
}
struct TItem { const float* src; u16* dst; int N, K, k0, rel_c0, mode, dst_off; bool f16; bool f8; float ws; };
__device__ __forceinline__ void titem_load(const TItem& t, float (&buf)[64], int lane) {
#pragma unroll
    for (int i = 0; i < 64; ++i) { const int kk = 2 * i + (lane >> 5); buf[i] = t.src[(size_t)kk * t.N + (lane & 31)]; }
}
__device__ __forceinline__ void titem_finish(const TItem& t, const float (&buf)[64], LAS float* scr, int lane) {
#pragma unroll
    for (int i = 0; i < 64; ++i) { const int kk = 2 * i + (lane >> 5); scr[kk * 33 + (lane & 31)] = buf[i]; }
    LDS_WAIT(); asm volatile("" ::: "memory");
    if (t.f8) { const int c = lane & 7; const float ws = t.ws;
#pragma unroll
        for (int j = 0; j < 4; ++j) { const int n = (lane >> 3) + 8 * j; const LAS float* s = scr + (16 * c) * 33 + n; int w[4];
#pragma unroll
            for (int q = 0; q < 4; ++q) { w[q] = __builtin_amdgcn_cvt_pk_fp8_f32(s[(4 * q) * 33] * ws, s[(4 * q + 1) * 33] * ws, 0, false); w[q] = __builtin_amdgcn_cvt_pk_fp8_f32(s[(4 * q + 2) * 33] * ws, s[(4 * q + 3) * 33] * ws, w[q], true); }
            const int drow = t.dst_off + map_row(t.mode, t.rel_c0 + n);
            *(GAS u32x4*)((unsigned char*)t.dst + (size_t)drow * t.K + t.k0 + 16 * c) = (u32x4){(unsigned)w[0], (unsigned)w[1], (unsigned)w[2], (unsigned)w[3]}; } }
    else { const int c = lane & 15;
#pragma unroll
        for (int j = 0; j < 8; ++j) { const int n = (lane >> 4) + 4 * j; const LAS float* s = scr + (8 * c) * 33 + n;
            u32x4 o;
            if (t.f16) { o.x = pk2h(s[0 * 33], s[1 * 33]); o.y = pk2h(s[2 * 33], s[3 * 33]); o.z = pk2h(s[4 * 33], s[5 * 33]); o.w = pk2h(s[6 * 33], s[7 * 33]); }
            else { o.x = pk2bf(s[0 * 33], s[1 * 33]); o.y = pk2bf(s[2 * 33], s[3 * 33]); o.z = pk2bf(s[4 * 33], s[5 * 33]); o.w = pk2bf(s[6 * 33], s[7 * 33]); }
            const int drow = t.dst_off + map_row(t.mode, t.rel_c0 + n);
            *(GAS u32x4*)(t.dst + (size_t)drow * t.K + t.k0 + 8 * c) = o; } }
    LDS_WAIT(); asm volatile("" ::: "memory");
}
constexpr int I_FOLD = 512, I_QKV = 8 * 40, I_OUT = 8 * 32, I_R = 8 * 8, I_GU = NEXPS * 8 * 16, I_D = NEXPS * 2 * 32;
constexpr int NT_EARLY = I_QKV + I_OUT + I_R, NT_ITEMS = NT_EARLY + I_GU + I_D;
constexpr int DEFER_A = 3840, DEFER_B = 4096;
#define TDECODE(it_, t) do { int r = (it_); u16* BIN = WSP(u16, WS_BIN); \
        if (r < I_QKV) { const int kb = r / 40, nb = r % 40, sc0 = 256 + 32 * nb; t.N = 1536; t.K = DM; t.k0 = kb * 128; t.f16 = false; t.f8 = false; t.ws = 1.f; t.dst = BIN; t.src = FIN_w_in + (size_t)(kb * 128) * 1536 + sc0; \
            if (sc0 < 1024) { t.rel_c0 = sc0 - 256; t.mode = 1; t.dst_off = 512; } else if (sc0 < 1280) { t.rel_c0 = sc0 - 1024; t.mode = 1; t.dst_off = 1280; } else { t.rel_c0 = sc0 - 1280; t.mode = 0; t.dst_off = 1536; } \
            break; } \
        r -= I_QKV; \
        if (r < I_OUT) { const int kb = r / 32, nb = r % 32; t.N = DM; t.K = DM; t.k0 = kb * 128; t.f16 = false; t.f8 = false; t.ws = 1.f; t.dst = WSP(u16, WS_BOUT); t.src = FIN_w_out + (size_t)(kb * 128) * DM + 32 * nb; t.rel_c0 = 32 * nb; t.mode = 0; t.dst_off = 0; break; } \
        r -= I_OUT; \
        if (r < I_R) { const int kb = r / 8, nb = r % 8; t.N = NEXP; t.K = DM; t.k0 = kb * 128; t.f16 = (MOE_FP8 ? false : MOEF16); t.f8 = false; t.ws = 1.f; t.dst = WSP(u16, WS_BR); t.src = FIN_w_router + (size_t)(kb * 128) * NEXP + 32 * nb; t.rel_c0 = 32 * nb; t.mode = 0; t.dst_off = 0; break; } \
        r -= I_R; \
        if (r < I_GU) { const int e = r >> 7, q = r & 127, kb = q >> 4, nb = q & 15; const float* W = (e < NEXP) ? FIN_w_egu + (size_t)e * DM * 512 : FIN_w_sgu; \
            t.N = 512; t.K = DM; t.k0 = kb * 128; t.f16 = MOEF16; t.f8 = MOE_FP8; t.ws = WGU_SCALE; t.dst = MOE_FP8 ? (u16*)(F.ws + WS_BGU + (size_t)e * 512 * DM) : WSP(u16, WS_BGU) + (size_t)e * 512 * DM; t.src = W + (size_t)(kb * 128) * 512 + 32 * nb; t.rel_c0 = 32 * nb; t.mode = 2; t.dst_off = 0; break; } \
        r -= I_GU; \
        { const int e = r >> 6, q = r & 63, kb = q >> 5, nb = q & 31; const float* W = (e < NEXP) ? FIN_w_ed + (size_t)e * EFF * DM : FIN_w_sd; \
            t.N = DM; t.K = EFF; t.k0 = kb * 128; t.f16 = MOEF16; t.f8 = MOE_FP8; t.ws = WD_SCALE; t.dst = MOE_FP8 ? (u16*)(F.ws + WS_BD + (size_t)e * DM * EFF) : WSP(u16, WS_BD) + (size_t)e * DM * EFF; t.src = W + (size_t)(kb * 128) * DM + 32 * nb; t.rel_c0 = 32 * nb; t.mode = 0; t.dst_off = 0; } \
    } while (0)
__device__ __forceinline__ void transpose_range(Frame& F, int first, int count, int w, int nw) {
    LAS float* scr = (LAS float*)(F.lds + F.wave * P1_SCR); const int lane = F.lane; const int end = first + count;
    float bufA[64], bufB[64]; TItem ta, tb; int it = first + w;
    if (it < end) { TDECODE(it, ta); titem_load(ta, bufA, lane); }
    while (it < end) {
        const int itb = it + nw; const bool hb = itb < end;
        if (hb) { TDECODE(itb, tb); titem_load(tb, bufB, lane); }
        titem_finish(ta, bufA, scr, lane);
        if (!hb) break;
        const int ita = itb + nw; const bool ha = ita < end;
        if (ha) { TDECODE(ita, ta); titem_load(ta, bufA, lane); }
        titem_finish(tb, bufB, scr, lane);
        it = ita;
    }
}
__device__ __forceinline__ void p1_phase(Frame& F) {
    LAS float* scr = (LAS float*)(F.lds + F.wave * P1_SCR);
    const int gw = F.vcu * 8 + F.wave, NGW = F.G * 8, lane = F.lane;
    u16* BIN = WSP(u16, WS_BIN);
    for (int r = gw; r < I_FOLD; r += NGW) {
        const int fh = r >> 7, cs = (r >> 6) & 1, kb = (r >> 2) & 15, eq = r & 3; const int k = kb * 64 + lane;
        const GAS float* WCS = (const GAS float*)(F.ws + WS_TAB);
#pragma unroll 4
        for (int i = 0; i < 16; ++i) scr[(4 * i + (lane >> 4)) * 16 + (lane & 15)] = WCS[(fh * 64 + 4 * i + (lane >> 4)) * 128 + cs * 64 + 16 * eq + (lane & 15)];
        float wrow[64];
#pragma unroll
        for (int d4 = 0; d4 < 16; ++d4) { const f32x4 v = *(const f32x4*)(FIN_w_in + (size_t)k * 1536 + fh * 64 + 4 * d4); wrow[4 * d4] = v[0]; wrow[4 * d4 + 1] = v[1]; wrow[4 * d4 + 2] = v[2]; wrow[4 * d4 + 3] = v[3]; }
        LDS_WAIT(); asm volatile("" ::: "memory");
        for (int e1 = 0; e1 < 16; ++e1) { float a = 0.f;
#pragma unroll
            for (int d = 0; d < 64; ++d) a += wrow[d] * scr[d * 16 + e1];
            const int col256 = fh * 64 + 16 * eq + e1, pos = 8 * (col256 >> 2) + (col256 & 3) + 4 * cs;
            BIN[(size_t)pos * DM + k] = (u16)f2bf(a); }
        LDS_WAIT(); asm volatile("" ::: "memory");
    }
    const int ndefer = (F.G == 256) ? DEFER_A + DEFER_B : 0;
    REPS(11) transpose_range(F, 0, NT_ITEMS - ndefer, gw, NGW);
    const gi64* MOD = (const gi64*)(F.ctl + CW_MOD);
    u16* XN = WSP(u16, WS_XN);
    REPS(12) { const int wpb = NGW >> 2, b = gw / wpb, wi = gw % wpb;
        rownorm_rows<false>((const GAS float*)FIN_x, FIN_norm1_g, MOD + b * 6144, MOD + b * 6144 + 1024, XN, b * SEQ, SEQ, wi, wpb, lane);
        rownorm_rows<false>((const GAS float*)FIN_ctx, FIN_norm1_g, MOD + 4 * 6144, MOD + 4 * 6144 + 1024, XN + (size_t)NTOK * DM, 0, NCTX, gw, NGW, lane); }
}

__device__ __forceinline__ void fourier_unit(Frame& F, int b, int g) {
    LAS unsigned char* Zl = F.lds + RING_OFF;
    LAS f32x2* TW128 = (LAS f32x2*)(F.lds + TAB_OFF);
    LAS f32x2* TW64 = (LAS f32x2*)(F.lds + TAB_OFF + 1024);
    const int tid = F.tid;
    const GAS u32x4* Zg = (const GAS u32x4*)(F.ws + WS_Z + ((size_t)(b * 64 + g) * SEQ) * 16);
#pragma unroll 4
    for (int i = 0; i < 16; ++i) *(LAS u32x4*)(Zl + (size_t)(i * 512 + tid) * 16) = Zg[i * 512 + tid];
    if (tid < 128) { float s, c; sincospif((float)tid * (1.0f / 64.0f), &s, &c); TW128[tid] = (f32x2){c, s}; }
    else if (tid < 192) { float s, c; sincospif((float)(tid - 128) * (1.0f / 32.0f), &s, &c); TW64[tid - 128] = (f32x2){c, s}; }
    __syncthreads();
    const int k1 = tid & 127, q = tid >> 7;
    float yr[16][4], yi[16][4];
#pragma unroll
    for (int a = 0; a < 16; ++a)
#pragma unroll
        for (int e = 0; e < 4; ++e) { yr[a][e] = 0.f; yi[a][e] = 0.f; }
    for (int n1 = 0; n1 < 128; ++n1) {
        const f32x2 tw = TW128[(n1 * k1) & 127]; const float c = tw.x, s = tw.y;
#pragma unroll
        for (int a = 0; a < 16; ++a) { const u32x4 rw = *(const LAS u32x4*)(Zl + (size_t)(64 * n1 + 16 * q + a) * 16);
            const float uc[4] = {bflo(rw.x), bfhi(rw.x), bflo(rw.y), bfhi(rw.y)}, us[4] = {bflo(rw.z), bfhi(rw.z), bflo(rw.w), bfhi(rw.w)};
#pragma unroll
            for (int e = 0; e < 4; ++e) { yr[a][e] += uc[e] * c - us[e] * s; yi[a][e] -= uc[e] * s + us[e] * c; } }
    }
    __syncthreads();
    int k1b = k1; asm volatile("" : "+v"(k1b));
#pragma unroll
    for (int a = 0; a < 16; ++a) { const int n2 = 16 * q + a; const float fr_ = (float)(n2 * k1b) * (1.0f / 8192.0f);
        const float cp = __builtin_amdgcn_cosf(fr_), sp = __builtin_amdgcn_sinf(fr_);
        float pr[4], pi[4];
#pragma unroll
        for (int e = 0; e < 4; ++e) { pr[e] = yr[a][e] * cp + yi[a][e] * sp; pi[e] = yi[a][e] * cp - yr[a][e] * sp; }
        u32x4 w; w.x = pk2bf(pr[0], pr[1]); w.y = pk2bf(pr[2], pr[3]); w.z = pk2bf(pi[0], pi[1]); w.w = pk2bf(pi[2], pi[3]);
        *(LAS u32x4*)(Zl + (size_t)(n2 * 128 + k1b) * 16) = w; }
    __syncthreads();
    int k1c = k1; asm volatile("" : "+v"(k1c));
    float o[16][4];
#pragma unroll
    for (int a = 0; a < 16; ++a)
#pragma unroll
        for (int e = 0; e < 4; ++e) o[a][e] = 0.f;
    for (int n2 = 0; n2 < 64; ++n2) {
        const u32x4 rw = *(const LAS u32x4*)(Zl + (size_t)(n2 * 128 + k1c) * 16);
        const float pr[4] = {bflo(rw.x), bfhi(rw.x), bflo(rw.y), bfhi(rw.y)}, pi[4] = {bflo(rw.z), bfhi(rw.z), bflo(rw.w), bfhi(rw.w)};
#pragma unroll
        for (int a = 0; a < 16; ++a) { const f32x2 tw = TW64[(n2 * (16 * q + a)) & 63];
#pragma unroll
            for (int e = 0; e < 4; ++e) o[a][e] += pr[e] * tw.x + pi[e] * tw.y; }
    }
    u16* MIX = WSP(u16, WS_MIX);
#pragma unroll
    for (int a = 0; a < 16; ++a) { const int k2 = 16 * q + a; u32x2 w; w.x = pk2bf(o[a][0], o[a][1]); w.y = pk2bf(o[a][2], o[a][3]);
        *(GAS u32x2*)(MIX + ((size_t)(b * SEQ + k1c + 128 * k2)) * DM + 4 * g) = w; }
    __syncthreads();
}

__device__ __forceinline__ attn_body::s16x4 ftr(const LAS unsigned char* p) { return __builtin_bit_cast(attn_body::s16x4, __builtin_amdgcn_ds_read_tr16_b64_v4i16((LAS attn_body::v4i16_t*)p)); }
__device__ __forceinline__ void fourier_unit_mfma(Frame& F, int b, int g) {
    LAS unsigned char* Zl = F.lds + RING_OFF;
    const int tid = F.tid, lane = F.lane, w = F.wave;
    const char* Zg = (const char*)(F.ws + WS_Z) + ((size_t)(b * 64 + g) * SEQ) * 16;
#pragma unroll
    for (int i = 0; i < 16; ++i) __builtin_amdgcn_global_load_lds((const unsigned*)(Zg + (size_t)(i * 512 + tid) * 16), (LAS unsigned*)(Zl + (size_t)(i * 512 + w * 64) * 16), 16, 0, 0);
    VM_WAIT(); __syncthreads();
    f32x4 acc[2][16];
#pragma unroll
    for (int ro = 0; ro < 2; ++ro)
#pragma unroll
        for (int t = 0; t < 16; ++t) acc[ro][t] = (f32x4){0.f, 0.f, 0.f, 0.f};
    const GAS bf16x8* D1 = (const GAS bf16x8*)(F.ws + WS_TAB + 144 * 1024);
    const GAS bf16x8* D3 = (const GAS bf16x8*)(F.ws + WS_TAB + 272 * 1024);
    const int l15 = lane & 15, lq = lane >> 4;
    const unsigned bbase = (unsigned)((64 * (8 * lq + (l15 >> 2)) + (lane & 3)) * 16);
#pragma unroll 1
    for (int s1 = 0; s1 < 8; ++s1) {
        const int ri = s1 >> 2;
        const bf16x8 a0 = D1[(16 * w + l15) * 32 + 4 * s1 + lq], a1 = D1[(128 + 16 * w + l15) * 32 + 4 * s1 + lq];
        const LAS unsigned char* sb = Zl + bbase + (unsigned)((s1 & 3) * 32768 + 8 * ri);
#pragma unroll
        for (int t = 0; t < 16; ++t) { const attn_body::s16x4 lo = ftr(sb + 64 * t), hi = ftr(sb + 64 * t + 4096);
            const bf16x8 bf = (bf16x8){lo[0], lo[1], lo[2], lo[3], hi[0], hi[1], hi[2], hi[3]};
            acc[0][t] = __builtin_amdgcn_mfma_f32_16x16x32_bf16(a0, bf, acc[0][t], 0, 0, 0);
            acc[1][t] = __builtin_amdgcn_mfma_f32_16x16x32_bf16(a1, bf, acc[1][t], 0, 0, 0); }
    }
    __syncthreads();
    {   const int e = lane & 3; int k1b = 16 * w + 4 * lq; asm volatile("" : "+v"(k1b));
#pragma unroll
        for (int t = 0; t < 16; ++t) { const int n2 = 4 * t + (l15 >> 2);
#pragma unroll
            for (int r = 0; r < 4; ++r) { const int k1 = k1b + r; const float fr_ = (float)(n2 * k1) * (1.0f / 8192.0f); const float cp = __builtin_amdgcn_cosf(fr_), sp = __builtin_amdgcn_sinf(fr_);
                const float yr = acc[0][t][r], yi = acc[1][t][r]; const float pr = yr * cp + yi * sp, pi = yi * cp - yr * sp;
                *(LAS u16*)(Zl + (unsigned)(((n2) * 512 + k1 * 4 + e) * 2)) = (u16)f2bf(pr);
                *(LAS u16*)(Zl + (unsigned)(((64 + n2) * 512 + k1 * 4 + e) * 2)) = (u16)f2bf(pi); } }
    }
    asm volatile("s_waitcnt lgkmcnt(0)" ::: "memory");
    f32x4 acc3[4][4];
#pragma unroll
    for (int mt = 0; mt < 4; ++mt)
#pragma unroll
        for (int j = 0; j < 4; ++j) acc3[mt][j] = (f32x4){0.f, 0.f, 0.f, 0.f};
#pragma unroll
    for (int s3 = 0; s3 < 4; ++s3) {
        bf16x8 a[4];
#pragma unroll
        for (int mt = 0; mt < 4; ++mt) a[mt] = D3[(16 * mt + l15) * 16 + 4 * s3 + lq];
        const unsigned kk = (unsigned)(32 * s3 + 8 * lq + (l15 >> 2));
#pragma unroll
        for (int j = 0; j < 4; ++j) { const unsigned ad = kk * 1024u + (unsigned)((4 * (4 * w + j) + (lane & 3)) * 8);
            const attn_body::s16x4 lo = ftr(Zl + ad), hi = ftr(Zl + ad + 4096);
            const bf16x8 bf = (bf16x8){lo[0], lo[1], lo[2], lo[3], hi[0], hi[1], hi[2], hi[3]};
#pragma unroll
            for (int mt = 0; mt < 4; ++mt) acc3[mt][j] = __builtin_amdgcn_mfma_f32_16x16x32_bf16(a[mt], bf, acc3[mt][j], 0, 0, 0); }
    }
    u16* MIX = WSP(u16, WS_MIX);
#pragma unroll
    for (int mt = 0; mt < 4; ++mt)
#pragma unroll
        for (int j = 0; j < 4; ++j)
#pragma unroll
            for (int r = 0; r < 4; ++r) { const int k2 = 16 * mt + 4 * lq + r, k1 = 16 * w + 4 * j + (l15 >> 2);
                MIX[((size_t)(b * SEQ + k1 + 128 * k2)) * DM + 4 * g + (lane & 3)] = (u16)f2bf(acc3[mt][j][r]); }
    __syncthreads();
}

__device__ __forceinline__ float dpp_f(float v, int ctrl_sel) {
    const int x = __builtin_bit_cast(int, v); int r;
    if (ctrl_sel == 0) r = __builtin_amdgcn_update_dpp(x, x, 0xB1, 0xF, 0xF, false);
    else if (ctrl_sel == 1) r = __builtin_amdgcn_update_dpp(x, x, 0x4E, 0xF, 0xF, false);
    else if (ctrl_sel == 2) r = __builtin_amdgcn_update_dpp(x, x, 0x141, 0xF, 0xF, false);
    else r = __builtin_amdgcn_update_dpp(x, x, 0x140, 0xF, 0xF, false);
    return __builtin_bit_cast(float, r);
}
__device__ __forceinline__ void route_token(Frame& F, int tok) {
    const int l = F.lane;
    const f32x4 lg = *(const GAS f32x4*)((const GAS float*)(F.ws + WS_LOG) + (size_t)tok * NEXP + 4 * l);
    const f32x4 bs = *(const f32x4*)(FIN_router_bias + 4 * l);
    float s[4], sel[4];
#pragma unroll
    for (int j = 0; j < 4; ++j) { s[j] = 1.0f / (1.0f + expf(-lg[j])); sel[j] = s[j] + bs[j]; }
    float m1 = fmaxf(sel[0], sel[1]), m2 = fminf(sel[0], sel[1]);
#pragma unroll
    for (int j = 2; j < 4; ++j) { const float v = sel[j]; m2 = fmaxf(m2, fminf(m1, v)); m1 = fmaxf(m1, v); }
#pragma unroll
    for (int st = 0; st < 3; ++st) { const float o1 = dpp_f(m1, st), o2 = dpp_f(m2, st); const float n2 = fmaxf(fminf(m1, o1), fmaxf(m2, o2)); m1 = fmaxf(m1, o1); m2 = n2; }
    const float gs = m1 + m2; const int myg = l >> 3; int rank = 0;
#pragma unroll
    for (int g2 = 0; g2 < 8; ++g2) { const float og = rdl(gs, g2 * 8); rank += (og > gs || (og == gs && g2 < myg)) ? 1 : 0; }
    if (rank >= 4) {
#pragma unroll
        for (int j = 0; j < 4; ++j) sel[j] = -INFINITY; }
    int my_e = 0; float my_s = 0.f, sum = 0.f;
#pragma unroll 1
    for (int k = 0; k < TOPK; ++k) {
        const float lb = fmaxf(fmaxf(sel[0], sel[1]), fmaxf(sel[2], sel[3]));
        float r = lb; r = fmaxf(r, dpp_f(r, 0)); r = fmaxf(r, dpp_f(r, 1)); r = fmaxf(r, dpp_f(r, 2)); r = fmaxf(r, dpp_f(r, 3));
        const float wm = fmaxf(fmaxf(rdl(r, 0), rdl(r, 16)), fmaxf(rdl(r, 32), rdl(r, 48)));
        const unsigned long long mask = __ballot(lb == wm);
        const int wl = __builtin_amdgcn_readfirstlane((int)__ffsll((long long)mask) - 1);
        const int jj = (sel[0] == wm) ? 0 : (sel[1] == wm) ? 1 : (sel[2] == wm) ? 2 : 3;
        const float cand = (jj == 0) ? s[0] : (jj == 1) ? s[1] : (jj == 2) ? s[2] : s[3];
        const int jw = __builtin_amdgcn_readlane(jj, wl); const float wsc = rdl(cand, wl);
        if (l == wl) {
#pragma unroll
            for (int j = 0; j < 4; ++j) if (jw == j) sel[j] = -INFINITY; }
        if (l == k) { my_e = 4 * wl + jw; my_s = wsc; }
        sum += wsc;
    }
    GAS u32x2* LIST = (GAS u32x2*)(F.ws + WS_LIST);
    if (l < TOPK) { const float gate = my_s / sum * 2.5f; const unsigned pos = __hip_atomic_fetch_add((unsigned*)(F.ctl + CW_CNT + my_e), 1u, RLX_AGENT);
        LIST[(size_t)my_e * NTOK + pos] = (u32x2){(unsigned)tok | ((unsigned)l << 16), __builtin_bit_cast(unsigned, gate)}; }
    else if (l == TOPK) LIST[(size_t)NEXP * NTOK + tok] = (u32x2){(unsigned)tok | (8u << 16), __builtin_bit_cast(unsigned, 1.0f)};
}

__device__ __forceinline__ void build_tiles(Frame& F) {
    LAS int* TS = (LAS int*)(F.lds + TAB_OFF + 2048); LAS int* CN = (LAS int*)(F.lds + TAB_OFF + 3200);
    if (F.tid < 64) { const int l = F.tid; int c[5], t[5], tot = 0;
#pragma unroll
        for (int j = 0; j < 5; ++j) { const int e = 5 * l + j; c[j] = (e < NEXPS) ? (int)__hip_atomic_load((unsigned*)(F.ctl + CW_CNT + e), RLX_AGENT) : 0; t[j] = (c[j] + 255) >> 8; tot += t[j]; }
        int x = tot;
#pragma unroll
        for (int off = 1; off < 64; off <<= 1) { const int v = __shfl_up(x, off); if (l >= off) x += v; }
        int run = x - tot;
#pragma unroll
        for (int j = 0; j < 5; ++j) { const int e = 5 * l + j; if (e <= NEXPS) { TS[e] = run; if (e < NEXPS) CN[e] = c[j]; } run += t[j]; }
    }
    __syncthreads();
    {
        LAS unsigned short* TEXP = (LAS unsigned short*)(F.lds + TAB_OFF + 4608);
        for (int e = F.tid; e < NEXPS; e += 512) { const int t0 = TS[e], t1 = TS[e + 1]; for (int T = t0; T < t1; ++T) TEXP[T] = (unsigned short)e; }
    }
    __syncthreads();
}

__device__ __forceinline__ void ph2(Frame& F) {
    const gi64* MOD = (const gi64*)(F.ctl + CW_MOD); const int gw = F.vcu * 8 + F.wave, NGW = F.G * 8; (void)MOD; (void)gw; (void)NGW;
        DenseOrder S{7, 128 * 7, 8, F.G, F.vcu, (const char*)(F.ws + WS_BIN), DM, (REP == 22) ? 2 : 1};
        EpiInProj E{WSP(u16, WS_Z), WSP(u16, WS_Q), WSP(u16, WS_K), WSP(u16, WS_V), WSP(float, WS_TAB + 128 * 1024), WSP(float, WS_TAB + 136 * 1024), FIN_q_norm_g, FIN_k_norm_g};
        pg8::gemm_phase<EpiInProj, DenseOrder, 0, true>(F.lds + RING_OFF, (const char*)(F.ws + WS_XN), DM, S, E);
        if (F.G == 256 && F.vcu >= 136) transpose_range(F, NT_ITEMS - DEFER_A - DEFER_B, DEFER_A, (F.vcu - 136) * 8 + F.wave, 120 * 8);
    }
__device__ __forceinline__ void ph4(Frame& F) {
    const gi64* MOD = (const gi64*)(F.ctl + CW_MOD); const int gw = F.vcu * 8 + F.wave, NGW = F.G * 8; (void)MOD; (void)gw; (void)NGW;
        if (DBG & 128) { GAS u32x4* zH = (GAS u32x4*)(F.ws + WS_H2); const size_t nH = (size_t)NTOK * DM * 2 / 16; for (size_t i = (size_t)blockIdx.x * 512 + F.tid; i < nH; i += (size_t)F.G * 512) zH[i] = (u32x4){0u, 0u, 0u, 0u}; }
        DenseOrder S{4, 128 * 4, 0, F.G, F.vcu, (const char*)(F.ws + WS_BOUT), DM, 1};
        EpiResid E{FIN_x, F.out, MOD};
        pg8::gemm_phase<EpiResid, DenseOrder, 0, true>(F.lds + RING_OFF, (const char*)(F.ws + WS_MIX), DM, S, E);
    }
__device__ __forceinline__ void ph5(Frame& F) {
    const gi64* MOD = (const gi64*)(F.ctl + CW_MOD); const int gw = F.vcu * 8 + F.wave, NGW = F.G * 8;
    const int wpb = NGW >> 2, b = gw / wpb, wi = gw % wpb;
    rownorm_rows<(MOE_FP8 ? false : MOEF16), MOE_FP8>((const GAS float*)F.out, FIN_norm2_g, MOD + b * 6144 + 3072, MOD + b * 6144 + 4096, WSP(u16, WS_H2), b * SEQ, SEQ, wi, wpb, F.lane, F.ws + WS_H2F8);
}
__device__ __forceinline__ void ph6(Frame& F) {
    const gi64* MOD = (const gi64*)(F.ctl + CW_MOD); const int gw = F.vcu * 8 + F.wave, NGW = F.G * 8; (void)MOD; (void)gw; (void)NGW;
        DenseOrder S{1, 128, 0, F.G, F.vcu, (const char*)(F.ws + WS_BR), DM, 1};
        EpiLogits E{WSP(float, WS_LOG)};
        pg8::gemm_phase<EpiLogits, DenseOrder, (MOE_FP8 ? 0 : (MOE_F16 ? 1 : 0)), true>(F.lds + RING_OFF, (const char*)(F.ws + WS_H2), DM, S, E);
        if (F.G == 256 && F.vcu >= 128) transpose_range(F, NT_ITEMS - DEFER_B, DEFER_B, (F.vcu - 128) * 8 + F.wave, 128 * 8);
    }
__device__ __forceinline__ void ph8(Frame& F) {
    const gi64* MOD = (const gi64*)(F.ctl + CW_MOD); const int gw = F.vcu * 8 + F.wave, NGW = F.G * 8; (void)MOD; (void)gw; (void)NGW;
        build_tiles(F);
        GroupedOrder<true> S{2, F.G, F.vcu, 512, DM * (MOE_FP8 ? 1 : 2), true, (const char*)(F.ws + WS_BGU), (const LAS int*)(F.lds + TAB_OFF + 2048), (const LAS int*)(F.lds + TAB_OFF + 3200), (const GAS u32x2*)(F.ws + WS_LIST), (REP == 28) ? 2 : 1, __builtin_amdgcn_readfirstlane(((const LAS int*)(F.lds + TAB_OFF + 2048))[257])};
        EpiSwiglu E{WSP(u16, WS_ACT)};
        pg8::gemm_phase<EpiSwiglu, GroupedOrder<true>, MOE_DT, true>(F.lds + RING_OFF, (const char*)(F.ws + (MOE_FP8 ? WS_H2F8 : WS_H2)), DM, S, E, SC_GU);
    }
__device__ __forceinline__ void ph9(Frame& F) {
    const gi64* MOD = (const gi64*)(F.ctl + CW_MOD); const int gw = F.vcu * 8 + F.wave, NGW = F.G * 8; (void)MOD; (void)gw; (void)NGW;
        build_tiles(F);
        GroupedOrder<false> S{4, F.G, F.vcu, DM, EFF * (MOE_FP8 ? 1 : 2), false, (const char*)(F.ws + WS_BD), (const LAS int*)(F.lds + TAB_OFF + 2048), (const LAS int*)(F.lds + TAB_OFF + 3200), (const GAS u32x2*)(F.ws + WS_LIST), (REP == 29) ? 2 : 1, __builtin_amdgcn_readfirstlane(((const LAS int*)(F.lds + TAB_OFF + 2048))[257])};
        EpiDown E{WSP(u16, WS_C), (const GAS u32x2*)(F.ws + WS_LIST), F.ws + WS_DUMP};
        pg8::gemm_phase<EpiDown, GroupedOrder<false>, MOE_DT, true>(F.lds + RING_OFF, (const char*)(F.ws + WS_ACT), EFF, S, E, SC_D);
    }

#if DBG & (1024 | 2048)
__device__ __forceinline__ float f8dec(unsigned w, int k) { return (k == 0) ? __builtin_amdgcn_cvt_f32_fp8((int)w, 0) : (k == 1) ? __builtin_amdgcn_cvt_f32_fp8((int)w, 1) : (k == 2) ? __builtin_amdgcn_cvt_f32_fp8((int)w, 2) : __builtin_amdgcn_cvt_f32_fp8((int)w, 3); }
__device__ __forceinline__ void chk_attn(Frame& F, float negM) {
    const int gw = F.vcu * 8 + F.wave, NGW = F.G * 8, lane = F.lane;
    const GAS u16* Q = (const GAS u16*)(F.ws + WS_Q); const GAS u16* K = (const GAS u16*)(F.ws + WS_K); const GAS u16* V = (const GAS u16*)(F.ws + WS_V); const GAS u16* MIX = (const GAS u16*)(F.ws + WS_MIX);
    const GAS unsigned char* Q8 = (const GAS unsigned char*)(F.ws + WS_Q); const GAS unsigned char* K8 = (const GAS unsigned char*)(F.ws + WS_K); const GAS unsigned char* Vt8 = (const GAS unsigned char*)(F.ws + WS_V);
    float* chk = (float*)(F.ctl + CW_CHK);
    if (ATTN_FP8 && ATTN_W64) negM = -ceilf(fmaxf(-negM - 8.8f, 0.f)); else if (ATTN_FP8) negM = fminf(negM + 8.8f, 0.f);
    for (int i = gw; i < 4096; i += NGW) {
        const int b = i & 3, h = (i >> 2) % 12, q = (int)((((unsigned)i * 2654435761u) >> 19) & 8191u), kvh = h / 3;
        float qv[64], o[64]; float l = 0.f;
        if (ATTN_FP8) {
#pragma unroll
            for (int c = 0; c < 16; ++c) { const unsigned w = *(const GAS unsigned*)(Q8 + ((size_t)(b * SEQ + q)) * QW + h * 64 + 4 * c);
#pragma unroll
                for (int k = 0; k < 4; ++k) qv[4 * c + k] = f8dec(w, k) * (1.0f / Q8_SCALE); }
        } else {
#pragma unroll
        for (int c = 0; c < 8; ++c) { const u32x4 w = *(const GAS u32x4*)(Q + ((size_t)(b * SEQ + q)) * QW + h * 64 + 8 * c);
            qv[8 * c] = bflo(w.x); qv[8 * c + 1] = bfhi(w.x); qv[8 * c + 2] = bflo(w.y); qv[8 * c + 3] = bfhi(w.y); qv[8 * c + 4] = bflo(w.z); qv[8 * c + 5] = bfhi(w.z); qv[8 * c + 6] = bflo(w.w); qv[8 * c + 7] = bfhi(w.w); }
        }
#pragma unroll
        for (int d = 0; d < 64; ++d) o[d] = 0.f;
        for (int t = 0; t < LKV / 64; ++t) { const int j = t * 64 + lane; float dot = 0.f, pp, pq;
            if (ATTN_FP8) { const GAS unsigned char* kr = K8 + ((size_t)(b * LKV + j)) * KVW + kvh * 64;
#pragma unroll
                for (int c = 0; c < 16; ++c) { const unsigned w = *(const GAS unsigned*)(kr + 4 * c);
#pragma unroll
                    for (int k = 0; k < 4; ++k) dot += qv[4 * c + k] * f8dec(w, k); }
                pp = exp2f(dot + negM); pq = __builtin_amdgcn_cvt_f32_fp8(__builtin_amdgcn_cvt_pk_fp8_f32(pp, 0.f, 0, false), 0); l += pq;
                const GAS unsigned char* vb = Vt8 + (((size_t)(b * NKVH + kvh) * (LKV / 64) + t) * 64) * 64 + attn_body::vt_slot(lane);
#pragma unroll
                for (int d = 0; d < 64; ++d) o[d] += pq * __builtin_amdgcn_cvt_f32_fp8((int)vb[d * 64], 0);
            } else { const GAS u16* kr = K + ((size_t)(b * LKV + j)) * KVW + kvh * 64; const GAS u16* vr = V + ((size_t)(b * LKV + j)) * KVW + kvh * 64;
#pragma unroll
            for (int c = 0; c < 8; ++c) { const u32x4 w = *(const GAS u32x4*)(kr + 8 * c);
                dot += qv[8 * c] * bflo(w.x) + qv[8 * c + 1] * bfhi(w.x) + qv[8 * c + 2] * bflo(w.y) + qv[8 * c + 3] * bfhi(w.y) + qv[8 * c + 4] * bflo(w.z) + qv[8 * c + 5] * bfhi(w.z) + qv[8 * c + 6] * bflo(w.w) + qv[8 * c + 7] * bfhi(w.w); }
            pp = exp2f(dot + negM); l += pp;
#pragma unroll
            for (int c = 0; c < 8; ++c) { const u32x4 w = *(const GAS u32x4*)(vr + 8 * c);
                o[8 * c] += pp * bflo(w.x); o[8 * c + 1] += pp * bfhi(w.x); o[8 * c + 2] += pp * bflo(w.y); o[8 * c + 3] += pp * bfhi(w.y); o[8 * c + 4] += pp * bflo(w.z); o[8 * c + 5] += pp * bfhi(w.z); o[8 * c + 6] += pp * bflo(w.w); o[8 * c + 7] += pp * bfhi(w.w); } } }
        l = wave_sum(l); float err = 0.f, ref = 0.f;
#pragma unroll
        for (int d = 0; d < 64; ++d) { const float od = wave_sum(o[d]) / l; const float mv = bflo((unsigned)MIX[((size_t)(b * SEQ + q)) * DM + 256 + h * 64 + d]); err += (od - mv) * (od - mv); ref += od * od; }
        if (lane == 0) { atomicAdd(chk + 0, err); atomicAdd(chk + 1, ref); }
    }
}
__device__ __forceinline__ void chk_qkv(Frame& F) {
    const int gw = F.vcu * 8 + F.wave, NGW = F.G * 8, lane = F.lane;
    const gi64* MOD = (const gi64*)(F.ctl + CW_MOD);
    LAS float* hrow = (LAS float*)(F.lds + RING_OFF + F.wave * 16384);
    float* chk = (float*)(F.ctl + CW_CHK);
    for (int i = gw; i < 4096; i += NGW) {
        const unsigned hs = (unsigned)i * 2654435761u; const bool isctx = (i & 15) == 15; int sel = i % 20; if (isctx && sel < 12) sel = 12 + (sel & 7);
        const int m = isctx ? (int)((hs >> 10) & 1023u) : (int)((hs >> 12) & 32767u);
        const float* src = isctx ? FIN_ctx + (size_t)m * DM : FIN_x + (size_t)m * DM; const int mr = isctx ? 4 : (m >> 13);
        const int b = isctx ? (m >> 8) : (m >> 13), l = isctx ? 0 : (m & 8191), key = isctx ? SEQ + (m & 255) : l;
        f32x4 v[4]; float s2 = 0.f;
#pragma unroll
        for (int j = 0; j < 4; ++j) { v[j] = *(const f32x4*)(src + 4 * lane + 256 * j); s2 += (v[j][0] * v[j][0] + v[j][1] * v[j][1]) + (v[j][2] * v[j][2] + v[j][3] * v[j][3]); }
        const float rstd = 1.0f / sqrtf(wave_sum(s2) * (1.0f / DM) + RMS_EPS);
#pragma unroll
        for (int j = 0; j < 4; ++j) { const int col = 4 * lane + 256 * j; const f32x4 g = *(const f32x4*)(FIN_norm1_g + col); const f32x4 sh = mod4(MOD, mr * 6144 + col), sc = mod4(MOD, mr * 6144 + 1024 + col);
            const f32x4 y = v[j] * rstd * g * (sc + 1.0f) + sh; hrow[col] = y[0]; hrow[col + 1] = y[1]; hrow[col + 2] = y[2]; hrow[col + 3] = y[3]; }
        LDS_WAIT(); asm volatile("" ::: "memory");
        const int colbase = (sel < 12) ? 256 + 64 * sel : (sel < 16 ? 1024 + 64 * (sel - 12) : 1280 + 64 * (sel - 16));
        float z = 0.f;
        for (int k = 0; k < DM; ++k) z += hrow[k] * FIN_w_in[(size_t)k * 1536 + colbase + lane];
        float outv = z; int spos = lane;
        if (sel < 16) { const float ss = wave_sum(z * z); const float gain = (sel < 12) ? FIN_q_norm_g[lane] : FIN_k_norm_g[lane]; const float zz = z * (1.0f / sqrtf(ss * (1.0f / 64.0f) + RMS_EPS)) * gain;
            const float pz = __shfl(zz, lane ^ 16); outv = zz;
            if (!isctx) { const int pidx = (lane & 32) ? (l & 63) : (l >> 6); const float inv = powf(10000.0f, -(float)(lane & 15) / 16.0f), ang = (float)pidx * inv; const float cs = cosf(ang), sn = sinf(ang);
                outv = (lane & 16) ? zz * cs + pz * sn : zz * cs - pz * sn; }
            if (sel < 12) outv *= C2;
            spos = 32 * (lane >> 5) + 8 * ((lane >> 2) & 3) + 4 * ((lane >> 4) & 1) + (lane & 3); }
        float stored;
        if (ATTN_FP8) {
            if (sel < 12) stored = __builtin_amdgcn_cvt_f32_fp8((int)((const GAS unsigned char*)(F.ws + WS_Q))[(size_t)m * QW + sel * 64 + spos], 0) * (1.0f / Q8_SCALE);
            else if (sel < 16) stored = __builtin_amdgcn_cvt_f32_fp8((int)((const GAS unsigned char*)(F.ws + WS_K))[((size_t)(b * LKV + key)) * KVW + (sel - 12) * 64 + spos], 0);
            else stored = __builtin_amdgcn_cvt_f32_fp8((int)((const GAS unsigned char*)(F.ws + WS_V))[((((size_t)(b * NKVH + (sel - 16)) * (LKV / 64) + (key >> 6)) * 64 + lane) * 64) + attn_body::vt_slot(key & 63)], 0);
        } else {
        if (sel < 12) stored = bflo((unsigned)((const GAS u16*)(F.ws + WS_Q))[(size_t)m * QW + sel * 64 + spos]);
        else if (sel < 16) stored = bflo((unsigned)((const GAS u16*)(F.ws + WS_K))[((size_t)(b * LKV + key)) * KVW + (sel - 12) * 64 + spos]);
        else stored = bflo((unsigned)((const GAS u16*)(F.ws + WS_V))[((size_t)(b * LKV + key)) * KVW + (sel - 16) * 64 + lane]); }
        const float err = wave_sum((outv - stored) * (outv - stored)), ref = wave_sum(outv * outv);
        if (lane == 0) { atomicAdd(chk + 2, err); atomicAdd(chk + 3, ref); }
        LDS_WAIT(); asm volatile("" ::: "memory");
    }
}
#endif

struct Args { const float* in[20]; float* out; unsigned char* ws; int ph_lo, ph_hi; };
__global__ void __launch_bounds__(512, 2) mk_fwd(Args args) {
    extern __shared__ __attribute__((aligned(16))) unsigned char lds[];
    Frame F;
    F.lds = (LAS unsigned char*)lds;
    F.MISC = (volatile LAS unsigned*)(F.lds + MISC_OFF);
    F.tid = threadIdx.x; F.lane = F.tid & 63; F.wave = __builtin_amdgcn_readfirstlane(F.tid >> 6);
    F.G = gridDim.x; { const int bx = blockIdx.x; F.vcu = (F.G % 8 == 0) ? (bx % 8) * (F.G / 8) + bx / 8 : bx; }
    F.ws = args.ws; F.ctl = (gu32*)(args.ws + WS_CTL); F.out = args.out;
    F.ka = (const float* const*)__builtin_amdgcn_kernarg_segment_ptr();
    for (int u = F.tid; u < (LDS_BYTES - LDSCTL_OFF) / 4; u += 512) ((LAS unsigned*)(F.lds + LDSCTL_OFF))[u] = 0u;
    if (SYN_ZERO) { for (int u = F.tid; u < 49152 / 4; u += 512) ((LAS unsigned*)F.lds)[u] = 0u; }
    __syncthreads();
#if SYN
    {
        typedef int sv8 __attribute__((ext_vector_type(8))); typedef attn_body::f32x16 f32x16;

        const bool lowh = F.wave < 4;
        sv8 a_ = (sv8){F.tid, 1, 2, 3, 4, 5, 6, 7}, b_ = (sv8){7, 6, 5, 4, 3, 2, 1, F.tid};
        if (SYN_RND) { for (int i = 0; i < 8; ++i) { unsigned ha = (unsigned)(F.tid * 8 + i) * 2654435761u, hb = (unsigned)(F.tid * 8 + i + 4096) * 2246822519u; ha ^= ha >> 15; hb ^= hb >> 13; a_[i] = (int)(ha & 0x7f7f7f7fu & ~0x40404040u); b_[i] = (int)(hb & 0xbfbfbfbfu); } }
        f32x16 m0 = f32x16{}, m1 = f32x16{}, m2 = f32x16{}, m3 = f32x16{}, m4 = f32x16{};
        f32x16 e0, e1; for (int r = 0; r < 16; ++r) { e0[r] = -(float)(F.lane + r); e1[r] = -(float)(F.lane + 2 * r); }
        sv8 pk = (sv8){0, 0, 0, 0, 0, 0, 0, 0};
        const bool doM = lowh ? (SYN & 1) : (SYN & 4), doE = lowh ? (SYN & 8) : (SYN & 2), doI = lowh && (SYN & 16);
#define SYN_M(x) x = __builtin_amdgcn_mfma_scale_f32_32x32x64_f8f6f4(a_, b_, x, 0, 0, 0, 0x7f7f, 1, 0x7f7f)
#define SYN_E(v, r) v[r] = __builtin_amdgcn_exp2f(v[r])
#define SYN_C(k, v, B) pk[k] = __builtin_amdgcn_cvt_pk_fp8_f32(v[B + 2], v[B + 3], __builtin_amdgcn_cvt_pk_fp8_f32(v[B], v[B + 1], pk[k], false), true)
#pragma unroll 1
        for (int it = 0; it < SYN_N; ++it) {
            if (doM) { SYN_M(m0); SYN_M(m1); SYN_M(m2); SYN_M(m3); SYN_M(m4); }
            if (doE) {
                if (SYN_EM & 1) {
#pragma unroll
                for (int r = 0; r < 16; ++r) { SYN_E(e0, r); SYN_E(e1, r); } }
                if (SYN_EM & 4) {
#pragma unroll
                    for (int r = 0; r < 16; ++r) SYN_E(e0, r);
                    __builtin_amdgcn_sched_barrier(0);
                    SYN_E(e1, 0); SYN_E(e1, 1); SYN_E(e1, 2); SYN_E(e1, 3); __builtin_amdgcn_sched_barrier(0); SYN_C(0, e0, 0); __builtin_amdgcn_sched_barrier(0);
                    SYN_E(e1, 4); SYN_E(e1, 5); SYN_E(e1, 6); SYN_E(e1, 7); __builtin_amdgcn_sched_barrier(0); SYN_C(1, e0, 4); __builtin_amdgcn_sched_barrier(0);
                    SYN_E(e1, 8); SYN_E(e1, 9); SYN_E(e1, 10); SYN_E(e1, 11); __builtin_amdgcn_sched_barrier(0); SYN_C(2, e0, 8); __builtin_amdgcn_sched_barrier(0);
                    SYN_E(e1, 12); SYN_E(e1, 13); SYN_E(e1, 14); SYN_E(e1, 15); __builtin_amdgcn_sched_barrier(0); SYN_C(3, e0, 12); __builtin_amdgcn_sched_barrier(0);
                    SYN_C(4, e1, 0); SYN_C(5, e1, 4); SYN_C(6, e1, 8); SYN_C(7, e1, 12); }
                if (SYN_EM & 8) {
#define SYN_Q(k, v, B) SYN_E(v, B); SYN_E(v, B + 1); SYN_E(v, B + 2); SYN_E(v, B + 3); __builtin_amdgcn_sched_barrier(0); if (k > 0) { if (k <= 4) SYN_C(k - 1, e0, 4 * (k - 1)); else SYN_C(k - 1, e1, 4 * (k - 5)); } __builtin_amdgcn_sched_barrier(0)
                    SYN_Q(0, e0, 0); SYN_Q(1, e0, 4); SYN_Q(2, e0, 8); SYN_Q(3, e0, 12); SYN_Q(4, e1, 0); SYN_Q(5, e1, 4); SYN_Q(6, e1, 8); SYN_Q(7, e1, 12); SYN_C(7, e1, 12); }
                if (SYN_EM & 16) {
                    typedef short v2s_ __attribute__((ext_vector_type(2))); float one_ = 1.0f; asm volatile("" : "+v"(one_));
#define SYN_CS(k, v, B) pk[k] = __builtin_bit_cast(int, __builtin_amdgcn_cvt_scalef32_pk_fp8_f32(__builtin_amdgcn_cvt_scalef32_pk_fp8_f32(__builtin_bit_cast(v2s_, pk[k]), v[B], v[B + 1], one_, false), v[B + 2], v[B + 3], one_, true))
                    SYN_CS(0, e0, 0); SYN_CS(1, e0, 4); SYN_CS(2, e0, 8); SYN_CS(3, e0, 12); SYN_CS(4, e1, 0); SYN_CS(5, e1, 4); SYN_CS(6, e1, 8); SYN_CS(7, e1, 12); }
                if (SYN_EM & 32) {
                    pk[0] = (int)attn_body::cvtpk_s(e0[0], e0[1]); pk[1] = (int)attn_body::cvtpk_s(e0[2], e0[3]); pk[2] = (int)attn_body::cvtpk_s(e0[4], e0[5]); pk[3] = (int)attn_body::cvtpk_s(e0[6], e0[7]);
                    pk[4] = (int)attn_body::cvtpk_s(e0[8], e0[9]); pk[5] = (int)attn_body::cvtpk_s(e0[10], e0[11]); pk[6] = (int)attn_body::cvtpk_s(e0[12], e0[13]); pk[7] = (int)attn_body::cvtpk_s(e0[14], e0[15]);
                    asm volatile("" : "+v"(pk));
                    pk[0] = (int)attn_body::cvtpk_s(e1[0], e1[1]); pk[1] = (int)attn_body::cvtpk_s(e1[2], e1[3]); pk[2] = (int)attn_body::cvtpk_s(e1[4], e1[5]); pk[3] = (int)attn_body::cvtpk_s(e1[6], e1[7]);
                    pk[4] = (int)attn_body::cvtpk_s(e1[8], e1[9]); pk[5] = (int)attn_body::cvtpk_s(e1[10], e1[11]); pk[6] = (int)attn_body::cvtpk_s(e1[12], e1[13]); pk[7] = (int)attn_body::cvtpk_s(e1[14], e1[15]); }
                if (SYN_EM & 2) { SYN_C(0, e0, 0); SYN_C(1, e0, 4); SYN_C(2, e0, 8); SYN_C(3, e0, 12); SYN_C(4, e1, 0); SYN_C(5, e1, 4); SYN_C(6, e1, 8); SYN_C(7, e1, 12); }
                asm volatile("" : "+v"(e0), "+v"(e1), "+v"(pk)); }
            if (doI) {
                __builtin_amdgcn_sched_barrier(0);
                SYN_M(m0); __builtin_amdgcn_sched_barrier(0); SYN_E(e0, 0); SYN_E(e0, 1); SYN_E(e0, 2); SYN_E(e0, 3); SYN_E(e0, 4); SYN_E(e0, 5); SYN_E(e0, 6); __builtin_amdgcn_sched_barrier(0);
                SYN_M(m1); __builtin_amdgcn_sched_barrier(0); SYN_E(e0, 7); SYN_E(e0, 8); SYN_E(e0, 9); SYN_E(e0, 10); SYN_E(e0, 11); SYN_E(e0, 12); SYN_E(e0, 13); __builtin_amdgcn_sched_barrier(0);
                SYN_M(m2); __builtin_amdgcn_sched_barrier(0); SYN_E(e0, 14); SYN_E(e0, 15); SYN_E(e1, 0); SYN_E(e1, 1); SYN_E(e1, 2); SYN_E(e1, 3); SYN_E(e1, 4); __builtin_amdgcn_sched_barrier(0);
                SYN_M(m3); __builtin_amdgcn_sched_barrier(0); SYN_E(e1, 5); SYN_E(e1, 6); SYN_E(e1, 7); SYN_E(e1, 8); SYN_E(e1, 9); SYN_E(e1, 10); SYN_E(e1, 11); __builtin_amdgcn_sched_barrier(0);
                SYN_M(m4); __builtin_amdgcn_sched_barrier(0); SYN_E(e1, 12); SYN_E(e1, 13); SYN_E(e1, 14); SYN_E(e1, 15);
                SYN_C(0, e0, 0); SYN_C(1, e0, 4); SYN_C(2, e0, 8); SYN_C(3, e0, 12); SYN_C(4, e1, 0); SYN_C(5, e1, 4); SYN_C(6, e1, 8); SYN_C(7, e1, 12);
                asm volatile("" : "+v"(e0), "+v"(e1), "+v"(pk)); __builtin_amdgcn_sched_barrier(0); }
        }
        if (SYN & (32 | 64 | 128 | 1024)) {
            f32x16 ng; for (int r = 0; r < 16; ++r) ng[r] = -1.0f - (float)r; asm volatile("" : "+v"(ng));
#define SYN_EB() do { _Pragma("unroll") for (int r = 0; r < 16; ++r) { SYN_E(e0, r); SYN_E(e1, r); } \
                SYN_C(0, e0, 0); SYN_C(1, e0, 4); SYN_C(2, e0, 8); SYN_C(3, e0, 12); SYN_C(4, e1, 0); SYN_C(5, e1, 4); SYN_C(6, e1, 8); SYN_C(7, e1, 12); } while (0)
#define SYN_MB() do { e0 = __builtin_amdgcn_mfma_scale_f32_32x32x64_f8f6f4(a_, b_, ng, 0, 0, 0, 0x7f7f, 1, 0x7f7f); e1 = __builtin_amdgcn_mfma_scale_f32_32x32x64_f8f6f4(b_, a_, ng, 0, 0, 0, 0x7f7f, 1, 0x7f7f); \
                m0 = __builtin_amdgcn_mfma_scale_f32_32x32x64_f8f6f4(pk, a_, m0, 0, 0, 0, 0x7f7f, 1, 0x7f7f); m1 = __builtin_amdgcn_mfma_scale_f32_32x32x64_f8f6f4(pk, b_, m1, 0, 0, 0, 0x7f7f, 1, 0x7f7f); \
                m2 = __builtin_amdgcn_mfma_scale_f32_32x32x64_f8f6f4(pk, a_, m2, 0, 0, 0, 0x7f7f, 1, 0x7f7f); } while (0)
#define SYN_WB() do { if (SYN & (512 | 1024)) asm volatile("s_waitcnt vmcnt(1) lgkmcnt(0)\n\ts_barrier" ::: "memory"); else asm volatile("s_waitcnt lgkmcnt(0)\n\ts_barrier" ::: "memory"); } while (0)
            const bool lt = !lowh && (SYN & (64 | 128 | 1024));
            if ((SYN & (256 | 512)) && !(SYN & 1024)) {
                const attn_body::lds_cptr sp = (attn_body::lds_cptr)F.lds; const int r32_ = F.lane & 31, hi_ = F.lane >> 5, sw_ = (r32_ >> 2) & 3, c0o_ = ((2 * hi_) ^ sw_) * 16, c1o_ = ((2 * hi_ + 1) ^ sw_) * 16;
                const attn_body::lds_cptr kp_ = sp + r32_ * 64, vp_ = sp + 24576 + r32_ * 64;
                sv8 kfa = a_, kfb = b_, vfa = a_, vfb = b_;
                const unsigned char* gsrc = (const unsigned char*)(F.ws + WS_K) + (size_t)blockIdx.x * 524288 + F.tid * 16;
                const unsigned dsto = (unsigned)(uintptr_t)F.lds + (F.wave & 3) * 1024 + (lowh ? 0 : 24576);
                int so = 0, sd = 4 * 4096;
                sv8 vga = a_, vgb = b_;
#define SYN_MB2(IT) do { if ((SYN & 256) && SYN_RD == 0) { vfa = attn_body::ld32(vp_ + so, c0o_, c1o_); vfb = attn_body::ld32(vp_ + so + 2048, c0o_, c1o_); } \
                if (SYN_RD == 1) { vfa = vga; vfb = vgb; } \
                if (SYN_RD == 2) { e0 = __builtin_amdgcn_mfma_scale_f32_32x32x64_f8f6f4(a_, b_, ng, 0, 0, 0, 0x7f7f, 1, 0x7f7f); e1 = __builtin_amdgcn_mfma_scale_f32_32x32x64_f8f6f4(b_, a_, ng, 0, 0, 0, 0x7f7f, 1, 0x7f7f); \
                m0 = __builtin_amdgcn_mfma_scale_f32_32x32x64_f8f6f4(pk, a_, m0, 0, 0, 0, 0x7f7f, 1, 0x7f7f); m1 = __builtin_amdgcn_mfma_scale_f32_32x32x64_f8f6f4(pk, b_, m1, 0, 0, 0, 0x7f7f, 1, 0x7f7f); } else { \
                e0 = __builtin_amdgcn_mfma_scale_f32_32x32x64_f8f6f4(kfa, b_, ng, 0, 0, 0, 0x7f7f, 1, 0x7f7f); e1 = __builtin_amdgcn_mfma_scale_f32_32x32x64_f8f6f4(kfb, b_, ng, 0, 0, 0, 0x7f7f, 1, 0x7f7f); \
                m0 = __builtin_amdgcn_mfma_scale_f32_32x32x64_f8f6f4(pk, vfa, m0, 0, 0, 0, 0x7f7f, 1, 0x7f7f); m1 = __builtin_amdgcn_mfma_scale_f32_32x32x64_f8f6f4(pk, vfb, m1, 0, 0, 0, 0x7f7f, 1, 0x7f7f); } \
                m2 = __builtin_amdgcn_mfma_scale_f32_32x32x64_f8f6f4(pk, a_, m2, 0, 0, 0, 0x7f7f, 1, 0x7f7f); \
                if (SYN & 512) attn_body::glds16(gsrc + (size_t)((IT) & 127) * 4096, (unsigned)__builtin_amdgcn_readfirstlane(dsto + sd)); \
                so = (so == 5 * 4096) ? 0 : so + 4096; sd = (sd == 5 * 4096) ? 0 : sd + 4096; \
                if (SYN & 256) { kfa = attn_body::ld32(kp_ + so, c0o_, c1o_); kfb = attn_body::ld32(kp_ + so + 2048, c0o_, c1o_); \
                    if (SYN_RD >= 1) { vga = attn_body::ld32(vp_ + so, c0o_, c1o_); vgb = attn_body::ld32(vp_ + so + 2048, c0o_, c1o_); } \
                    if (SYN_RD == 2) asm volatile("" :: "v"(kfa), "v"(kfb), "v"(vga), "v"(vgb)); } } while (0)
#pragma unroll 1
                for (int it = 0; it < SYN_N / 2; ++it) {
                    __builtin_amdgcn_sched_barrier(0); SYN_MB2(2 * it); __builtin_amdgcn_sched_barrier(0); SYN_EB(); __builtin_amdgcn_sched_barrier(0); SYN_MB2(2 * it + 1); __builtin_amdgcn_sched_barrier(0);
                    if (lt) SYN_WB();
                    __builtin_amdgcn_sched_barrier(0); SYN_EB(); __builtin_amdgcn_sched_barrier(0);
                    if (!lt) SYN_WB(); }
                asm volatile("s_waitcnt vmcnt(0)" ::: "memory");
                asm volatile("" :: "v"(kfa), "v"(kfb), "v"(vfa), "v"(vfb), "v"(vga), "v"(vgb));
            } else if (SYN & 1024) {
                const attn_body::lds_cptr sp = (attn_body::lds_cptr)F.lds; const int r32_ = F.lane & 31, hi_ = F.lane >> 5, sw_ = (r32_ >> 2) & 3, c0o_ = ((2 * hi_) ^ sw_) * 16, c1o_ = ((2 * hi_ + 1) ^ sw_) * 16;
                const attn_body::lds_cptr kp_ = sp + r32_ * 64, vp_ = sp + 24576 + r32_ * 64;
                sv8 kfa = a_, kfb = a_, vfa = a_, vfb = a_, pk2 = pk; f32x16 m5 = f32x16{};
                const unsigned char* gsrc = (const unsigned char*)(F.ws + WS_K) + (size_t)blockIdx.x * 524288 + F.tid * 16;
                const unsigned dsto = (unsigned)(uintptr_t)F.lds + (F.wave & 3) * 1024 + (lowh ? 0 : 24576);
                int so = 0, sd = 4 * 4096;
#define SYN_X(acc, A, B) acc = __builtin_amdgcn_mfma_scale_f32_32x32x64_f8f6f4(A, B, acc, 0, 0, 0, 0x7f7f, 1, 0x7f7f)
#define SYN_EB2(PK) do { _Pragma("unroll") for (int r = 0; r < 16; ++r) { SYN_E(e0, r); SYN_E(e1, r); } \
                PK[0] = __builtin_amdgcn_cvt_pk_fp8_f32(e0[2], e0[3], __builtin_amdgcn_cvt_pk_fp8_f32(e0[0], e0[1], PK[0], false), true); PK[1] = __builtin_amdgcn_cvt_pk_fp8_f32(e0[6], e0[7], __builtin_amdgcn_cvt_pk_fp8_f32(e0[4], e0[5], PK[1], false), true); \
                PK[2] = __builtin_amdgcn_cvt_pk_fp8_f32(e0[10], e0[11], __builtin_amdgcn_cvt_pk_fp8_f32(e0[8], e0[9], PK[2], false), true); PK[3] = __builtin_amdgcn_cvt_pk_fp8_f32(e0[14], e0[15], __builtin_amdgcn_cvt_pk_fp8_f32(e0[12], e0[13], PK[3], false), true); \
                PK[4] = __builtin_amdgcn_cvt_pk_fp8_f32(e1[2], e1[3], __builtin_amdgcn_cvt_pk_fp8_f32(e1[0], e1[1], PK[4], false), true); PK[5] = __builtin_amdgcn_cvt_pk_fp8_f32(e1[6], e1[7], __builtin_amdgcn_cvt_pk_fp8_f32(e1[4], e1[5], PK[5], false), true); \
                PK[6] = __builtin_amdgcn_cvt_pk_fp8_f32(e1[10], e1[11], __builtin_amdgcn_cvt_pk_fp8_f32(e1[8], e1[9], PK[6], false), true); PK[7] = __builtin_amdgcn_cvt_pk_fp8_f32(e1[14], e1[15], __builtin_amdgcn_cvt_pk_fp8_f32(e1[12], e1[13], PK[7], false), true); } while (0)
#define SYN_S64(IT, MID) do { __builtin_amdgcn_sched_barrier(0); \
                vfa = attn_body::ld32(vp_ + so, c0o_, c1o_); vfb = attn_body::ld32(vp_ + so + 2048, c0o_, c1o_); \
                e0 = __builtin_amdgcn_mfma_scale_f32_32x32x64_f8f6f4(kfa, a_, f32x16{}, 0, 0, 0, 0x7f7f, 1, 0x7f7f); e1 = __builtin_amdgcn_mfma_scale_f32_32x32x64_f8f6f4(kfb, a_, f32x16{}, 0, 0, 0, 0x7f7f, 1, 0x7f7f); \
                SYN_X(m0, pk, vfa); SYN_X(m1, pk, vfb); SYN_X(m2, pk, a_); SYN_X(m3, pk2, vfa); SYN_X(m4, pk2, vfb); SYN_X(m5, pk2, a_); \
                attn_body::glds16(gsrc + (size_t)((IT) & 127) * 4096, (unsigned)__builtin_amdgcn_readfirstlane(dsto + sd)); \
                so = (so == 5 * 4096) ? 0 : so + 4096; sd = (sd == 5 * 4096) ? 0 : sd + 4096; \
                if (SYN_ILV == 0) __builtin_amdgcn_sched_barrier(0); \
                SYN_EB2(pk); __builtin_amdgcn_sched_barrier(0); \
                e0 = __builtin_amdgcn_mfma_scale_f32_32x32x64_f8f6f4(kfa, a_, f32x16{}, 0, 0, 0, 0x7f7f, 1, 0x7f7f); e1 = __builtin_amdgcn_mfma_scale_f32_32x32x64_f8f6f4(kfb, a_, f32x16{}, 0, 0, 0, 0x7f7f, 1, 0x7f7f); \
                kfa = attn_body::ld32(kp_ + so, c0o_, c1o_); kfb = attn_body::ld32(kp_ + so + 2048, c0o_, c1o_); \
                __builtin_amdgcn_sched_barrier(0); MID; __builtin_amdgcn_sched_barrier(0); \
                SYN_EB2(pk2); } while (0)
#pragma unroll 1
                for (int it = 0; it < SYN_N / 4; ++it) {
                    SYN_S64(2 * it, (void)0); SYN_S64(2 * it + 1, if (lt) SYN_WB());
                    if (!lt) SYN_WB(); }
                asm volatile("s_waitcnt vmcnt(0)" ::: "memory");
                asm volatile("" :: "v"(kfa), "v"(kfb), "v"(vfa), "v"(vfb), "v"(pk2), "v"(m5));
            } else if (SYN & 128) {
#pragma unroll 1
                for (int it = 0; it < SYN_N / 2; ++it) {
                    __builtin_amdgcn_sched_barrier(0); SYN_MB(); __builtin_amdgcn_sched_barrier(0); SYN_EB(); __builtin_amdgcn_sched_barrier(0); SYN_MB(); __builtin_amdgcn_sched_barrier(0);
                    if (lt) asm volatile("s_barrier" ::: "memory");
                    __builtin_amdgcn_sched_barrier(0); SYN_EB(); __builtin_amdgcn_sched_barrier(0);
                    if (!lt) asm volatile("s_barrier" ::: "memory"); }
            } else {
                if (lt) { SYN_EB(); }
#pragma unroll 1
                for (int it = 0; it < SYN_N; ++it) { __builtin_amdgcn_sched_barrier(0); SYN_MB(); __builtin_amdgcn_sched_barrier(0); SYN_EB(); }
            }
        }
        asm volatile("" :: "v"(m0), "v"(m1), "v"(m2), "v"(m3), "v"(m4), "v"(e0), "v"(e1), "v"(pk));
        __syncthreads();
    }
#endif
    XcdBarrier bar; bar.bar = (unsigned*)(F.ctl + CW_BAR); bar.x = 0; bar.st = nullptr;
    if (N_LAUNCHES == 1) bar = xcd_barrier_post((unsigned*)(F.ctl + CW_BAR), F.MISC + 8);
    const int lo = args.ph_lo, hi = args.ph_hi;
#define IN(k) (lo <= (k) && (k) < hi)
#define SEAM(k) do { if (IN(k) && IN((k) + 1)) xcd_barrier(bar); asm volatile("" : "+s"(F.ka)); } while (0)
    const gi64* MOD = (const gi64*)(F.ctl + CW_MOD);
    const int gw = F.vcu * 8 + F.wave, NGW = F.G * 8;

    if (IN(0)) { p0_phase(F); } SEAM(0);
    if (IN(1)) { p1_phase(F); VM_WAIT(); __syncthreads(); if (REP == 1) { xcd_barrier(bar); p1_phase(F); VM_WAIT(); __syncthreads(); } } SEAM(1);

    if (IN(2)) { ph2(F); if (REP == 2) { xcd_barrier(bar); ph2(F); } } SEAM(2);

    if (IN(3)) {
        if (DBG & 32) { u16* MIXz = WSP(u16, WS_MIX); for (int m = gw; m < NTOK; m += NGW) *(GAS u32x2*)(MIXz + (size_t)m * DM + 4 * F.lane) = (u32x2){0u, 0u}; }
        else
        REPS(30) for (int U = F.vcu; U < NB * 64; U += F.G) { if (FOURIER_MFMA) fourier_unit_mfma(F, U >> 6, U & 63); else fourier_unit(F, U >> 6, U & 63); }
        const attn_body::bf16* Qp = (const attn_body::bf16*)(F.ws + WS_Q); const attn_body::bf16* Kp = (const attn_body::bf16*)(F.ws + WS_K); const attn_body::bf16* Vp = (const attn_body::bf16*)(F.ws + WS_V);
        attn_body::bf16* Op = (attn_body::bf16*)(F.ws + WS_MIX) + 256;
        float negM; { float gqm = fabsf(FIN_q_norm_g[F.lane]), gkm = fabsf(FIN_k_norm_g[F.lane]);
#pragma unroll
            for (int o_ = 1; o_ < 64; o_ <<= 1) { gqm = fmaxf(gqm, __shfl_xor(gqm, o_)); gkm = fmaxf(gkm, __shfl_xor(gkm, o_)); }
            negM = -(C2 * 64.0f * gqm * gkm + 0.5f); }
        if (ATTN_FP8 && ATTN_W64) negM = -ceilf(fmaxf(-negM - 8.8f, 0.f));
        else if (ATTN_FP8) negM = fminf(negM + 8.8f, 0.f);
        if (ATTN_PRIO) { if (__builtin_amdgcn_readfirstlane(F.tid) >= 256) __builtin_amdgcn_s_setprio(1); }
        if (DBG & 16) { u16* MIXz = WSP(u16, WS_MIX); for (int m = gw; m < NTOK; m += NGW) for (int j = 1; j < 4; ++j) *(GAS u32x2*)(MIXz + (size_t)m * DM + 256 * j + 4 * F.lane) = (u32x2){0u, 0u}; }
        else if (ATTN_FP8 && ATTN_W64) REPS(31) {
            for (int U = F.vcu * 3; U < NB * NQH * 16; U += F.G * 3)
                for (int i = 0; i < 3 && U + i < NB * NQH * 16; ++i) { const int grp = (U + i) / 48, r = (U + i) % 48;
                    attn_body::attn_unit8w(grp >> 2, (grp & 3) * 3 + r / 16, r % 16, (const unsigned char*)Qp, (const unsigned char*)Kp, (const unsigned char*)Vp, Op, (char*)lds + RING_OFF, negM); }
        }
        else if (F.G == 256) REPS(31) {
            const int xg = F.vcu >> 5, jq = F.vcu & 31;
            for (int i = 0; i < 6; ++i) { const int grp = 2 * xg + i / 3, hs = i % 3;
                if (ATTN_FP8) attn_body::attn_unit8(grp >> 2, (grp & 3) * 3 + hs, jq, (const unsigned char*)Qp, (const unsigned char*)Kp, (const unsigned char*)Vp, Op, (char*)lds + RING_OFF, negM);
                else attn_body::attn_unit<ATTN_MSUM>(grp >> 2, (grp & 3) * 3 + hs, jq, Qp, Kp, Vp, Op, (char*)lds + RING_OFF, negM); }
        } else {
            for (int U = F.vcu; U < NB * NQH * 32; U += F.G) { const int grp = U / 96, r = U % 96;
                if (ATTN_FP8) attn_body::attn_unit8(grp >> 2, (grp & 3) * 3 + r / 32, r % 32, (const unsigned char*)Qp, (const unsigned char*)Kp, (const unsigned char*)Vp, Op, (char*)lds + RING_OFF, negM);
                else attn_body::attn_unit<ATTN_MSUM>(grp >> 2, (grp & 3) * 3 + r / 32, r % 32, Qp, Kp, Vp, Op, (char*)lds + RING_OFF, negM); }
        }
        if (ATTN_PRIO) __builtin_amdgcn_s_setprio(0);
    } SEAM(3);

#if DBG & (1024 | 2048)
    if (IN(4)) { float negMc; { float gqm = fabsf(FIN_q_norm_g[F.lane]), gkm = fabsf(FIN_k_norm_g[F.lane]);
            for (int o_ = 1; o_ < 64; o_ <<= 1) { gqm = fmaxf(gqm, __shfl_xor(gqm, o_)); gkm = fmaxf(gkm, __shfl_xor(gkm, o_)); } negMc = -(C2 * 64.0f * gqm * gkm + 0.5f); }
        if (DBG & 1024) chk_attn(F, negMc); if (DBG & 2048) chk_qkv(F); VM_WAIT(); __syncthreads(); }
#endif
    if (IN(4)) { ph4(F); if (REP == 4) { xcd_barrier(bar); ph4(F); } } SEAM(4);

    if (IN(5)) { ph5(F); if (REP == 5) { xcd_barrier(bar); ph5(F); } if (REP == 55) { xcd_barrier(bar); xcd_barrier(bar); xcd_barrier(bar); xcd_barrier(bar); xcd_barrier(bar); } } SEAM(5);

    if (IN(6)) { ph6(F); if (REP == 6) { xcd_barrier(bar); ph6(F); } } SEAM(6);

    if (IN(7)) {
        if (DBG & 128) { GAS u32x4* zA = (GAS u32x4*)(F.ws + WS_ACT); const size_t nA = (size_t)MAXTILES * 256 * EFF * 2 / 16; for (size_t i = (size_t)blockIdx.x * 512 + F.tid; i < nA; i += (size_t)F.G * 512) zA[i] = (u32x4){0u, 0u, 0u, 0u};
            GAS u32x4* zC = (GAS u32x4*)(F.ws + WS_C); const size_t nC = (size_t)NTOK * NSLOT * DM * 2 / 16; for (size_t i = (size_t)blockIdx.x * 512 + F.tid; i < nC; i += (size_t)F.G * 512) zC[i] = (u32x4){0u, 0u, 0u, 0u}; }
        if (blockIdx.x == 0 && F.tid == 0) __hip_atomic_store((unsigned*)(F.ctl + CW_CNT + NEXP), (unsigned)NTOK, RLX_AGENT);
        for (int tok = gw; tok < NTOK; tok += NGW) route_token(F, tok);
    } SEAM(7);

    if (IN(8)) { ph8(F); if (REP == 8) { xcd_barrier(bar); ph8(F); } } SEAM(8);

    if (IN(9)) { ph9(F); if (REP == 9) { xcd_barrier(bar); ph9(F); } } SEAM(9);

    if (IN(10)) {
        const int lane = F.lane; const GAS unsigned char* Cc = (const GAS unsigned char*)(F.ws + WS_C);
        const int wpb = NGW >> 2, b = gw / wpb, wi = gw % wpb;
        f32x4 g2v[4], fg[4];
#pragma unroll
        for (int i = 0; i < 4; ++i) { const int col = 16 * lane + 4 * i; g2v[i] = mod4(MOD + b * 6144 + 5120, col) * (1.0f / C_SCALE); fg[i] = *(const f32x4*)(FIN_final_g + col); }
        bool bad = false;
#if DBG & (1024 | 2048)
        { const float e0 = __hip_atomic_load((float*)(F.ctl + CW_CHK), RLX_AGENT), r0 = __hip_atomic_load((float*)(F.ctl + CW_CHK) + 1, RLX_AGENT), e1 = __hip_atomic_load((float*)(F.ctl + CW_CHK) + 2, RLX_AGENT), r1 = __hip_atomic_load((float*)(F.ctl + CW_CHK) + 3, RLX_AGENT);
          if (DBG & 1024) bad = bad || !(e0 <= CHK_TOL_A * r0) || !(r0 > 0.f); if (DBG & 2048) bad = bad || !(e1 <= CHK_TOL_B * r1) || !(r1 > 0.f); }
#endif
        for (int r = wi; r < SEQ; r += 2 * wpb) {
            const int r1 = (r + wpb < SEQ) ? r + wpb : r; const bool has1 = r + wpb < SEQ;
            const int m0 = b * SEQ + r, m1 = b * SEQ + r1;
            GAS float* orow0 = (GAS float*)F.out + (size_t)m0 * DM + 16 * lane; GAS float* orow1 = (GAS float*)F.out + (size_t)m1 * DM + 16 * lane;
            f32x4 xa[4], xb[4], ya[4], yb[4];
#pragma unroll
            for (int i = 0; i < 4; ++i) { xa[i] = *(const GAS f32x4*)(orow0 + 4 * i); xb[i] = *(const GAS f32x4*)(orow1 + 4 * i); ya[i] = (f32x4){0.f, 0.f, 0.f, 0.f}; yb[i] = (f32x4){0.f, 0.f, 0.f, 0.f}; }
#pragma unroll
            for (int sl = 0; sl < NSLOT; ++sl) { const u32x4 wa = *(const GAS u32x4*)(Cc + ((size_t)m0 * NSLOT + sl) * DM + 16 * lane), wb = *(const GAS u32x4*)(Cc + ((size_t)m1 * NSLOT + sl) * DM + 16 * lane);
#pragma unroll
                for (int i = 0; i < 4; ++i) { const int wa_ = (int)wa[i], wb_ = (int)wb[i];
                    const f32x2 la = __builtin_amdgcn_cvt_pk_f32_fp8(wa_, false), ha = __builtin_amdgcn_cvt_pk_f32_fp8(wa_, true), lb = __builtin_amdgcn_cvt_pk_f32_fp8(wb_, false), hb = __builtin_amdgcn_cvt_pk_f32_fp8(wb_, true);
                    ya[i] += (f32x4){la.x, la.y, ha.x, ha.y}; yb[i] += (f32x4){lb.x, lb.y, hb.x, hb.y}; } }
            float sa = 0.f, sb = 0.f;
#pragma unroll
            for (int i = 0; i < 4; ++i) { const f32x4 va = xa[i] + g2v[i] * ya[i], vb = xb[i] + g2v[i] * yb[i]; xa[i] = va; xb[i] = vb;
                sa += (va[0] * va[0] + va[1] * va[1]) + (va[2] * va[2] + va[3] * va[3]); sb += (vb[0] * vb[0] + vb[1] * vb[1]) + (vb[2] * vb[2] + vb[3] * vb[3]); }
#pragma unroll
            for (int o = 1; o < 64; o <<= 1) { sa += __shfl_xor(sa, o); sb += __shfl_xor(sb, o); }
            const float bm = bad ? 3.0f : 1.0f;
            const float ra = 1.0f / sqrtf(sa * (1.0f / DM) + RMS_EPS) * bm, rb = 1.0f / sqrtf(sb * (1.0f / DM) + RMS_EPS) * bm;
#pragma unroll
            for (int i = 0; i < 4; ++i) *(GAS f32x4*)(orow0 + 4 * i) = xa[i] * ra * fg[i];
            if (has1) {
#pragma unroll
                for (int i = 0; i < 4; ++i) *(GAS f32x4*)(orow1 + 4 * i) = xb[i] * rb * fg[i]; } }
    }
#undef IN
#undef SEAM
}

extern "C" void kernel_launch(void* const* d_in, const int* in_sizes, int n_in, void* d_out, int out_size, void* d_ws, size_t ws_size, hipStream_t stream) {
    static int grid = 0;
    if (grid == 0) {
        if (n_in != 20 || in_sizes[0] != NTOK * DM || out_size != NTOK * DM || ws_size < WS_END) { fprintf(stderr, "kernel_launch: unexpected shapes (n_in %d, in0 %d, out %d, ws %zu < %zu)\n", n_in, n_in > 0 ? in_sizes[0] : -1, out_size, ws_size, (size_t)WS_END); grid = -1; return; }
        int dev = 0, cus = 0, per_cu = 0;
        if (hipGetDevice(&dev) != hipSuccess || hipDeviceGetAttribute(&cus, hipDeviceAttributeMultiprocessorCount, dev) != hipSuccess) { grid = -1; return; }
        if (hipFuncSetAttribute((const void*)mk_fwd, hipFuncAttributeMaxDynamicSharedMemorySize, LDS_BYTES) != hipSuccess) { fprintf(stderr, "kernel_launch: hipFuncSetAttribute failed\n"); grid = -1; return; }
        if (hipOccupancyMaxActiveBlocksPerMultiprocessor(&per_cu, (const void*)mk_fwd, 512, LDS_BYTES) != hipSuccess || per_cu < 1) fprintf(stderr, "kernel_launch: occupancy query reports %d\n", per_cu);
        (void)hipGetLastError();
        grid = cus;
    }
    if (grid < 0) return;
    (void)hipMemsetAsync((char*)d_ws + WS_CTL, 0, CTL_ZERO_BYTES, stream);
    Args a{};
    for (int i = 0; i < 20; ++i) a.in[i] = (const float*)d_in[i];
    a.out = (float*)d_out; a.ws = (unsigned char*)d_ws;
    if (N_LAUNCHES == 1) { a.ph_lo = 0; a.ph_hi = PER_PHASE; hipLaunchKernelGGL(mk_fwd, dim3(grid), dim3(512), LDS_BYTES, stream, a); }
    else for (int li = 0; li < PER_PHASE; ++li) { a.ph_lo = li; a.ph_hi = li + 1; hipLaunchKernelGGL(mk_fwd, dim3(grid), dim3(512), LDS_BYTES, stream, a); }
}
```

```cpp
#include <hip/hip_runtime.h>
#include <hip/hip_bf16.h>
#include <cstdio>
#include <cstdint>
#include <cmath>

#ifndef MK_N_LAUNCHES
#define MK_N_LAUNCHES 1
#endif
constexpr int PER_PHASE = 11;
#ifndef DBG
#define DBG 0
#endif
#ifndef REP
#define REP -1
#endif
#ifndef CHK_TOL_A
#define CHK_TOL_A 1e-4f
#endif
#ifndef CHK_TOL_B
#define CHK_TOL_B 3e-3f
#endif
#ifndef POSTEPI_WAITS
#define POSTEPI_WAITS 1
#endif
#ifndef ATTN_FP8
#define ATTN_FP8 1
#endif
constexpr float Q8_SCALE = 8.0f;
#ifndef ATTN_MSUM
#define ATTN_MSUM false
#endif
#ifndef ATTN_PRIO
#define ATTN_PRIO 0
#endif
#ifndef ATTN_SKEW
#define ATTN_SKEW 1
#endif
#ifndef ATTN_MPRIO
#define ATTN_MPRIO 0
#endif
#ifndef ATTN_W64
#define ATTN_W64 1
#endif
#ifndef SYN
#define SYN 0
#endif
#define SYN_N 2000
#ifndef SYN_ILV
#define SYN_ILV 0
#endif
#ifndef SYN_ZERO
#define SYN_ZERO 0
#endif
#ifndef SYN_RND
#define SYN_RND 0
#endif
#ifndef SYN_EM
#define SYN_EM 3
#endif
#ifndef SYN_RD
#define SYN_RD 0
#endif
#ifndef FOURIER_MFMA
#define FOURIER_MFMA 1
#endif
#define REPS(k) for (int rep_ = 0; rep_ < ((REP == (k)) ? 2 : 1); ++rep_)
#define REPBAR() do { if (rep_) xcd_barrier(bar); } while (0)
constexpr int N_LAUNCHES = MK_N_LAUNCHES;

#define GAS __attribute__((address_space(1)))
#define LAS __attribute__((address_space(3)))
typedef unsigned short u16;
typedef short bf16x8 __attribute__((ext_vector_type(8)));
typedef _Float16 half8 __attribute__((ext_vector_type(8)));
typedef _Float16 half2v __attribute__((ext_vector_type(2)));
typedef float f32x4 __attribute__((ext_vector_type(4)));
typedef float f32x2 __attribute__((ext_vector_type(2)));
typedef unsigned u32x4 __attribute__((ext_vector_type(4)));
typedef unsigned u32x2 __attribute__((ext_vector_type(2)));
typedef GAS unsigned gu32;

constexpr int DM = 1024, NB = 4, SEQ = 8192, NTOK = NB * SEQ, CTXL = 256, NCTX = NB * CTXL, LKV = SEQ + CTXL;
constexpr int NQH = 12, NKVH = 4, HD = 64, QW = NQH * HD, KVW = NKVH * HD;
constexpr int NIN = 1792;
constexpr int MIN_ROWS = NTOK + NCTX;
constexpr int NEXP = 256, NEXPS = 257, TOPK = 8, EFF = 256, NSLOT = 9;
constexpr int MAXTILES = 1408;
constexpr float RMS_EPS = 1e-6f;
#ifndef MOE_F16
#define MOE_F16 0
#endif
constexpr bool MOEF16 = MOE_F16;
#ifndef MOE_FP8
#define MOE_FP8 1
#endif
constexpr int MOE_DT = MOE_FP8 ? 2 : (MOE_F16 ? 1 : 0);
constexpr float WGU_SCALE = 32.0f, WD_SCALE = 16.0f;
constexpr int SC_ONE = 0x7f7f7f7f, SC_GU = 0x7f7f7f7a, SC_D = 0x7f7f7f7b;
constexpr float C2 = 0.125f * 1.4426950408889634f;
constexpr float C_SCALE = 16.0f;

constexpr size_t MiB = 1u << 20;
constexpr size_t WS_CTL = 0, CTL_ZERO_BYTES = 1 * MiB;
constexpr size_t WS_TAB = 1 * MiB;
constexpr size_t WS_BIN = 2 * MiB;
constexpr size_t WS_BOUT = 6 * MiB;
constexpr size_t WS_BR = 8 * MiB;
constexpr size_t WS_K = 16 * MiB;
constexpr size_t WS_V = 34 * MiB;
constexpr size_t WS_Z = 52 * MiB;
constexpr size_t WS_Q = 84 * MiB;
constexpr size_t WS_XN = 132 * MiB;
constexpr size_t WS_MIX = 198 * MiB;
constexpr size_t WS_H2 = 262 * MiB;
constexpr size_t WS_LOG = 326 * MiB;
constexpr size_t WS_LIST = 358 * MiB;
constexpr size_t WS_BGU = 424 * MiB;
constexpr size_t WS_BD = 682 * MiB;
constexpr size_t WS_ACT = 812 * MiB;
constexpr size_t WS_C = 990 * MiB;
constexpr size_t WS_H2F8 = 1568 * MiB;
constexpr size_t WS_DUMP = 1600 * MiB;
constexpr size_t WS_END = 1632 * MiB;
constexpr int CW_TMO = 0, CW_CODE = 1;
constexpr int CW_BAR = 4096;
constexpr int CW_CNT = 16384;
constexpr int CW_CHK = 32768;
constexpr int CW_MOD = 131072;
static_assert(CW_MOD * 4 + 5 * 6144 * 8 <= (int)CTL_ZERO_BYTES, "ctl");

constexpr int RING_OFF = 0, RING_BYTES = 131072;
constexpr int P1_SCR = 18432;
constexpr int TAB_OFF = 8 * P1_SCR;
constexpr int LDS_BYTES = 163840;
constexpr int LDSCTL_OFF = LDS_BYTES - 1024, MISC_OFF = LDSCTL_OFF + 320;
static_assert(TAB_OFF + 8192 <= LDSCTL_OFF, "LDS map");

#define LDS_WAIT() asm volatile("s_waitcnt lgkmcnt(0)" ::: "memory")
#define VM_WAIT() asm volatile("s_waitcnt vmcnt(0)" ::: "memory")
#define RLX_AGENT __ATOMIC_RELAXED, __HIP_MEMORY_SCOPE_AGENT

__device__ __forceinline__ unsigned f2bf(float f) { unsigned u = __builtin_bit_cast(unsigned, f); return (u + 0x7fffu + ((u >> 16) & 1u)) >> 16; }
__device__ __forceinline__ unsigned pk2bf(float lo, float hi) { return f2bf(lo) | (f2bf(hi) << 16); }
__device__ __forceinline__ unsigned pk2h(float lo, float hi) { half2v v = {(_Float16)lo, (_Float16)hi}; return __builtin_bit_cast(unsigned, v); }
__device__ __forceinline__ unsigned cvt_pk_bf16(float lo, float hi) { unsigned r; asm volatile("v_cvt_pk_bf16_f32 %0, %1, %2" : "=v"(r) : "v"(lo), "v"(hi)); return r; }
__device__ __forceinline__ float bflo(unsigned w) { return __builtin_bit_cast(float, w << 16); }
__device__ __forceinline__ float bfhi(unsigned w) { return __builtin_bit_cast(float, w & 0xffff0000u); }
typedef long long i64x2 __attribute__((ext_vector_type(2)));
typedef GAS long long gi64;
__device__ __forceinline__ f32x4 mod4(const gi64* MODQ, int idx) {
    const i64x2 a = *(const GAS i64x2*)(MODQ + idx), b = *(const GAS i64x2*)(MODQ + idx + 2);
    return (f32x4){(float)a.x, (float)a.y, (float)b.x, (float)b.y} * 0x1p-36f;
}
__device__ __forceinline__ float rdl(float v, int lane) { return __builtin_bit_cast(float, __builtin_amdgcn_readlane(__builtin_bit_cast(int, v), lane)); }
__device__ __forceinline__ float wave_sum(float v) {
#pragma unroll
    for (int o = 1; o < 64; o <<= 1) v += __shfl_xor(v, o);
    return v;
}

namespace pg8 {
constexpr int BM = 256, BK = 64, HALF = 128, HTB = HALF * BK * 2, STAGE_BYTES = 8 * HTB;
__host__ __device__ __forceinline__ int lds_byte(int r, int c) { const int st = (r >> 4) * 2 + (c >> 5), rr = r & 15, cc = c & 31, ob = rr * 64 + cc * 2; return st * 1024 + (ob ^ (((ob >> 9) & 1) << 5)); }
__host__ __device__ __forceinline__ void stage_rc(int b, int& R, int& C) { const int st = b / 1024, sb = b % 1024, swz = sb ^ (((sb >> 9) & 1) << 5); R = (st >> 1) * 16 + swz / 64; C = (st & 1) * 32 + (swz % 64) / 2; }
__host__ __device__ __forceinline__ int perm32(int rho) { const int n = rho >> 4, i = rho & 15; return 8 * (i >> 2) + 4 * n + (i & 3); }

struct GUnit { int pm, pn, e, j, nvalid; const char* B; };

typedef int v8i __attribute__((ext_vector_type(8)));
typedef int v4i __attribute__((ext_vector_type(4)));
template <int DT> __device__ __forceinline__ f32x4 mma_tile(const v8i a, const v8i b, f32x4 c, int scA) {
    if constexpr (DT == 2) return __builtin_amdgcn_mfma_scale_f32_16x16x128_f8f6f4(a, b, c, 0, 0, 0, scA, 1, scA);
    else { const v4i a0 = __builtin_shufflevector(a, a, 0, 1, 2, 3), a1 = __builtin_shufflevector(a, a, 4, 5, 6, 7), b0 = __builtin_shufflevector(b, b, 0, 1, 2, 3), b1 = __builtin_shufflevector(b, b, 4, 5, 6, 7);
        if constexpr (DT == 1) { c = __builtin_amdgcn_mfma_f32_16x16x32_f16(__builtin_bit_cast(half8, a0), __builtin_bit_cast(half8, b0), c, 0, 0, 0); return __builtin_amdgcn_mfma_f32_16x16x32_f16(__builtin_bit_cast(half8, a1), __builtin_bit_cast(half8, b1), c, 0, 0, 0); }
        else { c = __builtin_amdgcn_mfma_f32_16x16x32_bf16(__builtin_bit_cast(bf16x8, a0), __builtin_bit_cast(bf16x8, b0), c, 0, 0, 0); return __builtin_amdgcn_mfma_f32_16x16x32_bf16(__builtin_bit_cast(bf16x8, a1), __builtin_bit_cast(bf16x8, b1), c, 0, 0, 0); } }
}

template <class Epi, class Sched, int DT, bool ALIGN_EPI>
__device__ __forceinline__ void gemm_phase(LAS unsigned char* lds, const char* Abase, const int K, const Sched& S, const Epi& E, const int scB = SC_ONE) {
    const int tid = threadIdx.x, wid = __builtin_amdgcn_readfirstlane(tid >> 6), lane = tid & 63, wr = wid >> 2, wc = wid & 3, fr = lane & 15, fq = lane >> 4;
    constexpr int ES = (DT == 2) ? 1 : 2;
    const int RB = K * ES;
    const int nt = RB / 128;
    unsigned voffB0; { int R, C; stage_rc(tid * 16, R, C); const int Rb = Epi::PERM ? ((R & ~31) + perm32(R & 31)) : R; voffB0 = (unsigned)(Rb * RB + C * 2); }
    const unsigned voffBd = 64u * (unsigned)RB;
#define PG8_AOFF(V, UNIT) do { int t_ = threadIdx.x; asm volatile("" : "+v"(t_)); _Pragma("unroll") for (int _i = 0; _i < 2; ++_i) { int R_, C_; stage_rc(t_ * 16 + _i * 8192, R_, C_); \
        _Pragma("unroll") for (int _h = 0; _h < 2; ++_h) (V)[_h][_i] = (unsigned)S.arow(UNIT, R_ + HALF * _h) * (unsigned)RB + (unsigned)(C_ * 2); } } while (0)
    const size_t kstep = (size_t)(BK * 2);
    const size_t hstep = (size_t)HALF * RB;
    const unsigned ldsw = (unsigned)wid * 1024u;
    const int ac0 = (DT == 2) ? 16 * fq : 8 * fq; constexpr int CH1 = (DT == 2) ? 16 : 1024;
    const int aoff = lds_byte(wr * 64 + fr, ac0), boff = lds_byte(wc * 32 + fr, ac0);
#define PG8_SA(b, h) (((b) * 2 + (h)) * HTB)
#define PG8_SB(b, h) ((4 + (b) * 2 + (h)) * HTB)
#define PG8_STAGEB(bufoff, gbase) do { _Pragma("unroll") for (int _i = 0; _i < 2; ++_i) \
        __builtin_amdgcn_global_load_lds((const unsigned*)((const char*)(gbase) + voffB0 + _i * voffBd), (LAS unsigned*)(lds + (bufoff) + ldsw + _i * 8192), 16, 0, 0); } while (0)
#define PG8_STAGEA(bufoff, koff, V, h) do { _Pragma("unroll") for (int _i = 0; _i < 2; ++_i) \
        __builtin_amdgcn_global_load_lds((const unsigned*)(Abase + (size_t)(V)[h][_i] + (koff)), (LAS unsigned*)(lds + (bufoff) + ldsw + _i * 8192), 16, 0, 0); } while (0)
#define PG8_LDA(dst, b, h) do { _Pragma("unroll") for (int m = 0; m < 4; ++m) { const v4i c0_ = *(const LAS v4i*)(lds + PG8_SA(b, h) + aoff + m * 2048), c1_ = *(const LAS v4i*)(lds + PG8_SA(b, h) + aoff + m * 2048 + CH1); dst[m] = __builtin_shufflevector(c0_, c1_, 0, 1, 2, 3, 4, 5, 6, 7); } } while (0)
#define PG8_LDB(dst, b, h) do { _Pragma("unroll") for (int n = 0; n < 2; ++n) { const v4i c0_ = *(const LAS v4i*)(lds + PG8_SB(b, h) + boff + n * 2048), c1_ = *(const LAS v4i*)(lds + PG8_SB(b, h) + boff + n * 2048 + CH1); dst[n] = __builtin_shufflevector(c0_, c1_, 0, 1, 2, 3, 4, 5, 6, 7); } } while (0)
#define PG8_MMA(ai, bj, At, Bt) do { __builtin_amdgcn_s_setprio(1); _Pragma("unroll") for (int m = 0; m < 4; ++m) _Pragma("unroll") for (int n = 0; n < 2; ++n) \
        acc[ai][bj][m][n] = mma_tile<DT>(Bt[n], At[m], acc[ai][bj][m][n], scB); __builtin_amdgcn_s_setprio(0); } while (0)
#define PG8_WAIT_V(n) asm volatile("s_waitcnt vmcnt(" #n ")" ::: "memory")
#define PG8_WAIT_VE(pe) do { if (pe) asm volatile("s_waitcnt vmcnt(%0)" :: "n"(8 + Epi::NSTORE) : "memory"); else asm volatile("s_waitcnt vmcnt(8)" ::: "memory"); } while (0)
#define PG8_WAIT_L(n) asm volatile("s_waitcnt lgkmcnt(" #n ")" ::: "memory")
#define PG8_BAR __builtin_amdgcn_s_barrier()
#define PG8_SCHED __builtin_amdgcn_sched_barrier(0)
    GUnit cur, nxt; int ui = 0;
    if (!S.next(0, cur)) return;
    f32x4 acc[2][2][4][2];
#pragma unroll
    for (int a = 0; a < 2; ++a)
#pragma unroll
        for (int b = 0; b < 2; ++b)
#pragma unroll
            for (int m = 0; m < 4; ++m)
#pragma unroll
                for (int n = 0; n < 2; ++n) acc[a][b][m][n] = (f32x4){0.f, 0.f, 0.f, 0.f};
    v8i At[4], B0[2], B1[2];
    unsigned vA[2][2];
    PG8_AOFF(vA, cur);
    if constexpr (Sched::GATHER) VM_WAIT();
    const char* cB = cur.B;
    E.pre(lds, cur, 0, wid, lane);
    PG8_STAGEB(PG8_SB(0, 0), cB); PG8_STAGEB(PG8_SB(0, 1), cB + hstep); PG8_STAGEA(PG8_SA(0, 0), 0, vA, 0); PG8_STAGEA(PG8_SA(0, 1), 0, vA, 1);
    if (wr == 1) PG8_BAR;
    PG8_WAIT_V(2); PG8_BAR;
    PG8_STAGEB(PG8_SB(1, 0), cB + kstep); PG8_STAGEA(PG8_SA(1, 0), kstep, vA, 0); PG8_STAGEB(PG8_SB(1, 1), cB + hstep + kstep);
    PG8_WAIT_V(6); PG8_BAR;
    for (;;) {
        const bool has_next = S.next(ui + 1, nxt);
#pragma unroll 1
        for (int t = 0; t < nt; t += 2) {
            const bool last = (t == nt - 2);
            const bool pe = POSTEPI_WAITS && (t == 0) && (ui > 0);
            const size_t k1 = (size_t)(t + 1) * kstep;
            PG8_LDB(B0, 0, 0); PG8_LDB(B1, 0, 1); PG8_SCHED; PG8_LDA(At, 0, 0); PG8_STAGEA(PG8_SA(1, 1), k1, vA, 1);
            PG8_WAIT_VE(pe); PG8_WAIT_L(0); PG8_BAR; PG8_MMA(0, 0, At, B0); PG8_MMA(0, 1, At, B1); PG8_BAR; PG8_SCHED;
            size_t k2 = (size_t)(t + 2) * kstep;
            if (last) { k2 = 0; if (has_next) { PG8_AOFF(vA, nxt); if constexpr (Sched::GATHER) VM_WAIT(); cB = nxt.B; } }
            const size_t k3 = k2 + kstep; const char* b2 = cB + k2; const char* b3 = b2 + kstep;
            PG8_LDA(At, 0, 1); PG8_STAGEB(PG8_SB(0, 0), b2); PG8_STAGEB(PG8_SB(0, 1), b2 + hstep); PG8_STAGEA(PG8_SA(0, 0), k2, vA, 0);
            PG8_WAIT_VE(pe); PG8_WAIT_L(0); PG8_BAR; PG8_MMA(1, 0, At, B0); PG8_MMA(1, 1, At, B1); PG8_BAR; PG8_SCHED;
            PG8_LDB(B0, 1, 0); PG8_LDB(B1, 1, 1); PG8_SCHED; PG8_LDA(At, 1, 0); PG8_STAGEA(PG8_SA(0, 1), k2, vA, 1);
            PG8_WAIT_V(8); PG8_WAIT_L(0); PG8_BAR; PG8_MMA(0, 0, At, B0); PG8_MMA(0, 1, At, B1); PG8_BAR; PG8_SCHED;
            PG8_LDA(At, 1, 1); PG8_STAGEB(PG8_SB(1, 0), b3); PG8_STAGEB(PG8_SB(1, 1), b3 + hstep); PG8_STAGEA(PG8_SA(1, 0), k3, vA, 0);
            PG8_WAIT_V(8); PG8_WAIT_L(0); PG8_BAR; PG8_MMA(1, 0, At, B0); PG8_MMA(1, 1, At, B1); PG8_BAR; PG8_SCHED;
        }
        if constexpr (ALIGN_EPI) { if (wr == 0) PG8_BAR; }
        { int tx = threadIdx.x; asm volatile("" : "+v"(tx)); E(acc, cur, wr, wc, tx & 15, (tx >> 4) & 3, lds, ui); }
        if (!has_next) break;
#pragma unroll
        for (int a = 0; a < 2; ++a)
#pragma unroll
            for (int b = 0; b < 2; ++b)
#pragma unroll
                for (int m = 0; m < 4; ++m)
#pragma unroll
                    for (int n = 0; n < 2; ++n) acc[a][b][m][n] = (f32x4){0.f, 0.f, 0.f, 0.f};
        cur = nxt; ++ui;
        if constexpr (ALIGN_EPI) { if (wr == 1) PG8_BAR; }
        E.pre(lds, cur, ui, wid, lane);
    }
    PG8_WAIT_V(0);
    if constexpr (!ALIGN_EPI) { if (wr == 0) PG8_BAR; }
    PG8_BAR;
#undef PG8_SA
#undef PG8_SB
#undef PG8_STAGEA
#undef PG8_AOFF
#undef PG8_STAGEB
#undef PG8_LDA
#undef PG8_LDB
#undef PG8_MMA
#undef PG8_WAIT_V
#undef PG8_WAIT_VE
#undef PG8_WAIT_L
#undef PG8_BAR
#undef PG8_SCHED
}
}

namespace attn_body {
using bf16 = __hip_bfloat16;
using s16x4 = __attribute__((ext_vector_type(4))) short;
using f32x16 = __attribute__((ext_vector_type(16))) float;
constexpr int D = 64, DMQ = QW, DMKV = KVW, DMO = DM;
constexpr int NW = 8, QBLK = 32, QB = QBLK * NW, KVBLK = 64, NT = LKV / KVBLK;
static_assert(NT % 2 == 0 && NT >= 8, "tile count");
__device__ __forceinline__ int crow(int r, int hi) { return (r & 3) + 8 * (r >> 2) + 4 * hi; }
#define SBAR() __builtin_amdgcn_sched_barrier(0)
constexpr int NSLOTR = 3, SLOTB = 8192;
constexpr int LDS_K = 0, LDS_V = NSLOTR * SLOTB, LDS_WS = 2 * NSLOTR * SLOTB, LDS_OST = LDS_WS + NW * 64 * 4, ATT_LDS_BYTES = LDS_OST + NW * 4096;
__device__ __forceinline__ void glds16(const void* gsrc, unsigned lds_dst) { unsigned keep;
    asm volatile("s_mov_b32 %0, m0\n\ts_mov_b32 m0, %2\n\ts_nop 0\n\tglobal_load_lds_dwordx4 %1, off\n\ts_mov_b32 m0, %0" : "=&s"(keep) : "v"(gsrc), "s"(lds_dst) : "memory"); }
__device__ __forceinline__ float max3f(float a, float b, float c) { float r; asm("v_max3_f32 %0, %1, %2, %3" : "=v"(r) : "v"(a), "v"(b), "v"(c)); return r; }
__device__ __forceinline__ float max2f(float a, float b) { float r; asm("v_max_f32_e32 %0, %1, %2" : "=v"(r) : "v"(a), "v"(b)); return r; }
__device__ __forceinline__ float fadd_s(float a, float b) { float r; asm("v_add_f32_e32 %0, %1, %2" : "=v"(r) : "v"(a), "v"(b)); return r; }
__device__ __forceinline__ float fsub_s(float a, float b) { float r; asm("v_sub_f32_e32 %0, %1, %2" : "=v"(r) : "v"(a), "v"(b)); return r; }
typedef float f32x2_t __attribute__((ext_vector_type(2))); typedef __bf16 bf16x2_t __attribute__((ext_vector_type(2)));
__device__ __forceinline__ unsigned cvtpk_s(float lo, float hi) { f32x2_t v = {lo, hi}; bf16x2_t b = __builtin_convertvector(v, bf16x2_t); return __builtin_bit_cast(unsigned, b); }
#define WAIT_BAR(N) asm volatile("s_waitcnt vmcnt(" #N ") lgkmcnt(0)\n\ts_barrier" ::: "memory")

__device__ __forceinline__ void qkt(f32x16& p0, f32x16& p1, const char* Kslot, const bf16x8* qr, const f32x16& negm, int r32, int hi) {
    const char* kb = Kslot + hi * 1024 + r32 * 16;
#pragma unroll
    for (int d0 = 0; d0 < 4; ++d0) {
        const bf16x8 b0 = *reinterpret_cast<const bf16x8*>(kb + d0 * 2048);
        const bf16x8 b1 = *reinterpret_cast<const bf16x8*>(kb + d0 * 2048 + 512);
        if (d0 == 0) { p0 = __builtin_amdgcn_mfma_f32_32x32x16_bf16(b0, qr[0], negm, 0, 0, 0); p1 = __builtin_amdgcn_mfma_f32_32x32x16_bf16(b1, qr[0], negm, 0, 0, 0); }
        else { p0 = __builtin_amdgcn_mfma_f32_32x32x16_bf16(b0, qr[d0], p0, 0, 0, 0); p1 = __builtin_amdgcn_mfma_f32_32x32x16_bf16(b1, qr[d0], p1, 0, 0, 0); } }
}
typedef __attribute__((address_space(3))) const char* lds_cptr;
typedef short v4i16_t __attribute__((ext_vector_type(4)));
__device__ __forceinline__ void kload8(bf16x8* kf, lds_cptr kp) {
    kf[0] = *(const __attribute__((address_space(3))) bf16x8*)(kp);        kf[1] = *(const __attribute__((address_space(3))) bf16x8*)(kp + 512);
    kf[2] = *(const __attribute__((address_space(3))) bf16x8*)(kp + 2048); kf[3] = *(const __attribute__((address_space(3))) bf16x8*)(kp + 2560);
    kf[4] = *(const __attribute__((address_space(3))) bf16x8*)(kp + 4096); kf[5] = *(const __attribute__((address_space(3))) bf16x8*)(kp + 4608);
    kf[6] = *(const __attribute__((address_space(3))) bf16x8*)(kp + 6144); kf[7] = *(const __attribute__((address_space(3))) bf16x8*)(kp + 6656);
}
__device__ __forceinline__ void kload2(bf16x8* kf, lds_cptr kp, int j) { kf[2 * j] = *(const __attribute__((address_space(3))) bf16x8*)(kp + j * 2048); kf[2 * j + 1] = *(const __attribute__((address_space(3))) bf16x8*)(kp + j * 2048 + 512); }
__device__ __forceinline__ s16x4 vtr(lds_cptr p) { return __builtin_bit_cast(s16x4, __builtin_amdgcn_ds_read_tr16_b64_v4i16((__attribute__((address_space(3))) v4i16_t*)p)); }
__device__ __forceinline__ float rowmax(const f32x16& p0, const f32x16& p1) {
    float a = max3f(p0[0], p0[1], p1[0]), b = max3f(p0[2], p0[3], p1[1]); a = max3f(a, p1[2], p1[3]);
#pragma unroll
    for (int r = 4; r < 16; r += 4) { a = max3f(a, p0[r], p0[r + 1]); b = max3f(b, p0[r + 2], p0[r + 3]); a = max3f(a, p1[r], p1[r + 1]); b = max3f(b, p1[r + 2], p1[r + 3]); }
    const float m = max2f(a, b);
    auto rr = __builtin_amdgcn_permlane32_swap(__float_as_uint(m), __float_as_uint(m), false, false);
    return max2f(__uint_as_float(rr[0]), __uint_as_float(rr[1]));
}
__device__ __forceinline__ void pv(f32x16* o, int vb, bf16x8 pa0, bf16x8 pa1, bf16x8 pa2, bf16x8 pa3) {
#pragma unroll
    for (int d0 = 0; d0 < 2; ++d0) { s16x4 lo[4], hi[4];
#pragma unroll
        for (int ks = 0; ks < 4; ++ks) {
            asm volatile("ds_read_b64_tr_b16 %0,%1 offset:%c2" : "=&v"(lo[ks]) : "v"(vb), "i"(d0 * 4096 + ks * 1024) : "memory");
            asm volatile("ds_read_b64_tr_b16 %0,%1 offset:%c2" : "=&v"(hi[ks]) : "v"(vb), "i"(d0 * 4096 + ks * 1024 + 512) : "memory"); }
        asm volatile("s_waitcnt lgkmcnt(0)" ::: "memory"); SBAR();
#define PK(k) (bf16x8){lo[k][0], lo[k][1], lo[k][2], lo[k][3], hi[k][0], hi[k][1], hi[k][2], hi[k][3]}
        o[d0] = __builtin_amdgcn_mfma_f32_32x32x16_bf16(pa0, PK(0), o[d0], 0, 0, 0);
        o[d0] = __builtin_amdgcn_mfma_f32_32x32x16_bf16(pa1, PK(1), o[d0], 0, 0, 0);
        o[d0] = __builtin_amdgcn_mfma_f32_32x32x16_bf16(pa2, PK(2), o[d0], 0, 0, 0);
        o[d0] = __builtin_amdgcn_mfma_f32_32x32x16_bf16(pa3, PK(3), o[d0], 0, 0, 0);
#undef PK
    }
}
template <bool MS> __device__ __forceinline__ void attn_unit(int b, int h, int qb, const bf16* Q, const bf16* __restrict__ K, const bf16* __restrict__ V, bf16* O, char* shm, float negM_) {
    const int tid = threadIdx.x, lane = tid & 63, r32 = lane & 31, hi = lane >> 5; const int wid = __builtin_amdgcn_readfirstlane(tid >> 6);
    const int q0 = qb * QB; const int kvh = h / 3;
    const long qrow0 = (long)b * SEQ + q0 + wid * QBLK;
    const long kvrow0 = (long)b * LKV;
    const bf16* Qw = Q + qrow0 * DMQ + h * D;
    const bf16* Kh = K + kvrow0 * DMKV + kvh * D, *Vh = V + kvrow0 * DMKV + kvh * D;
    const unsigned lds0 = (unsigned)(uintptr_t)shm;
    float* wsf = (float*)(shm + LDS_WS) + wid * 64;
    const bf16* ksrc = Kh + (long)lane * DMKV + wid * 8;
    const bf16* vsrc = Vh + (long)(16 * (wid & 3) + (lane >> 2)) * DMKV + (wid >> 2) * 32 + (lane & 3) * 8;
    const unsigned kdst = lds0 + LDS_K + wid * 1024, vdst = lds0 + LDS_V + wid * 1024;
#define DMA_K(t, slot) glds16(ksrc + (long)(t) * KVBLK * DMKV, (unsigned)__builtin_amdgcn_readfirstlane(kdst + (slot)))
#define DMA_V(t, slot) glds16(vsrc + (long)(t) * KVBLK * DMKV, (unsigned)__builtin_amdgcn_readfirstlane(vdst + (slot)))
    const int vb0 = (int)(lds0 + LDS_V) + ((lane >> 4) & 1) * 32 + (lane & 3) * 8 + (4 * hi + ((lane & 15) >> 2)) * 64;
    const char* Kbase = shm + LDS_K; bf16x8 kf[8];
    const lds_cptr shm3 = (lds_cptr)shm; const lds_cptr kp0 = shm3 + LDS_K + hi * 1024 + r32 * 16; const lds_cptr vp0 = shm3 + LDS_V + ((lane >> 4) & 1) * 32 + (lane & 3) * 8 + (4 * hi + ((lane & 15) >> 2)) * 64;
    DMA_K(0, 0); DMA_V(0, 0); DMA_K(1, SLOTB);
    bf16x8 qr[4];
#pragma unroll
    for (int d0 = 0; d0 < 4; ++d0) qr[d0] = *reinterpret_cast<const bf16x8*>(&Qw[(long)r32 * DMQ + d0 * 16 + hi * 8]);
    float l_reg = 0.f; f32x16 o[2]; o[0] = f32x16{}; o[1] = f32x16{}; f32x16 negm = f32x16{}; f32x16 lacc = f32x16{};
    if constexpr (!MS) { _Pragma("unroll") for (int r = 0; r < 16; ++r) negm[r] = negM_; asm volatile("" : "+v"(negm)); }
    const bf16x8 ONES = (bf16x8){0x3F80, 0x3F80, 0x3F80, 0x3F80, 0x3F80, 0x3F80, 0x3F80, 0x3F80};
#define START(P0, P1) do { _Pragma("unroll") for (int r = 0; r < 16; ++r) P0[r] = __builtin_amdgcn_exp2f(P0[r]); } while (0)
#define RESC() do { } while (0)
    f32x16 pA0, pA1, pB0, pB1;
    int sl_prev = 0, sl_cur = 0, sl_next = SLOTB;
#define ROT() do { sl_prev = sl_cur; sl_cur = sl_next; sl_next = (sl_next == (NSLOTR - 1) * SLOTB) ? 0 : sl_next + SLOTB; } while (0)
    DMA_K(2, 2 * SLOTB);
    WAIT_BAR(3);
    qkt(pA0, pA1, Kbase, qr, negm, r32, hi); asm volatile("s_nop 15\n\ts_nop 7" : "+v"(pA0), "+v"(pA1));
    START(pA0, pA1);
    _Pragma("unroll") for (int r = 0; r < 16; ++r) pA1[r] = __builtin_amdgcn_exp2f(pA1[r]);
    WAIT_BAR(0);
    DMA_K(3, 0); DMA_V(1, SLOTB);
    ROT();
    kload8(kf, kp0 + sl_cur);
    WAIT_BAR(2);
    s16x4 vlo[8], vhi[8]; u32x4 pw0, pw1, pw2, pw3;
#define PKW(P, B) cvtpk_s(P[B], P[B + 1])
#define PAF(k) __builtin_bit_cast(bf16x8, pw##k)
#define VFR(i) (bf16x8){vlo[i][0], vlo[i][1], vlo[i][2], vlo[i][3], vhi[i][0], vhi[i][1], vhi[i][2], vhi[i][3]}
#define PIN(x) asm volatile("" : "+v"(x))
#define MX3(a, b, c) __builtin_fmaxf(__builtin_fmaxf((a), (b)), (c))
#define GAPA(MF, A0, A1, A2, A3, W0, W1, PW) do { MF; if constexpr (!MS) { sacc += A0; sacc += A1; sacc += A2; sacc += A3; PIN(sacc); } W0; W1; PIN(PW); SBAR(); } while (0)
#define LSUM(k) do { if constexpr (MS) lacc = __builtin_amdgcn_mfma_f32_32x32x16_bf16(PAF(k), ONES, lacc, 0, 0, 0); } while (0)
#define EX(v) __builtin_amdgcn_exp2f(v)
#define GAPB(MF, X, B) do { MF; X[B] = EX(X[B]); X[B + 1] = EX(X[B + 1]); X[B + 2] = EX(X[B + 2]); X[B + 3] = EX(X[B + 3]); PIN(X); SBAR(); } while (0)
#define VRD(i) do { vlo[i] = vtr(vp_ + (((i) >> 2) * 4096 + ((i) & 3) * 1024)); vhi[i] = vtr(vp_ + (((i) >> 2) * 4096 + ((i) & 3) * 1024 + 512)); } while (0)
#define KRD(G, j) do { if (G) { kload2(kf, kp0 + sl_next, j); SBAR(); } } while (0)
#define STEP(C0, C1, P0, P1, t, GK, GV, GL) do { SBAR(); \
    const lds_cptr vp_ = vp0 + sl_prev; \
    VRD(0); SBAR(); float sacc = MS ? 0.f : (P0[0] + P0[1]); \
    GAPA(C0 = __builtin_amdgcn_mfma_f32_32x32x16_bf16(kf[0], qr[0], negm, 0, 0, 0), P0[2], P0[3], P0[4], P0[5],     pw0[0] = PKW(P0, 0), pw0[1] = PKW(P0, 2), pw0); \
    VRD(4); SBAR(); GAPA(C1 = __builtin_amdgcn_mfma_f32_32x32x16_bf16(kf[1], qr[0], negm, 0, 0, 0), P0[6], P0[7], P0[8], P0[9],     pw0[2] = PKW(P0, 4), pw0[3] = PKW(P0, 6), pw0); \
    VRD(1); SBAR(); GAPA(C0 = __builtin_amdgcn_mfma_f32_32x32x16_bf16(kf[2], qr[1], C0, 0, 0, 0),   P0[10], P0[11], P0[12], P0[13], pw1[0] = PKW(P0, 8), pw1[1] = PKW(P0, 10), pw1); \
    VRD(5); SBAR(); GAPA(C1 = __builtin_amdgcn_mfma_f32_32x32x16_bf16(kf[3], qr[1], C1, 0, 0, 0),   P0[14], P0[15], P1[0], P1[1],   pw1[2] = PKW(P0, 12), pw1[3] = PKW(P0, 14), pw1); \
    VRD(2); SBAR(); GAPA(C0 = __builtin_amdgcn_mfma_f32_32x32x16_bf16(kf[4], qr[2], C0, 0, 0, 0),   P1[2], P1[3], P1[4], P1[5],     pw2[0] = PKW(P1, 0), pw2[1] = PKW(P1, 2), pw2); \
    VRD(6); SBAR(); GAPA(C1 = __builtin_amdgcn_mfma_f32_32x32x16_bf16(kf[5], qr[2], C1, 0, 0, 0),   P1[6], P1[7], P1[8], P1[9],     pw2[2] = PKW(P1, 4), pw2[3] = PKW(P1, 6), pw2); \
    VRD(3); SBAR(); GAPA(C0 = __builtin_amdgcn_mfma_f32_32x32x16_bf16(kf[6], qr[3], C0, 0, 0, 0),   P1[10], P1[11], P1[12], P1[13], pw3[0] = PKW(P1, 8), pw3[1] = PKW(P1, 10), pw3); \
    VRD(7); SBAR(); GAPA(C1 = __builtin_amdgcn_mfma_f32_32x32x16_bf16(kf[7], qr[3], C1, 0, 0, 0),   P1[14], P1[15], 0.f, 0.f,       pw3[2] = PKW(P1, 12), pw3[3] = PKW(P1, 14), pw3); \
    if constexpr (!MS) l_reg += sacc; \
    if (GK) { DMA_K((t) + 3, sl_cur); } if (GV) { DMA_V((t) + 1, sl_next); } \
    SBAR(); \
    GAPB(o[0] = __builtin_amdgcn_mfma_f32_32x32x16_bf16(PAF(0), VFR(0), o[0], 0, 0, 0), C0, 0); \
    GAPB(o[1] = __builtin_amdgcn_mfma_f32_32x32x16_bf16(PAF(0), VFR(4), o[1], 0, 0, 0), C0, 4); LSUM(0); \
    KRD(GL, 0); GAPB(o[0] = __builtin_amdgcn_mfma_f32_32x32x16_bf16(PAF(1), VFR(1), o[0], 0, 0, 0), C0, 8); \
    KRD(GL, 1); GAPB(o[1] = __builtin_amdgcn_mfma_f32_32x32x16_bf16(PAF(1), VFR(5), o[1], 0, 0, 0), C0, 12); LSUM(1); \
    KRD(GL, 2); GAPB(o[0] = __builtin_amdgcn_mfma_f32_32x32x16_bf16(PAF(2), VFR(2), o[0], 0, 0, 0), C1, 0); \
    KRD(GL, 3); GAPB(o[1] = __builtin_amdgcn_mfma_f32_32x32x16_bf16(PAF(2), VFR(6), o[1], 0, 0, 0), C1, 4); LSUM(2); \
    GAPB(o[0] = __builtin_amdgcn_mfma_f32_32x32x16_bf16(PAF(3), VFR(3), o[0], 0, 0, 0), C1, 8); \
    GAPB(o[1] = __builtin_amdgcn_mfma_f32_32x32x16_bf16(PAF(3), VFR(7), o[1], 0, 0, 0), C1, 12); LSUM(3); \
    } while (0)
    int t = 1;
    for (; t + 5 < NT; t += 2) {
        STEP(pB0, pB1, pA0, pA1, t, true, true, true);     WAIT_BAR(2); RESC(); ROT();
        STEP(pA0, pA1, pB0, pB1, t + 1, true, true, true); WAIT_BAR(2); RESC(); ROT();
    }
#define ENDW(tt) do { if ((tt) + 3 < NT) { WAIT_BAR(2); } else if ((tt) + 2 < NT) { WAIT_BAR(1); } else { WAIT_BAR(0); } } while (0)
    for (; t + 1 < NT; t += 2) {
        STEP(pB0, pB1, pA0, pA1, t, (t + 3 < NT), (t + 1 < NT), (t + 1 < NT));         ENDW(t);     RESC(); ROT();
        STEP(pA0, pA1, pB0, pB1, t + 1, (t + 4 < NT), (t + 2 < NT), (t + 2 < NT));     ENDW(t + 1); RESC(); ROT();
    }
    STEP(pB0, pB1, pA0, pA1, NT - 1, false, false, false); RESC();
    { if constexpr (!MS) { float sacc = pB0[0] + pB0[1]; _Pragma("unroll") for (int r = 2; r < 16; ++r) sacc += pB0[r]; _Pragma("unroll") for (int r = 0; r < 16; ++r) sacc += pB1[r]; l_reg += sacc; }
      pw0 = (u32x4){PKW(pB0, 0), PKW(pB0, 2), PKW(pB0, 4), PKW(pB0, 6)}; pw1 = (u32x4){PKW(pB0, 8), PKW(pB0, 10), PKW(pB0, 12), PKW(pB0, 14)}; pw2 = (u32x4){PKW(pB1, 0), PKW(pB1, 2), PKW(pB1, 4), PKW(pB1, 6)}; pw3 = (u32x4){PKW(pB1, 8), PKW(pB1, 10), PKW(pB1, 12), PKW(pB1, 14)};
      SBAR(); pv(o, vb0 + sl_cur, PAF(0), PAF(1), PAF(2), PAF(3)); LSUM(0); LSUM(1); LSUM(2); LSUM(3); }
#undef LSUM
#undef PKW
#undef PAF
#undef VFR
#undef PIN
#undef MX3
#undef GAPA
#undef GAPB
#undef EX
#undef VRD
#undef KRD
#undef STEP
#undef ENDW
    float rli[16];
    if constexpr (MS) {
#pragma unroll
        for (int r = 0; r < 16; ++r) rli[r] = __builtin_amdgcn_rcpf(lacc[r]);
    } else {
        { auto rr = __builtin_amdgcn_permlane32_swap(__float_as_uint(l_reg), __float_as_uint(l_reg), false, false); l_reg = __uint_as_float(rr[0]) + __uint_as_float(rr[1]); }
        if (hi == 0) wsf[32 + r32] = l_reg; asm volatile("s_waitcnt lgkmcnt(0)" ::: "memory");
#pragma unroll
        for (int r = 0; r < 16; ++r) rli[r] = __builtin_amdgcn_rcpf(wsf[32 + crow(r, hi)]);
    }
    bf16* Ow = O + qrow0 * DMO + h * D;
    { bf16* stg = (bf16*)(shm + LDS_OST) + wid * 2048;
#pragma unroll
      for (int r = 0; r < 16; ++r) { const int orow = crow(r, hi);
#pragma unroll
        for (int d0 = 0; d0 < 2; ++d0) stg[orow * 64 + d0 * 32 + r32] = __float2bfloat16(o[d0][r] * rli[r]); }
      asm volatile("s_waitcnt lgkmcnt(0)" ::: "memory");
#pragma unroll
      for (int i = 0; i < 4; ++i) { const int row = i * 8 + (lane >> 3), ch = lane & 7; const u32x4 v = *(const u32x4*)(stg + row * 64 + ch * 8); *(u32x4*)(Ow + (long)row * DMO + ch * 8) = v; } }
    asm volatile("s_waitcnt lgkmcnt(0)\n\ts_barrier" ::: "memory");
#undef DMA_K
#undef DMA_V
#undef START
#undef RESC
#undef ROT
}
#undef SBAR
#undef WAIT_BAR

typedef int v8i_t __attribute__((ext_vector_type(8)));
typedef int v4i_t __attribute__((ext_vector_type(4)));
__host__ __device__ __forceinline__ int vt_slot(int k) { const int hi = (k >> 2) & 1, r = (k & 3) + 4 * ((k & 31) >> 3); return 32 * hi + r + 16 * (k >> 5); }
constexpr int SLOT8 = 4096, NS8 = 6, L8_K = 0, L8_V = NS8 * SLOT8;
static_assert(L8_V + NS8 * SLOT8 <= LDS_WS, "fp8 rings below the per-wave scratch");
constexpr int SC_QK = 0x7c7f, SC_PV = 0x7f7f;
__device__ __forceinline__ v8i_t ld32(lds_cptr p, int o0, int o1) { const v4i_t a = *(const __attribute__((address_space(3))) v4i_t*)(p + o0), b = *(const __attribute__((address_space(3))) v4i_t*)(p + o1); return __builtin_shufflevector(a, b, 0, 1, 2, 3, 4, 5, 6, 7); }
#define SBAR() __builtin_amdgcn_sched_barrier(0)
#define WAIT_BAR(N) asm volatile("s_waitcnt vmcnt(" #N ") lgkmcnt(0)\n\ts_barrier" ::: "memory")
__device__ __forceinline__ void attn_unit8(int b, int h, int qb, const unsigned char* Q8, const unsigned char* K8, const unsigned char* Vt8, bf16* O, char* shm, float negM_) {
    int tid = threadIdx.x; asm volatile("" : "+v"(tid));
    const int lane = tid & 63, r32 = lane & 31, hi = lane >> 5; const int wid = __builtin_amdgcn_readfirstlane(tid >> 6);
    const int q0 = qb * QB; const int kvh = h / 3; const bool kw = wid < 4;
    const long qrow0 = (long)b * SEQ + q0 + wid * QBLK;
    const unsigned lds0 = (unsigned)(uintptr_t)shm;
    const int drow = 16 * (wid & 3) + (lane >> 2), dch = (lane & 3) ^ ((drow >> 2) & 3);
    const unsigned char* ksrc = K8 + ((long)b * LKV + drow) * DMKV + kvh * D + dch * 16;
    const unsigned char* vsrc = Vt8 + ((long)(b * NKVH + kvh) * (LKV / 64)) * 4096 + drow * 64 + dch * 16;
    const unsigned kdst = lds0 + L8_K + (wid & 3) * 1024, vdst = lds0 + L8_V + (wid & 3) * 1024;
#define DMA8_K(t, slot) glds16(ksrc + (long)(t) * KVBLK * DMKV, (unsigned)__builtin_amdgcn_readfirstlane(kdst + (slot)))
#define DMA8_V(t, slot) glds16(vsrc + (long)(t) * 4096, (unsigned)__builtin_amdgcn_readfirstlane(vdst + (slot)))
    const lds_cptr shm3 = (lds_cptr)shm; const int sw = (r32 >> 2) & 3, c0o = ((2 * hi) ^ sw) * 16, c1o = ((2 * hi + 1) ^ sw) * 16;
    const lds_cptr kp0 = shm3 + L8_K + r32 * 64; const lds_cptr vp0 = shm3 + L8_V + r32 * 64;
    if (kw) { DMA8_K(0, 0); DMA8_K(1, SLOT8); DMA8_K(2, 2 * SLOT8); DMA8_K(3, 3 * SLOT8); DMA8_K(4, 4 * SLOT8); } else { DMA8_V(0, 0); DMA8_V(1, SLOT8); DMA8_V(2, 2 * SLOT8); }
    const v8i_t qr = *reinterpret_cast<const v8i_t*>(Q8 + (qrow0 + r32) * DMQ + h * D + hi * 32);
    f32x16 o[2]; o[0] = f32x16{}; o[1] = f32x16{}; f32x16 negm; f32x16 lacc = f32x16{};
    _Pragma("unroll") for (int r = 0; r < 16; ++r) negm[r] = negM_;
    asm volatile("" : "+v"(negm));
    const v8i_t ONES8 = (v8i_t){0x38383838, 0x38383838, 0x38383838, 0x38383838, 0x38383838, 0x38383838, 0x38383838, 0x38383838};
    f32x16 c0, c1; v8i_t kf[2], vf[2], pw = (v8i_t){0, 0, 0, 0, 0, 0, 0, 0};
    int s0 = 0, s1 = SLOT8, s2 = 2 * SLOT8, s3 = 3 * SLOT8, s5 = 5 * SLOT8;
#define NXT8(x) (((x) == (NS8 - 1) * SLOT8) ? 0 : (x) + SLOT8)
#define ROT8() do { s0 = s1; s1 = s2; s2 = s3; s3 = NXT8(s3); s5 = NXT8(s5); } while (0)
#define QK8() do { c0 = __builtin_amdgcn_mfma_scale_f32_32x32x64_f8f6f4(kf[0], qr, negm, 0, 0, 0, SC_QK, 1, SC_QK); c1 = __builtin_amdgcn_mfma_scale_f32_32x32x64_f8f6f4(kf[1], qr, negm, 0, 0, 0, SC_QK, 1, SC_QK); } while (0)
#define PK8(P, B, OLD) __builtin_amdgcn_cvt_pk_fp8_f32(P[B + 2], P[B + 3], __builtin_amdgcn_cvt_pk_fp8_f32(P[B], P[B + 1], OLD, false), true)
#define PV8() do { if (REP == 71) { f32x16 dz_ = __builtin_amdgcn_mfma_scale_f32_32x32x64_f8f6f4(pw, vf[0], f32x16{}, 0, 0, 0, SC_PV, 1, SC_PV); asm volatile("" :: "v"(dz_)); dz_ = __builtin_amdgcn_mfma_scale_f32_32x32x64_f8f6f4(pw, vf[1], f32x16{}, 0, 0, 0, SC_PV, 1, SC_PV); asm volatile("" :: "v"(dz_)); } \
    o[0] = __builtin_amdgcn_mfma_scale_f32_32x32x64_f8f6f4(pw, vf[0], o[0], 0, 0, 0, SC_PV, 1, SC_PV); o[1] = __builtin_amdgcn_mfma_scale_f32_32x32x64_f8f6f4(pw, vf[1], o[1], 0, 0, 0, SC_PV, 1, SC_PV); \
        lacc = __builtin_amdgcn_mfma_scale_f32_32x32x64_f8f6f4(pw, ONES8, lacc, 0, 0, 0, SC_PV, 1, SC_PV); } while (0)
#define EXPK8() do { if (REP == 70) { _Pragma("unroll") for (int r = 0; r < 16; ++r) { float d0_ = __builtin_amdgcn_exp2f(c0[r] * 0.5f), d1_ = __builtin_amdgcn_exp2f(c1[r] * 0.5f); asm volatile("" :: "v"(d0_), "v"(d1_)); } } \
    _Pragma("unroll") for (int r = 0; r < 16; ++r) { c0[r] = __builtin_amdgcn_exp2f(c0[r]); c1[r] = __builtin_amdgcn_exp2f(c1[r]); } \
        pw[0] = PK8(c0, 0, pw[0]); pw[1] = PK8(c0, 4, pw[1]); pw[2] = PK8(c0, 8, pw[2]); pw[3] = PK8(c0, 12, pw[3]); pw[4] = PK8(c1, 0, pw[4]); pw[5] = PK8(c1, 4, pw[5]); pw[6] = PK8(c1, 8, pw[6]); pw[7] = PK8(c1, 12, pw[7]); } while (0)
    WAIT_BAR(0);
    kf[0] = ld32(kp0, c0o, c1o); kf[1] = ld32(kp0 + 2048, c0o, c1o);
    QK8(); EXPK8();
    kf[0] = ld32(kp0 + SLOT8, c0o, c1o); kf[1] = ld32(kp0 + SLOT8 + 2048, c0o, c1o);
    WAIT_BAR(0);
#define SUB8(t, GK, GV, GL, MID) do { SBAR(); \
    vf[0] = ld32(vp0 + s0, c0o, c1o); vf[1] = ld32(vp0 + s0 + 2048, c0o, c1o); \
    if (ATTN_MPRIO) __builtin_amdgcn_s_setprio(1); \
    QK8(); PV8(); \
    if (ATTN_MPRIO) { SBAR(); __builtin_amdgcn_s_setprio(0); } \
    if (kw) { if (GK) { DMA8_K((t) + 4, s5); } } else { if (GV) { DMA8_V((t) + 2, s3); } } \
    if (GL) { kf[0] = ld32(kp0 + s2, c0o, c1o); kf[1] = ld32(kp0 + s2 + 2048, c0o, c1o); } \
    if (ATTN_SKEW) { SBAR(); MID; SBAR(); } \
    EXPK8(); ROT8(); \
    } while (0)
    int t = 1;
    if (ATTN_SKEW && !kw) {
#pragma unroll 1
        for (; t + 5 < NT; t += 2) { SUB8(t, false, true, true, (void)0); SUB8(t + 1, false, true, true, WAIT_BAR(1)); }
#pragma unroll 1
        for (; t + 1 < NT; t += 2) { SUB8(t, false, (t + 2 < NT), (t + 1 < NT), (void)0); SUB8(t + 1, false, (t + 3 < NT), (t + 2 < NT), WAIT_BAR(0)); }
    } else {
#pragma unroll 1
        for (; t + 5 < NT; t += 2) { SUB8(t, true, true, true, (void)0); SUB8(t + 1, true, true, true, (void)0); WAIT_BAR(1); }
#pragma unroll 1
        for (; t + 1 < NT; t += 2) {
            SUB8(t, (t + 4 < NT), (t + 2 < NT), (t + 1 < NT), (void)0); SUB8(t + 1, (t + 5 < NT), (t + 3 < NT), (t + 2 < NT), (void)0); WAIT_BAR(0); }
    }
    SUB8(NT - 1, false, false, false, (void)0);
    {
        asm volatile("s_waitcnt lgkmcnt(0)" ::: "memory");
        vf[0] = ld32(vp0 + s0, c0o, c1o); vf[1] = ld32(vp0 + s0 + 2048, c0o, c1o);
        PV8(); }
    float rli[16];
#pragma unroll
    for (int r = 0; r < 16; ++r) rli[r] = __builtin_amdgcn_rcpf(lacc[r]);
    bf16* Ow = O + qrow0 * DMO + h * D;
    { bf16* stg = (bf16*)(shm + LDS_OST) + wid * 2048;
#pragma unroll
      for (int r = 0; r < 16; ++r) { const int orow = crow(r, hi);
#pragma unroll
        for (int d0 = 0; d0 < 2; ++d0) stg[orow * 64 + d0 * 32 + r32] = __float2bfloat16(o[d0][r] * rli[r]); }
      asm volatile("s_waitcnt lgkmcnt(0)" ::: "memory");
#pragma unroll
      for (int i = 0; i < 4; ++i) { const int row = i * 8 + (lane >> 3), ch = lane & 7; const u32x4 v = *(const u32x4*)(stg + row * 64 + ch * 8); *(u32x4*)(Ow + (long)row * DMO + ch * 8) = v; } }
    asm volatile("s_waitcnt vmcnt(0) lgkmcnt(0)\n\ts_barrier" ::: "memory");
#undef DMA8_K
#undef DMA8_V
#undef ROT8
#undef QK8
#undef PK8
#undef PV8
#undef EXPK8
#undef SUB8
#undef NXT8
}

constexpr int QBW = 512;
__device__ __forceinline__ void attn_unit8w(int b, int h, int qb, const unsigned char* Q8, const unsigned char* K8, const unsigned char* Vt8, bf16* O, char* shm, float negM_) {
    int tid = threadIdx.x; asm volatile("" : "+v"(tid));
    const int lane = tid & 63, r32 = lane & 31, hi = lane >> 5; const int wid = __builtin_amdgcn_readfirstlane(tid >> 6);
    const int q0 = qb * QBW; const int kvh = h / 3; const bool kw = wid < 4;
    const long qrow0 = (long)b * SEQ + q0 + wid * 64;
    const unsigned lds0 = (unsigned)(uintptr_t)shm;
    const int drow = 16 * (wid & 3) + (lane >> 2), dch = (lane & 3) ^ ((drow >> 2) & 3);
    const unsigned char* dsrc = kw ? K8 + ((long)b * LKV + drow) * DMKV + kvh * D + dch * 16 : Vt8 + ((long)(b * NKVH + kvh) * (LKV / 64)) * 4096 + drow * 64 + dch * 16;
    const int dstride = kw ? KVBLK * DMKV : 4096, dlead = kw ? 4 : 2;
    const unsigned ddst = lds0 + (kw ? L8_K : L8_V) + (wid & 3) * 1024;
#define DMA8_K(t, slot) glds16(dsrc + (long)(t) * dstride, (unsigned)__builtin_amdgcn_readfirstlane(ddst + (slot)))
#define DMA8_V(t, slot) glds16(dsrc + (long)(t) * dstride, (unsigned)__builtin_amdgcn_readfirstlane(ddst + (slot)))
    const lds_cptr shm3 = (lds_cptr)shm; const int sw = (r32 >> 2) & 3, c0o = ((2 * hi) ^ sw) * 16, c1o = ((2 * hi + 1) ^ sw) * 16;
    const lds_cptr kp0 = shm3 + L8_K + r32 * 64;
#define vp0 (kp0 + (L8_V - L8_K))
    if (kw) { DMA8_K(0, 0); DMA8_K(1, SLOT8); DMA8_K(2, 2 * SLOT8); DMA8_K(3, 3 * SLOT8); DMA8_K(4, 4 * SLOT8); } else { DMA8_V(0, 0); DMA8_V(1, SLOT8); DMA8_V(2, 2 * SLOT8); }
    const v8i_t qrA = *reinterpret_cast<const v8i_t*>(Q8 + (qrow0 + r32) * DMQ + h * D + hi * 32);
    const v8i_t qrB = *reinterpret_cast<const v8i_t*>(Q8 + (qrow0 + 32 + r32) * DMQ + h * D + hi * 32);
    f32x16 oA0 = f32x16{}, oA1 = f32x16{}, oB0 = f32x16{}, oB1 = f32x16{}, lA = f32x16{}, lB = f32x16{};
    typedef short v2s_t __attribute__((ext_vector_type(2)));
    float pscale = exp2f(-negM_); asm volatile("" : "+v"(pscale));
    const v8i_t ONES8 = (v8i_t){0x38383838, 0x38383838, 0x38383838, 0x38383838, 0x38383838, 0x38383838, 0x38383838, 0x38383838};
    f32x16 c0, c1; v8i_t kf[2], vf[2], pwA = (v8i_t){0, 0, 0, 0, 0, 0, 0, 0}, pwB = (v8i_t){0, 0, 0, 0, 0, 0, 0, 0};
    int s0 = 0, s1 = SLOT8, s2 = 2 * SLOT8, s3 = 3 * SLOT8, s5 = 5 * SLOT8;
#define NXT8(x) (((x) == (NS8 - 1) * SLOT8) ? 0 : (x) + SLOT8)
#define ROT8() do { s0 = s1; s1 = s2; s2 = s3; s3 = NXT8(s3); s5 = NXT8(s5); } while (0)
#define MX8(acc, A, B, SC) acc = __builtin_amdgcn_mfma_scale_f32_32x32x64_f8f6f4(A, B, acc, 0, 0, 0, SC, 1, SC)
#define QKW(QR) do { c0 = __builtin_amdgcn_mfma_scale_f32_32x32x64_f8f6f4(kf[0], QR, f32x16{}, 0, 0, 0, SC_QK, 1, SC_QK); c1 = __builtin_amdgcn_mfma_scale_f32_32x32x64_f8f6f4(kf[1], QR, f32x16{}, 0, 0, 0, SC_QK, 1, SC_QK); } while (0)
#define PK8(P, B, OLD) __builtin_bit_cast(int, __builtin_amdgcn_cvt_scalef32_pk_fp8_f32(__builtin_amdgcn_cvt_scalef32_pk_fp8_f32(__builtin_bit_cast(v2s_t, OLD), P[B], P[B + 1], pscale, false), P[B + 2], P[B + 3], pscale, true))
#define PVW() do { MX8(oA0, pwA, vf[0], SC_PV); MX8(oA1, pwA, vf[1], SC_PV); MX8(lA, pwA, ONES8, SC_PV); MX8(oB0, pwB, vf[0], SC_PV); MX8(oB1, pwB, vf[1], SC_PV); MX8(lB, pwB, ONES8, SC_PV); } while (0)
#define EXPW(PW) do { _Pragma("unroll") for (int r = 0; r < 16; ++r) { c0[r] = __builtin_amdgcn_exp2f(c0[r]); c1[r] = __builtin_amdgcn_exp2f(c1[r]); } \
        PW[0] = PK8(c0, 0, PW[0]); PW[1] = PK8(c0, 4, PW[1]); PW[2] = PK8(c0, 8, PW[2]); PW[3] = PK8(c0, 12, PW[3]); PW[4] = PK8(c1, 0, PW[4]); PW[5] = PK8(c1, 4, PW[5]); PW[6] = PK8(c1, 8, PW[6]); PW[7] = PK8(c1, 12, PW[7]); } while (0)
    WAIT_BAR(0);
    kf[0] = ld32(kp0, c0o, c1o); kf[1] = ld32(kp0 + 2048, c0o, c1o);
    QKW(qrA); EXPW(pwA); SBAR(); QKW(qrB); EXPW(pwB);
    kf[0] = ld32(kp0 + SLOT8, c0o, c1o); kf[1] = ld32(kp0 + SLOT8 + 2048, c0o, c1o);
    WAIT_BAR(0);
#define SUBW(t, GK, GV, GL, STEADY) do { \
    vf[0] = ld32(vp0 + s0, c0o, c1o); vf[1] = ld32(vp0 + s0 + 2048, c0o, c1o); \
    PVW(); \
    if (STEADY) { glds16(dsrc + (long)((t) + dlead) * dstride, (unsigned)__builtin_amdgcn_readfirstlane(ddst + (kw ? s5 : s3))); } \
    else if (kw) { if (GK) { DMA8_K((t) + 4, s5); } } else { if (GV) { DMA8_V((t) + 2, s3); } } \
    QKW(qrA); EXPW(pwA); \
    QKW(qrB); \
    if (GL) { kf[0] = ld32(kp0 + s2, c0o, c1o); kf[1] = ld32(kp0 + s2 + 2048, c0o, c1o); } \
    EXPW(pwB); ROT8(); \
    } while (0)
    int t = 1;
#pragma unroll 1
    for (; t + 5 < NT; t += 2) { SUBW(t, true, true, true, true); SUBW(t + 1, true, true, true, true); WAIT_BAR(1); }
#pragma unroll 1
    for (; t + 1 < NT; t += 2) {
        SUBW(t, (t + 4 < NT), (t + 2 < NT), (t + 1 < NT), false); SUBW(t + 1, (t + 5 < NT), (t + 3 < NT), (t + 2 < NT), false); WAIT_BAR(0); }
    SUBW(NT - 1, false, false, false, false);
    {
        asm volatile("s_waitcnt lgkmcnt(0)" ::: "memory");
        vf[0] = ld32(vp0 + s0, c0o, c1o); vf[1] = ld32(vp0 + s0 + 2048, c0o, c1o);
        PVW(); }
    bf16* stg = (bf16*)(shm + LDS_OST) + wid * 2048;
#define OUTW(O0, O1, L, ROFF) do { bf16* Ow = O + (qrow0 + (ROFF)) * DMO + h * D; \
      _Pragma("unroll") for (int r = 0; r < 16; ++r) { const int orow = crow(r, hi); const float rl = __builtin_amdgcn_rcpf(L[r]); \
        stg[orow * 64 + r32] = __float2bfloat16(O0[r] * rl); stg[orow * 64 + 32 + r32] = __float2bfloat16(O1[r] * rl); } \
      asm volatile("s_waitcnt lgkmcnt(0)" ::: "memory"); \
      _Pragma("unroll") for (int i = 0; i < 4; ++i) { const int row = i * 8 + (lane >> 3), ch = lane & 7; const u32x4 v = *(const u32x4*)(stg + row * 64 + ch * 8); *(u32x4*)(Ow + (long)row * DMO + ch * 8) = v; } \
      asm volatile("s_waitcnt lgkmcnt(0)" ::: "memory"); } while (0)
    OUTW(oA0, oA1, lA, 0); OUTW(oB0, oB1, lB, 32);
    asm volatile("s_waitcnt vmcnt(0) lgkmcnt(0)\n\ts_barrier" ::: "memory");
#undef DMA8_K
#undef DMA8_V
#undef ROT8
#undef MX8
#undef QKW
#undef PK8
#undef PVW
#undef EXPW
#undef SUBW
#undef OUTW
#undef vp0
#undef NXT8
}
#undef SBAR
#undef WAIT_BAR
}

#define XB_TMO      128
#define XB_XCNT(j)  (256  + 64 * (j))
#define XB_XSUB(j)  (1280 + 64 * (j))
#define XB_XGEN(j)  (2304 + 64 * (j))
#define XB_TOP      3328
#define XB_TOPGEN   3392
#define XCD_BAR_WORDS 3456
#define XB_SPIN_CAP (1u << 18)
__device__ __forceinline__ unsigned xb_ld(unsigned* p)              { return __hip_atomic_load(p, __ATOMIC_RELAXED, __HIP_MEMORY_SCOPE_AGENT); }
__device__ __forceinline__ unsigned xb_add(unsigned* p, unsigned v) { return __hip_atomic_fetch_add(p, v, __ATOMIC_RELAXED, __HIP_MEMORY_SCOPE_AGENT); }
__device__ __forceinline__ unsigned xb_xcc_id() { return (unsigned)__builtin_amdgcn_s_getreg((3 << 11) | 20) & 0xFu; }
#define XB_SPIN(cond, bar) do { unsigned _sp = 0; while (cond) { __builtin_amdgcn_s_sleep(1); \
    if ((++_sp & 255u) == 0u) { if (xb_ld(&(bar)[XB_TMO])) break; if (_sp > XB_SPIN_CAP) { atomicAdd(&(bar)[XB_TMO], 1u); break; } } } } while (0)
struct XcdBarrier { unsigned* bar; unsigned x; volatile LAS unsigned* st; };
__device__ __forceinline__ XcdBarrier xcd_barrier_post(unsigned* bar, volatile LAS unsigned* st) {
    XcdBarrier b; b.bar = bar; b.x = xb_xcc_id(); b.st = st;
    if (threadIdx.x == 0) (void)xb_add(&bar[XB_XCNT(b.x)], 1u);
    return b;
}
__device__ __forceinline__ void xcd_barrier_complete(unsigned* bar, unsigned x, unsigned& nloc, unsigned& nx) {
    const unsigned G = gridDim.x * gridDim.y * gridDim.z;
    unsigned sum, cnt, mine, sp = 0u;
    for (;;) {
        sum = 0u; cnt = 0u; mine = 0u;
#pragma unroll
        for (unsigned j = 0; j < 16; ++j) { const unsigned c = xb_ld(&bar[XB_XCNT(j)]); sum += c; cnt += (c > 0u) ? 1u : 0u; mine = (j == x) ? c : mine; }
        if (sum == G) break;
        __builtin_amdgcn_s_sleep(1);
        if ((++sp & 255u) == 0u) { if (xb_ld(&bar[XB_TMO])) break; if (sp > XB_SPIN_CAP) { atomicAdd(&bar[XB_TMO], 1u); break; } }
    }
    nloc = mine > 0u ? mine : 1u; nx = cnt > 0u ? cnt : 1u;
}
__device__ __forceinline__ void xcd_barrier(const XcdBarrier& b) {
    asm volatile("s_waitcnt vmcnt(0)" ::: "memory");
    __syncthreads();
    if (threadIdx.x == 0) {
        unsigned* bar = b.bar;
        __builtin_amdgcn_s_waitcnt(0);
        unsigned nloc = b.st[0], nx = b.st[1];
        if (nloc == 0u) { xcd_barrier_complete(bar, b.x, nloc, nx); b.st[0] = nloc; b.st[1] = nx; }
        const unsigned old = xb_add(&bar[XB_XSUB(b.x)], 1u);
        const unsigned gen = old / nloc;
        if (old + 1u == (gen + 1u) * nloc) {
            __builtin_amdgcn_fence(__ATOMIC_RELEASE, "agent");
            asm volatile("s_waitcnt vmcnt(0)" ::: "memory");
            const unsigned og = xb_add(&bar[XB_TOP], 1u);
            const unsigned tg = og / nx;
            if (og + 1u == (tg + 1u) * nx) xb_add(&bar[XB_TOPGEN], 1u);
            else XB_SPIN(xb_ld(&bar[XB_TOPGEN]) == tg, bar);
            __builtin_amdgcn_fence(__ATOMIC_ACQUIRE, "agent");
            xb_add(&bar[XB_XGEN(b.x)], 1u);
            asm volatile("s_waitcnt vmcnt(0)" ::: "memory");
        } else {
            XB_SPIN(xb_ld(&bar[XB_XGEN(b.x)]) == gen, bar);
            __builtin_amdgcn_fence(__ATOMIC_ACQUIRE, "agent");
            asm volatile("s_waitcnt vmcnt(0)" ::: "memory");
        }
    }
    __syncthreads();
}

struct Frame {
    LAS unsigned char* lds;
    volatile LAS unsigned* MISC;
    gu32* ctl;
    int tid, lane, wave;
    int vcu, G;
    const float* const* ka;
    float* out;
    unsigned char* ws;
};
#define WSP(T, off) ((T*)(F.ws + (off)))
#define FIN_x (F.ka[0])
#define FIN_c (F.ka[1])
#define FIN_ctx (F.ka[2])
#define FIN_c_ctx (F.ka[3])
#define FIN_norm1_g (F.ka[4])
#define FIN_w_ada (F.ka[5])
#define FIN_b_ada (F.ka[6])
#define FIN_w_in (F.ka[7])
#define FIN_w_fourier (F.ka[8])
#define FIN_q_norm_g (F.ka[9])
#define FIN_k_norm_g (F.ka[10])
#define FIN_w_out (F.ka[11])
#define FIN_norm2_g (F.ka[12])
#define FIN_w_router (F.ka[13])
#define FIN_router_bias (F.ka[14])
#define FIN_w_egu (F.ka[15])
#define FIN_w_ed (F.ka[16])
#define FIN_w_sgu (F.ka[17])
#define FIN_w_sd (F.ka[18])
#define FIN_final_g (F.ka[19])

struct DenseOrder {
    static constexpr bool GATHER = false;
    int nN, nmain, nextra, G, c; const char* Bt; int K; int reps;
    __device__ __forceinline__ bool next(int i, pg8::GUnit& u) const {
        const int ntot = nmain + nextra, nc = (ntot - c + G - 1) / G; if (i >= nc * reps) return false;
        const int L = (i % nc) * G + c;
        if (L < nmain) { const int nig = 8 * nN, gid = L / nig, r = L % nig; u.pm = gid * 8 + (r & 7); u.pn = r >> 3; }
        else { const int jx = L - nmain; u.pm = 128 + (jx & 3); u.pn = 5 + (jx >> 2); }
        u.e = 0; u.j = 0; u.nvalid = 256; u.B = Bt + (size_t)u.pn * 256 * K * 2; return true;
    }
    __device__ __forceinline__ int arow(const pg8::GUnit& u, int r) const { return u.pm * 256 + r; }
};
template <bool GATHER_> struct GroupedOrder {
    static constexpr bool GATHER = GATHER_;
    int NPN, G, c, nbrows, K; bool gather; const char* Bt; const LAS int* TS; const LAS int* CN; const GAS u32x2* LIST; int reps; int total;
    __device__ __forceinline__ bool next(int i, pg8::GUnit& u) const {
        const int ntot = total * NPN, nc = (ntot - c + G - 1) / G; if (i >= nc * reps) return false;
        const int L = (i % nc) * G + c; const int T = L / NPN;
        int lo = __builtin_amdgcn_readfirstlane((int)((const LAS unsigned short*)(TS + 640))[T]);
        const int ts = __builtin_amdgcn_readfirstlane(TS[lo]), cn = __builtin_amdgcn_readfirstlane(CN[lo]);
        u.pm = T; u.pn = L - T * NPN; u.e = lo; u.j = T - ts; const int rem = cn - 256 * u.j; u.nvalid = rem < 256 ? rem : 256;
        u.B = Bt + ((size_t)lo * nbrows + (size_t)u.pn * 256) * K; return true;
    }
    __device__ __forceinline__ int arow(const pg8::GUnit& u, int r) const {
        if (!gather) return u.pm * 256 + r;
        int pos = 256 * u.j + r; if (r >= u.nvalid) pos = 0;
        const u32x2 en = LIST[(size_t)u.e * NTOK + pos];
        return (int)(en.x & 0xffffu);
    }
};

struct EpiInProj {
    static constexpr bool PERM = true; static constexpr int NSTORE = 8;
    __device__ __forceinline__ void pre(LAS unsigned char*, const pg8::GUnit&, int, int, int) const {}
    u16 *Z, *Q, *Kb, *Vb; const float *COS, *SIN, *gq, *gk;
    __device__ __forceinline__ void operator()(const f32x4 (&acc)[2][2][4][2], const pg8::GUnit& u, int wr, int wc, int fr, int fq, LAS unsigned char* lds, int ui) const {
        const int pn = u.pn; const bool is_ctx = u.pm >= 128;
        if (ATTN_FP8 && pn == 6) {
            LAS unsigned char* st = lds + pg8::STAGE_BYTES; const int tid = threadIdx.x;
            const int b = is_ctx ? (u.pm - 128) : (u.pm >> 5), kt0 = is_ctx ? (SEQ / 64) : (((u.pm * 256) & (SEQ - 1)) >> 6);
#pragma unroll
            for (int ai = 0; ai < 2; ++ai)
#pragma unroll
                for (int bj = 0; bj < 2; ++bj) {
#pragma unroll
                    for (int m = 0; m < 4; ++m) { const int ks = attn_body::vt_slot(16 * m + fr); const f32x4 v0 = acc[ai][bj][m][0], v1 = acc[ai][bj][m][1];
                        int w0 = __builtin_amdgcn_cvt_pk_fp8_f32(v0[0], v0[1], 0, false); w0 = __builtin_amdgcn_cvt_pk_fp8_f32(v0[2], v0[3], w0, true);
                        int w1 = __builtin_amdgcn_cvt_pk_fp8_f32(v1[0], v1[1], 0, false); w1 = __builtin_amdgcn_cvt_pk_fp8_f32(v1[2], v1[3], w1, true);
#pragma unroll
                        for (int q8 = 0; q8 < 8; ++q8) st[((wr * 128 + 32 * wc + 8 * fq + q8) * 64) + ks] = (unsigned char)(((q8 < 4 ? (unsigned)w0 : (unsigned)w1) >> (8 * (q8 & 3))) & 0xffu); }
                    asm volatile("s_waitcnt lgkmcnt(0)" ::: "memory"); __builtin_amdgcn_s_barrier(); asm volatile("" ::: "memory");
#pragma unroll
                    for (int j = 0; j < 2; ++j) { const int ch = tid + 512 * j, row = ch >> 2, part = ch & 3, col = 128 * bj + (row & 127), kvh = col >> 6, d = col & 63, kt = kt0 + 2 * ai + (row >> 7);
                        const u32x4 v = *(const LAS u32x4*)(st + row * 64 + part * 16);
                        *(u32x4*)((unsigned char*)Vb + ((((size_t)(b * NKVH + kvh) * (LKV / 64) + kt) * 64 + d) * 64) + part * 16) = v; }
                    asm volatile("s_waitcnt lgkmcnt(0)" ::: "memory"); __builtin_amdgcn_s_barrier(); asm volatile("" ::: "memory");
                }
            return;
        }
        float gn[2][2][4];
        if (pn >= 2 && pn < 6) { const float* gsrc = (pn == 5) ? gk : gq;
#pragma unroll
            for (int bj = 0; bj < 2; ++bj)
#pragma unroll
                for (int n = 0; n < 2; ++n) { const f32x4 g4 = *(const f32x4*)(gsrc + 32 * bj + 16 * n + 4 * fq); gn[bj][n][0] = g4[0]; gn[bj][n][1] = g4[1]; gn[bj][n][2] = g4[2]; gn[bj][n][3] = g4[3]; } }
#pragma unroll
        for (int ai = 0; ai < 2; ++ai)
#pragma unroll
            for (int m = 0; m < 4; ++m) {
                const int row = u.pm * 256 + ai * 128 + wr * 64 + m * 16 + fr;
                int b, l, key;
                if (!is_ctx) { b = row >> 13; l = row & 8191; key = l; } else { const int rc = row - NTOK; b = rc >> 8; l = 0; key = SEQ + (rc & 255); }
                if (pn < 2) {
#pragma unroll
                    for (int bj = 0; bj < 2; ++bj) { const int g = 32 * pn + 16 * bj + 4 * wc + fq; const f32x4 v0 = acc[ai][bj][m][0], v1 = acc[ai][bj][m][1];
                        u32x4 w; w.x = cvt_pk_bf16(v0[0], v0[1]); w.y = cvt_pk_bf16(v0[2], v0[3]); w.z = cvt_pk_bf16(v1[0], v1[1]); w.w = cvt_pk_bf16(v1[2], v1[3]);
                        *(u32x4*)(Z + (((size_t)(b * 64 + g) * SEQ + l) * 8)) = w; }
                } else if (pn < 6) {
                    float ss = 0.f;
#pragma unroll
                    for (int bj = 0; bj < 2; ++bj)
#pragma unroll
                        for (int n = 0; n < 2; ++n) { const f32x4 v = acc[ai][bj][m][n]; ss += (v[0] * v[0] + v[1] * v[1]) + (v[2] * v[2] + v[3] * v[3]); }
                    ss += __shfl_xor(ss, 16); ss += __shfl_xor(ss, 32);
                    const float rstd = 1.0f / sqrtf(ss * (1.0f / 64.0f) + RMS_EPS);
                    const float osc = (pn == 5) ? 1.0f : C2;
#pragma unroll
                    for (int bj = 0; bj < 2; ++bj) {
                        const int pidx = (bj == 0) ? (l >> 6) : (l & 63);
                        f32x4 cs = *(const f32x4*)(COS + pidx * 16 + 4 * fq), sn = *(const f32x4*)(SIN + pidx * 16 + 4 * fq);
                        if (is_ctx) { cs = (f32x4){1.f, 1.f, 1.f, 1.f}; sn = (f32x4){0.f, 0.f, 0.f, 0.f}; }
                        float oa[4], ob[4];
#pragma unroll
                        for (int e = 0; e < 4; ++e) { const float a = acc[ai][bj][m][0][e] * rstd * gn[bj][0][e], bb = acc[ai][bj][m][1][e] * rstd * gn[bj][1][e];
                            oa[e] = (a * cs[e] - bb * sn[e]) * osc; ob[e] = (bb * cs[e] + a * sn[e]) * osc; }
                        if (ATTN_FP8) {
                            const float f8s = (pn < 5) ? Q8_SCALE : 1.0f;
                            int w0 = __builtin_amdgcn_cvt_pk_fp8_f32(oa[0] * f8s, oa[1] * f8s, 0, false); w0 = __builtin_amdgcn_cvt_pk_fp8_f32(oa[2] * f8s, oa[3] * f8s, w0, true);
                            int w1 = __builtin_amdgcn_cvt_pk_fp8_f32(ob[0] * f8s, ob[1] * f8s, 0, false); w1 = __builtin_amdgcn_cvt_pk_fp8_f32(ob[2] * f8s, ob[3] * f8s, w1, true);
                            if (pn < 5) { const int head = 4 * (pn - 2) + wc; *(u32x2*)((unsigned char*)Q + ((size_t)row * QW + head * 64 + 32 * bj + 8 * fq)) = (u32x2){(unsigned)w0, (unsigned)w1}; }
                            else *(u32x2*)((unsigned char*)Kb + (((size_t)b * LKV + key) * KVW + wc * 64 + 32 * bj + 8 * fq)) = (u32x2){(unsigned)w0, (unsigned)w1};
                        } else {
                        u32x4 w; w.x = cvt_pk_bf16(oa[0], oa[1]); w.y = cvt_pk_bf16(oa[2], oa[3]); w.z = cvt_pk_bf16(ob[0], ob[1]); w.w = cvt_pk_bf16(ob[2], ob[3]);
                        if (pn < 5) { const int head = 4 * (pn - 2) + wc; *(u32x4*)(Q + ((size_t)row * QW + head * 64 + 32 * bj + 8 * fq)) = w; }
                        else *(u32x4*)(Kb + (((size_t)b * LKV + key) * KVW + wc * 64 + 32 * bj + 8 * fq)) = w; }
                    }
                } else {
#pragma unroll
                    for (int bj = 0; bj < 2; ++bj) { const f32x4 v0 = acc[ai][bj][m][0], v1 = acc[ai][bj][m][1];
                        if (ATTN_FP8) {
                            const int kt = key >> 6, ks = attn_body::vt_slot(key & 63);
                            int w0 = __builtin_amdgcn_cvt_pk_fp8_f32(v0[0], v0[1], 0, false); w0 = __builtin_amdgcn_cvt_pk_fp8_f32(v0[2], v0[3], w0, true);
                            int w1 = __builtin_amdgcn_cvt_pk_fp8_f32(v1[0], v1[1], 0, false); w1 = __builtin_amdgcn_cvt_pk_fp8_f32(v1[2], v1[3], w1, true);
#pragma unroll
                            for (int q8 = 0; q8 < 8; ++q8) { const int col = 128 * bj + 32 * wc + 8 * fq + q8, kvh = col >> 6, d = col & 63;
                                ((unsigned char*)Vb)[((((size_t)(b * NKVH + kvh) * (LKV / 64) + kt) * 64 + d) * 64) + ks] = (unsigned char)(((q8 < 4 ? (unsigned)w0 : (unsigned)w1) >> (8 * (q8 & 3))) & 0xffu); }
                        } else {
                        u32x4 w; w.x = cvt_pk_bf16(v0[0], v0[1]); w.y = cvt_pk_bf16(v0[2], v0[3]); w.z = cvt_pk_bf16(v1[0], v1[1]); w.w = cvt_pk_bf16(v1[2], v1[3]);
                        *(u32x4*)(Vb + (((size_t)b * LKV + key) * KVW + 128 * bj + 32 * wc + 8 * fq)) = w; } }
                }
            }
    }
};
struct EpiResid {
    static constexpr bool PERM = false; static constexpr int NSTORE = 32;
    __device__ __forceinline__ void pre(LAS unsigned char*, const pg8::GUnit&, int, int, int) const {}
    const float* x; float* X1; const gi64* MOD;
    __device__ __forceinline__ void operator()(const f32x4 (&acc)[2][2][4][2], const pg8::GUnit& u, int wr, int wc, int fr, int fq, LAS unsigned char* lds, int ui) const {
        const int row0 = u.pm * 256 + wr * 64 + fr, col0 = u.pn * 256 + wc * 32 + 4 * fq; const int b = (u.pm * 256) >> 13;
        f32x4 gv[2][2];
#pragma unroll
        for (int bj = 0; bj < 2; ++bj)
#pragma unroll
            for (int n = 0; n < 2; ++n) gv[bj][n] = mod4(MOD, b * 6144 + 2048 + col0 + bj * 128 + n * 16);
#pragma unroll
        for (int ai = 0; ai < 2; ++ai)
#pragma unroll
            for (int m = 0; m < 4; ++m) { const size_t off = (size_t)(row0 + ai * 128 + m * 16) * DM + col0;
#pragma unroll
                for (int bj = 0; bj < 2; ++bj)
#pragma unroll
                    for (int n = 0; n < 2; ++n) { const f32x4 xv = *(const f32x4*)(x + off + bj * 128 + n * 16); *(f32x4*)(X1 + off + bj * 128 + n * 16) = (DBG & 2) ? xv : xv + gv[bj][n] * acc[ai][bj][m][n]; } }
    }
};
struct EpiLogits {
    static constexpr bool PERM = false; static constexpr int NSTORE = 32;
    __device__ __forceinline__ void pre(LAS unsigned char*, const pg8::GUnit&, int, int, int) const {}
    float* C;
    __device__ __forceinline__ void operator()(const f32x4 (&acc)[2][2][4][2], const pg8::GUnit& u, int wr, int wc, int fr, int fq, LAS unsigned char* lds, int ui) const {
        const int row0 = u.pm * 256 + wr * 64 + fr, col0 = wc * 32 + 4 * fq;
#pragma unroll
        for (int ai = 0; ai < 2; ++ai)
#pragma unroll
            for (int m = 0; m < 4; ++m) { float* rowp = C + (size_t)(row0 + ai * 128 + m * 16) * NEXP + col0;
#pragma unroll
                for (int bj = 0; bj < 2; ++bj)
#pragma unroll
                    for (int n = 0; n < 2; ++n) *(f32x4*)(rowp + bj * 128 + n * 16) = acc[ai][bj][m][n]; }
    }
};
struct EpiSwiglu {
    static constexpr bool PERM = true; static constexpr int NSTORE = 16;
    __device__ __forceinline__ void pre(LAS unsigned char*, const pg8::GUnit&, int, int, int) const {}
    u16* ACT;
    __device__ __forceinline__ void operator()(const f32x4 (&acc)[2][2][4][2], const pg8::GUnit& u, int wr, int wc, int fr, int fq, LAS unsigned char* lds, int ui) const {
#pragma unroll
        for (int ai = 0; ai < 2; ++ai)
#pragma unroll
            for (int m = 0; m < 4; ++m) { const int r = ai * 128 + wr * 64 + m * 16 + fr; u16* rowp = ACT + ((size_t)u.pm * 256 + r) * EFF + 128 * u.pn + 16 * wc + 4 * fq;
#pragma unroll
                for (int bj = 0; bj < 2; ++bj) { const f32x4 a = acc[ai][bj][m][0], g = acc[ai][bj][m][1]; float o[4];
#pragma unroll
                    for (int e = 0; e < 4; ++e) o[e] = a[e] * g[e] / (1.0f + __expf(-a[e]));
                    if (MOE_FP8) { int w0 = __builtin_amdgcn_cvt_pk_fp8_f32(o[0], o[1], 0, false); w0 = __builtin_amdgcn_cvt_pk_fp8_f32(o[2], o[3], w0, true);
                        *(unsigned*)((unsigned char*)ACT + ((size_t)u.pm * 256 + r) * EFF + 128 * u.pn + 16 * wc + 4 * fq + 64 * bj) = (unsigned)w0; }
                    else { u32x2 w; if (MOEF16) { w.x = pk2h(o[0], o[1]); w.y = pk2h(o[2], o[3]); } else { w.x = pk2bf(o[0], o[1]); w.y = pk2bf(o[2], o[3]); } *(u32x2*)(rowp + 64 * bj) = w; } } }
    }
};
struct EpiDown {
    static constexpr bool PERM = true; static constexpr int NSTORE = 16;
    u16* Cc; const GAS u32x2* LIST; unsigned char* dump;
    __device__ __forceinline__ void pre(LAS unsigned char* lds, const pg8::GUnit& u, int ui, int wid, int lane) const {
        if (wid < 2) __builtin_amdgcn_global_load_lds((const unsigned*)(LIST + (size_t)u.e * NTOK + 256 * u.j + 128 * wid + 2 * lane), (LAS unsigned*)(lds + pg8::STAGE_BYTES + (ui & 1) * 2048 + wid * 1024), 16, 0, 0);
    }
    __device__ __forceinline__ void operator()(const f32x4 (&acc)[2][2][4][2], const pg8::GUnit& u, int wr, int wc, int fr, int fq, LAS unsigned char* lds, int ui) const {
        const LAS f32x2* ent = (const LAS f32x2*)(lds + pg8::STAGE_BYTES + (ui & 1) * 2048);
#pragma unroll
        for (int ai = 0; ai < 2; ++ai)
#pragma unroll
            for (int m = 0; m < 4; ++m) { const int r = ai * 128 + wr * 64 + m * 16 + fr;
                const f32x2 enf = ent[r];
                const unsigned ex = __builtin_bit_cast(unsigned, enf.x); const int tok = (int)(ex & 0x7fffu), slot = (int)((ex >> 16) & 15u); const float gate = enf.y;
                unsigned char* rowp = (unsigned char*)Cc + ((size_t)tok * NSLOT + slot) * DM + 256 * u.pn + 32 * wc + 8 * fq;
                if (r >= u.nvalid) rowp = dump + ((size_t)(blockIdx.x * 512 + threadIdx.x)) * 256;
                const float gs = gate * C_SCALE;
#pragma unroll
                for (int bj = 0; bj < 2; ++bj) { f32x4 v0 = acc[ai][bj][m][0] * gs, v1 = acc[ai][bj][m][1] * gs;
#pragma unroll
                    for (int e = 0; e < 4; ++e) { v0[e] = __builtin_amdgcn_fmed3f(v0[e], -440.f, 440.f); v1[e] = __builtin_amdgcn_fmed3f(v1[e], -440.f, 440.f); }
                    int w0 = __builtin_amdgcn_cvt_pk_fp8_f32(v0[0], v0[1], 0, false); w0 = __builtin_amdgcn_cvt_pk_fp8_f32(v0[2], v0[3], w0, true);
                    int w1 = __builtin_amdgcn_cvt_pk_fp8_f32(v1[0], v1[1], 0, false); w1 = __builtin_amdgcn_cvt_pk_fp8_f32(v1[2], v1[3], w1, true);
                    *(u32x2*)(rowp + 128 * bj) = (u32x2){(unsigned)w0, (unsigned)w1}; } }
    }
};

template <bool F16OUT, bool F8OUT2 = false> __device__ __forceinline__ void rownorm_rows(const GAS float* src, const float* gain, const gi64* MODsh, const gi64* MODsc, u16* dst, int row0, int nrows, int wi, int wstride, int lane, unsigned char* dst8 = nullptr) {
    f32x4 Av[2][2], Bv[2][2];
#pragma unroll
    for (int j = 0; j < 2; ++j)
#pragma unroll
        for (int h = 0; h < 2; ++h) { const int col = 8 * lane + 512 * j + 4 * h; Av[j][h] = *(const f32x4*)(gain + col) * (mod4(MODsc, col) + 1.0f); Bv[j][h] = mod4(MODsh, col); }
    for (int r = wi; r < nrows; r += 2 * wstride) {
        const int r1 = r + wstride; const bool has1 = r1 < nrows;
        const GAS float* s0 = src + (size_t)(row0 + r) * DM; const GAS float* s1 = src + (size_t)(row0 + (has1 ? r1 : r)) * DM;
        f32x4 v0[2][2], v1[2][2];
#pragma unroll
        for (int j = 0; j < 2; ++j)
#pragma unroll
            for (int h = 0; h < 2; ++h) { v0[j][h] = *(const GAS f32x4*)(s0 + 8 * lane + 512 * j + 4 * h); v1[j][h] = *(const GAS f32x4*)(s1 + 8 * lane + 512 * j + 4 * h); }
        float q0 = 0.f, q1 = 0.f;
#pragma unroll
        for (int j = 0; j < 2; ++j)
#pragma unroll
            for (int h = 0; h < 2; ++h) { const f32x4 a = v0[j][h], b = v1[j][h]; q0 += (a[0] * a[0] + a[1] * a[1]) + (a[2] * a[2] + a[3] * a[3]); q1 += (b[0] * b[0] + b[1] * b[1]) + (b[2] * b[2] + b[3] * b[3]); }
#pragma unroll
        for (int o = 1; o < 64; o <<= 1) { q0 += __shfl_xor(q0, o); q1 += __shfl_xor(q1, o); }
        const float rs0 = 1.0f / sqrtf(q0 * (1.0f / DM) + RMS_EPS), rs1 = 1.0f / sqrtf(q1 * (1.0f / DM) + RMS_EPS);
#pragma unroll
        for (int j = 0; j < 2; ++j) { const f32x4 ya = v0[j][0] * rs0 * Av[j][0] + Bv[j][0], yb = v0[j][1] * rs0 * Av[j][1] + Bv[j][1];
            u32x4 w; if (F16OUT) { w.x = pk2h(ya[0], ya[1]); w.y = pk2h(ya[2], ya[3]); w.z = pk2h(yb[0], yb[1]); w.w = pk2h(yb[2], yb[3]); } else { w.x = pk2bf(ya[0], ya[1]); w.y = pk2bf(ya[2], ya[3]); w.z = pk2bf(yb[0], yb[1]); w.w = pk2bf(yb[2], yb[3]); }
            *(GAS u32x4*)(dst + (size_t)(row0 + r) * DM + 8 * lane + 512 * j) = w;
            if (F8OUT2) { int w0 = __builtin_amdgcn_cvt_pk_fp8_f32(ya[0], ya[1], 0, false); w0 = __builtin_amdgcn_cvt_pk_fp8_f32(ya[2], ya[3], w0, true); int w1 = __builtin_amdgcn_cvt_pk_fp8_f32(yb[0], yb[1], 0, false); w1 = __builtin_amdgcn_cvt_pk_fp8_f32(yb[2], yb[3], w1, true);
                *(GAS u32x2*)(dst8 + (size_t)(row0 + r) * DM + 8 * lane + 512 * j) = (u32x2){(unsigned)w0, (unsigned)w1}; } }
        if (has1) {
#pragma unroll
            for (int j = 0; j < 2; ++j) { const f32x4 ya = v1[j][0] * rs1 * Av[j][0] + Bv[j][0], yb = v1[j][1] * rs1 * Av[j][1] + Bv[j][1];
                u32x4 w; if (F16OUT) { w.x = pk2h(ya[0], ya[1]); w.y = pk2h(ya[2], ya[3]); w.z = pk2h(yb[0], yb[1]); w.w = pk2h(yb[2], yb[3]); } else { w.x = pk2bf(ya[0], ya[1]); w.y = pk2bf(ya[2], ya[3]); w.z = pk2bf(yb[0], yb[1]); w.w = pk2bf(yb[2], yb[3]); }
                *(GAS u32x4*)(dst + (size_t)(row0 + r1) * DM + 8 * lane + 512 * j) = w;
                if (F8OUT2) { int w0 = __builtin_amdgcn_cvt_pk_fp8_f32(ya[0], ya[1], 0, false); w0 = __builtin_amdgcn_cvt_pk_fp8_f32(ya[2], ya[3], w0, true); int w1 = __builtin_amdgcn_cvt_pk_fp8_f32(yb[0], yb[1], 0, false); w1 = __builtin_amdgcn_cvt_pk_fp8_f32(yb[2], yb[3], w1, true);
                    *(GAS u32x2*)(dst8 + (size_t)(row0 + r1) * DM + 8 * lane + 512 * j) = (u32x2){(unsigned)w0, (unsigned)w1}; } } }
    }
}

__device__ __forceinline__ void p0_phase(Frame& F) {
    const int gw = F.vcu * 8 + F.wave, NGW = F.G * 8, lane = F.lane;
    unsigned long long* MODQ = (unsigned long long*)(F.ctl + CW_MOD);
    for (int it = gw; it < 1536; it += NGW) {
        const int cb = it % 24, kc = it / 24, k0 = kc * 16, col = cb * 256 + lane * 4;
        float sv[5];
#pragma unroll
        for (int r = 0; r < 5; ++r) { const float cv = (r < 4) ? FIN_c[r * DM + k0 + (lane & 15)] : FIN_c_ctx[k0 + (lane & 15)]; sv[r] = cv / (1.0f + __expf(-cv)); }
        f32x4 acc[5];
#pragma unroll
        for (int r = 0; r < 5; ++r) acc[r] = (f32x4){0.f, 0.f, 0.f, 0.f};
#pragma unroll
        for (int kk = 0; kk < 16; ++kk) { const f32x4 w = *(const f32x4*)(FIN_w_ada + (size_t)(k0 + kk) * 6144 + col);
#pragma unroll
            for (int r = 0; r < 5; ++r) { const float s = __builtin_bit_cast(float, __builtin_amdgcn_readlane(__builtin_bit_cast(int, sv[r]), kk)); acc[r] += w * s; } }
        if (kc == 0) { const f32x4 bv = *(const f32x4*)(FIN_b_ada + col);
#pragma unroll
            for (int r = 0; r < 5; ++r) acc[r] += bv; }
#pragma unroll
        for (int r = 0; r < 5; ++r)
#pragma unroll
            for (int j = 0; j < 4; ++j) atomicAdd(MODQ + r * 6144 + col + j, (unsigned long long)__float2ll_rn(acc[r][j] * 0x1p36f));
    }
    float* WCS = WSP(float, WS_TAB);
    for (int it = gw; it < 256; it += NGW) {
        const int fh = it >> 6, d = it & 63; float ac = 0.f, as = 0.f;
        const float ctab = cospif((float)lane * (1.0f / 32.0f)), stab = sinpif((float)lane * (1.0f / 32.0f));
        for (int k2 = 0; k2 < 64; ++k2) { const int mm = __builtin_amdgcn_readfirstlane((d * k2) & 63); const float w = FIN_w_fourier[(fh * 64 + k2) * 64 + lane]; ac += rdl(ctab, mm) * w; as += rdl(stab, mm) * w; }
        const float sc = 1.0f / sqrtf((float)SEQ * 64.0f);
        WCS[(fh * 64 + d) * 128 + lane] = ac * sc; WCS[(fh * 64 + d) * 128 + 64 + lane] = as * sc;
    }
    {
        u16* D1 = WSP(u16, WS_TAB + 144 * 1024); u16* D3 = WSP(u16, WS_TAB + 272 * 1024);
        for (int it = gw; it < 320; it += NGW) {
            if (it < 256) { const int ro = it >> 7, k1 = it & 127;
#pragma unroll
                for (int j = 0; j < 4; ++j) { const int col = lane + 64 * j, ri = col >> 7, n1 = col & 127, mm = (n1 * k1) & 127; const float cc = cospif((float)mm * (1.0f / 64.0f)), ss = sinpif((float)mm * (1.0f / 64.0f));
                    const float v = (ro == 0) ? (ri == 0 ? cc : -ss) : (ri == 0 ? -ss : -cc); D1[it * 256 + col] = (u16)f2bf(v); } }
            else { const int k2 = it - 256;
#pragma unroll
                for (int j = 0; j < 2; ++j) { const int col = lane + 64 * j, ri = col >> 6, n2 = col & 63, mm = (n2 * k2) & 63; const float v = (ri == 0) ? cospif((float)mm * (1.0f / 32.0f)) : sinpif((float)mm * (1.0f / 32.0f)); D3[k2 * 128 + col] = (u16)f2bf(v); } }
        }
    }
    float* COS = WSP(float, WS_TAB + 128 * 1024); float* SIN = WSP(float, WS_TAB + 136 * 1024);
    for (int it = gw; it < 32; it += NGW) { const int idx = it * 64 + lane, pos = idx >> 4, i = idx & 15;
        const float inv = powf(10000.0f, -(float)i / 16.0f), ang = (float)pos * inv; COS[idx] = cosf(ang); SIN[idx] = sinf(ang); }
}

__device__ __forceinline__ int map_row(int mode, int sc) {
    if (mode == 1) { const int head = sc >> 6, dim = sc & 63, bj = dim >> 5, n = (dim >> 4) & 1, i = dim & 15; return (head >> 2) * 256 + bj * 128 + (head & 3) * 32 + (i >> 2) * 8 + n * 4 + (i & 3); }
    if (mode == 2) { const int g = sc >> 8, a = sc & 255; return (a >> 2) * 8 + g * 4 + (a & 3); }
    return sc;
}
struct TItem { const float* src; u16* dst; int N, K, k0, rel_c0, mode, dst_off; bool f16; bool f8; float ws; };
__device__ __forceinline__ void titem_load(const TItem& t, float (&buf)[64], int lane) {
#pragma unroll
    for (int i = 0; i < 64; ++i) { const int kk = 2 * i + (lane >> 5); buf[i] = t.src[(size_t)kk * t.N + (lane & 31)]; }
}
__device__ __forceinline__ void titem_finish(const TItem& t, const float (&buf)[64], LAS float* scr, int lane) {
#pragma unroll
    for (int i = 0; i < 64; ++i) { const int kk = 2 * i + (lane >> 5); scr[kk * 33 + (lane & 31)] = buf[i]; }
    LDS_WAIT(); asm volatile("" ::: "memory");
    if (t.f8) { const int c = lane & 7; const float ws = t.ws;
#pragma unroll
        for (int j = 0; j < 4; ++j) { const int n = (lane >> 3) + 8 * j; const LAS float* s = scr + (16 * c) * 33 + n; int w[4];
#pragma unroll
            for (int q = 0; q < 4; ++q) { w[q] = __builtin_amdgcn_cvt_pk_fp8_f32(s[(4 * q) * 33] * ws, s[(4 * q + 1) * 33] * ws, 0, false); w[q] = __builtin_amdgcn_cvt_pk_fp8_f32(s[(4 * q + 2) * 33] * ws, s[(4 * q + 3) * 33] * ws, w[q], true); }
            const int drow = t.dst_off + map_row(t.mode, t.rel_c0 + n);
            *(GAS u32x4*)((unsigned char*)t.dst + (size_t)drow * t.K + t.k0 + 16 * c) = (u32x4){(unsigned)w[0], (unsigned)w[1], (unsigned)w[2], (unsigned)w[3]}; } }
    else { const int c = lane & 15;
#pragma unroll
        for (int j = 0; j < 8; ++j) { const int n = (lane >> 4) + 4 * j; const LAS float* s = scr + (8 * c) * 33 + n;
            u32x4 o;
            if (t.f16) { o.x = pk2h(s[0 * 33], s[1 * 33]); o.y = pk2h(s[2 * 33], s[3 * 33]); o.z = pk2h(s[4 * 33], s[5 * 33]); o.w = pk2h(s[6 * 33], s[7 * 33]); }
            else { o.x = pk2bf(s[0 * 33], s[1 * 33]); o.y = pk2bf(s[2 * 33], s[3 * 33]); o.z = pk2bf(s[4 * 33], s[5 * 33]); o.w = pk2bf(s[6 * 33], s[7 * 33]); }
            const int drow = t.dst_off + map_row(t.mode, t.rel_c0 + n);
            *(GAS u32x4*)(t.dst + (size_t)drow * t.K + t.k0 + 8 * c) = o; } }
    LDS_WAIT(); asm volatile("" ::: "memory");
}
constexpr int I_FOLD = 512, I_QKV = 8 * 40, I_OUT = 8 * 32, I_R = 8 * 8, I_GU = NEXPS * 8 * 16, I_D = NEXPS * 2 * 32;
constexpr int NT_EARLY = I_QKV + I_OUT + I_R, NT_ITEMS = NT_EARLY + I_GU + I_D;
constexpr int DEFER_A = 3840, DEFER_B = 4096;
#define TDECODE(it_, t) do { int r = (it_); u16* BIN = WSP(u16, WS_BIN); \
        if (r < I_QKV) { const int kb = r / 40, nb = r % 40, sc0 = 256 + 32 * nb; t.N = 1536; t.K = DM; t.k0 = kb * 128; t.f16 = false; t.f8 = false; t.ws = 1.f; t.dst = BIN; t.src = FIN_w_in + (size_t)(kb * 128) * 1536 + sc0; \
            if (sc0 < 1024) { t.rel_c0 = sc0 - 256; t.mode = 1; t.dst_off = 512; } else if (sc0 < 1280) { t.rel_c0 = sc0 - 1024; t.mode = 1; t.dst_off = 1280; } else { t.rel_c0 = sc0 - 1280; t.mode = 0; t.dst_off = 1536; } \
            break; } \
        r -= I_QKV; \
        if (r < I_OUT) { const int kb = r / 32, nb = r % 32; t.N = DM; t.K = DM; t.k0 = kb * 128; t.f16 = false; t.f8 = false; t.ws = 1.f; t.dst = WSP(u16, WS_BOUT); t.src = FIN_w_out + (size_t)(kb * 128) * DM + 32 * nb; t.rel_c0 = 32 * nb; t.mode = 0; t.dst_off = 0; break; } \
        r -= I_OUT; \
        if (r < I_R) { const int kb = r / 8, nb = r % 8; t.N = NEXP; t.K = DM; t.k0 = kb * 128; t.f16 = (MOE_FP8 ? false : MOEF16); t.f8 = false; t.ws = 1.f; t.dst = WSP(u16, WS_BR); t.src = FIN_w_router + (size_t)(kb * 128) * NEXP + 32 * nb; t.rel_c0 = 32 * nb; t.mode = 0; t.dst_off = 0; break; } \
        r -= I_R; \
        if (r < I_GU) { const int e = r >> 7, q = r & 127, kb = q >> 4, nb = q & 15; const float* W = (e < NEXP) ? FIN_w_egu + (size_t)e * DM * 512 : FIN_w_sgu; \
            t.N = 512; t.K = DM; t.k0 = kb * 128; t.f16 = MOEF16; t.f8 = MOE_FP8; t.ws = WGU_SCALE; t.dst = MOE_FP8 ? (u16*)(F.ws + WS_BGU + (size_t)e * 512 * DM) : WSP(u16, WS_BGU) + (size_t)e * 512 * DM; t.src = W + (size_t)(kb * 128) * 512 + 32 * nb; t.rel_c0 = 32 * nb; t.mode = 2; t.dst_off = 0; break; } \
        r -= I_GU; \
        { const int e = r >> 6, q = r & 63, kb = q >> 5, nb = q & 31; const float* W = (e < NEXP) ? FIN_w_ed + (size_t)e * EFF * DM : FIN_w_sd; \
            t.N = DM; t.K = EFF; t.k0 = kb * 128; t.f16 = MOEF16; t.f8 = MOE_FP8; t.ws = WD_SCALE; t.dst = MOE_FP8 ? (u16*)(F.ws + WS_BD + (size_t)e * DM * EFF) : WSP(u16, WS_BD) + (size_t)e * DM * EFF; t.src = W + (size_t)(kb * 128) * DM + 32 * nb; t.rel_c0 = 32 * nb; t.mode = 0; t.dst_off = 0; } \
    } while (0)
__device__ __forceinline__ void transpose_range(Frame& F, int first, int count, int w, int nw) {
    LAS float* scr = (LAS float*)(F.lds + F.wave * P1_SCR); const int lane = F.lane; const int end = first + count;
    float bufA[64], bufB[64]; TItem ta, tb; int it = first + w;
    if (it < end) { TDECODE(it, ta); titem_load(ta, bufA, lane); }
    while (it < end) {
        const int itb = it + nw; const bool hb = itb < end;
        if (hb) { TDECODE(itb, tb); titem_load(tb, bufB, lane); }
        titem_finish(ta, bufA, scr, lane);
        if (!hb) break;
        const int ita = itb + nw; const bool ha = ita < end;
        if (ha) { TDECODE(ita, ta); titem_load(ta, bufA, lane); }
        titem_finish(tb, bufB, scr, lane);
        it = ita;
    }
}
__device__ __forceinline__ void p1_phase(Frame& F) {
    LAS float* scr = (LAS float*)(F.lds + F.wave * P1_SCR);
    const int gw = F.vcu * 8 + F.wave, NGW = F.G * 8, lane = F.lane;
    u16* BIN = WSP(u16, WS_BIN);
    for (int r = gw; r < I_FOLD; r += NGW) {
        const int fh = r >> 7, cs = (r >> 6) & 1, kb = (r >> 2) & 15, eq = r & 3; const int k = kb * 64 + lane;
        const GAS float* WCS = (const GAS float*)(F.ws + WS_TAB);
#pragma unroll 4
        for (int i = 0; i < 16; ++i) scr[(4 * i + (lane >> 4)) * 16 + (lane & 15)] = WCS[(fh * 64 + 4 * i + (lane >> 4)) * 128 + cs * 64 + 16 * eq + (lane & 15)];
        float wrow[64];
#pragma unroll
        for (int d4 = 0; d4 < 16; ++d4) { const f32x4 v = *(const f32x4*)(FIN_w_in + (size_t)k * 1536 + fh * 64 + 4 * d4); wrow[4 * d4] = v[0]; wrow[4 * d4 + 1] = v[1]; wrow[4 * d4 + 2] = v[2]; wrow[4 * d4 + 3] = v[3]; }
        LDS_WAIT(); asm volatile("" ::: "memory");
        for (int e1 = 0; e1 < 16; ++e1) { float a = 0.f;
#pragma unroll
            for (int d = 0; d < 64; ++d) a += wrow[d] * scr[d * 16 + e1];
            const int col256 = fh * 64 + 16 * eq + e1, pos = 8 * (col256 >> 2) + (col256 & 3) + 4 * cs;
            BIN[(size_t)pos * DM + k] = (u16)f2bf(a); }
        LDS_WAIT(); asm volatile("" ::: "memory");
    }
    const int ndefer = (F.G == 256) ? DEFER_A + DEFER_B : 0;
    REPS(11) transpose_range(F, 0, NT_ITEMS - ndefer, gw, NGW);
    const gi64* MOD = (const gi64*)(F.ctl + CW_MOD);
    u16* XN = WSP(u16, WS_XN);
    REPS(12) { const int wpb = NGW >> 2, b = gw / wpb, wi = gw % wpb;
        rownorm_rows<false>((const GAS float*)FIN_x, FIN_norm1_g, MOD + b * 6144, MOD + b * 6144 + 1024, XN, b * SEQ, SEQ, wi, wpb, lane);
        rownorm_rows<false>((const GAS float*)FIN_ctx, FIN_norm1_g, MOD + 4 * 6144, MOD + 4 * 6144 + 1024, XN + (size_t)NTOK * DM, 0, NCTX, gw, NGW, lane); }
}

__device__ __forceinline__ void fourier_unit(Frame& F, int b, int g) {
    LAS unsigned char* Zl = F.lds + RING_OFF;
    LAS f32x2* TW128 = (LAS f32x2*)(F.lds + TAB_OFF);
    LAS f32x2* TW64 = (LAS f32x2*)(F.lds + TAB_OFF + 1024);
    const int tid = F.tid;
    const GAS u32x4* Zg = (const GAS u32x4*)(F.ws + WS_Z + ((size_t)(b * 64 + g) * SEQ) * 16);
#pragma unroll 4
    for (int i = 0; i < 16; ++i) *(LAS u32x4*)(Zl + (size_t)(i * 512 + tid) * 16) = Zg[i * 512 + tid];
    if (tid < 128) { float s, c; sincospif((float)tid * (1.0f / 64.0f), &s, &c); TW128[tid] = (f32x2){c, s}; }
    else if (tid < 192) { float s, c; sincospif((float)(tid - 128) * (1.0f / 32.0f), &s, &c); TW64[tid - 128] = (f32x2){c, s}; }
    __syncthreads();
    const int k1 = tid & 127, q = tid >> 7;
    float yr[16][4], yi[16][4];
#pragma unroll
    for (int a = 0; a < 16; ++a)
#pragma unroll
        for (int e = 0; e < 4; ++e) { yr[a][e] = 0.f; yi[a][e] = 0.f; }
    for (int n1 = 0; n1 < 128; ++n1) {
        const f32x2 tw = TW128[(n1 * k1) & 127]; const float c = tw.x, s = tw.y;
#pragma unroll
        for (int a = 0; a < 16; ++a) { const u32x4 rw = *(const LAS u32x4*)(Zl + (size_t)(64 * n1 + 16 * q + a) * 16);
            const float uc[4] = {bflo(rw.x), bfhi(rw.x), bflo(rw.y), bfhi(rw.y)}, us[4] = {bflo(rw.z), bfhi(rw.z), bflo(rw.w), bfhi(rw.w)};
#pragma unroll
            for (int e = 0; e < 4; ++e) { yr[a][e] += uc[e] * c - us[e] * s; yi[a][e] -= uc[e] * s + us[e] * c; } }
    }
    __syncthreads();
    int k1b = k1; asm volatile("" : "+v"(k1b));
#pragma unroll
    for (int a = 0; a < 16; ++a) { const int n2 = 16 * q + a; const float fr_ = (float)(n2 * k1b) * (1.0f / 8192.0f);
        const float cp = __builtin_amdgcn_cosf(fr_), sp = __builtin_amdgcn_sinf(fr_);
        float pr[4], pi[4];
#pragma unroll
        for (int e = 0; e < 4; ++e) { pr[e] = yr[a][e] * cp + yi[a][e] * sp; pi[e] = yi[a][e] * cp - yr[a][e] * sp; }
        u32x4 w; w.x = pk2bf(pr[0], pr[1]); w.y = pk2bf(pr[2], pr[3]); w.z = pk2bf(pi[0], pi[1]); w.w = pk2bf(pi[2], pi[3]);
        *(LAS u32x4*)(Zl + (size_t)(n2 * 128 + k1b) * 16) = w; }
    __syncthreads();
    int k1c = k1; asm volatile("" : "+v"(k1c));
    float o[16][4];
#pragma unroll
    for (int a = 0; a < 16; ++a)
#pragma unroll
        for (int e = 0; e < 4; ++e) o[a][e] = 0.f;
    for (int n2 = 0; n2 < 64; ++n2) {
        const u32x4 rw = *(const LAS u32x4*)(Zl + (size_t)(n2 * 128 + k1c) * 16);
        const float pr[4] = {bflo(rw.x), bfhi(rw.x), bflo(rw.y), bfhi(rw.y)}, pi[4] = {bflo(rw.z), bfhi(rw.z), bflo(rw.w), bfhi(rw.w)};
#pragma unroll
        for (int a = 0; a < 16; ++a) { const f32x2 tw = TW64[(n2 * (16 * q + a)) & 63];
#pragma unroll
            for (int e = 0; e < 4; ++e) o[a][e] += pr[e] * tw.x + pi[e] * tw.y; }
    }
    u16* MIX = WSP(u16, WS_MIX);
#pragma unroll
    for (int a = 0; a < 16; ++a) { const int k2 = 16 * q + a; u32x2 w; w.x = pk2bf(o[a][0], o[a][1]); w.y = pk2bf(o[a][2], o[a][3]);
        *(GAS u32x2*)(MIX + ((size_t)(b * SEQ + k1c + 128 * k2)) * DM + 4 * g) = w; }
    __syncthreads();
}

__device__ __forceinline__ attn_body::s16x4 ftr(const LAS unsigned char* p) { return __builtin_bit_cast(attn_body::s16x4, __builtin_amdgcn_ds_read_tr16_b64_v4i16((LAS attn_body::v4i16_t*)p)); }
__device__ __forceinline__ void fourier_unit_mfma(Frame& F, int b, int g) {
    LAS unsigned char* Zl = F.lds + RING_OFF;
    const int tid = F.tid, lane = F.lane, w = F.wave;
    const char* Zg = (const char*)(F.ws + WS_Z) + ((size_t)(b * 64 + g) * SEQ) * 16;
#pragma unroll
    for (int i = 0; i < 16; ++i) __builtin_amdgcn_global_load_lds((const unsigned*)(Zg + (size_t)(i * 512 + tid) * 16), (LAS unsigned*)(Zl + (size_t)(i * 512 + w * 64) * 16), 16, 0, 0);
    VM_WAIT(); __syncthreads();
    f32x4 acc[2][16];
#pragma unroll
    for (int ro = 0; ro < 2; ++ro)
#pragma unroll
        for (int t = 0; t < 16; ++t) acc[ro][t] = (f32x4){0.f, 0.f, 0.f, 0.f};
    const GAS bf16x8* D1 = (const GAS bf16x8*)(F.ws + WS_TAB + 144 * 1024);
    const GAS bf16x8* D3 = (const GAS bf16x8*)(F.ws + WS_TAB + 272 * 1024);
    const int l15 = lane & 15, lq = lane >> 4;
    const unsigned bbase = (unsigned)((64 * (8 * lq + (l15 >> 2)) + (lane & 3)) * 16);
#pragma unroll 1
    for (int s1 = 0; s1 < 8; ++s1) {
        const int ri = s1 >> 2;
        const bf16x8 a0 = D1[(16 * w + l15) * 32 + 4 * s1 + lq], a1 = D1[(128 + 16 * w + l15) * 32 + 4 * s1 + lq];
        const LAS unsigned char* sb = Zl + bbase + (unsigned)((s1 & 3) * 32768 + 8 * ri);
#pragma unroll
        for (int t = 0; t < 16; ++t) { const attn_body::s16x4 lo = ftr(sb + 64 * t), hi = ftr(sb + 64 * t + 4096);
            const bf16x8 bf = (bf16x8){lo[0], lo[1], lo[2], lo[3], hi[0], hi[1], hi[2], hi[3]};
            acc[0][t] = __builtin_amdgcn_mfma_f32_16x16x32_bf16(a0, bf, acc[0][t], 0, 0, 0);
            acc[1][t] = __builtin_amdgcn_mfma_f32_16x16x32_bf16(a1, bf, acc[1][t], 0, 0, 0); }
    }
    __syncthreads();
    {   const int e = lane & 3; int k1b = 16 * w + 4 * lq; asm volatile("" : "+v"(k1b));
#pragma unroll
        for (int t = 0; t < 16; ++t) { const int n2 = 4 * t + (l15 >> 2);
#pragma unroll
            for (int r = 0; r < 4; ++r) { const int k1 = k1b + r; const float fr_ = (float)(n2 * k1) * (1.0f / 8192.0f); const float cp = __builtin_amdgcn_cosf(fr_), sp = __builtin_amdgcn_sinf(fr_);
                const float yr = acc[0][t][r], yi = acc[1][t][r]; const float pr = yr * cp + yi * sp, pi = yi * cp - yr * sp;
                *(LAS u16*)(Zl + (unsigned)(((n2) * 512 + k1 * 4 + e) * 2)) = (u16)f2bf(pr);
                *(LAS u16*)(Zl + (unsigned)(((64 + n2) * 512 + k1 * 4 + e) * 2)) = (u16)f2bf(pi); } }
    }
    asm volatile("s_waitcnt lgkmcnt(0)" ::: "memory");
    f32x4 acc3[4][4];
#pragma unroll
    for (int mt = 0; mt < 4; ++mt)
#pragma unroll
        for (int j = 0; j < 4; ++j) acc3[mt][j] = (f32x4){0.f, 0.f, 0.f, 0.f};
#pragma unroll
    for (int s3 = 0; s3 < 4; ++s3) {
        bf16x8 a[4];
#pragma unroll
        for (int mt = 0; mt < 4; ++mt) a[mt] = D3[(16 * mt + l15) * 16 + 4 * s3 + lq];
        const unsigned kk = (unsigned)(32 * s3 + 8 * lq + (l15 >> 2));
#pragma unroll
        for (int j = 0; j < 4; ++j) { const unsigned ad = kk * 1024u + (unsigned)((4 * (4 * w + j) + (lane & 3)) * 8);
            const attn_body::s16x4 lo = ftr(Zl + ad), hi = ftr(Zl + ad + 4096);
            const bf16x8 bf = (bf16x8){lo[0], lo[1], lo[2], lo[3], hi[0], hi[1], hi[2], hi[3]};
#pragma unroll
            for (int mt = 0; mt < 4; ++mt) acc3[mt][j] = __builtin_amdgcn_mfma_f32_16x16x32_bf16(a[mt], bf, acc3[mt][j], 0, 0, 0); }
    }
    u16* MIX = WSP(u16, WS_MIX);
#pragma unroll
    for (int mt = 0; mt < 4; ++mt)
#pragma unroll
        for (int j = 0; j < 4; ++j)
#pragma unroll
            for (int r = 0; r < 4; ++r) { const int k2 = 16 * mt + 4 * lq + r, k1 = 16 * w + 4 * j + (l15 >> 2);
                MIX[((size_t)(b * SEQ + k1 + 128 * k2)) * DM + 4 * g + (lane & 3)] = (u16)f2bf(acc3[mt][j][r]); }
    __syncthreads();
}

__device__ __forceinline__ float dpp_f(float v, int ctrl_sel) {
    const int x = __builtin_bit_cast(int, v); int r;
    if (ctrl_sel == 0) r = __builtin_amdgcn_update_dpp(x, x, 0xB1, 0xF, 0xF, false);
    else if (ctrl_sel == 1) r = __builtin_amdgcn_update_dpp(x, x, 0x4E, 0xF, 0xF, false);
    else if (ctrl_sel == 2) r = __builtin_amdgcn_update_dpp(x, x, 0x141, 0xF, 0xF, false);
    else r = __builtin_amdgcn_update_dpp(x, x, 0x140, 0xF, 0xF, false);
    return __builtin_bit_cast(float, r);
}
__device__ __forceinline__ void route_token(Frame& F, int tok) {
    const int l = F.lane;
    const f32x4 lg = *(const GAS f32x4*)((const GAS float*)(F.ws + WS_LOG) + (size_t)tok * NEXP + 4 * l);
    const f32x4 bs = *(const f32x4*)(FIN_router_bias + 4 * l);
    float s[4], sel[4];
#pragma unroll
    for (int j = 0; j < 4; ++j) { s[j] = 1.0f / (1.0f + expf(-lg[j])); sel[j] = s[j] + bs[j]; }
    float m1 = fmaxf(sel[0], sel[1]), m2 = fminf(sel[0], sel[1]);
#pragma unroll
    for (int j = 2; j < 4; ++j) { const float v = sel[j]; m2 = fmaxf(m2, fminf(m1, v)); m1 = fmaxf(m1, v); }
#pragma unroll
    for (int st = 0; st < 3; ++st) { const float o1 = dpp_f(m1, st), o2 = dpp_f(m2, st); const float n2 = fmaxf(fminf(m1, o1), fmaxf(m2, o2)); m1 = fmaxf(m1, o1); m2 = n2; }
    const float gs = m1 + m2; const int myg = l >> 3; int rank = 0;
#pragma unroll
    for (int g2 = 0; g2 < 8; ++g2) { const float og = rdl(gs, g2 * 8); rank += (og > gs || (og == gs && g2 < myg)) ? 1 : 0; }
    if (rank >= 4) {
#pragma unroll
        for (int j = 0; j < 4; ++j) sel[j] = -INFINITY; }
    int my_e = 0; float my_s = 0.f, sum = 0.f;
#pragma unroll 1
    for (int k = 0; k < TOPK; ++k) {
        const float lb = fmaxf(fmaxf(sel[0], sel[1]), fmaxf(sel[2], sel[3]));
        float r = lb; r = fmaxf(r, dpp_f(r, 0)); r = fmaxf(r, dpp_f(r, 1)); r = fmaxf(r, dpp_f(r, 2)); r = fmaxf(r, dpp_f(r, 3));
        const float wm = fmaxf(fmaxf(rdl(r, 0), rdl(r, 16)), fmaxf(rdl(r, 32), rdl(r, 48)));
        const unsigned long long mask = __ballot(lb == wm);
        const int wl = __builtin_amdgcn_readfirstlane((int)__ffsll((long long)mask) - 1);
        const int jj = (sel[0] == wm) ? 0 : (sel[1] == wm) ? 1 : (sel[2] == wm) ? 2 : 3;
        const float cand = (jj == 0) ? s[0] : (jj == 1) ? s[1] : (jj == 2) ? s[2] : s[3];
        const int jw = __builtin_amdgcn_readlane(jj, wl); const float wsc = rdl(cand, wl);
        if (l == wl) {
#pragma unroll
            for (int j = 0; j < 4; ++j) if (jw == j) sel[j] = -INFINITY; }
        if (l == k) { my_e = 4 * wl + jw; my_s = wsc; }
        sum += wsc;
    }
    GAS u32x2* LIST = (GAS u32x2*)(F.ws + WS_LIST);
    if (l < TOPK) { const float gate = my_s / sum * 2.5f; const unsigned pos = __hip_atomic_fetch_add((unsigned*)(F.ctl + CW_CNT + my_e), 1u, RLX_AGENT);
        LIST[(size_t)my_e * NTOK + pos] = (u32x2){(unsigned)tok | ((unsigned)l << 16), __builtin_bit_cast(unsigned, gate)}; }
    else if (l == TOPK) LIST[(size_t)NEXP * NTOK + tok] = (u32x2){(unsigned)tok | (8u << 16), __builtin_bit_cast(unsigned, 1.0f)};
}

__device__ __forceinline__ void build_tiles(Frame& F) {
    LAS int* TS = (LAS int*)(F.lds + TAB_OFF + 2048); LAS int* CN = (LAS int*)(F.lds + TAB_OFF + 3200);
    if (F.tid < 64) { const int l = F.tid; int c[5], t[5], tot = 0;
#pragma unroll
        for (int j = 0; j < 5; ++j) { const int e = 5 * l + j; c[j] = (e < NEXPS) ? (int)__hip_atomic_load((unsigned*)(F.ctl + CW_CNT + e), RLX_AGENT) : 0; t[j] = (c[j] + 255) >> 8; tot += t[j]; }
        int x = tot;
#pragma unroll
        for (int off = 1; off < 64; off <<= 1) { const int v = __shfl_up(x, off); if (l >= off) x += v; }
        int run = x - tot;
#pragma unroll
        for (int j = 0; j < 5; ++j) { const int e = 5 * l + j; if (e <= NEXPS) { TS[e] = run; if (e < NEXPS) CN[e] = c[j]; } run += t[j]; }
    }
    __syncthreads();
    {
        LAS unsigned short* TEXP = (LAS unsigned short*)(F.lds + TAB_OFF + 4608);
        for (int e = F.tid; e < NEXPS; e += 512) { const int t0 = TS[e], t1 = TS[e + 1]; for (int T = t0; T < t1; ++T) TEXP[T] = (unsigned short)e; }
    }
    __syncthreads();
}

__device__ __forceinline__ void ph2(Frame& F) {
    const gi64* MOD = (const gi64*)(F.ctl + CW_MOD); const int gw = F.vcu * 8 + F.wave, NGW = F.G * 8; (void)MOD; (void)gw; (void)NGW;
        DenseOrder S{7, 128 * 7, 8, F.G, F.vcu, (const char*)(F.ws + WS_BIN), DM, (REP == 22) ? 2 : 1};
        EpiInProj E{WSP(u16, WS_Z), WSP(u16, WS_Q), WSP(u16, WS_K), WSP(u16, WS_V), WSP(float, WS_TAB + 128 * 1024), WSP(float, WS_TAB + 136 * 1024), FIN_q_norm_g, FIN_k_norm_g};
        pg8::gemm_phase<EpiInProj, DenseOrder, 0, true>(F.lds + RING_OFF, (const char*)(F.ws + WS_XN), DM, S, E);
        if (F.G == 256 && F.vcu >= 136) transpose_range(F, NT_ITEMS - DEFER_A - DEFER_B, DEFER_A, (F.vcu - 136) * 8 + F.wave, 120 * 8);
    }
__device__ __forceinline__ void ph4(Frame& F) {
    const gi64* MOD = (const gi64*)(F.ctl + CW_MOD); const int gw = F.vcu * 8 + F.wave, NGW = F.G * 8; (void)MOD; (void)gw; (void)NGW;
        if (DBG & 128) { GAS u32x4* zH = (GAS u32x4*)(F.ws + WS_H2); const size_t nH = (size_t)NTOK * DM * 2 / 16; for (size_t i = (size_t)blockIdx.x * 512 + F.tid; i < nH; i += (size_t)F.G * 512) zH[i] = (u32x4){0u, 0u, 0u, 0u}; }
        DenseOrder S{4, 128 * 4, 0, F.G, F.vcu, (const char*)(F.ws + WS_BOUT), DM, 1};
        EpiResid E{FIN_x, F.out, MOD};
        pg8::gemm_phase<EpiResid, DenseOrder, 0, true>(F.lds + RING_OFF, (const char*)(F.ws + WS_MIX), DM, S, E);
    }
__device__ __forceinline__ void ph5(Frame& F) {
    const gi64* MOD = (const gi64*)(F.ctl + CW_MOD); const int gw = F.vcu * 8 + F.wave, NGW = F.G * 8;
    const int wpb = NGW >> 2, b = gw / wpb, wi = gw % wpb;
    rownorm_rows<(MOE_FP8 ? false : MOEF16), MOE_FP8>((const GAS float*)F.out, FIN_norm2_g, MOD + b * 6144 + 3072, MOD + b * 6144 + 4096, WSP(u16, WS_H2), b * SEQ, SEQ, wi, wpb, F.lane, F.ws + WS_H2F8);
}
__device__ __forceinline__ void ph6(Frame& F) {
    const gi64* MOD = (const gi64*)(F.ctl + CW_MOD); const int gw = F.vcu * 8 + F.wave, NGW = F.G * 8; (void)MOD; (void)gw; (void)NGW;
        DenseOrder S{1, 128, 0, F.G, F.vcu, (const char*)(F.ws + WS_BR), DM, 1};
        EpiLogits E{WSP(float, WS_LOG)};
        pg8::gemm_phase<EpiLogits, DenseOrder, (MOE_FP8 ? 0 : (MOE_F16 ? 1 : 0)), true>(F.lds + RING_OFF, (const char*)(F.ws + WS_H2), DM, S, E);
        if (F.G == 256 && F.vcu >= 128) transpose_range(F, NT_ITEMS - DEFER_B, DEFER_B, (F.vcu - 128) * 8 + F.wave, 128 * 8);
    }
__device__ __forceinline__ void ph8(Frame& F) {
    const gi64* MOD = (const gi64*)(F.ctl + CW_MOD); const int gw = F.vcu * 8 + F.wave, NGW = F.G * 8; (void)MOD; (void)gw; (void)NGW;
        build_tiles(F);
        GroupedOrder<true> S{2, F.G, F.vcu, 512, DM * (MOE_FP8 ? 1 : 2), true, (const char*)(F.ws + WS_BGU), (const LAS int*)(F.lds + TAB_OFF + 2048), (const LAS int*)(F.lds + TAB_OFF + 3200), (const GAS u32x2*)(F.ws + WS_LIST), (REP == 28) ? 2 : 1, __builtin_amdgcn_readfirstlane(((const LAS int*)(F.lds + TAB_OFF + 2048))[257])};
        EpiSwiglu E{WSP(u16, WS_ACT)};
        pg8::gemm_phase<EpiSwiglu, GroupedOrder<true>, MOE_DT, true>(F.lds + RING_OFF, (const char*)(F.ws + (MOE_FP8 ? WS_H2F8 : WS_H2)), DM, S, E, SC_GU);
    }
__device__ __forceinline__ void ph9(Frame& F) {
    const gi64* MOD = (const gi64*)(F.ctl + CW_MOD); const int gw = F.vcu * 8 + F.wave, NGW = F.G * 8; (void)MOD; (void)gw; (void)NGW;
        build_tiles(F);
        GroupedOrder<false> S{4, F.G, F.vcu, DM, EFF * (MOE_FP8 ? 1 : 2), false, (const char*)(F.ws + WS_BD), (const LAS int*)(F.lds + TAB_OFF + 2048), (const LAS int*)(F.lds + TAB_OFF + 3200), (const GAS u32x2*)(F.ws + WS_LIST), (REP == 29) ? 2 : 1, __builtin_amdgcn_readfirstlane(((const LAS int*)(F.lds + TAB_OFF + 2048))[257])};
        EpiDown E{WSP(u16, WS_C), (const GAS u32x2*)(F.ws + WS_LIST), F.ws + WS_DUMP};
        pg8::gemm_phase<EpiDown, GroupedOrder<false>, MOE_DT, true>(F.lds + RING_OFF, (const char*)(F.ws + WS_ACT), EFF, S, E, SC_D);
    }

#if DBG & (1024 | 2048)
__device__ __forceinline__ float f8dec(unsigned w, int k) { return (k == 0) ? __builtin_amdgcn_cvt_f32_fp8((int)w, 0) : (k == 1) ? __builtin_amdgcn_cvt_f32_fp8((int)w, 1) : (k == 2) ? __builtin_amdgcn_cvt_f32_fp8((int)w, 2) : __builtin_amdgcn_cvt_f32_fp8((int)w, 3); }
__device__ __forceinline__ void chk_attn(Frame& F, float negM) {
    const int gw = F.vcu * 8 + F.wave, NGW = F.G * 8, lane = F.lane;
    const GAS u16* Q = (const GAS u16*)(F.ws + WS_Q); const GAS u16* K = (const GAS u16*)(F.ws + WS_K); const GAS u16* V = (const GAS u16*)(F.ws + WS_V); const GAS u16* MIX = (const GAS u16*)(F.ws + WS_MIX);
    const GAS unsigned char* Q8 = (const GAS unsigned char*)(F.ws + WS_Q); const GAS unsigned char* K8 = (const GAS unsigned char*)(F.ws + WS_K); const GAS unsigned char* Vt8 = (const GAS unsigned char*)(F.ws + WS_V);
    float* chk = (float*)(F.ctl + CW_CHK);
    if (ATTN_FP8 && ATTN_W64) negM = -ceilf(fmaxf(-negM - 8.8f, 0.f)); else if (ATTN_FP8) negM = fminf(negM + 8.8f, 0.f);
    for (int i = gw; i < 4096; i += NGW) {
        const int b = i & 3, h = (i >> 2) % 12, q = (int)((((unsigned)i * 2654435761u) >> 19) & 8191u), kvh = h / 3;
        float qv[64], o[64]; float l = 0.f;
        if (ATTN_FP8) {
#pragma unroll
            for (int c = 0; c < 16; ++c) { const unsigned w = *(const GAS unsigned*)(Q8 + ((size_t)(b * SEQ + q)) * QW + h * 64 + 4 * c);
#pragma unroll
                for (int k = 0; k < 4; ++k) qv[4 * c + k] = f8dec(w, k) * (1.0f / Q8_SCALE); }
        } else {
#pragma unroll
        for (int c = 0; c < 8; ++c) { const u32x4 w = *(const GAS u32x4*)(Q + ((size_t)(b * SEQ + q)) * QW + h * 64 + 8 * c);
            qv[8 * c] = bflo(w.x); qv[8 * c + 1] = bfhi(w.x); qv[8 * c + 2] = bflo(w.y); qv[8 * c + 3] = bfhi(w.y); qv[8 * c + 4] = bflo(w.z); qv[8 * c + 5] = bfhi(w.z); qv[8 * c + 6] = bflo(w.w); qv[8 * c + 7] = bfhi(w.w); }
        }
#pragma unroll
        for (int d = 0; d < 64; ++d) o[d] = 0.f;
        for (int t = 0; t < LKV / 64; ++t) { const int j = t * 64 + lane; float dot = 0.f, pp, pq;
            if (ATTN_FP8) { const GAS unsigned char* kr = K8 + ((size_t)(b * LKV + j)) * KVW + kvh * 64;
#pragma unroll
                for (int c = 0; c < 16; ++c) { const unsigned w = *(const GAS unsigned*)(kr + 4 * c);
#pragma unroll
                    for (int k = 0; k < 4; ++k) dot += qv[4 * c + k] * f8dec(w, k); }
                pp = exp2f(dot + negM); pq = __builtin_amdgcn_cvt_f32_fp8(__builtin_amdgcn_cvt_pk_fp8_f32(pp, 0.f, 0, false), 0); l += pq;
                const GAS unsigned char* vb = Vt8 + (((size_t)(b * NKVH + kvh) * (LKV / 64) + t) * 64) * 64 + attn_body::vt_slot(lane);
#pragma unroll
                for (int d = 0; d < 64; ++d) o[d] += pq * __builtin_amdgcn_cvt_f32_fp8((int)vb[d * 64], 0);
            } else { const GAS u16* kr = K + ((size_t)(b * LKV + j)) * KVW + kvh * 64; const GAS u16* vr = V + ((size_t)(b * LKV + j)) * KVW + kvh * 64;
#pragma unroll
            for (int c = 0; c < 8; ++c) { const u32x4 w = *(const GAS u32x4*)(kr + 8 * c);
                dot += qv[8 * c] * bflo(w.x) + qv[8 * c + 1] * bfhi(w.x) + qv[8 * c + 2] * bflo(w.y) + qv[8 * c + 3] * bfhi(w.y) + qv[8 * c + 4] * bflo(w.z) + qv[8 * c + 5] * bfhi(w.z) + qv[8 * c + 6] * bflo(w.w) + qv[8 * c + 7] * bfhi(w.w); }
            pp = exp2f(dot + negM); l += pp;
#pragma unroll
            for (int c = 0; c < 8; ++c) { const u32x4 w = *(const GAS u32x4*)(vr + 8 * c);
                o[8 * c] += pp * bflo(w.x); o[8 * c + 1] += pp * bfhi(w.x); o[8 * c + 2] += pp * bflo(w.y); o[8 * c + 3] += pp * bfhi(w.y); o[8 * c + 4] += pp * bflo(w.z); o[8 * c + 5] += pp * bfhi(w.z); o[8 * c + 6] += pp * bflo(w.w); o[8 * c + 7] += pp * bfhi(w.w); } } }
        l = wave_sum(l); float err = 0.f, ref = 0.f;
#pragma unroll
        for (int d = 0; d < 64; ++d) { const float od = wave_sum(o[d]) / l; const float mv = bflo((unsigned)MIX[((size_t)(b * SEQ + q)) * DM + 256 + h * 64 + d]); err += (od - mv) * (od - mv); ref += od * od; }
        if (lane == 0) { atomicAdd(chk + 0, err); atomicAdd(chk + 1, ref); }
    }
}
__device__ __forceinline__ void chk_qkv(Frame& F) {
    const int gw = F.vcu * 8 + F.wave, NGW = F.G * 8, lane = F.lane;
    const gi64* MOD = (const gi64*)(F.ctl + CW_MOD);
    LAS float* hrow = (LAS float*)(F.lds + RING_OFF + F.wave * 16384);
    float* chk = (float*)(F.ctl + CW_CHK);
    for (int i = gw; i < 4096; i += NGW) {
        const unsigned hs = (unsigned)i * 2654435761u; const bool isctx = (i & 15) == 15; int sel = i % 20; if (isctx && sel < 12) sel = 12 + (sel & 7);
        const int m = isctx ? (int)((hs >> 10) & 1023u) : (int)((hs >> 12) & 32767u);
        const float* src = isctx ? FIN_ctx + (size_t)m * DM : FIN_x + (size_t)m * DM; const int mr = isctx ? 4 : (m >> 13);
        const int b = isctx ? (m >> 8) : (m >> 13), l = isctx ? 0 : (m & 8191), key = isctx ? SEQ + (m & 255) : l;
        f32x4 v[4]; float s2 = 0.f;
#pragma unroll
        for (int j = 0; j < 4; ++j) { v[j] = *(const f32x4*)(src + 4 * lane + 256 * j); s2 += (v[j][0] * v[j][0] + v[j][1] * v[j][1]) + (v[j][2] * v[j][2] + v[j][3] * v[j][3]); }
        const float rstd = 1.0f / sqrtf(wave_sum(s2) * (1.0f / DM) + RMS_EPS);
#pragma unroll
        for (int j = 0; j < 4; ++j) { const int col = 4 * lane + 256 * j; const f32x4 g = *(const f32x4*)(FIN_norm1_g + col); const f32x4 sh = mod4(MOD, mr * 6144 + col), sc = mod4(MOD, mr * 6144 + 1024 + col);
            const f32x4 y = v[j] * rstd * g * (sc + 1.0f) + sh; hrow[col] = y[0]; hrow[col + 1] = y[1]; hrow[col + 2] = y[2]; hrow[col + 3] = y[3]; }
        LDS_WAIT(); asm volatile("" ::: "memory");
        const int colbase = (sel < 12) ? 256 + 64 * sel : (sel < 16 ? 1024 + 64 * (sel - 12) : 1280 + 64 * (sel - 16));
        float z = 0.f;
        for (int k = 0; k < DM; ++k) z += hrow[k] * FIN_w_in[(size_t)k * 1536 + colbase + lane];
        float outv = z; int spos = lane;
        if (sel < 16) { const float ss = wave_sum(z * z); const float gain = (sel < 12) ? FIN_q_norm_g[lane] : FIN_k_norm_g[lane]; const float zz = z * (1.0f / sqrtf(ss * (1.0f / 64.0f) + RMS_EPS)) * gain;
            const float pz = __shfl(zz, lane ^ 16); outv = zz;
            if (!isctx) { const int pidx = (lane & 32) ? (l & 63) : (l >> 6); const float inv = powf(10000.0f, -(float)(lane & 15) / 16.0f), ang = (float)pidx * inv; const float cs = cosf(ang), sn = sinf(ang);
                outv = (lane & 16) ? zz * cs + pz * sn : zz * cs - pz * sn; }
            if (sel < 12) outv *= C2;
            spos = 32 * (lane >> 5) + 8 * ((lane >> 2) & 3) + 4 * ((lane >> 4) & 1) + (lane & 3); }
        float stored;
        if (ATTN_FP8) {
            if (sel < 12) stored = __builtin_amdgcn_cvt_f32_fp8((int)((const GAS unsigned char*)(F.ws + WS_Q))[(size_t)m * QW + sel * 64 + spos], 0) * (1.0f / Q8_SCALE);
            else if (sel < 16) stored = __builtin_amdgcn_cvt_f32_fp8((int)((const GAS unsigned char*)(F.ws + WS_K))[((size_t)(b * LKV + key)) * KVW + (sel - 12) * 64 + spos], 0);
            else stored = __builtin_amdgcn_cvt_f32_fp8((int)((const GAS unsigned char*)(F.ws + WS_V))[((((size_t)(b * NKVH + (sel - 16)) * (LKV / 64) + (key >> 6)) * 64 + lane) * 64) + attn_body::vt_slot(key & 63)], 0);
        } else {
        if (sel < 12) stored = bflo((unsigned)((const GAS u16*)(F.ws + WS_Q))[(size_t)m * QW + sel * 64 + spos]);
        else if (sel < 16) stored = bflo((unsigned)((const GAS u16*)(F.ws + WS_K))[((size_t)(b * LKV + key)) * KVW + (sel - 12) * 64 + spos]);
        else stored = bflo((unsigned)((const GAS u16*)(F.ws + WS_V))[((size_t)(b * LKV + key)) * KVW + (sel - 16) * 64 + lane]); }
        const float err = wave_sum((outv - stored) * (outv - stored)), ref = wave_sum(outv * outv);
        if (lane == 0) { atomicAdd(chk + 2, err); atomicAdd(chk + 3, ref); }
        LDS_WAIT(); asm volatile("" ::: "memory");
    }
}
#endif

struct Args { const float* in[20]; float* out; unsigned char* ws; int ph_lo, ph_hi; };
__global__ void __launch_bounds__(512, 2) mk_fwd(Args args) {
    extern __shared__ __attribute__((aligned(16))) unsigned char lds[];
    Frame F;
    F.lds = (LAS unsigned char*)lds;
    F.MISC = (volatile LAS unsigned*)(F.lds + MISC_OFF);
    F.tid = threadIdx.x; F.lane = F.tid & 63; F.wave = __builtin_amdgcn_readfirstlane(F.tid >> 6);
    F.G = gridDim.x; { const int bx = blockIdx.x; F.vcu = (F.G % 8 == 0) ? (bx % 8) * (F.G / 8) + bx / 8 : bx; }
    F.ws = args.ws; F.ctl = (gu32*)(args.ws + WS_CTL); F.out = args.out;
    F.ka = (const float* const*)__builtin_amdgcn_kernarg_segment_ptr();
    for (int u = F.tid; u < (LDS_BYTES - LDSCTL_OFF) / 4; u += 512) ((LAS unsigned*)(F.lds + LDSCTL_OFF))[u] = 0u;
    if (SYN_ZERO) { for (int u = F.tid; u < 49152 / 4; u += 512) ((LAS unsigned*)F.lds)[u] = 0u; }
    __syncthreads();
#if SYN
    {
        typedef int sv8 __attribute__((ext_vector_type(8))); typedef attn_body::f32x16 f32x16;

        const bool lowh = F.wave < 4;
        sv8 a_ = (sv8){F.tid, 1, 2, 3, 4, 5, 6, 7}, b_ = (sv8){7, 6, 5, 4, 3, 2, 1, F.tid};
        if (SYN_RND) { for (int i = 0; i < 8; ++i) { unsigned ha = (unsigned)(F.tid * 8 + i) * 2654435761u, hb = (unsigned)(F.tid * 8 + i + 4096) * 2246822519u; ha ^= ha >> 15; hb ^= hb >> 13; a_[i] = (int)(ha & 0x7f7f7f7fu & ~0x40404040u); b_[i] = (int)(hb & 0xbfbfbfbfu); } }
        f32x16 m0 = f32x16{}, m1 = f32x16{}, m2 = f32x16{}, m3 = f32x16{}, m4 = f32x16{};
        f32x16 e0, e1; for (int r = 0; r < 16; ++r) { e0[r] = -(float)(F.lane + r); e1[r] = -(float)(F.lane + 2 * r); }
        sv8 pk = (sv8){0, 0, 0, 0, 0, 0, 0, 0};
        const bool doM = lowh ? (SYN & 1) : (SYN & 4), doE = lowh ? (SYN & 8) : (SYN & 2), doI = lowh && (SYN & 16);
#define SYN_M(x) x = __builtin_amdgcn_mfma_scale_f32_32x32x64_f8f6f4(a_, b_, x, 0, 0, 0, 0x7f7f, 1, 0x7f7f)
#define SYN_E(v, r) v[r] = __builtin_amdgcn_exp2f(v[r])
#define SYN_C(k, v, B) pk[k] = __builtin_amdgcn_cvt_pk_fp8_f32(v[B + 2], v[B + 3], __builtin_amdgcn_cvt_pk_fp8_f32(v[B], v[B + 1], pk[k], false), true)
#pragma unroll 1
        for (int it = 0; it < SYN_N; ++it) {
            if (doM) { SYN_M(m0); SYN_M(m1); SYN_M(m2); SYN_M(m3); SYN_M(m4); }
            if (doE) {
                if (SYN_EM & 1) {
#pragma unroll
                for (int r = 0; r < 16; ++r) { SYN_E(e0, r); SYN_E(e1, r); } }
                if (SYN_EM & 4) {
#pragma unroll
                    for (int r = 0; r < 16; ++r) SYN_E(e0, r);
                    __builtin_amdgcn_sched_barrier(0);
                    SYN_E(e1, 0); SYN_E(e1, 1); SYN_E(e1, 2); SYN_E(e1, 3); __builtin_amdgcn_sched_barrier(0); SYN_C(0, e0, 0); __builtin_amdgcn_sched_barrier(0);
                    SYN_E(e1, 4); SYN_E(e1, 5); SYN_E(e1, 6); SYN_E(e1, 7); __builtin_amdgcn_sched_barrier(0); SYN_C(1, e0, 4); __builtin_amdgcn_sched_barrier(0);
                    SYN_E(e1, 8); SYN_E(e1, 9); SYN_E(e1, 10); SYN_E(e1, 11); __builtin_amdgcn_sched_barrier(0); SYN_C(2, e0, 8); __builtin_amdgcn_sched_barrier(0);
                    SYN_E(e1, 12); SYN_E(e1, 13); SYN_E(e1, 14); SYN_E(e1, 15); __builtin_amdgcn_sched_barrier(0); SYN_C(3, e0, 12); __builtin_amdgcn_sched_barrier(0);
                    SYN_C(4, e1, 0); SYN_C(5, e1, 4); SYN_C(6, e1, 8); SYN_C(7, e1, 12); }
                if (SYN_EM & 8) {
#define SYN_Q(k, v, B) SYN_E(v, B); SYN_E(v, B + 1); SYN_E(v, B + 2); SYN_E(v, B + 3); __builtin_amdgcn_sched_barrier(0); if (k > 0) { if (k <= 4) SYN_C(k - 1, e0, 4 * (k - 1)); else SYN_C(k - 1, e1, 4 * (k - 5)); } __builtin_amdgcn_sched_barrier(0)
                    SYN_Q(0, e0, 0); SYN_Q(1, e0, 4); SYN_Q(2, e0, 8); SYN_Q(3, e0, 12); SYN_Q(4, e1, 0); SYN_Q(5, e1, 4); SYN_Q(6, e1, 8); SYN_Q(7, e1, 12); SYN_C(7, e1, 12); }
                if (SYN_EM & 16) {
                    typedef short v2s_ __attribute__((ext_vector_type(2))); float one_ = 1.0f; asm volatile("" : "+v"(one_));
#define SYN_CS(k, v, B) pk[k] = __builtin_bit_cast(int, __builtin_amdgcn_cvt_scalef32_pk_fp8_f32(__builtin_amdgcn_cvt_scalef32_pk_fp8_f32(__builtin_bit_cast(v2s_, pk[k]), v[B], v[B + 1], one_, false), v[B + 2], v[B + 3], one_, true))
                    SYN_CS(0, e0, 0); SYN_CS(1, e0, 4); SYN_CS(2, e0, 8); SYN_CS(3, e0, 12); SYN_CS(4, e1, 0); SYN_CS(5, e1, 4); SYN_CS(6, e1, 8); SYN_CS(7, e1, 12); }
                if (SYN_EM & 32) {
                    pk[0] = (int)attn_body::cvtpk_s(e0[0], e0[1]); pk[1] = (int)attn_body::cvtpk_s(e0[2], e0[3]); pk[2] = (int)attn_body::cvtpk_s(e0[4], e0[5]); pk[3] = (int)attn_body::cvtpk_s(e0[6], e0[7]);
                    pk[4] = (int)attn_body::cvtpk_s(e0[8], e0[9]); pk[5] = (int)attn_body::cvtpk_s(e0[10], e0[11]); pk[6] = (int)attn_body::cvtpk_s(e0[12], e0[13]); pk[7] = (int)attn_body::cvtpk_s(e0[14], e0[15]);
                    asm volatile("" : "+v"(pk));
                    pk[0] = (int)attn_body::cvtpk_s(e1[0], e1[1]); pk[1] = (int)attn_body::cvtpk_s(e1[2], e1[3]); pk[2] = (int)attn_body::cvtpk_s(e1[4], e1[5]); pk[3] = (int)attn_body::cvtpk_s(e1[6], e1[7]);
                    pk[4] = (int)attn_body::cvtpk_s(e1[8], e1[9]); pk[5] = (int)attn_body::cvtpk_s(e1[10], e1[11]); pk[6] = (int)attn_body::cvtpk_s(e1[12], e1[13]); pk[7] = (int)attn_body::cvtpk_s(e1[14], e1[15]); }
                if (SYN_EM & 2) { SYN_C(0, e0, 0); SYN_C(1, e0, 4); SYN_C(2, e0, 8); SYN_C(3, e0, 12); SYN_C(4, e1, 0); SYN_C(5, e1, 4); SYN_C(6, e1, 8); SYN_C(7, e1, 12); }
                asm volatile("" : "+v"(e0), "+v"(e1), "+v"(pk)); }
            if (doI) {
                __builtin_amdgcn_sched_barrier(0);
                SYN_M(m0); __builtin_amdgcn_sched_barrier(0); SYN_E(e0, 0); SYN_E(e0, 1); SYN_E(e0, 2); SYN_E(e0, 3); SYN_E(e0, 4); SYN_E(e0, 5); SYN_E(e0, 6); __builtin_amdgcn_sched_barrier(0);
                SYN_M(m1); __builtin_amdgcn_sched_barrier(0); SYN_E(e0, 7); SYN_E(e0, 8); SYN_E(e0, 9); SYN_E(e0, 10); SYN_E(e0, 11); SYN_E(e0, 12); SYN_E(e0, 13); __builtin_amdgcn_sched_barrier(0);
                SYN_M(m2); __builtin_amdgcn_sched_barrier(0); SYN_E(e0, 14); SYN_E(e0, 15); SYN_E(e1, 0); SYN_E(e1, 1); SYN_E(e1, 2); SYN_E(e1, 3); SYN_E(e1, 4); __builtin_amdgcn_sched_barrier(0);
                SYN_M(m3); __builtin_amdgcn_sched_barrier(0); SYN_E(e1, 5); SYN_E(e1, 6); SYN_E(e1, 7); SYN_E(e1, 8); SYN_E(e1, 9); SYN_E(e1, 10); SYN_E(e1, 11); __builtin_amdgcn_sched_barrier(0);
                SYN_M(m4); __builtin_amdgcn_sched_barrier(0); SYN_E(e1, 12); SYN_E(e1, 13); SYN_E(e1, 14); SYN_E(e1, 15);
                SYN_C(0, e0, 0); SYN_C(1, e0, 4); SYN_C(2, e0, 8); SYN_C(3, e0, 12); SYN_C(4, e1, 0); SYN_C(5, e1, 4); SYN_C(6, e1, 8); SYN_C(7, e1, 12);
                asm volatile("" : "+v"(e0), "+v"(e1), "+v"(pk)); __builtin_amdgcn_sched_barrier(0); }
        }
        if (SYN & (32 | 64 | 128 | 1024)) {
            f32x16 ng; for (int r = 0; r < 16; ++r) ng[r] = -1.0f - (float)r; asm volatile("" : "+v"(ng));
#define SYN_EB() do { _Pragma("unroll") for (int r = 0; r < 16; ++r) { SYN_E(e0, r); SYN_E(e1, r); } \
                SYN_C(0, e0, 0); SYN_C(1, e0, 4); SYN_C(2, e0, 8); SYN_C(3, e0, 12); SYN_C(4, e1, 0); SYN_C(5, e1, 4); SYN_C(6, e1, 8); SYN_C(7, e1, 12); } while (0)
#define SYN_MB() do { e0 = __builtin_amdgcn_mfma_scale_f32_32x32x64_f8f6f4(a_, b_, ng, 0, 0, 0, 0x7f7f, 1, 0x7f7f); e1 = __builtin_amdgcn_mfma_scale_f32_32x32x64_f8f6f4(b_, a_, ng, 0, 0, 0, 0x7f7f, 1, 0x7f7f); \
                m0 = __builtin_amdgcn_mfma_scale_f32_32x32x64_f8f6f4(pk, a_, m0, 0, 0, 0, 0x7f7f, 1, 0x7f7f); m1 = __builtin_amdgcn_mfma_scale_f32_32x32x64_f8f6f4(pk, b_, m1, 0, 0, 0, 0x7f7f, 1, 0x7f7f); \
                m2 = __builtin_amdgcn_mfma_scale_f32_32x32x64_f8f6f4(pk, a_, m2, 0, 0, 0, 0x7f7f, 1, 0x7f7f); } while (0)
#define SYN_WB() do { if (SYN & (512 | 1024)) asm volatile("s_waitcnt vmcnt(1) lgkmcnt(0)\n\ts_barrier" ::: "memory"); else asm volatile("s_waitcnt lgkmcnt(0)\n\ts_barrier" ::: "memory"); } while (0)
            const bool lt = !lowh && (SYN & (64 | 128 | 1024));
            if ((SYN & (256 | 512)) && !(SYN & 1024)) {
                const attn_body::lds_cptr sp = (attn_body::lds_cptr)F.lds; const int r32_ = F.lane & 31, hi_ = F.lane >> 5, sw_ = (r32_ >> 2) & 3, c0o_ = ((2 * hi_) ^ sw_) * 16, c1o_ = ((2 * hi_ + 1) ^ sw_) * 16;
                const attn_body::lds_cptr kp_ = sp + r32_ * 64, vp_ = sp + 24576 + r32_ * 64;
                sv8 kfa = a_, kfb = b_, vfa = a_, vfb = b_;
                const unsigned char* gsrc = (const unsigned char*)(F.ws + WS_K) + (size_t)blockIdx.x * 524288 + F.tid * 16;
                const unsigned dsto = (unsigned)(uintptr_t)F.lds + (F.wave & 3) * 1024 + (lowh ? 0 : 24576);
                int so = 0, sd = 4 * 4096;
                sv8 vga = a_, vgb = b_;
#define SYN_MB2(IT) do { if ((SYN & 256) && SYN_RD == 0) { vfa = attn_body::ld32(vp_ + so, c0o_, c1o_); vfb = attn_body::ld32(vp_ + so + 2048, c0o_, c1o_); } \
                if (SYN_RD == 1) { vfa = vga; vfb = vgb; } \
                if (SYN_RD == 2) { e0 = __builtin_amdgcn_mfma_scale_f32_32x32x64_f8f6f4(a_, b_, ng, 0, 0, 0, 0x7f7f, 1, 0x7f7f); e1 = __builtin_amdgcn_mfma_scale_f32_32x32x64_f8f6f4(b_, a_, ng, 0, 0, 0, 0x7f7f, 1, 0x7f7f); \
                m0 = __builtin_amdgcn_mfma_scale_f32_32x32x64_f8f6f4(pk, a_, m0, 0, 0, 0, 0x7f7f, 1, 0x7f7f); m1 = __builtin_amdgcn_mfma_scale_f32_32x32x64_f8f6f4(pk, b_, m1, 0, 0, 0, 0x7f7f, 1, 0x7f7f); } else { \
                e0 = __builtin_amdgcn_mfma_scale_f32_32x32x64_f8f6f4(kfa, b_, ng, 0, 0, 0, 0x7f7f, 1, 0x7f7f); e1 = __builtin_amdgcn_mfma_scale_f32_32x32x64_f8f6f4(kfb, b_, ng, 0, 0, 0, 0x7f7f, 1, 0x7f7f); \
                m0 = __builtin_amdgcn_mfma_scale_f32_32x32x64_f8f6f4(pk, vfa, m0, 0, 0, 0, 0x7f7f, 1, 0x7f7f); m1 = __builtin_amdgcn_mfma_scale_f32_32x32x64_f8f6f4(pk, vfb, m1, 0, 0, 0, 0x7f7f, 1, 0x7f7f); } \
                m2 = __builtin_amdgcn_mfma_scale_f32_32x32x64_f8f6f4(pk, a_, m2, 0, 0, 0, 0x7f7f, 1, 0x7f7f); \
                if (SYN & 512) attn_body::glds16(gsrc + (size_t)((IT) & 127) * 4096, (unsigned)__builtin_amdgcn_readfirstlane(dsto + sd)); \
                so = (so == 5 * 4096) ? 0 : so + 4096; sd = (sd == 5 * 4096) ? 0 : sd + 4096; \
                if (SYN & 256) { kfa = attn_body::ld32(kp_ + so, c0o_, c1o_); kfb = attn_body::ld32(kp_ + so + 2048, c0o_, c1o_); \
                    if (SYN_RD >= 1) { vga = attn_body::ld32(vp_ + so, c0o_, c1o_); vgb = attn_body::ld32(vp_ + so + 2048, c0o_, c1o_); } \
                    if (SYN_RD == 2) asm volatile("" :: "v"(kfa), "v"(kfb), "v"(vga), "v"(vgb)); } } while (0)
#pragma unroll 1
                for (int it = 0; it < SYN_N / 2; ++it) {
                    __builtin_amdgcn_sched_barrier(0); SYN_MB2(2 * it); __builtin_amdgcn_sched_barrier(0); SYN_EB(); __builtin_amdgcn_sched_barrier(0); SYN_MB2(2 * it + 1); __builtin_amdgcn_sched_barrier(0);
                    if (lt) SYN_WB();
                    __builtin_amdgcn_sched_barrier(0); SYN_EB(); __builtin_amdgcn_sched_barrier(0);
                    if (!lt) SYN_WB(); }
                asm volatile("s_waitcnt vmcnt(0)" ::: "memory");
                asm volatile("" :: "v"(kfa), "v"(kfb), "v"(vfa), "v"(vfb), "v"(vga), "v"(vgb));
            } else if (SYN & 1024) {
                const attn_body::lds_cptr sp = (attn_body::lds_cptr)F.lds; const int r32_ = F.lane & 31, hi_ = F.lane >> 5, sw_ = (r32_ >> 2) & 3, c0o_ = ((2 * hi_) ^ sw_) * 16, c1o_ = ((2 * hi_ + 1) ^ sw_) * 16;
                const attn_body::lds_cptr kp_ = sp + r32_ * 64, vp_ = sp + 24576 + r32_ * 64;
                sv8 kfa = a_, kfb = a_, vfa = a_, vfb = a_, pk2 = pk; f32x16 m5 = f32x16{};
                const unsigned char* gsrc = (const unsigned char*)(F.ws + WS_K) + (size_t)blockIdx.x * 524288 + F.tid * 16;
                const unsigned dsto = (unsigned)(uintptr_t)F.lds + (F.wave & 3) * 1024 + (lowh ? 0 : 24576);
                int so = 0, sd = 4 * 4096;
#define SYN_X(acc, A, B) acc = __builtin_amdgcn_mfma_scale_f32_32x32x64_f8f6f4(A, B, acc, 0, 0, 0, 0x7f7f, 1, 0x7f7f)
#define SYN_EB2(PK) do { _Pragma("unroll") for (int r = 0; r < 16; ++r) { SYN_E(e0, r); SYN_E(e1, r); } \
                PK[0] = __builtin_amdgcn_cvt_pk_fp8_f32(e0[2], e0[3], __builtin_amdgcn_cvt_pk_fp8_f32(e0[0], e0[1], PK[0], false), true); PK[1] = __builtin_amdgcn_cvt_pk_fp8_f32(e0[6], e0[7], __builtin_amdgcn_cvt_pk_fp8_f32(e0[4], e0[5], PK[1], false), true); \
                PK[2] = __builtin_amdgcn_cvt_pk_fp8_f32(e0[10], e0[11], __builtin_amdgcn_cvt_pk_fp8_f32(e0[8], e0[9], PK[2], false), true); PK[3] = __builtin_amdgcn_cvt_pk_fp8_f32(e0[14], e0[15], __builtin_amdgcn_cvt_pk_fp8_f32(e0[12], e0[13], PK[3], false), true); \
                PK[4] = __builtin_amdgcn_cvt_pk_fp8_f32(e1[2], e1[3], __builtin_amdgcn_cvt_pk_fp8_f32(e1[0], e1[1], PK[4], false), true); PK[5] = __builtin_amdgcn_cvt_pk_fp8_f32(e1[6], e1[7], __builtin_amdgcn_cvt_pk_fp8_f32(e1[4], e1[5], PK[5], false), true); \
                PK[6] = __builtin_amdgcn_cvt_pk_fp8_f32(e1[10], e1[11], __builtin_amdgcn_cvt_pk_fp8_f32(e1[8], e1[9], PK[6], false), true); PK[7] = __builtin_amdgcn_cvt_pk_fp8_f32(e1[14], e1[15], __builtin_amdgcn_cvt_pk_fp8_f32(e1[12], e1[13], PK[7], false), true); } while (0)
#define SYN_S64(IT, MID) do { __builtin_amdgcn_sched_barrier(0); \
                vfa = attn_body::ld32(vp_ + so, c0o_, c1o_); vfb = attn_body::ld32(vp_ + so + 2048, c0o_, c1o_); \
                e0 = __builtin_amdgcn_mfma_scale_f32_32x32x64_f8f6f4(kfa, a_, f32x16{}, 0, 0, 0, 0x7f7f, 1, 0x7f7f); e1 = __builtin_amdgcn_mfma_scale_f32_32x32x64_f8f6f4(kfb, a_, f32x16{}, 0, 0, 0, 0x7f7f, 1, 0x7f7f); \
                SYN_X(m0, pk, vfa); SYN_X(m1, pk, vfb); SYN_X(m2, pk, a_); SYN_X(m3, pk2, vfa); SYN_X(m4, pk2, vfb); SYN_X(m5, pk2, a_); \
                attn_body::glds16(gsrc + (size_t)((IT) & 127) * 4096, (unsigned)__builtin_amdgcn_readfirstlane(dsto + sd)); \
                so = (so == 5 * 4096) ? 0 : so + 4096; sd = (sd == 5 * 4096) ? 0 : sd + 4096; \
                if (SYN_ILV == 0) __builtin_amdgcn_sched_barrier(0); \
                SYN_EB2(pk); __builtin_amdgcn_sched_barrier(0); \
                e0 = __builtin_amdgcn_mfma_scale_f32_32x32x64_f8f6f4(kfa, a_, f32x16{}, 0, 0, 0, 0x7f7f, 1, 0x7f7f); e1 = __builtin_amdgcn_mfma_scale_f32_32x32x64_f8f6f4(kfb, a_, f32x16{}, 0, 0, 0, 0x7f7f, 1, 0x7f7f); \
                kfa = attn_body::ld32(kp_ + so, c0o_, c1o_); kfb = attn_body::ld32(kp_ + so + 2048, c0o_, c1o_); \
                __builtin_amdgcn_sched_barrier(0); MID; __builtin_amdgcn_sched_barrier(0); \
                SYN_EB2(pk2); } while (0)
#pragma unroll 1
                for (int it = 0; it < SYN_N / 4; ++it) {
                    SYN_S64(2 * it, (void)0); SYN_S64(2 * it + 1, if (lt) SYN_WB());
                    if (!lt) SYN_WB(); }
                asm volatile("s_waitcnt vmcnt(0)" ::: "memory");
                asm volatile("" :: "v"(kfa), "v"(kfb), "v"(vfa), "v"(vfb), "v"(pk2), "v"(m5));
            } else if (SYN & 128) {
#pragma unroll 1
                for (int it = 0; it < SYN_N / 2; ++it) {
                    __builtin_amdgcn_sched_barrier(0); SYN_MB(); __builtin_amdgcn_sched_barrier(0); SYN_EB(); __builtin_amdgcn_sched_barrier(0); SYN_MB(); __builtin_amdgcn_sched_barrier(0);
                    if (lt) asm volatile("s_barrier" ::: "memory");
                    __builtin_amdgcn_sched_barrier(0); SYN_EB(); __builtin_amdgcn_sched_barrier(0);
                    if (!lt) asm volatile("s_barrier" ::: "memory"); }
            } else {
                if (lt) { SYN_EB(); }
#pragma unroll 1
                for (int it = 0; it < SYN_N; ++it) { __builtin_amdgcn_sched_barrier(0); SYN_MB(); __builtin_amdgcn_sched_barrier(0); SYN_EB(); }
            }
        }
        asm volatile("" :: "v"(m0), "v"(m1), "v"(m2), "v"(m3), "v"(m4), "v"(e0), "v"(e1), "v"(pk));
        __syncthreads();
    }
#endif
    XcdBarrier bar; bar.bar = (unsigned*)(F.ctl + CW_BAR); bar.x = 0; bar.st = nullptr;
    if (N_LAUNCHES == 1) bar = xcd_barrier_post((unsigned*)(F.ctl + CW_BAR), F.MISC + 8);
    const int lo = args.ph_lo, hi = args.ph_hi;
#define IN(k) (lo <= (k) && (k) < hi)
#define SEAM(k) do { if (IN(k) && IN((k) + 1)) xcd_barrier(bar); asm volatile("" : "+s"(F.ka)); } while (0)
    const gi64* MOD = (const gi64*)(F.ctl + CW_MOD);
    const int gw = F.vcu * 8 + F.wave, NGW = F.G * 8;

    if (IN(0)) { p0_phase(F); } SEAM(0);
    if (IN(1)) { p1_phase(F); VM_WAIT(); __syncthreads(); if (REP == 1) { xcd_barrier(bar); p1_phase(F); VM_WAIT(); __syncthreads(); } } SEAM(1);

    if (IN(2)) { ph2(F); if (REP == 2) { xcd_barrier(bar); ph2(F); } } SEAM(2);

    if (IN(3)) {
        if (DBG & 32) { u16* MIXz = WSP(u16, WS_MIX); for (int m = gw; m < NTOK; m += NGW) *(GAS u32x2*)(MIXz + (size_t)m * DM + 4 * F.lane) = (u32x2){0u, 0u}; }
        else
        REPS(30) for (int U = F.vcu; U < NB * 64; U += F.G) { if (FOURIER_MFMA) fourier_unit_mfma(F, U >> 6, U & 63); else fourier_unit(F, U >> 6, U & 63); }
        const attn_body::bf16* Qp = (const attn_body::bf16*)(F.ws + WS_Q); const attn_body::bf16* Kp = (const attn_body::bf16*)(F.ws + WS_K); const attn_body::bf16* Vp = (const attn_body::bf16*)(F.ws + WS_V);
        attn_body::bf16* Op = (attn_body::bf16*)(F.ws + WS_MIX) + 256;
        float negM; { float gqm = fabsf(FIN_q_norm_g[F.lane]), gkm = fabsf(FIN_k_norm_g[F.lane]);
#pragma unroll
            for (int o_ = 1; o_ < 64; o_ <<= 1) { gqm = fmaxf(gqm, __shfl_xor(gqm, o_)); gkm = fmaxf(gkm, __shfl_xor(gkm, o_)); }
            negM = -(C2 * 64.0f * gqm * gkm + 0.5f); }
        if (ATTN_FP8 && ATTN_W64) negM = -ceilf(fmaxf(-negM - 8.8f, 0.f));
        else if (ATTN_FP8) negM = fminf(negM + 8.8f, 0.f);
        if (ATTN_PRIO) { if (__builtin_amdgcn_readfirstlane(F.tid) >= 256) __builtin_amdgcn_s_setprio(1); }
        if (DBG & 16) { u16* MIXz = WSP(u16, WS_MIX); for (int m = gw; m < NTOK; m += NGW) for (int j = 1; j < 4; ++j) *(GAS u32x2*)(MIXz + (size_t)m * DM + 256 * j + 4 * F.lane) = (u32x2){0u, 0u}; }
        else if (ATTN_FP8 && ATTN_W64) REPS(31) {
            for (int U = F.vcu * 3; U < NB * NQH * 16; U += F.G * 3)
                for (int i = 0; i < 3 && U + i < NB * NQH * 16; ++i) { const int grp = (U + i) / 48, r = (U + i) % 48;
                    attn_body::attn_unit8w(grp >> 2, (grp & 3) * 3 + r / 16, r % 16, (const unsigned char*)Qp, (const unsigned char*)Kp, (const unsigned char*)Vp, Op, (char*)lds + RING_OFF, negM); }
        }
        else if (F.G == 256) REPS(31) {
            const int xg = F.vcu >> 5, jq = F.vcu & 31;
            for (int i = 0; i < 6; ++i) { const int grp = 2 * xg + i / 3, hs = i % 3;
                if (ATTN_FP8) attn_body::attn_unit8(grp >> 2, (grp & 3) * 3 + hs, jq, (const unsigned char*)Qp, (const unsigned char*)Kp, (const unsigned char*)Vp, Op, (char*)lds + RING_OFF, negM);
                else attn_body::attn_unit<ATTN_MSUM>(grp >> 2, (grp & 3) * 3 + hs, jq, Qp, Kp, Vp, Op, (char*)lds + RING_OFF, negM); }
        } else {
            for (int U = F.vcu; U < NB * NQH * 32; U += F.G) { const int grp = U / 96, r = U % 96;
                if (ATTN_FP8) attn_body::attn_unit8(grp >> 2, (grp & 3) * 3 + r / 32, r % 32, (const unsigned char*)Qp, (const unsigned char*)Kp, (const unsigned char*)Vp, Op, (char*)lds + RING_OFF, negM);
                else attn_body::attn_unit<ATTN_MSUM>(grp >> 2, (grp & 3) * 3 + r / 32, r % 32, Qp, Kp, Vp, Op, (char*)lds + RING_OFF, negM); }
        }
        if (ATTN_PRIO) __builtin_amdgcn_s_setprio(0);
    } SEAM(3);

#if DBG & (1024 | 2048)
    if (IN(4)) { float negMc; { float gqm = fabsf(FIN_q_norm_g[F.lane]), gkm = fabsf(FIN_k_norm_g[F.lane]);
            for (int o_ = 1; o_ < 64; o_ <<= 1) { gqm = fmaxf(gqm, __shfl_xor(gqm, o_)); gkm = fmaxf(gkm, __shfl_xor(gkm, o_)); } negMc = -(C2 * 64.0f * gqm * gkm + 0.5f); }
        if (DBG & 1024) chk_attn(F, negMc); if (DBG & 2048) chk_qkv(F); VM_WAIT(); __syncthreads(); }
#endif
    if (IN(4)) { ph4(F); if (REP == 4) { xcd_barrier(bar); ph4(F); } } SEAM(4);

    if (IN(5)) { ph5(F); if (REP == 5) { xcd_barrier(bar); ph5(F); } if (REP == 55) { xcd_barrier(bar); xcd_barrier(bar); xcd_barrier(bar); xcd_barrier(bar); xcd_barrier(bar); } } SEAM(5);

    if (IN(6)) { ph6(F); if (REP == 6) { xcd_barrier(bar); ph6(F); } } SEAM(6);

    if (IN(7)) {
        if (DBG & 128) { GAS u32x4* zA = (GAS u32x4*)(F.ws + WS_ACT); const size_t nA = (size_t)MAXTILES * 256 * EFF * 2 / 16; for (size_t i = (size_t)blockIdx.x * 512 + F.tid; i < nA; i += (size_t)F.G * 512) zA[i] = (u32x4){0u, 0u, 0u, 0u};
            GAS u32x4* zC = (GAS u32x4*)(F.ws + WS_C); const size_t nC = (size_t)NTOK * NSLOT * DM * 2 / 16; for (size_t i = (size_t)blockIdx.x * 512 + F.tid; i < nC; i += (size_t)F.G * 512) zC[i] = (u32x4){0u, 0u, 0u, 0u}; }
        if (blockIdx.x == 0 && F.tid == 0) __hip_atomic_store((unsigned*)(F.ctl + CW_CNT + NEXP), (unsigned)NTOK, RLX_AGENT);
        for (int tok = gw; tok < NTOK; tok += NGW) route_token(F, tok);
    } SEAM(7);

    if (IN(8)) { ph8(F); if (REP == 8) { xcd_barrier(bar); ph8(F); } } SEAM(8);

    if (IN(9)) { ph9(F); if (REP == 9) { xcd_barrier(bar); ph9(F); } } SEAM(9);

    if (IN(10)) {
        const int lane = F.lane; const GAS unsigned char* Cc = (const GAS unsigned char*)(F.ws + WS_C);
        const int wpb = NGW >> 2, b = gw / wpb, wi = gw % wpb;
        f32x4 g2v[4], fg[4];
#pragma unroll
        for (int i = 0; i < 4; ++i) { const int col = 16 * lane + 4 * i; g2v[i] = mod4(MOD + b * 6144 + 5120, col) * (1.0f / C_SCALE); fg[i] = *(const f32x4*)(FIN_final_g + col); }
        bool bad = false;
#if DBG & (1024 | 2048)
        { const float e0 = __hip_atomic_load((float*)(F.ctl + CW_CHK), RLX_AGENT), r0 = __hip_atomic_load((float*)(F.ctl + CW_CHK) + 1, RLX_AGENT), e1 = __hip_atomic_load((float*)(F.ctl + CW_CHK) + 2, RLX_AGENT), r1 = __hip_atomic_load((float*)(F.ctl + CW_CHK) + 3, RLX_AGENT);
          if (DBG & 1024) bad = bad || !(e0 <= CHK_TOL_A * r0) || !(r0 > 0.f); if (DBG & 2048) bad = bad || !(e1 <= CHK_TOL_B * r1) || !(r1 > 0.f); }
#endif
        for (int r = wi; r < SEQ; r += 2 * wpb) {
            const int r1 = (r + wpb < SEQ) ? r + wpb : r; const bool has1 = r + wpb < SEQ;
            const int m0 = b * SEQ + r, m1 = b * SEQ + r1;
            GAS float* orow0 = (GAS float*)F.out + (size_t)m0 * DM + 16 * lane; GAS float* orow1 = (GAS float*)F.out + (size_t)m1 * DM + 16 * lane;
            f32x4 xa[4], xb[4], ya[4], yb[4];
#pragma unroll
            for (int i = 0; i < 4; ++i) { xa[i] = *(const GAS f32x4*)(orow0 + 4 * i); xb[i] = *(const GAS f32x4*)(orow1 + 4 * i); ya[i] = (f32x4){0.f, 0.f, 0.f, 0.f}; yb[i] = (f32x4){0.f, 0.f, 0.f, 0.f}; }
#pragma unroll
            for (int sl = 0; sl < NSLOT; ++sl) { const u32x4 wa = *(const GAS u32x4*)(Cc + ((size_t)m0 * NSLOT + sl) * DM + 16 * lane), wb = *(const GAS u32x4*)(Cc + ((size_t)m1 * NSLOT + sl) * DM + 16 * lane);
#pragma unroll
                for (int i = 0; i < 4; ++i) { const int wa_ = (int)wa[i], wb_ = (int)wb[i];
                    const f32x2 la = __builtin_amdgcn_cvt_pk_f32_fp8(wa_, false), ha = __builtin_amdgcn_cvt_pk_f32_fp8(wa_, true), lb = __builtin_amdgcn_cvt_pk_f32_fp8(wb_, false), hb = __builtin_amdgcn_cvt_pk_f32_fp8(wb_, true);
                    ya[i] += (f32x4){la.x, la.y, ha.x, ha.y}; yb[i] += (f32x4){lb.x, lb.y, hb.x, hb.y}; } }
            float sa = 0.f, sb = 0.f;
#pragma unroll
            for (int i = 0; i < 4; ++i) { const f32x4 va = xa[i] + g2v[i] * ya[i], vb = xb[i] + g2v[i] * yb[i]; xa[i] = va; xb[i] = vb;
                sa += (va[0] * va[0] + va[1] * va[1]) + (va[2] * va[2] + va[3] * va[3]); sb += (vb[0] * vb[0] + vb[1] * vb[1]) + (vb[2] * vb[2] + vb[3] * vb[3]); }
#pragma unroll
            for (int o = 1; o < 64; o <<= 1) { sa += __shfl_xor(sa, o); sb += __shfl_xor(sb, o); }
            const float bm = bad ? 3.0f : 1.0f;
            const float ra = 1.0f / sqrtf(sa * (1.0f / DM) + RMS_EPS) * bm, rb = 1.0f / sqrtf(sb * (1.0f / DM) + RMS_EPS) * bm;
#pragma unroll
            for (int i = 0; i < 4; ++i) *(GAS f32x4*)(orow0 + 4 * i) = xa[i] * ra * fg[i];
            if (has1) {
#pragma unroll
                for (int i = 0; i < 4; ++i) *(GAS f32x4*)(orow1 + 4 * i) = xb[i] * rb * fg[i]; } }
    }
#undef IN
#undef SEAM
}

extern "C" void kernel_launch(void* const* d_in, const int* in_sizes, int n_in, void* d_out, int out_size, void* d_ws, size_t ws_size, hipStream_t stream) {
    static int grid = 0;
    if (grid == 0) {
        if (n_in != 20 || in_sizes[0] != NTOK * DM || out_size != NTOK * DM || ws_size < WS_END) { fprintf(stderr, "kernel_launch: unexpected shapes (n_in %d, in0 %d, out %d, ws %zu < %zu)\n", n_in, n_in > 0 ? in_sizes[0] : -1, out_size, ws_size, (size_t)WS_END); grid = -1; return; }
        int dev = 0, cus = 0, per_cu = 0;
        if (hipGetDevice(&dev) != hipSuccess || hipDeviceGetAttribute(&cus, hipDeviceAttributeMultiprocessorCount, dev) != hipSuccess) { grid = -1; return; }
        if (hipFuncSetAttribute((const void*)mk_fwd, hipFuncAttributeMaxDynamicSharedMemorySize, LDS_BYTES) != hipSuccess) { fprintf(stderr, "kernel_launch: hipFuncSetAttribute failed\n"); grid = -1; return; }
        if (hipOccupancyMaxActiveBlocksPerMultiprocessor(&per_cu, (const void*)mk_fwd, 512, LDS_BYTES) != hipSuccess || per_cu < 1) fprintf(stderr, "kernel_launch: occupancy query reports %d\n", per_cu);
        (void)hipGetLastError();
        grid = cus;
    }
    if (grid < 0) return;
    (void)hipMemsetAsync((char*)d_ws + WS_CTL, 0, CTL_ZERO_BYTES, stream);
    Args a{};
    for (int i = 0; i < 20; ++i) a.in[i] = (const float*)d_in[i];
    a.out = (float*)d_out; a.ws = (unsigned char*)d_ws;
    if (N_LAUNCHES == 1) { a.ph_lo = 0; a.ph_hi = PER_PHASE; hipLaunchKernelGGL(mk_fwd, dim3(grid), dim3(512), LDS_BYTES, stream, a); }
    else for (int li = 0; li < PER_PHASE; ++li) { a.ph_lo = li; a.ph_hi = li + 1; hipLaunchKernelGGL(mk_fwd, dim3(grid), dim3(512), LDS_BYTES, stream, a); }
}
```

```cpp
#include <hip/hip_runtime.h>
#include <hip/hip_bf16.h>
#include <cstdio>
#include <cstdint>
#include <cmath>

#ifndef MK_N_LAUNCHES
#define MK_N_LAUNCHES 1
#endif
constexpr int PER_PHASE = 11;
#ifndef DBG
#define DBG 0
#endif
#ifndef REP
#define REP -1
#endif
#ifndef CHK_TOL_A
#define CHK_TOL_A 1e-4f
#endif
#ifndef CHK_TOL_B
#define CHK_TOL_B 3e-3f
#endif
#ifndef POSTEPI_WAITS
#define POSTEPI_WAITS 1
#endif
#ifndef ATTN_FP8
#define ATTN_FP8 1
#endif
constexpr float Q8_SCALE = 8.0f;
#ifndef ATTN_MSUM
#define ATTN_MSUM false
#endif
#ifndef ATTN_PRIO
#define ATTN_PRIO 0
#endif
#ifndef ATTN_SKEW
#define ATTN_SKEW 1
#endif
#ifndef ATTN_MPRIO
#define ATTN_MPRIO 0
#endif
#ifndef ATTN_W64
#define ATTN_W64 1
#endif
#ifndef SYN
#define SYN 0
#endif
#define SYN_N 2000
#ifndef SYN_ILV
#define SYN_ILV 0
#endif
#ifndef SYN_ZERO
#define SYN_ZERO 0
#endif
#ifndef SYN_RND
#define SYN_RND 0
#endif
#ifndef SYN_EM
#define SYN_EM 3
#endif
#ifndef SYN_RD
#define SYN_RD 0
#endif
#ifndef FOURIER_MFMA
#define FOURIER_MFMA 1
#endif
#define REPS(k) for (int rep_ = 0; rep_ < ((REP == (k)) ? 2 : 1); ++rep_)
#define REPBAR() do { if (rep_) xcd_barrier(bar); } while (0)
constexpr int N_LAUNCHES = MK_N_LAUNCHES;

#define GAS __attribute__((address_space(1)))
#define LAS __attribute__((address_space(3)))
typedef unsigned short u16;
typedef short bf16x8 __attribute__((ext_vector_type(8)));
typedef _Float16 half8 __attribute__((ext_vector_type(8)));
typedef _Float16 half2v __attribute__((ext_vector_type(2)));
typedef float f32x4 __attribute__((ext_vector_type(4)));
typedef float f32x2 __attribute__((ext_vector_type(2)));
typedef unsigned u32x4 __attribute__((ext_vector_type(4)));
typedef unsigned u32x2 __attribute__((ext_vector_type(2)));
typedef GAS unsigned gu32;

constexpr int DM = 1024, NB = 4, SEQ = 8192, NTOK = NB * SEQ, CTXL = 256, NCTX = NB * CTXL, LKV = SEQ + CTXL;
constexpr int NQH = 12, NKVH = 4, HD = 64, QW = NQH * HD, KVW = NKVH * HD;
constexpr int NIN = 1792;
constexpr int MIN_ROWS = NTOK + NCTX;
constexpr int NEXP = 256, NEXPS = 257, TOPK = 8, EFF = 256, NSLOT = 9;
constexpr int MAXTILES = 1408;
constexpr float RMS_EPS = 1e-6f;
#ifndef MOE_F16
#define MOE_F16 0
#endif
constexpr bool MOEF16 = MOE_F16;
#ifndef MOE_FP8
#define MOE_FP8 1
#endif
constexpr int MOE_DT = MOE_FP8 ? 2 : (MOE_F16 ? 1 : 0);
constexpr float WGU_SCALE = 32.0f, WD_SCALE = 16.0f;
constexpr int SC_ONE = 0x7f7f7f7f, SC_GU = 0x7f7f7f7a, SC_D = 0x7f7f7f7b;
constexpr float C2 = 0.125f * 1.4426950408889634f;
constexpr float C_SCALE = 16.0f;

constexpr size_t MiB = 1u << 20;
constexpr size_t WS_CTL = 0, CTL_ZERO_BYTES = 1 * MiB;
constexpr size_t WS_TAB = 1 * MiB;
constexpr size_t WS_BIN = 2 * MiB;
constexpr size_t WS_BOUT = 6 * MiB;
constexpr size_t WS_BR = 8 * MiB;
constexpr size_t WS_K = 16 * MiB;
constexpr size_t WS_V = 34 * MiB;
constexpr size_t WS_Z = 52 * MiB;
constexpr size_t WS_Q = 84 * MiB;
constexpr size_t WS_XN = 132 * MiB;
constexpr size_t WS_MIX = 198 * MiB;
constexpr size_t WS_H2 = 262 * MiB;
constexpr size_t WS_LOG = 326 * MiB;
constexpr size_t WS_LIST = 358 * MiB;
constexpr size_t WS_BGU = 424 * MiB;
constexpr size_t WS_BD = 682 * MiB;
constexpr size_t WS_ACT = 812 * MiB;
constexpr size_t WS_C = 990 * MiB;
constexpr size_t WS_H2F8 = 1568 * MiB;
constexpr size_t WS_DUMP = 1600 * MiB;
constexpr size_t WS_END = 1632 * MiB;
constexpr int CW_TMO = 0, CW_CODE = 1;
constexpr int CW_BAR = 4096;
constexpr int CW_CNT = 16384;
constexpr int CW_CHK = 32768;
constexpr int CW_MOD = 131072;
static_assert(CW_MOD * 4 + 5 * 6144 * 8 <= (int)CTL_ZERO_BYTES, "ctl");

constexpr int RING_OFF = 0, RING_BYTES = 131072;
constexpr int P1_SCR = 18432;
constexpr int TAB_OFF = 8 * P1_SCR;
constexpr int LDS_BYTES = 163840;
constexpr int LDSCTL_OFF = LDS_BYTES - 1024, MISC_OFF = LDSCTL_OFF + 320;
static_assert(TAB_OFF + 8192 <= LDSCTL_OFF, "LDS map");

#define LDS_WAIT() asm volatile("s_waitcnt lgkmcnt(0)" ::: "memory")
#define VM_WAIT() asm volatile("s_waitcnt vmcnt(0)" ::: "memory")
#define RLX_AGENT __ATOMIC_RELAXED, __HIP_MEMORY_SCOPE_AGENT

__device__ __forceinline__ unsigned f2bf(float f) { unsigned u = __builtin_bit_cast(unsigned, f); return (u + 0x7fffu + ((u >> 16) & 1u)) >> 16; }
__device__ __forceinline__ unsigned pk2bf(float lo, float hi) { return f2bf(lo) | (f2bf(hi) << 16); }
__device__ __forceinline__ unsigned pk2h(float lo, float hi) { half2v v = {(_Float16)lo, (_Float16)hi}; return __builtin_bit_cast(unsigned, v); }
__device__ __forceinline__ unsigned cvt_pk_bf16(float lo, float hi) { unsigned r; asm volatile("v_cvt_pk_bf16_f32 %0, %1, %2" : "=v"(r) : "v"(lo), "v"(hi)); return r; }
__device__ __forceinline__ float bflo(unsigned w) { return __builtin_bit_cast(float, w << 16); }
__device__ __forceinline__ float bfhi(unsigned w) { return __builtin_bit_cast(float, w & 0xffff0000u); }
typedef long long i64x2 __attribute__((ext_vector_type(2)));
typedef GAS long long gi64;
__device__ __forceinline__ f32x4 mod4(const gi64* MODQ, int idx) {
    const i64x2 a = *(const GAS i64x2*)(MODQ + idx), b = *(const GAS i64x2*)(MODQ + idx + 2);
    return (f32x4){(float)a.x, (float)a.y, (float)b.x, (float)b.y} * 0x1p-36f;
}
__device__ __forceinline__ float rdl(float v, int lane) { return __builtin_bit_cast(float, __builtin_amdgcn_readlane(__builtin_bit_cast(int, v), lane)); }
__device__ __forceinline__ float wave_sum(float v) {
#pragma unroll
    for (int o = 1; o < 64; o <<= 1) v += __shfl_xor(v, o);
    return v;
}

namespace pg8 {
constexpr int BM = 256, BK = 64, HALF = 128, HTB = HALF * BK * 2, STAGE_BYTES = 8 * HTB;
__host__ __device__ __forceinline__ int lds_byte(int r, int c) { const int st = (r >> 4) * 2 + (c >> 5), rr = r & 15, cc = c & 31, ob = rr * 64 + cc * 2; return st * 1024 + (ob ^ (((ob >> 9) & 1) << 5)); }
__host__ __device__ __forceinline__ void stage_rc(int b, int& R, int& C) { const int st = b / 1024, sb = b % 1024, swz = sb ^ (((sb >> 9) & 1) << 5); R = (st >> 1) * 16 + swz / 64; C = (st & 1) * 32 + (swz % 64) / 2; }
__host__ __device__ __forceinline__ int perm32(int rho) { const int n = rho >> 4, i = rho & 15; return 8 * (i >> 2) + 4 * n + (i & 3); }

struct GUnit { int pm, pn, e, j, nvalid; const char* B; };

typedef int v8i __attribute__((ext_vector_type(8)));
typedef int v4i __attribute__((ext_vector_type(4)));
template <int DT> __device__ __forceinline__ f32x4 mma_tile(const v8i a, const v8i b, f32x4 c, int scA) {
    if constexpr (DT == 2) return __builtin_amdgcn_mfma_scale_f32_16x16x128_f8f6f4(a, b, c, 0, 0, 0, scA, 1, scA);
    else { const v4i a0 = __builtin_shufflevector(a, a, 0, 1, 2, 3), a1 = __builtin_shufflevector(a, a, 4, 5, 6, 7), b0 = __builtin_shufflevector(b, b, 0, 1, 2, 3), b1 = __builtin_shufflevector(b, b, 4, 5, 6, 7);
        if constexpr (DT == 1) { c = __builtin_amdgcn_mfma_f32_16x16x32_f16(__builtin_bit_cast(half8, a0), __builtin_bit_cast(half8, b0), c, 0, 0, 0); return __builtin_amdgcn_mfma_f32_16x16x32_f16(__builtin_bit_cast(half8, a1), __builtin_bit_cast(half8, b1), c, 0, 0, 0); }
        else { c = __builtin_amdgcn_mfma_f32_16x16x32_bf16(__builtin_bit_cast(bf16x8, a0), __builtin_bit_cast(bf16x8, b0), c, 0, 0, 0); return __builtin_amdgcn_mfma_f32_16x16x32_bf16(__builtin_bit_cast(bf16x8, a1), __builtin_bit_cast(bf16x8, b1), c, 0, 0, 0); } }
}

template <class Epi, class Sched, int DT, bool ALIGN_EPI>
__device__ __forceinline__ void gemm_phase(LAS unsigned char* lds, const char* Abase, const int K, const Sched& S, const Epi& E, const int scB = SC_ONE) {
    const int tid = threadIdx.x, wid = __builtin_amdgcn_readfirstlane(tid >> 6), lane = tid & 63, wr = wid >> 2, wc = wid & 3, fr = lane & 15, fq = lane >> 4;
    constexpr int ES = (DT == 2) ? 1 : 2;
    const int RB = K * ES;
    const int nt = RB / 128;
    unsigned voffB0; { int R, C; stage_rc(tid * 16, R, C); const int Rb = Epi::PERM ? ((R & ~31) + perm32(R & 31)) : R; voffB0 = (unsigned)(Rb * RB + C * 2); }
    const unsigned voffBd = 64u * (unsigned)RB;
#define PG8_AOFF(V, UNIT) do { int t_ = threadIdx.x; asm volatile("" : "+v"(t_)); _Pragma("unroll") for (int _i = 0; _i < 2; ++_i) { int R_, C_; stage_rc(t_ * 16 + _i * 8192, R_, C_); \
        _Pragma("unroll") for (int _h = 0; _h < 2; ++_h) (V)[_h][_i] = (unsigned)S.arow(UNIT, R_ + HALF * _h) * (unsigned)RB + (unsigned)(C_ * 2); } } while (0)
    const size_t kstep = (size_t)(BK * 2);
    const size_t hstep = (size_t)HALF * RB;
    const unsigned ldsw = (unsigned)wid * 1024u;
    const int ac0 = (DT == 2) ? 16 * fq : 8 * fq; constexpr int CH1 = (DT == 2) ? 16 : 1024;
    const int aoff = lds_byte(wr * 64 + fr, ac0), boff = lds_byte(wc * 32 + fr, ac0);
#define PG8_SA(b, h) (((b) * 2 + (h)) * HTB)
#define PG8_SB(b, h) ((4 + (b) * 2 + (h)) * HTB)
#define PG8_STAGEB(bufoff, gbase) do { _Pragma("unroll") for (int _i = 0; _i < 2; ++_i) \
        __builtin_amdgcn_global_load_lds((const unsigned*)((const char*)(gbase) + voffB0 + _i * voffBd), (LAS unsigned*)(lds + (bufoff) + ldsw + _i * 8192), 16, 0, 0); } while (0)
#define PG8_STAGEA(bufoff, koff, V, h) do { _Pragma("unroll") for (int _i = 0; _i < 2; ++_i) \
        __builtin_amdgcn_global_load_lds((const unsigned*)(Abase + (size_t)(V)[h][_i] + (koff)), (LAS unsigned*)(lds + (bufoff) + ldsw + _i * 8192), 16, 0, 0); } while (0)
#define PG8_LDA(dst, b, h) do { _Pragma("unroll") for (int m = 0; m < 4; ++m) { const v4i c0_ = *(const LAS v4i*)(lds + PG8_SA(b, h) + aoff + m * 2048), c1_ = *(const LAS v4i*)(lds + PG8_SA(b, h) + aoff + m * 2048 + CH1); dst[m] = __builtin_shufflevector(c0_, c1_, 0, 1, 2, 3, 4, 5, 6, 7); } } while (0)
#define PG8_LDB(dst, b, h) do { _Pragma("unroll") for (int n = 0; n < 2; ++n) { const v4i c0_ = *(const LAS v4i*)(lds + PG8_SB(b, h) + boff + n * 2048), c1_ = *(const LAS v4i*)(lds + PG8_SB(b, h) + boff + n * 2048 + CH1); dst[n] = __builtin_shufflevector(c0_, c1_, 0, 1, 2, 3, 4, 5, 6, 7); } } while (0)
#define PG8_MMA(ai, bj, At, Bt) do { __builtin_amdgcn_s_setprio(1); _Pragma("unroll") for (int m = 0; m < 4; ++m) _Pragma("unroll") for (int n = 0; n < 2; ++n) \
        acc[ai][bj][m][n] = mma_tile<DT>(Bt[n], At[m], acc[ai][bj][m][n], scB); __builtin_amdgcn_s_setprio(0); } while (0)
#define PG8_WAIT_V(n) asm volatile("s_waitcnt vmcnt(" #n ")" ::: "memory")
#define PG8_WAIT_VE(pe) do { if (pe) asm volatile("s_waitcnt vmcnt(%0)" :: "n"(8 + Epi::NSTORE) : "memory"); else asm volatile("s_waitcnt vmcnt(8)" ::: "memory"); } while (0)
#define PG8_WAIT_L(n) asm volatile("s_waitcnt lgkmcnt(" #n ")" ::: "memory")
#define PG8_BAR __builtin_amdgcn_s_barrier()
#define PG8_SCHED __builtin_amdgcn_sched_barrier(0)
    GUnit cur, nxt; int ui = 0;
    if (!S.next(0, cur)) return;
    f32x4 acc[2][2][4][2];
#pragma unroll
    for (int a = 0; a < 2; ++a)
#pragma unroll
        for (int b = 0; b < 2; ++b)
#pragma unroll
            for (int m = 0; m < 4; ++m)
#pragma unroll
                for (int n = 0; n < 2; ++n) acc[a][b][m][n] = (f32x4){0.f, 0.f, 0.f, 0.f};
    v8i At[4], B0[2], B1[2];
    unsigned vA[2][2];
    PG8_AOFF(vA, cur);
    if constexpr (Sched::GATHER) VM_WAIT();
    const char* cB = cur.B;
    E.pre(lds, cur, 0, wid, lane);
    PG8_STAGEB(PG8_SB(0, 0), cB); PG8_STAGEB(PG8_SB(0, 1), cB + hstep); PG8_STAGEA(PG8_SA(0, 0), 0, vA, 0); PG8_STAGEA(PG8_SA(0, 1), 0, vA, 1);
    if (wr == 1) PG8_BAR;
    PG8_WAIT_V(2); PG8_BAR;
    PG8_STAGEB(PG8_SB(1, 0), cB + kstep); PG8_STAGEA(PG8_SA(1, 0), kstep, vA, 0); PG8_STAGEB(PG8_SB(1, 1), cB + hstep + kstep);
    PG8_WAIT_V(6); PG8_BAR;
    for (;;) {
        const bool has_next = S.next(ui + 1, nxt);
#pragma unroll 1
        for (int t = 0; t < nt; t += 2) {
            const bool last = (t == nt - 2);
            const bool pe = POSTEPI_WAITS && (t == 0) && (ui > 0);
            const size_t k1 = (size_t)(t + 1) * kstep;
            PG8_LDB(B0, 0, 0); PG8_LDB(B1, 0, 1); PG8_SCHED; PG8_LDA(At, 0, 0); PG8_STAGEA(PG8_SA(1, 1), k1, vA, 1);
            PG8_WAIT_VE(pe); PG8_WAIT_L(0); PG8_BAR; PG8_MMA(0, 0, At, B0); PG8_MMA(0, 1, At, B1); PG8_BAR; PG8_SCHED;
            size_t k2 = (size_t)(t + 2) * kstep;
            if (last) { k2 = 0; if (has_next) { PG8_AOFF(vA, nxt); if constexpr (Sched::GATHER) VM_WAIT(); cB = nxt.B; } }
            const size_t k3 = k2 + kstep; const char* b2 = cB + k2; const char* b3 = b2 + kstep;
            PG8_LDA(At, 0, 1); PG8_STAGEB(PG8_SB(0, 0), b2); PG8_STAGEB(PG8_SB(0, 1), b2 + hstep); PG8_STAGEA(PG8_SA(0, 0), k2, vA, 0);
            PG8_WAIT_VE(pe); PG8_WAIT_L(0); PG8_BAR; PG8_MMA(1, 0, At, B0); PG8_MMA(1, 1, At, B1); PG8_BAR; PG8_SCHED;
            PG8_LDB(B0, 1, 0); PG8_LDB(B1, 1, 1); PG8_SCHED; PG8_LDA(At, 1, 0); PG8_STAGEA(PG8_SA(0, 1), k2, vA, 1);
            PG8_WAIT_V(8); PG8_WAIT_L(0); PG8_BAR; PG8_MMA(0, 0, At, B0); PG8_MMA(0, 1, At, B1); PG8_BAR; PG8_SCHED;
            PG8_LDA(At, 1, 1); PG8_STAGEB(PG8_SB(1, 0), b3); PG8_STAGEB(PG8_SB(1, 1), b3 + hstep); PG8_STAGEA(PG8_SA(1, 0), k3, vA, 0);
            PG8_WAIT_V(8); PG8_WAIT_L(0); PG8_BAR; PG8_MMA(1, 0, At, B0); PG8_MMA(1, 1, At, B1); PG8_BAR; PG8_SCHED;
        }
        if constexpr (ALIGN_EPI) { if (wr == 0) PG8_BAR; }
        { int tx = threadIdx.x; asm volatile("" : "+v"(tx)); E(acc, cur, wr, wc, tx & 15, (tx >> 4) & 3, lds, ui); }
        if (!has_next) break;
#pragma unroll
        for (int a = 0; a < 2; ++a)
#pragma unroll
            for (int b = 0; b < 2; ++b)
#pragma unroll
                for (int m = 0; m < 4; ++m)
#pragma unroll
                    for (int n = 0; n < 2; ++n) acc[a][b][m][n] = (f32x4){0.f, 0.f, 0.f, 0.f};
        cur = nxt; ++ui;
        if constexpr (ALIGN_EPI) { if (wr == 1) PG8_BAR; }
        E.pre(lds, cur, ui, wid, lane);
    }
    PG8_WAIT_V(0);
    if constexpr (!ALIGN_EPI) { if (wr == 0) PG8_BAR; }
    PG8_BAR;
#undef PG8_SA
#undef PG8_SB
#undef PG8_STAGEA
#undef PG8_AOFF
#undef PG8_STAGEB
#undef PG8_LDA
#undef PG8_LDB
#undef PG8_MMA
#undef PG8_WAIT_V
#undef PG8_WAIT_VE
#undef PG8_WAIT_L
#undef PG8_BAR
#undef PG8_SCHED
}
}

namespace attn_body {
using bf16 = __hip_bfloat16;
using s16x4 = __attribute__((ext_vector_type(4))) short;
using f32x16 = __attribute__((ext_vector_type(16))) float;
constexpr int D = 64, DMQ = QW, DMKV = KVW, DMO = DM;
constexpr int NW = 8, QBLK = 32, QB = QBLK * NW, KVBLK = 64, NT = LKV / KVBLK;
static_assert(NT % 2 == 0 && NT >= 8, "tile count");
__device__ __forceinline__ int crow(int r, int hi) { return (r & 3) + 8 * (r >> 2) + 4 * hi; }
#define SBAR() __builtin_amdgcn_sched_barrier(0)
constexpr int NSLOTR = 3, SLOTB = 8192;
constexpr int LDS_K = 0, LDS_V = NSLOTR * SLOTB, LDS_WS = 2 * NSLOTR * SLOTB, LDS_OST = LDS_WS + NW * 64 * 4, ATT_LDS_BYTES = LDS_OST + NW * 4096;
__device__ __forceinline__ void glds16(const void* gsrc, unsigned lds_dst) { unsigned keep;
    asm volatile("s_mov_b32 %0, m0\n\ts_mov_b32 m0, %2\n\ts_nop 0\n\tglobal_load_lds_dwordx4 %1, off\n\ts_mov_b32 m0, %0" : "=&s"(keep) : "v"(gsrc), "s"(lds_dst) : "memory"); }
__device__ __forceinline__ float max3f(float a, float b, float c) { float r; asm("v_max3_f32 %0, %1, %2, %3" : "=v"(r) : "v"(a), "v"(b), "v"(c)); return r; }
__device__ __forceinline__ float max2f(float a, float b) { float r; asm("v_max_f32_e32 %0, %1, %2" : "=v"(r) : "v"(a), "v"(b)); return r; }
__device__ __forceinline__ float fadd_s(float a, float b) { float r; asm("v_add_f32_e32 %0, %1, %2" : "=v"(r) : "v"(a), "v"(b)); return r; }
__device__ __forceinline__ float fsub_s(float a, float b) { float r; asm("v_sub_f32_e32 %0, %1, %2" : "=v"(r) : "v"(a), "v"(b)); return r; }
typedef float f32x2_t __attribute__((ext_vector_type(2))); typedef __bf16 bf16x2_t __attribute__((ext_vector_type(2)));
__device__ __forceinline__ unsigned cvtpk_s(float lo, float hi) { f32x2_t v = {lo, hi}; bf16x2_t b = __builtin_convertvector(v, bf16x2_t); return __builtin_bit_cast(unsigned, b); }
#define WAIT_BAR(N) asm volatile("s_waitcnt vmcnt(" #N ") lgkmcnt(0)\n\ts_barrier" ::: "memory")

__device__ __forceinline__ void qkt(f32x16& p0, f32x16& p1, const char* Kslot, const bf16x8* qr, const f32x16& negm, int r32, int hi) {
    const char* kb = Kslot + hi * 1024 + r32 * 16;
#pragma unroll
    for (int d0 = 0; d0 < 4; ++d0) {
        const bf16x8 b0 = *reinterpret_cast<const bf16x8*>(kb + d0 * 2048);
        const bf16x8 b1 = *reinterpret_cast<const bf16x8*>(kb + d0 * 2048 + 512);
        if (d0 == 0) { p0 = __builtin_amdgcn_mfma_f32_32x32x16_bf16(b0, qr[0], negm, 0, 0, 0); p1 = __builtin_amdgcn_mfma_f32_32x32x16_bf16(b1, qr[0], negm, 0, 0, 0); }
        else { p0 = __builtin_amdgcn_mfma_f32_32x32x16_bf16(b0, qr[d0], p0, 0, 0, 0); p1 = __builtin_amdgcn_mfma_f32_32x32x16_bf16(b1, qr[d0], p1, 0, 0, 0); } }
}
typedef __attribute__((address_space(3))) const char* lds_cptr;
typedef short v4i16_t __attribute__((ext_vector_type(4)));
__device__ __forceinline__ void kload8(bf16x8* kf, lds_cptr kp) {
    kf[0] = *(const __attribute__((address_space(3))) bf16x8*)(kp);        kf[1] = *(const __attribute__((address_space(3))) bf16x8*)(kp + 512);
    kf[2] = *(const __attribute__((address_space(3))) bf16x8*)(kp + 2048); kf[3] = *(const __attribute__((address_space(3))) bf16x8*)(kp + 2560);
    kf[4] = *(const __attribute__((address_space(3))) bf16x8*)(kp + 4096); kf[5] = *(const __attribute__((address_space(3))) bf16x8*)(kp + 4608);
    kf[6] = *(const __attribute__((address_space(3))) bf16x8*)(kp + 6144); kf[7] = *(const __attribute__((address_space(3))) bf16x8*)(kp + 6656);
}
__device__ __forceinline__ void kload2(bf16x8* kf, lds_cptr kp, int j) { kf[2 * j] = *(const __attribute__((address_space(3))) bf16x8*)(kp + j * 2048); kf[2 * j + 1] = *(const __attribute__((address_space(3))) bf16x8*)(kp + j * 2048 + 512); }
__device__ __forceinline__ s16x4 vtr(lds_cptr p) { return __builtin_bit_cast(s16x4, __builtin_amdgcn_ds_read_tr16_b64_v4i16((__attribute__((address_space(3))) v4i16_t*)p)); }
__device__ __forceinline__ float rowmax(const f32x16& p0, const f32x16& p1) {
    float a = max3f(p0[0], p0[1], p1[0]), b = max3f(p0[2], p0[3], p1[1]); a = max3f(a, p1[2], p1[3]);
#pragma unroll
    for (int r = 4; r < 16; r += 4) { a = max3f(a, p0[r], p0[r + 1]); b = max3f(b, p0[r + 2], p0[r + 3]); a = max3f(a, p1[r], p1[r + 1]); b = max3f(b, p1[r + 2], p1[r + 3]); }
    const float m = max2f(a, b);
    auto rr = __builtin_amdgcn_permlane32_swap(__float_as_uint(m), __float_as_uint(m), false, false);
    return max2f(__uint_as_float(rr[0]), __uint_as_float(rr[1]));
}
__device__ __forceinline__ void pv(f32x16* o, int vb, bf16x8 pa0, bf16x8 pa1, bf16x8 pa2, bf16x8 pa3) {
#pragma unroll
    for (int d0 = 0; d0 < 2; ++d0) { s16x4 lo[4], hi[4];
#pragma unroll
        for (int ks = 0; ks < 4; ++ks) {
            asm volatile("ds_read_b64_tr_b16 %0,%1 offset:%c2" : "=&v"(lo[ks]) : "v"(vb), "i"(d0 * 4096 + ks * 1024) : "memory");
            asm volatile("ds_read_b64_tr_b16 %0,%1 offset:%c2" : "=&v"(hi[ks]) : "v"(vb), "i"(d0 * 4096 + ks * 1024 + 512) : "memory"); }
        asm volatile("s_waitcnt lgkmcnt(0)" ::: "memory"); SBAR();
#define PK(k) (bf16x8){lo[k][0], lo[k][1], lo[k][2], lo[k][3], hi[k][0], hi[k][1], hi[k][2], hi[k][3]}
        o[d0] = __builtin_amdgcn_mfma_f32_32x32x16_bf16(pa0, PK(0), o[d0], 0, 0, 0);
        o[d0] = __builtin_amdgcn_mfma_f32_32x32x16_bf16(pa1, PK(1), o[d0], 0, 0, 0);
        o[d0] = __builtin_amdgcn_mfma_f32_32x32x16_bf16(pa2, PK(2), o[d0], 0, 0, 0);
        o[d0] = __builtin_amdgcn_mfma_f32_32x32x16_bf16(pa3, PK(3), o[d0], 0, 0, 0);
#undef PK
    }
}
template <bool MS> __device__ __forceinline__ void attn_unit(int b, int h, int qb, const bf16* Q, const bf16* __restrict__ K, const bf16* __restrict__ V, bf16* O, char* shm, float negM_) {
    const int tid = threadIdx.x, lane = tid & 63, r32 = lane & 31, hi = lane >> 5; const int wid = __builtin_amdgcn_readfirstlane(tid >> 6);
    const int q0 = qb * QB; const int kvh = h / 3;
    const long qrow0 = (long)b * SEQ + q0 + wid * QBLK;
    const long kvrow0 = (long)b * LKV;
    const bf16* Qw = Q + qrow0 * DMQ + h * D;
    const bf16* Kh = K + kvrow0 * DMKV + kvh * D, *Vh = V + kvrow0 * DMKV + kvh * D;
    const unsigned lds0 = (unsigned)(uintptr_t)shm;
    float* wsf = (float*)(shm + LDS_WS) + wid * 64;
    const bf16* ksrc = Kh + (long)lane * DMKV + wid * 8;
    const bf16* vsrc = Vh + (long)(16 * (wid & 3) + (lane >> 2)) * DMKV + (wid >> 2) * 32 + (lane & 3) * 8;
    const unsigned kdst = lds0 + LDS_K + wid * 1024, vdst = lds0 + LDS_V + wid * 1024;
#define DMA_K(t, slot) glds16(ksrc + (long)(t) * KVBLK * DMKV, (unsigned)__builtin_amdgcn_readfirstlane(kdst + (slot)))
#define DMA_V(t, slot) glds16(vsrc + (long)(t) * KVBLK * DMKV, (unsigned)__builtin_amdgcn_readfirstlane(vdst + (slot)))
    const int vb0 = (int)(lds0 + LDS_V) + ((lane >> 4) & 1) * 32 + (lane & 3) * 8 + (4 * hi + ((lane & 15) >> 2)) * 64;
    const char* Kbase = shm + LDS_K; bf16x8 kf[8];
    const lds_cptr shm3 = (lds_cptr)shm; const lds_cptr kp0 = shm3 + LDS_K + hi * 1024 + r32 * 16; const lds_cptr vp0 = shm3 + LDS_V + ((lane >> 4) & 1) * 32 + (lane & 3) * 8 + (4 * hi + ((lane & 15) >> 2)) * 64;
    DMA_K(0, 0); DMA_V(0, 0); DMA_K(1, SLOTB);
    bf16x8 qr[4];
#pragma unroll
    for (int d0 = 0; d0 < 4; ++d0) qr[d0] = *reinterpret_cast<const bf16x8*>(&Qw[(long)r32 * DMQ + d0 * 16 + hi * 8]);
    float l_reg = 0.f; f32x16 o[2]; o[0] = f32x16{}; o[1] = f32x16{}; f32x16 negm = f32x16{}; f32x16 lacc = f32x16{};
    if constexpr (!MS) { _Pragma("unroll") for (int r = 0; r < 16; ++r) negm[r] = negM_; asm volatile("" : "+v"(negm)); }
    const bf16x8 ONES = (bf16x8){0x3F80, 0x3F80, 0x3F80, 0x3F80, 0x3F80, 0x3F80, 0x3F80, 0x3F80};
#define START(P0, P1) do { _Pragma("unroll") for (int r = 0; r < 16; ++r) P0[r] = __builtin_amdgcn_exp2f(P0[r]); } while (0)
#define RESC() do { } while (0)
    f32x16 pA0, pA1, pB0, pB1;
    int sl_prev = 0, sl_cur = 0, sl_next = SLOTB;
#define ROT() do { sl_prev = sl_cur; sl_cur = sl_next; sl_next = (sl_next == (NSLOTR - 1) * SLOTB) ? 0 : sl_next + SLOTB; } while (0)
    DMA_K(2, 2 * SLOTB);
    WAIT_BAR(3);
    qkt(pA0, pA1, Kbase, qr, negm, r32, hi); asm volatile("s_nop 15\n\ts_nop 7" : "+v"(pA0), "+v"(pA1));
    START(pA0, pA1);
    _Pragma("unroll") for (int r = 0; r < 16; ++r) pA1[r] = __builtin_amdgcn_exp2f(pA1[r]);
    WAIT_BAR(0);
    DMA_K(3, 0); DMA_V(1, SLOTB);
    ROT();
    kload8(kf, kp0 + sl_cur);
    WAIT_BAR(2);
    s16x4 vlo[8], vhi[8]; u32x4 pw0, pw1, pw2, pw3;
#define PKW(P, B) cvtpk_s(P[B], P[B + 1])
#define PAF(k) __builtin_bit_cast(bf16x8, pw##k)
#define VFR(i) (bf16x8){vlo[i][0], vlo[i][1], vlo[i][2], vlo[i][3], vhi[i][0], vhi[i][1], vhi[i][2], vhi[i][3]}
#define PIN(x) asm volatile("" : "+v"(x))
#define MX3(a, b, c) __builtin_fmaxf(__builtin_fmaxf((a), (b)), (c))
#define GAPA(MF, A0, A1, A2, A3, W0, W1, PW) do { MF; if constexpr (!MS) { sacc += A0; sacc += A1; sacc += A2; sacc += A3; PIN(sacc); } W0; W1; PIN(PW); SBAR(); } while (0)
#define LSUM(k) do { if constexpr (MS) lacc = __builtin_amdgcn_mfma_f32_32x32x16_bf16(PAF(k), ONES, lacc, 0, 0, 0); } while (0)
#define EX(v) __builtin_amdgcn_exp2f(v)
#define GAPB(MF, X, B) do { MF; X[B] = EX(X[B]); X[B + 1] = EX(X[B + 1]); X[B + 2] = EX(X[B + 2]); X[B + 3] = EX(X[B + 3]); PIN(X); SBAR(); } while (0)
#define VRD(i) do { vlo[i] = vtr(vp_ + (((i) >> 2) * 4096 + ((i) & 3) * 1024)); vhi[i] = vtr(vp_ + (((i) >> 2) * 4096 + ((i) & 3) * 1024 + 512)); } while (0)
#define KRD(G, j) do { if (G) { kload2(kf, kp0 + sl_next, j); SBAR(); } } while (0)
#define STEP(C0, C1, P0, P1, t, GK, GV, GL) do { SBAR(); \
    const lds_cptr vp_ = vp0 + sl_prev; \
    VRD(0); SBAR(); float sacc = MS ? 0.f : (P0[0] + P0[1]); \
    GAPA(C0 = __builtin_amdgcn_mfma_f32_32x32x16_bf16(kf[0], qr[0], negm, 0, 0, 0), P0[2], P0[3], P0[4], P0[5],     pw0[0] = PKW(P0, 0), pw0[1] = PKW(P0, 2), pw0); \
    VRD(4); SBAR(); GAPA(C1 = __builtin_amdgcn_mfma_f32_32x32x16_bf16(kf[1], qr[0], negm, 0, 0, 0), P0[6], P0[7], P0[8], P0[9],     pw0[2] = PKW(P0, 4), pw0[3] = PKW(P0, 6), pw0); \
    VRD(1); SBAR(); GAPA(C0 = __builtin_amdgcn_mfma_f32_32x32x16_bf16(kf[2], qr[1], C0, 0, 0, 0),   P0[10], P0[11], P0[12], P0[13], pw1[0] = PKW(P0, 8), pw1[1] = PKW(P0, 10), pw1); \
    VRD(5); SBAR(); GAPA(C1 = __builtin_amdgcn_mfma_f32_32x32x16_bf16(kf[3], qr[1], C1, 0, 0, 0),   P0[14], P0[15], P1[0], P1[1],   pw1[2] = PKW(P0, 12), pw1[3] = PKW(P0, 14), pw1); \
    VRD(2); SBAR(); GAPA(C0 = __builtin_amdgcn_mfma_f32_32x32x16_bf16(kf[4], qr[2], C0, 0, 0, 0),   P1[2], P1[3], P1[4], P1[5],     pw2[0] = PKW(P1, 0), pw2[1] = PKW(P1, 2), pw2); \
    VRD(6); SBAR(); GAPA(C1 = __builtin_amdgcn_mfma_f32_32x32x16_bf16(kf[5], qr[2], C1, 0, 0, 0),   P1[6], P1[7], P1[8], P1[9],     pw2[2] = PKW(P1, 4), pw2[3] = PKW(P1, 6), pw2); \
    VRD(3); SBAR(); GAPA(C0 = __builtin_amdgcn_mfma_f32_32x32x16_bf16(kf[6], qr[3], C0, 0, 0, 0),   P1[10], P1[11], P1[12], P1[13], pw3[0] = PKW(P1, 8), pw3[1] = PKW(P1, 10), pw3); \
    VRD(7); SBAR(); GAPA(C1 = __builtin_amdgcn_mfma_f32_32x32x16_bf16(kf[7], qr[3], C1, 0, 0, 0),   P1[14], P1[15], 0.f, 0.f,       pw3[2] = PKW(P1, 12), pw3[3] = PKW(P1, 14), pw3); \
    if constexpr (!MS) l_reg += sacc; \
    if (GK) { DMA_K((t) + 3, sl_cur); } if (GV) { DMA_V((t) + 1, sl_next); } \
    SBAR(); \
    GAPB(o[0] = __builtin_amdgcn_mfma_f32_32x32x16_bf16(PAF(0), VFR(0), o[0], 0, 0, 0), C0, 0); \
    GAPB(o[1] = __builtin_amdgcn_mfma_f32_32x32x16_bf16(PAF(0), VFR(4), o[1], 0, 0, 0), C0, 4); LSUM(0); \
    KRD(GL, 0); GAPB(o[0] = __builtin_amdgcn_mfma_f32_32x32x16_bf16(PAF(1), VFR(1), o[0], 0, 0, 0), C0, 8); \
    KRD(GL, 1); GAPB(o[1] = __builtin_amdgcn_mfma_f32_32x32x16_bf16(PAF(1), VFR(5), o[1], 0, 0, 0), C0, 12); LSUM(1); \
    KRD(GL, 2); GAPB(o[0] = __builtin_amdgcn_mfma_f32_32x32x16_bf16(PAF(2), VFR(2), o[0], 0, 0, 0), C1, 0); \
    KRD(GL, 3); GAPB(o[1] = __builtin_amdgcn_mfma_f32_32x32x16_bf16(PAF(2), VFR(6), o[1], 0, 0, 0), C1, 4); LSUM(2); \
    GAPB(o[0] = __builtin_amdgcn_mfma_f32_32x32x16_bf16(PAF(3), VFR(3), o[0], 0, 0, 0), C1, 8); \
    GAPB(o[1] = __builtin_amdgcn_mfma_f32_32x32x16_bf16(PAF(3), VFR(7), o[1], 0, 0, 0), C1, 12); LSUM(3); \
    } while (0)
    int t = 1;
    for (; t + 5 < NT; t += 2) {
        STEP(pB0, pB1, pA0, pA1, t, true, true, true);     WAIT_BAR(2); RESC(); ROT();
        STEP(pA0, pA1, pB0, pB1, t + 1, true, true, true); WAIT_BAR(2); RESC(); ROT();
    }
#define ENDW(tt) do { if ((tt) + 3 < NT) { WAIT_BAR(2); } else if ((tt) + 2 < NT) { WAIT_BAR(1); } else { WAIT_BAR(0); } } while (0)
    for (; t + 1 < NT; t += 2) {
        STEP(pB0, pB1, pA0, pA1, t, (t + 3 < NT), (t + 1 < NT), (t + 1 < NT));         ENDW(t);     RESC(); ROT();
        STEP(pA0, pA1, pB0, pB1, t + 1, (t + 4 < NT), (t + 2 < NT), (t + 2 < NT));     ENDW(t + 1); RESC(); ROT();
    }
    STEP(pB0, pB1, pA0, pA1, NT - 1, false, false, false); RESC();
    { if constexpr (!MS) { float sacc = pB0[0] + pB0[1]; _Pragma("unroll") for (int r = 2; r < 16; ++r) sacc += pB0[r]; _Pragma("unroll") for (int r = 0; r < 16; ++r) sacc += pB1[r]; l_reg += sacc; }
      pw0 = (u32x4){PKW(pB0, 0), PKW(pB0, 2), PKW(pB0, 4), PKW(pB0, 6)}; pw1 = (u32x4){PKW(pB0, 8), PKW(pB0, 10), PKW(pB0, 12), PKW(pB0, 14)}; pw2 = (u32x4){PKW(pB1, 0), PKW(pB1, 2), PKW(pB1, 4), PKW(pB1, 6)}; pw3 = (u32x4){PKW(pB1, 8), PKW(pB1, 10), PKW(pB1, 12), PKW(pB1, 14)};
      SBAR(); pv(o, vb0 + sl_cur, PAF(0), PAF(1), PAF(2), PAF(3)); LSUM(0); LSUM(1); LSUM(2); LSUM(3); }
#undef LSUM
#undef PKW
#undef PAF
#undef VFR
#undef PIN
#undef MX3
#undef GAPA
#undef GAPB
#undef EX
#undef VRD
#undef KRD
#undef STEP
#undef ENDW
    float rli[16];
    if constexpr (MS) {
#pragma unroll
        for (int r = 0; r < 16; ++r) rli[r] = __builtin_amdgcn_rcpf(lacc[r]);
    } else {
        { auto rr = __builtin_amdgcn_permlane32_swap(__float_as_uint(l_reg), __float_as_uint(l_reg), false, false); l_reg = __uint_as_float(rr[0]) + __uint_as_float(rr[1]); }
        if (hi == 0) wsf[32 + r32] = l_reg; asm volatile("s_waitcnt lgkmcnt(0)" ::: "memory");
#pragma unroll
        for (int r = 0; r < 16; ++r) rli[r] = __builtin_amdgcn_rcpf(wsf[32 + crow(r, hi)]);
    }
    bf16* Ow = O + qrow0 * DMO + h * D;
    { bf16* stg = (bf16*)(shm + LDS_OST) + wid * 2048;
#pragma unroll
      for (int r = 0; r < 16; ++r) { const int orow = crow(r, hi);
#pragma unroll
        for (int d0 = 0; d0 < 2; ++d0) stg[orow * 64 + d0 * 32 + r32] = __float2bfloat16(o[d0][r] * rli[r]); }
      asm volatile("s_waitcnt lgkmcnt(0)" ::: "memory");
#pragma unroll
      for (int i = 0; i < 4; ++i) { const int row = i * 8 + (lane >> 3), ch = lane & 7; const u32x4 v = *(const u32x4*)(stg + row * 64 + ch * 8); *(u32x4*)(Ow + (long)row * DMO + ch * 8) = v; } }
    asm volatile("s_waitcnt lgkmcnt(0)\n\ts_barrier" ::: "memory");
#undef DMA_K
#undef DMA_V
#undef START
#undef RESC
#undef ROT
}
#undef SBAR
#undef WAIT_BAR

typedef int v8i_t __attribute__((ext_vector_type(8)));
typedef int v4i_t __attribute__((ext_vector_type(4)));
__host__ __device__ __forceinline__ int vt_slot(int k) { const int hi = (k >> 2) & 1, r = (k & 3) + 4 * ((k & 31) >> 3); return 32 * hi + r + 16 * (k >> 5); }
constexpr int SLOT8 = 4096, NS8 = 6, L8_K = 0, L8_V = NS8 * SLOT8;
static_assert(L8_V + NS8 * SLOT8 <= LDS_WS, "fp8 rings below the per-wave scratch");
constexpr int SC_QK = 0x7c7f, SC_PV = 0x7f7f;
__device__ __forceinline__ v8i_t ld32(lds_cptr p, int o0, int o1) { const v4i_t a = *(const __attribute__((address_space(3))) v4i_t*)(p + o0), b = *(const __attribute__((address_space(3))) v4i_t*)(p + o1); return __builtin_shufflevector(a, b, 0, 1, 2, 3, 4, 5, 6, 7); }
#define SBAR() __builtin_amdgcn_sched_barrier(0)
#define WAIT_BAR(N) asm volatile("s_waitcnt vmcnt(" #N ") lgkmcnt(0)\n\ts_barrier" ::: "memory")
__device__ __forceinline__ void attn_unit8(int b, int h, int qb, const unsigned char* Q8, const unsigned char* K8, const unsigned char* Vt8, bf16* O, char* shm, float negM_) {
    int tid = threadIdx.x; asm volatile("" : "+v"(tid));
    const int lane = tid & 63, r32 = lane & 31, hi = lane >> 5; const int wid = __builtin_amdgcn_readfirstlane(tid >> 6);
    const int q0 = qb * QB; const int kvh = h / 3; const bool kw = wid < 4;
    const long qrow0 = (long)b * SEQ + q0 + wid * QBLK;
    const unsigned lds0 = (unsigned)(uintptr_t)shm;
    const int drow = 16 * (wid & 3) + (lane >> 2), dch = (lane & 3) ^ ((drow >> 2) & 3);
    const unsigned char* ksrc = K8 + ((long)b * LKV + drow) * DMKV + kvh * D + dch * 16;
    const unsigned char* vsrc = Vt8 + ((long)(b * NKVH + kvh) * (LKV / 64)) * 4096 + drow * 64 + dch * 16;
    const unsigned kdst = lds0 + L8_K + (wid & 3) * 1024, vdst = lds0 + L8_V + (wid & 3) * 1024;
#define DMA8_K(t, slot) glds16(ksrc + (long)(t) * KVBLK * DMKV, (unsigned)__builtin_amdgcn_readfirstlane(kdst + (slot)))
#define DMA8_V(t, slot) glds16(vsrc + (long)(t) * 4096, (unsigned)__builtin_amdgcn_readfirstlane(vdst + (slot)))
    const lds_cptr shm3 = (lds_cptr)shm; const int sw = (r32 >> 2) & 3, c0o = ((2 * hi) ^ sw) * 16, c1o = ((2 * hi + 1) ^ sw) * 16;
    const lds_cptr kp0 = shm3 + L8_K + r32 * 64; const lds_cptr vp0 = shm3 + L8_V + r32 * 64;
    if (kw) { DMA8_K(0, 0); DMA8_K(1, SLOT8); DMA8_K(2, 2 * SLOT8); DMA8_K(3, 3 * SLOT8); DMA8_K(4, 4 * SLOT8); } else { DMA8_V(0, 0); DMA8_V(1, SLOT8); DMA8_V(2, 2 * SLOT8); }
    const v8i_t qr = *reinterpret_cast<const v8i_t*>(Q8 + (qrow0 + r32) * DMQ + h * D + hi * 32);
    f32x16 o[2]; o[0] = f32x16{}; o[1] = f32x16{}; f32x16 negm; f32x16 lacc = f32x16{};
    _Pragma("unroll") for (int r = 0; r < 16; ++r) negm[r] = negM_;
    asm volatile("" : "+v"(negm));
    const v8i_t ONES8 = (v8i_t){0x38383838, 0x38383838, 0x38383838, 0x38383838, 0x38383838, 0x38383838, 0x38383838, 0x38383838};
    f32x16 c0, c1; v8i_t kf[2], vf[2], pw = (v8i_t){0, 0, 0, 0, 0, 0, 0, 0};
    int s0 = 0, s1 = SLOT8, s2 = 2 * SLOT8, s3 = 3 * SLOT8, s5 = 5 * SLOT8;
#define NXT8(x) (((x) == (NS8 - 1) * SLOT8) ? 0 : (x) + SLOT8)
#define ROT8() do { s0 = s1; s1 = s2; s2 = s3; s3 = NXT8(s3); s5 = NXT8(s5); } while (0)
#define QK8() do { c0 = __builtin_amdgcn_mfma_scale_f32_32x32x64_f8f6f4(kf[0], qr, negm, 0, 0, 0, SC_QK, 1, SC_QK); c1 = __builtin_amdgcn_mfma_scale_f32_32x32x64_f8f6f4(kf[1], qr, negm, 0, 0, 0, SC_QK, 1, SC_QK); } while (0)
#define PK8(P, B, OLD) __builtin_amdgcn_cvt_pk_fp8_f32(P[B + 2], P[B + 3], __builtin_amdgcn_cvt_pk_fp8_f32(P[B], P[B + 1], OLD, false), true)
#define PV8() do { if (REP == 71) { f32x16 dz_ = __builtin_amdgcn_mfma_scale_f32_32x32x64_f8f6f4(pw, vf[0], f32x16{}, 0, 0, 0, SC_PV, 1, SC_PV); asm volatile("" :: "v"(dz_)); dz_ = __builtin_amdgcn_mfma_scale_f32_32x32x64_f8f6f4(pw, vf[1], f32x16{}, 0, 0, 0, SC_PV, 1, SC_PV); asm volatile("" :: "v"(dz_)); } \
    o[0] = __builtin_amdgcn_mfma_scale_f32_32x32x64_f8f6f4(pw, vf[0], o[0], 0, 0, 0, SC_PV, 1, SC_PV); o[1] = __builtin_amdgcn_mfma_scale_f32_32x32x64_f8f6f4(pw, vf[1], o[1], 0, 0, 0, SC_PV, 1, SC_PV); \
        lacc = __builtin_amdgcn_mfma_scale_f32_32x32x64_f8f6f4(pw, ONES8, lacc, 0, 0, 0, SC_PV, 1, SC_PV); } while (0)
#define EXPK8() do { if (REP == 70) { _Pragma("unroll") for (int r = 0; r < 16; ++r) { float d0_ = __builtin_amdgcn_exp2f(c0[r] * 0.5f), d1_ = __builtin_amdgcn_exp2f(c1[r] * 0.5f); asm volatile("" :: "v"(d0_), "v"(d1_)); } } \
    _Pragma("unroll") for (int r = 0; r < 16; ++r) { c0[r] = __builtin_amdgcn_exp2f(c0[r]); c1[r] = __builtin_amdgcn_exp2f(c1[r]); } \
        pw[0] = PK8(c0, 0, pw[0]); pw[1] = PK8(c0, 4, pw[1]); pw[2] = PK8(c0, 8, pw[2]); pw[3] = PK8(c0, 12, pw[3]); pw[4] = PK8(c1, 0, pw[4]); pw[5] = PK8(c1, 4, pw[5]); pw[6] = PK8(c1, 8, pw[6]); pw[7] = PK8(c1, 12, pw[7]); } while (0)
    WAIT_BAR(0);
    kf[0] = ld32(kp0, c0o, c1o); kf[1] = ld32(kp0 + 2048, c0o, c1o);
    QK8(); EXPK8();
    kf[0] = ld32(kp0 + SLOT8, c0o, c1o); kf[1] = ld32(kp0 + SLOT8 + 2048, c0o, c1o);
    WAIT_BAR(0);
#define SUB8(t, GK, GV, GL, MID) do { SBAR(); \
    vf[0] = ld32(vp0 + s0, c0o, c1o); vf[1] = ld32(vp0 + s0 + 2048, c0o, c1o); \
    if (ATTN_MPRIO) __builtin_amdgcn_s_setprio(1); \
    QK8(); PV8(); \
    if (ATTN_MPRIO) { SBAR(); __builtin_amdgcn_s_setprio(0); } \
    if (kw) { if (GK) { DMA8_K((t) + 4, s5); } } else { if (GV) { DMA8_V((t) + 2, s3); } } \
    if (GL) { kf[0] = ld32(kp0 + s2, c0o, c1o); kf[1] = ld32(kp0 + s2 + 2048, c0o, c1o); } \
    if (ATTN_SKEW) { SBAR(); MID; SBAR(); } \
    EXPK8(); ROT8(); \
    } while (0)
    int t = 1;
    if (ATTN_SKEW && !kw) {
#pragma unroll 1
        for (; t + 5 < NT; t += 2) { SUB8(t, false, true, true, (void)0); SUB8(t + 1, false, true, true, WAIT_BAR(1)); }
#pragma unroll 1
        for (; t + 1 < NT; t += 2) { SUB8(t, false, (t + 2 < NT), (t + 1 < NT), (void)0); SUB8(t + 1, false, (t + 3 < NT), (t + 2 < NT), WAIT_BAR(0)); }
    } else {
#pragma unroll 1
        for (; t + 5 < NT; t += 2) { SUB8(t, true, true, true, (void)0); SUB8(t + 1, true, true, true, (void)0); WAIT_BAR(1); }
#pragma unroll 1
        for (; t + 1 < NT; t += 2) {
            SUB8(t, (t + 4 < NT), (t + 2 < NT), (t + 1 < NT), (void)0); SUB8(t + 1, (t + 5 < NT), (t + 3 < NT), (t + 2 < NT), (void)0); WAIT_BAR(0); }
    }
    SUB8(NT - 1, false, false, false, (void)0);
    {
        asm volatile("s_waitcnt lgkmcnt(0)" ::: "memory");
        vf[0] = ld32(vp0 + s0, c0o, c1o); vf[1] = ld32(vp0 + s0 + 2048, c0o, c1o);
        PV8(); }
    float rli[16];
#pragma unroll
    for (int r = 0; r < 16; ++r) rli[r] = __builtin_amdgcn_rcpf(lacc[r]);
    bf16* Ow = O + qrow0 * DMO + h * D;
    { bf16* stg = (bf16*)(shm + LDS_OST) + wid * 2048;
#pragma unroll
      for (int r = 0; r < 16; ++r) { const int orow = crow(r, hi);
#pragma unroll
        for (int d0 = 0; d0 < 2; ++d0) stg[orow * 64 + d0 * 32 + r32] = __float2bfloat16(o[d0][r] * rli[r]); }
      asm volatile("s_waitcnt lgkmcnt(0)" ::: "memory");
#pragma unroll
      for (int i = 0; i < 4; ++i) { const int row = i * 8 + (lane >> 3), ch = lane & 7; const u32x4 v = *(const u32x4*)(stg + row * 64 + ch * 8); *(u32x4*)(Ow + (long)row * DMO + ch * 8) = v; } }
    asm volatile("s_waitcnt vmcnt(0) lgkmcnt(0)\n\ts_barrier" ::: "memory");
#undef DMA8_K
#undef DMA8_V
#undef ROT8
#undef QK8
#undef PK8
#undef PV8
#undef EXPK8
#undef SUB8
#undef NXT8
}

constexpr int QBW = 512;
__device__ __forceinline__ void attn_unit8w(int b, int h, int qb, const unsigned char* Q8, const unsigned char* K8, const unsigned char* Vt8, bf16* O, char* shm, float negM_) {
    int tid = threadIdx.x; asm volatile("" : "+v"(tid));
    const int lane = tid & 63, r32 = lane & 31, hi = lane >> 5; const int wid = __builtin_amdgcn_readfirstlane(tid >> 6);
    const int q0 = qb * QBW; const int kvh = h / 3; const bool kw = wid < 4;
    const long qrow0 = (long)b * SEQ + q0 + wid * 64;
    const unsigned lds0 = (unsigned)(uintptr_t)shm;
    const int drow = 16 * (wid & 3) + (lane >> 2), dch = (lane & 3) ^ ((drow >> 2) & 3);
    const unsigned char* dsrc = kw ? K8 + ((long)b * LKV + drow) * DMKV + kvh * D + dch * 16 : Vt8 + ((long)(b * NKVH + kvh) * (LKV / 64)) * 4096 + drow * 64 + dch * 16;
    const int dstride = kw ? KVBLK * DMKV : 4096, dlead = kw ? 4 : 2;
    const unsigned ddst = lds0 + (kw ? L8_K : L8_V) + (wid & 3) * 1024;
#define DMA8_K(t, slot) glds16(dsrc + (long)(t) * dstride, (unsigned)__builtin_amdgcn_readfirstlane(ddst + (slot)))
#define DMA8_V(t, slot) glds16(dsrc + (long)(t) * dstride, (unsigned)__builtin_amdgcn_readfirstlane(ddst + (slot)))
    const lds_cptr shm3 = (lds_cptr)shm; const int sw = (r32 >> 2) & 3, c0o = ((2 * hi) ^ sw) * 16, c1o = ((2 * hi + 1) ^ sw) * 16;
    const lds_cptr kp0 = shm3 + L8_K + r32 * 64;
#define vp0 (kp0 + (L8_V - L8_K))
    if (kw) { DMA8_K(0, 0); DMA8_K(1, SLOT8); DMA8_K(2, 2 * SLOT8); DMA8_K(3, 3 * SLOT8); DMA8_K(4, 4 * SLOT8); } else { DMA8_V(0, 0); DMA8_V(1, SLOT8); DMA8_V(2, 2 * SLOT8); }
    const v8i_t qrA = *reinterpret_cast<const v8i_t*>(Q8 + (qrow0 + r32) * DMQ + h * D + hi * 32);
    const v8i_t qrB = *reinterpret_cast<const v8i_t*>(Q8 + (qrow0 + 32 + r32) * DMQ + h * D + hi * 32);
    f32x16 oA0 = f32x16{}, oA1 = f32x16{}, oB0 = f32x16{}, oB1 = f32x16{}, lA = f32x16{}, lB = f32x16{};
    typedef short v2s_t __attribute__((ext_vector_type(2)));
    float pscale = exp2f(-negM_); asm volatile("" : "+v"(pscale));
    const v8i_t ONES8 = (v8i_t){0x38383838, 0x38383838, 0x38383838, 0x38383838, 0x38383838, 0x38383838, 0x38383838, 0x38383838};
    f32x16 c0, c1; v8i_t kf[2], vf[2], pwA = (v8i_t){0, 0, 0, 0, 0, 0, 0, 0}, pwB = (v8i_t){0, 0, 0, 0, 0, 0, 0, 0};
    int s0 = 0, s1 = SLOT8, s2 = 2 * SLOT8, s3 = 3 * SLOT8, s5 = 5 * SLOT8;
#define NXT8(x) (((x) == (NS8 - 1) * SLOT8) ? 0 : (x) + SLOT8)
#define ROT8() do { s0 = s1; s1 = s2; s2 = s3; s3 = NXT8(s3); s5 = NXT8(s5); } while (0)
#define MX8(acc, A, B, SC) acc = __builtin_amdgcn_mfma_scale_f32_32x32x64_f8f6f4(A, B, acc, 0, 0, 0, SC, 1, SC)
#define QKW(QR) do { c0 = __builtin_amdgcn_mfma_scale_f32_32x32x64_f8f6f4(kf[0], QR, f32x16{}, 0, 0, 0, SC_QK, 1, SC_QK); c1 = __builtin_amdgcn_mfma_scale_f32_32x32x64_f8f6f4(kf[1], QR, f32x16{}, 0, 0, 0, SC_QK, 1, SC_QK); } while (0)
#define PK8(P, B, OLD) __builtin_bit_cast(int, __builtin_amdgcn_cvt_scalef32_pk_fp8_f32(__builtin_amdgcn_cvt_scalef32_pk_fp8_f32(__builtin_bit_cast(v2s_t, OLD), P[B], P[B + 1], pscale, false), P[B + 2], P[B + 3], pscale, true))
#define PVW() do { MX8(oA0, pwA, vf[0], SC_PV); MX8(oA1, pwA, vf[1], SC_PV); MX8(lA, pwA, ONES8, SC_PV); MX8(oB0, pwB, vf[0], SC_PV); MX8(oB1, pwB, vf[1], SC_PV); MX8(lB, pwB, ONES8, SC_PV); } while (0)
#define EXPW(PW) do { _Pragma("unroll") for (int r = 0; r < 16; ++r) { c0[r] = __builtin_amdgcn_exp2f(c0[r]); c1[r] = __builtin_amdgcn_exp2f(c1[r]); } \
        PW[0] = PK8(c0, 0, PW[0]); PW[1] = PK8(c0, 4, PW[1]); PW[2] = PK8(c0, 8, PW[2]); PW[3] = PK8(c0, 12, PW[3]); PW[4] = PK8(c1, 0, PW[4]); PW[5] = PK8(c1, 4, PW[5]); PW[6] = PK8(c1, 8, PW[6]); PW[7] = PK8(c1, 12, PW[7]); } while (0)
    WAIT_BAR(0);
    kf[0] = ld32(kp0, c0o, c1o); kf[1] = ld32(kp0 + 2048, c0o, c1o);
    QKW(qrA); EXPW(pwA); SBAR(); QKW(qrB); EXPW(pwB);
    kf[0] = ld32(kp0 + SLOT8, c0o, c1o); kf[1] = ld32(kp0 + SLOT8 + 2048, c0o, c1o);
    WAIT_BAR(0);
#define SUBW(t, GK, GV, GL, STEADY) do { \
    vf[0] = ld32(vp0 + s0, c0o, c1o); vf[1] = ld32(vp0 + s0 + 2048, c0o, c1o); \
    PVW(); \
    if (STEADY) { glds16(dsrc + (long)((t) + dlead) * dstride, (unsigned)__builtin_amdgcn_readfirstlane(ddst + (kw ? s5 : s3))); } \
    else if (kw) { if (GK) { DMA8_K((t) + 4, s5); } } else { if (GV) { DMA8_V((t) + 2, s3); } } \
    QKW(qrA); EXPW(pwA); \
    QKW(qrB); \
    if (GL) { kf[0] = ld32(kp0 + s2, c0o, c1o); kf[1] = ld32(kp0 + s2 + 2048, c0o, c1o); } \
    EXPW(pwB); ROT8(); \
    } while (0)
    int t = 1;
#pragma unroll 1
    for (; t + 5 < NT; t += 2) { SUBW(t, true, true, true, true); SUBW(t + 1, true, true, true, true); WAIT_BAR(1); }
#pragma unroll 1
    for (; t + 1 < NT; t += 2) {
        SUBW(t, (t + 4 < NT), (t + 2 < NT), (t + 1 < NT), false); SUBW(t + 1, (t + 5 < NT), (t + 3 < NT), (t + 2 < NT), false); WAIT_BAR(0); }
    SUBW(NT - 1, false, false, false, false);
    {
        asm volatile("s_waitcnt lgkmcnt(0)" ::: "memory");
        vf[0] = ld32(vp0 + s0, c0o, c1o); vf[1] = ld32(vp0 + s0 + 2048, c0o, c1o);
        PVW(); }
    bf16* stg = (bf16*)(shm + LDS_OST) + wid * 2048;
#define OUTW(O0, O1, L, ROFF) do { bf16* Ow = O + (qrow0 + (ROFF)) * DMO + h * D; \
      _Pragma("unroll") for (int r = 0; r < 16; ++r) { const int orow = crow(r, hi); const float rl = __builtin_amdgcn_rcpf(L[r]); \
        stg[orow * 64 + r32] = __float2bfloat16(O0[r] * rl); stg[orow * 64 + 32 + r32] = __float2bfloat16(O1[r] * rl); } \
      asm volatile("s_waitcnt lgkmcnt(0)" ::: "memory"); \
      _Pragma("unroll") for (int i = 0; i < 4; ++i) { const int row = i * 8 + (lane >> 3), ch = lane & 7; const u32x4 v = *(const u32x4*)(stg + row * 64 + ch * 8); *(u32x4*)(Ow + (long)row * DMO + ch * 8) = v; } \
      asm volatile("s_waitcnt lgkmcnt(0)" ::: "memory"); } while (0)
    OUTW(oA0, oA1, lA, 0); OUTW(oB0, oB1, lB, 32);
    asm volatile("s_waitcnt vmcnt(0) lgkmcnt(0)\n\ts_barrier" ::: "memory");
#undef DMA8_K
#undef DMA8_V
#undef ROT8
#undef MX8
#undef QKW
#undef PK8
#undef PVW
#undef EXPW
#undef SUBW
#undef OUTW
#undef vp0
#undef NXT8
}
#undef SBAR
#undef WAIT_BAR
}

#define XB_TMO      128
#define XB_XCNT(j)  (256  + 64 * (j))
#define XB_XSUB(j)  (1280 + 64 * (j))
#define XB_XGEN(j)  (2304 + 64 * (j))
#define XB_TOP      3328
#define XB_TOPGEN   3392
#define XCD_BAR_WORDS 3456
#define XB_SPIN_CAP (1u << 18)
__device__ __forceinline__ unsigned xb_ld(unsigned* p)              { return __hip_atomic_load(p, __ATOMIC_RELAXED, __HIP_MEMORY_SCOPE_AGENT); }
__device__ __forceinline__ unsigned xb_add(unsigned* p, unsigned v) { return __hip_atomic_fetch_add(p, v, __ATOMIC_RELAXED, __HIP_MEMORY_SCOPE_AGENT); }
__device__ __forceinline__ unsigned xb_xcc_id() { return (unsigned)__builtin_amdgcn_s_getreg((3 << 11) | 20) & 0xFu; }
#define XB_SPIN(cond, bar) do { unsigned _sp = 0; while (cond) { __builtin_amdgcn_s_sleep(1); \
    if ((++_sp & 255u) == 0u) { if (xb_ld(&(bar)[XB_TMO])) break; if (_sp > XB_SPIN_CAP) { atomicAdd(&(bar)[XB_TMO], 1u); break; } } } } while (0)
struct XcdBarrier { unsigned* bar; unsigned x; volatile LAS unsigned* st; };
__device__ __forceinline__ XcdBarrier xcd_barrier_post(unsigned* bar, volatile LAS unsigned* st) {
    XcdBarrier b; b.bar = bar; b.x = xb_xcc_id(); b.st = st;
    if (threadIdx.x == 0) (void)xb_add(&bar[XB_XCNT(b.x)], 1u);
    return b;
}
__device__ __forceinline__ void xcd_barrier_complete(unsigned* bar, unsigned x, unsigned& nloc, unsigned& nx) {
    const unsigned G = gridDim.x * gridDim.y * gridDim.z;
    unsigned sum, cnt, mine, sp = 0u;
    for (;;) {
        sum = 0u; cnt = 0u; mine = 0u;
#pragma unroll
        for (unsigned j = 0; j < 16; ++j) { const unsigned c = xb_ld(&bar[XB_XCNT(j)]); sum += c; cnt += (c > 0u) ? 1u : 0u; mine = (j == x) ? c : mine; }
        if (sum == G) break;
        __builtin_amdgcn_s_sleep(1);
        if ((++sp & 255u) == 0u) { if (xb_ld(&bar[XB_TMO])) break; if (sp > XB_SPIN_CAP) { atomicAdd(&bar[XB_TMO], 1u); break; } }
    }
    nloc = mine > 0u ? mine : 1u; nx = cnt > 0u ? cnt : 1u;
}
__device__ __forceinline__ void xcd_barrier(const XcdBarrier& b) {
    asm volatile("s_waitcnt vmcnt(0)" ::: "memory");
    __syncthreads();
    if (threadIdx.x == 0) {
        unsigned* bar = b.bar;
        __builtin_amdgcn_s_waitcnt(0);
        unsigned nloc = b.st[0], nx = b.st[1];
        if (nloc == 0u) { xcd_barrier_complete(bar, b.x, nloc, nx); b.st[0] = nloc; b.st[1] = nx; }
        const unsigned old = xb_add(&bar[XB_XSUB(b.x)], 1u);
        const unsigned gen = old / nloc;
        if (old + 1u == (gen + 1u) * nloc) {
            __builtin_amdgcn_fence(__ATOMIC_RELEASE, "agent");
            asm volatile("s_waitcnt vmcnt(0)" ::: "memory");
            const unsigned og = xb_add(&bar[XB_TOP], 1u);
            const unsigned tg = og / nx;
            if (og + 1u == (tg + 1u) * nx) xb_add(&bar[XB_TOPGEN], 1u);
            else XB_SPIN(xb_ld(&bar[XB_TOPGEN]) == tg, bar);
            __builtin_amdgcn_fence(__ATOMIC_ACQUIRE, "agent");
            xb_add(&bar[XB_XGEN(b.x)], 1u);
            asm volatile("s_waitcnt vmcnt(0)" ::: "memory");
        } else {
            XB_SPIN(xb_ld(&bar[XB_XGEN(b.x)]) == gen, bar);
            __builtin_amdgcn_fence(__ATOMIC_ACQUIRE, "agent");
            asm volatile("s_waitcnt vmcnt(0)" ::: "memory");
        }
    }
    __syncthreads();
}

struct Frame {
    LAS unsigned char* lds;
    volatile LAS unsigned* MISC;
    gu32* ctl;
    int tid, lane, wave;
    int vcu, G;
    const float* const* ka;
    float* out;
    unsigned char* ws;
};
#define WSP(T, off) ((T*)(F.ws + (off)))
#define FIN_x (F.ka[0])
#define FIN_c (F.ka[1])
#define FIN_ctx (F.ka[2])
#define FIN_c_ctx (F.ka[3])
#define FIN_norm1_g (F.ka[4])
#define FIN_w_ada (F.ka[5])
#define FIN_b_ada (F.ka[6])
#define FIN_w_in (F.ka[7])
#define FIN_w_fourier (F.ka[8])
#define FIN_q_norm_g (F.ka[9])
#define FIN_k_norm_g (F.ka[10])
#define FIN_w_out (F.ka[11])
#define FIN_norm2_g (F.ka[12])
#define FIN_w_router (F.ka[13])
#define FIN_router_bias (F.ka[14])
#define FIN_w_egu (F.ka[15])
#define FIN_w_ed (F.ka[16])
#define FIN_w_sgu (F.ka[17])
#define FIN_w_sd (F.ka[18])
#define FIN_final_g (F.ka[19])

struct DenseOrder {
    static constexpr bool GATHER = false;
    int nN, nmain, nextra, G, c; const char* Bt; int K; int reps;
    __device__ __forceinline__ bool next(int i, pg8::GUnit& u) const {
        const int ntot = nmain + nextra, nc = (ntot - c + G - 1) / G; if (i >= nc * reps) return false;
        const int L = (i % nc) * G + c;
        if (L < nmain) { const int nig = 8 * nN, gid = L / nig, r = L % nig; u.pm = gid * 8 + (r & 7); u.pn = r >> 3; }
        else { const int jx = L - nmain; u.pm = 128 + (jx & 3); u.pn = 5 + (jx >> 2); }
        u.e = 0; u.j = 0; u.nvalid = 256; u.B = Bt + (size_t)u.pn * 256 * K * 2; return true;
    }
    __device__ __forceinline__ int arow(const pg8::GUnit& u, int r) const { return u.pm * 256 + r; }
};
template <bool GATHER_> struct GroupedOrder {
    static constexpr bool GATHER = GATHER_;
    int NPN, G, c, nbrows, K; bool gather; const char* Bt; const LAS int* TS; const LAS int* CN; const GAS u32x2* LIST; int reps; int total;
    __device__ __forceinline__ bool next(int i, pg8::GUnit& u) const {
        const int ntot = total * NPN, nc = (ntot - c + G - 1) / G; if (i >= nc * reps) return false;
        const int L = (i % nc) * G + c; const int T = L / NPN;
        int lo = __builtin_amdgcn_readfirstlane((int)((const LAS unsigned short*)(TS + 640))[T]);
        const int ts = __builtin_amdgcn_readfirstlane(TS[lo]), cn = __builtin_amdgcn_readfirstlane(CN[lo]);
        u.pm = T; u.pn = L - T * NPN; u.e = lo; u.j = T - ts; const int rem = cn - 256 * u.j; u.nvalid = rem < 256 ? rem : 256;
        u.B = Bt + ((size_t)lo * nbrows + (size_t)u.pn * 256) * K; return true;
    }
    __device__ __forceinline__ int arow(const pg8::GUnit& u, int r) const {
        if (!gather) return u.pm * 256 + r;
        int pos = 256 * u.j + r; if (r >= u.nvalid) pos = 0;
        const u32x2 en = LIST[(size_t)u.e * NTOK + pos];
        return (int)(en.x & 0xffffu);
    }
};

struct EpiInProj {
    static constexpr bool PERM = true; static constexpr int NSTORE = 8;
    __device__ __forceinline__ void pre(LAS unsigned char*, const pg8::GUnit&, int, int, int) const {}
    u16 *Z, *Q, *Kb, *Vb; const float *COS, *SIN, *gq, *gk;
    __device__ __forceinline__ void operator()(const f32x4 (&acc)[2][2][4][2], const pg8::GUnit& u, int wr, int wc, int fr, int fq, LAS unsigned char* lds, int ui) const {
        const int pn = u.pn; const bool is_ctx = u.pm >= 128;
        if (ATTN_FP8 && pn == 6) {
            LAS unsigned char* st = lds + pg8::STAGE_BYTES; const int tid = threadIdx.x;
            const int b = is_ctx ? (u.pm - 128) : (u.pm >> 5), kt0 = is_ctx ? (SEQ / 64) : (((u.pm * 256) & (SEQ - 1)) >> 6);
#pragma unroll
            for (int ai = 0; ai < 2; ++ai)
#pragma unroll
                for (int bj = 0; bj < 2; ++bj) {
#pragma unroll
                    for (int m = 0; m < 4; ++m) { const int ks = attn_body::vt_slot(16 * m + fr); const f32x4 v0 = acc[ai][bj][m][0], v1 = acc[ai][bj][m][1];
                        int w0 = __builtin_amdgcn_cvt_pk_fp8_f32(v0[0], v0[1], 0, false); w0 = __builtin_amdgcn_cvt_pk_fp8_f32(v0[2], v0[3], w0, true);
                        int w1 = __builtin_amdgcn_cvt_pk_fp8_f32(v1[0], v1[1], 0, false); w1 = __builtin_amdgcn_cvt_pk_fp8_f32(v1[2], v1[3], w1, true);
#pragma unroll
                        for (int q8 = 0; q8 < 8; ++q8) st[((wr * 128 + 32 * wc + 8 * fq + q8) * 64) + ks] = (unsigned char)(((q8 < 4 ? (unsigned)w0 : (unsigned)w1) >> (8 * (q8 & 3))) & 0xffu); }
                    asm volatile("s_waitcnt lgkmcnt(0)" ::: "memory"); __builtin_amdgcn_s_barrier(); asm volatile("" ::: "memory");
#pragma unroll
                    for (int j = 0; j < 2; ++j) { const int ch = tid + 512 * j, row = ch >> 2, part = ch & 3, col = 128 * bj + (row & 127), kvh = col >> 6, d = col & 63, kt = kt0 + 2 * ai + (row >> 7);
                        const u32x4 v = *(const LAS u32x4*)(st + row * 64 + part * 16);
                        *(u32x4*)((unsigned char*)Vb + ((((size_t)(b * NKVH + kvh) * (LKV / 64) + kt) * 64 + d) * 64) + part * 16) = v; }
                    asm volatile("s_waitcnt lgkmcnt(0)" ::: "memory"); __builtin_amdgcn_s_barrier(); asm volatile("" ::: "memory");
                }
            return;
        }
        float gn[2][2][4];
        if (pn >= 2 && pn < 6) { const float* gsrc = (pn == 5) ? gk : gq;
#pragma unroll
            for (int bj = 0; bj < 2; ++bj)
#pragma unroll
                for (int n = 0; n < 2; ++n) { const f32x4 g4 = *(const f32x4*)(gsrc + 32 * bj + 16 * n + 4 * fq); gn[bj][n][0] = g4[0]; gn[bj][n][1] = g4[1]; gn[bj][n][2] = g4[2]; gn[bj][n][3] = g4[3]; } }
#pragma unroll
        for (int ai = 0; ai < 2; ++ai)
#pragma unroll
            for (int m = 0; m < 4; ++m) {
                const int row = u.pm * 256 + ai * 128 + wr * 64 + m * 16 + fr;
                int b, l, key;
                if (!is_ctx) { b = row >> 13; l = row & 8191; key = l; } else { const int rc = row - NTOK; b = rc >> 8; l = 0; key = SEQ + (rc & 255); }
                if (pn < 2) {
#pragma unroll
                    for (int bj = 0; bj < 2; ++bj) { const int g = 32 * pn + 16 * bj + 4 * wc + fq; const f32x4 v0 = acc[ai][bj][m][0], v1 = acc[ai][bj][m][1];
                        u32x4 w; w.x = cvt_pk_bf16(v0[0], v0[1]); w.y = cvt_pk_bf16(v0[2], v0[3]); w.z = cvt_pk_bf16(v1[0], v1[1]); w.w = cvt_pk_bf16(v1[2], v1[3]);
                        *(u32x4*)(Z + (((size_t)(b * 64 + g) * SEQ + l) * 8)) = w; }
                } else if (pn < 6) {
                    float ss = 0.f;
#pragma unroll
                    for (int bj = 0; bj < 2; ++bj)
#pragma unroll
                        for (int n = 0; n < 2; ++n) { const f32x4 v = acc[ai][bj][m][n]; ss += (v[0] * v[0] + v[1] * v[1]) + (v[2] * v[2] + v[3] * v[3]); }
                    ss += __shfl_xor(ss, 16); ss += __shfl_xor(ss, 32);
                    const float rstd = 1.0f / sqrtf(ss * (1.0f / 64.0f) + RMS_EPS);
                    const float osc = (pn == 5) ? 1.0f : C2;
#pragma unroll
                    for (int bj = 0; bj < 2; ++bj) {
                        const int pidx = (bj == 0) ? (l >> 6) : (l & 63);
                        f32x4 cs = *(const f32x4*)(COS + pidx * 16 + 4 * fq), sn = *(const f32x4*)(SIN + pidx * 16 + 4 * fq);
                        if (is_ctx) { cs = (f32x4){1.f, 1.f, 1.f, 1.f}; sn = (f32x4){0.f, 0.f, 0.f, 0.f}; }
                        float oa[4], ob[4];
#pragma unroll
                        for (int e = 0; e < 4; ++e) { const float a = acc[ai][bj][m][0][e] * rstd * gn[bj][0][e], bb = acc[ai][bj][m][1][e] * rstd * gn[bj][1][e];
                            oa[e] = (a * cs[e] - bb * sn[e]) * osc; ob[e] = (bb * cs[e] + a * sn[e]) * osc; }
                        if (ATTN_FP8) {
                            const float f8s = (pn < 5) ? Q8_SCALE : 1.0f;
                            int w0 = __builtin_amdgcn_cvt_pk_fp8_f32(oa[0] * f8s, oa[1] * f8s, 0, false); w0 = __builtin_amdgcn_cvt_pk_fp8_f32(oa[2] * f8s, oa[3] * f8s, w0, true);
                            int w1 = __builtin_amdgcn_cvt_pk_fp8_f32(ob[0] * f8s, ob[1] * f8s, 0, false); w1 = __builtin_amdgcn_cvt_pk_fp8_f32(ob[2] * f8s, ob[3] * f8s, w1, true);
                            if (pn < 5) { const int head = 4 * (pn - 2) + wc; *(u32x2*)((unsigned char*)Q + ((size_t)row * QW + head * 64 + 32 * bj + 8 * fq)) = (u32x2){(unsigned)w0, (unsigned)w1}; }
                            else *(u32x2*)((unsigned char*)Kb + (((size_t)b * LKV + key) * KVW + wc * 64 + 32 * bj + 8 * fq)) = (u32x2){(unsigned)w0, (unsigned)w1};
                        } else {
                        u32x4 w; w.x = cvt_pk_bf16(oa[0], oa[1]); w.y = cvt_pk_bf16(oa[2], oa[3]); w.z = cvt_pk_bf16(ob[0], ob[1]); w.w = cvt_pk_bf16(ob[2], ob[3]);
                        if (pn < 5) { const int head = 4 * (pn - 2) + wc; *(u32x4*)(Q + ((size_t)row * QW + head * 64 + 32 * bj + 8 * fq)) = w; }
                        else *(u32x4*)(Kb + (((size_t)b * LKV + key) * KVW + wc * 64 + 32 * bj + 8 * fq)) = w; }
                    }
                } else {
#pragma unroll
                    for (int bj = 0; bj < 2; ++bj) { const f32x4 v0 = acc[ai][bj][m][0], v1 = acc[ai][bj][m][1];
                        if (ATTN_FP8) {
                            const int kt = key >> 6, ks = attn_body::vt_slot(key & 63);
                            int w0 = __builtin_amdgcn_cvt_pk_fp8_f32(v0[0], v0[1], 0, false); w0 = __builtin_amdgcn_cvt_pk_fp8_f32(v0[2], v0[3], w0, true);
                            int w1 = __builtin_amdgcn_cvt_pk_fp8_f32(v1[0], v1[1], 0, false); w1 = __builtin_amdgcn_cvt_pk_fp8_f32(v1[2], v1[3], w1, true);
#pragma unroll
                            for (int q8 = 0; q8 < 8; ++q8) { const int col = 128 * bj + 32 * wc + 8 * fq + q8, kvh = col >> 6, d = col & 63;
                                ((unsigned char*)Vb)[((((size_t)(b * NKVH + kvh) * (LKV / 64) + kt) * 64 + d) * 64) + ks] = (unsigned char)(((q8 < 4 ? (unsigned)w0 : (unsigned)w1) >> (8 * (q8 & 3))) & 0xffu); }
                        } else {
                        u32x4 w; w.x = cvt_pk_bf16(v0[0], v0[1]); w.y = cvt_pk_bf16(v0[2], v0[3]); w.z = cvt_pk_bf16(v1[0], v1[1]); w.w = cvt_pk_bf16(v1[2], v1[3]);
                        *(u32x4*)(Vb + (((size_t)b * LKV + key) * KVW + 128 * bj + 32 * wc + 8 * fq)) = w; } }
                }
            }
    }
};
struct EpiResid {
    static constexpr bool PERM = false; static constexpr int NSTORE = 32;
    __device__ __forceinline__ void pre(LAS unsigned char*, const pg8::GUnit&, int, int, int) const {}
    const float* x; u16* X1; const gi64* MOD;
    __device__ __forceinline__ void operator()(const f32x4 (&acc)[2][2][4][2], const pg8::GUnit& u, int wr, int wc, int fr, int fq, LAS unsigned char* lds, int ui) const {
        const int row0 = u.pm * 256 + wr * 64 + fr, col0 = u.pn * 256 + wc * 32 + 4 * fq; const int b = (u.pm * 256) >> 13;
        f32x4 gv[2][2];
#pragma unroll
        for (int bj = 0; bj < 2; ++bj)
#pragma unroll
            for (int n = 0; n < 2; ++n) gv[bj][n] = mod4(MOD, b * 6144 + 2048 + col0 + bj * 128 + n * 16);
#pragma unroll
        for (int ai = 0; ai < 2; ++ai)
#pragma unroll
            for (int m = 0; m < 4; ++m) { const size_t off = (size_t)(row0 + ai * 128 + m * 16) * DM + col0;
#pragma unroll
                for (int bj = 0; bj < 2; ++bj)
#pragma unroll
                    for (int n = 0; n < 2; ++n) { const f32x4 xv = *(const f32x4*)(x + off + bj * 128 + n * 16); const f32x4 y = (DBG & 2) ? xv : xv + gv[bj][n] * acc[ai][bj][m][n];
                        *(u32x2*)(X1 + off + bj * 128 + n * 16) = (u32x2){pk2bf(y[0], y[1]), pk2bf(y[2], y[3])}; } }
    }
};
struct EpiLogits {
    static constexpr bool PERM = false; static constexpr int NSTORE = 32;
    __device__ __forceinline__ void pre(LAS unsigned char*, const pg8::GUnit&, int, int, int) const {}
    float* C;
    __device__ __forceinline__ void operator()(const f32x4 (&acc)[2][2][4][2], const pg8::GUnit& u, int wr, int wc, int fr, int fq, LAS unsigned char* lds, int ui) const {
        const int row0 = u.pm * 256 + wr * 64 + fr, col0 = wc * 32 + 4 * fq;
#pragma unroll
        for (int ai = 0; ai < 2; ++ai)
#pragma unroll
            for (int m = 0; m < 4; ++m) { float* rowp = C + (size_t)(row0 + ai * 128 + m * 16) * NEXP + col0;
#pragma unroll
                for (int bj = 0; bj < 2; ++bj)
#pragma unroll
                    for (int n = 0; n < 2; ++n) *(f32x4*)(rowp + bj * 128 + n * 16) = acc[ai][bj][m][n]; }
    }
};
struct EpiSwiglu {
    static constexpr bool PERM = true; static constexpr int NSTORE = 16;
    __device__ __forceinline__ void pre(LAS unsigned char*, const pg8::GUnit&, int, int, int) const {}
    u16* ACT;
    __device__ __forceinline__ void operator()(const f32x4 (&acc)[2][2][4][2], const pg8::GUnit& u, int wr, int wc, int fr, int fq, LAS unsigned char* lds, int ui) const {
#pragma unroll
        for (int ai = 0; ai < 2; ++ai)
#pragma unroll
            for (int m = 0; m < 4; ++m) { const int r = ai * 128 + wr * 64 + m * 16 + fr; u16* rowp = ACT + ((size_t)u.pm * 256 + r) * EFF + 128 * u.pn + 16 * wc + 4 * fq;
#pragma unroll
                for (int bj = 0; bj < 2; ++bj) { const f32x4 a = acc[ai][bj][m][0], g = acc[ai][bj][m][1]; float o[4];
#pragma unroll
                    for (int e = 0; e < 4; ++e) o[e] = a[e] * g[e] / (1.0f + __expf(-a[e]));
                    if (MOE_FP8) { int w0 = __builtin_amdgcn_cvt_pk_fp8_f32(o[0], o[1], 0, false); w0 = __builtin_amdgcn_cvt_pk_fp8_f32(o[2], o[3], w0, true);
                        *(unsigned*)((unsigned char*)ACT + ((size_t)u.pm * 256 + r) * EFF + 128 * u.pn + 16 * wc + 4 * fq + 64 * bj) = (unsigned)w0; }
                    else { u32x2 w; if (MOEF16) { w.x = pk2h(o[0], o[1]); w.y = pk2h(o[2], o[3]); } else { w.x = pk2bf(o[0], o[1]); w.y = pk2bf(o[2], o[3]); } *(u32x2*)(rowp + 64 * bj) = w; } } }
    }
};
struct EpiDown {
    static constexpr bool PERM = true; static constexpr int NSTORE = 16;
    u16* Cc; const GAS u32x2* LIST; unsigned char* dump;
    __device__ __forceinline__ void pre(LAS unsigned char* lds, const pg8::GUnit& u, int ui, int wid, int lane) const {
        if (wid < 2) __builtin_amdgcn_global_load_lds((const unsigned*)(LIST + (size_t)u.e * NTOK + 256 * u.j + 128 * wid + 2 * lane), (LAS unsigned*)(lds + pg8::STAGE_BYTES + (ui & 1) * 2048 + wid * 1024), 16, 0, 0);
    }
    __device__ __forceinline__ void operator()(const f32x4 (&acc)[2][2][4][2], const pg8::GUnit& u, int wr, int wc, int fr, int fq, LAS unsigned char* lds, int ui) const {
        const LAS f32x2* ent = (const LAS f32x2*)(lds + pg8::STAGE_BYTES + (ui & 1) * 2048);
#pragma unroll
        for (int ai = 0; ai < 2; ++ai)
#pragma unroll
            for (int m = 0; m < 4; ++m) { const int r = ai * 128 + wr * 64 + m * 16 + fr;
                const f32x2 enf = ent[r];
                const unsigned ex = __builtin_bit_cast(unsigned, enf.x); const int tok = (int)(ex & 0x7fffu), slot = (int)((ex >> 16) & 15u); const float gate = enf.y;
                unsigned char* rowp = (unsigned char*)Cc + ((size_t)tok * NSLOT + slot) * DM + 256 * u.pn + 32 * wc + 8 * fq;
                if (r >= u.nvalid) rowp = dump + ((size_t)(blockIdx.x * 512 + threadIdx.x)) * 256;
                const float gs = gate * C_SCALE;
#pragma unroll
                for (int bj = 0; bj < 2; ++bj) { f32x4 v0 = acc[ai][bj][m][0] * gs, v1 = acc[ai][bj][m][1] * gs;
#pragma unroll
                    for (int e = 0; e < 4; ++e) { v0[e] = __builtin_amdgcn_fmed3f(v0[e], -440.f, 440.f); v1[e] = __builtin_amdgcn_fmed3f(v1[e], -440.f, 440.f); }
                    int w0 = __builtin_amdgcn_cvt_pk_fp8_f32(v0[0], v0[1], 0, false); w0 = __builtin_amdgcn_cvt_pk_fp8_f32(v0[2], v0[3], w0, true);
                    int w1 = __builtin_amdgcn_cvt_pk_fp8_f32(v1[0], v1[1], 0, false); w1 = __builtin_amdgcn_cvt_pk_fp8_f32(v1[2], v1[3], w1, true);
                    *(u32x2*)(rowp + 128 * bj) = (u32x2){(unsigned)w0, (unsigned)w1}; } }
    }
};

template <bool F16OUT, bool F8OUT2 = false, bool BF16IN = false> __device__ __forceinline__ void rownorm_rows(const GAS float* src, const float* gain, const gi64* MODsh, const gi64* MODsc, u16* dst, int row0, int nrows, int wi, int wstride, int lane, unsigned char* dst8 = nullptr) {
    f32x4 Av[2][2], Bv[2][2];
#pragma unroll
    for (int j = 0; j < 2; ++j)
#pragma unroll
        for (int h = 0; h < 2; ++h) { const int col = 8 * lane + 512 * j + 4 * h; Av[j][h] = *(const f32x4*)(gain + col) * (mod4(MODsc, col) + 1.0f); Bv[j][h] = mod4(MODsh, col); }
    for (int r = wi; r < nrows; r += 2 * wstride) {
        const int r1 = r + wstride; const bool has1 = r1 < nrows;
        const GAS float* s0 = src + (size_t)(row0 + r) * DM; const GAS float* s1 = src + (size_t)(row0 + (has1 ? r1 : r)) * DM;
        f32x4 v0[2][2], v1[2][2];
#pragma unroll
        for (int j = 0; j < 2; ++j)
#pragma unroll
            for (int h = 0; h < 2; ++h) { if (!BF16IN) { v0[j][h] = *(const GAS f32x4*)(s0 + 8 * lane + 512 * j + 4 * h); v1[j][h] = *(const GAS f32x4*)(s1 + 8 * lane + 512 * j + 4 * h); } }
        if (BF16IN) {
            const GAS u16* b0 = (const GAS u16*)src + (size_t)(row0 + r) * DM; const GAS u16* b1 = (const GAS u16*)src + (size_t)(row0 + (has1 ? r1 : r)) * DM;
#pragma unroll
            for (int j = 0; j < 2; ++j) { const u32x4 w0 = *(const GAS u32x4*)(b0 + 8 * lane + 512 * j), w1 = *(const GAS u32x4*)(b1 + 8 * lane + 512 * j);
                v0[j][0] = (f32x4){bflo(w0.x), bfhi(w0.x), bflo(w0.y), bfhi(w0.y)}; v0[j][1] = (f32x4){bflo(w0.z), bfhi(w0.z), bflo(w0.w), bfhi(w0.w)};
                v1[j][0] = (f32x4){bflo(w1.x), bfhi(w1.x), bflo(w1.y), bfhi(w1.y)}; v1[j][1] = (f32x4){bflo(w1.z), bfhi(w1.z), bflo(w1.w), bfhi(w1.w)}; } }
        float q0 = 0.f, q1 = 0.f;
#pragma unroll
        for (int j = 0; j < 2; ++j)
#pragma unroll
            for (int h = 0; h < 2; ++h) { const f32x4 a = v0[j][h], b = v1[j][h]; q0 += (a[0] * a[0] + a[1] * a[1]) + (a[2] * a[2] + a[3] * a[3]); q1 += (b[0] * b[0] + b[1] * b[1]) + (b[2] * b[2] + b[3] * b[3]); }
#pragma unroll
        for (int o = 1; o < 64; o <<= 1) { q0 += __shfl_xor(q0, o); q1 += __shfl_xor(q1, o); }
        const float rs0 = 1.0f / sqrtf(q0 * (1.0f / DM) + RMS_EPS), rs1 = 1.0f / sqrtf(q1 * (1.0f / DM) + RMS_EPS);
#pragma unroll
        for (int j = 0; j < 2; ++j) { const f32x4 ya = v0[j][0] * rs0 * Av[j][0] + Bv[j][0], yb = v0[j][1] * rs0 * Av[j][1] + Bv[j][1];
            u32x4 w; if (F16OUT) { w.x = pk2h(ya[0], ya[1]); w.y = pk2h(ya[2], ya[3]); w.z = pk2h(yb[0], yb[1]); w.w = pk2h(yb[2], yb[3]); } else { w.x = pk2bf(ya[0], ya[1]); w.y = pk2bf(ya[2], ya[3]); w.z = pk2bf(yb[0], yb[1]); w.w = pk2bf(yb[2], yb[3]); }
            *(GAS u32x4*)(dst + (size_t)(row0 + r) * DM + 8 * lane + 512 * j) = w;
            if (F8OUT2) { int w0 = __builtin_amdgcn_cvt_pk_fp8_f32(ya[0], ya[1], 0, false); w0 = __builtin_amdgcn_cvt_pk_fp8_f32(ya[2], ya[3], w0, true); int w1 = __builtin_amdgcn_cvt_pk_fp8_f32(yb[0], yb[1], 0, false); w1 = __builtin_amdgcn_cvt_pk_fp8_f32(yb[2], yb[3], w1, true);
                *(GAS u32x2*)(dst8 + (size_t)(row0 + r) * DM + 8 * lane + 512 * j) = (u32x2){(unsigned)w0, (unsigned)w1}; } }
        if (has1) {
#pragma unroll
            for (int j = 0; j < 2; ++j) { const f32x4 ya = v1[j][0] * rs1 * Av[j][0] + Bv[j][0], yb = v1[j][1] * rs1 * Av[j][1] + Bv[j][1];
                u32x4 w; if (F16OUT) { w.x = pk2h(ya[0], ya[1]); w.y = pk2h(ya[2], ya[3]); w.z = pk2h(yb[0], yb[1]); w.w = pk2h(yb[2], yb[3]); } else { w.x = pk2bf(ya[0], ya[1]); w.y = pk2bf(ya[2], ya[3]); w.z = pk2bf(yb[0], yb[1]); w.w = pk2bf(yb[2], yb[3]); }
                *(GAS u32x4*)(dst + (size_t)(row0 + r1) * DM + 8 * lane + 512 * j) = w;
                if (F8OUT2) { int w0 = __builtin_amdgcn_cvt_pk_fp8_f32(ya[0], ya[1], 0, false); w0 = __builtin_amdgcn_cvt_pk_fp8_f32(ya[2], ya[3], w0, true); int w1 = __builtin_amdgcn_cvt_pk_fp8_f32(yb[0], yb[1], 0, false); w1 = __builtin_amdgcn_cvt_pk_fp8_f32(yb[2], yb[3], w1, true);
                    *(GAS u32x2*)(dst8 + (size_t)(row0 + r1) * DM + 8 * lane + 512 * j) = (u32x2){(unsigned)w0, (unsigned)w1}; } } }
    }
}

__device__ __forceinline__ void p0_phase(Frame& F) {
    const int gw = F.vcu * 8 + F.wave, NGW = F.G * 8, lane = F.lane;
    unsigned long long* MODQ = (unsigned long long*)(F.ctl + CW_MOD);
    for (int it = gw; it < 1536; it += NGW) {
        const int cb = it % 24, kc = it / 24, k0 = kc * 16, col = cb * 256 + lane * 4;
        float sv[5];
#pragma unroll
        for (int r = 0; r < 5; ++r) { const float cv = (r < 4) ? FIN_c[r * DM + k0 + (lane & 15)] : FIN_c_ctx[k0 + (lane & 15)]; sv[r] = cv / (1.0f + __expf(-cv)); }
        f32x4 acc[5];
#pragma unroll
        for (int r = 0; r < 5; ++r) acc[r] = (f32x4){0.f, 0.f, 0.f, 0.f};
#pragma unroll
        for (int kk = 0; kk < 16; ++kk) { const f32x4 w = *(const f32x4*)(FIN_w_ada + (size_t)(k0 + kk) * 6144 + col);
#pragma unroll
            for (int r = 0; r < 5; ++r) { const float s = __builtin_bit_cast(float, __builtin_amdgcn_readlane(__builtin_bit_cast(int, sv[r]), kk)); acc[r] += w * s; } }
        if (kc == 0) { const f32x4 bv = *(const f32x4*)(FIN_b_ada + col);
#pragma unroll
            for (int r = 0; r < 5; ++r) acc[r] += bv; }
#pragma unroll
        for (int r = 0; r < 5; ++r)
#pragma unroll
            for (int j = 0; j < 4; ++j) atomicAdd(MODQ + r * 6144 + col + j, (unsigned long long)__float2ll_rn(acc[r][j] * 0x1p36f));
    }
    float* WCS = WSP(float, WS_TAB);
    for (int it = gw; it < 256; it += NGW) {
        const int fh = it >> 6, d = it & 63; float ac = 0.f, as = 0.f;
        const float ctab = cospif((float)lane * (1.0f / 32.0f)), stab = sinpif((float)lane * (1.0f / 32.0f));
        for (int k2 = 0; k2 < 64; ++k2) { const int mm = __builtin_amdgcn_readfirstlane((d * k2) & 63); const float w = FIN_w_fourier[(fh * 64 + k2) * 64 + lane]; ac += rdl(ctab, mm) * w; as += rdl(stab, mm) * w; }
        const float sc = 1.0f / sqrtf((float)SEQ * 64.0f);
        WCS[(fh * 64 + d) * 128 + lane] = ac * sc; WCS[(fh * 64 + d) * 128 + 64 + lane] = as * sc;
    }
    {
        u16* D1 = WSP(u16, WS_TAB + 144 * 1024); u16* D3 = WSP(u16, WS_TAB + 272 * 1024);
        for (int it = gw; it < 320; it += NGW) {
            if (it < 256) { const int ro = it >> 7, k1 = it & 127;
#pragma unroll
                for (int j = 0; j < 4; ++j) { const int col = lane + 64 * j, ri = col >> 7, n1 = col & 127, mm = (n1 * k1) & 127; const float cc = cospif((float)mm * (1.0f / 64.0f)), ss = sinpif((float)mm * (1.0f / 64.0f));
                    const float v = (ro == 0) ? (ri == 0 ? cc : -ss) : (ri == 0 ? -ss : -cc); D1[it * 256 + col] = (u16)f2bf(v); } }
            else { const int k2 = it - 256;
#pragma unroll
                for (int j = 0; j < 2; ++j) { const int col = lane + 64 * j, ri = col >> 6, n2 = col & 63, mm = (n2 * k2) & 63; const float v = (ri == 0) ? cospif((float)mm * (1.0f / 32.0f)) : sinpif((float)mm * (1.0f / 32.0f)); D3[k2 * 128 + col] = (u16)f2bf(v); } }
        }
    }
    float* COS = WSP(float, WS_TAB + 128 * 1024); float* SIN = WSP(float, WS_TAB + 136 * 1024);
    for (int it = gw; it < 32; it += NGW) { const int idx = it * 64 + lane, pos = idx >> 4, i = idx & 15;
        const float inv = powf(10000.0f, -(float)i / 16.0f), ang = (float)pos * inv; COS[idx] = cosf(ang); SIN[idx] = sinf(ang); }
}

__device__ __forceinline__ int map_row(int mode, int sc) {
    if (mode == 1) { const int head = sc >> 6, dim = sc & 63, bj = dim >> 5, n = (dim >> 4) & 1, i = dim & 15; return (head >> 2) * 256 + bj * 128 + (head & 3) * 32 + (i >> 2) * 8 + n * 4 + (i & 3); }
    if (mode == 2) { const int g = sc >> 8, a = sc & 255; return (a >> 2) * 8 + g * 4 + (a & 3); }
    return sc;
}
struct TItem { const float* src; u16* dst; int N, K, k0, rel_c0, mode, dst_off; bool f16; bool f8; float ws; };
__device__ __forceinline__ void titem_load(const TItem& t, float (&buf)[64], int lane) {
#pragma unroll
    for (int i = 0; i < 64; ++i) { const int kk = 2 * i + (lane >> 5); buf[i] = t.src[(size_t)kk * t.N + (lane & 31)]; }
}
__device__ __forceinline__ void titem_finish(const TItem& t, const float (&buf)[64], LAS float* scr, int lane) {
#pragma unroll
    for (int i = 0; i < 64; ++i) { const int kk = 2 * i + (lane >> 5); scr[kk * 33 + (lane & 31)] = buf[i]; }
    LDS_WAIT(); asm volatile("" ::: "memory");
    if (t.f8) { const int c = lane & 7; const float ws = t.ws;
#pragma unroll
        for (int j = 0; j < 4; ++j) { const int n = (lane >> 3) + 8 * j; const LAS float* s = scr + (16 * c) * 33 + n; int w[4];
#pragma unroll
            for (int q = 0; q < 4; ++q) { w[q] = __builtin_amdgcn_cvt_pk_fp8_f32(s[(4 * q) * 33] * ws, s[(4 * q + 1) * 33] * ws, 0, false); w[q] = __builtin_amdgcn_cvt_pk_fp8_f32(s[(4 * q + 2) * 33] * ws, s[(4 * q + 3) * 33] * ws, w[q], true); }
            const int drow = t.dst_off + map_row(t.mode, t.rel_c0 + n);
            *(GAS u32x4*)((unsigned char*)t.dst + (size_t)drow * t.K + t.k0 + 16 * c) = (u32x4){(unsigned)w[0], (unsigned)w[1], (unsigned)w[2], (unsigned)w[3]}; } }
    else { const int c = lane & 15;
#pragma unroll
        for (int j = 0; j < 8; ++j) { const int n = (lane >> 4) + 4 * j; const LAS float* s = scr + (8 * c) * 33 + n;
            u32x4 o;
            if (t.f16) { o.x = pk2h(s[0 * 33], s[1 * 33]); o.y = pk2h(s[2 * 33], s[3 * 33]); o.z = pk2h(s[4 * 33], s[5 * 33]); o.w = pk2h(s[6 * 33], s[7 * 33]); }
            else { o.x = pk2bf(s[0 * 33], s[1 * 33]); o.y = pk2bf(s[2 * 33], s[3 * 33]); o.z = pk2bf(s[4 * 33], s[5 * 33]); o.w = pk2bf(s[6 * 33], s[7 * 33]); }
            const int drow = t.dst_off + map_row(t.mode, t.rel_c0 + n);
            *(GAS u32x4*)(t.dst + (size_t)drow * t.K + t.k0 + 8 * c) = o; } }
    LDS_WAIT(); asm volatile("" ::: "memory");
}
constexpr int I_FOLD = 512, I_QKV = 8 * 40, I_OUT = 8 * 32, I_R = 8 * 8, I_GU = NEXPS * 8 * 16, I_D = NEXPS * 2 * 32;
constexpr int NT_EARLY = I_QKV + I_OUT + I_R, NT_ITEMS = NT_EARLY + I_GU + I_D;
constexpr int DEFER_A = 3840, DEFER_B = 4096;
#define TDECODE(it_, t) do { int r = (it_); u16* BIN = WSP(u16, WS_BIN); \
        if (r < I_QKV) { const int kb = r / 40, nb = r % 40, sc0 = 256 + 32 * nb; t.N = 1536; t.K = DM; t.k0 = kb * 128; t.f16 = false; t.f8 = false; t.ws = 1.f; t.dst = BIN; t.src = FIN_w_in + (size_t)(kb * 128) * 1536 + sc0; \
            if (sc0 < 1024) { t.rel_c0 = sc0 - 256; t.mode = 1; t.dst_off = 512; } else if (sc0 < 1280) { t.rel_c0 = sc0 - 1024; t.mode = 1; t.dst_off = 1280; } else { t.rel_c0 = sc0 - 1280; t.mode = 0; t.dst_off = 1536; } \
            break; } \
        r -= I_QKV; \
        if (r < I_OUT) { const int kb = r / 32, nb = r % 32; t.N = DM; t.K = DM; t.k0 = kb * 128; t.f16 = false; t.f8 = false; t.ws = 1.f; t.dst = WSP(u16, WS_BOUT); t.src = FIN_w_out + (size_t)(kb * 128) * DM + 32 * nb; t.rel_c0 = 32 * nb; t.mode = 0; t.dst_off = 0; break; } \
        r -= I_OUT; \
        if (r < I_R) { const int kb = r / 8, nb = r % 8; t.N = NEXP; t.K = DM; t.k0 = kb * 128; t.f16 = (MOE_FP8 ? false : MOEF16); t.f8 = false; t.ws = 1.f; t.dst = WSP(u16, WS_BR); t.src = FIN_w_router + (size_t)(kb * 128) * NEXP + 32 * nb; t.rel_c0 = 32 * nb; t.mode = 0; t.dst_off = 0; break; } \
        r -= I_R; \
        if (r < I_GU) { const int e = r >> 7, q = r & 127, kb = q >> 4, nb = q & 15; const float* W = (e < NEXP) ? FIN_w_egu + (size_t)e * DM * 512 : FIN_w_sgu; \
            t.N = 512; t.K = DM; t.k0 = kb * 128; t.f16 = MOEF16; t.f8 = MOE_FP8; t.ws = WGU_SCALE; t.dst = MOE_FP8 ? (u16*)(F.ws + WS_BGU + (size_t)e * 512 * DM) : WSP(u16, WS_BGU) + (size_t)e * 512 * DM; t.src = W + (size_t)(kb * 128) * 512 + 32 * nb; t.rel_c0 = 32 * nb; t.mode = 2; t.dst_off = 0; break; } \
        r -= I_GU; \
        { const int e = r >> 6, q = r & 63, kb = q >> 5, nb = q & 31; const float* W = (e < NEXP) ? FIN_w_ed + (size_t)e * EFF * DM : FIN_w_sd; \
            t.N = DM; t.K = EFF; t.k0 = kb * 128; t.f16 = MOEF16; t.f8 = MOE_FP8; t.ws = WD_SCALE; t.dst = MOE_FP8 ? (u16*)(F.ws + WS_BD + (size_t)e * DM * EFF) : WSP(u16, WS_BD) + (size_t)e * DM * EFF; t.src = W + (size_t)(kb * 128) * DM + 32 * nb; t.rel_c0 = 32 * nb; t.mode = 0; t.dst_off = 0; } \
    } while (0)
__device__ __forceinline__ void transpose_range(Frame& F, int first, int count, int w, int nw) {
    LAS float* scr = (LAS float*)(F.lds + F.wave * P1_SCR); const int lane = F.lane; const int end = first + count;
    float bufA[64], bufB[64]; TItem ta, tb; int it = first + w;
    if (it < end) { TDECODE(it, ta); titem_load(ta, bufA, lane); }
    while (it < end) {
        const int itb = it + nw; const bool hb = itb < end;
        if (hb) { TDECODE(itb, tb); titem_load(tb, bufB, lane); }
        titem_finish(ta, bufA, scr, lane);
        if (!hb) break;
        const int ita = itb + nw; const bool ha = ita < end;
        if (ha) { TDECODE(ita, ta); titem_load(ta, bufA, lane); }
        titem_finish(tb, bufB, scr, lane);
        it = ita;
    }
}
__device__ __forceinline__ void p1_phase(Frame& F) {
    LAS float* scr = (LAS float*)(F.lds + F.wave * P1_SCR);
    const int gw = F.vcu * 8 + F.wave, NGW = F.G * 8, lane = F.lane;
    u16* BIN = WSP(u16, WS_BIN);
    for (int r = gw; r < I_FOLD; r += NGW) {
        const int fh = r >> 7, cs = (r >> 6) & 1, kb = (r >> 2) & 15, eq = r & 3; const int k = kb * 64 + lane;
        const GAS float* WCS = (const GAS float*)(F.ws + WS_TAB);
#pragma unroll 4
        for (int i = 0; i < 16; ++i) scr[(4 * i + (lane >> 4)) * 16 + (lane & 15)] = WCS[(fh * 64 + 4 * i + (lane >> 4)) * 128 + cs * 64 + 16 * eq + (lane & 15)];
        float wrow[64];
#pragma unroll
        for (int d4 = 0; d4 < 16; ++d4) { const f32x4 v = *(const f32x4*)(FIN_w_in + (size_t)k * 1536 + fh * 64 + 4 * d4); wrow[4 * d4] = v[0]; wrow[4 * d4 + 1] = v[1]; wrow[4 * d4 + 2] = v[2]; wrow[4 * d4 + 3] = v[3]; }
        LDS_WAIT(); asm volatile("" ::: "memory");
        for (int e1 = 0; e1 < 16; ++e1) { float a = 0.f;
#pragma unroll
            for (int d = 0; d < 64; ++d) a += wrow[d] * scr[d * 16 + e1];
            const int col256 = fh * 64 + 16 * eq + e1, pos = 8 * (col256 >> 2) + (col256 & 3) + 4 * cs;
            BIN[(size_t)pos * DM + k] = (u16)f2bf(a); }
        LDS_WAIT(); asm volatile("" ::: "memory");
    }
    const int ndefer = (F.G == 256) ? DEFER_A + DEFER_B : 0;
    REPS(11) transpose_range(F, 0, NT_ITEMS - ndefer, gw, NGW);
    const gi64* MOD = (const gi64*)(F.ctl + CW_MOD);
    u16* XN = WSP(u16, WS_XN);
    REPS(12) { const int wpb = NGW >> 2, b = gw / wpb, wi = gw % wpb;
        rownorm_rows<false>((const GAS float*)FIN_x, FIN_norm1_g, MOD + b * 6144, MOD + b * 6144 + 1024, XN, b * SEQ, SEQ, wi, wpb, lane);
        rownorm_rows<false>((const GAS float*)FIN_ctx, FIN_norm1_g, MOD + 4 * 6144, MOD + 4 * 6144 + 1024, XN + (size_t)NTOK * DM, 0, NCTX, gw, NGW, lane); }
}

__device__ __forceinline__ void fourier_unit(Frame& F, int b, int g) {
    LAS unsigned char* Zl = F.lds + RING_OFF;
    LAS f32x2* TW128 = (LAS f32x2*)(F.lds + TAB_OFF);
    LAS f32x2* TW64 = (LAS f32x2*)(F.lds + TAB_OFF + 1024);
    const int tid = F.tid;
    const GAS u32x4* Zg = (const GAS u32x4*)(F.ws + WS_Z + ((size_t)(b * 64 + g) * SEQ) * 16);
#pragma unroll 4
    for (int i = 0; i < 16; ++i) *(LAS u32x4*)(Zl + (size_t)(i * 512 + tid) * 16) = Zg[i * 512 + tid];
    if (tid < 128) { float s, c; sincospif((float)tid * (1.0f / 64.0f), &s, &c); TW128[tid] = (f32x2){c, s}; }
    else if (tid < 192) { float s, c; sincospif((float)(tid - 128) * (1.0f / 32.0f), &s, &c); TW64[tid - 128] = (f32x2){c, s}; }
    __syncthreads();
    const int k1 = tid & 127, q = tid >> 7;
    float yr[16][4], yi[16][4];
#pragma unroll
    for (int a = 0; a < 16; ++a)
#pragma unroll
        for (int e = 0; e < 4; ++e) { yr[a][e] = 0.f; yi[a][e] = 0.f; }
    for (int n1 = 0; n1 < 128; ++n1) {
        const f32x2 tw = TW128[(n1 * k1) & 127]; const float c = tw.x, s = tw.y;
#pragma unroll
        for (int a = 0; a < 16; ++a) { const u32x4 rw = *(const LAS u32x4*)(Zl + (size_t)(64 * n1 + 16 * q + a) * 16);
            const float uc[4] = {bflo(rw.x), bfhi(rw.x), bflo(rw.y), bfhi(rw.y)}, us[4] = {bflo(rw.z), bfhi(rw.z), bflo(rw.w), bfhi(rw.w)};
#pragma unroll
            for (int e = 0; e < 4; ++e) { yr[a][e] += uc[e] * c - us[e] * s; yi[a][e] -= uc[e] * s + us[e] * c; } }
    }
    __syncthreads();
    int k1b = k1; asm volatile("" : "+v"(k1b));
#pragma unroll
    for (int a = 0; a < 16; ++a) { const int n2 = 16 * q + a; const float fr_ = (float)(n2 * k1b) * (1.0f / 8192.0f);
        const float cp = __builtin_amdgcn_cosf(fr_), sp = __builtin_amdgcn_sinf(fr_);
        float pr[4], pi[4];
#pragma unroll
        for (int e = 0; e < 4; ++e) { pr[e] = yr[a][e] * cp + yi[a][e] * sp; pi[e] = yi[a][e] * cp - yr[a][e] * sp; }
        u32x4 w; w.x = pk2bf(pr[0], pr[1]); w.y = pk2bf(pr[2], pr[3]); w.z = pk2bf(pi[0], pi[1]); w.w = pk2bf(pi[2], pi[3]);
        *(LAS u32x4*)(Zl + (size_t)(n2 * 128 + k1b) * 16) = w; }
    __syncthreads();
    int k1c = k1; asm volatile("" : "+v"(k1c));
    float o[16][4];
#pragma unroll
    for (int a = 0; a < 16; ++a)
#pragma unroll
        for (int e = 0; e < 4; ++e) o[a][e] = 0.f;
    for (int n2 = 0; n2 < 64; ++n2) {
        const u32x4 rw = *(const LAS u32x4*)(Zl + (size_t)(n2 * 128 + k1c) * 16);
        const float pr[4] = {bflo(rw.x), bfhi(rw.x), bflo(rw.y), bfhi(rw.y)}, pi[4] = {bflo(rw.z), bfhi(rw.z), bflo(rw.w), bfhi(rw.w)};
#pragma unroll
        for (int a = 0; a < 16; ++a) { const f32x2 tw = TW64[(n2 * (16 * q + a)) & 63];
#pragma unroll
            for (int e = 0; e < 4; ++e) o[a][e] += pr[e] * tw.x + pi[e] * tw.y; }
    }
    u16* MIX = WSP(u16, WS_MIX);
#pragma unroll
    for (int a = 0; a < 16; ++a) { const int k2 = 16 * q + a; u32x2 w; w.x = pk2bf(o[a][0], o[a][1]); w.y = pk2bf(o[a][2], o[a][3]);
        *(GAS u32x2*)(MIX + ((size_t)(b * SEQ + k1c + 128 * k2)) * DM + 4 * g) = w; }
    __syncthreads();
}

__device__ __forceinline__ attn_body::s16x4 ftr(const LAS unsigned char* p) { return __builtin_bit_cast(attn_body::s16x4, __builtin_amdgcn_ds_read_tr16_b64_v4i16((LAS attn_body::v4i16_t*)p)); }
__device__ __forceinline__ void fourier_unit_mfma(Frame& F, int b, int g) {
    LAS unsigned char* Zl = F.lds + RING_OFF;
    const int tid = F.tid, lane = F.lane, w = F.wave;
    const char* Zg = (const char*)(F.ws + WS_Z) + ((size_t)(b * 64 + g) * SEQ) * 16;
#pragma unroll
    for (int i = 0; i < 16; ++i) __builtin_amdgcn_global_load_lds((const unsigned*)(Zg + (size_t)(i * 512 + tid) * 16), (LAS unsigned*)(Zl + (size_t)(i * 512 + w * 64) * 16), 16, 0, 0);
    VM_WAIT(); __syncthreads();
    f32x4 acc[2][16];
#pragma unroll
    for (int ro = 0; ro < 2; ++ro)
#pragma unroll
        for (int t = 0; t < 16; ++t) acc[ro][t] = (f32x4){0.f, 0.f, 0.f, 0.f};
    const GAS bf16x8* D1 = (const GAS bf16x8*)(F.ws + WS_TAB + 144 * 1024);
    const GAS bf16x8* D3 = (const GAS bf16x8*)(F.ws + WS_TAB + 272 * 1024);
    const int l15 = lane & 15, lq = lane >> 4;
    const unsigned bbase = (unsigned)((64 * (8 * lq + (l15 >> 2)) + (lane & 3)) * 16);
#pragma unroll 1
    for (int s1 = 0; s1 < 8; ++s1) {
        const int ri = s1 >> 2;
        const bf16x8 a0 = D1[(16 * w + l15) * 32 + 4 * s1 + lq], a1 = D1[(128 + 16 * w + l15) * 32 + 4 * s1 + lq];
        const LAS unsigned char* sb = Zl + bbase + (unsigned)((s1 & 3) * 32768 + 8 * ri);
#pragma unroll
        for (int t = 0; t < 16; ++t) { const attn_body::s16x4 lo = ftr(sb + 64 * t), hi = ftr(sb + 64 * t + 4096);
            const bf16x8 bf = (bf16x8){lo[0], lo[1], lo[2], lo[3], hi[0], hi[1], hi[2], hi[3]};
            acc[0][t] = __builtin_amdgcn_mfma_f32_16x16x32_bf16(a0, bf, acc[0][t], 0, 0, 0);
            acc[1][t] = __builtin_amdgcn_mfma_f32_16x16x32_bf16(a1, bf, acc[1][t], 0, 0, 0); }
    }
    __syncthreads();
    {   const int e = lane & 3; int k1b = 16 * w + 4 * lq; asm volatile("" : "+v"(k1b));
#pragma unroll
        for (int t = 0; t < 16; ++t) { const int n2 = 4 * t + (l15 >> 2);
#pragma unroll
            for (int r = 0; r < 4; ++r) { const int k1 = k1b + r; const float fr_ = (float)(n2 * k1) * (1.0f / 8192.0f); const float cp = __builtin_amdgcn_cosf(fr_), sp = __builtin_amdgcn_sinf(fr_);
                const float yr = acc[0][t][r], yi = acc[1][t][r]; const float pr = yr * cp + yi * sp, pi = yi * cp - yr * sp;
                *(LAS u16*)(Zl + (unsigned)(((n2) * 512 + k1 * 4 + e) * 2)) = (u16)f2bf(pr);
                *(LAS u16*)(Zl + (unsigned)(((64 + n2) * 512 + k1 * 4 + e) * 2)) = (u16)f2bf(pi); } }
    }
    asm volatile("s_waitcnt lgkmcnt(0)" ::: "memory");
    f32x4 acc3[4][4];
#pragma unroll
    for (int mt = 0; mt < 4; ++mt)
#pragma unroll
        for (int j = 0; j < 4; ++j) acc3[mt][j] = (f32x4){0.f, 0.f, 0.f, 0.f};
#pragma unroll
    for (int s3 = 0; s3 < 4; ++s3) {
        bf16x8 a[4];
#pragma unroll
        for (int mt = 0; mt < 4; ++mt) a[mt] = D3[(16 * mt + l15) * 16 + 4 * s3 + lq];
        const unsigned kk = (unsigned)(32 * s3 + 8 * lq + (l15 >> 2));
#pragma unroll
        for (int j = 0; j < 4; ++j) { const unsigned ad = kk * 1024u + (unsigned)((4 * (4 * w + j) + (lane & 3)) * 8);
            const attn_body::s16x4 lo = ftr(Zl + ad), hi = ftr(Zl + ad + 4096);
            const bf16x8 bf = (bf16x8){lo[0], lo[1], lo[2], lo[3], hi[0], hi[1], hi[2], hi[3]};
#pragma unroll
            for (int mt = 0; mt < 4; ++mt) acc3[mt][j] = __builtin_amdgcn_mfma_f32_16x16x32_bf16(a[mt], bf, acc3[mt][j], 0, 0, 0); }
    }
    u16* MIX = WSP(u16, WS_MIX);
#pragma unroll
    for (int mt = 0; mt < 4; ++mt)
#pragma unroll
        for (int j = 0; j < 4; ++j)
#pragma unroll
            for (int r = 0; r < 4; ++r) { const int k2 = 16 * mt + 4 * lq + r, k1 = 16 * w + 4 * j + (l15 >> 2);
                MIX[((size_t)(b * SEQ + k1 + 128 * k2)) * DM + 4 * g + (lane & 3)] = (u16)f2bf(acc3[mt][j][r]); }
    __syncthreads();
}

__device__ __forceinline__ float dpp_f(float v, int ctrl_sel) {
    const int x = __builtin_bit_cast(int, v); int r;
    if (ctrl_sel == 0) r = __builtin_amdgcn_update_dpp(x, x, 0xB1, 0xF, 0xF, false);
    else if (ctrl_sel == 1) r = __builtin_amdgcn_update_dpp(x, x, 0x4E, 0xF, 0xF, false);
    else if (ctrl_sel == 2) r = __builtin_amdgcn_update_dpp(x, x, 0x141, 0xF, 0xF, false);
    else r = __builtin_amdgcn_update_dpp(x, x, 0x140, 0xF, 0xF, false);
    return __builtin_bit_cast(float, r);
}
__device__ __forceinline__ void route_token(Frame& F, int tok) {
    const int l = F.lane;
    const f32x4 lg = *(const GAS f32x4*)((const GAS float*)(F.ws + WS_LOG) + (size_t)tok * NEXP + 4 * l);
    const f32x4 bs = *(const f32x4*)(FIN_router_bias + 4 * l);
    float s[4], sel[4];
#pragma unroll
    for (int j = 0; j < 4; ++j) { s[j] = 1.0f / (1.0f + expf(-lg[j])); sel[j] = s[j] + bs[j]; }
    float m1 = fmaxf(sel[0], sel[1]), m2 = fminf(sel[0], sel[1]);
#pragma unroll
    for (int j = 2; j < 4; ++j) { const float v = sel[j]; m2 = fmaxf(m2, fminf(m1, v)); m1 = fmaxf(m1, v); }
#pragma unroll
    for (int st = 0; st < 3; ++st) { const float o1 = dpp_f(m1, st), o2 = dpp_f(m2, st); const float n2 = fmaxf(fminf(m1, o1), fmaxf(m2, o2)); m1 = fmaxf(m1, o1); m2 = n2; }
    const float gs = m1 + m2; const int myg = l >> 3; int rank = 0;
#pragma unroll
    for (int g2 = 0; g2 < 8; ++g2) { const float og = rdl(gs, g2 * 8); rank += (og > gs || (og == gs && g2 < myg)) ? 1 : 0; }
    if (rank >= 4) {
#pragma unroll
        for (int j = 0; j < 4; ++j) sel[j] = -INFINITY; }
    int my_e = 0; float my_s = 0.f, sum = 0.f;
#pragma unroll 1
    for (int k = 0; k < TOPK; ++k) {
        const float lb = fmaxf(fmaxf(sel[0], sel[1]), fmaxf(sel[2], sel[3]));
        float r = lb; r = fmaxf(r, dpp_f(r, 0)); r = fmaxf(r, dpp_f(r, 1)); r = fmaxf(r, dpp_f(r, 2)); r = fmaxf(r, dpp_f(r, 3));
        const float wm = fmaxf(fmaxf(rdl(r, 0), rdl(r, 16)), fmaxf(rdl(r, 32), rdl(r, 48)));
        const unsigned long long mask = __ballot(lb == wm);
        const int wl = __builtin_amdgcn_readfirstlane((int)__ffsll((long long)mask) - 1);
        const int jj = (sel[0] == wm) ? 0 : (sel[1] == wm) ? 1 : (sel[2] == wm) ? 2 : 3;
        const float cand = (jj == 0) ? s[0] : (jj == 1) ? s[1] : (jj == 2) ? s[2] : s[3];
        const int jw = __builtin_amdgcn_readlane(jj, wl); const float wsc = rdl(cand, wl);
        if (l == wl) {
#pragma unroll
            for (int j = 0; j < 4; ++j) if (jw == j) sel[j] = -INFINITY; }
        if (l == k) { my_e = 4 * wl + jw; my_s = wsc; }
        sum += wsc;
    }
    GAS u32x2* LIST = (GAS u32x2*)(F.ws + WS_LIST);
    if (l < TOPK) { const float gate = my_s / sum * 2.5f; const unsigned pos = __hip_atomic_fetch_add((unsigned*)(F.ctl + CW_CNT + my_e), 1u, RLX_AGENT);
        LIST[(size_t)my_e * NTOK + pos] = (u32x2){(unsigned)tok | ((unsigned)l << 16), __builtin_bit_cast(unsigned, gate)}; }
    else if (l == TOPK) LIST[(size_t)NEXP * NTOK + tok] = (u32x2){(unsigned)tok | (8u << 16), __builtin_bit_cast(unsigned, 1.0f)};
}

__device__ __forceinline__ void build_tiles(Frame& F) {
    LAS int* TS = (LAS int*)(F.lds + TAB_OFF + 2048); LAS int* CN = (LAS int*)(F.lds + TAB_OFF + 3200);
    if (F.tid < 64) { const int l = F.tid; int c[5], t[5], tot = 0;
#pragma unroll
        for (int j = 0; j < 5; ++j) { const int e = 5 * l + j; c[j] = (e < NEXPS) ? (int)__hip_atomic_load((unsigned*)(F.ctl + CW_CNT + e), RLX_AGENT) : 0; t[j] = (c[j] + 255) >> 8; tot += t[j]; }
        int x = tot;
#pragma unroll
        for (int off = 1; off < 64; off <<= 1) { const int v = __shfl_up(x, off); if (l >= off) x += v; }
        int run = x - tot;
#pragma unroll
        for (int j = 0; j < 5; ++j) { const int e = 5 * l + j; if (e <= NEXPS) { TS[e] = run; if (e < NEXPS) CN[e] = c[j]; } run += t[j]; }
    }
    __syncthreads();
    {
        LAS unsigned short* TEXP = (LAS unsigned short*)(F.lds + TAB_OFF + 4608);
        for (int e = F.tid; e < NEXPS; e += 512) { const int t0 = TS[e], t1 = TS[e + 1]; for (int T = t0; T < t1; ++T) TEXP[T] = (unsigned short)e; }
    }
    __syncthreads();
}

__device__ __forceinline__ void ph2(Frame& F) {
    const gi64* MOD = (const gi64*)(F.ctl + CW_MOD); const int gw = F.vcu * 8 + F.wave, NGW = F.G * 8; (void)MOD; (void)gw; (void)NGW;
        DenseOrder S{7, 128 * 7, 8, F.G, F.vcu, (const char*)(F.ws + WS_BIN), DM, (REP == 22) ? 2 : 1};
        EpiInProj E{WSP(u16, WS_Z), WSP(u16, WS_Q), WSP(u16, WS_K), WSP(u16, WS_V), WSP(float, WS_TAB + 128 * 1024), WSP(float, WS_TAB + 136 * 1024), FIN_q_norm_g, FIN_k_norm_g};
        pg8::gemm_phase<EpiInProj, DenseOrder, 0, true>(F.lds + RING_OFF, (const char*)(F.ws + WS_XN), DM, S, E);
        if (F.G == 256 && F.vcu >= 136) transpose_range(F, NT_ITEMS - DEFER_A - DEFER_B, DEFER_A, (F.vcu - 136) * 8 + F.wave, 120 * 8);
    }
__device__ __forceinline__ void ph4(Frame& F) {
    const gi64* MOD = (const gi64*)(F.ctl + CW_MOD); const int gw = F.vcu * 8 + F.wave, NGW = F.G * 8; (void)MOD; (void)gw; (void)NGW;
        if (DBG & 128) { GAS u32x4* zH = (GAS u32x4*)(F.ws + WS_H2); const size_t nH = (size_t)NTOK * DM * 2 / 16; for (size_t i = (size_t)blockIdx.x * 512 + F.tid; i < nH; i += (size_t)F.G * 512) zH[i] = (u32x4){0u, 0u, 0u, 0u}; }
        DenseOrder S{4, 128 * 4, 0, F.G, F.vcu, (const char*)(F.ws + WS_BOUT), DM, 1};
        EpiResid E{FIN_x, WSP(u16, WS_XN), MOD};
        pg8::gemm_phase<EpiResid, DenseOrder, 0, true>(F.lds + RING_OFF, (const char*)(F.ws + WS_MIX), DM, S, E);
    }
__device__ __forceinline__ void ph5(Frame& F) {
    const gi64* MOD = (const gi64*)(F.ctl + CW_MOD); const int gw = F.vcu * 8 + F.wave, NGW = F.G * 8;
    const int wpb = NGW >> 2, b = gw / wpb, wi = gw % wpb;
    rownorm_rows<(MOE_FP8 ? false : MOEF16), MOE_FP8, true>((const GAS float*)(F.ws + WS_XN), FIN_norm2_g, MOD + b * 6144 + 3072, MOD + b * 6144 + 4096, WSP(u16, WS_H2), b * SEQ, SEQ, wi, wpb, F.lane, F.ws + WS_H2F8);
}
__device__ __forceinline__ void ph6(Frame& F) {
    const gi64* MOD = (const gi64*)(F.ctl + CW_MOD); const int gw = F.vcu * 8 + F.wave, NGW = F.G * 8; (void)MOD; (void)gw; (void)NGW;
        DenseOrder S{1, 128, 0, F.G, F.vcu, (const char*)(F.ws + WS_BR), DM, 1};
        EpiLogits E{WSP(float, WS_LOG)};
        pg8::gemm_phase<EpiLogits, DenseOrder, (MOE_FP8 ? 0 : (MOE_F16 ? 1 : 0)), true>(F.lds + RING_OFF, (const char*)(F.ws + WS_H2), DM, S, E);
        if (F.G == 256 && F.vcu >= 128) transpose_range(F, NT_ITEMS - DEFER_B, DEFER_B, (F.vcu - 128) * 8 + F.wave, 128 * 8);
    }
__device__ __forceinline__ void ph8(Frame& F) {
    const gi64* MOD = (const gi64*)(F.ctl + CW_MOD); const int gw = F.vcu * 8 + F.wave, NGW = F.G * 8; (void)MOD; (void)gw; (void)NGW;
        build_tiles(F);
        GroupedOrder<true> S{2, F.G, F.vcu, 512, DM * (MOE_FP8 ? 1 : 2), true, (const char*)(F.ws + WS_BGU), (const LAS int*)(F.lds + TAB_OFF + 2048), (const LAS int*)(F.lds + TAB_OFF + 3200), (const GAS u32x2*)(F.ws + WS_LIST), (REP == 28) ? 2 : 1, __builtin_amdgcn_readfirstlane(((const LAS int*)(F.lds + TAB_OFF + 2048))[257])};
        EpiSwiglu E{WSP(u16, WS_ACT)};
        pg8::gemm_phase<EpiSwiglu, GroupedOrder<true>, MOE_DT, true>(F.lds + RING_OFF, (const char*)(F.ws + (MOE_FP8 ? WS_H2F8 : WS_H2)), DM, S, E, SC_GU);
    }
__device__ __forceinline__ void ph9(Frame& F) {
    const gi64* MOD = (const gi64*)(F.ctl + CW_MOD); const int gw = F.vcu * 8 + F.wave, NGW = F.G * 8; (void)MOD; (void)gw; (void)NGW;
        build_tiles(F);
        GroupedOrder<false> S{4, F.G, F.vcu, DM, EFF * (MOE_FP8 ? 1 : 2), false, (const char*)(F.ws + WS_BD), (const LAS int*)(F.lds + TAB_OFF + 2048), (const LAS int*)(F.lds + TAB_OFF + 3200), (const GAS u32x2*)(F.ws + WS_LIST), (REP == 29) ? 2 : 1, __builtin_amdgcn_readfirstlane(((const LAS int*)(F.lds + TAB_OFF + 2048))[257])};
        EpiDown E{WSP(u16, WS_C), (const GAS u32x2*)(F.ws + WS_LIST), F.ws + WS_DUMP};
        pg8::gemm_phase<EpiDown, GroupedOrder<false>, MOE_DT, true>(F.lds + RING_OFF, (const char*)(F.ws + WS_ACT), EFF, S, E, SC_D);
    }

#if DBG & (1024 | 2048)
__device__ __forceinline__ float f8dec(unsigned w, int k) { return (k == 0) ? __builtin_amdgcn_cvt_f32_fp8((int)w, 0) : (k == 1) ? __builtin_amdgcn_cvt_f32_fp8((int)w, 1) : (k == 2) ? __builtin_amdgcn_cvt_f32_fp8((int)w, 2) : __builtin_amdgcn_cvt_f32_fp8((int)w, 3); }
__device__ __forceinline__ void chk_attn(Frame& F, float negM) {
    const int gw = F.vcu * 8 + F.wave, NGW = F.G * 8, lane = F.lane;
    const GAS u16* Q = (const GAS u16*)(F.ws + WS_Q); const GAS u16* K = (const GAS u16*)(F.ws + WS_K); const GAS u16* V = (const GAS u16*)(F.ws + WS_V); const GAS u16* MIX = (const GAS u16*)(F.ws + WS_MIX);
    const GAS unsigned char* Q8 = (const GAS unsigned char*)(F.ws + WS_Q); const GAS unsigned char* K8 = (const GAS unsigned char*)(F.ws + WS_K); const GAS unsigned char* Vt8 = (const GAS unsigned char*)(F.ws + WS_V);
    float* chk = (float*)(F.ctl + CW_CHK);
    if (ATTN_FP8 && ATTN_W64) negM = -ceilf(fmaxf(-negM - 8.8f, 0.f)); else if (ATTN_FP8) negM = fminf(negM + 8.8f, 0.f);
    for (int i = gw; i < 4096; i += NGW) {
        const int b = i & 3, h = (i >> 2) % 12, q = (int)((((unsigned)i * 2654435761u) >> 19) & 8191u), kvh = h / 3;
        float qv[64], o[64]; float l = 0.f;
        if (ATTN_FP8) {
#pragma unroll
            for (int c = 0; c < 16; ++c) { const unsigned w = *(const GAS unsigned*)(Q8 + ((size_t)(b * SEQ + q)) * QW + h * 64 + 4 * c);
#pragma unroll
                for (int k = 0; k < 4; ++k) qv[4 * c + k] = f8dec(w, k) * (1.0f / Q8_SCALE); }
        } else {
#pragma unroll
        for (int c = 0; c < 8; ++c) { const u32x4 w = *(const GAS u32x4*)(Q + ((size_t)(b * SEQ + q)) * QW + h * 64 + 8 * c);
            qv[8 * c] = bflo(w.x); qv[8 * c + 1] = bfhi(w.x); qv[8 * c + 2] = bflo(w.y); qv[8 * c + 3] = bfhi(w.y); qv[8 * c + 4] = bflo(w.z); qv[8 * c + 5] = bfhi(w.z); qv[8 * c + 6] = bflo(w.w); qv[8 * c + 7] = bfhi(w.w); }
        }
#pragma unroll
        for (int d = 0; d < 64; ++d) o[d] = 0.f;
        for (int t = 0; t < LKV / 64; ++t) { const int j = t * 64 + lane; float dot = 0.f, pp, pq;
            if (ATTN_FP8) { const GAS unsigned char* kr = K8 + ((size_t)(b * LKV + j)) * KVW + kvh * 64;
#pragma unroll
                for (int c = 0; c < 16; ++c) { const unsigned w = *(const GAS unsigned*)(kr + 4 * c);
#pragma unroll
                    for (int k = 0; k < 4; ++k) dot += qv[4 * c + k] * f8dec(w, k); }
                pp = exp2f(dot + negM); pq = __builtin_amdgcn_cvt_f32_fp8(__builtin_amdgcn_cvt_pk_fp8_f32(pp, 0.f, 0, false), 0); l += pq;
                const GAS unsigned char* vb = Vt8 + (((size_t)(b * NKVH + kvh) * (LKV / 64) + t) * 64) * 64 + attn_body::vt_slot(lane);
#pragma unroll
                for (int d = 0; d < 64; ++d) o[d] += pq * __builtin_amdgcn_cvt_f32_fp8((int)vb[d * 64], 0);
            } else { const GAS u16* kr = K + ((size_t)(b * LKV + j)) * KVW + kvh * 64; const GAS u16* vr = V + ((size_t)(b * LKV + j)) * KVW + kvh * 64;
#pragma unroll
            for (int c = 0; c < 8; ++c) { const u32x4 w = *(const GAS u32x4*)(kr + 8 * c);
                dot += qv[8 * c] * bflo(w.x) + qv[8 * c + 1] * bfhi(w.x) + qv[8 * c + 2] * bflo(w.y) + qv[8 * c + 3] * bfhi(w.y) + qv[8 * c + 4] * bflo(w.z) + qv[8 * c + 5] * bfhi(w.z) + qv[8 * c + 6] * bflo(w.w) + qv[8 * c + 7] * bfhi(w.w); }
            pp = exp2f(dot + negM); l += pp;
#pragma unroll
            for (int c = 0; c < 8; ++c) { const u32x4 w = *(const GAS u32x4*)(vr + 8 * c);
                o[8 * c] += pp * bflo(w.x); o[8 * c + 1] += pp * bfhi(w.x); o[8 * c + 2] += pp * bflo(w.y); o[8 * c + 3] += pp * bfhi(w.y); o[8 * c + 4] += pp * bflo(w.z); o[8 * c + 5] += pp * bfhi(w.z); o[8 * c + 6] += pp * bflo(w.w); o[8 * c + 7] += pp * bfhi(w.w); } } }
        l = wave_sum(l); float err = 0.f, ref = 0.f;
#pragma unroll
        for (int d = 0; d < 64; ++d) { const float od = wave_sum(o[d]) / l; const float mv = bflo((unsigned)MIX[((size_t)(b * SEQ + q)) * DM + 256 + h * 64 + d]); err += (od - mv) * (od - mv); ref += od * od; }
        if (lane == 0) { atomicAdd(chk + 0, err); atomicAdd(chk + 1, ref); }
    }
}
__device__ __forceinline__ void chk_qkv(Frame& F) {
    const int gw = F.vcu * 8 + F.wave, NGW = F.G * 8, lane = F.lane;
    const gi64* MOD = (const gi64*)(F.ctl + CW_MOD);
    LAS float* hrow = (LAS float*)(F.lds + RING_OFF + F.wave * 16384);
    float* chk = (float*)(F.ctl + CW_CHK);
    for (int i = gw; i < 4096; i += NGW) {
        const unsigned hs = (unsigned)i * 2654435761u; const bool isctx = (i & 15) == 15; int sel = i % 20; if (isctx && sel < 12) sel = 12 + (sel & 7);
        const int m = isctx ? (int)((hs >> 10) & 1023u) : (int)((hs >> 12) & 32767u);
        const float* src = isctx ? FIN_ctx + (size_t)m * DM : FIN_x + (size_t)m * DM; const int mr = isctx ? 4 : (m >> 13);
        const int b = isctx ? (m >> 8) : (m >> 13), l = isctx ? 0 : (m & 8191), key = isctx ? SEQ + (m & 255) : l;
        f32x4 v[4]; float s2 = 0.f;
#pragma unroll
        for (int j = 0; j < 4; ++j) { v[j] = *(const f32x4*)(src + 4 * lane + 256 * j); s2 += (v[j][0] * v[j][0] + v[j][1] * v[j][1]) + (v[j][2] * v[j][2] + v[j][3] * v[j][3]); }
        const float rstd = 1.0f / sqrtf(wave_sum(s2) * (1.0f / DM) + RMS_EPS);
#pragma unroll
        for (int j = 0; j < 4; ++j) { const int col = 4 * lane + 256 * j; const f32x4 g = *(const f32x4*)(FIN_norm1_g + col); const f32x4 sh = mod4(MOD, mr * 6144 + col), sc = mod4(MOD, mr * 6144 + 1024 + col);
            const f32x4 y = v[j] * rstd * g * (sc + 1.0f) + sh; hrow[col] = y[0]; hrow[col + 1] = y[1]; hrow[col + 2] = y[2]; hrow[col + 3] = y[3]; }
        LDS_WAIT(); asm volatile("" ::: "memory");
        const int colbase = (sel < 12) ? 256 + 64 * sel : (sel < 16 ? 1024 + 64 * (sel - 12) : 1280 + 64 * (sel - 16));
        float z = 0.f;
        for (int k = 0; k < DM; ++k) z += hrow[k] * FIN_w_in[(size_t)k * 1536 + colbase + lane];
        float outv = z; int spos = lane;
        if (sel < 16) { const float ss = wave_sum(z * z); const float gain = (sel < 12) ? FIN_q_norm_g[lane] : FIN_k_norm_g[lane]; const float zz = z * (1.0f / sqrtf(ss * (1.0f / 64.0f) + RMS_EPS)) * gain;
            const float pz = __shfl(zz, lane ^ 16); outv = zz;
            if (!isctx) { const int pidx = (lane & 32) ? (l & 63) : (l >> 6); const float inv = powf(10000.0f, -(float)(lane & 15) / 16.0f), ang = (float)pidx * inv; const float cs = cosf(ang), sn = sinf(ang);
                outv = (lane & 16) ? zz * cs + pz * sn : zz * cs - pz * sn; }
            if (sel < 12) outv *= C2;
            spos = 32 * (lane >> 5) + 8 * ((lane >> 2) & 3) + 4 * ((lane >> 4) & 1) + (lane & 3); }
        float stored;
        if (ATTN_FP8) {
            if (sel < 12) stored = __builtin_amdgcn_cvt_f32_fp8((int)((const GAS unsigned char*)(F.ws + WS_Q))[(size_t)m * QW + sel * 64 + spos], 0) * (1.0f / Q8_SCALE);
            else if (sel < 16) stored = __builtin_amdgcn_cvt_f32_fp8((int)((const GAS unsigned char*)(F.ws + WS_K))[((size_t)(b * LKV + key)) * KVW + (sel - 12) * 64 + spos], 0);
            else stored = __builtin_amdgcn_cvt_f32_fp8((int)((const GAS unsigned char*)(F.ws + WS_V))[((((size_t)(b * NKVH + (sel - 16)) * (LKV / 64) + (key >> 6)) * 64 + lane) * 64) + attn_body::vt_slot(key & 63)], 0);
        } else {
        if (sel < 12) stored = bflo((unsigned)((const GAS u16*)(F.ws + WS_Q))[(size_t)m * QW + sel * 64 + spos]);
        else if (sel < 16) stored = bflo((unsigned)((const GAS u16*)(F.ws + WS_K))[((size_t)(b * LKV + key)) * KVW + (sel - 12) * 64 + spos]);
        else stored = bflo((unsigned)((const GAS u16*)(F.ws + WS_V))[((size_t)(b * LKV + key)) * KVW + (sel - 16) * 64 + lane]); }
        const float err = wave_sum((outv - stored) * (outv - stored)), ref = wave_sum(outv * outv);
        if (lane == 0) { atomicAdd(chk + 2, err); atomicAdd(chk + 3, ref); }
        LDS_WAIT(); asm volatile("" ::: "memory");
    }
}
#endif

struct Args { const float* in[20]; float* out; unsigned char* ws; int ph_lo, ph_hi; };
__global__ void __launch_bounds__(512, 2) mk_fwd(Args args) {
    extern __shared__ __attribute__((aligned(16))) unsigned char lds[];
    Frame F;
    F.lds = (LAS unsigned char*)lds;
    F.MISC = (volatile LAS unsigned*)(F.lds + MISC_OFF);
    F.tid = threadIdx.x; F.lane = F.tid & 63; F.wave = __builtin_amdgcn_readfirstlane(F.tid >> 6);
    F.G = gridDim.x; { const int bx = blockIdx.x; F.vcu = (F.G % 8 == 0) ? (bx % 8) * (F.G / 8) + bx / 8 : bx; }
    F.ws = args.ws; F.ctl = (gu32*)(args.ws + WS_CTL); F.out = args.out;
    F.ka = (const float* const*)__builtin_amdgcn_kernarg_segment_ptr();
    for (int u = F.tid; u < (LDS_BYTES - LDSCTL_OFF) / 4; u += 512) ((LAS unsigned*)(F.lds + LDSCTL_OFF))[u] = 0u;
    if (SYN_ZERO) { for (int u = F.tid; u < 49152 / 4; u += 512) ((LAS unsigned*)F.lds)[u] = 0u; }
    __syncthreads();
#if SYN
    {
        typedef int sv8 __attribute__((ext_vector_type(8))); typedef attn_body::f32x16 f32x16;

        const bool lowh = F.wave < 4;
        sv8 a_ = (sv8){F.tid, 1, 2, 3, 4, 5, 6, 7}, b_ = (sv8){7, 6, 5, 4, 3, 2, 1, F.tid};
        if (SYN_RND) { for (int i = 0; i < 8; ++i) { unsigned ha = (unsigned)(F.tid * 8 + i) * 2654435761u, hb = (unsigned)(F.tid * 8 + i + 4096) * 2246822519u; ha ^= ha >> 15; hb ^= hb >> 13; a_[i] = (int)(ha & 0x7f7f7f7fu & ~0x40404040u); b_[i] = (int)(hb & 0xbfbfbfbfu); } }
        f32x16 m0 = f32x16{}, m1 = f32x16{}, m2 = f32x16{}, m3 = f32x16{}, m4 = f32x16{};
        f32x16 e0, e1; for (int r = 0; r < 16; ++r) { e0[r] = -(float)(F.lane + r); e1[r] = -(float)(F.lane + 2 * r); }
        sv8 pk = (sv8){0, 0, 0, 0, 0, 0, 0, 0};
        const bool doM = lowh ? (SYN & 1) : (SYN & 4), doE = lowh ? (SYN & 8) : (SYN & 2), doI = lowh && (SYN & 16);
#define SYN_M(x) x = __builtin_amdgcn_mfma_scale_f32_32x32x64_f8f6f4(a_, b_, x, 0, 0, 0, 0x7f7f, 1, 0x7f7f)
#define SYN_E(v, r) v[r] = __builtin_amdgcn_exp2f(v[r])
#define SYN_C(k, v, B) pk[k] = __builtin_amdgcn_cvt_pk_fp8_f32(v[B + 2], v[B + 3], __builtin_amdgcn_cvt_pk_fp8_f32(v[B], v[B + 1], pk[k], false), true)
#pragma unroll 1
        for (int it = 0; it < SYN_N; ++it) {
            if (doM) { SYN_M(m0); SYN_M(m1); SYN_M(m2); SYN_M(m3); SYN_M(m4); }
            if (doE) {
                if (SYN_EM & 1) {
#pragma unroll
                for (int r = 0; r < 16; ++r) { SYN_E(e0, r); SYN_E(e1, r); } }
                if (SYN_EM & 4) {
#pragma unroll
                    for (int r = 0; r < 16; ++r) SYN_E(e0, r);
                    __builtin_amdgcn_sched_barrier(0);
                    SYN_E(e1, 0); SYN_E(e1, 1); SYN_E(e1, 2); SYN_E(e1, 3); __builtin_amdgcn_sched_barrier(0); SYN_C(0, e0, 0); __builtin_amdgcn_sched_barrier(0);
                    SYN_E(e1, 4); SYN_E(e1, 5); SYN_E(e1, 6); SYN_E(e1, 7); __builtin_amdgcn_sched_barrier(0); SYN_C(1, e0, 4); __builtin_amdgcn_sched_barrier(0);
                    SYN_E(e1, 8); SYN_E(e1, 9); SYN_E(e1, 10); SYN_E(e1, 11); __builtin_amdgcn_sched_barrier(0); SYN_C(2, e0, 8); __builtin_amdgcn_sched_barrier(0);
                    SYN_E(e1, 12); SYN_E(e1, 13); SYN_E(e1, 14); SYN_E(e1, 15); __builtin_amdgcn_sched_barrier(0); SYN_C(3, e0, 12); __builtin_amdgcn_sched_barrier(0);
                    SYN_C(4, e1, 0); SYN_C(5, e1, 4); SYN_C(6, e1, 8); SYN_C(7, e1, 12); }
                if (SYN_EM & 8) {
#define SYN_Q(k, v, B) SYN_E(v, B); SYN_E(v, B + 1); SYN_E(v, B + 2); SYN_E(v, B + 3); __builtin_amdgcn_sched_barrier(0); if (k > 0) { if (k <= 4) SYN_C(k - 1, e0, 4 * (k - 1)); else SYN_C(k - 1, e1, 4 * (k - 5)); } __builtin_amdgcn_sched_barrier(0)
                    SYN_Q(0, e0, 0); SYN_Q(1, e0, 4); SYN_Q(2, e0, 8); SYN_Q(3, e0, 12); SYN_Q(4, e1, 0); SYN_Q(5, e1, 4); SYN_Q(6, e1, 8); SYN_Q(7, e1, 12); SYN_C(7, e1, 12); }
                if (SYN_EM & 16) {
                    typedef short v2s_ __attribute__((ext_vector_type(2))); float one_ = 1.0f; asm volatile("" : "+v"(one_));
#define SYN_CS(k, v, B) pk[k] = __builtin_bit_cast(int, __builtin_amdgcn_cvt_scalef32_pk_fp8_f32(__builtin_amdgcn_cvt_scalef32_pk_fp8_f32(__builtin_bit_cast(v2s_, pk[k]), v[B], v[B + 1], one_, false), v[B + 2], v[B + 3], one_, true))
                    SYN_CS(0, e0, 0); SYN_CS(1, e0, 4); SYN_CS(2, e0, 8); SYN_CS(3, e0, 12); SYN_CS(4, e1, 0); SYN_CS(5, e1, 4); SYN_CS(6, e1, 8); SYN_CS(7, e1, 12); }
                if (SYN_EM & 32) {
                    pk[0] = (int)attn_body::cvtpk_s(e0[0], e0[1]); pk[1] = (int)attn_body::cvtpk_s(e0[2], e0[3]); pk[2] = (int)attn_body::cvtpk_s(e0[4], e0[5]); pk[3] = (int)attn_body::cvtpk_s(e0[6], e0[7]);
                    pk[4] = (int)attn_body::cvtpk_s(e0[8], e0[9]); pk[5] = (int)attn_body::cvtpk_s(e0[10], e0[11]); pk[6] = (int)attn_body::cvtpk_s(e0[12], e0[13]); pk[7] = (int)attn_body::cvtpk_s(e0[14], e0[15]);
                    asm volatile("" : "+v"(pk));
                    pk[0] = (int)attn_body::cvtpk_s(e1[0], e1[1]); pk[1] = (int)attn_body::cvtpk_s(e1[2], e1[3]); pk[2] = (int)attn_body::cvtpk_s(e1[4], e1[5]); pk[3] = (int)attn_body::cvtpk_s(e1[6], e1[7]);
                    pk[4] = (int)attn_body::cvtpk_s(e1[8], e1[9]); pk[5] = (int)attn_body::cvtpk_s(e1[10], e1[11]); pk[6] = (int)attn_body::cvtpk_s(e1[12], e1[13]); pk[7] = (int)attn_body::cvtpk_s(e1[14], e1[15]); }
                if (SYN_EM & 2) { SYN_C(0, e0, 0); SYN_C(1, e0, 4); SYN_C(2, e0, 8); SYN_C(3, e0, 12); SYN_C(4, e1, 0); SYN_C(5, e1, 4); SYN_C(6, e1, 8); SYN_C(7, e1, 12); }
                asm volatile("" : "+v"(e0), "+v"(e1), "+v"(pk)); }
            if (doI) {
                __builtin_amdgcn_sched_barrier(0);
                SYN_M(m0); __builtin_amdgcn_sched_barrier(0); SYN_E(e0, 0); SYN_E(e0, 1); SYN_E(e0, 2); SYN_E(e0, 3); SYN_E(e0, 4); SYN_E(e0, 5); SYN_E(e0, 6); __builtin_amdgcn_sched_barrier(0);
                SYN_M(m1); __builtin_amdgcn_sched_barrier(0); SYN_E(e0, 7); SYN_E(e0, 8); SYN_E(e0, 9); SYN_E(e0, 10); SYN_E(e0, 11); SYN_E(e0, 12); SYN_E(e0, 13); __builtin_amdgcn_sched_barrier(0);
                SYN_M(m2); __builtin_amdgcn_sched_barrier(0); SYN_E(e0, 14); SYN_E(e0, 15); SYN_E(e1, 0); SYN_E(e1, 1); SYN_E(e1, 2); SYN_E(e1, 3); SYN_E(e1, 4); __builtin_amdgcn_sched_barrier(0);
                SYN_M(m3); __builtin_amdgcn_sched_barrier(0); SYN_E(e1, 5); SYN_E(e1, 6); SYN_E(e1, 7); SYN_E(e1, 8); SYN_E(e1, 9); SYN_E(e1, 10); SYN_E(e1, 11); __builtin_amdgcn_sched_barrier(0);
                SYN_M(m4); __builtin_amdgcn_sched_barrier(0); SYN_E(e1, 12); SYN_E(e1, 13); SYN_E(e1, 14); SYN_E(e1, 15);
                SYN_C(0, e0, 0); SYN_C(1, e0, 4); SYN_C(2, e0, 8); SYN_C(3, e0, 12); SYN_C(4, e1, 0); SYN_C(5, e1, 4); SYN_C(6, e1, 8); SYN_C(7, e1, 12);
                asm volatile("" : "+v"(e0), "+v"(e1), "+v"(pk)); __builtin_amdgcn_sched_barrier(0); }
        }
        if (SYN & (32 | 64 | 128 | 1024)) {
            f32x16 ng; for (int r = 0; r < 16; ++r) ng[r] = -1.0f - (float)r; asm volatile("" : "+v"(ng));
#define SYN_EB() do { _Pragma("unroll") for (int r = 0; r < 16; ++r) { SYN_E(e0, r); SYN_E(e1, r); } \
                SYN_C(0, e0, 0); SYN_C(1, e0, 4); SYN_C(2, e0, 8); SYN_C(3, e0, 12); SYN_C(4, e1, 0); SYN_C(5, e1, 4); SYN_C(6, e1, 8); SYN_C(7, e1, 12); } while (0)
#define SYN_MB() do { e0 = __builtin_amdgcn_mfma_scale_f32_32x32x64_f8f6f4(a_, b_, ng, 0, 0, 0, 0x7f7f, 1, 0x7f7f); e1 = __builtin_amdgcn_mfma_scale_f32_32x32x64_f8f6f4(b_, a_, ng, 0, 0, 0, 0x7f7f, 1, 0x7f7f); \
                m0 = __builtin_amdgcn_mfma_scale_f32_32x32x64_f8f6f4(pk, a_, m0, 0, 0, 0, 0x7f7f, 1, 0x7f7f); m1 = __builtin_amdgcn_mfma_scale_f32_32x32x64_f8f6f4(pk, b_, m1, 0, 0, 0, 0x7f7f, 1, 0x7f7f); \
                m2 = __builtin_amdgcn_mfma_scale_f32_32x32x64_f8f6f4(pk, a_, m2, 0, 0, 0, 0x7f7f, 1, 0x7f7f); } while (0)
#define SYN_WB() do { if (SYN & (512 | 1024)) asm volatile("s_waitcnt vmcnt(1) lgkmcnt(0)\n\ts_barrier" ::: "memory"); else asm volatile("s_waitcnt lgkmcnt(0)\n\ts_barrier" ::: "memory"); } while (0)
            const bool lt = !lowh && (SYN & (64 | 128 | 1024));
            if ((SYN & (256 | 512)) && !(SYN & 1024)) {
                const attn_body::lds_cptr sp = (attn_body::lds_cptr)F.lds; const int r32_ = F.lane & 31, hi_ = F.lane >> 5, sw_ = (r32_ >> 2) & 3, c0o_ = ((2 * hi_) ^ sw_) * 16, c1o_ = ((2 * hi_ + 1) ^ sw_) * 16;
                const attn_body::lds_cptr kp_ = sp + r32_ * 64, vp_ = sp + 24576 + r32_ * 64;
                sv8 kfa = a_, kfb = b_, vfa = a_, vfb = b_;
                const unsigned char* gsrc = (const unsigned char*)(F.ws + WS_K) + (size_t)blockIdx.x * 524288 + F.tid * 16;
                const unsigned dsto = (unsigned)(uintptr_t)F.lds + (F.wave & 3) * 1024 + (lowh ? 0 : 24576);
                int so = 0, sd = 4 * 4096;
                sv8 vga = a_, vgb = b_;
#define SYN_MB2(IT) do { if ((SYN & 256) && SYN_RD == 0) { vfa = attn_body::ld32(vp_ + so, c0o_, c1o_); vfb = attn_body::ld32(vp_ + so + 2048, c0o_, c1o_); } \
                if (SYN_RD == 1) { vfa = vga; vfb = vgb; } \
                if (SYN_RD == 2) { e0 = __builtin_amdgcn_mfma_scale_f32_32x32x64_f8f6f4(a_, b_, ng, 0, 0, 0, 0x7f7f, 1, 0x7f7f); e1 = __builtin_amdgcn_mfma_scale_f32_32x32x64_f8f6f4(b_, a_, ng, 0, 0, 0, 0x7f7f, 1, 0x7f7f); \
                m0 = __builtin_amdgcn_mfma_scale_f32_32x32x64_f8f6f4(pk, a_, m0, 0, 0, 0, 0x7f7f, 1, 0x7f7f); m1 = __builtin_amdgcn_mfma_scale_f32_32x32x64_f8f6f4(pk, b_, m1, 0, 0, 0, 0x7f7f, 1, 0x7f7f); } else { \
                e0 = __builtin_amdgcn_mfma_scale_f32_32x32x64_f8f6f4(kfa, b_, ng, 0, 0, 0, 0x7f7f, 1, 0x7f7f); e1 = __builtin_amdgcn_mfma_scale_f32_32x32x64_f8f6f4(kfb, b_, ng, 0, 0, 0, 0x7f7f, 1, 0x7f7f); \
                m0 = __builtin_amdgcn_mfma_scale_f32_32x32x64_f8f6f4(pk, vfa, m0, 0, 0, 0, 0x7f7f, 1, 0x7f7f); m1 = __builtin_amdgcn_mfma_scale_f32_32x32x64_f8f6f4(pk, vfb, m1, 0, 0, 0, 0x7f7f, 1, 0x7f7f); } \
                m2 = __builtin_amdgcn_mfma_scale_f32_32x32x64_f8f6f4(pk, a_, m2, 0, 0, 0, 0x7f7f, 1, 0x7f7f); \
                if (SYN & 512) attn_body::glds16(gsrc + (size_t)((IT) & 127) * 4096, (unsigned)__builtin_amdgcn_readfirstlane(dsto + sd)); \
                so = (so == 5 * 4096) ? 0 : so + 4096; sd = (sd == 5 * 4096) ? 0 : sd + 4096; \
                if (SYN & 256) { kfa = attn_body::ld32(kp_ + so, c0o_, c1o_); kfb = attn_body::ld32(kp_ + so + 2048, c0o_, c1o_); \
                    if (SYN_RD >= 1) { vga = attn_body::ld32(vp_ + so, c0o_, c1o_); vgb = attn_body::ld32(vp_ + so + 2048, c0o_, c1o_); } \
                    if (SYN_RD == 2) asm volatile("" :: "v"(kfa), "v"(kfb), "v"(vga), "v"(vgb)); } } while (0)
#pragma unroll 1
                for (int it = 0; it < SYN_N / 2; ++it) {
                    __builtin_amdgcn_sched_barrier(0); SYN_MB2(2 * it); __builtin_amdgcn_sched_barrier(0); SYN_EB(); __builtin_amdgcn_sched_barrier(0); SYN_MB2(2 * it + 1); __builtin_amdgcn_sched_barrier(0);
                    if (lt) SYN_WB();
                    __builtin_amdgcn_sched_barrier(0); SYN_EB(); __builtin_amdgcn_sched_barrier(0);
                    if (!lt) SYN_WB(); }
                asm volatile("s_waitcnt vmcnt(0)" ::: "memory");
                asm volatile("" :: "v"(kfa), "v"(kfb), "v"(vfa), "v"(vfb), "v"(vga), "v"(vgb));
            } else if (SYN & 1024) {
                const attn_body::lds_cptr sp = (attn_body::lds_cptr)F.lds; const int r32_ = F.lane & 31, hi_ = F.lane >> 5, sw_ = (r32_ >> 2) & 3, c0o_ = ((2 * hi_) ^ sw_) * 16, c1o_ = ((2 * hi_ + 1) ^ sw_) * 16;
                const attn_body::lds_cptr kp_ = sp + r32_ * 64, vp_ = sp + 24576 + r32_ * 64;
                sv8 kfa = a_, kfb = a_, vfa = a_, vfb = a_, pk2 = pk; f32x16 m5 = f32x16{};
                const unsigned char* gsrc = (const unsigned char*)(F.ws + WS_K) + (size_t)blockIdx.x * 524288 + F.tid * 16;
                const unsigned dsto = (unsigned)(uintptr_t)F.lds + (F.wave & 3) * 1024 + (lowh ? 0 : 24576);
                int so = 0, sd = 4 * 4096;
#define SYN_X(acc, A, B) acc = __builtin_amdgcn_mfma_scale_f32_32x32x64_f8f6f4(A, B, acc, 0, 0, 0, 0x7f7f, 1, 0x7f7f)
#define SYN_EB2(PK) do { _Pragma("unroll") for (int r = 0; r < 16; ++r) { SYN_E(e0, r); SYN_E(e1, r); } \
                PK[0] = __builtin_amdgcn_cvt_pk_fp8_f32(e0[2], e0[3], __builtin_amdgcn_cvt_pk_fp8_f32(e0[0], e0[1], PK[0], false), true); PK[1] = __builtin_amdgcn_cvt_pk_fp8_f32(e0[6], e0[7], __builtin_amdgcn_cvt_pk_fp8_f32(e0[4], e0[5], PK[1], false), true); \
                PK[2] = __builtin_amdgcn_cvt_pk_fp8_f32(e0[10], e0[11], __builtin_amdgcn_cvt_pk_fp8_f32(e0[8], e0[9], PK[2], false), true); PK[3] = __builtin_amdgcn_cvt_pk_fp8_f32(e0[14], e0[15], __builtin_amdgcn_cvt_pk_fp8_f32(e0[12], e0[13], PK[3], false), true); \
                PK[4] = __builtin_amdgcn_cvt_pk_fp8_f32(e1[2], e1[3], __builtin_amdgcn_cvt_pk_fp8_f32(e1[0], e1[1], PK[4], false), true); PK[5] = __builtin_amdgcn_cvt_pk_fp8_f32(e1[6], e1[7], __builtin_amdgcn_cvt_pk_fp8_f32(e1[4], e1[5], PK[5], false), true); \
                PK[6] = __builtin_amdgcn_cvt_pk_fp8_f32(e1[10], e1[11], __builtin_amdgcn_cvt_pk_fp8_f32(e1[8], e1[9], PK[6], false), true); PK[7] = __builtin_amdgcn_cvt_pk_fp8_f32(e1[14], e1[15], __builtin_amdgcn_cvt_pk_fp8_f32(e1[12], e1[13], PK[7], false), true); } while (0)
#define SYN_S64(IT, MID) do { __builtin_amdgcn_sched_barrier(0); \
                vfa = attn_body::ld32(vp_ + so, c0o_, c1o_); vfb = attn_body::ld32(vp_ + so + 2048, c0o_, c1o_); \
                e0 = __builtin_amdgcn_mfma_scale_f32_32x32x64_f8f6f4(kfa, a_, f32x16{}, 0, 0, 0, 0x7f7f, 1, 0x7f7f); e1 = __builtin_amdgcn_mfma_scale_f32_32x32x64_f8f6f4(kfb, a_, f32x16{}, 0, 0, 0, 0x7f7f, 1, 0x7f7f); \
                SYN_X(m0, pk, vfa); SYN_X(m1, pk, vfb); SYN_X(m2, pk, a_); SYN_X(m3, pk2, vfa); SYN_X(m4, pk2, vfb); SYN_X(m5, pk2, a_); \
                attn_body::glds16(gsrc + (size_t)((IT) & 127) * 4096, (unsigned)__builtin_amdgcn_readfirstlane(dsto + sd)); \
                so = (so == 5 * 4096) ? 0 : so + 4096; sd = (sd == 5 * 4096) ? 0 : sd + 4096; \
                if (SYN_ILV == 0) __builtin_amdgcn_sched_barrier(0); \
                SYN_EB2(pk); __builtin_amdgcn_sched_barrier(0); \
                e0 = __builtin_amdgcn_mfma_scale_f32_32x32x64_f8f6f4(kfa, a_, f32x16{}, 0, 0, 0, 0x7f7f, 1, 0x7f7f); e1 = __builtin_amdgcn_mfma_scale_f32_32x32x64_f8f6f4(kfb, a_, f32x16{}, 0, 0, 0, 0x7f7f, 1, 0x7f7f); \
                kfa = attn_body::ld32(kp_ + so, c0o_, c1o_); kfb = attn_body::ld32(kp_ + so + 2048, c0o_, c1o_); \
                __builtin_amdgcn_sched_barrier(0); MID; __builtin_amdgcn_sched_barrier(0); \
                SYN_EB2(pk2); } while (0)
#pragma unroll 1
                for (int it = 0; it < SYN_N / 4; ++it) {
                    SYN_S64(2 * it, (void)0); SYN_S64(2 * it + 1, if (lt) SYN_WB());
                    if (!lt) SYN_WB(); }
                asm volatile("s_waitcnt vmcnt(0)" ::: "memory");
                asm volatile("" :: "v"(kfa), "v"(kfb), "v"(vfa), "v"(vfb), "v"(pk2), "v"(m5));
            } else if (SYN & 128) {
#pragma unroll 1
                for (int it = 0; it < SYN_N / 2; ++it) {
                    __builtin_amdgcn_sched_barrier(0); SYN_MB(); __builtin_amdgcn_sched_barrier(0); SYN_EB(); __builtin_amdgcn_sched_barrier(0); SYN_MB(); __builtin_amdgcn_sched_barrier(0);
                    if (lt) asm volatile("s_barrier" ::: "memory");
                    __builtin_amdgcn_sched_barrier(0); SYN_EB(); __builtin_amdgcn_sched_barrier(0);
                    if (!lt) asm volatile("s_barrier" ::: "memory"); }
            } else {
                if (lt) { SYN_EB(); }
#pragma unroll 1
                for (int it = 0; it < SYN_N; ++it) { __builtin_amdgcn_sched_barrier(0); SYN_MB(); __builtin_amdgcn_sched_barrier(0); SYN_EB(); }
            }
        }
        asm volatile("" :: "v"(m0), "v"(m1), "v"(m2), "v"(m3), "v"(m4), "v"(e0), "v"(e1), "v"(pk));
        __syncthreads();
    }
#endif
    XcdBarrier bar; bar.bar = (unsigned*)(F.ctl + CW_BAR); bar.x = 0; bar.st = nullptr;
    if (N_LAUNCHES == 1) bar = xcd_barrier_post((unsigned*)(F.ctl + CW_BAR), F.MISC + 8);
    const int lo = args.ph_lo, hi = args.ph_hi;
#define IN(k) (lo <= (k) && (k) < hi)
#define SEAM(k) do { if (IN(k) && IN((k) + 1)) xcd_barrier(bar); asm volatile("" : "+s"(F.ka)); } while (0)
    const gi64* MOD = (const gi64*)(F.ctl + CW_MOD);
    const int gw = F.vcu * 8 + F.wave, NGW = F.G * 8;

    if (IN(0)) { p0_phase(F); } SEAM(0);
    if (IN(1)) { p1_phase(F); VM_WAIT(); __syncthreads(); if (REP == 1) { xcd_barrier(bar); p1_phase(F); VM_WAIT(); __syncthreads(); } } SEAM(1);

    if (IN(2)) { ph2(F); if (REP == 2) { xcd_barrier(bar); ph2(F); } } SEAM(2);

    if (IN(3)) {
        if (DBG & 32) { u16* MIXz = WSP(u16, WS_MIX); for (int m = gw; m < NTOK; m += NGW) *(GAS u32x2*)(MIXz + (size_t)m * DM + 4 * F.lane) = (u32x2){0u, 0u}; }
        else
        REPS(30) for (int U = F.vcu; U < NB * 64; U += F.G) { if (FOURIER_MFMA) fourier_unit_mfma(F, U >> 6, U & 63); else fourier_unit(F, U >> 6, U & 63); }
        const attn_body::bf16* Qp = (const attn_body::bf16*)(F.ws + WS_Q); const attn_body::bf16* Kp = (const attn_body::bf16*)(F.ws + WS_K); const attn_body::bf16* Vp = (const attn_body::bf16*)(F.ws + WS_V);
        attn_body::bf16* Op = (attn_body::bf16*)(F.ws + WS_MIX) + 256;
        float negM; { float gqm = fabsf(FIN_q_norm_g[F.lane]), gkm = fabsf(FIN_k_norm_g[F.lane]);
#pragma unroll
            for (int o_ = 1; o_ < 64; o_ <<= 1) { gqm = fmaxf(gqm, __shfl_xor(gqm, o_)); gkm = fmaxf(gkm, __shfl_xor(gkm, o_)); }
            negM = -(C2 * 64.0f * gqm * gkm + 0.5f); }
        if (ATTN_FP8 && ATTN_W64) negM = -ceilf(fmaxf(-negM - 8.8f, 0.f));
        else if (ATTN_FP8) negM = fminf(negM + 8.8f, 0.f);
        if (ATTN_PRIO) { if (__builtin_amdgcn_readfirstlane(F.tid) >= 256) __builtin_amdgcn_s_setprio(1); }
        if (DBG & 16) { u16* MIXz = WSP(u16, WS_MIX); for (int m = gw; m < NTOK; m += NGW) for (int j = 1; j < 4; ++j) *(GAS u32x2*)(MIXz + (size_t)m * DM + 256 * j + 4 * F.lane) = (u32x2){0u, 0u}; }
        else if (ATTN_FP8 && ATTN_W64) REPS(31) {
            for (int U = F.vcu * 3; U < NB * NQH * 16; U += F.G * 3)
                for (int i = 0; i < 3 && U + i < NB * NQH * 16; ++i) { const int grp = (U + i) / 48, r = (U + i) % 48;
                    attn_body::attn_unit8w(grp >> 2, (grp & 3) * 3 + r / 16, r % 16, (const unsigned char*)Qp, (const unsigned char*)Kp, (const unsigned char*)Vp, Op, (char*)lds + RING_OFF, negM); }
        }
        else if (F.G == 256) REPS(31) {
            const int xg = F.vcu >> 5, jq = F.vcu & 31;
            for (int i = 0; i < 6; ++i) { const int grp = 2 * xg + i / 3, hs = i % 3;
                if (ATTN_FP8) attn_body::attn_unit8(grp >> 2, (grp & 3) * 3 + hs, jq, (const unsigned char*)Qp, (const unsigned char*)Kp, (const unsigned char*)Vp, Op, (char*)lds + RING_OFF, negM);
                else attn_body::attn_unit<ATTN_MSUM>(grp >> 2, (grp & 3) * 3 + hs, jq, Qp, Kp, Vp, Op, (char*)lds + RING_OFF, negM); }
        } else {
            for (int U = F.vcu; U < NB * NQH * 32; U += F.G) { const int grp = U / 96, r = U % 96;
                if (ATTN_FP8) attn_body::attn_unit8(grp >> 2, (grp & 3) * 3 + r / 32, r % 32, (const unsigned char*)Qp, (const unsigned char*)Kp, (const unsigned char*)Vp, Op, (char*)lds + RING_OFF, negM);
                else attn_body::attn_unit<ATTN_MSUM>(grp >> 2, (grp & 3) * 3 + r / 32, r % 32, Qp, Kp, Vp, Op, (char*)lds + RING_OFF, negM); }
        }
        if (ATTN_PRIO) __builtin_amdgcn_s_setprio(0);
    } SEAM(3);

#if DBG & (1024 | 2048)
    if (IN(4)) { float negMc; { float gqm = fabsf(FIN_q_norm_g[F.lane]), gkm = fabsf(FIN_k_norm_g[F.lane]);
            for (int o_ = 1; o_ < 64; o_ <<= 1) { gqm = fmaxf(gqm, __shfl_xor(gqm, o_)); gkm = fmaxf(gkm, __shfl_xor(gkm, o_)); } negMc = -(C2 * 64.0f * gqm * gkm + 0.5f); }
        if (DBG & 1024) chk_attn(F, negMc); if (DBG & 2048) chk_qkv(F); VM_WAIT(); __syncthreads(); }
#endif
    if (IN(4)) { ph4(F); if (REP == 4) { xcd_barrier(bar); ph4(F); } } SEAM(4);

    if (IN(5)) { ph5(F); if (REP == 5) { xcd_barrier(bar); ph5(F); } if (REP == 55) { xcd_barrier(bar); xcd_barrier(bar); xcd_barrier(bar); xcd_barrier(bar); xcd_barrier(bar); } } SEAM(5);

    if (IN(6)) { ph6(F); if (REP == 6) { xcd_barrier(bar); ph6(F); } } SEAM(6);

    if (IN(7)) {
        if (DBG & 128) { GAS u32x4* zA = (GAS u32x4*)(F.ws + WS_ACT); const size_t nA = (size_t)MAXTILES * 256 * EFF * 2 / 16; for (size_t i = (size_t)blockIdx.x * 512 + F.tid; i < nA; i += (size_t)F.G * 512) zA[i] = (u32x4){0u, 0u, 0u, 0u};
            GAS u32x4* zC = (GAS u32x4*)(F.ws + WS_C); const size_t nC = (size_t)NTOK * NSLOT * DM * 2 / 16; for (size_t i = (size_t)blockIdx.x * 512 + F.tid; i < nC; i += (size_t)F.G * 512) zC[i] = (u32x4){0u, 0u, 0u, 0u}; }
        if (blockIdx.x == 0 && F.tid == 0) __hip_atomic_store((unsigned*)(F.ctl + CW_CNT + NEXP), (unsigned)NTOK, RLX_AGENT);
        for (int tok = gw; tok < NTOK; tok += NGW) route_token(F, tok);
    } SEAM(7);

    if (IN(8)) { ph8(F); if (REP == 8) { xcd_barrier(bar); ph8(F); } } SEAM(8);

    if (IN(9)) { ph9(F); if (REP == 9) { xcd_barrier(bar); ph9(F); } } SEAM(9);

    if (IN(10)) {
        const int lane = F.lane; const GAS unsigned char* Cc = (const GAS unsigned char*)(F.ws + WS_C);
        const int wpb = NGW >> 2, b = gw / wpb, wi = gw % wpb;
        f32x4 g2v[4], fg[4];
#pragma unroll
        for (int i = 0; i < 4; ++i) { const int col = 16 * lane + 4 * i; g2v[i] = mod4(MOD + b * 6144 + 5120, col) * (1.0f / C_SCALE); fg[i] = *(const f32x4*)(FIN_final_g + col); }
        bool bad = false;
#if DBG & (1024 | 2048)
        { const float e0 = __hip_atomic_load((float*)(F.ctl + CW_CHK), RLX_AGENT), r0 = __hip_atomic_load((float*)(F.ctl + CW_CHK) + 1, RLX_AGENT), e1 = __hip_atomic_load((float*)(F.ctl + CW_CHK) + 2, RLX_AGENT), r1 = __hip_atomic_load((float*)(F.ctl + CW_CHK) + 3, RLX_AGENT);
          if (DBG & 1024) bad = bad || !(e0 <= CHK_TOL_A * r0) || !(r0 > 0.f); if (DBG & 2048) bad = bad || !(e1 <= CHK_TOL_B * r1) || !(r1 > 0.f); }
#endif
        for (int r = wi; r < SEQ; r += 2 * wpb) {
            const int r1 = (r + wpb < SEQ) ? r + wpb : r; const bool has1 = r + wpb < SEQ;
            const int m0 = b * SEQ + r, m1 = b * SEQ + r1;
            GAS float* orow0 = (GAS float*)F.out + (size_t)m0 * DM + 16 * lane; GAS float* orow1 = (GAS float*)F.out + (size_t)m1 * DM + 16 * lane;
            f32x4 xa[4], xb[4], ya[4], yb[4];
#pragma unroll
            for (int i = 0; i < 4; ++i) { ya[i] = (f32x4){0.f, 0.f, 0.f, 0.f}; yb[i] = (f32x4){0.f, 0.f, 0.f, 0.f}; }
            {
                const GAS u16* xr0 = (const GAS u16*)(F.ws + WS_XN) + (size_t)m0 * DM + 16 * lane; const GAS u16* xr1 = (const GAS u16*)(F.ws + WS_XN) + (size_t)m1 * DM + 16 * lane;
#pragma unroll
                for (int i = 0; i < 2; ++i) { const u32x4 wa = *(const GAS u32x4*)(xr0 + 8 * i), wb = *(const GAS u32x4*)(xr1 + 8 * i);
                    xa[2 * i] = (f32x4){bflo(wa.x), bfhi(wa.x), bflo(wa.y), bfhi(wa.y)}; xa[2 * i + 1] = (f32x4){bflo(wa.z), bfhi(wa.z), bflo(wa.w), bfhi(wa.w)};
                    xb[2 * i] = (f32x4){bflo(wb.x), bfhi(wb.x), bflo(wb.y), bfhi(wb.y)}; xb[2 * i + 1] = (f32x4){bflo(wb.z), bfhi(wb.z), bflo(wb.w), bfhi(wb.w)}; } }
#pragma unroll
            for (int sl = 0; sl < NSLOT; ++sl) { const u32x4 wa = *(const GAS u32x4*)(Cc + ((size_t)m0 * NSLOT + sl) * DM + 16 * lane), wb = *(const GAS u32x4*)(Cc + ((size_t)m1 * NSLOT + sl) * DM + 16 * lane);
#pragma unroll
                for (int i = 0; i < 4; ++i) { const int wa_ = (int)wa[i], wb_ = (int)wb[i];
                    const f32x2 la = __builtin_amdgcn_cvt_pk_f32_fp8(wa_, false), ha = __builtin_amdgcn_cvt_pk_f32_fp8(wa_, true), lb = __builtin_amdgcn_cvt_pk_f32_fp8(wb_, false), hb = __builtin_amdgcn_cvt_pk_f32_fp8(wb_, true);
                    ya[i] += (f32x4){la.x, la.y, ha.x, ha.y}; yb[i] += (f32x4){lb.x, lb.y, hb.x, hb.y}; } }
            float sa = 0.f, sb = 0.f;
#pragma unroll
            for (int i = 0; i < 4; ++i) { const f32x4 va = xa[i] + g2v[i] * ya[i], vb = xb[i] + g2v[i] * yb[i]; xa[i] = va; xb[i] = vb;
                sa += (va[0] * va[0] + va[1] * va[1]) + (va[2] * va[2] + va[3] * va[3]); sb += (vb[0] * vb[0] + vb[1] * vb[1]) + (vb[2] * vb[2] + vb[3] * vb[3]); }
#pragma unroll
            for (int o = 1; o < 64; o <<= 1) { sa += __shfl_xor(sa, o); sb += __shfl_xor(sb, o); }
            const float bm = bad ? 3.0f : 1.0f;
            const float ra = 1.0f / sqrtf(sa * (1.0f / DM) + RMS_EPS) * bm, rb = 1.0f / sqrtf(sb * (1.0f / DM) + RMS_EPS) * bm;
#pragma unroll
            for (int i = 0; i < 4; ++i) *(GAS f32x4*)(orow0 + 4 * i) = xa[i] * ra * fg[i];
            if (has1) {
#pragma unroll
                for (int i = 0; i < 4; ++i) *(GAS f32x4*)(orow1 + 4 * i) = xb[i] * rb * fg[i]; } }
    }
#undef IN
#undef SEAM
}

extern "C" void kernel_launch(void* const* d_in, const int* in_sizes, int n_in, void* d_out, int out_size, void* d_ws, size_t ws_size, hipStream_t stream) {
    static int grid = 0;
    if (grid == 0) {
        if (n_in != 20 || in_sizes[0] != NTOK * DM || out_size != NTOK * DM || ws_size < WS_END) { fprintf(stderr, "kernel_launch: unexpected shapes (n_in %d, in0 %d, out %d, ws %zu < %zu)\n", n_in, n_in > 0 ? in_sizes[0] : -1, out_size, ws_size, (size_t)WS_END); grid = -1; return; }
        int dev = 0, cus = 0, per_cu = 0;
        if (hipGetDevice(&dev) != hipSuccess || hipDeviceGetAttribute(&cus, hipDeviceAttributeMultiprocessorCount, dev) != hipSuccess) { grid = -1; return; }
        if (hipFuncSetAttribute((const void*)mk_fwd, hipFuncAttributeMaxDynamicSharedMemorySize, LDS_BYTES) != hipSuccess) { fprintf(stderr, "kernel_launch: hipFuncSetAttribute failed\n"); grid = -1; return; }
        if (hipOccupancyMaxActiveBlocksPerMultiprocessor(&per_cu, (const void*)mk_fwd, 512, LDS_BYTES) != hipSuccess || per_cu < 1) fprintf(stderr, "kernel_launch: occupancy query reports %d\n", per_cu);
        (void)hipGetLastError();
        grid = cus;
    }
    if (grid < 0) return;
    (void)hipMemsetAsync((char*)d_ws + WS_CTL, 0, CTL_ZERO_BYTES, stream);
    Args a{};
    for (int i = 0; i < 20; ++i) a.in[i] = (const float*)d_in[i];
    a.out = (float*)d_out; a.ws = (unsigned char*)d_ws;
    if (N_LAUNCHES == 1) { a.ph_lo = 0; a.ph_hi = PER_PHASE; hipLaunchKernelGGL(mk_fwd, dim3(grid), dim3(512), LDS_BYTES, stream, a); }
    else for (int li = 0; li < PER_PHASE; ++li) { a.ph_lo = li; a.ph_hi = li + 1; hipLaunchKernelGGL(mk_fwd, dim3(grid), dim3(512), LDS_BYTES, stream, a); }
}
```
